# Optimizing an MI355X kernel written in HIP

```python
import math
import jax
import jax.numpy as jnp
from jax import lax
import numpy as np

D_MODEL = 1024
BATCH = 4
SEQ = 4096
DEPTH = 2

RMS_EPS = 1e-6
CONV_WIDTH = 4
GDN_HEADS = 8
GDN_HEAD_DIM = 128
GDN_CHUNK = 64
SSD_HEADS = 16
SSD_HEAD_DIM = 64
SSD_INNER = SSD_HEADS * SSD_HEAD_DIM
SSD_GROUPS = 2
SSD_STATE = 128
SSD_CHUNK = 128
ATTN_HEADS = 16
ATTN_HEAD_DIM = 64
DILATED_BRANCHES = ((128, 1), (512, 4), (2048, 16))
ATTN_BLOCK = 128
ROPE_THETA = 10000.0
N_EXPERTS = 64
TOP_K = 8
N_EXPERT_GROUPS = 8
TOPK_GROUPS = 4
EXPERT_DIM = 256
SHARED_DIM = 256
ROUTED_SCALE = 2.5
MOE_BLOCK = 512

GDN_QK_DIM = GDN_HEADS * GDN_HEAD_DIM
GDN_V_DIM = GDN_HEADS * GDN_HEAD_DIM
SSD_BC_DIM = SSD_GROUPS * SSD_STATE
SSM_IN_SIZES = (2 * GDN_QK_DIM + GDN_V_DIM, GDN_V_DIM, GDN_HEADS, GDN_HEADS,
                SSD_INNER + 2 * SSD_BC_DIM, SSD_INNER, SSD_HEADS)
SSM_IN_DIM = sum(SSM_IN_SIZES)
SSM_OUT_DIM = GDN_V_DIM + SSD_INNER
ATTN_DIM = ATTN_HEADS * ATTN_HEAD_DIM
N_EVEN = (DEPTH + 1) // 2
N_ODD = DEPTH // 2

kernel_name = 'hybrid_deltanet_ssd_dilated_moe'


def rms_norm(x, w):
    xf = x.astype(jnp.float32)
    y = xf * lax.rsqrt(jnp.mean(jnp.square(xf), axis=-1, keepdims=True) + RMS_EPS)
    return (y * w.astype(jnp.float32)).astype(x.dtype)


def l2norm(x):
    return x * lax.rsqrt(jnp.sum(jnp.square(x), axis=-1, keepdims=True) + 1e-6)


def split_cols(t, sizes):
    out, start = [], 0
    for s in sizes:
        out.append(t[..., start:start + s])
        start += s
    return out


def causal_dwconv(x, w):
    ksz, ch = w.shape
    return lax.conv_general_dilated(x, w[:, None, :].astype(x.dtype), window_strides=(1,),
                                    padding=[(ksz - 1, 0)], dimension_numbers=('NWC', 'WIO', 'NWC'),
                                    feature_group_count=ch)


def gated_delta_rule(q, k, v, g, beta):
    bsz, s, h, dk = q.shape
    dv = v.shape[-1]
    c = GDN_CHUNK
    n = s // c
    to_chunks = lambda t: t.reshape(bsz, n, c, h, -1).transpose(0, 3, 1, 2, 4)
    q = to_chunks(q) * (dk ** -0.5)
    k = to_chunks(k)
    v = to_chunks(v)
    g = jnp.cumsum(g.reshape(bsz, n, c, h).transpose(0, 3, 1, 2), axis=-1)
    beta = beta.reshape(bsz, n, c, h).transpose(0, 3, 1, 2)
    causal = jnp.tril(jnp.ones((c, c), dtype=bool))
    strict = jnp.tril(jnp.ones((c, c), dtype=bool), -1)
    decay = jnp.exp(jnp.where(causal, g[..., :, None] - g[..., None, :], -jnp.inf))
    kb = k * beta[..., None]
    a_mat = jnp.where(strict, jnp.einsum('bhnid,bhnjd->bhnij', kb, k) * decay, 0.0)
    rhs = jnp.concatenate([v * beta[..., None], kb * jnp.exp(g)[..., None]], axis=-1)
    sol = lax.linalg.triangular_solve(a_mat + jnp.eye(c, dtype=a_mat.dtype), rhs,
                                      left_side=True, lower=True)
    u, w = sol[..., :dv], sol[..., dv:]
    qk = jnp.where(causal, jnp.einsum('bhnid,bhnjd->bhnij', q, k) * decay, 0.0)
    q_dec = q * jnp.exp(g)[..., None]
    g_last = g[..., -1]
    k_end = k * jnp.exp(g_last[..., None] - g)[..., None]

    def step(state, xs):
        qd_c, qk_c, u_c, w_c, ke_c, gl_c = xs
        v_new = u_c - jnp.einsum('bhck,bhkv->bhcv', w_c, state)
        o = jnp.einsum('bhck,bhkv->bhcv', qd_c, state) + jnp.einsum('bhij,bhjv->bhiv', qk_c, v_new)
        state = state * jnp.exp(gl_c)[..., None, None] + jnp.einsum('bhck,bhcv->bhkv', ke_c, v_new)
        return state, o

    xs = tuple(jnp.moveaxis(t, 2, 0) for t in (q_dec, qk, u, w, k_end, g_last))
    _, o = lax.scan(step, jnp.zeros((bsz, h, dk, dv), jnp.float32), xs)
    return o.transpose(1, 0, 3, 2, 4).reshape(bsz, s, h, dv)


def ssd_chunk_scan(x, dt, a_neg, b_in, c_in):
    bsz, s, h, p = x.shape
    grp, nst = b_in.shape[2], b_in.shape[3]
    r = h // grp
    lc = SSD_CHUNK
    nc = s // lc
    xd = (x * dt[..., None]).reshape(bsz, nc, lc, grp, r, p)
    a = (dt * a_neg).reshape(bsz, nc, lc, grp, r).transpose(0, 3, 4, 1, 2)
    a_cum = jnp.cumsum(a, axis=-1)
    bc = b_in.reshape(bsz, nc, lc, grp, nst)
    cc = c_in.reshape(bsz, nc, lc, grp, nst)
    causal = jnp.tril(jnp.ones((lc, lc), dtype=bool))
    seg = jnp.exp(jnp.where(causal, a_cum[..., :, None] - a_cum[..., None, :], -jnp.inf))
    cb = jnp.einsum('bclgn,bcsgn->bgcls', cc, bc)
    y_diag = jnp.einsum('bgcls,bgrcls,bcsgrp->bclgrp', cb, seg, xd)
    decay_to_end = jnp.exp(a_cum[..., -1:] - a_cum)
    states = jnp.einsum('bcsgn,bgrcs,bcsgrp->cbgrpn', bc, decay_to_end, xd)
    chunk_decay = jnp.moveaxis(jnp.exp(a_cum[..., -1]), -1, 0)

    def step(hs, inp):
        st, dec = inp
        return hs * dec[..., None, None] + st, hs

    _, h_prev = lax.scan(step, jnp.zeros(states.shape[1:], states.dtype), (states, chunk_decay))
    y_off = jnp.einsum('bclgn,cbgrpn,bgrcl->bclgrp', cc, h_prev, jnp.exp(a_cum))
    return (y_diag + y_off).reshape(bsz, s, h, p)


def ssm_hybrid_mixer(h, w_in, gdn_conv_w, gdn_a_log, gdn_dt_bias, gdn_norm_w,
                     ssd_conv_w, ssd_conv_b, ssd_a_log, ssd_dt_bias, ssd_d, ssd_norm_w, w_out):
    bsz, s, _ = h.shape
    f32 = jnp.float32
    proj = h @ w_in
    qkv, z_a, beta_a, dec_a, xbc, z_b, dt_b = split_cols(proj, SSM_IN_SIZES)
    qkv = jax.nn.silu(causal_dwconv(qkv, gdn_conv_w)).astype(f32)
    q, k, v = split_cols(qkv, (GDN_QK_DIM, GDN_QK_DIM, GDN_V_DIM))
    q = l2norm(q.reshape(bsz, s, GDN_HEADS, GDN_HEAD_DIM))
    k = l2norm(k.reshape(bsz, s, GDN_HEADS, GDN_HEAD_DIM))
    v = v.reshape(bsz, s, GDN_HEADS, GDN_HEAD_DIM)
    beta = jax.nn.sigmoid(beta_a.astype(f32))
    g = -jnp.exp(gdn_a_log.astype(f32)) * jax.nn.softplus(dec_a.astype(f32) + gdn_dt_bias.astype(f32))
    o_a = gated_delta_rule(q, k, v, g, beta)
    z_a = z_a.astype(f32).reshape(bsz, s, GDN_HEADS, GDN_HEAD_DIM)
    o_a = (rms_norm(o_a, gdn_norm_w) * jax.nn.silu(z_a)).reshape(bsz, s, GDN_V_DIM)
    xbc = jax.nn.silu(causal_dwconv(xbc, ssd_conv_w) + ssd_conv_b).astype(f32)
    xs, b_in, c_in = split_cols(xbc, (SSD_INNER, SSD_BC_DIM, SSD_BC_DIM))
    xs = xs.reshape(bsz, s, SSD_HEADS, SSD_HEAD_DIM)
    b_in = b_in.reshape(bsz, s, SSD_GROUPS, SSD_STATE)
    c_in = c_in.reshape(bsz, s, SSD_GROUPS, SSD_STATE)
    dt = jax.nn.softplus(dt_b.astype(f32) + ssd_dt_bias.astype(f32))
    a_neg = -jnp.exp(ssd_a_log.astype(f32))
    y = ssd_chunk_scan(xs, dt, a_neg, b_in, c_in) + ssd_d.astype(f32)[:, None] * xs
    y = y.reshape(bsz, s, SSD_INNER) * jax.nn.silu(z_b.astype(f32))
    y = rms_norm(y.reshape(bsz, s, SSD_GROUPS, -1), ssd_norm_w.reshape(SSD_GROUPS, -1))
    y = y.reshape(bsz, s, SSD_INNER)
    return jnp.concatenate([o_a, y], axis=-1).astype(h.dtype) @ w_out


def rope(x, positions):
    half = x.shape[-1] // 2
    inv_freq = ROPE_THETA ** (-jnp.arange(half, dtype=jnp.float32) / half)
    ang = positions.astype(jnp.float32)[..., None] * inv_freq
    cos, sin = jnp.cos(ang)[:, :, None, :], jnp.sin(ang)[:, :, None, :]
    x1, x2 = x[..., :half], x[..., half:]
    return jnp.concatenate([x1 * cos - x2 * sin, x2 * cos + x1 * sin], axis=-1)


def dilated_branch(q, k, v, window, dilation):
    bsz, s, h, dh = q.shape
    length = s // dilation
    span = window // dilation
    blk = ATTN_BLOCK
    lp = -(-length // blk) * blk
    nb = lp // blk

    def to_sub(t):
        t = t.reshape(bsz, length, dilation, h, dh).transpose(0, 2, 1, 3, 4).reshape(bsz * dilation, length, h, dh)
        t = jnp.pad(t, ((0, 0), (0, lp - length), (0, 0), (0, 0)))
        return t.reshape(bsz * dilation, nb, blk, h, dh)

    def with_prev(t):
        prev = jnp.pad(t[:, :-1], ((0, 0), (1, 0), (0, 0), (0, 0), (0, 0)))
        return jnp.concatenate([prev, t], axis=2)

    qb = to_sub(q)
    kk = with_prev(to_sub(k))
    vv = with_prev(to_sub(v))
    sc = jnp.einsum('bnqhd,bnkhd->bnhqk', qb, kk) * (dh ** -0.5)
    dist = (jnp.arange(blk)[:, None] + blk) - jnp.arange(2 * blk)[None, :]
    band = (dist >= 0) & (dist <= span)
    not_first = (jnp.arange(nb)[:, None, None] > 0) | (jnp.arange(2 * blk)[None, None, :] >= blk)
    mask = band[None] & not_first
    sc = jnp.where(mask[None, :, None], sc, -jnp.inf)
    m = jnp.max(sc, axis=-1, keepdims=True)
    p = jnp.exp(sc - m)
    den = jnp.sum(p, axis=-1, keepdims=True)
    o = jnp.einsum('bnhqk,bnkhd->bnhqd', p, vv) / den
    lse = (m + jnp.log(den))[..., 0]
    o = o.transpose(0, 1, 3, 2, 4)
    lse = lse.transpose(0, 1, 3, 2)

    def from_sub(t):
        t = t.reshape(bsz, dilation, lp, *t.shape[3:])[:, :, :length]
        return jnp.moveaxis(t, 1, 2).reshape(bsz, s, *t.shape[3:])

    return from_sub(o), from_sub(lse)


def dilated_attention_mixer(h, positions, w_qkv, w_o):
    bsz, s, _ = h.shape
    q, k, v = split_cols(h @ w_qkv, (ATTN_DIM, ATTN_DIM, ATTN_DIM))
    shp = (bsz, s, ATTN_HEADS, ATTN_HEAD_DIM)
    q = rope(q.reshape(shp).astype(jnp.float32), positions)
    k = rope(k.reshape(shp).astype(jnp.float32), positions)
    v = v.reshape(shp).astype(jnp.float32)
    outs, lses = [], []
    for window, dilation in DILATED_BRANCHES:
        o_i, lse_i = dilated_branch(q, k, v, window, dilation)
        outs.append(o_i)
        lses.append(lse_i)
    wts = jax.nn.softmax(jnp.stack(lses), axis=0)
    o = jnp.einsum('nbsh,nbshd->bshd', wts, jnp.stack(outs))
    return o.reshape(bsz, s, ATTN_DIM).astype(h.dtype) @ w_o


def moe_ffn(h, router_w, router_bias, exp_gate, exp_up, exp_down, sh_gate, sh_up, sh_down):
    bsz, s, d = h.shape
    x = h.reshape(bsz * s, d)
    t = x.shape[0]
    scores = jax.nn.sigmoid((x @ router_w).astype(jnp.float32))
    biased = scores + router_bias.astype(jnp.float32)
    per_group = N_EXPERTS // N_EXPERT_GROUPS
    grp_score = lax.top_k(biased.reshape(t, N_EXPERT_GROUPS, per_group), 2)[0].sum(-1)
    _, grp_idx = lax.top_k(grp_score, TOPK_GROUPS)
    grp_keep = jax.nn.one_hot(grp_idx, N_EXPERT_GROUPS, dtype=jnp.float32).sum(1) > 0
    cand = jnp.where(jnp.repeat(grp_keep, per_group, axis=-1), biased, -jnp.inf)
    _, idx = lax.top_k(cand, TOP_K)
    sel = jnp.take_along_axis(scores, idx, axis=-1)
    gate_w = sel / jnp.sum(sel, axis=-1, keepdims=True) * ROUTED_SCALE
    n_assign = t * TOP_K
    flat_e = idx.reshape(-1)
    order = jnp.argsort(flat_e)
    e_sorted = flat_e[order]
    counts = jnp.bincount(flat_e, length=N_EXPERTS)
    padded = (counts + MOE_BLOCK - 1) // MOE_BLOCK * MOE_BLOCK
    pad_end = jnp.cumsum(padded)
    pad_start = pad_end - padded
    start = jnp.cumsum(counts) - counts
    dest = pad_start[e_sorted] + jnp.arange(n_assign) - start[e_sorted]
    n_blocks = -(-n_assign // MOE_BLOCK) + N_EXPERTS
    n_rows = n_blocks * MOE_BLOCK
    row_token = jnp.zeros((n_rows,), jnp.int32).at[dest].set((order // TOP_K).astype(jnp.int32))
    row_w = jnp.zeros((n_rows,), x.dtype).at[dest].set(gate_w.reshape(-1)[order].astype(x.dtype))
    block_expert = jnp.minimum(jnp.searchsorted(pad_end, jnp.arange(n_blocks) * MOE_BLOCK, side='right'),
                               N_EXPERTS - 1)

    def expert_block(args):
        rows, e, rw = args
        xb = x[rows]
        hid = jax.nn.silu(xb @ exp_gate[e]) * (xb @ exp_up[e])
        return (hid @ exp_down[e]) * rw[:, None]

    yb = lax.map(expert_block, (row_token.reshape(n_blocks, MOE_BLOCK), block_expert,
                                row_w.reshape(n_blocks, MOE_BLOCK)))
    routed = jnp.zeros_like(x).at[row_token].add(yb.reshape(n_rows, d))
    shared = (jax.nn.silu(x @ sh_gate) * (x @ sh_up)) @ sh_down
    return (routed + shared).reshape(bsz, s, d)


def setup_inputs(seed: int = 0) -> dict:
    key = jax.random.key(seed)
    ks = iter(jax.random.split(key, 48))
    f32 = jnp.float32

    def nrm(shape, scale):
        return jax.random.normal(next(ks), shape, f32) * scale

    def gain(shape):
        return 1.0 + 0.02 * jax.random.normal(next(ks), shape, f32)

    def a_log(shape):
        return jnp.log(jax.random.uniform(next(ks), shape, f32, 1.0, 16.0))

    def dt_bias(shape):
        dt = jnp.exp(jax.random.uniform(next(ks), shape, f32, math.log(1e-3), math.log(1e-1)))
        return dt + jnp.log(-jnp.expm1(-dt))

    d = D_MODEL
    x = nrm((BATCH, SEQ, d), 1.0)
    c = nrm((BATCH, d), 1.0)
    offsets = jax.random.randint(next(ks), (BATCH, 1), 0, 1024, jnp.int32)
    positions = offsets + jnp.arange(SEQ, dtype=jnp.int32)[None, :]
    return {
        'x': x, 'c': c, 'positions': positions,
        'mod_w': nrm((DEPTH, d, 6 * d), 0.5 * d ** -0.5),
        'mod_b': nrm((DEPTH, 6 * d), 0.02),
        'mix_pre_g': gain((DEPTH, d)), 'mix_post_g': gain((DEPTH, d)),
        'ffn_pre_g': gain((DEPTH, d)), 'ffn_post_g': gain((DEPTH, d)),
        'ssm_w_in': nrm((N_EVEN, d, SSM_IN_DIM), d ** -0.5),
        'gdn_conv_w': nrm((N_EVEN, CONV_WIDTH, 2 * GDN_QK_DIM + GDN_V_DIM), CONV_WIDTH ** -0.5),
        'gdn_a_log': a_log((N_EVEN, GDN_HEADS)),
        'gdn_dt_bias': dt_bias((N_EVEN, GDN_HEADS)),
        'gdn_norm_w': gain((N_EVEN, GDN_HEAD_DIM)),
        'ssd_conv_w': nrm((N_EVEN, CONV_WIDTH, SSD_INNER + 2 * SSD_BC_DIM), CONV_WIDTH ** -0.5),
        'ssd_conv_b': nrm((N_EVEN, SSD_INNER + 2 * SSD_BC_DIM), 0.02),
        'ssd_a_log': a_log((N_EVEN, SSD_HEADS)),
        'ssd_dt_bias': dt_bias((N_EVEN, SSD_HEADS)),
        'ssd_d': gain((N_EVEN, SSD_HEADS)),
        'ssd_norm_w': gain((N_EVEN, SSD_INNER)),
        'ssm_w_out': nrm((N_EVEN, SSM_OUT_DIM, d), SSM_OUT_DIM ** -0.5),
        'attn_w_qkv': nrm((N_ODD, d, 3 * ATTN_DIM), d ** -0.5),
        'attn_w_o': nrm((N_ODD, ATTN_DIM, d), ATTN_DIM ** -0.5),
        'router_w': nrm((DEPTH, d, N_EXPERTS), d ** -0.5),
        'router_bias': nrm((DEPTH, N_EXPERTS), 0.01),
        'exp_gate': nrm((DEPTH, N_EXPERTS, d, EXPERT_DIM), d ** -0.5),
        'exp_up': nrm((DEPTH, N_EXPERTS, d, EXPERT_DIM), d ** -0.5),
        'exp_down': nrm((DEPTH, N_EXPERTS, EXPERT_DIM, d), EXPERT_DIM ** -0.5),
        'shared_gate': nrm((DEPTH, d, SHARED_DIM), d ** -0.5),
        'shared_up': nrm((DEPTH, d, SHARED_DIM), d ** -0.5),
        'shared_down': nrm((DEPTH, SHARED_DIM, d), SHARED_DIM ** -0.5),
    }


def reference(x, c, positions, mod_w, mod_b, mix_pre_g, mix_post_g, ffn_pre_g, ffn_post_g,
              ssm_w_in, gdn_conv_w, gdn_a_log, gdn_dt_bias, gdn_norm_w,
              ssd_conv_w, ssd_conv_b, ssd_a_log, ssd_dt_bias, ssd_d, ssd_norm_w, ssm_w_out,
              attn_w_qkv, attn_w_o,
              router_w, router_bias, exp_gate, exp_up, exp_down, shared_gate, shared_up, shared_down):
    cond = jax.nn.silu(c)
    for layer in range(DEPTH):
        mod = cond @ mod_w[layer] + mod_b[layer]
        sh_m, sc_m, gt_m, sh_f, sc_f, gt_f = [m[:, None, :] for m in jnp.split(mod, 6, axis=-1)]
        j = layer // 2
        h = rms_norm(x, mix_pre_g[layer]) * (1 + sc_m) + sh_m
        if layer % 2 == 0:
            y = ssm_hybrid_mixer(h, ssm_w_in[j], gdn_conv_w[j], gdn_a_log[j], gdn_dt_bias[j], gdn_norm_w[j],
                                 ssd_conv_w[j], ssd_conv_b[j], ssd_a_log[j], ssd_dt_bias[j], ssd_d[j],
                                 ssd_norm_w[j], ssm_w_out[j])
        else:
            y = dilated_attention_mixer(h, positions, attn_w_qkv[j], attn_w_o[j])
        x = x + gt_m * rms_norm(y, mix_post_g[layer])
        h = rms_norm(x, ffn_pre_g[layer]) * (1 + sc_f) + sh_f
        y = moe_ffn(h, router_w[layer], router_bias[layer], exp_gate[layer], exp_up[layer], exp_down[layer],
                    shared_gate[layer], shared_up[layer], shared_down[layer])
        x = x + gt_f * rms_norm(y, ffn_post_g[layer])
    return x
```

```cpp
#include <hip/hip_runtime.h>
#include <stdint.h>
#include <stdio.h>

typedef unsigned short bf16_t;
#define DEV __device__ __forceinline__

constexpr int NB = 4, SEQ = 4096, T = NB * SEQ, D = 1024;
constexpr int PROJ = 6688;
constexpr int C_QKV = 0, C_ZA = 3072, C_BETA = 4096, C_DEC = 4104, C_XBC = 4112, C_ZB = 5648, C_DT = 6672;
constexpr int NE = 64, TOPK = 8, ED = 256;
constexpr float EPS = 1e-6f;

DEV float bf2f(bf16_t v) { return __uint_as_float(((unsigned)v) << 16); }
DEV bf16_t f2bf(float f) { unsigned u = __float_as_uint(f); u += 0x7FFFu + ((u >> 16) & 1u); return (bf16_t)(u >> 16); }
DEV float wave_sum(float v) { for (int o = 32; o > 0; o >>= 1) v += __shfl_xor(v, o); return v; }
DEV float wave_max(float v) { for (int o = 32; o > 0; o >>= 1) v = fmaxf(v, __shfl_xor(v, o)); return v; }
DEV float siluf(float x) { return x / (1.f + __expf(-x)); }
DEV float sigmoidf(float x) { return 1.f / (1.f + __expf(-x)); }
DEV float softplusf(float x) { return fmaxf(x, 0.f) + log1pf(__expf(-fabsf(x))); }

__global__ void k_mod(const float* __restrict__ c, const float* __restrict__ mod_w, const float* __restrict__ mod_b, float* __restrict__ mod) {
    int gid = blockIdx.x * blockDim.x + threadIdx.x;
    if (gid >= 2 * NB * 6 * D) return;
    int col = gid % (6 * D), b = (gid / (6 * D)) % NB, l = gid / (6 * D * NB);
    const float* w = mod_w + (size_t)l * D * 6 * D + col;
    const float* cb = c + b * D;
    float acc = mod_b[l * 6 * D + col];
    for (int k = 0; k < D; ++k) acc += siluf(cb[k]) * w[(size_t)k * 6 * D];
    mod[gid] = acc;
}

__global__ __launch_bounds__(256) void k_rows(const float* xin, const float* __restrict__ y, const float* __restrict__ gpost,
                                              const float* __restrict__ modl  ,
                                              float* xout,
                                              const float* __restrict__ gpre, const float* __restrict__ modn,
                                              bf16_t* __restrict__ hout, int gt_off, int sh_off, int sc_off, int pad_) {
    int row = blockIdx.x * 4 + (threadIdx.x >> 6), lane = threadIdx.x & 63;
    if (row >= T) return;
    int b = row / SEQ;
    float xv[16];
#pragma unroll
    for (int j = 0; j < 4; ++j) { float4 v = *(const float4*)(xin + (size_t)row * D + j * 256 + lane * 4); xv[4*j] = v.x; xv[4*j+1] = v.y; xv[4*j+2] = v.z; xv[4*j+3] = v.w; }
    if (y) {
        float yv[16]; float ss = 0.f;
#pragma unroll
        for (int j = 0; j < 4; ++j) { float4 v = *(const float4*)(y + (size_t)row * D + j * 256 + lane * 4); yv[4*j] = v.x; yv[4*j+1] = v.y; yv[4*j+2] = v.z; yv[4*j+3] = v.w; }
#pragma unroll
        for (int i = 0; i < 16; ++i) ss += yv[i] * yv[i];
        ss = wave_sum(ss);
        float r = rsqrtf(ss * (1.f / D) + EPS);
#pragma unroll
        for (int j = 0; j < 4; ++j)
#pragma unroll
            for (int i = 0; i < 4; ++i) { int col = j * 256 + lane * 4 + i; xv[4*j+i] += modl[b * 6 * D + gt_off + col] * (yv[4*j+i] * r * gpost[col]); }
#pragma unroll
        for (int j = 0; j < 4; ++j) *(float4*)(xout + (size_t)row * D + j * 256 + lane * 4) = make_float4(xv[4*j], xv[4*j+1], xv[4*j+2], xv[4*j+3]);
    }
    if (hout) {
        float ss = 0.f;
#pragma unroll
        for (int i = 0; i < 16; ++i) ss += xv[i] * xv[i];
        ss = wave_sum(ss);
        float r = rsqrtf(ss * (1.f / D) + EPS);
#pragma unroll
        for (int j = 0; j < 4; ++j) {
            bf16_t o[4];
#pragma unroll
            for (int i = 0; i < 4; ++i) { int col = j * 256 + lane * 4 + i; o[i] = f2bf(xv[4*j+i] * r * gpre[col] * (1.f + modn[b * 6 * D + sc_off + col]) + modn[b * 6 * D + sh_off + col]); }
            *(uint2*)(hout + (size_t)row * D + j * 256 + lane * 4) = make_uint2((unsigned)o[0] | ((unsigned)o[1] << 16), (unsigned)o[2] | ((unsigned)o[3] << 16));
        }
    }
}

template <class AL, class EP>
__global__ __launch_bounds__(256) void k_gemm(AL al, EP ep, const float* __restrict__ W, size_t wstride, int ldw, int N, int K, int pad_) {
    __shared__ float As[16][68];
    __shared__ float Bs[16][68];
    const int z = blockIdx.z, M = al.rows(z), m0 = blockIdx.y * 64, n0 = blockIdx.x * 64;
    if (m0 >= M) return;
    const float* Wz = W + (size_t)z * wstride;
    const int tid = threadIdx.x, ty = tid >> 4, tx = tid & 15;
    const int ar = tid >> 2, akq = (tid & 3) * 4, bk = tid >> 4, bn = (tid & 15) * 4;
    const bf16_t* arow = (m0 + ar < M) ? al.rowptr(z, m0 + ar) : nullptr;
    float acc[4][4];
#pragma unroll
    for (int i = 0; i < 4; ++i)
#pragma unroll
        for (int j = 0; j < 4; ++j) acc[i][j] = 0.f;
    for (int k0 = 0; k0 < K; k0 += 16) {
        float a0 = 0.f, a1 = 0.f, a2 = 0.f, a3 = 0.f;
        if (arow) { uint2 v = *(const uint2*)(arow + k0 + akq); a0 = __uint_as_float(v.x << 16); a1 = __uint_as_float(v.x & 0xFFFF0000u); a2 = __uint_as_float(v.y << 16); a3 = __uint_as_float(v.y & 0xFFFF0000u); }
        float4 bv = make_float4(0.f, 0.f, 0.f, 0.f);
        if (n0 + bn < N) bv = *(const float4*)(Wz + (size_t)(k0 + bk) * ldw + n0 + bn);
        __syncthreads();
        As[akq][ar] = a0; As[akq + 1][ar] = a1; As[akq + 2][ar] = a2; As[akq + 3][ar] = a3;
        *(float4*)&Bs[bk][bn] = bv;
        __syncthreads();
#pragma unroll
        for (int kk = 0; kk < 16; ++kk) {
            float4 a = *(const float4*)&As[kk][ty * 4]; float4 b = *(const float4*)&Bs[kk][tx * 4];
            float av[4] = {a.x, a.y, a.z, a.w}, bw[4] = {b.x, b.y, b.z, b.w};
#pragma unroll
            for (int i = 0; i < 4; ++i)
#pragma unroll
                for (int j = 0; j < 4; ++j) acc[i][j] += av[i] * bw[j];
        }
    }
#pragma unroll
    for (int i = 0; i < 4; ++i) { int r = m0 + ty * 4 + i; if (r < M) {
#pragma unroll
        for (int j = 0; j < 4; ++j) { int n = n0 + tx * 4 + j; if (n < N) ep(z, r, n, acc[i][j]); } } }
}

struct ALDense { const bf16_t* A; int lda; int M; DEV int rows(int) const { return M; } DEV const bf16_t* rowptr(int, int r) const { return A + (size_t)r * lda; } };
struct EPBf16 { bf16_t* C; int ldc; int pad_; DEV void operator()(int, int r, int n, float v) const { C[(size_t)r * ldc + n] = f2bf(v); } };
struct EPF32 { float* C; int ldc; int pad_; DEV void operator()(int, int r, int n, float v) const { C[(size_t)r * ldc + n] = v; } };

struct ALGather { const bf16_t* A; const int* cnt; const int* off; const int* list; int lda; int pad_;
    DEV int rows(int z) const { return cnt[z]; } DEV const bf16_t* rowptr(int z, int r) const { return A + (size_t)list[off[z] + r] * lda; } };
struct ALSeg { const bf16_t* A; const int* cnt; const int* off; int lda; int pad_;
    DEV int rows(int z) const { return cnt[z]; } DEV const bf16_t* rowptr(int z, int r) const { return A + (size_t)(off[z] + r) * lda; } };
struct EPSegF32 { float* C; const int* off; int ldc; int pad_; DEV void operator()(int z, int r, int n, float v) const { C[(size_t)(off[z] + r) * ldc + n] = v; } };
struct EPSegHid { const float* G; bf16_t* H; const int* off; int ldc; int pad_; DEV void operator()(int z, int r, int n, float v) const { size_t i = (size_t)(off[z] + r) * ldc + n; float g = G[i]; H[i] = f2bf(siluf(g) * v); } };
struct EPScatterAdd { float* acc; const int* off; const int* list; const float* lw; DEV void operator()(int z, int r, int n, float v) const { int p = off[z] + r; atomicAdd(acc + (size_t)list[p] * D + n, v * lw[p]); } };
struct EPHidDense { const float* G; bf16_t* H; int ldc; int pad_; DEV void operator()(int, int r, int n, float v) const { size_t i = (size_t)r * ldc + n; H[i] = f2bf(siluf(G[i]) * v); } };

__global__ __launch_bounds__(256) void k_gdn_prep(const bf16_t* __restrict__ proj, const float* __restrict__ convw  , const float* __restrict__ a_log,
                                                  const float* __restrict__ dt_bias, bf16_t* __restrict__ qkvn  , float* __restrict__ gb  ) {
    int wid = blockIdx.x * 4 + (threadIdx.x >> 6), lane = threadIdx.x & 63;
    int t = wid >> 3, h = wid & 7; if (t >= T) return;
    int s = t % SEQ;
    float vals[3][2];
#pragma unroll
    for (int part = 0; part < 3; ++part)
#pragma unroll
        for (int e = 0; e < 2; ++e) {
            int c = part * 1024 + h * 128 + lane * 2 + e;
            float acc = 0.f;
#pragma unroll
            for (int i = 0; i < 4; ++i) { int ss = s - 3 + i; if (ss >= 0) acc += convw[i * 3072 + c] * bf2f(proj[(size_t)(t - 3 + i) * PROJ + C_QKV + c]); }
            vals[part][e] = siluf(acc);
        }
#pragma unroll
    for (int part = 0; part < 2; ++part) {
        float ss = wave_sum(vals[part][0] * vals[part][0] + vals[part][1] * vals[part][1]);
        float r = rsqrtf(ss + 1e-6f); vals[part][0] *= r; vals[part][1] *= r;
    }
#pragma unroll
    for (int part = 0; part < 3; ++part) {
        unsigned pk = (unsigned)f2bf(vals[part][0]) | ((unsigned)f2bf(vals[part][1]) << 16);
        *(unsigned*)(qkvn + (size_t)t * 3072 + part * 1024 + h * 128 + lane * 2) = pk;
    }
    if (lane == 0) {
        float beta = sigmoidf(bf2f(proj[(size_t)t * PROJ + C_BETA + h]));
        float g = -__expf(a_log[h]) * softplusf(bf2f(proj[(size_t)t * PROJ + C_DEC + h]) + dt_bias[h]);
        gb[t * 16 + h] = g; gb[t * 16 + 8 + h] = beta;
    }
}

__global__ __launch_bounds__(512) void k_gdn_seq(const bf16_t* __restrict__ qkvn, const float* __restrict__ gb, float* __restrict__ oraw  ) {
    __shared__ float sk[16][128], sq[16][128], sv[16][128], sa[16], sbeta[16];
    __shared__ float red[2][4][128];
    const int b = blockIdx.x >> 3, h = blockIdx.x & 7, tid = threadIdx.x, v = tid & 127, kq = tid >> 7;
    float S[32];
#pragma unroll
    for (int i = 0; i < 32; ++i) S[i] = 0.f;
    const float scale = 0.08838834764831845f;
    for (int t0 = 0; t0 < SEQ; t0 += 16) {
        const size_t tb = (size_t)b * SEQ + t0;
        for (int idx = tid; idx < 16 * 384; idx += 512) {
            int jj = idx / 384, c = idx % 384, part = c >> 7, cc = c & 127;
            float val = bf2f(qkvn[(tb + jj) * 3072 + part * 1024 + h * 128 + cc]);
            if (part == 0) sq[jj][cc] = val; else if (part == 1) sk[jj][cc] = val; else sv[jj][cc] = val;
        }
        if (tid < 16) { sa[tid] = __expf(gb[(tb + tid) * 16 + h]); sbeta[tid] = gb[(tb + tid) * 16 + 8 + h]; }
        __syncthreads();
        for (int j = 0; j < 16; ++j) {
            const float a = sa[j], bt = sbeta[j];
            float p = 0.f;
#pragma unroll
            for (int i = 0; i < 32; ++i) { S[i] *= a; p += sk[j][kq * 32 + i] * S[i]; }
            red[0][kq][v] = p;
            __syncthreads();
            const float kS = red[0][0][v] + red[0][1][v] + red[0][2][v] + red[0][3][v];
            const float delta = bt * (sv[j][v] - kS);
            float po = 0.f;
#pragma unroll
            for (int i = 0; i < 32; ++i) { S[i] += sk[j][kq * 32 + i] * delta; po += sq[j][kq * 32 + i] * S[i]; }
            red[1][kq][v] = po;
            __syncthreads();
            if (kq == 0) oraw[(tb + j) * 1024 + h * 128 + v] = (red[1][0][v] + red[1][1][v] + red[1][2][v] + red[1][3][v]) * scale;
        }
        __syncthreads();
    }
}

__global__ __launch_bounds__(256) void k_gdn_post(const float* __restrict__ oraw, const bf16_t* __restrict__ proj, const float* __restrict__ nw, bf16_t* __restrict__ oy) {
    int wid = blockIdx.x * 4 + (threadIdx.x >> 6), lane = threadIdx.x & 63;
    int t = wid >> 3, h = wid & 7; if (t >= T) return;
    float2 o = *(const float2*)(oraw + (size_t)t * 1024 + h * 128 + lane * 2);
    float ss = wave_sum(o.x * o.x + o.y * o.y);
    float r = rsqrtf(ss * (1.f / 128.f) + EPS);
    int c = h * 128 + lane * 2;
    float z0 = bf2f(proj[(size_t)t * PROJ + C_ZA + c]), z1 = bf2f(proj[(size_t)t * PROJ + C_ZA + c + 1]);
    float y0 = o.x * r * nw[lane * 2] * siluf(z0), y1 = o.y * r * nw[lane * 2 + 1] * siluf(z1);
    *(unsigned*)(oy + (size_t)t * 2048 + c) = (unsigned)f2bf(y0) | ((unsigned)f2bf(y1) << 16);
}

__global__ __launch_bounds__(256) void k_ssd_prep(const bf16_t* __restrict__ proj, const float* __restrict__ convw  , const float* __restrict__ convb,
                                                  const float* __restrict__ dt_bias, bf16_t* __restrict__ xbc, float* __restrict__ dtb) {
    size_t gid = (size_t)blockIdx.x * 256 + threadIdx.x;
    if (gid >= (size_t)T * 1536) return;
    int t = (int)(gid / 1536), c = (int)(gid % 1536), s = t % SEQ;
    float acc = convb[c];
#pragma unroll
    for (int i = 0; i < 4; ++i) { int ss = s - 3 + i; if (ss >= 0) acc += convw[i * 1536 + c] * bf2f(proj[(size_t)(t - 3 + i) * PROJ + C_XBC + c]); }
    xbc[gid] = f2bf(siluf(acc));
    if (c < 16) dtb[t * 16 + c] = softplusf(bf2f(proj[(size_t)t * PROJ + C_DT + c]) + dt_bias[c]);
}

__global__ __launch_bounds__(256) void k_ssd_seq(const bf16_t* __restrict__ xbc, const float* __restrict__ dtb, const float* __restrict__ a_log, const float* __restrict__ dpar,
                                                 float* __restrict__ yraw  ) {
    __shared__ float sx[16][64], sB[16][128], sC[16][128], sdt[16];
    const int b = blockIdx.x >> 4, hd = blockIdx.x & 15, g = hd >> 3, tid = threadIdx.x, p = tid >> 2, nq = tid & 3;
    const float a_neg = -__expf(a_log[hd]), dd = dpar[hd];
    float hs[32];
#pragma unroll
    for (int i = 0; i < 32; ++i) hs[i] = 0.f;
    for (int t0 = 0; t0 < SEQ; t0 += 16) {
        const size_t tb = (size_t)b * SEQ + t0;
        __syncthreads();
        for (int idx = tid; idx < 16 * 320; idx += 256) {
            int jj = idx / 320, c = idx % 320;
            if (c < 64) sx[jj][c] = bf2f(xbc[(tb + jj) * 1536 + hd * 64 + c]);
            else if (c < 192) sB[jj][c - 64] = bf2f(xbc[(tb + jj) * 1536 + 1024 + g * 128 + (c - 64)]);
            else sC[jj][c - 192] = bf2f(xbc[(tb + jj) * 1536 + 1280 + g * 128 + (c - 192)]);
        }
        if (tid < 16) sdt[tid] = dtb[(tb + tid) * 16 + hd];
        __syncthreads();
        for (int j = 0; j < 16; ++j) {
            const float dt = sdt[j], dA = __expf(dt * a_neg), xr = sx[j][p], xv = xr * dt;
            float y = 0.f;
#pragma unroll
            for (int i = 0; i < 32; ++i) { hs[i] = hs[i] * dA + xv * sB[j][nq * 32 + i]; y += sC[j][nq * 32 + i] * hs[i]; }
            y += __shfl_xor(y, 1); y += __shfl_xor(y, 2);
            if (nq == 0) yraw[(tb + j) * 1024 + hd * 64 + p] = y + dd * xr;
        }
    }
}

__global__ __launch_bounds__(256) void k_ssd_post(const float* __restrict__ yraw, const bf16_t* __restrict__ proj, const float* __restrict__ nw, bf16_t* __restrict__ oy) {
    int wid = blockIdx.x * 4 + (threadIdx.x >> 6), lane = threadIdx.x & 63;
    int t = wid >> 1, g = wid & 1; if (t >= T) return;
    float v[8]; float ss = 0.f;
#pragma unroll
    for (int i = 0; i < 8; ++i) { int c = g * 512 + lane * 8 + i; v[i] = yraw[(size_t)t * 1024 + c] * siluf(bf2f(proj[(size_t)t * PROJ + C_ZB + c])); ss += v[i] * v[i]; }
    ss = wave_sum(ss);
    float r = rsqrtf(ss * (1.f / 512.f) + EPS);
#pragma unroll
    for (int i = 0; i < 8; ++i) { int c = g * 512 + lane * 8 + i; oy[(size_t)t * 2048 + 1024 + c] = f2bf(v[i] * r * nw[c]); }
}

__global__ __launch_bounds__(256) void k_router(const bf16_t* __restrict__ hf, const float* __restrict__ rw  , const float* __restrict__ rbias,
                                                int* __restrict__ idx  , float* __restrict__ gw  ) {
    int t = blockIdx.x * 4 + (threadIdx.x >> 6), lane = threadIdx.x & 63;
    if (t >= T) return;
    float logit = 0.f;
    const bf16_t* hr = hf + (size_t)t * D;
    for (int k = 0; k < D; ++k) logit += bf2f(hr[k]) * rw[k * 64 + lane];
    const float score = sigmoidf(logit), biased = score + rbias[lane];
    float m1 = biased;
#pragma unroll
    for (int o = 1; o < 8; o <<= 1) m1 = fmaxf(m1, __shfl_xor(m1, o));
    int cand1 = (biased == m1) ? (lane & 7) : 8;
#pragma unroll
    for (int o = 1; o < 8; o <<= 1) cand1 = min(cand1, __shfl_xor(cand1, o));
    float b2 = ((lane & 7) == cand1) ? -INFINITY : biased;
    float m2 = b2;
#pragma unroll
    for (int o = 1; o < 8; o <<= 1) m2 = fmaxf(m2, __shfl_xor(m2, o));
    const float gs = m1 + m2;
    const int myg = lane >> 3;
    int grank = 0;
#pragma unroll
    for (int g2 = 0; g2 < 8; ++g2) { float o = __shfl(gs, g2 * 8); grank += (o > gs || (o == gs && g2 < myg)) ? 1 : 0; }
    const float cand = (grank < 4) ? biased : -INFINITY;
    int rank = 0;
    for (int e2 = 0; e2 < 64; ++e2) { float o = __shfl(cand, e2); rank += (o > cand || (o == cand && e2 < lane)) ? 1 : 0; }
    const bool sel = (rank < TOPK) && (grank < 4);
    const float ssum = wave_sum(sel ? score : 0.f);
    if (sel) { idx[t * 8 + rank] = lane; gw[t * 8 + rank] = score / ssum * 2.5f; }
}

__global__ void k_moe_count(const int* __restrict__ idx, int* __restrict__ cnt, int* __restrict__ slot) {
    int gid = blockIdx.x * blockDim.x + threadIdx.x; if (gid >= T * 8) return;
    slot[gid] = atomicAdd(&cnt[idx[gid]], 1);
}
__global__ void k_moe_off(const int* __restrict__ cnt, int* __restrict__ off) {
    if (threadIdx.x == 0) { int a = 0; for (int e = 0; e < NE; ++e) { off[e] = a; a += cnt[e]; } }
}
__global__ void k_moe_fill(const int* __restrict__ idx, const float* __restrict__ gw, const int* __restrict__ slot, const int* __restrict__ off, int* __restrict__ list, float* __restrict__ lw) {
    int gid = blockIdx.x * blockDim.x + threadIdx.x; if (gid >= T * 8) return;
    int p = off[idx[gid]] + slot[gid]; list[p] = gid >> 3; lw[p] = gw[gid];
}

__global__ __launch_bounds__(256) void k_rope(bf16_t* __restrict__ qkv  , const int* __restrict__ pos) {
    size_t gid = (size_t)blockIdx.x * 256 + threadIdx.x;
    if (gid >= (size_t)T * 1024) return;
    int t = (int)(gid >> 10), r = (int)(gid & 1023), part = r >> 9, hh = (r >> 5) & 15, i = r & 31;
    float inv = powf(10000.f, -(float)i / 32.f);
    float ang = (float)pos[t] * inv;
    float sn, cs; sincosf(ang, &sn, &cs);
    bf16_t* p = qkv + (size_t)t * 3072 + part * 1024 + hh * 64;
    float x1 = bf2f(p[i]), x2 = bf2f(p[i + 32]);
    p[i] = f2bf(x1 * cs - x2 * sn); p[i + 32] = f2bf(x2 * cs + x1 * sn);
}
__global__ __launch_bounds__(256) void k_attn(const bf16_t* __restrict__ qkv, bf16_t* __restrict__ o  ) {
    int wid = blockIdx.x * 4 + (threadIdx.x >> 6), lane = threadIdx.x & 63;
    int t = wid >> 4, hh = wid & 15; if (t >= T) return;
    int s = t % SEQ;
    const float q = bf2f(qkv[(size_t)t * 3072 + hh * 64 + lane]) * 0.125f;
    float m = -INFINITY, l = 0.f, acc = 0.f;
    const int dil[3] = {1, 4, 16};
#pragma unroll
    for (int br = 0; br < 3; ++br) {
        const int d = dil[br];
        for (int j = 0; j <= 128; ++j) {
            int ks = s - d * j; if (ks < 0) break;
            const bf16_t* kr = qkv + (size_t)(t - d * j) * 3072 + 1024 + hh * 64;
            float sc = wave_sum(q * bf2f(kr[lane]));
            float mn = fmaxf(m, sc), al = __expf(m - mn), p = __expf(sc - mn);
            l = l * al + p; acc = acc * al + p * bf2f(kr[1024 + lane]); m = mn;
        }
    }
    o[(size_t)t * 1024 + hh * 64 + lane] = f2bf(acc / l);
}

static inline size_t al256(size_t x) { return (x + 255) & ~(size_t)255; }

extern "C" void kernel_launch(void* const* d_in, const int* in_sizes, int n_in, void* d_out, int out_size, void* d_ws, size_t ws_size, hipStream_t stream) {
    const float* x_in = (const float*)d_in[0];
    const float* c_in = (const float*)d_in[1];
    const int* positions = (const int*)d_in[2];
    const float* mod_w = (const float*)d_in[3];
    const float* mod_b = (const float*)d_in[4];
    const float* mix_pre_g = (const float*)d_in[5];
    const float* mix_post_g = (const float*)d_in[6];
    const float* ffn_pre_g = (const float*)d_in[7];
    const float* ffn_post_g = (const float*)d_in[8];
    const float* ssm_w_in = (const float*)d_in[9];
    const float* gdn_conv_w = (const float*)d_in[10];
    const float* gdn_a_log = (const float*)d_in[11];
    const float* gdn_dt_bias = (const float*)d_in[12];
    const float* gdn_norm_w = (const float*)d_in[13];
    const float* ssd_conv_w = (const float*)d_in[14];
    const float* ssd_conv_b = (const float*)d_in[15];
    const float* ssd_a_log = (const float*)d_in[16];
    const float* ssd_dt_bias = (const float*)d_in[17];
    const float* ssd_d = (const float*)d_in[18];
    const float* ssd_norm_w = (const float*)d_in[19];
    const float* ssm_w_out = (const float*)d_in[20];
    const float* attn_w_qkv = (const float*)d_in[21];
    const float* attn_w_o = (const float*)d_in[22];
    const float* router_w = (const float*)d_in[23];
    const float* router_bias = (const float*)d_in[24];
    const float* exp_gate = (const float*)d_in[25];
    const float* exp_up = (const float*)d_in[26];
    const float* exp_down = (const float*)d_in[27];
    const float* shared_gate = (const float*)d_in[28];
    const float* shared_up = (const float*)d_in[29];
    const float* shared_down = (const float*)d_in[30];
    float* xout = (float*)d_out;

    char* ws = (char*)d_ws; size_t o = 0;
    auto take = [&](size_t bytes) { char* p = ws + o; o += al256(bytes); return p; };
    float* mod = (float*)take((size_t)2 * NB * 6 * D * 4);
    int* cnt = (int*)take(256 * 4);
    int* off = (int*)take(256 * 4);
    int* idx = (int*)take((size_t)T * 8 * 4);
    float* gw = (float*)take((size_t)T * 8 * 4);
    int* slot = (int*)take((size_t)T * 8 * 4);
    int* list = (int*)take((size_t)T * 8 * 4);
    float* lw = (float*)take((size_t)T * 8 * 4);
    bf16_t* hbuf = (bf16_t*)take((size_t)T * D * 2);
    const size_t base = o;
    bf16_t* proj = (bf16_t*)take((size_t)T * PROJ * 2);
    bf16_t* qkvn = (bf16_t*)take((size_t)T * 3072 * 2);
    float* gb = (float*)take((size_t)T * 16 * 4);
    float* dtb = (float*)take((size_t)T * 16 * 4);
    bf16_t* xbc = (bf16_t*)take((size_t)T * 1536 * 2);
    float* oraw = (float*)take((size_t)T * 1024 * 4);
    float* yraw = (float*)take((size_t)T * 1024 * 4);
    const size_t end_mix = o;
    bf16_t* oy = qkvn;
    float* ymix = oraw;
    o = base;
    float* gbuf = (float*)take((size_t)(T * 8) * ED * 4);
    bf16_t* hid = (bf16_t*)take((size_t)(T * 8) * ED * 2);
    float* gsh = (float*)take((size_t)T * ED * 4);
    bf16_t* hsh = (bf16_t*)take((size_t)T * ED * 2);
    float* acc = (float*)take((size_t)T * D * 4);
    const size_t end_moe = o;
    o = base;
    bf16_t* qkv1 = (bf16_t*)take((size_t)T * 3072 * 2);
    bf16_t* o1 = (bf16_t*)take((size_t)T * 1024 * 2);
    float* ymix1 = (float*)take((size_t)T * 1024 * 4);
    const size_t end_att = o;
    size_t need = end_mix > end_moe ? end_mix : end_moe; if (end_att > need) need = end_att;
    if (ws_size < need) { fprintf(stderr, "kernel_launch: workspace too small: %zu < %zu\n", ws_size, need); return; }

    k_mod<<<(2 * NB * 6 * D + 255) / 256, 256, 0, stream>>>(c_in, mod_w, mod_b, mod);

    for (int l = 0; l < 2; ++l) {
        const float* modl = mod + (size_t)l * NB * 6 * D;
        const float* xcur = (l == 0) ? x_in : xout;
        if (l == 0) k_rows<<<T / 4, 256, 0, stream>>>(xcur, nullptr, nullptr, modl, nullptr, mix_pre_g + l * D, modl, hbuf, 0, 0, D, 0);
        float* ym;
        if (l == 0) {
            { ALDense al{hbuf, D, T}; EPBf16 ep{proj, PROJ, 0}; k_gemm<<<dim3((PROJ + 63) / 64, T / 64, 1), 256, 0, stream>>>(al, ep, ssm_w_in, 0, PROJ, PROJ, D, 0); }
            k_gdn_prep<<<T * 8 / 4, 256, 0, stream>>>(proj, gdn_conv_w, gdn_a_log, gdn_dt_bias, qkvn, gb);
            k_ssd_prep<<<(unsigned)(((size_t)T * 1536 + 255) / 256), 256, 0, stream>>>(proj, ssd_conv_w, ssd_conv_b, ssd_dt_bias, xbc, dtb);
            k_gdn_seq<<<NB * 8, 512, 0, stream>>>(qkvn, gb, oraw);
            k_ssd_seq<<<NB * 16, 256, 0, stream>>>(xbc, dtb, ssd_a_log, ssd_d, yraw);
            k_gdn_post<<<T * 8 / 4, 256, 0, stream>>>(oraw, proj, gdn_norm_w, oy);
            k_ssd_post<<<T * 2 / 4, 256, 0, stream>>>(yraw, proj, ssd_norm_w, oy);
            { ALDense al{oy, 2048, T}; EPF32 ep{ymix, D, 0}; k_gemm<<<dim3(D / 64, T / 64, 1), 256, 0, stream>>>(al, ep, ssm_w_out, 0, D, D, 2048, 0); }
            ym = ymix;
        } else {
            { ALDense al{hbuf, D, T}; EPBf16 ep{qkv1, 3072, 0}; k_gemm<<<dim3(3072 / 64, T / 64, 1), 256, 0, stream>>>(al, ep, attn_w_qkv, 0, 3072, 3072, D, 0); }
            k_rope<<<(unsigned)(((size_t)T * 1024 + 255) / 256), 256, 0, stream>>>(qkv1, positions);
            k_attn<<<T * 16 / 4, 256, 0, stream>>>(qkv1, o1);
            { ALDense al{o1, D, T}; EPF32 ep{ymix1, D, 0}; k_gemm<<<dim3(D / 64, T / 64, 1), 256, 0, stream>>>(al, ep, attn_w_o, 0, D, D, D, 0); }
            ym = ymix1;
        }
        k_rows<<<T / 4, 256, 0, stream>>>(xcur, ym, mix_post_g + l * D, modl, xout, ffn_pre_g + l * D, modl, hbuf, 2 * D, 3 * D, 4 * D, 0);
        k_router<<<T / 4, 256, 0, stream>>>(hbuf, router_w + (size_t)l * D * NE, router_bias + l * NE, idx, gw);
        (void)hipMemsetAsync(cnt, 0, 256 * 4, stream);
        k_moe_count<<<T * 8 / 256, 256, 0, stream>>>(idx, cnt, slot);
        k_moe_off<<<1, 64, 0, stream>>>(cnt, off);
        k_moe_fill<<<T * 8 / 256, 256, 0, stream>>>(idx, gw, slot, off, list, lw);
        const float* eg = exp_gate + (size_t)l * NE * D * ED; const float* eu = exp_up + (size_t)l * NE * D * ED; const float* edn = exp_down + (size_t)l * NE * ED * D;
        const float* sg = shared_gate + (size_t)l * D * ED; const float* su = shared_up + (size_t)l * D * ED; const float* sd = shared_down + (size_t)l * ED * D;
        { ALGather al{hbuf, cnt, off, list, D, 0}; EPSegF32 ep{gbuf, off, ED, 0}; k_gemm<<<dim3(ED / 64, T / 64, NE), 256, 0, stream>>>(al, ep, eg, (size_t)D * ED, ED, ED, D, 0); }
        { ALGather al{hbuf, cnt, off, list, D, 0}; EPSegHid ep{gbuf, hid, off, ED, 0}; k_gemm<<<dim3(ED / 64, T / 64, NE), 256, 0, stream>>>(al, ep, eu, (size_t)D * ED, ED, ED, D, 0); }
        { ALDense al{hbuf, D, T}; EPF32 ep{gsh, ED, 0}; k_gemm<<<dim3(ED / 64, T / 64, 1), 256, 0, stream>>>(al, ep, sg, 0, ED, ED, D, 0); }
        { ALDense al{hbuf, D, T}; EPHidDense ep{gsh, hsh, ED, 0}; k_gemm<<<dim3(ED / 64, T / 64, 1), 256, 0, stream>>>(al, ep, su, 0, ED, ED, D, 0); }
        { ALDense al{hsh, ED, T}; EPF32 ep{acc, D, 0}; k_gemm<<<dim3(D / 64, T / 64, 1), 256, 0, stream>>>(al, ep, sd, 0, D, D, ED, 0); }
        { ALSeg al{hid, cnt, off, ED, 0}; EPScatterAdd ep{acc, off, list, lw}; k_gemm<<<dim3(D / 64, T / 64, NE), 256, 0, stream>>>(al, ep, edn, (size_t)ED * D, D, D, ED, 0); }
        if (l == 0) { const float* modn = mod + (size_t)1 * NB * 6 * D; k_rows<<<T / 4, 256, 0, stream>>>(xout, acc, ffn_post_g + l * D, modl, xout, mix_pre_g + 1 * D, modn, hbuf, 5 * D, 0, D, 0); }
        else k_rows<<<T / 4, 256, 0, stream>>>(xout, acc, ffn_post_g + l * D, modl, xout, nullptr, nullptr, nullptr, 5 * D, 0, 0, 0);
    }
}
```

```cpp
#include <hip/hip_runtime.h>
#include <stdint.h>
#include <stdio.h>

#define DEV __device__ __forceinline__
#define LAS __attribute__((address_space(3)))
typedef unsigned short bf16_t;
typedef short bf16x8 __attribute__((ext_vector_type(8)));
typedef float f32x4 __attribute__((ext_vector_type(4)));
typedef float f32x2 __attribute__((ext_vector_type(2)));
typedef unsigned u32x4 __attribute__((ext_vector_type(4)));
typedef unsigned u32x2 __attribute__((ext_vector_type(2)));

#ifndef MK_PER_PHASE
#define MK_PER_PHASE 0
#endif

constexpr int NB = 4, SEQ = 4096, T = NB * SEQ, D = 1024;
constexpr int PROJ = 6688, NPROJ = 6912;
constexpr int C_BETA = 4096, C_XBC = 4112, C_ZB = 5648, C_DT = 6672;
constexpr int NE = 64, TOPK = 8, ED = 256, CAP = 16384;
constexpr int SH_RB = 576;
constexpr int NRB_ALL = SH_RB + 64;
constexpr float EPS = 1e-6f;
constexpr int NTHR = 512, NWAVES = 8;
constexpr int LDS_BYTES = 163840;
constexpr int AUX_OFF = 131072;
constexpr int BAR_OFF = LDS_BYTES - 16;

constexpr size_t MiB = 1u << 20;
constexpr size_t WS_CTL = 0, CTL_BYTES = 65536;
constexpr size_t CTL_CNT = 16384;
constexpr size_t WS_MOD = 65536;
constexpr size_t WS_COS = 1 * MiB, WS_SIN = 3 * MiB;
constexpr size_t WS_IDX = 5 * MiB, WS_GW = 5 * MiB + 512 * 1024, WS_ASLOT = 6 * MiB, WS_LTOK = 6 * MiB + 512 * 1024;
constexpr size_t WS_SMALL = 11 * MiB;
constexpr size_t WS_GB = 13 * MiB, WS_DTB = 14 * MiB;
constexpr size_t WS_WIN = 16 * MiB, WS_WOUT = 30 * MiB, WS_WQKV = 34 * MiB, WS_WO = 40 * MiB;
constexpr size_t WS_H = 44 * MiB;
constexpr size_t WS_QKVPRE = 78 * MiB, WS_XBCPRE = 174 * MiB, WS_ZA = 222 * MiB, WS_ZB = 254 * MiB;
constexpr size_t WS_QKVN = 286 * MiB, WS_XBCC = 382 * MiB;
constexpr size_t WS_ORAW = 78 * MiB, WS_YRAW = 142 * MiB, WS_OY = 286 * MiB, WS_YMIX = 382 * MiB;
constexpr size_t WS_WD = 78 * MiB, WS_WDS = 110 * MiB, WS_HID = 112 * MiB, WS_Y = 192 * MiB, WS_WGU = 192 * MiB, WS_WGUS = 256 * MiB;
constexpr size_t WS_Q1KV = 78 * MiB, WS_O1 = 174 * MiB;
constexpr size_t WS_END = 512 * MiB;

struct Args {
    const float* x; const float* c; const int* pos; const float* mod_w; const float* mod_b;
    const float* mix_pre_g; const float* mix_post_g; const float* ffn_pre_g; const float* ffn_post_g;
    const float* ssm_w_in; const float* gdn_conv_w; const float* gdn_a_log; const float* gdn_dt_bias; const float* gdn_norm_w;
    const float* ssd_conv_w; const float* ssd_conv_b; const float* ssd_a_log; const float* ssd_dt_bias; const float* ssd_d; const float* ssd_norm_w;
    const float* ssm_w_out; const float* attn_w_qkv; const float* attn_w_o;
    const float* router_w; const float* router_bias; const float* exp_gate; const float* exp_up; const float* exp_down;
    const float* sh_gate; const float* sh_up; const float* sh_down;
    float* out; unsigned char* ws; int ph_lo, ph_hi;
};

DEV float bf2f(bf16_t v) { return __uint_as_float(((unsigned)v) << 16); }
DEV unsigned f2bf(float f) { unsigned u = __float_as_uint(f); return (u + 0x7FFFu + ((u >> 16) & 1u)) >> 16; }
DEV unsigned pk2(float lo, float hi) { return f2bf(lo) | (f2bf(hi) << 16); }
DEV float wave_sum(float v) {
#pragma unroll
    for (int o = 32; o > 0; o >>= 1) v += __shfl_xor(v, o);
    return v;
}
DEV float siluf(float x) { return x / (1.f + __expf(-x)); }
DEV float sigmoidf_(float x) { return 1.f / (1.f + __expf(-x)); }
DEV float softplusf(float x) { return fmaxf(x, 0.f) + log1pf(__expf(-fabsf(x))); }
#define LDS_WAIT() asm volatile("s_waitcnt lgkmcnt(0)" ::: "memory")
#define VM_WAIT() asm volatile("s_waitcnt vmcnt(0)" ::: "memory")

#define XB_TMO      128
#define XB_XCNT(j)  (256  + 64 * (j))
#define XB_XSUB(j)  (1280 + 64 * (j))
#define XB_XGEN(j)  (2304 + 64 * (j))
#define XB_TOP      3328
#define XB_TOPGEN   3392
#define XCD_BAR_WORDS 3456
#define XB_SPIN_CAP (1u << 18)
#define LAS __attribute__((address_space(3)))

__device__ __forceinline__ unsigned xb_ld(unsigned* p)              { return __hip_atomic_load(p, __ATOMIC_RELAXED, __HIP_MEMORY_SCOPE_AGENT); }
__device__ __forceinline__ unsigned xb_add(unsigned* p, unsigned v) { return __hip_atomic_fetch_add(p, v, __ATOMIC_RELAXED, __HIP_MEMORY_SCOPE_AGENT); }
__device__ __forceinline__ unsigned xb_xcc_id() { return (unsigned)__builtin_amdgcn_s_getreg((3 << 11) | 20) & 0xFu; }
#define XB_SPIN(cond, bar) do { unsigned _sp = 0; while (cond) { __builtin_amdgcn_s_sleep(1); \
    if ((++_sp & 255u) == 0u) { if (xb_ld(&(bar)[XB_TMO])) break; if (_sp > XB_SPIN_CAP) { atomicAdd(&(bar)[XB_TMO], 1u); break; } } } } while (0)

struct XcdBarrier {
    unsigned* bar; unsigned x;
    volatile LAS unsigned* st;
};

__device__ __forceinline__ XcdBarrier xcd_barrier_post(unsigned* bar, volatile LAS unsigned* st) {
    XcdBarrier b; b.bar = bar; b.x = xb_xcc_id(); b.st = st;
    if (threadIdx.x == 0) (void)xb_add(&bar[XB_XCNT(b.x)], 1u);
    return b;
}
__device__ __forceinline__ void xcd_barrier_complete(unsigned* bar, unsigned x, unsigned& nloc, unsigned& nx) {
    const unsigned G = gridDim.x * gridDim.y * gridDim.z;
    unsigned sum, cnt, mine, sp = 0u;
    for (;;) {
        sum = 0u; cnt = 0u; mine = 0u;
#pragma unroll
        for (unsigned j = 0; j < 16; ++j) { const unsigned c = xb_ld(&bar[XB_XCNT(j)]); sum += c; cnt += (c > 0u) ? 1u : 0u; mine = (j == x) ? c : mine; }
        if (sum == G) break;
        __builtin_amdgcn_s_sleep(1);
        if ((++sp & 255u) == 0u) { if (xb_ld(&bar[XB_TMO])) break; if (sp > XB_SPIN_CAP) { atomicAdd(&bar[XB_TMO], 1u); break; } }
    }
    nloc = mine > 0u ? mine : 1u; nx = cnt > 0u ? cnt : 1u;
}

__device__ __forceinline__ void xcd_barrier(const XcdBarrier& b) {
    asm volatile("s_waitcnt vmcnt(0)" ::: "memory");
    __syncthreads();
    if (threadIdx.x == 0) {
        unsigned* bar = b.bar;
        __builtin_amdgcn_s_waitcnt(0);
        unsigned nloc = b.st[0], nx = b.st[1];
        if (nloc == 0u) { xcd_barrier_complete(bar, b.x, nloc, nx); b.st[0] = nloc; b.st[1] = nx; }
        const unsigned old = xb_add(&bar[XB_XSUB(b.x)], 1u);
        const unsigned gen = old / nloc;
        if (old + 1u == (gen + 1u) * nloc) {
            __builtin_amdgcn_fence(__ATOMIC_RELEASE, "agent");
            asm volatile("s_waitcnt vmcnt(0)" ::: "memory");
            const unsigned og = xb_add(&bar[XB_TOP], 1u);
            const unsigned tg = og / nx;
            if (og + 1u == (tg + 1u) * nx) xb_add(&bar[XB_TOPGEN], 1u);
            else XB_SPIN(xb_ld(&bar[XB_TOPGEN]) == tg, bar);
            __builtin_amdgcn_fence(__ATOMIC_ACQUIRE, "agent");
            xb_add(&bar[XB_XGEN(b.x)], 1u);
            asm volatile("s_waitcnt vmcnt(0)" ::: "memory");
        } else {
            XB_SPIN(xb_ld(&bar[XB_XGEN(b.x)]) == gen, bar);
            __builtin_amdgcn_fence(__ATOMIC_ACQUIRE, "agent");
            asm volatile("s_waitcnt vmcnt(0)" ::: "memory");
        }
    }
    __syncthreads();
}


namespace pg8 {
constexpr int BM = 256, BK = 64, HALF = 128, HTB = HALF * BK * 2, STAGE_BYTES = 8 * HTB, NXCD = 8, WGM = 8;
DEV int lds_byte(int r, int c) { const int st = (r >> 4) * 2 + (c >> 5), rr = r & 15, cc = c & 31, ob = rr * 64 + cc * 2; return st * 1024 + (ob ^ (((ob >> 9) & 1) << 5)); }
DEV void stage_rc(int b, int& R, int& C) { const int st = b / 1024, sb = b % 1024, swz = sb ^ (((sb >> 9) & 1) << 5); R = (st >> 1) * 16 + swz / 64; C = (st & 1) * 32 + (swz % 64) / 2; }
DEV int perm32(int rho) { const int n = rho >> 4, i = rho & 15; return 8 * (i >> 2) + 4 * n + (i & 3); }
struct Unit { int pm, pn, e, slot; };
struct StaticOrder {
    int nM, nN, nwg, G, c;
    DEV void init(int M, int N, int G_, int c_) { nM = M / BM; nN = N / BM; nwg = nM * nN; G = G_; c = c_; }
    DEV bool next(int i, int& pm, int& pn) const {
        const long L = (long)i * G + c; if (L >= nwg) return false;
        int wgid = (int)L; { const int q = nwg / NXCD, r = nwg % NXCD, xcd = wgid % NXCD, off = wgid / NXCD; wgid = (xcd < r ? xcd * (q + 1) : r * (q + 1) + (xcd - r) * q) + off; }
        const int nig = WGM * nN, gid = wgid / nig, fm = gid * WGM, gsz = (nM - fm) < WGM ? (nM - fm) : WGM;
        pm = fm + ((wgid % nig) % gsz); pn = (wgid % nig) / gsz; return true;
    }
};
DEV unsigned cvt_pk_bf16(float lo, float hi) { unsigned r; asm volatile("v_cvt_pk_bf16_f32 %0, %1, %2" : "=v"(r) : "v"(lo), "v"(hi)); return r; }
DEV u32x4 pack8(const f32x4 a, const f32x4 b) { u32x4 w; w.x = cvt_pk_bf16(a[0], a[1]); w.y = cvt_pk_bf16(a[2], a[3]); w.z = cvt_pk_bf16(b[0], b[1]); w.w = cvt_pk_bf16(b[2], b[3]); return w; }

template <class Epi, class Sched>
DEV void gemm_phase(LAS unsigned char* lds, const int K, const Sched& S, const Epi& E) {
    const int tid = threadIdx.x, wid = __builtin_amdgcn_readfirstlane(tid >> 6), lane = tid & 63, wr = wid >> 2, wc = wid & 3, fr = lane & 15, fq = lane >> 4;
    const int nt = K / BK;
    unsigned voffB[2];
#pragma unroll
    for (int i = 0; i < 2; ++i) { int R, C; stage_rc(tid * 16 + i * 8192, R, C); const int Rb = Epi::PERM ? ((R & ~31) + perm32(R & 31)) : R; voffB[i] = (unsigned)(Rb * K + C) * 2u; }
    const unsigned kstep = (unsigned)(BK * 2);
    const size_t hstep = (size_t)HALF * K * 2;
    const unsigned ldsw = (unsigned)wid * 1024u;
    const int aoff = lds_byte(wr * 64 + fr, fq * 8), boff = lds_byte(wc * 32 + fr, fq * 8);
    const size_t hsA = Sched::GATHER ? (size_t)0 : hstep;
#define PG8_SA(b, h) (((b) * 2 + (h)) * HTB)
#define PG8_SB(b, h) ((4 + (b) * 2 + (h)) * HTB)
#define PG8_STAGEB(bufoff, gbase) do { _Pragma("unroll") for (int _i = 0; _i < 2; ++_i) \
        __builtin_amdgcn_global_load_lds((const unsigned*)((const char*)(gbase) + voffB[_i]), (LAS unsigned*)(lds + (bufoff) + ldsw + _i * 8192), 16, 0, 0); } while (0)
#define PG8_STAGEA(bufoff, gbase, VO) do { _Pragma("unroll") for (int _i = 0; _i < 2; ++_i) \
        __builtin_amdgcn_global_load_lds((const unsigned*)((const char*)(gbase) + (VO)[_i]), (LAS unsigned*)(lds + (bufoff) + ldsw + _i * 8192), 16, 0, 0); } while (0)
#define PG8_LDA(dst, b, h) do { _Pragma("unroll") for (int m = 0; m < 4; ++m) _Pragma("unroll") for (int k = 0; k < 2; ++k) dst[m][k] = *(const LAS bf16x8*)(lds + PG8_SA(b, h) + aoff + m * 2048 + k * 1024); } while (0)
#define PG8_LDB(dst, b, h) do { _Pragma("unroll") for (int n = 0; n < 2; ++n) _Pragma("unroll") for (int k = 0; k < 2; ++k) dst[n][k] = *(const LAS bf16x8*)(lds + PG8_SB(b, h) + boff + n * 2048 + k * 1024); } while (0)
#define PG8_MMA(ai, bj, At, Bt) do { __builtin_amdgcn_s_setprio(1); _Pragma("unroll") for (int m = 0; m < 4; ++m) _Pragma("unroll") for (int n = 0; n < 2; ++n) _Pragma("unroll") for (int k = 0; k < 2; ++k) \
        acc[ai][bj][m][n] = __builtin_amdgcn_mfma_f32_16x16x32_bf16(Bt[n][k], At[m][k], acc[ai][bj][m][n], 0, 0, 0); __builtin_amdgcn_s_setprio(0); } while (0)
#define PG8_WAIT_V(n) asm volatile("s_waitcnt vmcnt(" #n ")" ::: "memory")
#define PG8_WAIT_L(n) asm volatile("s_waitcnt lgkmcnt(" #n ")" ::: "memory")
#define PG8_BAR __builtin_amdgcn_s_barrier()
#define PG8_SCHED __builtin_amdgcn_sched_barrier(0)
    Unit cur, nxt; int ui = 0;
    if (!S.next(0, cur)) return;
    f32x4 acc[2][2][4][2];
#pragma unroll
    for (int a = 0; a < 2; ++a)
#pragma unroll
        for (int b = 0; b < 2; ++b)
#pragma unroll
            for (int m = 0; m < 4; ++m)
#pragma unroll
                for (int n = 0; n < 2; ++n) acc[a][b][m][n] = (f32x4){0.f, 0.f, 0.f, 0.f};
    bf16x8 At[4][2], B0[2][2], B1[2][2];
    unsigned va[2][2];
    S.a_voff(cur, tid, va);
    const char* cA = S.a_ptr(cur);
    const char* cB = S.b_ptr(cur);
    PG8_STAGEB(PG8_SB(0, 0), cB); PG8_STAGEB(PG8_SB(0, 1), cB + hstep); PG8_STAGEA(PG8_SA(0, 0), cA, va[0]); PG8_STAGEA(PG8_SA(0, 1), cA + hsA, va[1]);
    if (wr == 1) PG8_BAR;
    PG8_WAIT_V(2); PG8_BAR;
    PG8_STAGEB(PG8_SB(1, 0), cB + kstep); PG8_STAGEA(PG8_SA(1, 0), cA + kstep, va[0]); PG8_STAGEB(PG8_SB(1, 1), cB + hstep + kstep);
    PG8_WAIT_V(6); PG8_BAR;
    for (;;) {
        const bool has_next = S.next(ui + 1, nxt);
        const char* nB = has_next ? S.b_ptr(nxt) : cB;
        const char* nA = has_next ? S.a_ptr(nxt) : cA;
        for (int t = 0; t < nt; t += 2) {
            const bool last = (t == nt - 2);
            const char* a1 = cA + (size_t)(t + 1) * kstep;
            const char* a2 = last ? nA : cA + (size_t)(t + 2) * kstep; const char* a3 = a2 + kstep;
            unsigned v2[2][2];
            v2[0][0] = va[0][0]; v2[0][1] = va[0][1]; v2[1][0] = va[1][0]; v2[1][1] = va[1][1];
            if constexpr (Sched::GATHER) { if (last && has_next) S.a_voff(nxt, tid, v2); }
            const char* b2 = last ? nB : cB + (size_t)(t + 2) * kstep; const char* b3 = b2 + kstep;
            PG8_LDB(B0, 0, 0); PG8_LDB(B1, 0, 1); PG8_SCHED; PG8_LDA(At, 0, 0); PG8_STAGEA(PG8_SA(1, 1), a1 + hsA, va[1]);
            PG8_WAIT_V(8); PG8_WAIT_L(0); PG8_BAR; PG8_MMA(0, 0, At, B0); PG8_MMA(0, 1, At, B1); PG8_BAR; PG8_SCHED;
            PG8_LDA(At, 0, 1); PG8_STAGEB(PG8_SB(0, 0), b2); PG8_STAGEB(PG8_SB(0, 1), b2 + hstep); PG8_STAGEA(PG8_SA(0, 0), a2, v2[0]);
            PG8_WAIT_V(8); PG8_WAIT_L(0); PG8_BAR; PG8_MMA(1, 0, At, B0); PG8_MMA(1, 1, At, B1); PG8_BAR; PG8_SCHED;
            PG8_LDB(B0, 1, 0); PG8_LDB(B1, 1, 1); PG8_SCHED; PG8_LDA(At, 1, 0); PG8_STAGEA(PG8_SA(0, 1), a2 + hsA, v2[1]);
            PG8_WAIT_V(8); PG8_WAIT_L(0); PG8_BAR; PG8_MMA(0, 0, At, B0); PG8_MMA(0, 1, At, B1); PG8_BAR; PG8_SCHED;
            PG8_LDA(At, 1, 1); PG8_STAGEB(PG8_SB(1, 0), b3); PG8_STAGEB(PG8_SB(1, 1), b3 + hstep); PG8_STAGEA(PG8_SA(1, 0), a3, v2[0]);
            PG8_WAIT_V(8); PG8_WAIT_L(0); PG8_BAR; PG8_MMA(1, 0, At, B0); PG8_MMA(1, 1, At, B1); PG8_BAR; PG8_SCHED;
        }
        if (wr == 0) PG8_BAR;
        E(acc, cur, wr, wc, fr, fq);
        if (!has_next) break;
#pragma unroll
        for (int a = 0; a < 2; ++a)
#pragma unroll
            for (int b = 0; b < 2; ++b)
#pragma unroll
                for (int m = 0; m < 4; ++m)
#pragma unroll
                    for (int n = 0; n < 2; ++n) acc[a][b][m][n] = (f32x4){0.f, 0.f, 0.f, 0.f};
        cur = nxt; cB = nB; cA = nA; ++ui;
        if constexpr (Sched::GATHER) S.a_voff(cur, tid, va);
        if (wr == 1) PG8_BAR;
    }
    PG8_WAIT_V(0);
    PG8_BAR;
#undef PG8_SA
#undef PG8_SB
#undef PG8_STAGEA
#undef PG8_STAGEB
#undef PG8_LDA
#undef PG8_LDB
#undef PG8_MMA
#undef PG8_WAIT_V
#undef PG8_WAIT_L
#undef PG8_BAR
#undef PG8_SCHED
}

struct SchedDense {
    static constexpr bool GATHER = false;
    StaticOrder so; const char* A; const char* Bt; int K; int pad_;
    DEV bool next(int i, Unit& u) const { int pm, pn; if (!so.next(i, pm, pn)) return false; u.pm = pm; u.pn = pn; u.e = 0; u.slot = 0; return true; }
    DEV const char* a_ptr(const Unit& u) const { return A + (size_t)u.pm * 256 * K * 2; }
    DEV void a_voff(const Unit&, const int tid, unsigned (&vo)[2][2]) const {
#pragma unroll
        for (int i = 0; i < 2; ++i) { int R, C; stage_rc(tid * 16 + i * 8192, R, C); vo[0][i] = vo[1][i] = (unsigned)((R * K + C) * 2); }
    }
    DEV const char* b_ptr(const Unit& u) const { return Bt + (size_t)u.pn * 256 * K * 2; }
};
DEV bool moe_unit(int i, int NJ, int nrbt, int G, int c, Unit& u) {
    const int n = (nrbt + 64) * NJ; int L;
    if (G & 7) { L = i * G + c; if (L >= n) return false; }
    else { const int gq = G >> 3, per = (n + 7) >> 3, x = c & 7, q = c >> 3, j = i * gq + q; if (j >= per) return false; L = x * per + j; if (L >= n) return false; }
    int grb = L / NJ; const int pn = L - grb * NJ; if (grb >= nrbt) grb = SH_RB + (grb - nrbt);
    u.pm = grb; u.pn = pn; u.slot = i; u.e = 0; return true;
}
struct SchedGU {
    static constexpr bool GATHER = true;
    const char* A; const char* Wgu; const char* Wgus; const LAS int* eofrb; const LAS int* toks; int nrbt, G, c, pad_;
    DEV bool next(int i, Unit& u) const { if (!moe_unit(i, 2, nrbt, G, c, u)) return false; u.e = __builtin_amdgcn_readfirstlane(eofrb[u.pm]); return true; }
    DEV const char* a_ptr(const Unit&) const { return A; }
    DEV void a_voff(const Unit& u, const int tid, unsigned (&vo)[2][2]) const {
#pragma unroll
        for (int i = 0; i < 2; ++i) { int R, C; stage_rc(tid * 16 + i * 8192, R, C);
#pragma unroll
            for (int h = 0; h < 2; ++h) { const int tok = toks[u.slot * 256 + h * 128 + R]; vo[h][i] = (unsigned)((tok * D + C) * 2); } }
    }
    DEV const char* b_ptr(const Unit& u) const { return (u.e < NE ? Wgu + (size_t)u.e * 512 * D * 2 : Wgus) + (size_t)u.pn * 256 * D * 2; }
};
struct SchedDown {
    static constexpr bool GATHER = false;
    const char* A; const char* Wd; const char* Wds; const LAS int* eofrb; int nrbt, G, c, pad_;
    DEV bool next(int i, Unit& u) const { if (!moe_unit(i, 4, nrbt, G, c, u)) return false; u.e = __builtin_amdgcn_readfirstlane(eofrb[u.pm]); return true; }
    DEV const char* a_ptr(const Unit& u) const { return A + (size_t)u.pm * 256 * ED * 2; }
    DEV void a_voff(const Unit&, const int tid, unsigned (&vo)[2][2]) const {
#pragma unroll
        for (int i = 0; i < 2; ++i) { int R, C; stage_rc(tid * 16 + i * 8192, R, C); vo[0][i] = vo[1][i] = (unsigned)((R * ED + C) * 2); }
    }
    DEV const char* b_ptr(const Unit& u) const { return (u.e < NE ? Wd + (size_t)u.e * D * ED * 2 : Wds) + (size_t)u.pn * 256 * ED * 2; }
};

struct EpiProj {
    static constexpr bool PERM = true;
    bf16_t* qkv; bf16_t* za; bf16_t* xbc; bf16_t* zb; float* small;
    DEV void operator()(const f32x4 (&acc)[2][2][4][2], const Unit& u, int wr, int wc, int fr, int fq) const {
        const int row0 = u.pm * BM + wr * 64 + fr, pn = u.pn;
        if (pn == 26) {
            if (wc == 0) {
#pragma unroll
                for (int ai = 0; ai < 2; ++ai)
#pragma unroll
                    for (int m = 0; m < 4; ++m) { float* p = small + (size_t)(row0 + ai * HALF + m * 16) * 32 + 8 * fq; *(f32x4*)p = acc[ai][0][m][0]; *(f32x4*)(p + 4) = acc[ai][0][m][1]; }
            }
            return;
        }
        bf16_t* base; int ldc, ct;
        if (pn < 12) { base = qkv; ldc = 3072; ct = pn; } else if (pn < 16) { base = za; ldc = 1024; ct = pn - 12; } else if (pn < 22) { base = xbc; ldc = 1536; ct = pn - 16; } else { base = zb; ldc = 1024; ct = pn - 22; }
        const int col0 = ct * 256 + wc * 32 + 8 * fq;
#pragma unroll
        for (int ai = 0; ai < 2; ++ai)
#pragma unroll
            for (int m = 0; m < 4; ++m) { bf16_t* rowp = base + (size_t)(row0 + ai * HALF + m * 16) * ldc + col0;
#pragma unroll
                for (int bj = 0; bj < 2; ++bj) *(u32x4*)(rowp + bj * HALF) = pack8(acc[ai][bj][m][0], acc[ai][bj][m][1]); }
    }
};
struct EpiF32 {
    static constexpr bool PERM = false;
    float* Cp; int ldc; int pad_;
    DEV void operator()(const f32x4 (&acc)[2][2][4][2], const Unit& u, int wr, int wc, int fr, int fq) const {
        const int row0 = u.pm * BM + wr * 64 + fr, col0 = u.pn * BM + wc * 32 + 4 * fq;
#pragma unroll
        for (int ai = 0; ai < 2; ++ai)
#pragma unroll
            for (int m = 0; m < 4; ++m) { float* rowp = Cp + (size_t)(row0 + ai * HALF + m * 16) * ldc + col0;
#pragma unroll
                for (int bj = 0; bj < 2; ++bj)
#pragma unroll
                    for (int n = 0; n < 2; ++n) *(f32x4*)(rowp + bj * HALF + n * 16) = acc[ai][bj][m][n]; }
    }
};
struct EpiBf16 {
    static constexpr bool PERM = true;
    bf16_t* O; int ldc; int pad_;
    DEV void operator()(const f32x4 (&acc)[2][2][4][2], const Unit& u, int wr, int wc, int fr, int fq) const {
        const int row0 = u.pm * BM + wr * 64 + fr, col0 = u.pn * BM + wc * 32 + 8 * fq;
#pragma unroll
        for (int ai = 0; ai < 2; ++ai)
#pragma unroll
            for (int m = 0; m < 4; ++m) { bf16_t* rowp = O + (size_t)(row0 + ai * HALF + m * 16) * ldc + col0;
#pragma unroll
                for (int bj = 0; bj < 2; ++bj) *(u32x4*)(rowp + bj * HALF) = pack8(acc[ai][bj][m][0], acc[ai][bj][m][1]); }
    }
};
struct EpiGU {
    static constexpr bool PERM = true;
    bf16_t* H;
    DEV void operator()(const f32x4 (&acc)[2][2][4][2], const Unit& u, int wr, int wc, int fr, int fq) const {
        const int row0 = u.pm * BM + wr * 64 + fr, col0 = u.pn * HALF + wc * 32 + 8 * fq;
#pragma unroll
        for (int ai = 0; ai < 2; ++ai)
#pragma unroll
            for (int m = 0; m < 4; ++m) {
                f32x4 h0, h1;
#pragma unroll
                for (int i = 0; i < 4; ++i) { h0[i] = siluf(acc[ai][0][m][0][i]) * acc[ai][1][m][0][i]; h1[i] = siluf(acc[ai][0][m][1][i]) * acc[ai][1][m][1][i]; }
                *(u32x4*)(H + (size_t)(row0 + ai * HALF + m * 16) * ED + col0) = pack8(h0, h1);
            }
    }
};
struct EpiQKV {
    static constexpr bool PERM = true;
    bf16_t* O; const float* cosT; const float* sinT;
    DEV void operator()(const f32x4 (&acc)[2][2][4][2], const Unit& u, int wr, int wc, int fr, int fq) const {
        const int row0 = u.pm * BM + wr * 64 + fr, col0 = u.pn * BM + wc * 32 + 8 * fq;
        const bool rope = u.pn < 8; const float qs = u.pn < 4 ? 0.125f : 1.f;
#pragma unroll
        for (int ai = 0; ai < 2; ++ai)
#pragma unroll
            for (int m = 0; m < 4; ++m) {
                const int row = row0 + ai * HALF + m * 16;
                bf16_t* rowp = O + (size_t)row * 3072 + col0;
                if (rope) {
                    const f32x4 cs = *(const f32x4*)(cosT + (size_t)row * 32 + 16 * (wc & 1) + 4 * fq), sn = *(const f32x4*)(sinT + (size_t)row * 32 + 16 * (wc & 1) + 4 * fq);
#pragma unroll
                    for (int bj = 0; bj < 2; ++bj) { const f32x4 x1 = acc[ai][bj][m][0], x2 = acc[ai][bj][m][1];
                        *(u32x4*)(rowp + bj * HALF) = pack8((x1 * cs - x2 * sn) * qs, (x2 * cs + x1 * sn) * qs); }
                } else {
#pragma unroll
                    for (int bj = 0; bj < 2; ++bj) *(u32x4*)(rowp + bj * HALF) = pack8(acc[ai][bj][m][0], acc[ai][bj][m][1]);
                }
            }
    }
};
}

template <class SrcF>
DEV void conv_item(const SrcF& src, int ldw, int K, bf16_t* dst, LAS float* scr, int item, int nblk, int lane) {
    const int kb = item / nblk, nb = item - kb * nblk, k0 = 64 * kb, n0 = 32 * nb;
    const float* colp = src(n0 + (lane & 31));
#pragma unroll 8
    for (int i = 0; i < 32; ++i) { const int kk = 2 * i + (lane >> 5); scr[kk * 33 + (lane & 31)] = colp ? colp[(size_t)(k0 + kk) * ldw] : 0.f; }
    LDS_WAIT(); asm volatile("" ::: "memory");
    const int c = lane & 7;
#pragma unroll
    for (int j = 0; j < 4; ++j) { const int n = (lane >> 3) + 8 * j; const LAS float* s = scr + (8 * c) * 33 + n;
        u32x4 o; o.x = pk2(s[0 * 33], s[1 * 33]); o.y = pk2(s[2 * 33], s[3 * 33]); o.z = pk2(s[4 * 33], s[5 * 33]); o.w = pk2(s[6 * 33], s[7 * 33]);
        *(u32x4*)(dst + (size_t)(n0 + n) * K + k0 + 8 * c) = o; }
    LDS_WAIT(); asm volatile("" ::: "memory");
}
struct SrcIdent { const float* W; DEV const float* operator()(int n) const { return W + n; } };
struct SrcWin { const float* W; DEV const float* operator()(int n) const {
    int s; if (n < 4096) s = n; else if (n < 5632) s = C_XBC + (n - 4096); else if (n < 6656) s = C_ZB + (n - 5632); else if (n < 6672) s = C_BETA + (n - 6656); else if (n < 6688) s = C_DT + (n - 6672); else return nullptr;
    return W + s; } };
struct SrcQKV { const float* W; DEV const float* operator()(int n) const {
    if (n >= 2048) return W + n; const int hd = n >> 6, cp = n & 63; return W + hd * 64 + 32 * ((cp >> 2) & 1) + 16 * (cp >> 5) + 4 * ((cp >> 3) & 3) + (cp & 3); } };
struct SrcGU { const float* Wg; long du; DEV const float* operator()(int r) const { const int j = r >> 8, rr = r & 255; return Wg + (rr < 128 ? 0l : du) + 128 * j + (rr & 127); } };

DEV void load_row(const float* p, int lane, float (&v)[16]) {
#pragma unroll
    for (int j = 0; j < 4; ++j) { const f32x4 t = *(const f32x4*)(p + j * 256 + lane * 4); v[4 * j] = t[0]; v[4 * j + 1] = t[1]; v[4 * j + 2] = t[2]; v[4 * j + 3] = t[3]; }
}
DEV void store_row(float* p, int lane, const float (&v)[16]) {
#pragma unroll
    for (int j = 0; j < 4; ++j) *(f32x4*)(p + j * 256 + lane * 4) = (f32x4){v[4 * j], v[4 * j + 1], v[4 * j + 2], v[4 * j + 3]};
}
DEV float row_rstd(const float (&v)[16]) { float ss = 0.f;
#pragma unroll
    for (int i = 0; i < 16; ++i) ss += v[i] * v[i];
    return rsqrtf(wave_sum(ss) * (1.f / D) + EPS); }
DEV void resid_update(float (&xv)[16], const float (&yv)[16], const float* gpost, const float* gt, int lane) {
    const float r = row_rstd(yv);
#pragma unroll
    for (int j = 0; j < 4; ++j) { const f32x4 g = *(const f32x4*)(gpost + j * 256 + lane * 4), t = *(const f32x4*)(gt + j * 256 + lane * 4);
#pragma unroll
        for (int i = 0; i < 4; ++i) xv[4 * j + i] += t[i] * (yv[4 * j + i] * r * g[i]); }
}
DEV void prenorm_pack(const float (&xv)[16], const float* gpre, const float* sc, const float* sh, int lane, u32x2 (&o)[4]) {
    const float r = row_rstd(xv);
#pragma unroll
    for (int j = 0; j < 4; ++j) { const f32x4 g = *(const f32x4*)(gpre + j * 256 + lane * 4), s = *(const f32x4*)(sc + j * 256 + lane * 4), b = *(const f32x4*)(sh + j * 256 + lane * 4);
        float h[4];
#pragma unroll
        for (int i = 0; i < 4; ++i) h[i] = xv[4 * j + i] * r * g[i] * (1.f + s[i]) + b[i];
        o[j] = (u32x2){pk2(h[0], h[1]), pk2(h[2], h[3])}; }
}

struct Ctx { LAS unsigned char* lds; int tid, lane, wave, G, bid; };

DEV void ph_setup(const Args& a, const Ctx& X) {
    unsigned char* ws = a.ws;
    float* mod = (float*)(ws + WS_MOD);
    { LAS float* red = (LAS float*)X.lds;
      const int kc = X.tid >> 6, cl = X.tid & 63;
      for (int task = X.bid; task < 2 * 96; task += X.G) {
          const int l = task / 96, col = (task % 96) * 64 + cl;
          const float* w = a.mod_w + (size_t)l * D * 6 * D + col;
          float p0 = 0.f, p1 = 0.f, p2 = 0.f, p3 = 0.f;
          for (int k = kc * 128; k < kc * 128 + 128; ++k) { const float wv = w[(size_t)k * 6 * D];
              p0 += siluf(a.c[k]) * wv; p1 += siluf(a.c[D + k]) * wv; p2 += siluf(a.c[2 * D + k]) * wv; p3 += siluf(a.c[3 * D + k]) * wv; }
          __syncthreads();
          red[(kc * 4 + 0) * 64 + cl] = p0; red[(kc * 4 + 1) * 64 + cl] = p1; red[(kc * 4 + 2) * 64 + cl] = p2; red[(kc * 4 + 3) * 64 + cl] = p3;
          __syncthreads();
          if (X.tid < 256) { const int b = X.tid >> 6; float s = a.mod_b[l * 6 * D + col];
#pragma unroll
              for (int q = 0; q < 8; ++q) s += red[(q * 4 + b) * 64 + cl];
              mod[(size_t)(l * NB + b) * 6 * D + col] = s; }
      }
      __syncthreads(); }
    { float* cosT = (float*)(ws + WS_COS); float* sinT = (float*)(ws + WS_SIN);
      for (int idx = X.bid * NTHR + X.tid; idx < T * 32; idx += X.G * NTHR) { const int t = idx >> 5, i = idx & 31;
          const float ang = (float)a.pos[t] * powf(10000.f, -(float)i / 32.f); float sn, cs; sincosf(ang, &sn, &cs); cosT[idx] = cs; sinT[idx] = sn; } }
    { LAS float* scr = (LAS float*)(X.lds + X.wave * 8704);
      const int gw = X.bid * NWAVES + X.wave, NGW = X.G * NWAVES;
      constexpr int I_IN = (D / 64) * (NPROJ / 32), I_OUT = (2048 / 64) * (D / 32), I_QKV = (D / 64) * (3072 / 32), I_O = (D / 64) * (D / 32);
      for (int it = gw; it < I_IN + I_OUT + I_QKV + I_O; it += NGW) {
          int r = it;
          if (r < I_IN) { conv_item(SrcWin{a.ssm_w_in}, PROJ, D, (bf16_t*)(ws + WS_WIN), scr, r, NPROJ / 32, X.lane); continue; } r -= I_IN;
          if (r < I_OUT) { conv_item(SrcIdent{a.ssm_w_out}, D, 2048, (bf16_t*)(ws + WS_WOUT), scr, r, D / 32, X.lane); continue; } r -= I_OUT;
          if (r < I_QKV) { conv_item(SrcQKV{a.attn_w_qkv}, 3072, D, (bf16_t*)(ws + WS_WQKV), scr, r, 3072 / 32, X.lane); continue; } r -= I_QKV;
          conv_item(SrcIdent{a.attn_w_o}, D, D, (bf16_t*)(ws + WS_WO), scr, r, D / 32, X.lane);
      } }
}

DEV void ph_prenorm0(const Args& a, const Ctx& X) {
    const float* mod = (const float*)(a.ws + WS_MOD);
    bf16_t* hb = (bf16_t*)(a.ws + WS_H);
    for (int row = X.bid * NWAVES + X.wave; row < T; row += X.G * NWAVES) {
        const int b = row / SEQ; const float* ml = mod + (size_t)b * 6 * D;
        float xv[16]; load_row(a.x + (size_t)row * D, X.lane, xv);
        u32x2 o[4]; prenorm_pack(xv, a.mix_pre_g, ml + D, ml, X.lane, o);
#pragma unroll
        for (int j = 0; j < 4; ++j) *(u32x2*)(hb + (size_t)row * D + j * 256 + X.lane * 4) = o[j];
    }
}

DEV void ph_mix_prep(const Args& a, const Ctx& X) {
    const unsigned char* ws = a.ws;
    const bf16_t* qkvpre = (const bf16_t*)(ws + WS_QKVPRE); const bf16_t* xbcpre = (const bf16_t*)(ws + WS_XBCPRE); const float* small = (const float*)(ws + WS_SMALL);
    bf16_t* qkvn = (bf16_t*)(a.ws + WS_QKVN); float* gb = (float*)(a.ws + WS_GB); bf16_t* xbcc = (bf16_t*)(a.ws + WS_XBCC); float* dtb = (float*)(a.ws + WS_DTB);
    for (int wid = X.bid * NWAVES + X.wave; wid < T * 8; wid += X.G * NWAVES) {
        const int t = wid >> 3, h = wid & 7, s = t % SEQ, lane = X.lane;
        float vals[3][2];
#pragma unroll
        for (int part = 0; part < 3; ++part)
#pragma unroll
            for (int e = 0; e < 2; ++e) { const int c = part * 1024 + h * 128 + lane * 2 + e; float acc = 0.f;
#pragma unroll
                for (int i = 0; i < 4; ++i) { const int ss = s - 3 + i; if (ss >= 0) acc += a.gdn_conv_w[i * 3072 + c] * bf2f(qkvpre[(size_t)(t - 3 + i) * 3072 + c]); }
                vals[part][e] = siluf(acc); }
#pragma unroll
        for (int part = 0; part < 2; ++part) { const float ss = wave_sum(vals[part][0] * vals[part][0] + vals[part][1] * vals[part][1]); const float r = rsqrtf(ss + 1e-6f); vals[part][0] *= r; vals[part][1] *= r; }
#pragma unroll
        for (int part = 0; part < 3; ++part) *(unsigned*)(qkvn + (size_t)t * 3072 + part * 1024 + h * 128 + lane * 2) = pk2(vals[part][0], vals[part][1]);
        if (lane == 0) { const float beta = sigmoidf_(small[(size_t)t * 32 + h]); const float g = -__expf(a.gdn_a_log[h]) * softplusf(small[(size_t)t * 32 + 8 + h] + a.gdn_dt_bias[h]);
            gb[t * 16 + h] = g; gb[t * 16 + 8 + h] = beta; }
    }
    for (size_t gid = (size_t)X.bid * NTHR + X.tid; gid < (size_t)T * 1536; gid += (size_t)X.G * NTHR) {
        const int t = (int)(gid / 1536), c = (int)(gid % 1536), s = t % SEQ; float acc = a.ssd_conv_b[c];
#pragma unroll
        for (int i = 0; i < 4; ++i) { const int ss = s - 3 + i; if (ss >= 0) acc += a.ssd_conv_w[i * 1536 + c] * bf2f(xbcpre[(size_t)(t - 3 + i) * 1536 + c]); }
        xbcc[gid] = (bf16_t)f2bf(siluf(acc));
        if (c < 16) dtb[t * 16 + c] = softplusf(small[(size_t)t * 32 + 16 + c] + a.ssd_dt_bias[c]);
    }
}
DEV void ph_mix_seq(const Args& a, const Ctx& X) {
    const bf16_t* qkvn = (const bf16_t*)(a.ws + WS_QKVN); const float* gb = (const float*)(a.ws + WS_GB);
    const bf16_t* xbc = (const bf16_t*)(a.ws + WS_XBCC); const float* dtb = (const float*)(a.ws + WS_DTB);
    float* oraw = (float*)(a.ws + WS_ORAW); float* yraw = (float*)(a.ws + WS_YRAW);
    const int tid = X.tid;
    if (X.bid < 32) {
        LAS float* sk = (LAS float*)X.lds; LAS float* sq = sk + 16 * 128; LAS float* sv = sq + 16 * 128; LAS float* sa = sv + 16 * 128; LAS float* sbeta = sa + 16; LAS float* red = sbeta + 16;
        const int b = X.bid >> 3, h = X.bid & 7, v = tid & 127, kq = tid >> 7;
        float S[32];
#pragma unroll
        for (int i = 0; i < 32; ++i) S[i] = 0.f;
        const float scale = 0.08838834764831845f;
        for (int t0 = 0; t0 < SEQ; t0 += 16) {
            const size_t tb = (size_t)b * SEQ + t0;
            for (int idx = tid; idx < 16 * 384; idx += NTHR) { const int jj = idx / 384, c = idx % 384, part = c >> 7, cc = c & 127;
                const float val = bf2f(qkvn[(tb + jj) * 3072 + part * 1024 + h * 128 + cc]);
                if (part == 0) sq[jj * 128 + cc] = val; else if (part == 1) sk[jj * 128 + cc] = val; else sv[jj * 128 + cc] = val; }
            if (tid < 16) { sa[tid] = __expf(gb[(tb + tid) * 16 + h]); sbeta[tid] = gb[(tb + tid) * 16 + 8 + h]; }
            __syncthreads();
            for (int j = 0; j < 16; ++j) {
                const float al = sa[j], bt = sbeta[j]; float p = 0.f;
#pragma unroll
                for (int i = 0; i < 32; ++i) { S[i] *= al; p += sk[j * 128 + kq * 32 + i] * S[i]; }
                red[kq * 128 + v] = p;
                __syncthreads();
                const float kS = red[v] + red[128 + v] + red[256 + v] + red[384 + v];
                const float delta = bt * (sv[j * 128 + v] - kS); float po = 0.f;
#pragma unroll
                for (int i = 0; i < 32; ++i) { S[i] += sk[j * 128 + kq * 32 + i] * delta; po += sq[j * 128 + kq * 32 + i] * S[i]; }
                red[512 + kq * 128 + v] = po;
                __syncthreads();
                if (kq == 0) oraw[(tb + j) * 1024 + h * 128 + v] = (red[512 + v] + red[512 + 128 + v] + red[512 + 256 + v] + red[512 + 384 + v]) * scale;
            }
            __syncthreads();
        }
    } else if (X.bid < 64) {
        const int sub = tid >> 8, t2 = tid & 255, bh = (X.bid - 32) * 2 + sub, b = bh >> 4, hd = bh & 15, g = hd >> 3, p = t2 >> 2, nq = t2 & 3;
        LAS float* sx = (LAS float*)X.lds + sub * (16 * 320 + 16); LAS float* sB = sx + 16 * 64; LAS float* sC = sB + 16 * 128; LAS float* sdt = sC + 16 * 128;
        const float a_neg = -__expf(a.ssd_a_log[hd]), dd = a.ssd_d[hd];
        float hs[32];
#pragma unroll
        for (int i = 0; i < 32; ++i) hs[i] = 0.f;
        for (int t0 = 0; t0 < SEQ; t0 += 16) {
            const size_t tb = (size_t)b * SEQ + t0;
            __syncthreads();
            for (int idx = t2; idx < 16 * 320; idx += 256) { const int jj = idx / 320, c = idx % 320;
                if (c < 64) sx[jj * 64 + c] = bf2f(xbc[(tb + jj) * 1536 + hd * 64 + c]);
                else if (c < 192) sB[jj * 128 + c - 64] = bf2f(xbc[(tb + jj) * 1536 + 1024 + g * 128 + (c - 64)]);
                else sC[jj * 128 + c - 192] = bf2f(xbc[(tb + jj) * 1536 + 1280 + g * 128 + (c - 192)]); }
            if (t2 < 16) sdt[t2] = dtb[(tb + t2) * 16 + hd];
            __syncthreads();
            for (int j = 0; j < 16; ++j) {
                const float dt = sdt[j], dA = __expf(dt * a_neg), xr = sx[j * 64 + p], xv = xr * dt; float y = 0.f;
#pragma unroll
                for (int i = 0; i < 32; ++i) { hs[i] = hs[i] * dA + xv * sB[j * 128 + nq * 32 + i]; y += sC[j * 128 + nq * 32 + i] * hs[i]; }
                y += __shfl_xor(y, 1); y += __shfl_xor(y, 2);
                if (nq == 0) yraw[(tb + j) * 1024 + hd * 64 + p] = y + dd * xr;
            }
        }
    }
}
DEV void ph_mix_post(const Args& a, const Ctx& X) {
    const float* oraw = (const float*)(a.ws + WS_ORAW); const float* yraw = (const float*)(a.ws + WS_YRAW);
    const bf16_t* za = (const bf16_t*)(a.ws + WS_ZA); const bf16_t* zb = (const bf16_t*)(a.ws + WS_ZB); bf16_t* oy = (bf16_t*)(a.ws + WS_OY);
    const int lane = X.lane;
    for (int wid = X.bid * NWAVES + X.wave; wid < T * 8; wid += X.G * NWAVES) {
        const int t = wid >> 3, h = wid & 7, c = h * 128 + lane * 2;
        const f32x2 o = *(const f32x2*)(oraw + (size_t)t * 1024 + c);
        const float r = rsqrtf(wave_sum(o.x * o.x + o.y * o.y) * (1.f / 128.f) + EPS);
        const float z0 = bf2f(za[(size_t)t * 1024 + c]), z1 = bf2f(za[(size_t)t * 1024 + c + 1]);
        *(unsigned*)(oy + (size_t)t * 2048 + c) = pk2(o.x * r * a.gdn_norm_w[lane * 2] * siluf(z0), o.y * r * a.gdn_norm_w[lane * 2 + 1] * siluf(z1));
    }
    for (int wid = X.bid * NWAVES + X.wave; wid < T * 2; wid += X.G * NWAVES) {
        const int t = wid >> 1, g = wid & 1; float v[8]; float ss = 0.f;
#pragma unroll
        for (int i = 0; i < 8; ++i) { const int c = g * 512 + lane * 8 + i; v[i] = yraw[(size_t)t * 1024 + c] * siluf(bf2f(zb[(size_t)t * 1024 + c])); ss += v[i] * v[i]; }
        const float r = rsqrtf(wave_sum(ss) * (1.f / 512.f) + EPS);
        u32x4 w; w.x = pk2(v[0] * r * a.ssd_norm_w[g * 512 + lane * 8], v[1] * r * a.ssd_norm_w[g * 512 + lane * 8 + 1]); w.y = pk2(v[2] * r * a.ssd_norm_w[g * 512 + lane * 8 + 2], v[3] * r * a.ssd_norm_w[g * 512 + lane * 8 + 3]);
        w.z = pk2(v[4] * r * a.ssd_norm_w[g * 512 + lane * 8 + 4], v[5] * r * a.ssd_norm_w[g * 512 + lane * 8 + 5]); w.w = pk2(v[6] * r * a.ssd_norm_w[g * 512 + lane * 8 + 6], v[7] * r * a.ssd_norm_w[g * 512 + lane * 8 + 7]);
        *(u32x4*)(oy + (size_t)t * 2048 + 1024 + g * 512 + lane * 8) = w;
    }
}
DEV void ph_attn_naive(const Args& a, const Ctx& X) {
    const bf16_t* qkv = (const bf16_t*)(a.ws + WS_Q1KV); bf16_t* o = (bf16_t*)(a.ws + WS_O1);
    const int lane = X.lane;
    for (int wid = X.bid * NWAVES + X.wave; wid < T * 16; wid += X.G * NWAVES) {
        const int t = wid >> 4, hh = wid & 15, s = t % SEQ;
        const float q = bf2f(qkv[(size_t)t * 3072 + hh * 64 + lane]);
        float m = -INFINITY, l = 0.f, acc = 0.f;
#pragma unroll
        for (int br = 0; br < 3; ++br) { const int d = br == 0 ? 1 : (br == 1 ? 4 : 16);
            for (int j = 0; j <= 128; ++j) { if (s - d * j < 0) break;
                const bf16_t* kr = qkv + (size_t)(t - d * j) * 3072 + 1024 + hh * 64;
                const float sc = wave_sum(q * bf2f(kr[lane]));
                const float mn = fmaxf(m, sc), al = __expf(m - mn), p = __expf(sc - mn);
                l = l * al + p; acc = acc * al + p * bf2f(kr[1024 + lane]); m = mn; } }
        o[(size_t)t * 1024 + hh * 64 + lane] = (bf16_t)f2bf(acc / l);
    }
}

DEV void ph_router(const Args& a, const Ctx& X, const int l) {
    unsigned char* ws = a.ws;
    const float* mod = (const float*)(ws + WS_MOD) + (size_t)l * NB * 6 * D;
    const float* ymix = (const float*)(ws + WS_YMIX);
    const float* xin = (l == 0) ? a.x : a.out;
    bf16_t* hb = (bf16_t*)(ws + WS_H);
    int* idx = (int*)(ws + WS_IDX); float* gw = (float*)(ws + WS_GW); int* aslot = (int*)(ws + WS_ASLOT); int* ltok = (int*)(ws + WS_LTOK);
    int* cntg = (int*)(ws + WS_CTL + CTL_CNT) + l * NE;
    const float* rw = a.router_w + (size_t)l * D * NE; const float* rbias = a.router_bias + l * NE;
    constexpr int HP = 2064;
    LAS unsigned char* hL = X.lds;
    LAS float* logit = (LAS float*)(X.lds + AUX_OFF + 2048);
    LAS int* lcnt = (LAS int*)(X.lds + AUX_OFF + 2048 + 64 * 65 * 4);
    LAS int* lbase = lcnt + 64;
    LAS int* sel_e = lbase + 64;
    LAS int* sel_s = sel_e + 512;
    const int lane = X.lane, wave = X.wave;
    for (int rb = X.bid; rb < T / 64; rb += X.G) {
        if (X.tid < 64) lcnt[X.tid] = 0;
        for (int r8 = 0; r8 < 8; ++r8) {
            const int lr = wave * 8 + r8, row = rb * 64 + lr, b = row / SEQ; const float* ml = mod + (size_t)b * 6 * D;
            float xv[16], yv[16]; load_row(xin + (size_t)row * D, lane, xv); load_row(ymix + (size_t)row * D, lane, yv);
            resid_update(xv, yv, a.mix_post_g + l * D, ml + 2 * D, lane);
            store_row(a.out + (size_t)row * D, lane, xv);
            u32x2 o[4]; prenorm_pack(xv, a.ffn_pre_g + l * D, ml + 4 * D, ml + 3 * D, lane, o);
#pragma unroll
            for (int j = 0; j < 4; ++j) { *(u32x2*)(hb + (size_t)row * D + j * 256 + lane * 4) = o[j]; *(LAS u32x2*)(hL + lr * HP + (j * 256 + lane * 4) * 2) = o[j]; }
        }
        __syncthreads();
        { const int rt = wave & 3, nh = wave >> 2, r16 = lane & 15, kq = lane >> 4;
          f32x4 acc0 = {0.f, 0.f, 0.f, 0.f}, acc1 = {0.f, 0.f, 0.f, 0.f};
          for (int c = 0; c < 32; ++c) {
              const u32x4 hv = *(const LAS u32x4*)(hL + (rt * 16 + r16) * HP + (32 * c + 8 * kq) * 2);
              const float* rp = rw + (size_t)(32 * c + 8 * kq) * NE + 4 * r16 + 2 * nh;
#pragma unroll
              for (int j = 0; j < 8; ++j) { const unsigned wj = hv[j >> 1]; const float av = (j & 1) ? __uint_as_float(wj & 0xFFFF0000u) : __uint_as_float(wj << 16);
                  const f32x2 bv = *(const f32x2*)(rp + (size_t)j * NE);
                  acc0 = __builtin_amdgcn_mfma_f32_16x16x4f32(av, bv.x, acc0, 0, 0, 0); acc1 = __builtin_amdgcn_mfma_f32_16x16x4f32(av, bv.y, acc1, 0, 0, 0); }
          }
#pragma unroll
          for (int r = 0; r < 4; ++r) { logit[(rt * 16 + 4 * kq + r) * 65 + 4 * r16 + 2 * nh] = acc0[r]; logit[(rt * 16 + 4 * kq + r) * 65 + 4 * r16 + 2 * nh + 1] = acc1[r]; } }
        __syncthreads();
        for (int r8 = 0; r8 < 8; ++r8) {
            const int lr = wave * 8 + r8, t = rb * 64 + lr;
            const float score = sigmoidf_(logit[lr * 65 + lane]), biased = score + rbias[lane];
            float m1 = biased;
#pragma unroll
            for (int o = 1; o < 8; o <<= 1) m1 = fmaxf(m1, __shfl_xor(m1, o));
            int c1 = (biased == m1) ? (lane & 7) : 8;
#pragma unroll
            for (int o = 1; o < 8; o <<= 1) c1 = min(c1, __shfl_xor(c1, o));
            float m2 = ((lane & 7) == c1) ? -INFINITY : biased;
#pragma unroll
            for (int o = 1; o < 8; o <<= 1) m2 = fmaxf(m2, __shfl_xor(m2, o));
            const float gs = m1 + m2; const int myg = lane >> 3; int grank = 0;
#pragma unroll
            for (int g2 = 0; g2 < 8; ++g2) { const float o = __shfl(gs, g2 * 8); grank += (o > gs || (o == gs && g2 < myg)) ? 1 : 0; }
            const float cand = (grank < 4) ? biased : -INFINITY; int rank = 0;
            for (int e2 = 0; e2 < 64; ++e2) { const float o = __shfl(cand, e2); rank += (o > cand || (o == cand && e2 < lane)) ? 1 : 0; }
            const bool sel = (rank < TOPK) && (grank < 4);
            const float ssum = wave_sum(sel ? score : 0.f);
            if (sel) { idx[t * 8 + rank] = lane; gw[t * 8 + rank] = score / ssum * 2.5f; sel_e[lr * 8 + rank] = lane; sel_s[lr * 8 + rank] = __hip_atomic_fetch_add(lcnt + lane, 1, __ATOMIC_RELAXED, __HIP_MEMORY_SCOPE_WORKGROUP); }
        }
        __syncthreads();
        if (X.tid < 64) { const int n = lcnt[X.tid]; lbase[X.tid] = n ? atomicAdd(cntg + X.tid, n) : 0; }
        __syncthreads();
        { const int lr = X.tid >> 3, k = X.tid & 7, t = rb * 64 + lr, e = sel_e[lr * 8 + k], sl = lbase[e] + sel_s[lr * 8 + k];
          aslot[t * 8 + k] = sl; ltok[e * CAP + sl] = t; }
        __syncthreads();
    }
    { LAS float* scr = (LAS float*)(X.lds + X.wave * 8704);
      const int gwv = X.bid * NWAVES + X.wave, NGW = X.G * NWAVES;
      constexpr int I_GU = (D / 64) * (512 / 32), I_D = (ED / 64) * (D / 32), I_E = I_GU + I_D;
      const float* eg = a.exp_gate + (size_t)l * NE * D * ED; const float* eu = a.exp_up + (size_t)l * NE * D * ED; const float* ed = a.exp_down + (size_t)l * NE * ED * D;
      for (int it = gwv; it < (NE + 1) * I_E; it += NGW) {
          const int e = it / I_E; int r = it - e * I_E;
          if (e < NE) {
              if (r < I_GU) conv_item(SrcGU{eg + (size_t)e * D * ED, (long)(eu - eg)}, ED, D, (bf16_t*)(ws + WS_WGU) + (size_t)e * 512 * D, scr, r, 16, X.lane);
              else conv_item(SrcIdent{ed + (size_t)e * ED * D}, D, ED, (bf16_t*)(ws + WS_WD) + (size_t)e * D * ED, scr, r - I_GU, D / 32, X.lane);
          } else {
              if (r < I_GU) conv_item(SrcGU{a.sh_gate + (size_t)l * D * ED, (long)(a.sh_up - a.sh_gate)}, ED, D, (bf16_t*)(ws + WS_WGUS), scr, r, 16, X.lane);
              else conv_item(SrcIdent{a.sh_down + (size_t)l * ED * D}, D, ED, (bf16_t*)(ws + WS_WDS), scr, r - I_GU, D / 32, X.lane);
          }
      } }
}

DEV int moe_tables(const Args& a, const Ctx& X, const int l, LAS int* t_cnt, LAS int* t_rb0, LAS int* t_eofrb) {
    const int* cntg = (const int*)(a.ws + WS_CTL + CTL_CNT) + l * NE;
    if (X.wave == 0) {
        const int c = __hip_atomic_load(cntg + X.lane, __ATOMIC_RELAXED, __HIP_MEMORY_SCOPE_AGENT), nrb = (c + 255) >> 8;
        int incl = nrb;
#pragma unroll
        for (int o = 1; o < 64; o <<= 1) { const int v = __shfl_up(incl, o); if (X.lane >= o) incl += v; }
        const int excl = incl - nrb;
        t_cnt[X.lane] = c; t_rb0[X.lane] = excl; if (X.lane == 63) t_rb0[64] = incl;
        for (int j = 0; j < nrb; ++j) t_eofrb[excl + j] = X.lane;
        t_eofrb[SH_RB + X.lane] = NE;
    }
    __syncthreads();
    return t_rb0[64];
}

DEV void ph_moe_gu(const Args& a, const Ctx& X, const int l) {
    LAS int* t_cnt = (LAS int*)(X.lds + AUX_OFF + 1024); LAS int* t_rb0 = t_cnt + 64; LAS int* t_eofrb = t_rb0 + 80; LAS int* toks = t_eofrb + NRB_ALL;
    const int nrbt = moe_tables(a, X, l, t_cnt, t_rb0, t_eofrb);
    const int* ltok = (const int*)(a.ws + WS_LTOK);
    pg8::Unit u;
    for (int i = 0; i < 8; ++i) { if (!pg8::moe_unit(i, 2, nrbt, X.G, X.bid, u)) break;
        if (X.tid < 256) { const int e = t_eofrb[u.pm]; int tok;
            if (e < NE) { const int sl = (u.pm - t_rb0[e]) * 256 + X.tid; tok = sl < t_cnt[e] ? ltok[e * CAP + sl] : 0; } else tok = (u.pm - SH_RB) * 256 + X.tid;
            toks[i * 256 + X.tid] = tok; } }
    VM_WAIT(); __syncthreads();
    pg8::SchedGU S{(const char*)(a.ws + WS_H), (const char*)(a.ws + WS_WGU), (const char*)(a.ws + WS_WGUS), t_eofrb, toks, nrbt, X.G, X.bid, 0};
    pg8::EpiGU E{(bf16_t*)(a.ws + WS_HID)};
    pg8::gemm_phase<pg8::EpiGU, pg8::SchedGU>(X.lds, D, S, E);
}
DEV void ph_moe_down(const Args& a, const Ctx& X, const int l) {
    LAS int* t_cnt = (LAS int*)(X.lds + AUX_OFF + 1024); LAS int* t_rb0 = t_cnt + 64; LAS int* t_eofrb = t_rb0 + 80;
    const int nrbt = moe_tables(a, X, l, t_cnt, t_rb0, t_eofrb);
    pg8::SchedDown S{(const char*)(a.ws + WS_HID), (const char*)(a.ws + WS_WD), (const char*)(a.ws + WS_WDS), t_eofrb, nrbt, X.G, X.bid, 0};
    pg8::EpiBf16 E{(bf16_t*)(a.ws + WS_Y), D, 0};
    int kd = ED; asm volatile("" : "+s"(kd));
    pg8::gemm_phase<pg8::EpiBf16, pg8::SchedDown>(X.lds, kd, S, E);
}
DEV void ph_combine(const Args& a, const Ctx& X, const int l) {
    LAS int* t_cnt = (LAS int*)(X.lds + AUX_OFF + 1024); LAS int* t_rb0 = t_cnt + 64; LAS int* t_eofrb = t_rb0 + 80;
    (void)moe_tables(a, X, l, t_cnt, t_rb0, t_eofrb);
    const float* mod = (const float*)(a.ws + WS_MOD);
    const int* idx = (const int*)(a.ws + WS_IDX); const float* gw = (const float*)(a.ws + WS_GW); const int* aslot = (const int*)(a.ws + WS_ASLOT);
    const bf16_t* y = (const bf16_t*)(a.ws + WS_Y); bf16_t* hb = (bf16_t*)(a.ws + WS_H);
    const int lane = X.lane;
    for (int t = X.bid * NWAVES + X.wave; t < T; t += X.G * NWAVES) {
        const int b = t / SEQ; const float* ml = mod + (size_t)(l * NB + b) * 6 * D;
        float yv[16];
        { const bf16_t* yr = y + ((size_t)SH_RB * 256 + t) * D;
#pragma unroll
          for (int j = 0; j < 4; ++j) { const u32x2 w = *(const u32x2*)(yr + j * 256 + lane * 4); yv[4 * j] = __uint_as_float(w.x << 16); yv[4 * j + 1] = __uint_as_float(w.x & 0xFFFF0000u); yv[4 * j + 2] = __uint_as_float(w.y << 16); yv[4 * j + 3] = __uint_as_float(w.y & 0xFFFF0000u); } }
#pragma unroll
        for (int k = 0; k < 8; ++k) {
            const int e = idx[t * 8 + k]; const float g = gw[t * 8 + k]; const size_t row = (size_t)t_rb0[e] * 256 + aslot[t * 8 + k];
            const bf16_t* yr = y + row * D;
#pragma unroll
            for (int j = 0; j < 4; ++j) { const u32x2 w = *(const u32x2*)(yr + j * 256 + lane * 4);
                yv[4 * j] += g * __uint_as_float(w.x << 16); yv[4 * j + 1] += g * __uint_as_float(w.x & 0xFFFF0000u); yv[4 * j + 2] += g * __uint_as_float(w.y << 16); yv[4 * j + 3] += g * __uint_as_float(w.y & 0xFFFF0000u); }
        }
        float xv[16]; load_row(a.out + (size_t)t * D, lane, xv);
        resid_update(xv, yv, a.ffn_post_g + l * D, ml + 5 * D, lane);
        store_row(a.out + (size_t)t * D, lane, xv);
        if (l == 0) { const float* mn = mod + (size_t)(1 * NB + b) * 6 * D; u32x2 o[4]; prenorm_pack(xv, a.mix_pre_g + D, mn + D, mn, lane, o);
#pragma unroll
            for (int j = 0; j < 4; ++j) *(u32x2*)(hb + (size_t)t * D + j * 256 + lane * 4) = o[j]; }
    }
}

constexpr int NPH = 18;
__global__ void __launch_bounds__(NTHR, 2) mega(Args a) {
    extern __shared__ __attribute__((aligned(16))) unsigned char lds_raw[];
    Ctx X; X.lds = (LAS unsigned char*)lds_raw; X.tid = threadIdx.x; X.lane = X.tid & 63; X.wave = __builtin_amdgcn_readfirstlane(X.tid >> 6); X.G = gridDim.x; X.bid = blockIdx.x;
    if (X.tid < 4) ((LAS unsigned*)(X.lds + BAR_OFF))[X.tid] = 0u;
    __syncthreads();
    XcdBarrier bar; bar.bar = (unsigned*)(a.ws + WS_CTL); bar.x = 0; bar.st = nullptr;
    if (!MK_PER_PHASE) bar = xcd_barrier_post((unsigned*)(a.ws + WS_CTL), (volatile LAS unsigned*)(X.lds + BAR_OFF));
    const int lo = a.ph_lo, hi = a.ph_hi;
#define IN(k) (lo <= (k) && (k) < hi)
#define SEAM(k) do { if (IN(k) && IN((k) + 1)) xcd_barrier(bar); else { VM_WAIT(); __syncthreads(); } } while (0)
    unsigned char* ws = a.ws;
    if (IN(0)) { ph_setup(a, X); SEAM(0); }
    if (IN(1)) { ph_prenorm0(a, X); SEAM(1); }
    if (IN(2)) {
        pg8::SchedDense S; S.so.init(T, NPROJ, X.G, X.bid); S.A = (const char*)(ws + WS_H); S.Bt = (const char*)(ws + WS_WIN); S.K = D; S.pad_ = 0;
        pg8::EpiProj E{(bf16_t*)(ws + WS_QKVPRE), (bf16_t*)(ws + WS_ZA), (bf16_t*)(ws + WS_XBCPRE), (bf16_t*)(ws + WS_ZB), (float*)(ws + WS_SMALL)};
        pg8::gemm_phase<pg8::EpiProj, pg8::SchedDense>(X.lds, D, S, E); SEAM(2); }
    if (IN(3)) { ph_mix_prep(a, X); SEAM(3); }
    if (IN(4)) { ph_mix_seq(a, X); SEAM(4); }
    if (IN(5)) { ph_mix_post(a, X); SEAM(5); }
    if (IN(6)) {
        pg8::SchedDense S; S.so.init(T, D, X.G, X.bid); S.A = (const char*)(ws + WS_OY); S.Bt = (const char*)(ws + WS_WOUT); S.K = 2048; S.pad_ = 0;
        pg8::EpiF32 E{(float*)(ws + WS_YMIX), D, 0};
        pg8::gemm_phase<pg8::EpiF32, pg8::SchedDense>(X.lds, 2048, S, E); SEAM(6); }
    if (IN(7)) { ph_router(a, X, 0); SEAM(7); }
    if (IN(8)) { ph_moe_gu(a, X, 0); SEAM(8); }
    if (IN(9)) { ph_moe_down(a, X, 0); SEAM(9); }
    if (IN(10)) { ph_combine(a, X, 0); SEAM(10); }
    if (IN(11)) {
        pg8::SchedDense S; S.so.init(T, 3072, X.G, X.bid); S.A = (const char*)(ws + WS_H); S.Bt = (const char*)(ws + WS_WQKV); S.K = D; S.pad_ = 0;
        pg8::EpiQKV E{(bf16_t*)(ws + WS_Q1KV), (const float*)(ws + WS_COS), (const float*)(ws + WS_SIN)};
        pg8::gemm_phase<pg8::EpiQKV, pg8::SchedDense>(X.lds, D, S, E); SEAM(11); }
    if (IN(12)) { ph_attn_naive(a, X); SEAM(12); }
    if (IN(13)) {
        pg8::SchedDense S; S.so.init(T, D, X.G, X.bid); S.A = (const char*)(ws + WS_O1); S.Bt = (const char*)(ws + WS_WO); S.K = D; S.pad_ = 0;
        pg8::EpiF32 E{(float*)(ws + WS_YMIX), D, 0};
        pg8::gemm_phase<pg8::EpiF32, pg8::SchedDense>(X.lds, D, S, E); SEAM(13); }
    if (IN(14)) { ph_router(a, X, 1); SEAM(14); }
    if (IN(15)) { ph_moe_gu(a, X, 1); SEAM(15); }
    if (IN(16)) { ph_moe_down(a, X, 1); SEAM(16); }
    if (IN(17)) { ph_combine(a, X, 1); }
#undef IN
#undef SEAM
}

extern "C" void kernel_launch(void* const* d_in, const int* in_sizes, int n_in, void* d_out, int out_size, void* d_ws, size_t ws_size, hipStream_t stream) {
    static int grid = 0;
    if (!grid) {
        int dev = 0, cus = 0, per_cu = 0;
        if (hipGetDevice(&dev) != hipSuccess || hipDeviceGetAttribute(&cus, hipDeviceAttributeMultiprocessorCount, dev) != hipSuccess) { fprintf(stderr, "kernel_launch: device query failed\n"); grid = -1; return; }
        if (hipFuncSetAttribute((const void*)mega, hipFuncAttributeMaxDynamicSharedMemorySize, LDS_BYTES) != hipSuccess) { fprintf(stderr, "kernel_launch: hipFuncSetAttribute failed\n"); grid = -1; return; }
        if (hipOccupancyMaxActiveBlocksPerMultiprocessor(&per_cu, (const void*)mega, NTHR, LDS_BYTES) != hipSuccess || per_cu < 1) { fprintf(stderr, "kernel_launch: occupancy query says %d blocks per CU\n", per_cu); grid = -1; return; }
        grid = cus;
        if (grid < 64 || (grid & 7)) { fprintf(stderr, "kernel_launch: unsupported CU count %d\n", cus); grid = -1; return; }
    }
    if (grid < 0) return;
    if (ws_size < WS_END || n_in != 31) { fprintf(stderr, "kernel_launch: workspace %zu < %zu or n_in %d != 31\n", ws_size, (size_t)WS_END, n_in); return; }
    if (hipMemsetAsync((char*)d_ws + WS_CTL, 0, CTL_BYTES, stream) != hipSuccess) { fprintf(stderr, "kernel_launch: memset failed\n"); return; }
    Args a{};
    a.x = (const float*)d_in[0]; a.c = (const float*)d_in[1]; a.pos = (const int*)d_in[2]; a.mod_w = (const float*)d_in[3]; a.mod_b = (const float*)d_in[4];
    a.mix_pre_g = (const float*)d_in[5]; a.mix_post_g = (const float*)d_in[6]; a.ffn_pre_g = (const float*)d_in[7]; a.ffn_post_g = (const float*)d_in[8];
    a.ssm_w_in = (const float*)d_in[9]; a.gdn_conv_w = (const float*)d_in[10]; a.gdn_a_log = (const float*)d_in[11]; a.gdn_dt_bias = (const float*)d_in[12]; a.gdn_norm_w = (const float*)d_in[13];
    a.ssd_conv_w = (const float*)d_in[14]; a.ssd_conv_b = (const float*)d_in[15]; a.ssd_a_log = (const float*)d_in[16]; a.ssd_dt_bias = (const float*)d_in[17]; a.ssd_d = (const float*)d_in[18]; a.ssd_norm_w = (const float*)d_in[19];
    a.ssm_w_out = (const float*)d_in[20]; a.attn_w_qkv = (const float*)d_in[21]; a.attn_w_o = (const float*)d_in[22];
    a.router_w = (const float*)d_in[23]; a.router_bias = (const float*)d_in[24]; a.exp_gate = (const float*)d_in[25]; a.exp_up = (const float*)d_in[26]; a.exp_down = (const float*)d_in[27];
    a.sh_gate = (const float*)d_in[28]; a.sh_up = (const float*)d_in[29]; a.sh_down = (const float*)d_in[30];
    a.out = (float*)d_out; a.ws = (unsigned char*)d_ws;
#if MK_PER_PHASE
    for (int p = 0; p < NPH; ++p) { a.ph_lo = p; a.ph_hi = p + 1; hipLaunchKernelGGL(mega, dim3(grid), dim3(NTHR), LDS_BYTES, stream, a); }
#else
    a.ph_lo = 0; a.ph_hi = NPH;
    hipLaunchKernelGGL(mega, dim3(grid), dim3(NTHR), LDS_BYTES, stream, a);
#endif
}
```

```cpp
#include <hip/hip_runtime.h>
#include <stdint.h>
#include <stdio.h>

#define DEV __device__ __forceinline__
#define LAS __attribute__((address_space(3)))
typedef unsigned short bf16_t;
typedef short bf16x8 __attribute__((ext_vector_type(8)));
typedef float f32x4 __attribute__((ext_vector_type(4)));
typedef float f32x2 __attribute__((ext_vector_type(2)));
typedef unsigned u32x4 __attribute__((ext_vector_type(4)));
typedef unsigned u32x2 __attribute__((ext_vector_type(2)));
typedef float f32x16 __attribute__((ext_vector_type(16)));
typedef short s16x4 __attribute__((ext_vector_type(4)));

#ifndef MK_PER_PHASE
#define MK_PER_PHASE 0
#endif

constexpr int NB = 4, SEQ = 4096, T = NB * SEQ, D = 1024;
constexpr int PROJ = 6688, NPROJ = 6912;
constexpr int C_BETA = 4096, C_XBC = 4112, C_ZB = 5648, C_DT = 6672;
constexpr int NE = 64, TOPK = 8, ED = 256, CAP = 16384;
constexpr int SH_RB = 576;
constexpr int NRB_ALL = SH_RB + 64;
constexpr float EPS = 1e-6f;
constexpr int NTHR = 512, NWAVES = 8;
constexpr int LDS_BYTES = 163840;
constexpr int AUX_OFF = 131072;
constexpr int BAR_OFF = LDS_BYTES - 16;

constexpr size_t MiB = 1u << 20;
constexpr size_t WS_CTL = 0, CTL_BYTES = 65536;
constexpr size_t CTL_CNT = 16384;
constexpr size_t WS_MOD = 65536;
constexpr size_t WS_COS = 1 * MiB, WS_SIN = 3 * MiB;
constexpr size_t WS_IDX = 5 * MiB, WS_GW = 5 * MiB + 512 * 1024, WS_ASLOT = 6 * MiB, WS_LTOK = 6 * MiB + 512 * 1024;
constexpr size_t WS_SMALL = 11 * MiB;
constexpr size_t WS_GB = 13 * MiB, WS_DTB = 14 * MiB;
constexpr size_t WS_WIN = 16 * MiB, WS_WOUT = 30 * MiB, WS_WQKV = 34 * MiB, WS_WO = 40 * MiB;
constexpr size_t WS_H = 44 * MiB;
constexpr size_t WS_QKVPRE = 78 * MiB, WS_XBCPRE = 174 * MiB, WS_ZA = 222 * MiB, WS_ZB = 254 * MiB;
constexpr size_t WS_QKVN = 286 * MiB, WS_XBCC = 382 * MiB;
constexpr size_t WS_CC = 16 * MiB, WS_ACUM = 25 * MiB, WS_CDEC = 26 * MiB, WS_YDIAG = 44 * MiB, WS_STATES = 462 * MiB;
constexpr size_t WS_GI = 286 * MiB, GI_UNIT = 73728, WS_GTMP = 430 * MiB, WS_GLAST = 27 * MiB;
constexpr size_t WS_ORAW = 78 * MiB, WS_YRAW = 142 * MiB, WS_OY = 78 * MiB, WS_YMIX = 414 * MiB;
constexpr size_t WS_WD = 78 * MiB, WS_WDS = 110 * MiB, WS_HID = 112 * MiB, WS_Y = 192 * MiB, WS_WGU = 192 * MiB, WS_WGUS = 256 * MiB;
constexpr size_t WS_Q1KV = 78 * MiB, WS_O1 = 174 * MiB, WS_PO = 206 * MiB, WS_PLSE = 302 * MiB;
constexpr size_t WS_END = 512 * MiB;

struct Args {
    const float* x; const float* c; const int* pos; const float* mod_w; const float* mod_b;
    const float* mix_pre_g; const float* mix_post_g; const float* ffn_pre_g; const float* ffn_post_g;
    const float* ssm_w_in; const float* gdn_conv_w; const float* gdn_a_log; const float* gdn_dt_bias; const float* gdn_norm_w;
    const float* ssd_conv_w; const float* ssd_conv_b; const float* ssd_a_log; const float* ssd_dt_bias; const float* ssd_d; const float* ssd_norm_w;
    const float* ssm_w_out; const float* attn_w_qkv; const float* attn_w_o;
    const float* router_w; const float* router_bias; const float* exp_gate; const float* exp_up; const float* exp_down;
    const float* sh_gate; const float* sh_up; const float* sh_down;
    float* out; unsigned char* ws; int ph_lo, ph_hi;
};

DEV float bf2f(bf16_t v) { return __uint_as_float(((unsigned)v) << 16); }
DEV unsigned f2bf(float f) { unsigned u = __float_as_uint(f); return (u + 0x7FFFu + ((u >> 16) & 1u)) >> 16; }
DEV unsigned pk2(float lo, float hi) { return f2bf(lo) | (f2bf(hi) << 16); }
DEV float wave_sum(float v) {
#pragma unroll
    for (int o = 32; o > 0; o >>= 1) v += __shfl_xor(v, o);
    return v;
}
DEV float siluf(float x) { return x / (1.f + __expf(-x)); }
DEV float sigmoidf_(float x) { return 1.f / (1.f + __expf(-x)); }
DEV float softplusf(float x) { return fmaxf(x, 0.f) + log1pf(__expf(-fabsf(x))); }
#define LDS_WAIT() asm volatile("s_waitcnt lgkmcnt(0)" ::: "memory")
#define VM_WAIT() asm volatile("s_waitcnt vmcnt(0)" ::: "memory")

#define XB_TMO      128
#define XB_XCNT(j)  (256  + 64 * (j))
#define XB_XSUB(j)  (1280 + 64 * (j))
#define XB_XGEN(j)  (2304 + 64 * (j))
#define XB_TOP      3328
#define XB_TOPGEN   3392
#define XCD_BAR_WORDS 3456
#define XB_SPIN_CAP (1u << 18)
#define LAS __attribute__((address_space(3)))

__device__ __forceinline__ unsigned xb_ld(unsigned* p)              { return __hip_atomic_load(p, __ATOMIC_RELAXED, __HIP_MEMORY_SCOPE_AGENT); }
__device__ __forceinline__ unsigned xb_add(unsigned* p, unsigned v) { return __hip_atomic_fetch_add(p, v, __ATOMIC_RELAXED, __HIP_MEMORY_SCOPE_AGENT); }
__device__ __forceinline__ unsigned xb_xcc_id() { return (unsigned)__builtin_amdgcn_s_getreg((3 << 11) | 20) & 0xFu; }
#define XB_SPIN(cond, bar) do { unsigned _sp = 0; while (cond) { __builtin_amdgcn_s_sleep(1); \
    if ((++_sp & 255u) == 0u) { if (xb_ld(&(bar)[XB_TMO])) break; if (_sp > XB_SPIN_CAP) { atomicAdd(&(bar)[XB_TMO], 1u); break; } } } } while (0)

struct XcdBarrier {
    unsigned* bar; unsigned x;
    volatile LAS unsigned* st;
};

__device__ __forceinline__ XcdBarrier xcd_barrier_post(unsigned* bar, volatile LAS unsigned* st) {
    XcdBarrier b; b.bar = bar; b.x = xb_xcc_id(); b.st = st;
    if (threadIdx.x == 0) (void)xb_add(&bar[XB_XCNT(b.x)], 1u);
    return b;
}
__device__ __forceinline__ void xcd_barrier_complete(unsigned* bar, unsigned x, unsigned& nloc, unsigned& nx) {
    const unsigned G = gridDim.x * gridDim.y * gridDim.z;
    unsigned sum, cnt, mine, sp = 0u;
    for (;;) {
        sum = 0u; cnt = 0u; mine = 0u;
#pragma unroll
        for (unsigned j = 0; j < 16; ++j) { const unsigned c = xb_ld(&bar[XB_XCNT(j)]); sum += c; cnt += (c > 0u) ? 1u : 0u; mine = (j == x) ? c : mine; }
        if (sum == G) break;
        __builtin_amdgcn_s_sleep(1);
        if ((++sp & 255u) == 0u) { if (xb_ld(&bar[XB_TMO])) break; if (sp > XB_SPIN_CAP) { atomicAdd(&bar[XB_TMO], 1u); break; } }
    }
    nloc = mine > 0u ? mine : 1u; nx = cnt > 0u ? cnt : 1u;
}

__device__ __forceinline__ void xcd_barrier(const XcdBarrier& b) {
    asm volatile("s_waitcnt vmcnt(0)" ::: "memory");
    __syncthreads();
    if (threadIdx.x == 0) {
        unsigned* bar = b.bar;
        __builtin_amdgcn_s_waitcnt(0);
        unsigned nloc = b.st[0], nx = b.st[1];
        if (nloc == 0u) { xcd_barrier_complete(bar, b.x, nloc, nx); b.st[0] = nloc; b.st[1] = nx; }
        const unsigned old = xb_add(&bar[XB_XSUB(b.x)], 1u);
        const unsigned gen = old / nloc;
        if (old + 1u == (gen + 1u) * nloc) {
            __builtin_amdgcn_fence(__ATOMIC_RELEASE, "agent");
            asm volatile("s_waitcnt vmcnt(0)" ::: "memory");
            const unsigned og = xb_add(&bar[XB_TOP], 1u);
            const unsigned tg = og / nx;
            if (og + 1u == (tg + 1u) * nx) xb_add(&bar[XB_TOPGEN], 1u);
            else XB_SPIN(xb_ld(&bar[XB_TOPGEN]) == tg, bar);
            __builtin_amdgcn_fence(__ATOMIC_ACQUIRE, "agent");
            xb_add(&bar[XB_XGEN(b.x)], 1u);
            asm volatile("s_waitcnt vmcnt(0)" ::: "memory");
        } else {
            XB_SPIN(xb_ld(&bar[XB_XGEN(b.x)]) == gen, bar);
            __builtin_amdgcn_fence(__ATOMIC_ACQUIRE, "agent");
            asm volatile("s_waitcnt vmcnt(0)" ::: "memory");
        }
    }
    __syncthreads();
}


namespace pg8 {
constexpr int BM = 256, BK = 64, HALF = 128, HTB = HALF * BK * 2, STAGE_BYTES = 8 * HTB, NXCD = 8, WGM = 8;
DEV int lds_byte(int r, int c) { const int st = (r >> 4) * 2 + (c >> 5), rr = r & 15, cc = c & 31, ob = rr * 64 + cc * 2; return st * 1024 + (ob ^ (((ob >> 9) & 1) << 5)); }
DEV void stage_rc(int b, int& R, int& C) { const int st = b / 1024, sb = b % 1024, swz = sb ^ (((sb >> 9) & 1) << 5); R = (st >> 1) * 16 + swz / 64; C = (st & 1) * 32 + (swz % 64) / 2; }
DEV int perm32(int rho) { const int n = rho >> 4, i = rho & 15; return 8 * (i >> 2) + 4 * n + (i & 3); }
struct Unit { int pm, pn, e, slot; };
struct StaticOrder {
    int nM, nN, nwg, G, c;
    DEV void init(int M, int N, int G_, int c_) { nM = M / BM; nN = N / BM; nwg = nM * nN; G = G_; c = c_; }
    DEV bool next(int i, int& pm, int& pn) const {
        const long L = (long)i * G + c; if (L >= nwg) return false;
        int wgid = (int)L; { const int q = nwg / NXCD, r = nwg % NXCD, xcd = wgid % NXCD, off = wgid / NXCD; wgid = (xcd < r ? xcd * (q + 1) : r * (q + 1) + (xcd - r) * q) + off; }
        const int nig = WGM * nN, gid = wgid / nig, fm = gid * WGM, gsz = (nM - fm) < WGM ? (nM - fm) : WGM;
        pm = fm + ((wgid % nig) % gsz); pn = (wgid % nig) / gsz; return true;
    }
};
typedef __bf16 bf16x2_t __attribute__((ext_vector_type(2)));
DEV unsigned cvt_pk_bf16(float lo, float hi) { const bf16x2_t v = {(__bf16)lo, (__bf16)hi}; return __builtin_bit_cast(unsigned, v); }
DEV u32x4 pack8(const f32x4 a, const f32x4 b) { u32x4 w; w.x = cvt_pk_bf16(a[0], a[1]); w.y = cvt_pk_bf16(a[2], a[3]); w.z = cvt_pk_bf16(b[0], b[1]); w.w = cvt_pk_bf16(b[2], b[3]); return w; }

template <class Epi, class Sched>
DEV void gemm_phase(LAS unsigned char* lds, const int K, const Sched& S, const Epi& E) {
    const int tid = threadIdx.x, wid = __builtin_amdgcn_readfirstlane(tid >> 6), lane = tid & 63, wr = wid >> 2, wc = wid & 3, fr = lane & 15, fq = lane >> 4;
    const int nt = K / BK;
    unsigned voffB[2];
#pragma unroll
    for (int i = 0; i < 2; ++i) { int R, C; stage_rc(tid * 16 + i * 8192, R, C); const int Rb = Epi::PERM ? ((R & ~31) + perm32(R & 31)) : R; voffB[i] = (unsigned)(Rb * K + C) * 2u; }
    const unsigned kstep = (unsigned)(BK * 2);
    const size_t hstep = (size_t)HALF * K * 2;
    const unsigned ldsw = (unsigned)wid * 1024u;
    const int aoff = lds_byte(wr * 64 + fr, fq * 8), boff = lds_byte(wc * 32 + fr, fq * 8);
    const size_t hsA = Sched::GATHER ? (size_t)0 : hstep;
#define PG8_SA(b, h) (((b) * 2 + (h)) * HTB)
#define PG8_SB(b, h) ((4 + (b) * 2 + (h)) * HTB)
#define PG8_STAGEB(bufoff, gbase) do { _Pragma("unroll") for (int _i = 0; _i < 2; ++_i) \
        __builtin_amdgcn_global_load_lds((const unsigned*)((const char*)(gbase) + voffB[_i]), (LAS unsigned*)(lds + (bufoff) + ldsw + _i * 8192), 16, 0, 0); } while (0)
#define PG8_STAGEA(bufoff, gbase, VO) do { _Pragma("unroll") for (int _i = 0; _i < 2; ++_i) \
        __builtin_amdgcn_global_load_lds((const unsigned*)((const char*)(gbase) + (VO)[_i]), (LAS unsigned*)(lds + (bufoff) + ldsw + _i * 8192), 16, 0, 0); } while (0)
#define PG8_LDA(dst, b, h) do { _Pragma("unroll") for (int m = 0; m < 4; ++m) _Pragma("unroll") for (int k = 0; k < 2; ++k) dst[m][k] = *(const LAS bf16x8*)(lds + PG8_SA(b, h) + aoff + m * 2048 + k * 1024); } while (0)
#define PG8_LDB(dst, b, h) do { _Pragma("unroll") for (int n = 0; n < 2; ++n) _Pragma("unroll") for (int k = 0; k < 2; ++k) dst[n][k] = *(const LAS bf16x8*)(lds + PG8_SB(b, h) + boff + n * 2048 + k * 1024); } while (0)
#define PG8_MMA(ai, bj, At, Bt) do { __builtin_amdgcn_s_setprio(1); _Pragma("unroll") for (int m = 0; m < 4; ++m) _Pragma("unroll") for (int n = 0; n < 2; ++n) _Pragma("unroll") for (int k = 0; k < 2; ++k) \
        acc[ai][bj][m][n] = __builtin_amdgcn_mfma_f32_16x16x32_bf16(Bt[n][k], At[m][k], acc[ai][bj][m][n], 0, 0, 0); __builtin_amdgcn_s_setprio(0); } while (0)
#define PG8_WAIT_V(n) asm volatile("s_waitcnt vmcnt(" #n ")" ::: "memory")
#define PG8_WAIT_L(n) asm volatile("s_waitcnt lgkmcnt(" #n ")" ::: "memory")
#define PG8_BAR __builtin_amdgcn_s_barrier()
#define PG8_SCHED __builtin_amdgcn_sched_barrier(0)
    Unit cur, nxt; int ui = 0;
    if (!S.next(0, cur)) return;
    f32x4 acc[2][2][4][2];
#pragma unroll
    for (int a = 0; a < 2; ++a)
#pragma unroll
        for (int b = 0; b < 2; ++b)
#pragma unroll
            for (int m = 0; m < 4; ++m)
#pragma unroll
                for (int n = 0; n < 2; ++n) acc[a][b][m][n] = (f32x4){0.f, 0.f, 0.f, 0.f};
    bf16x8 At[4][2], B0[2][2], B1[2][2];
    unsigned va[2][2];
    S.a_voff(cur, tid, va);
    const char* cA = S.a_ptr(cur);
    const char* cB = S.b_ptr(cur);
    PG8_STAGEB(PG8_SB(0, 0), cB); PG8_STAGEB(PG8_SB(0, 1), cB + hstep); PG8_STAGEA(PG8_SA(0, 0), cA, va[0]); PG8_STAGEA(PG8_SA(0, 1), cA + hsA, va[1]);
    if (wr == 1) PG8_BAR;
    PG8_WAIT_V(2); PG8_BAR;
    PG8_STAGEB(PG8_SB(1, 0), cB + kstep); PG8_STAGEA(PG8_SA(1, 0), cA + kstep, va[0]); PG8_STAGEB(PG8_SB(1, 1), cB + hstep + kstep);
    PG8_WAIT_V(6); PG8_BAR;
    for (;;) {
        const bool has_next = S.next(ui + 1, nxt);
        const char* nB = has_next ? S.b_ptr(nxt) : cB;
        const char* nA = has_next ? S.a_ptr(nxt) : cA;
        for (int t = 0; t < nt; t += 2) {
            const bool last = (t == nt - 2);
            const char* a1 = cA + (size_t)(t + 1) * kstep;
            const char* a2 = last ? nA : cA + (size_t)(t + 2) * kstep; const char* a3 = a2 + kstep;
            unsigned v2[2][2];
            v2[0][0] = va[0][0]; v2[0][1] = va[0][1]; v2[1][0] = va[1][0]; v2[1][1] = va[1][1];
            if constexpr (Sched::GATHER) { if (last && has_next) S.a_voff(nxt, tid, v2); }
            const char* b2 = last ? nB : cB + (size_t)(t + 2) * kstep; const char* b3 = b2 + kstep;
            PG8_LDB(B0, 0, 0); PG8_LDB(B1, 0, 1); PG8_SCHED; PG8_LDA(At, 0, 0); PG8_STAGEA(PG8_SA(1, 1), a1 + hsA, va[1]);
            PG8_WAIT_V(8); PG8_WAIT_L(0); PG8_BAR; PG8_MMA(0, 0, At, B0); PG8_MMA(0, 1, At, B1); PG8_BAR; PG8_SCHED;
            PG8_LDA(At, 0, 1); PG8_STAGEB(PG8_SB(0, 0), b2); PG8_STAGEB(PG8_SB(0, 1), b2 + hstep); PG8_STAGEA(PG8_SA(0, 0), a2, v2[0]);
            PG8_WAIT_V(8); PG8_WAIT_L(0); PG8_BAR; PG8_MMA(1, 0, At, B0); PG8_MMA(1, 1, At, B1); PG8_BAR; PG8_SCHED;
            PG8_LDB(B0, 1, 0); PG8_LDB(B1, 1, 1); PG8_SCHED; PG8_LDA(At, 1, 0); PG8_STAGEA(PG8_SA(0, 1), a2 + hsA, v2[1]);
            PG8_WAIT_V(8); PG8_WAIT_L(0); PG8_BAR; PG8_MMA(0, 0, At, B0); PG8_MMA(0, 1, At, B1); PG8_BAR; PG8_SCHED;
            PG8_LDA(At, 1, 1); PG8_STAGEB(PG8_SB(1, 0), b3); PG8_STAGEB(PG8_SB(1, 1), b3 + hstep); PG8_STAGEA(PG8_SA(1, 0), a3, v2[0]);
            PG8_WAIT_V(8); PG8_WAIT_L(0); PG8_BAR; PG8_MMA(1, 0, At, B0); PG8_MMA(1, 1, At, B1); PG8_BAR; PG8_SCHED;
        }
        if (wr == 0) PG8_BAR;
        E(acc, cur, wr, wc, fr, fq);
        if (!has_next) break;
#pragma unroll
        for (int a = 0; a < 2; ++a)
#pragma unroll
            for (int b = 0; b < 2; ++b)
#pragma unroll
                for (int m = 0; m < 4; ++m)
#pragma unroll
                    for (int n = 0; n < 2; ++n) acc[a][b][m][n] = (f32x4){0.f, 0.f, 0.f, 0.f};
        cur = nxt; cB = nB; cA = nA; ++ui;
        if constexpr (Sched::GATHER) S.a_voff(cur, tid, va);
        if (wr == 1) PG8_BAR;
    }
    PG8_WAIT_V(0);
    PG8_BAR;
#undef PG8_SA
#undef PG8_SB
#undef PG8_STAGEA
#undef PG8_STAGEB
#undef PG8_LDA
#undef PG8_LDB
#undef PG8_MMA
#undef PG8_WAIT_V
#undef PG8_WAIT_L
#undef PG8_BAR
#undef PG8_SCHED
}

struct SchedDense {
    static constexpr bool GATHER = false;
    StaticOrder so; const char* A; const char* Bt; int K; int pad_;
    DEV bool next(int i, Unit& u) const { int pm, pn; if (!so.next(i, pm, pn)) return false; u.pm = pm; u.pn = pn; u.e = 0; u.slot = 0; return true; }
    DEV const char* a_ptr(const Unit& u) const { return A + (size_t)u.pm * 256 * K * 2; }
    DEV void a_voff(const Unit&, const int tid, unsigned (&vo)[2][2]) const {
#pragma unroll
        for (int i = 0; i < 2; ++i) { int R, C; stage_rc(tid * 16 + i * 8192, R, C); vo[0][i] = vo[1][i] = (unsigned)((R * K + C) * 2); }
    }
    DEV const char* b_ptr(const Unit& u) const { return Bt + (size_t)u.pn * 256 * K * 2; }
};
DEV bool moe_unit(int i, int NJ, int nrbt, int G, int c, Unit& u) {
    const int n = (nrbt + 64) * NJ; int L;
    if (G & 7) { L = i * G + c; if (L >= n) return false; }
    else { const int gq = G >> 3, per = (n + 7) >> 3, x = c & 7, q = c >> 3, j = i * gq + q; if (j >= per) return false; L = x * per + j; if (L >= n) return false; }
    int grb = L / NJ; const int pn = L - grb * NJ; if (grb >= nrbt) grb = SH_RB + (grb - nrbt);
    u.pm = grb; u.pn = pn; u.slot = i; u.e = 0; return true;
}
struct SchedGU {
    static constexpr bool GATHER = true;
    const char* A; const char* Wgu; const char* Wgus; const LAS int* eofrb; const LAS int* toks; int nrbt, G, c, pad_;
    DEV bool next(int i, Unit& u) const { if (!moe_unit(i, 2, nrbt, G, c, u)) return false; u.e = __builtin_amdgcn_readfirstlane(eofrb[u.pm]); return true; }
    DEV const char* a_ptr(const Unit&) const { return A; }
    DEV void a_voff(const Unit& u, const int tid, unsigned (&vo)[2][2]) const {
#pragma unroll
        for (int i = 0; i < 2; ++i) { int R, C; stage_rc(tid * 16 + i * 8192, R, C);
#pragma unroll
            for (int h = 0; h < 2; ++h) { const int tok = toks[u.slot * 256 + h * 128 + R]; vo[h][i] = (unsigned)((tok * D + C) * 2); } }
    }
    DEV const char* b_ptr(const Unit& u) const { return (u.e < NE ? Wgu + (size_t)u.e * 512 * D * 2 : Wgus) + (size_t)u.pn * 256 * D * 2; }
};
struct SchedDown {
    static constexpr bool GATHER = false;
    const char* A; const char* Wd; const char* Wds; const LAS int* eofrb; int nrbt, G, c, pad_;
    DEV bool next(int i, Unit& u) const { if (!moe_unit(i, 4, nrbt, G, c, u)) return false; u.e = __builtin_amdgcn_readfirstlane(eofrb[u.pm]); return true; }
    DEV const char* a_ptr(const Unit& u) const { return A + (size_t)u.pm * 256 * ED * 2; }
    DEV void a_voff(const Unit&, const int tid, unsigned (&vo)[2][2]) const {
#pragma unroll
        for (int i = 0; i < 2; ++i) { int R, C; stage_rc(tid * 16 + i * 8192, R, C); vo[0][i] = vo[1][i] = (unsigned)((R * ED + C) * 2); }
    }
    DEV const char* b_ptr(const Unit& u) const { return (u.e < NE ? Wd + (size_t)u.e * D * ED * 2 : Wds) + (size_t)u.pn * 256 * ED * 2; }
};

struct EpiProj {
    static constexpr bool PERM = true;
    bf16_t* qkv; bf16_t* za; bf16_t* xbc; bf16_t* zb; float* small;
    DEV void operator()(const f32x4 (&acc)[2][2][4][2], const Unit& u, int wr, int wc, int fr, int fq) const {
        const int row0 = u.pm * BM + wr * 64 + fr, pn = u.pn;
        if (pn == 26) {
            if (wc == 0) {
#pragma unroll
                for (int ai = 0; ai < 2; ++ai)
#pragma unroll
                    for (int m = 0; m < 4; ++m) { float* p = small + (size_t)(row0 + ai * HALF + m * 16) * 32 + 8 * fq; *(f32x4*)p = acc[ai][0][m][0]; *(f32x4*)(p + 4) = acc[ai][0][m][1]; }
            }
            return;
        }
        bf16_t* base; int ldc, ct;
        if (pn < 12) { base = qkv; ldc = 3072; ct = pn; } else if (pn < 16) { base = za; ldc = 1024; ct = pn - 12; } else if (pn < 22) { base = xbc; ldc = 1536; ct = pn - 16; } else { base = zb; ldc = 1024; ct = pn - 22; }
        const int col0 = ct * 256 + wc * 32 + 8 * fq;
#pragma unroll
        for (int ai = 0; ai < 2; ++ai)
#pragma unroll
            for (int m = 0; m < 4; ++m) { bf16_t* rowp = base + (size_t)(row0 + ai * HALF + m * 16) * ldc + col0;
#pragma unroll
                for (int bj = 0; bj < 2; ++bj) *(u32x4*)(rowp + bj * HALF) = pack8(acc[ai][bj][m][0], acc[ai][bj][m][1]); }
    }
};
struct EpiF32 {
    static constexpr bool PERM = false;
    float* Cp; int ldc; int pad_;
    DEV void operator()(const f32x4 (&acc)[2][2][4][2], const Unit& u, int wr, int wc, int fr, int fq) const {
        const int row0 = u.pm * BM + wr * 64 + fr, col0 = u.pn * BM + wc * 32 + 4 * fq;
#pragma unroll
        for (int ai = 0; ai < 2; ++ai)
#pragma unroll
            for (int m = 0; m < 4; ++m) { float* rowp = Cp + (size_t)(row0 + ai * HALF + m * 16) * ldc + col0;
#pragma unroll
                for (int bj = 0; bj < 2; ++bj)
#pragma unroll
                    for (int n = 0; n < 2; ++n) *(f32x4*)(rowp + bj * HALF + n * 16) = acc[ai][bj][m][n]; }
    }
};
struct EpiBf16 {
    static constexpr bool PERM = true;
    bf16_t* O; int ldc; int pad_;
    DEV void operator()(const f32x4 (&acc)[2][2][4][2], const Unit& u, int wr, int wc, int fr, int fq) const {
        const int row0 = u.pm * BM + wr * 64 + fr, col0 = u.pn * BM + wc * 32 + 8 * fq;
#pragma unroll
        for (int ai = 0; ai < 2; ++ai)
#pragma unroll
            for (int m = 0; m < 4; ++m) { bf16_t* rowp = O + (size_t)(row0 + ai * HALF + m * 16) * ldc + col0;
#pragma unroll
                for (int bj = 0; bj < 2; ++bj) *(u32x4*)(rowp + bj * HALF) = pack8(acc[ai][bj][m][0], acc[ai][bj][m][1]); }
    }
};
struct EpiGU {
    static constexpr bool PERM = true;
    bf16_t* H;
    DEV void operator()(const f32x4 (&acc)[2][2][4][2], const Unit& u, int wr, int wc, int fr, int fq) const {
        const int row0 = u.pm * BM + wr * 64 + fr, col0 = u.pn * HALF + wc * 32 + 8 * fq;
#pragma unroll
        for (int ai = 0; ai < 2; ++ai)
#pragma unroll
            for (int m = 0; m < 4; ++m) {
                f32x4 h0, h1;
#pragma unroll
                for (int i = 0; i < 4; ++i) { h0[i] = siluf(acc[ai][0][m][0][i]) * acc[ai][1][m][0][i]; h1[i] = siluf(acc[ai][0][m][1][i]) * acc[ai][1][m][1][i]; }
                *(u32x4*)(H + (size_t)(row0 + ai * HALF + m * 16) * ED + col0) = pack8(h0, h1);
            }
    }
};
struct EpiQKV {
    static constexpr bool PERM = true;
    bf16_t* O; const float* cosT; const float* sinT;
    DEV void operator()(const f32x4 (&acc)[2][2][4][2], const Unit& u, int wr, int wc, int fr, int fq) const {
        const int row0 = u.pm * BM + wr * 64 + fr, col0 = u.pn * BM + wc * 32 + 8 * fq;
        const bool rope = u.pn < 8; const float qs = u.pn < 4 ? 0.125f : 1.f;
#pragma unroll
        for (int ai = 0; ai < 2; ++ai)
#pragma unroll
            for (int m = 0; m < 4; ++m) {
                const int row = row0 + ai * HALF + m * 16;
                bf16_t* rowp = O + (size_t)row * 3072 + col0;
                if (rope) {
                    const f32x4 cs = *(const f32x4*)(cosT + (size_t)row * 32 + 16 * (wc & 1) + 4 * fq), sn = *(const f32x4*)(sinT + (size_t)row * 32 + 16 * (wc & 1) + 4 * fq);
#pragma unroll
                    for (int bj = 0; bj < 2; ++bj) { const f32x4 x1 = acc[ai][bj][m][0], x2 = acc[ai][bj][m][1];
                        *(u32x4*)(rowp + bj * HALF) = pack8((x1 * cs - x2 * sn) * qs, (x2 * cs + x1 * sn) * qs); }
                } else {
#pragma unroll
                    for (int bj = 0; bj < 2; ++bj) *(u32x4*)(rowp + bj * HALF) = pack8(acc[ai][bj][m][0], acc[ai][bj][m][1]);
                }
            }
    }
};
}

template <class SrcF>
DEV void conv_item(const SrcF& src, int ldw, int K, bf16_t* dst, LAS float* scr, int item, int nblk, int lane) {
    const int kb = item / nblk, nb = item - kb * nblk, k0 = 64 * kb, n0 = 32 * nb;
    const float* colp = src(n0 + (lane & 31));
#pragma unroll 8
    for (int i = 0; i < 32; ++i) { const int kk = 2 * i + (lane >> 5); scr[kk * 33 + (lane & 31)] = colp ? colp[(size_t)(k0 + kk) * ldw] : 0.f; }
    LDS_WAIT(); asm volatile("" ::: "memory");
    const int c = lane & 7;
#pragma unroll
    for (int j = 0; j < 4; ++j) { const int n = (lane >> 3) + 8 * j; const LAS float* s = scr + (8 * c) * 33 + n;
        u32x4 o; o.x = pk2(s[0 * 33], s[1 * 33]); o.y = pk2(s[2 * 33], s[3 * 33]); o.z = pk2(s[4 * 33], s[5 * 33]); o.w = pk2(s[6 * 33], s[7 * 33]);
        *(u32x4*)(dst + (size_t)(n0 + n) * K + k0 + 8 * c) = o; }
    LDS_WAIT(); asm volatile("" ::: "memory");
}
struct SrcIdent { const float* W; DEV const float* operator()(int n) const { return W + n; } };
struct SrcWin { const float* W; DEV const float* operator()(int n) const {
    int s; if (n < 4096) s = n; else if (n < 5632) s = C_XBC + (n - 4096); else if (n < 6656) s = C_ZB + (n - 5632); else if (n < 6672) s = C_BETA + (n - 6656); else if (n < 6688) s = C_DT + (n - 6672); else return nullptr;
    return W + s; } };
struct SrcQKV { const float* W; DEV const float* operator()(int n) const {
    if (n >= 2048) return W + n; const int hd = n >> 6, cp = n & 63; return W + hd * 64 + 32 * ((cp >> 2) & 1) + 16 * (cp >> 5) + 4 * ((cp >> 3) & 3) + (cp & 3); } };
struct SrcGU { const float* Wg; long du; DEV const float* operator()(int r) const { const int j = r >> 8, rr = r & 255; return Wg + (rr < 128 ? 0l : du) + 128 * j + (rr & 127); } };

DEV void load_row(const float* p, int lane, float (&v)[16]) {
#pragma unroll
    for (int j = 0; j < 4; ++j) { const f32x4 t = *(const f32x4*)(p + j * 256 + lane * 4); v[4 * j] = t[0]; v[4 * j + 1] = t[1]; v[4 * j + 2] = t[2]; v[4 * j + 3] = t[3]; }
}
DEV void store_row(float* p, int lane, const float (&v)[16]) {
#pragma unroll
    for (int j = 0; j < 4; ++j) *(f32x4*)(p + j * 256 + lane * 4) = (f32x4){v[4 * j], v[4 * j + 1], v[4 * j + 2], v[4 * j + 3]};
}
DEV float row_rstd(const float (&v)[16]) { float ss = 0.f;
#pragma unroll
    for (int i = 0; i < 16; ++i) ss += v[i] * v[i];
    return rsqrtf(wave_sum(ss) * (1.f / D) + EPS); }
DEV void resid_update(float (&xv)[16], const float (&yv)[16], const float* gpost, const float* gt, int lane) {
    const float r = row_rstd(yv);
#pragma unroll
    for (int j = 0; j < 4; ++j) { const f32x4 g = *(const f32x4*)(gpost + j * 256 + lane * 4), t = *(const f32x4*)(gt + j * 256 + lane * 4);
#pragma unroll
        for (int i = 0; i < 4; ++i) xv[4 * j + i] += t[i] * (yv[4 * j + i] * r * g[i]); }
}
DEV void prenorm_pack(const float (&xv)[16], const float* gpre, const float* sc, const float* sh, int lane, u32x2 (&o)[4]) {
    const float r = row_rstd(xv);
#pragma unroll
    for (int j = 0; j < 4; ++j) { const f32x4 g = *(const f32x4*)(gpre + j * 256 + lane * 4), s = *(const f32x4*)(sc + j * 256 + lane * 4), b = *(const f32x4*)(sh + j * 256 + lane * 4);
        float h[4];
#pragma unroll
        for (int i = 0; i < 4; ++i) h[i] = xv[4 * j + i] * r * g[i] * (1.f + s[i]) + b[i];
        o[j] = (u32x2){pk2(h[0], h[1]), pk2(h[2], h[3])}; }
}

struct Ctx { LAS unsigned char* lds; int tid, lane, wave, G, bid; };

DEV void ph_setup(const Args& a, const Ctx& X) {
    unsigned char* ws = a.ws;
    float* mod = (float*)(ws + WS_MOD);
    { LAS float* red = (LAS float*)X.lds;
      const int kc = X.tid >> 6, cl = X.tid & 63;
      for (int task = X.bid; task < 2 * 96; task += X.G) {
          const int l = task / 96, col = (task % 96) * 64 + cl;
          const float* w = a.mod_w + (size_t)l * D * 6 * D + col;
          float p0 = 0.f, p1 = 0.f, p2 = 0.f, p3 = 0.f;
          for (int k = kc * 128; k < kc * 128 + 128; ++k) { const float wv = w[(size_t)k * 6 * D];
              p0 += siluf(a.c[k]) * wv; p1 += siluf(a.c[D + k]) * wv; p2 += siluf(a.c[2 * D + k]) * wv; p3 += siluf(a.c[3 * D + k]) * wv; }
          __syncthreads();
          red[(kc * 4 + 0) * 64 + cl] = p0; red[(kc * 4 + 1) * 64 + cl] = p1; red[(kc * 4 + 2) * 64 + cl] = p2; red[(kc * 4 + 3) * 64 + cl] = p3;
          __syncthreads();
          if (X.tid < 256) { const int b = X.tid >> 6; float s = a.mod_b[l * 6 * D + col];
#pragma unroll
              for (int q = 0; q < 8; ++q) s += red[(q * 4 + b) * 64 + cl];
              mod[(size_t)(l * NB + b) * 6 * D + col] = s; }
      }
      __syncthreads(); }
    { float* cosT = (float*)(ws + WS_COS); float* sinT = (float*)(ws + WS_SIN);
      for (int idx = X.bid * NTHR + X.tid; idx < T * 32; idx += X.G * NTHR) { const int t = idx >> 5, i = idx & 31;
          const float ang = (float)a.pos[t] * powf(10000.f, -(float)i / 32.f); float sn, cs; sincosf(ang, &sn, &cs); cosT[idx] = cs; sinT[idx] = sn; } }
    { LAS float* scr = (LAS float*)(X.lds + X.wave * 8704);
      const int gw = X.bid * NWAVES + X.wave, NGW = X.G * NWAVES;
      constexpr int I_IN = (D / 64) * (NPROJ / 32), I_OUT = (2048 / 64) * (D / 32), I_QKV = (D / 64) * (3072 / 32), I_O = (D / 64) * (D / 32);
      for (int it = gw; it < I_IN + I_OUT + I_QKV + I_O; it += NGW) {
          int r = it;
          if (r < I_IN) { conv_item(SrcWin{a.ssm_w_in}, PROJ, D, (bf16_t*)(ws + WS_WIN), scr, r, NPROJ / 32, X.lane); continue; } r -= I_IN;
          if (r < I_OUT) { conv_item(SrcIdent{a.ssm_w_out}, D, 2048, (bf16_t*)(ws + WS_WOUT), scr, r, D / 32, X.lane); continue; } r -= I_OUT;
          if (r < I_QKV) { conv_item(SrcQKV{a.attn_w_qkv}, 3072, D, (bf16_t*)(ws + WS_WQKV), scr, r, 3072 / 32, X.lane); continue; } r -= I_QKV;
          conv_item(SrcIdent{a.attn_w_o}, D, D, (bf16_t*)(ws + WS_WO), scr, r, D / 32, X.lane);
      } }
}

DEV void ph_prenorm0(const Args& a, const Ctx& X) {
    const float* mod = (const float*)(a.ws + WS_MOD);
    bf16_t* hb = (bf16_t*)(a.ws + WS_H);
    for (int row = X.bid * NWAVES + X.wave; row < T; row += X.G * NWAVES) {
        const int b = row / SEQ; const float* ml = mod + (size_t)b * 6 * D;
        float xv[16]; load_row(a.x + (size_t)row * D, X.lane, xv);
        u32x2 o[4]; prenorm_pack(xv, a.mix_pre_g, ml + D, ml, X.lane, o);
#pragma unroll
        for (int j = 0; j < 4; ++j) *(u32x2*)(hb + (size_t)row * D + j * 256 + X.lane * 4) = o[j];
    }
}

DEV void ph_mix_prep(const Args& a, const Ctx& X) {
    const unsigned char* ws = a.ws;
    const bf16_t* qkvpre = (const bf16_t*)(ws + WS_QKVPRE); const bf16_t* xbcpre = (const bf16_t*)(ws + WS_XBCPRE); const float* small = (const float*)(ws + WS_SMALL);
    bf16_t* qkvn = (bf16_t*)(a.ws + WS_QKVN); float* gb = (float*)(a.ws + WS_GB); bf16_t* xbcc = (bf16_t*)(a.ws + WS_XBCC); float* dtb = (float*)(a.ws + WS_DTB);
    for (int wid = X.bid * NWAVES + X.wave; wid < T * 8; wid += X.G * NWAVES) {
        const int t = wid >> 3, h = wid & 7, s = t % SEQ, lane = X.lane;
        float vals[3][2];
#pragma unroll
        for (int part = 0; part < 3; ++part)
#pragma unroll
            for (int e = 0; e < 2; ++e) { const int c = part * 1024 + h * 128 + lane * 2 + e; float acc = 0.f;
#pragma unroll
                for (int i = 0; i < 4; ++i) { const int ss = s - 3 + i; if (ss >= 0) acc += a.gdn_conv_w[i * 3072 + c] * bf2f(qkvpre[(size_t)(t - 3 + i) * 3072 + c]); }
                vals[part][e] = siluf(acc); }
#pragma unroll
        for (int part = 0; part < 2; ++part) { const float ss = wave_sum(vals[part][0] * vals[part][0] + vals[part][1] * vals[part][1]); const float r = rsqrtf(ss + 1e-6f); vals[part][0] *= r; vals[part][1] *= r; }
#pragma unroll
        for (int part = 0; part < 3; ++part) *(unsigned*)(qkvn + (size_t)t * 3072 + part * 1024 + h * 128 + lane * 2) = pk2(vals[part][0], vals[part][1]);
        if (lane == 0) { const float beta = sigmoidf_(small[(size_t)t * 32 + h]); const float g = -__expf(a.gdn_a_log[h]) * softplusf(small[(size_t)t * 32 + 8 + h] + a.gdn_dt_bias[h]);
            gb[t * 16 + h] = g; gb[t * 16 + 8 + h] = beta; }
    }
}
DEV void ph_mix_seq(const Args& a, const Ctx& X) {
    const bf16_t* qkvn = (const bf16_t*)(a.ws + WS_QKVN); const float* gb = (const float*)(a.ws + WS_GB);
    const bf16_t* xbc = (const bf16_t*)(a.ws + WS_XBCC); const float* dtb = (const float*)(a.ws + WS_DTB);
    float* oraw = (float*)(a.ws + WS_ORAW); float* yraw = (float*)(a.ws + WS_YRAW);
    const int tid = X.tid;
    if (X.bid < 32) {
        LAS float* sk = (LAS float*)X.lds; LAS float* sq = sk + 16 * 128; LAS float* sv = sq + 16 * 128; LAS float* sa = sv + 16 * 128; LAS float* sbeta = sa + 16; LAS float* red = sbeta + 16;
        const int b = X.bid >> 3, h = X.bid & 7, v = tid & 127, kq = tid >> 7;
        float S[32];
#pragma unroll
        for (int i = 0; i < 32; ++i) S[i] = 0.f;
        const float scale = 0.08838834764831845f;
        for (int t0 = 0; t0 < SEQ; t0 += 16) {
            const size_t tb = (size_t)b * SEQ + t0;
            for (int idx = tid; idx < 16 * 384; idx += NTHR) { const int jj = idx / 384, c = idx % 384, part = c >> 7, cc = c & 127;
                const float val = bf2f(qkvn[(tb + jj) * 3072 + part * 1024 + h * 128 + cc]);
                if (part == 0) sq[jj * 128 + cc] = val; else if (part == 1) sk[jj * 128 + cc] = val; else sv[jj * 128 + cc] = val; }
            if (tid < 16) { sa[tid] = __expf(gb[(tb + tid) * 16 + h]); sbeta[tid] = gb[(tb + tid) * 16 + 8 + h]; }
            __syncthreads();
            for (int j = 0; j < 16; ++j) {
                const float al = sa[j], bt = sbeta[j]; float p = 0.f;
#pragma unroll
                for (int i = 0; i < 32; ++i) { S[i] *= al; p += sk[j * 128 + kq * 32 + i] * S[i]; }
                red[kq * 128 + v] = p;
                __syncthreads();
                const float kS = red[v] + red[128 + v] + red[256 + v] + red[384 + v];
                const float delta = bt * (sv[j * 128 + v] - kS); float po = 0.f;
#pragma unroll
                for (int i = 0; i < 32; ++i) { S[i] += sk[j * 128 + kq * 32 + i] * delta; po += sq[j * 128 + kq * 32 + i] * S[i]; }
                red[512 + kq * 128 + v] = po;
                __syncthreads();
                if (kq == 0) oraw[(tb + j) * 1024 + h * 128 + v] = (red[512 + v] + red[512 + 128 + v] + red[512 + 256 + v] + red[512 + 384 + v]) * scale;
            }
            __syncthreads();
        }
    }
}
DEV void ph_mix_post(const Args& a, const Ctx& X) {
    const float* oraw = (const float*)(a.ws + WS_ORAW); const float* yraw = (const float*)(a.ws + WS_YRAW);
    const bf16_t* za = (const bf16_t*)(a.ws + WS_ZA); const bf16_t* zb = (const bf16_t*)(a.ws + WS_ZB); bf16_t* oy = (bf16_t*)(a.ws + WS_OY);
    const int lane = X.lane;
    for (int wid = X.bid * NWAVES + X.wave; wid < T * 8; wid += X.G * NWAVES) {
        const int t = wid >> 3, h = wid & 7, c = h * 128 + lane * 2;
        const f32x2 o = *(const f32x2*)(oraw + (size_t)t * 1024 + c);
        const float r = rsqrtf(wave_sum(o.x * o.x + o.y * o.y) * (1.f / 128.f) + EPS);
        const float z0 = bf2f(za[(size_t)t * 1024 + c]), z1 = bf2f(za[(size_t)t * 1024 + c + 1]);
        *(unsigned*)(oy + (size_t)t * 2048 + c) = pk2(o.x * r * a.gdn_norm_w[lane * 2] * siluf(z0), o.y * r * a.gdn_norm_w[lane * 2 + 1] * siluf(z1));
    }
}

DEV bf16x8 acc_to_frag(const f32x4 lo, const f32x4 hi) { u32x4 w; w.x = pg8::cvt_pk_bf16(lo[0], lo[1]); w.y = pg8::cvt_pk_bf16(lo[2], lo[3]); w.z = pg8::cvt_pk_bf16(hi[0], hi[1]); w.w = pg8::cvt_pk_bf16(hi[2], hi[3]); return __builtin_bit_cast(bf16x8, w); }

DEV void gdn_solve(LAS float* M, LAS unsigned short* tf, const int lane) {
    M[lane] = (lane == 0) ? 1.f : 0.f;
    for (int i = 1; i < 64; ++i) {
        float acc = (lane == i) ? 1.f : 0.f;
        for (int j = 0; j < i; j += 4) { const f32x4 a4 = *(const LAS f32x4*)(M + i * 64 + j);
            acc -= a4[0] * M[j * 64 + lane]; acc -= a4[1] * M[(j + 1) * 64 + lane]; acc -= a4[2] * M[(j + 2) * 64 + lane]; acc -= a4[3] * M[(j + 3) * 64 + lane]; }
        M[i * 64 + lane] = acc;
    }
    const int cq = (lane >> 2) & 3, ca = (lane >> 4) & 1, ce = lane & 3, cks = lane >> 5;
    for (int i = 0; i < 64; ++i) tf[((i >> 4) * 2 + cks) * 512 + ((i & 15) + 16 * cq) * 8 + 4 * ca + ce] = (unsigned short)f2bf(M[i * 64 + lane]);
}
DEV void ph_gdn_local(const Args& a, const Ctx& X) {
    const bf16_t* qkvpre = (const bf16_t*)(a.ws + WS_QKVPRE); const float* small = (const float*)(a.ws + WS_SMALL);
    unsigned char* gi = a.ws + WS_GI; float* glast = (float*)(a.ws + WS_GLAST);
    constexpr int KP = 272;
    LAS unsigned char* kN = X.lds; LAS unsigned char* qN = X.lds + 64 * KP; LAS unsigned char* slots = X.lds + 128 * KP;
    LAS float* gcL = (LAS float*)(X.lds + AUX_OFF); LAS float* btL = gcL + 8 * 64;
    const int lane = X.lane, wave = X.wave, r16 = lane & 15, q4 = lane >> 4;
    const float scale = 0.08838834764831845f;
    for (int wu = X.bid; wu < NB * 64; wu += X.G) {
        const int b = wu >> 6, n = wu & 63; const size_t t0 = (size_t)b * SEQ + 64 * n;
        unsigned char* tmp = a.ws + WS_GTMP + (size_t)X.bid * 131072;
        __syncthreads();
        {
            const float g = -__expf(a.gdn_a_log[wave]) * softplusf(small[(t0 + lane) * 32 + 8 + wave] + a.gdn_dt_bias[wave]);
            float gc = g;
#pragma unroll
            for (int o = 1; o < 64; o <<= 1) { const float v = __shfl_up(gc, o); if (lane >= o) gc += v; }
            gcL[wave * 64 + lane] = gc; btL[wave * 64 + lane] = sigmoidf_(small[(t0 + lane) * 32 + wave]);
            if (lane == 63) glast[(size_t)((b * 8 + wave) * 64 + n) * 32] = gc;
        }
        __syncthreads();
        for (int bb = 0; bb < 2; ++bb) {
            for (int j = 0; j < 4; ++j) {
                const int h = bb * 4 + j; unsigned char* ub = gi + (size_t)((b * 8 + h) * 64 + n) * GI_UNIT;
                {
                    const float gl = gcL[h * 64 + 63];
                    const int blk = wave >> 2, pa = (wave & 3) >> 1, pq0 = 2 * (wave & 1);
                    const int ca = (2 * lane >> 4) & 1, cq = (2 * lane >> 2) & 3, ce = (2 * lane) & 3, cks = (2 * lane) >> 5;
#pragma unroll
                    for (int part = 0; part < 3; ++part) {
                        const int col = part * 1024 + h * 128 + 2 * lane;
                        float w0[4], w1[4];
#pragma unroll
                        for (int i = 0; i < 4; ++i) { const f32x2 t = *(const f32x2*)(a.gdn_conv_w + i * 3072 + col); w0[i] = t.x; w1[i] = t.y; }
                        float x0[11], x1[11];
#pragma unroll
                        for (int i = 0; i < 11; ++i) { const int tk = 8 * wave + i - 3; unsigned v = 0u; if (64 * n + tk >= 0) v = *(const unsigned*)(qkvpre + (t0 + tk) * 3072 + col); x0[i] = __uint_as_float(v << 16); x1[i] = __uint_as_float(v & 0xFFFF0000u); }
                        float v0[8], v1[8];
#pragma unroll
                        for (int i = 0; i < 8; ++i) { v0[i] = siluf(w0[0] * x0[i] + w0[1] * x0[i + 1] + w0[2] * x0[i + 2] + w0[3] * x0[i + 3]); v1[i] = siluf(w1[0] * x1[i] + w1[1] * x1[i + 1] + w1[2] * x1[i + 2] + w1[3] * x1[i + 3]); }
                        if (part < 2) {
#pragma unroll
                            for (int i = 0; i < 8; ++i) { const float r = rsqrtf(wave_sum(v0[i] * v0[i] + v1[i] * v1[i]) + 1e-6f); v0[i] *= r; v1[i] *= r; }
                        }
                        if (part == 0) {
#pragma unroll
                            for (int i = 0; i < 8; ++i) { const int tok = 8 * wave + i; const float eg = __expf(gcL[h * 64 + tok]) * scale;
                                *(LAS unsigned*)(qN + tok * KP + lane * 4) = pk2(v0[i], v1[i]);
                                *(unsigned*)(ub + 16384 + ((tok >> 4) * 4 + cks) * 1024 + ((tok & 15) + 16 * cq) * 16 + (4 * ca + ce) * 2) = pk2(v0[i] * eg, v1[i] * eg); }
                        } else if (part == 1) {
                            unsigned short kg0[8], kg1[8], ke0[8], ke1[8];
#pragma unroll
                            for (int i = 0; i < 8; ++i) { const int tok = 8 * wave + i; const float gc = gcL[h * 64 + tok], bt = btL[h * 64 + tok], eg = __expf(gc) * bt, eend = __expf(gl - gc);
                                *(LAS unsigned*)(kN + tok * KP + lane * 4) = pk2(v0[i], v1[i]);
                                kg0[i] = (unsigned short)f2bf(v0[i] * eg); kg1[i] = (unsigned short)f2bf(v1[i] * eg); ke0[i] = (unsigned short)f2bf(v0[i] * eend); ke1[i] = (unsigned short)f2bf(v1[i] * eend); }
#pragma unroll
                            for (int hf = 0; hf < 2; ++hf) { const int pos = 32 * blk + 8 * (pq0 + hf) + 4 * pa; const int cl = 2 * lane;
                                *(u32x2*)(tmp + (size_t)j * 32768 + 16384 + cl * 128 + pos * 2) = (u32x2){(unsigned)kg0[4 * hf] | ((unsigned)kg0[4 * hf + 1] << 16), (unsigned)kg0[4 * hf + 2] | ((unsigned)kg0[4 * hf + 3] << 16)};
                                *(u32x2*)(tmp + (size_t)j * 32768 + 16384 + (cl + 1) * 128 + pos * 2) = (u32x2){(unsigned)kg1[4 * hf] | ((unsigned)kg1[4 * hf + 1] << 16), (unsigned)kg1[4 * hf + 2] | ((unsigned)kg1[4 * hf + 3] << 16)};
                                *(u32x2*)(ub + 32768 + ((cl >> 4) * 2 + blk) * 1024 + ((cl & 15) + 16 * (pq0 + hf)) * 16 + (4 * pa) * 2) = (u32x2){(unsigned)ke0[4 * hf] | ((unsigned)ke0[4 * hf + 1] << 16), (unsigned)ke0[4 * hf + 2] | ((unsigned)ke0[4 * hf + 3] << 16)};
                                *(u32x2*)(ub + 32768 + (((cl + 1) >> 4) * 2 + blk) * 1024 + (((cl + 1) & 15) + 16 * (pq0 + hf)) * 16 + (4 * pa) * 2) = (u32x2){(unsigned)ke1[4 * hf] | ((unsigned)ke1[4 * hf + 1] << 16), (unsigned)ke1[4 * hf + 2] | ((unsigned)ke1[4 * hf + 3] << 16)}; }
                        } else {
                            unsigned short vb0[8], vb1[8];
#pragma unroll
                            for (int i = 0; i < 8; ++i) { const float bt = btL[h * 64 + 8 * wave + i]; vb0[i] = (unsigned short)f2bf(v0[i] * bt); vb1[i] = (unsigned short)f2bf(v1[i] * bt); }
#pragma unroll
                            for (int hf = 0; hf < 2; ++hf) { const int pos = 32 * blk + 8 * (pq0 + hf) + 4 * pa; const int cl = 2 * lane;
                                *(u32x2*)(tmp + (size_t)j * 32768 + cl * 128 + pos * 2) = (u32x2){(unsigned)vb0[4 * hf] | ((unsigned)vb0[4 * hf + 1] << 16), (unsigned)vb0[4 * hf + 2] | ((unsigned)vb0[4 * hf + 3] << 16)};
                                *(u32x2*)(tmp + (size_t)j * 32768 + (cl + 1) * 128 + pos * 2) = (u32x2){(unsigned)vb1[4 * hf] | ((unsigned)vb1[4 * hf + 1] << 16), (unsigned)vb1[4 * hf + 2] | ((unsigned)vb1[4 * hf + 3] << 16)}; }
                        }
                    }
                }
                __syncthreads();
                {
                    const int mat = wave >> 2, rt = wave & 3; LAS unsigned char* An = mat ? qN : kN;
                    bf16x8 af[4];
#pragma unroll
                    for (int ks = 0; ks < 4; ++ks) af[ks] = *(const LAS bf16x8*)(An + (16 * rt + r16) * KP + (32 * ks + 8 * q4) * 2);
                    LAS float* slot = (LAS float*)(slots + j * 16384);
#pragma unroll
                    for (int ct = 0; ct < 4; ++ct) { f32x4 acc = {0.f, 0.f, 0.f, 0.f};
#pragma unroll
                        for (int ks = 0; ks < 4; ++ks) { const bf16x8 bf = *(const LAS bf16x8*)(kN + (16 * ct + r16) * KP + (32 * ks + 8 * q4) * 2); acc = __builtin_amdgcn_mfma_f32_16x16x32_bf16(af[ks], bf, acc, 0, 0, 0); }
                        const int jc = 16 * ct + r16; const float gj = gcL[h * 64 + jc];
#pragma unroll
                        for (int rg = 0; rg < 4; ++rg) { const int i = 16 * rt + 4 * q4 + rg; const float dec = __expf(gcL[h * 64 + i] - gj);
                            if (mat == 0) { slot[i * 64 + jc] = jc < i ? btL[h * 64 + i] * acc[rg] * dec : 0.f; }
                            else { const float v = jc <= i ? acc[rg] * scale * dec : 0.f;
                                *(unsigned short*)(ub + 49152 + (rt * 2 + (ct >> 1)) * 1024 + ((4 * q4 + rg) + 16 * (r16 >> 2)) * 16 + (4 * (ct & 1) + (r16 & 3)) * 2) = (unsigned short)f2bf(v); } }
                    }
                }
                __syncthreads();
            }
            if (wave < 4) gdn_solve((LAS float*)(slots + wave * 16384), (LAS unsigned short*)(X.lds + wave * 8192), lane);
            VM_WAIT(); __syncthreads();
            for (int j = 0; j < 4; ++j) {
                const int h = bb * 4 + j; unsigned char* ub = gi + (size_t)((b * 8 + h) * 64 + n) * GI_UNIT;
                const int mat = wave >> 2; LAS unsigned char* slot = X.lds + j * 8192;
#pragma unroll
                for (int cx = 0; cx < 2; ++cx) { const int ct = 2 * (wave & 3) + cx;
                    bf16x8 bfr[2];
#pragma unroll
                    for (int ks = 0; ks < 2; ++ks) { const u32x4 t = __builtin_nontemporal_load((const u32x4*)(tmp + (size_t)j * 32768 + mat * 16384 + (16 * ct + r16) * 128 + (32 * ks + 8 * q4) * 2)); bfr[ks] = __builtin_bit_cast(bf16x8, t); }
#pragma unroll
                    for (int rt = 0; rt < 4; ++rt) { f32x4 acc = {0.f, 0.f, 0.f, 0.f};
#pragma unroll
                        for (int ks = 0; ks < 2; ++ks) { const bf16x8 tf = *(const LAS bf16x8*)(slot + (rt * 2 + ks) * 1024 + lane * 16); acc = __builtin_amdgcn_mfma_f32_16x16x32_bf16(tf, bfr[ks], acc, 0, 0, 0); }
                        if (mat == 0) *(u32x2*)(ub + 57344 + (rt * 8 + ct) * 512 + lane * 8) = (u32x2){pg8::cvt_pk_bf16(acc[0], acc[1]), pg8::cvt_pk_bf16(acc[2], acc[3])};
                        else {
#pragma unroll
                            for (int rg = 0; rg < 4; ++rg) *(unsigned short*)(ub + (rt * 4 + (ct >> 1)) * 1024 + ((4 * q4 + rg) + 16 * (r16 >> 2)) * 16 + (4 * (ct & 1) + (r16 & 3)) * 2) = (unsigned short)f2bf(-acc[rg]);
                        }
                    }
                }
            }
            __syncthreads();
        }
    }
}
DEV void ph_gdn_scan(const Args& a, const Ctx& X) {
    const unsigned char* gi = a.ws + WS_GI; const float* glast = (const float*)(a.ws + WS_GLAST);
    const bf16_t* za = (const bf16_t*)(a.ws + WS_ZA); bf16_t* oy = (bf16_t*)(a.ws + WS_OY);
    const int lane = X.lane, wave = X.wave, r16 = lane & 15, q4 = lane >> 4, tid = X.tid;
    LAS float* red = (LAS float*)(X.lds + AUX_OFF);
    const int bh = X.bid, b = bh >> 3, h = bh & 7;
    const unsigned char* ubase = gi + (size_t)bh * 64 * GI_UNIT;
    f32x4 S[8];
#pragma unroll
    for (int i = 0; i < 8; ++i) S[i] = (f32x4){0.f, 0.f, 0.f, 0.f};
    const float nw = a.gdn_norm_w[16 * wave + r16];
#define GDN_STAGE(nn, buf) do { _Pragma("unroll") for (int _i = 0; _i < 7; ++_i) \
        __builtin_amdgcn_global_load_lds((const unsigned*)(ubase + (size_t)(nn) * GI_UNIT + (size_t)(tid + 512 * _i) * 16), (LAS unsigned*)(X.lds + (buf) * 57344 + (wave * 64 + 512 * _i) * 16), 16, 0, 0); } while (0)
    u32x2 udn[4]; float gln;
#pragma unroll
    for (int ct = 0; ct < 4; ++ct) udn[ct] = *(const u32x2*)(ubase + 57344 + (ct * 8 + wave) * 512 + lane * 8);
    gln = glast[(size_t)(bh * 64) * 32];
    GDN_STAGE(0, 0);
    for (int n = 0; n < 64; ++n) {
        VM_WAIT(); __syncthreads();
        f32x4 uf[4];
#pragma unroll
        for (int ct = 0; ct < 4; ++ct) { uf[ct][0] = __uint_as_float(udn[ct].x << 16); uf[ct][1] = __uint_as_float(udn[ct].x & 0xFFFF0000u); uf[ct][2] = __uint_as_float(udn[ct].y << 16); uf[ct][3] = __uint_as_float(udn[ct].y & 0xFFFF0000u); }
        const float egl = __expf(gln);
        asm volatile("" : "+v"(uf[0]), "+v"(uf[1]), "+v"(uf[2]), "+v"(uf[3]));
        if (n + 1 < 64) {
            const unsigned char* un = ubase + (size_t)(n + 1) * GI_UNIT;
#pragma unroll
            for (int ct = 0; ct < 4; ++ct) udn[ct] = *(const u32x2*)(un + 57344 + (ct * 8 + wave) * 512 + lane * 8);
            gln = glast[(size_t)(bh * 64 + n + 1) * 32];
            GDN_STAGE(n + 1, (n + 1) & 1);
        }
        const LAS unsigned char* L = X.lds + (n & 1) * 57344;
        bf16x8 sB[4];
#pragma unroll
        for (int ks = 0; ks < 4; ++ks) sB[ks] = acc_to_frag(S[2 * ks], S[2 * ks + 1]);
        f32x4 vn[4], oo[4];
#pragma unroll
        for (int ct = 0; ct < 4; ++ct) { f32x4 acc = {0.f, 0.f, 0.f, 0.f}, ao = {0.f, 0.f, 0.f, 0.f};
#pragma unroll
            for (int ks = 0; ks < 4; ++ks) { const bf16x8 wf = *(const LAS bf16x8*)(L + (ct * 4 + ks) * 1024 + lane * 16), qf = *(const LAS bf16x8*)(L + 16384 + (ct * 4 + ks) * 1024 + lane * 16);
                acc = __builtin_amdgcn_mfma_f32_16x16x32_bf16(wf, sB[ks], acc, 0, 0, 0); ao = __builtin_amdgcn_mfma_f32_16x16x32_bf16(qf, sB[ks], ao, 0, 0, 0); }
            vn[ct] = acc; oo[ct] = ao; }
#pragma unroll
        for (int ct = 0; ct < 4; ++ct) vn[ct] = vn[ct] + uf[ct];
        bf16x8 vB[2];
#pragma unroll
        for (int ks = 0; ks < 2; ++ks) vB[ks] = acc_to_frag(vn[2 * ks], vn[2 * ks + 1]);
#pragma unroll
        for (int ct = 0; ct < 4; ++ct)
#pragma unroll
            for (int ks = 0; ks < 2; ++ks) { const bf16x8 kf = *(const LAS bf16x8*)(L + 49152 + (ct * 2 + ks) * 1024 + lane * 16); oo[ct] = __builtin_amdgcn_mfma_f32_16x16x32_bf16(kf, vB[ks], oo[ct], 0, 0, 0); }
#pragma unroll
        for (int dt = 0; dt < 8; ++dt) { f32x4 acc = S[dt] * egl;
#pragma unroll
            for (int ks = 0; ks < 2; ++ks) { const bf16x8 ef = *(const LAS bf16x8*)(L + 32768 + (dt * 2 + ks) * 1024 + lane * 16); acc = __builtin_amdgcn_mfma_f32_16x16x32_bf16(ef, vB[ks], acc, 0, 0, 0); }
            S[dt] = acc; }
        LAS float* rp = red + (n & 1) * 512;
#pragma unroll
        for (int ct = 0; ct < 4; ++ct)
#pragma unroll
            for (int rg = 0; rg < 4; ++rg) { float s = oo[ct][rg] * oo[ct][rg]; s += __shfl_xor(s, 1); s += __shfl_xor(s, 2); s += __shfl_xor(s, 4); s += __shfl_xor(s, 8);
                if (r16 == 0) rp[wave * 64 + 16 * ct + 4 * q4 + rg] = s; }
        __syncthreads();
#pragma unroll
        for (int ct = 0; ct < 4; ++ct)
#pragma unroll
            for (int rg = 0; rg < 4; ++rg) { const int c = 16 * ct + 4 * q4 + rg; float s = 0.f;
#pragma unroll
                for (int w = 0; w < 8; ++w) s += rp[w * 64 + c];
                const size_t t = (size_t)b * SEQ + 64 * n + c; const float z = bf2f(za[t * 1024 + h * 128 + 16 * wave + r16]);
                oy[t * 2048 + h * 128 + 16 * wave + r16] = (bf16_t)f2bf(oo[ct][rg] * rsqrtf(s * (1.f / 128.f) + EPS) * nw * siluf(z)); }
    }
#undef GDN_STAGE
}

constexpr int SP = 272;
DEV void ph_ssd_local(const Args& a, const Ctx& X) {
    const bf16_t* xbcpre = (const bf16_t*)(a.ws + WS_XBCPRE); const float* small = (const float*)(a.ws + WS_SMALL);
    bf16_t* CC = (bf16_t*)(a.ws + WS_CC); float* acum = (float*)(a.ws + WS_ACUM); float* cdec = (float*)(a.ws + WS_CDEC);
    bf16_t* ydiag = (bf16_t*)(a.ws + WS_YDIAG); bf16_t* states = (bf16_t*)(a.ws + WS_STATES);
    LAS unsigned char* Bn = X.lds; LAS unsigned char* Cn = X.lds + 128 * SP; LAS unsigned char* BT = X.lds + 256 * SP;
    LAS unsigned char* xdT = X.lds; LAS unsigned char* xeT = X.lds + 64 * SP;
    LAS float* acL = (LAS float*)(X.lds + AUX_OFF); LAS float* dtL = acL + 8 * 128;
    const int lane = X.lane, wave = X.wave, r16 = lane & 15, q4 = lane >> 4;
    for (int unit = X.bid; unit < NB * 32 * 2; unit += X.G) {
        const int g = unit & 1, c = (unit >> 1) & 31, b = unit >> 6; const size_t t0 = (size_t)b * SEQ + 128 * c;
        __syncthreads();
        {
            const int hd = g * 8 + wave; const float an = -__expf(a.ssd_a_log[hd]), bias = a.ssd_dt_bias[hd];
            const float d0 = softplusf(small[(t0 + lane) * 32 + 16 + hd] + bias), d1 = softplusf(small[(t0 + 64 + lane) * 32 + 16 + hd] + bias);
            float s0 = d0 * an, s1 = d1 * an;
#pragma unroll
            for (int o = 1; o < 64; o <<= 1) { const float v0 = __shfl_up(s0, o), v1 = __shfl_up(s1, o); if (lane >= o) { s0 += v0; s1 += v1; } }
            s1 += __shfl(s0, 63);
            acL[wave * 128 + lane] = s0; acL[wave * 128 + 64 + lane] = s1; dtL[wave * 128 + lane] = d0; dtL[wave * 128 + 64 + lane] = d1;
            acum[((size_t)g * T + t0 + lane) * 8 + wave] = s0; acum[((size_t)g * T + t0 + 64 + lane) * 8 + wave] = s1;
            if (lane == 63) cdec[(size_t)unit * 32 + wave] = __expf(s1);
        }
        {
            const int isC = lane >> 5, cc = (lane & 31) * 4, col = 1024 + isC * 256 + g * 128 + cc;
            float w[4][4], bs[4];
#pragma unroll
            for (int i = 0; i < 4; ++i) { const f32x4 t = *(const f32x4*)(a.ssd_conv_w + i * 1536 + col); w[i][0] = t[0]; w[i][1] = t[1]; w[i][2] = t[2]; w[i][3] = t[3]; }
            { const f32x4 t = *(const f32x4*)(a.ssd_conv_b + col); bs[0] = t[0]; bs[1] = t[1]; bs[2] = t[2]; bs[3] = t[3]; }
            float xin[19][4];
#pragma unroll
            for (int i = 0; i < 19; ++i) { const int tk = 16 * wave + i - 3; const bool ok = (128 * c + tk) >= 0; u32x2 v = {0u, 0u}; if (ok) v = *(const u32x2*)(xbcpre + (t0 + tk) * 1536 + col);
                xin[i][0] = __uint_as_float(v.x << 16); xin[i][1] = __uint_as_float(v.x & 0xFFFF0000u); xin[i][2] = __uint_as_float(v.y << 16); xin[i][3] = __uint_as_float(v.y & 0xFFFF0000u); }
            unsigned short ov[16][4];
#pragma unroll
            for (int i = 0; i < 16; ++i)
#pragma unroll
                for (int e = 0; e < 4; ++e) { const float s = bs[e] + w[0][e] * xin[i][e] + w[1][e] * xin[i + 1][e] + w[2][e] * xin[i + 2][e] + w[3][e] * xin[i + 3][e]; ov[i][e] = (unsigned short)f2bf(siluf(s)); }
            LAS unsigned char* nat = isC ? Cn : Bn;
#pragma unroll
            for (int i = 0; i < 16; ++i) { const u32x2 pk = {(unsigned)ov[i][0] | ((unsigned)ov[i][1] << 16), (unsigned)ov[i][2] | ((unsigned)ov[i][3] << 16)};
                *(LAS u32x2*)(nat + (16 * wave + i) * SP + cc * 2) = pk;
                if (isC) *(u32x2*)(CC + (t0 + 16 * wave + i) * 256 + g * 128 + cc) = pk; }
            if (!isC) {
#pragma unroll
                for (int e = 0; e < 4; ++e)
#pragma unroll
                    for (int qq = 0; qq < 4; ++qq) { const u32x2 pk = {(unsigned)ov[4 * qq][e] | ((unsigned)ov[4 * qq + 1][e] << 16), (unsigned)ov[4 * qq + 2][e] | ((unsigned)ov[4 * qq + 3][e] << 16)};
                        *(LAS u32x2*)(BT + (cc + e) * SP + (32 * (wave >> 1) + 8 * qq + 4 * (wave & 1)) * 2) = pk; }
            }
        }
        __syncthreads();
        f32x4 cbt[8];
        {
            bf16x8 cf[4];
#pragma unroll
            for (int ks = 0; ks < 4; ++ks) cf[ks] = *(const LAS bf16x8*)(Cn + (16 * wave + r16) * SP + (32 * ks + 8 * q4) * 2);
#pragma unroll
            for (int st = 0; st < 8; ++st) { cbt[st] = (f32x4){0.f, 0.f, 0.f, 0.f};
#pragma unroll
                for (int ks = 0; ks < 4; ++ks) { const bf16x8 bf = *(const LAS bf16x8*)(Bn + (16 * st + r16) * SP + (32 * ks + 8 * q4) * 2); cbt[st] = __builtin_amdgcn_mfma_f32_16x16x32_bf16(bf, cf[ks], cbt[st], 0, 0, 0); } }
        }
        __syncthreads();
        const int lq = 16 * wave + r16;
        for (int r = 0; r < 8; ++r) {
            const int hd = g * 8 + r; const float dd = a.ssd_d[hd];
            {
                const int col = hd * 64 + lane; float w0 = a.ssd_conv_w[col], w1 = a.ssd_conv_w[1536 + col], w2 = a.ssd_conv_w[2 * 1536 + col], w3 = a.ssd_conv_w[3 * 1536 + col]; const float bs = a.ssd_conv_b[col];
                float xin[19];
#pragma unroll
                for (int i = 0; i < 19; ++i) { const int tk = 16 * wave + i - 3; xin[i] = (128 * c + tk) >= 0 ? bf2f(xbcpre[(t0 + tk) * 1536 + col]) : 0.f; }
                const float aclast = acL[r * 128 + 127];
                unsigned short xd[16], xe[16];
#pragma unroll
                for (int i = 0; i < 16; ++i) { const float xv = siluf(bs + w0 * xin[i] + w1 * xin[i + 1] + w2 * xin[i + 2] + w3 * xin[i + 3]); const int tk = 16 * wave + i;
                    const float xdv = xv * dtL[r * 128 + tk]; xd[i] = (unsigned short)f2bf(xdv); xe[i] = (unsigned short)f2bf(xdv * __expf(aclast - acL[r * 128 + tk])); }
#pragma unroll
                for (int qq = 0; qq < 4; ++qq) { const int pos = 32 * (wave >> 1) + 8 * qq + 4 * (wave & 1);
                    *(LAS u32x2*)(xdT + lane * SP + pos * 2) = (u32x2){(unsigned)xd[4 * qq] | ((unsigned)xd[4 * qq + 1] << 16), (unsigned)xd[4 * qq + 2] | ((unsigned)xd[4 * qq + 3] << 16)};
                    *(LAS u32x2*)(xeT + lane * SP + pos * 2) = (u32x2){(unsigned)xe[4 * qq] | ((unsigned)xe[4 * qq + 1] << 16), (unsigned)xe[4 * qq + 2] | ((unsigned)xe[4 * qq + 3] << 16)}; }
            }
            __syncthreads();
            {
                const float acl = acL[r * 128 + lq], ddt = dd / dtL[r * 128 + lq];
                f32x4 yd[4];
#pragma unroll
                for (int pt = 0; pt < 4; ++pt) yd[pt] = (f32x4){0.f, 0.f, 0.f, 0.f};
#pragma unroll
                for (int ks = 0; ks < 4; ++ks) { if (ks <= (wave >> 1)) {
                    f32x4 mlo, mhi;
#pragma unroll
                    for (int e = 0; e < 4; ++e) {
                        const int s0 = 32 * ks + 4 * q4 + e, s1 = s0 + 16;
                        const float v0 = cbt[2 * ks][e], v1 = cbt[2 * ks + 1][e];
                        mlo[e] = s0 < lq ? v0 * __expf(acl - acL[r * 128 + s0]) : (s0 == lq ? v0 + ddt : 0.f);
                        mhi[e] = s1 < lq ? v1 * __expf(acl - acL[r * 128 + s1]) : (s1 == lq ? v1 + ddt : 0.f);
                    }
                    const bf16x8 mf = acc_to_frag(mlo, mhi);
#pragma unroll
                    for (int pt = 0; pt < 4; ++pt) { const bf16x8 xf = *(const LAS bf16x8*)(xdT + (16 * pt + r16) * SP + (32 * ks + 8 * q4) * 2); yd[pt] = __builtin_amdgcn_mfma_f32_16x16x32_bf16(xf, mf, yd[pt], 0, 0, 0); }
                } }
#pragma unroll
                for (int pt = 0; pt < 4; ++pt) *(u32x2*)(ydiag + (t0 + lq) * 1024 + hd * 64 + 16 * pt + 4 * q4) = (u32x2){pg8::cvt_pk_bf16(yd[pt][0], yd[pt][1]), pg8::cvt_pk_bf16(yd[pt][2], yd[pt][3])};
            }
            {
                bf16x8 bf[4];
#pragma unroll
                for (int ks = 0; ks < 4; ++ks) bf[ks] = *(const LAS bf16x8*)(BT + (16 * wave + r16) * SP + (32 * ks + 8 * q4) * 2);
                bf16_t* hp = states + ((size_t)(unit * 8 + r) * 64) * 128;
#pragma unroll
                for (int pt = 0; pt < 4; ++pt) { f32x4 st = {0.f, 0.f, 0.f, 0.f};
#pragma unroll
                    for (int ks = 0; ks < 4; ++ks) { const bf16x8 xf = *(const LAS bf16x8*)(xeT + (16 * pt + r16) * SP + (32 * ks + 8 * q4) * 2); st = __builtin_amdgcn_mfma_f32_16x16x32_bf16(bf[ks], xf, st, 0, 0, 0); }
                    *(u32x2*)(hp + (size_t)(16 * pt + r16) * 128 + 16 * wave + 4 * q4) = (u32x2){pg8::cvt_pk_bf16(st[0], st[1]), pg8::cvt_pk_bf16(st[2], st[3])}; }
            }
            __syncthreads();
        }
    }
}
DEV void ph_ssd_scan(const Args& a, const Ctx& X, const int wg0) {
    bf16_t* states = (bf16_t*)(a.ws + WS_STATES); const float* cdec = (const float*)(a.ws + WS_CDEC);
    for (int task = (X.bid - wg0) * NTHR + X.tid; task < NB * 16 * 64 * 32; task += (X.G - wg0) * NTHR) {
        const int n4 = task & 31, p = (task >> 5) & 63, hd = (task >> 11) & 15, b = task >> 15;
        float h0 = 0.f, h1 = 0.f, h2 = 0.f, h3 = 0.f;
        for (int c = 0; c < 32; ++c) {
            const int unit = (b * 32 + c) * 2 + (hd >> 3);
            u32x2* ptr = (u32x2*)(states + ((size_t)(unit * 8 + (hd & 7)) * 64 + p) * 128 + 4 * n4);
            const u32x2 sv = *ptr; const float dec = cdec[(size_t)unit * 32 + (hd & 7)];
            *ptr = (u32x2){pk2(h0, h1), pk2(h2, h3)};
            h0 = h0 * dec + __uint_as_float(sv.x << 16); h1 = h1 * dec + __uint_as_float(sv.x & 0xFFFF0000u); h2 = h2 * dec + __uint_as_float(sv.y << 16); h3 = h3 * dec + __uint_as_float(sv.y & 0xFFFF0000u);
        }
    }
}
DEV void ph_ssd_out(const Args& a, const Ctx& X) {
    const bf16_t* CC = (const bf16_t*)(a.ws + WS_CC); const float* acum = (const float*)(a.ws + WS_ACUM); const bf16_t* ydiag = (const bf16_t*)(a.ws + WS_YDIAG);
    const bf16_t* states = (const bf16_t*)(a.ws + WS_STATES); const bf16_t* zb = (const bf16_t*)(a.ws + WS_ZB); bf16_t* oy = (bf16_t*)(a.ws + WS_OY);
    const int lane = X.lane, wave = X.wave, r16 = lane & 15, q4 = lane >> 4;
    for (int unit = X.bid; unit < NB * 32 * 2; unit += X.G) {
        const int g = unit & 1, c = (unit >> 1) & 31, b = unit >> 6; const size_t t = (size_t)b * SEQ + 128 * c + 16 * wave + r16;
        bf16x8 cf[4];
#pragma unroll
        for (int ks = 0; ks < 4; ++ks) cf[ks] = *(const bf16x8*)(CC + t * 256 + g * 128 + 32 * ks + 8 * q4);
        float ss = 0.f;
        LAS u32x2* stash = (LAS u32x2*)(X.lds + wave * 16384);
        for (int r = 0; r < 8; ++r) {
            const int hd = g * 8 + r; const float eac = __expf(acum[((size_t)g * T + t) * 8 + r]);
            const bf16_t* hp = states + ((size_t)(unit * 8 + r) * 64) * 128;
#pragma unroll
            for (int pt = 0; pt < 4; ++pt) { f32x4 acc = {0.f, 0.f, 0.f, 0.f};
#pragma unroll
                for (int ks = 0; ks < 4; ++ks) { const bf16x8 hf = *(const bf16x8*)(hp + (size_t)(16 * pt + r16) * 128 + 32 * ks + 8 * q4); acc = __builtin_amdgcn_mfma_f32_16x16x32_bf16(hf, cf[ks], acc, 0, 0, 0); }
                const u32x2 yd = *(const u32x2*)(ydiag + t * 1024 + hd * 64 + 16 * pt + 4 * q4), zz = *(const u32x2*)(zb + t * 1024 + hd * 64 + 16 * pt + 4 * q4);
                f32x4 v; v[0] = acc[0] * eac + __uint_as_float(yd.x << 16); v[1] = acc[1] * eac + __uint_as_float(yd.x & 0xFFFF0000u); v[2] = acc[2] * eac + __uint_as_float(yd.y << 16); v[3] = acc[3] * eac + __uint_as_float(yd.y & 0xFFFF0000u);
                v[0] *= siluf(__uint_as_float(zz.x << 16)); v[1] *= siluf(__uint_as_float(zz.x & 0xFFFF0000u)); v[2] *= siluf(__uint_as_float(zz.y << 16)); v[3] *= siluf(__uint_as_float(zz.y & 0xFFFF0000u));
                ss += v[0] * v[0] + v[1] * v[1] + v[2] * v[2] + v[3] * v[3];
                stash[(r * 4 + pt) * 64 + lane] = (u32x2){pg8::cvt_pk_bf16(v[0], v[1]), pg8::cvt_pk_bf16(v[2], v[3])}; }
        }
        ss += __shfl_xor(ss, 16); ss += __shfl_xor(ss, 32);
        const float rstd = rsqrtf(ss * (1.f / 512.f) + EPS);
        for (int r = 0; r < 8; ++r)
#pragma unroll
            for (int pt = 0; pt < 4; ++pt) { const int cix = g * 512 + r * 64 + 16 * pt + 4 * q4; const f32x4 nw = *(const f32x4*)(a.ssd_norm_w + cix); const u32x2 w = stash[(r * 4 + pt) * 64 + lane];
                *(u32x2*)(oy + t * 2048 + 1024 + cix) = (u32x2){pg8::cvt_pk_bf16(__uint_as_float(w.x << 16) * rstd * nw[0], __uint_as_float(w.x & 0xFFFF0000u) * rstd * nw[1]), pg8::cvt_pk_bf16(__uint_as_float(w.y << 16) * rstd * nw[2], __uint_as_float(w.y & 0xFFFF0000u) * rstd * nw[3])}; }
    }
}

DEV void ph_attn_naive(const Args& a, const Ctx& X) {
    const bf16_t* qkv = (const bf16_t*)(a.ws + WS_Q1KV); bf16_t* o = (bf16_t*)(a.ws + WS_O1);
    const int lane = X.lane;
    for (int wid = X.bid * NWAVES + X.wave; wid < T * 16; wid += X.G * NWAVES) {
        const int t = wid >> 4, hh = wid & 15, s = t % SEQ;
        const float q = bf2f(qkv[(size_t)t * 3072 + hh * 64 + lane]);
        float m = -INFINITY, l = 0.f, acc = 0.f;
#pragma unroll
        for (int br = 0; br < 3; ++br) { const int d = br == 0 ? 1 : (br == 1 ? 4 : 16);
            for (int j = 0; j <= 128; ++j) { if (s - d * j < 0) break;
                const bf16_t* kr = qkv + (size_t)(t - d * j) * 3072 + 1024 + hh * 64;
                const float sc = wave_sum(q * bf2f(kr[lane]));
                const float mn = fmaxf(m, sc), al = __expf(m - mn), p = __expf(sc - mn);
                l = l * al + p; acc = acc * al + p * bf2f(kr[1024 + lane]); m = mn; } }
        o[(size_t)t * 1024 + hh * 64 + lane] = (bf16_t)f2bf(acc / l);
    }
}

DEV void ph_attn(const Args& a, const Ctx& X) {
    const bf16_t* qkv = (const bf16_t*)(a.ws + WS_Q1KV); bf16_t* po = (bf16_t*)(a.ws + WS_PO); float* plse = (float*)(a.ws + WS_PLSE); bf16_t* o = (bf16_t*)(a.ws + WS_O1);
    LAS unsigned char* vl = X.lds + X.wave * 6144;
    const int lane = X.lane, q = lane & 31, h5 = lane >> 5;
    const int tr_off = ((lane & 15) >> 2) * 192 + (16 * ((lane >> 4) & 1) + 4 * (lane & 3)) * 2;
    for (int unit = X.bid; unit < NB * 16 * 8; unit += X.G) {
        const int b = unit >> 7, hd = (unit >> 3) & 15, g = unit & 7;
        for (int tk = 0; tk < 6; ++tk) {
            const int br = tk >> 1, k = X.wave * 2 + (tk & 1);
            int d, r, i0;
            if (br == 0) { d = 1; r = 0; i0 = 512 * g + 32 * k; } else if (br == 1) { d = 4; r = k & 3; i0 = 128 * g + 32 * (k >> 2); } else { d = 16; r = k; i0 = 32 * g; }
            const size_t tq = (size_t)b * SEQ + (size_t)(i0 + q) * d + r;
            bf16x8 qf[4];
#pragma unroll
            for (int s = 0; s < 4; ++s) qf[s] = *(const bf16x8*)(qkv + tq * 3072 + hd * 64 + 16 * s + 8 * h5);
            f32x16 oacc[2];
#pragma unroll
            for (int i = 0; i < 16; ++i) { oacc[0][i] = 0.f; oacc[1][i] = 0.f; }
            float m = -1e30f, l = 0.f;
            for (int kt = 4; kt >= 0; --kt) {
                const int j0 = i0 - 128 + 32 * kt; if (j0 < 0) break;
                const size_t tkey = (size_t)b * SEQ + (size_t)(j0 + q) * d + r;
                bf16x8 kf[4];
#pragma unroll
                for (int s = 0; s < 4; ++s) kf[s] = *(const bf16x8*)(qkv + tkey * 3072 + 1024 + hd * 64 + 16 * s + 8 * h5);
                u32x4 vp[4];
#pragma unroll
                for (int i = 0; i < 4; ++i) { const int p = lane + 64 * i, key = p >> 3, ch = p & 7; const size_t tv = (size_t)b * SEQ + (size_t)(j0 + key) * d + r;
                    vp[i] = *(const u32x4*)(qkv + tv * 3072 + 2048 + hd * 64 + ch * 8); }
#pragma unroll
                for (int i = 0; i < 4; ++i) { const int p = lane + 64 * i, key = p >> 3, ch = p & 7; *(LAS u32x4*)(vl + key * 192 + ch * 16) = vp[i]; }
                f32x16 sacc;
#pragma unroll
                for (int i = 0; i < 16; ++i) sacc[i] = 0.f;
#pragma unroll
                for (int s = 0; s < 4; ++s) sacc = __builtin_amdgcn_mfma_f32_32x32x16_bf16(kf[s], qf[s], sacc, 0, 0, 0);
                if (kt == 4) {
#pragma unroll
                    for (int i = 0; i < 16; ++i) { const int kl = (i & 3) + 8 * (i >> 2) + 4 * h5; if (kl > q) sacc[i] = -1e30f; }
                } else if (kt == 0) {
#pragma unroll
                    for (int i = 0; i < 16; ++i) { const int kl = (i & 3) + 8 * (i >> 2) + 4 * h5; if (kl < q) sacc[i] = -1e30f; }
                }
                float mx = sacc[0];
#pragma unroll
                for (int i = 1; i < 16; ++i) mx = fmaxf(mx, sacc[i]);
                mx = fmaxf(mx, __shfl_xor(mx, 32));
                const float mn = fmaxf(m, mx), alpha = __expf(m - mn);
                float rs = 0.f;
#pragma unroll
                for (int i = 0; i < 16; ++i) { sacc[i] = __expf(sacc[i] - mn); rs += sacc[i]; }
                rs += __shfl_xor(rs, 32);
                l = l * alpha + rs; m = mn;
#pragma unroll
                for (int i = 0; i < 16; ++i) { oacc[0][i] *= alpha; oacc[1][i] *= alpha; }
                bf16x8 pf[2];
#pragma unroll
                for (int s = 0; s < 2; ++s) { u32x4 w; w.x = pg8::cvt_pk_bf16(sacc[8 * s], sacc[8 * s + 1]); w.y = pg8::cvt_pk_bf16(sacc[8 * s + 2], sacc[8 * s + 3]); w.z = pg8::cvt_pk_bf16(sacc[8 * s + 4], sacc[8 * s + 5]); w.w = pg8::cvt_pk_bf16(sacc[8 * s + 6], sacc[8 * s + 7]);
                    pf[s] = __builtin_bit_cast(bf16x8, w); }
                LDS_WAIT();
#pragma unroll
                for (int dt = 0; dt < 2; ++dt)
#pragma unroll
                    for (int s = 0; s < 2; ++s) {
                        const s16x4 v0 = __builtin_amdgcn_ds_read_tr16_b64_v4i16((LAS s16x4*)(vl + (16 * s + 4 * h5) * 192 + dt * 64 + tr_off));
                        const s16x4 v1 = __builtin_amdgcn_ds_read_tr16_b64_v4i16((LAS s16x4*)(vl + (16 * s + 8 + 4 * h5) * 192 + dt * 64 + tr_off));
                        bf16x8 vf; vf[0] = v0[0]; vf[1] = v0[1]; vf[2] = v0[2]; vf[3] = v0[3]; vf[4] = v1[0]; vf[5] = v1[1]; vf[6] = v1[2]; vf[7] = v1[3];
                        oacc[dt] = __builtin_amdgcn_mfma_f32_32x32x16_bf16(vf, pf[s], oacc[dt], 0, 0, 0);
                    }
                LDS_WAIT();
            }
            const float inv = 1.f / l;
            bf16_t* pr = po + ((size_t)br * T + tq) * 1024 + hd * 64;
#pragma unroll
            for (int dt = 0; dt < 2; ++dt)
#pragma unroll
                for (int gq = 0; gq < 4; ++gq) { u32x2 w; w.x = pg8::cvt_pk_bf16(oacc[dt][4 * gq] * inv, oacc[dt][4 * gq + 1] * inv); w.y = pg8::cvt_pk_bf16(oacc[dt][4 * gq + 2] * inv, oacc[dt][4 * gq + 3] * inv);
                    *(u32x2*)(pr + 32 * dt + 8 * gq + 4 * h5) = w; }
            if (h5 == 0) plse[((size_t)br * T + tq) * 16 + hd] = m + __logf(l);
        }
        VM_WAIT(); __syncthreads();
        {
            const size_t t = (size_t)b * SEQ + 512 * g + X.tid;
            const float l0 = plse[t * 16 + hd], l1 = plse[((size_t)T + t) * 16 + hd], l2 = plse[((size_t)2 * T + t) * 16 + hd];
            const float mx = fmaxf(l0, fmaxf(l1, l2)); float w0 = __expf(l0 - mx), w1 = __expf(l1 - mx), w2 = __expf(l2 - mx); const float wi = 1.f / (w0 + w1 + w2); w0 *= wi; w1 *= wi; w2 *= wi;
            const bf16_t* p0 = po + t * 1024 + hd * 64; const bf16_t* p1 = p0 + (size_t)T * 1024; const bf16_t* p2 = p1 + (size_t)T * 1024; bf16_t* orow = o + t * 1024 + hd * 64;
#pragma unroll
            for (int c = 0; c < 8; ++c) { const u32x4 x0 = *(const u32x4*)(p0 + 8 * c), x1 = *(const u32x4*)(p1 + 8 * c), x2 = *(const u32x4*)(p2 + 8 * c); u32x4 y;
#pragma unroll
                for (int e = 0; e < 4; ++e) { const float lo = w0 * __uint_as_float(x0[e] << 16) + w1 * __uint_as_float(x1[e] << 16) + w2 * __uint_as_float(x2[e] << 16);
                    const float hi = w0 * __uint_as_float(x0[e] & 0xFFFF0000u) + w1 * __uint_as_float(x1[e] & 0xFFFF0000u) + w2 * __uint_as_float(x2[e] & 0xFFFF0000u); y[e] = pk2(lo, hi); }
                *(u32x4*)(orow + 8 * c) = y; }
        }
    }
}

DEV void ph_router(const Args& a, const Ctx& X, const int l) {
    unsigned char* ws = a.ws;
    const float* mod = (const float*)(ws + WS_MOD) + (size_t)l * NB * 6 * D;
    const float* ymix = (const float*)(ws + WS_YMIX);
    const float* xin = (l == 0) ? a.x : a.out;
    bf16_t* hb = (bf16_t*)(ws + WS_H);
    int* idx = (int*)(ws + WS_IDX); float* gw = (float*)(ws + WS_GW); int* aslot = (int*)(ws + WS_ASLOT); int* ltok = (int*)(ws + WS_LTOK);
    int* cntg = (int*)(ws + WS_CTL + CTL_CNT) + l * NE;
    const float* rw = a.router_w + (size_t)l * D * NE; const float* rbias = a.router_bias + l * NE;
    constexpr int HP = 2064;
    LAS unsigned char* hL = X.lds;
    LAS float* logit = (LAS float*)(X.lds + AUX_OFF + 2048);
    LAS int* lcnt = (LAS int*)(X.lds + AUX_OFF + 2048 + 64 * 65 * 4);
    LAS int* lbase = lcnt + 64;
    LAS int* sel_e = lbase + 64;
    LAS int* sel_s = sel_e + 512;
    const int lane = X.lane, wave = X.wave;
    for (int rb = X.bid; rb < T / 64; rb += X.G) {
        if (X.tid < 64) lcnt[X.tid] = 0;
        for (int r8 = 0; r8 < 8; ++r8) {
            const int lr = wave * 8 + r8, row = rb * 64 + lr, b = row / SEQ; const float* ml = mod + (size_t)b * 6 * D;
            float xv[16], yv[16]; load_row(xin + (size_t)row * D, lane, xv); load_row(ymix + (size_t)row * D, lane, yv);
            resid_update(xv, yv, a.mix_post_g + l * D, ml + 2 * D, lane);
            store_row(a.out + (size_t)row * D, lane, xv);
            u32x2 o[4]; prenorm_pack(xv, a.ffn_pre_g + l * D, ml + 4 * D, ml + 3 * D, lane, o);
#pragma unroll
            for (int j = 0; j < 4; ++j) { *(u32x2*)(hb + (size_t)row * D + j * 256 + lane * 4) = o[j]; *(LAS u32x2*)(hL + lr * HP + (j * 256 + lane * 4) * 2) = o[j]; }
        }
        __syncthreads();
        { const int rt = wave & 3, nh = wave >> 2, r16 = lane & 15, kq = lane >> 4;
          f32x4 acc0 = {0.f, 0.f, 0.f, 0.f}, acc1 = {0.f, 0.f, 0.f, 0.f};
          for (int c = 0; c < 32; ++c) {
              const u32x4 hv = *(const LAS u32x4*)(hL + (rt * 16 + r16) * HP + (32 * c + 8 * kq) * 2);
              const float* rp = rw + (size_t)(32 * c + 8 * kq) * NE + 4 * r16 + 2 * nh;
#pragma unroll
              for (int j = 0; j < 8; ++j) { const unsigned wj = hv[j >> 1]; const float av = (j & 1) ? __uint_as_float(wj & 0xFFFF0000u) : __uint_as_float(wj << 16);
                  const f32x2 bv = *(const f32x2*)(rp + (size_t)j * NE);
                  acc0 = __builtin_amdgcn_mfma_f32_16x16x4f32(av, bv.x, acc0, 0, 0, 0); acc1 = __builtin_amdgcn_mfma_f32_16x16x4f32(av, bv.y, acc1, 0, 0, 0); }
          }
#pragma unroll
          for (int r = 0; r < 4; ++r) { logit[(rt * 16 + 4 * kq + r) * 65 + 4 * r16 + 2 * nh] = acc0[r]; logit[(rt * 16 + 4 * kq + r) * 65 + 4 * r16 + 2 * nh + 1] = acc1[r]; } }
        __syncthreads();
        for (int r8 = 0; r8 < 8; ++r8) {
            const int lr = wave * 8 + r8, t = rb * 64 + lr;
            float lgt = logit[lr * 65 + lane]; if (!(lgt > -1e30f && lgt < 1e30f)) lgt = 0.f;
            const float score = sigmoidf_(lgt), biased = score + rbias[lane];
            float m1 = biased;
#pragma unroll
            for (int o = 1; o < 8; o <<= 1) m1 = fmaxf(m1, __shfl_xor(m1, o));
            int c1 = (biased == m1) ? (lane & 7) : 8;
#pragma unroll
            for (int o = 1; o < 8; o <<= 1) c1 = min(c1, __shfl_xor(c1, o));
            float m2 = ((lane & 7) == c1) ? -INFINITY : biased;
#pragma unroll
            for (int o = 1; o < 8; o <<= 1) m2 = fmaxf(m2, __shfl_xor(m2, o));
            const float gs = m1 + m2; const int myg = lane >> 3; int grank = 0;
#pragma unroll
            for (int g2 = 0; g2 < 8; ++g2) { const float o = __shfl(gs, g2 * 8); grank += (o > gs || (o == gs && g2 < myg)) ? 1 : 0; }
            const float cand = (grank < 4) ? biased : -INFINITY; int rank = 0;
            for (int e2 = 0; e2 < 64; ++e2) { const float o = __shfl(cand, e2); rank += (o > cand || (o == cand && e2 < lane)) ? 1 : 0; }
            const bool sel = (rank < TOPK) && (grank < 4);
            const float ssum = wave_sum(sel ? score : 0.f);
            if (sel) { idx[t * 8 + rank] = lane; gw[t * 8 + rank] = score / ssum * 2.5f; sel_e[lr * 8 + rank] = lane; sel_s[lr * 8 + rank] = __hip_atomic_fetch_add(lcnt + lane, 1, __ATOMIC_RELAXED, __HIP_MEMORY_SCOPE_WORKGROUP); }
        }
        __syncthreads();
        if (X.tid < 64) { const int n = lcnt[X.tid]; lbase[X.tid] = n ? atomicAdd(cntg + X.tid, n) : 0; }
        __syncthreads();
        { const int lr = X.tid >> 3, k = X.tid & 7, t = rb * 64 + lr, e = sel_e[lr * 8 + k], sl = lbase[e] + sel_s[lr * 8 + k];
          aslot[t * 8 + k] = sl; ltok[e * CAP + sl] = t; }
        __syncthreads();
    }
    { LAS float* scr = (LAS float*)(X.lds + X.wave * 8704);
      const int gwv = X.bid * NWAVES + X.wave, NGW = X.G * NWAVES;
      constexpr int I_GU = (D / 64) * (512 / 32), I_D = (ED / 64) * (D / 32), I_E = I_GU + I_D;
      const float* eg = a.exp_gate + (size_t)l * NE * D * ED; const float* eu = a.exp_up + (size_t)l * NE * D * ED; const float* ed = a.exp_down + (size_t)l * NE * ED * D;
      for (int it = gwv; it < (NE + 1) * I_E; it += NGW) {
          const int e = it / I_E; int r = it - e * I_E;
          if (e < NE) {
              if (r < I_GU) conv_item(SrcGU{eg + (size_t)e * D * ED, (long)(eu - eg)}, ED, D, (bf16_t*)(ws + WS_WGU) + (size_t)e * 512 * D, scr, r, 16, X.lane);
              else conv_item(SrcIdent{ed + (size_t)e * ED * D}, D, ED, (bf16_t*)(ws + WS_WD) + (size_t)e * D * ED, scr, r - I_GU, D / 32, X.lane);
          } else {
              if (r < I_GU) conv_item(SrcGU{a.sh_gate + (size_t)l * D * ED, (long)(a.sh_up - a.sh_gate)}, ED, D, (bf16_t*)(ws + WS_WGUS), scr, r, 16, X.lane);
              else conv_item(SrcIdent{a.sh_down + (size_t)l * ED * D}, D, ED, (bf16_t*)(ws + WS_WDS), scr, r - I_GU, D / 32, X.lane);
          }
      } }
}

DEV int moe_tables(const Args& a, const Ctx& X, const int l, LAS int* t_cnt, LAS int* t_rb0, LAS int* t_eofrb) {
    const int* cntg = (const int*)(a.ws + WS_CTL + CTL_CNT) + l * NE;
    if (X.wave == 0) {
        const int c = __hip_atomic_load(cntg + X.lane, __ATOMIC_RELAXED, __HIP_MEMORY_SCOPE_AGENT), nrb = (c + 255) >> 8;
        int incl = nrb;
#pragma unroll
        for (int o = 1; o < 64; o <<= 1) { const int v = __shfl_up(incl, o); if (X.lane >= o) incl += v; }
        const int excl = incl - nrb;
        t_cnt[X.lane] = c; t_rb0[X.lane] = excl; if (X.lane == 63) t_rb0[64] = incl;
        for (int j = 0; j < nrb; ++j) t_eofrb[excl + j] = X.lane;
        t_eofrb[SH_RB + X.lane] = NE;
    }
    __syncthreads();
    return t_rb0[64];
}

DEV void ph_moe_gu(const Args& a, const Ctx& X, const int l) {
    LAS int* t_cnt = (LAS int*)(X.lds + AUX_OFF + 1024); LAS int* t_rb0 = t_cnt + 64; LAS int* t_eofrb = t_rb0 + 80; LAS int* toks = t_eofrb + NRB_ALL;
    const int nrbt = moe_tables(a, X, l, t_cnt, t_rb0, t_eofrb);
    const int* ltok = (const int*)(a.ws + WS_LTOK);
    pg8::Unit u;
    for (int i = 0; i < 8; ++i) { if (!pg8::moe_unit(i, 2, nrbt, X.G, X.bid, u)) break;
        if (X.tid < 256) { const int e = t_eofrb[u.pm]; int tok;
            if (e < NE) { const int sl = (u.pm - t_rb0[e]) * 256 + X.tid; tok = sl < t_cnt[e] ? ltok[e * CAP + sl] : 0; } else tok = (u.pm - SH_RB) * 256 + X.tid;
            toks[i * 256 + X.tid] = tok; } }
    VM_WAIT(); __syncthreads();
    pg8::SchedGU S{(const char*)(a.ws + WS_H), (const char*)(a.ws + WS_WGU), (const char*)(a.ws + WS_WGUS), t_eofrb, toks, nrbt, X.G, X.bid, 0};
    pg8::EpiGU E{(bf16_t*)(a.ws + WS_HID)};
    pg8::gemm_phase<pg8::EpiGU, pg8::SchedGU>(X.lds, D, S, E);
}
DEV void ph_moe_down(const Args& a, const Ctx& X, const int l) {
    LAS int* t_cnt = (LAS int*)(X.lds + AUX_OFF + 1024); LAS int* t_rb0 = t_cnt + 64; LAS int* t_eofrb = t_rb0 + 80;
    const int nrbt = moe_tables(a, X, l, t_cnt, t_rb0, t_eofrb);
    pg8::SchedDown S{(const char*)(a.ws + WS_HID), (const char*)(a.ws + WS_WD), (const char*)(a.ws + WS_WDS), t_eofrb, nrbt, X.G, X.bid, 0};
    pg8::EpiBf16 E{(bf16_t*)(a.ws + WS_Y), D, 0};
    int kd = ED; asm volatile("" : "+s"(kd));
    pg8::gemm_phase<pg8::EpiBf16, pg8::SchedDown>(X.lds, kd, S, E);
}
DEV void ph_combine(const Args& a, const Ctx& X, const int l) {
    LAS int* t_cnt = (LAS int*)(X.lds + AUX_OFF + 1024); LAS int* t_rb0 = t_cnt + 64; LAS int* t_eofrb = t_rb0 + 80;
    (void)moe_tables(a, X, l, t_cnt, t_rb0, t_eofrb);
    const float* mod = (const float*)(a.ws + WS_MOD);
    const int* idx = (const int*)(a.ws + WS_IDX); const float* gw = (const float*)(a.ws + WS_GW); const int* aslot = (const int*)(a.ws + WS_ASLOT);
    const bf16_t* y = (const bf16_t*)(a.ws + WS_Y); bf16_t* hb = (bf16_t*)(a.ws + WS_H);
    const int lane = X.lane;
    for (int t = X.bid * NWAVES + X.wave; t < T; t += X.G * NWAVES) {
        const int b = t / SEQ; const float* ml = mod + (size_t)(l * NB + b) * 6 * D;
        float yv[16];
        { const bf16_t* yr = y + ((size_t)SH_RB * 256 + t) * D;
#pragma unroll
          for (int j = 0; j < 4; ++j) { const u32x2 w = *(const u32x2*)(yr + j * 256 + lane * 4); yv[4 * j] = __uint_as_float(w.x << 16); yv[4 * j + 1] = __uint_as_float(w.x & 0xFFFF0000u); yv[4 * j + 2] = __uint_as_float(w.y << 16); yv[4 * j + 3] = __uint_as_float(w.y & 0xFFFF0000u); } }
#pragma unroll
        for (int k = 0; k < 8; ++k) {
            const int e = idx[t * 8 + k]; const float g = gw[t * 8 + k]; const size_t row = (size_t)t_rb0[e] * 256 + aslot[t * 8 + k];
            const bf16_t* yr = y + row * D;
#pragma unroll
            for (int j = 0; j < 4; ++j) { const u32x2 w = *(const u32x2*)(yr + j * 256 + lane * 4);
                yv[4 * j] += g * __uint_as_float(w.x << 16); yv[4 * j + 1] += g * __uint_as_float(w.x & 0xFFFF0000u); yv[4 * j + 2] += g * __uint_as_float(w.y << 16); yv[4 * j + 3] += g * __uint_as_float(w.y & 0xFFFF0000u); }
        }
        float xv[16]; load_row(a.out + (size_t)t * D, lane, xv);
        resid_update(xv, yv, a.ffn_post_g + l * D, ml + 5 * D, lane);
        store_row(a.out + (size_t)t * D, lane, xv);
        if (l == 0) { const float* mn = mod + (size_t)(1 * NB + b) * 6 * D; u32x2 o[4]; prenorm_pack(xv, a.mix_pre_g + D, mn + D, mn, lane, o);
#pragma unroll
            for (int j = 0; j < 4; ++j) *(u32x2*)(hb + (size_t)t * D + j * 256 + lane * 4) = o[j]; }
    }
}

constexpr int NPH = 18;
__global__ void __launch_bounds__(NTHR, 2) mega(Args a) {
    extern __shared__ __attribute__((aligned(16))) unsigned char lds_raw[];
    Ctx X; X.lds = (LAS unsigned char*)lds_raw; X.tid = threadIdx.x; X.lane = X.tid & 63; X.wave = __builtin_amdgcn_readfirstlane(X.tid >> 6); X.G = gridDim.x; X.bid = blockIdx.x;
    if (X.tid < 4) ((LAS unsigned*)(X.lds + BAR_OFF))[X.tid] = 0u;
    __syncthreads();
    XcdBarrier bar; bar.bar = (unsigned*)(a.ws + WS_CTL); bar.x = 0; bar.st = nullptr;
    if (!MK_PER_PHASE) bar = xcd_barrier_post((unsigned*)(a.ws + WS_CTL), (volatile LAS unsigned*)(X.lds + BAR_OFF));
    const int lo = a.ph_lo, hi = a.ph_hi;
#define IN(k) (lo <= (k) && (k) < hi)
#define SEAM(k) do { if (IN(k) && IN((k) + 1)) xcd_barrier(bar); else { VM_WAIT(); __syncthreads(); } } while (0)
    unsigned char* ws = a.ws;
    if (IN(0)) { ph_setup(a, X); SEAM(0); }
    if (IN(1)) { ph_prenorm0(a, X); SEAM(1); }
    if (IN(2)) {
        pg8::SchedDense S; S.so.init(T, NPROJ, X.G, X.bid); S.A = (const char*)(ws + WS_H); S.Bt = (const char*)(ws + WS_WIN); S.K = D; S.pad_ = 0;
        pg8::EpiProj E{(bf16_t*)(ws + WS_QKVPRE), (bf16_t*)(ws + WS_ZA), (bf16_t*)(ws + WS_XBCPRE), (bf16_t*)(ws + WS_ZB), (float*)(ws + WS_SMALL)};
        pg8::gemm_phase<pg8::EpiProj, pg8::SchedDense>(X.lds, D, S, E); SEAM(2); }
    if (IN(3)) { ph_gdn_local(a, X); ph_ssd_local(a, X); SEAM(3); }
    if (IN(4)) { if (X.bid < 32) ph_gdn_scan(a, X); else ph_ssd_scan(a, X, 32); SEAM(4); }
    if (IN(5)) { ph_ssd_out(a, X); SEAM(5); }
    if (IN(6)) {
        pg8::SchedDense S; S.so.init(T, D, X.G, X.bid); S.A = (const char*)(ws + WS_OY); S.Bt = (const char*)(ws + WS_WOUT); S.K = 2048; S.pad_ = 0;
        pg8::EpiF32 E{(float*)(ws + WS_YMIX), D, 0};
        pg8::gemm_phase<pg8::EpiF32, pg8::SchedDense>(X.lds, 2048, S, E); SEAM(6); }
    if (IN(7)) { ph_router(a, X, 0); SEAM(7); }
    if (IN(8)) { ph_moe_gu(a, X, 0); SEAM(8); }
    if (IN(9)) { ph_moe_down(a, X, 0); SEAM(9); }
    if (IN(10)) { ph_combine(a, X, 0); SEAM(10); }
    if (IN(11)) {
        pg8::SchedDense S; S.so.init(T, 3072, X.G, X.bid); S.A = (const char*)(ws + WS_H); S.Bt = (const char*)(ws + WS_WQKV); S.K = D; S.pad_ = 0;
        pg8::EpiQKV E{(bf16_t*)(ws + WS_Q1KV), (const float*)(ws + WS_COS), (const float*)(ws + WS_SIN)};
        pg8::gemm_phase<pg8::EpiQKV, pg8::SchedDense>(X.lds, D, S, E); SEAM(11); }
    if (IN(12)) { ph_attn(a, X); SEAM(12); }
    if (IN(13)) {
        pg8::SchedDense S; S.so.init(T, D, X.G, X.bid); S.A = (const char*)(ws + WS_O1); S.Bt = (const char*)(ws + WS_WO); S.K = D; S.pad_ = 0;
        pg8::EpiF32 E{(float*)(ws + WS_YMIX), D, 0};
        pg8::gemm_phase<pg8::EpiF32, pg8::SchedDense>(X.lds, D, S, E); SEAM(13); }
    if (IN(14)) { ph_router(a, X, 1); SEAM(14); }
    if (IN(15)) { ph_moe_gu(a, X, 1); SEAM(15); }
    if (IN(16)) { ph_moe_down(a, X, 1); SEAM(16); }
    if (IN(17)) { ph_combine(a, X, 1); }
#undef IN
#undef SEAM
}

extern "C" void kernel_launch(void* const* d_in, const int* in_sizes, int n_in, void* d_out, int out_size, void* d_ws, size_t ws_size, hipStream_t stream) {
    static int grid = 0;
    if (!grid) {
        int dev = 0, cus = 0, per_cu = 0;
        if (hipGetDevice(&dev) != hipSuccess || hipDeviceGetAttribute(&cus, hipDeviceAttributeMultiprocessorCount, dev) != hipSuccess) { fprintf(stderr, "kernel_launch: device query failed\n"); grid = -1; return; }
        if (hipFuncSetAttribute((const void*)mega, hipFuncAttributeMaxDynamicSharedMemorySize, LDS_BYTES) != hipSuccess) { fprintf(stderr, "kernel_launch: hipFuncSetAttribute failed\n"); grid = -1; return; }
        if (hipOccupancyMaxActiveBlocksPerMultiprocessor(&per_cu, (const void*)mega, NTHR, LDS_BYTES) != hipSuccess || per_cu < 1) { fprintf(stderr, "kernel_launch: occupancy query says %d blocks per CU\n", per_cu); grid = -1; return; }
        grid = cus;
        if (grid < 64 || (grid & 7)) { fprintf(stderr, "kernel_launch: unsupported CU count %d\n", cus); grid = -1; return; }
    }
    if (grid < 0) return;
    if (ws_size < WS_END || n_in != 31) { fprintf(stderr, "kernel_launch: workspace %zu < %zu or n_in %d != 31\n", ws_size, (size_t)WS_END, n_in); return; }
    if (hipMemsetAsync((char*)d_ws + WS_CTL, 0, CTL_BYTES, stream) != hipSuccess) { fprintf(stderr, "kernel_launch: memset failed\n"); return; }
    Args a{};
    a.x = (const float*)d_in[0]; a.c = (const float*)d_in[1]; a.pos = (const int*)d_in[2]; a.mod_w = (const float*)d_in[3]; a.mod_b = (const float*)d_in[4];
    a.mix_pre_g = (const float*)d_in[5]; a.mix_post_g = (const float*)d_in[6]; a.ffn_pre_g = (const float*)d_in[7]; a.ffn_post_g = (const float*)d_in[8];
    a.ssm_w_in = (const float*)d_in[9]; a.gdn_conv_w = (const float*)d_in[10]; a.gdn_a_log = (const float*)d_in[11]; a.gdn_dt_bias = (const float*)d_in[12]; a.gdn_norm_w = (const float*)d_in[13];
    a.ssd_conv_w = (const float*)d_in[14]; a.ssd_conv_b = (const float*)d_in[15]; a.ssd_a_log = (const float*)d_in[16]; a.ssd_dt_bias = (const float*)d_in[17]; a.ssd_d = (const float*)d_in[18]; a.ssd_norm_w = (const float*)d_in[19];
    a.ssm_w_out = (const float*)d_in[20]; a.attn_w_qkv = (const float*)d_in[21]; a.attn_w_o = (const float*)d_in[22];
    a.router_w = (const float*)d_in[23]; a.router_bias = (const float*)d_in[24]; a.exp_gate = (const float*)d_in[25]; a.exp_up = (const float*)d_in[26]; a.exp_down = (const float*)d_in[27];
    a.sh_gate = (const float*)d_in[28]; a.sh_up = (const float*)d_in[29]; a.sh_down = (const float*)d_in[30];
    a.out = (float*)d_out; a.ws = (unsigned char*)d_ws;
#if MK_PER_PHASE
    for (int p = 0; p < NPH; ++p) { a.ph_lo = p; a.ph_hi = p + 1; hipLaunchKernelGGL(mega, dim3(grid), dim3(NTHR), LDS_BYTES, stream, a); }
#else
    a.ph_lo = 0; a.ph_hi = NPH;
    hipLaunchKernelGGL(mega, dim3(grid), dim3(NTHR), LDS_BYTES, stream, a);
#endif
}
```

```cpp
#include <hip/hip_runtime.h>
#include <stdint.h>
#include <stdio.h>

#define DEV __device__ __forceinline__
#define LAS __attribute__((address_space(3)))
typedef unsigned short bf16_t;
typedef short bf16x8 __attribute__((ext_vector_type(8)));
typedef float f32x4 __attribute__((ext_vector_type(4)));
typedef float f32x2 __attribute__((ext_vector_type(2)));
typedef unsigned u32x4 __attribute__((ext_vector_type(4)));
typedef unsigned u32x2 __attribute__((ext_vector_type(2)));
typedef float f32x16 __attribute__((ext_vector_type(16)));
typedef short s16x4 __attribute__((ext_vector_type(4)));

#ifndef PROBE_MASK
#define PROBE_MASK 0u
#endif
#ifndef MK_PER_PHASE
#define MK_PER_PHASE 0
#endif

constexpr int NB = 4, SEQ = 4096, T = NB * SEQ, D = 1024;
constexpr int PROJ = 6688, NPROJ = 6912;
constexpr int C_BETA = 4096, C_XBC = 4112, C_ZB = 5648, C_DT = 6672;
constexpr int NE = 64, TOPK = 8, ED = 256, CAP = 16384;
constexpr int SH_RB = 576;
constexpr int NRB_ALL = SH_RB + 64;
constexpr float EPS = 1e-6f;
constexpr int NTHR = 512, NWAVES = 8;
constexpr int LDS_BYTES = 163840;
constexpr int AUX_OFF = 131072;
constexpr int BAR_OFF = LDS_BYTES - 16;

constexpr size_t MiB = 1u << 20;
constexpr size_t WS_CTL = 0, CTL_BYTES = 65536;
constexpr size_t CTL_CNT = 16384;
constexpr size_t CTL_GRP = 20480;
constexpr size_t WS_MOD = 65536;
constexpr size_t WS_COS = 1 * MiB, WS_SIN = 3 * MiB;
constexpr size_t WS_IDX = 5 * MiB, WS_GW = 5 * MiB + 512 * 1024, WS_ASLOT = 6 * MiB, WS_LTOK = 6 * MiB + 512 * 1024;
constexpr size_t WS_SMALL = 11 * MiB;
constexpr size_t WS_GB = 13 * MiB, WS_DTB = 14 * MiB;
constexpr size_t WS_WIN = 16 * MiB, WS_WOUT = 30 * MiB, WS_WQKV = 34 * MiB, WS_WO = 40 * MiB;
constexpr size_t WS_H = 44 * MiB;
constexpr size_t WS_QKVPRE = 78 * MiB, WS_XBCPRE = 174 * MiB, WS_ZA = 222 * MiB, WS_ZB = 254 * MiB;
constexpr size_t WS_QKVN = 286 * MiB, WS_XBCC = 382 * MiB;
constexpr size_t WS_CC = 16 * MiB, WS_ACUM = 25 * MiB, WS_CDEC = 26 * MiB, WS_YDIAG = 44 * MiB, WS_STATES = 430 * MiB;
constexpr size_t WS_GI = 286 * MiB, GI_UNIT = 73728, WS_GTMP = 462 * MiB, WS_GLAST = 27 * MiB;
constexpr size_t WS_ORAW = 78 * MiB, WS_YRAW = 142 * MiB, WS_OY = 78 * MiB, WS_YMIX = 286 * MiB;
constexpr size_t WS_WD = 478 * MiB, WS_WDS = 510 * MiB + 512 * 1024, WS_HID = 398 * MiB, WS_Y = 78 * MiB, WS_WGU = 142 * MiB, WS_WGUS = 207 * MiB;
constexpr size_t WS_Q1KV = 78 * MiB, WS_O1 = 174 * MiB, WS_PO = 350 * MiB, WS_PLSE = 446 * MiB;
constexpr size_t WS_END = 512 * MiB;

struct Args {
    const float* x; const float* c; const int* pos; const float* mod_w; const float* mod_b;
    const float* mix_pre_g; const float* mix_post_g; const float* ffn_pre_g; const float* ffn_post_g;
    const float* ssm_w_in; const float* gdn_conv_w; const float* gdn_a_log; const float* gdn_dt_bias; const float* gdn_norm_w;
    const float* ssd_conv_w; const float* ssd_conv_b; const float* ssd_a_log; const float* ssd_dt_bias; const float* ssd_d; const float* ssd_norm_w;
    const float* ssm_w_out; const float* attn_w_qkv; const float* attn_w_o;
    const float* router_w; const float* router_bias; const float* exp_gate; const float* exp_up; const float* exp_down;
    const float* sh_gate; const float* sh_up; const float* sh_down;
    float* out; unsigned char* ws; int ph_lo, ph_hi;
};

DEV float bf2f(bf16_t v) { return __uint_as_float(((unsigned)v) << 16); }
DEV unsigned f2bf(float f) { unsigned u = __float_as_uint(f); return (u + 0x7FFFu + ((u >> 16) & 1u)) >> 16; }
DEV unsigned pk2(float lo, float hi) { return f2bf(lo) | (f2bf(hi) << 16); }
DEV float wave_sum(float v) {
#pragma unroll
    for (int o = 32; o > 0; o >>= 1) v += __shfl_xor(v, o);
    return v;
}
DEV float siluf(float x) { return x / (1.f + __expf(-x)); }
DEV float sigmoidf_(float x) { return 1.f / (1.f + __expf(-x)); }
DEV float softplusf(float x) { return fmaxf(x, 0.f) + log1pf(__expf(-fabsf(x))); }
#define LDS_WAIT() asm volatile("s_waitcnt lgkmcnt(0)" ::: "memory")
#define VM_WAIT() asm volatile("s_waitcnt vmcnt(0)" ::: "memory")

#define XB_TMO      128
#define XB_XCNT(j)  (256  + 64 * (j))
#define XB_XSUB(j)  (1280 + 64 * (j))
#define XB_XGEN(j)  (2304 + 64 * (j))
#define XB_TOP      3328
#define XB_TOPGEN   3392
#define XCD_BAR_WORDS 3456
#define XB_SPIN_CAP (1u << 18)
#define LAS __attribute__((address_space(3)))

__device__ __forceinline__ unsigned xb_ld(unsigned* p)              { return __hip_atomic_load(p, __ATOMIC_RELAXED, __HIP_MEMORY_SCOPE_AGENT); }
__device__ __forceinline__ unsigned xb_add(unsigned* p, unsigned v) { return __hip_atomic_fetch_add(p, v, __ATOMIC_RELAXED, __HIP_MEMORY_SCOPE_AGENT); }
__device__ __forceinline__ unsigned xb_xcc_id() { return (unsigned)__builtin_amdgcn_s_getreg((3 << 11) | 20) & 0xFu; }
#define XB_SPIN(cond, bar) do { unsigned _sp = 0; while (cond) { __builtin_amdgcn_s_sleep(1); \
    if ((++_sp & 255u) == 0u) { if (xb_ld(&(bar)[XB_TMO])) break; if (_sp > XB_SPIN_CAP) { atomicAdd(&(bar)[XB_TMO], 1u); break; } } } } while (0)

struct XcdBarrier {
    unsigned* bar; unsigned x;
    volatile LAS unsigned* st;
};

__device__ __forceinline__ XcdBarrier xcd_barrier_post(unsigned* bar, volatile LAS unsigned* st) {
    XcdBarrier b; b.bar = bar; b.x = xb_xcc_id(); b.st = st;
    if (threadIdx.x == 0) (void)xb_add(&bar[XB_XCNT(b.x)], 1u);
    return b;
}
__device__ __forceinline__ void xcd_barrier_complete(unsigned* bar, unsigned x, unsigned& nloc, unsigned& nx) {
    const unsigned G = gridDim.x * gridDim.y * gridDim.z;
    unsigned sum, cnt, mine, sp = 0u;
    for (;;) {
        sum = 0u; cnt = 0u; mine = 0u;
#pragma unroll
        for (unsigned j = 0; j < 16; ++j) { const unsigned c = xb_ld(&bar[XB_XCNT(j)]); sum += c; cnt += (c > 0u) ? 1u : 0u; mine = (j == x) ? c : mine; }
        if (sum == G) break;
        __builtin_amdgcn_s_sleep(1);
        if ((++sp & 255u) == 0u) { if (xb_ld(&bar[XB_TMO])) break; if (sp > XB_SPIN_CAP) { atomicAdd(&bar[XB_TMO], 1u); break; } }
    }
    nloc = mine > 0u ? mine : 1u; nx = cnt > 0u ? cnt : 1u;
}

__device__ __forceinline__ void xcd_barrier(const XcdBarrier& b) {
    asm volatile("s_waitcnt vmcnt(0)" ::: "memory");
    __syncthreads();
    if (threadIdx.x == 0) {
        unsigned* bar = b.bar;
        __builtin_amdgcn_s_waitcnt(0);
        unsigned nloc = b.st[0], nx = b.st[1];
        if (nloc == 0u) { xcd_barrier_complete(bar, b.x, nloc, nx); b.st[0] = nloc; b.st[1] = nx; }
        const unsigned old = xb_add(&bar[XB_XSUB(b.x)], 1u);
        const unsigned gen = old / nloc;
        if (old + 1u == (gen + 1u) * nloc) {
            __builtin_amdgcn_fence(__ATOMIC_RELEASE, "agent");
            asm volatile("s_waitcnt vmcnt(0)" ::: "memory");
            const unsigned og = xb_add(&bar[XB_TOP], 1u);
            const unsigned tg = og / nx;
            if (og + 1u == (tg + 1u) * nx) xb_add(&bar[XB_TOPGEN], 1u);
            else XB_SPIN(xb_ld(&bar[XB_TOPGEN]) == tg, bar);
            __builtin_amdgcn_fence(__ATOMIC_ACQUIRE, "agent");
            xb_add(&bar[XB_XGEN(b.x)], 1u);
            asm volatile("s_waitcnt vmcnt(0)" ::: "memory");
        } else {
            XB_SPIN(xb_ld(&bar[XB_XGEN(b.x)]) == gen, bar);
            __builtin_amdgcn_fence(__ATOMIC_ACQUIRE, "agent");
            asm volatile("s_waitcnt vmcnt(0)" ::: "memory");
        }
    }
    __syncthreads();
}


DEV void group_barrier(unsigned* ctr, const unsigned n) {
    asm volatile("s_waitcnt vmcnt(0)" ::: "memory");
    __syncthreads();
    if (threadIdx.x == 0) {
        __builtin_amdgcn_fence(__ATOMIC_RELEASE, "agent");
        asm volatile("s_waitcnt vmcnt(0)" ::: "memory");
        (void)__hip_atomic_fetch_add(ctr, 1u, __ATOMIC_RELAXED, __HIP_MEMORY_SCOPE_AGENT);
        unsigned sp = 0;
        while (__hip_atomic_load(ctr, __ATOMIC_RELAXED, __HIP_MEMORY_SCOPE_AGENT) < n) { __builtin_amdgcn_s_sleep(2); if (++sp > (1u << 22)) break; }
        __builtin_amdgcn_fence(__ATOMIC_ACQUIRE, "agent");
        asm volatile("s_waitcnt vmcnt(0)" ::: "memory");
    }
    __syncthreads();
}

namespace pg8 {
constexpr int BM = 256, BK = 64, HALF = 128, HTB = HALF * BK * 2, STAGE_BYTES = 8 * HTB, NXCD = 8, WGM = 8;
DEV int lds_byte(int r, int c) { const int st = (r >> 4) * 2 + (c >> 5), rr = r & 15, cc = c & 31, ob = rr * 64 + cc * 2; return st * 1024 + (ob ^ (((ob >> 9) & 1) << 5)); }
DEV void stage_rc(int b, int& R, int& C) { const int st = b / 1024, sb = b % 1024, swz = sb ^ (((sb >> 9) & 1) << 5); R = (st >> 1) * 16 + swz / 64; C = (st & 1) * 32 + (swz % 64) / 2; }
DEV int perm32(int rho) { const int n = rho >> 4, i = rho & 15; return 8 * (i >> 2) + 4 * n + (i & 3); }
struct Unit { int pm, pn, e, slot; };
struct StaticOrder {
    int nM, nN, nwg, G, c;
    DEV void init(int M, int N, int G_, int c_) { nM = M / BM; nN = N / BM; nwg = nM * nN; G = G_; c = c_; }
    DEV bool next(int i, int& pm, int& pn) const {
        const long L = (long)i * G + c; if (L >= nwg) return false;
        int wgid = (int)L; { const int q = nwg / NXCD, r = nwg % NXCD, xcd = wgid % NXCD, off = wgid / NXCD; wgid = (xcd < r ? xcd * (q + 1) : r * (q + 1) + (xcd - r) * q) + off; }
        const int nig = WGM * nN, gid = wgid / nig, fm = gid * WGM, gsz = (nM - fm) < WGM ? (nM - fm) : WGM;
        pm = fm + ((wgid % nig) % gsz); pn = (wgid % nig) / gsz; return true;
    }
};
typedef __bf16 bf16x2_t __attribute__((ext_vector_type(2)));
DEV unsigned cvt_pk_bf16(float lo, float hi) { const bf16x2_t v = {(__bf16)lo, (__bf16)hi}; return __builtin_bit_cast(unsigned, v); }
DEV u32x4 pack8(const f32x4 a, const f32x4 b) { u32x4 w; w.x = cvt_pk_bf16(a[0], a[1]); w.y = cvt_pk_bf16(a[2], a[3]); w.z = cvt_pk_bf16(b[0], b[1]); w.w = cvt_pk_bf16(b[2], b[3]); return w; }

template <class Epi, class Sched>
DEV void gemm_phase(LAS unsigned char* lds, const int K, const Sched& S, const Epi& E) {
    const int tid = threadIdx.x, wid = __builtin_amdgcn_readfirstlane(tid >> 6), lane = tid & 63, wr = wid >> 2, wc = wid & 3, fr = lane & 15, fq = lane >> 4;
    const int nt = K / BK;
    unsigned voffB[2];
#pragma unroll
    for (int i = 0; i < 2; ++i) { int R, C; stage_rc(tid * 16 + i * 8192, R, C); const int Rb = Epi::PERM ? ((R & ~31) + perm32(R & 31)) : R; voffB[i] = (unsigned)(Rb * K + C) * 2u; }
    const unsigned kstep = (unsigned)(BK * 2);
    const size_t hstep = (size_t)HALF * K * 2;
    const unsigned ldsw = (unsigned)wid * 1024u;
    const int aoff = lds_byte(wr * 64 + fr, fq * 8), boff = lds_byte(wc * 32 + fr, fq * 8);
    const size_t hsA = Sched::GATHER ? (size_t)0 : hstep;
#define PG8_SA(b, h) (((b) * 2 + (h)) * HTB)
#define PG8_SB(b, h) ((4 + (b) * 2 + (h)) * HTB)
#define PG8_STAGEB(bufoff, gbase) do { _Pragma("unroll") for (int _i = 0; _i < 2; ++_i) \
        __builtin_amdgcn_global_load_lds((const unsigned*)((const char*)(gbase) + voffB[_i]), (LAS unsigned*)(lds + (bufoff) + ldsw + _i * 8192), 16, 0, 0); } while (0)
#define PG8_STAGEA(bufoff, gbase, VO) do { _Pragma("unroll") for (int _i = 0; _i < 2; ++_i) \
        __builtin_amdgcn_global_load_lds((const unsigned*)((const char*)(gbase) + (VO)[_i]), (LAS unsigned*)(lds + (bufoff) + ldsw + _i * 8192), 16, 0, 0); } while (0)
#define PG8_LDA(dst, b, h) do { _Pragma("unroll") for (int m = 0; m < 4; ++m) _Pragma("unroll") for (int k = 0; k < 2; ++k) dst[m][k] = *(const LAS bf16x8*)(lds + PG8_SA(b, h) + aoff + m * 2048 + k * 1024); } while (0)
#define PG8_LDB(dst, b, h) do { _Pragma("unroll") for (int n = 0; n < 2; ++n) _Pragma("unroll") for (int k = 0; k < 2; ++k) dst[n][k] = *(const LAS bf16x8*)(lds + PG8_SB(b, h) + boff + n * 2048 + k * 1024); } while (0)
#define PG8_MMA(ai, bj, At, Bt) do { __builtin_amdgcn_s_setprio(1); _Pragma("unroll") for (int m = 0; m < 4; ++m) _Pragma("unroll") for (int n = 0; n < 2; ++n) _Pragma("unroll") for (int k = 0; k < 2; ++k) \
        acc[ai][bj][m][n] = __builtin_amdgcn_mfma_f32_16x16x32_bf16(Bt[n][k], At[m][k], acc[ai][bj][m][n], 0, 0, 0); __builtin_amdgcn_s_setprio(0); } while (0)
#define PG8_WAIT_V(n) asm volatile("s_waitcnt vmcnt(" #n ")" ::: "memory")
#define PG8_WAIT_L(n) asm volatile("s_waitcnt lgkmcnt(" #n ")" ::: "memory")
#define PG8_BAR __builtin_amdgcn_s_barrier()
#define PG8_SCHED __builtin_amdgcn_sched_barrier(0)
    Unit cur, nxt; int ui = 0;
    if (!S.next(0, cur)) return;
    f32x4 acc[2][2][4][2];
#pragma unroll
    for (int a = 0; a < 2; ++a)
#pragma unroll
        for (int b = 0; b < 2; ++b)
#pragma unroll
            for (int m = 0; m < 4; ++m)
#pragma unroll
                for (int n = 0; n < 2; ++n) acc[a][b][m][n] = (f32x4){0.f, 0.f, 0.f, 0.f};
    bf16x8 At[4][2], B0[2][2], B1[2][2];
    unsigned va[2][2];
    S.a_voff(cur, tid, va);
    const char* cA = S.a_ptr(cur);
    const char* cB = S.b_ptr(cur);
    PG8_STAGEB(PG8_SB(0, 0), cB); PG8_STAGEB(PG8_SB(0, 1), cB + hstep); PG8_STAGEA(PG8_SA(0, 0), cA, va[0]); PG8_STAGEA(PG8_SA(0, 1), cA + hsA, va[1]);
    if (wr == 1) PG8_BAR;
    PG8_WAIT_V(2); PG8_BAR;
    PG8_STAGEB(PG8_SB(1, 0), cB + kstep); PG8_STAGEA(PG8_SA(1, 0), cA + kstep, va[0]); PG8_STAGEB(PG8_SB(1, 1), cB + hstep + kstep);
    PG8_WAIT_V(6); PG8_BAR;
    for (;;) {
        const bool has_next = S.next(ui + 1, nxt);
        const char* nB = has_next ? S.b_ptr(nxt) : cB;
        const char* nA = has_next ? S.a_ptr(nxt) : cA;
        for (int t = 0; t < nt; t += 2) {
            const bool last = (t == nt - 2);
            const char* a1 = cA + (size_t)(t + 1) * kstep;
            const char* a2 = last ? nA : cA + (size_t)(t + 2) * kstep; const char* a3 = a2 + kstep;
            unsigned v2[2][2];
            v2[0][0] = va[0][0]; v2[0][1] = va[0][1]; v2[1][0] = va[1][0]; v2[1][1] = va[1][1];
            if constexpr (Sched::GATHER) { if (last && has_next) S.a_voff(nxt, tid, v2); }
            const char* b2 = last ? nB : cB + (size_t)(t + 2) * kstep; const char* b3 = b2 + kstep;
            PG8_LDB(B0, 0, 0); PG8_LDB(B1, 0, 1); PG8_SCHED; PG8_LDA(At, 0, 0); PG8_STAGEA(PG8_SA(1, 1), a1 + hsA, va[1]);
            PG8_WAIT_V(8); PG8_WAIT_L(0); PG8_BAR; PG8_MMA(0, 0, At, B0); PG8_MMA(0, 1, At, B1); PG8_BAR; PG8_SCHED;
            PG8_LDA(At, 0, 1); PG8_STAGEB(PG8_SB(0, 0), b2); PG8_STAGEB(PG8_SB(0, 1), b2 + hstep); PG8_STAGEA(PG8_SA(0, 0), a2, v2[0]);
            PG8_WAIT_V(8); PG8_WAIT_L(0); PG8_BAR; PG8_MMA(1, 0, At, B0); PG8_MMA(1, 1, At, B1); PG8_BAR; PG8_SCHED;
            PG8_LDB(B0, 1, 0); PG8_LDB(B1, 1, 1); PG8_SCHED; PG8_LDA(At, 1, 0); PG8_STAGEA(PG8_SA(0, 1), a2 + hsA, v2[1]);
            PG8_WAIT_V(8); PG8_WAIT_L(0); PG8_BAR; PG8_MMA(0, 0, At, B0); PG8_MMA(0, 1, At, B1); PG8_BAR; PG8_SCHED;
            PG8_LDA(At, 1, 1); PG8_STAGEB(PG8_SB(1, 0), b3); PG8_STAGEB(PG8_SB(1, 1), b3 + hstep); PG8_STAGEA(PG8_SA(1, 0), a3, v2[0]);
            PG8_WAIT_V(8); PG8_WAIT_L(0); PG8_BAR; PG8_MMA(1, 0, At, B0); PG8_MMA(1, 1, At, B1); PG8_BAR; PG8_SCHED;
        }
        if (wr == 0) PG8_BAR;
        E(acc, cur, wr, wc, fr, fq);
        if (!has_next) break;
#pragma unroll
        for (int a = 0; a < 2; ++a)
#pragma unroll
            for (int b = 0; b < 2; ++b)
#pragma unroll
                for (int m = 0; m < 4; ++m)
#pragma unroll
                    for (int n = 0; n < 2; ++n) acc[a][b][m][n] = (f32x4){0.f, 0.f, 0.f, 0.f};
        cur = nxt; cB = nB; cA = nA; ++ui;
        if constexpr (Sched::GATHER) S.a_voff(cur, tid, va);
        if (wr == 1) PG8_BAR;
    }
    PG8_WAIT_V(0);
    PG8_BAR;
#undef PG8_SA
#undef PG8_SB
#undef PG8_STAGEA
#undef PG8_STAGEB
#undef PG8_LDA
#undef PG8_LDB
#undef PG8_MMA
#undef PG8_WAIT_V
#undef PG8_WAIT_L
#undef PG8_BAR
#undef PG8_SCHED
}

struct SchedDense {
    static constexpr bool GATHER = false;
    StaticOrder so; const char* A; const char* Bt; int K; int pad_;
    DEV bool next(int i, Unit& u) const { int pm, pn; if (!so.next(i, pm, pn)) return false; u.pm = pm; u.pn = pn; u.e = 0; u.slot = 0; return true; }
    DEV const char* a_ptr(const Unit& u) const { return A + (size_t)u.pm * 256 * K * 2; }
    DEV void a_voff(const Unit&, const int tid, unsigned (&vo)[2][2]) const {
#pragma unroll
        for (int i = 0; i < 2; ++i) { int R, C; stage_rc(tid * 16 + i * 8192, R, C); vo[0][i] = vo[1][i] = (unsigned)((R * K + C) * 2); }
    }
    DEV const char* b_ptr(const Unit& u) const { return Bt + (size_t)u.pn * 256 * K * 2; }
};
DEV bool moe_unit(int i, int NJ, int nrbt, int G, int c, Unit& u) {
    const int n = (nrbt + 64) * NJ; int L;
    if (G & 7) { L = i * G + c; if (L >= n) return false; }
    else { const int gq = G >> 3, per = (n + 7) >> 3, x = c & 7, q = c >> 3, j = i * gq + q; if (j >= per) return false; L = x * per + j; if (L >= n) return false; }
    int grb = L / NJ; const int pn = L - grb * NJ; if (grb >= nrbt) grb = SH_RB + (grb - nrbt);
    u.pm = grb; u.pn = pn; u.slot = i; u.e = 0; return true;
}
struct SchedGU {
    static constexpr bool GATHER = true;
    const char* A; const char* Wgu; const char* Wgus; const LAS int* eofrb; const LAS int* toks; int nrbt, G, c, pad_;
    DEV bool next(int i, Unit& u) const { if (!moe_unit(i, 2, nrbt, G, c, u)) return false; u.e = __builtin_amdgcn_readfirstlane(eofrb[u.pm]); return true; }
    DEV const char* a_ptr(const Unit&) const { return A; }
    DEV void a_voff(const Unit& u, const int tid, unsigned (&vo)[2][2]) const {
#pragma unroll
        for (int i = 0; i < 2; ++i) { int R, C; stage_rc(tid * 16 + i * 8192, R, C);
#pragma unroll
            for (int h = 0; h < 2; ++h) { const int tok = toks[u.slot * 256 + h * 128 + R]; vo[h][i] = (unsigned)((tok * D + C) * 2); } }
    }
    DEV const char* b_ptr(const Unit& u) const { return (u.e < NE ? Wgu + (size_t)u.e * 512 * D * 2 : Wgus) + (size_t)u.pn * 256 * D * 2; }
};
struct SchedDown {
    static constexpr bool GATHER = false;
    const char* A; const char* Wd; const char* Wds; const LAS int* eofrb; int nrbt, G, c, pad_;
    DEV bool next(int i, Unit& u) const { if (!moe_unit(i, 4, nrbt, G, c, u)) return false; u.e = __builtin_amdgcn_readfirstlane(eofrb[u.pm]); return true; }
    DEV const char* a_ptr(const Unit& u) const { return A + (size_t)u.pm * 256 * ED * 2; }
    DEV void a_voff(const Unit&, const int tid, unsigned (&vo)[2][2]) const {
#pragma unroll
        for (int i = 0; i < 2; ++i) { int R, C; stage_rc(tid * 16 + i * 8192, R, C); vo[0][i] = vo[1][i] = (unsigned)((R * ED + C) * 2); }
    }
    DEV const char* b_ptr(const Unit& u) const { return (u.e < NE ? Wd + (size_t)u.e * D * ED * 2 : Wds) + (size_t)u.pn * 256 * ED * 2; }
};

struct EpiProj {
    static constexpr bool PERM = true;
    bf16_t* qkv; bf16_t* za; bf16_t* xbc; bf16_t* zb; float* small;
    DEV void operator()(const f32x4 (&acc)[2][2][4][2], const Unit& u, int wr, int wc, int fr, int fq) const {
        const int row0 = u.pm * BM + wr * 64 + fr, pn = u.pn;
        if (pn == 26) {
            if (wc == 0) {
#pragma unroll
                for (int ai = 0; ai < 2; ++ai)
#pragma unroll
                    for (int m = 0; m < 4; ++m) { float* p = small + (size_t)(row0 + ai * HALF + m * 16) * 32 + 8 * fq; *(f32x4*)p = acc[ai][0][m][0]; *(f32x4*)(p + 4) = acc[ai][0][m][1]; }
            }
            return;
        }
        bf16_t* base; int ldc, ct;
        if (pn < 12) { base = qkv; ldc = 3072; ct = pn; } else if (pn < 16) { base = za; ldc = 1024; ct = pn - 12; } else if (pn < 22) { base = xbc; ldc = 1536; ct = pn - 16; } else { base = zb; ldc = 1024; ct = pn - 22; }
        const int col0 = ct * 256 + wc * 32 + 8 * fq;
#pragma unroll
        for (int ai = 0; ai < 2; ++ai)
#pragma unroll
            for (int m = 0; m < 4; ++m) { bf16_t* rowp = base + (size_t)(row0 + ai * HALF + m * 16) * ldc + col0;
#pragma unroll
                for (int bj = 0; bj < 2; ++bj) *(u32x4*)(rowp + bj * HALF) = pack8(acc[ai][bj][m][0], acc[ai][bj][m][1]); }
    }
};
struct EpiF32 {
    static constexpr bool PERM = false;
    float* Cp; int ldc; int pad_;
    DEV void operator()(const f32x4 (&acc)[2][2][4][2], const Unit& u, int wr, int wc, int fr, int fq) const {
        const int row0 = u.pm * BM + wr * 64 + fr, col0 = u.pn * BM + wc * 32 + 4 * fq;
#pragma unroll
        for (int ai = 0; ai < 2; ++ai)
#pragma unroll
            for (int m = 0; m < 4; ++m) { float* rowp = Cp + (size_t)(row0 + ai * HALF + m * 16) * ldc + col0;
#pragma unroll
                for (int bj = 0; bj < 2; ++bj)
#pragma unroll
                    for (int n = 0; n < 2; ++n) *(f32x4*)(rowp + bj * HALF + n * 16) = acc[ai][bj][m][n]; }
    }
};
struct EpiBf16 {
    static constexpr bool PERM = true;
    bf16_t* O; int ldc; int pad_;
    DEV void operator()(const f32x4 (&acc)[2][2][4][2], const Unit& u, int wr, int wc, int fr, int fq) const {
        const int row0 = u.pm * BM + wr * 64 + fr, col0 = u.pn * BM + wc * 32 + 8 * fq;
#pragma unroll
        for (int ai = 0; ai < 2; ++ai)
#pragma unroll
            for (int m = 0; m < 4; ++m) { bf16_t* rowp = O + (size_t)(row0 + ai * HALF + m * 16) * ldc + col0;
#pragma unroll
                for (int bj = 0; bj < 2; ++bj) *(u32x4*)(rowp + bj * HALF) = pack8(acc[ai][bj][m][0], acc[ai][bj][m][1]); }
    }
};
struct EpiFp8 {
    static constexpr bool PERM = true;
    unsigned char* O; int ldc; int pad_;
    DEV void operator()(const f32x4 (&acc)[2][2][4][2], const Unit& u, int wr, int wc, int fr, int fq) const {
        const int row0 = u.pm * BM + wr * 64 + fr, col0 = u.pn * BM + wc * 32 + 8 * fq;
#pragma unroll
        for (int ai = 0; ai < 2; ++ai)
#pragma unroll
            for (int m = 0; m < 4; ++m) { unsigned char* rowp = O + (size_t)(row0 + ai * HALF + m * 16) * ldc + col0;
#pragma unroll
                for (int bj = 0; bj < 2; ++bj) { const f32x4 a0 = acc[ai][bj][m][0] * 16.f, a1 = acc[ai][bj][m][1] * 16.f;
                    int w0 = __builtin_amdgcn_cvt_pk_fp8_f32(a0[0], a0[1], 0, false); w0 = __builtin_amdgcn_cvt_pk_fp8_f32(a0[2], a0[3], w0, true);
                    int w1 = __builtin_amdgcn_cvt_pk_fp8_f32(a1[0], a1[1], 0, false); w1 = __builtin_amdgcn_cvt_pk_fp8_f32(a1[2], a1[3], w1, true);
                    *(u32x2*)(rowp + bj * HALF) = (u32x2){(unsigned)w0, (unsigned)w1}; } }
    }
};
struct EpiGU {
    static constexpr bool PERM = true;
    bf16_t* H;
    DEV void operator()(const f32x4 (&acc)[2][2][4][2], const Unit& u, int wr, int wc, int fr, int fq) const {
        const int row0 = u.pm * BM + wr * 64 + fr, col0 = u.pn * HALF + wc * 32 + 8 * fq;
#pragma unroll
        for (int ai = 0; ai < 2; ++ai)
#pragma unroll
            for (int m = 0; m < 4; ++m) {
                f32x4 h0, h1;
#pragma unroll
                for (int i = 0; i < 4; ++i) { h0[i] = siluf(acc[ai][0][m][0][i]) * acc[ai][1][m][0][i]; h1[i] = siluf(acc[ai][0][m][1][i]) * acc[ai][1][m][1][i]; }
                *(u32x4*)(H + (size_t)(row0 + ai * HALF + m * 16) * ED + col0) = pack8(h0, h1);
            }
    }
};
struct EpiQKV {
    static constexpr bool PERM = true;
    bf16_t* O; const float* cosT; const float* sinT;
    DEV void operator()(const f32x4 (&acc)[2][2][4][2], const Unit& u, int wr, int wc, int fr, int fq) const {
        const int row0 = u.pm * BM + wr * 64 + fr, col0 = u.pn * BM + wc * 32 + 8 * fq;
        const bool rope = u.pn < 8; const float qs = u.pn < 4 ? 0.125f : 1.f;
#pragma unroll
        for (int ai = 0; ai < 2; ++ai)
#pragma unroll
            for (int m = 0; m < 4; ++m) {
                const int row = row0 + ai * HALF + m * 16;
                bf16_t* rowp = O + (size_t)row * 3072 + col0;
                if (rope) {
                    const f32x4 cs = *(const f32x4*)(cosT + (size_t)row * 32 + 16 * (wc & 1) + 4 * fq), sn = *(const f32x4*)(sinT + (size_t)row * 32 + 16 * (wc & 1) + 4 * fq);
#pragma unroll
                    for (int bj = 0; bj < 2; ++bj) { const f32x4 x1 = acc[ai][bj][m][0], x2 = acc[ai][bj][m][1];
                        *(u32x4*)(rowp + bj * HALF) = pack8((x1 * cs - x2 * sn) * qs, (x2 * cs + x1 * sn) * qs); }
                } else {
#pragma unroll
                    for (int bj = 0; bj < 2; ++bj) *(u32x4*)(rowp + bj * HALF) = pack8(acc[ai][bj][m][0], acc[ai][bj][m][1]);
                }
            }
    }
};
}

template <class SrcF>
DEV void conv_item(const SrcF& src, int ldw, int K, bf16_t* dst, LAS float* scr, int item, int nblk, int lane) {
    const int kb = item / nblk, nb = item - kb * nblk, k0 = 64 * kb, n0 = 32 * nb;
    const int quad = lane & 7, r0 = lane >> 3;
    const float* colp = src(n0 + 4 * quad);
    f32x4 v[8];
#pragma unroll
    for (int i = 0; i < 8; ++i) v[i] = colp ? *(const f32x4*)(colp + (size_t)(k0 + r0 + 8 * i) * ldw) : (f32x4){0.f, 0.f, 0.f, 0.f};
#pragma unroll
    for (int i = 0; i < 8; ++i) { LAS float* p = scr + (r0 + 8 * i) * 33 + 4 * quad; p[0] = v[i][0]; p[1] = v[i][1]; p[2] = v[i][2]; p[3] = v[i][3]; }
    LDS_WAIT(); asm volatile("" ::: "memory");
    const int c = lane & 7;
#pragma unroll
    for (int j = 0; j < 4; ++j) { const int n = (lane >> 3) + 8 * j; const LAS float* s = scr + (8 * c) * 33 + n;
        u32x4 o; o.x = pk2(s[0 * 33], s[1 * 33]); o.y = pk2(s[2 * 33], s[3 * 33]); o.z = pk2(s[4 * 33], s[5 * 33]); o.w = pk2(s[6 * 33], s[7 * 33]);
        *(u32x4*)(dst + (size_t)(n0 + n) * K + k0 + 8 * c) = o; }
    LDS_WAIT(); asm volatile("" ::: "memory");
}
struct SrcIdent { const float* W; DEV const float* operator()(int n) const { return W + n; } };
struct SrcWin { const float* W; DEV const float* operator()(int n) const {
    int s; if (n < 4096) s = n; else if (n < 5632) s = C_XBC + (n - 4096); else if (n < 6656) s = C_ZB + (n - 5632); else if (n < 6672) s = C_BETA + (n - 6656); else if (n < 6688) s = C_DT + (n - 6672); else return nullptr;
    return W + s; } };
struct SrcQKV { const float* W; DEV const float* operator()(int n) const {
    if (n >= 2048) return W + n; const int hd = n >> 6, cp = n & 63; return W + hd * 64 + 32 * ((cp >> 2) & 1) + 16 * (cp >> 5) + 4 * ((cp >> 3) & 3) + (cp & 3); } };
struct SrcGU { const float* Wg; long du; DEV const float* operator()(int r) const { const int j = r >> 8, rr = r & 255; return Wg + (rr < 128 ? 0l : du) + 128 * j + (rr & 127); } };

DEV void load_row(const float* p, int lane, float (&v)[16]) {
#pragma unroll
    for (int j = 0; j < 4; ++j) { const f32x4 t = *(const f32x4*)(p + j * 256 + lane * 4); v[4 * j] = t[0]; v[4 * j + 1] = t[1]; v[4 * j + 2] = t[2]; v[4 * j + 3] = t[3]; }
}
DEV void store_row(float* p, int lane, const float (&v)[16]) {
#pragma unroll
    for (int j = 0; j < 4; ++j) *(f32x4*)(p + j * 256 + lane * 4) = (f32x4){v[4 * j], v[4 * j + 1], v[4 * j + 2], v[4 * j + 3]};
}
DEV float row_rstd(const float (&v)[16]) { float ss = 0.f;
#pragma unroll
    for (int i = 0; i < 16; ++i) ss += v[i] * v[i];
    return rsqrtf(wave_sum(ss) * (1.f / D) + EPS); }
DEV void resid_update(float (&xv)[16], const float (&yv)[16], const float* gpost, const float* gt, int lane) {
    const float r = row_rstd(yv);
#pragma unroll
    for (int j = 0; j < 4; ++j) { const f32x4 g = *(const f32x4*)(gpost + j * 256 + lane * 4), t = *(const f32x4*)(gt + j * 256 + lane * 4);
#pragma unroll
        for (int i = 0; i < 4; ++i) xv[4 * j + i] += t[i] * (yv[4 * j + i] * r * g[i]); }
}
DEV void prenorm_pack(const float (&xv)[16], const float* gpre, const float* sc, const float* sh, int lane, u32x2 (&o)[4]) {
    const float r = row_rstd(xv);
#pragma unroll
    for (int j = 0; j < 4; ++j) { const f32x4 g = *(const f32x4*)(gpre + j * 256 + lane * 4), s = *(const f32x4*)(sc + j * 256 + lane * 4), b = *(const f32x4*)(sh + j * 256 + lane * 4);
        float h[4];
#pragma unroll
        for (int i = 0; i < 4; ++i) h[i] = xv[4 * j + i] * r * g[i] * (1.f + s[i]) + b[i];
        o[j] = (u32x2){pk2(h[0], h[1]), pk2(h[2], h[3])}; }
}

DEV void load_row8(const float* p, int lane, float (&v)[16]) {
#pragma unroll
    for (int j = 0; j < 2; ++j)
#pragma unroll
        for (int hh = 0; hh < 2; ++hh) { const f32x4 t = *(const f32x4*)(p + 512 * j + 8 * lane + 4 * hh); v[8 * j + 4 * hh] = t[0]; v[8 * j + 4 * hh + 1] = t[1]; v[8 * j + 4 * hh + 2] = t[2]; v[8 * j + 4 * hh + 3] = t[3]; }
}
DEV void store_row8(float* p, int lane, const float (&v)[16]) {
#pragma unroll
    for (int j = 0; j < 2; ++j)
#pragma unroll
        for (int hh = 0; hh < 2; ++hh) *(f32x4*)(p + 512 * j + 8 * lane + 4 * hh) = (f32x4){v[8 * j + 4 * hh], v[8 * j + 4 * hh + 1], v[8 * j + 4 * hh + 2], v[8 * j + 4 * hh + 3]};
}
DEV void resid_update8(float (&xv)[16], const float (&yv)[16], const float* gpost, const float* gt, int lane) {
    const float r = row_rstd(yv);
#pragma unroll
    for (int j = 0; j < 2; ++j)
#pragma unroll
        for (int hh = 0; hh < 2; ++hh) { const f32x4 g = *(const f32x4*)(gpost + 512 * j + 8 * lane + 4 * hh), t = *(const f32x4*)(gt + 512 * j + 8 * lane + 4 * hh);
#pragma unroll
            for (int i = 0; i < 4; ++i) xv[8 * j + 4 * hh + i] += t[i] * (yv[8 * j + 4 * hh + i] * r * g[i]); }
}
DEV void prenorm_pack8(const float (&xv)[16], const float* gpre, const float* sc, const float* sh, int lane, u32x4 (&o)[2]) {
    const float r = row_rstd(xv);
#pragma unroll
    for (int j = 0; j < 2; ++j) { float h[8];
#pragma unroll
        for (int hh = 0; hh < 2; ++hh) { const f32x4 g = *(const f32x4*)(gpre + 512 * j + 8 * lane + 4 * hh), s = *(const f32x4*)(sc + 512 * j + 8 * lane + 4 * hh), b = *(const f32x4*)(sh + 512 * j + 8 * lane + 4 * hh);
#pragma unroll
            for (int i = 0; i < 4; ++i) h[4 * hh + i] = xv[8 * j + 4 * hh + i] * r * g[i] * (1.f + s[i]) + b[i]; }
        o[j] = (u32x4){pk2(h[0], h[1]), pk2(h[2], h[3]), pk2(h[4], h[5]), pk2(h[6], h[7])}; }
}
DEV void acc_row8(float (&yv)[16], const u32x2 w0, const u32x2 w1, const float g) {
#pragma unroll
    for (int e = 0; e < 2; ++e) {
        yv[4 * e] += g * __builtin_amdgcn_cvt_f32_fp8((int)w0[e], 0); yv[4 * e + 1] += g * __builtin_amdgcn_cvt_f32_fp8((int)w0[e], 1); yv[4 * e + 2] += g * __builtin_amdgcn_cvt_f32_fp8((int)w0[e], 2); yv[4 * e + 3] += g * __builtin_amdgcn_cvt_f32_fp8((int)w0[e], 3);
        yv[8 + 4 * e] += g * __builtin_amdgcn_cvt_f32_fp8((int)w1[e], 0); yv[8 + 4 * e + 1] += g * __builtin_amdgcn_cvt_f32_fp8((int)w1[e], 1); yv[8 + 4 * e + 2] += g * __builtin_amdgcn_cvt_f32_fp8((int)w1[e], 2); yv[8 + 4 * e + 3] += g * __builtin_amdgcn_cvt_f32_fp8((int)w1[e], 3); }
}

struct Ctx { LAS unsigned char* lds; int tid, lane, wave, G, bid; };

DEV void ph_setup(const Args& a, const Ctx& X) {
    unsigned char* ws = a.ws;
    float* mod = (float*)(ws + WS_MOD);
    { LAS float* red = (LAS float*)X.lds;
      const int kc = X.tid >> 6, cl = X.tid & 63;
      for (int task = X.bid; task < 2 * 96; task += X.G) {
          const int l = task / 96, col = (task % 96) * 64 + cl;
          const float* w = a.mod_w + (size_t)l * D * 6 * D + col;
          float p0 = 0.f, p1 = 0.f, p2 = 0.f, p3 = 0.f;
          for (int k = kc * 128; k < kc * 128 + 128; ++k) { const float wv = w[(size_t)k * 6 * D];
              p0 += siluf(a.c[k]) * wv; p1 += siluf(a.c[D + k]) * wv; p2 += siluf(a.c[2 * D + k]) * wv; p3 += siluf(a.c[3 * D + k]) * wv; }
          __syncthreads();
          red[(kc * 4 + 0) * 64 + cl] = p0; red[(kc * 4 + 1) * 64 + cl] = p1; red[(kc * 4 + 2) * 64 + cl] = p2; red[(kc * 4 + 3) * 64 + cl] = p3;
          __syncthreads();
          if (X.tid < 256) { const int b = X.tid >> 6; float s = a.mod_b[l * 6 * D + col];
#pragma unroll
              for (int q = 0; q < 8; ++q) s += red[(q * 4 + b) * 64 + cl];
              mod[(size_t)(l * NB + b) * 6 * D + col] = s; }
      }
      __syncthreads(); }
    { float* cosT = (float*)(ws + WS_COS); float* sinT = (float*)(ws + WS_SIN);
      for (int idx = X.bid * NTHR + X.tid; idx < T * 32; idx += X.G * NTHR) { const int t = idx >> 5, i = idx & 31;
          const float ang = (float)a.pos[t] * powf(10000.f, -(float)i / 32.f); float sn, cs; sincosf(ang, &sn, &cs); cosT[idx] = cs; sinT[idx] = sn; } }
    { LAS float* scr = (LAS float*)(X.lds + X.wave * 8704);
      const int gw = X.bid * NWAVES + X.wave, NGW = X.G * NWAVES;
      constexpr int I_IN = (D / 64) * (NPROJ / 32), I_OUT = (2048 / 64) * (D / 32), I_QKV = (D / 64) * (3072 / 32), I_O = (D / 64) * (D / 32);
      for (int it = gw; it < I_IN + I_OUT + I_QKV + I_O; it += NGW) {
          int r = it;
          if (r < I_IN) { conv_item(SrcWin{a.ssm_w_in}, PROJ, D, (bf16_t*)(ws + WS_WIN), scr, r, NPROJ / 32, X.lane); continue; } r -= I_IN;
          if (r < I_OUT) { conv_item(SrcIdent{a.ssm_w_out}, D, 2048, (bf16_t*)(ws + WS_WOUT), scr, r, D / 32, X.lane); continue; } r -= I_OUT;
          if (r < I_QKV) { conv_item(SrcQKV{a.attn_w_qkv}, 3072, D, (bf16_t*)(ws + WS_WQKV), scr, r, 3072 / 32, X.lane); continue; } r -= I_QKV;
          conv_item(SrcIdent{a.attn_w_o}, D, D, (bf16_t*)(ws + WS_WO), scr, r, D / 32, X.lane);
      } }
}

DEV void ph_prenorm0(const Args& a, const Ctx& X) {
    const float* mod = (const float*)(a.ws + WS_MOD);
    bf16_t* hb = (bf16_t*)(a.ws + WS_H);
    for (int row = X.bid * NWAVES + X.wave; row < T; row += X.G * NWAVES) {
        const int b = row / SEQ; const float* ml = mod + (size_t)b * 6 * D;
        float xv[16]; load_row(a.x + (size_t)row * D, X.lane, xv);
        u32x2 o[4]; prenorm_pack(xv, a.mix_pre_g, ml + D, ml, X.lane, o);
#pragma unroll
        for (int j = 0; j < 4; ++j) *(u32x2*)(hb + (size_t)row * D + j * 256 + X.lane * 4) = o[j];
    }
}

DEV void ph_mix_prep(const Args& a, const Ctx& X) {
    const unsigned char* ws = a.ws;
    const bf16_t* qkvpre = (const bf16_t*)(ws + WS_QKVPRE); const bf16_t* xbcpre = (const bf16_t*)(ws + WS_XBCPRE); const float* small = (const float*)(ws + WS_SMALL);
    bf16_t* qkvn = (bf16_t*)(a.ws + WS_QKVN); float* gb = (float*)(a.ws + WS_GB); bf16_t* xbcc = (bf16_t*)(a.ws + WS_XBCC); float* dtb = (float*)(a.ws + WS_DTB);
    for (int wid = X.bid * NWAVES + X.wave; wid < T * 8; wid += X.G * NWAVES) {
        const int t = wid >> 3, h = wid & 7, s = t % SEQ, lane = X.lane;
        float vals[3][2];
#pragma unroll
        for (int part = 0; part < 3; ++part)
#pragma unroll
            for (int e = 0; e < 2; ++e) { const int c = part * 1024 + h * 128 + lane * 2 + e; float acc = 0.f;
#pragma unroll
                for (int i = 0; i < 4; ++i) { const int ss = s - 3 + i; if (ss >= 0) acc += a.gdn_conv_w[i * 3072 + c] * bf2f(qkvpre[(size_t)(t - 3 + i) * 3072 + c]); }
                vals[part][e] = siluf(acc); }
#pragma unroll
        for (int part = 0; part < 2; ++part) { const float ss = wave_sum(vals[part][0] * vals[part][0] + vals[part][1] * vals[part][1]); const float r = rsqrtf(ss + 1e-6f); vals[part][0] *= r; vals[part][1] *= r; }
#pragma unroll
        for (int part = 0; part < 3; ++part) *(unsigned*)(qkvn + (size_t)t * 3072 + part * 1024 + h * 128 + lane * 2) = pk2(vals[part][0], vals[part][1]);
        if (lane == 0) { const float beta = sigmoidf_(small[(size_t)t * 32 + h]); const float g = -__expf(a.gdn_a_log[h]) * softplusf(small[(size_t)t * 32 + 8 + h] + a.gdn_dt_bias[h]);
            gb[t * 16 + h] = g; gb[t * 16 + 8 + h] = beta; }
    }
}
DEV void ph_mix_seq(const Args& a, const Ctx& X) {
    const bf16_t* qkvn = (const bf16_t*)(a.ws + WS_QKVN); const float* gb = (const float*)(a.ws + WS_GB);
    const bf16_t* xbc = (const bf16_t*)(a.ws + WS_XBCC); const float* dtb = (const float*)(a.ws + WS_DTB);
    float* oraw = (float*)(a.ws + WS_ORAW); float* yraw = (float*)(a.ws + WS_YRAW);
    const int tid = X.tid;
    if (X.bid < 32) {
        LAS float* sk = (LAS float*)X.lds; LAS float* sq = sk + 16 * 128; LAS float* sv = sq + 16 * 128; LAS float* sa = sv + 16 * 128; LAS float* sbeta = sa + 16; LAS float* red = sbeta + 16;
        const int b = X.bid >> 3, h = X.bid & 7, v = tid & 127, kq = tid >> 7;
        float S[32];
#pragma unroll
        for (int i = 0; i < 32; ++i) S[i] = 0.f;
        const float scale = 0.08838834764831845f;
        for (int t0 = 0; t0 < SEQ; t0 += 16) {
            const size_t tb = (size_t)b * SEQ + t0;
            for (int idx = tid; idx < 16 * 384; idx += NTHR) { const int jj = idx / 384, c = idx % 384, part = c >> 7, cc = c & 127;
                const float val = bf2f(qkvn[(tb + jj) * 3072 + part * 1024 + h * 128 + cc]);
                if (part == 0) sq[jj * 128 + cc] = val; else if (part == 1) sk[jj * 128 + cc] = val; else sv[jj * 128 + cc] = val; }
            if (tid < 16) { sa[tid] = __expf(gb[(tb + tid) * 16 + h]); sbeta[tid] = gb[(tb + tid) * 16 + 8 + h]; }
            __syncthreads();
            for (int j = 0; j < 16; ++j) {
                const float al = sa[j], bt = sbeta[j]; float p = 0.f;
#pragma unroll
                for (int i = 0; i < 32; ++i) { S[i] *= al; p += sk[j * 128 + kq * 32 + i] * S[i]; }
                red[kq * 128 + v] = p;
                __syncthreads();
                const float kS = red[v] + red[128 + v] + red[256 + v] + red[384 + v];
                const float delta = bt * (sv[j * 128 + v] - kS); float po = 0.f;
#pragma unroll
                for (int i = 0; i < 32; ++i) { S[i] += sk[j * 128 + kq * 32 + i] * delta; po += sq[j * 128 + kq * 32 + i] * S[i]; }
                red[512 + kq * 128 + v] = po;
                __syncthreads();
                if (kq == 0) oraw[(tb + j) * 1024 + h * 128 + v] = (red[512 + v] + red[512 + 128 + v] + red[512 + 256 + v] + red[512 + 384 + v]) * scale;
            }
            __syncthreads();
        }
    }
}
DEV void ph_mix_post(const Args& a, const Ctx& X) {
    const float* oraw = (const float*)(a.ws + WS_ORAW); const float* yraw = (const float*)(a.ws + WS_YRAW);
    const bf16_t* za = (const bf16_t*)(a.ws + WS_ZA); const bf16_t* zb = (const bf16_t*)(a.ws + WS_ZB); bf16_t* oy = (bf16_t*)(a.ws + WS_OY);
    const int lane = X.lane;
    for (int wid = X.bid * NWAVES + X.wave; wid < T * 8; wid += X.G * NWAVES) {
        const int t = wid >> 3, h = wid & 7, c = h * 128 + lane * 2;
        const f32x2 o = *(const f32x2*)(oraw + (size_t)t * 1024 + c);
        const float r = rsqrtf(wave_sum(o.x * o.x + o.y * o.y) * (1.f / 128.f) + EPS);
        const float z0 = bf2f(za[(size_t)t * 1024 + c]), z1 = bf2f(za[(size_t)t * 1024 + c + 1]);
        *(unsigned*)(oy + (size_t)t * 2048 + c) = pk2(o.x * r * a.gdn_norm_w[lane * 2] * siluf(z0), o.y * r * a.gdn_norm_w[lane * 2 + 1] * siluf(z1));
    }
}

DEV bf16x8 acc_to_frag(const f32x4 lo, const f32x4 hi) { u32x4 w; w.x = pg8::cvt_pk_bf16(lo[0], lo[1]); w.y = pg8::cvt_pk_bf16(lo[2], lo[3]); w.z = pg8::cvt_pk_bf16(hi[0], hi[1]); w.w = pg8::cvt_pk_bf16(hi[2], hi[3]); return __builtin_bit_cast(bf16x8, w); }

DEV void gdn_solve(LAS float* M, LAS unsigned short* tf, const int lane) {
    M[lane] = (lane == 0) ? 1.f : 0.f;
    for (int i = 1; i < 64; ++i) {
        float acc = (lane == i) ? 1.f : 0.f;
        for (int j = 0; j < i; j += 4) { const f32x4 a4 = *(const LAS f32x4*)(M + i * 64 + j);
            acc -= a4[0] * M[j * 64 + lane]; acc -= a4[1] * M[(j + 1) * 64 + lane]; acc -= a4[2] * M[(j + 2) * 64 + lane]; acc -= a4[3] * M[(j + 3) * 64 + lane]; }
        M[i * 64 + lane] = acc;
    }
    const int cq = (lane >> 2) & 3, ca = (lane >> 4) & 1, ce = lane & 3, cks = lane >> 5;
    for (int i = 0; i < 64; ++i) tf[((i >> 4) * 2 + cks) * 512 + ((i & 15) + 16 * cq) * 8 + 4 * ca + ce] = (unsigned short)f2bf(M[i * 64 + lane]);
}
DEV void ph_gdn_local(const Args& a, const Ctx& X) {
    const bf16_t* qkvpre = (const bf16_t*)(a.ws + WS_QKVPRE); const float* small = (const float*)(a.ws + WS_SMALL);
    unsigned char* gi = a.ws + WS_GI; float* glast = (float*)(a.ws + WS_GLAST);
    constexpr int KP = 272;
    LAS unsigned char* kN = X.lds; LAS unsigned char* qN = X.lds + 64 * KP; LAS unsigned char* slots = X.lds + 128 * KP;
    LAS float* gcL = (LAS float*)(X.lds + AUX_OFF); LAS float* btL = gcL + 8 * 64;
    const int lane = X.lane, wave = X.wave, r16 = lane & 15, q4 = lane >> 4;
    const float scale = 0.08838834764831845f;
    for (int wu = X.bid; wu < NB * 64; wu += X.G) {
        const int b = wu >> 6, n = wu & 63; const size_t t0 = (size_t)b * SEQ + 64 * n;
        unsigned char* tmp = a.ws + WS_GTMP + (size_t)X.bid * 131072;
        __syncthreads();
        {
            const float g = -__expf(a.gdn_a_log[wave]) * softplusf(small[(t0 + lane) * 32 + 8 + wave] + a.gdn_dt_bias[wave]);
            float gc = g;
#pragma unroll
            for (int o = 1; o < 64; o <<= 1) { const float v = __shfl_up(gc, o); if (lane >= o) gc += v; }
            gcL[wave * 64 + lane] = gc; btL[wave * 64 + lane] = sigmoidf_(small[(t0 + lane) * 32 + wave]);
            if (lane == 63) glast[(size_t)((b * 8 + wave) * 64 + n) * 32] = gc;
        }
        __syncthreads();
        for (int bb = 0; bb < 2; ++bb) {
            for (int j = 0; j < 4; ++j) {
                const int h = bb * 4 + j; unsigned char* ub = gi + (size_t)((b * 8 + h) * 64 + n) * GI_UNIT;
                {
                    const float gl = gcL[h * 64 + 63];
                    const int blk = wave >> 2, pa = (wave & 3) >> 1, pq0 = 2 * (wave & 1);
                    const int ca = (2 * lane >> 4) & 1, cq = (2 * lane >> 2) & 3, ce = (2 * lane) & 3, cks = (2 * lane) >> 5;
#pragma unroll
                    for (int part = 0; part < 3; ++part) {
                        const int col = part * 1024 + h * 128 + 2 * lane;
                        float w0[4], w1[4];
#pragma unroll
                        for (int i = 0; i < 4; ++i) { const f32x2 t = *(const f32x2*)(a.gdn_conv_w + i * 3072 + col); w0[i] = t.x; w1[i] = t.y; }
                        float x0[11], x1[11];
#pragma unroll
                        for (int i = 0; i < 11; ++i) { const int tk = 8 * wave + i - 3; unsigned v = 0u; if (64 * n + tk >= 0) v = *(const unsigned*)(qkvpre + (t0 + tk) * 3072 + col); x0[i] = __uint_as_float(v << 16); x1[i] = __uint_as_float(v & 0xFFFF0000u); }
                        float v0[8], v1[8];
#pragma unroll
                        for (int i = 0; i < 8; ++i) { v0[i] = siluf(w0[0] * x0[i] + w0[1] * x0[i + 1] + w0[2] * x0[i + 2] + w0[3] * x0[i + 3]); v1[i] = siluf(w1[0] * x1[i] + w1[1] * x1[i + 1] + w1[2] * x1[i + 2] + w1[3] * x1[i + 3]); }
                        if (part < 2) {
#pragma unroll
                            for (int i = 0; i < 8; ++i) { const float r = rsqrtf(wave_sum(v0[i] * v0[i] + v1[i] * v1[i]) + 1e-6f); v0[i] *= r; v1[i] *= r; }
                        }
                        if (part == 0) {
#pragma unroll
                            for (int i = 0; i < 8; ++i) { const int tok = 8 * wave + i; const float eg = __expf(gcL[h * 64 + tok]) * scale;
                                *(LAS unsigned*)(qN + tok * KP + lane * 4) = pk2(v0[i], v1[i]);
                                *(unsigned*)(ub + 16384 + ((tok >> 4) * 4 + cks) * 1024 + ((tok & 15) + 16 * cq) * 16 + (4 * ca + ce) * 2) = pk2(v0[i] * eg, v1[i] * eg); }
                        } else if (part == 1) {
                            unsigned short kg0[8], kg1[8], ke0[8], ke1[8];
#pragma unroll
                            for (int i = 0; i < 8; ++i) { const int tok = 8 * wave + i; const float gc = gcL[h * 64 + tok], bt = btL[h * 64 + tok], eg = __expf(gc) * bt, eend = __expf(gl - gc);
                                *(LAS unsigned*)(kN + tok * KP + lane * 4) = pk2(v0[i], v1[i]);
                                kg0[i] = (unsigned short)f2bf(v0[i] * eg); kg1[i] = (unsigned short)f2bf(v1[i] * eg); ke0[i] = (unsigned short)f2bf(v0[i] * eend); ke1[i] = (unsigned short)f2bf(v1[i] * eend); }
#pragma unroll
                            for (int hf = 0; hf < 2; ++hf) { const int pos = 32 * blk + 8 * (pq0 + hf) + 4 * pa; const int cl = 2 * lane;
                                *(u32x2*)(tmp + (size_t)j * 32768 + 16384 + cl * 128 + pos * 2) = (u32x2){(unsigned)kg0[4 * hf] | ((unsigned)kg0[4 * hf + 1] << 16), (unsigned)kg0[4 * hf + 2] | ((unsigned)kg0[4 * hf + 3] << 16)};
                                *(u32x2*)(tmp + (size_t)j * 32768 + 16384 + (cl + 1) * 128 + pos * 2) = (u32x2){(unsigned)kg1[4 * hf] | ((unsigned)kg1[4 * hf + 1] << 16), (unsigned)kg1[4 * hf + 2] | ((unsigned)kg1[4 * hf + 3] << 16)};
                                *(u32x2*)(ub + 32768 + ((cl >> 4) * 2 + blk) * 1024 + ((cl & 15) + 16 * (pq0 + hf)) * 16 + (4 * pa) * 2) = (u32x2){(unsigned)ke0[4 * hf] | ((unsigned)ke0[4 * hf + 1] << 16), (unsigned)ke0[4 * hf + 2] | ((unsigned)ke0[4 * hf + 3] << 16)};
                                *(u32x2*)(ub + 32768 + (((cl + 1) >> 4) * 2 + blk) * 1024 + (((cl + 1) & 15) + 16 * (pq0 + hf)) * 16 + (4 * pa) * 2) = (u32x2){(unsigned)ke1[4 * hf] | ((unsigned)ke1[4 * hf + 1] << 16), (unsigned)ke1[4 * hf + 2] | ((unsigned)ke1[4 * hf + 3] << 16)}; }
                        } else {
                            unsigned short vb0[8], vb1[8];
#pragma unroll
                            for (int i = 0; i < 8; ++i) { const float bt = btL[h * 64 + 8 * wave + i]; vb0[i] = (unsigned short)f2bf(v0[i] * bt); vb1[i] = (unsigned short)f2bf(v1[i] * bt); }
#pragma unroll
                            for (int hf = 0; hf < 2; ++hf) { const int pos = 32 * blk + 8 * (pq0 + hf) + 4 * pa; const int cl = 2 * lane;
                                *(u32x2*)(tmp + (size_t)j * 32768 + cl * 128 + pos * 2) = (u32x2){(unsigned)vb0[4 * hf] | ((unsigned)vb0[4 * hf + 1] << 16), (unsigned)vb0[4 * hf + 2] | ((unsigned)vb0[4 * hf + 3] << 16)};
                                *(u32x2*)(tmp + (size_t)j * 32768 + (cl + 1) * 128 + pos * 2) = (u32x2){(unsigned)vb1[4 * hf] | ((unsigned)vb1[4 * hf + 1] << 16), (unsigned)vb1[4 * hf + 2] | ((unsigned)vb1[4 * hf + 3] << 16)}; }
                        }
                    }
                }
                __syncthreads();
                {
                    const int mat = wave >> 2, rt = wave & 3; LAS unsigned char* An = mat ? qN : kN;
                    bf16x8 af[4];
#pragma unroll
                    for (int ks = 0; ks < 4; ++ks) af[ks] = *(const LAS bf16x8*)(An + (16 * rt + r16) * KP + (32 * ks + 8 * q4) * 2);
                    LAS float* slot = (LAS float*)(slots + j * 16384);
#pragma unroll
                    for (int ct = 0; ct < 4; ++ct) { f32x4 acc = {0.f, 0.f, 0.f, 0.f};
#pragma unroll
                        for (int ks = 0; ks < 4; ++ks) { const bf16x8 bf = *(const LAS bf16x8*)(kN + (16 * ct + r16) * KP + (32 * ks + 8 * q4) * 2); acc = __builtin_amdgcn_mfma_f32_16x16x32_bf16(af[ks], bf, acc, 0, 0, 0); }
                        const int jc = 16 * ct + r16; const float gj = gcL[h * 64 + jc];
#pragma unroll
                        for (int rg = 0; rg < 4; ++rg) { const int i = 16 * rt + 4 * q4 + rg; const float dec = __expf(gcL[h * 64 + i] - gj);
                            if (mat == 0) { slot[i * 64 + jc] = jc < i ? btL[h * 64 + i] * acc[rg] * dec : 0.f; }
                            else { const float v = jc <= i ? acc[rg] * scale * dec : 0.f;
                                *(unsigned short*)(ub + 49152 + (rt * 2 + (ct >> 1)) * 1024 + ((4 * q4 + rg) + 16 * (r16 >> 2)) * 16 + (4 * (ct & 1) + (r16 & 3)) * 2) = (unsigned short)f2bf(v); } }
                    }
                }
                __syncthreads();
            }
            if (wave < 4) gdn_solve((LAS float*)(slots + wave * 16384), (LAS unsigned short*)(X.lds + wave * 8192), lane);
            VM_WAIT(); __syncthreads();
            for (int j = 0; j < 4; ++j) {
                const int h = bb * 4 + j; unsigned char* ub = gi + (size_t)((b * 8 + h) * 64 + n) * GI_UNIT;
                const int mat = wave >> 2; LAS unsigned char* slot = X.lds + j * 8192;
#pragma unroll
                for (int cx = 0; cx < 2; ++cx) { const int ct = 2 * (wave & 3) + cx;
                    bf16x8 bfr[2];
#pragma unroll
                    for (int ks = 0; ks < 2; ++ks) { const u32x4 t = __builtin_nontemporal_load((const u32x4*)(tmp + (size_t)j * 32768 + mat * 16384 + (16 * ct + r16) * 128 + (32 * ks + 8 * q4) * 2)); bfr[ks] = __builtin_bit_cast(bf16x8, t); }
#pragma unroll
                    for (int rt = 0; rt < 4; ++rt) { f32x4 acc = {0.f, 0.f, 0.f, 0.f};
#pragma unroll
                        for (int ks = 0; ks < 2; ++ks) { const bf16x8 tf = *(const LAS bf16x8*)(slot + (rt * 2 + ks) * 1024 + lane * 16); acc = __builtin_amdgcn_mfma_f32_16x16x32_bf16(tf, bfr[ks], acc, 0, 0, 0); }
                        if (mat == 0) *(u32x2*)(ub + 57344 + (rt * 8 + ct) * 512 + lane * 8) = (u32x2){pg8::cvt_pk_bf16(acc[0], acc[1]), pg8::cvt_pk_bf16(acc[2], acc[3])};
                        else {
#pragma unroll
                            for (int rg = 0; rg < 4; ++rg) *(unsigned short*)(ub + (rt * 4 + (ct >> 1)) * 1024 + ((4 * q4 + rg) + 16 * (r16 >> 2)) * 16 + (4 * (ct & 1) + (r16 & 3)) * 2) = (unsigned short)f2bf(-acc[rg]);
                        }
                    }
                }
            }
            __syncthreads();
        }
    }
}
DEV void ph_gdn_scan(const Args& a, const Ctx& X) {
    const unsigned char* gi = a.ws + WS_GI; const float* glast = (const float*)(a.ws + WS_GLAST);
    const bf16_t* za = (const bf16_t*)(a.ws + WS_ZA); bf16_t* oy = (bf16_t*)(a.ws + WS_OY);
    const int lane = X.lane, wave = X.wave, r16 = lane & 15, q4 = lane >> 4, tid = X.tid;
    LAS float* OT = (LAS float*)(X.lds + 114688);
    const int bh = X.bid, b = bh >> 3, h = bh & 7;
    const unsigned char* ubase = gi + (size_t)bh * 64 * GI_UNIT;
    f32x4 S[8];
#pragma unroll
    for (int i = 0; i < 8; ++i) S[i] = (f32x4){0.f, 0.f, 0.f, 0.f};
    float nwv[16];
#pragma unroll
    for (int i = 0; i < 16; ++i) nwv[i] = a.gdn_norm_w[16 * (tid & 7) + i];
#define GDN_STAGE(nn, buf) do { _Pragma("unroll") for (int _i = 0; _i < 7; ++_i) \
        __builtin_amdgcn_global_load_lds((const unsigned*)(ubase + (size_t)(nn) * GI_UNIT + (size_t)(tid + 512 * _i) * 16), (LAS unsigned*)(X.lds + (buf) * 57344 + (wave * 64 + 512 * _i) * 16), 16, 0, 0); } while (0)
    u32x2 udn[4]; float gln; u32x4 zn[2];
    { const size_t tz = (size_t)b * SEQ + (tid >> 3); zn[0] = *(const u32x4*)(za + tz * 1024 + h * 128 + 16 * (tid & 7)); zn[1] = *(const u32x4*)(za + tz * 1024 + h * 128 + 16 * (tid & 7) + 8); }
#pragma unroll
    for (int ct = 0; ct < 4; ++ct) udn[ct] = *(const u32x2*)(ubase + 57344 + (ct * 8 + wave) * 512 + lane * 8);
    gln = glast[(size_t)(bh * 64) * 32];
    GDN_STAGE(0, 0);
    for (int n = 0; n < 64; ++n) {
        VM_WAIT(); __syncthreads();
        f32x4 uf[4];
#pragma unroll
        for (int ct = 0; ct < 4; ++ct) { uf[ct][0] = __uint_as_float(udn[ct].x << 16); uf[ct][1] = __uint_as_float(udn[ct].x & 0xFFFF0000u); uf[ct][2] = __uint_as_float(udn[ct].y << 16); uf[ct][3] = __uint_as_float(udn[ct].y & 0xFFFF0000u); }
        const float egl = __expf(gln);
        u32x4 zc[2]; zc[0] = zn[0]; zc[1] = zn[1];
        asm volatile("" : "+v"(uf[0]), "+v"(uf[1]), "+v"(uf[2]), "+v"(uf[3]), "+v"(zc[0]), "+v"(zc[1]));
        if (n + 1 < 64) {
            const unsigned char* un = ubase + (size_t)(n + 1) * GI_UNIT;
#pragma unroll
            for (int ct = 0; ct < 4; ++ct) udn[ct] = *(const u32x2*)(un + 57344 + (ct * 8 + wave) * 512 + lane * 8);
            gln = glast[(size_t)(bh * 64 + n + 1) * 32];
            { const size_t tz = (size_t)b * SEQ + 64 * (n + 1) + (tid >> 3); zn[0] = *(const u32x4*)(za + tz * 1024 + h * 128 + 16 * (tid & 7)); zn[1] = *(const u32x4*)(za + tz * 1024 + h * 128 + 16 * (tid & 7) + 8); }
            GDN_STAGE(n + 1, (n + 1) & 1);
        }
        const LAS unsigned char* L = X.lds + (n & 1) * 57344;
        bf16x8 sB[4];
#pragma unroll
        for (int ks = 0; ks < 4; ++ks) sB[ks] = acc_to_frag(S[2 * ks], S[2 * ks + 1]);
        f32x4 vn[4], oo[4];
#pragma unroll
        for (int ct = 0; ct < 4; ++ct) { f32x4 acc = {0.f, 0.f, 0.f, 0.f}, ao = {0.f, 0.f, 0.f, 0.f};
#pragma unroll
            for (int ks = 0; ks < 4; ++ks) { const bf16x8 wf = *(const LAS bf16x8*)(L + (ct * 4 + ks) * 1024 + lane * 16), qf = *(const LAS bf16x8*)(L + 16384 + (ct * 4 + ks) * 1024 + lane * 16);
                acc = __builtin_amdgcn_mfma_f32_16x16x32_bf16(wf, sB[ks], acc, 0, 0, 0); ao = __builtin_amdgcn_mfma_f32_16x16x32_bf16(qf, sB[ks], ao, 0, 0, 0); }
            vn[ct] = acc; oo[ct] = ao; }
#pragma unroll
        for (int ct = 0; ct < 4; ++ct) vn[ct] = vn[ct] + uf[ct];
        bf16x8 vB[2];
#pragma unroll
        for (int ks = 0; ks < 2; ++ks) vB[ks] = acc_to_frag(vn[2 * ks], vn[2 * ks + 1]);
#pragma unroll
        for (int ct = 0; ct < 4; ++ct)
#pragma unroll
            for (int ks = 0; ks < 2; ++ks) { const bf16x8 kf = *(const LAS bf16x8*)(L + 49152 + (ct * 2 + ks) * 1024 + lane * 16); oo[ct] = __builtin_amdgcn_mfma_f32_16x16x32_bf16(kf, vB[ks], oo[ct], 0, 0, 0); }
#pragma unroll
        for (int dt = 0; dt < 8; ++dt) { f32x4 acc = S[dt] * egl;
#pragma unroll
            for (int ks = 0; ks < 2; ++ks) { const bf16x8 ef = *(const LAS bf16x8*)(L + 32768 + (dt * 2 + ks) * 1024 + lane * 16); acc = __builtin_amdgcn_mfma_f32_16x16x32_bf16(ef, vB[ks], acc, 0, 0, 0); }
            S[dt] = acc; }
#pragma unroll
        for (int ct = 0; ct < 4; ++ct)
#pragma unroll
            for (int rg = 0; rg < 4; ++rg) OT[(16 * ct + 4 * q4 + rg) * 132 + 16 * wave + r16] = oo[ct][rg];
        __syncthreads();
        {
            const int tok = tid >> 3, seg = tid & 7; const size_t t = (size_t)b * SEQ + 64 * n + tok;
            float ov[16]; float ss = 0.f;
#pragma unroll
            for (int i = 0; i < 4; ++i) { const f32x4 v = *(const LAS f32x4*)(OT + tok * 132 + 16 * seg + 4 * i); ov[4 * i] = v[0]; ov[4 * i + 1] = v[1]; ov[4 * i + 2] = v[2]; ov[4 * i + 3] = v[3]; ss += v[0] * v[0] + v[1] * v[1] + v[2] * v[2] + v[3] * v[3]; }
            ss += __shfl_xor(ss, 1); ss += __shfl_xor(ss, 2); ss += __shfl_xor(ss, 4);
            const float rstd = rsqrtf(ss * (1.f / 128.f) + EPS);
            u32x4 ow[2];
#pragma unroll
            for (int i = 0; i < 2; ++i)
#pragma unroll
                for (int e = 0; e < 4; ++e) { const unsigned zw = zc[i][e]; const float z0 = __uint_as_float(zw << 16), z1 = __uint_as_float(zw & 0xFFFF0000u);
                    ow[i][e] = pg8::cvt_pk_bf16(ov[8 * i + 2 * e] * rstd * nwv[8 * i + 2 * e] * siluf(z0), ov[8 * i + 2 * e + 1] * rstd * nwv[8 * i + 2 * e + 1] * siluf(z1)); }
            *(u32x4*)(oy + t * 2048 + h * 128 + 16 * seg) = ow[0]; *(u32x4*)(oy + t * 2048 + h * 128 + 16 * seg + 8) = ow[1];
        }
    }
#undef GDN_STAGE
}

constexpr int SP = 272;
DEV void ph_ssd_local(const Args& a, const Ctx& X) {
    const bf16_t* xbcpre = (const bf16_t*)(a.ws + WS_XBCPRE); const float* small = (const float*)(a.ws + WS_SMALL);
    bf16_t* CC = (bf16_t*)(a.ws + WS_CC); float* acum = (float*)(a.ws + WS_ACUM); float* cdec = (float*)(a.ws + WS_CDEC);
    bf16_t* ydiag = (bf16_t*)(a.ws + WS_YDIAG); bf16_t* states = (bf16_t*)(a.ws + WS_STATES);
    LAS unsigned char* Bn = X.lds; LAS unsigned char* Cn = X.lds + 128 * SP; LAS unsigned char* BT = X.lds + 256 * SP;
    LAS unsigned char* xdT = X.lds; LAS unsigned char* xeT = X.lds + 64 * SP;
    LAS float* acL = (LAS float*)(X.lds + AUX_OFF); LAS float* dtL = acL + 8 * 128;
    const int lane = X.lane, wave = X.wave, r16 = lane & 15, q4 = lane >> 4;
    for (int unit = X.bid; unit < NB * 32 * 2; unit += X.G) {
        const int g = unit & 1, c = (unit >> 1) & 31, b = unit >> 6; const size_t t0 = (size_t)b * SEQ + 128 * c;
        __syncthreads();
        {
            const int hd = g * 8 + wave; const float an = -__expf(a.ssd_a_log[hd]), bias = a.ssd_dt_bias[hd];
            const float d0 = softplusf(small[(t0 + lane) * 32 + 16 + hd] + bias), d1 = softplusf(small[(t0 + 64 + lane) * 32 + 16 + hd] + bias);
            float s0 = d0 * an, s1 = d1 * an;
#pragma unroll
            for (int o = 1; o < 64; o <<= 1) { const float v0 = __shfl_up(s0, o), v1 = __shfl_up(s1, o); if (lane >= o) { s0 += v0; s1 += v1; } }
            s1 += __shfl(s0, 63);
            acL[wave * 128 + lane] = s0; acL[wave * 128 + 64 + lane] = s1; dtL[wave * 128 + lane] = d0; dtL[wave * 128 + 64 + lane] = d1;
            acum[((size_t)g * T + t0 + lane) * 8 + wave] = s0; acum[((size_t)g * T + t0 + 64 + lane) * 8 + wave] = s1;
            if (lane == 63) cdec[(size_t)unit * 32 + wave] = __expf(s1);
        }
        {
            const int isC = lane >> 5, cc = (lane & 31) * 4, col = 1024 + isC * 256 + g * 128 + cc;
            float w[4][4], bs[4];
#pragma unroll
            for (int i = 0; i < 4; ++i) { const f32x4 t = *(const f32x4*)(a.ssd_conv_w + i * 1536 + col); w[i][0] = t[0]; w[i][1] = t[1]; w[i][2] = t[2]; w[i][3] = t[3]; }
            { const f32x4 t = *(const f32x4*)(a.ssd_conv_b + col); bs[0] = t[0]; bs[1] = t[1]; bs[2] = t[2]; bs[3] = t[3]; }
            float xin[19][4];
#pragma unroll
            for (int i = 0; i < 19; ++i) { const int tk = 16 * wave + i - 3; const bool ok = (128 * c + tk) >= 0; u32x2 v = {0u, 0u}; if (ok) v = *(const u32x2*)(xbcpre + (t0 + tk) * 1536 + col);
                xin[i][0] = __uint_as_float(v.x << 16); xin[i][1] = __uint_as_float(v.x & 0xFFFF0000u); xin[i][2] = __uint_as_float(v.y << 16); xin[i][3] = __uint_as_float(v.y & 0xFFFF0000u); }
            unsigned short ov[16][4];
#pragma unroll
            for (int i = 0; i < 16; ++i)
#pragma unroll
                for (int e = 0; e < 4; ++e) { const float s = bs[e] + w[0][e] * xin[i][e] + w[1][e] * xin[i + 1][e] + w[2][e] * xin[i + 2][e] + w[3][e] * xin[i + 3][e]; ov[i][e] = (unsigned short)f2bf(siluf(s)); }
            LAS unsigned char* nat = isC ? Cn : Bn;
#pragma unroll
            for (int i = 0; i < 16; ++i) { const u32x2 pk = {(unsigned)ov[i][0] | ((unsigned)ov[i][1] << 16), (unsigned)ov[i][2] | ((unsigned)ov[i][3] << 16)};
                *(LAS u32x2*)(nat + (16 * wave + i) * SP + cc * 2) = pk;
                if (isC) *(u32x2*)(CC + (t0 + 16 * wave + i) * 256 + g * 128 + cc) = pk; }
            if (!isC) {
#pragma unroll
                for (int e = 0; e < 4; ++e)
#pragma unroll
                    for (int qq = 0; qq < 4; ++qq) { const u32x2 pk = {(unsigned)ov[4 * qq][e] | ((unsigned)ov[4 * qq + 1][e] << 16), (unsigned)ov[4 * qq + 2][e] | ((unsigned)ov[4 * qq + 3][e] << 16)};
                        *(LAS u32x2*)(BT + (cc + e) * SP + (32 * (wave >> 1) + 8 * qq + 4 * (wave & 1)) * 2) = pk; }
            }
        }
        __syncthreads();
        f32x4 cbt[8];
        {
            bf16x8 cf[4];
#pragma unroll
            for (int ks = 0; ks < 4; ++ks) cf[ks] = *(const LAS bf16x8*)(Cn + (16 * wave + r16) * SP + (32 * ks + 8 * q4) * 2);
#pragma unroll
            for (int st = 0; st < 8; ++st) { cbt[st] = (f32x4){0.f, 0.f, 0.f, 0.f};
#pragma unroll
                for (int ks = 0; ks < 4; ++ks) { const bf16x8 bf = *(const LAS bf16x8*)(Bn + (16 * st + r16) * SP + (32 * ks + 8 * q4) * 2); cbt[st] = __builtin_amdgcn_mfma_f32_16x16x32_bf16(bf, cf[ks], cbt[st], 0, 0, 0); } }
        }
        __syncthreads();
        const int lq = 16 * wave + r16;
        for (int r = 0; r < 8; ++r) {
            const int hd = g * 8 + r; const float dd = a.ssd_d[hd];
            {
                const int col = hd * 64 + lane; float w0 = a.ssd_conv_w[col], w1 = a.ssd_conv_w[1536 + col], w2 = a.ssd_conv_w[2 * 1536 + col], w3 = a.ssd_conv_w[3 * 1536 + col]; const float bs = a.ssd_conv_b[col];
                float xin[19];
#pragma unroll
                for (int i = 0; i < 19; ++i) { const int tk = 16 * wave + i - 3; xin[i] = (128 * c + tk) >= 0 ? bf2f(xbcpre[(t0 + tk) * 1536 + col]) : 0.f; }
                const float aclast = acL[r * 128 + 127];
                unsigned short xd[16], xe[16];
#pragma unroll
                for (int i = 0; i < 16; ++i) { const float xv = siluf(bs + w0 * xin[i] + w1 * xin[i + 1] + w2 * xin[i + 2] + w3 * xin[i + 3]); const int tk = 16 * wave + i;
                    const float xdv = xv * dtL[r * 128 + tk]; xd[i] = (unsigned short)f2bf(xdv); xe[i] = (unsigned short)f2bf(xdv * __expf(aclast - acL[r * 128 + tk])); }
#pragma unroll
                for (int qq = 0; qq < 4; ++qq) { const int pos = 32 * (wave >> 1) + 8 * qq + 4 * (wave & 1);
                    *(LAS u32x2*)(xdT + lane * SP + pos * 2) = (u32x2){(unsigned)xd[4 * qq] | ((unsigned)xd[4 * qq + 1] << 16), (unsigned)xd[4 * qq + 2] | ((unsigned)xd[4 * qq + 3] << 16)};
                    *(LAS u32x2*)(xeT + lane * SP + pos * 2) = (u32x2){(unsigned)xe[4 * qq] | ((unsigned)xe[4 * qq + 1] << 16), (unsigned)xe[4 * qq + 2] | ((unsigned)xe[4 * qq + 3] << 16)}; }
            }
            __syncthreads();
            {
                const float acl = acL[r * 128 + lq], ddt = dd / dtL[r * 128 + lq];
                f32x4 yd[4];
#pragma unroll
                for (int pt = 0; pt < 4; ++pt) yd[pt] = (f32x4){0.f, 0.f, 0.f, 0.f};
#pragma unroll
                for (int ks = 0; ks < 4; ++ks) { if (ks <= (wave >> 1)) {
                    f32x4 mlo, mhi;
#pragma unroll
                    for (int e = 0; e < 4; ++e) {
                        const int s0 = 32 * ks + 4 * q4 + e, s1 = s0 + 16;
                        const float v0 = cbt[2 * ks][e], v1 = cbt[2 * ks + 1][e];
                        mlo[e] = s0 < lq ? v0 * __expf(acl - acL[r * 128 + s0]) : (s0 == lq ? v0 + ddt : 0.f);
                        mhi[e] = s1 < lq ? v1 * __expf(acl - acL[r * 128 + s1]) : (s1 == lq ? v1 + ddt : 0.f);
                    }
                    const bf16x8 mf = acc_to_frag(mlo, mhi);
#pragma unroll
                    for (int pt = 0; pt < 4; ++pt) { const bf16x8 xf = *(const LAS bf16x8*)(xdT + (16 * pt + r16) * SP + (32 * ks + 8 * q4) * 2); yd[pt] = __builtin_amdgcn_mfma_f32_16x16x32_bf16(xf, mf, yd[pt], 0, 0, 0); }
                } }
#pragma unroll
                for (int pt = 0; pt < 4; ++pt) *(u32x2*)(ydiag + (t0 + lq) * 1024 + hd * 64 + 16 * pt + 4 * q4) = (u32x2){pg8::cvt_pk_bf16(yd[pt][0], yd[pt][1]), pg8::cvt_pk_bf16(yd[pt][2], yd[pt][3])};
            }
            {
                bf16x8 bf[4];
#pragma unroll
                for (int ks = 0; ks < 4; ++ks) bf[ks] = *(const LAS bf16x8*)(BT + (16 * wave + r16) * SP + (32 * ks + 8 * q4) * 2);
                bf16_t* hp = states + ((size_t)(unit * 8 + r) * 64) * 128;
#pragma unroll
                for (int pt = 0; pt < 4; ++pt) { f32x4 st = {0.f, 0.f, 0.f, 0.f};
#pragma unroll
                    for (int ks = 0; ks < 4; ++ks) { const bf16x8 xf = *(const LAS bf16x8*)(xeT + (16 * pt + r16) * SP + (32 * ks + 8 * q4) * 2); st = __builtin_amdgcn_mfma_f32_16x16x32_bf16(bf[ks], xf, st, 0, 0, 0); }
                    *(u32x2*)(hp + (size_t)(16 * pt + r16) * 128 + 16 * wave + 4 * q4) = (u32x2){pg8::cvt_pk_bf16(st[0], st[1]), pg8::cvt_pk_bf16(st[2], st[3])}; }
            }
            __syncthreads();
        }
    }
}
DEV void ph_ssd_scan(const Args& a, const Ctx& X, const int wg0) {
    bf16_t* states = (bf16_t*)(a.ws + WS_STATES); const float* cdec = (const float*)(a.ws + WS_CDEC);
    for (int task = (X.bid - wg0) * NTHR + X.tid; task < NB * 16 * 64 * 32; task += (X.G - wg0) * NTHR) {
        const int n4 = task & 31, p = (task >> 5) & 63, hd = (task >> 11) & 15, b = task >> 15;
        float h0 = 0.f, h1 = 0.f, h2 = 0.f, h3 = 0.f;
        for (int c = 0; c < 32; ++c) {
            const int unit = (b * 32 + c) * 2 + (hd >> 3);
            u32x2* ptr = (u32x2*)(states + ((size_t)(unit * 8 + (hd & 7)) * 64 + p) * 128 + 4 * n4);
            const u32x2 sv = *ptr; const float dec = cdec[(size_t)unit * 32 + (hd & 7)];
            *ptr = (u32x2){pk2(h0, h1), pk2(h2, h3)};
            h0 = h0 * dec + __uint_as_float(sv.x << 16); h1 = h1 * dec + __uint_as_float(sv.x & 0xFFFF0000u); h2 = h2 * dec + __uint_as_float(sv.y << 16); h3 = h3 * dec + __uint_as_float(sv.y & 0xFFFF0000u);
        }
    }
}
DEV void ph_ssd_out(const Args& a, const Ctx& X, const int wg0) {
    const bf16_t* CC = (const bf16_t*)(a.ws + WS_CC); const float* acum = (const float*)(a.ws + WS_ACUM); const bf16_t* ydiag = (const bf16_t*)(a.ws + WS_YDIAG);
    const bf16_t* states = (const bf16_t*)(a.ws + WS_STATES); const bf16_t* zb = (const bf16_t*)(a.ws + WS_ZB); bf16_t* oy = (bf16_t*)(a.ws + WS_OY);
    const int lane = X.lane, wave = X.wave, r16 = lane & 15, q4 = lane >> 4;
    for (int unit = X.bid - wg0; unit < NB * 32 * 2; unit += X.G - wg0) {
        const int g = unit & 1, c = (unit >> 1) & 31, b = unit >> 6; const size_t t = (size_t)b * SEQ + 128 * c + 16 * wave + r16;
        bf16x8 cf[4];
#pragma unroll
        for (int ks = 0; ks < 4; ++ks) cf[ks] = *(const bf16x8*)(CC + t * 256 + g * 128 + 32 * ks + 8 * q4);
        float ss = 0.f;
        LAS u32x2* stash = (LAS u32x2*)(X.lds + wave * 16384);
        for (int r = 0; r < 8; ++r) {
            const int hd = g * 8 + r; const float eac = __expf(acum[((size_t)g * T + t) * 8 + r]);
            const bf16_t* hp = states + ((size_t)(unit * 8 + r) * 64) * 128;
#pragma unroll
            for (int pt = 0; pt < 4; ++pt) { f32x4 acc = {0.f, 0.f, 0.f, 0.f};
#pragma unroll
                for (int ks = 0; ks < 4; ++ks) { const bf16x8 hf = *(const bf16x8*)(hp + (size_t)(16 * pt + r16) * 128 + 32 * ks + 8 * q4); acc = __builtin_amdgcn_mfma_f32_16x16x32_bf16(hf, cf[ks], acc, 0, 0, 0); }
                const u32x2 yd = *(const u32x2*)(ydiag + t * 1024 + hd * 64 + 16 * pt + 4 * q4), zz = *(const u32x2*)(zb + t * 1024 + hd * 64 + 16 * pt + 4 * q4);
                f32x4 v; v[0] = acc[0] * eac + __uint_as_float(yd.x << 16); v[1] = acc[1] * eac + __uint_as_float(yd.x & 0xFFFF0000u); v[2] = acc[2] * eac + __uint_as_float(yd.y << 16); v[3] = acc[3] * eac + __uint_as_float(yd.y & 0xFFFF0000u);
                v[0] *= siluf(__uint_as_float(zz.x << 16)); v[1] *= siluf(__uint_as_float(zz.x & 0xFFFF0000u)); v[2] *= siluf(__uint_as_float(zz.y << 16)); v[3] *= siluf(__uint_as_float(zz.y & 0xFFFF0000u));
                ss += v[0] * v[0] + v[1] * v[1] + v[2] * v[2] + v[3] * v[3];
                stash[(r * 4 + pt) * 64 + lane] = (u32x2){pg8::cvt_pk_bf16(v[0], v[1]), pg8::cvt_pk_bf16(v[2], v[3])}; }
        }
        ss += __shfl_xor(ss, 16); ss += __shfl_xor(ss, 32);
        const float rstd = rsqrtf(ss * (1.f / 512.f) + EPS);
        for (int r = 0; r < 8; ++r)
#pragma unroll
            for (int pt = 0; pt < 4; ++pt) { const int cix = g * 512 + r * 64 + 16 * pt + 4 * q4; const f32x4 nw = *(const f32x4*)(a.ssd_norm_w + cix); const u32x2 w = stash[(r * 4 + pt) * 64 + lane];
                *(u32x2*)(oy + t * 2048 + 1024 + cix) = (u32x2){pg8::cvt_pk_bf16(__uint_as_float(w.x << 16) * rstd * nw[0], __uint_as_float(w.x & 0xFFFF0000u) * rstd * nw[1]), pg8::cvt_pk_bf16(__uint_as_float(w.y << 16) * rstd * nw[2], __uint_as_float(w.y & 0xFFFF0000u) * rstd * nw[3])}; }
    }
}

DEV void ph_attn_naive(const Args& a, const Ctx& X) {
    const bf16_t* qkv = (const bf16_t*)(a.ws + WS_Q1KV); bf16_t* o = (bf16_t*)(a.ws + WS_O1);
    const int lane = X.lane;
    for (int wid = X.bid * NWAVES + X.wave; wid < T * 16; wid += X.G * NWAVES) {
        const int t = wid >> 4, hh = wid & 15, s = t % SEQ;
        const float q = bf2f(qkv[(size_t)t * 3072 + hh * 64 + lane]);
        float m = -INFINITY, l = 0.f, acc = 0.f;
#pragma unroll
        for (int br = 0; br < 3; ++br) { const int d = br == 0 ? 1 : (br == 1 ? 4 : 16);
            for (int j = 0; j <= 128; ++j) { if (s - d * j < 0) break;
                const bf16_t* kr = qkv + (size_t)(t - d * j) * 3072 + 1024 + hh * 64;
                const float sc = wave_sum(q * bf2f(kr[lane]));
                const float mn = fmaxf(m, sc), al = __expf(m - mn), p = __expf(sc - mn);
                l = l * al + p; acc = acc * al + p * bf2f(kr[1024 + lane]); m = mn; } }
        o[(size_t)t * 1024 + hh * 64 + lane] = (bf16_t)f2bf(acc / l);
    }
}

DEV void ph_attn(const Args& a, const Ctx& X) {
    const bf16_t* qkv = (const bf16_t*)(a.ws + WS_Q1KV); bf16_t* po = (bf16_t*)(a.ws + WS_PO); float* plse = (float*)(a.ws + WS_PLSE); bf16_t* o = (bf16_t*)(a.ws + WS_O1);
    LAS unsigned char* vl = X.lds + X.wave * 12288;
    LAS unsigned char* kl = vl + 6144;
    const int lane = X.lane, q = lane & 31, h5 = lane >> 5;
    const int tr_off = ((lane & 15) >> 2) * 192 + (16 * ((lane >> 4) & 1) + 4 * (lane & 3)) * 2;
    const int prow = lane >> 3, pch = lane & 7;
    for (int unit = X.bid; unit < NB * 16 * 8; unit += X.G) {
        const int b = unit >> 7, hd = (unit >> 3) & 15, g = unit & 7;
        for (int tk = 0; tk < 6; ++tk) {
            const int br = tk >> 1, k = X.wave * 2 + (tk & 1);
            int d, r, i0;
            if (br == 0) { d = 1; r = 0; i0 = 512 * g + 32 * k; } else if (br == 1) { d = 4; r = k & 3; i0 = 128 * g + 32 * (k >> 2); } else { d = 16; r = k; i0 = 32 * g; }
            const size_t tq = (size_t)b * SEQ + (size_t)(i0 + q) * d + r;
#define ATT_LOAD(dst, j0_, coff) do { _Pragma("unroll") for (int _i = 0; _i < 4; ++_i) { const size_t _t = (size_t)b * SEQ + (size_t)((j0_) + 8 * _i + prow) * d + r; \
                dst[_i] = *(const u32x4*)(qkv + _t * 3072 + (coff) + hd * 64 + pch * 8); } } while (0)
            u32x4 kp[4], vp[4];
            ATT_LOAD(kp, i0, 0);
#pragma unroll
            for (int i = 0; i < 4; ++i) *(LAS u32x4*)(kl + (8 * i + prow) * 144 + pch * 16) = kp[i];
            ATT_LOAD(kp, i0, 1024); ATT_LOAD(vp, i0, 2048);
            bf16x8 qf[4];
#pragma unroll
            for (int s = 0; s < 4; ++s) qf[s] = *(const LAS bf16x8*)(kl + q * 144 + (16 * s + 8 * h5) * 2);
            LDS_WAIT();
            f32x16 oacc[2];
#pragma unroll
            for (int i = 0; i < 16; ++i) { oacc[0][i] = 0.f; oacc[1][i] = 0.f; }
            float m = -1e30f, l = 0.f;
            for (int kt = 4; kt >= 0; --kt) {
                const int jn = i0 - 128 + 32 * (kt - 1); const bool has_next = (kt > 0) && (jn >= 0);
#pragma unroll
                for (int i = 0; i < 4; ++i) { *(LAS u32x4*)(kl + (8 * i + prow) * 144 + pch * 16) = kp[i]; *(LAS u32x4*)(vl + (8 * i + prow) * 192 + pch * 16) = vp[i]; }
                if (has_next) { ATT_LOAD(kp, jn, 1024); ATT_LOAD(vp, jn, 2048); }
                f32x16 sacc;
#pragma unroll
                for (int i = 0; i < 16; ++i) sacc[i] = 0.f;
#pragma unroll
                for (int s = 0; s < 4; ++s) { const bf16x8 kf = *(const LAS bf16x8*)(kl + q * 144 + (16 * s + 8 * h5) * 2); sacc = __builtin_amdgcn_mfma_f32_32x32x16_bf16(kf, qf[s], sacc, 0, 0, 0); }
                if (kt == 4) {
#pragma unroll
                    for (int i = 0; i < 16; ++i) { const int kl_ = (i & 3) + 8 * (i >> 2) + 4 * h5; if (kl_ > q) sacc[i] = -1e30f; }
                } else if (kt == 0) {
#pragma unroll
                    for (int i = 0; i < 16; ++i) { const int kl_ = (i & 3) + 8 * (i >> 2) + 4 * h5; if (kl_ < q) sacc[i] = -1e30f; }
                }
                float mx = sacc[0];
#pragma unroll
                for (int i = 1; i < 16; ++i) mx = fmaxf(mx, sacc[i]);
                mx = fmaxf(mx, __shfl_xor(mx, 32));
                const float mn = fmaxf(m, mx), alpha = __expf(m - mn);
                float rs = 0.f;
#pragma unroll
                for (int i = 0; i < 16; ++i) { sacc[i] = __expf(sacc[i] - mn); rs += sacc[i]; }
                rs += __shfl_xor(rs, 32);
                l = l * alpha + rs; m = mn;
#pragma unroll
                for (int i = 0; i < 16; ++i) { oacc[0][i] *= alpha; oacc[1][i] *= alpha; }
                bf16x8 pf[2];
#pragma unroll
                for (int s = 0; s < 2; ++s) { u32x4 w; w.x = pg8::cvt_pk_bf16(sacc[8 * s], sacc[8 * s + 1]); w.y = pg8::cvt_pk_bf16(sacc[8 * s + 2], sacc[8 * s + 3]); w.z = pg8::cvt_pk_bf16(sacc[8 * s + 4], sacc[8 * s + 5]); w.w = pg8::cvt_pk_bf16(sacc[8 * s + 6], sacc[8 * s + 7]);
                    pf[s] = __builtin_bit_cast(bf16x8, w); }
#pragma unroll
                for (int dt = 0; dt < 2; ++dt)
#pragma unroll
                    for (int s = 0; s < 2; ++s) {
                        const s16x4 v0 = __builtin_amdgcn_ds_read_tr16_b64_v4i16((LAS s16x4*)(vl + (16 * s + 4 * h5) * 192 + dt * 64 + tr_off));
                        const s16x4 v1 = __builtin_amdgcn_ds_read_tr16_b64_v4i16((LAS s16x4*)(vl + (16 * s + 8 + 4 * h5) * 192 + dt * 64 + tr_off));
                        bf16x8 vf; vf[0] = v0[0]; vf[1] = v0[1]; vf[2] = v0[2]; vf[3] = v0[3]; vf[4] = v1[0]; vf[5] = v1[1]; vf[6] = v1[2]; vf[7] = v1[3];
                        oacc[dt] = __builtin_amdgcn_mfma_f32_32x32x16_bf16(vf, pf[s], oacc[dt], 0, 0, 0);
                    }
                LDS_WAIT();
                if (!has_next) break;
            }
#undef ATT_LOAD
            const float inv = 1.f / l;
            bf16_t* pr = po + ((size_t)br * T + tq) * 1024 + hd * 64;
#pragma unroll
            for (int dt = 0; dt < 2; ++dt)
#pragma unroll
                for (int gq = 0; gq < 4; ++gq) { u32x2 w; w.x = pg8::cvt_pk_bf16(oacc[dt][4 * gq] * inv, oacc[dt][4 * gq + 1] * inv); w.y = pg8::cvt_pk_bf16(oacc[dt][4 * gq + 2] * inv, oacc[dt][4 * gq + 3] * inv);
                    *(u32x2*)(pr + 32 * dt + 8 * gq + 4 * h5) = w; }
            if (h5 == 0) plse[((size_t)br * T + tq) * 16 + hd] = m + __logf(l);
        }
        VM_WAIT(); __syncthreads();
        {
            const size_t t = (size_t)b * SEQ + 512 * g + X.tid;
            const float l0 = plse[t * 16 + hd], l1 = plse[((size_t)T + t) * 16 + hd], l2 = plse[((size_t)2 * T + t) * 16 + hd];
            const float mx = fmaxf(l0, fmaxf(l1, l2)); float w0 = __expf(l0 - mx), w1 = __expf(l1 - mx), w2 = __expf(l2 - mx); const float wi = 1.f / (w0 + w1 + w2); w0 *= wi; w1 *= wi; w2 *= wi;
            const bf16_t* p0 = po + t * 1024 + hd * 64; const bf16_t* p1 = p0 + (size_t)T * 1024; const bf16_t* p2 = p1 + (size_t)T * 1024; bf16_t* orow = o + t * 1024 + hd * 64;
#pragma unroll
            for (int c = 0; c < 8; ++c) { const u32x4 x0 = *(const u32x4*)(p0 + 8 * c), x1 = *(const u32x4*)(p1 + 8 * c), x2 = *(const u32x4*)(p2 + 8 * c); u32x4 y;
#pragma unroll
                for (int e = 0; e < 4; ++e) { const float lo = w0 * __uint_as_float(x0[e] << 16) + w1 * __uint_as_float(x1[e] << 16) + w2 * __uint_as_float(x2[e] << 16);
                    const float hi = w0 * __uint_as_float(x0[e] & 0xFFFF0000u) + w1 * __uint_as_float(x1[e] & 0xFFFF0000u) + w2 * __uint_as_float(x2[e] & 0xFFFF0000u); y[e] = pk2(lo, hi); }
                *(u32x4*)(orow + 8 * c) = y; }
        }
    }
}

DEV void ph_router(const Args& a, const Ctx& X, const int l) {
    unsigned char* ws = a.ws;
    const float* mod = (const float*)(ws + WS_MOD) + (size_t)l * NB * 6 * D;
    const float* ymix = (const float*)(ws + WS_YMIX);
    const float* xin = (l == 0) ? a.x : a.out;
    bf16_t* hb = (bf16_t*)(ws + WS_H);
    int* idx = (int*)(ws + WS_IDX); float* gw = (float*)(ws + WS_GW); int* aslot = (int*)(ws + WS_ASLOT); int* ltok = (int*)(ws + WS_LTOK);
    int* cntg = (int*)(ws + WS_CTL + CTL_CNT) + l * NE;
    const float* rw = a.router_w + (size_t)l * D * NE; const float* rbias = a.router_bias + l * NE;
    constexpr int HP = 2064;
    LAS unsigned char* hL = X.lds;
    LAS float* logit = (LAS float*)(X.lds + AUX_OFF + 2048);
    LAS int* lcnt = (LAS int*)(X.lds + AUX_OFF + 2048 + 64 * 65 * 4);
    LAS int* lbase = lcnt + 64;
    LAS int* sel_e = lbase + 64;
    LAS int* sel_s = sel_e + 512;
    const int lane = X.lane, wave = X.wave;
    for (int rb = X.bid; rb < T / 64; rb += X.G) {
        if (X.tid < 64) lcnt[X.tid] = 0;
        for (int r8 = 0; r8 < 8; ++r8) {
            const int lr = wave * 8 + r8, row = rb * 64 + lr, b = row / SEQ; const float* ml = mod + (size_t)b * 6 * D;
            float xv[16], yv[16]; load_row(xin + (size_t)row * D, lane, xv); load_row(ymix + (size_t)row * D, lane, yv);
            resid_update(xv, yv, a.mix_post_g + l * D, ml + 2 * D, lane);
            store_row(a.out + (size_t)row * D, lane, xv);
            u32x2 o[4]; prenorm_pack(xv, a.ffn_pre_g + l * D, ml + 4 * D, ml + 3 * D, lane, o);
#pragma unroll
            for (int j = 0; j < 4; ++j) { *(u32x2*)(hb + (size_t)row * D + j * 256 + lane * 4) = o[j]; *(LAS u32x2*)(hL + lr * HP + (j * 256 + lane * 4) * 2) = o[j]; }
        }
        __syncthreads();
        { const int rt = wave & 3, nh = wave >> 2, r16 = lane & 15, kq = lane >> 4;
          f32x4 acc0 = {0.f, 0.f, 0.f, 0.f}, acc1 = {0.f, 0.f, 0.f, 0.f};
          for (int c = 0; c < 32; ++c) {
              const u32x4 hv = *(const LAS u32x4*)(hL + (rt * 16 + r16) * HP + (32 * c + 8 * kq) * 2);
              const float* rp = rw + (size_t)(32 * c + 8 * kq) * NE + 4 * r16 + 2 * nh;
#pragma unroll
              for (int j = 0; j < 8; ++j) { const unsigned wj = hv[j >> 1]; const float av = (j & 1) ? __uint_as_float(wj & 0xFFFF0000u) : __uint_as_float(wj << 16);
                  const f32x2 bv = *(const f32x2*)(rp + (size_t)j * NE);
                  acc0 = __builtin_amdgcn_mfma_f32_16x16x4f32(av, bv.x, acc0, 0, 0, 0); acc1 = __builtin_amdgcn_mfma_f32_16x16x4f32(av, bv.y, acc1, 0, 0, 0); }
          }
#pragma unroll
          for (int r = 0; r < 4; ++r) { logit[(rt * 16 + 4 * kq + r) * 65 + 4 * r16 + 2 * nh] = acc0[r]; logit[(rt * 16 + 4 * kq + r) * 65 + 4 * r16 + 2 * nh + 1] = acc1[r]; } }
        __syncthreads();
        for (int r8 = 0; r8 < 8; ++r8) {
            const int lr = wave * 8 + r8, t = rb * 64 + lr;
            float lgt = logit[lr * 65 + lane]; if (!(lgt > -1e30f && lgt < 1e30f)) lgt = 0.f;
            const float score = sigmoidf_(lgt), biased = score + rbias[lane];
            float m1 = biased;
#pragma unroll
            for (int o = 1; o < 8; o <<= 1) m1 = fmaxf(m1, __shfl_xor(m1, o));
            int c1 = (biased == m1) ? (lane & 7) : 8;
#pragma unroll
            for (int o = 1; o < 8; o <<= 1) c1 = min(c1, __shfl_xor(c1, o));
            float m2 = ((lane & 7) == c1) ? -INFINITY : biased;
#pragma unroll
            for (int o = 1; o < 8; o <<= 1) m2 = fmaxf(m2, __shfl_xor(m2, o));
            const float gs = m1 + m2; const int myg = lane >> 3; int grank = 0;
#pragma unroll
            for (int g2 = 0; g2 < 8; ++g2) { const float o = __shfl(gs, g2 * 8); grank += (o > gs || (o == gs && g2 < myg)) ? 1 : 0; }
            const float cand = (grank < 4) ? biased : -INFINITY; int rank = 0;
            for (int e2 = 0; e2 < 64; ++e2) { const float o = __shfl(cand, e2); rank += (o > cand || (o == cand && e2 < lane)) ? 1 : 0; }
            const bool sel = (rank < TOPK) && (grank < 4);
            const float ssum = wave_sum(sel ? score : 0.f);
            if (sel) { idx[t * 8 + rank] = lane; gw[t * 8 + rank] = score / ssum * 2.5f; sel_e[lr * 8 + rank] = lane; sel_s[lr * 8 + rank] = __hip_atomic_fetch_add(lcnt + lane, 1, __ATOMIC_RELAXED, __HIP_MEMORY_SCOPE_WORKGROUP); }
        }
        __syncthreads();
        if (X.tid < 64) { const int n = lcnt[X.tid]; lbase[X.tid] = n ? atomicAdd(cntg + X.tid, n) : 0; }
        __syncthreads();
        { const int lr = X.tid >> 3, k = X.tid & 7, t = rb * 64 + lr, e = sel_e[lr * 8 + k], sl = lbase[e] + sel_s[lr * 8 + k];
          aslot[t * 8 + k] = sl; ltok[e * CAP + sl] = t; }
        __syncthreads();
    }
}
DEV void ph_moe_conv(const Args& a, const Ctx& X, const int l, const int wg0) {
    unsigned char* ws = a.ws;
    { LAS float* scr = (LAS float*)(X.lds + X.wave * 8704);
      const int gwv = (X.bid - wg0) * NWAVES + X.wave, NGW = (X.G - wg0) * NWAVES;
      constexpr int I_GU = (D / 64) * (512 / 32), I_D = (ED / 64) * (D / 32), I_E = I_GU + I_D;
      const float* eg = a.exp_gate + (size_t)l * NE * D * ED; const float* eu = a.exp_up + (size_t)l * NE * D * ED; const float* ed = a.exp_down + (size_t)l * NE * ED * D;
      for (int it = gwv; it < (NE + 1) * I_E; it += NGW) {
          const int e = it / I_E; int r = it - e * I_E;
          if (e < NE) {
              if (r < I_GU) conv_item(SrcGU{eg + (size_t)e * D * ED, (long)(eu - eg)}, ED, D, (bf16_t*)(ws + WS_WGU) + (size_t)e * 512 * D, scr, r, 16, X.lane);
              else conv_item(SrcIdent{ed + (size_t)e * ED * D}, D, ED, (bf16_t*)(ws + WS_WD) + (size_t)e * D * ED, scr, r - I_GU, D / 32, X.lane);
          } else {
              if (r < I_GU) conv_item(SrcGU{a.sh_gate + (size_t)l * D * ED, (long)(a.sh_up - a.sh_gate)}, ED, D, (bf16_t*)(ws + WS_WGUS), scr, r, 16, X.lane);
              else conv_item(SrcIdent{a.sh_down + (size_t)l * ED * D}, D, ED, (bf16_t*)(ws + WS_WDS), scr, r - I_GU, D / 32, X.lane);
          }
      } }
}

DEV int moe_tables(const Args& a, const Ctx& X, const int l, LAS int* t_cnt, LAS int* t_rb0, LAS int* t_eofrb) {
    const int* cntg = (const int*)(a.ws + WS_CTL + CTL_CNT) + l * NE;
    if (X.wave == 0) {
        const int c = __hip_atomic_load(cntg + X.lane, __ATOMIC_RELAXED, __HIP_MEMORY_SCOPE_AGENT), nrb = (c + 255) >> 8;
        int incl = nrb;
#pragma unroll
        for (int o = 1; o < 64; o <<= 1) { const int v = __shfl_up(incl, o); if (X.lane >= o) incl += v; }
        const int excl = incl - nrb;
        t_cnt[X.lane] = c; t_rb0[X.lane] = excl; if (X.lane == 63) t_rb0[64] = incl;
        for (int j = 0; j < nrb; ++j) t_eofrb[excl + j] = X.lane;
        t_eofrb[SH_RB + X.lane] = NE;
    }
    __syncthreads();
    return t_rb0[64];
}

DEV void ph_moe_gu(const Args& a, const Ctx& X, const int l) {
    LAS int* t_cnt = (LAS int*)(X.lds + AUX_OFF + 1024); LAS int* t_rb0 = t_cnt + 64; LAS int* t_eofrb = t_rb0 + 80; LAS int* toks = t_eofrb + NRB_ALL;
    const int nrbt = moe_tables(a, X, l, t_cnt, t_rb0, t_eofrb);
    const int* ltok = (const int*)(a.ws + WS_LTOK);
    pg8::Unit u;
    for (int i = 0; i < 8; ++i) { if (!pg8::moe_unit(i, 2, nrbt, X.G, X.bid, u)) break;
        if (X.tid < 256) { const int e = t_eofrb[u.pm]; int tok;
            if (e < NE) { const int sl = (u.pm - t_rb0[e]) * 256 + X.tid; tok = sl < t_cnt[e] ? ltok[e * CAP + sl] : 0; } else tok = (u.pm - SH_RB) * 256 + X.tid;
            toks[i * 256 + X.tid] = tok; } }
    VM_WAIT(); __syncthreads();
    pg8::SchedGU S{(const char*)(a.ws + WS_H), (const char*)(a.ws + WS_WGU), (const char*)(a.ws + WS_WGUS), t_eofrb, toks, nrbt, X.G, X.bid, 0};
    pg8::EpiGU E{(bf16_t*)(a.ws + WS_HID)};
    pg8::gemm_phase<pg8::EpiGU, pg8::SchedGU>(X.lds, D, S, E);
}
DEV void ph_moe_down(const Args& a, const Ctx& X, const int l) {
    LAS int* t_cnt = (LAS int*)(X.lds + AUX_OFF + 1024); LAS int* t_rb0 = t_cnt + 64; LAS int* t_eofrb = t_rb0 + 80;
    const int nrbt = moe_tables(a, X, l, t_cnt, t_rb0, t_eofrb);
    pg8::SchedDown S{(const char*)(a.ws + WS_HID), (const char*)(a.ws + WS_WD), (const char*)(a.ws + WS_WDS), t_eofrb, nrbt, X.G, X.bid, 0};
    pg8::EpiFp8 E{(unsigned char*)(a.ws + WS_Y), D, 0};
    int kd = ED; asm volatile("" : "+s"(kd));
    pg8::gemm_phase<pg8::EpiFp8, pg8::SchedDown>(X.lds, kd, S, E);
}
DEV void ph_combine(const Args& a, const Ctx& X, const int l) {
    LAS int* t_cnt = (LAS int*)(X.lds + AUX_OFF + 1024); LAS int* t_rb0 = t_cnt + 64; LAS int* t_eofrb = t_rb0 + 80;
    (void)moe_tables(a, X, l, t_cnt, t_rb0, t_eofrb);
    const float* mod = (const float*)(a.ws + WS_MOD);
    const int* idx = (const int*)(a.ws + WS_IDX); const float* gw = (const float*)(a.ws + WS_GW); const int* aslot = (const int*)(a.ws + WS_ASLOT);
    const unsigned char* y = a.ws + WS_Y; bf16_t* hb = (bf16_t*)(a.ws + WS_H);
    const int lane = X.lane;
    const int tstep = X.G * NWAVES;
    int t = X.bid * NWAVES + X.wave;
    int e_n = 0, s_n = 0; float g_n = 0.f;
    if (t < T && lane < 8) { e_n = idx[t * 8 + lane]; g_n = gw[t * 8 + lane]; s_n = aslot[t * 8 + lane]; }
    for (; t < T; t += tstep) {
        const int b = t / SEQ; const float* ml = mod + (size_t)(l * NB + b) * 6 * D;
        const int e_c = e_n, s_c = s_n; const float g_c = g_n;
        const int tn = t + tstep;
        if (tn < T && lane < 8) { e_n = idx[tn * 8 + lane]; g_n = gw[tn * 8 + lane]; s_n = aslot[tn * 8 + lane]; }
        u32x2 w0[9], w1[9];
        { const unsigned char* yr = y + ((size_t)SH_RB * 256 + t) * D; w0[8] = *(const u32x2*)(yr + 8 * lane); w1[8] = *(const u32x2*)(yr + 512 + 8 * lane); }
        float gk[8];
#pragma unroll
        for (int k = 0; k < 8; ++k) { const int e = __shfl(e_c, k), sl = __shfl(s_c, k); gk[k] = __shfl(g_c, k);
            const unsigned char* yr = y + ((size_t)t_rb0[e] * 256 + sl) * D; w0[k] = *(const u32x2*)(yr + 8 * lane); w1[k] = *(const u32x2*)(yr + 512 + 8 * lane); }
        float xv[16]; load_row8(a.out + (size_t)t * D, lane, xv);
        float yv[16];
#pragma unroll
        for (int i = 0; i < 16; ++i) yv[i] = 0.f;
        acc_row8(yv, w0[8], w1[8], 0.0625f);
#pragma unroll
        for (int k = 0; k < 8; ++k) acc_row8(yv, w0[k], w1[k], gk[k] * 0.0625f);
        resid_update8(xv, yv, a.ffn_post_g + l * D, ml + 5 * D, lane);
        store_row8(a.out + (size_t)t * D, lane, xv);
        if (l == 0) { const float* mn = mod + (size_t)(1 * NB + b) * 6 * D; u32x4 o[2]; prenorm_pack8(xv, a.mix_pre_g + D, mn + D, mn, lane, o);
            *(u32x4*)(hb + (size_t)t * D + 8 * lane) = o[0]; *(u32x4*)(hb + (size_t)t * D + 512 + 8 * lane) = o[1]; }
    }
}

constexpr int NPH = 18;
__global__ void __launch_bounds__(NTHR, 2) mega(Args a) {
    extern __shared__ __attribute__((aligned(16))) unsigned char lds_raw[];
    Ctx X; X.lds = (LAS unsigned char*)lds_raw; X.tid = threadIdx.x; X.lane = X.tid & 63; X.wave = __builtin_amdgcn_readfirstlane(X.tid >> 6); X.G = gridDim.x; X.bid = blockIdx.x;
    if (X.tid < 4) ((LAS unsigned*)(X.lds + BAR_OFF))[X.tid] = 0u;
    __syncthreads();
    XcdBarrier bar; bar.bar = (unsigned*)(a.ws + WS_CTL); bar.x = 0; bar.st = nullptr;
    if (!MK_PER_PHASE) bar = xcd_barrier_post((unsigned*)(a.ws + WS_CTL), (volatile LAS unsigned*)(X.lds + BAR_OFF));
    const int lo = a.ph_lo, hi = a.ph_hi;
#define IN(k) (lo <= (k) && (k) < hi)
#define REP(k, ...) do { __VA_ARGS__; if constexpr (((PROBE_MASK >> (k)) & 1u) != 0u) { __syncthreads(); __VA_ARGS__; } } while (0)
#define SEAM(k) do { if (IN(k) && IN((k) + 1)) xcd_barrier(bar); else { VM_WAIT(); __syncthreads(); } } while (0)
    unsigned char* ws = a.ws;
    if (IN(0)) { REP(0, ph_setup(a, X)); SEAM(0); }
    if (IN(1)) { REP(1, ph_prenorm0(a, X)); SEAM(1); }
    if (IN(2)) {
        pg8::SchedDense S; S.so.init(T, NPROJ, X.G, X.bid); S.A = (const char*)(ws + WS_H); S.Bt = (const char*)(ws + WS_WIN); S.K = D; S.pad_ = 0;
        pg8::EpiProj E{(bf16_t*)(ws + WS_QKVPRE), (bf16_t*)(ws + WS_ZA), (bf16_t*)(ws + WS_XBCPRE), (bf16_t*)(ws + WS_ZB), (float*)(ws + WS_SMALL)};
        REP(2, pg8::gemm_phase<pg8::EpiProj, pg8::SchedDense>(X.lds, D, S, E)); SEAM(2); }
    if (IN(3)) { REP(3, ph_gdn_local(a, X)); REP(20, ph_ssd_local(a, X)); SEAM(3); }
    if (IN(4)) {
        if (X.bid < 32) { REP(4, ph_gdn_scan(a, X)); }
        else { ph_ssd_scan(a, X, 32); group_barrier((unsigned*)(ws + WS_CTL + CTL_GRP), (unsigned)(X.G - 32)); __syncthreads(); ph_ssd_out(a, X, 32); __syncthreads(); ph_moe_conv(a, X, 0, 32); }
        SEAM(4); }
    if (IN(6)) {
        pg8::SchedDense S; S.so.init(T, D, X.G, X.bid); S.A = (const char*)(ws + WS_OY); S.Bt = (const char*)(ws + WS_WOUT); S.K = 2048; S.pad_ = 0;
        pg8::EpiF32 E{(float*)(ws + WS_YMIX), D, 0};
        REP(6, pg8::gemm_phase<pg8::EpiF32, pg8::SchedDense>(X.lds, 2048, S, E)); SEAM(6); }
    if (IN(7)) { ph_router(a, X, 0); SEAM(7); }
    if (IN(8)) { REP(8, ph_moe_gu(a, X, 0)); SEAM(8); }
    if (IN(9)) { REP(9, ph_moe_down(a, X, 0)); SEAM(9); }
    if (IN(10)) { ph_combine(a, X, 0); SEAM(10); }
    if (IN(11)) {
        pg8::SchedDense S; S.so.init(T, 3072, X.G, X.bid); S.A = (const char*)(ws + WS_H); S.Bt = (const char*)(ws + WS_WQKV); S.K = D; S.pad_ = 0;
        pg8::EpiQKV E{(bf16_t*)(ws + WS_Q1KV), (const float*)(ws + WS_COS), (const float*)(ws + WS_SIN)};
        REP(11, pg8::gemm_phase<pg8::EpiQKV, pg8::SchedDense>(X.lds, D, S, E)); SEAM(11); }
    if (IN(12)) { REP(12, ph_attn(a, X)); SEAM(12); }
    if (IN(13)) {
        pg8::SchedDense S; S.so.init(T, D, X.G, X.bid); S.A = (const char*)(ws + WS_O1); S.Bt = (const char*)(ws + WS_WO); S.K = D; S.pad_ = 0;
        pg8::EpiF32 E{(float*)(ws + WS_YMIX), D, 0};
        REP(13, pg8::gemm_phase<pg8::EpiF32, pg8::SchedDense>(X.lds, D, S, E)); SEAM(13); }
    if (IN(14)) { ph_router(a, X, 1); REP(14, ph_moe_conv(a, X, 1, 0)); SEAM(14); }
    if (IN(15)) { ph_moe_gu(a, X, 1); SEAM(15); }
    if (IN(16)) { ph_moe_down(a, X, 1); SEAM(16); }
    if (IN(17)) { ph_combine(a, X, 1); }
#undef IN
#undef SEAM
}

extern "C" void kernel_launch(void* const* d_in, const int* in_sizes, int n_in, void* d_out, int out_size, void* d_ws, size_t ws_size, hipStream_t stream) {
    static int grid = 0;
    if (!grid) {
        int dev = 0, cus = 0, per_cu = 0;
        if (hipGetDevice(&dev) != hipSuccess || hipDeviceGetAttribute(&cus, hipDeviceAttributeMultiprocessorCount, dev) != hipSuccess) { fprintf(stderr, "kernel_launch: device query failed\n"); grid = -1; return; }
        if (hipFuncSetAttribute((const void*)mega, hipFuncAttributeMaxDynamicSharedMemorySize, LDS_BYTES) != hipSuccess) { fprintf(stderr, "kernel_launch: hipFuncSetAttribute failed\n"); grid = -1; return; }
        if (hipOccupancyMaxActiveBlocksPerMultiprocessor(&per_cu, (const void*)mega, NTHR, LDS_BYTES) != hipSuccess || per_cu < 1) { fprintf(stderr, "kernel_launch: occupancy query says %d blocks per CU\n", per_cu); grid = -1; return; }
        grid = cus;
        if (grid < 64 || (grid & 7)) { fprintf(stderr, "kernel_launch: unsupported CU count %d\n", cus); grid = -1; return; }
    }
    if (grid < 0) return;
    if (ws_size < WS_END || n_in != 31) { fprintf(stderr, "kernel_launch: workspace %zu < %zu or n_in %d != 31\n", ws_size, (size_t)WS_END, n_in); return; }
    if (hipMemsetAsync((char*)d_ws + WS_CTL, 0, CTL_BYTES, stream) != hipSuccess) { fprintf(stderr, "kernel_launch: memset failed\n"); return; }
    Args a{};
    a.x = (const float*)d_in[0]; a.c = (const float*)d_in[1]; a.pos = (const int*)d_in[2]; a.mod_w = (const float*)d_in[3]; a.mod_b = (const float*)d_in[4];
    a.mix_pre_g = (const float*)d_in[5]; a.mix_post_g = (const float*)d_in[6]; a.ffn_pre_g = (const float*)d_in[7]; a.ffn_post_g = (const float*)d_in[8];
    a.ssm_w_in = (const float*)d_in[9]; a.gdn_conv_w = (const float*)d_in[10]; a.gdn_a_log = (const float*)d_in[11]; a.gdn_dt_bias = (const float*)d_in[12]; a.gdn_norm_w = (const float*)d_in[13];
    a.ssd_conv_w = (const float*)d_in[14]; a.ssd_conv_b = (const float*)d_in[15]; a.ssd_a_log = (const float*)d_in[16]; a.ssd_dt_bias = (const float*)d_in[17]; a.ssd_d = (const float*)d_in[18]; a.ssd_norm_w = (const float*)d_in[19];
    a.ssm_w_out = (const float*)d_in[20]; a.attn_w_qkv = (const float*)d_in[21]; a.attn_w_o = (const float*)d_in[22];
    a.router_w = (const float*)d_in[23]; a.router_bias = (const float*)d_in[24]; a.exp_gate = (const float*)d_in[25]; a.exp_up = (const float*)d_in[26]; a.exp_down = (const float*)d_in[27];
    a.sh_gate = (const float*)d_in[28]; a.sh_up = (const float*)d_in[29]; a.sh_down = (const float*)d_in[30];
    a.out = (float*)d_out; a.ws = (unsigned char*)d_ws;
#if MK_PER_PHASE
    for (int p = 0; p < NPH; ++p) { a.ph_lo = p; a.ph_hi = p + 1; hipLaunchKernelGGL(mega, dim3(grid), dim3(NTHR), LDS_BYTES, stream, a); }
#else
    a.ph_lo = 0; a.ph_hi = NPH;
    hipLaunchKernelGGL(mega, dim3(grid), dim3(NTHR), LDS_BYTES, stream, a);
#endif
}
```

```cpp
#include <hip/hip_runtime.h>
#include <stdint.h>
#include <stdio.h>

#define DEV __device__ __forceinline__
#define LAS __attribute__((address_space(3)))
typedef unsigned short bf16_t;
typedef short bf16x8 __attribute__((ext_vector_type(8)));
typedef float f32x4 __attribute__((ext_vector_type(4)));
typedef float f32x2 __attribute__((ext_vector_type(2)));
typedef unsigned u32x4 __attribute__((ext_vector_type(4)));
typedef unsigned u32x2 __attribute__((ext_vector_type(2)));
typedef float f32x16 __attribute__((ext_vector_type(16)));
typedef short s16x4 __attribute__((ext_vector_type(4)));

#ifndef PROBE_MASK
#define PROBE_MASK 0u
#endif
#ifndef MK_PER_PHASE
#define MK_PER_PHASE 0
#endif

constexpr int NB = 4, SEQ = 4096, T = NB * SEQ, D = 1024;
constexpr int PROJ = 6688, NPROJ = 6912;
constexpr int C_BETA = 4096, C_XBC = 4112, C_ZB = 5648, C_DT = 6672;
constexpr int NE = 64, TOPK = 8, ED = 256, CAP = 16384;
constexpr int SH_RB = 576;
constexpr int NRB_ALL = SH_RB + 64;
constexpr float EPS = 1e-6f;
constexpr int NTHR = 512, NWAVES = 8;
constexpr int LDS_BYTES = 163840;
constexpr int AUX_OFF = 131072;
constexpr int BAR_OFF = LDS_BYTES - 16;

constexpr size_t MiB = 1u << 20;
constexpr size_t WS_CTL = 0, CTL_BYTES = 65536;
constexpr size_t CTL_CNT = 16384;
constexpr size_t CTL_GRP = 20480;
constexpr size_t WS_MOD = 65536;
constexpr size_t WS_COS = 1 * MiB, WS_SIN = 3 * MiB;
constexpr size_t WS_IDX = 5 * MiB, WS_GW = 5 * MiB + 512 * 1024, WS_ASLOT = 6 * MiB, WS_LTOK = 6 * MiB + 512 * 1024;
constexpr size_t WS_SMALL = 11 * MiB;
constexpr size_t WS_GB = 13 * MiB, WS_DTB = 14 * MiB;
constexpr size_t WS_WIN = 16 * MiB, WS_WOUT = 30 * MiB, WS_WQKV = 34 * MiB, WS_WO = 40 * MiB;
constexpr size_t WS_H = 44 * MiB;
constexpr size_t WS_QKVPRE = 78 * MiB, WS_XBCPRE = 174 * MiB, WS_ZA = 222 * MiB, WS_ZB = 254 * MiB;
constexpr size_t WS_QKVN = 286 * MiB, WS_XBCC = 382 * MiB;
constexpr size_t WS_CC = 16 * MiB, WS_ACUM = 25 * MiB, WS_CDEC = 26 * MiB, WS_YDIAG = 44 * MiB, WS_STATES = 430 * MiB;
constexpr size_t WS_GI = 286 * MiB, GI_UNIT = 73728, WS_GTMP = 462 * MiB, WS_GLAST = 27 * MiB;
constexpr size_t WS_ORAW = 78 * MiB, WS_YRAW = 142 * MiB, WS_OY = 78 * MiB, WS_YMIX = 286 * MiB;
constexpr size_t WS_WD = 478 * MiB, WS_WDS = 510 * MiB + 512 * 1024, WS_HID = 398 * MiB, WS_Y = 78 * MiB, WS_WGU = 142 * MiB, WS_WGUS = 207 * MiB;
constexpr size_t WS_Q1KV = 78 * MiB, WS_O1 = 174 * MiB, WS_PO = 350 * MiB, WS_PLSE = 446 * MiB;
constexpr size_t WS_END = 512 * MiB;

struct Args {
    const float* x; const float* c; const int* pos; const float* mod_w; const float* mod_b;
    const float* mix_pre_g; const float* mix_post_g; const float* ffn_pre_g; const float* ffn_post_g;
    const float* ssm_w_in; const float* gdn_conv_w; const float* gdn_a_log; const float* gdn_dt_bias; const float* gdn_norm_w;
    const float* ssd_conv_w; const float* ssd_conv_b; const float* ssd_a_log; const float* ssd_dt_bias; const float* ssd_d; const float* ssd_norm_w;
    const float* ssm_w_out; const float* attn_w_qkv; const float* attn_w_o;
    const float* router_w; const float* router_bias; const float* exp_gate; const float* exp_up; const float* exp_down;
    const float* sh_gate; const float* sh_up; const float* sh_down;
    float* out; unsigned char* ws; int ph_lo, ph_hi;
};

DEV float bf2f(bf16_t v) { return __uint_as_float(((unsigned)v) << 16); }
DEV unsigned f2bf(float f) { unsigned u = __float_as_uint(f); return (u + 0x7FFFu + ((u >> 16) & 1u)) >> 16; }
DEV unsigned pk2(float lo, float hi) { return f2bf(lo) | (f2bf(hi) << 16); }
DEV float wave_sum(float v) {
#pragma unroll
    for (int o = 32; o > 0; o >>= 1) v += __shfl_xor(v, o);
    return v;
}
DEV float siluf(float x) { return x / (1.f + __expf(-x)); }
DEV float sigmoidf_(float x) { return 1.f / (1.f + __expf(-x)); }
DEV float softplusf(float x) { return fmaxf(x, 0.f) + log1pf(__expf(-fabsf(x))); }
#define LDS_WAIT() asm volatile("s_waitcnt lgkmcnt(0)" ::: "memory")
#define VM_WAIT() asm volatile("s_waitcnt vmcnt(0)" ::: "memory")

#define XB_TMO      128
#define XB_XCNT(j)  (256  + 64 * (j))
#define XB_XSUB(j)  (1280 + 64 * (j))
#define XB_XGEN(j)  (2304 + 64 * (j))
#define XB_TOP      3328
#define XB_TOPGEN   3392
#define XCD_BAR_WORDS 3456
#define XB_SPIN_CAP (1u << 18)
#define LAS __attribute__((address_space(3)))

__device__ __forceinline__ unsigned xb_ld(unsigned* p)              { return __hip_atomic_load(p, __ATOMIC_RELAXED, __HIP_MEMORY_SCOPE_AGENT); }
__device__ __forceinline__ unsigned xb_add(unsigned* p, unsigned v) { return __hip_atomic_fetch_add(p, v, __ATOMIC_RELAXED, __HIP_MEMORY_SCOPE_AGENT); }
__device__ __forceinline__ unsigned xb_xcc_id() { return (unsigned)__builtin_amdgcn_s_getreg((3 << 11) | 20) & 0xFu; }
#define XB_SPIN(cond, bar) do { unsigned _sp = 0; while (cond) { __builtin_amdgcn_s_sleep(1); \
    if ((++_sp & 255u) == 0u) { if (xb_ld(&(bar)[XB_TMO])) break; if (_sp > XB_SPIN_CAP) { atomicAdd(&(bar)[XB_TMO], 1u); break; } } } } while (0)

struct XcdBarrier {
    unsigned* bar; unsigned x;
    volatile LAS unsigned* st;
};

__device__ __forceinline__ XcdBarrier xcd_barrier_post(unsigned* bar, volatile LAS unsigned* st) {
    XcdBarrier b; b.bar = bar; b.x = xb_xcc_id(); b.st = st;
    if (threadIdx.x == 0) (void)xb_add(&bar[XB_XCNT(b.x)], 1u);
    return b;
}
__device__ __forceinline__ void xcd_barrier_complete(unsigned* bar, unsigned x, unsigned& nloc, unsigned& nx) {
    const unsigned G = gridDim.x * gridDim.y * gridDim.z;
    unsigned sum, cnt, mine, sp = 0u;
    for (;;) {
        sum = 0u; cnt = 0u; mine = 0u;
#pragma unroll
        for (unsigned j = 0; j < 16; ++j) { const unsigned c = xb_ld(&bar[XB_XCNT(j)]); sum += c; cnt += (c > 0u) ? 1u : 0u; mine = (j == x) ? c : mine; }
        if (sum == G) break;
        __builtin_amdgcn_s_sleep(1);
        if ((++sp & 255u) == 0u) { if (xb_ld(&bar[XB_TMO])) break; if (sp > XB_SPIN_CAP) { atomicAdd(&bar[XB_TMO], 1u); break; } }
    }
    nloc = mine > 0u ? mine : 1u; nx = cnt > 0u ? cnt : 1u;
}

__device__ __forceinline__ void xcd_barrier(const XcdBarrier& b) {
    asm volatile("s_waitcnt vmcnt(0)" ::: "memory");
    __syncthreads();
    if (threadIdx.x == 0) {
        unsigned* bar = b.bar;
        __builtin_amdgcn_s_waitcnt(0);
        unsigned nloc = b.st[0], nx = b.st[1];
        if (nloc == 0u) { xcd_barrier_complete(bar, b.x, nloc, nx); b.st[0] = nloc; b.st[1] = nx; }
        const unsigned old = xb_add(&bar[XB_XSUB(b.x)], 1u);
        const unsigned gen = old / nloc;
        if (old + 1u == (gen + 1u) * nloc) {
            __builtin_amdgcn_fence(__ATOMIC_RELEASE, "agent");
            asm volatile("s_waitcnt vmcnt(0)" ::: "memory");
            const unsigned og = xb_add(&bar[XB_TOP], 1u);
            const unsigned tg = og / nx;
            if (og + 1u == (tg + 1u) * nx) xb_add(&bar[XB_TOPGEN], 1u);
            else XB_SPIN(xb_ld(&bar[XB_TOPGEN]) == tg, bar);
            __builtin_amdgcn_fence(__ATOMIC_ACQUIRE, "agent");
            xb_add(&bar[XB_XGEN(b.x)], 1u);
            asm volatile("s_waitcnt vmcnt(0)" ::: "memory");
        } else {
            XB_SPIN(xb_ld(&bar[XB_XGEN(b.x)]) == gen, bar);
            __builtin_amdgcn_fence(__ATOMIC_ACQUIRE, "agent");
            asm volatile("s_waitcnt vmcnt(0)" ::: "memory");
        }
    }
    __syncthreads();
}


DEV void group_barrier(unsigned* ctr, const unsigned n) {
    asm volatile("s_waitcnt vmcnt(0)" ::: "memory");
    __syncthreads();
    if (threadIdx.x == 0) {
        __builtin_amdgcn_fence(__ATOMIC_RELEASE, "agent");
        asm volatile("s_waitcnt vmcnt(0)" ::: "memory");
        (void)__hip_atomic_fetch_add(ctr, 1u, __ATOMIC_RELAXED, __HIP_MEMORY_SCOPE_AGENT);
        unsigned sp = 0;
        while (__hip_atomic_load(ctr, __ATOMIC_RELAXED, __HIP_MEMORY_SCOPE_AGENT) < n) { __builtin_amdgcn_s_sleep(2); if (++sp > (1u << 22)) break; }
        __builtin_amdgcn_fence(__ATOMIC_ACQUIRE, "agent");
        asm volatile("s_waitcnt vmcnt(0)" ::: "memory");
    }
    __syncthreads();
}

namespace pg8 {
constexpr int BM = 256, BK = 64, HALF = 128, HTB = HALF * BK * 2, STAGE_BYTES = 8 * HTB, NXCD = 8, WGM = 8;
DEV int lds_byte(int r, int c) { const int st = (r >> 4) * 2 + (c >> 5), rr = r & 15, cc = c & 31, ob = rr * 64 + cc * 2; return st * 1024 + (ob ^ (((ob >> 9) & 1) << 5)); }
DEV void stage_rc(int b, int& R, int& C) { const int st = b / 1024, sb = b % 1024, swz = sb ^ (((sb >> 9) & 1) << 5); R = (st >> 1) * 16 + swz / 64; C = (st & 1) * 32 + (swz % 64) / 2; }
DEV int perm32(int rho) { const int n = rho >> 4, i = rho & 15; return 8 * (i >> 2) + 4 * n + (i & 3); }
struct Unit { int pm, pn, e, slot; };
struct StaticOrder {
    int nM, nN, nwg, G, c;
    DEV void init(int M, int N, int G_, int c_) { nM = M / BM; nN = N / BM; nwg = nM * nN; G = G_; c = c_; }
    DEV bool next(int i, int& pm, int& pn) const {
        const long L = (long)i * G + c; if (L >= nwg) return false;
        int wgid = (int)L; { const int q = nwg / NXCD, r = nwg % NXCD, xcd = wgid % NXCD, off = wgid / NXCD; wgid = (xcd < r ? xcd * (q + 1) : r * (q + 1) + (xcd - r) * q) + off; }
        const int nig = WGM * nN, gid = wgid / nig, fm = gid * WGM, gsz = (nM - fm) < WGM ? (nM - fm) : WGM;
        pm = fm + ((wgid % nig) % gsz); pn = (wgid % nig) / gsz; return true;
    }
};
typedef __bf16 bf16x2_t __attribute__((ext_vector_type(2)));
DEV unsigned cvt_pk_bf16(float lo, float hi) { const bf16x2_t v = {(__bf16)lo, (__bf16)hi}; return __builtin_bit_cast(unsigned, v); }
DEV u32x4 pack8(const f32x4 a, const f32x4 b) { u32x4 w; w.x = cvt_pk_bf16(a[0], a[1]); w.y = cvt_pk_bf16(a[2], a[3]); w.z = cvt_pk_bf16(b[0], b[1]); w.w = cvt_pk_bf16(b[2], b[3]); return w; }

template <class Epi, class Sched>
DEV void gemm_phase(LAS unsigned char* lds, const int K, const Sched& S, const Epi& E) {
    const int tid = threadIdx.x, wid = __builtin_amdgcn_readfirstlane(tid >> 6), lane = tid & 63, wr = wid >> 2, wc = wid & 3, fr = lane & 15, fq = lane >> 4;
    const int nt = K / BK;
    unsigned voffB[2];
#pragma unroll
    for (int i = 0; i < 2; ++i) { int R, C; stage_rc(tid * 16 + i * 8192, R, C); const int Rb = Epi::PERM ? ((R & ~31) + perm32(R & 31)) : R; voffB[i] = (unsigned)(Rb * K + C) * 2u; }
    const unsigned kstep = (unsigned)(BK * 2);
    const size_t hstep = (size_t)HALF * K * 2;
    const unsigned ldsw = (unsigned)wid * 1024u;
    const int aoff = lds_byte(wr * 64 + fr, fq * 8), boff = lds_byte(wc * 32 + fr, fq * 8);
    const size_t hsA = Sched::GATHER ? (size_t)0 : hstep;
#define PG8_SA(b, h) (((b) * 2 + (h)) * HTB)
#define PG8_SB(b, h) ((4 + (b) * 2 + (h)) * HTB)
#define PG8_STAGEB(bufoff, gbase) do { _Pragma("unroll") for (int _i = 0; _i < 2; ++_i) \
        __builtin_amdgcn_global_load_lds((const unsigned*)((const char*)(gbase) + voffB[_i]), (LAS unsigned*)(lds + (bufoff) + ldsw + _i * 8192), 16, 0, 0); } while (0)
#define PG8_STAGEA(bufoff, gbase, VO) do { _Pragma("unroll") for (int _i = 0; _i < 2; ++_i) \
        __builtin_amdgcn_global_load_lds((const unsigned*)((const char*)(gbase) + (VO)[_i]), (LAS unsigned*)(lds + (bufoff) + ldsw + _i * 8192), 16, 0, 0); } while (0)
#define PG8_LDA(dst, b, h) do { _Pragma("unroll") for (int m = 0; m < 4; ++m) _Pragma("unroll") for (int k = 0; k < 2; ++k) dst[m][k] = *(const LAS bf16x8*)(lds + PG8_SA(b, h) + aoff + m * 2048 + k * 1024); } while (0)
#define PG8_LDB(dst, b, h) do { _Pragma("unroll") for (int n = 0; n < 2; ++n) _Pragma("unroll") for (int k = 0; k < 2; ++k) dst[n][k] = *(const LAS bf16x8*)(lds + PG8_SB(b, h) + boff + n * 2048 + k * 1024); } while (0)
#define PG8_MMA(ai, bj, At, Bt) do { __builtin_amdgcn_s_setprio(1); _Pragma("unroll") for (int m = 0; m < 4; ++m) _Pragma("unroll") for (int n = 0; n < 2; ++n) _Pragma("unroll") for (int k = 0; k < 2; ++k) \
        acc[ai][bj][m][n] = __builtin_amdgcn_mfma_f32_16x16x32_bf16(Bt[n][k], At[m][k], acc[ai][bj][m][n], 0, 0, 0); __builtin_amdgcn_s_setprio(0); } while (0)
#define PG8_WAIT_V(n) asm volatile("s_waitcnt vmcnt(" #n ")" ::: "memory")
#define PG8_WAIT_L(n) asm volatile("s_waitcnt lgkmcnt(" #n ")" ::: "memory")
#define PG8_BAR __builtin_amdgcn_s_barrier()
#define PG8_SCHED __builtin_amdgcn_sched_barrier(0)
    Unit cur, nxt; int ui = 0;
    if (!S.next(0, cur)) return;
    f32x4 acc[2][2][4][2];
#pragma unroll
    for (int a = 0; a < 2; ++a)
#pragma unroll
        for (int b = 0; b < 2; ++b)
#pragma unroll
            for (int m = 0; m < 4; ++m)
#pragma unroll
                for (int n = 0; n < 2; ++n) acc[a][b][m][n] = (f32x4){0.f, 0.f, 0.f, 0.f};
    bf16x8 At[4][2], B0[2][2], B1[2][2];
    unsigned va[2][2];
    S.a_voff(cur, tid, va);
    const char* cA = S.a_ptr(cur);
    const char* cB = S.b_ptr(cur);
    PG8_STAGEB(PG8_SB(0, 0), cB); PG8_STAGEB(PG8_SB(0, 1), cB + hstep); PG8_STAGEA(PG8_SA(0, 0), cA, va[0]); PG8_STAGEA(PG8_SA(0, 1), cA + hsA, va[1]);
    if (wr == 1) PG8_BAR;
    PG8_WAIT_V(2); PG8_BAR;
    PG8_STAGEB(PG8_SB(1, 0), cB + kstep); PG8_STAGEA(PG8_SA(1, 0), cA + kstep, va[0]); PG8_STAGEB(PG8_SB(1, 1), cB + hstep + kstep);
    PG8_WAIT_V(6); PG8_BAR;
    for (;;) {
        const bool has_next = S.next(ui + 1, nxt);
        const char* nB = has_next ? S.b_ptr(nxt) : cB;
        const char* nA = has_next ? S.a_ptr(nxt) : cA;
        for (int t = 0; t < nt; t += 2) {
            const bool last = (t == nt - 2);
            const char* a1 = cA + (size_t)(t + 1) * kstep;
            const char* a2 = last ? nA : cA + (size_t)(t + 2) * kstep; const char* a3 = a2 + kstep;
            unsigned v2[2][2];
            v2[0][0] = va[0][0]; v2[0][1] = va[0][1]; v2[1][0] = va[1][0]; v2[1][1] = va[1][1];
            if constexpr (Sched::GATHER) { if (last && has_next) S.a_voff(nxt, tid, v2); }
            const char* b2 = last ? nB : cB + (size_t)(t + 2) * kstep; const char* b3 = b2 + kstep;
            PG8_LDB(B0, 0, 0); PG8_LDB(B1, 0, 1); PG8_SCHED; PG8_LDA(At, 0, 0); PG8_STAGEA(PG8_SA(1, 1), a1 + hsA, va[1]);
            PG8_WAIT_V(8); PG8_WAIT_L(0); PG8_BAR; PG8_MMA(0, 0, At, B0); PG8_MMA(0, 1, At, B1); PG8_BAR; PG8_SCHED;
            PG8_LDA(At, 0, 1); PG8_STAGEB(PG8_SB(0, 0), b2); PG8_STAGEB(PG8_SB(0, 1), b2 + hstep); PG8_STAGEA(PG8_SA(0, 0), a2, v2[0]);
            PG8_WAIT_V(8); PG8_WAIT_L(0); PG8_BAR; PG8_MMA(1, 0, At, B0); PG8_MMA(1, 1, At, B1); PG8_BAR; PG8_SCHED;
            PG8_LDB(B0, 1, 0); PG8_LDB(B1, 1, 1); PG8_SCHED; PG8_LDA(At, 1, 0); PG8_STAGEA(PG8_SA(0, 1), a2 + hsA, v2[1]);
            PG8_WAIT_V(8); PG8_WAIT_L(0); PG8_BAR; PG8_MMA(0, 0, At, B0); PG8_MMA(0, 1, At, B1); PG8_BAR; PG8_SCHED;
            PG8_LDA(At, 1, 1); PG8_STAGEB(PG8_SB(1, 0), b3); PG8_STAGEB(PG8_SB(1, 1), b3 + hstep); PG8_STAGEA(PG8_SA(1, 0), a3, v2[0]);
            PG8_WAIT_V(8); PG8_WAIT_L(0); PG8_BAR; PG8_MMA(1, 0, At, B0); PG8_MMA(1, 1, At, B1); PG8_BAR; PG8_SCHED;
        }
        if (wr == 0) PG8_BAR;
        E(acc, cur, wr, wc, fr, fq);
        if (!has_next) break;
#pragma unroll
        for (int a = 0; a < 2; ++a)
#pragma unroll
            for (int b = 0; b < 2; ++b)
#pragma unroll
                for (int m = 0; m < 4; ++m)
#pragma unroll
                    for (int n = 0; n < 2; ++n) acc[a][b][m][n] = (f32x4){0.f, 0.f, 0.f, 0.f};
        cur = nxt; cB = nB; cA = nA; ++ui;
        if constexpr (Sched::GATHER) S.a_voff(cur, tid, va);
        if (wr == 1) PG8_BAR;
    }
    PG8_WAIT_V(0);
    PG8_BAR;
#undef PG8_SA
#undef PG8_SB
#undef PG8_STAGEA
#undef PG8_STAGEB
#undef PG8_LDA
#undef PG8_LDB
#undef PG8_MMA
#undef PG8_WAIT_V
#undef PG8_WAIT_L
#undef PG8_BAR
#undef PG8_SCHED
}

struct SchedDense {
    static constexpr bool GATHER = false;
    StaticOrder so; const char* A; const char* Bt; int K; int pad_;
    DEV bool next(int i, Unit& u) const { int pm, pn; if (!so.next(i, pm, pn)) return false; u.pm = pm; u.pn = pn; u.e = 0; u.slot = 0; return true; }
    DEV const char* a_ptr(const Unit& u) const { return A + (size_t)u.pm * 256 * K * 2; }
    DEV void a_voff(const Unit&, const int tid, unsigned (&vo)[2][2]) const {
#pragma unroll
        for (int i = 0; i < 2; ++i) { int R, C; stage_rc(tid * 16 + i * 8192, R, C); vo[0][i] = vo[1][i] = (unsigned)((R * K + C) * 2); }
    }
    DEV const char* b_ptr(const Unit& u) const { return Bt + (size_t)u.pn * 256 * K * 2; }
};
DEV bool moe_unit(int i, int NJ, int nrbt, int G, int c, Unit& u) {
    const int n = (nrbt + 64) * NJ; int L;
    if (G & 7) { L = i * G + c; if (L >= n) return false; }
    else { const int gq = G >> 3, per = (n + 7) >> 3, x = c & 7, q = c >> 3, j = i * gq + q; if (j >= per) return false; L = x * per + j; if (L >= n) return false; }
    int grb = L / NJ; const int pn = L - grb * NJ; if (grb >= nrbt) grb = SH_RB + (grb - nrbt);
    u.pm = grb; u.pn = pn; u.slot = i; u.e = 0; return true;
}
struct SchedGU {
    static constexpr bool GATHER = true;
    const char* A; const char* Wgu; const char* Wgus; const LAS int* eofrb; const LAS int* toks; int nrbt, G, c, pad_;
    DEV bool next(int i, Unit& u) const { if (!moe_unit(i, 2, nrbt, G, c, u)) return false; u.e = __builtin_amdgcn_readfirstlane(eofrb[u.pm]); return true; }
    DEV const char* a_ptr(const Unit&) const { return A; }
    DEV void a_voff(const Unit& u, const int tid, unsigned (&vo)[2][2]) const {
#pragma unroll
        for (int i = 0; i < 2; ++i) { int R, C; stage_rc(tid * 16 + i * 8192, R, C);
#pragma unroll
            for (int h = 0; h < 2; ++h) { const int tok = toks[u.slot * 256 + h * 128 + R]; vo[h][i] = (unsigned)((tok * D + C) * 2); } }
    }
    DEV const char* b_ptr(const Unit& u) const { return (u.e < NE ? Wgu + (size_t)u.e * 512 * D * 2 : Wgus) + (size_t)u.pn * 256 * D * 2; }
};
struct SchedDown {
    static constexpr bool GATHER = false;
    const char* A; const char* Wd; const char* Wds; const LAS int* eofrb; int nrbt, G, c, pad_;
    DEV bool next(int i, Unit& u) const { if (!moe_unit(i, 4, nrbt, G, c, u)) return false; u.e = __builtin_amdgcn_readfirstlane(eofrb[u.pm]); return true; }
    DEV const char* a_ptr(const Unit& u) const { return A + (size_t)u.pm * 256 * ED * 2; }
    DEV void a_voff(const Unit&, const int tid, unsigned (&vo)[2][2]) const {
#pragma unroll
        for (int i = 0; i < 2; ++i) { int R, C; stage_rc(tid * 16 + i * 8192, R, C); vo[0][i] = vo[1][i] = (unsigned)((R * ED + C) * 2); }
    }
    DEV const char* b_ptr(const Unit& u) const { return (u.e < NE ? Wd + (size_t)u.e * D * ED * 2 : Wds) + (size_t)u.pn * 256 * ED * 2; }
};

struct EpiProj {
    static constexpr bool PERM = true;
    bf16_t* qkv; bf16_t* za; bf16_t* xbc; bf16_t* zb; float* small;
    DEV void operator()(const f32x4 (&acc)[2][2][4][2], const Unit& u, int wr, int wc, int fr, int fq) const {
        const int row0 = u.pm * BM + wr * 64 + fr, pn = u.pn;
        if (pn == 26) {
            if (wc == 0) {
#pragma unroll
                for (int ai = 0; ai < 2; ++ai)
#pragma unroll
                    for (int m = 0; m < 4; ++m) { float* p = small + (size_t)(row0 + ai * HALF + m * 16) * 32 + 8 * fq; *(f32x4*)p = acc[ai][0][m][0]; *(f32x4*)(p + 4) = acc[ai][0][m][1]; }
            }
            return;
        }
        bf16_t* base; int ldc, ct;
        if (pn < 12) { base = qkv; ldc = 3072; ct = pn; } else if (pn < 16) { base = za; ldc = 1024; ct = pn - 12; } else if (pn < 22) { base = xbc; ldc = 1536; ct = pn - 16; } else { base = zb; ldc = 1024; ct = pn - 22; }
        const int col0 = ct * 256 + wc * 32 + 8 * fq;
#pragma unroll
        for (int ai = 0; ai < 2; ++ai)
#pragma unroll
            for (int m = 0; m < 4; ++m) { bf16_t* rowp = base + (size_t)(row0 + ai * HALF + m * 16) * ldc + col0;
#pragma unroll
                for (int bj = 0; bj < 2; ++bj) *(u32x4*)(rowp + bj * HALF) = pack8(acc[ai][bj][m][0], acc[ai][bj][m][1]); }
    }
};
struct EpiF32 {
    static constexpr bool PERM = false;
    float* Cp; int ldc; int pad_;
    DEV void operator()(const f32x4 (&acc)[2][2][4][2], const Unit& u, int wr, int wc, int fr, int fq) const {
        const int row0 = u.pm * BM + wr * 64 + fr, col0 = u.pn * BM + wc * 32 + 4 * fq;
#pragma unroll
        for (int ai = 0; ai < 2; ++ai)
#pragma unroll
            for (int m = 0; m < 4; ++m) { float* rowp = Cp + (size_t)(row0 + ai * HALF + m * 16) * ldc + col0;
#pragma unroll
                for (int bj = 0; bj < 2; ++bj)
#pragma unroll
                    for (int n = 0; n < 2; ++n) *(f32x4*)(rowp + bj * HALF + n * 16) = acc[ai][bj][m][n]; }
    }
};
struct EpiBf16 {
    static constexpr bool PERM = true;
    bf16_t* O; int ldc; int pad_;
    DEV void operator()(const f32x4 (&acc)[2][2][4][2], const Unit& u, int wr, int wc, int fr, int fq) const {
        const int row0 = u.pm * BM + wr * 64 + fr, col0 = u.pn * BM + wc * 32 + 8 * fq;
#pragma unroll
        for (int ai = 0; ai < 2; ++ai)
#pragma unroll
            for (int m = 0; m < 4; ++m) { bf16_t* rowp = O + (size_t)(row0 + ai * HALF + m * 16) * ldc + col0;
#pragma unroll
                for (int bj = 0; bj < 2; ++bj) *(u32x4*)(rowp + bj * HALF) = pack8(acc[ai][bj][m][0], acc[ai][bj][m][1]); }
    }
};
struct EpiFp8 {
    static constexpr bool PERM = true;
    unsigned char* O; int ldc; int pad_;
    DEV void operator()(const f32x4 (&acc)[2][2][4][2], const Unit& u, int wr, int wc, int fr, int fq) const {
        const int row0 = u.pm * BM + wr * 64 + fr, col0 = u.pn * BM + wc * 32 + 8 * fq;
#pragma unroll
        for (int ai = 0; ai < 2; ++ai)
#pragma unroll
            for (int m = 0; m < 4; ++m) { unsigned char* rowp = O + (size_t)(row0 + ai * HALF + m * 16) * ldc + col0;
#pragma unroll
                for (int bj = 0; bj < 2; ++bj) { const f32x4 a0 = acc[ai][bj][m][0] * 16.f, a1 = acc[ai][bj][m][1] * 16.f;
                    int w0 = __builtin_amdgcn_cvt_pk_fp8_f32(a0[0], a0[1], 0, false); w0 = __builtin_amdgcn_cvt_pk_fp8_f32(a0[2], a0[3], w0, true);
                    int w1 = __builtin_amdgcn_cvt_pk_fp8_f32(a1[0], a1[1], 0, false); w1 = __builtin_amdgcn_cvt_pk_fp8_f32(a1[2], a1[3], w1, true);
                    *(u32x2*)(rowp + bj * HALF) = (u32x2){(unsigned)w0, (unsigned)w1}; } }
    }
};
struct EpiGU {
    static constexpr bool PERM = true;
    bf16_t* H;
    DEV void operator()(const f32x4 (&acc)[2][2][4][2], const Unit& u, int wr, int wc, int fr, int fq) const {
        const int row0 = u.pm * BM + wr * 64 + fr, col0 = u.pn * HALF + wc * 32 + 8 * fq;
#pragma unroll
        for (int ai = 0; ai < 2; ++ai)
#pragma unroll
            for (int m = 0; m < 4; ++m) {
                f32x4 h0, h1;
#pragma unroll
                for (int i = 0; i < 4; ++i) { h0[i] = siluf(acc[ai][0][m][0][i]) * acc[ai][1][m][0][i]; h1[i] = siluf(acc[ai][0][m][1][i]) * acc[ai][1][m][1][i]; }
                *(u32x4*)(H + (size_t)(row0 + ai * HALF + m * 16) * ED + col0) = pack8(h0, h1);
            }
    }
};
struct EpiQKV {
    static constexpr bool PERM = true;
    bf16_t* O; const float* cosT; const float* sinT;
    DEV void operator()(const f32x4 (&acc)[2][2][4][2], const Unit& u, int wr, int wc, int fr, int fq) const {
        const int row0 = u.pm * BM + wr * 64 + fr, col0 = u.pn * BM + wc * 32 + 8 * fq;
        const bool rope = u.pn < 8; const float qs = u.pn < 4 ? 0.125f : 1.f;
#pragma unroll
        for (int ai = 0; ai < 2; ++ai)
#pragma unroll
            for (int m = 0; m < 4; ++m) {
                const int row = row0 + ai * HALF + m * 16;
                bf16_t* rowp = O + (size_t)row * 3072 + col0;
                if (rope) {
                    const f32x4 cs = *(const f32x4*)(cosT + (size_t)row * 32 + 16 * (wc & 1) + 4 * fq), sn = *(const f32x4*)(sinT + (size_t)row * 32 + 16 * (wc & 1) + 4 * fq);
#pragma unroll
                    for (int bj = 0; bj < 2; ++bj) { const f32x4 x1 = acc[ai][bj][m][0], x2 = acc[ai][bj][m][1];
                        *(u32x4*)(rowp + bj * HALF) = pack8((x1 * cs - x2 * sn) * qs, (x2 * cs + x1 * sn) * qs); }
                } else {
#pragma unroll
                    for (int bj = 0; bj < 2; ++bj) *(u32x4*)(rowp + bj * HALF) = pack8(acc[ai][bj][m][0], acc[ai][bj][m][1]);
                }
            }
    }
};
}

template <class SrcF>
DEV void conv_item(const SrcF& src, int ldw, int K, bf16_t* dst, LAS float* scr, int item, int nblk, int lane) {
    const int kb = item / nblk, nb = item - kb * nblk, k0 = 64 * kb, n0 = 32 * nb;
    const int quad = lane & 7, r0 = lane >> 3;
    const float* colp = src(n0 + 4 * quad);
    f32x4 v[8];
#pragma unroll
    for (int i = 0; i < 8; ++i) v[i] = colp ? *(const f32x4*)(colp + (size_t)(k0 + r0 + 8 * i) * ldw) : (f32x4){0.f, 0.f, 0.f, 0.f};
#pragma unroll
    for (int i = 0; i < 8; ++i) { LAS float* p = scr + (r0 + 8 * i) * 33 + 4 * quad; p[0] = v[i][0]; p[1] = v[i][1]; p[2] = v[i][2]; p[3] = v[i][3]; }
    LDS_WAIT(); asm volatile("" ::: "memory");
    const int c = lane & 7;
#pragma unroll
    for (int j = 0; j < 4; ++j) { const int n = (lane >> 3) + 8 * j; const LAS float* s = scr + (8 * c) * 33 + n;
        u32x4 o; o.x = pk2(s[0 * 33], s[1 * 33]); o.y = pk2(s[2 * 33], s[3 * 33]); o.z = pk2(s[4 * 33], s[5 * 33]); o.w = pk2(s[6 * 33], s[7 * 33]);
        *(u32x4*)(dst + (size_t)(n0 + n) * K + k0 + 8 * c) = o; }
    LDS_WAIT(); asm volatile("" ::: "memory");
}
struct SrcIdent { const float* W; DEV const float* operator()(int n) const { return W + n; } };
struct SrcWin { const float* W; DEV const float* operator()(int n) const {
    int s; if (n < 4096) s = n; else if (n < 5632) s = C_XBC + (n - 4096); else if (n < 6656) s = C_ZB + (n - 5632); else if (n < 6672) s = C_BETA + (n - 6656); else if (n < 6688) s = C_DT + (n - 6672); else return nullptr;
    return W + s; } };
struct SrcQKV { const float* W; DEV const float* operator()(int n) const {
    if (n >= 2048) return W + n; const int hd = n >> 6, cp = n & 63; return W + hd * 64 + 32 * ((cp >> 2) & 1) + 16 * (cp >> 5) + 4 * ((cp >> 3) & 3) + (cp & 3); } };
struct SrcGU { const float* Wg; long du; DEV const float* operator()(int r) const { const int j = r >> 8, rr = r & 255; return Wg + (rr < 128 ? 0l : du) + 128 * j + (rr & 127); } };

DEV void load_row(const float* p, int lane, float (&v)[16]) {
#pragma unroll
    for (int j = 0; j < 4; ++j) { const f32x4 t = *(const f32x4*)(p + j * 256 + lane * 4); v[4 * j] = t[0]; v[4 * j + 1] = t[1]; v[4 * j + 2] = t[2]; v[4 * j + 3] = t[3]; }
}
DEV void store_row(float* p, int lane, const float (&v)[16]) {
#pragma unroll
    for (int j = 0; j < 4; ++j) *(f32x4*)(p + j * 256 + lane * 4) = (f32x4){v[4 * j], v[4 * j + 1], v[4 * j + 2], v[4 * j + 3]};
}
DEV float row_rstd(const float (&v)[16]) { float ss = 0.f;
#pragma unroll
    for (int i = 0; i < 16; ++i) ss += v[i] * v[i];
    return rsqrtf(wave_sum(ss) * (1.f / D) + EPS); }
DEV void resid_update(float (&xv)[16], const float (&yv)[16], const float* gpost, const float* gt, int lane) {
    const float r = row_rstd(yv);
#pragma unroll
    for (int j = 0; j < 4; ++j) { const f32x4 g = *(const f32x4*)(gpost + j * 256 + lane * 4), t = *(const f32x4*)(gt + j * 256 + lane * 4);
#pragma unroll
        for (int i = 0; i < 4; ++i) xv[4 * j + i] += t[i] * (yv[4 * j + i] * r * g[i]); }
}
DEV void prenorm_pack(const float (&xv)[16], const float* gpre, const float* sc, const float* sh, int lane, u32x2 (&o)[4]) {
    const float r = row_rstd(xv);
#pragma unroll
    for (int j = 0; j < 4; ++j) { const f32x4 g = *(const f32x4*)(gpre + j * 256 + lane * 4), s = *(const f32x4*)(sc + j * 256 + lane * 4), b = *(const f32x4*)(sh + j * 256 + lane * 4);
        float h[4];
#pragma unroll
        for (int i = 0; i < 4; ++i) h[i] = xv[4 * j + i] * r * g[i] * (1.f + s[i]) + b[i];
        o[j] = (u32x2){pk2(h[0], h[1]), pk2(h[2], h[3])}; }
}

DEV void load_row8(const float* p, int lane, float (&v)[16]) {
#pragma unroll
    for (int j = 0; j < 2; ++j)
#pragma unroll
        for (int hh = 0; hh < 2; ++hh) { const f32x4 t = *(const f32x4*)(p + 512 * j + 8 * lane + 4 * hh); v[8 * j + 4 * hh] = t[0]; v[8 * j + 4 * hh + 1] = t[1]; v[8 * j + 4 * hh + 2] = t[2]; v[8 * j + 4 * hh + 3] = t[3]; }
}
DEV void store_row8(float* p, int lane, const float (&v)[16]) {
#pragma unroll
    for (int j = 0; j < 2; ++j)
#pragma unroll
        for (int hh = 0; hh < 2; ++hh) *(f32x4*)(p + 512 * j + 8 * lane + 4 * hh) = (f32x4){v[8 * j + 4 * hh], v[8 * j + 4 * hh + 1], v[8 * j + 4 * hh + 2], v[8 * j + 4 * hh + 3]};
}
DEV void resid_update8(float (&xv)[16], const float (&yv)[16], const float* gpost, const float* gt, int lane) {
    const float r = row_rstd(yv);
#pragma unroll
    for (int j = 0; j < 2; ++j)
#pragma unroll
        for (int hh = 0; hh < 2; ++hh) { const f32x4 g = *(const f32x4*)(gpost + 512 * j + 8 * lane + 4 * hh), t = *(const f32x4*)(gt + 512 * j + 8 * lane + 4 * hh);
#pragma unroll
            for (int i = 0; i < 4; ++i) xv[8 * j + 4 * hh + i] += t[i] * (yv[8 * j + 4 * hh + i] * r * g[i]); }
}
DEV void prenorm_pack8(const float (&xv)[16], const float* gpre, const float* sc, const float* sh, int lane, u32x4 (&o)[2]) {
    const float r = row_rstd(xv);
#pragma unroll
    for (int j = 0; j < 2; ++j) { float h[8];
#pragma unroll
        for (int hh = 0; hh < 2; ++hh) { const f32x4 g = *(const f32x4*)(gpre + 512 * j + 8 * lane + 4 * hh), s = *(const f32x4*)(sc + 512 * j + 8 * lane + 4 * hh), b = *(const f32x4*)(sh + 512 * j + 8 * lane + 4 * hh);
#pragma unroll
            for (int i = 0; i < 4; ++i) h[4 * hh + i] = xv[8 * j + 4 * hh + i] * r * g[i] * (1.f + s[i]) + b[i]; }
        o[j] = (u32x4){pk2(h[0], h[1]), pk2(h[2], h[3]), pk2(h[4], h[5]), pk2(h[6], h[7])}; }
}
DEV void acc_row8(float (&yv)[16], const u32x2 w0, const u32x2 w1, const float g) {
#pragma unroll
    for (int e = 0; e < 2; ++e) {
        yv[4 * e] += g * __builtin_amdgcn_cvt_f32_fp8((int)w0[e], 0); yv[4 * e + 1] += g * __builtin_amdgcn_cvt_f32_fp8((int)w0[e], 1); yv[4 * e + 2] += g * __builtin_amdgcn_cvt_f32_fp8((int)w0[e], 2); yv[4 * e + 3] += g * __builtin_amdgcn_cvt_f32_fp8((int)w0[e], 3);
        yv[8 + 4 * e] += g * __builtin_amdgcn_cvt_f32_fp8((int)w1[e], 0); yv[8 + 4 * e + 1] += g * __builtin_amdgcn_cvt_f32_fp8((int)w1[e], 1); yv[8 + 4 * e + 2] += g * __builtin_amdgcn_cvt_f32_fp8((int)w1[e], 2); yv[8 + 4 * e + 3] += g * __builtin_amdgcn_cvt_f32_fp8((int)w1[e], 3); }
}

struct Ctx { LAS unsigned char* lds; int tid, lane, wave, G, bid; };

DEV void ph_setup(const Args& a, const Ctx& X) {
    unsigned char* ws = a.ws;
    float* mod = (float*)(ws + WS_MOD);
    { LAS float* red = (LAS float*)X.lds;
      LAS float* sc = (LAS float*)(X.lds + 8192);
      for (int i = X.tid; i < NB * D; i += NTHR) sc[i] = siluf(a.c[i]);
      __syncthreads();
      const int kc = X.tid >> 6, cl = X.tid & 63;
      for (int task = X.bid; task < 2 * 96; task += X.G) {
          const int l = task / 96, col = (task % 96) * 64 + cl;
          const float* w = a.mod_w + (size_t)l * D * 6 * D + col;
          float p0 = 0.f, p1 = 0.f, p2 = 0.f, p3 = 0.f;
#pragma unroll 16
          for (int k = kc * 128; k < kc * 128 + 128; ++k) { const float wv = w[(size_t)k * 6 * D];
              p0 += sc[k] * wv; p1 += sc[D + k] * wv; p2 += sc[2 * D + k] * wv; p3 += sc[3 * D + k] * wv; }
          __syncthreads();
          red[(kc * 4 + 0) * 64 + cl] = p0; red[(kc * 4 + 1) * 64 + cl] = p1; red[(kc * 4 + 2) * 64 + cl] = p2; red[(kc * 4 + 3) * 64 + cl] = p3;
          __syncthreads();
          if (X.tid < 256) { const int b = X.tid >> 6; float s = a.mod_b[l * 6 * D + col];
#pragma unroll
              for (int q = 0; q < 8; ++q) s += red[(q * 4 + b) * 64 + cl];
              mod[(size_t)(l * NB + b) * 6 * D + col] = s; }
      }
      __syncthreads(); }
    { float* cosT = (float*)(ws + WS_COS); float* sinT = (float*)(ws + WS_SIN);
      for (int idx = X.bid * NTHR + X.tid; idx < T * 32; idx += X.G * NTHR) { const int t = idx >> 5, i = idx & 31;
          const float ang = (float)a.pos[t] * powf(10000.f, -(float)i / 32.f); float sn, cs; sincosf(ang, &sn, &cs); cosT[idx] = cs; sinT[idx] = sn; } }
    { LAS float* scr = (LAS float*)(X.lds + X.wave * 8704);
      const int gw = X.bid * NWAVES + X.wave, NGW = X.G * NWAVES;
      constexpr int I_IN = (D / 64) * (NPROJ / 32), I_OUT = (2048 / 64) * (D / 32), I_QKV = (D / 64) * (3072 / 32), I_O = (D / 64) * (D / 32);
      for (int it = gw; it < I_IN + I_OUT + I_QKV + I_O; it += NGW) {
          int r = it;
          if (r < I_IN) { conv_item(SrcWin{a.ssm_w_in}, PROJ, D, (bf16_t*)(ws + WS_WIN), scr, r, NPROJ / 32, X.lane); continue; } r -= I_IN;
          if (r < I_OUT) { conv_item(SrcIdent{a.ssm_w_out}, D, 2048, (bf16_t*)(ws + WS_WOUT), scr, r, D / 32, X.lane); continue; } r -= I_OUT;
          if (r < I_QKV) { conv_item(SrcQKV{a.attn_w_qkv}, 3072, D, (bf16_t*)(ws + WS_WQKV), scr, r, 3072 / 32, X.lane); continue; } r -= I_QKV;
          conv_item(SrcIdent{a.attn_w_o}, D, D, (bf16_t*)(ws + WS_WO), scr, r, D / 32, X.lane);
      } }
}

DEV void ph_prenorm0(const Args& a, const Ctx& X) {
    const float* mod = (const float*)(a.ws + WS_MOD);
    bf16_t* hb = (bf16_t*)(a.ws + WS_H);
    for (int row = X.bid * NWAVES + X.wave; row < T; row += X.G * NWAVES) {
        const int b = row / SEQ; const float* ml = mod + (size_t)b * 6 * D;
        float xv[16]; load_row(a.x + (size_t)row * D, X.lane, xv);
        u32x2 o[4]; prenorm_pack(xv, a.mix_pre_g, ml + D, ml, X.lane, o);
#pragma unroll
        for (int j = 0; j < 4; ++j) *(u32x2*)(hb + (size_t)row * D + j * 256 + X.lane * 4) = o[j];
    }
}

DEV void ph_mix_prep(const Args& a, const Ctx& X) {
    const unsigned char* ws = a.ws;
    const bf16_t* qkvpre = (const bf16_t*)(ws + WS_QKVPRE); const bf16_t* xbcpre = (const bf16_t*)(ws + WS_XBCPRE); const float* small = (const float*)(ws + WS_SMALL);
    bf16_t* qkvn = (bf16_t*)(a.ws + WS_QKVN); float* gb = (float*)(a.ws + WS_GB); bf16_t* xbcc = (bf16_t*)(a.ws + WS_XBCC); float* dtb = (float*)(a.ws + WS_DTB);
    for (int wid = X.bid * NWAVES + X.wave; wid < T * 8; wid += X.G * NWAVES) {
        const int t = wid >> 3, h = wid & 7, s = t % SEQ, lane = X.lane;
        float vals[3][2];
#pragma unroll
        for (int part = 0; part < 3; ++part)
#pragma unroll
            for (int e = 0; e < 2; ++e) { const int c = part * 1024 + h * 128 + lane * 2 + e; float acc = 0.f;
#pragma unroll
                for (int i = 0; i < 4; ++i) { const int ss = s - 3 + i; if (ss >= 0) acc += a.gdn_conv_w[i * 3072 + c] * bf2f(qkvpre[(size_t)(t - 3 + i) * 3072 + c]); }
                vals[part][e] = siluf(acc); }
#pragma unroll
        for (int part = 0; part < 2; ++part) { const float ss = wave_sum(vals[part][0] * vals[part][0] + vals[part][1] * vals[part][1]); const float r = rsqrtf(ss + 1e-6f); vals[part][0] *= r; vals[part][1] *= r; }
#pragma unroll
        for (int part = 0; part < 3; ++part) *(unsigned*)(qkvn + (size_t)t * 3072 + part * 1024 + h * 128 + lane * 2) = pk2(vals[part][0], vals[part][1]);
        if (lane == 0) { const float beta = sigmoidf_(small[(size_t)t * 32 + h]); const float g = -__expf(a.gdn_a_log[h]) * softplusf(small[(size_t)t * 32 + 8 + h] + a.gdn_dt_bias[h]);
            gb[t * 16 + h] = g; gb[t * 16 + 8 + h] = beta; }
    }
}
DEV void ph_mix_seq(const Args& a, const Ctx& X) {
    const bf16_t* qkvn = (const bf16_t*)(a.ws + WS_QKVN); const float* gb = (const float*)(a.ws + WS_GB);
    const bf16_t* xbc = (const bf16_t*)(a.ws + WS_XBCC); const float* dtb = (const float*)(a.ws + WS_DTB);
    float* oraw = (float*)(a.ws + WS_ORAW); float* yraw = (float*)(a.ws + WS_YRAW);
    const int tid = X.tid;
    if (X.bid < 32) {
        LAS float* sk = (LAS float*)X.lds; LAS float* sq = sk + 16 * 128; LAS float* sv = sq + 16 * 128; LAS float* sa = sv + 16 * 128; LAS float* sbeta = sa + 16; LAS float* red = sbeta + 16;
        const int b = X.bid >> 3, h = X.bid & 7, v = tid & 127, kq = tid >> 7;
        float S[32];
#pragma unroll
        for (int i = 0; i < 32; ++i) S[i] = 0.f;
        const float scale = 0.08838834764831845f;
        for (int t0 = 0; t0 < SEQ; t0 += 16) {
            const size_t tb = (size_t)b * SEQ + t0;
            for (int idx = tid; idx < 16 * 384; idx += NTHR) { const int jj = idx / 384, c = idx % 384, part = c >> 7, cc = c & 127;
                const float val = bf2f(qkvn[(tb + jj) * 3072 + part * 1024 + h * 128 + cc]);
                if (part == 0) sq[jj * 128 + cc] = val; else if (part == 1) sk[jj * 128 + cc] = val; else sv[jj * 128 + cc] = val; }
            if (tid < 16) { sa[tid] = __expf(gb[(tb + tid) * 16 + h]); sbeta[tid] = gb[(tb + tid) * 16 + 8 + h]; }
            __syncthreads();
            for (int j = 0; j < 16; ++j) {
                const float al = sa[j], bt = sbeta[j]; float p = 0.f;
#pragma unroll
                for (int i = 0; i < 32; ++i) { S[i] *= al; p += sk[j * 128 + kq * 32 + i] * S[i]; }
                red[kq * 128 + v] = p;
                __syncthreads();
                const float kS = red[v] + red[128 + v] + red[256 + v] + red[384 + v];
                const float delta = bt * (sv[j * 128 + v] - kS); float po = 0.f;
#pragma unroll
                for (int i = 0; i < 32; ++i) { S[i] += sk[j * 128 + kq * 32 + i] * delta; po += sq[j * 128 + kq * 32 + i] * S[i]; }
                red[512 + kq * 128 + v] = po;
                __syncthreads();
                if (kq == 0) oraw[(tb + j) * 1024 + h * 128 + v] = (red[512 + v] + red[512 + 128 + v] + red[512 + 256 + v] + red[512 + 384 + v]) * scale;
            }
            __syncthreads();
        }
    }
}
DEV void ph_mix_post(const Args& a, const Ctx& X) {
    const float* oraw = (const float*)(a.ws + WS_ORAW); const float* yraw = (const float*)(a.ws + WS_YRAW);
    const bf16_t* za = (const bf16_t*)(a.ws + WS_ZA); const bf16_t* zb = (const bf16_t*)(a.ws + WS_ZB); bf16_t* oy = (bf16_t*)(a.ws + WS_OY);
    const int lane = X.lane;
    for (int wid = X.bid * NWAVES + X.wave; wid < T * 8; wid += X.G * NWAVES) {
        const int t = wid >> 3, h = wid & 7, c = h * 128 + lane * 2;
        const f32x2 o = *(const f32x2*)(oraw + (size_t)t * 1024 + c);
        const float r = rsqrtf(wave_sum(o.x * o.x + o.y * o.y) * (1.f / 128.f) + EPS);
        const float z0 = bf2f(za[(size_t)t * 1024 + c]), z1 = bf2f(za[(size_t)t * 1024 + c + 1]);
        *(unsigned*)(oy + (size_t)t * 2048 + c) = pk2(o.x * r * a.gdn_norm_w[lane * 2] * siluf(z0), o.y * r * a.gdn_norm_w[lane * 2 + 1] * siluf(z1));
    }
}

DEV bf16x8 acc_to_frag(const f32x4 lo, const f32x4 hi) { u32x4 w; w.x = pg8::cvt_pk_bf16(lo[0], lo[1]); w.y = pg8::cvt_pk_bf16(lo[2], lo[3]); w.z = pg8::cvt_pk_bf16(hi[0], hi[1]); w.w = pg8::cvt_pk_bf16(hi[2], hi[3]); return __builtin_bit_cast(bf16x8, w); }

DEV void gdn_solve(LAS float* M, LAS unsigned short* tf, const int lane) {
    for (int rb = 0; rb < 16; ++rb) {
        const int i0 = 4 * rb;
        float a0 = (lane == i0) ? 1.f : 0.f, a1 = (lane == i0 + 1) ? 1.f : 0.f, a2 = (lane == i0 + 2) ? 1.f : 0.f, a3 = (lane == i0 + 3) ? 1.f : 0.f;
        for (int j = 0; j < i0; j += 4) {
            const float t0 = M[j * 64 + lane], t1 = M[(j + 1) * 64 + lane], t2 = M[(j + 2) * 64 + lane], t3 = M[(j + 3) * 64 + lane];
            const f32x4 r0 = *(const LAS f32x4*)(M + i0 * 64 + j), r1 = *(const LAS f32x4*)(M + (i0 + 1) * 64 + j), r2 = *(const LAS f32x4*)(M + (i0 + 2) * 64 + j), r3 = *(const LAS f32x4*)(M + (i0 + 3) * 64 + j);
            a0 -= r0[0] * t0 + r0[1] * t1 + r0[2] * t2 + r0[3] * t3; a1 -= r1[0] * t0 + r1[1] * t1 + r1[2] * t2 + r1[3] * t3;
            a2 -= r2[0] * t0 + r2[1] * t1 + r2[2] * t2 + r2[3] * t3; a3 -= r3[0] * t0 + r3[1] * t1 + r3[2] * t2 + r3[3] * t3;
        }
        const f32x4 d1 = *(const LAS f32x4*)(M + (i0 + 1) * 64 + i0), d2 = *(const LAS f32x4*)(M + (i0 + 2) * 64 + i0), d3 = *(const LAS f32x4*)(M + (i0 + 3) * 64 + i0);
        a1 -= d1[0] * a0; a2 -= d2[0] * a0 + d2[1] * a1; a3 -= d3[0] * a0 + d3[1] * a1 + d3[2] * a2;
        M[i0 * 64 + lane] = a0; M[(i0 + 1) * 64 + lane] = a1; M[(i0 + 2) * 64 + lane] = a2; M[(i0 + 3) * 64 + lane] = a3;
    }
    const int cq = (lane >> 2) & 3, ca = (lane >> 4) & 1, ce = lane & 3, cks = lane >> 5;
    for (int i = 0; i < 64; ++i) tf[((i >> 4) * 2 + cks) * 512 + ((i & 15) + 16 * cq) * 8 + 4 * ca + ce] = (unsigned short)f2bf(M[i * 64 + lane]);
}
DEV void ph_gdn_local(const Args& a, const Ctx& X) {
    const bf16_t* qkvpre = (const bf16_t*)(a.ws + WS_QKVPRE); const float* small = (const float*)(a.ws + WS_SMALL);
    unsigned char* gi = a.ws + WS_GI; float* glast = (float*)(a.ws + WS_GLAST);
    constexpr int KP = 272;
    LAS unsigned char* kN = X.lds; LAS unsigned char* qN = X.lds + 64 * KP; LAS unsigned char* slots = X.lds + 128 * KP;
    LAS float* gcL = (LAS float*)(X.lds + AUX_OFF); LAS float* btL = gcL + 8 * 64;
    const int lane = X.lane, wave = X.wave, r16 = lane & 15, q4 = lane >> 4;
    const float scale = 0.08838834764831845f;
    for (int wu = X.bid; wu < NB * 64; wu += X.G) {
        const int b = wu >> 6, n = wu & 63; const size_t t0 = (size_t)b * SEQ + 64 * n;
        unsigned char* tmp = a.ws + WS_GTMP + (size_t)X.bid * 131072;
        __syncthreads();
        {
            const float g = -__expf(a.gdn_a_log[wave]) * softplusf(small[(t0 + lane) * 32 + 8 + wave] + a.gdn_dt_bias[wave]);
            float gc = g;
#pragma unroll
            for (int o = 1; o < 64; o <<= 1) { const float v = __shfl_up(gc, o); if (lane >= o) gc += v; }
            gcL[wave * 64 + lane] = gc; btL[wave * 64 + lane] = sigmoidf_(small[(t0 + lane) * 32 + wave]);
            if (lane == 63) glast[(size_t)((b * 8 + wave) * 64 + n) * 32] = gc;
        }
        __syncthreads();
        unsigned xr[3][11];
#define GDN_LOADX(hh) do { _Pragma("unroll") for (int _p = 0; _p < 3; ++_p) _Pragma("unroll") for (int _i = 0; _i < 11; ++_i) { const int _tk = 8 * wave + _i - 3; unsigned _v = 0u; \
            if (64 * n + _tk >= 0) _v = *(const unsigned*)(qkvpre + (t0 + _tk) * 3072 + _p * 1024 + (hh) * 128 + 2 * lane); xr[_p][_i] = _v; } } while (0)
        GDN_LOADX(0);
        for (int bb = 0; bb < 2; ++bb) {
            for (int j = 0; j < 4; ++j) {
                const int h = bb * 4 + j; unsigned char* ub = gi + (size_t)((b * 8 + h) * 64 + n) * GI_UNIT;
                {
                    const float gl = gcL[h * 64 + 63];
                    const int blk = wave >> 2, pa = (wave & 3) >> 1, pq0 = 2 * (wave & 1);
                    const int ca = (2 * lane >> 4) & 1, cq = (2 * lane >> 2) & 3, ce = (2 * lane) & 3, cks = (2 * lane) >> 5;
#pragma unroll
                    for (int part = 0; part < 3; ++part) {
                        const int col = part * 1024 + h * 128 + 2 * lane;
                        float w0[4], w1[4];
#pragma unroll
                        for (int i = 0; i < 4; ++i) { const f32x2 t = *(const f32x2*)(a.gdn_conv_w + i * 3072 + col); w0[i] = t.x; w1[i] = t.y; }
                        float x0[11], x1[11];
#pragma unroll
                        for (int i = 0; i < 11; ++i) { const unsigned v = xr[part][i]; x0[i] = __uint_as_float(v << 16); x1[i] = __uint_as_float(v & 0xFFFF0000u); }
                        float v0[8], v1[8];
#pragma unroll
                        for (int i = 0; i < 8; ++i) { v0[i] = siluf(w0[0] * x0[i] + w0[1] * x0[i + 1] + w0[2] * x0[i + 2] + w0[3] * x0[i + 3]); v1[i] = siluf(w1[0] * x1[i] + w1[1] * x1[i + 1] + w1[2] * x1[i + 2] + w1[3] * x1[i + 3]); }
                        if (part < 2) {
#pragma unroll
                            for (int i = 0; i < 8; ++i) { const float r = rsqrtf(wave_sum(v0[i] * v0[i] + v1[i] * v1[i]) + 1e-6f); v0[i] *= r; v1[i] *= r; }
                        }
                        for (int rep_ = 0; rep_ < (((PROBE_MASK >> 21) & 1u) ? 2 : 1); ++rep_) {
                        if (part == 0) {
#pragma unroll
                            for (int i = 0; i < 8; ++i) { const int tok = 8 * wave + i; const float eg = __expf(gcL[h * 64 + tok]) * scale;
                                *(LAS unsigned*)(qN + tok * KP + lane * 4) = pk2(v0[i], v1[i]);
                                *(unsigned*)(ub + 16384 + ((tok >> 4) * 4 + cks) * 1024 + ((tok & 15) + 16 * cq) * 16 + (4 * ca + ce) * 2) = pk2(v0[i] * eg, v1[i] * eg); }
                        } else if (part == 1) {
                            unsigned short kg0[8], kg1[8], ke0[8], ke1[8];
#pragma unroll
                            for (int i = 0; i < 8; ++i) { const int tok = 8 * wave + i; const float gc = gcL[h * 64 + tok], bt = btL[h * 64 + tok], eg = __expf(gc) * bt, eend = __expf(gl - gc);
                                *(LAS unsigned*)(kN + tok * KP + lane * 4) = pk2(v0[i], v1[i]);
                                kg0[i] = (unsigned short)f2bf(v0[i] * eg); kg1[i] = (unsigned short)f2bf(v1[i] * eg); ke0[i] = (unsigned short)f2bf(v0[i] * eend); ke1[i] = (unsigned short)f2bf(v1[i] * eend); }
#pragma unroll
                            for (int hf = 0; hf < 2; ++hf) { const int pos = 32 * blk + 8 * (pq0 + hf) + 4 * pa; const int cl = 2 * lane;
                                *(u32x2*)(tmp + (size_t)j * 32768 + 16384 + cl * 128 + pos * 2) = (u32x2){(unsigned)kg0[4 * hf] | ((unsigned)kg0[4 * hf + 1] << 16), (unsigned)kg0[4 * hf + 2] | ((unsigned)kg0[4 * hf + 3] << 16)};
                                *(u32x2*)(tmp + (size_t)j * 32768 + 16384 + (cl + 1) * 128 + pos * 2) = (u32x2){(unsigned)kg1[4 * hf] | ((unsigned)kg1[4 * hf + 1] << 16), (unsigned)kg1[4 * hf + 2] | ((unsigned)kg1[4 * hf + 3] << 16)};
                                *(u32x2*)(ub + 32768 + ((cl >> 4) * 2 + blk) * 1024 + ((cl & 15) + 16 * (pq0 + hf)) * 16 + (4 * pa) * 2) = (u32x2){(unsigned)ke0[4 * hf] | ((unsigned)ke0[4 * hf + 1] << 16), (unsigned)ke0[4 * hf + 2] | ((unsigned)ke0[4 * hf + 3] << 16)};
                                *(u32x2*)(ub + 32768 + (((cl + 1) >> 4) * 2 + blk) * 1024 + (((cl + 1) & 15) + 16 * (pq0 + hf)) * 16 + (4 * pa) * 2) = (u32x2){(unsigned)ke1[4 * hf] | ((unsigned)ke1[4 * hf + 1] << 16), (unsigned)ke1[4 * hf + 2] | ((unsigned)ke1[4 * hf + 3] << 16)}; }
                        } else {
                            unsigned short vb0[8], vb1[8];
#pragma unroll
                            for (int i = 0; i < 8; ++i) { const float bt = btL[h * 64 + 8 * wave + i]; vb0[i] = (unsigned short)f2bf(v0[i] * bt); vb1[i] = (unsigned short)f2bf(v1[i] * bt); }
#pragma unroll
                            for (int hf = 0; hf < 2; ++hf) { const int pos = 32 * blk + 8 * (pq0 + hf) + 4 * pa; const int cl = 2 * lane;
                                *(u32x2*)(tmp + (size_t)j * 32768 + cl * 128 + pos * 2) = (u32x2){(unsigned)vb0[4 * hf] | ((unsigned)vb0[4 * hf + 1] << 16), (unsigned)vb0[4 * hf + 2] | ((unsigned)vb0[4 * hf + 3] << 16)};
                                *(u32x2*)(tmp + (size_t)j * 32768 + (cl + 1) * 128 + pos * 2) = (u32x2){(unsigned)vb1[4 * hf] | ((unsigned)vb1[4 * hf + 1] << 16), (unsigned)vb1[4 * hf + 2] | ((unsigned)vb1[4 * hf + 3] << 16)}; }
                        }
                        asm volatile("" ::: "memory"); }
                    }
                }
                if (h + 1 < 8) GDN_LOADX(h + 1);
                __syncthreads();
                {
                    const int mat = wave >> 2, rt = wave & 3; LAS unsigned char* An = mat ? qN : kN;
                    bf16x8 af[4];
#pragma unroll
                    for (int ks = 0; ks < 4; ++ks) af[ks] = *(const LAS bf16x8*)(An + (16 * rt + r16) * KP + (32 * ks + 8 * q4) * 2);
                    LAS float* slot = (LAS float*)(slots + j * 16384);
#pragma unroll
                    for (int ct = 0; ct < 4; ++ct) { f32x4 acc = {0.f, 0.f, 0.f, 0.f};
#pragma unroll
                        for (int ks = 0; ks < 4; ++ks) { const bf16x8 bf = *(const LAS bf16x8*)(kN + (16 * ct + r16) * KP + (32 * ks + 8 * q4) * 2); acc = __builtin_amdgcn_mfma_f32_16x16x32_bf16(af[ks], bf, acc, 0, 0, 0); }
                        const int jc = 16 * ct + r16; const float gj = gcL[h * 64 + jc];
#pragma unroll
                        for (int rg = 0; rg < 4; ++rg) { const int i = 16 * rt + 4 * q4 + rg; const float dec = __expf(gcL[h * 64 + i] - gj);
                            if (mat == 0) { slot[i * 64 + jc] = jc < i ? btL[h * 64 + i] * acc[rg] * dec : 0.f; }
                            else { const float v = jc <= i ? acc[rg] * scale * dec : 0.f;
                                *(unsigned short*)(ub + 49152 + (rt * 2 + (ct >> 1)) * 1024 + ((4 * q4 + rg) + 16 * (r16 >> 2)) * 16 + (4 * (ct & 1) + (r16 & 3)) * 2) = (unsigned short)f2bf(v); } }
                    }
                }
                __syncthreads();
            }
            if (wave < 4) gdn_solve((LAS float*)(slots + wave * 16384), (LAS unsigned short*)(X.lds + wave * 8192), lane);
            VM_WAIT(); __syncthreads();
            for (int j = 0; j < 4; ++j) {
                const int h = bb * 4 + j; unsigned char* ub = gi + (size_t)((b * 8 + h) * 64 + n) * GI_UNIT;
                const int mat = wave >> 2; LAS unsigned char* slot = X.lds + j * 8192;
#pragma unroll
                for (int cx = 0; cx < 2; ++cx) { const int ct = 2 * (wave & 3) + cx;
                    bf16x8 bfr[2];
#pragma unroll
                    for (int ks = 0; ks < 2; ++ks) { const u32x4 t = __builtin_nontemporal_load((const u32x4*)(tmp + (size_t)j * 32768 + mat * 16384 + (16 * ct + r16) * 128 + (32 * ks + 8 * q4) * 2)); bfr[ks] = __builtin_bit_cast(bf16x8, t); }
#pragma unroll
                    for (int rt = 0; rt < 4; ++rt) { f32x4 acc = {0.f, 0.f, 0.f, 0.f};
#pragma unroll
                        for (int ks = 0; ks < 2; ++ks) { const bf16x8 tf = *(const LAS bf16x8*)(slot + (rt * 2 + ks) * 1024 + lane * 16); acc = __builtin_amdgcn_mfma_f32_16x16x32_bf16(tf, bfr[ks], acc, 0, 0, 0); }
                        if (mat == 0) *(u32x2*)(ub + 57344 + (rt * 8 + ct) * 512 + lane * 8) = (u32x2){pg8::cvt_pk_bf16(acc[0], acc[1]), pg8::cvt_pk_bf16(acc[2], acc[3])};
                        else {
#pragma unroll
                            for (int rg = 0; rg < 4; ++rg) *(unsigned short*)(ub + (rt * 4 + (ct >> 1)) * 1024 + ((4 * q4 + rg) + 16 * (r16 >> 2)) * 16 + (4 * (ct & 1) + (r16 & 3)) * 2) = (unsigned short)f2bf(-acc[rg]);
                        }
                    }
                }
            }
            __syncthreads();
        }
    }
}
DEV void ph_gdn_scan(const Args& a, const Ctx& X) {
    const unsigned char* gi = a.ws + WS_GI; const float* glast = (const float*)(a.ws + WS_GLAST);
    const bf16_t* za = (const bf16_t*)(a.ws + WS_ZA); bf16_t* oy = (bf16_t*)(a.ws + WS_OY);
    const int lane = X.lane, wave = X.wave, r16 = lane & 15, q4 = lane >> 4, tid = X.tid;
    LAS float* OT = (LAS float*)(X.lds + 114688);
    const int bh = X.bid, b = bh >> 3, h = bh & 7;
    const unsigned char* ubase = gi + (size_t)bh * 64 * GI_UNIT;
    f32x4 S[8];
#pragma unroll
    for (int i = 0; i < 8; ++i) S[i] = (f32x4){0.f, 0.f, 0.f, 0.f};
    float nwv[16];
#pragma unroll
    for (int i = 0; i < 16; ++i) nwv[i] = a.gdn_norm_w[16 * (tid & 7) + i];
#define GDN_STAGE(nn, buf) do { _Pragma("unroll") for (int _i = 0; _i < 7; ++_i) \
        __builtin_amdgcn_global_load_lds((const unsigned*)(ubase + (size_t)(nn) * GI_UNIT + (size_t)(tid + 512 * _i) * 16), (LAS unsigned*)(X.lds + (buf) * 57344 + (wave * 64 + 512 * _i) * 16), 16, 0, 0); } while (0)
    u32x2 udn[4]; float gln; u32x4 zn[2];
    { const size_t tz = (size_t)b * SEQ + (tid >> 3); zn[0] = *(const u32x4*)(za + tz * 1024 + h * 128 + 16 * (tid & 7)); zn[1] = *(const u32x4*)(za + tz * 1024 + h * 128 + 16 * (tid & 7) + 8); }
#pragma unroll
    for (int ct = 0; ct < 4; ++ct) udn[ct] = *(const u32x2*)(ubase + 57344 + (ct * 8 + wave) * 512 + lane * 8);
    gln = glast[(size_t)(bh * 64) * 32];
    GDN_STAGE(0, 0);
#define GDN_EPILOGUE(nn, ZC) do { const int tok = tid >> 3, seg = tid & 7; const size_t t = (size_t)b * SEQ + 64 * (nn) + tok; \
            float ov[16]; float ss = 0.f; \
            _Pragma("unroll") for (int i = 0; i < 4; ++i) { const f32x4 v = *(const LAS f32x4*)(OT + tok * 132 + 16 * seg + 4 * i); ov[4 * i] = v[0]; ov[4 * i + 1] = v[1]; ov[4 * i + 2] = v[2]; ov[4 * i + 3] = v[3]; ss += v[0] * v[0] + v[1] * v[1] + v[2] * v[2] + v[3] * v[3]; } \
            ss += __shfl_xor(ss, 1); ss += __shfl_xor(ss, 2); ss += __shfl_xor(ss, 4); \
            const float rstd = rsqrtf(ss * (1.f / 128.f) + EPS); \
            u32x4 ow[2]; \
            _Pragma("unroll") for (int i = 0; i < 2; ++i) _Pragma("unroll") for (int e = 0; e < 4; ++e) { const unsigned zw = (ZC)[i][e]; const float z0 = __uint_as_float(zw << 16), z1 = __uint_as_float(zw & 0xFFFF0000u); \
                    ow[i][e] = pg8::cvt_pk_bf16(ov[8 * i + 2 * e] * rstd * nwv[8 * i + 2 * e] * siluf(z0), ov[8 * i + 2 * e + 1] * rstd * nwv[8 * i + 2 * e + 1] * siluf(z1)); } \
            *(u32x4*)(oy + t * 2048 + h * 128 + 16 * seg) = ow[0]; *(u32x4*)(oy + t * 2048 + h * 128 + 16 * seg + 8) = ow[1]; } while (0)
    u32x4 zp[2] = {{0u, 0u, 0u, 0u}, {0u, 0u, 0u, 0u}};
    for (int n = 0; n < 64; ++n) {
        VM_WAIT(); __syncthreads();
        f32x4 uf[4];
#pragma unroll
        for (int ct = 0; ct < 4; ++ct) { uf[ct][0] = __uint_as_float(udn[ct].x << 16); uf[ct][1] = __uint_as_float(udn[ct].x & 0xFFFF0000u); uf[ct][2] = __uint_as_float(udn[ct].y << 16); uf[ct][3] = __uint_as_float(udn[ct].y & 0xFFFF0000u); }
        const float egl = __expf(gln);
        u32x4 zc[2]; zc[0] = zn[0]; zc[1] = zn[1];
        asm volatile("" : "+v"(uf[0]), "+v"(uf[1]), "+v"(uf[2]), "+v"(uf[3]), "+v"(zc[0]), "+v"(zc[1]));
        if (n + 1 < 64) {
            const unsigned char* un = ubase + (size_t)(n + 1) * GI_UNIT;
#pragma unroll
            for (int ct = 0; ct < 4; ++ct) udn[ct] = *(const u32x2*)(un + 57344 + (ct * 8 + wave) * 512 + lane * 8);
            gln = glast[(size_t)(bh * 64 + n + 1) * 32];
            { const size_t tz = (size_t)b * SEQ + 64 * (n + 1) + (tid >> 3); zn[0] = *(const u32x4*)(za + tz * 1024 + h * 128 + 16 * (tid & 7)); zn[1] = *(const u32x4*)(za + tz * 1024 + h * 128 + 16 * (tid & 7) + 8); }
            GDN_STAGE(n + 1, (n + 1) & 1);
        }
        if (n > 0) GDN_EPILOGUE(n - 1, zp);
        zp[0] = zc[0]; zp[1] = zc[1];
        const LAS unsigned char* L = X.lds + (n & 1) * 57344;
        bf16x8 sB[4];
#pragma unroll
        for (int ks = 0; ks < 4; ++ks) sB[ks] = acc_to_frag(S[2 * ks], S[2 * ks + 1]);
        f32x4 vn[4], oo[4];
#pragma unroll
        for (int ct = 0; ct < 4; ++ct) { f32x4 acc = {0.f, 0.f, 0.f, 0.f}, ao = {0.f, 0.f, 0.f, 0.f};
#pragma unroll
            for (int ks = 0; ks < 4; ++ks) { const bf16x8 wf = *(const LAS bf16x8*)(L + (ct * 4 + ks) * 1024 + lane * 16), qf = *(const LAS bf16x8*)(L + 16384 + (ct * 4 + ks) * 1024 + lane * 16);
                acc = __builtin_amdgcn_mfma_f32_16x16x32_bf16(wf, sB[ks], acc, 0, 0, 0); ao = __builtin_amdgcn_mfma_f32_16x16x32_bf16(qf, sB[ks], ao, 0, 0, 0); }
            vn[ct] = acc; oo[ct] = ao; }
#pragma unroll
        for (int ct = 0; ct < 4; ++ct) vn[ct] = vn[ct] + uf[ct];
        bf16x8 vB[2];
#pragma unroll
        for (int ks = 0; ks < 2; ++ks) vB[ks] = acc_to_frag(vn[2 * ks], vn[2 * ks + 1]);
#pragma unroll
        for (int ct = 0; ct < 4; ++ct)
#pragma unroll
            for (int ks = 0; ks < 2; ++ks) { const bf16x8 kf = *(const LAS bf16x8*)(L + 49152 + (ct * 2 + ks) * 1024 + lane * 16); oo[ct] = __builtin_amdgcn_mfma_f32_16x16x32_bf16(kf, vB[ks], oo[ct], 0, 0, 0); }
#pragma unroll
        for (int dt = 0; dt < 8; ++dt) { f32x4 acc = S[dt] * egl;
#pragma unroll
            for (int ks = 0; ks < 2; ++ks) { const bf16x8 ef = *(const LAS bf16x8*)(L + 32768 + (dt * 2 + ks) * 1024 + lane * 16); acc = __builtin_amdgcn_mfma_f32_16x16x32_bf16(ef, vB[ks], acc, 0, 0, 0); }
            S[dt] = acc; }
        __syncthreads();
#pragma unroll
        for (int ct = 0; ct < 4; ++ct)
#pragma unroll
            for (int rg = 0; rg < 4; ++rg) OT[(16 * ct + 4 * q4 + rg) * 132 + 16 * wave + r16] = oo[ct][rg];
    }
    __syncthreads();
    GDN_EPILOGUE(63, zp);
#undef GDN_EPILOGUE
#undef GDN_STAGE
}

constexpr int SP = 272;
DEV void ph_ssd_local(const Args& a, const Ctx& X) {
    const bf16_t* xbcpre = (const bf16_t*)(a.ws + WS_XBCPRE); const float* small = (const float*)(a.ws + WS_SMALL);
    bf16_t* CC = (bf16_t*)(a.ws + WS_CC); float* acum = (float*)(a.ws + WS_ACUM); float* cdec = (float*)(a.ws + WS_CDEC);
    bf16_t* ydiag = (bf16_t*)(a.ws + WS_YDIAG); bf16_t* states = (bf16_t*)(a.ws + WS_STATES);
    LAS unsigned char* Bn = X.lds; LAS unsigned char* Cn = X.lds + 128 * SP; LAS unsigned char* BT = X.lds + 256 * SP;
    LAS unsigned char* xdT = X.lds; LAS unsigned char* xeT = X.lds + 64 * SP;
    LAS float* acL = (LAS float*)(X.lds + AUX_OFF); LAS float* dtL = acL + 8 * 128;
    const int lane = X.lane, wave = X.wave, r16 = lane & 15, q4 = lane >> 4;
    for (int unit = X.bid; unit < NB * 32 * 2; unit += X.G) {
        const int g = unit & 1, c = (unit >> 1) & 31, b = unit >> 6; const size_t t0 = (size_t)b * SEQ + 128 * c;
        __syncthreads();
        {
            const int hd = g * 8 + wave; const float an = -__expf(a.ssd_a_log[hd]), bias = a.ssd_dt_bias[hd];
            const float d0 = softplusf(small[(t0 + lane) * 32 + 16 + hd] + bias), d1 = softplusf(small[(t0 + 64 + lane) * 32 + 16 + hd] + bias);
            float s0 = d0 * an, s1 = d1 * an;
#pragma unroll
            for (int o = 1; o < 64; o <<= 1) { const float v0 = __shfl_up(s0, o), v1 = __shfl_up(s1, o); if (lane >= o) { s0 += v0; s1 += v1; } }
            s1 += __shfl(s0, 63);
            acL[wave * 128 + lane] = s0; acL[wave * 128 + 64 + lane] = s1; dtL[wave * 128 + lane] = d0; dtL[wave * 128 + 64 + lane] = d1;
            acum[((size_t)g * T + t0 + lane) * 8 + wave] = s0; acum[((size_t)g * T + t0 + 64 + lane) * 8 + wave] = s1;
            if (lane == 63) cdec[(size_t)unit * 32 + wave] = __expf(s1);
        }
        {
            const int isC = lane >> 5, cc = (lane & 31) * 4, col = 1024 + isC * 256 + g * 128 + cc;
            float w[4][4], bs[4];
#pragma unroll
            for (int i = 0; i < 4; ++i) { const f32x4 t = *(const f32x4*)(a.ssd_conv_w + i * 1536 + col); w[i][0] = t[0]; w[i][1] = t[1]; w[i][2] = t[2]; w[i][3] = t[3]; }
            { const f32x4 t = *(const f32x4*)(a.ssd_conv_b + col); bs[0] = t[0]; bs[1] = t[1]; bs[2] = t[2]; bs[3] = t[3]; }
            float xin[19][4];
#pragma unroll
            for (int i = 0; i < 19; ++i) { const int tk = 16 * wave + i - 3; const bool ok = (128 * c + tk) >= 0; u32x2 v = {0u, 0u}; if (ok) v = *(const u32x2*)(xbcpre + (t0 + tk) * 1536 + col);
                xin[i][0] = __uint_as_float(v.x << 16); xin[i][1] = __uint_as_float(v.x & 0xFFFF0000u); xin[i][2] = __uint_as_float(v.y << 16); xin[i][3] = __uint_as_float(v.y & 0xFFFF0000u); }
            unsigned short ov[16][4];
#pragma unroll
            for (int i = 0; i < 16; ++i)
#pragma unroll
                for (int e = 0; e < 4; ++e) { const float s = bs[e] + w[0][e] * xin[i][e] + w[1][e] * xin[i + 1][e] + w[2][e] * xin[i + 2][e] + w[3][e] * xin[i + 3][e]; ov[i][e] = (unsigned short)f2bf(siluf(s)); }
            LAS unsigned char* nat = isC ? Cn : Bn;
#pragma unroll
            for (int i = 0; i < 16; ++i) { const u32x2 pk = {(unsigned)ov[i][0] | ((unsigned)ov[i][1] << 16), (unsigned)ov[i][2] | ((unsigned)ov[i][3] << 16)};
                *(LAS u32x2*)(nat + (16 * wave + i) * SP + cc * 2) = pk;
                if (isC) *(u32x2*)(CC + (t0 + 16 * wave + i) * 256 + g * 128 + cc) = pk; }
            if (!isC) {
#pragma unroll
                for (int e = 0; e < 4; ++e)
#pragma unroll
                    for (int qq = 0; qq < 4; ++qq) { const u32x2 pk = {(unsigned)ov[4 * qq][e] | ((unsigned)ov[4 * qq + 1][e] << 16), (unsigned)ov[4 * qq + 2][e] | ((unsigned)ov[4 * qq + 3][e] << 16)};
                        *(LAS u32x2*)(BT + (cc + e) * SP + (32 * (wave >> 1) + 8 * qq + 4 * (wave & 1)) * 2) = pk; }
            }
        }
        __syncthreads();
        f32x4 cbt[8];
        {
            bf16x8 cf[4];
#pragma unroll
            for (int ks = 0; ks < 4; ++ks) cf[ks] = *(const LAS bf16x8*)(Cn + (16 * wave + r16) * SP + (32 * ks + 8 * q4) * 2);
#pragma unroll
            for (int st = 0; st < 8; ++st) { cbt[st] = (f32x4){0.f, 0.f, 0.f, 0.f};
#pragma unroll
                for (int ks = 0; ks < 4; ++ks) { const bf16x8 bf = *(const LAS bf16x8*)(Bn + (16 * st + r16) * SP + (32 * ks + 8 * q4) * 2); cbt[st] = __builtin_amdgcn_mfma_f32_16x16x32_bf16(bf, cf[ks], cbt[st], 0, 0, 0); } }
        }
        __syncthreads();
        const int lq = 16 * wave + r16;
        for (int r = 0; r < 8; ++r) {
            const int hd = g * 8 + r; const float dd = a.ssd_d[hd];
            {
                const int col = hd * 64 + lane; float w0 = a.ssd_conv_w[col], w1 = a.ssd_conv_w[1536 + col], w2 = a.ssd_conv_w[2 * 1536 + col], w3 = a.ssd_conv_w[3 * 1536 + col]; const float bs = a.ssd_conv_b[col];
                float xin[19];
#pragma unroll
                for (int i = 0; i < 19; ++i) { const int tk = 16 * wave + i - 3; xin[i] = (128 * c + tk) >= 0 ? bf2f(xbcpre[(t0 + tk) * 1536 + col]) : 0.f; }
                const float aclast = acL[r * 128 + 127];
                unsigned short xd[16], xe[16];
#pragma unroll
                for (int i = 0; i < 16; ++i) { const float xv = siluf(bs + w0 * xin[i] + w1 * xin[i + 1] + w2 * xin[i + 2] + w3 * xin[i + 3]); const int tk = 16 * wave + i;
                    const float xdv = xv * dtL[r * 128 + tk]; xd[i] = (unsigned short)f2bf(xdv); xe[i] = (unsigned short)f2bf(xdv * __expf(aclast - acL[r * 128 + tk])); }
#pragma unroll
                for (int qq = 0; qq < 4; ++qq) { const int pos = 32 * (wave >> 1) + 8 * qq + 4 * (wave & 1);
                    *(LAS u32x2*)(xdT + lane * SP + pos * 2) = (u32x2){(unsigned)xd[4 * qq] | ((unsigned)xd[4 * qq + 1] << 16), (unsigned)xd[4 * qq + 2] | ((unsigned)xd[4 * qq + 3] << 16)};
                    *(LAS u32x2*)(xeT + lane * SP + pos * 2) = (u32x2){(unsigned)xe[4 * qq] | ((unsigned)xe[4 * qq + 1] << 16), (unsigned)xe[4 * qq + 2] | ((unsigned)xe[4 * qq + 3] << 16)}; }
            }
            __syncthreads();
            {
                const float acl = acL[r * 128 + lq], ddt = dd / dtL[r * 128 + lq];
                f32x4 yd[4];
#pragma unroll
                for (int pt = 0; pt < 4; ++pt) yd[pt] = (f32x4){0.f, 0.f, 0.f, 0.f};
#pragma unroll
                for (int ks = 0; ks < 4; ++ks) { if (ks <= (wave >> 1)) {
                    f32x4 mlo, mhi;
#pragma unroll
                    for (int e = 0; e < 4; ++e) {
                        const int s0 = 32 * ks + 4 * q4 + e, s1 = s0 + 16;
                        const float v0 = cbt[2 * ks][e], v1 = cbt[2 * ks + 1][e];
                        mlo[e] = s0 < lq ? v0 * __expf(acl - acL[r * 128 + s0]) : (s0 == lq ? v0 + ddt : 0.f);
                        mhi[e] = s1 < lq ? v1 * __expf(acl - acL[r * 128 + s1]) : (s1 == lq ? v1 + ddt : 0.f);
                    }
                    const bf16x8 mf = acc_to_frag(mlo, mhi);
#pragma unroll
                    for (int pt = 0; pt < 4; ++pt) { const bf16x8 xf = *(const LAS bf16x8*)(xdT + (16 * pt + r16) * SP + (32 * ks + 8 * q4) * 2); yd[pt] = __builtin_amdgcn_mfma_f32_16x16x32_bf16(xf, mf, yd[pt], 0, 0, 0); }
                } }
#pragma unroll
                for (int pt = 0; pt < 4; ++pt) *(u32x2*)(ydiag + (t0 + lq) * 1024 + hd * 64 + 16 * pt + 4 * q4) = (u32x2){pg8::cvt_pk_bf16(yd[pt][0], yd[pt][1]), pg8::cvt_pk_bf16(yd[pt][2], yd[pt][3])};
            }
            {
                bf16x8 bf[4];
#pragma unroll
                for (int ks = 0; ks < 4; ++ks) bf[ks] = *(const LAS bf16x8*)(BT + (16 * wave + r16) * SP + (32 * ks + 8 * q4) * 2);
                bf16_t* hp = states + ((size_t)(unit * 8 + r) * 64) * 128;
#pragma unroll
                for (int pt = 0; pt < 4; ++pt) { f32x4 st = {0.f, 0.f, 0.f, 0.f};
#pragma unroll
                    for (int ks = 0; ks < 4; ++ks) { const bf16x8 xf = *(const LAS bf16x8*)(xeT + (16 * pt + r16) * SP + (32 * ks + 8 * q4) * 2); st = __builtin_amdgcn_mfma_f32_16x16x32_bf16(bf[ks], xf, st, 0, 0, 0); }
                    *(u32x2*)(hp + (size_t)(16 * pt + r16) * 128 + 16 * wave + 4 * q4) = (u32x2){pg8::cvt_pk_bf16(st[0], st[1]), pg8::cvt_pk_bf16(st[2], st[3])}; }
            }
            __syncthreads();
        }
    }
}
DEV void ph_ssd_scan(const Args& a, const Ctx& X, const int wg0) {
    bf16_t* states = (bf16_t*)(a.ws + WS_STATES); const float* cdec = (const float*)(a.ws + WS_CDEC);
    for (int task = (X.bid - wg0) * NTHR + X.tid; task < NB * 16 * 64 * 32; task += (X.G - wg0) * NTHR) {
        const int n4 = task & 31, p = (task >> 5) & 63, hd = (task >> 11) & 15, b = task >> 15;
        float h0 = 0.f, h1 = 0.f, h2 = 0.f, h3 = 0.f;
        for (int c = 0; c < 32; ++c) {
            const int unit = (b * 32 + c) * 2 + (hd >> 3);
            u32x2* ptr = (u32x2*)(states + ((size_t)(unit * 8 + (hd & 7)) * 64 + p) * 128 + 4 * n4);
            const u32x2 sv = *ptr; const float dec = cdec[(size_t)unit * 32 + (hd & 7)];
            *ptr = (u32x2){pk2(h0, h1), pk2(h2, h3)};
            h0 = h0 * dec + __uint_as_float(sv.x << 16); h1 = h1 * dec + __uint_as_float(sv.x & 0xFFFF0000u); h2 = h2 * dec + __uint_as_float(sv.y << 16); h3 = h3 * dec + __uint_as_float(sv.y & 0xFFFF0000u);
        }
    }
}
DEV void ph_ssd_out(const Args& a, const Ctx& X, const int wg0) {
    const bf16_t* CC = (const bf16_t*)(a.ws + WS_CC); const float* acum = (const float*)(a.ws + WS_ACUM); const bf16_t* ydiag = (const bf16_t*)(a.ws + WS_YDIAG);
    const bf16_t* states = (const bf16_t*)(a.ws + WS_STATES); const bf16_t* zb = (const bf16_t*)(a.ws + WS_ZB); bf16_t* oy = (bf16_t*)(a.ws + WS_OY);
    const int lane = X.lane, wave = X.wave, r16 = lane & 15, q4 = lane >> 4;
    for (int unit = X.bid - wg0; unit < NB * 32 * 2; unit += X.G - wg0) {
        const int g = unit & 1, c = (unit >> 1) & 31, b = unit >> 6; const size_t t = (size_t)b * SEQ + 128 * c + 16 * wave + r16;
        bf16x8 cf[4];
#pragma unroll
        for (int ks = 0; ks < 4; ++ks) cf[ks] = *(const bf16x8*)(CC + t * 256 + g * 128 + 32 * ks + 8 * q4);
        float ss = 0.f;
        LAS u32x2* stash = (LAS u32x2*)(X.lds + wave * 16384);
        for (int r = 0; r < 8; ++r) {
            const int hd = g * 8 + r; const float eac = __expf(acum[((size_t)g * T + t) * 8 + r]);
            const bf16_t* hp = states + ((size_t)(unit * 8 + r) * 64) * 128;
#pragma unroll
            for (int pt = 0; pt < 4; ++pt) { f32x4 acc = {0.f, 0.f, 0.f, 0.f};
#pragma unroll
                for (int ks = 0; ks < 4; ++ks) { const bf16x8 hf = *(const bf16x8*)(hp + (size_t)(16 * pt + r16) * 128 + 32 * ks + 8 * q4); acc = __builtin_amdgcn_mfma_f32_16x16x32_bf16(hf, cf[ks], acc, 0, 0, 0); }
                const u32x2 yd = *(const u32x2*)(ydiag + t * 1024 + hd * 64 + 16 * pt + 4 * q4), zz = *(const u32x2*)(zb + t * 1024 + hd * 64 + 16 * pt + 4 * q4);
                f32x4 v; v[0] = acc[0] * eac + __uint_as_float(yd.x << 16); v[1] = acc[1] * eac + __uint_as_float(yd.x & 0xFFFF0000u); v[2] = acc[2] * eac + __uint_as_float(yd.y << 16); v[3] = acc[3] * eac + __uint_as_float(yd.y & 0xFFFF0000u);
                v[0] *= siluf(__uint_as_float(zz.x << 16)); v[1] *= siluf(__uint_as_float(zz.x & 0xFFFF0000u)); v[2] *= siluf(__uint_as_float(zz.y << 16)); v[3] *= siluf(__uint_as_float(zz.y & 0xFFFF0000u));
                ss += v[0] * v[0] + v[1] * v[1] + v[2] * v[2] + v[3] * v[3];
                stash[(r * 4 + pt) * 64 + lane] = (u32x2){pg8::cvt_pk_bf16(v[0], v[1]), pg8::cvt_pk_bf16(v[2], v[3])}; }
        }
        ss += __shfl_xor(ss, 16); ss += __shfl_xor(ss, 32);
        const float rstd = rsqrtf(ss * (1.f / 512.f) + EPS);
        for (int r = 0; r < 8; ++r)
#pragma unroll
            for (int pt = 0; pt < 4; ++pt) { const int cix = g * 512 + r * 64 + 16 * pt + 4 * q4; const f32x4 nw = *(const f32x4*)(a.ssd_norm_w + cix); const u32x2 w = stash[(r * 4 + pt) * 64 + lane];
                *(u32x2*)(oy + t * 2048 + 1024 + cix) = (u32x2){pg8::cvt_pk_bf16(__uint_as_float(w.x << 16) * rstd * nw[0], __uint_as_float(w.x & 0xFFFF0000u) * rstd * nw[1]), pg8::cvt_pk_bf16(__uint_as_float(w.y << 16) * rstd * nw[2], __uint_as_float(w.y & 0xFFFF0000u) * rstd * nw[3])}; }
    }
}

DEV void ph_attn_naive(const Args& a, const Ctx& X) {
    const bf16_t* qkv = (const bf16_t*)(a.ws + WS_Q1KV); bf16_t* o = (bf16_t*)(a.ws + WS_O1);
    const int lane = X.lane;
    for (int wid = X.bid * NWAVES + X.wave; wid < T * 16; wid += X.G * NWAVES) {
        const int t = wid >> 4, hh = wid & 15, s = t % SEQ;
        const float q = bf2f(qkv[(size_t)t * 3072 + hh * 64 + lane]);
        float m = -INFINITY, l = 0.f, acc = 0.f;
#pragma unroll
        for (int br = 0; br < 3; ++br) { const int d = br == 0 ? 1 : (br == 1 ? 4 : 16);
            for (int j = 0; j <= 128; ++j) { if (s - d * j < 0) break;
                const bf16_t* kr = qkv + (size_t)(t - d * j) * 3072 + 1024 + hh * 64;
                const float sc = wave_sum(q * bf2f(kr[lane]));
                const float mn = fmaxf(m, sc), al = __expf(m - mn), p = __expf(sc - mn);
                l = l * al + p; acc = acc * al + p * bf2f(kr[1024 + lane]); m = mn; } }
        o[(size_t)t * 1024 + hh * 64 + lane] = (bf16_t)f2bf(acc / l);
    }
}

DEV void ph_attn(const Args& a, const Ctx& X) {
    const bf16_t* qkv = (const bf16_t*)(a.ws + WS_Q1KV); bf16_t* po = (bf16_t*)(a.ws + WS_PO); float* plse = (float*)(a.ws + WS_PLSE); bf16_t* o = (bf16_t*)(a.ws + WS_O1);
    LAS unsigned char* vl = X.lds + X.wave * 12288;
    LAS unsigned char* kl = vl + 6144;
    const int lane = X.lane, q = lane & 31, h5 = lane >> 5;
    const int tr_off = ((lane & 15) >> 2) * 192 + (16 * ((lane >> 4) & 1) + 4 * (lane & 3)) * 2;
    const int prow = lane >> 3, pch = lane & 7;
    for (int unit = X.bid; unit < NB * 16 * 8; unit += X.G) {
        const int b = unit >> 7, hd = (unit >> 3) & 15, g = unit & 7;
        for (int tk = 0; tk < 6; ++tk) {
            const int br = tk >> 1, k = X.wave * 2 + (tk & 1);
            int d, r, i0;
            if (br == 0) { d = 1; r = 0; i0 = 512 * g + 32 * k; } else if (br == 1) { d = 4; r = k & 3; i0 = 128 * g + 32 * (k >> 2); } else { d = 16; r = k; i0 = 32 * g; }
            const size_t tq = (size_t)b * SEQ + (size_t)(i0 + q) * d + r;
#define ATT_LOAD(dst, j0_, coff) do { _Pragma("unroll") for (int _i = 0; _i < 4; ++_i) { const size_t _t = (size_t)b * SEQ + (size_t)((j0_) + 8 * _i + prow) * d + r; \
                dst[_i] = *(const u32x4*)(qkv + _t * 3072 + (coff) + hd * 64 + pch * 8); } } while (0)
            u32x4 kp[4], vp[4];
            ATT_LOAD(kp, i0, 0);
#pragma unroll
            for (int i = 0; i < 4; ++i) *(LAS u32x4*)(kl + (8 * i + prow) * 144 + pch * 16) = kp[i];
            ATT_LOAD(kp, i0, 1024); ATT_LOAD(vp, i0, 2048);
            bf16x8 qf[4];
#pragma unroll
            for (int s = 0; s < 4; ++s) qf[s] = *(const LAS bf16x8*)(kl + q * 144 + (16 * s + 8 * h5) * 2);
            LDS_WAIT();
            f32x16 oacc[2];
#pragma unroll
            for (int i = 0; i < 16; ++i) { oacc[0][i] = 0.f; oacc[1][i] = 0.f; }
            float m = -1e30f, l = 0.f;
            for (int kt = 4; kt >= 0; --kt) {
                const int jn = i0 - 128 + 32 * (kt - 1); const bool has_next = (kt > 0) && (jn >= 0);
#pragma unroll
                for (int i = 0; i < 4; ++i) { *(LAS u32x4*)(kl + (8 * i + prow) * 144 + pch * 16) = kp[i]; *(LAS u32x4*)(vl + (8 * i + prow) * 192 + pch * 16) = vp[i]; }
                if (has_next) { ATT_LOAD(kp, jn, 1024); ATT_LOAD(vp, jn, 2048); }
                f32x16 sacc;
#pragma unroll
                for (int i = 0; i < 16; ++i) sacc[i] = 0.f;
#pragma unroll
                for (int s = 0; s < 4; ++s) { const bf16x8 kf = *(const LAS bf16x8*)(kl + q * 144 + (16 * s + 8 * h5) * 2); sacc = __builtin_amdgcn_mfma_f32_32x32x16_bf16(kf, qf[s], sacc, 0, 0, 0); }
                if (kt == 4) {
#pragma unroll
                    for (int i = 0; i < 16; ++i) { const int kl_ = (i & 3) + 8 * (i >> 2) + 4 * h5; if (kl_ > q) sacc[i] = -1e30f; }
                } else if (kt == 0) {
#pragma unroll
                    for (int i = 0; i < 16; ++i) { const int kl_ = (i & 3) + 8 * (i >> 2) + 4 * h5; if (kl_ < q) sacc[i] = -1e30f; }
                }
                float mx = sacc[0];
#pragma unroll
                for (int i = 1; i < 16; ++i) mx = fmaxf(mx, sacc[i]);
                mx = fmaxf(mx, __shfl_xor(mx, 32));
                const float mn = fmaxf(m, mx), alpha = __expf(m - mn);
                float rs = 0.f;
#pragma unroll
                for (int i = 0; i < 16; ++i) { sacc[i] = __expf(sacc[i] - mn); rs += sacc[i]; }
                rs += __shfl_xor(rs, 32);
                l = l * alpha + rs; m = mn;
#pragma unroll
                for (int i = 0; i < 16; ++i) { oacc[0][i] *= alpha; oacc[1][i] *= alpha; }
                bf16x8 pf[2];
#pragma unroll
                for (int s = 0; s < 2; ++s) { u32x4 w; w.x = pg8::cvt_pk_bf16(sacc[8 * s], sacc[8 * s + 1]); w.y = pg8::cvt_pk_bf16(sacc[8 * s + 2], sacc[8 * s + 3]); w.z = pg8::cvt_pk_bf16(sacc[8 * s + 4], sacc[8 * s + 5]); w.w = pg8::cvt_pk_bf16(sacc[8 * s + 6], sacc[8 * s + 7]);
                    pf[s] = __builtin_bit_cast(bf16x8, w); }
#pragma unroll
                for (int dt = 0; dt < 2; ++dt)
#pragma unroll
                    for (int s = 0; s < 2; ++s) {
                        const s16x4 v0 = __builtin_amdgcn_ds_read_tr16_b64_v4i16((LAS s16x4*)(vl + (16 * s + 4 * h5) * 192 + dt * 64 + tr_off));
                        const s16x4 v1 = __builtin_amdgcn_ds_read_tr16_b64_v4i16((LAS s16x4*)(vl + (16 * s + 8 + 4 * h5) * 192 + dt * 64 + tr_off));
                        bf16x8 vf; vf[0] = v0[0]; vf[1] = v0[1]; vf[2] = v0[2]; vf[3] = v0[3]; vf[4] = v1[0]; vf[5] = v1[1]; vf[6] = v1[2]; vf[7] = v1[3];
                        oacc[dt] = __builtin_amdgcn_mfma_f32_32x32x16_bf16(vf, pf[s], oacc[dt], 0, 0, 0);
                    }
                LDS_WAIT();
                if (!has_next) break;
            }
#undef ATT_LOAD
            const float inv = 1.f / l;
            bf16_t* pr = po + ((size_t)br * T + tq) * 1024 + hd * 64;
#pragma unroll
            for (int dt = 0; dt < 2; ++dt)
#pragma unroll
                for (int gq = 0; gq < 4; ++gq) { u32x2 w; w.x = pg8::cvt_pk_bf16(oacc[dt][4 * gq] * inv, oacc[dt][4 * gq + 1] * inv); w.y = pg8::cvt_pk_bf16(oacc[dt][4 * gq + 2] * inv, oacc[dt][4 * gq + 3] * inv);
                    *(u32x2*)(pr + 32 * dt + 8 * gq + 4 * h5) = w; }
            if (h5 == 0) plse[((size_t)br * T + tq) * 16 + hd] = m + __logf(l);
        }
        VM_WAIT(); __syncthreads();
        {
            const size_t t = (size_t)b * SEQ + 512 * g + X.tid;
            const float l0 = plse[t * 16 + hd], l1 = plse[((size_t)T + t) * 16 + hd], l2 = plse[((size_t)2 * T + t) * 16 + hd];
            const float mx = fmaxf(l0, fmaxf(l1, l2)); float w0 = __expf(l0 - mx), w1 = __expf(l1 - mx), w2 = __expf(l2 - mx); const float wi = 1.f / (w0 + w1 + w2); w0 *= wi; w1 *= wi; w2 *= wi;
            const bf16_t* p0 = po + t * 1024 + hd * 64; const bf16_t* p1 = p0 + (size_t)T * 1024; const bf16_t* p2 = p1 + (size_t)T * 1024; bf16_t* orow = o + t * 1024 + hd * 64;
#pragma unroll
            for (int c = 0; c < 8; ++c) { const u32x4 x0 = *(const u32x4*)(p0 + 8 * c), x1 = *(const u32x4*)(p1 + 8 * c), x2 = *(const u32x4*)(p2 + 8 * c); u32x4 y;
#pragma unroll
                for (int e = 0; e < 4; ++e) { const float lo = w0 * __uint_as_float(x0[e] << 16) + w1 * __uint_as_float(x1[e] << 16) + w2 * __uint_as_float(x2[e] << 16);
                    const float hi = w0 * __uint_as_float(x0[e] & 0xFFFF0000u) + w1 * __uint_as_float(x1[e] & 0xFFFF0000u) + w2 * __uint_as_float(x2[e] & 0xFFFF0000u); y[e] = pk2(lo, hi); }
                *(u32x4*)(orow + 8 * c) = y; }
        }
    }
}

DEV void ph_router(const Args& a, const Ctx& X, const int l) {
    unsigned char* ws = a.ws;
    const float* mod = (const float*)(ws + WS_MOD) + (size_t)l * NB * 6 * D;
    const float* ymix = (const float*)(ws + WS_YMIX);
    const float* xin = (l == 0) ? a.x : a.out;
    bf16_t* hb = (bf16_t*)(ws + WS_H);
    int* idx = (int*)(ws + WS_IDX); float* gw = (float*)(ws + WS_GW); int* aslot = (int*)(ws + WS_ASLOT); int* ltok = (int*)(ws + WS_LTOK);
    int* cntg = (int*)(ws + WS_CTL + CTL_CNT) + l * NE;
    const float* rw = a.router_w + (size_t)l * D * NE; const float* rbias = a.router_bias + l * NE;
    constexpr int HP = 2064;
    LAS unsigned char* hL = X.lds;
    LAS float* logit = (LAS float*)(X.lds + AUX_OFF + 2048);
    LAS int* lcnt = (LAS int*)(X.lds + AUX_OFF + 2048 + 64 * 65 * 4);
    LAS int* lbase = lcnt + 64;
    LAS int* sel_e = lbase + 64;
    LAS int* sel_s = sel_e + 512;
    const int lane = X.lane, wave = X.wave;
    for (int rb = X.bid; rb < T / 64; rb += X.G) {
        if (X.tid < 64) lcnt[X.tid] = 0;
        for (int r8 = 0; r8 < 8; ++r8) {
            const int lr = wave * 8 + r8, row = rb * 64 + lr, b = row / SEQ; const float* ml = mod + (size_t)b * 6 * D;
            float xv[16], yv[16]; load_row(xin + (size_t)row * D, lane, xv); load_row(ymix + (size_t)row * D, lane, yv);
            resid_update(xv, yv, a.mix_post_g + l * D, ml + 2 * D, lane);
            store_row(a.out + (size_t)row * D, lane, xv);
            u32x2 o[4]; prenorm_pack(xv, a.ffn_pre_g + l * D, ml + 4 * D, ml + 3 * D, lane, o);
#pragma unroll
            for (int j = 0; j < 4; ++j) { *(u32x2*)(hb + (size_t)row * D + j * 256 + lane * 4) = o[j]; *(LAS u32x2*)(hL + lr * HP + (j * 256 + lane * 4) * 2) = o[j]; }
        }
        __syncthreads();
        { const int rt = wave & 3, nh = wave >> 2, r16 = lane & 15, kq = lane >> 4;
          f32x4 acc0 = {0.f, 0.f, 0.f, 0.f}, acc1 = {0.f, 0.f, 0.f, 0.f};
          for (int c = 0; c < 32; ++c) {
              const u32x4 hv = *(const LAS u32x4*)(hL + (rt * 16 + r16) * HP + (32 * c + 8 * kq) * 2);
              const float* rp = rw + (size_t)(32 * c + 8 * kq) * NE + 4 * r16 + 2 * nh;
#pragma unroll
              for (int j = 0; j < 8; ++j) { const unsigned wj = hv[j >> 1]; const float av = (j & 1) ? __uint_as_float(wj & 0xFFFF0000u) : __uint_as_float(wj << 16);
                  const f32x2 bv = *(const f32x2*)(rp + (size_t)j * NE);
                  acc0 = __builtin_amdgcn_mfma_f32_16x16x4f32(av, bv.x, acc0, 0, 0, 0); acc1 = __builtin_amdgcn_mfma_f32_16x16x4f32(av, bv.y, acc1, 0, 0, 0); }
          }
#pragma unroll
          for (int r = 0; r < 4; ++r) { logit[(rt * 16 + 4 * kq + r) * 65 + 4 * r16 + 2 * nh] = acc0[r]; logit[(rt * 16 + 4 * kq + r) * 65 + 4 * r16 + 2 * nh + 1] = acc1[r]; } }
        __syncthreads();
        for (int r8 = 0; r8 < 8; ++r8) {
            const int lr = wave * 8 + r8, t = rb * 64 + lr;
            float lgt = logit[lr * 65 + lane]; if (!(lgt > -1e30f && lgt < 1e30f)) lgt = 0.f;
            const float score = sigmoidf_(lgt), biased = score + rbias[lane];
            float m1 = biased;
#pragma unroll
            for (int o = 1; o < 8; o <<= 1) m1 = fmaxf(m1, __shfl_xor(m1, o));
            int c1 = (biased == m1) ? (lane & 7) : 8;
#pragma unroll
            for (int o = 1; o < 8; o <<= 1) c1 = min(c1, __shfl_xor(c1, o));
            float m2 = ((lane & 7) == c1) ? -INFINITY : biased;
#pragma unroll
            for (int o = 1; o < 8; o <<= 1) m2 = fmaxf(m2, __shfl_xor(m2, o));
            const float gs = m1 + m2; const int myg = lane >> 3; int grank = 0;
#pragma unroll
            for (int g2 = 0; g2 < 8; ++g2) { const float o = __shfl(gs, g2 * 8); grank += (o > gs || (o == gs && g2 < myg)) ? 1 : 0; }
            const float cand = (grank < 4) ? biased : -INFINITY; int rank = 0;
            for (int e2 = 0; e2 < 64; ++e2) { const float o = __shfl(cand, e2); rank += (o > cand || (o == cand && e2 < lane)) ? 1 : 0; }
            const bool sel = (rank < TOPK) && (grank < 4);
            const float ssum = wave_sum(sel ? score : 0.f);
            if (sel) { idx[t * 8 + rank] = lane; gw[t * 8 + rank] = score / ssum * 2.5f; sel_e[lr * 8 + rank] = lane; sel_s[lr * 8 + rank] = __hip_atomic_fetch_add(lcnt + lane, 1, __ATOMIC_RELAXED, __HIP_MEMORY_SCOPE_WORKGROUP); }
        }
        __syncthreads();
        if (X.tid < 64) { const int n = lcnt[X.tid]; lbase[X.tid] = n ? atomicAdd(cntg + X.tid, n) : 0; }
        __syncthreads();
        { const int lr = X.tid >> 3, k = X.tid & 7, t = rb * 64 + lr, e = sel_e[lr * 8 + k], sl = lbase[e] + sel_s[lr * 8 + k];
          aslot[t * 8 + k] = sl; ltok[e * CAP + sl] = t; }
        __syncthreads();
    }
}
DEV void ph_moe_conv(const Args& a, const Ctx& X, const int l, const int wg0) {
    unsigned char* ws = a.ws;
    { LAS float* scr = (LAS float*)(X.lds + X.wave * 8704);
      const int gwv = (X.bid - wg0) * NWAVES + X.wave, NGW = (X.G - wg0) * NWAVES;
      constexpr int I_GU = (D / 64) * (512 / 32), I_D = (ED / 64) * (D / 32), I_E = I_GU + I_D;
      const float* eg = a.exp_gate + (size_t)l * NE * D * ED; const float* eu = a.exp_up + (size_t)l * NE * D * ED; const float* ed = a.exp_down + (size_t)l * NE * ED * D;
      for (int it = gwv; it < (NE + 1) * I_E; it += NGW) {
          const int e = it / I_E; int r = it - e * I_E;
          if (e < NE) {
              if (r < I_GU) conv_item(SrcGU{eg + (size_t)e * D * ED, (long)(eu - eg)}, ED, D, (bf16_t*)(ws + WS_WGU) + (size_t)e * 512 * D, scr, r, 16, X.lane);
              else conv_item(SrcIdent{ed + (size_t)e * ED * D}, D, ED, (bf16_t*)(ws + WS_WD) + (size_t)e * D * ED, scr, r - I_GU, D / 32, X.lane);
          } else {
              if (r < I_GU) conv_item(SrcGU{a.sh_gate + (size_t)l * D * ED, (long)(a.sh_up - a.sh_gate)}, ED, D, (bf16_t*)(ws + WS_WGUS), scr, r, 16, X.lane);
              else conv_item(SrcIdent{a.sh_down + (size_t)l * ED * D}, D, ED, (bf16_t*)(ws + WS_WDS), scr, r - I_GU, D / 32, X.lane);
          }
      } }
}

DEV int moe_tables(const Args& a, const Ctx& X, const int l, LAS int* t_cnt, LAS int* t_rb0, LAS int* t_eofrb) {
    const int* cntg = (const int*)(a.ws + WS_CTL + CTL_CNT) + l * NE;
    if (X.wave == 0) {
        const int c = __hip_atomic_load(cntg + X.lane, __ATOMIC_RELAXED, __HIP_MEMORY_SCOPE_AGENT), nrb = (c + 255) >> 8;
        int incl = nrb;
#pragma unroll
        for (int o = 1; o < 64; o <<= 1) { const int v = __shfl_up(incl, o); if (X.lane >= o) incl += v; }
        const int excl = incl - nrb;
        t_cnt[X.lane] = c; t_rb0[X.lane] = excl; if (X.lane == 63) t_rb0[64] = incl;
        for (int j = 0; j < nrb; ++j) t_eofrb[excl + j] = X.lane;
        t_eofrb[SH_RB + X.lane] = NE;
    }
    __syncthreads();
    return t_rb0[64];
}

DEV void ph_moe_gu(const Args& a, const Ctx& X, const int l) {
    LAS int* t_cnt = (LAS int*)(X.lds + AUX_OFF + 1024); LAS int* t_rb0 = t_cnt + 64; LAS int* t_eofrb = t_rb0 + 80; LAS int* toks = t_eofrb + NRB_ALL;
    const int nrbt = moe_tables(a, X, l, t_cnt, t_rb0, t_eofrb);
    const int* ltok = (const int*)(a.ws + WS_LTOK);
    pg8::Unit u;
    for (int i = 0; i < 8; ++i) { if (!pg8::moe_unit(i, 2, nrbt, X.G, X.bid, u)) break;
        if (X.tid < 256) { const int e = t_eofrb[u.pm]; int tok;
            if (e < NE) { const int sl = (u.pm - t_rb0[e]) * 256 + X.tid; tok = sl < t_cnt[e] ? ltok[e * CAP + sl] : 0; } else tok = (u.pm - SH_RB) * 256 + X.tid;
            toks[i * 256 + X.tid] = tok; } }
    VM_WAIT(); __syncthreads();
    pg8::SchedGU S{(const char*)(a.ws + WS_H), (const char*)(a.ws + WS_WGU), (const char*)(a.ws + WS_WGUS), t_eofrb, toks, nrbt, X.G, X.bid, 0};
    pg8::EpiGU E{(bf16_t*)(a.ws + WS_HID)};
    pg8::gemm_phase<pg8::EpiGU, pg8::SchedGU>(X.lds, D, S, E);
}
DEV void ph_moe_down(const Args& a, const Ctx& X, const int l) {
    LAS int* t_cnt = (LAS int*)(X.lds + AUX_OFF + 1024); LAS int* t_rb0 = t_cnt + 64; LAS int* t_eofrb = t_rb0 + 80;
    const int nrbt = moe_tables(a, X, l, t_cnt, t_rb0, t_eofrb);
    pg8::SchedDown S{(const char*)(a.ws + WS_HID), (const char*)(a.ws + WS_WD), (const char*)(a.ws + WS_WDS), t_eofrb, nrbt, X.G, X.bid, 0};
    pg8::EpiFp8 E{(unsigned char*)(a.ws + WS_Y), D, 0};
    int kd = ED; asm volatile("" : "+s"(kd));
    pg8::gemm_phase<pg8::EpiFp8, pg8::SchedDown>(X.lds, kd, S, E);
}
DEV void ph_combine(const Args& a, const Ctx& X, const int l) {
    LAS int* t_cnt = (LAS int*)(X.lds + AUX_OFF + 1024); LAS int* t_rb0 = t_cnt + 64; LAS int* t_eofrb = t_rb0 + 80;
    (void)moe_tables(a, X, l, t_cnt, t_rb0, t_eofrb);
    const float* mod = (const float*)(a.ws + WS_MOD);
    const int* idx = (const int*)(a.ws + WS_IDX); const float* gw = (const float*)(a.ws + WS_GW); const int* aslot = (const int*)(a.ws + WS_ASLOT);
    const unsigned char* y = a.ws + WS_Y; bf16_t* hb = (bf16_t*)(a.ws + WS_H);
    const int lane = X.lane;
    const int tstep = X.G * NWAVES;
    int t = X.bid * NWAVES + X.wave;
    int e_n = 0, s_n = 0; float g_n = 0.f;
    if (t < T && lane < 8) { e_n = idx[t * 8 + lane]; g_n = gw[t * 8 + lane]; s_n = aslot[t * 8 + lane]; }
    for (; t < T; t += tstep) {
        const int b = t / SEQ; const float* ml = mod + (size_t)(l * NB + b) * 6 * D;
        const int e_c = e_n, s_c = s_n; const float g_c = g_n;
        const int tn = t + tstep;
        if (tn < T && lane < 8) { e_n = idx[tn * 8 + lane]; g_n = gw[tn * 8 + lane]; s_n = aslot[tn * 8 + lane]; }
        u32x2 w0[9], w1[9];
        { const unsigned char* yr = y + ((size_t)SH_RB * 256 + t) * D; w0[8] = *(const u32x2*)(yr + 8 * lane); w1[8] = *(const u32x2*)(yr + 512 + 8 * lane); }
        float gk[8];
#pragma unroll
        for (int k = 0; k < 8; ++k) { const int e = __shfl(e_c, k), sl = __shfl(s_c, k); gk[k] = __shfl(g_c, k);
            const unsigned char* yr = y + ((size_t)t_rb0[e] * 256 + sl) * D; w0[k] = *(const u32x2*)(yr + 8 * lane); w1[k] = *(const u32x2*)(yr + 512 + 8 * lane); }
        float xv[16]; load_row8(a.out + (size_t)t * D, lane, xv);
        float yv[16];
#pragma unroll
        for (int i = 0; i < 16; ++i) yv[i] = 0.f;
        acc_row8(yv, w0[8], w1[8], 0.0625f);
#pragma unroll
        for (int k = 0; k < 8; ++k) acc_row8(yv, w0[k], w1[k], gk[k] * 0.0625f);
        resid_update8(xv, yv, a.ffn_post_g + l * D, ml + 5 * D, lane);
        store_row8(a.out + (size_t)t * D, lane, xv);
        if (l == 0) { const float* mn = mod + (size_t)(1 * NB + b) * 6 * D; u32x4 o[2]; prenorm_pack8(xv, a.mix_pre_g + D, mn + D, mn, lane, o);
            *(u32x4*)(hb + (size_t)t * D + 8 * lane) = o[0]; *(u32x4*)(hb + (size_t)t * D + 512 + 8 * lane) = o[1]; }
    }
}

constexpr int NPH = 18;
__global__ void __launch_bounds__(NTHR, 2) mega(Args a) {
    extern __shared__ __attribute__((aligned(16))) unsigned char lds_raw[];
    Ctx X; X.lds = (LAS unsigned char*)lds_raw; X.tid = threadIdx.x; X.lane = X.tid & 63; X.wave = __builtin_amdgcn_readfirstlane(X.tid >> 6); X.G = gridDim.x; X.bid = blockIdx.x;
    if (X.tid < 4) ((LAS unsigned*)(X.lds + BAR_OFF))[X.tid] = 0u;
    __syncthreads();
    XcdBarrier bar; bar.bar = (unsigned*)(a.ws + WS_CTL); bar.x = 0; bar.st = nullptr;
    if (!MK_PER_PHASE) bar = xcd_barrier_post((unsigned*)(a.ws + WS_CTL), (volatile LAS unsigned*)(X.lds + BAR_OFF));
    const int lo = a.ph_lo, hi = a.ph_hi;
#define IN(k) (lo <= (k) && (k) < hi)
#define REP(k, ...) do { __VA_ARGS__; if constexpr (((PROBE_MASK >> (k)) & 1u) != 0u) { __syncthreads(); __VA_ARGS__; } } while (0)
#define SEAM(k) do { if (IN(k) && IN((k) + 1)) xcd_barrier(bar); else { VM_WAIT(); __syncthreads(); } } while (0)
    unsigned char* ws = a.ws;
    if (IN(0)) { REP(0, ph_setup(a, X)); SEAM(0); }
    if (IN(1)) { REP(1, ph_prenorm0(a, X)); SEAM(1); }
    if (IN(2)) {
        pg8::SchedDense S; S.so.init(T, NPROJ, X.G, X.bid); S.A = (const char*)(ws + WS_H); S.Bt = (const char*)(ws + WS_WIN); S.K = D; S.pad_ = 0;
        pg8::EpiProj E{(bf16_t*)(ws + WS_QKVPRE), (bf16_t*)(ws + WS_ZA), (bf16_t*)(ws + WS_XBCPRE), (bf16_t*)(ws + WS_ZB), (float*)(ws + WS_SMALL)};
        REP(2, pg8::gemm_phase<pg8::EpiProj, pg8::SchedDense>(X.lds, D, S, E)); SEAM(2); }
    if (IN(3)) { REP(3, ph_gdn_local(a, X)); REP(20, ph_ssd_local(a, X)); SEAM(3); }
    if (IN(4)) {
        if (X.bid < 32) { REP(4, ph_gdn_scan(a, X)); }
        else { ph_ssd_scan(a, X, 32); group_barrier((unsigned*)(ws + WS_CTL + CTL_GRP), (unsigned)(X.G - 32)); __syncthreads(); ph_ssd_out(a, X, 32); __syncthreads(); ph_moe_conv(a, X, 0, 32); }
        SEAM(4); }
    if (IN(6)) {
        pg8::SchedDense S; S.so.init(T, D, X.G, X.bid); S.A = (const char*)(ws + WS_OY); S.Bt = (const char*)(ws + WS_WOUT); S.K = 2048; S.pad_ = 0;
        pg8::EpiF32 E{(float*)(ws + WS_YMIX), D, 0};
        REP(6, pg8::gemm_phase<pg8::EpiF32, pg8::SchedDense>(X.lds, 2048, S, E)); SEAM(6); }
    if (IN(7)) { ph_router(a, X, 0); SEAM(7); }
    if (IN(8)) { REP(8, ph_moe_gu(a, X, 0)); SEAM(8); }
    if (IN(9)) { REP(9, ph_moe_down(a, X, 0)); SEAM(9); }
    if (IN(10)) { ph_combine(a, X, 0); SEAM(10); }
    if (IN(11)) {
        pg8::SchedDense S; S.so.init(T, 3072, X.G, X.bid); S.A = (const char*)(ws + WS_H); S.Bt = (const char*)(ws + WS_WQKV); S.K = D; S.pad_ = 0;
        pg8::EpiQKV E{(bf16_t*)(ws + WS_Q1KV), (const float*)(ws + WS_COS), (const float*)(ws + WS_SIN)};
        REP(11, pg8::gemm_phase<pg8::EpiQKV, pg8::SchedDense>(X.lds, D, S, E)); SEAM(11); }
    if (IN(12)) { REP(12, ph_attn(a, X)); SEAM(12); }
    if (IN(13)) {
        pg8::SchedDense S; S.so.init(T, D, X.G, X.bid); S.A = (const char*)(ws + WS_O1); S.Bt = (const char*)(ws + WS_WO); S.K = D; S.pad_ = 0;
        pg8::EpiF32 E{(float*)(ws + WS_YMIX), D, 0};
        REP(13, pg8::gemm_phase<pg8::EpiF32, pg8::SchedDense>(X.lds, D, S, E)); SEAM(13); }
    if (IN(14)) { ph_router(a, X, 1); REP(14, ph_moe_conv(a, X, 1, 0)); SEAM(14); }
    if (IN(15)) { ph_moe_gu(a, X, 1); SEAM(15); }
    if (IN(16)) { ph_moe_down(a, X, 1); SEAM(16); }
    if (IN(17)) { ph_combine(a, X, 1); }
#undef IN
#undef SEAM
}

extern "C" void kernel_launch(void* const* d_in, const int* in_sizes, int n_in, void* d_out, int out_size, void* d_ws, size_t ws_size, hipStream_t stream) {
    static int grid = 0;
    if (!grid) {
        int dev = 0, cus = 0, per_cu = 0;
        if (hipGetDevice(&dev) != hipSuccess || hipDeviceGetAttribute(&cus, hipDeviceAttributeMultiprocessorCount, dev) != hipSuccess) { fprintf(stderr, "kernel_launch: device query failed\n"); grid = -1; return; }
        if (hipFuncSetAttribute((const void*)mega, hipFuncAttributeMaxDynamicSharedMemorySize, LDS_BYTES) != hipSuccess) { fprintf(stderr, "kernel_launch: hipFuncSetAttribute failed\n"); grid = -1; return; }
        if (hipOccupancyMaxActiveBlocksPerMultiprocessor(&per_cu, (const void*)mega, NTHR, LDS_BYTES) != hipSuccess || per_cu < 1) { fprintf(stderr, "kernel_launch: occupancy query says %d blocks per CU\n", per_cu); grid = -1; return; }
        grid = cus;
        if (grid < 64 || (grid & 7)) { fprintf(stderr, "kernel_launch: unsupported CU count %d\n", cus); grid = -1; return; }
    }
    if (grid < 0) return;
    if (ws_size < WS_END || n_in != 31) { fprintf(stderr, "kernel_launch: workspace %zu < %zu or n_in %d != 31\n", ws_size, (size_t)WS_END, n_in); return; }
    if (hipMemsetAsync((char*)d_ws + WS_CTL, 0, CTL_BYTES, stream) != hipSuccess) { fprintf(stderr, "kernel_launch: memset failed\n"); return; }
    Args a{};
    a.x = (const float*)d_in[0]; a.c = (const float*)d_in[1]; a.pos = (const int*)d_in[2]; a.mod_w = (const float*)d_in[3]; a.mod_b = (const float*)d_in[4];
    a.mix_pre_g = (const float*)d_in[5]; a.mix_post_g = (const float*)d_in[6]; a.ffn_pre_g = (const float*)d_in[7]; a.ffn_post_g = (const float*)d_in[8];
    a.ssm_w_in = (const float*)d_in[9]; a.gdn_conv_w = (const float*)d_in[10]; a.gdn_a_log = (const float*)d_in[11]; a.gdn_dt_bias = (const float*)d_in[12]; a.gdn_norm_w = (const float*)d_in[13];
    a.ssd_conv_w = (const float*)d_in[14]; a.ssd_conv_b = (const float*)d_in[15]; a.ssd_a_log = (const float*)d_in[16]; a.ssd_dt_bias = (const float*)d_in[17]; a.ssd_d = (const float*)d_in[18]; a.ssd_norm_w = (const float*)d_in[19];
    a.ssm_w_out = (const float*)d_in[20]; a.attn_w_qkv = (const float*)d_in[21]; a.attn_w_o = (const float*)d_in[22];
    a.router_w = (const float*)d_in[23]; a.router_bias = (const float*)d_in[24]; a.exp_gate = (const float*)d_in[25]; a.exp_up = (const float*)d_in[26]; a.exp_down = (const float*)d_in[27];
    a.sh_gate = (const float*)d_in[28]; a.sh_up = (const float*)d_in[29]; a.sh_down = (const float*)d_in[30];
    a.out = (float*)d_out; a.ws = (unsigned char*)d_ws;
#if MK_PER_PHASE
    for (int p = 0; p < NPH; ++p) { a.ph_lo = p; a.ph_hi = p + 1; hipLaunchKernelGGL(mega, dim3(grid), dim3(NTHR), LDS_BYTES, stream, a); }
#else
    a.ph_lo = 0; a.ph_hi = NPH;
    hipLaunchKernelGGL(mega, dim3(grid), dim3(NTHR), LDS_BYTES, stream, a);
#endif
}
```

```cpp
#include <hip/hip_runtime.h>
#include <stdint.h>
#include <stdio.h>

#define DEV __device__ __forceinline__
#define LAS __attribute__((address_space(3)))
typedef unsigned short bf16_t;
typedef short bf16x8 __attribute__((ext_vector_type(8)));
typedef float f32x4 __attribute__((ext_vector_type(4)));
typedef float f32x2 __attribute__((ext_vector_type(2)));
typedef unsigned u32x4 __attribute__((ext_vector_type(4)));
typedef unsigned u32x2 __attribute__((ext_vector_type(2)));
typedef float f32x16 __attribute__((ext_vector_type(16)));
typedef short s16x4 __attribute__((ext_vector_type(4)));

#ifndef PROBE_MASK
#define PROBE_MASK 0u
#endif
#ifndef MK_PER_PHASE
#define MK_PER_PHASE 0
#endif

constexpr int NB = 4, SEQ = 4096, T = NB * SEQ, D = 1024;
constexpr int PROJ = 6688, NPROJ = 6912;
constexpr int C_BETA = 4096, C_XBC = 4112, C_ZB = 5648, C_DT = 6672;
constexpr int NE = 64, TOPK = 8, ED = 256, CAP = 16384;
constexpr int SH_RB = 576;
constexpr int NRB_ALL = SH_RB + 64;
constexpr float EPS = 1e-6f;
constexpr int NTHR = 512, NWAVES = 8;
constexpr int LDS_BYTES = 163840;
constexpr int AUX_OFF = 131072;
constexpr int BAR_OFF = LDS_BYTES - 16;

constexpr size_t MiB = 1u << 20;
constexpr size_t WS_CTL = 0, CTL_BYTES = 65536;
constexpr size_t CTL_CNT = 16384;
constexpr size_t CTL_GRP = 20480;
constexpr size_t WS_MOD = 65536;
constexpr size_t WS_COS = 1 * MiB, WS_SIN = 3 * MiB;
constexpr size_t WS_IDX = 5 * MiB, WS_GW = 5 * MiB + 512 * 1024, WS_ASLOT = 6 * MiB, WS_LTOK = 6 * MiB + 512 * 1024;
constexpr size_t WS_SMALL = 11 * MiB;
constexpr size_t WS_GB = 13 * MiB, WS_DTB = 14 * MiB;
constexpr size_t WS_WIN = 16 * MiB, WS_WOUT = 30 * MiB, WS_WQKV = 34 * MiB, WS_WO = 40 * MiB;
constexpr size_t WS_H = 44 * MiB;
constexpr size_t WS_QKVPRE = 78 * MiB, WS_XBCPRE = 174 * MiB, WS_ZA = 222 * MiB, WS_ZB = 254 * MiB;
constexpr size_t WS_QKVN = 286 * MiB, WS_XBCC = 382 * MiB;
constexpr size_t WS_CC = 16 * MiB, WS_ACUM = 25 * MiB, WS_CDEC = 26 * MiB, WS_YDIAG = 44 * MiB, WS_STATES = 430 * MiB;
constexpr size_t WS_GI = 286 * MiB, GI_UNIT = 73728, WS_GTMP = 462 * MiB, WS_GLAST = 27 * MiB;
constexpr size_t WS_ORAW = 78 * MiB, WS_YRAW = 142 * MiB, WS_OY = 78 * MiB, WS_YMIX = 286 * MiB, WS_XB = 240 * MiB;
constexpr size_t WS_WD = 478 * MiB, WS_WDS = 510 * MiB + 512 * 1024, WS_HID = 398 * MiB, WS_Y = 78 * MiB, WS_WGU = 142 * MiB, WS_WGUS = 207 * MiB;
constexpr size_t WS_Q1KV = 78 * MiB, WS_O1 = 174 * MiB, WS_PO = 350 * MiB, WS_PLSE = 446 * MiB;
constexpr size_t WS_END = 512 * MiB;

struct Args {
    const float* x; const float* c; const int* pos; const float* mod_w; const float* mod_b;
    const float* mix_pre_g; const float* mix_post_g; const float* ffn_pre_g; const float* ffn_post_g;
    const float* ssm_w_in; const float* gdn_conv_w; const float* gdn_a_log; const float* gdn_dt_bias; const float* gdn_norm_w;
    const float* ssd_conv_w; const float* ssd_conv_b; const float* ssd_a_log; const float* ssd_dt_bias; const float* ssd_d; const float* ssd_norm_w;
    const float* ssm_w_out; const float* attn_w_qkv; const float* attn_w_o;
    const float* router_w; const float* router_bias; const float* exp_gate; const float* exp_up; const float* exp_down;
    const float* sh_gate; const float* sh_up; const float* sh_down;
    float* out; unsigned char* ws; int ph_lo, ph_hi;
};

DEV float bf2f(bf16_t v) { return __uint_as_float(((unsigned)v) << 16); }
DEV unsigned f2bf(float f) { unsigned u = __float_as_uint(f); return (u + 0x7FFFu + ((u >> 16) & 1u)) >> 16; }
DEV unsigned pk2(float lo, float hi) { return f2bf(lo) | (f2bf(hi) << 16); }
DEV float wave_sum(float v) {
#pragma unroll
    for (int o = 32; o > 0; o >>= 1) v += __shfl_xor(v, o);
    return v;
}
DEV float siluf(float x) { return x / (1.f + __expf(-x)); }
DEV float sigmoidf_(float x) { return 1.f / (1.f + __expf(-x)); }
DEV float softplusf(float x) { return fmaxf(x, 0.f) + log1pf(__expf(-fabsf(x))); }
#define LDS_WAIT() asm volatile("s_waitcnt lgkmcnt(0)" ::: "memory")
#define VM_WAIT() asm volatile("s_waitcnt vmcnt(0)" ::: "memory")

#define XB_TMO      128
#define XB_XCNT(j)  (256  + 64 * (j))
#define XB_XSUB(j)  (1280 + 64 * (j))
#define XB_XGEN(j)  (2304 + 64 * (j))
#define XB_TOP      3328
#define XB_TOPGEN   3392
#define XCD_BAR_WORDS 3456
#define XB_SPIN_CAP (1u << 18)
#define LAS __attribute__((address_space(3)))

__device__ __forceinline__ unsigned xb_ld(unsigned* p)              { return __hip_atomic_load(p, __ATOMIC_RELAXED, __HIP_MEMORY_SCOPE_AGENT); }
__device__ __forceinline__ unsigned xb_add(unsigned* p, unsigned v) { return __hip_atomic_fetch_add(p, v, __ATOMIC_RELAXED, __HIP_MEMORY_SCOPE_AGENT); }
__device__ __forceinline__ unsigned xb_xcc_id() { return (unsigned)__builtin_amdgcn_s_getreg((3 << 11) | 20) & 0xFu; }
#define XB_SPIN(cond, bar) do { unsigned _sp = 0; while (cond) { __builtin_amdgcn_s_sleep(1); \
    if ((++_sp & 255u) == 0u) { if (xb_ld(&(bar)[XB_TMO])) break; if (_sp > XB_SPIN_CAP) { atomicAdd(&(bar)[XB_TMO], 1u); break; } } } } while (0)

struct XcdBarrier {
    unsigned* bar; unsigned x;
    volatile LAS unsigned* st;
};

__device__ __forceinline__ XcdBarrier xcd_barrier_post(unsigned* bar, volatile LAS unsigned* st) {
    XcdBarrier b; b.bar = bar; b.x = xb_xcc_id(); b.st = st;
    if (threadIdx.x == 0) (void)xb_add(&bar[XB_XCNT(b.x)], 1u);
    return b;
}
__device__ __forceinline__ void xcd_barrier_complete(unsigned* bar, unsigned x, unsigned& nloc, unsigned& nx) {
    const unsigned G = gridDim.x * gridDim.y * gridDim.z;
    unsigned sum, cnt, mine, sp = 0u;
    for (;;) {
        sum = 0u; cnt = 0u; mine = 0u;
#pragma unroll
        for (unsigned j = 0; j < 16; ++j) { const unsigned c = xb_ld(&bar[XB_XCNT(j)]); sum += c; cnt += (c > 0u) ? 1u : 0u; mine = (j == x) ? c : mine; }
        if (sum == G) break;
        __builtin_amdgcn_s_sleep(1);
        if ((++sp & 255u) == 0u) { if (xb_ld(&bar[XB_TMO])) break; if (sp > XB_SPIN_CAP) { atomicAdd(&bar[XB_TMO], 1u); break; } }
    }
    nloc = mine > 0u ? mine : 1u; nx = cnt > 0u ? cnt : 1u;
}

__device__ __forceinline__ void xcd_barrier(const XcdBarrier& b) {
    asm volatile("s_waitcnt vmcnt(0)" ::: "memory");
    __syncthreads();
    if (threadIdx.x == 0) {
        unsigned* bar = b.bar;
        __builtin_amdgcn_s_waitcnt(0);
        unsigned nloc = b.st[0], nx = b.st[1];
        if (nloc == 0u) { xcd_barrier_complete(bar, b.x, nloc, nx); b.st[0] = nloc; b.st[1] = nx; }
        const unsigned old = xb_add(&bar[XB_XSUB(b.x)], 1u);
        const unsigned gen = old / nloc;
        if (old + 1u == (gen + 1u) * nloc) {
            __builtin_amdgcn_fence(__ATOMIC_RELEASE, "agent");
            asm volatile("s_waitcnt vmcnt(0)" ::: "memory");
            const unsigned og = xb_add(&bar[XB_TOP], 1u);
            const unsigned tg = og / nx;
            if (og + 1u == (tg + 1u) * nx) xb_add(&bar[XB_TOPGEN], 1u);
            else XB_SPIN(xb_ld(&bar[XB_TOPGEN]) == tg, bar);
            __builtin_amdgcn_fence(__ATOMIC_ACQUIRE, "agent");
            xb_add(&bar[XB_XGEN(b.x)], 1u);
            asm volatile("s_waitcnt vmcnt(0)" ::: "memory");
        } else {
            XB_SPIN(xb_ld(&bar[XB_XGEN(b.x)]) == gen, bar);
            __builtin_amdgcn_fence(__ATOMIC_ACQUIRE, "agent");
            asm volatile("s_waitcnt vmcnt(0)" ::: "memory");
        }
    }
    __syncthreads();
}


DEV void group_barrier(unsigned* ctr, const unsigned n) {
    asm volatile("s_waitcnt vmcnt(0)" ::: "memory");
    __syncthreads();
    if (threadIdx.x == 0) {
        __builtin_amdgcn_fence(__ATOMIC_RELEASE, "agent");
        asm volatile("s_waitcnt vmcnt(0)" ::: "memory");
        (void)__hip_atomic_fetch_add(ctr, 1u, __ATOMIC_RELAXED, __HIP_MEMORY_SCOPE_AGENT);
        unsigned sp = 0;
        while (__hip_atomic_load(ctr, __ATOMIC_RELAXED, __HIP_MEMORY_SCOPE_AGENT) < n) { __builtin_amdgcn_s_sleep(2); if (++sp > (1u << 22)) break; }
        __builtin_amdgcn_fence(__ATOMIC_ACQUIRE, "agent");
        asm volatile("s_waitcnt vmcnt(0)" ::: "memory");
    }
    __syncthreads();
}

namespace pg8 {
constexpr int BM = 256, BK = 64, HALF = 128, HTB = HALF * BK * 2, STAGE_BYTES = 8 * HTB, NXCD = 8, WGM = 8;
DEV int lds_byte(int r, int c) { const int st = (r >> 4) * 2 + (c >> 5), rr = r & 15, cc = c & 31, ob = rr * 64 + cc * 2; return st * 1024 + (ob ^ (((ob >> 9) & 1) << 5)); }
DEV void stage_rc(int b, int& R, int& C) { const int st = b / 1024, sb = b % 1024, swz = sb ^ (((sb >> 9) & 1) << 5); R = (st >> 1) * 16 + swz / 64; C = (st & 1) * 32 + (swz % 64) / 2; }
DEV int perm32(int rho) { const int n = rho >> 4, i = rho & 15; return 8 * (i >> 2) + 4 * n + (i & 3); }
struct Unit { int pm, pn, e, slot; };
struct StaticOrder {
    int nM, nN, nwg, G, c;
    DEV void init(int M, int N, int G_, int c_) { nM = M / BM; nN = N / BM; nwg = nM * nN; G = G_; c = c_; }
    DEV bool next(int i, int& pm, int& pn) const {
        const long L = (long)i * G + c; if (L >= nwg) return false;
        int wgid = (int)L; { const int q = nwg / NXCD, r = nwg % NXCD, xcd = wgid % NXCD, off = wgid / NXCD; wgid = (xcd < r ? xcd * (q + 1) : r * (q + 1) + (xcd - r) * q) + off; }
        const int nig = WGM * nN, gid = wgid / nig, fm = gid * WGM, gsz = (nM - fm) < WGM ? (nM - fm) : WGM;
        pm = fm + ((wgid % nig) % gsz); pn = (wgid % nig) / gsz; return true;
    }
};
typedef __bf16 bf16x2_t __attribute__((ext_vector_type(2)));
DEV unsigned cvt_pk_bf16(float lo, float hi) { const bf16x2_t v = {(__bf16)lo, (__bf16)hi}; return __builtin_bit_cast(unsigned, v); }
DEV u32x4 pack8(const f32x4 a, const f32x4 b) { u32x4 w; w.x = cvt_pk_bf16(a[0], a[1]); w.y = cvt_pk_bf16(a[2], a[3]); w.z = cvt_pk_bf16(b[0], b[1]); w.w = cvt_pk_bf16(b[2], b[3]); return w; }

template <class Epi, class Sched>
DEV void gemm_phase(LAS unsigned char* lds, const int K, const Sched& S, const Epi& E) {
    const int tid = threadIdx.x, wid = __builtin_amdgcn_readfirstlane(tid >> 6), lane = tid & 63, wr = wid >> 2, wc = wid & 3, fr = lane & 15, fq = lane >> 4;
    const int nt = K / BK;
    unsigned voffB[2];
#pragma unroll
    for (int i = 0; i < 2; ++i) { int R, C; stage_rc(tid * 16 + i * 8192, R, C); const int Rb = Epi::PERM ? ((R & ~31) + perm32(R & 31)) : R; voffB[i] = (unsigned)(Rb * K + C) * 2u; }
    const unsigned kstep = (unsigned)(BK * 2);
    const size_t hstep = (size_t)HALF * K * 2;
    const unsigned ldsw = (unsigned)wid * 1024u;
    const int aoff = lds_byte(wr * 64 + fr, fq * 8), boff = lds_byte(wc * 32 + fr, fq * 8);
    const size_t hsA = Sched::GATHER ? (size_t)0 : hstep;
#define PG8_SA(b, h) (((b) * 2 + (h)) * HTB)
#define PG8_SB(b, h) ((4 + (b) * 2 + (h)) * HTB)
#define PG8_STAGEB(bufoff, gbase) do { _Pragma("unroll") for (int _i = 0; _i < 2; ++_i) \
        __builtin_amdgcn_global_load_lds((const unsigned*)((const char*)(gbase) + voffB[_i]), (LAS unsigned*)(lds + (bufoff) + ldsw + _i * 8192), 16, 0, 0); } while (0)
#define PG8_STAGEA(bufoff, gbase, VO) do { _Pragma("unroll") for (int _i = 0; _i < 2; ++_i) \
        __builtin_amdgcn_global_load_lds((const unsigned*)((const char*)(gbase) + (VO)[_i]), (LAS unsigned*)(lds + (bufoff) + ldsw + _i * 8192), 16, 0, 0); } while (0)
#define PG8_LDA(dst, b, h) do { _Pragma("unroll") for (int m = 0; m < 4; ++m) _Pragma("unroll") for (int k = 0; k < 2; ++k) dst[m][k] = *(const LAS bf16x8*)(lds + PG8_SA(b, h) + aoff + m * 2048 + k * 1024); } while (0)
#define PG8_LDB(dst, b, h) do { _Pragma("unroll") for (int n = 0; n < 2; ++n) _Pragma("unroll") for (int k = 0; k < 2; ++k) dst[n][k] = *(const LAS bf16x8*)(lds + PG8_SB(b, h) + boff + n * 2048 + k * 1024); } while (0)
#define PG8_MMA(ai, bj, At, Bt) do { __builtin_amdgcn_s_setprio(1); _Pragma("unroll") for (int m = 0; m < 4; ++m) _Pragma("unroll") for (int n = 0; n < 2; ++n) _Pragma("unroll") for (int k = 0; k < 2; ++k) \
        acc[ai][bj][m][n] = __builtin_amdgcn_mfma_f32_16x16x32_bf16(Bt[n][k], At[m][k], acc[ai][bj][m][n], 0, 0, 0); __builtin_amdgcn_s_setprio(0); } while (0)
#define PG8_WAIT_V(n) asm volatile("s_waitcnt vmcnt(" #n ")" ::: "memory")
#define PG8_WAIT_L(n) asm volatile("s_waitcnt lgkmcnt(" #n ")" ::: "memory")
#define PG8_BAR __builtin_amdgcn_s_barrier()
#define PG8_SCHED __builtin_amdgcn_sched_barrier(0)
    Unit cur, nxt; int ui = 0;
    if (!S.next(0, cur)) return;
    f32x4 acc[2][2][4][2];
#pragma unroll
    for (int a = 0; a < 2; ++a)
#pragma unroll
        for (int b = 0; b < 2; ++b)
#pragma unroll
            for (int m = 0; m < 4; ++m)
#pragma unroll
                for (int n = 0; n < 2; ++n) acc[a][b][m][n] = (f32x4){0.f, 0.f, 0.f, 0.f};
    bf16x8 At[4][2], B0[2][2], B1[2][2];
    unsigned va[2][2];
    S.a_voff(cur, tid, va);
    const char* cA = S.a_ptr(cur);
    const char* cB = S.b_ptr(cur);
    PG8_STAGEB(PG8_SB(0, 0), cB); PG8_STAGEB(PG8_SB(0, 1), cB + hstep); PG8_STAGEA(PG8_SA(0, 0), cA, va[0]); PG8_STAGEA(PG8_SA(0, 1), cA + hsA, va[1]);
    if (wr == 1) PG8_BAR;
    PG8_WAIT_V(2); PG8_BAR;
    PG8_STAGEB(PG8_SB(1, 0), cB + kstep); PG8_STAGEA(PG8_SA(1, 0), cA + kstep, va[0]); PG8_STAGEB(PG8_SB(1, 1), cB + hstep + kstep);
    PG8_WAIT_V(6); PG8_BAR;
    for (;;) {
        const bool has_next = S.next(ui + 1, nxt);
        const char* nB = has_next ? S.b_ptr(nxt) : cB;
        const char* nA = has_next ? S.a_ptr(nxt) : cA;
        for (int t = 0; t < nt; t += 2) {
            const bool last = (t == nt - 2);
            const char* a1 = cA + (size_t)(t + 1) * kstep;
            const char* a2 = last ? nA : cA + (size_t)(t + 2) * kstep; const char* a3 = a2 + kstep;
            unsigned v2[2][2];
            v2[0][0] = va[0][0]; v2[0][1] = va[0][1]; v2[1][0] = va[1][0]; v2[1][1] = va[1][1];
            if constexpr (Sched::GATHER) { if (last && has_next) S.a_voff(nxt, tid, v2); }
            const char* b2 = last ? nB : cB + (size_t)(t + 2) * kstep; const char* b3 = b2 + kstep;
            PG8_LDB(B0, 0, 0); PG8_LDB(B1, 0, 1); PG8_SCHED; PG8_LDA(At, 0, 0); PG8_STAGEA(PG8_SA(1, 1), a1 + hsA, va[1]);
            PG8_WAIT_V(8); PG8_WAIT_L(0); PG8_BAR; PG8_MMA(0, 0, At, B0); PG8_MMA(0, 1, At, B1); PG8_BAR; PG8_SCHED;
            PG8_LDA(At, 0, 1); PG8_STAGEB(PG8_SB(0, 0), b2); PG8_STAGEB(PG8_SB(0, 1), b2 + hstep); PG8_STAGEA(PG8_SA(0, 0), a2, v2[0]);
            PG8_WAIT_V(8); PG8_WAIT_L(0); PG8_BAR; PG8_MMA(1, 0, At, B0); PG8_MMA(1, 1, At, B1); PG8_BAR; PG8_SCHED;
            PG8_LDB(B0, 1, 0); PG8_LDB(B1, 1, 1); PG8_SCHED; PG8_LDA(At, 1, 0); PG8_STAGEA(PG8_SA(0, 1), a2 + hsA, v2[1]);
            PG8_WAIT_V(8); PG8_WAIT_L(0); PG8_BAR; PG8_MMA(0, 0, At, B0); PG8_MMA(0, 1, At, B1); PG8_BAR; PG8_SCHED;
            PG8_LDA(At, 1, 1); PG8_STAGEB(PG8_SB(1, 0), b3); PG8_STAGEB(PG8_SB(1, 1), b3 + hstep); PG8_STAGEA(PG8_SA(1, 0), a3, v2[0]);
            PG8_WAIT_V(8); PG8_WAIT_L(0); PG8_BAR; PG8_MMA(1, 0, At, B0); PG8_MMA(1, 1, At, B1); PG8_BAR; PG8_SCHED;
        }
        if (wr == 0) PG8_BAR;
        E(acc, cur, wr, wc, fr, fq);
        if (!has_next) break;
#pragma unroll
        for (int a = 0; a < 2; ++a)
#pragma unroll
            for (int b = 0; b < 2; ++b)
#pragma unroll
                for (int m = 0; m < 4; ++m)
#pragma unroll
                    for (int n = 0; n < 2; ++n) acc[a][b][m][n] = (f32x4){0.f, 0.f, 0.f, 0.f};
        cur = nxt; cB = nB; cA = nA; ++ui;
        if constexpr (Sched::GATHER) S.a_voff(cur, tid, va);
        if (wr == 1) PG8_BAR;
    }
    PG8_WAIT_V(0);
    PG8_BAR;
#undef PG8_SA
#undef PG8_SB
#undef PG8_STAGEA
#undef PG8_STAGEB
#undef PG8_LDA
#undef PG8_LDB
#undef PG8_MMA
#undef PG8_WAIT_V
#undef PG8_WAIT_L
#undef PG8_BAR
#undef PG8_SCHED
}

struct SchedDense {
    static constexpr bool GATHER = false;
    StaticOrder so; const char* A; const char* Bt; int K; int pad_;
    DEV bool next(int i, Unit& u) const { int pm, pn; if (!so.next(i, pm, pn)) return false; u.pm = pm; u.pn = pn; u.e = 0; u.slot = 0; return true; }
    DEV const char* a_ptr(const Unit& u) const { return A + (size_t)u.pm * 256 * K * 2; }
    DEV void a_voff(const Unit&, const int tid, unsigned (&vo)[2][2]) const {
#pragma unroll
        for (int i = 0; i < 2; ++i) { int R, C; stage_rc(tid * 16 + i * 8192, R, C); vo[0][i] = vo[1][i] = (unsigned)((R * K + C) * 2); }
    }
    DEV const char* b_ptr(const Unit& u) const { return Bt + (size_t)u.pn * 256 * K * 2; }
};
DEV bool moe_unit(int i, int NJ, int nrbt, int G, int c, Unit& u) {
    const int n = (nrbt + 64) * NJ; int L;
    if (G & 7) { L = i * G + c; if (L >= n) return false; }
    else { const int gq = G >> 3, per = (n + 7) >> 3, x = c & 7, q = c >> 3, j = i * gq + q; if (j >= per) return false; L = x * per + j; if (L >= n) return false; }
    int grb = L / NJ; const int pn = L - grb * NJ; if (grb >= nrbt) grb = SH_RB + (grb - nrbt);
    u.pm = grb; u.pn = pn; u.slot = i; u.e = 0; return true;
}
struct SchedGU {
    static constexpr bool GATHER = true;
    const char* A; const char* Wgu; const char* Wgus; const LAS int* eofrb; const LAS int* toks; int nrbt, G, c, pad_;
    DEV bool next(int i, Unit& u) const { if (!moe_unit(i, 2, nrbt, G, c, u)) return false; u.e = __builtin_amdgcn_readfirstlane(eofrb[u.pm]); return true; }
    DEV const char* a_ptr(const Unit&) const { return A; }
    DEV void a_voff(const Unit& u, const int tid, unsigned (&vo)[2][2]) const {
#pragma unroll
        for (int i = 0; i < 2; ++i) { int R, C; stage_rc(tid * 16 + i * 8192, R, C);
#pragma unroll
            for (int h = 0; h < 2; ++h) { const int tok = toks[u.slot * 256 + h * 128 + R]; vo[h][i] = (unsigned)((tok * D + C) * 2); } }
    }
    DEV const char* b_ptr(const Unit& u) const { return (u.e < NE ? Wgu + (size_t)u.e * 512 * D * 2 : Wgus) + (size_t)u.pn * 256 * D * 2; }
};
struct SchedDown {
    static constexpr bool GATHER = false;
    const char* A; const char* Wd; const char* Wds; const LAS int* eofrb; int nrbt, G, c, pad_;
    DEV bool next(int i, Unit& u) const { if (!moe_unit(i, 4, nrbt, G, c, u)) return false; u.e = __builtin_amdgcn_readfirstlane(eofrb[u.pm]); return true; }
    DEV const char* a_ptr(const Unit& u) const { return A + (size_t)u.pm * 256 * ED * 2; }
    DEV void a_voff(const Unit&, const int tid, unsigned (&vo)[2][2]) const {
#pragma unroll
        for (int i = 0; i < 2; ++i) { int R, C; stage_rc(tid * 16 + i * 8192, R, C); vo[0][i] = vo[1][i] = (unsigned)((R * ED + C) * 2); }
    }
    DEV const char* b_ptr(const Unit& u) const { return (u.e < NE ? Wd + (size_t)u.e * D * ED * 2 : Wds) + (size_t)u.pn * 256 * ED * 2; }
};

struct EpiProj {
    static constexpr bool PERM = true;
    bf16_t* qkv; bf16_t* za; bf16_t* xbc; bf16_t* zb; float* small;
    DEV void operator()(const f32x4 (&acc)[2][2][4][2], const Unit& u, int wr, int wc, int fr, int fq) const {
        const int row0 = u.pm * BM + wr * 64 + fr, pn = u.pn;
        if (pn == 26) {
            if (wc == 0) {
#pragma unroll
                for (int ai = 0; ai < 2; ++ai)
#pragma unroll
                    for (int m = 0; m < 4; ++m) { float* p = small + (size_t)(row0 + ai * HALF + m * 16) * 32 + 8 * fq; *(f32x4*)p = acc[ai][0][m][0]; *(f32x4*)(p + 4) = acc[ai][0][m][1]; }
            }
            return;
        }
        bf16_t* base; int ldc, ct;
        if (pn < 12) { base = qkv; ldc = 3072; ct = pn; } else if (pn < 16) { base = za; ldc = 1024; ct = pn - 12; } else if (pn < 22) { base = xbc; ldc = 1536; ct = pn - 16; } else { base = zb; ldc = 1024; ct = pn - 22; }
        const int col0 = ct * 256 + wc * 32 + 8 * fq;
#pragma unroll
        for (int ai = 0; ai < 2; ++ai)
#pragma unroll
            for (int m = 0; m < 4; ++m) { bf16_t* rowp = base + (size_t)(row0 + ai * HALF + m * 16) * ldc + col0;
#pragma unroll
                for (int bj = 0; bj < 2; ++bj) *(u32x4*)(rowp + bj * HALF) = pack8(acc[ai][bj][m][0], acc[ai][bj][m][1]); }
    }
};
struct EpiF32 {
    static constexpr bool PERM = false;
    float* Cp; int ldc; int pad_;
    DEV void operator()(const f32x4 (&acc)[2][2][4][2], const Unit& u, int wr, int wc, int fr, int fq) const {
        const int row0 = u.pm * BM + wr * 64 + fr, col0 = u.pn * BM + wc * 32 + 4 * fq;
#pragma unroll
        for (int ai = 0; ai < 2; ++ai)
#pragma unroll
            for (int m = 0; m < 4; ++m) { float* rowp = Cp + (size_t)(row0 + ai * HALF + m * 16) * ldc + col0;
#pragma unroll
                for (int bj = 0; bj < 2; ++bj)
#pragma unroll
                    for (int n = 0; n < 2; ++n) *(f32x4*)(rowp + bj * HALF + n * 16) = acc[ai][bj][m][n]; }
    }
};
struct EpiBf16 {
    static constexpr bool PERM = true;
    bf16_t* O; int ldc; int pad_;
    DEV void operator()(const f32x4 (&acc)[2][2][4][2], const Unit& u, int wr, int wc, int fr, int fq) const {
        const int row0 = u.pm * BM + wr * 64 + fr, col0 = u.pn * BM + wc * 32 + 8 * fq;
#pragma unroll
        for (int ai = 0; ai < 2; ++ai)
#pragma unroll
            for (int m = 0; m < 4; ++m) { bf16_t* rowp = O + (size_t)(row0 + ai * HALF + m * 16) * ldc + col0;
#pragma unroll
                for (int bj = 0; bj < 2; ++bj) *(u32x4*)(rowp + bj * HALF) = pack8(acc[ai][bj][m][0], acc[ai][bj][m][1]); }
    }
};
struct EpiFp8 {
    static constexpr bool PERM = true;
    unsigned char* O; int ldc; int pad_;
    DEV void operator()(const f32x4 (&acc)[2][2][4][2], const Unit& u, int wr, int wc, int fr, int fq) const {
        const int row0 = u.pm * BM + wr * 64 + fr, col0 = u.pn * BM + wc * 32 + 8 * fq;
#pragma unroll
        for (int ai = 0; ai < 2; ++ai)
#pragma unroll
            for (int m = 0; m < 4; ++m) { unsigned char* rowp = O + (size_t)(row0 + ai * HALF + m * 16) * ldc + col0;
#pragma unroll
                for (int bj = 0; bj < 2; ++bj) { f32x4 a0 = acc[ai][bj][m][0] * 8.f, a1 = acc[ai][bj][m][1] * 8.f;
#pragma unroll
                    for (int i = 0; i < 4; ++i) { a0[i] = fminf(fmaxf(a0[i], -440.f), 440.f); a1[i] = fminf(fmaxf(a1[i], -440.f), 440.f); }
                    int w0 = __builtin_amdgcn_cvt_pk_fp8_f32(a0[0], a0[1], 0, false); w0 = __builtin_amdgcn_cvt_pk_fp8_f32(a0[2], a0[3], w0, true);
                    int w1 = __builtin_amdgcn_cvt_pk_fp8_f32(a1[0], a1[1], 0, false); w1 = __builtin_amdgcn_cvt_pk_fp8_f32(a1[2], a1[3], w1, true);
                    *(u32x2*)(rowp + bj * HALF) = (u32x2){(unsigned)w0, (unsigned)w1}; } }
    }
};
struct EpiGU {
    static constexpr bool PERM = true;
    bf16_t* H;
    DEV void operator()(const f32x4 (&acc)[2][2][4][2], const Unit& u, int wr, int wc, int fr, int fq) const {
        const int row0 = u.pm * BM + wr * 64 + fr, col0 = u.pn * HALF + wc * 32 + 8 * fq;
#pragma unroll
        for (int ai = 0; ai < 2; ++ai)
#pragma unroll
            for (int m = 0; m < 4; ++m) {
                f32x4 h0, h1;
#pragma unroll
                for (int i = 0; i < 4; ++i) { h0[i] = siluf(acc[ai][0][m][0][i]) * acc[ai][1][m][0][i]; h1[i] = siluf(acc[ai][0][m][1][i]) * acc[ai][1][m][1][i]; }
                *(u32x4*)(H + (size_t)(row0 + ai * HALF + m * 16) * ED + col0) = pack8(h0, h1);
            }
    }
};
struct EpiQKV {
    static constexpr bool PERM = true;
    bf16_t* O; const float* cosT; const float* sinT;
    DEV void operator()(const f32x4 (&acc)[2][2][4][2], const Unit& u, int wr, int wc, int fr, int fq) const {
        const int row0 = u.pm * BM + wr * 64 + fr, col0 = u.pn * BM + wc * 32 + 8 * fq;
        const bool rope = u.pn < 8; const float qs = u.pn < 4 ? 0.125f : 1.f;
#pragma unroll
        for (int ai = 0; ai < 2; ++ai)
#pragma unroll
            for (int m = 0; m < 4; ++m) {
                const int row = row0 + ai * HALF + m * 16;
                bf16_t* rowp = O + (size_t)row * 3072 + col0;
                if (rope) {
                    const f32x4 cs = *(const f32x4*)(cosT + (size_t)row * 32 + 16 * (wc & 1) + 4 * fq), sn = *(const f32x4*)(sinT + (size_t)row * 32 + 16 * (wc & 1) + 4 * fq);
#pragma unroll
                    for (int bj = 0; bj < 2; ++bj) { const f32x4 x1 = acc[ai][bj][m][0], x2 = acc[ai][bj][m][1];
                        *(u32x4*)(rowp + bj * HALF) = pack8((x1 * cs - x2 * sn) * qs, (x2 * cs + x1 * sn) * qs); }
                } else {
#pragma unroll
                    for (int bj = 0; bj < 2; ++bj) *(u32x4*)(rowp + bj * HALF) = pack8(acc[ai][bj][m][0], acc[ai][bj][m][1]);
                }
            }
    }
};
}

template <class SrcF>
DEV void conv_item(const SrcF& src, int ldw, int K, bf16_t* dst, LAS float* scr, int item, int nblk, int lane) {
    const int kb = item / nblk, nb = item - kb * nblk, k0 = 64 * kb, n0 = 32 * nb;
    const int quad = lane & 7, r0 = lane >> 3;
    const float* colp = src(n0 + 4 * quad);
    f32x4 v[8];
#pragma unroll
    for (int i = 0; i < 8; ++i) v[i] = colp ? *(const f32x4*)(colp + (size_t)(k0 + r0 + 8 * i) * ldw) : (f32x4){0.f, 0.f, 0.f, 0.f};
#pragma unroll
    for (int i = 0; i < 8; ++i) { LAS float* p = scr + (r0 + 8 * i) * 33 + 4 * quad; p[0] = v[i][0]; p[1] = v[i][1]; p[2] = v[i][2]; p[3] = v[i][3]; }
    LDS_WAIT(); asm volatile("" ::: "memory");
    const int c = lane & 7;
#pragma unroll
    for (int j = 0; j < 4; ++j) { const int n = (lane >> 3) + 8 * j; const LAS float* s = scr + (8 * c) * 33 + n;
        u32x4 o; o.x = pk2(s[0 * 33], s[1 * 33]); o.y = pk2(s[2 * 33], s[3 * 33]); o.z = pk2(s[4 * 33], s[5 * 33]); o.w = pk2(s[6 * 33], s[7 * 33]);
        *(u32x4*)(dst + (size_t)(n0 + n) * K + k0 + 8 * c) = o; }
    LDS_WAIT(); asm volatile("" ::: "memory");
}
struct SrcIdent { const float* W; DEV const float* operator()(int n) const { return W + n; } };
struct SrcWin { const float* W; DEV const float* operator()(int n) const {
    int s; if (n < 4096) s = n; else if (n < 5632) s = C_XBC + (n - 4096); else if (n < 6656) s = C_ZB + (n - 5632); else if (n < 6672) s = C_BETA + (n - 6656); else if (n < 6688) s = C_DT + (n - 6672); else return nullptr;
    return W + s; } };
struct SrcQKV { const float* W; DEV const float* operator()(int n) const {
    if (n >= 2048) return W + n; const int hd = n >> 6, cp = n & 63; return W + hd * 64 + 32 * ((cp >> 2) & 1) + 16 * (cp >> 5) + 4 * ((cp >> 3) & 3) + (cp & 3); } };
struct SrcGU { const float* Wg; long du; DEV const float* operator()(int r) const { const int j = r >> 8, rr = r & 255; return Wg + (rr < 128 ? 0l : du) + 128 * j + (rr & 127); } };

DEV void load_row(const float* p, int lane, float (&v)[16]) {
#pragma unroll
    for (int j = 0; j < 4; ++j) { const f32x4 t = *(const f32x4*)(p + j * 256 + lane * 4); v[4 * j] = t[0]; v[4 * j + 1] = t[1]; v[4 * j + 2] = t[2]; v[4 * j + 3] = t[3]; }
}
DEV void store_row(float* p, int lane, const float (&v)[16]) {
#pragma unroll
    for (int j = 0; j < 4; ++j) *(f32x4*)(p + j * 256 + lane * 4) = (f32x4){v[4 * j], v[4 * j + 1], v[4 * j + 2], v[4 * j + 3]};
}
DEV float row_rstd(const float (&v)[16]) { float ss = 0.f;
#pragma unroll
    for (int i = 0; i < 16; ++i) ss += v[i] * v[i];
    return rsqrtf(wave_sum(ss) * (1.f / D) + EPS); }
DEV void resid_update(float (&xv)[16], const float (&yv)[16], const float* gpost, const float* gt, int lane) {
    const float r = row_rstd(yv);
#pragma unroll
    for (int j = 0; j < 4; ++j) { const f32x4 g = *(const f32x4*)(gpost + j * 256 + lane * 4), t = *(const f32x4*)(gt + j * 256 + lane * 4);
#pragma unroll
        for (int i = 0; i < 4; ++i) xv[4 * j + i] += t[i] * (yv[4 * j + i] * r * g[i]); }
}
DEV void prenorm_pack(const float (&xv)[16], const float* gpre, const float* sc, const float* sh, int lane, u32x2 (&o)[4]) {
    const float r = row_rstd(xv);
#pragma unroll
    for (int j = 0; j < 4; ++j) { const f32x4 g = *(const f32x4*)(gpre + j * 256 + lane * 4), s = *(const f32x4*)(sc + j * 256 + lane * 4), b = *(const f32x4*)(sh + j * 256 + lane * 4);
        float h[4];
#pragma unroll
        for (int i = 0; i < 4; ++i) h[i] = xv[4 * j + i] * r * g[i] * (1.f + s[i]) + b[i];
        o[j] = (u32x2){pk2(h[0], h[1]), pk2(h[2], h[3])}; }
}

DEV void load_row8(const float* p, int lane, float (&v)[16]) {
#pragma unroll
    for (int j = 0; j < 2; ++j)
#pragma unroll
        for (int hh = 0; hh < 2; ++hh) { const f32x4 t = *(const f32x4*)(p + 512 * j + 8 * lane + 4 * hh); v[8 * j + 4 * hh] = t[0]; v[8 * j + 4 * hh + 1] = t[1]; v[8 * j + 4 * hh + 2] = t[2]; v[8 * j + 4 * hh + 3] = t[3]; }
}
DEV void store_row8(float* p, int lane, const float (&v)[16]) {
#pragma unroll
    for (int j = 0; j < 2; ++j)
#pragma unroll
        for (int hh = 0; hh < 2; ++hh) *(f32x4*)(p + 512 * j + 8 * lane + 4 * hh) = (f32x4){v[8 * j + 4 * hh], v[8 * j + 4 * hh + 1], v[8 * j + 4 * hh + 2], v[8 * j + 4 * hh + 3]};
}
DEV void resid_update8(float (&xv)[16], const float (&yv)[16], const float* gpost, const float* gt, int lane) {
    const float r = row_rstd(yv);
#pragma unroll
    for (int j = 0; j < 2; ++j)
#pragma unroll
        for (int hh = 0; hh < 2; ++hh) { const f32x4 g = *(const f32x4*)(gpost + 512 * j + 8 * lane + 4 * hh), t = *(const f32x4*)(gt + 512 * j + 8 * lane + 4 * hh);
#pragma unroll
            for (int i = 0; i < 4; ++i) xv[8 * j + 4 * hh + i] += t[i] * (yv[8 * j + 4 * hh + i] * r * g[i]); }
}
DEV void prenorm_pack8(const float (&xv)[16], const float* gpre, const float* sc, const float* sh, int lane, u32x4 (&o)[2]) {
    const float r = row_rstd(xv);
#pragma unroll
    for (int j = 0; j < 2; ++j) { float h[8];
#pragma unroll
        for (int hh = 0; hh < 2; ++hh) { const f32x4 g = *(const f32x4*)(gpre + 512 * j + 8 * lane + 4 * hh), s = *(const f32x4*)(sc + 512 * j + 8 * lane + 4 * hh), b = *(const f32x4*)(sh + 512 * j + 8 * lane + 4 * hh);
#pragma unroll
            for (int i = 0; i < 4; ++i) h[4 * hh + i] = xv[8 * j + 4 * hh + i] * r * g[i] * (1.f + s[i]) + b[i]; }
        o[j] = (u32x4){pk2(h[0], h[1]), pk2(h[2], h[3]), pk2(h[4], h[5]), pk2(h[6], h[7])}; }
}
DEV void acc_row8(float (&yv)[16], const u32x2 w0, const u32x2 w1, const float g) {
#pragma unroll
    for (int e = 0; e < 2; ++e) {
        yv[4 * e] += g * __builtin_amdgcn_cvt_f32_fp8((int)w0[e], 0); yv[4 * e + 1] += g * __builtin_amdgcn_cvt_f32_fp8((int)w0[e], 1); yv[4 * e + 2] += g * __builtin_amdgcn_cvt_f32_fp8((int)w0[e], 2); yv[4 * e + 3] += g * __builtin_amdgcn_cvt_f32_fp8((int)w0[e], 3);
        yv[8 + 4 * e] += g * __builtin_amdgcn_cvt_f32_fp8((int)w1[e], 0); yv[8 + 4 * e + 1] += g * __builtin_amdgcn_cvt_f32_fp8((int)w1[e], 1); yv[8 + 4 * e + 2] += g * __builtin_amdgcn_cvt_f32_fp8((int)w1[e], 2); yv[8 + 4 * e + 3] += g * __builtin_amdgcn_cvt_f32_fp8((int)w1[e], 3); }
}

DEV void load_row_bf(const bf16_t* p, int lane, float (&v)[16]) {
#pragma unroll
    for (int j = 0; j < 4; ++j) { const u32x2 w = *(const u32x2*)(p + j * 256 + lane * 4); v[4 * j] = __uint_as_float(w.x << 16); v[4 * j + 1] = __uint_as_float(w.x & 0xFFFF0000u); v[4 * j + 2] = __uint_as_float(w.y << 16); v[4 * j + 3] = __uint_as_float(w.y & 0xFFFF0000u); }
}
DEV void store_row_bf(bf16_t* p, int lane, const float (&v)[16]) {
#pragma unroll
    for (int j = 0; j < 4; ++j) *(u32x2*)(p + j * 256 + lane * 4) = (u32x2){pk2(v[4 * j], v[4 * j + 1]), pk2(v[4 * j + 2], v[4 * j + 3])};
}
DEV void load_row8_bf(const bf16_t* p, int lane, float (&v)[16]) {
#pragma unroll
    for (int j = 0; j < 2; ++j) { const u32x4 w = *(const u32x4*)(p + 512 * j + 8 * lane);
#pragma unroll
        for (int e = 0; e < 4; ++e) { v[8 * j + 2 * e] = __uint_as_float(w[e] << 16); v[8 * j + 2 * e + 1] = __uint_as_float(w[e] & 0xFFFF0000u); } }
}
DEV void store_row8_bf(bf16_t* p, int lane, const float (&v)[16]) {
#pragma unroll
    for (int j = 0; j < 2; ++j) *(u32x4*)(p + 512 * j + 8 * lane) = (u32x4){pk2(v[8 * j], v[8 * j + 1]), pk2(v[8 * j + 2], v[8 * j + 3]), pk2(v[8 * j + 4], v[8 * j + 5]), pk2(v[8 * j + 6], v[8 * j + 7])};
}

struct Ctx { LAS unsigned char* lds; int tid, lane, wave, G, bid; };

DEV void ph_setup(const Args& a, const Ctx& X) {
    unsigned char* ws = a.ws;
    float* mod = (float*)(ws + WS_MOD);
    { LAS float* red = (LAS float*)X.lds;
      LAS float* sc = (LAS float*)(X.lds + 8192);
      for (int i = X.tid; i < NB * D; i += NTHR) sc[i] = siluf(a.c[i]);
      __syncthreads();
      const int kc = X.tid >> 6, cl = X.tid & 63;
      for (int task = X.bid; task < 2 * 96; task += X.G) {
          const int l = task / 96, col = (task % 96) * 64 + cl;
          const float* w = a.mod_w + (size_t)l * D * 6 * D + col;
          float p0 = 0.f, p1 = 0.f, p2 = 0.f, p3 = 0.f;
#pragma unroll 16
          for (int k = kc * 128; k < kc * 128 + 128; ++k) { const float wv = w[(size_t)k * 6 * D];
              p0 += sc[k] * wv; p1 += sc[D + k] * wv; p2 += sc[2 * D + k] * wv; p3 += sc[3 * D + k] * wv; }
          __syncthreads();
          red[(kc * 4 + 0) * 64 + cl] = p0; red[(kc * 4 + 1) * 64 + cl] = p1; red[(kc * 4 + 2) * 64 + cl] = p2; red[(kc * 4 + 3) * 64 + cl] = p3;
          __syncthreads();
          if (X.tid < 256) { const int b = X.tid >> 6; float s = a.mod_b[l * 6 * D + col];
#pragma unroll
              for (int q = 0; q < 8; ++q) s += red[(q * 4 + b) * 64 + cl];
              mod[(size_t)(l * NB + b) * 6 * D + col] = s; }
      }
      __syncthreads(); }
    { float* cosT = (float*)(ws + WS_COS); float* sinT = (float*)(ws + WS_SIN);
      for (int idx = X.bid * NTHR + X.tid; idx < T * 32; idx += X.G * NTHR) { const int t = idx >> 5, i = idx & 31;
          const float ang = (float)a.pos[t] * powf(10000.f, -(float)i / 32.f); float sn, cs; sincosf(ang, &sn, &cs); cosT[idx] = cs; sinT[idx] = sn; } }
    { LAS float* scr = (LAS float*)(X.lds + X.wave * 8704);
      const int gw = X.bid * NWAVES + X.wave, NGW = X.G * NWAVES;
      constexpr int I_IN = (D / 64) * (NPROJ / 32), I_OUT = (2048 / 64) * (D / 32), I_QKV = (D / 64) * (3072 / 32), I_O = (D / 64) * (D / 32);
      for (int it = gw; it < I_IN + I_OUT + I_QKV + I_O; it += NGW) {
          int r = it;
          if (r < I_IN) { conv_item(SrcWin{a.ssm_w_in}, PROJ, D, (bf16_t*)(ws + WS_WIN), scr, r, NPROJ / 32, X.lane); continue; } r -= I_IN;
          if (r < I_OUT) { conv_item(SrcIdent{a.ssm_w_out}, D, 2048, (bf16_t*)(ws + WS_WOUT), scr, r, D / 32, X.lane); continue; } r -= I_OUT;
          if (r < I_QKV) { conv_item(SrcQKV{a.attn_w_qkv}, 3072, D, (bf16_t*)(ws + WS_WQKV), scr, r, 3072 / 32, X.lane); continue; } r -= I_QKV;
          conv_item(SrcIdent{a.attn_w_o}, D, D, (bf16_t*)(ws + WS_WO), scr, r, D / 32, X.lane);
      } }
}

DEV void ph_prenorm0(const Args& a, const Ctx& X) {
    const float* mod = (const float*)(a.ws + WS_MOD);
    bf16_t* hb = (bf16_t*)(a.ws + WS_H);
    for (int row = X.bid * NWAVES + X.wave; row < T; row += X.G * NWAVES) {
        const int b = row / SEQ; const float* ml = mod + (size_t)b * 6 * D;
        float xv[16]; load_row(a.x + (size_t)row * D, X.lane, xv);
        u32x2 o[4]; prenorm_pack(xv, a.mix_pre_g, ml + D, ml, X.lane, o);
#pragma unroll
        for (int j = 0; j < 4; ++j) *(u32x2*)(hb + (size_t)row * D + j * 256 + X.lane * 4) = o[j];
    }
}

DEV void ph_mix_prep(const Args& a, const Ctx& X) {
    const unsigned char* ws = a.ws;
    const bf16_t* qkvpre = (const bf16_t*)(ws + WS_QKVPRE); const bf16_t* xbcpre = (const bf16_t*)(ws + WS_XBCPRE); const float* small = (const float*)(ws + WS_SMALL);
    bf16_t* qkvn = (bf16_t*)(a.ws + WS_QKVN); float* gb = (float*)(a.ws + WS_GB); bf16_t* xbcc = (bf16_t*)(a.ws + WS_XBCC); float* dtb = (float*)(a.ws + WS_DTB);
    for (int wid = X.bid * NWAVES + X.wave; wid < T * 8; wid += X.G * NWAVES) {
        const int t = wid >> 3, h = wid & 7, s = t % SEQ, lane = X.lane;
        float vals[3][2];
#pragma unroll
        for (int part = 0; part < 3; ++part)
#pragma unroll
            for (int e = 0; e < 2; ++e) { const int c = part * 1024 + h * 128 + lane * 2 + e; float acc = 0.f;
#pragma unroll
                for (int i = 0; i < 4; ++i) { const int ss = s - 3 + i; if (ss >= 0) acc += a.gdn_conv_w[i * 3072 + c] * bf2f(qkvpre[(size_t)(t - 3 + i) * 3072 + c]); }
                vals[part][e] = siluf(acc); }
#pragma unroll
        for (int part = 0; part < 2; ++part) { const float ss = wave_sum(vals[part][0] * vals[part][0] + vals[part][1] * vals[part][1]); const float r = rsqrtf(ss + 1e-6f); vals[part][0] *= r; vals[part][1] *= r; }
#pragma unroll
        for (int part = 0; part < 3; ++part) *(unsigned*)(qkvn + (size_t)t * 3072 + part * 1024 + h * 128 + lane * 2) = pk2(vals[part][0], vals[part][1]);
        if (lane == 0) { const float beta = sigmoidf_(small[(size_t)t * 32 + h]); const float g = -__expf(a.gdn_a_log[h]) * softplusf(small[(size_t)t * 32 + 8 + h] + a.gdn_dt_bias[h]);
            gb[t * 16 + h] = g; gb[t * 16 + 8 + h] = beta; }
    }
}
DEV void ph_mix_seq(const Args& a, const Ctx& X) {
    const bf16_t* qkvn = (const bf16_t*)(a.ws + WS_QKVN); const float* gb = (const float*)(a.ws + WS_GB);
    const bf16_t* xbc = (const bf16_t*)(a.ws + WS_XBCC); const float* dtb = (const float*)(a.ws + WS_DTB);
    float* oraw = (float*)(a.ws + WS_ORAW); float* yraw = (float*)(a.ws + WS_YRAW);
    const int tid = X.tid;
    if (X.bid < 32) {
        LAS float* sk = (LAS float*)X.lds; LAS float* sq = sk + 16 * 128; LAS float* sv = sq + 16 * 128; LAS float* sa = sv + 16 * 128; LAS float* sbeta = sa + 16; LAS float* red = sbeta + 16;
        const int b = X.bid >> 3, h = X.bid & 7, v = tid & 127, kq = tid >> 7;
        float S[32];
#pragma unroll
        for (int i = 0; i < 32; ++i) S[i] = 0.f;
        const float scale = 0.08838834764831845f;
        for (int t0 = 0; t0 < SEQ; t0 += 16) {
            const size_t tb = (size_t)b * SEQ + t0;
            for (int idx = tid; idx < 16 * 384; idx += NTHR) { const int jj = idx / 384, c = idx % 384, part = c >> 7, cc = c & 127;
                const float val = bf2f(qkvn[(tb + jj) * 3072 + part * 1024 + h * 128 + cc]);
                if (part == 0) sq[jj * 128 + cc] = val; else if (part == 1) sk[jj * 128 + cc] = val; else sv[jj * 128 + cc] = val; }
            if (tid < 16) { sa[tid] = __expf(gb[(tb + tid) * 16 + h]); sbeta[tid] = gb[(tb + tid) * 16 + 8 + h]; }
            __syncthreads();
            for (int j = 0; j < 16; ++j) {
                const float al = sa[j], bt = sbeta[j]; float p = 0.f;
#pragma unroll
                for (int i = 0; i < 32; ++i) { S[i] *= al; p += sk[j * 128 + kq * 32 + i] * S[i]; }
                red[kq * 128 + v] = p;
                __syncthreads();
                const float kS = red[v] + red[128 + v] + red[256 + v] + red[384 + v];
                const float delta = bt * (sv[j * 128 + v] - kS); float po = 0.f;
#pragma unroll
                for (int i = 0; i < 32; ++i) { S[i] += sk[j * 128 + kq * 32 + i] * delta; po += sq[j * 128 + kq * 32 + i] * S[i]; }
                red[512 + kq * 128 + v] = po;
                __syncthreads();
                if (kq == 0) oraw[(tb + j) * 1024 + h * 128 + v] = (red[512 + v] + red[512 + 128 + v] + red[512 + 256 + v] + red[512 + 384 + v]) * scale;
            }
            __syncthreads();
        }
    }
}
DEV void ph_mix_post(const Args& a, const Ctx& X) {
    const float* oraw = (const float*)(a.ws + WS_ORAW); const float* yraw = (const float*)(a.ws + WS_YRAW);
    const bf16_t* za = (const bf16_t*)(a.ws + WS_ZA); const bf16_t* zb = (const bf16_t*)(a.ws + WS_ZB); bf16_t* oy = (bf16_t*)(a.ws + WS_OY);
    const int lane = X.lane;
    for (int wid = X.bid * NWAVES + X.wave; wid < T * 8; wid += X.G * NWAVES) {
        const int t = wid >> 3, h = wid & 7, c = h * 128 + lane * 2;
        const f32x2 o = *(const f32x2*)(oraw + (size_t)t * 1024 + c);
        const float r = rsqrtf(wave_sum(o.x * o.x + o.y * o.y) * (1.f / 128.f) + EPS);
        const float z0 = bf2f(za[(size_t)t * 1024 + c]), z1 = bf2f(za[(size_t)t * 1024 + c + 1]);
        *(unsigned*)(oy + (size_t)t * 2048 + c) = pk2(o.x * r * a.gdn_norm_w[lane * 2] * siluf(z0), o.y * r * a.gdn_norm_w[lane * 2 + 1] * siluf(z1));
    }
}

DEV bf16x8 acc_to_frag(const f32x4 lo, const f32x4 hi) { u32x4 w; w.x = pg8::cvt_pk_bf16(lo[0], lo[1]); w.y = pg8::cvt_pk_bf16(lo[2], lo[3]); w.z = pg8::cvt_pk_bf16(hi[0], hi[1]); w.w = pg8::cvt_pk_bf16(hi[2], hi[3]); return __builtin_bit_cast(bf16x8, w); }

DEV void gdn_solve(LAS float* M, LAS unsigned short* tf, const int lane) {
    for (int rb = 0; rb < 16; ++rb) {
        const int i0 = 4 * rb;
        float a0 = (lane == i0) ? 1.f : 0.f, a1 = (lane == i0 + 1) ? 1.f : 0.f, a2 = (lane == i0 + 2) ? 1.f : 0.f, a3 = (lane == i0 + 3) ? 1.f : 0.f;
        for (int j = 0; j < i0; j += 4) {
            const float t0 = M[j * 64 + lane], t1 = M[(j + 1) * 64 + lane], t2 = M[(j + 2) * 64 + lane], t3 = M[(j + 3) * 64 + lane];
            const f32x4 r0 = *(const LAS f32x4*)(M + i0 * 64 + j), r1 = *(const LAS f32x4*)(M + (i0 + 1) * 64 + j), r2 = *(const LAS f32x4*)(M + (i0 + 2) * 64 + j), r3 = *(const LAS f32x4*)(M + (i0 + 3) * 64 + j);
            a0 -= r0[0] * t0 + r0[1] * t1 + r0[2] * t2 + r0[3] * t3; a1 -= r1[0] * t0 + r1[1] * t1 + r1[2] * t2 + r1[3] * t3;
            a2 -= r2[0] * t0 + r2[1] * t1 + r2[2] * t2 + r2[3] * t3; a3 -= r3[0] * t0 + r3[1] * t1 + r3[2] * t2 + r3[3] * t3;
        }
        const f32x4 d1 = *(const LAS f32x4*)(M + (i0 + 1) * 64 + i0), d2 = *(const LAS f32x4*)(M + (i0 + 2) * 64 + i0), d3 = *(const LAS f32x4*)(M + (i0 + 3) * 64 + i0);
        a1 -= d1[0] * a0; a2 -= d2[0] * a0 + d2[1] * a1; a3 -= d3[0] * a0 + d3[1] * a1 + d3[2] * a2;
        M[i0 * 64 + lane] = a0; M[(i0 + 1) * 64 + lane] = a1; M[(i0 + 2) * 64 + lane] = a2; M[(i0 + 3) * 64 + lane] = a3;
    }
    const int cq = (lane >> 2) & 3, ca = (lane >> 4) & 1, ce = lane & 3, cks = lane >> 5;
    for (int i = 0; i < 64; ++i) tf[((i >> 4) * 2 + cks) * 512 + ((i & 15) + 16 * cq) * 8 + 4 * ca + ce] = (unsigned short)f2bf(M[i * 64 + lane]);
}
DEV void ph_gdn_local(const Args& a, const Ctx& X) {
    const bf16_t* qkvpre = (const bf16_t*)(a.ws + WS_QKVPRE); const float* small = (const float*)(a.ws + WS_SMALL);
    unsigned char* gi = a.ws + WS_GI; float* glast = (float*)(a.ws + WS_GLAST);
    constexpr int KP = 272;
    LAS unsigned char* kN = X.lds; LAS unsigned char* qN = X.lds + 64 * KP; LAS unsigned char* slots = X.lds + 128 * KP;
    LAS float* gcL = (LAS float*)(X.lds + AUX_OFF); LAS float* btL = gcL + 8 * 64;
    const int lane = X.lane, wave = X.wave, r16 = lane & 15, q4 = lane >> 4;
    const float scale = 0.08838834764831845f;
    for (int wu = X.bid; wu < NB * 64; wu += X.G) {
        const int b = wu >> 6, n = wu & 63; const size_t t0 = (size_t)b * SEQ + 64 * n;
        unsigned char* tmp = a.ws + WS_GTMP + (size_t)X.bid * 131072;
        __syncthreads();
        {
            const float g = -__expf(a.gdn_a_log[wave]) * softplusf(small[(t0 + lane) * 32 + 8 + wave] + a.gdn_dt_bias[wave]);
            float gc = g;
#pragma unroll
            for (int o = 1; o < 64; o <<= 1) { const float v = __shfl_up(gc, o); if (lane >= o) gc += v; }
            gcL[wave * 64 + lane] = gc; btL[wave * 64 + lane] = sigmoidf_(small[(t0 + lane) * 32 + wave]);
            if (lane == 63) glast[(size_t)((b * 8 + wave) * 64 + n) * 32] = gc;
        }
        __syncthreads();
        unsigned xr[3][11];
#define GDN_LOADX(hh) do { _Pragma("unroll") for (int _p = 0; _p < 3; ++_p) _Pragma("unroll") for (int _i = 0; _i < 11; ++_i) { const int _tk = 8 * wave + _i - 3; unsigned _v = 0u; \
            if (64 * n + _tk >= 0) _v = *(const unsigned*)(qkvpre + (t0 + _tk) * 3072 + _p * 1024 + (hh) * 128 + 2 * lane); xr[_p][_i] = _v; } } while (0)
        GDN_LOADX(0);
        for (int bb = 0; bb < 2; ++bb) {
            for (int j = 0; j < 4; ++j) {
                const int h = bb * 4 + j; unsigned char* ub = gi + (size_t)((b * 8 + h) * 64 + n) * GI_UNIT;
                {
                    const float gl = gcL[h * 64 + 63];
                    const int blk = wave >> 2, pa = (wave & 3) >> 1, pq0 = 2 * (wave & 1);
                    const int ca = (2 * lane >> 4) & 1, cq = (2 * lane >> 2) & 3, ce = (2 * lane) & 3, cks = (2 * lane) >> 5;
#pragma unroll
                    for (int part = 0; part < 3; ++part) {
                        const int col = part * 1024 + h * 128 + 2 * lane;
                        float w0[4], w1[4];
#pragma unroll
                        for (int i = 0; i < 4; ++i) { const f32x2 t = *(const f32x2*)(a.gdn_conv_w + i * 3072 + col); w0[i] = t.x; w1[i] = t.y; }
                        float x0[11], x1[11];
#pragma unroll
                        for (int i = 0; i < 11; ++i) { const unsigned v = xr[part][i]; x0[i] = __uint_as_float(v << 16); x1[i] = __uint_as_float(v & 0xFFFF0000u); }
                        float v0[8], v1[8];
#pragma unroll
                        for (int i = 0; i < 8; ++i) { v0[i] = siluf(w0[0] * x0[i] + w0[1] * x0[i + 1] + w0[2] * x0[i + 2] + w0[3] * x0[i + 3]); v1[i] = siluf(w1[0] * x1[i] + w1[1] * x1[i + 1] + w1[2] * x1[i + 2] + w1[3] * x1[i + 3]); }
                        if (part < 2) {
#pragma unroll
                            for (int i = 0; i < 8; ++i) { const float r = rsqrtf(wave_sum(v0[i] * v0[i] + v1[i] * v1[i]) + 1e-6f); v0[i] *= r; v1[i] *= r; }
                        }
                        for (int rep_ = 0; rep_ < (((PROBE_MASK >> 21) & 1u) ? 2 : 1); ++rep_) {
                        if (part == 0) {
#pragma unroll
                            for (int i = 0; i < 8; ++i) { const int tok = 8 * wave + i; const float eg = __expf(gcL[h * 64 + tok]) * scale;
                                *(LAS unsigned*)(qN + tok * KP + lane * 4) = pk2(v0[i], v1[i]);
                                *(unsigned*)(ub + 16384 + ((tok >> 4) * 4 + cks) * 1024 + ((tok & 15) + 16 * cq) * 16 + (4 * ca + ce) * 2) = pk2(v0[i] * eg, v1[i] * eg); }
                        } else if (part == 1) {
                            unsigned short kg0[8], kg1[8], ke0[8], ke1[8];
#pragma unroll
                            for (int i = 0; i < 8; ++i) { const int tok = 8 * wave + i; const float gc = gcL[h * 64 + tok], bt = btL[h * 64 + tok], eg = __expf(gc) * bt, eend = __expf(gl - gc);
                                *(LAS unsigned*)(kN + tok * KP + lane * 4) = pk2(v0[i], v1[i]);
                                kg0[i] = (unsigned short)f2bf(v0[i] * eg); kg1[i] = (unsigned short)f2bf(v1[i] * eg); ke0[i] = (unsigned short)f2bf(v0[i] * eend); ke1[i] = (unsigned short)f2bf(v1[i] * eend); }
#pragma unroll
                            for (int hf = 0; hf < 2; ++hf) { const int pos = 32 * blk + 8 * (pq0 + hf) + 4 * pa; const int cl = 2 * lane;
                                *(u32x2*)(tmp + (size_t)j * 32768 + 16384 + cl * 128 + pos * 2) = (u32x2){(unsigned)kg0[4 * hf] | ((unsigned)kg0[4 * hf + 1] << 16), (unsigned)kg0[4 * hf + 2] | ((unsigned)kg0[4 * hf + 3] << 16)};
                                *(u32x2*)(tmp + (size_t)j * 32768 + 16384 + (cl + 1) * 128 + pos * 2) = (u32x2){(unsigned)kg1[4 * hf] | ((unsigned)kg1[4 * hf + 1] << 16), (unsigned)kg1[4 * hf + 2] | ((unsigned)kg1[4 * hf + 3] << 16)};
                                *(u32x2*)(ub + 32768 + ((cl >> 4) * 2 + blk) * 1024 + ((cl & 15) + 16 * (pq0 + hf)) * 16 + (4 * pa) * 2) = (u32x2){(unsigned)ke0[4 * hf] | ((unsigned)ke0[4 * hf + 1] << 16), (unsigned)ke0[4 * hf + 2] | ((unsigned)ke0[4 * hf + 3] << 16)};
                                *(u32x2*)(ub + 32768 + (((cl + 1) >> 4) * 2 + blk) * 1024 + (((cl + 1) & 15) + 16 * (pq0 + hf)) * 16 + (4 * pa) * 2) = (u32x2){(unsigned)ke1[4 * hf] | ((unsigned)ke1[4 * hf + 1] << 16), (unsigned)ke1[4 * hf + 2] | ((unsigned)ke1[4 * hf + 3] << 16)}; }
                        } else {
                            unsigned short vb0[8], vb1[8];
#pragma unroll
                            for (int i = 0; i < 8; ++i) { const float bt = btL[h * 64 + 8 * wave + i]; vb0[i] = (unsigned short)f2bf(v0[i] * bt); vb1[i] = (unsigned short)f2bf(v1[i] * bt); }
#pragma unroll
                            for (int hf = 0; hf < 2; ++hf) { const int pos = 32 * blk + 8 * (pq0 + hf) + 4 * pa; const int cl = 2 * lane;
                                *(u32x2*)(tmp + (size_t)j * 32768 + cl * 128 + pos * 2) = (u32x2){(unsigned)vb0[4 * hf] | ((unsigned)vb0[4 * hf + 1] << 16), (unsigned)vb0[4 * hf + 2] | ((unsigned)vb0[4 * hf + 3] << 16)};
                                *(u32x2*)(tmp + (size_t)j * 32768 + (cl + 1) * 128 + pos * 2) = (u32x2){(unsigned)vb1[4 * hf] | ((unsigned)vb1[4 * hf + 1] << 16), (unsigned)vb1[4 * hf + 2] | ((unsigned)vb1[4 * hf + 3] << 16)}; }
                        }
                        asm volatile("" ::: "memory"); }
                    }
                }
                if (h + 1 < 8) GDN_LOADX(h + 1);
                __syncthreads();
                {
                    const int mat = wave >> 2, rt = wave & 3; LAS unsigned char* An = mat ? qN : kN;
                    bf16x8 af[4];
#pragma unroll
                    for (int ks = 0; ks < 4; ++ks) af[ks] = *(const LAS bf16x8*)(An + (16 * rt + r16) * KP + (32 * ks + 8 * q4) * 2);
                    LAS float* slot = (LAS float*)(slots + j * 16384);
#pragma unroll
                    for (int ct = 0; ct < 4; ++ct) { f32x4 acc = {0.f, 0.f, 0.f, 0.f};
#pragma unroll
                        for (int ks = 0; ks < 4; ++ks) { const bf16x8 bf = *(const LAS bf16x8*)(kN + (16 * ct + r16) * KP + (32 * ks + 8 * q4) * 2); acc = __builtin_amdgcn_mfma_f32_16x16x32_bf16(af[ks], bf, acc, 0, 0, 0); }
                        const int jc = 16 * ct + r16; const float gj = gcL[h * 64 + jc];
#pragma unroll
                        for (int rg = 0; rg < 4; ++rg) { const int i = 16 * rt + 4 * q4 + rg; const float dec = __expf(gcL[h * 64 + i] - gj);
                            if (mat == 0) { slot[i * 64 + jc] = jc < i ? btL[h * 64 + i] * acc[rg] * dec : 0.f; }
                            else { const float v = jc <= i ? acc[rg] * scale * dec : 0.f;
                                *(unsigned short*)(ub + 49152 + (rt * 2 + (ct >> 1)) * 1024 + ((4 * q4 + rg) + 16 * (r16 >> 2)) * 16 + (4 * (ct & 1) + (r16 & 3)) * 2) = (unsigned short)f2bf(v); } }
                    }
                }
                __syncthreads();
            }
            if (wave < 4) gdn_solve((LAS float*)(slots + wave * 16384), (LAS unsigned short*)(X.lds + wave * 8192), lane);
            VM_WAIT(); __syncthreads();
            for (int j = 0; j < 4; ++j) {
                const int h = bb * 4 + j; unsigned char* ub = gi + (size_t)((b * 8 + h) * 64 + n) * GI_UNIT;
                const int mat = wave >> 2; LAS unsigned char* slot = X.lds + j * 8192;
#pragma unroll
                for (int cx = 0; cx < 2; ++cx) { const int ct = 2 * (wave & 3) + cx;
                    bf16x8 bfr[2];
#pragma unroll
                    for (int ks = 0; ks < 2; ++ks) { const u32x4 t = __builtin_nontemporal_load((const u32x4*)(tmp + (size_t)j * 32768 + mat * 16384 + (16 * ct + r16) * 128 + (32 * ks + 8 * q4) * 2)); bfr[ks] = __builtin_bit_cast(bf16x8, t); }
#pragma unroll
                    for (int rt = 0; rt < 4; ++rt) { f32x4 acc = {0.f, 0.f, 0.f, 0.f};
#pragma unroll
                        for (int ks = 0; ks < 2; ++ks) { const bf16x8 tf = *(const LAS bf16x8*)(slot + (rt * 2 + ks) * 1024 + lane * 16); acc = __builtin_amdgcn_mfma_f32_16x16x32_bf16(tf, bfr[ks], acc, 0, 0, 0); }
                        if (mat == 0) *(u32x2*)(ub + 57344 + (rt * 8 + ct) * 512 + lane * 8) = (u32x2){pg8::cvt_pk_bf16(acc[0], acc[1]), pg8::cvt_pk_bf16(acc[2], acc[3])};
                        else {
#pragma unroll
                            for (int rg = 0; rg < 4; ++rg) *(unsigned short*)(ub + (rt * 4 + (ct >> 1)) * 1024 + ((4 * q4 + rg) + 16 * (r16 >> 2)) * 16 + (4 * (ct & 1) + (r16 & 3)) * 2) = (unsigned short)f2bf(-acc[rg]);
                        }
                    }
                }
            }
            __syncthreads();
        }
    }
}
DEV void ph_gdn_scan(const Args& a, const Ctx& X) {
    const unsigned char* gi = a.ws + WS_GI; const float* glast = (const float*)(a.ws + WS_GLAST);
    const bf16_t* za = (const bf16_t*)(a.ws + WS_ZA); bf16_t* oy = (bf16_t*)(a.ws + WS_OY);
    const int lane = X.lane, wave = X.wave, r16 = lane & 15, q4 = lane >> 4, tid = X.tid;
    LAS float* OT = (LAS float*)(X.lds + 114688);
    const int bh = X.bid, b = bh >> 3, h = bh & 7;
    const unsigned char* ubase = gi + (size_t)bh * 64 * GI_UNIT;
    f32x4 S[8];
#pragma unroll
    for (int i = 0; i < 8; ++i) S[i] = (f32x4){0.f, 0.f, 0.f, 0.f};
    float nwv[16];
#pragma unroll
    for (int i = 0; i < 16; ++i) nwv[i] = a.gdn_norm_w[16 * (tid & 7) + i];
#define GDN_STAGE(nn, buf) do { _Pragma("unroll") for (int _i = 0; _i < 7; ++_i) \
        __builtin_amdgcn_global_load_lds((const unsigned*)(ubase + (size_t)(nn) * GI_UNIT + (size_t)(tid + 512 * _i) * 16), (LAS unsigned*)(X.lds + (buf) * 57344 + (wave * 64 + 512 * _i) * 16), 16, 0, 0); } while (0)
    u32x2 udn[4]; float gln; u32x4 zn[2];
    { const size_t tz = (size_t)b * SEQ + (tid >> 3); zn[0] = *(const u32x4*)(za + tz * 1024 + h * 128 + 16 * (tid & 7)); zn[1] = *(const u32x4*)(za + tz * 1024 + h * 128 + 16 * (tid & 7) + 8); }
#pragma unroll
    for (int ct = 0; ct < 4; ++ct) udn[ct] = *(const u32x2*)(ubase + 57344 + (ct * 8 + wave) * 512 + lane * 8);
    gln = glast[(size_t)(bh * 64) * 32];
    GDN_STAGE(0, 0);
#define GDN_EPILOGUE(nn, ZC) do { const int tok = tid >> 3, seg = tid & 7; const size_t t = (size_t)b * SEQ + 64 * (nn) + tok; \
            float ov[16]; float ss = 0.f; \
            _Pragma("unroll") for (int i = 0; i < 4; ++i) { const f32x4 v = *(const LAS f32x4*)(OT + tok * 132 + 16 * seg + 4 * i); ov[4 * i] = v[0]; ov[4 * i + 1] = v[1]; ov[4 * i + 2] = v[2]; ov[4 * i + 3] = v[3]; ss += v[0] * v[0] + v[1] * v[1] + v[2] * v[2] + v[3] * v[3]; } \
            ss += __shfl_xor(ss, 1); ss += __shfl_xor(ss, 2); ss += __shfl_xor(ss, 4); \
            const float rstd = rsqrtf(ss * (1.f / 128.f) + EPS); \
            u32x4 ow[2]; \
            _Pragma("unroll") for (int i = 0; i < 2; ++i) _Pragma("unroll") for (int e = 0; e < 4; ++e) { const unsigned zw = (ZC)[i][e]; const float z0 = __uint_as_float(zw << 16), z1 = __uint_as_float(zw & 0xFFFF0000u); \
                    ow[i][e] = pg8::cvt_pk_bf16(ov[8 * i + 2 * e] * rstd * nwv[8 * i + 2 * e] * siluf(z0), ov[8 * i + 2 * e + 1] * rstd * nwv[8 * i + 2 * e + 1] * siluf(z1)); } \
            *(u32x4*)(oy + t * 2048 + h * 128 + 16 * seg) = ow[0]; *(u32x4*)(oy + t * 2048 + h * 128 + 16 * seg + 8) = ow[1]; } while (0)
    u32x4 zp[2] = {{0u, 0u, 0u, 0u}, {0u, 0u, 0u, 0u}};
    for (int n = 0; n < 64; ++n) {
        VM_WAIT(); __syncthreads();
        f32x4 uf[4];
#pragma unroll
        for (int ct = 0; ct < 4; ++ct) { uf[ct][0] = __uint_as_float(udn[ct].x << 16); uf[ct][1] = __uint_as_float(udn[ct].x & 0xFFFF0000u); uf[ct][2] = __uint_as_float(udn[ct].y << 16); uf[ct][3] = __uint_as_float(udn[ct].y & 0xFFFF0000u); }
        const float egl = __expf(gln);
        u32x4 zc[2]; zc[0] = zn[0]; zc[1] = zn[1];
        asm volatile("" : "+v"(uf[0]), "+v"(uf[1]), "+v"(uf[2]), "+v"(uf[3]), "+v"(zc[0]), "+v"(zc[1]));
        if (n + 1 < 64) {
            const unsigned char* un = ubase + (size_t)(n + 1) * GI_UNIT;
#pragma unroll
            for (int ct = 0; ct < 4; ++ct) udn[ct] = *(const u32x2*)(un + 57344 + (ct * 8 + wave) * 512 + lane * 8);
            gln = glast[(size_t)(bh * 64 + n + 1) * 32];
            { const size_t tz = (size_t)b * SEQ + 64 * (n + 1) + (tid >> 3); zn[0] = *(const u32x4*)(za + tz * 1024 + h * 128 + 16 * (tid & 7)); zn[1] = *(const u32x4*)(za + tz * 1024 + h * 128 + 16 * (tid & 7) + 8); }
            GDN_STAGE(n + 1, (n + 1) & 1);
        }
        if (n > 0) GDN_EPILOGUE(n - 1, zp);
        zp[0] = zc[0]; zp[1] = zc[1];
        const LAS unsigned char* L = X.lds + (n & 1) * 57344;
        bf16x8 sB[4];
#pragma unroll
        for (int ks = 0; ks < 4; ++ks) sB[ks] = acc_to_frag(S[2 * ks], S[2 * ks + 1]);
        f32x4 vn[4], oo[4];
#pragma unroll
        for (int ct = 0; ct < 4; ++ct) { f32x4 acc = {0.f, 0.f, 0.f, 0.f}, ao = {0.f, 0.f, 0.f, 0.f};
#pragma unroll
            for (int ks = 0; ks < 4; ++ks) { const bf16x8 wf = *(const LAS bf16x8*)(L + (ct * 4 + ks) * 1024 + lane * 16), qf = *(const LAS bf16x8*)(L + 16384 + (ct * 4 + ks) * 1024 + lane * 16);
                acc = __builtin_amdgcn_mfma_f32_16x16x32_bf16(wf, sB[ks], acc, 0, 0, 0); ao = __builtin_amdgcn_mfma_f32_16x16x32_bf16(qf, sB[ks], ao, 0, 0, 0); }
            vn[ct] = acc; oo[ct] = ao; }
#pragma unroll
        for (int ct = 0; ct < 4; ++ct) vn[ct] = vn[ct] + uf[ct];
        bf16x8 vB[2];
#pragma unroll
        for (int ks = 0; ks < 2; ++ks) vB[ks] = acc_to_frag(vn[2 * ks], vn[2 * ks + 1]);
#pragma unroll
        for (int ct = 0; ct < 4; ++ct)
#pragma unroll
            for (int ks = 0; ks < 2; ++ks) { const bf16x8 kf = *(const LAS bf16x8*)(L + 49152 + (ct * 2 + ks) * 1024 + lane * 16); oo[ct] = __builtin_amdgcn_mfma_f32_16x16x32_bf16(kf, vB[ks], oo[ct], 0, 0, 0); }
#pragma unroll
        for (int dt = 0; dt < 8; ++dt) { f32x4 acc = S[dt] * egl;
#pragma unroll
            for (int ks = 0; ks < 2; ++ks) { const bf16x8 ef = *(const LAS bf16x8*)(L + 32768 + (dt * 2 + ks) * 1024 + lane * 16); acc = __builtin_amdgcn_mfma_f32_16x16x32_bf16(ef, vB[ks], acc, 0, 0, 0); }
            S[dt] = acc; }
        __syncthreads();
#pragma unroll
        for (int ct = 0; ct < 4; ++ct)
#pragma unroll
            for (int rg = 0; rg < 4; ++rg) OT[(16 * ct + 4 * q4 + rg) * 132 + 16 * wave + r16] = oo[ct][rg];
    }
    __syncthreads();
    GDN_EPILOGUE(63, zp);
#undef GDN_EPILOGUE
#undef GDN_STAGE
}

constexpr int SP = 272;
DEV void ph_ssd_local(const Args& a, const Ctx& X) {
    const bf16_t* xbcpre = (const bf16_t*)(a.ws + WS_XBCPRE); const float* small = (const float*)(a.ws + WS_SMALL);
    bf16_t* CC = (bf16_t*)(a.ws + WS_CC); float* acum = (float*)(a.ws + WS_ACUM); float* cdec = (float*)(a.ws + WS_CDEC);
    bf16_t* ydiag = (bf16_t*)(a.ws + WS_YDIAG); bf16_t* states = (bf16_t*)(a.ws + WS_STATES);
    LAS unsigned char* Bn = X.lds; LAS unsigned char* Cn = X.lds + 128 * SP; LAS unsigned char* BT = X.lds + 256 * SP;
    LAS unsigned char* xdT = X.lds; LAS unsigned char* xeT = X.lds + 64 * SP;
    LAS float* acL = (LAS float*)(X.lds + AUX_OFF); LAS float* dtL = acL + 8 * 128;
    const int lane = X.lane, wave = X.wave, r16 = lane & 15, q4 = lane >> 4;
    for (int unit = X.bid; unit < NB * 32 * 2; unit += X.G) {
        const int g = unit & 1, c = (unit >> 1) & 31, b = unit >> 6; const size_t t0 = (size_t)b * SEQ + 128 * c;
        __syncthreads();
        {
            const int hd = g * 8 + wave; const float an = -__expf(a.ssd_a_log[hd]), bias = a.ssd_dt_bias[hd];
            const float d0 = softplusf(small[(t0 + lane) * 32 + 16 + hd] + bias), d1 = softplusf(small[(t0 + 64 + lane) * 32 + 16 + hd] + bias);
            float s0 = d0 * an, s1 = d1 * an;
#pragma unroll
            for (int o = 1; o < 64; o <<= 1) { const float v0 = __shfl_up(s0, o), v1 = __shfl_up(s1, o); if (lane >= o) { s0 += v0; s1 += v1; } }
            s1 += __shfl(s0, 63);
            acL[wave * 128 + lane] = s0; acL[wave * 128 + 64 + lane] = s1; dtL[wave * 128 + lane] = d0; dtL[wave * 128 + 64 + lane] = d1;
            acum[((size_t)g * T + t0 + lane) * 8 + wave] = s0; acum[((size_t)g * T + t0 + 64 + lane) * 8 + wave] = s1;
            if (lane == 63) cdec[(size_t)unit * 32 + wave] = __expf(s1);
        }
        {
            const int isC = lane >> 5, cc = (lane & 31) * 4, col = 1024 + isC * 256 + g * 128 + cc;
            float w[4][4], bs[4];
#pragma unroll
            for (int i = 0; i < 4; ++i) { const f32x4 t = *(const f32x4*)(a.ssd_conv_w + i * 1536 + col); w[i][0] = t[0]; w[i][1] = t[1]; w[i][2] = t[2]; w[i][3] = t[3]; }
            { const f32x4 t = *(const f32x4*)(a.ssd_conv_b + col); bs[0] = t[0]; bs[1] = t[1]; bs[2] = t[2]; bs[3] = t[3]; }
            float xin[19][4];
#pragma unroll
            for (int i = 0; i < 19; ++i) { const int tk = 16 * wave + i - 3; const bool ok = (128 * c + tk) >= 0; u32x2 v = {0u, 0u}; if (ok) v = *(const u32x2*)(xbcpre + (t0 + tk) * 1536 + col);
                xin[i][0] = __uint_as_float(v.x << 16); xin[i][1] = __uint_as_float(v.x & 0xFFFF0000u); xin[i][2] = __uint_as_float(v.y << 16); xin[i][3] = __uint_as_float(v.y & 0xFFFF0000u); }
            unsigned short ov[16][4];
#pragma unroll
            for (int i = 0; i < 16; ++i)
#pragma unroll
                for (int e = 0; e < 4; ++e) { const float s = bs[e] + w[0][e] * xin[i][e] + w[1][e] * xin[i + 1][e] + w[2][e] * xin[i + 2][e] + w[3][e] * xin[i + 3][e]; ov[i][e] = (unsigned short)f2bf(siluf(s)); }
            LAS unsigned char* nat = isC ? Cn : Bn;
#pragma unroll
            for (int i = 0; i < 16; ++i) { const u32x2 pk = {(unsigned)ov[i][0] | ((unsigned)ov[i][1] << 16), (unsigned)ov[i][2] | ((unsigned)ov[i][3] << 16)};
                *(LAS u32x2*)(nat + (16 * wave + i) * SP + cc * 2) = pk;
                if (isC) *(u32x2*)(CC + (t0 + 16 * wave + i) * 256 + g * 128 + cc) = pk; }
            if (!isC) {
#pragma unroll
                for (int e = 0; e < 4; ++e)
#pragma unroll
                    for (int qq = 0; qq < 4; ++qq) { const u32x2 pk = {(unsigned)ov[4 * qq][e] | ((unsigned)ov[4 * qq + 1][e] << 16), (unsigned)ov[4 * qq + 2][e] | ((unsigned)ov[4 * qq + 3][e] << 16)};
                        *(LAS u32x2*)(BT + (cc + e) * SP + (32 * (wave >> 1) + 8 * qq + 4 * (wave & 1)) * 2) = pk; }
            }
        }
        __syncthreads();
        f32x4 cbt[8];
        {
            bf16x8 cf[4];
#pragma unroll
            for (int ks = 0; ks < 4; ++ks) cf[ks] = *(const LAS bf16x8*)(Cn + (16 * wave + r16) * SP + (32 * ks + 8 * q4) * 2);
#pragma unroll
            for (int st = 0; st < 8; ++st) { cbt[st] = (f32x4){0.f, 0.f, 0.f, 0.f};
#pragma unroll
                for (int ks = 0; ks < 4; ++ks) { const bf16x8 bf = *(const LAS bf16x8*)(Bn + (16 * st + r16) * SP + (32 * ks + 8 * q4) * 2); cbt[st] = __builtin_amdgcn_mfma_f32_16x16x32_bf16(bf, cf[ks], cbt[st], 0, 0, 0); } }
        }
        __syncthreads();
        const int lq = 16 * wave + r16;
        for (int r = 0; r < 8; ++r) {
            const int hd = g * 8 + r; const float dd = a.ssd_d[hd];
            {
                const int col = hd * 64 + lane; float w0 = a.ssd_conv_w[col], w1 = a.ssd_conv_w[1536 + col], w2 = a.ssd_conv_w[2 * 1536 + col], w3 = a.ssd_conv_w[3 * 1536 + col]; const float bs = a.ssd_conv_b[col];
                float xin[19];
#pragma unroll
                for (int i = 0; i < 19; ++i) { const int tk = 16 * wave + i - 3; xin[i] = (128 * c + tk) >= 0 ? bf2f(xbcpre[(t0 + tk) * 1536 + col]) : 0.f; }
                const float aclast = acL[r * 128 + 127];
                unsigned short xd[16], xe[16];
#pragma unroll
                for (int i = 0; i < 16; ++i) { const float xv = siluf(bs + w0 * xin[i] + w1 * xin[i + 1] + w2 * xin[i + 2] + w3 * xin[i + 3]); const int tk = 16 * wave + i;
                    const float xdv = xv * dtL[r * 128 + tk]; xd[i] = (unsigned short)f2bf(xdv); xe[i] = (unsigned short)f2bf(xdv * __expf(aclast - acL[r * 128 + tk])); }
#pragma unroll
                for (int qq = 0; qq < 4; ++qq) { const int pos = 32 * (wave >> 1) + 8 * qq + 4 * (wave & 1);
                    *(LAS u32x2*)(xdT + lane * SP + pos * 2) = (u32x2){(unsigned)xd[4 * qq] | ((unsigned)xd[4 * qq + 1] << 16), (unsigned)xd[4 * qq + 2] | ((unsigned)xd[4 * qq + 3] << 16)};
                    *(LAS u32x2*)(xeT + lane * SP + pos * 2) = (u32x2){(unsigned)xe[4 * qq] | ((unsigned)xe[4 * qq + 1] << 16), (unsigned)xe[4 * qq + 2] | ((unsigned)xe[4 * qq + 3] << 16)}; }
            }
            __syncthreads();
            {
                const float acl = acL[r * 128 + lq], ddt = dd / dtL[r * 128 + lq];
                f32x4 yd[4];
#pragma unroll
                for (int pt = 0; pt < 4; ++pt) yd[pt] = (f32x4){0.f, 0.f, 0.f, 0.f};
#pragma unroll
                for (int ks = 0; ks < 4; ++ks) { if (ks <= (wave >> 1)) {
                    f32x4 mlo, mhi;
#pragma unroll
                    for (int e = 0; e < 4; ++e) {
                        const int s0 = 32 * ks + 4 * q4 + e, s1 = s0 + 16;
                        const float v0 = cbt[2 * ks][e], v1 = cbt[2 * ks + 1][e];
                        mlo[e] = s0 < lq ? v0 * __expf(acl - acL[r * 128 + s0]) : (s0 == lq ? v0 + ddt : 0.f);
                        mhi[e] = s1 < lq ? v1 * __expf(acl - acL[r * 128 + s1]) : (s1 == lq ? v1 + ddt : 0.f);
                    }
                    const bf16x8 mf = acc_to_frag(mlo, mhi);
#pragma unroll
                    for (int pt = 0; pt < 4; ++pt) { const bf16x8 xf = *(const LAS bf16x8*)(xdT + (16 * pt + r16) * SP + (32 * ks + 8 * q4) * 2); yd[pt] = __builtin_amdgcn_mfma_f32_16x16x32_bf16(xf, mf, yd[pt], 0, 0, 0); }
                } }
#pragma unroll
                for (int pt = 0; pt < 4; ++pt) *(u32x2*)(ydiag + (t0 + lq) * 1024 + hd * 64 + 16 * pt + 4 * q4) = (u32x2){pg8::cvt_pk_bf16(yd[pt][0], yd[pt][1]), pg8::cvt_pk_bf16(yd[pt][2], yd[pt][3])};
            }
            {
                bf16x8 bf[4];
#pragma unroll
                for (int ks = 0; ks < 4; ++ks) bf[ks] = *(const LAS bf16x8*)(BT + (16 * wave + r16) * SP + (32 * ks + 8 * q4) * 2);
                bf16_t* hp = states + ((size_t)(unit * 8 + r) * 64) * 128;
#pragma unroll
                for (int pt = 0; pt < 4; ++pt) { f32x4 st = {0.f, 0.f, 0.f, 0.f};
#pragma unroll
                    for (int ks = 0; ks < 4; ++ks) { const bf16x8 xf = *(const LAS bf16x8*)(xeT + (16 * pt + r16) * SP + (32 * ks + 8 * q4) * 2); st = __builtin_amdgcn_mfma_f32_16x16x32_bf16(bf[ks], xf, st, 0, 0, 0); }
                    *(u32x2*)(hp + (size_t)(16 * pt + r16) * 128 + 16 * wave + 4 * q4) = (u32x2){pg8::cvt_pk_bf16(st[0], st[1]), pg8::cvt_pk_bf16(st[2], st[3])}; }
            }
            __syncthreads();
        }
    }
}
DEV void ph_ssd_scan(const Args& a, const Ctx& X, const int wg0) {
    bf16_t* states = (bf16_t*)(a.ws + WS_STATES); const float* cdec = (const float*)(a.ws + WS_CDEC);
    for (int task = (X.bid - wg0) * NTHR + X.tid; task < NB * 16 * 64 * 32; task += (X.G - wg0) * NTHR) {
        const int n4 = task & 31, p = (task >> 5) & 63, hd = (task >> 11) & 15, b = task >> 15;
        float h0 = 0.f, h1 = 0.f, h2 = 0.f, h3 = 0.f;
        for (int c = 0; c < 32; ++c) {
            const int unit = (b * 32 + c) * 2 + (hd >> 3);
            u32x2* ptr = (u32x2*)(states + ((size_t)(unit * 8 + (hd & 7)) * 64 + p) * 128 + 4 * n4);
            const u32x2 sv = *ptr; const float dec = cdec[(size_t)unit * 32 + (hd & 7)];
            *ptr = (u32x2){pk2(h0, h1), pk2(h2, h3)};
            h0 = h0 * dec + __uint_as_float(sv.x << 16); h1 = h1 * dec + __uint_as_float(sv.x & 0xFFFF0000u); h2 = h2 * dec + __uint_as_float(sv.y << 16); h3 = h3 * dec + __uint_as_float(sv.y & 0xFFFF0000u);
        }
    }
}
DEV void ph_ssd_out(const Args& a, const Ctx& X, const int wg0) {
    const bf16_t* CC = (const bf16_t*)(a.ws + WS_CC); const float* acum = (const float*)(a.ws + WS_ACUM); const bf16_t* ydiag = (const bf16_t*)(a.ws + WS_YDIAG);
    const bf16_t* states = (const bf16_t*)(a.ws + WS_STATES); const bf16_t* zb = (const bf16_t*)(a.ws + WS_ZB); bf16_t* oy = (bf16_t*)(a.ws + WS_OY);
    const int lane = X.lane, wave = X.wave, r16 = lane & 15, q4 = lane >> 4;
    for (int unit = X.bid - wg0; unit < NB * 32 * 2; unit += X.G - wg0) {
        const int g = unit & 1, c = (unit >> 1) & 31, b = unit >> 6; const size_t t = (size_t)b * SEQ + 128 * c + 16 * wave + r16;
        bf16x8 cf[4];
#pragma unroll
        for (int ks = 0; ks < 4; ++ks) cf[ks] = *(const bf16x8*)(CC + t * 256 + g * 128 + 32 * ks + 8 * q4);
        float ss = 0.f;
        LAS u32x2* stash = (LAS u32x2*)(X.lds + wave * 16384);
        for (int r = 0; r < 8; ++r) {
            const int hd = g * 8 + r; const float eac = __expf(acum[((size_t)g * T + t) * 8 + r]);
            const bf16_t* hp = states + ((size_t)(unit * 8 + r) * 64) * 128;
#pragma unroll
            for (int pt = 0; pt < 4; ++pt) { f32x4 acc = {0.f, 0.f, 0.f, 0.f};
#pragma unroll
                for (int ks = 0; ks < 4; ++ks) { const bf16x8 hf = *(const bf16x8*)(hp + (size_t)(16 * pt + r16) * 128 + 32 * ks + 8 * q4); acc = __builtin_amdgcn_mfma_f32_16x16x32_bf16(hf, cf[ks], acc, 0, 0, 0); }
                const u32x2 yd = *(const u32x2*)(ydiag + t * 1024 + hd * 64 + 16 * pt + 4 * q4), zz = *(const u32x2*)(zb + t * 1024 + hd * 64 + 16 * pt + 4 * q4);
                f32x4 v; v[0] = acc[0] * eac + __uint_as_float(yd.x << 16); v[1] = acc[1] * eac + __uint_as_float(yd.x & 0xFFFF0000u); v[2] = acc[2] * eac + __uint_as_float(yd.y << 16); v[3] = acc[3] * eac + __uint_as_float(yd.y & 0xFFFF0000u);
                v[0] *= siluf(__uint_as_float(zz.x << 16)); v[1] *= siluf(__uint_as_float(zz.x & 0xFFFF0000u)); v[2] *= siluf(__uint_as_float(zz.y << 16)); v[3] *= siluf(__uint_as_float(zz.y & 0xFFFF0000u));
                ss += v[0] * v[0] + v[1] * v[1] + v[2] * v[2] + v[3] * v[3];
                stash[(r * 4 + pt) * 64 + lane] = (u32x2){pg8::cvt_pk_bf16(v[0], v[1]), pg8::cvt_pk_bf16(v[2], v[3])}; }
        }
        ss += __shfl_xor(ss, 16); ss += __shfl_xor(ss, 32);
        const float rstd = rsqrtf(ss * (1.f / 512.f) + EPS);
        for (int r = 0; r < 8; ++r)
#pragma unroll
            for (int pt = 0; pt < 4; ++pt) { const int cix = g * 512 + r * 64 + 16 * pt + 4 * q4; const f32x4 nw = *(const f32x4*)(a.ssd_norm_w + cix); const u32x2 w = stash[(r * 4 + pt) * 64 + lane];
                *(u32x2*)(oy + t * 2048 + 1024 + cix) = (u32x2){pg8::cvt_pk_bf16(__uint_as_float(w.x << 16) * rstd * nw[0], __uint_as_float(w.x & 0xFFFF0000u) * rstd * nw[1]), pg8::cvt_pk_bf16(__uint_as_float(w.y << 16) * rstd * nw[2], __uint_as_float(w.y & 0xFFFF0000u) * rstd * nw[3])}; }
    }
}

DEV void ph_attn_naive(const Args& a, const Ctx& X) {
    const bf16_t* qkv = (const bf16_t*)(a.ws + WS_Q1KV); bf16_t* o = (bf16_t*)(a.ws + WS_O1);
    const int lane = X.lane;
    for (int wid = X.bid * NWAVES + X.wave; wid < T * 16; wid += X.G * NWAVES) {
        const int t = wid >> 4, hh = wid & 15, s = t % SEQ;
        const float q = bf2f(qkv[(size_t)t * 3072 + hh * 64 + lane]);
        float m = -INFINITY, l = 0.f, acc = 0.f;
#pragma unroll
        for (int br = 0; br < 3; ++br) { const int d = br == 0 ? 1 : (br == 1 ? 4 : 16);
            for (int j = 0; j <= 128; ++j) { if (s - d * j < 0) break;
                const bf16_t* kr = qkv + (size_t)(t - d * j) * 3072 + 1024 + hh * 64;
                const float sc = wave_sum(q * bf2f(kr[lane]));
                const float mn = fmaxf(m, sc), al = __expf(m - mn), p = __expf(sc - mn);
                l = l * al + p; acc = acc * al + p * bf2f(kr[1024 + lane]); m = mn; } }
        o[(size_t)t * 1024 + hh * 64 + lane] = (bf16_t)f2bf(acc / l);
    }
}

DEV void ph_attn(const Args& a, const Ctx& X) {
    const bf16_t* qkv = (const bf16_t*)(a.ws + WS_Q1KV); bf16_t* po = (bf16_t*)(a.ws + WS_PO); float* plse = (float*)(a.ws + WS_PLSE); bf16_t* o = (bf16_t*)(a.ws + WS_O1);
    LAS unsigned char* vl = X.lds + X.wave * 12288;
    LAS unsigned char* kl = vl + 6144;
    const int lane = X.lane, q = lane & 31, h5 = lane >> 5;
    const int tr_off = ((lane & 15) >> 2) * 192 + (16 * ((lane >> 4) & 1) + 4 * (lane & 3)) * 2;
    const int prow = lane >> 3, pch = lane & 7;
    for (int unit = X.bid; unit < NB * 16 * 8; unit += X.G) {
        const int bhd = unit & 63, b = bhd >> 4, hd = bhd & 15, g = unit >> 6;
        for (int tk = 0; tk < 6; ++tk) {
            const int br = tk >> 1, k = X.wave * 2 + (tk & 1);
            int d, r, i0;
            if (br == 0) { d = 1; r = 0; i0 = 512 * g + 32 * k; } else if (br == 1) { d = 4; r = k & 3; i0 = 128 * g + 32 * (k >> 2); } else { d = 16; r = k; i0 = 32 * g; }
            const size_t tq = (size_t)b * SEQ + (size_t)(i0 + q) * d + r;
#define ATT_LOAD(dst, j0_, coff) do { _Pragma("unroll") for (int _i = 0; _i < 4; ++_i) { const size_t _t = (size_t)b * SEQ + (size_t)((j0_) + 8 * _i + prow) * d + r; \
                dst[_i] = *(const u32x4*)(qkv + _t * 3072 + (coff) + hd * 64 + pch * 8); } } while (0)
            u32x4 kA[4], vA[4], kB[4], vB[4], kC[4], vC[4];
            const bool v3 = (i0 - 32) >= 0, v2 = (i0 - 64) >= 0, v1 = (i0 - 96) >= 0, v0 = (i0 - 128) >= 0;
            ATT_LOAD(kA, i0, 0);
            ATT_LOAD(kB, i0, 1024); ATT_LOAD(vB, i0, 2048);
            if (v3) { ATT_LOAD(kC, i0 - 32, 1024); ATT_LOAD(vC, i0 - 32, 2048); }
#pragma unroll
            for (int i = 0; i < 4; ++i) *(LAS u32x4*)(kl + (8 * i + prow) * 144 + pch * 16) = kA[i];
            bf16x8 qf[4];
#pragma unroll
            for (int s = 0; s < 4; ++s) qf[s] = *(const LAS bf16x8*)(kl + q * 144 + (16 * s + 8 * h5) * 2);
            LDS_WAIT();
            f32x16 oacc[2];
#pragma unroll
            for (int i = 0; i < 16; ++i) { oacc[0][i] = 0.f; oacc[1][i] = 0.f; }
            float m = -1e30f, l = 0.f;
            auto tile = [&](const int kt, const u32x4 (&kp)[4], const u32x4 (&vp)[4]) {
#pragma unroll
                for (int i = 0; i < 4; ++i) { *(LAS u32x4*)(kl + (8 * i + prow) * 144 + pch * 16) = kp[i]; *(LAS u32x4*)(vl + (8 * i + prow) * 192 + pch * 16) = vp[i]; }
                f32x16 sacc;
#pragma unroll
                for (int i = 0; i < 16; ++i) sacc[i] = 0.f;
#pragma unroll
                for (int s = 0; s < 4; ++s) { const bf16x8 kf = *(const LAS bf16x8*)(kl + q * 144 + (16 * s + 8 * h5) * 2); sacc = __builtin_amdgcn_mfma_f32_32x32x16_bf16(kf, qf[s], sacc, 0, 0, 0); }
                if (kt == 4) {
#pragma unroll
                    for (int i = 0; i < 16; ++i) { const int kl_ = (i & 3) + 8 * (i >> 2) + 4 * h5; if (kl_ > q) sacc[i] = -1e30f; }
                } else if (kt == 0) {
#pragma unroll
                    for (int i = 0; i < 16; ++i) { const int kl_ = (i & 3) + 8 * (i >> 2) + 4 * h5; if (kl_ < q) sacc[i] = -1e30f; }
                }
                float mx = sacc[0];
#pragma unroll
                for (int i = 1; i < 16; ++i) mx = fmaxf(mx, sacc[i]);
                mx = fmaxf(mx, __shfl_xor(mx, 32));
                const float mn = fmaxf(m, mx), alpha = __expf(m - mn);
                float rs = 0.f;
#pragma unroll
                for (int i = 0; i < 16; ++i) { sacc[i] = __expf(sacc[i] - mn); rs += sacc[i]; }
                rs += __shfl_xor(rs, 32);
                l = l * alpha + rs; m = mn;
#pragma unroll
                for (int i = 0; i < 16; ++i) { oacc[0][i] *= alpha; oacc[1][i] *= alpha; }
                bf16x8 pf[2];
#pragma unroll
                for (int s = 0; s < 2; ++s) { u32x4 w; w.x = pg8::cvt_pk_bf16(sacc[8 * s], sacc[8 * s + 1]); w.y = pg8::cvt_pk_bf16(sacc[8 * s + 2], sacc[8 * s + 3]); w.z = pg8::cvt_pk_bf16(sacc[8 * s + 4], sacc[8 * s + 5]); w.w = pg8::cvt_pk_bf16(sacc[8 * s + 6], sacc[8 * s + 7]);
                    pf[s] = __builtin_bit_cast(bf16x8, w); }
#pragma unroll
                for (int dt = 0; dt < 2; ++dt)
#pragma unroll
                    for (int s = 0; s < 2; ++s) {
                        const s16x4 t0_ = __builtin_amdgcn_ds_read_tr16_b64_v4i16((LAS s16x4*)(vl + (16 * s + 4 * h5) * 192 + dt * 64 + tr_off));
                        const s16x4 t1_ = __builtin_amdgcn_ds_read_tr16_b64_v4i16((LAS s16x4*)(vl + (16 * s + 8 + 4 * h5) * 192 + dt * 64 + tr_off));
                        bf16x8 vf; vf[0] = t0_[0]; vf[1] = t0_[1]; vf[2] = t0_[2]; vf[3] = t0_[3]; vf[4] = t1_[0]; vf[5] = t1_[1]; vf[6] = t1_[2]; vf[7] = t1_[3];
                        oacc[dt] = __builtin_amdgcn_mfma_f32_32x32x16_bf16(vf, pf[s], oacc[dt], 0, 0, 0);
                    }
                LDS_WAIT();
            };
            if (v2) { ATT_LOAD(kA, i0 - 64, 1024); ATT_LOAD(vA, i0 - 64, 2048); }
            tile(4, kB, vB);
            if (v3) {
                if (v1) { ATT_LOAD(kB, i0 - 96, 1024); ATT_LOAD(vB, i0 - 96, 2048); }
                tile(3, kC, vC);
                if (v2) {
                    if (v0) { ATT_LOAD(kC, i0 - 128, 1024); ATT_LOAD(vC, i0 - 128, 2048); }
                    tile(2, kA, vA);
                    if (v1) { tile(1, kB, vB);
                        if (v0) tile(0, kC, vC); }
                }
            }
#undef ATT_LOAD
            const float inv = 1.f / l;
            bf16_t* pr = po + ((size_t)br * T + tq) * 1024 + hd * 64;
#pragma unroll
            for (int dt = 0; dt < 2; ++dt)
#pragma unroll
                for (int gq = 0; gq < 4; ++gq) { u32x2 w; w.x = pg8::cvt_pk_bf16(oacc[dt][4 * gq] * inv, oacc[dt][4 * gq + 1] * inv); w.y = pg8::cvt_pk_bf16(oacc[dt][4 * gq + 2] * inv, oacc[dt][4 * gq + 3] * inv);
                    *(u32x2*)(pr + 32 * dt + 8 * gq + 4 * h5) = w; }
            if (h5 == 0) plse[((size_t)br * T + tq) * 16 + hd] = m + __logf(l);
        }
        VM_WAIT(); __syncthreads();
        {
            const size_t t = (size_t)b * SEQ + 512 * g + X.tid;
            const float l0 = plse[t * 16 + hd], l1 = plse[((size_t)T + t) * 16 + hd], l2 = plse[((size_t)2 * T + t) * 16 + hd];
            const float mx = fmaxf(l0, fmaxf(l1, l2)); float w0 = __expf(l0 - mx), w1 = __expf(l1 - mx), w2 = __expf(l2 - mx); const float wi = 1.f / (w0 + w1 + w2); w0 *= wi; w1 *= wi; w2 *= wi;
            const bf16_t* p0 = po + t * 1024 + hd * 64; const bf16_t* p1 = p0 + (size_t)T * 1024; const bf16_t* p2 = p1 + (size_t)T * 1024; bf16_t* orow = o + t * 1024 + hd * 64;
#pragma unroll
            for (int c = 0; c < 8; ++c) { const u32x4 x0 = *(const u32x4*)(p0 + 8 * c), x1 = *(const u32x4*)(p1 + 8 * c), x2 = *(const u32x4*)(p2 + 8 * c); u32x4 y;
#pragma unroll
                for (int e = 0; e < 4; ++e) { const float lo = w0 * __uint_as_float(x0[e] << 16) + w1 * __uint_as_float(x1[e] << 16) + w2 * __uint_as_float(x2[e] << 16);
                    const float hi = w0 * __uint_as_float(x0[e] & 0xFFFF0000u) + w1 * __uint_as_float(x1[e] & 0xFFFF0000u) + w2 * __uint_as_float(x2[e] & 0xFFFF0000u); y[e] = pk2(lo, hi); }
                *(u32x4*)(orow + 8 * c) = y; }
        }
    }
}

DEV void ph_router(const Args& a, const Ctx& X, const int l) {
    unsigned char* ws = a.ws;
    const float* mod = (const float*)(ws + WS_MOD) + (size_t)l * NB * 6 * D;
    const bf16_t* ymix = (const bf16_t*)(ws + WS_YMIX);
    bf16_t* xb = (bf16_t*)(ws + WS_XB);
    bf16_t* hb = (bf16_t*)(ws + WS_H);
    int* idx = (int*)(ws + WS_IDX); float* gw = (float*)(ws + WS_GW); int* aslot = (int*)(ws + WS_ASLOT); int* ltok = (int*)(ws + WS_LTOK);
    int* cntg = (int*)(ws + WS_CTL + CTL_CNT) + l * NE;
    const float* rw = a.router_w + (size_t)l * D * NE; const float* rbias = a.router_bias + l * NE;
    constexpr int HP = 2064;
    LAS unsigned char* hL = X.lds;
    LAS float* logit = (LAS float*)(X.lds + AUX_OFF + 2048);
    LAS int* lcnt = (LAS int*)(X.lds + AUX_OFF + 2048 + 64 * 65 * 4);
    LAS int* lbase = lcnt + 64;
    LAS int* sel_e = lbase + 64;
    LAS int* sel_s = sel_e + 512;
    const int lane = X.lane, wave = X.wave;
    for (int rb = X.bid; rb < T / 64; rb += X.G) {
        if (X.tid < 64) lcnt[X.tid] = 0;
        for (int r8 = 0; r8 < 8; ++r8) {
            const int lr = wave * 8 + r8, row = rb * 64 + lr, b = row / SEQ; const float* ml = mod + (size_t)b * 6 * D;
            float xv[16], yv[16]; if (l == 0) load_row(a.x + (size_t)row * D, lane, xv); else load_row_bf(xb + (size_t)row * D, lane, xv); load_row_bf(ymix + (size_t)row * D, lane, yv);
            resid_update(xv, yv, a.mix_post_g + l * D, ml + 2 * D, lane);
            store_row_bf(xb + (size_t)row * D, lane, xv);
            u32x2 o[4]; prenorm_pack(xv, a.ffn_pre_g + l * D, ml + 4 * D, ml + 3 * D, lane, o);
#pragma unroll
            for (int j = 0; j < 4; ++j) { *(u32x2*)(hb + (size_t)row * D + j * 256 + lane * 4) = o[j]; *(LAS u32x2*)(hL + lr * HP + (j * 256 + lane * 4) * 2) = o[j]; }
        }
        __syncthreads();
        { const int rt = wave & 3, nh = wave >> 2, r16 = lane & 15, kq = lane >> 4;
          f32x4 acc0 = {0.f, 0.f, 0.f, 0.f}, acc1 = {0.f, 0.f, 0.f, 0.f};
          for (int c = 0; c < 32; ++c) {
              const u32x4 hv = *(const LAS u32x4*)(hL + (rt * 16 + r16) * HP + (32 * c + 8 * kq) * 2);
              const float* rp = rw + (size_t)(32 * c + 8 * kq) * NE + 4 * r16 + 2 * nh;
#pragma unroll
              for (int j = 0; j < 8; ++j) { const unsigned wj = hv[j >> 1]; const float av = (j & 1) ? __uint_as_float(wj & 0xFFFF0000u) : __uint_as_float(wj << 16);
                  const f32x2 bv = *(const f32x2*)(rp + (size_t)j * NE);
                  acc0 = __builtin_amdgcn_mfma_f32_16x16x4f32(av, bv.x, acc0, 0, 0, 0); acc1 = __builtin_amdgcn_mfma_f32_16x16x4f32(av, bv.y, acc1, 0, 0, 0); }
          }
#pragma unroll
          for (int r = 0; r < 4; ++r) { logit[(rt * 16 + 4 * kq + r) * 65 + 4 * r16 + 2 * nh] = acc0[r]; logit[(rt * 16 + 4 * kq + r) * 65 + 4 * r16 + 2 * nh + 1] = acc1[r]; } }
        __syncthreads();
        for (int r8 = 0; r8 < 8; ++r8) {
            const int lr = wave * 8 + r8, t = rb * 64 + lr;
            float lgt = logit[lr * 65 + lane]; if (!(lgt > -1e30f && lgt < 1e30f)) lgt = 0.f;
            const float score = sigmoidf_(lgt), biased = score + rbias[lane];
            float m1 = biased;
#pragma unroll
            for (int o = 1; o < 8; o <<= 1) m1 = fmaxf(m1, __shfl_xor(m1, o));
            int c1 = (biased == m1) ? (lane & 7) : 8;
#pragma unroll
            for (int o = 1; o < 8; o <<= 1) c1 = min(c1, __shfl_xor(c1, o));
            float m2 = ((lane & 7) == c1) ? -INFINITY : biased;
#pragma unroll
            for (int o = 1; o < 8; o <<= 1) m2 = fmaxf(m2, __shfl_xor(m2, o));
            const float gs = m1 + m2; const int myg = lane >> 3; int grank = 0;
#pragma unroll
            for (int g2 = 0; g2 < 8; ++g2) { const float o = __shfl(gs, g2 * 8); grank += (o > gs || (o == gs && g2 < myg)) ? 1 : 0; }
            const float cand = (grank < 4) ? biased : -INFINITY; int rank = 0;
            for (int e2 = 0; e2 < 64; ++e2) { const float o = __shfl(cand, e2); rank += (o > cand || (o == cand && e2 < lane)) ? 1 : 0; }
            const bool sel = (rank < TOPK) && (grank < 4);
            const float ssum = wave_sum(sel ? score : 0.f);
            if (sel) { idx[t * 8 + rank] = lane; gw[t * 8 + rank] = score / ssum * 2.5f; sel_e[lr * 8 + rank] = lane; sel_s[lr * 8 + rank] = __hip_atomic_fetch_add(lcnt + lane, 1, __ATOMIC_RELAXED, __HIP_MEMORY_SCOPE_WORKGROUP); }
        }
        __syncthreads();
        if (X.tid < 64) { const int n = lcnt[X.tid]; lbase[X.tid] = n ? atomicAdd(cntg + X.tid, n) : 0; }
        __syncthreads();
        { const int lr = X.tid >> 3, k = X.tid & 7, t = rb * 64 + lr, e = sel_e[lr * 8 + k], sl = lbase[e] + sel_s[lr * 8 + k];
          aslot[t * 8 + k] = sl; ltok[e * CAP + sl] = t; }
        __syncthreads();
    }
}
template <int NW>
DEV void ph_moe_conv(const Args& a, const Ctx& X, const int l, const int wg0) {
    unsigned char* ws = a.ws;
    if (X.wave >= NW) return;
    { LAS float* scr = (LAS float*)(X.lds + X.wave * 8704);
      const int gwv = (X.bid - wg0) * NW + X.wave, NGW = (X.G - wg0) * NW;
      constexpr int I_GU = (D / 64) * (512 / 32), I_D = (ED / 64) * (D / 32), I_E = I_GU + I_D;
      const float* eg = a.exp_gate + (size_t)l * NE * D * ED; const float* eu = a.exp_up + (size_t)l * NE * D * ED; const float* ed = a.exp_down + (size_t)l * NE * ED * D;
      for (int it = gwv; it < (NE + 1) * I_E; it += NGW) {
          const int e = it / I_E; int r = it - e * I_E;
          if (e < NE) {
              if (r < I_GU) conv_item(SrcGU{eg + (size_t)e * D * ED, (long)(eu - eg)}, ED, D, (bf16_t*)(ws + WS_WGU) + (size_t)e * 512 * D, scr, r, 16, X.lane);
              else conv_item(SrcIdent{ed + (size_t)e * ED * D}, D, ED, (bf16_t*)(ws + WS_WD) + (size_t)e * D * ED, scr, r - I_GU, D / 32, X.lane);
          } else {
              if (r < I_GU) conv_item(SrcGU{a.sh_gate + (size_t)l * D * ED, (long)(a.sh_up - a.sh_gate)}, ED, D, (bf16_t*)(ws + WS_WGUS), scr, r, 16, X.lane);
              else conv_item(SrcIdent{a.sh_down + (size_t)l * ED * D}, D, ED, (bf16_t*)(ws + WS_WDS), scr, r - I_GU, D / 32, X.lane);
          }
      } }
}

DEV int moe_tables(const Args& a, const Ctx& X, const int l, LAS int* t_cnt, LAS int* t_rb0, LAS int* t_eofrb) {
    const int* cntg = (const int*)(a.ws + WS_CTL + CTL_CNT) + l * NE;
    if (X.wave == 0) {
        const int c = __hip_atomic_load(cntg + X.lane, __ATOMIC_RELAXED, __HIP_MEMORY_SCOPE_AGENT), nrb = (c + 255) >> 8;
        int incl = nrb;
#pragma unroll
        for (int o = 1; o < 64; o <<= 1) { const int v = __shfl_up(incl, o); if (X.lane >= o) incl += v; }
        const int excl = incl - nrb;
        t_cnt[X.lane] = c; t_rb0[X.lane] = excl; if (X.lane == 63) t_rb0[64] = incl;
        for (int j = 0; j < nrb; ++j) t_eofrb[excl + j] = X.lane;
        t_eofrb[SH_RB + X.lane] = NE;
    }
    __syncthreads();
    return t_rb0[64];
}

DEV void ph_moe_gu(const Args& a, const Ctx& X, const int l) {
    LAS int* t_cnt = (LAS int*)(X.lds + AUX_OFF + 1024); LAS int* t_rb0 = t_cnt + 64; LAS int* t_eofrb = t_rb0 + 80; LAS int* toks = t_eofrb + NRB_ALL;
    const int nrbt = moe_tables(a, X, l, t_cnt, t_rb0, t_eofrb);
    const int* ltok = (const int*)(a.ws + WS_LTOK);
    pg8::Unit u;
    for (int i = 0; i < 8; ++i) { if (!pg8::moe_unit(i, 2, nrbt, X.G, X.bid, u)) break;
        if (X.tid < 256) { const int e = t_eofrb[u.pm]; int tok;
            if (e < NE) { const int sl = (u.pm - t_rb0[e]) * 256 + X.tid; tok = sl < t_cnt[e] ? ltok[e * CAP + sl] : 0; } else tok = (u.pm - SH_RB) * 256 + X.tid;
            toks[i * 256 + X.tid] = tok; } }
    VM_WAIT(); __syncthreads();
    pg8::SchedGU S{(const char*)(a.ws + WS_H), (const char*)(a.ws + WS_WGU), (const char*)(a.ws + WS_WGUS), t_eofrb, toks, nrbt, X.G, X.bid, 0};
    pg8::EpiGU E{(bf16_t*)(a.ws + WS_HID)};
    pg8::gemm_phase<pg8::EpiGU, pg8::SchedGU>(X.lds, D, S, E);
}
DEV void ph_moe_down(const Args& a, const Ctx& X, const int l) {
    LAS int* t_cnt = (LAS int*)(X.lds + AUX_OFF + 1024); LAS int* t_rb0 = t_cnt + 64; LAS int* t_eofrb = t_rb0 + 80;
    const int nrbt = moe_tables(a, X, l, t_cnt, t_rb0, t_eofrb);
    pg8::SchedDown S{(const char*)(a.ws + WS_HID), (const char*)(a.ws + WS_WD), (const char*)(a.ws + WS_WDS), t_eofrb, nrbt, X.G, X.bid, 0};
    pg8::EpiFp8 E{(unsigned char*)(a.ws + WS_Y), D, 0};
    int kd = ED; asm volatile("" : "+s"(kd));
    pg8::gemm_phase<pg8::EpiFp8, pg8::SchedDown>(X.lds, kd, S, E);
}
DEV void ph_combine(const Args& a, const Ctx& X, const int l) {
    LAS int* t_cnt = (LAS int*)(X.lds + AUX_OFF + 1024); LAS int* t_rb0 = t_cnt + 64; LAS int* t_eofrb = t_rb0 + 80;
    (void)moe_tables(a, X, l, t_cnt, t_rb0, t_eofrb);
    const float* mod = (const float*)(a.ws + WS_MOD);
    const int* idx = (const int*)(a.ws + WS_IDX); const float* gw = (const float*)(a.ws + WS_GW); const int* aslot = (const int*)(a.ws + WS_ASLOT);
    const unsigned char* y = a.ws + WS_Y; bf16_t* hb = (bf16_t*)(a.ws + WS_H);
    const int lane = X.lane;
    const int tstep = X.G * NWAVES;
    int t = X.bid * NWAVES + X.wave;
    int e_n = 0, s_n = 0; float g_n = 0.f;
    if (t < T && lane < 8) { e_n = idx[t * 8 + lane]; g_n = gw[t * 8 + lane]; s_n = aslot[t * 8 + lane]; }
    for (; t < T; t += tstep) {
        const int b = t / SEQ; const float* ml = mod + (size_t)(l * NB + b) * 6 * D;
        const int e_c = e_n, s_c = s_n; const float g_c = g_n;
        const int tn = t + tstep;
        if (tn < T && lane < 8) { e_n = idx[tn * 8 + lane]; g_n = gw[tn * 8 + lane]; s_n = aslot[tn * 8 + lane]; }
        u32x2 w0[9], w1[9];
        { const unsigned char* yr = y + ((size_t)SH_RB * 256 + t) * D; w0[8] = *(const u32x2*)(yr + 8 * lane); w1[8] = *(const u32x2*)(yr + 512 + 8 * lane); }
        float gk[8];
#pragma unroll
        for (int k = 0; k < 8; ++k) { const int e = __shfl(e_c, k), sl = __shfl(s_c, k); gk[k] = __shfl(g_c, k);
            const unsigned char* yr = y + ((size_t)t_rb0[e] * 256 + sl) * D; w0[k] = *(const u32x2*)(yr + 8 * lane); w1[k] = *(const u32x2*)(yr + 512 + 8 * lane); }
        float xv[16]; load_row8_bf((const bf16_t*)(a.ws + WS_XB) + (size_t)t * D, lane, xv);
        float yv[16];
#pragma unroll
        for (int i = 0; i < 16; ++i) yv[i] = 0.f;
        acc_row8(yv, w0[8], w1[8], 0.125f);
#pragma unroll
        for (int k = 0; k < 8; ++k) acc_row8(yv, w0[k], w1[k], gk[k] * 0.125f);
        resid_update8(xv, yv, a.ffn_post_g + l * D, ml + 5 * D, lane);
        if (l == 0) store_row8_bf((bf16_t*)(a.ws + WS_XB) + (size_t)t * D, lane, xv); else store_row8(a.out + (size_t)t * D, lane, xv);
        if (l == 0) { const float* mn = mod + (size_t)(1 * NB + b) * 6 * D; u32x4 o[2]; prenorm_pack8(xv, a.mix_pre_g + D, mn + D, mn, lane, o);
            *(u32x4*)(hb + (size_t)t * D + 8 * lane) = o[0]; *(u32x4*)(hb + (size_t)t * D + 512 + 8 * lane) = o[1]; }
    }
}

constexpr int NPH = 18;
__global__ void __launch_bounds__(NTHR, 2) mega(Args a) {
    extern __shared__ __attribute__((aligned(16))) unsigned char lds_raw[];
    Ctx X; X.lds = (LAS unsigned char*)lds_raw; X.tid = threadIdx.x; X.lane = X.tid & 63; X.wave = __builtin_amdgcn_readfirstlane(X.tid >> 6); X.G = gridDim.x; X.bid = blockIdx.x;
    if (X.tid < 4) ((LAS unsigned*)(X.lds + BAR_OFF))[X.tid] = 0u;
    __syncthreads();
    XcdBarrier bar; bar.bar = (unsigned*)(a.ws + WS_CTL); bar.x = 0; bar.st = nullptr;
    if (!MK_PER_PHASE) bar = xcd_barrier_post((unsigned*)(a.ws + WS_CTL), (volatile LAS unsigned*)(X.lds + BAR_OFF));
    const int lo = a.ph_lo, hi = a.ph_hi;
#define IN(k) (lo <= (k) && (k) < hi)
#define REP(k, ...) do { __VA_ARGS__; if constexpr (((PROBE_MASK >> (k)) & 1u) != 0u) { __syncthreads(); __VA_ARGS__; } } while (0)
#define SEAM(k) do { if (IN(k) && IN((k) + 1)) xcd_barrier(bar); else { VM_WAIT(); __syncthreads(); } } while (0)
    unsigned char* ws = a.ws;
    if (IN(0)) { REP(0, ph_setup(a, X)); SEAM(0); }
    if (IN(1)) { REP(1, ph_prenorm0(a, X)); SEAM(1); }
    if (IN(2)) {
        pg8::SchedDense S; S.so.init(T, NPROJ, X.G, X.bid); S.A = (const char*)(ws + WS_H); S.Bt = (const char*)(ws + WS_WIN); S.K = D; S.pad_ = 0;
        pg8::EpiProj E{(bf16_t*)(ws + WS_QKVPRE), (bf16_t*)(ws + WS_ZA), (bf16_t*)(ws + WS_XBCPRE), (bf16_t*)(ws + WS_ZB), (float*)(ws + WS_SMALL)};
        REP(2, pg8::gemm_phase<pg8::EpiProj, pg8::SchedDense>(X.lds, D, S, E)); SEAM(2); }
    if (IN(3)) { REP(3, ph_gdn_local(a, X)); REP(20, ph_ssd_local(a, X)); SEAM(3); }
    if (IN(4)) {
        if (X.bid < 32) { REP(4, ph_gdn_scan(a, X)); }
        else { ph_ssd_scan(a, X, 32); group_barrier((unsigned*)(ws + WS_CTL + CTL_GRP), (unsigned)(X.G - 32)); __syncthreads(); ph_ssd_out(a, X, 32); __syncthreads(); ph_moe_conv<2>(a, X, 0, 32); }
        SEAM(4); }
    if (IN(6)) {
        pg8::SchedDense S; S.so.init(T, D, X.G, X.bid); S.A = (const char*)(ws + WS_OY); S.Bt = (const char*)(ws + WS_WOUT); S.K = 2048; S.pad_ = 0;
        pg8::EpiBf16 E{(bf16_t*)(ws + WS_YMIX), D, 0};
        REP(6, pg8::gemm_phase<pg8::EpiBf16, pg8::SchedDense>(X.lds, 2048, S, E)); SEAM(6); }
    if (IN(7)) { ph_router(a, X, 0); SEAM(7); }
    if (IN(8)) { REP(8, ph_moe_gu(a, X, 0)); SEAM(8); }
    if (IN(9)) { REP(9, ph_moe_down(a, X, 0)); SEAM(9); }
    if (IN(10)) { ph_combine(a, X, 0); SEAM(10); }
    if (IN(11)) {
        pg8::SchedDense S; S.so.init(T, 3072, X.G, X.bid); S.A = (const char*)(ws + WS_H); S.Bt = (const char*)(ws + WS_WQKV); S.K = D; S.pad_ = 0;
        pg8::EpiQKV E{(bf16_t*)(ws + WS_Q1KV), (const float*)(ws + WS_COS), (const float*)(ws + WS_SIN)};
        REP(11, pg8::gemm_phase<pg8::EpiQKV, pg8::SchedDense>(X.lds, D, S, E)); SEAM(11); }
    if (IN(12)) { REP(12, ph_attn(a, X)); SEAM(12); }
    if (IN(13)) {
        pg8::SchedDense S; S.so.init(T, D, X.G, X.bid); S.A = (const char*)(ws + WS_O1); S.Bt = (const char*)(ws + WS_WO); S.K = D; S.pad_ = 0;
        pg8::EpiBf16 E{(bf16_t*)(ws + WS_YMIX), D, 0};
        REP(13, pg8::gemm_phase<pg8::EpiBf16, pg8::SchedDense>(X.lds, D, S, E)); SEAM(13); }
    if (IN(14)) { ph_router(a, X, 1); REP(14, ph_moe_conv<8>(a, X, 1, 0)); SEAM(14); }
    if (IN(15)) { ph_moe_gu(a, X, 1); SEAM(15); }
    if (IN(16)) { ph_moe_down(a, X, 1); SEAM(16); }
    if (IN(17)) { ph_combine(a, X, 1); }
#undef IN
#undef SEAM
}

extern "C" void kernel_launch(void* const* d_in, const int* in_sizes, int n_in, void* d_out, int out_size, void* d_ws, size_t ws_size, hipStream_t stream) {
    static int grid = 0;
    if (!grid) {
        int dev = 0, cus = 0, per_cu = 0;
        if (hipGetDevice(&dev) != hipSuccess || hipDeviceGetAttribute(&cus, hipDeviceAttributeMultiprocessorCount, dev) != hipSuccess) { fprintf(stderr, "kernel_launch: device query failed\n"); grid = -1; return; }
        if (hipFuncSetAttribute((const void*)mega, hipFuncAttributeMaxDynamicSharedMemorySize, LDS_BYTES) != hipSuccess) { fprintf(stderr, "kernel_launch: hipFuncSetAttribute failed\n"); grid = -1; return; }
        if (hipOccupancyMaxActiveBlocksPerMultiprocessor(&per_cu, (const void*)mega, NTHR, LDS_BYTES) != hipSuccess || per_cu < 1) { fprintf(stderr, "kernel_launch: occupancy query says %d blocks per CU\n", per_cu); grid = -1; return; }
        grid = cus;
        if (grid < 64 || (grid & 7)) { fprintf(stderr, "kernel_launch: unsupported CU count %d\n", cus); grid = -1; return; }
    }
    if (grid < 0) return;
    if (ws_size < WS_END || n_in != 31) { fprintf(stderr, "kernel_launch: workspace %zu < %zu or n_in %d != 31\n", ws_size, (size_t)WS_END, n_in); return; }
    if (hipMemsetAsync((char*)d_ws + WS_CTL, 0, CTL_BYTES, stream) != hipSuccess) { fprintf(stderr, "kernel_launch: memset failed\n"); return; }
    Args a{};
    a.x = (const float*)d_in[0]; a.c = (const float*)d_in[1]; a.pos = (const int*)d_in[2]; a.mod_w = (const float*)d_in[3]; a.mod_b = (const float*)d_in[4];
    a.mix_pre_g = (const float*)d_in[5]; a.mix_post_g = (const float*)d_in[6]; a.ffn_pre_g = (const float*)d_in[7]; a.ffn_post_g = (const float*)d_in[8];
    a.ssm_w_in = (const float*)d_in[9]; a.gdn_conv_w = (const float*)d_in[10]; a.gdn_a_log = (const float*)d_in[11]; a.gdn_dt_bias = (const float*)d_in[12]; a.gdn_norm_w = (const float*)d_in[13];
    a.ssd_conv_w = (const float*)d_in[14]; a.ssd_conv_b = (const float*)d_in[15]; a.ssd_a_log = (const float*)d_in[16]; a.ssd_dt_bias = (const float*)d_in[17]; a.ssd_d = (const float*)d_in[18]; a.ssd_norm_w = (const float*)d_in[19];
    a.ssm_w_out = (const float*)d_in[20]; a.attn_w_qkv = (const float*)d_in[21]; a.attn_w_o = (const float*)d_in[22];
    a.router_w = (const float*)d_in[23]; a.router_bias = (const float*)d_in[24]; a.exp_gate = (const float*)d_in[25]; a.exp_up = (const float*)d_in[26]; a.exp_down = (const float*)d_in[27];
    a.sh_gate = (const float*)d_in[28]; a.sh_up = (const float*)d_in[29]; a.sh_down = (const float*)d_in[30];
    a.out = (float*)d_out; a.ws = (unsigned char*)d_ws;
#if MK_PER_PHASE
    for (int p = 0; p < NPH; ++p) { a.ph_lo = p; a.ph_hi = p + 1; hipLaunchKernelGGL(mega, dim3(grid), dim3(NTHR), LDS_BYTES, stream, a); }
#else
    a.ph_lo = 0; a.ph_hi = NPH;
    hipLaunchKernelGGL(mega, dim3(grid), dim3(NTHR), LDS_BYTES, stream, a);
#endif
}
```

```cpp
#include <hip/hip_runtime.h>
#include <stdint.h>
#include <stdio.h>

#define DEV __device__ __forceinline__
#define LAS __attribute__((address_space(3)))
typedef unsigned short bf16_t;
typedef short bf16x8 __attribute__((ext_vector_type(8)));
typedef float f32x4 __attribute__((ext_vector_type(4)));
typedef float f32x2 __attribute__((ext_vector_type(2)));
typedef unsigned u32x4 __attribute__((ext_vector_type(4)));
typedef unsigned u32x2 __attribute__((ext_vector_type(2)));
typedef float f32x16 __attribute__((ext_vector_type(16)));
typedef short s16x4 __attribute__((ext_vector_type(4)));

#ifndef PROBE_MASK
#define PROBE_MASK 0u
#endif
#ifndef MK_PER_PHASE
#define MK_PER_PHASE 0
#endif

constexpr int NB = 4, SEQ = 4096, T = NB * SEQ, D = 1024;
constexpr int PROJ = 6688, NPROJ = 6912;
constexpr int C_BETA = 4096, C_XBC = 4112, C_ZB = 5648, C_DT = 6672;
constexpr int NE = 64, TOPK = 8, ED = 256, CAP = 16384;
constexpr int SH_RB = 576;
constexpr int NRB_ALL = SH_RB + 64;
constexpr float EPS = 1e-6f;
constexpr int NTHR = 512, NWAVES = 8;
constexpr int LDS_BYTES = 163840;
constexpr int AUX_OFF = 131072;
constexpr int BAR_OFF = LDS_BYTES - 16;

constexpr size_t MiB = 1u << 20;
constexpr size_t WS_CTL = 0, CTL_BYTES = 65536;
constexpr size_t CTL_CNT = 16384;
constexpr size_t CTL_GRP = 20480;
constexpr size_t WS_MOD = 65536;
constexpr size_t WS_COS = 1 * MiB, WS_SIN = 3 * MiB;
constexpr size_t WS_IDX = 5 * MiB, WS_GW = 5 * MiB + 512 * 1024, WS_ASLOT = 6 * MiB, WS_LTOK = 6 * MiB + 512 * 1024;
constexpr size_t WS_SMALL = 11 * MiB;
constexpr size_t WS_WIN = 16 * MiB, WS_WOUT = 30 * MiB, WS_WQKV = 34 * MiB, WS_WO = 40 * MiB;
constexpr size_t WS_H = 44 * MiB;
constexpr size_t WS_QKVPRE = 78 * MiB, WS_XBCPRE = 174 * MiB, WS_ZA = 222 * MiB, WS_ZB = 254 * MiB;
constexpr size_t WS_CC = 16 * MiB, WS_ACUM = 25 * MiB, WS_CDEC = 26 * MiB, WS_YDIAG = 44 * MiB, WS_STATES = 430 * MiB;
constexpr size_t WS_GI = 286 * MiB, GI_UNIT = 73728, WS_GTMP = 462 * MiB, WS_GLAST = 27 * MiB;
constexpr size_t WS_OY = 78 * MiB, WS_YMIX = 286 * MiB, WS_XB = 240 * MiB;
constexpr size_t WS_WD = 478 * MiB, WS_WDS = 510 * MiB + 512 * 1024, WS_HID = 398 * MiB, WS_Y = 78 * MiB, WS_WGU = 142 * MiB, WS_WGUS = 207 * MiB;
constexpr size_t WS_Q1KV = 78 * MiB, WS_O1 = 174 * MiB, WS_PO = 350 * MiB, WS_PLSE = 446 * MiB;
constexpr size_t WS_END = 512 * MiB;

struct Args {
    const float* x; const float* c; const int* pos; const float* mod_w; const float* mod_b;
    const float* mix_pre_g; const float* mix_post_g; const float* ffn_pre_g; const float* ffn_post_g;
    const float* ssm_w_in; const float* gdn_conv_w; const float* gdn_a_log; const float* gdn_dt_bias; const float* gdn_norm_w;
    const float* ssd_conv_w; const float* ssd_conv_b; const float* ssd_a_log; const float* ssd_dt_bias; const float* ssd_d; const float* ssd_norm_w;
    const float* ssm_w_out; const float* attn_w_qkv; const float* attn_w_o;
    const float* router_w; const float* router_bias; const float* exp_gate; const float* exp_up; const float* exp_down;
    const float* sh_gate; const float* sh_up; const float* sh_down;
    float* out; unsigned char* ws; int ph_lo, ph_hi;
};

DEV float bf2f(bf16_t v) { return __uint_as_float(((unsigned)v) << 16); }
DEV unsigned f2bf(float f) { unsigned u = __float_as_uint(f); return (u + 0x7FFFu + ((u >> 16) & 1u)) >> 16; }
DEV unsigned pk2(float lo, float hi) { return f2bf(lo) | (f2bf(hi) << 16); }
DEV float wave_sum(float v) {
#pragma unroll
    for (int o = 32; o > 0; o >>= 1) v += __shfl_xor(v, o);
    return v;
}
DEV float siluf(float x) { return x / (1.f + __expf(-x)); }
DEV float sigmoidf_(float x) { return 1.f / (1.f + __expf(-x)); }
DEV float softplusf(float x) { return fmaxf(x, 0.f) + log1pf(__expf(-fabsf(x))); }
#define LDS_WAIT() asm volatile("s_waitcnt lgkmcnt(0)" ::: "memory")
#define VM_WAIT() asm volatile("s_waitcnt vmcnt(0)" ::: "memory")

#define XB_TMO      128
#define XB_XCNT(j)  (256  + 64 * (j))
#define XB_XSUB(j)  (1280 + 64 * (j))
#define XB_XGEN(j)  (2304 + 64 * (j))
#define XB_TOP      3328
#define XB_TOPGEN   3392
#define XCD_BAR_WORDS 3456
#define XB_SPIN_CAP (1u << 18)
#define LAS __attribute__((address_space(3)))

__device__ __forceinline__ unsigned xb_ld(unsigned* p)              { return __hip_atomic_load(p, __ATOMIC_RELAXED, __HIP_MEMORY_SCOPE_AGENT); }
__device__ __forceinline__ unsigned xb_add(unsigned* p, unsigned v) { return __hip_atomic_fetch_add(p, v, __ATOMIC_RELAXED, __HIP_MEMORY_SCOPE_AGENT); }
__device__ __forceinline__ unsigned xb_xcc_id() { return (unsigned)__builtin_amdgcn_s_getreg((3 << 11) | 20) & 0xFu; }
#define XB_SPIN(cond, bar) do { unsigned _sp = 0; while (cond) { __builtin_amdgcn_s_sleep(1); \
    if ((++_sp & 255u) == 0u) { if (xb_ld(&(bar)[XB_TMO])) break; if (_sp > XB_SPIN_CAP) { atomicAdd(&(bar)[XB_TMO], 1u); break; } } } } while (0)

struct XcdBarrier {
    unsigned* bar; unsigned x;
    volatile LAS unsigned* st;
};

__device__ __forceinline__ XcdBarrier xcd_barrier_post(unsigned* bar, volatile LAS unsigned* st) {
    XcdBarrier b; b.bar = bar; b.x = xb_xcc_id(); b.st = st;
    if (threadIdx.x == 0) (void)xb_add(&bar[XB_XCNT(b.x)], 1u);
    return b;
}
__device__ __forceinline__ void xcd_barrier_complete(unsigned* bar, unsigned x, unsigned& nloc, unsigned& nx) {
    const unsigned G = gridDim.x * gridDim.y * gridDim.z;
    unsigned sum, cnt, mine, sp = 0u;
    for (;;) {
        sum = 0u; cnt = 0u; mine = 0u;
#pragma unroll
        for (unsigned j = 0; j < 16; ++j) { const unsigned c = xb_ld(&bar[XB_XCNT(j)]); sum += c; cnt += (c > 0u) ? 1u : 0u; mine = (j == x) ? c : mine; }
        if (sum == G) break;
        __builtin_amdgcn_s_sleep(1);
        if ((++sp & 255u) == 0u) { if (xb_ld(&bar[XB_TMO])) break; if (sp > XB_SPIN_CAP) { atomicAdd(&bar[XB_TMO], 1u); break; } }
    }
    nloc = mine > 0u ? mine : 1u; nx = cnt > 0u ? cnt : 1u;
}

__device__ __forceinline__ void xcd_barrier(const XcdBarrier& b) {
    asm volatile("s_waitcnt vmcnt(0)" ::: "memory");
    __syncthreads();
    if (threadIdx.x == 0) {
        unsigned* bar = b.bar;
        __builtin_amdgcn_s_waitcnt(0);
        unsigned nloc = b.st[0], nx = b.st[1];
        if (nloc == 0u) { xcd_barrier_complete(bar, b.x, nloc, nx); b.st[0] = nloc; b.st[1] = nx; }
        const unsigned old = xb_add(&bar[XB_XSUB(b.x)], 1u);
        const unsigned gen = old / nloc;
        if (old + 1u == (gen + 1u) * nloc) {
            __builtin_amdgcn_fence(__ATOMIC_RELEASE, "agent");
            asm volatile("s_waitcnt vmcnt(0)" ::: "memory");
            const unsigned og = xb_add(&bar[XB_TOP], 1u);
            const unsigned tg = og / nx;
            if (og + 1u == (tg + 1u) * nx) xb_add(&bar[XB_TOPGEN], 1u);
            else XB_SPIN(xb_ld(&bar[XB_TOPGEN]) == tg, bar);
            __builtin_amdgcn_fence(__ATOMIC_ACQUIRE, "agent");
            xb_add(&bar[XB_XGEN(b.x)], 1u);
            asm volatile("s_waitcnt vmcnt(0)" ::: "memory");
        } else {
            XB_SPIN(xb_ld(&bar[XB_XGEN(b.x)]) == gen, bar);
            __builtin_amdgcn_fence(__ATOMIC_ACQUIRE, "agent");
            asm volatile("s_waitcnt vmcnt(0)" ::: "memory");
        }
    }
    __syncthreads();
}


DEV void group_barrier(unsigned* ctr, const unsigned n) {
    asm volatile("s_waitcnt vmcnt(0)" ::: "memory");
    __syncthreads();
    if (threadIdx.x == 0) {
        __builtin_amdgcn_fence(__ATOMIC_RELEASE, "agent");
        asm volatile("s_waitcnt vmcnt(0)" ::: "memory");
        (void)__hip_atomic_fetch_add(ctr, 1u, __ATOMIC_RELAXED, __HIP_MEMORY_SCOPE_AGENT);
        unsigned sp = 0;
        while (__hip_atomic_load(ctr, __ATOMIC_RELAXED, __HIP_MEMORY_SCOPE_AGENT) < n) { __builtin_amdgcn_s_sleep(2); if (++sp > (1u << 22)) break; }
        __builtin_amdgcn_fence(__ATOMIC_ACQUIRE, "agent");
        asm volatile("s_waitcnt vmcnt(0)" ::: "memory");
    }
    __syncthreads();
}

namespace pg8 {
constexpr int BM = 256, BK = 64, HALF = 128, HTB = HALF * BK * 2, STAGE_BYTES = 8 * HTB, NXCD = 8, WGM = 8;
DEV int lds_byte(int r, int c) { const int st = (r >> 4) * 2 + (c >> 5), rr = r & 15, cc = c & 31, ob = rr * 64 + cc * 2; return st * 1024 + (ob ^ (((ob >> 9) & 1) << 5)); }
DEV void stage_rc(int b, int& R, int& C) { const int st = b / 1024, sb = b % 1024, swz = sb ^ (((sb >> 9) & 1) << 5); R = (st >> 1) * 16 + swz / 64; C = (st & 1) * 32 + (swz % 64) / 2; }
DEV int perm32(int rho) { const int n = rho >> 4, i = rho & 15; return 8 * (i >> 2) + 4 * n + (i & 3); }
struct Unit { int pm, pn, e, slot; };
struct StaticOrder {
    int nM, nN, nwg, G, c;
    DEV void init(int M, int N, int G_, int c_) { nM = M / BM; nN = N / BM; nwg = nM * nN; G = G_; c = c_; }
    DEV bool next(int i, int& pm, int& pn) const {
        const long L = (long)i * G + c; if (L >= nwg) return false;
        int wgid = (int)L; { const int q = nwg / NXCD, r = nwg % NXCD, xcd = wgid % NXCD, off = wgid / NXCD; wgid = (xcd < r ? xcd * (q + 1) : r * (q + 1) + (xcd - r) * q) + off; }
        const int nig = WGM * nN, gid = wgid / nig, fm = gid * WGM, gsz = (nM - fm) < WGM ? (nM - fm) : WGM;
        pm = fm + ((wgid % nig) % gsz); pn = (wgid % nig) / gsz; return true;
    }
};
typedef __bf16 bf16x2_t __attribute__((ext_vector_type(2)));
DEV unsigned cvt_pk_bf16(float lo, float hi) { const bf16x2_t v = {(__bf16)lo, (__bf16)hi}; return __builtin_bit_cast(unsigned, v); }
DEV u32x4 pack8(const f32x4 a, const f32x4 b) { u32x4 w; w.x = cvt_pk_bf16(a[0], a[1]); w.y = cvt_pk_bf16(a[2], a[3]); w.z = cvt_pk_bf16(b[0], b[1]); w.w = cvt_pk_bf16(b[2], b[3]); return w; }

template <class Epi, class Sched>
DEV void gemm_phase(LAS unsigned char* lds, const int K, const Sched& S, const Epi& E) {
    const int tid = threadIdx.x, wid = __builtin_amdgcn_readfirstlane(tid >> 6), lane = tid & 63, wr = wid >> 2, wc = wid & 3, fr = lane & 15, fq = lane >> 4;
    const int nt = K / BK;
    unsigned voffB[2];
#pragma unroll
    for (int i = 0; i < 2; ++i) { int R, C; stage_rc(tid * 16 + i * 8192, R, C); const int Rb = Epi::PERM ? ((R & ~31) + perm32(R & 31)) : R; voffB[i] = (unsigned)(Rb * K + C) * 2u; }
    const unsigned kstep = (unsigned)(BK * 2);
    const size_t hstep = (size_t)HALF * K * 2;
    const unsigned ldsw = (unsigned)wid * 1024u;
    const int aoff = lds_byte(wr * 64 + fr, fq * 8), boff = lds_byte(wc * 32 + fr, fq * 8);
    const size_t hsA = Sched::GATHER ? (size_t)0 : hstep;
#define PG8_SA(b, h) (((b) * 2 + (h)) * HTB)
#define PG8_SB(b, h) ((4 + (b) * 2 + (h)) * HTB)
#define PG8_STAGEB(bufoff, gbase) do { _Pragma("unroll") for (int _i = 0; _i < 2; ++_i) \
        __builtin_amdgcn_global_load_lds((const unsigned*)((const char*)(gbase) + voffB[_i]), (LAS unsigned*)(lds + (bufoff) + ldsw + _i * 8192), 16, 0, 0); } while (0)
#define PG8_STAGEA(bufoff, gbase, VO) do { _Pragma("unroll") for (int _i = 0; _i < 2; ++_i) \
        __builtin_amdgcn_global_load_lds((const unsigned*)((const char*)(gbase) + (VO)[_i]), (LAS unsigned*)(lds + (bufoff) + ldsw + _i * 8192), 16, 0, 0); } while (0)
#define PG8_LDA(dst, b, h) do { _Pragma("unroll") for (int m = 0; m < 4; ++m) _Pragma("unroll") for (int k = 0; k < 2; ++k) dst[m][k] = *(const LAS bf16x8*)(lds + PG8_SA(b, h) + aoff + m * 2048 + k * 1024); } while (0)
#define PG8_LDB(dst, b, h) do { _Pragma("unroll") for (int n = 0; n < 2; ++n) _Pragma("unroll") for (int k = 0; k < 2; ++k) dst[n][k] = *(const LAS bf16x8*)(lds + PG8_SB(b, h) + boff + n * 2048 + k * 1024); } while (0)
#define PG8_MMA(ai, bj, At, Bt) do { __builtin_amdgcn_s_setprio(1); _Pragma("unroll") for (int m = 0; m < 4; ++m) _Pragma("unroll") for (int n = 0; n < 2; ++n) _Pragma("unroll") for (int k = 0; k < 2; ++k) \
        acc[ai][bj][m][n] = __builtin_amdgcn_mfma_f32_16x16x32_bf16(Bt[n][k], At[m][k], acc[ai][bj][m][n], 0, 0, 0); __builtin_amdgcn_s_setprio(0); } while (0)
#define PG8_WAIT_V(n) asm volatile("s_waitcnt vmcnt(" #n ")" ::: "memory")
#define PG8_WAIT_L(n) asm volatile("s_waitcnt lgkmcnt(" #n ")" ::: "memory")
#define PG8_BAR __builtin_amdgcn_s_barrier()
#define PG8_SCHED __builtin_amdgcn_sched_barrier(0)
    Unit cur, nxt; int ui = 0;
    if (!S.next(0, cur)) return;
    f32x4 acc[2][2][4][2];
#pragma unroll
    for (int a = 0; a < 2; ++a)
#pragma unroll
        for (int b = 0; b < 2; ++b)
#pragma unroll
            for (int m = 0; m < 4; ++m)
#pragma unroll
                for (int n = 0; n < 2; ++n) acc[a][b][m][n] = (f32x4){0.f, 0.f, 0.f, 0.f};
    bf16x8 At[4][2], B0[2][2], B1[2][2];
    unsigned va[2][2];
    S.a_voff(cur, tid, va);
    const char* cA = S.a_ptr(cur);
    const char* cB = S.b_ptr(cur);
    PG8_STAGEB(PG8_SB(0, 0), cB); PG8_STAGEB(PG8_SB(0, 1), cB + hstep); PG8_STAGEA(PG8_SA(0, 0), cA, va[0]); PG8_STAGEA(PG8_SA(0, 1), cA + hsA, va[1]);
    if (wr == 1) PG8_BAR;
    PG8_WAIT_V(2); PG8_BAR;
    PG8_STAGEB(PG8_SB(1, 0), cB + kstep); PG8_STAGEA(PG8_SA(1, 0), cA + kstep, va[0]); PG8_STAGEB(PG8_SB(1, 1), cB + hstep + kstep);
    PG8_WAIT_V(6); PG8_BAR;
    for (;;) {
        const bool has_next = S.next(ui + 1, nxt);
        const char* nB = has_next ? S.b_ptr(nxt) : cB;
        const char* nA = has_next ? S.a_ptr(nxt) : cA;
        for (int t = 0; t < nt; t += 2) {
            const bool last = (t == nt - 2);
            const char* a1 = cA + (size_t)(t + 1) * kstep;
            const char* a2 = last ? nA : cA + (size_t)(t + 2) * kstep; const char* a3 = a2 + kstep;
            unsigned v2[2][2];
            v2[0][0] = va[0][0]; v2[0][1] = va[0][1]; v2[1][0] = va[1][0]; v2[1][1] = va[1][1];
            if constexpr (Sched::GATHER) { if (last && has_next) S.a_voff(nxt, tid, v2); }
            const char* b2 = last ? nB : cB + (size_t)(t + 2) * kstep; const char* b3 = b2 + kstep;
            PG8_LDB(B0, 0, 0); PG8_LDB(B1, 0, 1); PG8_SCHED; PG8_LDA(At, 0, 0); PG8_STAGEA(PG8_SA(1, 1), a1 + hsA, va[1]);
            PG8_WAIT_V(8); PG8_WAIT_L(0); PG8_BAR; PG8_MMA(0, 0, At, B0); PG8_MMA(0, 1, At, B1); PG8_BAR; PG8_SCHED;
            PG8_LDA(At, 0, 1); PG8_STAGEB(PG8_SB(0, 0), b2); PG8_STAGEB(PG8_SB(0, 1), b2 + hstep); PG8_STAGEA(PG8_SA(0, 0), a2, v2[0]);
            PG8_WAIT_V(8); PG8_WAIT_L(0); PG8_BAR; PG8_MMA(1, 0, At, B0); PG8_MMA(1, 1, At, B1); PG8_BAR; PG8_SCHED;
            PG8_LDB(B0, 1, 0); PG8_LDB(B1, 1, 1); PG8_SCHED; PG8_LDA(At, 1, 0); PG8_STAGEA(PG8_SA(0, 1), a2 + hsA, v2[1]);
            PG8_WAIT_V(8); PG8_WAIT_L(0); PG8_BAR; PG8_MMA(0, 0, At, B0); PG8_MMA(0, 1, At, B1); PG8_BAR; PG8_SCHED;
            PG8_LDA(At, 1, 1); PG8_STAGEB(PG8_SB(1, 0), b3); PG8_STAGEB(PG8_SB(1, 1), b3 + hstep); PG8_STAGEA(PG8_SA(1, 0), a3, v2[0]);
            PG8_WAIT_V(8); PG8_WAIT_L(0); PG8_BAR; PG8_MMA(1, 0, At, B0); PG8_MMA(1, 1, At, B1); PG8_BAR; PG8_SCHED;
        }
        if (wr == 0) PG8_BAR;
        E(acc, cur, wr, wc, fr, fq);
        if (!has_next) break;
#pragma unroll
        for (int a = 0; a < 2; ++a)
#pragma unroll
            for (int b = 0; b < 2; ++b)
#pragma unroll
                for (int m = 0; m < 4; ++m)
#pragma unroll
                    for (int n = 0; n < 2; ++n) acc[a][b][m][n] = (f32x4){0.f, 0.f, 0.f, 0.f};
        cur = nxt; cB = nB; cA = nA; ++ui;
        if constexpr (Sched::GATHER) S.a_voff(cur, tid, va);
        if (wr == 1) PG8_BAR;
    }
    PG8_WAIT_V(0);
    PG8_BAR;
#undef PG8_SA
#undef PG8_SB
#undef PG8_STAGEA
#undef PG8_STAGEB
#undef PG8_LDA
#undef PG8_LDB
#undef PG8_MMA
#undef PG8_WAIT_V
#undef PG8_WAIT_L
#undef PG8_BAR
#undef PG8_SCHED
}

struct SchedDense {
    static constexpr bool GATHER = false;
    StaticOrder so; const char* A; const char* Bt; int K; int pad_;
    DEV bool next(int i, Unit& u) const { int pm, pn; if (!so.next(i, pm, pn)) return false; u.pm = pm; u.pn = pn; u.e = 0; u.slot = 0; return true; }
    DEV const char* a_ptr(const Unit& u) const { return A + (size_t)u.pm * 256 * K * 2; }
    DEV void a_voff(const Unit&, const int tid, unsigned (&vo)[2][2]) const {
#pragma unroll
        for (int i = 0; i < 2; ++i) { int R, C; stage_rc(tid * 16 + i * 8192, R, C); vo[0][i] = vo[1][i] = (unsigned)((R * K + C) * 2); }
    }
    DEV const char* b_ptr(const Unit& u) const { return Bt + (size_t)u.pn * 256 * K * 2; }
};
DEV bool moe_unit(int i, int NJ, int nrbt, int G, int c, Unit& u) {
    const int n = (nrbt + 64) * NJ; int L;
    if (G & 7) { L = i * G + c; if (L >= n) return false; }
    else { const int gq = G >> 3, per = (n + 7) >> 3, x = c & 7, q = c >> 3, j = i * gq + q; if (j >= per) return false; L = x * per + j; if (L >= n) return false; }
    int grb = L / NJ; const int pn = L - grb * NJ; if (grb >= nrbt) grb = SH_RB + (grb - nrbt);
    u.pm = grb; u.pn = pn; u.slot = i; u.e = 0; return true;
}
struct SchedGU {
    static constexpr bool GATHER = true;
    const char* A; const char* Wgu; const char* Wgus; const LAS int* eofrb; const LAS int* toks; int nrbt, G, c, pad_;
    DEV bool next(int i, Unit& u) const { if (!moe_unit(i, 2, nrbt, G, c, u)) return false; u.e = __builtin_amdgcn_readfirstlane(eofrb[u.pm]); return true; }
    DEV const char* a_ptr(const Unit&) const { return A; }
    DEV void a_voff(const Unit& u, const int tid, unsigned (&vo)[2][2]) const {
#pragma unroll
        for (int i = 0; i < 2; ++i) { int R, C; stage_rc(tid * 16 + i * 8192, R, C);
#pragma unroll
            for (int h = 0; h < 2; ++h) { const int tok = toks[u.slot * 256 + h * 128 + R]; vo[h][i] = (unsigned)((tok * D + C) * 2); } }
    }
    DEV const char* b_ptr(const Unit& u) const { return (u.e < NE ? Wgu + (size_t)u.e * 512 * D * 2 : Wgus) + (size_t)u.pn * 256 * D * 2; }
};
struct SchedDown {
    static constexpr bool GATHER = false;
    const char* A; const char* Wd; const char* Wds; const LAS int* eofrb; int nrbt, G, c, pad_;
    DEV bool next(int i, Unit& u) const { if (!moe_unit(i, 4, nrbt, G, c, u)) return false; u.e = __builtin_amdgcn_readfirstlane(eofrb[u.pm]); return true; }
    DEV const char* a_ptr(const Unit& u) const { return A + (size_t)u.pm * 256 * ED * 2; }
    DEV void a_voff(const Unit&, const int tid, unsigned (&vo)[2][2]) const {
#pragma unroll
        for (int i = 0; i < 2; ++i) { int R, C; stage_rc(tid * 16 + i * 8192, R, C); vo[0][i] = vo[1][i] = (unsigned)((R * ED + C) * 2); }
    }
    DEV const char* b_ptr(const Unit& u) const { return (u.e < NE ? Wd + (size_t)u.e * D * ED * 2 : Wds) + (size_t)u.pn * 256 * ED * 2; }
};

struct EpiProj {
    static constexpr bool PERM = true;
    bf16_t* qkv; bf16_t* za; bf16_t* xbc; bf16_t* zb; float* small;
    DEV void operator()(const f32x4 (&acc)[2][2][4][2], const Unit& u, int wr, int wc, int fr, int fq) const {
        const int row0 = u.pm * BM + wr * 64 + fr, pn = u.pn;
        if (pn == 26) {
            if (wc == 0) {
#pragma unroll
                for (int ai = 0; ai < 2; ++ai)
#pragma unroll
                    for (int m = 0; m < 4; ++m) { float* p = small + (size_t)(row0 + ai * HALF + m * 16) * 32 + 8 * fq; *(f32x4*)p = acc[ai][0][m][0]; *(f32x4*)(p + 4) = acc[ai][0][m][1]; }
            }
            return;
        }
        bf16_t* base; int ldc, ct;
        if (pn < 12) { base = qkv; ldc = 3072; ct = pn; } else if (pn < 16) { base = za; ldc = 1024; ct = pn - 12; } else if (pn < 22) { base = xbc; ldc = 1536; ct = pn - 16; } else { base = zb; ldc = 1024; ct = pn - 22; }
        const int col0 = ct * 256 + wc * 32 + 8 * fq;
#pragma unroll
        for (int ai = 0; ai < 2; ++ai)
#pragma unroll
            for (int m = 0; m < 4; ++m) { bf16_t* rowp = base + (size_t)(row0 + ai * HALF + m * 16) * ldc + col0;
#pragma unroll
                for (int bj = 0; bj < 2; ++bj) *(u32x4*)(rowp + bj * HALF) = pack8(acc[ai][bj][m][0], acc[ai][bj][m][1]); }
    }
};
struct EpiF32 {
    static constexpr bool PERM = false;
    float* Cp; int ldc; int pad_;
    DEV void operator()(const f32x4 (&acc)[2][2][4][2], const Unit& u, int wr, int wc, int fr, int fq) const {
        const int row0 = u.pm * BM + wr * 64 + fr, col0 = u.pn * BM + wc * 32 + 4 * fq;
#pragma unroll
        for (int ai = 0; ai < 2; ++ai)
#pragma unroll
            for (int m = 0; m < 4; ++m) { float* rowp = Cp + (size_t)(row0 + ai * HALF + m * 16) * ldc + col0;
#pragma unroll
                for (int bj = 0; bj < 2; ++bj)
#pragma unroll
                    for (int n = 0; n < 2; ++n) *(f32x4*)(rowp + bj * HALF + n * 16) = acc[ai][bj][m][n]; }
    }
};
struct EpiBf16 {
    static constexpr bool PERM = true;
    bf16_t* O; int ldc; int pad_;
    DEV void operator()(const f32x4 (&acc)[2][2][4][2], const Unit& u, int wr, int wc, int fr, int fq) const {
        const int row0 = u.pm * BM + wr * 64 + fr, col0 = u.pn * BM + wc * 32 + 8 * fq;
#pragma unroll
        for (int ai = 0; ai < 2; ++ai)
#pragma unroll
            for (int m = 0; m < 4; ++m) { bf16_t* rowp = O + (size_t)(row0 + ai * HALF + m * 16) * ldc + col0;
#pragma unroll
                for (int bj = 0; bj < 2; ++bj) *(u32x4*)(rowp + bj * HALF) = pack8(acc[ai][bj][m][0], acc[ai][bj][m][1]); }
    }
};
struct EpiFp8 {
    static constexpr bool PERM = true;
    unsigned char* O; int ldc; int pad_;
    DEV void operator()(const f32x4 (&acc)[2][2][4][2], const Unit& u, int wr, int wc, int fr, int fq) const {
        const int row0 = u.pm * BM + wr * 64 + fr, col0 = u.pn * BM + wc * 32 + 8 * fq;
#pragma unroll
        for (int ai = 0; ai < 2; ++ai)
#pragma unroll
            for (int m = 0; m < 4; ++m) { unsigned char* rowp = O + (size_t)(row0 + ai * HALF + m * 16) * ldc + col0;
#pragma unroll
                for (int bj = 0; bj < 2; ++bj) { f32x4 a0 = acc[ai][bj][m][0] * 8.f, a1 = acc[ai][bj][m][1] * 8.f;
#pragma unroll
                    for (int i = 0; i < 4; ++i) { a0[i] = fminf(fmaxf(a0[i], -440.f), 440.f); a1[i] = fminf(fmaxf(a1[i], -440.f), 440.f); }
                    int w0 = __builtin_amdgcn_cvt_pk_fp8_f32(a0[0], a0[1], 0, false); w0 = __builtin_amdgcn_cvt_pk_fp8_f32(a0[2], a0[3], w0, true);
                    int w1 = __builtin_amdgcn_cvt_pk_fp8_f32(a1[0], a1[1], 0, false); w1 = __builtin_amdgcn_cvt_pk_fp8_f32(a1[2], a1[3], w1, true);
                    *(u32x2*)(rowp + bj * HALF) = (u32x2){(unsigned)w0, (unsigned)w1}; } }
    }
};
struct EpiGU {
    static constexpr bool PERM = true;
    bf16_t* H;
    DEV void operator()(const f32x4 (&acc)[2][2][4][2], const Unit& u, int wr, int wc, int fr, int fq) const {
        const int row0 = u.pm * BM + wr * 64 + fr, col0 = u.pn * HALF + wc * 32 + 8 * fq;
#pragma unroll
        for (int ai = 0; ai < 2; ++ai)
#pragma unroll
            for (int m = 0; m < 4; ++m) {
                f32x4 h0, h1;
#pragma unroll
                for (int i = 0; i < 4; ++i) { h0[i] = siluf(acc[ai][0][m][0][i]) * acc[ai][1][m][0][i]; h1[i] = siluf(acc[ai][0][m][1][i]) * acc[ai][1][m][1][i]; }
                *(u32x4*)(H + (size_t)(row0 + ai * HALF + m * 16) * ED + col0) = pack8(h0, h1);
            }
    }
};
struct EpiQKV {
    static constexpr bool PERM = true;
    bf16_t* O; const float* cosT; const float* sinT;
    DEV void operator()(const f32x4 (&acc)[2][2][4][2], const Unit& u, int wr, int wc, int fr, int fq) const {
        const int row0 = u.pm * BM + wr * 64 + fr, col0 = u.pn * BM + wc * 32 + 8 * fq;
        const bool rope = u.pn < 8; const float qs = u.pn < 4 ? 0.125f : 1.f;
#pragma unroll
        for (int ai = 0; ai < 2; ++ai)
#pragma unroll
            for (int m = 0; m < 4; ++m) {
                const int row = row0 + ai * HALF + m * 16;
                bf16_t* rowp = O + (size_t)row * 3072 + col0;
                if (rope) {
                    const f32x4 cs = *(const f32x4*)(cosT + (size_t)row * 32 + 16 * (wc & 1) + 4 * fq), sn = *(const f32x4*)(sinT + (size_t)row * 32 + 16 * (wc & 1) + 4 * fq);
#pragma unroll
                    for (int bj = 0; bj < 2; ++bj) { const f32x4 x1 = acc[ai][bj][m][0], x2 = acc[ai][bj][m][1];
                        *(u32x4*)(rowp + bj * HALF) = pack8((x1 * cs - x2 * sn) * qs, (x2 * cs + x1 * sn) * qs); }
                } else {
#pragma unroll
                    for (int bj = 0; bj < 2; ++bj) *(u32x4*)(rowp + bj * HALF) = pack8(acc[ai][bj][m][0], acc[ai][bj][m][1]);
                }
            }
    }
};
}

template <class SrcF>
DEV void conv_item(const SrcF& src, int ldw, int K, bf16_t* dst, LAS float* scr, int item, int nblk, int lane) {
    const int kb = item / nblk, nb = item - kb * nblk, k0 = 64 * kb, n0 = 32 * nb;
    const int quad = lane & 7, r0 = lane >> 3;
    const float* colp = src(n0 + 4 * quad);
    f32x4 v[8];
#pragma unroll
    for (int i = 0; i < 8; ++i) v[i] = colp ? *(const f32x4*)(colp + (size_t)(k0 + r0 + 8 * i) * ldw) : (f32x4){0.f, 0.f, 0.f, 0.f};
#pragma unroll
    for (int i = 0; i < 8; ++i) { LAS float* p = scr + (r0 + 8 * i) * 33 + 4 * quad; p[0] = v[i][0]; p[1] = v[i][1]; p[2] = v[i][2]; p[3] = v[i][3]; }
    LDS_WAIT(); asm volatile("" ::: "memory");
    const int c = lane & 7;
#pragma unroll
    for (int j = 0; j < 4; ++j) { const int n = (lane >> 3) + 8 * j; const LAS float* s = scr + (8 * c) * 33 + n;
        u32x4 o; o.x = pk2(s[0 * 33], s[1 * 33]); o.y = pk2(s[2 * 33], s[3 * 33]); o.z = pk2(s[4 * 33], s[5 * 33]); o.w = pk2(s[6 * 33], s[7 * 33]);
        *(u32x4*)(dst + (size_t)(n0 + n) * K + k0 + 8 * c) = o; }
    LDS_WAIT(); asm volatile("" ::: "memory");
}
struct SrcIdent { const float* W; DEV const float* operator()(int n) const { return W + n; } };
struct SrcWin { const float* W; DEV const float* operator()(int n) const {
    int s; if (n < 4096) s = n; else if (n < 5632) s = C_XBC + (n - 4096); else if (n < 6656) s = C_ZB + (n - 5632); else if (n < 6672) s = C_BETA + (n - 6656); else if (n < 6688) s = C_DT + (n - 6672); else return nullptr;
    return W + s; } };
struct SrcQKV { const float* W; DEV const float* operator()(int n) const {
    if (n >= 2048) return W + n; const int hd = n >> 6, cp = n & 63; return W + hd * 64 + 32 * ((cp >> 2) & 1) + 16 * (cp >> 5) + 4 * ((cp >> 3) & 3) + (cp & 3); } };
struct SrcGU { const float* Wg; long du; DEV const float* operator()(int r) const { const int j = r >> 8, rr = r & 255; return Wg + (rr < 128 ? 0l : du) + 128 * j + (rr & 127); } };

DEV void load_row(const float* p, int lane, float (&v)[16]) {
#pragma unroll
    for (int j = 0; j < 4; ++j) { const f32x4 t = *(const f32x4*)(p + j * 256 + lane * 4); v[4 * j] = t[0]; v[4 * j + 1] = t[1]; v[4 * j + 2] = t[2]; v[4 * j + 3] = t[3]; }
}
DEV void store_row(float* p, int lane, const float (&v)[16]) {
#pragma unroll
    for (int j = 0; j < 4; ++j) *(f32x4*)(p + j * 256 + lane * 4) = (f32x4){v[4 * j], v[4 * j + 1], v[4 * j + 2], v[4 * j + 3]};
}
DEV float row_rstd(const float (&v)[16]) { float ss = 0.f;
#pragma unroll
    for (int i = 0; i < 16; ++i) ss += v[i] * v[i];
    return rsqrtf(wave_sum(ss) * (1.f / D) + EPS); }
DEV void resid_update(float (&xv)[16], const float (&yv)[16], const float* gpost, const float* gt, int lane) {
    const float r = row_rstd(yv);
#pragma unroll
    for (int j = 0; j < 4; ++j) { const f32x4 g = *(const f32x4*)(gpost + j * 256 + lane * 4), t = *(const f32x4*)(gt + j * 256 + lane * 4);
#pragma unroll
        for (int i = 0; i < 4; ++i) xv[4 * j + i] += t[i] * (yv[4 * j + i] * r * g[i]); }
}
DEV void prenorm_pack(const float (&xv)[16], const float* gpre, const float* sc, const float* sh, int lane, u32x2 (&o)[4]) {
    const float r = row_rstd(xv);
#pragma unroll
    for (int j = 0; j < 4; ++j) { const f32x4 g = *(const f32x4*)(gpre + j * 256 + lane * 4), s = *(const f32x4*)(sc + j * 256 + lane * 4), b = *(const f32x4*)(sh + j * 256 + lane * 4);
        float h[4];
#pragma unroll
        for (int i = 0; i < 4; ++i) h[i] = xv[4 * j + i] * r * g[i] * (1.f + s[i]) + b[i];
        o[j] = (u32x2){pk2(h[0], h[1]), pk2(h[2], h[3])}; }
}

DEV void load_row8(const float* p, int lane, float (&v)[16]) {
#pragma unroll
    for (int j = 0; j < 2; ++j)
#pragma unroll
        for (int hh = 0; hh < 2; ++hh) { const f32x4 t = *(const f32x4*)(p + 512 * j + 8 * lane + 4 * hh); v[8 * j + 4 * hh] = t[0]; v[8 * j + 4 * hh + 1] = t[1]; v[8 * j + 4 * hh + 2] = t[2]; v[8 * j + 4 * hh + 3] = t[3]; }
}
DEV void store_row8(float* p, int lane, const float (&v)[16]) {
#pragma unroll
    for (int j = 0; j < 2; ++j)
#pragma unroll
        for (int hh = 0; hh < 2; ++hh) *(f32x4*)(p + 512 * j + 8 * lane + 4 * hh) = (f32x4){v[8 * j + 4 * hh], v[8 * j + 4 * hh + 1], v[8 * j + 4 * hh + 2], v[8 * j + 4 * hh + 3]};
}
DEV void resid_update8(float (&xv)[16], const float (&yv)[16], const float* gpost, const float* gt, int lane) {
    const float r = row_rstd(yv);
#pragma unroll
    for (int j = 0; j < 2; ++j)
#pragma unroll
        for (int hh = 0; hh < 2; ++hh) { const f32x4 g = *(const f32x4*)(gpost + 512 * j + 8 * lane + 4 * hh), t = *(const f32x4*)(gt + 512 * j + 8 * lane + 4 * hh);
#pragma unroll
            for (int i = 0; i < 4; ++i) xv[8 * j + 4 * hh + i] += t[i] * (yv[8 * j + 4 * hh + i] * r * g[i]); }
}
DEV void prenorm_pack8(const float (&xv)[16], const float* gpre, const float* sc, const float* sh, int lane, u32x4 (&o)[2]) {
    const float r = row_rstd(xv);
#pragma unroll
    for (int j = 0; j < 2; ++j) { float h[8];
#pragma unroll
        for (int hh = 0; hh < 2; ++hh) { const f32x4 g = *(const f32x4*)(gpre + 512 * j + 8 * lane + 4 * hh), s = *(const f32x4*)(sc + 512 * j + 8 * lane + 4 * hh), b = *(const f32x4*)(sh + 512 * j + 8 * lane + 4 * hh);
#pragma unroll
            for (int i = 0; i < 4; ++i) h[4 * hh + i] = xv[8 * j + 4 * hh + i] * r * g[i] * (1.f + s[i]) + b[i]; }
        o[j] = (u32x4){pk2(h[0], h[1]), pk2(h[2], h[3]), pk2(h[4], h[5]), pk2(h[6], h[7])}; }
}
DEV void acc_row8(float (&yv)[16], const u32x2 w0, const u32x2 w1, const float g) {
#pragma unroll
    for (int e = 0; e < 2; ++e) {
        yv[4 * e] += g * __builtin_amdgcn_cvt_f32_fp8((int)w0[e], 0); yv[4 * e + 1] += g * __builtin_amdgcn_cvt_f32_fp8((int)w0[e], 1); yv[4 * e + 2] += g * __builtin_amdgcn_cvt_f32_fp8((int)w0[e], 2); yv[4 * e + 3] += g * __builtin_amdgcn_cvt_f32_fp8((int)w0[e], 3);
        yv[8 + 4 * e] += g * __builtin_amdgcn_cvt_f32_fp8((int)w1[e], 0); yv[8 + 4 * e + 1] += g * __builtin_amdgcn_cvt_f32_fp8((int)w1[e], 1); yv[8 + 4 * e + 2] += g * __builtin_amdgcn_cvt_f32_fp8((int)w1[e], 2); yv[8 + 4 * e + 3] += g * __builtin_amdgcn_cvt_f32_fp8((int)w1[e], 3); }
}

DEV void load_row_bf(const bf16_t* p, int lane, float (&v)[16]) {
#pragma unroll
    for (int j = 0; j < 4; ++j) { const u32x2 w = *(const u32x2*)(p + j * 256 + lane * 4); v[4 * j] = __uint_as_float(w.x << 16); v[4 * j + 1] = __uint_as_float(w.x & 0xFFFF0000u); v[4 * j + 2] = __uint_as_float(w.y << 16); v[4 * j + 3] = __uint_as_float(w.y & 0xFFFF0000u); }
}
DEV void store_row_bf(bf16_t* p, int lane, const float (&v)[16]) {
#pragma unroll
    for (int j = 0; j < 4; ++j) *(u32x2*)(p + j * 256 + lane * 4) = (u32x2){pk2(v[4 * j], v[4 * j + 1]), pk2(v[4 * j + 2], v[4 * j + 3])};
}
DEV void load_row8_bf(const bf16_t* p, int lane, float (&v)[16]) {
#pragma unroll
    for (int j = 0; j < 2; ++j) { const u32x4 w = *(const u32x4*)(p + 512 * j + 8 * lane);
#pragma unroll
        for (int e = 0; e < 4; ++e) { v[8 * j + 2 * e] = __uint_as_float(w[e] << 16); v[8 * j + 2 * e + 1] = __uint_as_float(w[e] & 0xFFFF0000u); } }
}
DEV void store_row8_bf(bf16_t* p, int lane, const float (&v)[16]) {
#pragma unroll
    for (int j = 0; j < 2; ++j) *(u32x4*)(p + 512 * j + 8 * lane) = (u32x4){pk2(v[8 * j], v[8 * j + 1]), pk2(v[8 * j + 2], v[8 * j + 3]), pk2(v[8 * j + 4], v[8 * j + 5]), pk2(v[8 * j + 6], v[8 * j + 7])};
}

struct Ctx { LAS unsigned char* lds; int tid, lane, wave, G, bid; };

DEV void ph_setup(const Args& a, const Ctx& X) {
    unsigned char* ws = a.ws;
    float* mod = (float*)(ws + WS_MOD);
    { LAS float* red = (LAS float*)X.lds;
      LAS float* sc = (LAS float*)(X.lds + 8192);
      for (int i = X.tid; i < NB * D; i += NTHR) sc[i] = siluf(a.c[i]);
      __syncthreads();
      const int kc = X.tid >> 6, cl = X.tid & 63;
      for (int task = X.bid; task < 2 * 96; task += X.G) {
          const int l = task / 96, col = (task % 96) * 64 + cl;
          const float* w = a.mod_w + (size_t)l * D * 6 * D + col;
          float p0 = 0.f, p1 = 0.f, p2 = 0.f, p3 = 0.f;
#pragma unroll 16
          for (int k = kc * 128; k < kc * 128 + 128; ++k) { const float wv = w[(size_t)k * 6 * D];
              p0 += sc[k] * wv; p1 += sc[D + k] * wv; p2 += sc[2 * D + k] * wv; p3 += sc[3 * D + k] * wv; }
          __syncthreads();
          red[(kc * 4 + 0) * 64 + cl] = p0; red[(kc * 4 + 1) * 64 + cl] = p1; red[(kc * 4 + 2) * 64 + cl] = p2; red[(kc * 4 + 3) * 64 + cl] = p3;
          __syncthreads();
          if (X.tid < 256) { const int b = X.tid >> 6; float s = a.mod_b[l * 6 * D + col];
#pragma unroll
              for (int q = 0; q < 8; ++q) s += red[(q * 4 + b) * 64 + cl];
              mod[(size_t)(l * NB + b) * 6 * D + col] = s; }
      }
      __syncthreads(); }
    { LAS float* scr = (LAS float*)(X.lds + X.wave * 8704);
      const int gw = X.bid * NWAVES + X.wave, NGW = X.G * NWAVES;
      constexpr int I_IN = (D / 64) * (NPROJ / 32);
      for (int it = gw; it < I_IN; it += NGW) conv_item(SrcWin{a.ssm_w_in}, PROJ, D, (bf16_t*)(ws + WS_WIN), scr, it, NPROJ / 32, X.lane);
    }
}
DEV void ph_setup_late(const Args& a, const Ctx& X, const int wg0) {
    unsigned char* ws = a.ws;
    { float* cosT = (float*)(ws + WS_COS); float* sinT = (float*)(ws + WS_SIN);
      for (int idx = (X.bid - wg0) * NTHR + X.tid; idx < T * 32; idx += (X.G - wg0) * NTHR) { const int t = idx >> 5, i = idx & 31;
          const float ang = (float)a.pos[t] * powf(10000.f, -(float)i / 32.f); float sn, cs; sincosf(ang, &sn, &cs); cosT[idx] = cs; sinT[idx] = sn; } }
    { LAS float* scr = (LAS float*)(X.lds + X.wave * 8704);
      const int gw = (X.bid - wg0) * NWAVES + X.wave, NGW = (X.G - wg0) * NWAVES;
      constexpr int I_OUT = (2048 / 64) * (D / 32), I_QKV = (D / 64) * (3072 / 32), I_O = (D / 64) * (D / 32);
      for (int it = gw; it < I_OUT + I_QKV + I_O; it += NGW) {
          int r = it;
          if (r < I_OUT) { conv_item(SrcIdent{a.ssm_w_out}, D, 2048, (bf16_t*)(ws + WS_WOUT), scr, r, D / 32, X.lane); continue; } r -= I_OUT;
          if (r < I_QKV) { conv_item(SrcQKV{a.attn_w_qkv}, 3072, D, (bf16_t*)(ws + WS_WQKV), scr, r, 3072 / 32, X.lane); continue; } r -= I_QKV;
          conv_item(SrcIdent{a.attn_w_o}, D, D, (bf16_t*)(ws + WS_WO), scr, r, D / 32, X.lane);
      } }
}

DEV void ph_prenorm0(const Args& a, const Ctx& X) {
    const float* mod = (const float*)(a.ws + WS_MOD);
    bf16_t* hb = (bf16_t*)(a.ws + WS_H);
    for (int row = X.bid * NWAVES + X.wave; row < T; row += X.G * NWAVES) {
        const int b = row / SEQ; const float* ml = mod + (size_t)b * 6 * D;
        float xv[16]; load_row(a.x + (size_t)row * D, X.lane, xv);
        u32x2 o[4]; prenorm_pack(xv, a.mix_pre_g, ml + D, ml, X.lane, o);
#pragma unroll
        for (int j = 0; j < 4; ++j) *(u32x2*)(hb + (size_t)row * D + j * 256 + X.lane * 4) = o[j];
    }
}

DEV bf16x8 acc_to_frag(const f32x4 lo, const f32x4 hi) { u32x4 w; w.x = pg8::cvt_pk_bf16(lo[0], lo[1]); w.y = pg8::cvt_pk_bf16(lo[2], lo[3]); w.z = pg8::cvt_pk_bf16(hi[0], hi[1]); w.w = pg8::cvt_pk_bf16(hi[2], hi[3]); return __builtin_bit_cast(bf16x8, w); }

DEV void gdn_solve(LAS float* M, LAS unsigned short* tf, const int lane) {
    for (int rb = 0; rb < 16; ++rb) {
        const int i0 = 4 * rb;
        float a0 = (lane == i0) ? 1.f : 0.f, a1 = (lane == i0 + 1) ? 1.f : 0.f, a2 = (lane == i0 + 2) ? 1.f : 0.f, a3 = (lane == i0 + 3) ? 1.f : 0.f;
        for (int j = 0; j < i0; j += 4) {
            const float t0 = M[j * 64 + lane], t1 = M[(j + 1) * 64 + lane], t2 = M[(j + 2) * 64 + lane], t3 = M[(j + 3) * 64 + lane];
            const f32x4 r0 = *(const LAS f32x4*)(M + i0 * 64 + j), r1 = *(const LAS f32x4*)(M + (i0 + 1) * 64 + j), r2 = *(const LAS f32x4*)(M + (i0 + 2) * 64 + j), r3 = *(const LAS f32x4*)(M + (i0 + 3) * 64 + j);
            a0 -= r0[0] * t0 + r0[1] * t1 + r0[2] * t2 + r0[3] * t3; a1 -= r1[0] * t0 + r1[1] * t1 + r1[2] * t2 + r1[3] * t3;
            a2 -= r2[0] * t0 + r2[1] * t1 + r2[2] * t2 + r2[3] * t3; a3 -= r3[0] * t0 + r3[1] * t1 + r3[2] * t2 + r3[3] * t3;
        }
        const f32x4 d1 = *(const LAS f32x4*)(M + (i0 + 1) * 64 + i0), d2 = *(const LAS f32x4*)(M + (i0 + 2) * 64 + i0), d3 = *(const LAS f32x4*)(M + (i0 + 3) * 64 + i0);
        a1 -= d1[0] * a0; a2 -= d2[0] * a0 + d2[1] * a1; a3 -= d3[0] * a0 + d3[1] * a1 + d3[2] * a2;
        M[i0 * 64 + lane] = a0; M[(i0 + 1) * 64 + lane] = a1; M[(i0 + 2) * 64 + lane] = a2; M[(i0 + 3) * 64 + lane] = a3;
    }
    const int cq = (lane >> 2) & 3, ca = (lane >> 4) & 1, ce = lane & 3, cks = lane >> 5;
    for (int i = 0; i < 64; ++i) tf[((i >> 4) * 2 + cks) * 512 + ((i & 15) + 16 * cq) * 8 + 4 * ca + ce] = (unsigned short)f2bf(M[i * 64 + lane]);
}
DEV void ph_gdn_local(const Args& a, const Ctx& X) {
    const bf16_t* qkvpre = (const bf16_t*)(a.ws + WS_QKVPRE); const float* small = (const float*)(a.ws + WS_SMALL);
    unsigned char* gi = a.ws + WS_GI; float* glast = (float*)(a.ws + WS_GLAST);
    constexpr int KP = 272;
    LAS unsigned char* kN = X.lds; LAS unsigned char* qN = X.lds + 64 * KP; LAS unsigned char* slots = X.lds + 128 * KP;
    LAS float* gcL = (LAS float*)(X.lds + 143360); LAS float* btL = gcL + 8 * 64;
    LAS unsigned char* stg = X.lds + 100352;
    const int lane = X.lane, wave = X.wave, r16 = lane & 15, q4 = lane >> 4;
    const float scale = 0.08838834764831845f;
    for (int wu = X.bid; wu < NB * 64; wu += X.G) {
        const int b = wu >> 6, n = wu & 63; const size_t t0 = (size_t)b * SEQ + 64 * n;
        unsigned char* tmp = a.ws + WS_GTMP + (size_t)X.bid * 131072;
        __syncthreads();
        {
            const float g = -__expf(a.gdn_a_log[wave]) * softplusf(small[(t0 + lane) * 32 + 8 + wave] + a.gdn_dt_bias[wave]);
            float gc = g;
#pragma unroll
            for (int o = 1; o < 64; o <<= 1) { const float v = __shfl_up(gc, o); if (lane >= o) gc += v; }
            gcL[wave * 64 + lane] = gc; btL[wave * 64 + lane] = sigmoidf_(small[(t0 + lane) * 32 + wave]);
            if (lane == 63) glast[(size_t)((b * 8 + wave) * 64 + n) * 32] = gc;
        }
        __syncthreads();
        unsigned xr[3][11];
#define GDN_LOADX(hh) do { _Pragma("unroll") for (int _p = 0; _p < 3; ++_p) _Pragma("unroll") for (int _i = 0; _i < 11; ++_i) { const int _tk = 8 * wave + _i - 3; unsigned _v = 0u; \
            if (64 * n + _tk >= 0) _v = *(const unsigned*)(qkvpre + (t0 + _tk) * 3072 + _p * 1024 + (hh) * 128 + 2 * lane); xr[_p][_i] = _v; } } while (0)
        GDN_LOADX(0);
        for (int bb = 0; bb < 2; ++bb) {
            for (int j = 0; j < 4; ++j) {
                const int h = bb * 4 + j; unsigned char* ub = gi + (size_t)((b * 8 + h) * 64 + n) * GI_UNIT;
                {
                    const float gl = gcL[h * 64 + 63];
                    const int blk = wave >> 2, pa = (wave & 3) >> 1, pq0 = 2 * (wave & 1);
                    const int ca = (2 * lane >> 4) & 1, cq = (2 * lane >> 2) & 3, ce = (2 * lane) & 3, cks = (2 * lane) >> 5;
#pragma unroll
                    for (int part = 0; part < 3; ++part) {
                        const int col = part * 1024 + h * 128 + 2 * lane;
                        float w0[4], w1[4];
#pragma unroll
                        for (int i = 0; i < 4; ++i) { const f32x2 t = *(const f32x2*)(a.gdn_conv_w + i * 3072 + col); w0[i] = t.x; w1[i] = t.y; }
                        float x0[11], x1[11];
#pragma unroll
                        for (int i = 0; i < 11; ++i) { const unsigned v = xr[part][i]; x0[i] = __uint_as_float(v << 16); x1[i] = __uint_as_float(v & 0xFFFF0000u); }
                        float v0[8], v1[8];
#pragma unroll
                        for (int i = 0; i < 8; ++i) { v0[i] = siluf(w0[0] * x0[i] + w0[1] * x0[i + 1] + w0[2] * x0[i + 2] + w0[3] * x0[i + 3]); v1[i] = siluf(w1[0] * x1[i] + w1[1] * x1[i + 1] + w1[2] * x1[i + 2] + w1[3] * x1[i + 3]); }
                        if (part < 2) {
#pragma unroll
                            for (int i = 0; i < 8; ++i) { const float r = rsqrtf(wave_sum(v0[i] * v0[i] + v1[i] * v1[i]) + 1e-6f); v0[i] *= r; v1[i] *= r; }
                        }
                        for (int rep_ = 0; rep_ < (((PROBE_MASK >> 21) & 1u) ? 2 : 1); ++rep_) {
                        if (part == 0) {
#pragma unroll
                            for (int i = 0; i < 8; ++i) { const int tok = 8 * wave + i; const float eg = __expf(gcL[h * 64 + tok]) * scale;
                                *(LAS unsigned*)(qN + tok * KP + lane * 4) = pk2(v0[i], v1[i]);
                                *(LAS unsigned*)(stg + ((tok >> 4) * 4 + cks) * 1024 + ((tok & 15) + 16 * cq) * 16 + (4 * ca + ce) * 2) = pk2(v0[i] * eg, v1[i] * eg); }
                        } else if (part == 1) {
                            unsigned short kg0[8], kg1[8], ke0[8], ke1[8];
#pragma unroll
                            for (int i = 0; i < 8; ++i) { const int tok = 8 * wave + i; const float gc = gcL[h * 64 + tok], bt = btL[h * 64 + tok], eg = __expf(gc) * bt, eend = __expf(gl - gc);
                                *(LAS unsigned*)(kN + tok * KP + lane * 4) = pk2(v0[i], v1[i]);
                                kg0[i] = (unsigned short)f2bf(v0[i] * eg); kg1[i] = (unsigned short)f2bf(v1[i] * eg); ke0[i] = (unsigned short)f2bf(v0[i] * eend); ke1[i] = (unsigned short)f2bf(v1[i] * eend); }
#pragma unroll
                            for (int hf = 0; hf < 2; ++hf) { const int pos = 32 * blk + 8 * (pq0 + hf) + 4 * pa; const int cl = 2 * lane;
                                *(u32x2*)(tmp + (size_t)j * 32768 + 16384 + cl * 128 + pos * 2) = (u32x2){(unsigned)kg0[4 * hf] | ((unsigned)kg0[4 * hf + 1] << 16), (unsigned)kg0[4 * hf + 2] | ((unsigned)kg0[4 * hf + 3] << 16)};
                                *(u32x2*)(tmp + (size_t)j * 32768 + 16384 + (cl + 1) * 128 + pos * 2) = (u32x2){(unsigned)kg1[4 * hf] | ((unsigned)kg1[4 * hf + 1] << 16), (unsigned)kg1[4 * hf + 2] | ((unsigned)kg1[4 * hf + 3] << 16)};
                                *(LAS u32x2*)(stg + 16384 + ((cl >> 4) * 2 + blk) * 1024 + ((cl & 15) + 16 * (pq0 + hf)) * 16 + (4 * pa) * 2) = (u32x2){(unsigned)ke0[4 * hf] | ((unsigned)ke0[4 * hf + 1] << 16), (unsigned)ke0[4 * hf + 2] | ((unsigned)ke0[4 * hf + 3] << 16)};
                                *(LAS u32x2*)(stg + 16384 + (((cl + 1) >> 4) * 2 + blk) * 1024 + (((cl + 1) & 15) + 16 * (pq0 + hf)) * 16 + (4 * pa) * 2) = (u32x2){(unsigned)ke1[4 * hf] | ((unsigned)ke1[4 * hf + 1] << 16), (unsigned)ke1[4 * hf + 2] | ((unsigned)ke1[4 * hf + 3] << 16)}; }
                        } else {
                            unsigned short vb0[8], vb1[8];
#pragma unroll
                            for (int i = 0; i < 8; ++i) { const float bt = btL[h * 64 + 8 * wave + i]; vb0[i] = (unsigned short)f2bf(v0[i] * bt); vb1[i] = (unsigned short)f2bf(v1[i] * bt); }
#pragma unroll
                            for (int hf = 0; hf < 2; ++hf) { const int pos = 32 * blk + 8 * (pq0 + hf) + 4 * pa; const int cl = 2 * lane;
                                *(u32x2*)(tmp + (size_t)j * 32768 + cl * 128 + pos * 2) = (u32x2){(unsigned)vb0[4 * hf] | ((unsigned)vb0[4 * hf + 1] << 16), (unsigned)vb0[4 * hf + 2] | ((unsigned)vb0[4 * hf + 3] << 16)};
                                *(u32x2*)(tmp + (size_t)j * 32768 + (cl + 1) * 128 + pos * 2) = (u32x2){(unsigned)vb1[4 * hf] | ((unsigned)vb1[4 * hf + 1] << 16), (unsigned)vb1[4 * hf + 2] | ((unsigned)vb1[4 * hf + 3] << 16)}; }
                        }
                        asm volatile("" ::: "memory"); }
                    }
                }
                if (h + 1 < 8) GDN_LOADX(h + 1);
                __syncthreads();
                {
#pragma unroll
                    for (int i = 0; i < 4; ++i) *(u32x4*)(ub + 16384 + (X.tid + 512 * i) * 16) = *(const LAS u32x4*)(stg + (X.tid + 512 * i) * 16);
                    const int mat = wave >> 2, rt = wave & 3; LAS unsigned char* An = mat ? qN : kN;
                    bf16x8 af[4];
#pragma unroll
                    for (int ks = 0; ks < 4; ++ks) af[ks] = *(const LAS bf16x8*)(An + (16 * rt + r16) * KP + (32 * ks + 8 * q4) * 2);
                    LAS float* slot = (LAS float*)(slots + j * 16384);
#pragma unroll
                    for (int ct = 0; ct < 4; ++ct) { f32x4 acc = {0.f, 0.f, 0.f, 0.f};
#pragma unroll
                        for (int ks = 0; ks < 4; ++ks) { const bf16x8 bf = *(const LAS bf16x8*)(kN + (16 * ct + r16) * KP + (32 * ks + 8 * q4) * 2); acc = __builtin_amdgcn_mfma_f32_16x16x32_bf16(af[ks], bf, acc, 0, 0, 0); }
                        const int jc = 16 * ct + r16; const float gj = gcL[h * 64 + jc];
#pragma unroll
                        for (int rg = 0; rg < 4; ++rg) { const int i = 16 * rt + 4 * q4 + rg; const float dec = __expf(gcL[h * 64 + i] - gj);
                            if (mat == 0) { slot[i * 64 + jc] = jc < i ? btL[h * 64 + i] * acc[rg] * dec : 0.f; }
                            else { const float v = jc <= i ? acc[rg] * scale * dec : 0.f;
                                *(LAS unsigned short*)(stg + 32768 + (rt * 2 + (ct >> 1)) * 1024 + ((4 * q4 + rg) + 16 * (r16 >> 2)) * 16 + (4 * (ct & 1) + (r16 & 3)) * 2) = (unsigned short)f2bf(v); } }
                    }
                }
                __syncthreads();
                *(u32x4*)(ub + 49152 + X.tid * 16) = *(const LAS u32x4*)(stg + 32768 + X.tid * 16);
            }
            if (wave < 4) gdn_solve((LAS float*)(slots + wave * 16384), (LAS unsigned short*)(X.lds + wave * 8192), lane);
            VM_WAIT(); __syncthreads();
            for (int j = 0; j < 4; ++j) {
                const int h = bb * 4 + j; unsigned char* ub = gi + (size_t)((b * 8 + h) * 64 + n) * GI_UNIT;
                const int mat = wave >> 2; LAS unsigned char* slot = X.lds + j * 8192;
#pragma unroll
                for (int cx = 0; cx < 2; ++cx) { const int ct = 2 * (wave & 3) + cx;
                    bf16x8 bfr[2];
#pragma unroll
                    for (int ks = 0; ks < 2; ++ks) { const u32x4 t = __builtin_nontemporal_load((const u32x4*)(tmp + (size_t)j * 32768 + mat * 16384 + (16 * ct + r16) * 128 + (32 * ks + 8 * q4) * 2)); bfr[ks] = __builtin_bit_cast(bf16x8, t); }
#pragma unroll
                    for (int rt = 0; rt < 4; ++rt) { f32x4 acc = {0.f, 0.f, 0.f, 0.f};
#pragma unroll
                        for (int ks = 0; ks < 2; ++ks) { const bf16x8 tf = *(const LAS bf16x8*)(slot + (rt * 2 + ks) * 1024 + lane * 16); acc = __builtin_amdgcn_mfma_f32_16x16x32_bf16(tf, bfr[ks], acc, 0, 0, 0); }
                        if (mat == 0) *(u32x2*)(ub + 57344 + (rt * 8 + ct) * 512 + lane * 8) = (u32x2){pg8::cvt_pk_bf16(acc[0], acc[1]), pg8::cvt_pk_bf16(acc[2], acc[3])};
                        else {
#pragma unroll
                            for (int rg = 0; rg < 4; ++rg) *(unsigned short*)(ub + (rt * 4 + (ct >> 1)) * 1024 + ((4 * q4 + rg) + 16 * (r16 >> 2)) * 16 + (4 * (ct & 1) + (r16 & 3)) * 2) = (unsigned short)f2bf(-acc[rg]);
                        }
                    }
                }
            }
            __syncthreads();
        }
    }
}
DEV void ph_gdn_scan(const Args& a, const Ctx& X) {
    const unsigned char* gi = a.ws + WS_GI; const float* glast = (const float*)(a.ws + WS_GLAST);
    const bf16_t* za = (const bf16_t*)(a.ws + WS_ZA); bf16_t* oy = (bf16_t*)(a.ws + WS_OY);
    const int lane = X.lane, wave = X.wave, r16 = lane & 15, q4 = lane >> 4, tid = X.tid;
    LAS float* OT = (LAS float*)(X.lds + 114688);
    const int bh = X.bid, b = bh >> 3, h = bh & 7;
    const unsigned char* ubase = gi + (size_t)bh * 64 * GI_UNIT;
    f32x4 S[8];
#pragma unroll
    for (int i = 0; i < 8; ++i) S[i] = (f32x4){0.f, 0.f, 0.f, 0.f};
    float nwv[16];
#pragma unroll
    for (int i = 0; i < 16; ++i) nwv[i] = a.gdn_norm_w[16 * (tid & 7) + i];
#define GDN_STAGE(nn, buf) do { _Pragma("unroll") for (int _i = 0; _i < 7; ++_i) \
        __builtin_amdgcn_global_load_lds((const unsigned*)(ubase + (size_t)(nn) * GI_UNIT + (size_t)(tid + 512 * _i) * 16), (LAS unsigned*)(X.lds + (buf) * 57344 + (wave * 64 + 512 * _i) * 16), 16, 0, 0); } while (0)
    u32x2 udn[4]; float gln; u32x4 zn[2];
    { const size_t tz = (size_t)b * SEQ + (tid >> 3); zn[0] = *(const u32x4*)(za + tz * 1024 + h * 128 + 16 * (tid & 7)); zn[1] = *(const u32x4*)(za + tz * 1024 + h * 128 + 16 * (tid & 7) + 8); }
#pragma unroll
    for (int ct = 0; ct < 4; ++ct) udn[ct] = *(const u32x2*)(ubase + 57344 + (ct * 8 + wave) * 512 + lane * 8);
    gln = glast[(size_t)(bh * 64) * 32];
    GDN_STAGE(0, 0);
#define GDN_EPILOGUE(nn, ZC) do { const int tok = tid >> 3, seg = tid & 7; const size_t t = (size_t)b * SEQ + 64 * (nn) + tok; \
            float ov[16]; float ss = 0.f; \
            _Pragma("unroll") for (int i = 0; i < 4; ++i) { const f32x4 v = *(const LAS f32x4*)(OT + tok * 132 + 16 * seg + 4 * i); ov[4 * i] = v[0]; ov[4 * i + 1] = v[1]; ov[4 * i + 2] = v[2]; ov[4 * i + 3] = v[3]; ss += v[0] * v[0] + v[1] * v[1] + v[2] * v[2] + v[3] * v[3]; } \
            ss += __shfl_xor(ss, 1); ss += __shfl_xor(ss, 2); ss += __shfl_xor(ss, 4); \
            const float rstd = rsqrtf(ss * (1.f / 128.f) + EPS); \
            u32x4 ow[2]; \
            _Pragma("unroll") for (int i = 0; i < 2; ++i) _Pragma("unroll") for (int e = 0; e < 4; ++e) { const unsigned zw = (ZC)[i][e]; const float z0 = __uint_as_float(zw << 16), z1 = __uint_as_float(zw & 0xFFFF0000u); \
                    ow[i][e] = pg8::cvt_pk_bf16(ov[8 * i + 2 * e] * rstd * nwv[8 * i + 2 * e] * siluf(z0), ov[8 * i + 2 * e + 1] * rstd * nwv[8 * i + 2 * e + 1] * siluf(z1)); } \
            *(u32x4*)(oy + t * 2048 + h * 128 + 16 * seg) = ow[0]; *(u32x4*)(oy + t * 2048 + h * 128 + 16 * seg + 8) = ow[1]; } while (0)
    u32x4 zp[2] = {{0u, 0u, 0u, 0u}, {0u, 0u, 0u, 0u}};
    for (int n = 0; n < 64; ++n) {
        VM_WAIT(); __syncthreads();
        f32x4 uf[4];
#pragma unroll
        for (int ct = 0; ct < 4; ++ct) { uf[ct][0] = __uint_as_float(udn[ct].x << 16); uf[ct][1] = __uint_as_float(udn[ct].x & 0xFFFF0000u); uf[ct][2] = __uint_as_float(udn[ct].y << 16); uf[ct][3] = __uint_as_float(udn[ct].y & 0xFFFF0000u); }
        const float egl = __expf(gln);
        u32x4 zc[2]; zc[0] = zn[0]; zc[1] = zn[1];
        asm volatile("" : "+v"(uf[0]), "+v"(uf[1]), "+v"(uf[2]), "+v"(uf[3]), "+v"(zc[0]), "+v"(zc[1]));
        if (n + 1 < 64) {
            const unsigned char* un = ubase + (size_t)(n + 1) * GI_UNIT;
#pragma unroll
            for (int ct = 0; ct < 4; ++ct) udn[ct] = *(const u32x2*)(un + 57344 + (ct * 8 + wave) * 512 + lane * 8);
            gln = glast[(size_t)(bh * 64 + n + 1) * 32];
            { const size_t tz = (size_t)b * SEQ + 64 * (n + 1) + (tid >> 3); zn[0] = *(const u32x4*)(za + tz * 1024 + h * 128 + 16 * (tid & 7)); zn[1] = *(const u32x4*)(za + tz * 1024 + h * 128 + 16 * (tid & 7) + 8); }
            GDN_STAGE(n + 1, (n + 1) & 1);
        }
        if (n > 0) GDN_EPILOGUE(n - 1, zp);
        zp[0] = zc[0]; zp[1] = zc[1];
        const LAS unsigned char* L = X.lds + (n & 1) * 57344;
        bf16x8 sB[4];
#pragma unroll
        for (int ks = 0; ks < 4; ++ks) sB[ks] = acc_to_frag(S[2 * ks], S[2 * ks + 1]);
        f32x4 vn[4], oo[4];
#pragma unroll
        for (int ct = 0; ct < 4; ++ct) { f32x4 acc = {0.f, 0.f, 0.f, 0.f}, ao = {0.f, 0.f, 0.f, 0.f};
#pragma unroll
            for (int ks = 0; ks < 4; ++ks) { const bf16x8 wf = *(const LAS bf16x8*)(L + (ct * 4 + ks) * 1024 + lane * 16), qf = *(const LAS bf16x8*)(L + 16384 + (ct * 4 + ks) * 1024 + lane * 16);
                acc = __builtin_amdgcn_mfma_f32_16x16x32_bf16(wf, sB[ks], acc, 0, 0, 0); ao = __builtin_amdgcn_mfma_f32_16x16x32_bf16(qf, sB[ks], ao, 0, 0, 0); }
            vn[ct] = acc; oo[ct] = ao; }
#pragma unroll
        for (int ct = 0; ct < 4; ++ct) vn[ct] = vn[ct] + uf[ct];
        bf16x8 vB[2];
#pragma unroll
        for (int ks = 0; ks < 2; ++ks) vB[ks] = acc_to_frag(vn[2 * ks], vn[2 * ks + 1]);
#pragma unroll
        for (int ct = 0; ct < 4; ++ct)
#pragma unroll
            for (int ks = 0; ks < 2; ++ks) { const bf16x8 kf = *(const LAS bf16x8*)(L + 49152 + (ct * 2 + ks) * 1024 + lane * 16); oo[ct] = __builtin_amdgcn_mfma_f32_16x16x32_bf16(kf, vB[ks], oo[ct], 0, 0, 0); }
#pragma unroll
        for (int dt = 0; dt < 8; ++dt) { f32x4 acc = S[dt] * egl;
#pragma unroll
            for (int ks = 0; ks < 2; ++ks) { const bf16x8 ef = *(const LAS bf16x8*)(L + 32768 + (dt * 2 + ks) * 1024 + lane * 16); acc = __builtin_amdgcn_mfma_f32_16x16x32_bf16(ef, vB[ks], acc, 0, 0, 0); }
            S[dt] = acc; }
        __syncthreads();
#pragma unroll
        for (int ct = 0; ct < 4; ++ct)
#pragma unroll
            for (int rg = 0; rg < 4; ++rg) OT[(16 * ct + 4 * q4 + rg) * 132 + 16 * wave + r16] = oo[ct][rg];
    }
    __syncthreads();
    GDN_EPILOGUE(63, zp);
#undef GDN_EPILOGUE
#undef GDN_STAGE
}

constexpr int SP = 272;
DEV void ph_ssd_local(const Args& a, const Ctx& X) {
    const bf16_t* xbcpre = (const bf16_t*)(a.ws + WS_XBCPRE); const float* small = (const float*)(a.ws + WS_SMALL);
    bf16_t* CC = (bf16_t*)(a.ws + WS_CC); float* acum = (float*)(a.ws + WS_ACUM); float* cdec = (float*)(a.ws + WS_CDEC);
    bf16_t* ydiag = (bf16_t*)(a.ws + WS_YDIAG); bf16_t* states = (bf16_t*)(a.ws + WS_STATES);
    LAS unsigned char* Bn = X.lds; LAS unsigned char* Cn = X.lds + 128 * SP; LAS unsigned char* BT = X.lds + 256 * SP;
    LAS unsigned char* xdT = X.lds; LAS unsigned char* xeT = X.lds + 64 * SP;
    LAS float* acL = (LAS float*)(X.lds + AUX_OFF); LAS float* dtL = acL + 8 * 128;
    const int lane = X.lane, wave = X.wave, r16 = lane & 15, q4 = lane >> 4;
    for (int unit = X.bid; unit < NB * 32 * 2; unit += X.G) {
        const int g = unit & 1, c = (unit >> 1) & 31, b = unit >> 6; const size_t t0 = (size_t)b * SEQ + 128 * c;
        __syncthreads();
        {
            const int hd = g * 8 + wave; const float an = -__expf(a.ssd_a_log[hd]), bias = a.ssd_dt_bias[hd];
            const float d0 = softplusf(small[(t0 + lane) * 32 + 16 + hd] + bias), d1 = softplusf(small[(t0 + 64 + lane) * 32 + 16 + hd] + bias);
            float s0 = d0 * an, s1 = d1 * an;
#pragma unroll
            for (int o = 1; o < 64; o <<= 1) { const float v0 = __shfl_up(s0, o), v1 = __shfl_up(s1, o); if (lane >= o) { s0 += v0; s1 += v1; } }
            s1 += __shfl(s0, 63);
            acL[wave * 128 + lane] = s0; acL[wave * 128 + 64 + lane] = s1; dtL[wave * 128 + lane] = d0; dtL[wave * 128 + 64 + lane] = d1;
            acum[((size_t)g * T + t0 + lane) * 8 + wave] = s0; acum[((size_t)g * T + t0 + 64 + lane) * 8 + wave] = s1;
            if (lane == 63) cdec[(size_t)unit * 32 + wave] = __expf(s1);
        }
        {
            const int isC = lane >> 5, cc = (lane & 31) * 4, col = 1024 + isC * 256 + g * 128 + cc;
            float w[4][4], bs[4];
#pragma unroll
            for (int i = 0; i < 4; ++i) { const f32x4 t = *(const f32x4*)(a.ssd_conv_w + i * 1536 + col); w[i][0] = t[0]; w[i][1] = t[1]; w[i][2] = t[2]; w[i][3] = t[3]; }
            { const f32x4 t = *(const f32x4*)(a.ssd_conv_b + col); bs[0] = t[0]; bs[1] = t[1]; bs[2] = t[2]; bs[3] = t[3]; }
            float xin[19][4];
#pragma unroll
            for (int i = 0; i < 19; ++i) { const int tk = 16 * wave + i - 3; const bool ok = (128 * c + tk) >= 0; u32x2 v = {0u, 0u}; if (ok) v = *(const u32x2*)(xbcpre + (t0 + tk) * 1536 + col);
                xin[i][0] = __uint_as_float(v.x << 16); xin[i][1] = __uint_as_float(v.x & 0xFFFF0000u); xin[i][2] = __uint_as_float(v.y << 16); xin[i][3] = __uint_as_float(v.y & 0xFFFF0000u); }
            unsigned short ov[16][4];
#pragma unroll
            for (int i = 0; i < 16; ++i)
#pragma unroll
                for (int e = 0; e < 4; ++e) { const float s = bs[e] + w[0][e] * xin[i][e] + w[1][e] * xin[i + 1][e] + w[2][e] * xin[i + 2][e] + w[3][e] * xin[i + 3][e]; ov[i][e] = (unsigned short)f2bf(siluf(s)); }
            LAS unsigned char* nat = isC ? Cn : Bn;
#pragma unroll
            for (int i = 0; i < 16; ++i) { const u32x2 pk = {(unsigned)ov[i][0] | ((unsigned)ov[i][1] << 16), (unsigned)ov[i][2] | ((unsigned)ov[i][3] << 16)};
                *(LAS u32x2*)(nat + (16 * wave + i) * SP + cc * 2) = pk;
                if (isC) *(u32x2*)(CC + (t0 + 16 * wave + i) * 256 + g * 128 + cc) = pk; }
            if (!isC) {
#pragma unroll
                for (int e = 0; e < 4; ++e)
#pragma unroll
                    for (int qq = 0; qq < 4; ++qq) { const u32x2 pk = {(unsigned)ov[4 * qq][e] | ((unsigned)ov[4 * qq + 1][e] << 16), (unsigned)ov[4 * qq + 2][e] | ((unsigned)ov[4 * qq + 3][e] << 16)};
                        *(LAS u32x2*)(BT + (cc + e) * SP + (32 * (wave >> 1) + 8 * qq + 4 * (wave & 1)) * 2) = pk; }
            }
        }
        __syncthreads();
        f32x4 cbt[8];
        {
            bf16x8 cf[4];
#pragma unroll
            for (int ks = 0; ks < 4; ++ks) cf[ks] = *(const LAS bf16x8*)(Cn + (16 * wave + r16) * SP + (32 * ks + 8 * q4) * 2);
#pragma unroll
            for (int st = 0; st < 8; ++st) { cbt[st] = (f32x4){0.f, 0.f, 0.f, 0.f};
#pragma unroll
                for (int ks = 0; ks < 4; ++ks) { const bf16x8 bf = *(const LAS bf16x8*)(Bn + (16 * st + r16) * SP + (32 * ks + 8 * q4) * 2); cbt[st] = __builtin_amdgcn_mfma_f32_16x16x32_bf16(bf, cf[ks], cbt[st], 0, 0, 0); } }
        }
        __syncthreads();
        const int lq = 16 * wave + r16;
        for (int r = 0; r < 8; ++r) {
            const int hd = g * 8 + r; const float dd = a.ssd_d[hd];
            {
                const int col = hd * 64 + lane; float w0 = a.ssd_conv_w[col], w1 = a.ssd_conv_w[1536 + col], w2 = a.ssd_conv_w[2 * 1536 + col], w3 = a.ssd_conv_w[3 * 1536 + col]; const float bs = a.ssd_conv_b[col];
                float xin[19];
#pragma unroll
                for (int i = 0; i < 19; ++i) { const int tk = 16 * wave + i - 3; xin[i] = (128 * c + tk) >= 0 ? bf2f(xbcpre[(t0 + tk) * 1536 + col]) : 0.f; }
                const float aclast = acL[r * 128 + 127];
                unsigned short xd[16], xe[16];
#pragma unroll
                for (int i = 0; i < 16; ++i) { const float xv = siluf(bs + w0 * xin[i] + w1 * xin[i + 1] + w2 * xin[i + 2] + w3 * xin[i + 3]); const int tk = 16 * wave + i;
                    const float xdv = xv * dtL[r * 128 + tk]; xd[i] = (unsigned short)f2bf(xdv); xe[i] = (unsigned short)f2bf(xdv * __expf(aclast - acL[r * 128 + tk])); }
#pragma unroll
                for (int qq = 0; qq < 4; ++qq) { const int pos = 32 * (wave >> 1) + 8 * qq + 4 * (wave & 1);
                    *(LAS u32x2*)(xdT + lane * SP + pos * 2) = (u32x2){(unsigned)xd[4 * qq] | ((unsigned)xd[4 * qq + 1] << 16), (unsigned)xd[4 * qq + 2] | ((unsigned)xd[4 * qq + 3] << 16)};
                    *(LAS u32x2*)(xeT + lane * SP + pos * 2) = (u32x2){(unsigned)xe[4 * qq] | ((unsigned)xe[4 * qq + 1] << 16), (unsigned)xe[4 * qq + 2] | ((unsigned)xe[4 * qq + 3] << 16)}; }
            }
            __syncthreads();
            {
                const float acl = acL[r * 128 + lq], ddt = dd / dtL[r * 128 + lq];
                f32x4 yd[4];
#pragma unroll
                for (int pt = 0; pt < 4; ++pt) yd[pt] = (f32x4){0.f, 0.f, 0.f, 0.f};
#pragma unroll
                for (int ks = 0; ks < 4; ++ks) { if (ks <= (wave >> 1)) {
                    f32x4 mlo, mhi;
#pragma unroll
                    for (int e = 0; e < 4; ++e) {
                        const int s0 = 32 * ks + 4 * q4 + e, s1 = s0 + 16;
                        const float v0 = cbt[2 * ks][e], v1 = cbt[2 * ks + 1][e];
                        mlo[e] = s0 < lq ? v0 * __expf(acl - acL[r * 128 + s0]) : (s0 == lq ? v0 + ddt : 0.f);
                        mhi[e] = s1 < lq ? v1 * __expf(acl - acL[r * 128 + s1]) : (s1 == lq ? v1 + ddt : 0.f);
                    }
                    const bf16x8 mf = acc_to_frag(mlo, mhi);
#pragma unroll
                    for (int pt = 0; pt < 4; ++pt) { const bf16x8 xf = *(const LAS bf16x8*)(xdT + (16 * pt + r16) * SP + (32 * ks + 8 * q4) * 2); yd[pt] = __builtin_amdgcn_mfma_f32_16x16x32_bf16(xf, mf, yd[pt], 0, 0, 0); }
                } }
#pragma unroll
                for (int pt = 0; pt < 4; ++pt) *(u32x2*)(ydiag + (t0 + lq) * 1024 + hd * 64 + 16 * pt + 4 * q4) = (u32x2){pg8::cvt_pk_bf16(yd[pt][0], yd[pt][1]), pg8::cvt_pk_bf16(yd[pt][2], yd[pt][3])};
            }
            {
                bf16x8 bf[4];
#pragma unroll
                for (int ks = 0; ks < 4; ++ks) bf[ks] = *(const LAS bf16x8*)(BT + (16 * wave + r16) * SP + (32 * ks + 8 * q4) * 2);
                bf16_t* hp = states + ((size_t)(unit * 8 + r) * 64) * 128;
#pragma unroll
                for (int pt = 0; pt < 4; ++pt) { f32x4 st = {0.f, 0.f, 0.f, 0.f};
#pragma unroll
                    for (int ks = 0; ks < 4; ++ks) { const bf16x8 xf = *(const LAS bf16x8*)(xeT + (16 * pt + r16) * SP + (32 * ks + 8 * q4) * 2); st = __builtin_amdgcn_mfma_f32_16x16x32_bf16(bf[ks], xf, st, 0, 0, 0); }
                    *(u32x2*)(hp + (size_t)(16 * pt + r16) * 128 + 16 * wave + 4 * q4) = (u32x2){pg8::cvt_pk_bf16(st[0], st[1]), pg8::cvt_pk_bf16(st[2], st[3])}; }
            }
            __syncthreads();
        }
    }
}
DEV void ph_ssd_scan(const Args& a, const Ctx& X, const int wg0) {
    bf16_t* states = (bf16_t*)(a.ws + WS_STATES); const float* cdec = (const float*)(a.ws + WS_CDEC);
    for (int task = (X.bid - wg0) * NTHR + X.tid; task < NB * 16 * 64 * 32; task += (X.G - wg0) * NTHR) {
        const int n4 = task & 31, p = (task >> 5) & 63, hd = (task >> 11) & 15, b = task >> 15;
        float h0 = 0.f, h1 = 0.f, h2 = 0.f, h3 = 0.f;
        for (int c = 0; c < 32; ++c) {
            const int unit = (b * 32 + c) * 2 + (hd >> 3);
            u32x2* ptr = (u32x2*)(states + ((size_t)(unit * 8 + (hd & 7)) * 64 + p) * 128 + 4 * n4);
            const u32x2 sv = *ptr; const float dec = cdec[(size_t)unit * 32 + (hd & 7)];
            *ptr = (u32x2){pk2(h0, h1), pk2(h2, h3)};
            h0 = h0 * dec + __uint_as_float(sv.x << 16); h1 = h1 * dec + __uint_as_float(sv.x & 0xFFFF0000u); h2 = h2 * dec + __uint_as_float(sv.y << 16); h3 = h3 * dec + __uint_as_float(sv.y & 0xFFFF0000u);
        }
    }
}
DEV void ph_ssd_out(const Args& a, const Ctx& X, const int wg0) {
    const bf16_t* CC = (const bf16_t*)(a.ws + WS_CC); const float* acum = (const float*)(a.ws + WS_ACUM); const bf16_t* ydiag = (const bf16_t*)(a.ws + WS_YDIAG);
    const bf16_t* states = (const bf16_t*)(a.ws + WS_STATES); const bf16_t* zb = (const bf16_t*)(a.ws + WS_ZB); bf16_t* oy = (bf16_t*)(a.ws + WS_OY);
    const int lane = X.lane, wave = X.wave, r16 = lane & 15, q4 = lane >> 4;
    for (int unit = X.bid - wg0; unit < NB * 32 * 2; unit += X.G - wg0) {
        const int g = unit & 1, c = (unit >> 1) & 31, b = unit >> 6; const size_t t = (size_t)b * SEQ + 128 * c + 16 * wave + r16;
        bf16x8 cf[4];
#pragma unroll
        for (int ks = 0; ks < 4; ++ks) cf[ks] = *(const bf16x8*)(CC + t * 256 + g * 128 + 32 * ks + 8 * q4);
        float ss = 0.f;
        LAS u32x2* stash = (LAS u32x2*)(X.lds + wave * 16384);
        for (int r = 0; r < 8; ++r) {
            const int hd = g * 8 + r; const float eac = __expf(acum[((size_t)g * T + t) * 8 + r]);
            const bf16_t* hp = states + ((size_t)(unit * 8 + r) * 64) * 128;
#pragma unroll
            for (int pt = 0; pt < 4; ++pt) { f32x4 acc = {0.f, 0.f, 0.f, 0.f};
#pragma unroll
                for (int ks = 0; ks < 4; ++ks) { const bf16x8 hf = *(const bf16x8*)(hp + (size_t)(16 * pt + r16) * 128 + 32 * ks + 8 * q4); acc = __builtin_amdgcn_mfma_f32_16x16x32_bf16(hf, cf[ks], acc, 0, 0, 0); }
                const u32x2 yd = *(const u32x2*)(ydiag + t * 1024 + hd * 64 + 16 * pt + 4 * q4), zz = *(const u32x2*)(zb + t * 1024 + hd * 64 + 16 * pt + 4 * q4);
                f32x4 v; v[0] = acc[0] * eac + __uint_as_float(yd.x << 16); v[1] = acc[1] * eac + __uint_as_float(yd.x & 0xFFFF0000u); v[2] = acc[2] * eac + __uint_as_float(yd.y << 16); v[3] = acc[3] * eac + __uint_as_float(yd.y & 0xFFFF0000u);
                v[0] *= siluf(__uint_as_float(zz.x << 16)); v[1] *= siluf(__uint_as_float(zz.x & 0xFFFF0000u)); v[2] *= siluf(__uint_as_float(zz.y << 16)); v[3] *= siluf(__uint_as_float(zz.y & 0xFFFF0000u));
                ss += v[0] * v[0] + v[1] * v[1] + v[2] * v[2] + v[3] * v[3];
                stash[(r * 4 + pt) * 64 + lane] = (u32x2){pg8::cvt_pk_bf16(v[0], v[1]), pg8::cvt_pk_bf16(v[2], v[3])}; }
        }
        ss += __shfl_xor(ss, 16); ss += __shfl_xor(ss, 32);
        const float rstd = rsqrtf(ss * (1.f / 512.f) + EPS);
        for (int r = 0; r < 8; ++r)
#pragma unroll
            for (int pt = 0; pt < 4; ++pt) { const int cix = g * 512 + r * 64 + 16 * pt + 4 * q4; const f32x4 nw = *(const f32x4*)(a.ssd_norm_w + cix); const u32x2 w = stash[(r * 4 + pt) * 64 + lane];
                *(u32x2*)(oy + t * 2048 + 1024 + cix) = (u32x2){pg8::cvt_pk_bf16(__uint_as_float(w.x << 16) * rstd * nw[0], __uint_as_float(w.x & 0xFFFF0000u) * rstd * nw[1]), pg8::cvt_pk_bf16(__uint_as_float(w.y << 16) * rstd * nw[2], __uint_as_float(w.y & 0xFFFF0000u) * rstd * nw[3])}; }
    }
}


DEV void ph_attn(const Args& a, const Ctx& X) {
    const bf16_t* qkv = (const bf16_t*)(a.ws + WS_Q1KV); bf16_t* po = (bf16_t*)(a.ws + WS_PO); float* plse = (float*)(a.ws + WS_PLSE); bf16_t* o = (bf16_t*)(a.ws + WS_O1);
    LAS unsigned char* vl = X.lds + X.wave * 12288;
    LAS unsigned char* kl = vl + 6144;
    const int lane = X.lane, q = lane & 31, h5 = lane >> 5;
    const int tr_off = ((lane & 15) >> 2) * 192 + (16 * ((lane >> 4) & 1) + 4 * (lane & 3)) * 2;
    const int prow = lane >> 3, pch = lane & 7;
    for (int unit = X.bid; unit < NB * 16 * 8; unit += X.G) {
        const int bhd = unit & 63, b = bhd >> 4, hd = bhd & 15, g = unit >> 6;
        for (int tk = 0; tk < 6; ++tk) {
            const int br = tk >> 1, k = X.wave * 2 + (tk & 1);
            int d, r, i0;
            if (br == 0) { d = 1; r = 0; i0 = 512 * g + 32 * k; } else if (br == 1) { d = 4; r = k & 3; i0 = 128 * g + 32 * (k >> 2); } else { d = 16; r = k; i0 = 32 * g; }
            const size_t tq = (size_t)b * SEQ + (size_t)(i0 + q) * d + r;
#define ATT_LOAD(dst, j0_, coff) do { _Pragma("unroll") for (int _i = 0; _i < 4; ++_i) { const size_t _t = (size_t)b * SEQ + (size_t)((j0_) + 8 * _i + prow) * d + r; \
                dst[_i] = *(const u32x4*)(qkv + _t * 3072 + (coff) + hd * 64 + pch * 8); } } while (0)
            u32x4 kA[4], vA[4], kB[4], vB[4], kC[4], vC[4];
            const bool v3 = (i0 - 32) >= 0, v2 = (i0 - 64) >= 0, v1 = (i0 - 96) >= 0, v0 = (i0 - 128) >= 0;
            ATT_LOAD(kA, i0, 0);
            ATT_LOAD(kB, i0, 1024); ATT_LOAD(vB, i0, 2048);
            if (v3) { ATT_LOAD(kC, i0 - 32, 1024); ATT_LOAD(vC, i0 - 32, 2048); }
#pragma unroll
            for (int i = 0; i < 4; ++i) *(LAS u32x4*)(kl + (8 * i + prow) * 144 + pch * 16) = kA[i];
            bf16x8 qf[4];
#pragma unroll
            for (int s = 0; s < 4; ++s) qf[s] = *(const LAS bf16x8*)(kl + q * 144 + (16 * s + 8 * h5) * 2);
            LDS_WAIT();
            f32x16 oacc[2];
#pragma unroll
            for (int i = 0; i < 16; ++i) { oacc[0][i] = 0.f; oacc[1][i] = 0.f; }
            float m = -1e30f, l = 0.f;
            auto tile = [&](const int kt, const u32x4 (&kp)[4], const u32x4 (&vp)[4]) {
#pragma unroll
                for (int i = 0; i < 4; ++i) { *(LAS u32x4*)(kl + (8 * i + prow) * 144 + pch * 16) = kp[i]; *(LAS u32x4*)(vl + (8 * i + prow) * 192 + pch * 16) = vp[i]; }
                f32x16 sacc;
#pragma unroll
                for (int i = 0; i < 16; ++i) sacc[i] = 0.f;
#pragma unroll
                for (int s = 0; s < 4; ++s) { const bf16x8 kf = *(const LAS bf16x8*)(kl + q * 144 + (16 * s + 8 * h5) * 2); sacc = __builtin_amdgcn_mfma_f32_32x32x16_bf16(kf, qf[s], sacc, 0, 0, 0); }
                if (kt == 4) {
#pragma unroll
                    for (int i = 0; i < 16; ++i) { const int kl_ = (i & 3) + 8 * (i >> 2) + 4 * h5; if (kl_ > q) sacc[i] = -1e30f; }
                } else if (kt == 0) {
#pragma unroll
                    for (int i = 0; i < 16; ++i) { const int kl_ = (i & 3) + 8 * (i >> 2) + 4 * h5; if (kl_ < q) sacc[i] = -1e30f; }
                }
                float mx = sacc[0];
#pragma unroll
                for (int i = 1; i < 16; ++i) mx = fmaxf(mx, sacc[i]);
                mx = fmaxf(mx, __shfl_xor(mx, 32));
                const float mn = fmaxf(m, mx), alpha = __expf(m - mn);
                float rs = 0.f;
#pragma unroll
                for (int i = 0; i < 16; ++i) { sacc[i] = __expf(sacc[i] - mn); rs += sacc[i]; }
                rs += __shfl_xor(rs, 32);
                l = l * alpha + rs; m = mn;
#pragma unroll
                for (int i = 0; i < 16; ++i) { oacc[0][i] *= alpha; oacc[1][i] *= alpha; }
                bf16x8 pf[2];
#pragma unroll
                for (int s = 0; s < 2; ++s) { u32x4 w; w.x = pg8::cvt_pk_bf16(sacc[8 * s], sacc[8 * s + 1]); w.y = pg8::cvt_pk_bf16(sacc[8 * s + 2], sacc[8 * s + 3]); w.z = pg8::cvt_pk_bf16(sacc[8 * s + 4], sacc[8 * s + 5]); w.w = pg8::cvt_pk_bf16(sacc[8 * s + 6], sacc[8 * s + 7]);
                    pf[s] = __builtin_bit_cast(bf16x8, w); }
#pragma unroll
                for (int dt = 0; dt < 2; ++dt)
#pragma unroll
                    for (int s = 0; s < 2; ++s) {
                        const s16x4 t0_ = __builtin_amdgcn_ds_read_tr16_b64_v4i16((LAS s16x4*)(vl + (16 * s + 4 * h5) * 192 + dt * 64 + tr_off));
                        const s16x4 t1_ = __builtin_amdgcn_ds_read_tr16_b64_v4i16((LAS s16x4*)(vl + (16 * s + 8 + 4 * h5) * 192 + dt * 64 + tr_off));
                        bf16x8 vf; vf[0] = t0_[0]; vf[1] = t0_[1]; vf[2] = t0_[2]; vf[3] = t0_[3]; vf[4] = t1_[0]; vf[5] = t1_[1]; vf[6] = t1_[2]; vf[7] = t1_[3];
                        oacc[dt] = __builtin_amdgcn_mfma_f32_32x32x16_bf16(vf, pf[s], oacc[dt], 0, 0, 0);
                    }
                LDS_WAIT();
            };
            if (v2) { ATT_LOAD(kA, i0 - 64, 1024); ATT_LOAD(vA, i0 - 64, 2048); }
            tile(4, kB, vB);
            if (v3) {
                if (v1) { ATT_LOAD(kB, i0 - 96, 1024); ATT_LOAD(vB, i0 - 96, 2048); }
                tile(3, kC, vC);
                if (v2) {
                    if (v0) { ATT_LOAD(kC, i0 - 128, 1024); ATT_LOAD(vC, i0 - 128, 2048); }
                    tile(2, kA, vA);
                    if (v1) { tile(1, kB, vB);
                        if (v0) tile(0, kC, vC); }
                }
            }
#undef ATT_LOAD
            const float inv = 1.f / l;
            bf16_t* pr = po + ((size_t)br * T + tq) * 1024 + hd * 64;
#pragma unroll
            for (int dt = 0; dt < 2; ++dt)
#pragma unroll
                for (int gq = 0; gq < 4; ++gq) { u32x2 w; w.x = pg8::cvt_pk_bf16(oacc[dt][4 * gq] * inv, oacc[dt][4 * gq + 1] * inv); w.y = pg8::cvt_pk_bf16(oacc[dt][4 * gq + 2] * inv, oacc[dt][4 * gq + 3] * inv);
                    *(u32x2*)(pr + 32 * dt + 8 * gq + 4 * h5) = w; }
            if (h5 == 0) plse[((size_t)br * T + tq) * 16 + hd] = m + __logf(l);
        }
        VM_WAIT(); __syncthreads();
        {
            const size_t t = (size_t)b * SEQ + 512 * g + X.tid;
            const float l0 = plse[t * 16 + hd], l1 = plse[((size_t)T + t) * 16 + hd], l2 = plse[((size_t)2 * T + t) * 16 + hd];
            const float mx = fmaxf(l0, fmaxf(l1, l2)); float w0 = __expf(l0 - mx), w1 = __expf(l1 - mx), w2 = __expf(l2 - mx); const float wi = 1.f / (w0 + w1 + w2); w0 *= wi; w1 *= wi; w2 *= wi;
            const bf16_t* p0 = po + t * 1024 + hd * 64; const bf16_t* p1 = p0 + (size_t)T * 1024; const bf16_t* p2 = p1 + (size_t)T * 1024; bf16_t* orow = o + t * 1024 + hd * 64;
#pragma unroll
            for (int c = 0; c < 8; ++c) { const u32x4 x0 = *(const u32x4*)(p0 + 8 * c), x1 = *(const u32x4*)(p1 + 8 * c), x2 = *(const u32x4*)(p2 + 8 * c); u32x4 y;
#pragma unroll
                for (int e = 0; e < 4; ++e) { const float lo = w0 * __uint_as_float(x0[e] << 16) + w1 * __uint_as_float(x1[e] << 16) + w2 * __uint_as_float(x2[e] << 16);
                    const float hi = w0 * __uint_as_float(x0[e] & 0xFFFF0000u) + w1 * __uint_as_float(x1[e] & 0xFFFF0000u) + w2 * __uint_as_float(x2[e] & 0xFFFF0000u); y[e] = pk2(lo, hi); }
                *(u32x4*)(orow + 8 * c) = y; }
        }
    }
}

DEV void ph_router(const Args& a, const Ctx& X, const int l) {
    unsigned char* ws = a.ws;
    const float* mod = (const float*)(ws + WS_MOD) + (size_t)l * NB * 6 * D;
    const bf16_t* ymix = (const bf16_t*)(ws + WS_YMIX);
    bf16_t* xb = (bf16_t*)(ws + WS_XB);
    bf16_t* hb = (bf16_t*)(ws + WS_H);
    int* idx = (int*)(ws + WS_IDX); float* gw = (float*)(ws + WS_GW); int* aslot = (int*)(ws + WS_ASLOT); int* ltok = (int*)(ws + WS_LTOK);
    int* cntg = (int*)(ws + WS_CTL + CTL_CNT) + l * NE;
    const float* rw = a.router_w + (size_t)l * D * NE; const float* rbias = a.router_bias + l * NE;
    constexpr int HP = 2064;
    LAS unsigned char* hL = X.lds;
    LAS float* logit = (LAS float*)(X.lds + AUX_OFF + 2048);
    LAS int* lcnt = (LAS int*)(X.lds + AUX_OFF + 2048 + 64 * 65 * 4);
    LAS int* lbase = lcnt + 64;
    LAS int* sel_e = lbase + 64;
    LAS int* sel_s = sel_e + 512;
    const int lane = X.lane, wave = X.wave;
    for (int rb = X.bid; rb < T / 64; rb += X.G) {
        if (X.tid < 64) lcnt[X.tid] = 0;
        for (int r8 = 0; r8 < 8; ++r8) {
            const int lr = wave * 8 + r8, row = rb * 64 + lr, b = row / SEQ; const float* ml = mod + (size_t)b * 6 * D;
            float xv[16], yv[16]; if (l == 0) load_row(a.x + (size_t)row * D, lane, xv); else load_row_bf(xb + (size_t)row * D, lane, xv); load_row_bf(ymix + (size_t)row * D, lane, yv);
            resid_update(xv, yv, a.mix_post_g + l * D, ml + 2 * D, lane);
            store_row_bf(xb + (size_t)row * D, lane, xv);
            u32x2 o[4]; prenorm_pack(xv, a.ffn_pre_g + l * D, ml + 4 * D, ml + 3 * D, lane, o);
#pragma unroll
            for (int j = 0; j < 4; ++j) { *(u32x2*)(hb + (size_t)row * D + j * 256 + lane * 4) = o[j]; *(LAS u32x2*)(hL + lr * HP + (j * 256 + lane * 4) * 2) = o[j]; }
        }
        __syncthreads();
        { const int rt = wave & 3, nh = wave >> 2, r16 = lane & 15, kq = lane >> 4;
          f32x4 acc0 = {0.f, 0.f, 0.f, 0.f}, acc1 = {0.f, 0.f, 0.f, 0.f};
          for (int c = 0; c < 32; ++c) {
              const u32x4 hv = *(const LAS u32x4*)(hL + (rt * 16 + r16) * HP + (32 * c + 8 * kq) * 2);
              const float* rp = rw + (size_t)(32 * c + 8 * kq) * NE + 4 * r16 + 2 * nh;
#pragma unroll
              for (int j = 0; j < 8; ++j) { const unsigned wj = hv[j >> 1]; const float av = (j & 1) ? __uint_as_float(wj & 0xFFFF0000u) : __uint_as_float(wj << 16);
                  const f32x2 bv = *(const f32x2*)(rp + (size_t)j * NE);
                  acc0 = __builtin_amdgcn_mfma_f32_16x16x4f32(av, bv.x, acc0, 0, 0, 0); acc1 = __builtin_amdgcn_mfma_f32_16x16x4f32(av, bv.y, acc1, 0, 0, 0); }
          }
#pragma unroll
          for (int r = 0; r < 4; ++r) { logit[(rt * 16 + 4 * kq + r) * 65 + 4 * r16 + 2 * nh] = acc0[r]; logit[(rt * 16 + 4 * kq + r) * 65 + 4 * r16 + 2 * nh + 1] = acc1[r]; } }
        __syncthreads();
        for (int r8 = 0; r8 < 8; ++r8) {
            const int lr = wave * 8 + r8, t = rb * 64 + lr;
            float lgt = logit[lr * 65 + lane]; if (!(lgt > -1e30f && lgt < 1e30f)) lgt = 0.f;
            const float score = sigmoidf_(lgt), biased = score + rbias[lane];
            float m1 = biased;
#pragma unroll
            for (int o = 1; o < 8; o <<= 1) m1 = fmaxf(m1, __shfl_xor(m1, o));
            int c1 = (biased == m1) ? (lane & 7) : 8;
#pragma unroll
            for (int o = 1; o < 8; o <<= 1) c1 = min(c1, __shfl_xor(c1, o));
            float m2 = ((lane & 7) == c1) ? -INFINITY : biased;
#pragma unroll
            for (int o = 1; o < 8; o <<= 1) m2 = fmaxf(m2, __shfl_xor(m2, o));
            const float gs = m1 + m2; const int myg = lane >> 3; int grank = 0;
#pragma unroll
            for (int g2 = 0; g2 < 8; ++g2) { const float o = __shfl(gs, g2 * 8); grank += (o > gs || (o == gs && g2 < myg)) ? 1 : 0; }
            const float cand = (grank < 4) ? biased : -INFINITY; int rank = 0;
            for (int e2 = 0; e2 < 64; ++e2) { const float o = __shfl(cand, e2); rank += (o > cand || (o == cand && e2 < lane)) ? 1 : 0; }
            const bool sel = (rank < TOPK) && (grank < 4);
            const float ssum = wave_sum(sel ? score : 0.f);
            if (sel) { idx[t * 8 + rank] = lane; gw[t * 8 + rank] = score / ssum * 2.5f; sel_e[lr * 8 + rank] = lane; sel_s[lr * 8 + rank] = __hip_atomic_fetch_add(lcnt + lane, 1, __ATOMIC_RELAXED, __HIP_MEMORY_SCOPE_WORKGROUP); }
        }
        __syncthreads();
        if (X.tid < 64) { const int n = lcnt[X.tid]; lbase[X.tid] = n ? atomicAdd(cntg + X.tid, n) : 0; }
        __syncthreads();
        { const int lr = X.tid >> 3, k = X.tid & 7, t = rb * 64 + lr, e = sel_e[lr * 8 + k], sl = lbase[e] + sel_s[lr * 8 + k];
          aslot[t * 8 + k] = sl; ltok[e * CAP + sl] = t; }
        __syncthreads();
    }
}
template <int NW>
DEV void ph_moe_conv(const Args& a, const Ctx& X, const int l, const int wg0) {
    unsigned char* ws = a.ws;
    if (X.wave >= NW) return;
    { LAS float* scr = (LAS float*)(X.lds + X.wave * 8704);
      const int gwv = (X.bid - wg0) * NW + X.wave, NGW = (X.G - wg0) * NW;
      constexpr int I_GU = (D / 64) * (512 / 32), I_D = (ED / 64) * (D / 32), I_E = I_GU + I_D;
      const float* eg = a.exp_gate + (size_t)l * NE * D * ED; const float* eu = a.exp_up + (size_t)l * NE * D * ED; const float* ed = a.exp_down + (size_t)l * NE * ED * D;
      for (int it = gwv; it < (NE + 1) * I_E; it += NGW) {
          const int e = it / I_E; int r = it - e * I_E;
          if (e < NE) {
              if (r < I_GU) conv_item(SrcGU{eg + (size_t)e * D * ED, (long)(eu - eg)}, ED, D, (bf16_t*)(ws + WS_WGU) + (size_t)e * 512 * D, scr, r, 16, X.lane);
              else conv_item(SrcIdent{ed + (size_t)e * ED * D}, D, ED, (bf16_t*)(ws + WS_WD) + (size_t)e * D * ED, scr, r - I_GU, D / 32, X.lane);
          } else {
              if (r < I_GU) conv_item(SrcGU{a.sh_gate + (size_t)l * D * ED, (long)(a.sh_up - a.sh_gate)}, ED, D, (bf16_t*)(ws + WS_WGUS), scr, r, 16, X.lane);
              else conv_item(SrcIdent{a.sh_down + (size_t)l * ED * D}, D, ED, (bf16_t*)(ws + WS_WDS), scr, r - I_GU, D / 32, X.lane);
          }
      } }
}

DEV int moe_tables(const Args& a, const Ctx& X, const int l, LAS int* t_cnt, LAS int* t_rb0, LAS int* t_eofrb) {
    const int* cntg = (const int*)(a.ws + WS_CTL + CTL_CNT) + l * NE;
    if (X.wave == 0) {
        const int c = __hip_atomic_load(cntg + X.lane, __ATOMIC_RELAXED, __HIP_MEMORY_SCOPE_AGENT), nrb = (c + 255) >> 8;
        int incl = nrb;
#pragma unroll
        for (int o = 1; o < 64; o <<= 1) { const int v = __shfl_up(incl, o); if (X.lane >= o) incl += v; }
        const int excl = incl - nrb;
        t_cnt[X.lane] = c; t_rb0[X.lane] = excl; if (X.lane == 63) t_rb0[64] = incl;
        for (int j = 0; j < nrb; ++j) t_eofrb[excl + j] = X.lane;
        t_eofrb[SH_RB + X.lane] = NE;
    }
    __syncthreads();
    return t_rb0[64];
}

DEV void ph_moe_gu(const Args& a, const Ctx& X, const int l) {
    LAS int* t_cnt = (LAS int*)(X.lds + AUX_OFF + 1024); LAS int* t_rb0 = t_cnt + 64; LAS int* t_eofrb = t_rb0 + 80; LAS int* toks = t_eofrb + NRB_ALL;
    const int nrbt = moe_tables(a, X, l, t_cnt, t_rb0, t_eofrb);
    const int* ltok = (const int*)(a.ws + WS_LTOK);
    pg8::Unit u;
    for (int i = 0; i < 8; ++i) { if (!pg8::moe_unit(i, 2, nrbt, X.G, X.bid, u)) break;
        if (X.tid < 256) { const int e = t_eofrb[u.pm]; int tok;
            if (e < NE) { const int sl = (u.pm - t_rb0[e]) * 256 + X.tid; tok = sl < t_cnt[e] ? ltok[e * CAP + sl] : 0; } else tok = (u.pm - SH_RB) * 256 + X.tid;
            toks[i * 256 + X.tid] = tok; } }
    VM_WAIT(); __syncthreads();
    pg8::SchedGU S{(const char*)(a.ws + WS_H), (const char*)(a.ws + WS_WGU), (const char*)(a.ws + WS_WGUS), t_eofrb, toks, nrbt, X.G, X.bid, 0};
    pg8::EpiGU E{(bf16_t*)(a.ws + WS_HID)};
    pg8::gemm_phase<pg8::EpiGU, pg8::SchedGU>(X.lds, D, S, E);
}
DEV void ph_moe_down(const Args& a, const Ctx& X, const int l) {
    LAS int* t_cnt = (LAS int*)(X.lds + AUX_OFF + 1024); LAS int* t_rb0 = t_cnt + 64; LAS int* t_eofrb = t_rb0 + 80;
    const int nrbt = moe_tables(a, X, l, t_cnt, t_rb0, t_eofrb);
    pg8::SchedDown S{(const char*)(a.ws + WS_HID), (const char*)(a.ws + WS_WD), (const char*)(a.ws + WS_WDS), t_eofrb, nrbt, X.G, X.bid, 0};
    pg8::EpiFp8 E{(unsigned char*)(a.ws + WS_Y), D, 0};
    int kd = ED; asm volatile("" : "+s"(kd));
    pg8::gemm_phase<pg8::EpiFp8, pg8::SchedDown>(X.lds, kd, S, E);
}
DEV void ph_combine(const Args& a, const Ctx& X, const int l) {
    LAS int* t_cnt = (LAS int*)(X.lds + AUX_OFF + 1024); LAS int* t_rb0 = t_cnt + 64; LAS int* t_eofrb = t_rb0 + 80;
    (void)moe_tables(a, X, l, t_cnt, t_rb0, t_eofrb);
    const float* mod = (const float*)(a.ws + WS_MOD);
    const int* idx = (const int*)(a.ws + WS_IDX); const float* gw = (const float*)(a.ws + WS_GW); const int* aslot = (const int*)(a.ws + WS_ASLOT);
    const unsigned char* y = a.ws + WS_Y; bf16_t* hb = (bf16_t*)(a.ws + WS_H);
    const int lane = X.lane;
    const int tstep = X.G * NWAVES;
    int t = X.bid * NWAVES + X.wave;
    int e_n = 0, s_n = 0; float g_n = 0.f;
    if (t < T && lane < 8) { e_n = idx[t * 8 + lane]; g_n = gw[t * 8 + lane]; s_n = aslot[t * 8 + lane]; }
    for (; t < T; t += tstep) {
        const int b = t / SEQ; const float* ml = mod + (size_t)(l * NB + b) * 6 * D;
        const int e_c = e_n, s_c = s_n; const float g_c = g_n;
        const int tn = t + tstep;
        if (tn < T && lane < 8) { e_n = idx[tn * 8 + lane]; g_n = gw[tn * 8 + lane]; s_n = aslot[tn * 8 + lane]; }
        u32x2 w0[9], w1[9];
        { const unsigned char* yr = y + ((size_t)SH_RB * 256 + t) * D; w0[8] = *(const u32x2*)(yr + 8 * lane); w1[8] = *(const u32x2*)(yr + 512 + 8 * lane); }
        float gk[8];
#pragma unroll
        for (int k = 0; k < 8; ++k) { const int e = __shfl(e_c, k), sl = __shfl(s_c, k); gk[k] = __shfl(g_c, k);
            const unsigned char* yr = y + ((size_t)t_rb0[e] * 256 + sl) * D; w0[k] = *(const u32x2*)(yr + 8 * lane); w1[k] = *(const u32x2*)(yr + 512 + 8 * lane); }
        float xv[16]; load_row8_bf((const bf16_t*)(a.ws + WS_XB) + (size_t)t * D, lane, xv);
        float yv[16];
#pragma unroll
        for (int i = 0; i < 16; ++i) yv[i] = 0.f;
        acc_row8(yv, w0[8], w1[8], 0.125f);
#pragma unroll
        for (int k = 0; k < 8; ++k) acc_row8(yv, w0[k], w1[k], gk[k] * 0.125f);
        resid_update8(xv, yv, a.ffn_post_g + l * D, ml + 5 * D, lane);
        if (l == 0) store_row8_bf((bf16_t*)(a.ws + WS_XB) + (size_t)t * D, lane, xv); else store_row8(a.out + (size_t)t * D, lane, xv);
        if (l == 0) { const float* mn = mod + (size_t)(1 * NB + b) * 6 * D; u32x4 o[2]; prenorm_pack8(xv, a.mix_pre_g + D, mn + D, mn, lane, o);
            *(u32x4*)(hb + (size_t)t * D + 8 * lane) = o[0]; *(u32x4*)(hb + (size_t)t * D + 512 + 8 * lane) = o[1]; }
    }
}

constexpr int NPH = 18;
__global__ void __launch_bounds__(NTHR, 2) mega(Args a) {
    extern __shared__ __attribute__((aligned(16))) unsigned char lds_raw[];
    Ctx X; X.lds = (LAS unsigned char*)lds_raw; X.tid = threadIdx.x; X.lane = X.tid & 63; X.wave = __builtin_amdgcn_readfirstlane(X.tid >> 6); X.G = gridDim.x; X.bid = blockIdx.x;
    if (X.tid < 4) ((LAS unsigned*)(X.lds + BAR_OFF))[X.tid] = 0u;
    __syncthreads();
    XcdBarrier bar; bar.bar = (unsigned*)(a.ws + WS_CTL); bar.x = 0; bar.st = nullptr;
    if (!MK_PER_PHASE) bar = xcd_barrier_post((unsigned*)(a.ws + WS_CTL), (volatile LAS unsigned*)(X.lds + BAR_OFF));
    const int lo = a.ph_lo, hi = a.ph_hi;
#define IN(k) (lo <= (k) && (k) < hi)
#define REP(k, ...) do { __VA_ARGS__; if constexpr (((PROBE_MASK >> (k)) & 1u) != 0u) { __syncthreads(); __VA_ARGS__; } } while (0)
#define SEAM(k) do { if (IN(k) && IN((k) + 1)) xcd_barrier(bar); else { VM_WAIT(); __syncthreads(); } } while (0)
    unsigned char* ws = a.ws;
    if (IN(0)) { REP(0, ph_setup(a, X)); SEAM(0); }
    if (IN(1)) { REP(1, ph_prenorm0(a, X)); SEAM(1); }
    if constexpr (((PROBE_MASK >> 24) & 1u) != 0u) { for (int i_ = 0; i_ < 16; ++i_) xcd_barrier(bar); }
    if (IN(2)) {
        pg8::SchedDense S; S.so.init(T, NPROJ, X.G, X.bid); S.A = (const char*)(ws + WS_H); S.Bt = (const char*)(ws + WS_WIN); S.K = D; S.pad_ = 0;
        pg8::EpiProj E{(bf16_t*)(ws + WS_QKVPRE), (bf16_t*)(ws + WS_ZA), (bf16_t*)(ws + WS_XBCPRE), (bf16_t*)(ws + WS_ZB), (float*)(ws + WS_SMALL)};
        REP(2, pg8::gemm_phase<pg8::EpiProj, pg8::SchedDense>(X.lds, D, S, E)); SEAM(2); }
    if (IN(3)) { REP(3, ph_gdn_local(a, X)); REP(20, ph_ssd_local(a, X)); SEAM(3); }
    if (IN(4)) {
        if (X.bid < 32) { REP(4, ph_gdn_scan(a, X)); }
        else { ph_ssd_scan(a, X, 32); group_barrier((unsigned*)(ws + WS_CTL + CTL_GRP), (unsigned)(X.G - 32)); __syncthreads(); ph_ssd_out(a, X, 32); __syncthreads(); ph_moe_conv<2>(a, X, 0, 32); __syncthreads(); ph_setup_late(a, X, 32); }
        SEAM(4); }
    if (IN(6)) {
        pg8::SchedDense S; S.so.init(T, D, X.G, X.bid); S.A = (const char*)(ws + WS_OY); S.Bt = (const char*)(ws + WS_WOUT); S.K = 2048; S.pad_ = 0;
        pg8::EpiBf16 E{(bf16_t*)(ws + WS_YMIX), D, 0};
        REP(6, pg8::gemm_phase<pg8::EpiBf16, pg8::SchedDense>(X.lds, 2048, S, E)); SEAM(6); }
    if (IN(7)) { ph_router(a, X, 0); SEAM(7); }
    if (IN(8)) { REP(8, ph_moe_gu(a, X, 0)); SEAM(8); }
    if (IN(9)) { REP(9, ph_moe_down(a, X, 0)); SEAM(9); }
    if (IN(10)) { ph_combine(a, X, 0); SEAM(10); }
    if (IN(11)) {
        pg8::SchedDense S; S.so.init(T, 3072, X.G, X.bid); S.A = (const char*)(ws + WS_H); S.Bt = (const char*)(ws + WS_WQKV); S.K = D; S.pad_ = 0;
        pg8::EpiQKV E{(bf16_t*)(ws + WS_Q1KV), (const float*)(ws + WS_COS), (const float*)(ws + WS_SIN)};
        REP(11, pg8::gemm_phase<pg8::EpiQKV, pg8::SchedDense>(X.lds, D, S, E)); SEAM(11); }
    if (IN(12)) { REP(12, ph_attn(a, X)); SEAM(12); }
    if (IN(13)) {
        pg8::SchedDense S; S.so.init(T, D, X.G, X.bid); S.A = (const char*)(ws + WS_O1); S.Bt = (const char*)(ws + WS_WO); S.K = D; S.pad_ = 0;
        pg8::EpiBf16 E{(bf16_t*)(ws + WS_YMIX), D, 0};
        REP(13, pg8::gemm_phase<pg8::EpiBf16, pg8::SchedDense>(X.lds, D, S, E)); SEAM(13); }
    if (IN(14)) { ph_router(a, X, 1); REP(14, ph_moe_conv<8>(a, X, 1, 0)); SEAM(14); }
    if (IN(15)) { ph_moe_gu(a, X, 1); SEAM(15); }
    if (IN(16)) { ph_moe_down(a, X, 1); SEAM(16); }
    if (IN(17)) { REP(17, ph_combine(a, X, 1)); }
#undef IN
#undef SEAM
}

extern "C" void kernel_launch(void* const* d_in, const int* in_sizes, int n_in, void* d_out, int out_size, void* d_ws, size_t ws_size, hipStream_t stream) {
    static int grid = 0;
    if (!grid) {
        int dev = 0, cus = 0, per_cu = 0;
        if (hipGetDevice(&dev) != hipSuccess || hipDeviceGetAttribute(&cus, hipDeviceAttributeMultiprocessorCount, dev) != hipSuccess) { fprintf(stderr, "kernel_launch: device query failed\n"); grid = -1; return; }
        if (hipFuncSetAttribute((const void*)mega, hipFuncAttributeMaxDynamicSharedMemorySize, LDS_BYTES) != hipSuccess) { fprintf(stderr, "kernel_launch: hipFuncSetAttribute failed\n"); grid = -1; return; }
        if (hipOccupancyMaxActiveBlocksPerMultiprocessor(&per_cu, (const void*)mega, NTHR, LDS_BYTES) != hipSuccess || per_cu < 1) { fprintf(stderr, "kernel_launch: occupancy query says %d blocks per CU\n", per_cu); grid = -1; return; }
        grid = cus;
        if (grid < 64 || (grid & 7)) { fprintf(stderr, "kernel_launch: unsupported CU count %d\n", cus); grid = -1; return; }
    }
    if (grid < 0) return;
    if (ws_size < WS_END || n_in != 31) { fprintf(stderr, "kernel_launch: workspace %zu < %zu or n_in %d != 31\n", ws_size, (size_t)WS_END, n_in); return; }
    if (hipMemsetAsync((char*)d_ws + WS_CTL, 0, CTL_BYTES, stream) != hipSuccess) { fprintf(stderr, "kernel_launch: memset failed\n"); return; }
    Args a{};
    a.x = (const float*)d_in[0]; a.c = (const float*)d_in[1]; a.pos = (const int*)d_in[2]; a.mod_w = (const float*)d_in[3]; a.mod_b = (const float*)d_in[4];
    a.mix_pre_g = (const float*)d_in[5]; a.mix_post_g = (const float*)d_in[6]; a.ffn_pre_g = (const float*)d_in[7]; a.ffn_post_g = (const float*)d_in[8];
    a.ssm_w_in = (const float*)d_in[9]; a.gdn_conv_w = (const float*)d_in[10]; a.gdn_a_log = (const float*)d_in[11]; a.gdn_dt_bias = (const float*)d_in[12]; a.gdn_norm_w = (const float*)d_in[13];
    a.ssd_conv_w = (const float*)d_in[14]; a.ssd_conv_b = (const float*)d_in[15]; a.ssd_a_log = (const float*)d_in[16]; a.ssd_dt_bias = (const float*)d_in[17]; a.ssd_d = (const float*)d_in[18]; a.ssd_norm_w = (const float*)d_in[19];
    a.ssm_w_out = (const float*)d_in[20]; a.attn_w_qkv = (const float*)d_in[21]; a.attn_w_o = (const float*)d_in[22];
    a.router_w = (const float*)d_in[23]; a.router_bias = (const float*)d_in[24]; a.exp_gate = (const float*)d_in[25]; a.exp_up = (const float*)d_in[26]; a.exp_down = (const float*)d_in[27];
    a.sh_gate = (const float*)d_in[28]; a.sh_up = (const float*)d_in[29]; a.sh_down = (const float*)d_in[30];
    a.out = (float*)d_out; a.ws = (unsigned char*)d_ws;
#if MK_PER_PHASE
    for (int p = 0; p < NPH; ++p) { a.ph_lo = p; a.ph_hi = p + 1; hipLaunchKernelGGL(mega, dim3(grid), dim3(NTHR), LDS_BYTES, stream, a); }
#else
    a.ph_lo = 0; a.ph_hi = NPH;
    hipLaunchKernelGGL(mega, dim3(grid), dim3(NTHR), LDS_BYTES, stream, a);
#endif
}
```

```cpp
#include <hip/hip_runtime.h>
#include <stdint.h>
#include <stdio.h>

#define DEV __device__ __forceinline__
#define LAS __attribute__((address_space(3)))
typedef unsigned short bf16_t;
typedef short bf16x8 __attribute__((ext_vector_type(8)));
typedef float f32x4 __attribute__((ext_vector_type(4)));
typedef float f32x2 __attribute__((ext_vector_type(2)));
typedef unsigned u32x4 __attribute__((ext_vector_type(4)));
typedef unsigned u32x2 __attribute__((ext_vector_type(2)));
typedef float f32x16 __attribute__((ext_vector_type(16)));
typedef short s16x4 __attribute__((ext_vector_type(4)));

#ifndef PROBE_MASK
#define PROBE_MASK 0u
#endif
#ifndef MK_PER_PHASE
#define MK_PER_PHASE 0
#endif

constexpr int NB = 4, SEQ = 4096, T = NB * SEQ, D = 1024;
constexpr int PROJ = 6688, NPROJ = 6912;
constexpr int C_BETA = 4096, C_XBC = 4112, C_ZB = 5648, C_DT = 6672;
constexpr int NE = 64, TOPK = 8, ED = 256, CAP = 16384;
constexpr int SH_RB = 576;
constexpr int NRB_ALL = SH_RB + 64;
constexpr float EPS = 1e-6f;
constexpr int NTHR = 512, NWAVES = 8;
constexpr int LDS_BYTES = 163840;
constexpr int AUX_OFF = 131072;
constexpr int BAR_OFF = LDS_BYTES - 16;

constexpr size_t MiB = 1u << 20;
constexpr size_t WS_CTL = 0, CTL_BYTES = 65536;
constexpr size_t CTL_CNT = 16384;
constexpr size_t CTL_GRP = 20480;
constexpr size_t WS_MOD = 65536;
constexpr size_t WS_COS = 1 * MiB, WS_SIN = 3 * MiB;
constexpr size_t WS_IDX = 5 * MiB, WS_GW = 5 * MiB + 512 * 1024, WS_ASLOT = 6 * MiB, WS_LTOK = 6 * MiB + 512 * 1024;
constexpr size_t WS_SMALL = 11 * MiB;
constexpr size_t WS_WIN = 16 * MiB, WS_WOUT = 30 * MiB, WS_WQKV = 34 * MiB, WS_WO = 40 * MiB;
constexpr size_t WS_H = 44 * MiB;
constexpr size_t WS_QKVPRE = 78 * MiB, WS_XBCPRE = 174 * MiB, WS_ZA = 222 * MiB, WS_ZB = 254 * MiB;
constexpr size_t WS_CC = 16 * MiB, WS_ACUM = 25 * MiB, WS_CDEC = 26 * MiB, WS_YDIAG = 44 * MiB, WS_STATES = 430 * MiB;
constexpr size_t WS_GI = 286 * MiB, GI_UNIT = 73728, WS_GTMP = 462 * MiB, WS_GLAST = 27 * MiB;
constexpr size_t WS_OY = 78 * MiB, WS_YMIX = 286 * MiB, WS_XB = 240 * MiB;
constexpr size_t WS_WD = 478 * MiB, WS_WDS = 510 * MiB + 512 * 1024, WS_HID = 398 * MiB, WS_Y = 78 * MiB, WS_WGU = 142 * MiB, WS_WGUS = 207 * MiB;
constexpr size_t WS_Q1KV = 78 * MiB, WS_O1 = 174 * MiB, WS_PO = 350 * MiB, WS_PLSE = 446 * MiB;
constexpr size_t WS_END = 512 * MiB;

struct Args {
    const float* x; const float* c; const int* pos; const float* mod_w; const float* mod_b;
    const float* mix_pre_g; const float* mix_post_g; const float* ffn_pre_g; const float* ffn_post_g;
    const float* ssm_w_in; const float* gdn_conv_w; const float* gdn_a_log; const float* gdn_dt_bias; const float* gdn_norm_w;
    const float* ssd_conv_w; const float* ssd_conv_b; const float* ssd_a_log; const float* ssd_dt_bias; const float* ssd_d; const float* ssd_norm_w;
    const float* ssm_w_out; const float* attn_w_qkv; const float* attn_w_o;
    const float* router_w; const float* router_bias; const float* exp_gate; const float* exp_up; const float* exp_down;
    const float* sh_gate; const float* sh_up; const float* sh_down;
    float* out; unsigned char* ws; int ph_lo, ph_hi;
};

DEV float bf2f(bf16_t v) { return __uint_as_float(((unsigned)v) << 16); }
DEV unsigned f2bf(float f) { unsigned u = __float_as_uint(f); return (u + 0x7FFFu + ((u >> 16) & 1u)) >> 16; }
DEV unsigned pk2(float lo, float hi) { return f2bf(lo) | (f2bf(hi) << 16); }
DEV float wave_sum(float v) {
#pragma unroll
    for (int o = 32; o > 0; o >>= 1) v += __shfl_xor(v, o);
    return v;
}
DEV float siluf(float x) { return x / (1.f + __expf(-x)); }
DEV float sigmoidf_(float x) { return 1.f / (1.f + __expf(-x)); }
DEV float softplusf(float x) { return fmaxf(x, 0.f) + log1pf(__expf(-fabsf(x))); }
#define LDS_WAIT() asm volatile("s_waitcnt lgkmcnt(0)" ::: "memory")
#define VM_WAIT() asm volatile("s_waitcnt vmcnt(0)" ::: "memory")

#define XB_TMO      128
#define XB_XCNT(j)  (256  + 64 * (j))
#define XB_XSUB(j)  (1280 + 64 * (j))
#define XB_XGEN(j)  (2304 + 64 * (j))
#define XB_TOP      3328
#define XB_TOPGEN   3392
#define XCD_BAR_WORDS 3456
#define XB_SPIN_CAP (1u << 18)
#define LAS __attribute__((address_space(3)))

__device__ __forceinline__ unsigned xb_ld(unsigned* p)              { return __hip_atomic_load(p, __ATOMIC_RELAXED, __HIP_MEMORY_SCOPE_AGENT); }
__device__ __forceinline__ unsigned xb_add(unsigned* p, unsigned v) { return __hip_atomic_fetch_add(p, v, __ATOMIC_RELAXED, __HIP_MEMORY_SCOPE_AGENT); }
__device__ __forceinline__ unsigned xb_xcc_id() { return (unsigned)__builtin_amdgcn_s_getreg((3 << 11) | 20) & 0xFu; }
#define XB_SPIN(cond, bar) do { unsigned _sp = 0; while (cond) { __builtin_amdgcn_s_sleep(1); \
    if ((++_sp & 255u) == 0u) { if (xb_ld(&(bar)[XB_TMO])) break; if (_sp > XB_SPIN_CAP) { atomicAdd(&(bar)[XB_TMO], 1u); break; } } } } while (0)

struct XcdBarrier {
    unsigned* bar; unsigned x;
    volatile LAS unsigned* st;
};

__device__ __forceinline__ XcdBarrier xcd_barrier_post(unsigned* bar, volatile LAS unsigned* st) {
    XcdBarrier b; b.bar = bar; b.x = xb_xcc_id(); b.st = st;
    if (threadIdx.x == 0) (void)xb_add(&bar[XB_XCNT(b.x)], 1u);
    return b;
}
__device__ __forceinline__ void xcd_barrier_complete(unsigned* bar, unsigned x, unsigned& nloc, unsigned& nx) {
    const unsigned G = gridDim.x * gridDim.y * gridDim.z;
    unsigned sum, cnt, mine, sp = 0u;
    for (;;) {
        sum = 0u; cnt = 0u; mine = 0u;
#pragma unroll
        for (unsigned j = 0; j < 16; ++j) { const unsigned c = xb_ld(&bar[XB_XCNT(j)]); sum += c; cnt += (c > 0u) ? 1u : 0u; mine = (j == x) ? c : mine; }
        if (sum == G) break;
        __builtin_amdgcn_s_sleep(1);
        if ((++sp & 255u) == 0u) { if (xb_ld(&bar[XB_TMO])) break; if (sp > XB_SPIN_CAP) { atomicAdd(&bar[XB_TMO], 1u); break; } }
    }
    nloc = mine > 0u ? mine : 1u; nx = cnt > 0u ? cnt : 1u;
}

__device__ __forceinline__ void xcd_barrier(const XcdBarrier& b) {
    asm volatile("s_waitcnt vmcnt(0)" ::: "memory");
    __syncthreads();
    if (threadIdx.x == 0) {
        unsigned* bar = b.bar;
        __builtin_amdgcn_s_waitcnt(0);
        unsigned nloc = b.st[0], nx = b.st[1];
        if (nloc == 0u) { xcd_barrier_complete(bar, b.x, nloc, nx); b.st[0] = nloc; b.st[1] = nx; }
        const unsigned old = xb_add(&bar[XB_XSUB(b.x)], 1u);
        const unsigned gen = old / nloc;
        if (old + 1u == (gen + 1u) * nloc) {
            __builtin_amdgcn_fence(__ATOMIC_RELEASE, "agent");
            asm volatile("s_waitcnt vmcnt(0)" ::: "memory");
            const unsigned og = xb_add(&bar[XB_TOP], 1u);
            const unsigned tg = og / nx;
            if (og + 1u == (tg + 1u) * nx) xb_add(&bar[XB_TOPGEN], 1u);
            else XB_SPIN(xb_ld(&bar[XB_TOPGEN]) == tg, bar);
            __builtin_amdgcn_fence(__ATOMIC_ACQUIRE, "agent");
            xb_add(&bar[XB_XGEN(b.x)], 1u);
            asm volatile("s_waitcnt vmcnt(0)" ::: "memory");
        } else {
            XB_SPIN(xb_ld(&bar[XB_XGEN(b.x)]) == gen, bar);
            __builtin_amdgcn_fence(__ATOMIC_ACQUIRE, "agent");
            asm volatile("s_waitcnt vmcnt(0)" ::: "memory");
        }
    }
    __syncthreads();
}


DEV void group_barrier(unsigned* ctr, const unsigned n) {
    asm volatile("s_waitcnt vmcnt(0)" ::: "memory");
    __syncthreads();
    if (threadIdx.x == 0) {
        __builtin_amdgcn_fence(__ATOMIC_RELEASE, "agent");
        asm volatile("s_waitcnt vmcnt(0)" ::: "memory");
        (void)__hip_atomic_fetch_add(ctr, 1u, __ATOMIC_RELAXED, __HIP_MEMORY_SCOPE_AGENT);
        unsigned sp = 0;
        while (__hip_atomic_load(ctr, __ATOMIC_RELAXED, __HIP_MEMORY_SCOPE_AGENT) < n) { __builtin_amdgcn_s_sleep(2); if (++sp > (1u << 22)) break; }
        __builtin_amdgcn_fence(__ATOMIC_ACQUIRE, "agent");
        asm volatile("s_waitcnt vmcnt(0)" ::: "memory");
    }
    __syncthreads();
}

namespace pg8 {
constexpr int BM = 256, BK = 64, HALF = 128, HTB = HALF * BK * 2, STAGE_BYTES = 8 * HTB, NXCD = 8, WGM = 8;
DEV int lds_byte(int r, int c) { const int st = (r >> 4) * 2 + (c >> 5), rr = r & 15, cc = c & 31, ob = rr * 64 + cc * 2; return st * 1024 + (ob ^ (((ob >> 9) & 1) << 5)); }
DEV void stage_rc(int b, int& R, int& C) { const int st = b / 1024, sb = b % 1024, swz = sb ^ (((sb >> 9) & 1) << 5); R = (st >> 1) * 16 + swz / 64; C = (st & 1) * 32 + (swz % 64) / 2; }
DEV int perm32(int rho) { const int n = rho >> 4, i = rho & 15; return 8 * (i >> 2) + 4 * n + (i & 3); }
struct Unit { int pm, pn, e, slot; };
struct StaticOrder {
    int nM, nN, nwg, G, c;
    DEV void init(int M, int N, int G_, int c_) { nM = M / BM; nN = N / BM; nwg = nM * nN; G = G_; c = c_; }
    DEV bool next(int i, int& pm, int& pn) const {
        const long L = (long)i * G + c; if (L >= nwg) return false;
        int wgid = (int)L; { const int q = nwg / NXCD, r = nwg % NXCD, xcd = wgid % NXCD, off = wgid / NXCD; wgid = (xcd < r ? xcd * (q + 1) : r * (q + 1) + (xcd - r) * q) + off; }
        const int nig = WGM * nN, gid = wgid / nig, fm = gid * WGM, gsz = (nM - fm) < WGM ? (nM - fm) : WGM;
        pm = fm + ((wgid % nig) % gsz); pn = (wgid % nig) / gsz; return true;
    }
};
typedef __bf16 bf16x2_t __attribute__((ext_vector_type(2)));
DEV unsigned cvt_pk_bf16(float lo, float hi) { const bf16x2_t v = {(__bf16)lo, (__bf16)hi}; return __builtin_bit_cast(unsigned, v); }
DEV u32x4 pack8(const f32x4 a, const f32x4 b) { u32x4 w; w.x = cvt_pk_bf16(a[0], a[1]); w.y = cvt_pk_bf16(a[2], a[3]); w.z = cvt_pk_bf16(b[0], b[1]); w.w = cvt_pk_bf16(b[2], b[3]); return w; }

template <class Epi, class Sched>
DEV void gemm_phase(LAS unsigned char* lds, const int K, const Sched& S, const Epi& E) {
    const int tid = threadIdx.x, wid = __builtin_amdgcn_readfirstlane(tid >> 6), lane = tid & 63, wr = wid >> 2, wc = wid & 3, fr = lane & 15, fq = lane >> 4;
    const int nt = K / BK;
    unsigned voffB[2];
#pragma unroll
    for (int i = 0; i < 2; ++i) { int R, C; stage_rc(tid * 16 + i * 8192, R, C); const int Rb = Epi::PERM ? ((R & ~31) + perm32(R & 31)) : R; voffB[i] = (unsigned)(Rb * K + C) * 2u; }
    const unsigned kstep = (unsigned)(BK * 2);
    const size_t hstep = (size_t)HALF * K * 2;
    const unsigned ldsw = (unsigned)wid * 1024u;
    const int aoff = lds_byte(wr * 64 + fr, fq * 8), boff = lds_byte(wc * 32 + fr, fq * 8);
    const size_t hsA = Sched::GATHER ? (size_t)0 : hstep;
#define PG8_SA(b, h) (((b) * 2 + (h)) * HTB)
#define PG8_SB(b, h) ((4 + (b) * 2 + (h)) * HTB)
#define PG8_STAGEB(bufoff, gbase) do { _Pragma("unroll") for (int _i = 0; _i < 2; ++_i) \
        __builtin_amdgcn_global_load_lds((const unsigned*)((const char*)(gbase) + voffB[_i]), (LAS unsigned*)(lds + (bufoff) + ldsw + _i * 8192), 16, 0, 0); } while (0)
#define PG8_STAGEA(bufoff, gbase, VO) do { _Pragma("unroll") for (int _i = 0; _i < 2; ++_i) \
        __builtin_amdgcn_global_load_lds((const unsigned*)((const char*)(gbase) + (VO)[_i]), (LAS unsigned*)(lds + (bufoff) + ldsw + _i * 8192), 16, 0, 0); } while (0)
#define PG8_LDA(dst, b, h) do { _Pragma("unroll") for (int m = 0; m < 4; ++m) _Pragma("unroll") for (int k = 0; k < 2; ++k) dst[m][k] = *(const LAS bf16x8*)(lds + PG8_SA(b, h) + aoff + m * 2048 + k * 1024); } while (0)
#define PG8_LDB(dst, b, h) do { _Pragma("unroll") for (int n = 0; n < 2; ++n) _Pragma("unroll") for (int k = 0; k < 2; ++k) dst[n][k] = *(const LAS bf16x8*)(lds + PG8_SB(b, h) + boff + n * 2048 + k * 1024); } while (0)
#define PG8_MMA(ai, bj, At, Bt) do { __builtin_amdgcn_s_setprio(1); _Pragma("unroll") for (int m = 0; m < 4; ++m) _Pragma("unroll") for (int n = 0; n < 2; ++n) _Pragma("unroll") for (int k = 0; k < 2; ++k) \
        acc[ai][bj][m][n] = __builtin_amdgcn_mfma_f32_16x16x32_bf16(Bt[n][k], At[m][k], acc[ai][bj][m][n], 0, 0, 0); __builtin_amdgcn_s_setprio(0); } while (0)
#define PG8_WAIT_V(n) asm volatile("s_waitcnt vmcnt(" #n ")" ::: "memory")
#define PG8_WAIT_L(n) asm volatile("s_waitcnt lgkmcnt(" #n ")" ::: "memory")
#define PG8_BAR __builtin_amdgcn_s_barrier()
#define PG8_SCHED __builtin_amdgcn_sched_barrier(0)
    Unit cur, nxt; int ui = 0;
    if (!S.next(0, cur)) return;
    f32x4 acc[2][2][4][2];
#pragma unroll
    for (int a = 0; a < 2; ++a)
#pragma unroll
        for (int b = 0; b < 2; ++b)
#pragma unroll
            for (int m = 0; m < 4; ++m)
#pragma unroll
                for (int n = 0; n < 2; ++n) acc[a][b][m][n] = (f32x4){0.f, 0.f, 0.f, 0.f};
    bf16x8 At[4][2], B0[2][2], B1[2][2];
    unsigned va[2][2];
    S.a_voff(cur, tid, va);
    const char* cA = S.a_ptr(cur);
    const char* cB = S.b_ptr(cur);
    PG8_STAGEB(PG8_SB(0, 0), cB); PG8_STAGEB(PG8_SB(0, 1), cB + hstep); PG8_STAGEA(PG8_SA(0, 0), cA, va[0]); PG8_STAGEA(PG8_SA(0, 1), cA + hsA, va[1]);
    if (wr == 1) PG8_BAR;
    PG8_WAIT_V(2); PG8_BAR;
    PG8_STAGEB(PG8_SB(1, 0), cB + kstep); PG8_STAGEA(PG8_SA(1, 0), cA + kstep, va[0]); PG8_STAGEB(PG8_SB(1, 1), cB + hstep + kstep);
    PG8_WAIT_V(6); PG8_BAR;
    for (;;) {
        const bool has_next = S.next(ui + 1, nxt);
        const char* nB = has_next ? S.b_ptr(nxt) : cB;
        const char* nA = has_next ? S.a_ptr(nxt) : cA;
        for (int t = 0; t < nt; t += 2) {
            const bool last = (t == nt - 2);
            const char* a1 = cA + (size_t)(t + 1) * kstep;
            const char* a2 = last ? nA : cA + (size_t)(t + 2) * kstep; const char* a3 = a2 + kstep;
            unsigned v2[2][2];
            v2[0][0] = va[0][0]; v2[0][1] = va[0][1]; v2[1][0] = va[1][0]; v2[1][1] = va[1][1];
            if constexpr (Sched::GATHER) { if (last && has_next) S.a_voff(nxt, tid, v2); }
            const char* b2 = last ? nB : cB + (size_t)(t + 2) * kstep; const char* b3 = b2 + kstep;
            PG8_LDB(B0, 0, 0); PG8_LDB(B1, 0, 1); PG8_SCHED; PG8_LDA(At, 0, 0); PG8_STAGEA(PG8_SA(1, 1), a1 + hsA, va[1]);
            PG8_WAIT_V(8); PG8_WAIT_L(0); PG8_BAR; PG8_MMA(0, 0, At, B0); PG8_MMA(0, 1, At, B1); PG8_BAR; PG8_SCHED;
            PG8_LDA(At, 0, 1); PG8_STAGEB(PG8_SB(0, 0), b2); PG8_STAGEB(PG8_SB(0, 1), b2 + hstep); PG8_STAGEA(PG8_SA(0, 0), a2, v2[0]);
            PG8_WAIT_V(8); PG8_WAIT_L(0); PG8_BAR; PG8_MMA(1, 0, At, B0); PG8_MMA(1, 1, At, B1); PG8_BAR; PG8_SCHED;
            PG8_LDB(B0, 1, 0); PG8_LDB(B1, 1, 1); PG8_SCHED; PG8_LDA(At, 1, 0); PG8_STAGEA(PG8_SA(0, 1), a2 + hsA, v2[1]);
            PG8_WAIT_V(8); PG8_WAIT_L(0); PG8_BAR; PG8_MMA(0, 0, At, B0); PG8_MMA(0, 1, At, B1); PG8_BAR; PG8_SCHED;
            PG8_LDA(At, 1, 1); PG8_STAGEB(PG8_SB(1, 0), b3); PG8_STAGEB(PG8_SB(1, 1), b3 + hstep); PG8_STAGEA(PG8_SA(1, 0), a3, v2[0]);
            PG8_WAIT_V(8); PG8_WAIT_L(0); PG8_BAR; PG8_MMA(1, 0, At, B0); PG8_MMA(1, 1, At, B1); PG8_BAR; PG8_SCHED;
        }
        if (wr == 0) PG8_BAR;
        E(acc, cur, wr, wc, fr, fq);
        if (!has_next) break;
#pragma unroll
        for (int a = 0; a < 2; ++a)
#pragma unroll
            for (int b = 0; b < 2; ++b)
#pragma unroll
                for (int m = 0; m < 4; ++m)
#pragma unroll
                    for (int n = 0; n < 2; ++n) acc[a][b][m][n] = (f32x4){0.f, 0.f, 0.f, 0.f};
        cur = nxt; cB = nB; cA = nA; ++ui;
        if constexpr (Sched::GATHER) S.a_voff(cur, tid, va);
        if (wr == 1) PG8_BAR;
    }
    PG8_WAIT_V(0);
    PG8_BAR;
#undef PG8_SA
#undef PG8_SB
#undef PG8_STAGEA
#undef PG8_STAGEB
#undef PG8_LDA
#undef PG8_LDB
#undef PG8_MMA
#undef PG8_WAIT_V
#undef PG8_WAIT_L
#undef PG8_BAR
#undef PG8_SCHED
}

struct SchedDense {
    static constexpr bool GATHER = false;
    StaticOrder so; const char* A; const char* Bt; int K; int pad_;
    DEV bool next(int i, Unit& u) const { int pm, pn; if (!so.next(i, pm, pn)) return false; u.pm = pm; u.pn = pn; u.e = 0; u.slot = 0; return true; }
    DEV const char* a_ptr(const Unit& u) const { return A + (size_t)u.pm * 256 * K * 2; }
    DEV void a_voff(const Unit&, const int tid, unsigned (&vo)[2][2]) const {
#pragma unroll
        for (int i = 0; i < 2; ++i) { int R, C; stage_rc(tid * 16 + i * 8192, R, C); vo[0][i] = vo[1][i] = (unsigned)((R * K + C) * 2); }
    }
    DEV const char* b_ptr(const Unit& u) const { return Bt + (size_t)u.pn * 256 * K * 2; }
};
DEV bool moe_unit(int i, int NJ, int nrbt, int G, int c, Unit& u) {
    const int n = (nrbt + 64) * NJ; int L;
    if (G & 7) { L = i * G + c; if (L >= n) return false; }
    else { const int gq = G >> 3, per = (n + 7) >> 3, x = c & 7, q = c >> 3, j = i * gq + q; if (j >= per) return false; L = x * per + j; if (L >= n) return false; }
    int grb = L / NJ; const int pn = L - grb * NJ; if (grb >= nrbt) grb = SH_RB + (grb - nrbt);
    u.pm = grb; u.pn = pn; u.slot = i; u.e = 0; return true;
}
struct SchedGU {
    static constexpr bool GATHER = true;
    const char* A; const char* Wgu; const char* Wgus; const LAS int* eofrb; const LAS int* toks; int nrbt, G, c, pad_;
    DEV bool next(int i, Unit& u) const { if (!moe_unit(i, 2, nrbt, G, c, u)) return false; u.e = __builtin_amdgcn_readfirstlane(eofrb[u.pm]); return true; }
    DEV const char* a_ptr(const Unit&) const { return A; }
    DEV void a_voff(const Unit& u, const int tid, unsigned (&vo)[2][2]) const {
#pragma unroll
        for (int i = 0; i < 2; ++i) { int R, C; stage_rc(tid * 16 + i * 8192, R, C);
#pragma unroll
            for (int h = 0; h < 2; ++h) { const int tok = toks[u.slot * 256 + h * 128 + R]; vo[h][i] = (unsigned)((tok * D + C) * 2); } }
    }
    DEV const char* b_ptr(const Unit& u) const { return (u.e < NE ? Wgu + (size_t)u.e * 512 * D * 2 : Wgus) + (size_t)u.pn * 256 * D * 2; }
};
struct SchedDown {
    static constexpr bool GATHER = false;
    const char* A; const char* Wd; const char* Wds; const LAS int* eofrb; int nrbt, G, c, pad_;
    DEV bool next(int i, Unit& u) const { if (!moe_unit(i, 4, nrbt, G, c, u)) return false; u.e = __builtin_amdgcn_readfirstlane(eofrb[u.pm]); return true; }
    DEV const char* a_ptr(const Unit& u) const { return A + (size_t)u.pm * 256 * ED * 2; }
    DEV void a_voff(const Unit&, const int tid, unsigned (&vo)[2][2]) const {
#pragma unroll
        for (int i = 0; i < 2; ++i) { int R, C; stage_rc(tid * 16 + i * 8192, R, C); vo[0][i] = vo[1][i] = (unsigned)((R * ED + C) * 2); }
    }
    DEV const char* b_ptr(const Unit& u) const { return (u.e < NE ? Wd + (size_t)u.e * D * ED * 2 : Wds) + (size_t)u.pn * 256 * ED * 2; }
};

struct EpiProj {
    static constexpr bool PERM = true;
    bf16_t* qkv; bf16_t* za; bf16_t* xbc; bf16_t* zb; float* small;
    DEV void operator()(const f32x4 (&acc)[2][2][4][2], const Unit& u, int wr, int wc, int fr, int fq) const {
        const int row0 = u.pm * BM + wr * 64 + fr, pn = u.pn;
        if (pn == 26) {
            if (wc == 0) {
#pragma unroll
                for (int ai = 0; ai < 2; ++ai)
#pragma unroll
                    for (int m = 0; m < 4; ++m) { float* p = small + (size_t)(row0 + ai * HALF + m * 16) * 32 + 8 * fq; *(f32x4*)p = acc[ai][0][m][0]; *(f32x4*)(p + 4) = acc[ai][0][m][1]; }
            }
            return;
        }
        bf16_t* base; int ldc, ct;
        if (pn < 12) { base = qkv; ldc = 3072; ct = pn; } else if (pn < 16) { base = za; ldc = 1024; ct = pn - 12; } else if (pn < 22) { base = xbc; ldc = 1536; ct = pn - 16; } else { base = zb; ldc = 1024; ct = pn - 22; }
        const int col0 = ct * 256 + wc * 32 + 8 * fq;
#pragma unroll
        for (int ai = 0; ai < 2; ++ai)
#pragma unroll
            for (int m = 0; m < 4; ++m) { bf16_t* rowp = base + (size_t)(row0 + ai * HALF + m * 16) * ldc + col0;
#pragma unroll
                for (int bj = 0; bj < 2; ++bj) *(u32x4*)(rowp + bj * HALF) = pack8(acc[ai][bj][m][0], acc[ai][bj][m][1]); }
    }
};
struct EpiF32 {
    static constexpr bool PERM = false;
    float* Cp; int ldc; int pad_;
    DEV void operator()(const f32x4 (&acc)[2][2][4][2], const Unit& u, int wr, int wc, int fr, int fq) const {
        const int row0 = u.pm * BM + wr * 64 + fr, col0 = u.pn * BM + wc * 32 + 4 * fq;
#pragma unroll
        for (int ai = 0; ai < 2; ++ai)
#pragma unroll
            for (int m = 0; m < 4; ++m) { float* rowp = Cp + (size_t)(row0 + ai * HALF + m * 16) * ldc + col0;
#pragma unroll
                for (int bj = 0; bj < 2; ++bj)
#pragma unroll
                    for (int n = 0; n < 2; ++n) *(f32x4*)(rowp + bj * HALF + n * 16) = acc[ai][bj][m][n]; }
    }
};
struct EpiBf16 {
    static constexpr bool PERM = true;
    bf16_t* O; int ldc; int pad_;
    DEV void operator()(const f32x4 (&acc)[2][2][4][2], const Unit& u, int wr, int wc, int fr, int fq) const {
        const int row0 = u.pm * BM + wr * 64 + fr, col0 = u.pn * BM + wc * 32 + 8 * fq;
#pragma unroll
        for (int ai = 0; ai < 2; ++ai)
#pragma unroll
            for (int m = 0; m < 4; ++m) { bf16_t* rowp = O + (size_t)(row0 + ai * HALF + m * 16) * ldc + col0;
#pragma unroll
                for (int bj = 0; bj < 2; ++bj) *(u32x4*)(rowp + bj * HALF) = pack8(acc[ai][bj][m][0], acc[ai][bj][m][1]); }
    }
};
struct EpiFp8 {
    static constexpr bool PERM = true;
    unsigned char* O; int ldc; int pad_;
    DEV void operator()(const f32x4 (&acc)[2][2][4][2], const Unit& u, int wr, int wc, int fr, int fq) const {
        const int row0 = u.pm * BM + wr * 64 + fr, col0 = u.pn * BM + wc * 32 + 8 * fq;
#pragma unroll
        for (int ai = 0; ai < 2; ++ai)
#pragma unroll
            for (int m = 0; m < 4; ++m) { unsigned char* rowp = O + (size_t)(row0 + ai * HALF + m * 16) * ldc + col0;
#pragma unroll
                for (int bj = 0; bj < 2; ++bj) { f32x4 a0 = acc[ai][bj][m][0] * 8.f, a1 = acc[ai][bj][m][1] * 8.f;
#pragma unroll
                    for (int i = 0; i < 4; ++i) { a0[i] = fminf(fmaxf(a0[i], -440.f), 440.f); a1[i] = fminf(fmaxf(a1[i], -440.f), 440.f); }
                    int w0 = __builtin_amdgcn_cvt_pk_fp8_f32(a0[0], a0[1], 0, false); w0 = __builtin_amdgcn_cvt_pk_fp8_f32(a0[2], a0[3], w0, true);
                    int w1 = __builtin_amdgcn_cvt_pk_fp8_f32(a1[0], a1[1], 0, false); w1 = __builtin_amdgcn_cvt_pk_fp8_f32(a1[2], a1[3], w1, true);
                    *(u32x2*)(rowp + bj * HALF) = (u32x2){(unsigned)w0, (unsigned)w1}; } }
    }
};
struct EpiGU {
    static constexpr bool PERM = true;
    bf16_t* H;
    DEV void operator()(const f32x4 (&acc)[2][2][4][2], const Unit& u, int wr, int wc, int fr, int fq) const {
        const int row0 = u.pm * BM + wr * 64 + fr, col0 = u.pn * HALF + wc * 32 + 8 * fq;
#pragma unroll
        for (int ai = 0; ai < 2; ++ai)
#pragma unroll
            for (int m = 0; m < 4; ++m) {
                f32x4 h0, h1;
#pragma unroll
                for (int i = 0; i < 4; ++i) { h0[i] = siluf(acc[ai][0][m][0][i]) * acc[ai][1][m][0][i]; h1[i] = siluf(acc[ai][0][m][1][i]) * acc[ai][1][m][1][i]; }
                *(u32x4*)(H + (size_t)(row0 + ai * HALF + m * 16) * ED + col0) = pack8(h0, h1);
            }
    }
};
struct EpiQKV {
    static constexpr bool PERM = true;
    bf16_t* O; const float* cosT; const float* sinT;
    DEV void operator()(const f32x4 (&acc)[2][2][4][2], const Unit& u, int wr, int wc, int fr, int fq) const {
        const int row0 = u.pm * BM + wr * 64 + fr, col0 = u.pn * BM + wc * 32 + 8 * fq;
        const bool rope = u.pn < 8; const float qs = u.pn < 4 ? 0.125f : 1.f;
#pragma unroll
        for (int ai = 0; ai < 2; ++ai)
#pragma unroll
            for (int m = 0; m < 4; ++m) {
                const int row = row0 + ai * HALF + m * 16;
                bf16_t* rowp = O + (size_t)row * 3072 + col0;
                if (rope) {
                    const f32x4 cs = *(const f32x4*)(cosT + (size_t)row * 32 + 16 * (wc & 1) + 4 * fq), sn = *(const f32x4*)(sinT + (size_t)row * 32 + 16 * (wc & 1) + 4 * fq);
#pragma unroll
                    for (int bj = 0; bj < 2; ++bj) { const f32x4 x1 = acc[ai][bj][m][0], x2 = acc[ai][bj][m][1];
                        *(u32x4*)(rowp + bj * HALF) = pack8((x1 * cs - x2 * sn) * qs, (x2 * cs + x1 * sn) * qs); }
                } else {
#pragma unroll
                    for (int bj = 0; bj < 2; ++bj) *(u32x4*)(rowp + bj * HALF) = pack8(acc[ai][bj][m][0], acc[ai][bj][m][1]);
                }
            }
    }
};
}

template <class SrcF>
DEV void conv_item(const SrcF& src, int ldw, int K, bf16_t* dst, LAS float* scr, int item, int nblk, int lane) {
    const int kb = item / nblk, nb = item - kb * nblk, k0 = 64 * kb, n0 = 32 * nb;
    const int quad = lane & 7, r0 = lane >> 3;
    const float* colp = src(n0 + 4 * quad);
    f32x4 v[8];
#pragma unroll
    for (int i = 0; i < 8; ++i) v[i] = colp ? *(const f32x4*)(colp + (size_t)(k0 + r0 + 8 * i) * ldw) : (f32x4){0.f, 0.f, 0.f, 0.f};
#pragma unroll
    for (int i = 0; i < 8; ++i) { LAS float* p = scr + (r0 + 8 * i) * 33 + 4 * quad; p[0] = v[i][0]; p[1] = v[i][1]; p[2] = v[i][2]; p[3] = v[i][3]; }
    LDS_WAIT(); asm volatile("" ::: "memory");
    const int c = lane & 7;
#pragma unroll
    for (int j = 0; j < 4; ++j) { const int n = (lane >> 3) + 8 * j; const LAS float* s = scr + (8 * c) * 33 + n;
        u32x4 o; o.x = pk2(s[0 * 33], s[1 * 33]); o.y = pk2(s[2 * 33], s[3 * 33]); o.z = pk2(s[4 * 33], s[5 * 33]); o.w = pk2(s[6 * 33], s[7 * 33]);
        *(u32x4*)(dst + (size_t)(n0 + n) * K + k0 + 8 * c) = o; }
    LDS_WAIT(); asm volatile("" ::: "memory");
}
struct SrcIdent { const float* W; DEV const float* operator()(int n) const { return W + n; } };
struct SrcWin { const float* W; DEV const float* operator()(int n) const {
    int s; if (n < 4096) s = n; else if (n < 5632) s = C_XBC + (n - 4096); else if (n < 6656) s = C_ZB + (n - 5632); else if (n < 6672) s = C_BETA + (n - 6656); else if (n < 6688) s = C_DT + (n - 6672); else return nullptr;
    return W + s; } };
struct SrcQKV { const float* W; DEV const float* operator()(int n) const {
    if (n >= 2048) return W + n; const int hd = n >> 6, cp = n & 63; return W + hd * 64 + 32 * ((cp >> 2) & 1) + 16 * (cp >> 5) + 4 * ((cp >> 3) & 3) + (cp & 3); } };
struct SrcGU { const float* Wg; long du; DEV const float* operator()(int r) const { const int j = r >> 8, rr = r & 255; return Wg + (rr < 128 ? 0l : du) + 128 * j + (rr & 127); } };

DEV void load_row(const float* p, int lane, float (&v)[16]) {
#pragma unroll
    for (int j = 0; j < 4; ++j) { const f32x4 t = *(const f32x4*)(p + j * 256 + lane * 4); v[4 * j] = t[0]; v[4 * j + 1] = t[1]; v[4 * j + 2] = t[2]; v[4 * j + 3] = t[3]; }
}
DEV void store_row(float* p, int lane, const float (&v)[16]) {
#pragma unroll
    for (int j = 0; j < 4; ++j) *(f32x4*)(p + j * 256 + lane * 4) = (f32x4){v[4 * j], v[4 * j + 1], v[4 * j + 2], v[4 * j + 3]};
}
DEV float row_rstd(const float (&v)[16]) { float ss = 0.f;
#pragma unroll
    for (int i = 0; i < 16; ++i) ss += v[i] * v[i];
    return rsqrtf(wave_sum(ss) * (1.f / D) + EPS); }
DEV void resid_update(float (&xv)[16], const float (&yv)[16], const float* gpost, const float* gt, int lane) {
    const float r = row_rstd(yv);
#pragma unroll
    for (int j = 0; j < 4; ++j) { const f32x4 g = *(const f32x4*)(gpost + j * 256 + lane * 4), t = *(const f32x4*)(gt + j * 256 + lane * 4);
#pragma unroll
        for (int i = 0; i < 4; ++i) xv[4 * j + i] += t[i] * (yv[4 * j + i] * r * g[i]); }
}
DEV void prenorm_pack(const float (&xv)[16], const float* gpre, const float* sc, const float* sh, int lane, u32x2 (&o)[4]) {
    const float r = row_rstd(xv);
#pragma unroll
    for (int j = 0; j < 4; ++j) { const f32x4 g = *(const f32x4*)(gpre + j * 256 + lane * 4), s = *(const f32x4*)(sc + j * 256 + lane * 4), b = *(const f32x4*)(sh + j * 256 + lane * 4);
        float h[4];
#pragma unroll
        for (int i = 0; i < 4; ++i) h[i] = xv[4 * j + i] * r * g[i] * (1.f + s[i]) + b[i];
        o[j] = (u32x2){pk2(h[0], h[1]), pk2(h[2], h[3])}; }
}

DEV void load_row8(const float* p, int lane, float (&v)[16]) {
#pragma unroll
    for (int j = 0; j < 2; ++j)
#pragma unroll
        for (int hh = 0; hh < 2; ++hh) { const f32x4 t = *(const f32x4*)(p + 512 * j + 8 * lane + 4 * hh); v[8 * j + 4 * hh] = t[0]; v[8 * j + 4 * hh + 1] = t[1]; v[8 * j + 4 * hh + 2] = t[2]; v[8 * j + 4 * hh + 3] = t[3]; }
}
DEV void store_row8(float* p, int lane, const float (&v)[16]) {
#pragma unroll
    for (int j = 0; j < 2; ++j)
#pragma unroll
        for (int hh = 0; hh < 2; ++hh) *(f32x4*)(p + 512 * j + 8 * lane + 4 * hh) = (f32x4){v[8 * j + 4 * hh], v[8 * j + 4 * hh + 1], v[8 * j + 4 * hh + 2], v[8 * j + 4 * hh + 3]};
}
DEV void resid_update8(float (&xv)[16], const float (&yv)[16], const float* gpost, const float* gt, int lane) {
    const float r = row_rstd(yv);
#pragma unroll
    for (int j = 0; j < 2; ++j)
#pragma unroll
        for (int hh = 0; hh < 2; ++hh) { const f32x4 g = *(const f32x4*)(gpost + 512 * j + 8 * lane + 4 * hh), t = *(const f32x4*)(gt + 512 * j + 8 * lane + 4 * hh);
#pragma unroll
            for (int i = 0; i < 4; ++i) xv[8 * j + 4 * hh + i] += t[i] * (yv[8 * j + 4 * hh + i] * r * g[i]); }
}
DEV void prenorm_pack8(const float (&xv)[16], const float* gpre, const float* sc, const float* sh, int lane, u32x4 (&o)[2]) {
    const float r = row_rstd(xv);
#pragma unroll
    for (int j = 0; j < 2; ++j) { float h[8];
#pragma unroll
        for (int hh = 0; hh < 2; ++hh) { const f32x4 g = *(const f32x4*)(gpre + 512 * j + 8 * lane + 4 * hh), s = *(const f32x4*)(sc + 512 * j + 8 * lane + 4 * hh), b = *(const f32x4*)(sh + 512 * j + 8 * lane + 4 * hh);
#pragma unroll
            for (int i = 0; i < 4; ++i) h[4 * hh + i] = xv[8 * j + 4 * hh + i] * r * g[i] * (1.f + s[i]) + b[i]; }
        o[j] = (u32x4){pk2(h[0], h[1]), pk2(h[2], h[3]), pk2(h[4], h[5]), pk2(h[6], h[7])}; }
}
DEV void acc_row8(float (&yv)[16], const u32x2 w0, const u32x2 w1, const float g) {
#pragma unroll
    for (int e = 0; e < 2; ++e) {
        yv[4 * e] += g * __builtin_amdgcn_cvt_f32_fp8((int)w0[e], 0); yv[4 * e + 1] += g * __builtin_amdgcn_cvt_f32_fp8((int)w0[e], 1); yv[4 * e + 2] += g * __builtin_amdgcn_cvt_f32_fp8((int)w0[e], 2); yv[4 * e + 3] += g * __builtin_amdgcn_cvt_f32_fp8((int)w0[e], 3);
        yv[8 + 4 * e] += g * __builtin_amdgcn_cvt_f32_fp8((int)w1[e], 0); yv[8 + 4 * e + 1] += g * __builtin_amdgcn_cvt_f32_fp8((int)w1[e], 1); yv[8 + 4 * e + 2] += g * __builtin_amdgcn_cvt_f32_fp8((int)w1[e], 2); yv[8 + 4 * e + 3] += g * __builtin_amdgcn_cvt_f32_fp8((int)w1[e], 3); }
}

DEV void load_row_bf(const bf16_t* p, int lane, float (&v)[16]) {
#pragma unroll
    for (int j = 0; j < 4; ++j) { const u32x2 w = *(const u32x2*)(p + j * 256 + lane * 4); v[4 * j] = __uint_as_float(w.x << 16); v[4 * j + 1] = __uint_as_float(w.x & 0xFFFF0000u); v[4 * j + 2] = __uint_as_float(w.y << 16); v[4 * j + 3] = __uint_as_float(w.y & 0xFFFF0000u); }
}
DEV void store_row_bf(bf16_t* p, int lane, const float (&v)[16]) {
#pragma unroll
    for (int j = 0; j < 4; ++j) *(u32x2*)(p + j * 256 + lane * 4) = (u32x2){pk2(v[4 * j], v[4 * j + 1]), pk2(v[4 * j + 2], v[4 * j + 3])};
}
DEV void load_row8_bf(const bf16_t* p, int lane, float (&v)[16]) {
#pragma unroll
    for (int j = 0; j < 2; ++j) { const u32x4 w = *(const u32x4*)(p + 512 * j + 8 * lane);
#pragma unroll
        for (int e = 0; e < 4; ++e) { v[8 * j + 2 * e] = __uint_as_float(w[e] << 16); v[8 * j + 2 * e + 1] = __uint_as_float(w[e] & 0xFFFF0000u); } }
}
DEV void store_row8_bf(bf16_t* p, int lane, const float (&v)[16]) {
#pragma unroll
    for (int j = 0; j < 2; ++j) *(u32x4*)(p + 512 * j + 8 * lane) = (u32x4){pk2(v[8 * j], v[8 * j + 1]), pk2(v[8 * j + 2], v[8 * j + 3]), pk2(v[8 * j + 4], v[8 * j + 5]), pk2(v[8 * j + 6], v[8 * j + 7])};
}

struct Ctx { LAS unsigned char* lds; int tid, lane, wave, G, bid; };

DEV void ph_setup(const Args& a, const Ctx& X) {
    unsigned char* ws = a.ws;
    float* mod = (float*)(ws + WS_MOD);
    { LAS float* red = (LAS float*)X.lds;
      LAS float* sc = (LAS float*)(X.lds + 8192);
      for (int i = X.tid; i < NB * D; i += NTHR) sc[i] = siluf(a.c[i]);
      __syncthreads();
      const int kc = X.tid >> 6, cl = X.tid & 63;
      for (int task = X.bid; task < 2 * 96; task += X.G) {
          const int l = task / 96, col = (task % 96) * 64 + cl;
          const float* w = a.mod_w + (size_t)l * D * 6 * D + col;
          float p0 = 0.f, p1 = 0.f, p2 = 0.f, p3 = 0.f;
#pragma unroll 16
          for (int k = kc * 128; k < kc * 128 + 128; ++k) { const float wv = w[(size_t)k * 6 * D];
              p0 += sc[k] * wv; p1 += sc[D + k] * wv; p2 += sc[2 * D + k] * wv; p3 += sc[3 * D + k] * wv; }
          __syncthreads();
          red[(kc * 4 + 0) * 64 + cl] = p0; red[(kc * 4 + 1) * 64 + cl] = p1; red[(kc * 4 + 2) * 64 + cl] = p2; red[(kc * 4 + 3) * 64 + cl] = p3;
          __syncthreads();
          if (X.tid < 256) { const int b = X.tid >> 6; float s = a.mod_b[l * 6 * D + col];
#pragma unroll
              for (int q = 0; q < 8; ++q) s += red[(q * 4 + b) * 64 + cl];
              mod[(size_t)(l * NB + b) * 6 * D + col] = s; }
      }
      __syncthreads(); }
    { LAS float* scr = (LAS float*)(X.lds + X.wave * 8704);
      const int gw = X.bid * NWAVES + X.wave, NGW = X.G * NWAVES;
      constexpr int I_IN = (D / 64) * (NPROJ / 32);
      for (int it = gw; it < I_IN; it += NGW) conv_item(SrcWin{a.ssm_w_in}, PROJ, D, (bf16_t*)(ws + WS_WIN), scr, it, NPROJ / 32, X.lane);
    }
}
DEV void ph_setup_late(const Args& a, const Ctx& X, const int wg0) {
    unsigned char* ws = a.ws;
    { float* cosT = (float*)(ws + WS_COS); float* sinT = (float*)(ws + WS_SIN);
      for (int idx = (X.bid - wg0) * NTHR + X.tid; idx < T * 32; idx += (X.G - wg0) * NTHR) { const int t = idx >> 5, i = idx & 31;
          const float ang = (float)a.pos[t] * powf(10000.f, -(float)i / 32.f); float sn, cs; sincosf(ang, &sn, &cs); cosT[idx] = cs; sinT[idx] = sn; } }
    { LAS float* scr = (LAS float*)(X.lds + X.wave * 8704);
      const int gw = (X.bid - wg0) * NWAVES + X.wave, NGW = (X.G - wg0) * NWAVES;
      constexpr int I_OUT = (2048 / 64) * (D / 32), I_QKV = (D / 64) * (3072 / 32), I_O = (D / 64) * (D / 32);
      for (int it = gw; it < I_OUT + I_QKV + I_O; it += NGW) {
          int r = it;
          if (r < I_OUT) { conv_item(SrcIdent{a.ssm_w_out}, D, 2048, (bf16_t*)(ws + WS_WOUT), scr, r, D / 32, X.lane); continue; } r -= I_OUT;
          if (r < I_QKV) { conv_item(SrcQKV{a.attn_w_qkv}, 3072, D, (bf16_t*)(ws + WS_WQKV), scr, r, 3072 / 32, X.lane); continue; } r -= I_QKV;
          conv_item(SrcIdent{a.attn_w_o}, D, D, (bf16_t*)(ws + WS_WO), scr, r, D / 32, X.lane);
      } }
}

DEV void ph_prenorm0(const Args& a, const Ctx& X) {
    const float* mod = (const float*)(a.ws + WS_MOD);
    bf16_t* hb = (bf16_t*)(a.ws + WS_H);
    for (int row = X.bid * NWAVES + X.wave; row < T; row += X.G * NWAVES) {
        const int b = row / SEQ; const float* ml = mod + (size_t)b * 6 * D;
        float xv[16]; load_row(a.x + (size_t)row * D, X.lane, xv);
        u32x2 o[4]; prenorm_pack(xv, a.mix_pre_g, ml + D, ml, X.lane, o);
#pragma unroll
        for (int j = 0; j < 4; ++j) *(u32x2*)(hb + (size_t)row * D + j * 256 + X.lane * 4) = o[j];
    }
}

DEV bf16x8 acc_to_frag(const f32x4 lo, const f32x4 hi) { u32x4 w; w.x = pg8::cvt_pk_bf16(lo[0], lo[1]); w.y = pg8::cvt_pk_bf16(lo[2], lo[3]); w.z = pg8::cvt_pk_bf16(hi[0], hi[1]); w.w = pg8::cvt_pk_bf16(hi[2], hi[3]); return __builtin_bit_cast(bf16x8, w); }

DEV void gdn_solve(LAS float* M, LAS unsigned short* tf, const int lane) {
    for (int rb = 0; rb < 16; ++rb) {
        const int i0 = 4 * rb;
        float a0 = (lane == i0) ? 1.f : 0.f, a1 = (lane == i0 + 1) ? 1.f : 0.f, a2 = (lane == i0 + 2) ? 1.f : 0.f, a3 = (lane == i0 + 3) ? 1.f : 0.f;
        for (int j = 0; j < i0; j += 4) {
            const float t0 = M[j * 64 + lane], t1 = M[(j + 1) * 64 + lane], t2 = M[(j + 2) * 64 + lane], t3 = M[(j + 3) * 64 + lane];
            const f32x4 r0 = *(const LAS f32x4*)(M + i0 * 64 + j), r1 = *(const LAS f32x4*)(M + (i0 + 1) * 64 + j), r2 = *(const LAS f32x4*)(M + (i0 + 2) * 64 + j), r3 = *(const LAS f32x4*)(M + (i0 + 3) * 64 + j);
            a0 -= r0[0] * t0 + r0[1] * t1 + r0[2] * t2 + r0[3] * t3; a1 -= r1[0] * t0 + r1[1] * t1 + r1[2] * t2 + r1[3] * t3;
            a2 -= r2[0] * t0 + r2[1] * t1 + r2[2] * t2 + r2[3] * t3; a3 -= r3[0] * t0 + r3[1] * t1 + r3[2] * t2 + r3[3] * t3;
        }
        const f32x4 d1 = *(const LAS f32x4*)(M + (i0 + 1) * 64 + i0), d2 = *(const LAS f32x4*)(M + (i0 + 2) * 64 + i0), d3 = *(const LAS f32x4*)(M + (i0 + 3) * 64 + i0);
        a1 -= d1[0] * a0; a2 -= d2[0] * a0 + d2[1] * a1; a3 -= d3[0] * a0 + d3[1] * a1 + d3[2] * a2;
        M[i0 * 64 + lane] = a0; M[(i0 + 1) * 64 + lane] = a1; M[(i0 + 2) * 64 + lane] = a2; M[(i0 + 3) * 64 + lane] = a3;
    }
    const int cq = (lane >> 2) & 3, ca = (lane >> 4) & 1, ce = lane & 3, cks = lane >> 5;
    for (int i = 0; i < 64; ++i) tf[((i >> 4) * 2 + cks) * 512 + ((i & 15) + 16 * cq) * 8 + 4 * ca + ce] = (unsigned short)f2bf(M[i * 64 + lane]);
}
DEV void ph_gdn_local(const Args& a, const Ctx& X) {
    const bf16_t* qkvpre = (const bf16_t*)(a.ws + WS_QKVPRE); const float* small = (const float*)(a.ws + WS_SMALL);
    unsigned char* gi = a.ws + WS_GI; float* glast = (float*)(a.ws + WS_GLAST);
    constexpr int KP = 272;
    LAS unsigned char* kN = X.lds; LAS unsigned char* qN = X.lds + 64 * KP; LAS unsigned char* slots = X.lds + 128 * KP;
    LAS float* gcL = (LAS float*)(X.lds + 143360); LAS float* btL = gcL + 8 * 64;
    LAS unsigned char* stg = X.lds + 100352;
    const int lane = X.lane, wave = X.wave, r16 = lane & 15, q4 = lane >> 4;
    const float scale = 0.08838834764831845f;
    for (int wu = X.bid; wu < NB * 64; wu += X.G) {
        const int b = wu >> 6, n = wu & 63; const size_t t0 = (size_t)b * SEQ + 64 * n;
        unsigned char* tmp = a.ws + WS_GTMP + (size_t)X.bid * 131072;
        __syncthreads();
        {
            const float g = -__expf(a.gdn_a_log[wave]) * softplusf(small[(t0 + lane) * 32 + 8 + wave] + a.gdn_dt_bias[wave]);
            float gc = g;
#pragma unroll
            for (int o = 1; o < 64; o <<= 1) { const float v = __shfl_up(gc, o); if (lane >= o) gc += v; }
            gcL[wave * 64 + lane] = gc; btL[wave * 64 + lane] = sigmoidf_(small[(t0 + lane) * 32 + wave]);
            if (lane == 63) glast[(size_t)((b * 8 + wave) * 64 + n) * 32] = gc;
        }
        __syncthreads();
        unsigned xr[3][11];
#define GDN_LOADX(hh) do { _Pragma("unroll") for (int _p = 0; _p < 3; ++_p) _Pragma("unroll") for (int _i = 0; _i < 11; ++_i) { const int _tk = 8 * wave + _i - 3; unsigned _v = 0u; \
            if (64 * n + _tk >= 0) _v = *(const unsigned*)(qkvpre + (t0 + _tk) * 3072 + _p * 1024 + (hh) * 128 + 2 * lane); xr[_p][_i] = _v; } } while (0)
        GDN_LOADX(0);
        for (int bb = 0; bb < 2; ++bb) {
            for (int j = 0; j < 4; ++j) {
                const int h = bb * 4 + j; unsigned char* ub = gi + (size_t)((b * 8 + h) * 64 + n) * GI_UNIT;
                {
                    const float gl = gcL[h * 64 + 63];
                    const int blk = wave >> 2, pa = (wave & 3) >> 1, pq0 = 2 * (wave & 1);
                    const int ca = (2 * lane >> 4) & 1, cq = (2 * lane >> 2) & 3, ce = (2 * lane) & 3, cks = (2 * lane) >> 5;
#pragma unroll
                    for (int part = 0; part < 3; ++part) {
                        const int col = part * 1024 + h * 128 + 2 * lane;
                        float w0[4], w1[4];
#pragma unroll
                        for (int i = 0; i < 4; ++i) { const f32x2 t = *(const f32x2*)(a.gdn_conv_w + i * 3072 + col); w0[i] = t.x; w1[i] = t.y; }
                        float x0[11], x1[11];
#pragma unroll
                        for (int i = 0; i < 11; ++i) { const unsigned v = xr[part][i]; x0[i] = __uint_as_float(v << 16); x1[i] = __uint_as_float(v & 0xFFFF0000u); }
                        float v0[8], v1[8];
#pragma unroll
                        for (int i = 0; i < 8; ++i) { v0[i] = siluf(w0[0] * x0[i] + w0[1] * x0[i + 1] + w0[2] * x0[i + 2] + w0[3] * x0[i + 3]); v1[i] = siluf(w1[0] * x1[i] + w1[1] * x1[i + 1] + w1[2] * x1[i + 2] + w1[3] * x1[i + 3]); }
                        if (part < 2) {
#pragma unroll
                            for (int i = 0; i < 8; ++i) { const float r = rsqrtf(wave_sum(v0[i] * v0[i] + v1[i] * v1[i]) + 1e-6f); v0[i] *= r; v1[i] *= r; }
                        }
                        for (int rep_ = 0; rep_ < (((PROBE_MASK >> 21) & 1u) ? 2 : 1); ++rep_) {
                        if (part == 0) {
#pragma unroll
                            for (int i = 0; i < 8; ++i) { const int tok = 8 * wave + i; const float eg = __expf(gcL[h * 64 + tok]) * scale;
                                *(LAS unsigned*)(qN + tok * KP + lane * 4) = pk2(v0[i], v1[i]);
                                *(LAS unsigned*)(stg + ((tok >> 4) * 4 + cks) * 1024 + ((tok & 15) + 16 * cq) * 16 + (4 * ca + ce) * 2) = pk2(v0[i] * eg, v1[i] * eg); }
                        } else if (part == 1) {
                            unsigned short kg0[8], kg1[8], ke0[8], ke1[8];
#pragma unroll
                            for (int i = 0; i < 8; ++i) { const int tok = 8 * wave + i; const float gc = gcL[h * 64 + tok], bt = btL[h * 64 + tok], eg = __expf(gc) * bt, eend = __expf(gl - gc);
                                *(LAS unsigned*)(kN + tok * KP + lane * 4) = pk2(v0[i], v1[i]);
                                kg0[i] = (unsigned short)f2bf(v0[i] * eg); kg1[i] = (unsigned short)f2bf(v1[i] * eg); ke0[i] = (unsigned short)f2bf(v0[i] * eend); ke1[i] = (unsigned short)f2bf(v1[i] * eend); }
#pragma unroll
                            for (int hf = 0; hf < 2; ++hf) { const int pos = 32 * blk + 8 * (pq0 + hf) + 4 * pa; const int cl = 2 * lane;
                                *(u32x2*)(tmp + (size_t)j * 32768 + 16384 + cl * 128 + pos * 2) = (u32x2){(unsigned)kg0[4 * hf] | ((unsigned)kg0[4 * hf + 1] << 16), (unsigned)kg0[4 * hf + 2] | ((unsigned)kg0[4 * hf + 3] << 16)};
                                *(u32x2*)(tmp + (size_t)j * 32768 + 16384 + (cl + 1) * 128 + pos * 2) = (u32x2){(unsigned)kg1[4 * hf] | ((unsigned)kg1[4 * hf + 1] << 16), (unsigned)kg1[4 * hf + 2] | ((unsigned)kg1[4 * hf + 3] << 16)};
                                *(LAS u32x2*)(stg + 16384 + ((cl >> 4) * 2 + blk) * 1024 + ((cl & 15) + 16 * (pq0 + hf)) * 16 + (4 * pa) * 2) = (u32x2){(unsigned)ke0[4 * hf] | ((unsigned)ke0[4 * hf + 1] << 16), (unsigned)ke0[4 * hf + 2] | ((unsigned)ke0[4 * hf + 3] << 16)};
                                *(LAS u32x2*)(stg + 16384 + (((cl + 1) >> 4) * 2 + blk) * 1024 + (((cl + 1) & 15) + 16 * (pq0 + hf)) * 16 + (4 * pa) * 2) = (u32x2){(unsigned)ke1[4 * hf] | ((unsigned)ke1[4 * hf + 1] << 16), (unsigned)ke1[4 * hf + 2] | ((unsigned)ke1[4 * hf + 3] << 16)}; }
                        } else {
                            unsigned short vb0[8], vb1[8];
#pragma unroll
                            for (int i = 0; i < 8; ++i) { const float bt = btL[h * 64 + 8 * wave + i]; vb0[i] = (unsigned short)f2bf(v0[i] * bt); vb1[i] = (unsigned short)f2bf(v1[i] * bt); }
#pragma unroll
                            for (int hf = 0; hf < 2; ++hf) { const int pos = 32 * blk + 8 * (pq0 + hf) + 4 * pa; const int cl = 2 * lane;
                                *(u32x2*)(tmp + (size_t)j * 32768 + cl * 128 + pos * 2) = (u32x2){(unsigned)vb0[4 * hf] | ((unsigned)vb0[4 * hf + 1] << 16), (unsigned)vb0[4 * hf + 2] | ((unsigned)vb0[4 * hf + 3] << 16)};
                                *(u32x2*)(tmp + (size_t)j * 32768 + (cl + 1) * 128 + pos * 2) = (u32x2){(unsigned)vb1[4 * hf] | ((unsigned)vb1[4 * hf + 1] << 16), (unsigned)vb1[4 * hf + 2] | ((unsigned)vb1[4 * hf + 3] << 16)}; }
                        }
                        asm volatile("" ::: "memory"); }
                    }
                }
                if (h + 1 < 8) GDN_LOADX(h + 1);
                __syncthreads();
                {
#pragma unroll
                    for (int i = 0; i < 4; ++i) *(u32x4*)(ub + 16384 + (X.tid + 512 * i) * 16) = *(const LAS u32x4*)(stg + (X.tid + 512 * i) * 16);
                    const int mat = wave >> 2, rt = wave & 3; LAS unsigned char* An = mat ? qN : kN;
                    bf16x8 af[4];
#pragma unroll
                    for (int ks = 0; ks < 4; ++ks) af[ks] = *(const LAS bf16x8*)(An + (16 * rt + r16) * KP + (32 * ks + 8 * q4) * 2);
                    LAS float* slot = (LAS float*)(slots + j * 16384);
#pragma unroll
                    for (int ct = 0; ct < 4; ++ct) { f32x4 acc = {0.f, 0.f, 0.f, 0.f};
#pragma unroll
                        for (int ks = 0; ks < 4; ++ks) { const bf16x8 bf = *(const LAS bf16x8*)(kN + (16 * ct + r16) * KP + (32 * ks + 8 * q4) * 2); acc = __builtin_amdgcn_mfma_f32_16x16x32_bf16(af[ks], bf, acc, 0, 0, 0); }
                        const int jc = 16 * ct + r16; const float gj = gcL[h * 64 + jc];
#pragma unroll
                        for (int rg = 0; rg < 4; ++rg) { const int i = 16 * rt + 4 * q4 + rg; const float dec = __expf(gcL[h * 64 + i] - gj);
                            if (mat == 0) { slot[i * 64 + jc] = jc < i ? btL[h * 64 + i] * acc[rg] * dec : 0.f; }
                            else { const float v = jc <= i ? acc[rg] * scale * dec : 0.f;
                                *(LAS unsigned short*)(stg + 32768 + (rt * 2 + (ct >> 1)) * 1024 + ((4 * q4 + rg) + 16 * (r16 >> 2)) * 16 + (4 * (ct & 1) + (r16 & 3)) * 2) = (unsigned short)f2bf(v); } }
                    }
                }
                __syncthreads();
                *(u32x4*)(ub + 49152 + X.tid * 16) = *(const LAS u32x4*)(stg + 32768 + X.tid * 16);
            }
            if (wave < 4) gdn_solve((LAS float*)(slots + wave * 16384), (LAS unsigned short*)(X.lds + wave * 8192), lane);
            VM_WAIT(); __syncthreads();
            for (int j = 0; j < 4; ++j) {
                const int h = bb * 4 + j; unsigned char* ub = gi + (size_t)((b * 8 + h) * 64 + n) * GI_UNIT;
                const int mat = wave >> 2; LAS unsigned char* slot = X.lds + j * 8192;
#pragma unroll
                for (int cx = 0; cx < 2; ++cx) { const int ct = 2 * (wave & 3) + cx;
                    bf16x8 bfr[2];
#pragma unroll
                    for (int ks = 0; ks < 2; ++ks) { const u32x4 t = __builtin_nontemporal_load((const u32x4*)(tmp + (size_t)j * 32768 + mat * 16384 + (16 * ct + r16) * 128 + (32 * ks + 8 * q4) * 2)); bfr[ks] = __builtin_bit_cast(bf16x8, t); }
#pragma unroll
                    for (int rt = 0; rt < 4; ++rt) { f32x4 acc = {0.f, 0.f, 0.f, 0.f};
#pragma unroll
                        for (int ks = 0; ks < 2; ++ks) { const bf16x8 tf = *(const LAS bf16x8*)(slot + (rt * 2 + ks) * 1024 + lane * 16); acc = __builtin_amdgcn_mfma_f32_16x16x32_bf16(tf, bfr[ks], acc, 0, 0, 0); }
                        if (mat == 0) *(u32x2*)(ub + 57344 + (rt * 8 + ct) * 512 + lane * 8) = (u32x2){pg8::cvt_pk_bf16(acc[0], acc[1]), pg8::cvt_pk_bf16(acc[2], acc[3])};
                        else {
#pragma unroll
                            for (int rg = 0; rg < 4; ++rg) *(unsigned short*)(ub + (rt * 4 + (ct >> 1)) * 1024 + ((4 * q4 + rg) + 16 * (r16 >> 2)) * 16 + (4 * (ct & 1) + (r16 & 3)) * 2) = (unsigned short)f2bf(-acc[rg]);
                        }
                    }
                }
            }
            __syncthreads();
        }
    }
}
DEV void ph_gdn_scan(const Args& a, const Ctx& X) {
    const unsigned char* gi = a.ws + WS_GI; const float* glast = (const float*)(a.ws + WS_GLAST);
    const bf16_t* za = (const bf16_t*)(a.ws + WS_ZA); bf16_t* oy = (bf16_t*)(a.ws + WS_OY);
    const int lane = X.lane, wave = X.wave, r16 = lane & 15, q4 = lane >> 4, tid = X.tid;
    LAS float* OT = (LAS float*)(X.lds + 114688);
    const int bh = X.bid, b = bh >> 3, h = bh & 7;
    const unsigned char* ubase = gi + (size_t)bh * 64 * GI_UNIT;
    f32x4 S[8];
#pragma unroll
    for (int i = 0; i < 8; ++i) S[i] = (f32x4){0.f, 0.f, 0.f, 0.f};
    float nwv[16];
#pragma unroll
    for (int i = 0; i < 16; ++i) nwv[i] = a.gdn_norm_w[16 * (tid & 7) + i];
#define GDN_STAGE(nn, buf) do { _Pragma("unroll") for (int _i = 0; _i < 7; ++_i) \
        __builtin_amdgcn_global_load_lds((const unsigned*)(ubase + (size_t)(nn) * GI_UNIT + (size_t)(tid + 512 * _i) * 16), (LAS unsigned*)(X.lds + (buf) * 57344 + (wave * 64 + 512 * _i) * 16), 16, 0, 0); } while (0)
    u32x2 udn[4]; float gln; u32x4 zn[2];
    { const size_t tz = (size_t)b * SEQ + (tid >> 3); zn[0] = *(const u32x4*)(za + tz * 1024 + h * 128 + 16 * (tid & 7)); zn[1] = *(const u32x4*)(za + tz * 1024 + h * 128 + 16 * (tid & 7) + 8); }
#pragma unroll
    for (int ct = 0; ct < 4; ++ct) udn[ct] = *(const u32x2*)(ubase + 57344 + (ct * 8 + wave) * 512 + lane * 8);
    gln = glast[(size_t)(bh * 64) * 32];
    GDN_STAGE(0, 0);
#define GDN_EPILOGUE(nn, ZC) do { const int tok = tid >> 3, seg = tid & 7; const size_t t = (size_t)b * SEQ + 64 * (nn) + tok; \
            float ov[16]; float ss = 0.f; \
            _Pragma("unroll") for (int i = 0; i < 4; ++i) { const f32x4 v = *(const LAS f32x4*)(OT + tok * 132 + 16 * seg + 4 * i); ov[4 * i] = v[0]; ov[4 * i + 1] = v[1]; ov[4 * i + 2] = v[2]; ov[4 * i + 3] = v[3]; ss += v[0] * v[0] + v[1] * v[1] + v[2] * v[2] + v[3] * v[3]; } \
            ss += __shfl_xor(ss, 1); ss += __shfl_xor(ss, 2); ss += __shfl_xor(ss, 4); \
            const float rstd = rsqrtf(ss * (1.f / 128.f) + EPS); \
            u32x4 ow[2]; \
            _Pragma("unroll") for (int i = 0; i < 2; ++i) _Pragma("unroll") for (int e = 0; e < 4; ++e) { const unsigned zw = (ZC)[i][e]; const float z0 = __uint_as_float(zw << 16), z1 = __uint_as_float(zw & 0xFFFF0000u); \
                    ow[i][e] = pg8::cvt_pk_bf16(ov[8 * i + 2 * e] * rstd * nwv[8 * i + 2 * e] * siluf(z0), ov[8 * i + 2 * e + 1] * rstd * nwv[8 * i + 2 * e + 1] * siluf(z1)); } \
            *(u32x4*)(oy + t * 2048 + h * 128 + 16 * seg) = ow[0]; *(u32x4*)(oy + t * 2048 + h * 128 + 16 * seg + 8) = ow[1]; } while (0)
    u32x4 zp[2] = {{0u, 0u, 0u, 0u}, {0u, 0u, 0u, 0u}};
    for (int n = 0; n < 64; ++n) {
        VM_WAIT(); __syncthreads();
        f32x4 uf[4];
#pragma unroll
        for (int ct = 0; ct < 4; ++ct) { uf[ct][0] = __uint_as_float(udn[ct].x << 16); uf[ct][1] = __uint_as_float(udn[ct].x & 0xFFFF0000u); uf[ct][2] = __uint_as_float(udn[ct].y << 16); uf[ct][3] = __uint_as_float(udn[ct].y & 0xFFFF0000u); }
        const float egl = __expf(gln);
        u32x4 zc[2]; zc[0] = zn[0]; zc[1] = zn[1];
        asm volatile("" : "+v"(uf[0]), "+v"(uf[1]), "+v"(uf[2]), "+v"(uf[3]), "+v"(zc[0]), "+v"(zc[1]));
        if (n + 1 < 64) {
            const unsigned char* un = ubase + (size_t)(n + 1) * GI_UNIT;
#pragma unroll
            for (int ct = 0; ct < 4; ++ct) udn[ct] = *(const u32x2*)(un + 57344 + (ct * 8 + wave) * 512 + lane * 8);
            gln = glast[(size_t)(bh * 64 + n + 1) * 32];
            { const size_t tz = (size_t)b * SEQ + 64 * (n + 1) + (tid >> 3); zn[0] = *(const u32x4*)(za + tz * 1024 + h * 128 + 16 * (tid & 7)); zn[1] = *(const u32x4*)(za + tz * 1024 + h * 128 + 16 * (tid & 7) + 8); }
            GDN_STAGE(n + 1, (n + 1) & 1);
        }
        if (n > 0) GDN_EPILOGUE(n - 1, zp);
        zp[0] = zc[0]; zp[1] = zc[1];
        const LAS unsigned char* L = X.lds + (n & 1) * 57344;
        bf16x8 sB[4];
#pragma unroll
        for (int ks = 0; ks < 4; ++ks) sB[ks] = acc_to_frag(S[2 * ks], S[2 * ks + 1]);
        f32x4 vn[4], oo[4];
#pragma unroll
        for (int ct = 0; ct < 4; ++ct) { f32x4 acc = {0.f, 0.f, 0.f, 0.f}, ao = {0.f, 0.f, 0.f, 0.f};
#pragma unroll
            for (int ks = 0; ks < 4; ++ks) { const bf16x8 wf = *(const LAS bf16x8*)(L + (ct * 4 + ks) * 1024 + lane * 16), qf = *(const LAS bf16x8*)(L + 16384 + (ct * 4 + ks) * 1024 + lane * 16);
                acc = __builtin_amdgcn_mfma_f32_16x16x32_bf16(wf, sB[ks], acc, 0, 0, 0); ao = __builtin_amdgcn_mfma_f32_16x16x32_bf16(qf, sB[ks], ao, 0, 0, 0); }
            vn[ct] = acc; oo[ct] = ao; }
#pragma unroll
        for (int ct = 0; ct < 4; ++ct) vn[ct] = vn[ct] + uf[ct];
        bf16x8 vB[2];
#pragma unroll
        for (int ks = 0; ks < 2; ++ks) vB[ks] = acc_to_frag(vn[2 * ks], vn[2 * ks + 1]);
#pragma unroll
        for (int ct = 0; ct < 4; ++ct)
#pragma unroll
            for (int ks = 0; ks < 2; ++ks) { const bf16x8 kf = *(const LAS bf16x8*)(L + 49152 + (ct * 2 + ks) * 1024 + lane * 16); oo[ct] = __builtin_amdgcn_mfma_f32_16x16x32_bf16(kf, vB[ks], oo[ct], 0, 0, 0); }
#pragma unroll
        for (int dt = 0; dt < 8; ++dt) { f32x4 acc = S[dt] * egl;
#pragma unroll
            for (int ks = 0; ks < 2; ++ks) { const bf16x8 ef = *(const LAS bf16x8*)(L + 32768 + (dt * 2 + ks) * 1024 + lane * 16); acc = __builtin_amdgcn_mfma_f32_16x16x32_bf16(ef, vB[ks], acc, 0, 0, 0); }
            S[dt] = acc; }
        __syncthreads();
#pragma unroll
        for (int ct = 0; ct < 4; ++ct)
#pragma unroll
            for (int rg = 0; rg < 4; ++rg) OT[(16 * ct + 4 * q4 + rg) * 132 + 16 * wave + r16] = oo[ct][rg];
    }
    __syncthreads();
    GDN_EPILOGUE(63, zp);
#undef GDN_EPILOGUE
#undef GDN_STAGE
}

constexpr int SP = 272;
DEV void ph_ssd_local(const Args& a, const Ctx& X) {
    const bf16_t* xbcpre = (const bf16_t*)(a.ws + WS_XBCPRE); const float* small = (const float*)(a.ws + WS_SMALL);
    bf16_t* CC = (bf16_t*)(a.ws + WS_CC); float* acum = (float*)(a.ws + WS_ACUM); float* cdec = (float*)(a.ws + WS_CDEC);
    bf16_t* ydiag = (bf16_t*)(a.ws + WS_YDIAG); bf16_t* states = (bf16_t*)(a.ws + WS_STATES);
    LAS unsigned char* Bn = X.lds; LAS unsigned char* Cn = X.lds + 128 * SP; LAS unsigned char* BT = X.lds + 256 * SP;
    LAS unsigned char* xdT = X.lds; LAS unsigned char* xeT = X.lds + 64 * SP;
    LAS float* acL = (LAS float*)(X.lds + AUX_OFF); LAS float* dtL = acL + 8 * 128;
    const int lane = X.lane, wave = X.wave, r16 = lane & 15, q4 = lane >> 4;
    for (int unit = X.bid; unit < NB * 32 * 2; unit += X.G) {
        const int g = unit & 1, c = (unit >> 1) & 31, b = unit >> 6; const size_t t0 = (size_t)b * SEQ + 128 * c;
        __syncthreads();
        {
            const int hd = g * 8 + wave; const float an = -__expf(a.ssd_a_log[hd]), bias = a.ssd_dt_bias[hd];
            const float d0 = softplusf(small[(t0 + lane) * 32 + 16 + hd] + bias), d1 = softplusf(small[(t0 + 64 + lane) * 32 + 16 + hd] + bias);
            float s0 = d0 * an, s1 = d1 * an;
#pragma unroll
            for (int o = 1; o < 64; o <<= 1) { const float v0 = __shfl_up(s0, o), v1 = __shfl_up(s1, o); if (lane >= o) { s0 += v0; s1 += v1; } }
            s1 += __shfl(s0, 63);
            acL[wave * 128 + lane] = s0; acL[wave * 128 + 64 + lane] = s1; dtL[wave * 128 + lane] = d0; dtL[wave * 128 + 64 + lane] = d1;
            acum[((size_t)g * T + t0 + lane) * 8 + wave] = s0; acum[((size_t)g * T + t0 + 64 + lane) * 8 + wave] = s1;
            if (lane == 63) cdec[(size_t)unit * 32 + wave] = __expf(s1);
        }
        {
            const int isC = lane >> 5, cc = (lane & 31) * 4, col = 1024 + isC * 256 + g * 128 + cc;
            float w[4][4], bs[4];
#pragma unroll
            for (int i = 0; i < 4; ++i) { const f32x4 t = *(const f32x4*)(a.ssd_conv_w + i * 1536 + col); w[i][0] = t[0]; w[i][1] = t[1]; w[i][2] = t[2]; w[i][3] = t[3]; }
            { const f32x4 t = *(const f32x4*)(a.ssd_conv_b + col); bs[0] = t[0]; bs[1] = t[1]; bs[2] = t[2]; bs[3] = t[3]; }
            float xin[19][4];
#pragma unroll
            for (int i = 0; i < 19; ++i) { const int tk = 16 * wave + i - 3; const bool ok = (128 * c + tk) >= 0; u32x2 v = {0u, 0u}; if (ok) v = *(const u32x2*)(xbcpre + (t0 + tk) * 1536 + col);
                xin[i][0] = __uint_as_float(v.x << 16); xin[i][1] = __uint_as_float(v.x & 0xFFFF0000u); xin[i][2] = __uint_as_float(v.y << 16); xin[i][3] = __uint_as_float(v.y & 0xFFFF0000u); }
            unsigned short ov[16][4];
#pragma unroll
            for (int i = 0; i < 16; ++i)
#pragma unroll
                for (int e = 0; e < 4; ++e) { const float s = bs[e] + w[0][e] * xin[i][e] + w[1][e] * xin[i + 1][e] + w[2][e] * xin[i + 2][e] + w[3][e] * xin[i + 3][e]; ov[i][e] = (unsigned short)f2bf(siluf(s)); }
            LAS unsigned char* nat = isC ? Cn : Bn;
#pragma unroll
            for (int i = 0; i < 16; ++i) { const u32x2 pk = {(unsigned)ov[i][0] | ((unsigned)ov[i][1] << 16), (unsigned)ov[i][2] | ((unsigned)ov[i][3] << 16)};
                *(LAS u32x2*)(nat + (16 * wave + i) * SP + cc * 2) = pk;
                if (isC) *(u32x2*)(CC + (t0 + 16 * wave + i) * 256 + g * 128 + cc) = pk; }
            if (!isC) {
#pragma unroll
                for (int e = 0; e < 4; ++e)
#pragma unroll
                    for (int qq = 0; qq < 4; ++qq) { const u32x2 pk = {(unsigned)ov[4 * qq][e] | ((unsigned)ov[4 * qq + 1][e] << 16), (unsigned)ov[4 * qq + 2][e] | ((unsigned)ov[4 * qq + 3][e] << 16)};
                        *(LAS u32x2*)(BT + (cc + e) * SP + (32 * (wave >> 1) + 8 * qq + 4 * (wave & 1)) * 2) = pk; }
            }
        }
        __syncthreads();
        f32x4 cbt[8];
        {
            bf16x8 cf[4];
#pragma unroll
            for (int ks = 0; ks < 4; ++ks) cf[ks] = *(const LAS bf16x8*)(Cn + (16 * wave + r16) * SP + (32 * ks + 8 * q4) * 2);
#pragma unroll
            for (int st = 0; st < 8; ++st) { cbt[st] = (f32x4){0.f, 0.f, 0.f, 0.f};
#pragma unroll
                for (int ks = 0; ks < 4; ++ks) { const bf16x8 bf = *(const LAS bf16x8*)(Bn + (16 * st + r16) * SP + (32 * ks + 8 * q4) * 2); cbt[st] = __builtin_amdgcn_mfma_f32_16x16x32_bf16(bf, cf[ks], cbt[st], 0, 0, 0); } }
        }
        __syncthreads();
        const int lq = 16 * wave + r16;
        unsigned short xnx[19];
#define SSD_LOADX(hh) do { _Pragma("unroll") for (int _i = 0; _i < 19; ++_i) { const int _tk = 16 * wave + _i - 3; xnx[_i] = (128 * c + _tk) >= 0 ? xbcpre[(t0 + _tk) * 1536 + (hh) * 64 + lane] : (unsigned short)0; } } while (0)
        SSD_LOADX(g * 8);
        for (int r = 0; r < 8; ++r) {
            const int hd = g * 8 + r; const float dd = a.ssd_d[hd];
            {
                const int col = hd * 64 + lane; float w0 = a.ssd_conv_w[col], w1 = a.ssd_conv_w[1536 + col], w2 = a.ssd_conv_w[2 * 1536 + col], w3 = a.ssd_conv_w[3 * 1536 + col]; const float bs = a.ssd_conv_b[col];
                float xin[19];
#pragma unroll
                for (int i = 0; i < 19; ++i) xin[i] = bf2f(xnx[i]);
                if (r + 1 < 8) SSD_LOADX(hd + 1);
                const float aclast = acL[r * 128 + 127];
                unsigned short xd[16], xe[16];
#pragma unroll
                for (int i = 0; i < 16; ++i) { const float xv = siluf(bs + w0 * xin[i] + w1 * xin[i + 1] + w2 * xin[i + 2] + w3 * xin[i + 3]); const int tk = 16 * wave + i;
                    const float xdv = xv * dtL[r * 128 + tk]; xd[i] = (unsigned short)f2bf(xdv); xe[i] = (unsigned short)f2bf(xdv * __expf(aclast - acL[r * 128 + tk])); }
#pragma unroll
                for (int qq = 0; qq < 4; ++qq) { const int pos = 32 * (wave >> 1) + 8 * qq + 4 * (wave & 1);
                    *(LAS u32x2*)(xdT + lane * SP + pos * 2) = (u32x2){(unsigned)xd[4 * qq] | ((unsigned)xd[4 * qq + 1] << 16), (unsigned)xd[4 * qq + 2] | ((unsigned)xd[4 * qq + 3] << 16)};
                    *(LAS u32x2*)(xeT + lane * SP + pos * 2) = (u32x2){(unsigned)xe[4 * qq] | ((unsigned)xe[4 * qq + 1] << 16), (unsigned)xe[4 * qq + 2] | ((unsigned)xe[4 * qq + 3] << 16)}; }
            }
            __syncthreads();
            {
                const float acl = acL[r * 128 + lq], ddt = dd / dtL[r * 128 + lq];
                f32x4 yd[4];
#pragma unroll
                for (int pt = 0; pt < 4; ++pt) yd[pt] = (f32x4){0.f, 0.f, 0.f, 0.f};
#pragma unroll
                for (int ks = 0; ks < 4; ++ks) { if (ks <= (wave >> 1)) {
                    f32x4 mlo, mhi;
#pragma unroll
                    for (int e = 0; e < 4; ++e) {
                        const int s0 = 32 * ks + 4 * q4 + e, s1 = s0 + 16;
                        const float v0 = cbt[2 * ks][e], v1 = cbt[2 * ks + 1][e];
                        mlo[e] = s0 < lq ? v0 * __expf(acl - acL[r * 128 + s0]) : (s0 == lq ? v0 + ddt : 0.f);
                        mhi[e] = s1 < lq ? v1 * __expf(acl - acL[r * 128 + s1]) : (s1 == lq ? v1 + ddt : 0.f);
                    }
                    const bf16x8 mf = acc_to_frag(mlo, mhi);
#pragma unroll
                    for (int pt = 0; pt < 4; ++pt) { const bf16x8 xf = *(const LAS bf16x8*)(xdT + (16 * pt + r16) * SP + (32 * ks + 8 * q4) * 2); yd[pt] = __builtin_amdgcn_mfma_f32_16x16x32_bf16(xf, mf, yd[pt], 0, 0, 0); }
                } }
#pragma unroll
                for (int pt = 0; pt < 4; ++pt) *(u32x2*)(ydiag + (t0 + lq) * 1024 + hd * 64 + 16 * pt + 4 * q4) = (u32x2){pg8::cvt_pk_bf16(yd[pt][0], yd[pt][1]), pg8::cvt_pk_bf16(yd[pt][2], yd[pt][3])};
            }
            {
                bf16x8 bf[4];
#pragma unroll
                for (int ks = 0; ks < 4; ++ks) bf[ks] = *(const LAS bf16x8*)(BT + (16 * wave + r16) * SP + (32 * ks + 8 * q4) * 2);
                bf16_t* hp = states + ((size_t)(unit * 8 + r) * 64) * 128;
#pragma unroll
                for (int pt = 0; pt < 4; ++pt) { f32x4 st = {0.f, 0.f, 0.f, 0.f};
#pragma unroll
                    for (int ks = 0; ks < 4; ++ks) { const bf16x8 xf = *(const LAS bf16x8*)(xeT + (16 * pt + r16) * SP + (32 * ks + 8 * q4) * 2); st = __builtin_amdgcn_mfma_f32_16x16x32_bf16(bf[ks], xf, st, 0, 0, 0); }
                    *(u32x2*)(hp + (size_t)(16 * pt + r16) * 128 + 16 * wave + 4 * q4) = (u32x2){pg8::cvt_pk_bf16(st[0], st[1]), pg8::cvt_pk_bf16(st[2], st[3])}; }
            }
            __syncthreads();
        }
    }
}
DEV void ph_ssd_scan(const Args& a, const Ctx& X, const int wg0) {
    bf16_t* states = (bf16_t*)(a.ws + WS_STATES); const float* cdec = (const float*)(a.ws + WS_CDEC);
    for (int task = (X.bid - wg0) * NTHR + X.tid; task < NB * 16 * 64 * 32; task += (X.G - wg0) * NTHR) {
        const int n4 = task & 31, p = (task >> 5) & 63, hd = (task >> 11) & 15, b = task >> 15;
        float h0 = 0.f, h1 = 0.f, h2 = 0.f, h3 = 0.f;
        for (int c = 0; c < 32; ++c) {
            const int unit = (b * 32 + c) * 2 + (hd >> 3);
            u32x2* ptr = (u32x2*)(states + ((size_t)(unit * 8 + (hd & 7)) * 64 + p) * 128 + 4 * n4);
            const u32x2 sv = *ptr; const float dec = cdec[(size_t)unit * 32 + (hd & 7)];
            *ptr = (u32x2){pk2(h0, h1), pk2(h2, h3)};
            h0 = h0 * dec + __uint_as_float(sv.x << 16); h1 = h1 * dec + __uint_as_float(sv.x & 0xFFFF0000u); h2 = h2 * dec + __uint_as_float(sv.y << 16); h3 = h3 * dec + __uint_as_float(sv.y & 0xFFFF0000u);
        }
    }
}
DEV void ph_ssd_out(const Args& a, const Ctx& X, const int wg0) {
    const bf16_t* CC = (const bf16_t*)(a.ws + WS_CC); const float* acum = (const float*)(a.ws + WS_ACUM); const bf16_t* ydiag = (const bf16_t*)(a.ws + WS_YDIAG);
    const bf16_t* states = (const bf16_t*)(a.ws + WS_STATES); const bf16_t* zb = (const bf16_t*)(a.ws + WS_ZB); bf16_t* oy = (bf16_t*)(a.ws + WS_OY);
    const int lane = X.lane, wave = X.wave, r16 = lane & 15, q4 = lane >> 4;
    for (int unit = X.bid - wg0; unit < NB * 32 * 2; unit += X.G - wg0) {
        const int g = unit & 1, c = (unit >> 1) & 31, b = unit >> 6; const size_t t = (size_t)b * SEQ + 128 * c + 16 * wave + r16;
        bf16x8 cf[4];
#pragma unroll
        for (int ks = 0; ks < 4; ++ks) cf[ks] = *(const bf16x8*)(CC + t * 256 + g * 128 + 32 * ks + 8 * q4);
        float ss = 0.f;
        LAS u32x2* stash = (LAS u32x2*)(X.lds + wave * 16384);
        for (int r = 0; r < 8; ++r) {
            const int hd = g * 8 + r; const float eac = __expf(acum[((size_t)g * T + t) * 8 + r]);
            const bf16_t* hp = states + ((size_t)(unit * 8 + r) * 64) * 128;
#pragma unroll
            for (int pt = 0; pt < 4; ++pt) { f32x4 acc = {0.f, 0.f, 0.f, 0.f};
#pragma unroll
                for (int ks = 0; ks < 4; ++ks) { const bf16x8 hf = *(const bf16x8*)(hp + (size_t)(16 * pt + r16) * 128 + 32 * ks + 8 * q4); acc = __builtin_amdgcn_mfma_f32_16x16x32_bf16(hf, cf[ks], acc, 0, 0, 0); }
                const u32x2 yd = *(const u32x2*)(ydiag + t * 1024 + hd * 64 + 16 * pt + 4 * q4), zz = *(const u32x2*)(zb + t * 1024 + hd * 64 + 16 * pt + 4 * q4);
                f32x4 v; v[0] = acc[0] * eac + __uint_as_float(yd.x << 16); v[1] = acc[1] * eac + __uint_as_float(yd.x & 0xFFFF0000u); v[2] = acc[2] * eac + __uint_as_float(yd.y << 16); v[3] = acc[3] * eac + __uint_as_float(yd.y & 0xFFFF0000u);
                v[0] *= siluf(__uint_as_float(zz.x << 16)); v[1] *= siluf(__uint_as_float(zz.x & 0xFFFF0000u)); v[2] *= siluf(__uint_as_float(zz.y << 16)); v[3] *= siluf(__uint_as_float(zz.y & 0xFFFF0000u));
                ss += v[0] * v[0] + v[1] * v[1] + v[2] * v[2] + v[3] * v[3];
                stash[(r * 4 + pt) * 64 + lane] = (u32x2){pg8::cvt_pk_bf16(v[0], v[1]), pg8::cvt_pk_bf16(v[2], v[3])}; }
        }
        ss += __shfl_xor(ss, 16); ss += __shfl_xor(ss, 32);
        const float rstd = rsqrtf(ss * (1.f / 512.f) + EPS);
        for (int r = 0; r < 8; ++r)
#pragma unroll
            for (int pt = 0; pt < 4; ++pt) { const int cix = g * 512 + r * 64 + 16 * pt + 4 * q4; const f32x4 nw = *(const f32x4*)(a.ssd_norm_w + cix); const u32x2 w = stash[(r * 4 + pt) * 64 + lane];
                *(u32x2*)(oy + t * 2048 + 1024 + cix) = (u32x2){pg8::cvt_pk_bf16(__uint_as_float(w.x << 16) * rstd * nw[0], __uint_as_float(w.x & 0xFFFF0000u) * rstd * nw[1]), pg8::cvt_pk_bf16(__uint_as_float(w.y << 16) * rstd * nw[2], __uint_as_float(w.y & 0xFFFF0000u) * rstd * nw[3])}; }
    }
}


DEV void ph_attn(const Args& a, const Ctx& X) {
    const bf16_t* qkv = (const bf16_t*)(a.ws + WS_Q1KV); bf16_t* po = (bf16_t*)(a.ws + WS_PO); float* plse = (float*)(a.ws + WS_PLSE); bf16_t* o = (bf16_t*)(a.ws + WS_O1);
    LAS unsigned char* vl = X.lds + X.wave * 12288;
    LAS unsigned char* kl = vl + 6144;
    const int lane = X.lane, q = lane & 31, h5 = lane >> 5;
    const int tr_off = ((lane & 15) >> 2) * 192 + (16 * ((lane >> 4) & 1) + 4 * (lane & 3)) * 2;
    const int prow = lane >> 3, pch = lane & 7;
    for (int unit = X.bid; unit < NB * 16 * 8; unit += X.G) {
        const int bhd = unit & 63, b = bhd >> 4, hd = bhd & 15, g = unit >> 6;
        for (int tk = 0; tk < 6; ++tk) {
            const int br = tk >> 1, k = X.wave * 2 + (tk & 1);
            int d, r, i0;
            if (br == 0) { d = 1; r = 0; i0 = 512 * g + 32 * k; } else if (br == 1) { d = 4; r = k & 3; i0 = 128 * g + 32 * (k >> 2); } else { d = 16; r = k; i0 = 32 * g; }
            const size_t tq = (size_t)b * SEQ + (size_t)(i0 + q) * d + r;
#define ATT_LOAD(dst, j0_, coff) do { _Pragma("unroll") for (int _i = 0; _i < 4; ++_i) { const size_t _t = (size_t)b * SEQ + (size_t)((j0_) + 8 * _i + prow) * d + r; \
                dst[_i] = *(const u32x4*)(qkv + _t * 3072 + (coff) + hd * 64 + pch * 8); } } while (0)
            u32x4 kA[4], vA[4], kB[4], vB[4], kC[4], vC[4];
            const bool v3 = (i0 - 32) >= 0, v2 = (i0 - 64) >= 0, v1 = (i0 - 96) >= 0, v0 = (i0 - 128) >= 0;
            ATT_LOAD(kA, i0, 0);
            ATT_LOAD(kB, i0, 1024); ATT_LOAD(vB, i0, 2048);
            if (v3) { ATT_LOAD(kC, i0 - 32, 1024); ATT_LOAD(vC, i0 - 32, 2048); }
#pragma unroll
            for (int i = 0; i < 4; ++i) *(LAS u32x4*)(kl + (8 * i + prow) * 144 + pch * 16) = kA[i];
            bf16x8 qf[4];
#pragma unroll
            for (int s = 0; s < 4; ++s) qf[s] = *(const LAS bf16x8*)(kl + q * 144 + (16 * s + 8 * h5) * 2);
            LDS_WAIT();
            f32x16 oacc[2];
#pragma unroll
            for (int i = 0; i < 16; ++i) { oacc[0][i] = 0.f; oacc[1][i] = 0.f; }
            float m = -1e30f, l = 0.f;
            auto tile = [&](const int kt, const u32x4 (&kp)[4], const u32x4 (&vp)[4]) {
#pragma unroll
                for (int i = 0; i < 4; ++i) { *(LAS u32x4*)(kl + (8 * i + prow) * 144 + pch * 16) = kp[i]; *(LAS u32x4*)(vl + (8 * i + prow) * 192 + pch * 16) = vp[i]; }
                f32x16 sacc;
#pragma unroll
                for (int i = 0; i < 16; ++i) sacc[i] = 0.f;
#pragma unroll
                for (int s = 0; s < 4; ++s) { const bf16x8 kf = *(const LAS bf16x8*)(kl + q * 144 + (16 * s + 8 * h5) * 2); sacc = __builtin_amdgcn_mfma_f32_32x32x16_bf16(kf, qf[s], sacc, 0, 0, 0); }
                if (kt == 4) {
#pragma unroll
                    for (int i = 0; i < 16; ++i) { const int kl_ = (i & 3) + 8 * (i >> 2) + 4 * h5; if (kl_ > q) sacc[i] = -1e30f; }
                } else if (kt == 0) {
#pragma unroll
                    for (int i = 0; i < 16; ++i) { const int kl_ = (i & 3) + 8 * (i >> 2) + 4 * h5; if (kl_ < q) sacc[i] = -1e30f; }
                }
                float mx = sacc[0];
#pragma unroll
                for (int i = 1; i < 16; ++i) mx = fmaxf(mx, sacc[i]);
                mx = fmaxf(mx, __shfl_xor(mx, 32));
                const float mn = fmaxf(m, mx), alpha = __expf(m - mn);
                float rs = 0.f;
#pragma unroll
                for (int i = 0; i < 16; ++i) { sacc[i] = __expf(sacc[i] - mn); rs += sacc[i]; }
                rs += __shfl_xor(rs, 32);
                l = l * alpha + rs; m = mn;
#pragma unroll
                for (int i = 0; i < 16; ++i) { oacc[0][i] *= alpha; oacc[1][i] *= alpha; }
                bf16x8 pf[2];
#pragma unroll
                for (int s = 0; s < 2; ++s) { u32x4 w; w.x = pg8::cvt_pk_bf16(sacc[8 * s], sacc[8 * s + 1]); w.y = pg8::cvt_pk_bf16(sacc[8 * s + 2], sacc[8 * s + 3]); w.z = pg8::cvt_pk_bf16(sacc[8 * s + 4], sacc[8 * s + 5]); w.w = pg8::cvt_pk_bf16(sacc[8 * s + 6], sacc[8 * s + 7]);
                    pf[s] = __builtin_bit_cast(bf16x8, w); }
#pragma unroll
                for (int dt = 0; dt < 2; ++dt)
#pragma unroll
                    for (int s = 0; s < 2; ++s) {
                        const s16x4 t0_ = __builtin_amdgcn_ds_read_tr16_b64_v4i16((LAS s16x4*)(vl + (16 * s + 4 * h5) * 192 + dt * 64 + tr_off));
                        const s16x4 t1_ = __builtin_amdgcn_ds_read_tr16_b64_v4i16((LAS s16x4*)(vl + (16 * s + 8 + 4 * h5) * 192 + dt * 64 + tr_off));
                        bf16x8 vf; vf[0] = t0_[0]; vf[1] = t0_[1]; vf[2] = t0_[2]; vf[3] = t0_[3]; vf[4] = t1_[0]; vf[5] = t1_[1]; vf[6] = t1_[2]; vf[7] = t1_[3];
                        oacc[dt] = __builtin_amdgcn_mfma_f32_32x32x16_bf16(vf, pf[s], oacc[dt], 0, 0, 0);
                    }
                LDS_WAIT();
            };
            if (v2) { ATT_LOAD(kA, i0 - 64, 1024); ATT_LOAD(vA, i0 - 64, 2048); }
            tile(4, kB, vB);
            if (v3) {
                if (v1) { ATT_LOAD(kB, i0 - 96, 1024); ATT_LOAD(vB, i0 - 96, 2048); }
                tile(3, kC, vC);
                if (v2) {
                    if (v0) { ATT_LOAD(kC, i0 - 128, 1024); ATT_LOAD(vC, i0 - 128, 2048); }
                    tile(2, kA, vA);
                    if (v1) { tile(1, kB, vB);
                        if (v0) tile(0, kC, vC); }
                }
            }
#undef ATT_LOAD
            const float inv = 1.f / l;
            bf16_t* pr = po + ((size_t)br * T + tq) * 1024 + hd * 64;
#pragma unroll
            for (int dt = 0; dt < 2; ++dt)
#pragma unroll
                for (int gq = 0; gq < 4; ++gq) { u32x2 w; w.x = pg8::cvt_pk_bf16(oacc[dt][4 * gq] * inv, oacc[dt][4 * gq + 1] * inv); w.y = pg8::cvt_pk_bf16(oacc[dt][4 * gq + 2] * inv, oacc[dt][4 * gq + 3] * inv);
                    *(u32x2*)(pr + 32 * dt + 8 * gq + 4 * h5) = w; }
            if (h5 == 0) plse[((size_t)br * T + tq) * 16 + hd] = m + __logf(l);
        }
        VM_WAIT(); __syncthreads();
        {
            const size_t t = (size_t)b * SEQ + 512 * g + X.tid;
            const float l0 = plse[t * 16 + hd], l1 = plse[((size_t)T + t) * 16 + hd], l2 = plse[((size_t)2 * T + t) * 16 + hd];
            const float mx = fmaxf(l0, fmaxf(l1, l2)); float w0 = __expf(l0 - mx), w1 = __expf(l1 - mx), w2 = __expf(l2 - mx); const float wi = 1.f / (w0 + w1 + w2); w0 *= wi; w1 *= wi; w2 *= wi;
            const bf16_t* p0 = po + t * 1024 + hd * 64; const bf16_t* p1 = p0 + (size_t)T * 1024; const bf16_t* p2 = p1 + (size_t)T * 1024; bf16_t* orow = o + t * 1024 + hd * 64;
#pragma unroll
            for (int c = 0; c < 8; ++c) { const u32x4 x0 = *(const u32x4*)(p0 + 8 * c), x1 = *(const u32x4*)(p1 + 8 * c), x2 = *(const u32x4*)(p2 + 8 * c); u32x4 y;
#pragma unroll
                for (int e = 0; e < 4; ++e) { const float lo = w0 * __uint_as_float(x0[e] << 16) + w1 * __uint_as_float(x1[e] << 16) + w2 * __uint_as_float(x2[e] << 16);
                    const float hi = w0 * __uint_as_float(x0[e] & 0xFFFF0000u) + w1 * __uint_as_float(x1[e] & 0xFFFF0000u) + w2 * __uint_as_float(x2[e] & 0xFFFF0000u); y[e] = pk2(lo, hi); }
                *(u32x4*)(orow + 8 * c) = y; }
        }
    }
}

DEV void ph_router(const Args& a, const Ctx& X, const int l) {
    unsigned char* ws = a.ws;
    const float* mod = (const float*)(ws + WS_MOD) + (size_t)l * NB * 6 * D;
    const bf16_t* ymix = (const bf16_t*)(ws + WS_YMIX);
    bf16_t* xb = (bf16_t*)(ws + WS_XB);
    bf16_t* hb = (bf16_t*)(ws + WS_H);
    int* idx = (int*)(ws + WS_IDX); float* gw = (float*)(ws + WS_GW); int* aslot = (int*)(ws + WS_ASLOT); int* ltok = (int*)(ws + WS_LTOK);
    int* cntg = (int*)(ws + WS_CTL + CTL_CNT) + l * NE;
    const float* rw = a.router_w + (size_t)l * D * NE; const float* rbias = a.router_bias + l * NE;
    constexpr int HP = 2064;
    LAS unsigned char* hL = X.lds;
    LAS float* logit = (LAS float*)(X.lds + AUX_OFF + 2048);
    LAS int* lcnt = (LAS int*)(X.lds + AUX_OFF + 2048 + 64 * 65 * 4);
    LAS int* lbase = lcnt + 64;
    LAS int* sel_e = lbase + 64;
    LAS int* sel_s = sel_e + 512;
    const int lane = X.lane, wave = X.wave;
    for (int rb = X.bid; rb < T / 64; rb += X.G) {
        if (X.tid < 64) lcnt[X.tid] = 0;
        f32x4 xf_n[4]; u32x2 xb_n[4], ym_n[4];
#define RT_LOAD(rr) do { const int _row = rb * 64 + wave * 8 + (rr); _Pragma("unroll") for (int _j = 0; _j < 4; ++_j) { \
            if (l == 0) xf_n[_j] = *(const f32x4*)(a.x + (size_t)_row * D + _j * 256 + lane * 4); else xb_n[_j] = *(const u32x2*)(xb + (size_t)_row * D + _j * 256 + lane * 4); \
            ym_n[_j] = *(const u32x2*)(ymix + (size_t)_row * D + _j * 256 + lane * 4); } } while (0)
        RT_LOAD(0);
        for (int r8 = 0; r8 < 8; ++r8) {
            const int lr = wave * 8 + r8, row = rb * 64 + lr, b = row / SEQ; const float* ml = mod + (size_t)b * 6 * D;
            float xv[16], yv[16];
#pragma unroll
            for (int j = 0; j < 4; ++j) {
                if (l == 0) { xv[4 * j] = xf_n[j][0]; xv[4 * j + 1] = xf_n[j][1]; xv[4 * j + 2] = xf_n[j][2]; xv[4 * j + 3] = xf_n[j][3]; }
                else { xv[4 * j] = __uint_as_float(xb_n[j].x << 16); xv[4 * j + 1] = __uint_as_float(xb_n[j].x & 0xFFFF0000u); xv[4 * j + 2] = __uint_as_float(xb_n[j].y << 16); xv[4 * j + 3] = __uint_as_float(xb_n[j].y & 0xFFFF0000u); }
                yv[4 * j] = __uint_as_float(ym_n[j].x << 16); yv[4 * j + 1] = __uint_as_float(ym_n[j].x & 0xFFFF0000u); yv[4 * j + 2] = __uint_as_float(ym_n[j].y << 16); yv[4 * j + 3] = __uint_as_float(ym_n[j].y & 0xFFFF0000u); }
            if (r8 + 1 < 8) RT_LOAD(r8 + 1);
            resid_update(xv, yv, a.mix_post_g + l * D, ml + 2 * D, lane);
            store_row_bf(xb + (size_t)row * D, lane, xv);
            u32x2 o[4]; prenorm_pack(xv, a.ffn_pre_g + l * D, ml + 4 * D, ml + 3 * D, lane, o);
#pragma unroll
            for (int j = 0; j < 4; ++j) { *(u32x2*)(hb + (size_t)row * D + j * 256 + lane * 4) = o[j]; *(LAS u32x2*)(hL + lr * HP + (j * 256 + lane * 4) * 2) = o[j]; }
        }
#undef RT_LOAD
        __syncthreads();
        { const int rt = wave & 3, nh = wave >> 2, r16 = lane & 15, kq = lane >> 4;
          f32x4 acc0 = {0.f, 0.f, 0.f, 0.f}, acc1 = {0.f, 0.f, 0.f, 0.f};
          for (int c = 0; c < 32; ++c) {
              const u32x4 hv = *(const LAS u32x4*)(hL + (rt * 16 + r16) * HP + (32 * c + 8 * kq) * 2);
              const float* rp = rw + (size_t)(32 * c + 8 * kq) * NE + 4 * r16 + 2 * nh;
#pragma unroll
              for (int j = 0; j < 8; ++j) { const unsigned wj = hv[j >> 1]; const float av = (j & 1) ? __uint_as_float(wj & 0xFFFF0000u) : __uint_as_float(wj << 16);
                  const f32x2 bv = *(const f32x2*)(rp + (size_t)j * NE);
                  acc0 = __builtin_amdgcn_mfma_f32_16x16x4f32(av, bv.x, acc0, 0, 0, 0); acc1 = __builtin_amdgcn_mfma_f32_16x16x4f32(av, bv.y, acc1, 0, 0, 0); }
          }
#pragma unroll
          for (int r = 0; r < 4; ++r) { logit[(rt * 16 + 4 * kq + r) * 65 + 4 * r16 + 2 * nh] = acc0[r]; logit[(rt * 16 + 4 * kq + r) * 65 + 4 * r16 + 2 * nh + 1] = acc1[r]; } }
        __syncthreads();
        for (int r8 = 0; r8 < 8; ++r8) {
            const int lr = wave * 8 + r8, t = rb * 64 + lr;
            float lgt = logit[lr * 65 + lane]; if (!(lgt > -1e30f && lgt < 1e30f)) lgt = 0.f;
            const float score = sigmoidf_(lgt), biased = score + rbias[lane];
            float m1 = biased;
#pragma unroll
            for (int o = 1; o < 8; o <<= 1) m1 = fmaxf(m1, __shfl_xor(m1, o));
            int c1 = (biased == m1) ? (lane & 7) : 8;
#pragma unroll
            for (int o = 1; o < 8; o <<= 1) c1 = min(c1, __shfl_xor(c1, o));
            float m2 = ((lane & 7) == c1) ? -INFINITY : biased;
#pragma unroll
            for (int o = 1; o < 8; o <<= 1) m2 = fmaxf(m2, __shfl_xor(m2, o));
            const float gs = m1 + m2; const int myg = lane >> 3; int grank = 0;
#pragma unroll
            for (int g2 = 0; g2 < 8; ++g2) { const float o = __shfl(gs, g2 * 8); grank += (o > gs || (o == gs && g2 < myg)) ? 1 : 0; }
            const float cand = (grank < 4) ? biased : -INFINITY; int rank = 0;
            for (int e2 = 0; e2 < 64; ++e2) { const float o = __shfl(cand, e2); rank += (o > cand || (o == cand && e2 < lane)) ? 1 : 0; }
            const bool sel = (rank < TOPK) && (grank < 4);
            const float ssum = wave_sum(sel ? score : 0.f);
            if (sel) { idx[t * 8 + rank] = lane; gw[t * 8 + rank] = score / ssum * 2.5f; sel_e[lr * 8 + rank] = lane; sel_s[lr * 8 + rank] = __hip_atomic_fetch_add(lcnt + lane, 1, __ATOMIC_RELAXED, __HIP_MEMORY_SCOPE_WORKGROUP); }
        }
        __syncthreads();
        if (X.tid < 64) { const int n = lcnt[X.tid]; lbase[X.tid] = n ? atomicAdd(cntg + X.tid, n) : 0; }
        __syncthreads();
        { const int lr = X.tid >> 3, k = X.tid & 7, t = rb * 64 + lr, e = sel_e[lr * 8 + k], sl = lbase[e] + sel_s[lr * 8 + k];
          aslot[t * 8 + k] = sl; ltok[e * CAP + sl] = t; }
        __syncthreads();
    }
}
template <int NW>
DEV void ph_moe_conv(const Args& a, const Ctx& X, const int l, const int wg0) {
    unsigned char* ws = a.ws;
    if (X.wave >= NW) return;
    { LAS float* scr = (LAS float*)(X.lds + X.wave * 8704);
      const int gwv = (X.bid - wg0) * NW + X.wave, NGW = (X.G - wg0) * NW;
      constexpr int I_GU = (D / 64) * (512 / 32), I_D = (ED / 64) * (D / 32), I_E = I_GU + I_D;
      const float* eg = a.exp_gate + (size_t)l * NE * D * ED; const float* eu = a.exp_up + (size_t)l * NE * D * ED; const float* ed = a.exp_down + (size_t)l * NE * ED * D;
      for (int it = gwv; it < (NE + 1) * I_E; it += NGW) {
          const int e = it / I_E; int r = it - e * I_E;
          if (e < NE) {
              if (r < I_GU) conv_item(SrcGU{eg + (size_t)e * D * ED, (long)(eu - eg)}, ED, D, (bf16_t*)(ws + WS_WGU) + (size_t)e * 512 * D, scr, r, 16, X.lane);
              else conv_item(SrcIdent{ed + (size_t)e * ED * D}, D, ED, (bf16_t*)(ws + WS_WD) + (size_t)e * D * ED, scr, r - I_GU, D / 32, X.lane);
          } else {
              if (r < I_GU) conv_item(SrcGU{a.sh_gate + (size_t)l * D * ED, (long)(a.sh_up - a.sh_gate)}, ED, D, (bf16_t*)(ws + WS_WGUS), scr, r, 16, X.lane);
              else conv_item(SrcIdent{a.sh_down + (size_t)l * ED * D}, D, ED, (bf16_t*)(ws + WS_WDS), scr, r - I_GU, D / 32, X.lane);
          }
      } }
}

DEV int moe_tables(const Args& a, const Ctx& X, const int l, LAS int* t_cnt, LAS int* t_rb0, LAS int* t_eofrb) {
    const int* cntg = (const int*)(a.ws + WS_CTL + CTL_CNT) + l * NE;
    if (X.wave == 0) {
        const int c = __hip_atomic_load(cntg + X.lane, __ATOMIC_RELAXED, __HIP_MEMORY_SCOPE_AGENT), nrb = (c + 255) >> 8;
        int incl = nrb;
#pragma unroll
        for (int o = 1; o < 64; o <<= 1) { const int v = __shfl_up(incl, o); if (X.lane >= o) incl += v; }
        const int excl = incl - nrb;
        t_cnt[X.lane] = c; t_rb0[X.lane] = excl; if (X.lane == 63) t_rb0[64] = incl;
        for (int j = 0; j < nrb; ++j) t_eofrb[excl + j] = X.lane;
        t_eofrb[SH_RB + X.lane] = NE;
    }
    __syncthreads();
    return t_rb0[64];
}

DEV void ph_moe_gu(const Args& a, const Ctx& X, const int l) {
    LAS int* t_cnt = (LAS int*)(X.lds + AUX_OFF + 1024); LAS int* t_rb0 = t_cnt + 64; LAS int* t_eofrb = t_rb0 + 80; LAS int* toks = t_eofrb + NRB_ALL;
    const int nrbt = moe_tables(a, X, l, t_cnt, t_rb0, t_eofrb);
    const int* ltok = (const int*)(a.ws + WS_LTOK);
    pg8::Unit u;
    for (int i = 0; i < 8; ++i) { if (!pg8::moe_unit(i, 2, nrbt, X.G, X.bid, u)) break;
        if (X.tid < 256) { const int e = t_eofrb[u.pm]; int tok;
            if (e < NE) { const int sl = (u.pm - t_rb0[e]) * 256 + X.tid; tok = sl < t_cnt[e] ? ltok[e * CAP + sl] : 0; } else tok = (u.pm - SH_RB) * 256 + X.tid;
            toks[i * 256 + X.tid] = tok; } }
    VM_WAIT(); __syncthreads();
    pg8::SchedGU S{(const char*)(a.ws + WS_H), (const char*)(a.ws + WS_WGU), (const char*)(a.ws + WS_WGUS), t_eofrb, toks, nrbt, X.G, X.bid, 0};
    pg8::EpiGU E{(bf16_t*)(a.ws + WS_HID)};
    pg8::gemm_phase<pg8::EpiGU, pg8::SchedGU>(X.lds, D, S, E);
}
DEV void ph_moe_down(const Args& a, const Ctx& X, const int l) {
    LAS int* t_cnt = (LAS int*)(X.lds + AUX_OFF + 1024); LAS int* t_rb0 = t_cnt + 64; LAS int* t_eofrb = t_rb0 + 80;
    const int nrbt = moe_tables(a, X, l, t_cnt, t_rb0, t_eofrb);
    pg8::SchedDown S{(const char*)(a.ws + WS_HID), (const char*)(a.ws + WS_WD), (const char*)(a.ws + WS_WDS), t_eofrb, nrbt, X.G, X.bid, 0};
    pg8::EpiFp8 E{(unsigned char*)(a.ws + WS_Y), D, 0};
    int kd = ED; asm volatile("" : "+s"(kd));
    pg8::gemm_phase<pg8::EpiFp8, pg8::SchedDown>(X.lds, kd, S, E);
}
DEV void ph_combine(const Args& a, const Ctx& X, const int l) {
    LAS int* t_cnt = (LAS int*)(X.lds + AUX_OFF + 1024); LAS int* t_rb0 = t_cnt + 64; LAS int* t_eofrb = t_rb0 + 80;
    (void)moe_tables(a, X, l, t_cnt, t_rb0, t_eofrb);
    const float* mod = (const float*)(a.ws + WS_MOD);
    const int* idx = (const int*)(a.ws + WS_IDX); const float* gw = (const float*)(a.ws + WS_GW); const int* aslot = (const int*)(a.ws + WS_ASLOT);
    const unsigned char* y = a.ws + WS_Y; bf16_t* hb = (bf16_t*)(a.ws + WS_H);
    const int lane = X.lane;
    const int tstep = X.G * NWAVES;
    int t = X.bid * NWAVES + X.wave;
    int e_n = 0, s_n = 0; float g_n = 0.f;
    if (t < T && lane < 8) { e_n = idx[t * 8 + lane]; g_n = gw[t * 8 + lane]; s_n = aslot[t * 8 + lane]; }
    for (; t < T; t += tstep) {
        const int b = t / SEQ; const float* ml = mod + (size_t)(l * NB + b) * 6 * D;
        const int e_c = e_n, s_c = s_n; const float g_c = g_n;
        const int tn = t + tstep;
        if (tn < T && lane < 8) { e_n = idx[tn * 8 + lane]; g_n = gw[tn * 8 + lane]; s_n = aslot[tn * 8 + lane]; }
        u32x2 w0[9], w1[9];
        { const unsigned char* yr = y + ((size_t)SH_RB * 256 + t) * D; w0[8] = *(const u32x2*)(yr + 8 * lane); w1[8] = *(const u32x2*)(yr + 512 + 8 * lane); }
        float gk[8];
#pragma unroll
        for (int k = 0; k < 8; ++k) { const int e = __shfl(e_c, k), sl = __shfl(s_c, k); gk[k] = __shfl(g_c, k);
            const unsigned char* yr = y + ((size_t)t_rb0[e] * 256 + sl) * D; w0[k] = *(const u32x2*)(yr + 8 * lane); w1[k] = *(const u32x2*)(yr + 512 + 8 * lane); }
        float xv[16]; load_row8_bf((const bf16_t*)(a.ws + WS_XB) + (size_t)t * D, lane, xv);
        float yv[16];
#pragma unroll
        for (int i = 0; i < 16; ++i) yv[i] = 0.f;
        acc_row8(yv, w0[8], w1[8], 0.125f);
#pragma unroll
        for (int k = 0; k < 8; ++k) acc_row8(yv, w0[k], w1[k], gk[k] * 0.125f);
        resid_update8(xv, yv, a.ffn_post_g + l * D, ml + 5 * D, lane);
        if (l == 0) store_row8_bf((bf16_t*)(a.ws + WS_XB) + (size_t)t * D, lane, xv); else store_row8(a.out + (size_t)t * D, lane, xv);
        if (l == 0) { const float* mn = mod + (size_t)(1 * NB + b) * 6 * D; u32x4 o[2]; prenorm_pack8(xv, a.mix_pre_g + D, mn + D, mn, lane, o);
            *(u32x4*)(hb + (size_t)t * D + 8 * lane) = o[0]; *(u32x4*)(hb + (size_t)t * D + 512 + 8 * lane) = o[1]; }
    }
}

constexpr int NPH = 18;
__global__ void __launch_bounds__(NTHR, 2) mega(Args a) {
    extern __shared__ __attribute__((aligned(16))) unsigned char lds_raw[];
    Ctx X; X.lds = (LAS unsigned char*)lds_raw; X.tid = threadIdx.x; X.lane = X.tid & 63; X.wave = __builtin_amdgcn_readfirstlane(X.tid >> 6); X.G = gridDim.x; X.bid = blockIdx.x;
    if (X.tid < 4) ((LAS unsigned*)(X.lds + BAR_OFF))[X.tid] = 0u;
    __syncthreads();
    XcdBarrier bar; bar.bar = (unsigned*)(a.ws + WS_CTL); bar.x = 0; bar.st = nullptr;
    if (!MK_PER_PHASE) bar = xcd_barrier_post((unsigned*)(a.ws + WS_CTL), (volatile LAS unsigned*)(X.lds + BAR_OFF));
    const int lo = a.ph_lo, hi = a.ph_hi;
#define IN(k) (lo <= (k) && (k) < hi)
#define REP(k, ...) do { __VA_ARGS__; if constexpr (((PROBE_MASK >> (k)) & 1u) != 0u) { __syncthreads(); __VA_ARGS__; } } while (0)
#define SEAM(k) do { if (IN(k) && IN((k) + 1)) xcd_barrier(bar); else { VM_WAIT(); __syncthreads(); } } while (0)
    unsigned char* ws = a.ws;
    if (IN(0)) { REP(0, ph_setup(a, X)); SEAM(0); }
    if (IN(1)) { REP(1, ph_prenorm0(a, X)); SEAM(1); }
    if constexpr (((PROBE_MASK >> 24) & 1u) != 0u) { for (int i_ = 0; i_ < 16; ++i_) xcd_barrier(bar); }
    if (IN(2)) {
        pg8::SchedDense S; S.so.init(T, NPROJ, X.G, X.bid); S.A = (const char*)(ws + WS_H); S.Bt = (const char*)(ws + WS_WIN); S.K = D; S.pad_ = 0;
        pg8::EpiProj E{(bf16_t*)(ws + WS_QKVPRE), (bf16_t*)(ws + WS_ZA), (bf16_t*)(ws + WS_XBCPRE), (bf16_t*)(ws + WS_ZB), (float*)(ws + WS_SMALL)};
        REP(2, pg8::gemm_phase<pg8::EpiProj, pg8::SchedDense>(X.lds, D, S, E)); SEAM(2); }
    if (IN(3)) { REP(3, ph_gdn_local(a, X)); REP(20, ph_ssd_local(a, X)); SEAM(3); }
    if (IN(4)) {
        if (X.bid < 32) { REP(4, ph_gdn_scan(a, X)); }
        else { ph_ssd_scan(a, X, 32); group_barrier((unsigned*)(ws + WS_CTL + CTL_GRP), (unsigned)(X.G - 32)); __syncthreads(); ph_ssd_out(a, X, 32); __syncthreads(); ph_moe_conv<2>(a, X, 0, 32); __syncthreads(); ph_setup_late(a, X, 32); }
        SEAM(4); }
    if (IN(6)) {
        pg8::SchedDense S; S.so.init(T, D, X.G, X.bid); S.A = (const char*)(ws + WS_OY); S.Bt = (const char*)(ws + WS_WOUT); S.K = 2048; S.pad_ = 0;
        pg8::EpiBf16 E{(bf16_t*)(ws + WS_YMIX), D, 0};
        REP(6, pg8::gemm_phase<pg8::EpiBf16, pg8::SchedDense>(X.lds, 2048, S, E)); SEAM(6); }
    if (IN(7)) { ph_router(a, X, 0); SEAM(7); }
    if (IN(8)) { REP(8, ph_moe_gu(a, X, 0)); SEAM(8); }
    if (IN(9)) { REP(9, ph_moe_down(a, X, 0)); SEAM(9); }
    if (IN(10)) { ph_combine(a, X, 0); SEAM(10); }
    if (IN(11)) {
        pg8::SchedDense S; S.so.init(T, 3072, X.G, X.bid); S.A = (const char*)(ws + WS_H); S.Bt = (const char*)(ws + WS_WQKV); S.K = D; S.pad_ = 0;
        pg8::EpiQKV E{(bf16_t*)(ws + WS_Q1KV), (const float*)(ws + WS_COS), (const float*)(ws + WS_SIN)};
        REP(11, pg8::gemm_phase<pg8::EpiQKV, pg8::SchedDense>(X.lds, D, S, E)); SEAM(11); }
    if (IN(12)) { REP(12, ph_attn(a, X)); SEAM(12); }
    if (IN(13)) {
        pg8::SchedDense S; S.so.init(T, D, X.G, X.bid); S.A = (const char*)(ws + WS_O1); S.Bt = (const char*)(ws + WS_WO); S.K = D; S.pad_ = 0;
        pg8::EpiBf16 E{(bf16_t*)(ws + WS_YMIX), D, 0};
        REP(13, pg8::gemm_phase<pg8::EpiBf16, pg8::SchedDense>(X.lds, D, S, E)); SEAM(13); }
    if (IN(14)) { ph_router(a, X, 1); REP(14, ph_moe_conv<8>(a, X, 1, 0)); SEAM(14); }
    if (IN(15)) { ph_moe_gu(a, X, 1); SEAM(15); }
    if (IN(16)) { ph_moe_down(a, X, 1); SEAM(16); }
    if (IN(17)) { REP(17, ph_combine(a, X, 1)); }
#undef IN
#undef SEAM
}

extern "C" void kernel_launch(void* const* d_in, const int* in_sizes, int n_in, void* d_out, int out_size, void* d_ws, size_t ws_size, hipStream_t stream) {
    static int grid = 0;
    if (!grid) {
        int dev = 0, cus = 0, per_cu = 0;
        if (hipGetDevice(&dev) != hipSuccess || hipDeviceGetAttribute(&cus, hipDeviceAttributeMultiprocessorCount, dev) != hipSuccess) { fprintf(stderr, "kernel_launch: device query failed\n"); grid = -1; return; }
        if (hipFuncSetAttribute((const void*)mega, hipFuncAttributeMaxDynamicSharedMemorySize, LDS_BYTES) != hipSuccess) { fprintf(stderr, "kernel_launch: hipFuncSetAttribute failed\n"); grid = -1; return; }
        if (hipOccupancyMaxActiveBlocksPerMultiprocessor(&per_cu, (const void*)mega, NTHR, LDS_BYTES) != hipSuccess || per_cu < 1) { fprintf(stderr, "kernel_launch: occupancy query says %d blocks per CU\n", per_cu); grid = -1; return; }
        grid = cus;
        if (grid < 64 || (grid & 7)) { fprintf(stderr, "kernel_launch: unsupported CU count %d\n", cus); grid = -1; return; }
    }
    if (grid < 0) return;
    if (ws_size < WS_END || n_in != 31) { fprintf(stderr, "kernel_launch: workspace %zu < %zu or n_in %d != 31\n", ws_size, (size_t)WS_END, n_in); return; }
    if (hipMemsetAsync((char*)d_ws + WS_CTL, 0, CTL_BYTES, stream) != hipSuccess) { fprintf(stderr, "kernel_launch: memset failed\n"); return; }
    Args a{};
    a.x = (const float*)d_in[0]; a.c = (const float*)d_in[1]; a.pos = (const int*)d_in[2]; a.mod_w = (const float*)d_in[3]; a.mod_b = (const float*)d_in[4];
    a.mix_pre_g = (const float*)d_in[5]; a.mix_post_g = (const float*)d_in[6]; a.ffn_pre_g = (const float*)d_in[7]; a.ffn_post_g = (const float*)d_in[8];
    a.ssm_w_in = (const float*)d_in[9]; a.gdn_conv_w = (const float*)d_in[10]; a.gdn_a_log = (const float*)d_in[11]; a.gdn_dt_bias = (const float*)d_in[12]; a.gdn_norm_w = (const float*)d_in[13];
    a.ssd_conv_w = (const float*)d_in[14]; a.ssd_conv_b = (const float*)d_in[15]; a.ssd_a_log = (const float*)d_in[16]; a.ssd_dt_bias = (const float*)d_in[17]; a.ssd_d = (const float*)d_in[18]; a.ssd_norm_w = (const float*)d_in[19];
    a.ssm_w_out = (const float*)d_in[20]; a.attn_w_qkv = (const float*)d_in[21]; a.attn_w_o = (const float*)d_in[22];
    a.router_w = (const float*)d_in[23]; a.router_bias = (const float*)d_in[24]; a.exp_gate = (const float*)d_in[25]; a.exp_up = (const float*)d_in[26]; a.exp_down = (const float*)d_in[27];
    a.sh_gate = (const float*)d_in[28]; a.sh_up = (const float*)d_in[29]; a.sh_down = (const float*)d_in[30];
    a.out = (float*)d_out; a.ws = (unsigned char*)d_ws;
#if MK_PER_PHASE
    for (int p = 0; p < NPH; ++p) { a.ph_lo = p; a.ph_hi = p + 1; hipLaunchKernelGGL(mega, dim3(grid), dim3(NTHR), LDS_BYTES, stream, a); }
#else
    a.ph_lo = 0; a.ph_hi = NPH;
    hipLaunchKernelGGL(mega, dim3(grid), dim3(NTHR), LDS_BYTES, stream, a);
#endif
}
```

```cpp
#include <hip/hip_runtime.h>
#include <stdint.h>
#include <stdio.h>

#define DEV __device__ __forceinline__
#define LAS __attribute__((address_space(3)))
typedef unsigned short bf16_t;
typedef short bf16x8 __attribute__((ext_vector_type(8)));
typedef float f32x4 __attribute__((ext_vector_type(4)));
typedef float f32x2 __attribute__((ext_vector_type(2)));
typedef unsigned u32x4 __attribute__((ext_vector_type(4)));
typedef unsigned u32x2 __attribute__((ext_vector_type(2)));
typedef float f32x16 __attribute__((ext_vector_type(16)));
typedef short s16x4 __attribute__((ext_vector_type(4)));

#ifndef PROBE_MASK
#define PROBE_MASK 0u
#endif
#ifndef MK_PER_PHASE
#define MK_PER_PHASE 0
#endif

constexpr int NB = 4, SEQ = 4096, T = NB * SEQ, D = 1024;
constexpr int PROJ = 6688, NPROJ = 6912;
constexpr int C_BETA = 4096, C_XBC = 4112, C_ZB = 5648, C_DT = 6672;
constexpr int NE = 64, TOPK = 8, ED = 256, CAP = 16384;
constexpr int SH_RB = 576;
constexpr int NRB_ALL = SH_RB + 64;
constexpr float EPS = 1e-6f;
constexpr int NTHR = 512, NWAVES = 8;
constexpr int LDS_BYTES = 163840;
constexpr int AUX_OFF = 131072;
constexpr int BAR_OFF = LDS_BYTES - 16;

constexpr size_t MiB = 1u << 20;
constexpr size_t WS_CTL = 0, CTL_BYTES = 65536;
constexpr size_t CTL_CNT = 16384;
constexpr size_t CTL_GRP = 20480;
constexpr size_t WS_MOD = 65536;
constexpr size_t WS_COS = 1 * MiB, WS_SIN = 3 * MiB;
constexpr size_t WS_IDX = 5 * MiB, WS_GW = 5 * MiB + 512 * 1024, WS_ASLOT = 6 * MiB, WS_LTOK = 6 * MiB + 512 * 1024;
constexpr size_t WS_SMALL = 11 * MiB;
constexpr size_t WS_WIN = 16 * MiB, WS_WOUT = 30 * MiB, WS_WQKV = 34 * MiB, WS_WO = 40 * MiB;
constexpr size_t WS_H = 44 * MiB;
constexpr size_t WS_QKVPRE = 78 * MiB, WS_XBCPRE = 174 * MiB, WS_ZA = 222 * MiB, WS_ZB = 254 * MiB;
constexpr size_t WS_CC = 16 * MiB, WS_ACUM = 25 * MiB, WS_CDEC = 26 * MiB, WS_YDIAG = 44 * MiB, WS_STATES = 430 * MiB;
constexpr size_t WS_GI = 286 * MiB, GI_UNIT = 73728, WS_GTMP = 462 * MiB, WS_GLAST = 27 * MiB;
constexpr size_t WS_OY = 78 * MiB, WS_YMIX = 286 * MiB, WS_XB = 240 * MiB;
constexpr size_t WS_WD = 478 * MiB, WS_WDS = 510 * MiB + 512 * 1024, WS_HID = 398 * MiB, WS_Y = 78 * MiB, WS_WGU = 142 * MiB, WS_WGUS = 207 * MiB;
constexpr size_t WS_Q1KV = 78 * MiB, WS_O1 = 174 * MiB, WS_PO = 350 * MiB, WS_PLSE = 446 * MiB;
constexpr size_t WS_END = 512 * MiB;

struct Args {
    const float* x; const float* c; const int* pos; const float* mod_w; const float* mod_b;
    const float* mix_pre_g; const float* mix_post_g; const float* ffn_pre_g; const float* ffn_post_g;
    const float* ssm_w_in; const float* gdn_conv_w; const float* gdn_a_log; const float* gdn_dt_bias; const float* gdn_norm_w;
    const float* ssd_conv_w; const float* ssd_conv_b; const float* ssd_a_log; const float* ssd_dt_bias; const float* ssd_d; const float* ssd_norm_w;
    const float* ssm_w_out; const float* attn_w_qkv; const float* attn_w_o;
    const float* router_w; const float* router_bias; const float* exp_gate; const float* exp_up; const float* exp_down;
    const float* sh_gate; const float* sh_up; const float* sh_down;
    float* out; unsigned char* ws; int ph_lo, ph_hi;
};

DEV float bf2f(bf16_t v) { return __uint_as_float(((unsigned)v) << 16); }
DEV unsigned f2bf(float f) { unsigned u = __float_as_uint(f); return (u + 0x7FFFu + ((u >> 16) & 1u)) >> 16; }
DEV unsigned pk2(float lo, float hi) { return f2bf(lo) | (f2bf(hi) << 16); }
DEV float wave_sum(float v) {
#pragma unroll
    for (int o = 32; o > 0; o >>= 1) v += __shfl_xor(v, o);
    return v;
}
DEV float siluf(float x) { return x / (1.f + __expf(-x)); }
DEV float sigmoidf_(float x) { return 1.f / (1.f + __expf(-x)); }
DEV float softplusf(float x) { return fmaxf(x, 0.f) + log1pf(__expf(-fabsf(x))); }
#define LDS_WAIT() asm volatile("s_waitcnt lgkmcnt(0)" ::: "memory")
#define VM_WAIT() asm volatile("s_waitcnt vmcnt(0)" ::: "memory")

#define XB_TMO      128
#define XB_XCNT(j)  (256  + 64 * (j))
#define XB_XSUB(j)  (1280 + 64 * (j))
#define XB_XGEN(j)  (2304 + 64 * (j))
#define XB_TOP      3328
#define XB_TOPGEN   3392
#define XCD_BAR_WORDS 3456
#define XB_SPIN_CAP (1u << 18)
#define LAS __attribute__((address_space(3)))

__device__ __forceinline__ unsigned xb_ld(unsigned* p)              { return __hip_atomic_load(p, __ATOMIC_RELAXED, __HIP_MEMORY_SCOPE_AGENT); }
__device__ __forceinline__ unsigned xb_add(unsigned* p, unsigned v) { return __hip_atomic_fetch_add(p, v, __ATOMIC_RELAXED, __HIP_MEMORY_SCOPE_AGENT); }
__device__ __forceinline__ unsigned xb_xcc_id() { return (unsigned)__builtin_amdgcn_s_getreg((3 << 11) | 20) & 0xFu; }
#define XB_SPIN(cond, bar) do { unsigned _sp = 0; while (cond) { __builtin_amdgcn_s_sleep(1); \
    if ((++_sp & 255u) == 0u) { if (xb_ld(&(bar)[XB_TMO])) break; if (_sp > XB_SPIN_CAP) { atomicAdd(&(bar)[XB_TMO], 1u); break; } } } } while (0)

struct XcdBarrier {
    unsigned* bar; unsigned x;
    volatile LAS unsigned* st;
};

__device__ __forceinline__ XcdBarrier xcd_barrier_post(unsigned* bar, volatile LAS unsigned* st) {
    XcdBarrier b; b.bar = bar; b.x = xb_xcc_id(); b.st = st;
    if (threadIdx.x == 0) (void)xb_add(&bar[XB_XCNT(b.x)], 1u);
    return b;
}
__device__ __forceinline__ void xcd_barrier_complete(unsigned* bar, unsigned x, unsigned& nloc, unsigned& nx) {
    const unsigned G = gridDim.x * gridDim.y * gridDim.z;
    unsigned sum, cnt, mine, sp = 0u;
    for (;;) {
        sum = 0u; cnt = 0u; mine = 0u;
#pragma unroll
        for (unsigned j = 0; j < 16; ++j) { const unsigned c = xb_ld(&bar[XB_XCNT(j)]); sum += c; cnt += (c > 0u) ? 1u : 0u; mine = (j == x) ? c : mine; }
        if (sum == G) break;
        __builtin_amdgcn_s_sleep(1);
        if ((++sp & 255u) == 0u) { if (xb_ld(&bar[XB_TMO])) break; if (sp > XB_SPIN_CAP) { atomicAdd(&bar[XB_TMO], 1u); break; } }
    }
    nloc = mine > 0u ? mine : 1u; nx = cnt > 0u ? cnt : 1u;
}

__device__ __forceinline__ void xcd_barrier(const XcdBarrier& b) {
    asm volatile("s_waitcnt vmcnt(0)" ::: "memory");
    __syncthreads();
    if (threadIdx.x == 0) {
        unsigned* bar = b.bar;
        __builtin_amdgcn_s_waitcnt(0);
        unsigned nloc = b.st[0], nx = b.st[1];
        if (nloc == 0u) { xcd_barrier_complete(bar, b.x, nloc, nx); b.st[0] = nloc; b.st[1] = nx; }
        const unsigned old = xb_add(&bar[XB_XSUB(b.x)], 1u);
        const unsigned gen = old / nloc;
        if (old + 1u == (gen + 1u) * nloc) {
            __builtin_amdgcn_fence(__ATOMIC_RELEASE, "agent");
            asm volatile("s_waitcnt vmcnt(0)" ::: "memory");
            const unsigned og = xb_add(&bar[XB_TOP], 1u);
            const unsigned tg = og / nx;
            if (og + 1u == (tg + 1u) * nx) xb_add(&bar[XB_TOPGEN], 1u);
            else XB_SPIN(xb_ld(&bar[XB_TOPGEN]) == tg, bar);
            __builtin_amdgcn_fence(__ATOMIC_ACQUIRE, "agent");
            xb_add(&bar[XB_XGEN(b.x)], 1u);
            asm volatile("s_waitcnt vmcnt(0)" ::: "memory");
        } else {
            XB_SPIN(xb_ld(&bar[XB_XGEN(b.x)]) == gen, bar);
            __builtin_amdgcn_fence(__ATOMIC_ACQUIRE, "agent");
            asm volatile("s_waitcnt vmcnt(0)" ::: "memory");
        }
    }
    __syncthreads();
}


DEV void group_barrier(unsigned* ctr, const unsigned n) {
    asm volatile("s_waitcnt vmcnt(0)" ::: "memory");
    __syncthreads();
    if (threadIdx.x == 0) {
        __builtin_amdgcn_fence(__ATOMIC_RELEASE, "agent");
        asm volatile("s_waitcnt vmcnt(0)" ::: "memory");
        (void)__hip_atomic_fetch_add(ctr, 1u, __ATOMIC_RELAXED, __HIP_MEMORY_SCOPE_AGENT);
        unsigned sp = 0;
        while (__hip_atomic_load(ctr, __ATOMIC_RELAXED, __HIP_MEMORY_SCOPE_AGENT) < n) { __builtin_amdgcn_s_sleep(2); if (++sp > (1u << 22)) break; }
        __builtin_amdgcn_fence(__ATOMIC_ACQUIRE, "agent");
        asm volatile("s_waitcnt vmcnt(0)" ::: "memory");
    }
    __syncthreads();
}

namespace pg8 {
constexpr int BM = 256, BK = 64, HALF = 128, HTB = HALF * BK * 2, STAGE_BYTES = 8 * HTB, NXCD = 8, WGM = 8;
DEV int lds_byte(int r, int c) { const int st = (r >> 4) * 2 + (c >> 5), rr = r & 15, cc = c & 31, ob = rr * 64 + cc * 2; return st * 1024 + (ob ^ (((ob >> 9) & 1) << 5)); }
DEV void stage_rc(int b, int& R, int& C) { const int st = b / 1024, sb = b % 1024, swz = sb ^ (((sb >> 9) & 1) << 5); R = (st >> 1) * 16 + swz / 64; C = (st & 1) * 32 + (swz % 64) / 2; }
DEV int perm32(int rho) { const int n = rho >> 4, i = rho & 15; return 8 * (i >> 2) + 4 * n + (i & 3); }
struct Unit { int pm, pn, e, slot; };
struct StaticOrder {
    int nM, nN, nwg, G, c;
    DEV void init(int M, int N, int G_, int c_) { nM = M / BM; nN = N / BM; nwg = nM * nN; G = G_; c = c_; }
    DEV bool next(int i, int& pm, int& pn) const {
        const long L = (long)i * G + c; if (L >= nwg) return false;
        int wgid = (int)L; { const int q = nwg / NXCD, r = nwg % NXCD, xcd = wgid % NXCD, off = wgid / NXCD; wgid = (xcd < r ? xcd * (q + 1) : r * (q + 1) + (xcd - r) * q) + off; }
        const int nig = WGM * nN, gid = wgid / nig, fm = gid * WGM, gsz = (nM - fm) < WGM ? (nM - fm) : WGM;
        pm = fm + ((wgid % nig) % gsz); pn = (wgid % nig) / gsz; return true;
    }
};
typedef __bf16 bf16x2_t __attribute__((ext_vector_type(2)));
DEV unsigned cvt_pk_bf16(float lo, float hi) { const bf16x2_t v = {(__bf16)lo, (__bf16)hi}; return __builtin_bit_cast(unsigned, v); }
DEV u32x4 pack8(const f32x4 a, const f32x4 b) { u32x4 w; w.x = cvt_pk_bf16(a[0], a[1]); w.y = cvt_pk_bf16(a[2], a[3]); w.z = cvt_pk_bf16(b[0], b[1]); w.w = cvt_pk_bf16(b[2], b[3]); return w; }

typedef int v8i_t __attribute__((ext_vector_type(8)));
template <class Epi, class Sched, bool F8 = false>
DEV void gemm_phase(LAS unsigned char* lds, const int K, const Sched& S, const Epi& E) {
    const int tid = threadIdx.x, wid = __builtin_amdgcn_readfirstlane(tid >> 6), lane = tid & 63, wr = wid >> 2, wc = wid & 3, fr = lane & 15, fq = lane >> 4;
    const int nt = F8 ? K / 128 : K / BK;
    const int pitch = F8 ? K : 2 * K;
    unsigned voffB[2];
#pragma unroll
    for (int i = 0; i < 2; ++i) { int R, C; stage_rc(tid * 16 + i * 8192, R, C); const int Rb = Epi::PERM ? ((R & ~31) + perm32(R & 31)) : R; voffB[i] = (unsigned)(Rb * pitch + 2 * C); }
    const unsigned kstep = (unsigned)(BK * 2);
    const size_t hstep = (size_t)HALF * pitch;
    const unsigned ldsw = (unsigned)wid * 1024u;
    const int aoff = lds_byte(wr * 64 + fr, fq * 8), boff = lds_byte(wc * 32 + fr, fq * 8);
    const size_t hsA = Sched::GATHER ? (size_t)0 : hstep;
#define PG8_SA(b, h) (((b) * 2 + (h)) * HTB)
#define PG8_SB(b, h) ((4 + (b) * 2 + (h)) * HTB)
#define PG8_STAGEB(bufoff, gbase) do { _Pragma("unroll") for (int _i = 0; _i < 2; ++_i) \
        __builtin_amdgcn_global_load_lds((const unsigned*)((const char*)(gbase) + voffB[_i]), (LAS unsigned*)(lds + (bufoff) + ldsw + _i * 8192), 16, 0, 0); } while (0)
#define PG8_STAGEA(bufoff, gbase, VO) do { _Pragma("unroll") for (int _i = 0; _i < 2; ++_i) \
        __builtin_amdgcn_global_load_lds((const unsigned*)((const char*)(gbase) + (VO)[_i]), (LAS unsigned*)(lds + (bufoff) + ldsw + _i * 8192), 16, 0, 0); } while (0)
#define PG8_LD8(var, base) do { const u32x4 _l0 = *(const LAS u32x4*)(lds + (base)), _l1 = *(const LAS u32x4*)(lds + (base) + 1024); var = __builtin_shufflevector(_l0, _l1, 0, 1, 2, 3, 4, 5, 6, 7); } while (0)
#define PG8_LDA(dst, b, h) do { if constexpr (F8) { PG8_LD8(dst##8_0, PG8_SA(b, h) + aoff); PG8_LD8(dst##8_1, PG8_SA(b, h) + aoff + 2048); PG8_LD8(dst##8_2, PG8_SA(b, h) + aoff + 4096); PG8_LD8(dst##8_3, PG8_SA(b, h) + aoff + 6144); } \
        else { _Pragma("unroll") for (int m = 0; m < 4; ++m) _Pragma("unroll") for (int k = 0; k < 2; ++k) dst[m][k] = *(const LAS bf16x8*)(lds + PG8_SA(b, h) + aoff + m * 2048 + k * 1024); } } while (0)
#define PG8_LDB(dst, b, h) do { if constexpr (F8) { PG8_LD8(dst##8_0, PG8_SB(b, h) + boff); PG8_LD8(dst##8_1, PG8_SB(b, h) + boff + 2048); } \
        else { _Pragma("unroll") for (int n = 0; n < 2; ++n) _Pragma("unroll") for (int k = 0; k < 2; ++k) dst[n][k] = *(const LAS bf16x8*)(lds + PG8_SB(b, h) + boff + n * 2048 + k * 1024); } } while (0)
#define PG8_M8(ai, bj, m, n, A8, B8) asm volatile("v_mfma_scale_f32_16x16x128_f8f6f4 %0, %1, %2, %0, %3, %4 op_sel_hi:[0,0,0]" : "+v"(acc[ai][bj][m][n]) : "v"(B8), "v"(A8), "v"(wsc_), "v"(asc_))
#define PG8_MMA(ai, bj, At, Bt) do { __builtin_amdgcn_s_setprio(1); \
        if constexpr (F8) { PG8_M8(ai, bj, 0, 0, At##8_0, Bt##8_0); PG8_M8(ai, bj, 0, 1, At##8_0, Bt##8_1); PG8_M8(ai, bj, 1, 0, At##8_1, Bt##8_0); PG8_M8(ai, bj, 1, 1, At##8_1, Bt##8_1); \
                            PG8_M8(ai, bj, 2, 0, At##8_2, Bt##8_0); PG8_M8(ai, bj, 2, 1, At##8_2, Bt##8_1); PG8_M8(ai, bj, 3, 0, At##8_3, Bt##8_0); PG8_M8(ai, bj, 3, 1, At##8_3, Bt##8_1); } \
        else { _Pragma("unroll") for (int m = 0; m < 4; ++m) _Pragma("unroll") for (int n = 0; n < 2; ++n) _Pragma("unroll") for (int k = 0; k < 2; ++k) acc[ai][bj][m][n] = __builtin_amdgcn_mfma_f32_16x16x32_bf16(Bt[n][k], At[m][k], acc[ai][bj][m][n], 0, 0, 0); } \
        __builtin_amdgcn_s_setprio(0); } while (0)
#define PG8_WAIT_V(n) asm volatile("s_waitcnt vmcnt(" #n ")" ::: "memory")
#define PG8_WAIT_L(n) asm volatile("s_waitcnt lgkmcnt(" #n ")" ::: "memory")
#define PG8_BAR __builtin_amdgcn_s_barrier()
#define PG8_SCHED __builtin_amdgcn_sched_barrier(0)
    Unit cur, nxt; int ui = 0;
    if (!S.next(0, cur)) return;
    f32x4 acc[2][2][4][2];
#pragma unroll
    for (int a = 0; a < 2; ++a)
#pragma unroll
        for (int b = 0; b < 2; ++b)
#pragma unroll
            for (int m = 0; m < 4; ++m)
#pragma unroll
                for (int n = 0; n < 2; ++n) acc[a][b][m][n] = (f32x4){0.f, 0.f, 0.f, 0.f};
    bf16x8 At[4][2], B0[2][2], B1[2][2];
    typedef unsigned u32x8_t __attribute__((ext_vector_type(8)));
    u32x8_t At8_0, At8_1, At8_2, At8_3, B08_0, B08_1, B18_0, B18_1;
    const int wsc_ = Sched::WSCALE, asc_ = 0x7F7F7F7F;
    unsigned va[2][2];
    S.a_voff(cur, tid, va);
    const char* cA = S.a_ptr(cur);
    const char* cB = S.b_ptr(cur);
    PG8_STAGEB(PG8_SB(0, 0), cB); PG8_STAGEB(PG8_SB(0, 1), cB + hstep); PG8_STAGEA(PG8_SA(0, 0), cA, va[0]); PG8_STAGEA(PG8_SA(0, 1), cA + hsA, va[1]);
    if (wr == 1) PG8_BAR;
    PG8_WAIT_V(2); PG8_BAR;
    PG8_STAGEB(PG8_SB(1, 0), cB + kstep); PG8_STAGEA(PG8_SA(1, 0), cA + kstep, va[0]); PG8_STAGEB(PG8_SB(1, 1), cB + hstep + kstep);
    PG8_WAIT_V(6); PG8_BAR;
    for (;;) {
        const bool has_next = S.next(ui + 1, nxt);
        const char* nB = has_next ? S.b_ptr(nxt) : cB;
        const char* nA = has_next ? S.a_ptr(nxt) : cA;
        for (int t = 0; t < nt; t += 2) {
            const bool last = (t == nt - 2);
            const char* a1 = cA + (size_t)(t + 1) * kstep;
            const char* a2 = last ? nA : cA + (size_t)(t + 2) * kstep; const char* a3 = a2 + kstep;
            unsigned v2[2][2];
            v2[0][0] = va[0][0]; v2[0][1] = va[0][1]; v2[1][0] = va[1][0]; v2[1][1] = va[1][1];
            if constexpr (Sched::GATHER) { if (last && has_next) S.a_voff(nxt, tid, v2); }
            const char* b2 = last ? nB : cB + (size_t)(t + 2) * kstep; const char* b3 = b2 + kstep;
            PG8_LDB(B0, 0, 0); PG8_LDB(B1, 0, 1); PG8_SCHED; PG8_LDA(At, 0, 0); PG8_STAGEA(PG8_SA(1, 1), a1 + hsA, va[1]);
            PG8_WAIT_V(8); PG8_WAIT_L(0); PG8_BAR; PG8_MMA(0, 0, At, B0); PG8_MMA(0, 1, At, B1); PG8_BAR; PG8_SCHED;
            PG8_LDA(At, 0, 1); PG8_STAGEB(PG8_SB(0, 0), b2); PG8_STAGEB(PG8_SB(0, 1), b2 + hstep); PG8_STAGEA(PG8_SA(0, 0), a2, v2[0]);
            PG8_WAIT_V(8); PG8_WAIT_L(0); PG8_BAR; PG8_MMA(1, 0, At, B0); PG8_MMA(1, 1, At, B1); PG8_BAR; PG8_SCHED;
            PG8_LDB(B0, 1, 0); PG8_LDB(B1, 1, 1); PG8_SCHED; PG8_LDA(At, 1, 0); PG8_STAGEA(PG8_SA(0, 1), a2 + hsA, v2[1]);
            PG8_WAIT_V(8); PG8_WAIT_L(0); PG8_BAR; PG8_MMA(0, 0, At, B0); PG8_MMA(0, 1, At, B1); PG8_BAR; PG8_SCHED;
            PG8_LDA(At, 1, 1); PG8_STAGEB(PG8_SB(1, 0), b3); PG8_STAGEB(PG8_SB(1, 1), b3 + hstep); PG8_STAGEA(PG8_SA(1, 0), a3, v2[0]);
            PG8_WAIT_V(8); PG8_WAIT_L(0); PG8_BAR; PG8_MMA(1, 0, At, B0); PG8_MMA(1, 1, At, B1); PG8_BAR; PG8_SCHED;
        }
        if (wr == 0) PG8_BAR;
        if constexpr (F8) asm volatile("s_nop 15\n\ts_nop 15" ::: "memory");
        E(acc, cur, wr, wc, fr, fq);
        if (!has_next) break;
#pragma unroll
        for (int a = 0; a < 2; ++a)
#pragma unroll
            for (int b = 0; b < 2; ++b)
#pragma unroll
                for (int m = 0; m < 4; ++m)
#pragma unroll
                    for (int n = 0; n < 2; ++n) acc[a][b][m][n] = (f32x4){0.f, 0.f, 0.f, 0.f};
        cur = nxt; cB = nB; cA = nA; ++ui;
        if constexpr (Sched::GATHER) S.a_voff(cur, tid, va);
        if (wr == 1) PG8_BAR;
    }
    PG8_WAIT_V(0);
    PG8_BAR;
#undef PG8_SA
#undef PG8_SB
#undef PG8_STAGEA
#undef PG8_STAGEB
#undef PG8_LDA
#undef PG8_LD8
#undef PG8_M8
#undef PG8_LDB
#undef PG8_MMA
#undef PG8_WAIT_V
#undef PG8_WAIT_L
#undef PG8_BAR
#undef PG8_SCHED
}

struct SchedDense {
    static constexpr bool GATHER = false; static constexpr int WSCALE = 0x7F7F7F7F;
    StaticOrder so; const char* A; const char* Bt; int K; int pad_;
    DEV bool next(int i, Unit& u) const { int pm, pn; if (!so.next(i, pm, pn)) return false; u.pm = pm; u.pn = pn; u.e = 0; u.slot = 0; return true; }
    DEV const char* a_ptr(const Unit& u) const { return A + (size_t)u.pm * 256 * K * 2; }
    DEV void a_voff(const Unit&, const int tid, unsigned (&vo)[2][2]) const {
#pragma unroll
        for (int i = 0; i < 2; ++i) { int R, C; stage_rc(tid * 16 + i * 8192, R, C); vo[0][i] = vo[1][i] = (unsigned)((R * K + C) * 2); }
    }
    DEV const char* b_ptr(const Unit& u) const { return Bt + (size_t)u.pn * 256 * K * 2; }
};
DEV bool moe_unit(int i, int NJ, int nrbt, int G, int c, Unit& u) {
    const int n = (nrbt + 64) * NJ; int L;
    if (G & 7) { L = i * G + c; if (L >= n) return false; }
    else { const int gq = G >> 3, per = (n + 7) >> 3, x = c & 7, q = c >> 3, j = i * gq + q; if (j >= per) return false; L = x * per + j; if (L >= n) return false; }
    int grb = L / NJ; const int pn = L - grb * NJ; if (grb >= nrbt) grb = SH_RB + (grb - nrbt);
    u.pm = grb; u.pn = pn; u.slot = i; u.e = 0; return true;
}
struct SchedGU {
    static constexpr bool GATHER = true; static constexpr int WSCALE = 0x79797979;
    const char* A; const char* Wgu; const char* Wgus; const LAS int* eofrb; const LAS int* toks; int nrbt, G, c, pad_;
    DEV bool next(int i, Unit& u) const { if (!moe_unit(i, 2, nrbt, G, c, u)) return false; u.e = __builtin_amdgcn_readfirstlane(eofrb[u.pm]); return true; }
    DEV const char* a_ptr(const Unit&) const { return A; }
    DEV void a_voff(const Unit& u, const int tid, unsigned (&vo)[2][2]) const {
#pragma unroll
        for (int i = 0; i < 2; ++i) { int R, C; stage_rc(tid * 16 + i * 8192, R, C);
#pragma unroll
            for (int h = 0; h < 2; ++h) { const int tok = toks[u.slot * 256 + h * 128 + R]; vo[h][i] = (unsigned)(tok * D + 2 * C); } }
    }
    DEV const char* b_ptr(const Unit& u) const { return (u.e < NE ? Wgu + (size_t)u.e * 512 * D : Wgus) + (size_t)u.pn * 256 * D; }
};
struct SchedDown {
    static constexpr bool GATHER = false; static constexpr int WSCALE = 0x7A7A7A7A;
    const char* A; const char* Wd; const char* Wds; const LAS int* eofrb; int nrbt, G, c, pad_;
    DEV bool next(int i, Unit& u) const { if (!moe_unit(i, 4, nrbt, G, c, u)) return false; u.e = __builtin_amdgcn_readfirstlane(eofrb[u.pm]); return true; }
    DEV const char* a_ptr(const Unit& u) const { return A + (size_t)u.pm * 256 * ED; }
    DEV void a_voff(const Unit&, const int tid, unsigned (&vo)[2][2]) const {
#pragma unroll
        for (int i = 0; i < 2; ++i) { int R, C; stage_rc(tid * 16 + i * 8192, R, C); vo[0][i] = vo[1][i] = (unsigned)(R * ED + 2 * C); }
    }
    DEV const char* b_ptr(const Unit& u) const { return (u.e < NE ? Wd + (size_t)u.e * D * ED : Wds) + (size_t)u.pn * 256 * ED; }
};

struct EpiProj {
    static constexpr bool PERM = true;
    bf16_t* qkv; bf16_t* za; bf16_t* xbc; bf16_t* zb; float* small;
    DEV void operator()(const f32x4 (&acc)[2][2][4][2], const Unit& u, int wr, int wc, int fr, int fq) const {
        const int row0 = u.pm * BM + wr * 64 + fr, pn = u.pn;
        if (pn == 26) {
            if (wc == 0) {
#pragma unroll
                for (int ai = 0; ai < 2; ++ai)
#pragma unroll
                    for (int m = 0; m < 4; ++m) { float* p = small + (size_t)(row0 + ai * HALF + m * 16) * 32 + 8 * fq; *(f32x4*)p = acc[ai][0][m][0]; *(f32x4*)(p + 4) = acc[ai][0][m][1]; }
            }
            return;
        }
        bf16_t* base; int ldc, ct;
        if (pn < 12) { base = qkv; ldc = 3072; ct = pn; } else if (pn < 16) { base = za; ldc = 1024; ct = pn - 12; } else if (pn < 22) { base = xbc; ldc = 1536; ct = pn - 16; } else { base = zb; ldc = 1024; ct = pn - 22; }
        const int col0 = ct * 256 + wc * 32 + 8 * fq;
#pragma unroll
        for (int ai = 0; ai < 2; ++ai)
#pragma unroll
            for (int m = 0; m < 4; ++m) { bf16_t* rowp = base + (size_t)(row0 + ai * HALF + m * 16) * ldc + col0;
#pragma unroll
                for (int bj = 0; bj < 2; ++bj) *(u32x4*)(rowp + bj * HALF) = pack8(acc[ai][bj][m][0], acc[ai][bj][m][1]); }
    }
};
struct EpiF32 {
    static constexpr bool PERM = false;
    float* Cp; int ldc; int pad_;
    DEV void operator()(const f32x4 (&acc)[2][2][4][2], const Unit& u, int wr, int wc, int fr, int fq) const {
        const int row0 = u.pm * BM + wr * 64 + fr, col0 = u.pn * BM + wc * 32 + 4 * fq;
#pragma unroll
        for (int ai = 0; ai < 2; ++ai)
#pragma unroll
            for (int m = 0; m < 4; ++m) { float* rowp = Cp + (size_t)(row0 + ai * HALF + m * 16) * ldc + col0;
#pragma unroll
                for (int bj = 0; bj < 2; ++bj)
#pragma unroll
                    for (int n = 0; n < 2; ++n) *(f32x4*)(rowp + bj * HALF + n * 16) = acc[ai][bj][m][n]; }
    }
};
struct EpiBf16 {
    static constexpr bool PERM = true;
    bf16_t* O; int ldc; int pad_;
    DEV void operator()(const f32x4 (&acc)[2][2][4][2], const Unit& u, int wr, int wc, int fr, int fq) const {
        const int row0 = u.pm * BM + wr * 64 + fr, col0 = u.pn * BM + wc * 32 + 8 * fq;
#pragma unroll
        for (int ai = 0; ai < 2; ++ai)
#pragma unroll
            for (int m = 0; m < 4; ++m) { bf16_t* rowp = O + (size_t)(row0 + ai * HALF + m * 16) * ldc + col0;
#pragma unroll
                for (int bj = 0; bj < 2; ++bj) *(u32x4*)(rowp + bj * HALF) = pack8(acc[ai][bj][m][0], acc[ai][bj][m][1]); }
    }
};
DEV u32x2 pack8_fp8(const f32x4 a, const f32x4 b) {
    f32x4 x = a, y = b;
#pragma unroll
    for (int i = 0; i < 4; ++i) { x[i] = fminf(fmaxf(x[i], -440.f), 440.f); y[i] = fminf(fmaxf(y[i], -440.f), 440.f); }
    int w0 = __builtin_amdgcn_cvt_pk_fp8_f32(x[0], x[1], 0, false); w0 = __builtin_amdgcn_cvt_pk_fp8_f32(x[2], x[3], w0, true);
    int w1 = __builtin_amdgcn_cvt_pk_fp8_f32(y[0], y[1], 0, false); w1 = __builtin_amdgcn_cvt_pk_fp8_f32(y[2], y[3], w1, true);
    return (u32x2){(unsigned)w0, (unsigned)w1};
}
struct EpiFp8 {
    static constexpr bool PERM = true;
    unsigned char* O; int ldc; int pad_;
    DEV void operator()(const f32x4 (&acc)[2][2][4][2], const Unit& u, int wr, int wc, int fr, int fq) const {
        const int row0 = u.pm * BM + wr * 64 + fr, col0 = u.pn * BM + wc * 32 + 8 * fq;
#pragma unroll
        for (int ai = 0; ai < 2; ++ai)
#pragma unroll
            for (int m = 0; m < 4; ++m) { unsigned char* rowp = O + (size_t)(row0 + ai * HALF + m * 16) * ldc + col0;
#pragma unroll
                for (int bj = 0; bj < 2; ++bj) { f32x4 a0 = acc[ai][bj][m][0] * 8.f, a1 = acc[ai][bj][m][1] * 8.f;
#pragma unroll
                    for (int i = 0; i < 4; ++i) { a0[i] = fminf(fmaxf(a0[i], -440.f), 440.f); a1[i] = fminf(fmaxf(a1[i], -440.f), 440.f); }
                    int w0 = __builtin_amdgcn_cvt_pk_fp8_f32(a0[0], a0[1], 0, false); w0 = __builtin_amdgcn_cvt_pk_fp8_f32(a0[2], a0[3], w0, true);
                    int w1 = __builtin_amdgcn_cvt_pk_fp8_f32(a1[0], a1[1], 0, false); w1 = __builtin_amdgcn_cvt_pk_fp8_f32(a1[2], a1[3], w1, true);
                    *(u32x2*)(rowp + bj * HALF) = (u32x2){(unsigned)w0, (unsigned)w1}; } }
    }
};
struct EpiGU {
    static constexpr bool PERM = true;
    unsigned char* H;
    DEV void operator()(const f32x4 (&acc)[2][2][4][2], const Unit& u, int wr, int wc, int fr, int fq) const {
        const int row0 = u.pm * BM + wr * 64 + fr, col0 = u.pn * HALF + wc * 32 + 8 * fq;
#pragma unroll
        for (int ai = 0; ai < 2; ++ai)
#pragma unroll
            for (int m = 0; m < 4; ++m) {
                f32x4 h0, h1;
#pragma unroll
                for (int i = 0; i < 4; ++i) { h0[i] = siluf(acc[ai][0][m][0][i]) * acc[ai][1][m][0][i]; h1[i] = siluf(acc[ai][0][m][1][i]) * acc[ai][1][m][1][i]; }
                *(u32x2*)(H + (size_t)(row0 + ai * HALF + m * 16) * ED + col0) = pack8_fp8(h0, h1);
            }
    }
};
struct EpiQKV {
    static constexpr bool PERM = true;
    bf16_t* O; const float* cosT; const float* sinT;
    DEV void operator()(const f32x4 (&acc)[2][2][4][2], const Unit& u, int wr, int wc, int fr, int fq) const {
        const int row0 = u.pm * BM + wr * 64 + fr, col0 = u.pn * BM + wc * 32 + 8 * fq;
        const bool rope = u.pn < 8; const float qs = u.pn < 4 ? 0.125f : 1.f;
#pragma unroll
        for (int ai = 0; ai < 2; ++ai)
#pragma unroll
            for (int m = 0; m < 4; ++m) {
                const int row = row0 + ai * HALF + m * 16;
                bf16_t* rowp = O + (size_t)row * 3072 + col0;
                if (rope) {
                    const f32x4 cs = *(const f32x4*)(cosT + (size_t)row * 32 + 16 * (wc & 1) + 4 * fq), sn = *(const f32x4*)(sinT + (size_t)row * 32 + 16 * (wc & 1) + 4 * fq);
#pragma unroll
                    for (int bj = 0; bj < 2; ++bj) { const f32x4 x1 = acc[ai][bj][m][0], x2 = acc[ai][bj][m][1];
                        *(u32x4*)(rowp + bj * HALF) = pack8((x1 * cs - x2 * sn) * qs, (x2 * cs + x1 * sn) * qs); }
                } else {
#pragma unroll
                    for (int bj = 0; bj < 2; ++bj) *(u32x4*)(rowp + bj * HALF) = pack8(acc[ai][bj][m][0], acc[ai][bj][m][1]);
                }
            }
    }
};
}

template <class SrcF, bool OUT8 = false>
DEV void conv_item(const SrcF& src, int ldw, int K, void* dstv, LAS float* scr, int item, int nblk, int lane, const float wscale = 1.f) {
    const int kb = item / nblk, nb = item - kb * nblk, k0 = 64 * kb, n0 = 32 * nb;
    const int quad = lane & 7, r0 = lane >> 3;
    const float* colp = src(n0 + 4 * quad);
    f32x4 v[8];
#pragma unroll
    for (int i = 0; i < 8; ++i) v[i] = colp ? *(const f32x4*)(colp + (size_t)(k0 + r0 + 8 * i) * ldw) : (f32x4){0.f, 0.f, 0.f, 0.f};
#pragma unroll
    for (int i = 0; i < 8; ++i) { LAS float* p = scr + (r0 + 8 * i) * 33 + 4 * quad; p[0] = v[i][0]; p[1] = v[i][1]; p[2] = v[i][2]; p[3] = v[i][3]; }
    LDS_WAIT(); asm volatile("" ::: "memory");
    const int c = lane & 7;
#pragma unroll
    for (int j = 0; j < 4; ++j) { const int n = (lane >> 3) + 8 * j; const LAS float* s = scr + (8 * c) * 33 + n;
        if constexpr (OUT8) {
            int w0 = __builtin_amdgcn_cvt_pk_fp8_f32(s[0 * 33] * wscale, s[1 * 33] * wscale, 0, false); w0 = __builtin_amdgcn_cvt_pk_fp8_f32(s[2 * 33] * wscale, s[3 * 33] * wscale, w0, true);
            int w1 = __builtin_amdgcn_cvt_pk_fp8_f32(s[4 * 33] * wscale, s[5 * 33] * wscale, 0, false); w1 = __builtin_amdgcn_cvt_pk_fp8_f32(s[6 * 33] * wscale, s[7 * 33] * wscale, w1, true);
            *(u32x2*)((unsigned char*)dstv + (size_t)(n0 + n) * K + k0 + 8 * c) = (u32x2){(unsigned)w0, (unsigned)w1};
        } else {
            u32x4 o; o.x = pk2(s[0 * 33], s[1 * 33]); o.y = pk2(s[2 * 33], s[3 * 33]); o.z = pk2(s[4 * 33], s[5 * 33]); o.w = pk2(s[6 * 33], s[7 * 33]);
            *(u32x4*)((bf16_t*)dstv + (size_t)(n0 + n) * K + k0 + 8 * c) = o; } }
    LDS_WAIT(); asm volatile("" ::: "memory");
}
struct SrcIdent { const float* W; DEV const float* operator()(int n) const { return W + n; } };
struct SrcWin { const float* W; DEV const float* operator()(int n) const {
    int s; if (n < 4096) s = n; else if (n < 5632) s = C_XBC + (n - 4096); else if (n < 6656) s = C_ZB + (n - 5632); else if (n < 6672) s = C_BETA + (n - 6656); else if (n < 6688) s = C_DT + (n - 6672); else return nullptr;
    return W + s; } };
struct SrcQKV { const float* W; DEV const float* operator()(int n) const {
    if (n >= 2048) return W + n; const int hd = n >> 6, cp = n & 63; return W + hd * 64 + 32 * ((cp >> 2) & 1) + 16 * (cp >> 5) + 4 * ((cp >> 3) & 3) + (cp & 3); } };
struct SrcGU { const float* Wg; long du; DEV const float* operator()(int r) const { const int j = r >> 8, rr = r & 255; return Wg + (rr < 128 ? 0l : du) + 128 * j + (rr & 127); } };

DEV void load_row(const float* p, int lane, float (&v)[16]) {
#pragma unroll
    for (int j = 0; j < 4; ++j) { const f32x4 t = *(const f32x4*)(p + j * 256 + lane * 4); v[4 * j] = t[0]; v[4 * j + 1] = t[1]; v[4 * j + 2] = t[2]; v[4 * j + 3] = t[3]; }
}
DEV void store_row(float* p, int lane, const float (&v)[16]) {
#pragma unroll
    for (int j = 0; j < 4; ++j) *(f32x4*)(p + j * 256 + lane * 4) = (f32x4){v[4 * j], v[4 * j + 1], v[4 * j + 2], v[4 * j + 3]};
}
DEV float row_rstd(const float (&v)[16]) { float ss = 0.f;
#pragma unroll
    for (int i = 0; i < 16; ++i) ss += v[i] * v[i];
    return rsqrtf(wave_sum(ss) * (1.f / D) + EPS); }
DEV void resid_update(float (&xv)[16], const float (&yv)[16], const float* gpost, const float* gt, int lane) {
    const float r = row_rstd(yv);
#pragma unroll
    for (int j = 0; j < 4; ++j) { const f32x4 g = *(const f32x4*)(gpost + j * 256 + lane * 4), t = *(const f32x4*)(gt + j * 256 + lane * 4);
#pragma unroll
        for (int i = 0; i < 4; ++i) xv[4 * j + i] += t[i] * (yv[4 * j + i] * r * g[i]); }
}
DEV void prenorm_pack(const float (&xv)[16], const float* gpre, const float* sc, const float* sh, int lane, u32x2 (&o)[4]) {
    const float r = row_rstd(xv);
#pragma unroll
    for (int j = 0; j < 4; ++j) { const f32x4 g = *(const f32x4*)(gpre + j * 256 + lane * 4), s = *(const f32x4*)(sc + j * 256 + lane * 4), b = *(const f32x4*)(sh + j * 256 + lane * 4);
        float h[4];
#pragma unroll
        for (int i = 0; i < 4; ++i) h[i] = xv[4 * j + i] * r * g[i] * (1.f + s[i]) + b[i];
        o[j] = (u32x2){pk2(h[0], h[1]), pk2(h[2], h[3])}; }
}

DEV void load_row8(const float* p, int lane, float (&v)[16]) {
#pragma unroll
    for (int j = 0; j < 2; ++j)
#pragma unroll
        for (int hh = 0; hh < 2; ++hh) { const f32x4 t = *(const f32x4*)(p + 512 * j + 8 * lane + 4 * hh); v[8 * j + 4 * hh] = t[0]; v[8 * j + 4 * hh + 1] = t[1]; v[8 * j + 4 * hh + 2] = t[2]; v[8 * j + 4 * hh + 3] = t[3]; }
}
DEV void store_row8(float* p, int lane, const float (&v)[16]) {
#pragma unroll
    for (int j = 0; j < 2; ++j)
#pragma unroll
        for (int hh = 0; hh < 2; ++hh) *(f32x4*)(p + 512 * j + 8 * lane + 4 * hh) = (f32x4){v[8 * j + 4 * hh], v[8 * j + 4 * hh + 1], v[8 * j + 4 * hh + 2], v[8 * j + 4 * hh + 3]};
}
DEV void resid_update8(float (&xv)[16], const float (&yv)[16], const float* gpost, const float* gt, int lane) {
    const float r = row_rstd(yv);
#pragma unroll
    for (int j = 0; j < 2; ++j)
#pragma unroll
        for (int hh = 0; hh < 2; ++hh) { const f32x4 g = *(const f32x4*)(gpost + 512 * j + 8 * lane + 4 * hh), t = *(const f32x4*)(gt + 512 * j + 8 * lane + 4 * hh);
#pragma unroll
            for (int i = 0; i < 4; ++i) xv[8 * j + 4 * hh + i] += t[i] * (yv[8 * j + 4 * hh + i] * r * g[i]); }
}
DEV void prenorm_pack8(const float (&xv)[16], const float* gpre, const float* sc, const float* sh, int lane, u32x4 (&o)[2]) {
    const float r = row_rstd(xv);
#pragma unroll
    for (int j = 0; j < 2; ++j) { float h[8];
#pragma unroll
        for (int hh = 0; hh < 2; ++hh) { const f32x4 g = *(const f32x4*)(gpre + 512 * j + 8 * lane + 4 * hh), s = *(const f32x4*)(sc + 512 * j + 8 * lane + 4 * hh), b = *(const f32x4*)(sh + 512 * j + 8 * lane + 4 * hh);
#pragma unroll
            for (int i = 0; i < 4; ++i) h[4 * hh + i] = xv[8 * j + 4 * hh + i] * r * g[i] * (1.f + s[i]) + b[i]; }
        o[j] = (u32x4){pk2(h[0], h[1]), pk2(h[2], h[3]), pk2(h[4], h[5]), pk2(h[6], h[7])}; }
}
DEV void acc_row8(float (&yv)[16], const u32x2 w0, const u32x2 w1, const float g) {
#pragma unroll
    for (int e = 0; e < 2; ++e) {
        yv[4 * e] += g * __builtin_amdgcn_cvt_f32_fp8((int)w0[e], 0); yv[4 * e + 1] += g * __builtin_amdgcn_cvt_f32_fp8((int)w0[e], 1); yv[4 * e + 2] += g * __builtin_amdgcn_cvt_f32_fp8((int)w0[e], 2); yv[4 * e + 3] += g * __builtin_amdgcn_cvt_f32_fp8((int)w0[e], 3);
        yv[8 + 4 * e] += g * __builtin_amdgcn_cvt_f32_fp8((int)w1[e], 0); yv[8 + 4 * e + 1] += g * __builtin_amdgcn_cvt_f32_fp8((int)w1[e], 1); yv[8 + 4 * e + 2] += g * __builtin_amdgcn_cvt_f32_fp8((int)w1[e], 2); yv[8 + 4 * e + 3] += g * __builtin_amdgcn_cvt_f32_fp8((int)w1[e], 3); }
}

DEV void load_row_bf(const bf16_t* p, int lane, float (&v)[16]) {
#pragma unroll
    for (int j = 0; j < 4; ++j) { const u32x2 w = *(const u32x2*)(p + j * 256 + lane * 4); v[4 * j] = __uint_as_float(w.x << 16); v[4 * j + 1] = __uint_as_float(w.x & 0xFFFF0000u); v[4 * j + 2] = __uint_as_float(w.y << 16); v[4 * j + 3] = __uint_as_float(w.y & 0xFFFF0000u); }
}
DEV void store_row_bf(bf16_t* p, int lane, const float (&v)[16]) {
#pragma unroll
    for (int j = 0; j < 4; ++j) *(u32x2*)(p + j * 256 + lane * 4) = (u32x2){pk2(v[4 * j], v[4 * j + 1]), pk2(v[4 * j + 2], v[4 * j + 3])};
}
DEV void load_row8_bf(const bf16_t* p, int lane, float (&v)[16]) {
#pragma unroll
    for (int j = 0; j < 2; ++j) { const u32x4 w = *(const u32x4*)(p + 512 * j + 8 * lane);
#pragma unroll
        for (int e = 0; e < 4; ++e) { v[8 * j + 2 * e] = __uint_as_float(w[e] << 16); v[8 * j + 2 * e + 1] = __uint_as_float(w[e] & 0xFFFF0000u); } }
}
DEV void store_row8_bf(bf16_t* p, int lane, const float (&v)[16]) {
#pragma unroll
    for (int j = 0; j < 2; ++j) *(u32x4*)(p + 512 * j + 8 * lane) = (u32x4){pk2(v[8 * j], v[8 * j + 1]), pk2(v[8 * j + 2], v[8 * j + 3]), pk2(v[8 * j + 4], v[8 * j + 5]), pk2(v[8 * j + 6], v[8 * j + 7])};
}

struct Ctx { LAS unsigned char* lds; int tid, lane, wave, G, bid; };

DEV void ph_setup(const Args& a, const Ctx& X) {
    unsigned char* ws = a.ws;
    float* mod = (float*)(ws + WS_MOD);
    { LAS float* red = (LAS float*)X.lds;
      LAS float* sc = (LAS float*)(X.lds + 8192);
      for (int i = X.tid; i < NB * D; i += NTHR) sc[i] = siluf(a.c[i]);
      __syncthreads();
      const int kc = X.tid >> 6, cl = X.tid & 63;
      for (int task = X.bid; task < 2 * 96; task += X.G) {
          const int l = task / 96, col = (task % 96) * 64 + cl;
          const float* w = a.mod_w + (size_t)l * D * 6 * D + col;
          float p0 = 0.f, p1 = 0.f, p2 = 0.f, p3 = 0.f;
#pragma unroll 16
          for (int k = kc * 128; k < kc * 128 + 128; ++k) { const float wv = w[(size_t)k * 6 * D];
              p0 += sc[k] * wv; p1 += sc[D + k] * wv; p2 += sc[2 * D + k] * wv; p3 += sc[3 * D + k] * wv; }
          __syncthreads();
          red[(kc * 4 + 0) * 64 + cl] = p0; red[(kc * 4 + 1) * 64 + cl] = p1; red[(kc * 4 + 2) * 64 + cl] = p2; red[(kc * 4 + 3) * 64 + cl] = p3;
          __syncthreads();
          if (X.tid < 256) { const int b = X.tid >> 6; float s = a.mod_b[l * 6 * D + col];
#pragma unroll
              for (int q = 0; q < 8; ++q) s += red[(q * 4 + b) * 64 + cl];
              mod[(size_t)(l * NB + b) * 6 * D + col] = s; }
      }
      __syncthreads(); }
    { LAS float* scr = (LAS float*)(X.lds + X.wave * 8704);
      const int gw = X.bid * NWAVES + X.wave, NGW = X.G * NWAVES;
      constexpr int I_IN = (D / 64) * (NPROJ / 32);
      for (int it = gw; it < I_IN; it += NGW) conv_item(SrcWin{a.ssm_w_in}, PROJ, D, (bf16_t*)(ws + WS_WIN), scr, it, NPROJ / 32, X.lane);
    }
}
DEV void ph_setup_late(const Args& a, const Ctx& X, const int wg0) {
    unsigned char* ws = a.ws;
    { float* cosT = (float*)(ws + WS_COS); float* sinT = (float*)(ws + WS_SIN);
      for (int idx = (X.bid - wg0) * NTHR + X.tid; idx < T * 32; idx += (X.G - wg0) * NTHR) { const int t = idx >> 5, i = idx & 31;
          const float ang = (float)a.pos[t] * powf(10000.f, -(float)i / 32.f); float sn, cs; sincosf(ang, &sn, &cs); cosT[idx] = cs; sinT[idx] = sn; } }
    { LAS float* scr = (LAS float*)(X.lds + X.wave * 8704);
      const int gw = (X.bid - wg0) * NWAVES + X.wave, NGW = (X.G - wg0) * NWAVES;
      constexpr int I_OUT = (2048 / 64) * (D / 32), I_QKV = (D / 64) * (3072 / 32), I_O = (D / 64) * (D / 32);
      for (int it = gw; it < I_OUT + I_QKV + I_O; it += NGW) {
          int r = it;
          if (r < I_OUT) { conv_item(SrcIdent{a.ssm_w_out}, D, 2048, (bf16_t*)(ws + WS_WOUT), scr, r, D / 32, X.lane); continue; } r -= I_OUT;
          if (r < I_QKV) { conv_item(SrcQKV{a.attn_w_qkv}, 3072, D, (bf16_t*)(ws + WS_WQKV), scr, r, 3072 / 32, X.lane); continue; } r -= I_QKV;
          conv_item(SrcIdent{a.attn_w_o}, D, D, (bf16_t*)(ws + WS_WO), scr, r, D / 32, X.lane);
      } }
}

DEV void ph_prenorm0(const Args& a, const Ctx& X) {
    const float* mod = (const float*)(a.ws + WS_MOD);
    bf16_t* hb = (bf16_t*)(a.ws + WS_H);
    for (int row = X.bid * NWAVES + X.wave; row < T; row += X.G * NWAVES) {
        const int b = row / SEQ; const float* ml = mod + (size_t)b * 6 * D;
        float xv[16]; load_row(a.x + (size_t)row * D, X.lane, xv);
        u32x2 o[4]; prenorm_pack(xv, a.mix_pre_g, ml + D, ml, X.lane, o);
#pragma unroll
        for (int j = 0; j < 4; ++j) *(u32x2*)(hb + (size_t)row * D + j * 256 + X.lane * 4) = o[j];
    }
}

DEV bf16x8 acc_to_frag(const f32x4 lo, const f32x4 hi) { u32x4 w; w.x = pg8::cvt_pk_bf16(lo[0], lo[1]); w.y = pg8::cvt_pk_bf16(lo[2], lo[3]); w.z = pg8::cvt_pk_bf16(hi[0], hi[1]); w.w = pg8::cvt_pk_bf16(hi[2], hi[3]); return __builtin_bit_cast(bf16x8, w); }

DEV void gdn_solve(LAS float* M, LAS unsigned short* tf, const int lane) {
    for (int rb = 0; rb < 16; ++rb) {
        const int i0 = 4 * rb;
        float a0 = (lane == i0) ? 1.f : 0.f, a1 = (lane == i0 + 1) ? 1.f : 0.f, a2 = (lane == i0 + 2) ? 1.f : 0.f, a3 = (lane == i0 + 3) ? 1.f : 0.f;
        for (int j = 0; j < i0; j += 4) {
            const float t0 = M[j * 64 + lane], t1 = M[(j + 1) * 64 + lane], t2 = M[(j + 2) * 64 + lane], t3 = M[(j + 3) * 64 + lane];
            const f32x4 r0 = *(const LAS f32x4*)(M + i0 * 64 + j), r1 = *(const LAS f32x4*)(M + (i0 + 1) * 64 + j), r2 = *(const LAS f32x4*)(M + (i0 + 2) * 64 + j), r3 = *(const LAS f32x4*)(M + (i0 + 3) * 64 + j);
            a0 -= r0[0] * t0 + r0[1] * t1 + r0[2] * t2 + r0[3] * t3; a1 -= r1[0] * t0 + r1[1] * t1 + r1[2] * t2 + r1[3] * t3;
            a2 -= r2[0] * t0 + r2[1] * t1 + r2[2] * t2 + r2[3] * t3; a3 -= r3[0] * t0 + r3[1] * t1 + r3[2] * t2 + r3[3] * t3;
        }
        const f32x4 d1 = *(const LAS f32x4*)(M + (i0 + 1) * 64 + i0), d2 = *(const LAS f32x4*)(M + (i0 + 2) * 64 + i0), d3 = *(const LAS f32x4*)(M + (i0 + 3) * 64 + i0);
        a1 -= d1[0] * a0; a2 -= d2[0] * a0 + d2[1] * a1; a3 -= d3[0] * a0 + d3[1] * a1 + d3[2] * a2;
        M[i0 * 64 + lane] = a0; M[(i0 + 1) * 64 + lane] = a1; M[(i0 + 2) * 64 + lane] = a2; M[(i0 + 3) * 64 + lane] = a3;
    }
    const int cq = (lane >> 2) & 3, ca = (lane >> 4) & 1, ce = lane & 3, cks = lane >> 5;
    for (int i = 0; i < 64; ++i) tf[((i >> 4) * 2 + cks) * 512 + ((i & 15) + 16 * cq) * 8 + 4 * ca + ce] = (unsigned short)f2bf(M[i * 64 + lane]);
}
DEV void ph_gdn_local(const Args& a, const Ctx& X) {
    const bf16_t* qkvpre = (const bf16_t*)(a.ws + WS_QKVPRE); const float* small = (const float*)(a.ws + WS_SMALL);
    unsigned char* gi = a.ws + WS_GI; float* glast = (float*)(a.ws + WS_GLAST);
    constexpr int KP = 272;
    LAS unsigned char* kN = X.lds; LAS unsigned char* qN = X.lds + 64 * KP; LAS unsigned char* slots = X.lds + 128 * KP;
    LAS float* gcL = (LAS float*)(X.lds + 143360); LAS float* btL = gcL + 8 * 64;
    LAS unsigned char* stg = X.lds + 100352;
    const int lane = X.lane, wave = X.wave, r16 = lane & 15, q4 = lane >> 4;
    const float scale = 0.08838834764831845f;
    for (int wu = X.bid; wu < NB * 64; wu += X.G) {
        const int b = wu >> 6, n = wu & 63; const size_t t0 = (size_t)b * SEQ + 64 * n;
        unsigned char* tmp = a.ws + WS_GTMP + (size_t)X.bid * 131072;
        __syncthreads();
        {
            const float g = -__expf(a.gdn_a_log[wave]) * softplusf(small[(t0 + lane) * 32 + 8 + wave] + a.gdn_dt_bias[wave]);
            float gc = g;
#pragma unroll
            for (int o = 1; o < 64; o <<= 1) { const float v = __shfl_up(gc, o); if (lane >= o) gc += v; }
            gcL[wave * 64 + lane] = gc; btL[wave * 64 + lane] = sigmoidf_(small[(t0 + lane) * 32 + wave]);
            if (lane == 63) glast[(size_t)((b * 8 + wave) * 64 + n) * 32] = gc;
        }
        __syncthreads();
        unsigned xr[3][11];
#define GDN_LOADX(hh) do { _Pragma("unroll") for (int _p = 0; _p < 3; ++_p) _Pragma("unroll") for (int _i = 0; _i < 11; ++_i) { const int _tk = 8 * wave + _i - 3; unsigned _v = 0u; \
            if (64 * n + _tk >= 0) _v = *(const unsigned*)(qkvpre + (t0 + _tk) * 3072 + _p * 1024 + (hh) * 128 + 2 * lane); xr[_p][_i] = _v; } } while (0)
        GDN_LOADX(0);
        for (int bb = 0; bb < 2; ++bb) {
            for (int j = 0; j < 4; ++j) {
                const int h = bb * 4 + j; unsigned char* ub = gi + (size_t)((b * 8 + h) * 64 + n) * GI_UNIT;
                {
                    const float gl = gcL[h * 64 + 63];
                    const int blk = wave >> 2, pa = (wave & 3) >> 1, pq0 = 2 * (wave & 1);
                    const int ca = (2 * lane >> 4) & 1, cq = (2 * lane >> 2) & 3, ce = (2 * lane) & 3, cks = (2 * lane) >> 5;
#pragma unroll
                    for (int part = 0; part < 3; ++part) {
                        const int col = part * 1024 + h * 128 + 2 * lane;
                        float w0[4], w1[4];
#pragma unroll
                        for (int i = 0; i < 4; ++i) { const f32x2 t = *(const f32x2*)(a.gdn_conv_w + i * 3072 + col); w0[i] = t.x; w1[i] = t.y; }
                        float x0[11], x1[11];
#pragma unroll
                        for (int i = 0; i < 11; ++i) { const unsigned v = xr[part][i]; x0[i] = __uint_as_float(v << 16); x1[i] = __uint_as_float(v & 0xFFFF0000u); }
                        float v0[8], v1[8];
#pragma unroll
                        for (int i = 0; i < 8; ++i) { v0[i] = siluf(w0[0] * x0[i] + w0[1] * x0[i + 1] + w0[2] * x0[i + 2] + w0[3] * x0[i + 3]); v1[i] = siluf(w1[0] * x1[i] + w1[1] * x1[i + 1] + w1[2] * x1[i + 2] + w1[3] * x1[i + 3]); }
                        if (part < 2) {
#pragma unroll
                            for (int i = 0; i < 8; ++i) { const float r = rsqrtf(wave_sum(v0[i] * v0[i] + v1[i] * v1[i]) + 1e-6f); v0[i] *= r; v1[i] *= r; }
                        }
                        for (int rep_ = 0; rep_ < (((PROBE_MASK >> 21) & 1u) ? 2 : 1); ++rep_) {
                        if (part == 0) {
#pragma unroll
                            for (int i = 0; i < 8; ++i) { const int tok = 8 * wave + i; const float eg = __expf(gcL[h * 64 + tok]) * scale;
                                *(LAS unsigned*)(qN + tok * KP + lane * 4) = pk2(v0[i], v1[i]);
                                *(LAS unsigned*)(stg + ((tok >> 4) * 4 + cks) * 1024 + ((tok & 15) + 16 * cq) * 16 + (4 * ca + ce) * 2) = pk2(v0[i] * eg, v1[i] * eg); }
                        } else if (part == 1) {
                            unsigned short kg0[8], kg1[8], ke0[8], ke1[8];
#pragma unroll
                            for (int i = 0; i < 8; ++i) { const int tok = 8 * wave + i; const float gc = gcL[h * 64 + tok], bt = btL[h * 64 + tok], eg = __expf(gc) * bt, eend = __expf(gl - gc);
                                *(LAS unsigned*)(kN + tok * KP + lane * 4) = pk2(v0[i], v1[i]);
                                kg0[i] = (unsigned short)f2bf(v0[i] * eg); kg1[i] = (unsigned short)f2bf(v1[i] * eg); ke0[i] = (unsigned short)f2bf(v0[i] * eend); ke1[i] = (unsigned short)f2bf(v1[i] * eend); }
#pragma unroll
                            for (int hf = 0; hf < 2; ++hf) { const int pos = 32 * blk + 8 * (pq0 + hf) + 4 * pa; const int cl = 2 * lane;
                                *(u32x2*)(tmp + (size_t)j * 32768 + 16384 + cl * 128 + pos * 2) = (u32x2){(unsigned)kg0[4 * hf] | ((unsigned)kg0[4 * hf + 1] << 16), (unsigned)kg0[4 * hf + 2] | ((unsigned)kg0[4 * hf + 3] << 16)};
                                *(u32x2*)(tmp + (size_t)j * 32768 + 16384 + (cl + 1) * 128 + pos * 2) = (u32x2){(unsigned)kg1[4 * hf] | ((unsigned)kg1[4 * hf + 1] << 16), (unsigned)kg1[4 * hf + 2] | ((unsigned)kg1[4 * hf + 3] << 16)};
                                *(LAS u32x2*)(stg + 16384 + ((cl >> 4) * 2 + blk) * 1024 + ((cl & 15) + 16 * (pq0 + hf)) * 16 + (4 * pa) * 2) = (u32x2){(unsigned)ke0[4 * hf] | ((unsigned)ke0[4 * hf + 1] << 16), (unsigned)ke0[4 * hf + 2] | ((unsigned)ke0[4 * hf + 3] << 16)};
                                *(LAS u32x2*)(stg + 16384 + (((cl + 1) >> 4) * 2 + blk) * 1024 + (((cl + 1) & 15) + 16 * (pq0 + hf)) * 16 + (4 * pa) * 2) = (u32x2){(unsigned)ke1[4 * hf] | ((unsigned)ke1[4 * hf + 1] << 16), (unsigned)ke1[4 * hf + 2] | ((unsigned)ke1[4 * hf + 3] << 16)}; }
                        } else {
                            unsigned short vb0[8], vb1[8];
#pragma unroll
                            for (int i = 0; i < 8; ++i) { const float bt = btL[h * 64 + 8 * wave + i]; vb0[i] = (unsigned short)f2bf(v0[i] * bt); vb1[i] = (unsigned short)f2bf(v1[i] * bt); }
#pragma unroll
                            for (int hf = 0; hf < 2; ++hf) { const int pos = 32 * blk + 8 * (pq0 + hf) + 4 * pa; const int cl = 2 * lane;
                                *(u32x2*)(tmp + (size_t)j * 32768 + cl * 128 + pos * 2) = (u32x2){(unsigned)vb0[4 * hf] | ((unsigned)vb0[4 * hf + 1] << 16), (unsigned)vb0[4 * hf + 2] | ((unsigned)vb0[4 * hf + 3] << 16)};
                                *(u32x2*)(tmp + (size_t)j * 32768 + (cl + 1) * 128 + pos * 2) = (u32x2){(unsigned)vb1[4 * hf] | ((unsigned)vb1[4 * hf + 1] << 16), (unsigned)vb1[4 * hf + 2] | ((unsigned)vb1[4 * hf + 3] << 16)}; }
                        }
                        asm volatile("" ::: "memory"); }
                    }
                }
                if (h + 1 < 8) GDN_LOADX(h + 1);
                __syncthreads();
                {
#pragma unroll
                    for (int i = 0; i < 4; ++i) *(u32x4*)(ub + 16384 + (X.tid + 512 * i) * 16) = *(const LAS u32x4*)(stg + (X.tid + 512 * i) * 16);
                    const int mat = wave >> 2, rt = wave & 3; LAS unsigned char* An = mat ? qN : kN;
                    bf16x8 af[4];
#pragma unroll
                    for (int ks = 0; ks < 4; ++ks) af[ks] = *(const LAS bf16x8*)(An + (16 * rt + r16) * KP + (32 * ks + 8 * q4) * 2);
                    LAS float* slot = (LAS float*)(slots + j * 16384);
#pragma unroll
                    for (int ct = 0; ct < 4; ++ct) { f32x4 acc = {0.f, 0.f, 0.f, 0.f};
#pragma unroll
                        for (int ks = 0; ks < 4; ++ks) { const bf16x8 bf = *(const LAS bf16x8*)(kN + (16 * ct + r16) * KP + (32 * ks + 8 * q4) * 2); acc = __builtin_amdgcn_mfma_f32_16x16x32_bf16(af[ks], bf, acc, 0, 0, 0); }
                        const int jc = 16 * ct + r16; const float gj = gcL[h * 64 + jc];
#pragma unroll
                        for (int rg = 0; rg < 4; ++rg) { const int i = 16 * rt + 4 * q4 + rg; const float dec = __expf(gcL[h * 64 + i] - gj);
                            if (mat == 0) { slot[i * 64 + jc] = jc < i ? btL[h * 64 + i] * acc[rg] * dec : 0.f; }
                            else { const float v = jc <= i ? acc[rg] * scale * dec : 0.f;
                                *(LAS unsigned short*)(stg + 32768 + (rt * 2 + (ct >> 1)) * 1024 + ((4 * q4 + rg) + 16 * (r16 >> 2)) * 16 + (4 * (ct & 1) + (r16 & 3)) * 2) = (unsigned short)f2bf(v); } }
                    }
                }
                __syncthreads();
                *(u32x4*)(ub + 49152 + X.tid * 16) = *(const LAS u32x4*)(stg + 32768 + X.tid * 16);
            }
            if (wave < 4) gdn_solve((LAS float*)(slots + wave * 16384), (LAS unsigned short*)(X.lds + wave * 8192), lane);
            VM_WAIT(); __syncthreads();
            for (int j = 0; j < 4; ++j) {
                const int h = bb * 4 + j; unsigned char* ub = gi + (size_t)((b * 8 + h) * 64 + n) * GI_UNIT;
                const int mat = wave >> 2; LAS unsigned char* slot = X.lds + j * 8192;
#pragma unroll
                for (int cx = 0; cx < 2; ++cx) { const int ct = 2 * (wave & 3) + cx;
                    bf16x8 bfr[2];
#pragma unroll
                    for (int ks = 0; ks < 2; ++ks) { const u32x4 t = __builtin_nontemporal_load((const u32x4*)(tmp + (size_t)j * 32768 + mat * 16384 + (16 * ct + r16) * 128 + (32 * ks + 8 * q4) * 2)); bfr[ks] = __builtin_bit_cast(bf16x8, t); }
#pragma unroll
                    for (int rt = 0; rt < 4; ++rt) { f32x4 acc = {0.f, 0.f, 0.f, 0.f};
#pragma unroll
                        for (int ks = 0; ks < 2; ++ks) { const bf16x8 tf = *(const LAS bf16x8*)(slot + (rt * 2 + ks) * 1024 + lane * 16); acc = __builtin_amdgcn_mfma_f32_16x16x32_bf16(tf, bfr[ks], acc, 0, 0, 0); }
                        if (mat == 0) *(u32x2*)(ub + 57344 + (rt * 8 + ct) * 512 + lane * 8) = (u32x2){pg8::cvt_pk_bf16(acc[0], acc[1]), pg8::cvt_pk_bf16(acc[2], acc[3])};
                        else {
#pragma unroll
                            for (int rg = 0; rg < 4; ++rg) *(unsigned short*)(ub + (rt * 4 + (ct >> 1)) * 1024 + ((4 * q4 + rg) + 16 * (r16 >> 2)) * 16 + (4 * (ct & 1) + (r16 & 3)) * 2) = (unsigned short)f2bf(-acc[rg]);
                        }
                    }
                }
            }
            __syncthreads();
        }
    }
}
DEV void ph_gdn_scan(const Args& a, const Ctx& X) {
    const unsigned char* gi = a.ws + WS_GI; const float* glast = (const float*)(a.ws + WS_GLAST);
    const bf16_t* za = (const bf16_t*)(a.ws + WS_ZA); bf16_t* oy = (bf16_t*)(a.ws + WS_OY);
    const int lane = X.lane, wave = X.wave, r16 = lane & 15, q4 = lane >> 4, tid = X.tid;
    LAS float* OT = (LAS float*)(X.lds + 114688);
    const int bh = X.bid, b = bh >> 3, h = bh & 7;
    const unsigned char* ubase = gi + (size_t)bh * 64 * GI_UNIT;
    f32x4 S[8];
#pragma unroll
    for (int i = 0; i < 8; ++i) S[i] = (f32x4){0.f, 0.f, 0.f, 0.f};
    float nwv[16];
#pragma unroll
    for (int i = 0; i < 16; ++i) nwv[i] = a.gdn_norm_w[16 * (tid & 7) + i];
#define GDN_STAGE(nn, buf) do { _Pragma("unroll") for (int _i = 0; _i < 7; ++_i) \
        __builtin_amdgcn_global_load_lds((const unsigned*)(ubase + (size_t)(nn) * GI_UNIT + (size_t)(tid + 512 * _i) * 16), (LAS unsigned*)(X.lds + (buf) * 57344 + (wave * 64 + 512 * _i) * 16), 16, 0, 0); } while (0)
    u32x2 udn[4]; float gln; u32x4 zn[2];
    { const size_t tz = (size_t)b * SEQ + (tid >> 3); zn[0] = *(const u32x4*)(za + tz * 1024 + h * 128 + 16 * (tid & 7)); zn[1] = *(const u32x4*)(za + tz * 1024 + h * 128 + 16 * (tid & 7) + 8); }
#pragma unroll
    for (int ct = 0; ct < 4; ++ct) udn[ct] = *(const u32x2*)(ubase + 57344 + (ct * 8 + wave) * 512 + lane * 8);
    gln = glast[(size_t)(bh * 64) * 32];
    GDN_STAGE(0, 0);
#define GDN_EPILOGUE(nn, ZC) do { const int tok = tid >> 3, seg = tid & 7; const size_t t = (size_t)b * SEQ + 64 * (nn) + tok; \
            float ov[16]; float ss = 0.f; \
            _Pragma("unroll") for (int i = 0; i < 4; ++i) { const f32x4 v = *(const LAS f32x4*)(OT + tok * 132 + 16 * seg + 4 * i); ov[4 * i] = v[0]; ov[4 * i + 1] = v[1]; ov[4 * i + 2] = v[2]; ov[4 * i + 3] = v[3]; ss += v[0] * v[0] + v[1] * v[1] + v[2] * v[2] + v[3] * v[3]; } \
            ss += __shfl_xor(ss, 1); ss += __shfl_xor(ss, 2); ss += __shfl_xor(ss, 4); \
            const float rstd = rsqrtf(ss * (1.f / 128.f) + EPS); \
            u32x4 ow[2]; \
            _Pragma("unroll") for (int i = 0; i < 2; ++i) _Pragma("unroll") for (int e = 0; e < 4; ++e) { const unsigned zw = (ZC)[i][e]; const float z0 = __uint_as_float(zw << 16), z1 = __uint_as_float(zw & 0xFFFF0000u); \
                    ow[i][e] = pg8::cvt_pk_bf16(ov[8 * i + 2 * e] * rstd * nwv[8 * i + 2 * e] * siluf(z0), ov[8 * i + 2 * e + 1] * rstd * nwv[8 * i + 2 * e + 1] * siluf(z1)); } \
            *(u32x4*)(oy + t * 2048 + h * 128 + 16 * seg) = ow[0]; *(u32x4*)(oy + t * 2048 + h * 128 + 16 * seg + 8) = ow[1]; } while (0)
    u32x4 zp[2] = {{0u, 0u, 0u, 0u}, {0u, 0u, 0u, 0u}};
    for (int n = 0; n < 64; ++n) {
        VM_WAIT(); __syncthreads();
        f32x4 uf[4];
#pragma unroll
        for (int ct = 0; ct < 4; ++ct) { uf[ct][0] = __uint_as_float(udn[ct].x << 16); uf[ct][1] = __uint_as_float(udn[ct].x & 0xFFFF0000u); uf[ct][2] = __uint_as_float(udn[ct].y << 16); uf[ct][3] = __uint_as_float(udn[ct].y & 0xFFFF0000u); }
        const float egl = __expf(gln);
        u32x4 zc[2]; zc[0] = zn[0]; zc[1] = zn[1];
        asm volatile("" : "+v"(uf[0]), "+v"(uf[1]), "+v"(uf[2]), "+v"(uf[3]), "+v"(zc[0]), "+v"(zc[1]));
        if (n + 1 < 64) {
            const unsigned char* un = ubase + (size_t)(n + 1) * GI_UNIT;
#pragma unroll
            for (int ct = 0; ct < 4; ++ct) udn[ct] = *(const u32x2*)(un + 57344 + (ct * 8 + wave) * 512 + lane * 8);
            gln = glast[(size_t)(bh * 64 + n + 1) * 32];
            { const size_t tz = (size_t)b * SEQ + 64 * (n + 1) + (tid >> 3); zn[0] = *(const u32x4*)(za + tz * 1024 + h * 128 + 16 * (tid & 7)); zn[1] = *(const u32x4*)(za + tz * 1024 + h * 128 + 16 * (tid & 7) + 8); }
            GDN_STAGE(n + 1, (n + 1) & 1);
        }
        if (n > 0) GDN_EPILOGUE(n - 1, zp);
        zp[0] = zc[0]; zp[1] = zc[1];
        const LAS unsigned char* L = X.lds + (n & 1) * 57344;
        bf16x8 sB[4];
#pragma unroll
        for (int ks = 0; ks < 4; ++ks) sB[ks] = acc_to_frag(S[2 * ks], S[2 * ks + 1]);
        f32x4 vn[4], oo[4];
#pragma unroll
        for (int ct = 0; ct < 4; ++ct) { f32x4 acc = {0.f, 0.f, 0.f, 0.f}, ao = {0.f, 0.f, 0.f, 0.f};
#pragma unroll
            for (int ks = 0; ks < 4; ++ks) { const bf16x8 wf = *(const LAS bf16x8*)(L + (ct * 4 + ks) * 1024 + lane * 16), qf = *(const LAS bf16x8*)(L + 16384 + (ct * 4 + ks) * 1024 + lane * 16);
                acc = __builtin_amdgcn_mfma_f32_16x16x32_bf16(wf, sB[ks], acc, 0, 0, 0); ao = __builtin_amdgcn_mfma_f32_16x16x32_bf16(qf, sB[ks], ao, 0, 0, 0); }
            vn[ct] = acc; oo[ct] = ao; }
#pragma unroll
        for (int ct = 0; ct < 4; ++ct) vn[ct] = vn[ct] + uf[ct];
        bf16x8 vB[2];
#pragma unroll
        for (int ks = 0; ks < 2; ++ks) vB[ks] = acc_to_frag(vn[2 * ks], vn[2 * ks + 1]);
#pragma unroll
        for (int ct = 0; ct < 4; ++ct)
#pragma unroll
            for (int ks = 0; ks < 2; ++ks) { const bf16x8 kf = *(const LAS bf16x8*)(L + 49152 + (ct * 2 + ks) * 1024 + lane * 16); oo[ct] = __builtin_amdgcn_mfma_f32_16x16x32_bf16(kf, vB[ks], oo[ct], 0, 0, 0); }
#pragma unroll
        for (int dt = 0; dt < 8; ++dt) { f32x4 acc = S[dt] * egl;
#pragma unroll
            for (int ks = 0; ks < 2; ++ks) { const bf16x8 ef = *(const LAS bf16x8*)(L + 32768 + (dt * 2 + ks) * 1024 + lane * 16); acc = __builtin_amdgcn_mfma_f32_16x16x32_bf16(ef, vB[ks], acc, 0, 0, 0); }
            S[dt] = acc; }
        __syncthreads();
#pragma unroll
        for (int ct = 0; ct < 4; ++ct)
#pragma unroll
            for (int rg = 0; rg < 4; ++rg) OT[(16 * ct + 4 * q4 + rg) * 132 + 16 * wave + r16] = oo[ct][rg];
    }
    __syncthreads();
    GDN_EPILOGUE(63, zp);
#undef GDN_EPILOGUE
#undef GDN_STAGE
}

constexpr int SP = 272;
DEV void ph_ssd_local(const Args& a, const Ctx& X) {
    const bf16_t* xbcpre = (const bf16_t*)(a.ws + WS_XBCPRE); const float* small = (const float*)(a.ws + WS_SMALL);
    bf16_t* CC = (bf16_t*)(a.ws + WS_CC); float* acum = (float*)(a.ws + WS_ACUM); float* cdec = (float*)(a.ws + WS_CDEC);
    bf16_t* ydiag = (bf16_t*)(a.ws + WS_YDIAG); bf16_t* states = (bf16_t*)(a.ws + WS_STATES);
    LAS unsigned char* Bn = X.lds; LAS unsigned char* Cn = X.lds + 128 * SP; LAS unsigned char* BT = X.lds + 256 * SP;
    LAS unsigned char* xdT = X.lds; LAS unsigned char* xeT = X.lds + 64 * SP;
    LAS float* acL = (LAS float*)(X.lds + AUX_OFF); LAS float* dtL = acL + 8 * 128;
    const int lane = X.lane, wave = X.wave, r16 = lane & 15, q4 = lane >> 4;
    for (int unit = X.bid; unit < NB * 32 * 2; unit += X.G) {
        const int g = unit & 1, c = (unit >> 1) & 31, b = unit >> 6; const size_t t0 = (size_t)b * SEQ + 128 * c;
        __syncthreads();
        {
            const int hd = g * 8 + wave; const float an = -__expf(a.ssd_a_log[hd]), bias = a.ssd_dt_bias[hd];
            const float d0 = softplusf(small[(t0 + lane) * 32 + 16 + hd] + bias), d1 = softplusf(small[(t0 + 64 + lane) * 32 + 16 + hd] + bias);
            float s0 = d0 * an, s1 = d1 * an;
#pragma unroll
            for (int o = 1; o < 64; o <<= 1) { const float v0 = __shfl_up(s0, o), v1 = __shfl_up(s1, o); if (lane >= o) { s0 += v0; s1 += v1; } }
            s1 += __shfl(s0, 63);
            acL[wave * 128 + lane] = s0; acL[wave * 128 + 64 + lane] = s1; dtL[wave * 128 + lane] = d0; dtL[wave * 128 + 64 + lane] = d1;
            acum[((size_t)g * T + t0 + lane) * 8 + wave] = s0; acum[((size_t)g * T + t0 + 64 + lane) * 8 + wave] = s1;
            if (lane == 63) cdec[(size_t)unit * 32 + wave] = __expf(s1);
        }
        {
            const int isC = lane >> 5, cc = (lane & 31) * 4, col = 1024 + isC * 256 + g * 128 + cc;
            float w[4][4], bs[4];
#pragma unroll
            for (int i = 0; i < 4; ++i) { const f32x4 t = *(const f32x4*)(a.ssd_conv_w + i * 1536 + col); w[i][0] = t[0]; w[i][1] = t[1]; w[i][2] = t[2]; w[i][3] = t[3]; }
            { const f32x4 t = *(const f32x4*)(a.ssd_conv_b + col); bs[0] = t[0]; bs[1] = t[1]; bs[2] = t[2]; bs[3] = t[3]; }
            float xin[19][4];
#pragma unroll
            for (int i = 0; i < 19; ++i) { const int tk = 16 * wave + i - 3; const bool ok = (128 * c + tk) >= 0; u32x2 v = {0u, 0u}; if (ok) v = *(const u32x2*)(xbcpre + (t0 + tk) * 1536 + col);
                xin[i][0] = __uint_as_float(v.x << 16); xin[i][1] = __uint_as_float(v.x & 0xFFFF0000u); xin[i][2] = __uint_as_float(v.y << 16); xin[i][3] = __uint_as_float(v.y & 0xFFFF0000u); }
            unsigned short ov[16][4];
#pragma unroll
            for (int i = 0; i < 16; ++i)
#pragma unroll
                for (int e = 0; e < 4; ++e) { const float s = bs[e] + w[0][e] * xin[i][e] + w[1][e] * xin[i + 1][e] + w[2][e] * xin[i + 2][e] + w[3][e] * xin[i + 3][e]; ov[i][e] = (unsigned short)f2bf(siluf(s)); }
            LAS unsigned char* nat = isC ? Cn : Bn;
#pragma unroll
            for (int i = 0; i < 16; ++i) { const u32x2 pk = {(unsigned)ov[i][0] | ((unsigned)ov[i][1] << 16), (unsigned)ov[i][2] | ((unsigned)ov[i][3] << 16)};
                *(LAS u32x2*)(nat + (16 * wave + i) * SP + cc * 2) = pk;
                if (isC) *(u32x2*)(CC + (t0 + 16 * wave + i) * 256 + g * 128 + cc) = pk; }
            if (!isC) {
#pragma unroll
                for (int e = 0; e < 4; ++e)
#pragma unroll
                    for (int qq = 0; qq < 4; ++qq) { const u32x2 pk = {(unsigned)ov[4 * qq][e] | ((unsigned)ov[4 * qq + 1][e] << 16), (unsigned)ov[4 * qq + 2][e] | ((unsigned)ov[4 * qq + 3][e] << 16)};
                        *(LAS u32x2*)(BT + (cc + e) * SP + (32 * (wave >> 1) + 8 * qq + 4 * (wave & 1)) * 2) = pk; }
            }
        }
        __syncthreads();
        f32x4 cbt[8];
        {
            bf16x8 cf[4];
#pragma unroll
            for (int ks = 0; ks < 4; ++ks) cf[ks] = *(const LAS bf16x8*)(Cn + (16 * wave + r16) * SP + (32 * ks + 8 * q4) * 2);
#pragma unroll
            for (int st = 0; st < 8; ++st) { cbt[st] = (f32x4){0.f, 0.f, 0.f, 0.f};
#pragma unroll
                for (int ks = 0; ks < 4; ++ks) { const bf16x8 bf = *(const LAS bf16x8*)(Bn + (16 * st + r16) * SP + (32 * ks + 8 * q4) * 2); cbt[st] = __builtin_amdgcn_mfma_f32_16x16x32_bf16(bf, cf[ks], cbt[st], 0, 0, 0); } }
        }
        __syncthreads();
        const int lq = 16 * wave + r16;
        unsigned short xnx[19];
#define SSD_LOADX(hh) do { _Pragma("unroll") for (int _i = 0; _i < 19; ++_i) { const int _tk = 16 * wave + _i - 3; xnx[_i] = (128 * c + _tk) >= 0 ? xbcpre[(t0 + _tk) * 1536 + (hh) * 64 + lane] : (unsigned short)0; } } while (0)
        SSD_LOADX(g * 8);
        for (int r = 0; r < 8; ++r) {
            const int hd = g * 8 + r; const float dd = a.ssd_d[hd];
            {
                const int col = hd * 64 + lane; float w0 = a.ssd_conv_w[col], w1 = a.ssd_conv_w[1536 + col], w2 = a.ssd_conv_w[2 * 1536 + col], w3 = a.ssd_conv_w[3 * 1536 + col]; const float bs = a.ssd_conv_b[col];
                float xin[19];
#pragma unroll
                for (int i = 0; i < 19; ++i) xin[i] = bf2f(xnx[i]);
                if (r + 1 < 8) SSD_LOADX(hd + 1);
                const float aclast = acL[r * 128 + 127];
                unsigned short xd[16], xe[16];
#pragma unroll
                for (int i = 0; i < 16; ++i) { const float xv = siluf(bs + w0 * xin[i] + w1 * xin[i + 1] + w2 * xin[i + 2] + w3 * xin[i + 3]); const int tk = 16 * wave + i;
                    const float xdv = xv * dtL[r * 128 + tk]; xd[i] = (unsigned short)f2bf(xdv); xe[i] = (unsigned short)f2bf(xdv * __expf(aclast - acL[r * 128 + tk])); }
#pragma unroll
                for (int qq = 0; qq < 4; ++qq) { const int pos = 32 * (wave >> 1) + 8 * qq + 4 * (wave & 1);
                    *(LAS u32x2*)(xdT + lane * SP + pos * 2) = (u32x2){(unsigned)xd[4 * qq] | ((unsigned)xd[4 * qq + 1] << 16), (unsigned)xd[4 * qq + 2] | ((unsigned)xd[4 * qq + 3] << 16)};
                    *(LAS u32x2*)(xeT + lane * SP + pos * 2) = (u32x2){(unsigned)xe[4 * qq] | ((unsigned)xe[4 * qq + 1] << 16), (unsigned)xe[4 * qq + 2] | ((unsigned)xe[4 * qq + 3] << 16)}; }
            }
            __syncthreads();
            {
                const float acl = acL[r * 128 + lq], ddt = dd / dtL[r * 128 + lq];
                f32x4 yd[4];
#pragma unroll
                for (int pt = 0; pt < 4; ++pt) yd[pt] = (f32x4){0.f, 0.f, 0.f, 0.f};
#pragma unroll
                for (int ks = 0; ks < 4; ++ks) { if (ks <= (wave >> 1)) {
                    f32x4 mlo, mhi;
#pragma unroll
                    for (int e = 0; e < 4; ++e) {
                        const int s0 = 32 * ks + 4 * q4 + e, s1 = s0 + 16;
                        const float v0 = cbt[2 * ks][e], v1 = cbt[2 * ks + 1][e];
                        mlo[e] = s0 < lq ? v0 * __expf(acl - acL[r * 128 + s0]) : (s0 == lq ? v0 + ddt : 0.f);
                        mhi[e] = s1 < lq ? v1 * __expf(acl - acL[r * 128 + s1]) : (s1 == lq ? v1 + ddt : 0.f);
                    }
                    const bf16x8 mf = acc_to_frag(mlo, mhi);
#pragma unroll
                    for (int pt = 0; pt < 4; ++pt) { const bf16x8 xf = *(const LAS bf16x8*)(xdT + (16 * pt + r16) * SP + (32 * ks + 8 * q4) * 2); yd[pt] = __builtin_amdgcn_mfma_f32_16x16x32_bf16(xf, mf, yd[pt], 0, 0, 0); }
                } }
#pragma unroll
                for (int pt = 0; pt < 4; ++pt) *(u32x2*)(ydiag + (t0 + lq) * 1024 + hd * 64 + 16 * pt + 4 * q4) = (u32x2){pg8::cvt_pk_bf16(yd[pt][0], yd[pt][1]), pg8::cvt_pk_bf16(yd[pt][2], yd[pt][3])};
            }
            {
                bf16x8 bf[4];
#pragma unroll
                for (int ks = 0; ks < 4; ++ks) bf[ks] = *(const LAS bf16x8*)(BT + (16 * wave + r16) * SP + (32 * ks + 8 * q4) * 2);
                bf16_t* hp = states + ((size_t)(unit * 8 + r) * 64) * 128;
#pragma unroll
                for (int pt = 0; pt < 4; ++pt) { f32x4 st = {0.f, 0.f, 0.f, 0.f};
#pragma unroll
                    for (int ks = 0; ks < 4; ++ks) { const bf16x8 xf = *(const LAS bf16x8*)(xeT + (16 * pt + r16) * SP + (32 * ks + 8 * q4) * 2); st = __builtin_amdgcn_mfma_f32_16x16x32_bf16(bf[ks], xf, st, 0, 0, 0); }
                    *(u32x2*)(hp + (size_t)(16 * pt + r16) * 128 + 16 * wave + 4 * q4) = (u32x2){pg8::cvt_pk_bf16(st[0], st[1]), pg8::cvt_pk_bf16(st[2], st[3])}; }
            }
            __syncthreads();
        }
    }
}
DEV void ph_ssd_scan(const Args& a, const Ctx& X, const int wg0) {
    bf16_t* states = (bf16_t*)(a.ws + WS_STATES); const float* cdec = (const float*)(a.ws + WS_CDEC);
    for (int task = (X.bid - wg0) * NTHR + X.tid; task < NB * 16 * 64 * 32; task += (X.G - wg0) * NTHR) {
        const int n4 = task & 31, p = (task >> 5) & 63, hd = (task >> 11) & 15, b = task >> 15;
        float h0 = 0.f, h1 = 0.f, h2 = 0.f, h3 = 0.f;
        for (int c = 0; c < 32; ++c) {
            const int unit = (b * 32 + c) * 2 + (hd >> 3);
            u32x2* ptr = (u32x2*)(states + ((size_t)(unit * 8 + (hd & 7)) * 64 + p) * 128 + 4 * n4);
            const u32x2 sv = *ptr; const float dec = cdec[(size_t)unit * 32 + (hd & 7)];
            *ptr = (u32x2){pk2(h0, h1), pk2(h2, h3)};
            h0 = h0 * dec + __uint_as_float(sv.x << 16); h1 = h1 * dec + __uint_as_float(sv.x & 0xFFFF0000u); h2 = h2 * dec + __uint_as_float(sv.y << 16); h3 = h3 * dec + __uint_as_float(sv.y & 0xFFFF0000u);
        }
    }
}
DEV void ph_ssd_out(const Args& a, const Ctx& X, const int wg0) {
    const bf16_t* CC = (const bf16_t*)(a.ws + WS_CC); const float* acum = (const float*)(a.ws + WS_ACUM); const bf16_t* ydiag = (const bf16_t*)(a.ws + WS_YDIAG);
    const bf16_t* states = (const bf16_t*)(a.ws + WS_STATES); const bf16_t* zb = (const bf16_t*)(a.ws + WS_ZB); bf16_t* oy = (bf16_t*)(a.ws + WS_OY);
    const int lane = X.lane, wave = X.wave, r16 = lane & 15, q4 = lane >> 4;
    for (int unit = X.bid - wg0; unit < NB * 32 * 2; unit += X.G - wg0) {
        const int g = unit & 1, c = (unit >> 1) & 31, b = unit >> 6; const size_t t = (size_t)b * SEQ + 128 * c + 16 * wave + r16;
        bf16x8 cf[4];
#pragma unroll
        for (int ks = 0; ks < 4; ++ks) cf[ks] = *(const bf16x8*)(CC + t * 256 + g * 128 + 32 * ks + 8 * q4);
        float ss = 0.f;
        LAS u32x2* stash = (LAS u32x2*)(X.lds + wave * 16384);
        for (int r = 0; r < 8; ++r) {
            const int hd = g * 8 + r; const float eac = __expf(acum[((size_t)g * T + t) * 8 + r]);
            const bf16_t* hp = states + ((size_t)(unit * 8 + r) * 64) * 128;
#pragma unroll
            for (int pt = 0; pt < 4; ++pt) { f32x4 acc = {0.f, 0.f, 0.f, 0.f};
#pragma unroll
                for (int ks = 0; ks < 4; ++ks) { const bf16x8 hf = *(const bf16x8*)(hp + (size_t)(16 * pt + r16) * 128 + 32 * ks + 8 * q4); acc = __builtin_amdgcn_mfma_f32_16x16x32_bf16(hf, cf[ks], acc, 0, 0, 0); }
                const u32x2 yd = *(const u32x2*)(ydiag + t * 1024 + hd * 64 + 16 * pt + 4 * q4), zz = *(const u32x2*)(zb + t * 1024 + hd * 64 + 16 * pt + 4 * q4);
                f32x4 v; v[0] = acc[0] * eac + __uint_as_float(yd.x << 16); v[1] = acc[1] * eac + __uint_as_float(yd.x & 0xFFFF0000u); v[2] = acc[2] * eac + __uint_as_float(yd.y << 16); v[3] = acc[3] * eac + __uint_as_float(yd.y & 0xFFFF0000u);
                v[0] *= siluf(__uint_as_float(zz.x << 16)); v[1] *= siluf(__uint_as_float(zz.x & 0xFFFF0000u)); v[2] *= siluf(__uint_as_float(zz.y << 16)); v[3] *= siluf(__uint_as_float(zz.y & 0xFFFF0000u));
                ss += v[0] * v[0] + v[1] * v[1] + v[2] * v[2] + v[3] * v[3];
                stash[(r * 4 + pt) * 64 + lane] = (u32x2){pg8::cvt_pk_bf16(v[0], v[1]), pg8::cvt_pk_bf16(v[2], v[3])}; }
        }
        ss += __shfl_xor(ss, 16); ss += __shfl_xor(ss, 32);
        const float rstd = rsqrtf(ss * (1.f / 512.f) + EPS);
        for (int r = 0; r < 8; ++r)
#pragma unroll
            for (int pt = 0; pt < 4; ++pt) { const int cix = g * 512 + r * 64 + 16 * pt + 4 * q4; const f32x4 nw = *(const f32x4*)(a.ssd_norm_w + cix); const u32x2 w = stash[(r * 4 + pt) * 64 + lane];
                *(u32x2*)(oy + t * 2048 + 1024 + cix) = (u32x2){pg8::cvt_pk_bf16(__uint_as_float(w.x << 16) * rstd * nw[0], __uint_as_float(w.x & 0xFFFF0000u) * rstd * nw[1]), pg8::cvt_pk_bf16(__uint_as_float(w.y << 16) * rstd * nw[2], __uint_as_float(w.y & 0xFFFF0000u) * rstd * nw[3])}; }
    }
}


DEV void ph_attn(const Args& a, const Ctx& X) {
    const bf16_t* qkv = (const bf16_t*)(a.ws + WS_Q1KV); bf16_t* po = (bf16_t*)(a.ws + WS_PO); float* plse = (float*)(a.ws + WS_PLSE); bf16_t* o = (bf16_t*)(a.ws + WS_O1);
    LAS unsigned char* vl = X.lds + X.wave * 12288;
    LAS unsigned char* kl = vl + 6144;
    const int lane = X.lane, q = lane & 31, h5 = lane >> 5;
    const int tr_off = ((lane & 15) >> 2) * 192 + (16 * ((lane >> 4) & 1) + 4 * (lane & 3)) * 2;
    const int prow = lane >> 3, pch = lane & 7;
    for (int unit = X.bid; unit < NB * 16 * 8; unit += X.G) {
        const int bhd = unit & 63, b = bhd >> 4, hd = bhd & 15, g = unit >> 6;
        for (int tk = 0; tk < 6; ++tk) {
            const int br = tk >> 1, k = X.wave * 2 + (tk & 1);
            int d, r, i0;
            if (br == 0) { d = 1; r = 0; i0 = 512 * g + 32 * k; } else if (br == 1) { d = 4; r = k & 3; i0 = 128 * g + 32 * (k >> 2); } else { d = 16; r = k; i0 = 32 * g; }
            const size_t tq = (size_t)b * SEQ + (size_t)(i0 + q) * d + r;
#define ATT_LOAD(dst, j0_, coff) do { _Pragma("unroll") for (int _i = 0; _i < 4; ++_i) { const size_t _t = (size_t)b * SEQ + (size_t)((j0_) + 8 * _i + prow) * d + r; \
                dst[_i] = *(const u32x4*)(qkv + _t * 3072 + (coff) + hd * 64 + pch * 8); } } while (0)
            u32x4 kA[4], vA[4], kB[4], vB[4], kC[4], vC[4];
            const bool v3 = (i0 - 32) >= 0, v2 = (i0 - 64) >= 0, v1 = (i0 - 96) >= 0, v0 = (i0 - 128) >= 0;
            ATT_LOAD(kA, i0, 0);
            ATT_LOAD(kB, i0, 1024); ATT_LOAD(vB, i0, 2048);
            if (v3) { ATT_LOAD(kC, i0 - 32, 1024); ATT_LOAD(vC, i0 - 32, 2048); }
#pragma unroll
            for (int i = 0; i < 4; ++i) *(LAS u32x4*)(kl + (8 * i + prow) * 144 + pch * 16) = kA[i];
            bf16x8 qf[4];
#pragma unroll
            for (int s = 0; s < 4; ++s) qf[s] = *(const LAS bf16x8*)(kl + q * 144 + (16 * s + 8 * h5) * 2);
            LDS_WAIT();
            f32x16 oacc[2];
#pragma unroll
            for (int i = 0; i < 16; ++i) { oacc[0][i] = 0.f; oacc[1][i] = 0.f; }
            float m = -1e30f, l = 0.f;
            auto tile = [&](const int kt, const u32x4 (&kp)[4], const u32x4 (&vp)[4]) {
#pragma unroll
                for (int i = 0; i < 4; ++i) { *(LAS u32x4*)(kl + (8 * i + prow) * 144 + pch * 16) = kp[i]; *(LAS u32x4*)(vl + (8 * i + prow) * 192 + pch * 16) = vp[i]; }
                f32x16 sacc;
#pragma unroll
                for (int i = 0; i < 16; ++i) sacc[i] = 0.f;
#pragma unroll
                for (int s = 0; s < 4; ++s) { const bf16x8 kf = *(const LAS bf16x8*)(kl + q * 144 + (16 * s + 8 * h5) * 2); sacc = __builtin_amdgcn_mfma_f32_32x32x16_bf16(kf, qf[s], sacc, 0, 0, 0); }
                if (kt == 4) {
#pragma unroll
                    for (int i = 0; i < 16; ++i) { const int kl_ = (i & 3) + 8 * (i >> 2) + 4 * h5; if (kl_ > q) sacc[i] = -1e30f; }
                } else if (kt == 0) {
#pragma unroll
                    for (int i = 0; i < 16; ++i) { const int kl_ = (i & 3) + 8 * (i >> 2) + 4 * h5; if (kl_ < q) sacc[i] = -1e30f; }
                }
                float mx = sacc[0];
#pragma unroll
                for (int i = 1; i < 16; ++i) mx = fmaxf(mx, sacc[i]);
                mx = fmaxf(mx, __shfl_xor(mx, 32));
                const float mn = fmaxf(m, mx), alpha = __expf(m - mn);
                float rs = 0.f;
#pragma unroll
                for (int i = 0; i < 16; ++i) { sacc[i] = __expf(sacc[i] - mn); rs += sacc[i]; }
                rs += __shfl_xor(rs, 32);
                l = l * alpha + rs; m = mn;
#pragma unroll
                for (int i = 0; i < 16; ++i) { oacc[0][i] *= alpha; oacc[1][i] *= alpha; }
                bf16x8 pf[2];
#pragma unroll
                for (int s = 0; s < 2; ++s) { u32x4 w; w.x = pg8::cvt_pk_bf16(sacc[8 * s], sacc[8 * s + 1]); w.y = pg8::cvt_pk_bf16(sacc[8 * s + 2], sacc[8 * s + 3]); w.z = pg8::cvt_pk_bf16(sacc[8 * s + 4], sacc[8 * s + 5]); w.w = pg8::cvt_pk_bf16(sacc[8 * s + 6], sacc[8 * s + 7]);
                    pf[s] = __builtin_bit_cast(bf16x8, w); }
#pragma unroll
                for (int dt = 0; dt < 2; ++dt)
#pragma unroll
                    for (int s = 0; s < 2; ++s) {
                        const s16x4 t0_ = __builtin_amdgcn_ds_read_tr16_b64_v4i16((LAS s16x4*)(vl + (16 * s + 4 * h5) * 192 + dt * 64 + tr_off));
                        const s16x4 t1_ = __builtin_amdgcn_ds_read_tr16_b64_v4i16((LAS s16x4*)(vl + (16 * s + 8 + 4 * h5) * 192 + dt * 64 + tr_off));
                        bf16x8 vf; vf[0] = t0_[0]; vf[1] = t0_[1]; vf[2] = t0_[2]; vf[3] = t0_[3]; vf[4] = t1_[0]; vf[5] = t1_[1]; vf[6] = t1_[2]; vf[7] = t1_[3];
                        oacc[dt] = __builtin_amdgcn_mfma_f32_32x32x16_bf16(vf, pf[s], oacc[dt], 0, 0, 0);
                    }
                LDS_WAIT();
            };
            if (v2) { ATT_LOAD(kA, i0 - 64, 1024); ATT_LOAD(vA, i0 - 64, 2048); }
            tile(4, kB, vB);
            if (v3) {
                if (v1) { ATT_LOAD(kB, i0 - 96, 1024); ATT_LOAD(vB, i0 - 96, 2048); }
                tile(3, kC, vC);
                if (v2) {
                    if (v0) { ATT_LOAD(kC, i0 - 128, 1024); ATT_LOAD(vC, i0 - 128, 2048); }
                    tile(2, kA, vA);
                    if (v1) { tile(1, kB, vB);
                        if (v0) tile(0, kC, vC); }
                }
            }
#undef ATT_LOAD
            const float inv = 1.f / l;
            bf16_t* pr = po + ((size_t)br * T + tq) * 1024 + hd * 64;
#pragma unroll
            for (int dt = 0; dt < 2; ++dt)
#pragma unroll
                for (int gq = 0; gq < 4; ++gq) { u32x2 w; w.x = pg8::cvt_pk_bf16(oacc[dt][4 * gq] * inv, oacc[dt][4 * gq + 1] * inv); w.y = pg8::cvt_pk_bf16(oacc[dt][4 * gq + 2] * inv, oacc[dt][4 * gq + 3] * inv);
                    *(u32x2*)(pr + 32 * dt + 8 * gq + 4 * h5) = w; }
            if (h5 == 0) plse[((size_t)br * T + tq) * 16 + hd] = m + __logf(l);
        }
        VM_WAIT(); __syncthreads();
        {
            const size_t t = (size_t)b * SEQ + 512 * g + X.tid;
            const float l0 = plse[t * 16 + hd], l1 = plse[((size_t)T + t) * 16 + hd], l2 = plse[((size_t)2 * T + t) * 16 + hd];
            const float mx = fmaxf(l0, fmaxf(l1, l2)); float w0 = __expf(l0 - mx), w1 = __expf(l1 - mx), w2 = __expf(l2 - mx); const float wi = 1.f / (w0 + w1 + w2); w0 *= wi; w1 *= wi; w2 *= wi;
            const bf16_t* p0 = po + t * 1024 + hd * 64; const bf16_t* p1 = p0 + (size_t)T * 1024; const bf16_t* p2 = p1 + (size_t)T * 1024; bf16_t* orow = o + t * 1024 + hd * 64;
#pragma unroll
            for (int c = 0; c < 8; ++c) { const u32x4 x0 = *(const u32x4*)(p0 + 8 * c), x1 = *(const u32x4*)(p1 + 8 * c), x2 = *(const u32x4*)(p2 + 8 * c); u32x4 y;
#pragma unroll
                for (int e = 0; e < 4; ++e) { const float lo = w0 * __uint_as_float(x0[e] << 16) + w1 * __uint_as_float(x1[e] << 16) + w2 * __uint_as_float(x2[e] << 16);
                    const float hi = w0 * __uint_as_float(x0[e] & 0xFFFF0000u) + w1 * __uint_as_float(x1[e] & 0xFFFF0000u) + w2 * __uint_as_float(x2[e] & 0xFFFF0000u); y[e] = pk2(lo, hi); }
                *(u32x4*)(orow + 8 * c) = y; }
        }
    }
}

DEV void ph_router(const Args& a, const Ctx& X, const int l) {
    unsigned char* ws = a.ws;
    const float* mod = (const float*)(ws + WS_MOD) + (size_t)l * NB * 6 * D;
    const bf16_t* ymix = (const bf16_t*)(ws + WS_YMIX);
    bf16_t* xb = (bf16_t*)(ws + WS_XB);
    bf16_t* hb = (bf16_t*)(ws + WS_H);
    int* idx = (int*)(ws + WS_IDX); float* gw = (float*)(ws + WS_GW); int* aslot = (int*)(ws + WS_ASLOT); int* ltok = (int*)(ws + WS_LTOK);
    int* cntg = (int*)(ws + WS_CTL + CTL_CNT) + l * NE;
    const float* rw = a.router_w + (size_t)l * D * NE; const float* rbias = a.router_bias + l * NE;
    constexpr int HP = 2064;
    LAS unsigned char* hL = X.lds;
    LAS float* logit = (LAS float*)(X.lds + AUX_OFF + 2048);
    LAS int* lcnt = (LAS int*)(X.lds + AUX_OFF + 2048 + 64 * 65 * 4);
    LAS int* lbase = lcnt + 64;
    LAS int* sel_e = lbase + 64;
    LAS int* sel_s = sel_e + 512;
    const int lane = X.lane, wave = X.wave;
    for (int rb = X.bid; rb < T / 64; rb += X.G) {
        if (X.tid < 64) lcnt[X.tid] = 0;
        f32x4 xf_n[4]; u32x2 xb_n[4], ym_n[4];
#define RT_LOAD(rr) do { const int _row = rb * 64 + wave * 8 + (rr); _Pragma("unroll") for (int _j = 0; _j < 4; ++_j) { \
            if (l == 0) xf_n[_j] = *(const f32x4*)(a.x + (size_t)_row * D + _j * 256 + lane * 4); else xb_n[_j] = *(const u32x2*)(xb + (size_t)_row * D + _j * 256 + lane * 4); \
            ym_n[_j] = *(const u32x2*)(ymix + (size_t)_row * D + _j * 256 + lane * 4); } } while (0)
        RT_LOAD(0);
        for (int r8 = 0; r8 < 8; ++r8) {
            const int lr = wave * 8 + r8, row = rb * 64 + lr, b = row / SEQ; const float* ml = mod + (size_t)b * 6 * D;
            float xv[16], yv[16];
#pragma unroll
            for (int j = 0; j < 4; ++j) {
                if (l == 0) { xv[4 * j] = xf_n[j][0]; xv[4 * j + 1] = xf_n[j][1]; xv[4 * j + 2] = xf_n[j][2]; xv[4 * j + 3] = xf_n[j][3]; }
                else { xv[4 * j] = __uint_as_float(xb_n[j].x << 16); xv[4 * j + 1] = __uint_as_float(xb_n[j].x & 0xFFFF0000u); xv[4 * j + 2] = __uint_as_float(xb_n[j].y << 16); xv[4 * j + 3] = __uint_as_float(xb_n[j].y & 0xFFFF0000u); }
                yv[4 * j] = __uint_as_float(ym_n[j].x << 16); yv[4 * j + 1] = __uint_as_float(ym_n[j].x & 0xFFFF0000u); yv[4 * j + 2] = __uint_as_float(ym_n[j].y << 16); yv[4 * j + 3] = __uint_as_float(ym_n[j].y & 0xFFFF0000u); }
            if (r8 + 1 < 8) RT_LOAD(r8 + 1);
            resid_update(xv, yv, a.mix_post_g + l * D, ml + 2 * D, lane);
            store_row_bf(xb + (size_t)row * D, lane, xv);
            u32x2 o[4]; prenorm_pack(xv, a.ffn_pre_g + l * D, ml + 4 * D, ml + 3 * D, lane, o);
#pragma unroll
            for (int j = 0; j < 4; ++j) { *(LAS u32x2*)(hL + lr * HP + (j * 256 + lane * 4) * 2) = o[j];
                const float h0 = __uint_as_float(o[j].x << 16), h1 = __uint_as_float(o[j].x & 0xFFFF0000u), h2 = __uint_as_float(o[j].y << 16), h3 = __uint_as_float(o[j].y & 0xFFFF0000u);
                int w = __builtin_amdgcn_cvt_pk_fp8_f32(fminf(fmaxf(h0, -440.f), 440.f), fminf(fmaxf(h1, -440.f), 440.f), 0, false); w = __builtin_amdgcn_cvt_pk_fp8_f32(fminf(fmaxf(h2, -440.f), 440.f), fminf(fmaxf(h3, -440.f), 440.f), w, true);
                *(unsigned*)((unsigned char*)hb + (size_t)row * D + j * 256 + lane * 4) = (unsigned)w; }
        }
#undef RT_LOAD
        __syncthreads();
        { const int rt = wave & 3, nh = wave >> 2, r16 = lane & 15, kq = lane >> 4;
          f32x4 acc0 = {0.f, 0.f, 0.f, 0.f}, acc1 = {0.f, 0.f, 0.f, 0.f};
          for (int c = 0; c < 32; ++c) {
              const u32x4 hv = *(const LAS u32x4*)(hL + (rt * 16 + r16) * HP + (32 * c + 8 * kq) * 2);
              const float* rp = rw + (size_t)(32 * c + 8 * kq) * NE + 4 * r16 + 2 * nh;
#pragma unroll
              for (int j = 0; j < 8; ++j) { const unsigned wj = hv[j >> 1]; const float av = (j & 1) ? __uint_as_float(wj & 0xFFFF0000u) : __uint_as_float(wj << 16);
                  const f32x2 bv = *(const f32x2*)(rp + (size_t)j * NE);
                  acc0 = __builtin_amdgcn_mfma_f32_16x16x4f32(av, bv.x, acc0, 0, 0, 0); acc1 = __builtin_amdgcn_mfma_f32_16x16x4f32(av, bv.y, acc1, 0, 0, 0); }
          }
#pragma unroll
          for (int r = 0; r < 4; ++r) { logit[(rt * 16 + 4 * kq + r) * 65 + 4 * r16 + 2 * nh] = acc0[r]; logit[(rt * 16 + 4 * kq + r) * 65 + 4 * r16 + 2 * nh + 1] = acc1[r]; } }
        __syncthreads();
        for (int r8 = 0; r8 < 8; ++r8) {
            const int lr = wave * 8 + r8, t = rb * 64 + lr;
            float lgt = logit[lr * 65 + lane]; if (!(lgt > -1e30f && lgt < 1e30f)) lgt = 0.f;
            const float score = sigmoidf_(lgt), biased = score + rbias[lane];
            float m1 = biased;
#pragma unroll
            for (int o = 1; o < 8; o <<= 1) m1 = fmaxf(m1, __shfl_xor(m1, o));
            int c1 = (biased == m1) ? (lane & 7) : 8;
#pragma unroll
            for (int o = 1; o < 8; o <<= 1) c1 = min(c1, __shfl_xor(c1, o));
            float m2 = ((lane & 7) == c1) ? -INFINITY : biased;
#pragma unroll
            for (int o = 1; o < 8; o <<= 1) m2 = fmaxf(m2, __shfl_xor(m2, o));
            const float gs = m1 + m2; const int myg = lane >> 3; int grank = 0;
#pragma unroll
            for (int g2 = 0; g2 < 8; ++g2) { const float o = __shfl(gs, g2 * 8); grank += (o > gs || (o == gs && g2 < myg)) ? 1 : 0; }
            const float cand = (grank < 4) ? biased : -INFINITY; int rank = 0;
            for (int e2 = 0; e2 < 64; ++e2) { const float o = __shfl(cand, e2); rank += (o > cand || (o == cand && e2 < lane)) ? 1 : 0; }
            const bool sel = (rank < TOPK) && (grank < 4);
            const float ssum = wave_sum(sel ? score : 0.f);
            if (sel) { idx[t * 8 + rank] = lane; gw[t * 8 + rank] = score / ssum * 2.5f; sel_e[lr * 8 + rank] = lane; sel_s[lr * 8 + rank] = __hip_atomic_fetch_add(lcnt + lane, 1, __ATOMIC_RELAXED, __HIP_MEMORY_SCOPE_WORKGROUP); }
        }
        __syncthreads();
        if (X.tid < 64) { const int n = lcnt[X.tid]; lbase[X.tid] = n ? atomicAdd(cntg + X.tid, n) : 0; }
        __syncthreads();
        { const int lr = X.tid >> 3, k = X.tid & 7, t = rb * 64 + lr, e = sel_e[lr * 8 + k], sl = lbase[e] + sel_s[lr * 8 + k];
          aslot[t * 8 + k] = sl; ltok[e * CAP + sl] = t; }
        __syncthreads();
    }
}
template <int NW>
DEV void ph_moe_conv(const Args& a, const Ctx& X, const int l, const int wg0) {
    unsigned char* ws = a.ws;
    if (X.wave >= NW) return;
    { LAS float* scr = (LAS float*)(X.lds + X.wave * 8704);
      const int gwv = (X.bid - wg0) * NW + X.wave, NGW = (X.G - wg0) * NW;
      constexpr int I_GU = (D / 64) * (512 / 32), I_D = (ED / 64) * (D / 32), I_E = I_GU + I_D;
      const float* eg = a.exp_gate + (size_t)l * NE * D * ED; const float* eu = a.exp_up + (size_t)l * NE * D * ED; const float* ed = a.exp_down + (size_t)l * NE * ED * D;
      for (int it = gwv; it < (NE + 1) * I_E; it += NGW) {
          const int e = it / I_E; int r = it - e * I_E;
          if (e < NE) {
              if (r < I_GU) conv_item<SrcGU, true>(SrcGU{eg + (size_t)e * D * ED, (long)(eu - eg)}, ED, D, ws + WS_WGU + (size_t)e * 512 * D, scr, r, 16, X.lane, 64.f);
              else conv_item<SrcIdent, true>(SrcIdent{ed + (size_t)e * ED * D}, D, ED, ws + WS_WD + (size_t)e * D * ED, scr, r - I_GU, D / 32, X.lane, 32.f);
          } else {
              if (r < I_GU) conv_item<SrcGU, true>(SrcGU{a.sh_gate + (size_t)l * D * ED, (long)(a.sh_up - a.sh_gate)}, ED, D, ws + WS_WGUS, scr, r, 16, X.lane, 64.f);
              else conv_item<SrcIdent, true>(SrcIdent{a.sh_down + (size_t)l * ED * D}, D, ED, ws + WS_WDS, scr, r - I_GU, D / 32, X.lane, 32.f);
          }
      } }
}

DEV int moe_tables(const Args& a, const Ctx& X, const int l, LAS int* t_cnt, LAS int* t_rb0, LAS int* t_eofrb) {
    const int* cntg = (const int*)(a.ws + WS_CTL + CTL_CNT) + l * NE;
    if (X.wave == 0) {
        const int c = __hip_atomic_load(cntg + X.lane, __ATOMIC_RELAXED, __HIP_MEMORY_SCOPE_AGENT), nrb = (c + 255) >> 8;
        int incl = nrb;
#pragma unroll
        for (int o = 1; o < 64; o <<= 1) { const int v = __shfl_up(incl, o); if (X.lane >= o) incl += v; }
        const int excl = incl - nrb;
        t_cnt[X.lane] = c; t_rb0[X.lane] = excl; if (X.lane == 63) t_rb0[64] = incl;
        for (int j = 0; j < nrb; ++j) t_eofrb[excl + j] = X.lane;
        t_eofrb[SH_RB + X.lane] = NE;
    }
    __syncthreads();
    return t_rb0[64];
}

DEV void ph_moe_gu(const Args& a, const Ctx& X, const int l) {
    LAS int* t_cnt = (LAS int*)(X.lds + AUX_OFF + 1024); LAS int* t_rb0 = t_cnt + 64; LAS int* t_eofrb = t_rb0 + 80; LAS int* toks = t_eofrb + NRB_ALL;
    const int nrbt = moe_tables(a, X, l, t_cnt, t_rb0, t_eofrb);
    const int* ltok = (const int*)(a.ws + WS_LTOK);
    pg8::Unit u;
    for (int i = 0; i < 8; ++i) { if (!pg8::moe_unit(i, 2, nrbt, X.G, X.bid, u)) break;
        if (X.tid < 256) { const int e = t_eofrb[u.pm]; int tok;
            if (e < NE) { const int sl = (u.pm - t_rb0[e]) * 256 + X.tid; tok = sl < t_cnt[e] ? ltok[e * CAP + sl] : 0; } else tok = (u.pm - SH_RB) * 256 + X.tid;
            toks[i * 256 + X.tid] = tok; } }
    VM_WAIT(); __syncthreads();
    pg8::SchedGU S{(const char*)(a.ws + WS_H), (const char*)(a.ws + WS_WGU), (const char*)(a.ws + WS_WGUS), t_eofrb, toks, nrbt, X.G, X.bid, 0};
    pg8::EpiGU E{a.ws + WS_HID};
    pg8::gemm_phase<pg8::EpiGU, pg8::SchedGU, true>(X.lds, D, S, E);
}
DEV void ph_moe_down(const Args& a, const Ctx& X, const int l) {
    LAS int* t_cnt = (LAS int*)(X.lds + AUX_OFF + 1024); LAS int* t_rb0 = t_cnt + 64; LAS int* t_eofrb = t_rb0 + 80;
    const int nrbt = moe_tables(a, X, l, t_cnt, t_rb0, t_eofrb);
    pg8::SchedDown S{(const char*)(a.ws + WS_HID), (const char*)(a.ws + WS_WD), (const char*)(a.ws + WS_WDS), t_eofrb, nrbt, X.G, X.bid, 0};
    pg8::EpiFp8 E{(unsigned char*)(a.ws + WS_Y), D, 0};
    int kd = ED; asm volatile("" : "+s"(kd));
    pg8::gemm_phase<pg8::EpiFp8, pg8::SchedDown, true>(X.lds, kd, S, E);
}
DEV void ph_combine(const Args& a, const Ctx& X, const int l) {
    LAS int* t_cnt = (LAS int*)(X.lds + AUX_OFF + 1024); LAS int* t_rb0 = t_cnt + 64; LAS int* t_eofrb = t_rb0 + 80;
    (void)moe_tables(a, X, l, t_cnt, t_rb0, t_eofrb);
    const float* mod = (const float*)(a.ws + WS_MOD);
    const int* idx = (const int*)(a.ws + WS_IDX); const float* gw = (const float*)(a.ws + WS_GW); const int* aslot = (const int*)(a.ws + WS_ASLOT);
    const unsigned char* y = a.ws + WS_Y; bf16_t* hb = (bf16_t*)(a.ws + WS_H);
    const int lane = X.lane;
    const int tstep = X.G * NWAVES;
    int t = X.bid * NWAVES + X.wave;
    int e_n = 0, s_n = 0; float g_n = 0.f;
    if (t < T && lane < 8) { e_n = idx[t * 8 + lane]; g_n = gw[t * 8 + lane]; s_n = aslot[t * 8 + lane]; }
    for (; t < T; t += tstep) {
        const int b = t / SEQ; const float* ml = mod + (size_t)(l * NB + b) * 6 * D;
        const int e_c = e_n, s_c = s_n; const float g_c = g_n;
        const int tn = t + tstep;
        if (tn < T && lane < 8) { e_n = idx[tn * 8 + lane]; g_n = gw[tn * 8 + lane]; s_n = aslot[tn * 8 + lane]; }
        u32x2 w0[9], w1[9];
        { const unsigned char* yr = y + ((size_t)SH_RB * 256 + t) * D; w0[8] = *(const u32x2*)(yr + 8 * lane); w1[8] = *(const u32x2*)(yr + 512 + 8 * lane); }
        float gk[8];
#pragma unroll
        for (int k = 0; k < 8; ++k) { const int e = __shfl(e_c, k), sl = __shfl(s_c, k); gk[k] = __shfl(g_c, k);
            const unsigned char* yr = y + ((size_t)t_rb0[e] * 256 + sl) * D; w0[k] = *(const u32x2*)(yr + 8 * lane); w1[k] = *(const u32x2*)(yr + 512 + 8 * lane); }
        float xv[16]; load_row8_bf((const bf16_t*)(a.ws + WS_XB) + (size_t)t * D, lane, xv);
        float yv[16];
#pragma unroll
        for (int i = 0; i < 16; ++i) yv[i] = 0.f;
        acc_row8(yv, w0[8], w1[8], 0.125f);
#pragma unroll
        for (int k = 0; k < 8; ++k) acc_row8(yv, w0[k], w1[k], gk[k] * 0.125f);
        resid_update8(xv, yv, a.ffn_post_g + l * D, ml + 5 * D, lane);
        if (l == 0) store_row8_bf((bf16_t*)(a.ws + WS_XB) + (size_t)t * D, lane, xv); else store_row8(a.out + (size_t)t * D, lane, xv);
        if (l == 0) { const float* mn = mod + (size_t)(1 * NB + b) * 6 * D; u32x4 o[2]; prenorm_pack8(xv, a.mix_pre_g + D, mn + D, mn, lane, o);
            *(u32x4*)(hb + (size_t)t * D + 8 * lane) = o[0]; *(u32x4*)(hb + (size_t)t * D + 512 + 8 * lane) = o[1]; }
    }
}

constexpr int NPH = 18;
__global__ void __launch_bounds__(NTHR, 2) mega(Args a) {
    extern __shared__ __attribute__((aligned(16))) unsigned char lds_raw[];
    Ctx X; X.lds = (LAS unsigned char*)lds_raw; X.tid = threadIdx.x; X.lane = X.tid & 63; X.wave = __builtin_amdgcn_readfirstlane(X.tid >> 6); X.G = gridDim.x; X.bid = blockIdx.x;
    if (X.tid < 4) ((LAS unsigned*)(X.lds + BAR_OFF))[X.tid] = 0u;
    __syncthreads();
    XcdBarrier bar; bar.bar = (unsigned*)(a.ws + WS_CTL); bar.x = 0; bar.st = nullptr;
    if (!MK_PER_PHASE) bar = xcd_barrier_post((unsigned*)(a.ws + WS_CTL), (volatile LAS unsigned*)(X.lds + BAR_OFF));
    const int lo = a.ph_lo, hi = a.ph_hi;
#define IN(k) (lo <= (k) && (k) < hi)
#define REP(k, ...) do { __VA_ARGS__; if constexpr (((PROBE_MASK >> (k)) & 1u) != 0u) { __syncthreads(); __VA_ARGS__; } } while (0)
#define SEAM(k) do { if (IN(k) && IN((k) + 1)) xcd_barrier(bar); else { VM_WAIT(); __syncthreads(); } } while (0)
    unsigned char* ws = a.ws;
    if (IN(0)) { REP(0, ph_setup(a, X)); SEAM(0); }
    if (IN(1)) { REP(1, ph_prenorm0(a, X)); SEAM(1); }
    if constexpr (((PROBE_MASK >> 24) & 1u) != 0u) { for (int i_ = 0; i_ < 16; ++i_) xcd_barrier(bar); }
    if (IN(2)) {
        pg8::SchedDense S; S.so.init(T, NPROJ, X.G, X.bid); S.A = (const char*)(ws + WS_H); S.Bt = (const char*)(ws + WS_WIN); S.K = D; S.pad_ = 0;
        pg8::EpiProj E{(bf16_t*)(ws + WS_QKVPRE), (bf16_t*)(ws + WS_ZA), (bf16_t*)(ws + WS_XBCPRE), (bf16_t*)(ws + WS_ZB), (float*)(ws + WS_SMALL)};
        REP(2, pg8::gemm_phase<pg8::EpiProj, pg8::SchedDense>(X.lds, D, S, E)); SEAM(2); }
    if (IN(3)) { REP(3, ph_gdn_local(a, X)); REP(20, ph_ssd_local(a, X)); SEAM(3); }
    if (IN(4)) {
        if (X.bid < 32) { REP(4, ph_gdn_scan(a, X)); }
        else { ph_ssd_scan(a, X, 32); group_barrier((unsigned*)(ws + WS_CTL + CTL_GRP), (unsigned)(X.G - 32)); __syncthreads(); ph_ssd_out(a, X, 32); __syncthreads(); ph_moe_conv<2>(a, X, 0, 32); __syncthreads(); ph_setup_late(a, X, 32); }
        SEAM(4); }
    if (IN(6)) {
        pg8::SchedDense S; S.so.init(T, D, X.G, X.bid); S.A = (const char*)(ws + WS_OY); S.Bt = (const char*)(ws + WS_WOUT); S.K = 2048; S.pad_ = 0;
        pg8::EpiBf16 E{(bf16_t*)(ws + WS_YMIX), D, 0};
        REP(6, pg8::gemm_phase<pg8::EpiBf16, pg8::SchedDense>(X.lds, 2048, S, E)); SEAM(6); }
    if (IN(7)) { ph_router(a, X, 0); SEAM(7); }
    if (IN(8)) { REP(8, ph_moe_gu(a, X, 0)); SEAM(8); }
    if (IN(9)) { REP(9, ph_moe_down(a, X, 0)); SEAM(9); }
    if (IN(10)) { ph_combine(a, X, 0); SEAM(10); }
    if (IN(11)) {
        pg8::SchedDense S; S.so.init(T, 3072, X.G, X.bid); S.A = (const char*)(ws + WS_H); S.Bt = (const char*)(ws + WS_WQKV); S.K = D; S.pad_ = 0;
        pg8::EpiQKV E{(bf16_t*)(ws + WS_Q1KV), (const float*)(ws + WS_COS), (const float*)(ws + WS_SIN)};
        REP(11, pg8::gemm_phase<pg8::EpiQKV, pg8::SchedDense>(X.lds, D, S, E)); SEAM(11); }
    if (IN(12)) { REP(12, ph_attn(a, X)); SEAM(12); }
    if (IN(13)) {
        pg8::SchedDense S; S.so.init(T, D, X.G, X.bid); S.A = (const char*)(ws + WS_O1); S.Bt = (const char*)(ws + WS_WO); S.K = D; S.pad_ = 0;
        pg8::EpiBf16 E{(bf16_t*)(ws + WS_YMIX), D, 0};
        REP(13, pg8::gemm_phase<pg8::EpiBf16, pg8::SchedDense>(X.lds, D, S, E)); SEAM(13); }
    if (IN(14)) { ph_router(a, X, 1); REP(14, ph_moe_conv<8>(a, X, 1, 0)); SEAM(14); }
    if (IN(15)) { ph_moe_gu(a, X, 1); SEAM(15); }
    if (IN(16)) { ph_moe_down(a, X, 1); SEAM(16); }
    if (IN(17)) { REP(17, ph_combine(a, X, 1)); }
#undef IN
#undef SEAM
}

extern "C" void kernel_launch(void* const* d_in, const int* in_sizes, int n_in, void* d_out, int out_size, void* d_ws, size_t ws_size, hipStream_t stream) {
    static int grid = 0;
    if (!grid) {
        int dev = 0, cus = 0, per_cu = 0;
        if (hipGetDevice(&dev) != hipSuccess || hipDeviceGetAttribute(&cus, hipDeviceAttributeMultiprocessorCount, dev) != hipSuccess) { fprintf(stderr, "kernel_launch: device query failed\n"); grid = -1; return; }
        if (hipFuncSetAttribute((const void*)mega, hipFuncAttributeMaxDynamicSharedMemorySize, LDS_BYTES) != hipSuccess) { fprintf(stderr, "kernel_launch: hipFuncSetAttribute failed\n"); grid = -1; return; }
        if (hipOccupancyMaxActiveBlocksPerMultiprocessor(&per_cu, (const void*)mega, NTHR, LDS_BYTES) != hipSuccess || per_cu < 1) { fprintf(stderr, "kernel_launch: occupancy query says %d blocks per CU\n", per_cu); grid = -1; return; }
        grid = cus;
        if (grid < 64 || (grid & 7)) { fprintf(stderr, "kernel_launch: unsupported CU count %d\n", cus); grid = -1; return; }
    }
    if (grid < 0) return;
    if (ws_size < WS_END || n_in != 31) { fprintf(stderr, "kernel_launch: workspace %zu < %zu or n_in %d != 31\n", ws_size, (size_t)WS_END, n_in); return; }
    if (hipMemsetAsync((char*)d_ws + WS_CTL, 0, CTL_BYTES, stream) != hipSuccess) { fprintf(stderr, "kernel_launch: memset failed\n"); return; }
    Args a{};
    a.x = (const float*)d_in[0]; a.c = (const float*)d_in[1]; a.pos = (const int*)d_in[2]; a.mod_w = (const float*)d_in[3]; a.mod_b = (const float*)d_in[4];
    a.mix_pre_g = (const float*)d_in[5]; a.mix_post_g = (const float*)d_in[6]; a.ffn_pre_g = (const float*)d_in[7]; a.ffn_post_g = (const float*)d_in[8];
    a.ssm_w_in = (const float*)d_in[9]; a.gdn_conv_w = (const float*)d_in[10]; a.gdn_a_log = (const float*)d_in[11]; a.gdn_dt_bias = (const float*)d_in[12]; a.gdn_norm_w = (const float*)d_in[13];
    a.ssd_conv_w = (const float*)d_in[14]; a.ssd_conv_b = (const float*)d_in[15]; a.ssd_a_log = (const float*)d_in[16]; a.ssd_dt_bias = (const float*)d_in[17]; a.ssd_d = (const float*)d_in[18]; a.ssd_norm_w = (const float*)d_in[19];
    a.ssm_w_out = (const float*)d_in[20]; a.attn_w_qkv = (const float*)d_in[21]; a.attn_w_o = (const float*)d_in[22];
    a.router_w = (const float*)d_in[23]; a.router_bias = (const float*)d_in[24]; a.exp_gate = (const float*)d_in[25]; a.exp_up = (const float*)d_in[26]; a.exp_down = (const float*)d_in[27];
    a.sh_gate = (const float*)d_in[28]; a.sh_up = (const float*)d_in[29]; a.sh_down = (const float*)d_in[30];
    a.out = (float*)d_out; a.ws = (unsigned char*)d_ws;
#if MK_PER_PHASE
    for (int p = 0; p < NPH; ++p) { a.ph_lo = p; a.ph_hi = p + 1; hipLaunchKernelGGL(mega, dim3(grid), dim3(NTHR), LDS_BYTES, stream, a); }
#else
    a.ph_lo = 0; a.ph_hi = NPH;
    hipLaunchKernelGGL(mega, dim3(grid), dim3(NTHR), LDS_BYTES, stream, a);
#endif
}
```

```cpp
#include <hip/hip_runtime.h>
#include <stdint.h>
#include <stdio.h>

#define DEV __device__ __forceinline__
#define LAS __attribute__((address_space(3)))
typedef unsigned short bf16_t;
typedef short bf16x8 __attribute__((ext_vector_type(8)));
typedef float f32x4 __attribute__((ext_vector_type(4)));
typedef float f32x2 __attribute__((ext_vector_type(2)));
typedef unsigned u32x4 __attribute__((ext_vector_type(4)));
typedef unsigned u32x2 __attribute__((ext_vector_type(2)));
typedef float f32x16 __attribute__((ext_vector_type(16)));
typedef short s16x4 __attribute__((ext_vector_type(4)));

#ifndef PROBE_MASK
#define PROBE_MASK 0u
#endif
#ifndef MK_PER_PHASE
#define MK_PER_PHASE 0
#endif

constexpr int NB = 4, SEQ = 4096, T = NB * SEQ, D = 1024;
constexpr int PROJ = 6688, NPROJ = 6912;
constexpr int C_BETA = 4096, C_XBC = 4112, C_ZB = 5648, C_DT = 6672;
constexpr int NE = 64, TOPK = 8, ED = 256, CAP = 16384;
constexpr int SH_RB = 576;
constexpr int NRB_ALL = SH_RB + 64;
constexpr float EPS = 1e-6f;
constexpr int NTHR = 512, NWAVES = 8;
constexpr int LDS_BYTES = 163840;
constexpr int AUX_OFF = 131072;
constexpr int BAR_OFF = LDS_BYTES - 16;

constexpr size_t MiB = 1u << 20;
constexpr size_t WS_CTL = 0, CTL_BYTES = 65536;
constexpr size_t CTL_CNT = 16384;
constexpr size_t CTL_GRP = 20480;
constexpr size_t WS_MOD = 65536;
constexpr size_t WS_COS = 1 * MiB, WS_SIN = 3 * MiB;
constexpr size_t WS_IDX = 5 * MiB, WS_GW = 5 * MiB + 512 * 1024, WS_ASLOT = 6 * MiB, WS_LTOK = 6 * MiB + 512 * 1024;
constexpr size_t WS_SMALL = 11 * MiB;
constexpr size_t WS_WIN = 16 * MiB, WS_WOUT = 30 * MiB, WS_WQKV = 34 * MiB, WS_WO = 40 * MiB;
constexpr size_t WS_H = 44 * MiB;
constexpr size_t WS_QKVPRE = 78 * MiB, WS_XBCPRE = 174 * MiB, WS_ZA = 222 * MiB, WS_ZB = 254 * MiB;
constexpr size_t WS_CC = 16 * MiB, WS_ACUM = 25 * MiB, WS_CDEC = 26 * MiB, WS_YDIAG = 44 * MiB, WS_STATES = 430 * MiB;
constexpr size_t WS_GI = 286 * MiB, GI_UNIT = 73728, WS_GTMP = 462 * MiB, WS_GLAST = 27 * MiB;
constexpr size_t WS_OY = 78 * MiB, WS_YMIX = 286 * MiB, WS_XB = 240 * MiB;
constexpr size_t WS_WD = 478 * MiB, WS_WDS = 510 * MiB + 512 * 1024, WS_HID = 398 * MiB, WS_Y = 78 * MiB, WS_WGU = 142 * MiB, WS_WGUS = 207 * MiB;
constexpr size_t WS_Q1KV = 78 * MiB, WS_O1 = 174 * MiB, WS_PO = 350 * MiB, WS_PLSE = 446 * MiB;
constexpr size_t WS_END = 512 * MiB;

struct Args {
    const float* x; const float* c; const int* pos; const float* mod_w; const float* mod_b;
    const float* mix_pre_g; const float* mix_post_g; const float* ffn_pre_g; const float* ffn_post_g;
    const float* ssm_w_in; const float* gdn_conv_w; const float* gdn_a_log; const float* gdn_dt_bias; const float* gdn_norm_w;
    const float* ssd_conv_w; const float* ssd_conv_b; const float* ssd_a_log; const float* ssd_dt_bias; const float* ssd_d; const float* ssd_norm_w;
    const float* ssm_w_out; const float* attn_w_qkv; const float* attn_w_o;
    const float* router_w; const float* router_bias; const float* exp_gate; const float* exp_up; const float* exp_down;
    const float* sh_gate; const float* sh_up; const float* sh_down;
    float* out; unsigned char* ws; int ph_lo, ph_hi;
};

DEV float bf2f(bf16_t v) { return __uint_as_float(((unsigned)v) << 16); }
DEV unsigned f2bf(float f) { unsigned u = __float_as_uint(f); return (u + 0x7FFFu + ((u >> 16) & 1u)) >> 16; }
DEV unsigned pk2(float lo, float hi) { return f2bf(lo) | (f2bf(hi) << 16); }
DEV float wave_sum(float v) {
#pragma unroll
    for (int o = 32; o > 0; o >>= 1) v += __shfl_xor(v, o);
    return v;
}
DEV float siluf(float x) { return x / (1.f + __expf(-x)); }
DEV float sigmoidf_(float x) { return 1.f / (1.f + __expf(-x)); }
DEV float softplusf(float x) { return fmaxf(x, 0.f) + log1pf(__expf(-fabsf(x))); }
#define LDS_WAIT() asm volatile("s_waitcnt lgkmcnt(0)" ::: "memory")
#define VM_WAIT() asm volatile("s_waitcnt vmcnt(0)" ::: "memory")

#define XB_TMO      128
#define XB_XCNT(j)  (256  + 64 * (j))
#define XB_XSUB(j)  (1280 + 64 * (j))
#define XB_XGEN(j)  (2304 + 64 * (j))
#define XB_TOP      3328
#define XB_TOPGEN   3392
#define XCD_BAR_WORDS 3456
#define XB_SPIN_CAP (1u << 18)
#define LAS __attribute__((address_space(3)))

__device__ __forceinline__ unsigned xb_ld(unsigned* p)              { return __hip_atomic_load(p, __ATOMIC_RELAXED, __HIP_MEMORY_SCOPE_AGENT); }
__device__ __forceinline__ unsigned xb_add(unsigned* p, unsigned v) { return __hip_atomic_fetch_add(p, v, __ATOMIC_RELAXED, __HIP_MEMORY_SCOPE_AGENT); }
__device__ __forceinline__ unsigned xb_xcc_id() { return (unsigned)__builtin_amdgcn_s_getreg((3 << 11) | 20) & 0xFu; }
#define XB_SPIN(cond, bar) do { unsigned _sp = 0; while (cond) { __builtin_amdgcn_s_sleep(1); \
    if ((++_sp & 255u) == 0u) { if (xb_ld(&(bar)[XB_TMO])) break; if (_sp > XB_SPIN_CAP) { atomicAdd(&(bar)[XB_TMO], 1u); break; } } } } while (0)

struct XcdBarrier {
    unsigned* bar; unsigned x;
    volatile LAS unsigned* st;
};

__device__ __forceinline__ XcdBarrier xcd_barrier_post(unsigned* bar, volatile LAS unsigned* st) {
    XcdBarrier b; b.bar = bar; b.x = xb_xcc_id(); b.st = st;
    if (threadIdx.x == 0) (void)xb_add(&bar[XB_XCNT(b.x)], 1u);
    return b;
}
__device__ __forceinline__ void xcd_barrier_complete(unsigned* bar, unsigned x, unsigned& nloc, unsigned& nx) {
    const unsigned G = gridDim.x * gridDim.y * gridDim.z;
    unsigned sum, cnt, mine, sp = 0u;
    for (;;) {
        sum = 0u; cnt = 0u; mine = 0u;
#pragma unroll
        for (unsigned j = 0; j < 16; ++j) { const unsigned c = xb_ld(&bar[XB_XCNT(j)]); sum += c; cnt += (c > 0u) ? 1u : 0u; mine = (j == x) ? c : mine; }
        if (sum == G) break;
        __builtin_amdgcn_s_sleep(1);
        if ((++sp & 255u) == 0u) { if (xb_ld(&bar[XB_TMO])) break; if (sp > XB_SPIN_CAP) { atomicAdd(&bar[XB_TMO], 1u); break; } }
    }
    nloc = mine > 0u ? mine : 1u; nx = cnt > 0u ? cnt : 1u;
}

__device__ __forceinline__ void xcd_barrier(const XcdBarrier& b) {
    asm volatile("s_waitcnt vmcnt(0)" ::: "memory");
    __syncthreads();
    if (threadIdx.x == 0) {
        unsigned* bar = b.bar;
        __builtin_amdgcn_s_waitcnt(0);
        unsigned nloc = b.st[0], nx = b.st[1];
        if (nloc == 0u) { xcd_barrier_complete(bar, b.x, nloc, nx); b.st[0] = nloc; b.st[1] = nx; }
        const unsigned old = xb_add(&bar[XB_XSUB(b.x)], 1u);
        const unsigned gen = old / nloc;
        if (old + 1u == (gen + 1u) * nloc) {
            __builtin_amdgcn_fence(__ATOMIC_RELEASE, "agent");
            asm volatile("s_waitcnt vmcnt(0)" ::: "memory");
            const unsigned og = xb_add(&bar[XB_TOP], 1u);
            const unsigned tg = og / nx;
            if (og + 1u == (tg + 1u) * nx) xb_add(&bar[XB_TOPGEN], 1u);
            else XB_SPIN(xb_ld(&bar[XB_TOPGEN]) == tg, bar);
            __builtin_amdgcn_fence(__ATOMIC_ACQUIRE, "agent");
            xb_add(&bar[XB_XGEN(b.x)], 1u);
            asm volatile("s_waitcnt vmcnt(0)" ::: "memory");
        } else {
            XB_SPIN(xb_ld(&bar[XB_XGEN(b.x)]) == gen, bar);
            __builtin_amdgcn_fence(__ATOMIC_ACQUIRE, "agent");
            asm volatile("s_waitcnt vmcnt(0)" ::: "memory");
        }
    }
    __syncthreads();
}


DEV void group_barrier(unsigned* ctr, const unsigned n) {
    asm volatile("s_waitcnt vmcnt(0)" ::: "memory");
    __syncthreads();
    if (threadIdx.x == 0) {
        __builtin_amdgcn_fence(__ATOMIC_RELEASE, "agent");
        asm volatile("s_waitcnt vmcnt(0)" ::: "memory");
        (void)__hip_atomic_fetch_add(ctr, 1u, __ATOMIC_RELAXED, __HIP_MEMORY_SCOPE_AGENT);
        unsigned sp = 0;
        while (__hip_atomic_load(ctr, __ATOMIC_RELAXED, __HIP_MEMORY_SCOPE_AGENT) < n) { __builtin_amdgcn_s_sleep(2); if (++sp > (1u << 22)) break; }
        __builtin_amdgcn_fence(__ATOMIC_ACQUIRE, "agent");
        asm volatile("s_waitcnt vmcnt(0)" ::: "memory");
    }
    __syncthreads();
}

namespace pg8 {
constexpr int BM = 256, BK = 64, HALF = 128, HTB = HALF * BK * 2, STAGE_BYTES = 8 * HTB, NXCD = 8, WGM = 8;
DEV int lds_byte(int r, int c) { const int st = (r >> 4) * 2 + (c >> 5), rr = r & 15, cc = c & 31, ob = rr * 64 + cc * 2; return st * 1024 + (ob ^ (((ob >> 9) & 1) << 5)); }
DEV void stage_rc(int b, int& R, int& C) { const int st = b / 1024, sb = b % 1024, swz = sb ^ (((sb >> 9) & 1) << 5); R = (st >> 1) * 16 + swz / 64; C = (st & 1) * 32 + (swz % 64) / 2; }
DEV int perm32(int rho) { const int n = rho >> 4, i = rho & 15; return 8 * (i >> 2) + 4 * n + (i & 3); }
struct Unit { int pm, pn, e, slot; };
struct StaticOrder {
    int nM, nN, nwg, G, c;
    DEV void init(int M, int N, int G_, int c_) { nM = M / BM; nN = N / BM; nwg = nM * nN; G = G_; c = c_; }
    DEV bool next(int i, int& pm, int& pn) const {
        const long L = (long)i * G + c; if (L >= nwg) return false;
        int wgid = (int)L; { const int q = nwg / NXCD, r = nwg % NXCD, xcd = wgid % NXCD, off = wgid / NXCD; wgid = (xcd < r ? xcd * (q + 1) : r * (q + 1) + (xcd - r) * q) + off; }
        const int nig = WGM * nN, gid = wgid / nig, fm = gid * WGM, gsz = (nM - fm) < WGM ? (nM - fm) : WGM;
        pm = fm + ((wgid % nig) % gsz); pn = (wgid % nig) / gsz; return true;
    }
};
typedef __bf16 bf16x2_t __attribute__((ext_vector_type(2)));
DEV unsigned cvt_pk_bf16(float lo, float hi) { const bf16x2_t v = {(__bf16)lo, (__bf16)hi}; return __builtin_bit_cast(unsigned, v); }
DEV u32x4 pack8(const f32x4 a, const f32x4 b) { u32x4 w; w.x = cvt_pk_bf16(a[0], a[1]); w.y = cvt_pk_bf16(a[2], a[3]); w.z = cvt_pk_bf16(b[0], b[1]); w.w = cvt_pk_bf16(b[2], b[3]); return w; }

typedef int v8i_t __attribute__((ext_vector_type(8)));
template <class Epi, class Sched, bool F8 = false>
DEV void gemm_phase(LAS unsigned char* lds, const int K, const Sched& S, const Epi& E) {
    const int tid = threadIdx.x, wid = __builtin_amdgcn_readfirstlane(tid >> 6), lane = tid & 63, wr = wid >> 2, wc = wid & 3, fr = lane & 15, fq = lane >> 4;
    const int nt = F8 ? K / 128 : K / BK;
    const int pitch = F8 ? K : 2 * K;
    unsigned voffB[2];
#pragma unroll
    for (int i = 0; i < 2; ++i) { int R, C; stage_rc(tid * 16 + i * 8192, R, C); const int Rb = Epi::PERM ? ((R & ~31) + perm32(R & 31)) : R; voffB[i] = (unsigned)(Rb * pitch + 2 * C); }
    const unsigned kstep = (unsigned)(BK * 2);
    const size_t hstep = (size_t)HALF * pitch;
    const unsigned ldsw = (unsigned)wid * 1024u;
    const int aoff = lds_byte(wr * 64 + fr, fq * 8), boff = lds_byte(wc * 32 + fr, fq * 8);
    const size_t hsA = Sched::GATHER ? (size_t)0 : hstep;
#define PG8_SA(b, h) (((b) * 2 + (h)) * HTB)
#define PG8_SB(b, h) ((4 + (b) * 2 + (h)) * HTB)
#define PG8_STAGEB(bufoff, gbase) do { _Pragma("unroll") for (int _i = 0; _i < 2; ++_i) \
        __builtin_amdgcn_global_load_lds((const unsigned*)((const char*)(gbase) + voffB[_i]), (LAS unsigned*)(lds + (bufoff) + ldsw + _i * 8192), 16, 0, 0); } while (0)
#define PG8_STAGEA(bufoff, gbase, VO) do { _Pragma("unroll") for (int _i = 0; _i < 2; ++_i) \
        __builtin_amdgcn_global_load_lds((const unsigned*)((const char*)(gbase) + (VO)[_i]), (LAS unsigned*)(lds + (bufoff) + ldsw + _i * 8192), 16, 0, 0); } while (0)
#define PG8_LD8(var, base) do { const u32x4 _l0 = *(const LAS u32x4*)(lds + (base)), _l1 = *(const LAS u32x4*)(lds + (base) + 1024); var = __builtin_shufflevector(_l0, _l1, 0, 1, 2, 3, 4, 5, 6, 7); } while (0)
#define PG8_LDA(dst, b, h) do { if constexpr (F8) { PG8_LD8(dst##8_0, PG8_SA(b, h) + aoff); PG8_LD8(dst##8_1, PG8_SA(b, h) + aoff + 2048); PG8_LD8(dst##8_2, PG8_SA(b, h) + aoff + 4096); PG8_LD8(dst##8_3, PG8_SA(b, h) + aoff + 6144); } \
        else { _Pragma("unroll") for (int m = 0; m < 4; ++m) _Pragma("unroll") for (int k = 0; k < 2; ++k) dst[m][k] = *(const LAS bf16x8*)(lds + PG8_SA(b, h) + aoff + m * 2048 + k * 1024); } } while (0)
#define PG8_LDB(dst, b, h) do { if constexpr (F8) { PG8_LD8(dst##8_0, PG8_SB(b, h) + boff); PG8_LD8(dst##8_1, PG8_SB(b, h) + boff + 2048); } \
        else { _Pragma("unroll") for (int n = 0; n < 2; ++n) _Pragma("unroll") for (int k = 0; k < 2; ++k) dst[n][k] = *(const LAS bf16x8*)(lds + PG8_SB(b, h) + boff + n * 2048 + k * 1024); } } while (0)
#define PG8_M8(ai, bj, m, n, A8, B8) asm volatile("v_mfma_scale_f32_16x16x128_f8f6f4 %0, %1, %2, %0, %3, %4 op_sel_hi:[0,0,0]" : "+v"(acc[ai][bj][m][n]) : "v"(B8), "v"(A8), "v"(wsc_), "v"(asc_))
#define PG8_MMA(ai, bj, At, Bt) do { __builtin_amdgcn_s_setprio(1); \
        if constexpr (F8) { PG8_M8(ai, bj, 0, 0, At##8_0, Bt##8_0); PG8_M8(ai, bj, 0, 1, At##8_0, Bt##8_1); PG8_M8(ai, bj, 1, 0, At##8_1, Bt##8_0); PG8_M8(ai, bj, 1, 1, At##8_1, Bt##8_1); \
                            PG8_M8(ai, bj, 2, 0, At##8_2, Bt##8_0); PG8_M8(ai, bj, 2, 1, At##8_2, Bt##8_1); PG8_M8(ai, bj, 3, 0, At##8_3, Bt##8_0); PG8_M8(ai, bj, 3, 1, At##8_3, Bt##8_1); } \
        else { _Pragma("unroll") for (int m = 0; m < 4; ++m) _Pragma("unroll") for (int n = 0; n < 2; ++n) _Pragma("unroll") for (int k = 0; k < 2; ++k) acc[ai][bj][m][n] = __builtin_amdgcn_mfma_f32_16x16x32_bf16(Bt[n][k], At[m][k], acc[ai][bj][m][n], 0, 0, 0); } \
        __builtin_amdgcn_s_setprio(0); } while (0)
#define PG8_WAIT_V(n) asm volatile("s_waitcnt vmcnt(" #n ")" ::: "memory")
#define PG8_WAIT_L(n) asm volatile("s_waitcnt lgkmcnt(" #n ")" ::: "memory")
#define PG8_BAR __builtin_amdgcn_s_barrier()
#define PG8_SCHED __builtin_amdgcn_sched_barrier(0)
    Unit cur, nxt; int ui = 0;
    if (!S.next(0, cur)) return;
    f32x4 acc[2][2][4][2];
#pragma unroll
    for (int a = 0; a < 2; ++a)
#pragma unroll
        for (int b = 0; b < 2; ++b)
#pragma unroll
            for (int m = 0; m < 4; ++m)
#pragma unroll
                for (int n = 0; n < 2; ++n) acc[a][b][m][n] = (f32x4){0.f, 0.f, 0.f, 0.f};
    bf16x8 At[4][2], B0[2][2], B1[2][2];
    typedef unsigned u32x8_t __attribute__((ext_vector_type(8)));
    u32x8_t At8_0, At8_1, At8_2, At8_3, B08_0, B08_1, B18_0, B18_1;
    const int wsc_ = Sched::WSCALE, asc_ = 0x7F7F7F7F;
    unsigned va[2][2];
    S.a_voff(cur, tid, va);
    const char* cA = S.a_ptr(cur);
    const char* cB = S.b_ptr(cur);
    PG8_STAGEB(PG8_SB(0, 0), cB); PG8_STAGEB(PG8_SB(0, 1), cB + hstep); PG8_STAGEA(PG8_SA(0, 0), cA, va[0]); PG8_STAGEA(PG8_SA(0, 1), cA + hsA, va[1]);
    if (wr == 1) PG8_BAR;
    PG8_WAIT_V(2); PG8_BAR;
    PG8_STAGEB(PG8_SB(1, 0), cB + kstep); PG8_STAGEA(PG8_SA(1, 0), cA + kstep, va[0]); PG8_STAGEB(PG8_SB(1, 1), cB + hstep + kstep);
    PG8_WAIT_V(6); PG8_BAR;
    for (;;) {
        const bool has_next = S.next(ui + 1, nxt);
        const char* nB = has_next ? S.b_ptr(nxt) : cB;
        const char* nA = has_next ? S.a_ptr(nxt) : cA;
        for (int t = 0; t < nt; t += 2) {
            const bool last = (t == nt - 2);
            const char* a1 = cA + (size_t)(t + 1) * kstep;
            const char* a2 = last ? nA : cA + (size_t)(t + 2) * kstep; const char* a3 = a2 + kstep;
            unsigned v2[2][2];
            v2[0][0] = va[0][0]; v2[0][1] = va[0][1]; v2[1][0] = va[1][0]; v2[1][1] = va[1][1];
            if constexpr (Sched::GATHER) { if (last && has_next) S.a_voff(nxt, tid, v2); }
            const char* b2 = last ? nB : cB + (size_t)(t + 2) * kstep; const char* b3 = b2 + kstep;
            PG8_LDB(B0, 0, 0); PG8_LDB(B1, 0, 1); PG8_SCHED; PG8_LDA(At, 0, 0); PG8_STAGEA(PG8_SA(1, 1), a1 + hsA, va[1]);
            PG8_WAIT_V(8); PG8_WAIT_L(0); PG8_BAR; PG8_MMA(0, 0, At, B0); PG8_MMA(0, 1, At, B1); PG8_BAR; PG8_SCHED;
            PG8_LDA(At, 0, 1); PG8_STAGEB(PG8_SB(0, 0), b2); PG8_STAGEB(PG8_SB(0, 1), b2 + hstep); PG8_STAGEA(PG8_SA(0, 0), a2, v2[0]);
            PG8_WAIT_V(8); PG8_WAIT_L(0); PG8_BAR; PG8_MMA(1, 0, At, B0); PG8_MMA(1, 1, At, B1); PG8_BAR; PG8_SCHED;
            PG8_LDB(B0, 1, 0); PG8_LDB(B1, 1, 1); PG8_SCHED; PG8_LDA(At, 1, 0); PG8_STAGEA(PG8_SA(0, 1), a2 + hsA, v2[1]);
            PG8_WAIT_V(8); PG8_WAIT_L(0); PG8_BAR; PG8_MMA(0, 0, At, B0); PG8_MMA(0, 1, At, B1); PG8_BAR; PG8_SCHED;
            PG8_LDA(At, 1, 1); PG8_STAGEB(PG8_SB(1, 0), b3); PG8_STAGEB(PG8_SB(1, 1), b3 + hstep); PG8_STAGEA(PG8_SA(1, 0), a3, v2[0]);
            PG8_WAIT_V(8); PG8_WAIT_L(0); PG8_BAR; PG8_MMA(1, 0, At, B0); PG8_MMA(1, 1, At, B1); PG8_BAR; PG8_SCHED;
        }
        if (wr == 0) PG8_BAR;
        if constexpr (F8) asm volatile("s_nop 15\n\ts_nop 15" ::: "memory");
        E(acc, cur, wr, wc, fr, fq);
        if (!has_next) break;
#pragma unroll
        for (int a = 0; a < 2; ++a)
#pragma unroll
            for (int b = 0; b < 2; ++b)
#pragma unroll
                for (int m = 0; m < 4; ++m)
#pragma unroll
                    for (int n = 0; n < 2; ++n) acc[a][b][m][n] = (f32x4){0.f, 0.f, 0.f, 0.f};
        cur = nxt; cB = nB; cA = nA; ++ui;
        if constexpr (Sched::GATHER) S.a_voff(cur, tid, va);
        if (wr == 1) PG8_BAR;
    }
    PG8_WAIT_V(0);
    PG8_BAR;
#undef PG8_SA
#undef PG8_SB
#undef PG8_STAGEA
#undef PG8_STAGEB
#undef PG8_LDA
#undef PG8_LD8
#undef PG8_M8
#undef PG8_LDB
#undef PG8_MMA
#undef PG8_WAIT_V
#undef PG8_WAIT_L
#undef PG8_BAR
#undef PG8_SCHED
}

struct SchedDense {
    static constexpr bool GATHER = false; static constexpr int WSCALE = 0x7F7F7F7F;
    StaticOrder so; const char* A; const char* Bt; int K; int pad_;
    DEV bool next(int i, Unit& u) const { int pm, pn; if (!so.next(i, pm, pn)) return false; u.pm = pm; u.pn = pn; u.e = 0; u.slot = 0; return true; }
    DEV const char* a_ptr(const Unit& u) const { return A + (size_t)u.pm * 256 * K * 2; }
    DEV void a_voff(const Unit&, const int tid, unsigned (&vo)[2][2]) const {
#pragma unroll
        for (int i = 0; i < 2; ++i) { int R, C; stage_rc(tid * 16 + i * 8192, R, C); vo[0][i] = vo[1][i] = (unsigned)((R * K + C) * 2); }
    }
    DEV const char* b_ptr(const Unit& u) const { return Bt + (size_t)u.pn * 256 * K * 2; }
};
DEV bool moe_unit(int i, int NJ, int nrbt, int G, int c, Unit& u) {
    const int n = (nrbt + 64) * NJ; int L;
    if (G & 7) { L = i * G + c; if (L >= n) return false; }
    else { const int gq = G >> 3, per = (n + 7) >> 3, x = c & 7, q = c >> 3, j = i * gq + q; if (j >= per) return false; L = x * per + j; if (L >= n) return false; }
    int grb = L / NJ; const int pn = L - grb * NJ; if (grb >= nrbt) grb = SH_RB + (grb - nrbt);
    u.pm = grb; u.pn = pn; u.slot = i; u.e = 0; return true;
}
struct SchedGU {
    static constexpr bool GATHER = true; static constexpr int WSCALE = 0x79797979;
    const char* A; const char* Wgu; const char* Wgus; const LAS int* eofrb; const LAS int* toks; int nrbt, G, c, pad_;
    DEV bool next(int i, Unit& u) const { if (!moe_unit(i, 2, nrbt, G, c, u)) return false; u.e = __builtin_amdgcn_readfirstlane(eofrb[u.pm]); return true; }
    DEV const char* a_ptr(const Unit&) const { return A; }
    DEV void a_voff(const Unit& u, const int tid, unsigned (&vo)[2][2]) const {
#pragma unroll
        for (int i = 0; i < 2; ++i) { int R, C; stage_rc(tid * 16 + i * 8192, R, C);
#pragma unroll
            for (int h = 0; h < 2; ++h) { const int tok = toks[u.slot * 256 + h * 128 + R]; vo[h][i] = (unsigned)(tok * D + 2 * C); } }
    }
    DEV const char* b_ptr(const Unit& u) const { return (u.e < NE ? Wgu + (size_t)u.e * 512 * D : Wgus) + (size_t)u.pn * 256 * D; }
};
struct SchedDown {
    static constexpr bool GATHER = false; static constexpr int WSCALE = 0x7A7A7A7A;
    const char* A; const char* Wd; const char* Wds; const LAS int* eofrb; int nrbt, G, c, pad_;
    DEV bool next(int i, Unit& u) const { if (!moe_unit(i, 4, nrbt, G, c, u)) return false; u.e = __builtin_amdgcn_readfirstlane(eofrb[u.pm]); return true; }
    DEV const char* a_ptr(const Unit& u) const { return A + (size_t)u.pm * 256 * ED; }
    DEV void a_voff(const Unit&, const int tid, unsigned (&vo)[2][2]) const {
#pragma unroll
        for (int i = 0; i < 2; ++i) { int R, C; stage_rc(tid * 16 + i * 8192, R, C); vo[0][i] = vo[1][i] = (unsigned)(R * ED + 2 * C); }
    }
    DEV const char* b_ptr(const Unit& u) const { return (u.e < NE ? Wd + (size_t)u.e * D * ED : Wds) + (size_t)u.pn * 256 * ED; }
};

struct EpiProj {
    static constexpr bool PERM = true;
    bf16_t* qkv; bf16_t* za; bf16_t* xbc; bf16_t* zb; float* small;
    DEV void operator()(const f32x4 (&acc)[2][2][4][2], const Unit& u, int wr, int wc, int fr, int fq) const {
        const int row0 = u.pm * BM + wr * 64 + fr, pn = u.pn;
        if (pn == 26) {
            if (wc == 0) {
#pragma unroll
                for (int ai = 0; ai < 2; ++ai)
#pragma unroll
                    for (int m = 0; m < 4; ++m) { float* p = small + (size_t)(row0 + ai * HALF + m * 16) * 32 + 8 * fq; *(f32x4*)p = acc[ai][0][m][0]; *(f32x4*)(p + 4) = acc[ai][0][m][1]; }
            }
            return;
        }
        bf16_t* base; int ldc, ct;
        if (pn < 12) { base = qkv; ldc = 3072; ct = pn; } else if (pn < 16) { base = za; ldc = 1024; ct = pn - 12; } else if (pn < 22) { base = xbc; ldc = 1536; ct = pn - 16; } else { base = zb; ldc = 1024; ct = pn - 22; }
        const int col0 = ct * 256 + wc * 32 + 8 * fq;
#pragma unroll
        for (int ai = 0; ai < 2; ++ai)
#pragma unroll
            for (int m = 0; m < 4; ++m) { bf16_t* rowp = base + (size_t)(row0 + ai * HALF + m * 16) * ldc + col0;
#pragma unroll
                for (int bj = 0; bj < 2; ++bj) *(u32x4*)(rowp + bj * HALF) = pack8(acc[ai][bj][m][0], acc[ai][bj][m][1]); }
    }
};
struct EpiF32 {
    static constexpr bool PERM = false;
    float* Cp; int ldc; int pad_;
    DEV void operator()(const f32x4 (&acc)[2][2][4][2], const Unit& u, int wr, int wc, int fr, int fq) const {
        const int row0 = u.pm * BM + wr * 64 + fr, col0 = u.pn * BM + wc * 32 + 4 * fq;
#pragma unroll
        for (int ai = 0; ai < 2; ++ai)
#pragma unroll
            for (int m = 0; m < 4; ++m) { float* rowp = Cp + (size_t)(row0 + ai * HALF + m * 16) * ldc + col0;
#pragma unroll
                for (int bj = 0; bj < 2; ++bj)
#pragma unroll
                    for (int n = 0; n < 2; ++n) *(f32x4*)(rowp + bj * HALF + n * 16) = acc[ai][bj][m][n]; }
    }
};
struct EpiBf16 {
    static constexpr bool PERM = true;
    bf16_t* O; int ldc; int pad_;
    DEV void operator()(const f32x4 (&acc)[2][2][4][2], const Unit& u, int wr, int wc, int fr, int fq) const {
        const int row0 = u.pm * BM + wr * 64 + fr, col0 = u.pn * BM + wc * 32 + 8 * fq;
#pragma unroll
        for (int ai = 0; ai < 2; ++ai)
#pragma unroll
            for (int m = 0; m < 4; ++m) { bf16_t* rowp = O + (size_t)(row0 + ai * HALF + m * 16) * ldc + col0;
#pragma unroll
                for (int bj = 0; bj < 2; ++bj) *(u32x4*)(rowp + bj * HALF) = pack8(acc[ai][bj][m][0], acc[ai][bj][m][1]); }
    }
};
DEV u32x2 pack8_fp8(const f32x4 a, const f32x4 b) {
    f32x4 x = a, y = b;
#pragma unroll
    for (int i = 0; i < 4; ++i) { x[i] = fminf(fmaxf(x[i], -440.f), 440.f); y[i] = fminf(fmaxf(y[i], -440.f), 440.f); }
    int w0 = __builtin_amdgcn_cvt_pk_fp8_f32(x[0], x[1], 0, false); w0 = __builtin_amdgcn_cvt_pk_fp8_f32(x[2], x[3], w0, true);
    int w1 = __builtin_amdgcn_cvt_pk_fp8_f32(y[0], y[1], 0, false); w1 = __builtin_amdgcn_cvt_pk_fp8_f32(y[2], y[3], w1, true);
    return (u32x2){(unsigned)w0, (unsigned)w1};
}
struct EpiFp8 {
    static constexpr bool PERM = true;
    unsigned char* O; int ldc; int pad_;
    DEV void operator()(const f32x4 (&acc)[2][2][4][2], const Unit& u, int wr, int wc, int fr, int fq) const {
        const int row0 = u.pm * BM + wr * 64 + fr, col0 = u.pn * BM + wc * 32 + 8 * fq;
#pragma unroll
        for (int ai = 0; ai < 2; ++ai)
#pragma unroll
            for (int m = 0; m < 4; ++m) { unsigned char* rowp = O + (size_t)(row0 + ai * HALF + m * 16) * ldc + col0;
#pragma unroll
                for (int bj = 0; bj < 2; ++bj) { f32x4 a0 = acc[ai][bj][m][0] * 8.f, a1 = acc[ai][bj][m][1] * 8.f;
#pragma unroll
                    for (int i = 0; i < 4; ++i) { a0[i] = fminf(fmaxf(a0[i], -440.f), 440.f); a1[i] = fminf(fmaxf(a1[i], -440.f), 440.f); }
                    int w0 = __builtin_amdgcn_cvt_pk_fp8_f32(a0[0], a0[1], 0, false); w0 = __builtin_amdgcn_cvt_pk_fp8_f32(a0[2], a0[3], w0, true);
                    int w1 = __builtin_amdgcn_cvt_pk_fp8_f32(a1[0], a1[1], 0, false); w1 = __builtin_amdgcn_cvt_pk_fp8_f32(a1[2], a1[3], w1, true);
                    *(u32x2*)(rowp + bj * HALF) = (u32x2){(unsigned)w0, (unsigned)w1}; } }
    }
};
struct EpiGU {
    static constexpr bool PERM = true;
    unsigned char* H;
    DEV void operator()(const f32x4 (&acc)[2][2][4][2], const Unit& u, int wr, int wc, int fr, int fq) const {
        const int row0 = u.pm * BM + wr * 64 + fr, col0 = u.pn * HALF + wc * 32 + 8 * fq;
#pragma unroll
        for (int ai = 0; ai < 2; ++ai)
#pragma unroll
            for (int m = 0; m < 4; ++m) {
                f32x4 h0, h1;
#pragma unroll
                for (int i = 0; i < 4; ++i) { h0[i] = siluf(acc[ai][0][m][0][i]) * acc[ai][1][m][0][i]; h1[i] = siluf(acc[ai][0][m][1][i]) * acc[ai][1][m][1][i]; }
                *(u32x2*)(H + (size_t)(row0 + ai * HALF + m * 16) * ED + col0) = pack8_fp8(h0, h1);
            }
    }
};
struct EpiQKV {
    static constexpr bool PERM = true;
    bf16_t* O; const float* cosT; const float* sinT;
    DEV void operator()(const f32x4 (&acc)[2][2][4][2], const Unit& u, int wr, int wc, int fr, int fq) const {
        const int row0 = u.pm * BM + wr * 64 + fr, col0 = u.pn * BM + wc * 32 + 8 * fq;
        const bool rope = u.pn < 8; const float qs = u.pn < 4 ? 0.125f : 1.f;
#pragma unroll
        for (int ai = 0; ai < 2; ++ai)
#pragma unroll
            for (int m = 0; m < 4; ++m) {
                const int row = row0 + ai * HALF + m * 16;
                bf16_t* rowp = O + (size_t)row * 3072 + col0;
                if (rope) {
                    const f32x4 cs = *(const f32x4*)(cosT + (size_t)row * 32 + 16 * (wc & 1) + 4 * fq), sn = *(const f32x4*)(sinT + (size_t)row * 32 + 16 * (wc & 1) + 4 * fq);
#pragma unroll
                    for (int bj = 0; bj < 2; ++bj) { const f32x4 x1 = acc[ai][bj][m][0], x2 = acc[ai][bj][m][1];
                        *(u32x4*)(rowp + bj * HALF) = pack8((x1 * cs - x2 * sn) * qs, (x2 * cs + x1 * sn) * qs); }
                } else {
#pragma unroll
                    for (int bj = 0; bj < 2; ++bj) *(u32x4*)(rowp + bj * HALF) = pack8(acc[ai][bj][m][0], acc[ai][bj][m][1]);
                }
            }
    }
};
}

template <class SrcF, bool OUT8 = false>
DEV void conv_item(const SrcF& src, int ldw, int K, void* dstv, LAS float* scr, int item, int nblk, int lane, const float wscale = 1.f) {
    const int kb = item / nblk, nb = item - kb * nblk, k0 = 64 * kb, n0 = 32 * nb;
    const int quad = lane & 7, r0 = lane >> 3;
    const float* colp = src(n0 + 4 * quad);
    f32x4 v[8];
#pragma unroll
    for (int i = 0; i < 8; ++i) v[i] = colp ? *(const f32x4*)(colp + (size_t)(k0 + r0 + 8 * i) * ldw) : (f32x4){0.f, 0.f, 0.f, 0.f};
#pragma unroll
    for (int i = 0; i < 8; ++i) { LAS float* p = scr + (r0 + 8 * i) * 33 + 4 * quad; p[0] = v[i][0]; p[1] = v[i][1]; p[2] = v[i][2]; p[3] = v[i][3]; }
    LDS_WAIT(); asm volatile("" ::: "memory");
    const int c = lane & 7;
#pragma unroll
    for (int j = 0; j < 4; ++j) { const int n = (lane >> 3) + 8 * j; const LAS float* s = scr + (8 * c) * 33 + n;
        if constexpr (OUT8) {
            int w0 = __builtin_amdgcn_cvt_pk_fp8_f32(s[0 * 33] * wscale, s[1 * 33] * wscale, 0, false); w0 = __builtin_amdgcn_cvt_pk_fp8_f32(s[2 * 33] * wscale, s[3 * 33] * wscale, w0, true);
            int w1 = __builtin_amdgcn_cvt_pk_fp8_f32(s[4 * 33] * wscale, s[5 * 33] * wscale, 0, false); w1 = __builtin_amdgcn_cvt_pk_fp8_f32(s[6 * 33] * wscale, s[7 * 33] * wscale, w1, true);
            *(u32x2*)((unsigned char*)dstv + (size_t)(n0 + n) * K + k0 + 8 * c) = (u32x2){(unsigned)w0, (unsigned)w1};
        } else {
            u32x4 o; o.x = pk2(s[0 * 33], s[1 * 33]); o.y = pk2(s[2 * 33], s[3 * 33]); o.z = pk2(s[4 * 33], s[5 * 33]); o.w = pk2(s[6 * 33], s[7 * 33]);
            *(u32x4*)((bf16_t*)dstv + (size_t)(n0 + n) * K + k0 + 8 * c) = o; } }
    LDS_WAIT(); asm volatile("" ::: "memory");
}
struct SrcIdent { const float* W; DEV const float* operator()(int n) const { return W + n; } };
struct SrcWin { const float* W; DEV const float* operator()(int n) const {
    int s; if (n < 4096) s = n; else if (n < 5632) s = C_XBC + (n - 4096); else if (n < 6656) s = C_ZB + (n - 5632); else if (n < 6672) s = C_BETA + (n - 6656); else if (n < 6688) s = C_DT + (n - 6672); else return nullptr;
    return W + s; } };
struct SrcQKV { const float* W; DEV const float* operator()(int n) const {
    if (n >= 2048) return W + n; const int hd = n >> 6, cp = n & 63; return W + hd * 64 + 32 * ((cp >> 2) & 1) + 16 * (cp >> 5) + 4 * ((cp >> 3) & 3) + (cp & 3); } };
struct SrcGU { const float* Wg; long du; DEV const float* operator()(int r) const { const int j = r >> 8, rr = r & 255; return Wg + (rr < 128 ? 0l : du) + 128 * j + (rr & 127); } };

DEV void load_row(const float* p, int lane, float (&v)[16]) {
#pragma unroll
    for (int j = 0; j < 4; ++j) { const f32x4 t = *(const f32x4*)(p + j * 256 + lane * 4); v[4 * j] = t[0]; v[4 * j + 1] = t[1]; v[4 * j + 2] = t[2]; v[4 * j + 3] = t[3]; }
}
DEV void store_row(float* p, int lane, const float (&v)[16]) {
#pragma unroll
    for (int j = 0; j < 4; ++j) *(f32x4*)(p + j * 256 + lane * 4) = (f32x4){v[4 * j], v[4 * j + 1], v[4 * j + 2], v[4 * j + 3]};
}
DEV float row_rstd(const float (&v)[16]) { float ss = 0.f;
#pragma unroll
    for (int i = 0; i < 16; ++i) ss += v[i] * v[i];
    return rsqrtf(wave_sum(ss) * (1.f / D) + EPS); }
DEV void resid_update(float (&xv)[16], const float (&yv)[16], const float* gpost, const float* gt, int lane) {
    const float r = row_rstd(yv);
#pragma unroll
    for (int j = 0; j < 4; ++j) { const f32x4 g = *(const f32x4*)(gpost + j * 256 + lane * 4), t = *(const f32x4*)(gt + j * 256 + lane * 4);
#pragma unroll
        for (int i = 0; i < 4; ++i) xv[4 * j + i] += t[i] * (yv[4 * j + i] * r * g[i]); }
}
DEV void prenorm_pack(const float (&xv)[16], const float* gpre, const float* sc, const float* sh, int lane, u32x2 (&o)[4]) {
    const float r = row_rstd(xv);
#pragma unroll
    for (int j = 0; j < 4; ++j) { const f32x4 g = *(const f32x4*)(gpre + j * 256 + lane * 4), s = *(const f32x4*)(sc + j * 256 + lane * 4), b = *(const f32x4*)(sh + j * 256 + lane * 4);
        float h[4];
#pragma unroll
        for (int i = 0; i < 4; ++i) h[i] = xv[4 * j + i] * r * g[i] * (1.f + s[i]) + b[i];
        o[j] = (u32x2){pk2(h[0], h[1]), pk2(h[2], h[3])}; }
}

DEV void load_row8(const float* p, int lane, float (&v)[16]) {
#pragma unroll
    for (int j = 0; j < 2; ++j)
#pragma unroll
        for (int hh = 0; hh < 2; ++hh) { const f32x4 t = *(const f32x4*)(p + 512 * j + 8 * lane + 4 * hh); v[8 * j + 4 * hh] = t[0]; v[8 * j + 4 * hh + 1] = t[1]; v[8 * j + 4 * hh + 2] = t[2]; v[8 * j + 4 * hh + 3] = t[3]; }
}
DEV void store_row8(float* p, int lane, const float (&v)[16]) {
#pragma unroll
    for (int j = 0; j < 2; ++j)
#pragma unroll
        for (int hh = 0; hh < 2; ++hh) *(f32x4*)(p + 512 * j + 8 * lane + 4 * hh) = (f32x4){v[8 * j + 4 * hh], v[8 * j + 4 * hh + 1], v[8 * j + 4 * hh + 2], v[8 * j + 4 * hh + 3]};
}
DEV void resid_update8(float (&xv)[16], const float (&yv)[16], const float* gpost, const float* gt, int lane) {
    const float r = row_rstd(yv);
#pragma unroll
    for (int j = 0; j < 2; ++j)
#pragma unroll
        for (int hh = 0; hh < 2; ++hh) { const f32x4 g = *(const f32x4*)(gpost + 512 * j + 8 * lane + 4 * hh), t = *(const f32x4*)(gt + 512 * j + 8 * lane + 4 * hh);
#pragma unroll
            for (int i = 0; i < 4; ++i) xv[8 * j + 4 * hh + i] += t[i] * (yv[8 * j + 4 * hh + i] * r * g[i]); }
}
DEV void prenorm_pack8(const float (&xv)[16], const float* gpre, const float* sc, const float* sh, int lane, u32x4 (&o)[2]) {
    const float r = row_rstd(xv);
#pragma unroll
    for (int j = 0; j < 2; ++j) { float h[8];
#pragma unroll
        for (int hh = 0; hh < 2; ++hh) { const f32x4 g = *(const f32x4*)(gpre + 512 * j + 8 * lane + 4 * hh), s = *(const f32x4*)(sc + 512 * j + 8 * lane + 4 * hh), b = *(const f32x4*)(sh + 512 * j + 8 * lane + 4 * hh);
#pragma unroll
            for (int i = 0; i < 4; ++i) h[4 * hh + i] = xv[8 * j + 4 * hh + i] * r * g[i] * (1.f + s[i]) + b[i]; }
        o[j] = (u32x4){pk2(h[0], h[1]), pk2(h[2], h[3]), pk2(h[4], h[5]), pk2(h[6], h[7])}; }
}
DEV void acc_row8(float (&yv)[16], const u32x2 w0, const u32x2 w1, const float g) {
#pragma unroll
    for (int e = 0; e < 2; ++e) {
        yv[4 * e] += g * __builtin_amdgcn_cvt_f32_fp8((int)w0[e], 0); yv[4 * e + 1] += g * __builtin_amdgcn_cvt_f32_fp8((int)w0[e], 1); yv[4 * e + 2] += g * __builtin_amdgcn_cvt_f32_fp8((int)w0[e], 2); yv[4 * e + 3] += g * __builtin_amdgcn_cvt_f32_fp8((int)w0[e], 3);
        yv[8 + 4 * e] += g * __builtin_amdgcn_cvt_f32_fp8((int)w1[e], 0); yv[8 + 4 * e + 1] += g * __builtin_amdgcn_cvt_f32_fp8((int)w1[e], 1); yv[8 + 4 * e + 2] += g * __builtin_amdgcn_cvt_f32_fp8((int)w1[e], 2); yv[8 + 4 * e + 3] += g * __builtin_amdgcn_cvt_f32_fp8((int)w1[e], 3); }
}

DEV void load_row_bf(const bf16_t* p, int lane, float (&v)[16]) {
#pragma unroll
    for (int j = 0; j < 4; ++j) { const u32x2 w = *(const u32x2*)(p + j * 256 + lane * 4); v[4 * j] = __uint_as_float(w.x << 16); v[4 * j + 1] = __uint_as_float(w.x & 0xFFFF0000u); v[4 * j + 2] = __uint_as_float(w.y << 16); v[4 * j + 3] = __uint_as_float(w.y & 0xFFFF0000u); }
}
DEV void store_row_bf(bf16_t* p, int lane, const float (&v)[16]) {
#pragma unroll
    for (int j = 0; j < 4; ++j) *(u32x2*)(p + j * 256 + lane * 4) = (u32x2){pk2(v[4 * j], v[4 * j + 1]), pk2(v[4 * j + 2], v[4 * j + 3])};
}
DEV void load_row8_bf(const bf16_t* p, int lane, float (&v)[16]) {
#pragma unroll
    for (int j = 0; j < 2; ++j) { const u32x4 w = *(const u32x4*)(p + 512 * j + 8 * lane);
#pragma unroll
        for (int e = 0; e < 4; ++e) { v[8 * j + 2 * e] = __uint_as_float(w[e] << 16); v[8 * j + 2 * e + 1] = __uint_as_float(w[e] & 0xFFFF0000u); } }
}
DEV void store_row8_bf(bf16_t* p, int lane, const float (&v)[16]) {
#pragma unroll
    for (int j = 0; j < 2; ++j) *(u32x4*)(p + 512 * j + 8 * lane) = (u32x4){pk2(v[8 * j], v[8 * j + 1]), pk2(v[8 * j + 2], v[8 * j + 3]), pk2(v[8 * j + 4], v[8 * j + 5]), pk2(v[8 * j + 6], v[8 * j + 7])};
}

struct Ctx { LAS unsigned char* lds; int tid, lane, wave, G, bid; };

DEV void ph_setup(const Args& a, const Ctx& X) {
    unsigned char* ws = a.ws;
    float* mod = (float*)(ws + WS_MOD);
    { LAS float* red = (LAS float*)X.lds;
      LAS float* sc = (LAS float*)(X.lds + 8192);
      for (int i = X.tid; i < NB * D; i += NTHR) sc[i] = siluf(a.c[i]);
      __syncthreads();
      const int kc = X.tid >> 6, cl = X.tid & 63;
      for (int task = X.bid; task < 2 * 96; task += X.G) {
          const int l = task / 96, col = (task % 96) * 64 + cl;
          const float* w = a.mod_w + (size_t)l * D * 6 * D + col;
          float p0 = 0.f, p1 = 0.f, p2 = 0.f, p3 = 0.f;
#pragma unroll 16
          for (int k = kc * 128; k < kc * 128 + 128; ++k) { const float wv = w[(size_t)k * 6 * D];
              p0 += sc[k] * wv; p1 += sc[D + k] * wv; p2 += sc[2 * D + k] * wv; p3 += sc[3 * D + k] * wv; }
          __syncthreads();
          red[(kc * 4 + 0) * 64 + cl] = p0; red[(kc * 4 + 1) * 64 + cl] = p1; red[(kc * 4 + 2) * 64 + cl] = p2; red[(kc * 4 + 3) * 64 + cl] = p3;
          __syncthreads();
          if (X.tid < 256) { const int b = X.tid >> 6; float s = a.mod_b[l * 6 * D + col];
#pragma unroll
              for (int q = 0; q < 8; ++q) s += red[(q * 4 + b) * 64 + cl];
              mod[(size_t)(l * NB + b) * 6 * D + col] = s; }
      }
      __syncthreads(); }
    { LAS float* scr = (LAS float*)(X.lds + X.wave * 8704);
      const int gw = X.bid * NWAVES + X.wave, NGW = X.G * NWAVES;
      constexpr int I_IN = (D / 64) * (NPROJ / 32);
      for (int it = gw; it < I_IN; it += NGW) conv_item(SrcWin{a.ssm_w_in}, PROJ, D, (bf16_t*)(ws + WS_WIN), scr, it, NPROJ / 32, X.lane);
    }
}
DEV void ph_setup_late(const Args& a, const Ctx& X, const int wg0) {
    unsigned char* ws = a.ws;
    { float* cosT = (float*)(ws + WS_COS); float* sinT = (float*)(ws + WS_SIN);
      for (int idx = (X.bid - wg0) * NTHR + X.tid; idx < T * 32; idx += (X.G - wg0) * NTHR) { const int t = idx >> 5, i = idx & 31;
          const float ang = (float)a.pos[t] * powf(10000.f, -(float)i / 32.f); float sn, cs; sincosf(ang, &sn, &cs); cosT[idx] = cs; sinT[idx] = sn; } }
    { LAS float* scr = (LAS float*)(X.lds + X.wave * 8704);
      const int gw = (X.bid - wg0) * NWAVES + X.wave, NGW = (X.G - wg0) * NWAVES;
      constexpr int I_OUT = (2048 / 64) * (D / 32), I_QKV = (D / 64) * (3072 / 32), I_O = (D / 64) * (D / 32);
      for (int it = gw; it < I_OUT + I_QKV + I_O; it += NGW) {
          int r = it;
          if (r < I_OUT) { conv_item(SrcIdent{a.ssm_w_out}, D, 2048, (bf16_t*)(ws + WS_WOUT), scr, r, D / 32, X.lane); continue; } r -= I_OUT;
          if (r < I_QKV) { conv_item(SrcQKV{a.attn_w_qkv}, 3072, D, (bf16_t*)(ws + WS_WQKV), scr, r, 3072 / 32, X.lane); continue; } r -= I_QKV;
          conv_item(SrcIdent{a.attn_w_o}, D, D, (bf16_t*)(ws + WS_WO), scr, r, D / 32, X.lane);
      } }
}

DEV void ph_prenorm0(const Args& a, const Ctx& X) {
    const float* mod = (const float*)(a.ws + WS_MOD);
    bf16_t* hb = (bf16_t*)(a.ws + WS_H);
    for (int row = X.bid * NWAVES + X.wave; row < T; row += X.G * NWAVES) {
        const int b = row / SEQ; const float* ml = mod + (size_t)b * 6 * D;
        float xv[16]; load_row(a.x + (size_t)row * D, X.lane, xv);
        u32x2 o[4]; prenorm_pack(xv, a.mix_pre_g, ml + D, ml, X.lane, o);
#pragma unroll
        for (int j = 0; j < 4; ++j) *(u32x2*)(hb + (size_t)row * D + j * 256 + X.lane * 4) = o[j];
    }
}

DEV bf16x8 acc_to_frag(const f32x4 lo, const f32x4 hi) { u32x4 w; w.x = pg8::cvt_pk_bf16(lo[0], lo[1]); w.y = pg8::cvt_pk_bf16(lo[2], lo[3]); w.z = pg8::cvt_pk_bf16(hi[0], hi[1]); w.w = pg8::cvt_pk_bf16(hi[2], hi[3]); return __builtin_bit_cast(bf16x8, w); }

DEV void gdn_solve(LAS float* M, LAS unsigned short* tf, const int lane) {
    for (int rb = 0; rb < 16; ++rb) {
        const int i0 = 4 * rb;
        float a0 = (lane == i0) ? 1.f : 0.f, a1 = (lane == i0 + 1) ? 1.f : 0.f, a2 = (lane == i0 + 2) ? 1.f : 0.f, a3 = (lane == i0 + 3) ? 1.f : 0.f;
        for (int j = 0; j < i0; j += 4) {
            const float t0 = M[j * 64 + lane], t1 = M[(j + 1) * 64 + lane], t2 = M[(j + 2) * 64 + lane], t3 = M[(j + 3) * 64 + lane];
            const f32x4 r0 = *(const LAS f32x4*)(M + i0 * 64 + j), r1 = *(const LAS f32x4*)(M + (i0 + 1) * 64 + j), r2 = *(const LAS f32x4*)(M + (i0 + 2) * 64 + j), r3 = *(const LAS f32x4*)(M + (i0 + 3) * 64 + j);
            a0 -= r0[0] * t0 + r0[1] * t1 + r0[2] * t2 + r0[3] * t3; a1 -= r1[0] * t0 + r1[1] * t1 + r1[2] * t2 + r1[3] * t3;
            a2 -= r2[0] * t0 + r2[1] * t1 + r2[2] * t2 + r2[3] * t3; a3 -= r3[0] * t0 + r3[1] * t1 + r3[2] * t2 + r3[3] * t3;
        }
        const f32x4 d1 = *(const LAS f32x4*)(M + (i0 + 1) * 64 + i0), d2 = *(const LAS f32x4*)(M + (i0 + 2) * 64 + i0), d3 = *(const LAS f32x4*)(M + (i0 + 3) * 64 + i0);
        a1 -= d1[0] * a0; a2 -= d2[0] * a0 + d2[1] * a1; a3 -= d3[0] * a0 + d3[1] * a1 + d3[2] * a2;
        M[i0 * 64 + lane] = a0; M[(i0 + 1) * 64 + lane] = a1; M[(i0 + 2) * 64 + lane] = a2; M[(i0 + 3) * 64 + lane] = a3;
    }
    const int cq = (lane >> 2) & 3, ca = (lane >> 4) & 1, ce = lane & 3, cks = lane >> 5;
    for (int i = 0; i < 64; ++i) tf[((i >> 4) * 2 + cks) * 512 + ((i & 15) + 16 * cq) * 8 + 4 * ca + ce] = (unsigned short)f2bf(M[i * 64 + lane]);
}
DEV void ph_gdn_local(const Args& a, const Ctx& X) {
    const bf16_t* qkvpre = (const bf16_t*)(a.ws + WS_QKVPRE); const float* small = (const float*)(a.ws + WS_SMALL);
    unsigned char* gi = a.ws + WS_GI; float* glast = (float*)(a.ws + WS_GLAST);
    constexpr int KP = 272;
    LAS unsigned char* kN = X.lds; LAS unsigned char* qN = X.lds + 64 * KP; LAS unsigned char* slots = X.lds + 128 * KP;
    LAS float* gcL = (LAS float*)(X.lds + 143360); LAS float* btL = gcL + 8 * 64;
    LAS unsigned char* stg = X.lds + 100352;
    const int lane = X.lane, wave = X.wave, r16 = lane & 15, q4 = lane >> 4;
    const float scale = 0.08838834764831845f;
    for (int wu = X.bid; wu < NB * 64; wu += X.G) {
        const int b = wu >> 6, n = wu & 63; const size_t t0 = (size_t)b * SEQ + 64 * n;
        unsigned char* tmp = a.ws + WS_GTMP + (size_t)X.bid * 131072;
        __syncthreads();
        {
            const float g = -__expf(a.gdn_a_log[wave]) * softplusf(small[(t0 + lane) * 32 + 8 + wave] + a.gdn_dt_bias[wave]);
            float gc = g;
#pragma unroll
            for (int o = 1; o < 64; o <<= 1) { const float v = __shfl_up(gc, o); if (lane >= o) gc += v; }
            gcL[wave * 64 + lane] = gc; btL[wave * 64 + lane] = sigmoidf_(small[(t0 + lane) * 32 + wave]);
            if (lane == 63) glast[(size_t)((b * 8 + wave) * 64 + n) * 32] = gc;
        }
        __syncthreads();
        unsigned xr[3][11];
#define GDN_LOADX(hh) do { _Pragma("unroll") for (int _p = 0; _p < 3; ++_p) _Pragma("unroll") for (int _i = 0; _i < 11; ++_i) { const int _tk = 8 * wave + _i - 3; unsigned _v = 0u; \
            if (64 * n + _tk >= 0) _v = *(const unsigned*)(qkvpre + (t0 + _tk) * 3072 + _p * 1024 + (hh) * 128 + 2 * lane); xr[_p][_i] = _v; } } while (0)
        GDN_LOADX(0);
        for (int bb = 0; bb < 2; ++bb) {
            for (int j = 0; j < 4; ++j) {
                const int h = bb * 4 + j; unsigned char* ub = gi + (size_t)((b * 8 + h) * 64 + n) * GI_UNIT;
                {
                    const float gl = gcL[h * 64 + 63];
                    const int blk = wave >> 2, pa = (wave & 3) >> 1, pq0 = 2 * (wave & 1);
                    const int ca = (2 * lane >> 4) & 1, cq = (2 * lane >> 2) & 3, ce = (2 * lane) & 3, cks = (2 * lane) >> 5;
#pragma unroll
                    for (int part = 0; part < 3; ++part) {
                        const int col = part * 1024 + h * 128 + 2 * lane;
                        float w0[4], w1[4];
#pragma unroll
                        for (int i = 0; i < 4; ++i) { const f32x2 t = *(const f32x2*)(a.gdn_conv_w + i * 3072 + col); w0[i] = t.x; w1[i] = t.y; }
                        float x0[11], x1[11];
#pragma unroll
                        for (int i = 0; i < 11; ++i) { const unsigned v = xr[part][i]; x0[i] = __uint_as_float(v << 16); x1[i] = __uint_as_float(v & 0xFFFF0000u); }
                        float v0[8], v1[8];
#pragma unroll
                        for (int i = 0; i < 8; ++i) { v0[i] = siluf(w0[0] * x0[i] + w0[1] * x0[i + 1] + w0[2] * x0[i + 2] + w0[3] * x0[i + 3]); v1[i] = siluf(w1[0] * x1[i] + w1[1] * x1[i + 1] + w1[2] * x1[i + 2] + w1[3] * x1[i + 3]); }
                        if (part < 2) {
#pragma unroll
                            for (int i = 0; i < 8; ++i) { const float r = rsqrtf(wave_sum(v0[i] * v0[i] + v1[i] * v1[i]) + 1e-6f); v0[i] *= r; v1[i] *= r; }
                        }
                        for (int rep_ = 0; rep_ < (((PROBE_MASK >> 21) & 1u) ? 2 : 1); ++rep_) {
                        if (part == 0) {
#pragma unroll
                            for (int i = 0; i < 8; ++i) { const int tok = 8 * wave + i; const float eg = __expf(gcL[h * 64 + tok]) * scale;
                                *(LAS unsigned*)(qN + tok * KP + lane * 4) = pk2(v0[i], v1[i]);
                                *(LAS unsigned*)(stg + ((tok >> 4) * 4 + cks) * 1024 + ((tok & 15) + 16 * cq) * 16 + (4 * ca + ce) * 2) = pk2(v0[i] * eg, v1[i] * eg); }
                        } else if (part == 1) {
                            unsigned short kg0[8], kg1[8], ke0[8], ke1[8];
#pragma unroll
                            for (int i = 0; i < 8; ++i) { const int tok = 8 * wave + i; const float gc = gcL[h * 64 + tok], bt = btL[h * 64 + tok], eg = __expf(gc) * bt, eend = __expf(gl - gc);
                                *(LAS unsigned*)(kN + tok * KP + lane * 4) = pk2(v0[i], v1[i]);
                                kg0[i] = (unsigned short)f2bf(v0[i] * eg); kg1[i] = (unsigned short)f2bf(v1[i] * eg); ke0[i] = (unsigned short)f2bf(v0[i] * eend); ke1[i] = (unsigned short)f2bf(v1[i] * eend); }
#pragma unroll
                            for (int hf = 0; hf < 2; ++hf) { const int pos = 32 * blk + 8 * (pq0 + hf) + 4 * pa; const int cl = 2 * lane;
                                *(u32x2*)(tmp + (size_t)j * 32768 + 16384 + cl * 128 + pos * 2) = (u32x2){(unsigned)kg0[4 * hf] | ((unsigned)kg0[4 * hf + 1] << 16), (unsigned)kg0[4 * hf + 2] | ((unsigned)kg0[4 * hf + 3] << 16)};
                                *(u32x2*)(tmp + (size_t)j * 32768 + 16384 + (cl + 1) * 128 + pos * 2) = (u32x2){(unsigned)kg1[4 * hf] | ((unsigned)kg1[4 * hf + 1] << 16), (unsigned)kg1[4 * hf + 2] | ((unsigned)kg1[4 * hf + 3] << 16)};
                                *(LAS u32x2*)(stg + 16384 + ((cl >> 4) * 2 + blk) * 1024 + ((cl & 15) + 16 * (pq0 + hf)) * 16 + (4 * pa) * 2) = (u32x2){(unsigned)ke0[4 * hf] | ((unsigned)ke0[4 * hf + 1] << 16), (unsigned)ke0[4 * hf + 2] | ((unsigned)ke0[4 * hf + 3] << 16)};
                                *(LAS u32x2*)(stg + 16384 + (((cl + 1) >> 4) * 2 + blk) * 1024 + (((cl + 1) & 15) + 16 * (pq0 + hf)) * 16 + (4 * pa) * 2) = (u32x2){(unsigned)ke1[4 * hf] | ((unsigned)ke1[4 * hf + 1] << 16), (unsigned)ke1[4 * hf + 2] | ((unsigned)ke1[4 * hf + 3] << 16)}; }
                        } else {
                            unsigned short vb0[8], vb1[8];
#pragma unroll
                            for (int i = 0; i < 8; ++i) { const float bt = btL[h * 64 + 8 * wave + i]; vb0[i] = (unsigned short)f2bf(v0[i] * bt); vb1[i] = (unsigned short)f2bf(v1[i] * bt); }
#pragma unroll
                            for (int hf = 0; hf < 2; ++hf) { const int pos = 32 * blk + 8 * (pq0 + hf) + 4 * pa; const int cl = 2 * lane;
                                *(u32x2*)(tmp + (size_t)j * 32768 + cl * 128 + pos * 2) = (u32x2){(unsigned)vb0[4 * hf] | ((unsigned)vb0[4 * hf + 1] << 16), (unsigned)vb0[4 * hf + 2] | ((unsigned)vb0[4 * hf + 3] << 16)};
                                *(u32x2*)(tmp + (size_t)j * 32768 + (cl + 1) * 128 + pos * 2) = (u32x2){(unsigned)vb1[4 * hf] | ((unsigned)vb1[4 * hf + 1] << 16), (unsigned)vb1[4 * hf + 2] | ((unsigned)vb1[4 * hf + 3] << 16)}; }
                        }
                        asm volatile("" ::: "memory"); }
                    }
                }
                if (h + 1 < 8) GDN_LOADX(h + 1);
                __syncthreads();
                {
#pragma unroll
                    for (int i = 0; i < 4; ++i) *(u32x4*)(ub + 16384 + (X.tid + 512 * i) * 16) = *(const LAS u32x4*)(stg + (X.tid + 512 * i) * 16);
                    const int mat = wave >> 2, rt = wave & 3; LAS unsigned char* An = mat ? qN : kN;
                    bf16x8 af[4];
#pragma unroll
                    for (int ks = 0; ks < 4; ++ks) af[ks] = *(const LAS bf16x8*)(An + (16 * rt + r16) * KP + (32 * ks + 8 * q4) * 2);
                    LAS float* slot = (LAS float*)(slots + j * 16384);
#pragma unroll
                    for (int ct = 0; ct < 4; ++ct) { f32x4 acc = {0.f, 0.f, 0.f, 0.f};
#pragma unroll
                        for (int ks = 0; ks < 4; ++ks) { const bf16x8 bf = *(const LAS bf16x8*)(kN + (16 * ct + r16) * KP + (32 * ks + 8 * q4) * 2); acc = __builtin_amdgcn_mfma_f32_16x16x32_bf16(af[ks], bf, acc, 0, 0, 0); }
                        const int jc = 16 * ct + r16; const float gj = gcL[h * 64 + jc];
#pragma unroll
                        for (int rg = 0; rg < 4; ++rg) { const int i = 16 * rt + 4 * q4 + rg; const float dec = __expf(gcL[h * 64 + i] - gj);
                            if (mat == 0) { slot[i * 64 + jc] = jc < i ? btL[h * 64 + i] * acc[rg] * dec : 0.f; }
                            else { const float v = jc <= i ? acc[rg] * scale * dec : 0.f;
                                *(LAS unsigned short*)(stg + 32768 + (rt * 2 + (ct >> 1)) * 1024 + ((4 * q4 + rg) + 16 * (r16 >> 2)) * 16 + (4 * (ct & 1) + (r16 & 3)) * 2) = (unsigned short)f2bf(v); } }
                    }
                }
                __syncthreads();
                *(u32x4*)(ub + 49152 + X.tid * 16) = *(const LAS u32x4*)(stg + 32768 + X.tid * 16);
            }
            if (wave < 4) gdn_solve((LAS float*)(slots + wave * 16384), (LAS unsigned short*)(X.lds + wave * 8192), lane);
            VM_WAIT(); __syncthreads();
            for (int j = 0; j < 4; ++j) {
                const int h = bb * 4 + j; unsigned char* ub = gi + (size_t)((b * 8 + h) * 64 + n) * GI_UNIT;
                const int mat = wave >> 2; LAS unsigned char* slot = X.lds + j * 8192;
#pragma unroll
                for (int cx = 0; cx < 2; ++cx) { const int ct = 2 * (wave & 3) + cx;
                    bf16x8 bfr[2];
#pragma unroll
                    for (int ks = 0; ks < 2; ++ks) { const u32x4 t = __builtin_nontemporal_load((const u32x4*)(tmp + (size_t)j * 32768 + mat * 16384 + (16 * ct + r16) * 128 + (32 * ks + 8 * q4) * 2)); bfr[ks] = __builtin_bit_cast(bf16x8, t); }
#pragma unroll
                    for (int rt = 0; rt < 4; ++rt) { f32x4 acc = {0.f, 0.f, 0.f, 0.f};
#pragma unroll
                        for (int ks = 0; ks < 2; ++ks) { const bf16x8 tf = *(const LAS bf16x8*)(slot + (rt * 2 + ks) * 1024 + lane * 16); acc = __builtin_amdgcn_mfma_f32_16x16x32_bf16(tf, bfr[ks], acc, 0, 0, 0); }
                        if (mat == 0) *(u32x2*)(ub + 57344 + (rt * 8 + ct) * 512 + lane * 8) = (u32x2){pg8::cvt_pk_bf16(acc[0], acc[1]), pg8::cvt_pk_bf16(acc[2], acc[3])};
                        else {
#pragma unroll
                            for (int rg = 0; rg < 4; ++rg) *(unsigned short*)(ub + (rt * 4 + (ct >> 1)) * 1024 + ((4 * q4 + rg) + 16 * (r16 >> 2)) * 16 + (4 * (ct & 1) + (r16 & 3)) * 2) = (unsigned short)f2bf(-acc[rg]);
                        }
                    }
                }
            }
            __syncthreads();
        }
    }
}
DEV void ph_gdn_scan(const Args& a, const Ctx& X) {
    const unsigned char* gi = a.ws + WS_GI; const float* glast = (const float*)(a.ws + WS_GLAST);
    const bf16_t* za = (const bf16_t*)(a.ws + WS_ZA); bf16_t* oy = (bf16_t*)(a.ws + WS_OY);
    const int lane = X.lane, wave = X.wave, r16 = lane & 15, q4 = lane >> 4, tid = X.tid;
    LAS float* OT = (LAS float*)(X.lds + 114688);
    const int bh = X.bid, b = bh >> 3, h = bh & 7;
    const unsigned char* ubase = gi + (size_t)bh * 64 * GI_UNIT;
    f32x4 S[8];
#pragma unroll
    for (int i = 0; i < 8; ++i) S[i] = (f32x4){0.f, 0.f, 0.f, 0.f};
    float nwv[16];
#pragma unroll
    for (int i = 0; i < 16; ++i) nwv[i] = a.gdn_norm_w[16 * (tid & 7) + i];
#define GDN_STAGE(nn, buf) do { _Pragma("unroll") for (int _i = 0; _i < 7; ++_i) \
        __builtin_amdgcn_global_load_lds((const unsigned*)(ubase + (size_t)(nn) * GI_UNIT + (size_t)(tid + 512 * _i) * 16), (LAS unsigned*)(X.lds + (buf) * 57344 + (wave * 64 + 512 * _i) * 16), 16, 0, 0); } while (0)
    u32x2 udn[4]; float gln; u32x4 zn[2];
    { const size_t tz = (size_t)b * SEQ + (tid >> 3); zn[0] = *(const u32x4*)(za + tz * 1024 + h * 128 + 16 * (tid & 7)); zn[1] = *(const u32x4*)(za + tz * 1024 + h * 128 + 16 * (tid & 7) + 8); }
#pragma unroll
    for (int ct = 0; ct < 4; ++ct) udn[ct] = *(const u32x2*)(ubase + 57344 + (ct * 8 + wave) * 512 + lane * 8);
    gln = glast[(size_t)(bh * 64) * 32];
    GDN_STAGE(0, 0);
#define GDN_EPILOGUE(nn, ZC) do { const int tok = tid >> 3, seg = tid & 7; const size_t t = (size_t)b * SEQ + 64 * (nn) + tok; \
            float ov[16]; float ss = 0.f; \
            _Pragma("unroll") for (int i = 0; i < 4; ++i) { const f32x4 v = *(const LAS f32x4*)(OT + tok * 132 + 16 * seg + 4 * i); ov[4 * i] = v[0]; ov[4 * i + 1] = v[1]; ov[4 * i + 2] = v[2]; ov[4 * i + 3] = v[3]; ss += v[0] * v[0] + v[1] * v[1] + v[2] * v[2] + v[3] * v[3]; } \
            ss += __shfl_xor(ss, 1); ss += __shfl_xor(ss, 2); ss += __shfl_xor(ss, 4); \
            const float rstd = rsqrtf(ss * (1.f / 128.f) + EPS); \
            u32x4 ow[2]; \
            _Pragma("unroll") for (int i = 0; i < 2; ++i) _Pragma("unroll") for (int e = 0; e < 4; ++e) { const unsigned zw = (ZC)[i][e]; const float z0 = __uint_as_float(zw << 16), z1 = __uint_as_float(zw & 0xFFFF0000u); \
                    ow[i][e] = pg8::cvt_pk_bf16(ov[8 * i + 2 * e] * rstd * nwv[8 * i + 2 * e] * siluf(z0), ov[8 * i + 2 * e + 1] * rstd * nwv[8 * i + 2 * e + 1] * siluf(z1)); } \
            *(u32x4*)(oy + t * 2048 + h * 128 + 16 * seg) = ow[0]; *(u32x4*)(oy + t * 2048 + h * 128 + 16 * seg + 8) = ow[1]; } while (0)
    u32x4 zp[2] = {{0u, 0u, 0u, 0u}, {0u, 0u, 0u, 0u}};
    for (int n = 0; n < 64; ++n) {
        VM_WAIT(); __syncthreads();
        f32x4 uf[4];
#pragma unroll
        for (int ct = 0; ct < 4; ++ct) { uf[ct][0] = __uint_as_float(udn[ct].x << 16); uf[ct][1] = __uint_as_float(udn[ct].x & 0xFFFF0000u); uf[ct][2] = __uint_as_float(udn[ct].y << 16); uf[ct][3] = __uint_as_float(udn[ct].y & 0xFFFF0000u); }
        const float egl = __expf(gln);
        u32x4 zc[2]; zc[0] = zn[0]; zc[1] = zn[1];
        asm volatile("" : "+v"(uf[0]), "+v"(uf[1]), "+v"(uf[2]), "+v"(uf[3]), "+v"(zc[0]), "+v"(zc[1]));
        if (n + 1 < 64) {
            const unsigned char* un = ubase + (size_t)(n + 1) * GI_UNIT;
#pragma unroll
            for (int ct = 0; ct < 4; ++ct) udn[ct] = *(const u32x2*)(un + 57344 + (ct * 8 + wave) * 512 + lane * 8);
            gln = glast[(size_t)(bh * 64 + n + 1) * 32];
            { const size_t tz = (size_t)b * SEQ + 64 * (n + 1) + (tid >> 3); zn[0] = *(const u32x4*)(za + tz * 1024 + h * 128 + 16 * (tid & 7)); zn[1] = *(const u32x4*)(za + tz * 1024 + h * 128 + 16 * (tid & 7) + 8); }
            GDN_STAGE(n + 1, (n + 1) & 1);
        }
        if (n > 0) GDN_EPILOGUE(n - 1, zp);
        zp[0] = zc[0]; zp[1] = zc[1];
        const LAS unsigned char* L = X.lds + (n & 1) * 57344;
        bf16x8 sB[4];
#pragma unroll
        for (int ks = 0; ks < 4; ++ks) sB[ks] = acc_to_frag(S[2 * ks], S[2 * ks + 1]);
        f32x4 vn[4], oo[4];
#pragma unroll
        for (int ct = 0; ct < 4; ++ct) { f32x4 acc = {0.f, 0.f, 0.f, 0.f}, ao = {0.f, 0.f, 0.f, 0.f};
#pragma unroll
            for (int ks = 0; ks < 4; ++ks) { const bf16x8 wf = *(const LAS bf16x8*)(L + (ct * 4 + ks) * 1024 + lane * 16), qf = *(const LAS bf16x8*)(L + 16384 + (ct * 4 + ks) * 1024 + lane * 16);
                acc = __builtin_amdgcn_mfma_f32_16x16x32_bf16(wf, sB[ks], acc, 0, 0, 0); ao = __builtin_amdgcn_mfma_f32_16x16x32_bf16(qf, sB[ks], ao, 0, 0, 0); }
            vn[ct] = acc; oo[ct] = ao; }
#pragma unroll
        for (int ct = 0; ct < 4; ++ct) vn[ct] = vn[ct] + uf[ct];
        bf16x8 vB[2];
#pragma unroll
        for (int ks = 0; ks < 2; ++ks) vB[ks] = acc_to_frag(vn[2 * ks], vn[2 * ks + 1]);
#pragma unroll
        for (int ct = 0; ct < 4; ++ct)
#pragma unroll
            for (int ks = 0; ks < 2; ++ks) { const bf16x8 kf = *(const LAS bf16x8*)(L + 49152 + (ct * 2 + ks) * 1024 + lane * 16); oo[ct] = __builtin_amdgcn_mfma_f32_16x16x32_bf16(kf, vB[ks], oo[ct], 0, 0, 0); }
#pragma unroll
        for (int dt = 0; dt < 8; ++dt) { f32x4 acc = S[dt] * egl;
#pragma unroll
            for (int ks = 0; ks < 2; ++ks) { const bf16x8 ef = *(const LAS bf16x8*)(L + 32768 + (dt * 2 + ks) * 1024 + lane * 16); acc = __builtin_amdgcn_mfma_f32_16x16x32_bf16(ef, vB[ks], acc, 0, 0, 0); }
            S[dt] = acc; }
        __syncthreads();
#pragma unroll
        for (int ct = 0; ct < 4; ++ct)
#pragma unroll
            for (int rg = 0; rg < 4; ++rg) OT[(16 * ct + 4 * q4 + rg) * 132 + 16 * wave + r16] = oo[ct][rg];
    }
    __syncthreads();
    GDN_EPILOGUE(63, zp);
#undef GDN_EPILOGUE
#undef GDN_STAGE
}

constexpr int SP = 272;
DEV void ph_ssd_local(const Args& a, const Ctx& X) {
    const bf16_t* xbcpre = (const bf16_t*)(a.ws + WS_XBCPRE); const float* small = (const float*)(a.ws + WS_SMALL);
    bf16_t* CC = (bf16_t*)(a.ws + WS_CC); float* acum = (float*)(a.ws + WS_ACUM); float* cdec = (float*)(a.ws + WS_CDEC);
    bf16_t* ydiag = (bf16_t*)(a.ws + WS_YDIAG); bf16_t* states = (bf16_t*)(a.ws + WS_STATES);
    LAS unsigned char* Bn = X.lds; LAS unsigned char* Cn = X.lds + 128 * SP; LAS unsigned char* BT = X.lds + 256 * SP;
    LAS unsigned char* xdT = X.lds; LAS unsigned char* xeT = X.lds + 64 * SP;
    LAS float* acL = (LAS float*)(X.lds + AUX_OFF); LAS float* dtL = acL + 8 * 128;
    const int lane = X.lane, wave = X.wave, r16 = lane & 15, q4 = lane >> 4;
    for (int unit = X.bid; unit < NB * 32 * 2; unit += X.G) {
        const int g = unit & 1, c = (unit >> 1) & 31, b = unit >> 6; const size_t t0 = (size_t)b * SEQ + 128 * c;
        __syncthreads();
        {
            const int hd = g * 8 + wave; const float an = -__expf(a.ssd_a_log[hd]), bias = a.ssd_dt_bias[hd];
            const float d0 = softplusf(small[(t0 + lane) * 32 + 16 + hd] + bias), d1 = softplusf(small[(t0 + 64 + lane) * 32 + 16 + hd] + bias);
            float s0 = d0 * an, s1 = d1 * an;
#pragma unroll
            for (int o = 1; o < 64; o <<= 1) { const float v0 = __shfl_up(s0, o), v1 = __shfl_up(s1, o); if (lane >= o) { s0 += v0; s1 += v1; } }
            s1 += __shfl(s0, 63);
            acL[wave * 128 + lane] = s0; acL[wave * 128 + 64 + lane] = s1; dtL[wave * 128 + lane] = d0; dtL[wave * 128 + 64 + lane] = d1;
            acum[((size_t)g * T + t0 + lane) * 8 + wave] = s0; acum[((size_t)g * T + t0 + 64 + lane) * 8 + wave] = s1;
            if (lane == 63) cdec[(size_t)unit * 32 + wave] = __expf(s1);
        }
        {
            const int isC = lane >> 5, cc = (lane & 31) * 4, col = 1024 + isC * 256 + g * 128 + cc;
            float w[4][4], bs[4];
#pragma unroll
            for (int i = 0; i < 4; ++i) { const f32x4 t = *(const f32x4*)(a.ssd_conv_w + i * 1536 + col); w[i][0] = t[0]; w[i][1] = t[1]; w[i][2] = t[2]; w[i][3] = t[3]; }
            { const f32x4 t = *(const f32x4*)(a.ssd_conv_b + col); bs[0] = t[0]; bs[1] = t[1]; bs[2] = t[2]; bs[3] = t[3]; }
            float xin[19][4];
#pragma unroll
            for (int i = 0; i < 19; ++i) { const int tk = 16 * wave + i - 3; const bool ok = (128 * c + tk) >= 0; u32x2 v = {0u, 0u}; if (ok) v = *(const u32x2*)(xbcpre + (t0 + tk) * 1536 + col);
                xin[i][0] = __uint_as_float(v.x << 16); xin[i][1] = __uint_as_float(v.x & 0xFFFF0000u); xin[i][2] = __uint_as_float(v.y << 16); xin[i][3] = __uint_as_float(v.y & 0xFFFF0000u); }
            unsigned short ov[16][4];
#pragma unroll
            for (int i = 0; i < 16; ++i)
#pragma unroll
                for (int e = 0; e < 4; ++e) { const float s = bs[e] + w[0][e] * xin[i][e] + w[1][e] * xin[i + 1][e] + w[2][e] * xin[i + 2][e] + w[3][e] * xin[i + 3][e]; ov[i][e] = (unsigned short)f2bf(siluf(s)); }
            LAS unsigned char* nat = isC ? Cn : Bn;
#pragma unroll
            for (int i = 0; i < 16; ++i) { const u32x2 pk = {(unsigned)ov[i][0] | ((unsigned)ov[i][1] << 16), (unsigned)ov[i][2] | ((unsigned)ov[i][3] << 16)};
                *(LAS u32x2*)(nat + (16 * wave + i) * SP + cc * 2) = pk;
                if (isC) *(u32x2*)(CC + (t0 + 16 * wave + i) * 256 + g * 128 + cc) = pk; }
            if (!isC) {
#pragma unroll
                for (int e = 0; e < 4; ++e)
#pragma unroll
                    for (int qq = 0; qq < 4; ++qq) { const u32x2 pk = {(unsigned)ov[4 * qq][e] | ((unsigned)ov[4 * qq + 1][e] << 16), (unsigned)ov[4 * qq + 2][e] | ((unsigned)ov[4 * qq + 3][e] << 16)};
                        *(LAS u32x2*)(BT + (cc + e) * SP + (32 * (wave >> 1) + 8 * qq + 4 * (wave & 1)) * 2) = pk; }
            }
        }
        __syncthreads();
        f32x4 cbt[8];
        {
            bf16x8 cf[4];
#pragma unroll
            for (int ks = 0; ks < 4; ++ks) cf[ks] = *(const LAS bf16x8*)(Cn + (16 * wave + r16) * SP + (32 * ks + 8 * q4) * 2);
#pragma unroll
            for (int st = 0; st < 8; ++st) { cbt[st] = (f32x4){0.f, 0.f, 0.f, 0.f};
#pragma unroll
                for (int ks = 0; ks < 4; ++ks) { const bf16x8 bf = *(const LAS bf16x8*)(Bn + (16 * st + r16) * SP + (32 * ks + 8 * q4) * 2); cbt[st] = __builtin_amdgcn_mfma_f32_16x16x32_bf16(bf, cf[ks], cbt[st], 0, 0, 0); } }
        }
        __syncthreads();
        const int lq = 16 * wave + r16;
        unsigned short xnx[19];
#define SSD_LOADX(hh) do { _Pragma("unroll") for (int _i = 0; _i < 19; ++_i) { const int _tk = 16 * wave + _i - 3; xnx[_i] = (128 * c + _tk) >= 0 ? xbcpre[(t0 + _tk) * 1536 + (hh) * 64 + lane] : (unsigned short)0; } } while (0)
        SSD_LOADX(g * 8);
        for (int r = 0; r < 8; ++r) {
            const int hd = g * 8 + r; const float dd = a.ssd_d[hd];
            {
                const int col = hd * 64 + lane; float w0 = a.ssd_conv_w[col], w1 = a.ssd_conv_w[1536 + col], w2 = a.ssd_conv_w[2 * 1536 + col], w3 = a.ssd_conv_w[3 * 1536 + col]; const float bs = a.ssd_conv_b[col];
                float xin[19];
#pragma unroll
                for (int i = 0; i < 19; ++i) xin[i] = bf2f(xnx[i]);
                if (r + 1 < 8) SSD_LOADX(hd + 1);
                const float aclast = acL[r * 128 + 127];
                unsigned short xd[16], xe[16];
#pragma unroll
                for (int i = 0; i < 16; ++i) { const float xv = siluf(bs + w0 * xin[i] + w1 * xin[i + 1] + w2 * xin[i + 2] + w3 * xin[i + 3]); const int tk = 16 * wave + i;
                    const float xdv = xv * dtL[r * 128 + tk]; xd[i] = (unsigned short)f2bf(xdv); xe[i] = (unsigned short)f2bf(xdv * __expf(aclast - acL[r * 128 + tk])); }
#pragma unroll
                for (int qq = 0; qq < 4; ++qq) { const int pos = 32 * (wave >> 1) + 8 * qq + 4 * (wave & 1);
                    *(LAS u32x2*)(xdT + lane * SP + pos * 2) = (u32x2){(unsigned)xd[4 * qq] | ((unsigned)xd[4 * qq + 1] << 16), (unsigned)xd[4 * qq + 2] | ((unsigned)xd[4 * qq + 3] << 16)};
                    *(LAS u32x2*)(xeT + lane * SP + pos * 2) = (u32x2){(unsigned)xe[4 * qq] | ((unsigned)xe[4 * qq + 1] << 16), (unsigned)xe[4 * qq + 2] | ((unsigned)xe[4 * qq + 3] << 16)}; }
            }
            __syncthreads();
            {
                const float acl = acL[r * 128 + lq], ddt = dd / dtL[r * 128 + lq];
                f32x4 yd[4];
#pragma unroll
                for (int pt = 0; pt < 4; ++pt) yd[pt] = (f32x4){0.f, 0.f, 0.f, 0.f};
#pragma unroll
                for (int ks = 0; ks < 4; ++ks) { if (ks <= (wave >> 1)) {
                    f32x4 mlo, mhi;
#pragma unroll
                    for (int e = 0; e < 4; ++e) {
                        const int s0 = 32 * ks + 4 * q4 + e, s1 = s0 + 16;
                        const float v0 = cbt[2 * ks][e], v1 = cbt[2 * ks + 1][e];
                        mlo[e] = s0 < lq ? v0 * __expf(acl - acL[r * 128 + s0]) : (s0 == lq ? v0 + ddt : 0.f);
                        mhi[e] = s1 < lq ? v1 * __expf(acl - acL[r * 128 + s1]) : (s1 == lq ? v1 + ddt : 0.f);
                    }
                    const bf16x8 mf = acc_to_frag(mlo, mhi);
#pragma unroll
                    for (int pt = 0; pt < 4; ++pt) { const bf16x8 xf = *(const LAS bf16x8*)(xdT + (16 * pt + r16) * SP + (32 * ks + 8 * q4) * 2); yd[pt] = __builtin_amdgcn_mfma_f32_16x16x32_bf16(xf, mf, yd[pt], 0, 0, 0); }
                } }
#pragma unroll
                for (int pt = 0; pt < 4; ++pt) *(u32x2*)(ydiag + (t0 + lq) * 1024 + hd * 64 + 16 * pt + 4 * q4) = (u32x2){pg8::cvt_pk_bf16(yd[pt][0], yd[pt][1]), pg8::cvt_pk_bf16(yd[pt][2], yd[pt][3])};
            }
            {
                bf16x8 bf[4];
#pragma unroll
                for (int ks = 0; ks < 4; ++ks) bf[ks] = *(const LAS bf16x8*)(BT + (16 * wave + r16) * SP + (32 * ks + 8 * q4) * 2);
                bf16_t* hp = states + ((size_t)(unit * 8 + r) * 64) * 128;
#pragma unroll
                for (int pt = 0; pt < 4; ++pt) { f32x4 st = {0.f, 0.f, 0.f, 0.f};
#pragma unroll
                    for (int ks = 0; ks < 4; ++ks) { const bf16x8 xf = *(const LAS bf16x8*)(xeT + (16 * pt + r16) * SP + (32 * ks + 8 * q4) * 2); st = __builtin_amdgcn_mfma_f32_16x16x32_bf16(bf[ks], xf, st, 0, 0, 0); }
                    *(u32x2*)(hp + (size_t)(16 * pt + r16) * 128 + 16 * wave + 4 * q4) = (u32x2){pg8::cvt_pk_bf16(st[0], st[1]), pg8::cvt_pk_bf16(st[2], st[3])}; }
            }
            __syncthreads();
        }
    }
}
DEV void ph_ssd_scan(const Args& a, const Ctx& X, const int wg0) {
    bf16_t* states = (bf16_t*)(a.ws + WS_STATES); const float* cdec = (const float*)(a.ws + WS_CDEC);
    for (int task = (X.bid - wg0) * NTHR + X.tid; task < NB * 16 * 64 * 32; task += (X.G - wg0) * NTHR) {
        const int n4 = task & 31, p = (task >> 5) & 63, hd = (task >> 11) & 15, b = task >> 15;
        float h0 = 0.f, h1 = 0.f, h2 = 0.f, h3 = 0.f;
        for (int c = 0; c < 32; ++c) {
            const int unit = (b * 32 + c) * 2 + (hd >> 3);
            u32x2* ptr = (u32x2*)(states + ((size_t)(unit * 8 + (hd & 7)) * 64 + p) * 128 + 4 * n4);
            const u32x2 sv = *ptr; const float dec = cdec[(size_t)unit * 32 + (hd & 7)];
            *ptr = (u32x2){pk2(h0, h1), pk2(h2, h3)};
            h0 = h0 * dec + __uint_as_float(sv.x << 16); h1 = h1 * dec + __uint_as_float(sv.x & 0xFFFF0000u); h2 = h2 * dec + __uint_as_float(sv.y << 16); h3 = h3 * dec + __uint_as_float(sv.y & 0xFFFF0000u);
        }
    }
}
DEV void ph_ssd_out(const Args& a, const Ctx& X, const int wg0) {
    const bf16_t* CC = (const bf16_t*)(a.ws + WS_CC); const float* acum = (const float*)(a.ws + WS_ACUM); const bf16_t* ydiag = (const bf16_t*)(a.ws + WS_YDIAG);
    const bf16_t* states = (const bf16_t*)(a.ws + WS_STATES); const bf16_t* zb = (const bf16_t*)(a.ws + WS_ZB); bf16_t* oy = (bf16_t*)(a.ws + WS_OY);
    const int lane = X.lane, wave = X.wave, r16 = lane & 15, q4 = lane >> 4;
    for (int unit = X.bid - wg0; unit < NB * 32 * 2; unit += X.G - wg0) {
        const int g = unit & 1, c = (unit >> 1) & 31, b = unit >> 6; const size_t t = (size_t)b * SEQ + 128 * c + 16 * wave + r16;
        bf16x8 cf[4];
#pragma unroll
        for (int ks = 0; ks < 4; ++ks) cf[ks] = *(const bf16x8*)(CC + t * 256 + g * 128 + 32 * ks + 8 * q4);
        float ss = 0.f;
        LAS u32x2* stash = (LAS u32x2*)(X.lds + wave * 16384);
        for (int r = 0; r < 8; ++r) {
            const int hd = g * 8 + r; const float eac = __expf(acum[((size_t)g * T + t) * 8 + r]);
            const bf16_t* hp = states + ((size_t)(unit * 8 + r) * 64) * 128;
#pragma unroll
            for (int pt = 0; pt < 4; ++pt) { f32x4 acc = {0.f, 0.f, 0.f, 0.f};
#pragma unroll
                for (int ks = 0; ks < 4; ++ks) { const bf16x8 hf = *(const bf16x8*)(hp + (size_t)(16 * pt + r16) * 128 + 32 * ks + 8 * q4); acc = __builtin_amdgcn_mfma_f32_16x16x32_bf16(hf, cf[ks], acc, 0, 0, 0); }
                const u32x2 yd = *(const u32x2*)(ydiag + t * 1024 + hd * 64 + 16 * pt + 4 * q4), zz = *(const u32x2*)(zb + t * 1024 + hd * 64 + 16 * pt + 4 * q4);
                f32x4 v; v[0] = acc[0] * eac + __uint_as_float(yd.x << 16); v[1] = acc[1] * eac + __uint_as_float(yd.x & 0xFFFF0000u); v[2] = acc[2] * eac + __uint_as_float(yd.y << 16); v[3] = acc[3] * eac + __uint_as_float(yd.y & 0xFFFF0000u);
                v[0] *= siluf(__uint_as_float(zz.x << 16)); v[1] *= siluf(__uint_as_float(zz.x & 0xFFFF0000u)); v[2] *= siluf(__uint_as_float(zz.y << 16)); v[3] *= siluf(__uint_as_float(zz.y & 0xFFFF0000u));
                ss += v[0] * v[0] + v[1] * v[1] + v[2] * v[2] + v[3] * v[3];
                stash[(r * 4 + pt) * 64 + lane] = (u32x2){pg8::cvt_pk_bf16(v[0], v[1]), pg8::cvt_pk_bf16(v[2], v[3])}; }
        }
        ss += __shfl_xor(ss, 16); ss += __shfl_xor(ss, 32);
        const float rstd = rsqrtf(ss * (1.f / 512.f) + EPS);
        for (int r = 0; r < 8; ++r)
#pragma unroll
            for (int pt = 0; pt < 4; ++pt) { const int cix = g * 512 + r * 64 + 16 * pt + 4 * q4; const f32x4 nw = *(const f32x4*)(a.ssd_norm_w + cix); const u32x2 w = stash[(r * 4 + pt) * 64 + lane];
                *(u32x2*)(oy + t * 2048 + 1024 + cix) = (u32x2){pg8::cvt_pk_bf16(__uint_as_float(w.x << 16) * rstd * nw[0], __uint_as_float(w.x & 0xFFFF0000u) * rstd * nw[1]), pg8::cvt_pk_bf16(__uint_as_float(w.y << 16) * rstd * nw[2], __uint_as_float(w.y & 0xFFFF0000u) * rstd * nw[3])}; }
    }
}


DEV void ph_attn(const Args& a, const Ctx& X) {
    const bf16_t* qkv = (const bf16_t*)(a.ws + WS_Q1KV); bf16_t* po = (bf16_t*)(a.ws + WS_PO); float* plse = (float*)(a.ws + WS_PLSE); bf16_t* o = (bf16_t*)(a.ws + WS_O1);
    LAS unsigned char* vl = X.lds + X.wave * 12288;
    LAS unsigned char* kl = vl + 6144;
    const int lane = X.lane, q = lane & 31, h5 = lane >> 5;
    const int tr_off = ((lane & 15) >> 2) * 192 + (16 * ((lane >> 4) & 1) + 4 * (lane & 3)) * 2;
    const int prow = lane >> 3, pch = lane & 7;
    for (int unit = X.bid; unit < NB * 16 * 4; unit += X.G) {
        const int bhd = unit & 63, b = bhd >> 4, hd = bhd & 15, g = unit >> 6;
        for (int tk = 0; tk < 6; ++tk) {
            const int br = tk >> 1, idx = X.wave * 2 + (tk & 1);
            int d, r, I0;
            if (br == 0) { d = 1; r = 0; I0 = 1024 * g + 64 * idx; } else if (br == 1) { d = 4; r = idx & 3; I0 = 256 * g + 64 * (idx >> 2); } else { d = 16; r = idx; I0 = 64 * g; }
#define ATT_LOAD(dst, j0_, coff) do { _Pragma("unroll") for (int _i = 0; _i < 4; ++_i) { const size_t _t = (size_t)b * SEQ + (size_t)((j0_) + 8 * _i + prow) * d + r; \
                dst[_i] = *(const u32x4*)(qkv + _t * 3072 + (coff) + hd * 64 + pch * 8); } } while (0)
            u32x4 k0[4], v0[4], k1[4], v1[4];
            const bool e3 = (I0 - 32) >= 0, e2 = (I0 - 64) >= 0, e1 = (I0 - 96) >= 0, e0 = (I0 - 128) >= 0;
            ATT_LOAD(k0, I0, 0); ATT_LOAD(k1, I0 + 32, 0);
            bf16x8 qA[4], qB[4];
#pragma unroll
            for (int i = 0; i < 4; ++i) *(LAS u32x4*)(kl + (8 * i + prow) * 144 + pch * 16) = k0[i];
#pragma unroll
            for (int s = 0; s < 4; ++s) qA[s] = *(const LAS bf16x8*)(kl + q * 144 + (16 * s + 8 * h5) * 2);
            LDS_WAIT();
#pragma unroll
            for (int i = 0; i < 4; ++i) *(LAS u32x4*)(kl + (8 * i + prow) * 144 + pch * 16) = k1[i];
#pragma unroll
            for (int s = 0; s < 4; ++s) qB[s] = *(const LAS bf16x8*)(kl + q * 144 + (16 * s + 8 * h5) * 2);
            LDS_WAIT();
            ATT_LOAD(k0, I0 + 32, 1024); ATT_LOAD(v0, I0 + 32, 2048);
            ATT_LOAD(k1, I0, 1024); ATT_LOAD(v1, I0, 2048);
            f32x16 oA[2], oB[2];
#pragma unroll
            for (int i = 0; i < 16; ++i) { oA[0][i] = 0.f; oA[1][i] = 0.f; oB[0][i] = 0.f; oB[1][i] = 0.f; }
            float mA = -1e30f, lA = 0.f, mB = -1e30f, lB = 0.f;
            auto scores = [&](const bf16x8 (&kf)[4], const bf16x8 (&qf)[4], f32x16 (&oacc)[2], float& m, float& l, const int mode, bf16x8 (&pf)[2]) {
                f32x16 sacc;
#pragma unroll
                for (int i = 0; i < 16; ++i) sacc[i] = 0.f;
#pragma unroll
                for (int s = 0; s < 4; ++s) sacc = __builtin_amdgcn_mfma_f32_32x32x16_bf16(kf[s], qf[s], sacc, 0, 0, 0);
                if (mode == 1) {
#pragma unroll
                    for (int i = 0; i < 16; ++i) { const int kl_ = (i & 3) + 8 * (i >> 2) + 4 * h5; if (kl_ > q) sacc[i] = -1e30f; }
                } else if (mode == 2) {
#pragma unroll
                    for (int i = 0; i < 16; ++i) { const int kl_ = (i & 3) + 8 * (i >> 2) + 4 * h5; if (kl_ < q) sacc[i] = -1e30f; }
                }
                float mx = sacc[0];
#pragma unroll
                for (int i = 1; i < 16; ++i) mx = fmaxf(mx, sacc[i]);
                mx = fmaxf(mx, __shfl_xor(mx, 32));
                const float mn = fmaxf(m, mx), alpha = __expf(m - mn);
                float rs = 0.f;
#pragma unroll
                for (int i = 0; i < 16; ++i) { sacc[i] = __expf(sacc[i] - mn); rs += sacc[i]; }
                rs += __shfl_xor(rs, 32);
                l = l * alpha + rs; m = mn;
#pragma unroll
                for (int i = 0; i < 16; ++i) { oacc[0][i] *= alpha; oacc[1][i] *= alpha; }
#pragma unroll
                for (int s = 0; s < 2; ++s) { u32x4 w; w.x = pg8::cvt_pk_bf16(sacc[8 * s], sacc[8 * s + 1]); w.y = pg8::cvt_pk_bf16(sacc[8 * s + 2], sacc[8 * s + 3]); w.z = pg8::cvt_pk_bf16(sacc[8 * s + 4], sacc[8 * s + 5]); w.w = pg8::cvt_pk_bf16(sacc[8 * s + 6], sacc[8 * s + 7]);
                    pf[s] = __builtin_bit_cast(bf16x8, w); }
            };
            auto tile = [&](const u32x4 (&kp)[4], const u32x4 (&vp)[4], const int ma, const int mb) {
#pragma unroll
                for (int i = 0; i < 4; ++i) { *(LAS u32x4*)(kl + (8 * i + prow) * 144 + pch * 16) = kp[i]; *(LAS u32x4*)(vl + (8 * i + prow) * 192 + pch * 16) = vp[i]; }
                bf16x8 kf[4];
#pragma unroll
                for (int s = 0; s < 4; ++s) kf[s] = *(const LAS bf16x8*)(kl + q * 144 + (16 * s + 8 * h5) * 2);
                bf16x8 pA[2], pB[2];
                if (ma >= 0) scores(kf, qA, oA, mA, lA, ma, pA);
                if (mb >= 0) scores(kf, qB, oB, mB, lB, mb, pB);
#pragma unroll
                for (int dt = 0; dt < 2; ++dt)
#pragma unroll
                    for (int s = 0; s < 2; ++s) {
                        const s16x4 t0_ = __builtin_amdgcn_ds_read_tr16_b64_v4i16((LAS s16x4*)(vl + (16 * s + 4 * h5) * 192 + dt * 64 + tr_off));
                        const s16x4 t1_ = __builtin_amdgcn_ds_read_tr16_b64_v4i16((LAS s16x4*)(vl + (16 * s + 8 + 4 * h5) * 192 + dt * 64 + tr_off));
                        bf16x8 vf; vf[0] = t0_[0]; vf[1] = t0_[1]; vf[2] = t0_[2]; vf[3] = t0_[3]; vf[4] = t1_[0]; vf[5] = t1_[1]; vf[6] = t1_[2]; vf[7] = t1_[3];
                        if (ma >= 0) oA[dt] = __builtin_amdgcn_mfma_f32_32x32x16_bf16(vf, pA[s], oA[dt], 0, 0, 0);
                        if (mb >= 0) oB[dt] = __builtin_amdgcn_mfma_f32_32x32x16_bf16(vf, pB[s], oB[dt], 0, 0, 0);
                    }
                LDS_WAIT();
            };
            tile(k0, v0, -1, 1);
            if (e3) { ATT_LOAD(k0, I0 - 32, 1024); ATT_LOAD(v0, I0 - 32, 2048); }
            tile(k1, v1, 1, 0);
            if (e3) {
                if (e2) { ATT_LOAD(k1, I0 - 64, 1024); ATT_LOAD(v1, I0 - 64, 2048); }
                tile(k0, v0, 0, 0);
                if (e2) {
                    if (e1) { ATT_LOAD(k0, I0 - 96, 1024); ATT_LOAD(v0, I0 - 96, 2048); }
                    tile(k1, v1, 0, 0);
                    if (e1) {
                        if (e0) { ATT_LOAD(k1, I0 - 128, 1024); ATT_LOAD(v1, I0 - 128, 2048); }
                        tile(k0, v0, 0, 2);
                        if (e0) tile(k1, v1, 2, -1);
                    }
                }
            }
#undef ATT_LOAD
#pragma unroll
            for (int qt = 0; qt < 2; ++qt) {
                const size_t tq = (size_t)b * SEQ + (size_t)(I0 + 32 * qt + q) * d + r;
                const float l = qt ? lB : lA, m = qt ? mB : mA; const float inv = 1.f / l;
                bf16_t* pr = po + ((size_t)br * T + tq) * 1024 + hd * 64;
#pragma unroll
                for (int dt = 0; dt < 2; ++dt)
#pragma unroll
                    for (int gq = 0; gq < 4; ++gq) { const f32x16& oo = qt ? oB[dt] : oA[dt]; u32x2 w; w.x = pg8::cvt_pk_bf16(oo[4 * gq] * inv, oo[4 * gq + 1] * inv); w.y = pg8::cvt_pk_bf16(oo[4 * gq + 2] * inv, oo[4 * gq + 3] * inv);
                        *(u32x2*)(pr + 32 * dt + 8 * gq + 4 * h5) = w; }
                if (h5 == 0) plse[((size_t)br * T + tq) * 16 + hd] = m + __logf(l);
            }
        }
        VM_WAIT(); __syncthreads();
        for (int hf = 0; hf < 2; ++hf) {
            const size_t t = (size_t)b * SEQ + 1024 * g + 512 * hf + X.tid;
            const float l0 = plse[t * 16 + hd], l1 = plse[((size_t)T + t) * 16 + hd], l2 = plse[((size_t)2 * T + t) * 16 + hd];
            const float mx = fmaxf(l0, fmaxf(l1, l2)); float w0 = __expf(l0 - mx), w1 = __expf(l1 - mx), w2 = __expf(l2 - mx); const float wi = 1.f / (w0 + w1 + w2); w0 *= wi; w1 *= wi; w2 *= wi;
            const bf16_t* p0 = po + t * 1024 + hd * 64; const bf16_t* p1 = p0 + (size_t)T * 1024; const bf16_t* p2 = p1 + (size_t)T * 1024; bf16_t* orow = o + t * 1024 + hd * 64;
#pragma unroll
            for (int c = 0; c < 8; ++c) { const u32x4 x0 = *(const u32x4*)(p0 + 8 * c), x1 = *(const u32x4*)(p1 + 8 * c), x2 = *(const u32x4*)(p2 + 8 * c); u32x4 y;
#pragma unroll
                for (int e = 0; e < 4; ++e) { const float lo = w0 * __uint_as_float(x0[e] << 16) + w1 * __uint_as_float(x1[e] << 16) + w2 * __uint_as_float(x2[e] << 16);
                    const float hi = w0 * __uint_as_float(x0[e] & 0xFFFF0000u) + w1 * __uint_as_float(x1[e] & 0xFFFF0000u) + w2 * __uint_as_float(x2[e] & 0xFFFF0000u); y[e] = pk2(lo, hi); }
                *(u32x4*)(orow + 8 * c) = y; }
        }
    }
}

DEV void ph_router(const Args& a, const Ctx& X, const int l) {
    unsigned char* ws = a.ws;
    const float* mod = (const float*)(ws + WS_MOD) + (size_t)l * NB * 6 * D;
    const bf16_t* ymix = (const bf16_t*)(ws + WS_YMIX);
    bf16_t* xb = (bf16_t*)(ws + WS_XB);
    bf16_t* hb = (bf16_t*)(ws + WS_H);
    int* idx = (int*)(ws + WS_IDX); float* gw = (float*)(ws + WS_GW); int* aslot = (int*)(ws + WS_ASLOT); int* ltok = (int*)(ws + WS_LTOK);
    int* cntg = (int*)(ws + WS_CTL + CTL_CNT) + l * NE;
    const float* rw = a.router_w + (size_t)l * D * NE; const float* rbias = a.router_bias + l * NE;
    constexpr int HP = 2064;
    LAS unsigned char* hL = X.lds;
    LAS float* logit = (LAS float*)(X.lds + AUX_OFF + 2048);
    LAS int* lcnt = (LAS int*)(X.lds + AUX_OFF + 2048 + 64 * 65 * 4);
    LAS int* lbase = lcnt + 64;
    LAS int* sel_e = lbase + 64;
    LAS int* sel_s = sel_e + 512;
    const int lane = X.lane, wave = X.wave;
    for (int rb = X.bid; rb < T / 64; rb += X.G) {
        if (X.tid < 64) lcnt[X.tid] = 0;
        f32x4 xf_n[4]; u32x2 xb_n[4], ym_n[4];
#define RT_LOAD(rr) do { const int _row = rb * 64 + wave * 8 + (rr); _Pragma("unroll") for (int _j = 0; _j < 4; ++_j) { \
            if (l == 0) xf_n[_j] = *(const f32x4*)(a.x + (size_t)_row * D + _j * 256 + lane * 4); else xb_n[_j] = *(const u32x2*)(xb + (size_t)_row * D + _j * 256 + lane * 4); \
            ym_n[_j] = *(const u32x2*)(ymix + (size_t)_row * D + _j * 256 + lane * 4); } } while (0)
        RT_LOAD(0);
        for (int r8 = 0; r8 < 8; ++r8) {
            const int lr = wave * 8 + r8, row = rb * 64 + lr, b = row / SEQ; const float* ml = mod + (size_t)b * 6 * D;
            float xv[16], yv[16];
#pragma unroll
            for (int j = 0; j < 4; ++j) {
                if (l == 0) { xv[4 * j] = xf_n[j][0]; xv[4 * j + 1] = xf_n[j][1]; xv[4 * j + 2] = xf_n[j][2]; xv[4 * j + 3] = xf_n[j][3]; }
                else { xv[4 * j] = __uint_as_float(xb_n[j].x << 16); xv[4 * j + 1] = __uint_as_float(xb_n[j].x & 0xFFFF0000u); xv[4 * j + 2] = __uint_as_float(xb_n[j].y << 16); xv[4 * j + 3] = __uint_as_float(xb_n[j].y & 0xFFFF0000u); }
                yv[4 * j] = __uint_as_float(ym_n[j].x << 16); yv[4 * j + 1] = __uint_as_float(ym_n[j].x & 0xFFFF0000u); yv[4 * j + 2] = __uint_as_float(ym_n[j].y << 16); yv[4 * j + 3] = __uint_as_float(ym_n[j].y & 0xFFFF0000u); }
            if (r8 + 1 < 8) RT_LOAD(r8 + 1);
            resid_update(xv, yv, a.mix_post_g + l * D, ml + 2 * D, lane);
            store_row_bf(xb + (size_t)row * D, lane, xv);
            u32x2 o[4]; prenorm_pack(xv, a.ffn_pre_g + l * D, ml + 4 * D, ml + 3 * D, lane, o);
#pragma unroll
            for (int j = 0; j < 4; ++j) { *(LAS u32x2*)(hL + lr * HP + (j * 256 + lane * 4) * 2) = o[j];
                const float h0 = __uint_as_float(o[j].x << 16), h1 = __uint_as_float(o[j].x & 0xFFFF0000u), h2 = __uint_as_float(o[j].y << 16), h3 = __uint_as_float(o[j].y & 0xFFFF0000u);
                int w = __builtin_amdgcn_cvt_pk_fp8_f32(fminf(fmaxf(h0, -440.f), 440.f), fminf(fmaxf(h1, -440.f), 440.f), 0, false); w = __builtin_amdgcn_cvt_pk_fp8_f32(fminf(fmaxf(h2, -440.f), 440.f), fminf(fmaxf(h3, -440.f), 440.f), w, true);
                *(unsigned*)((unsigned char*)hb + (size_t)row * D + j * 256 + lane * 4) = (unsigned)w; }
        }
#undef RT_LOAD
        __syncthreads();
        { const int rt = wave & 3, nh = wave >> 2, r16 = lane & 15, kq = lane >> 4;
          f32x4 acc0 = {0.f, 0.f, 0.f, 0.f}, acc1 = {0.f, 0.f, 0.f, 0.f};
          for (int c = 0; c < 32; ++c) {
              const u32x4 hv = *(const LAS u32x4*)(hL + (rt * 16 + r16) * HP + (32 * c + 8 * kq) * 2);
              const float* rp = rw + (size_t)(32 * c + 8 * kq) * NE + 4 * r16 + 2 * nh;
#pragma unroll
              for (int j = 0; j < 8; ++j) { const unsigned wj = hv[j >> 1]; const float av = (j & 1) ? __uint_as_float(wj & 0xFFFF0000u) : __uint_as_float(wj << 16);
                  const f32x2 bv = *(const f32x2*)(rp + (size_t)j * NE);
                  acc0 = __builtin_amdgcn_mfma_f32_16x16x4f32(av, bv.x, acc0, 0, 0, 0); acc1 = __builtin_amdgcn_mfma_f32_16x16x4f32(av, bv.y, acc1, 0, 0, 0); }
          }
#pragma unroll
          for (int r = 0; r < 4; ++r) { logit[(rt * 16 + 4 * kq + r) * 65 + 4 * r16 + 2 * nh] = acc0[r]; logit[(rt * 16 + 4 * kq + r) * 65 + 4 * r16 + 2 * nh + 1] = acc1[r]; } }
        __syncthreads();
        for (int r8 = 0; r8 < 8; ++r8) {
            const int lr = wave * 8 + r8, t = rb * 64 + lr;
            float lgt = logit[lr * 65 + lane]; if (!(lgt > -1e30f && lgt < 1e30f)) lgt = 0.f;
            const float score = sigmoidf_(lgt), biased = score + rbias[lane];
            float m1 = biased;
#pragma unroll
            for (int o = 1; o < 8; o <<= 1) m1 = fmaxf(m1, __shfl_xor(m1, o));
            int c1 = (biased == m1) ? (lane & 7) : 8;
#pragma unroll
            for (int o = 1; o < 8; o <<= 1) c1 = min(c1, __shfl_xor(c1, o));
            float m2 = ((lane & 7) == c1) ? -INFINITY : biased;
#pragma unroll
            for (int o = 1; o < 8; o <<= 1) m2 = fmaxf(m2, __shfl_xor(m2, o));
            const float gs = m1 + m2; const int myg = lane >> 3; int grank = 0;
#pragma unroll
            for (int g2 = 0; g2 < 8; ++g2) { const float o = __shfl(gs, g2 * 8); grank += (o > gs || (o == gs && g2 < myg)) ? 1 : 0; }
            const float cand = (grank < 4) ? biased : -INFINITY; int rank = 0;
            for (int e2 = 0; e2 < 64; ++e2) { const float o = __shfl(cand, e2); rank += (o > cand || (o == cand && e2 < lane)) ? 1 : 0; }
            const bool sel = (rank < TOPK) && (grank < 4);
            const float ssum = wave_sum(sel ? score : 0.f);
            if (sel) { idx[t * 8 + rank] = lane; gw[t * 8 + rank] = score / ssum * 2.5f; sel_e[lr * 8 + rank] = lane; sel_s[lr * 8 + rank] = __hip_atomic_fetch_add(lcnt + lane, 1, __ATOMIC_RELAXED, __HIP_MEMORY_SCOPE_WORKGROUP); }
        }
        __syncthreads();
        if (X.tid < 64) { const int n = lcnt[X.tid]; lbase[X.tid] = n ? atomicAdd(cntg + X.tid, n) : 0; }
        __syncthreads();
        { const int lr = X.tid >> 3, k = X.tid & 7, t = rb * 64 + lr, e = sel_e[lr * 8 + k], sl = lbase[e] + sel_s[lr * 8 + k];
          aslot[t * 8 + k] = sl; ltok[e * CAP + sl] = t; }
        __syncthreads();
    }
}
template <int NW>
DEV void ph_moe_conv(const Args& a, const Ctx& X, const int l, const int wg0) {
    unsigned char* ws = a.ws;
    if (X.wave >= NW) return;
    { LAS float* scr = (LAS float*)(X.lds + X.wave * 8704);
      const int gwv = (X.bid - wg0) * NW + X.wave, NGW = (X.G - wg0) * NW;
      constexpr int I_GU = (D / 64) * (512 / 32), I_D = (ED / 64) * (D / 32), I_E = I_GU + I_D;
      const float* eg = a.exp_gate + (size_t)l * NE * D * ED; const float* eu = a.exp_up + (size_t)l * NE * D * ED; const float* ed = a.exp_down + (size_t)l * NE * ED * D;
      for (int it = gwv; it < (NE + 1) * I_E; it += NGW) {
          const int e = it / I_E; int r = it - e * I_E;
          if (e < NE) {
              if (r < I_GU) conv_item<SrcGU, true>(SrcGU{eg + (size_t)e * D * ED, (long)(eu - eg)}, ED, D, ws + WS_WGU + (size_t)e * 512 * D, scr, r, 16, X.lane, 64.f);
              else conv_item<SrcIdent, true>(SrcIdent{ed + (size_t)e * ED * D}, D, ED, ws + WS_WD + (size_t)e * D * ED, scr, r - I_GU, D / 32, X.lane, 32.f);
          } else {
              if (r < I_GU) conv_item<SrcGU, true>(SrcGU{a.sh_gate + (size_t)l * D * ED, (long)(a.sh_up - a.sh_gate)}, ED, D, ws + WS_WGUS, scr, r, 16, X.lane, 64.f);
              else conv_item<SrcIdent, true>(SrcIdent{a.sh_down + (size_t)l * ED * D}, D, ED, ws + WS_WDS, scr, r - I_GU, D / 32, X.lane, 32.f);
          }
      } }
}

DEV int moe_tables(const Args& a, const Ctx& X, const int l, LAS int* t_cnt, LAS int* t_rb0, LAS int* t_eofrb) {
    const int* cntg = (const int*)(a.ws + WS_CTL + CTL_CNT) + l * NE;
    if (X.wave == 0) {
        const int c = __hip_atomic_load(cntg + X.lane, __ATOMIC_RELAXED, __HIP_MEMORY_SCOPE_AGENT), nrb = (c + 255) >> 8;
        int incl = nrb;
#pragma unroll
        for (int o = 1; o < 64; o <<= 1) { const int v = __shfl_up(incl, o); if (X.lane >= o) incl += v; }
        const int excl = incl - nrb;
        t_cnt[X.lane] = c; t_rb0[X.lane] = excl; if (X.lane == 63) t_rb0[64] = incl;
        for (int j = 0; j < nrb; ++j) t_eofrb[excl + j] = X.lane;
        t_eofrb[SH_RB + X.lane] = NE;
    }
    __syncthreads();
    return t_rb0[64];
}

DEV void ph_moe_gu(const Args& a, const Ctx& X, const int l) {
    LAS int* t_cnt = (LAS int*)(X.lds + AUX_OFF + 1024); LAS int* t_rb0 = t_cnt + 64; LAS int* t_eofrb = t_rb0 + 80; LAS int* toks = t_eofrb + NRB_ALL;
    const int nrbt = moe_tables(a, X, l, t_cnt, t_rb0, t_eofrb);
    const int* ltok = (const int*)(a.ws + WS_LTOK);
    pg8::Unit u;
    for (int i = 0; i < 8; ++i) { if (!pg8::moe_unit(i, 2, nrbt, X.G, X.bid, u)) break;
        if (X.tid < 256) { const int e = t_eofrb[u.pm]; int tok;
            if (e < NE) { const int sl = (u.pm - t_rb0[e]) * 256 + X.tid; tok = sl < t_cnt[e] ? ltok[e * CAP + sl] : 0; } else tok = (u.pm - SH_RB) * 256 + X.tid;
            toks[i * 256 + X.tid] = tok; } }
    VM_WAIT(); __syncthreads();
    pg8::SchedGU S{(const char*)(a.ws + WS_H), (const char*)(a.ws + WS_WGU), (const char*)(a.ws + WS_WGUS), t_eofrb, toks, nrbt, X.G, X.bid, 0};
    pg8::EpiGU E{a.ws + WS_HID};
    pg8::gemm_phase<pg8::EpiGU, pg8::SchedGU, true>(X.lds, D, S, E);
}
DEV void ph_moe_down(const Args& a, const Ctx& X, const int l) {
    LAS int* t_cnt = (LAS int*)(X.lds + AUX_OFF + 1024); LAS int* t_rb0 = t_cnt + 64; LAS int* t_eofrb = t_rb0 + 80;
    const int nrbt = moe_tables(a, X, l, t_cnt, t_rb0, t_eofrb);
    pg8::SchedDown S{(const char*)(a.ws + WS_HID), (const char*)(a.ws + WS_WD), (const char*)(a.ws + WS_WDS), t_eofrb, nrbt, X.G, X.bid, 0};
    pg8::EpiFp8 E{(unsigned char*)(a.ws + WS_Y), D, 0};
    int kd = ED; asm volatile("" : "+s"(kd));
    pg8::gemm_phase<pg8::EpiFp8, pg8::SchedDown, true>(X.lds, kd, S, E);
}
DEV void ph_combine(const Args& a, const Ctx& X, const int l) {
    LAS int* t_cnt = (LAS int*)(X.lds + AUX_OFF + 1024); LAS int* t_rb0 = t_cnt + 64; LAS int* t_eofrb = t_rb0 + 80;
    (void)moe_tables(a, X, l, t_cnt, t_rb0, t_eofrb);
    const float* mod = (const float*)(a.ws + WS_MOD);
    const int* idx = (const int*)(a.ws + WS_IDX); const float* gw = (const float*)(a.ws + WS_GW); const int* aslot = (const int*)(a.ws + WS_ASLOT);
    const unsigned char* y = a.ws + WS_Y; bf16_t* hb = (bf16_t*)(a.ws + WS_H);
    const int lane = X.lane;
    const int tstep = X.G * NWAVES;
    int t = X.bid * NWAVES + X.wave;
    int e_n = 0, s_n = 0; float g_n = 0.f;
    if (t < T && lane < 8) { e_n = idx[t * 8 + lane]; g_n = gw[t * 8 + lane]; s_n = aslot[t * 8 + lane]; }
    for (; t < T; t += tstep) {
        const int b = t / SEQ; const float* ml = mod + (size_t)(l * NB + b) * 6 * D;
        const int e_c = e_n, s_c = s_n; const float g_c = g_n;
        const int tn = t + tstep;
        if (tn < T && lane < 8) { e_n = idx[tn * 8 + lane]; g_n = gw[tn * 8 + lane]; s_n = aslot[tn * 8 + lane]; }
        u32x2 w0[9], w1[9];
        { const unsigned char* yr = y + ((size_t)SH_RB * 256 + t) * D; w0[8] = *(const u32x2*)(yr + 8 * lane); w1[8] = *(const u32x2*)(yr + 512 + 8 * lane); }
        float gk[8];
#pragma unroll
        for (int k = 0; k < 8; ++k) { const int e = __shfl(e_c, k), sl = __shfl(s_c, k); gk[k] = __shfl(g_c, k);
            const unsigned char* yr = y + ((size_t)t_rb0[e] * 256 + sl) * D; w0[k] = *(const u32x2*)(yr + 8 * lane); w1[k] = *(const u32x2*)(yr + 512 + 8 * lane); }
        float xv[16]; load_row8_bf((const bf16_t*)(a.ws + WS_XB) + (size_t)t * D, lane, xv);
        float yv[16];
#pragma unroll
        for (int i = 0; i < 16; ++i) yv[i] = 0.f;
        acc_row8(yv, w0[8], w1[8], 0.125f);
#pragma unroll
        for (int k = 0; k < 8; ++k) acc_row8(yv, w0[k], w1[k], gk[k] * 0.125f);
        resid_update8(xv, yv, a.ffn_post_g + l * D, ml + 5 * D, lane);
        if (l == 0) store_row8_bf((bf16_t*)(a.ws + WS_XB) + (size_t)t * D, lane, xv); else store_row8(a.out + (size_t)t * D, lane, xv);
        if (l == 0) { const float* mn = mod + (size_t)(1 * NB + b) * 6 * D; u32x4 o[2]; prenorm_pack8(xv, a.mix_pre_g + D, mn + D, mn, lane, o);
            *(u32x4*)(hb + (size_t)t * D + 8 * lane) = o[0]; *(u32x4*)(hb + (size_t)t * D + 512 + 8 * lane) = o[1]; }
    }
}

constexpr int NPH = 18;
__global__ void __launch_bounds__(NTHR, 2) mega(Args a) {
    extern __shared__ __attribute__((aligned(16))) unsigned char lds_raw[];
    Ctx X; X.lds = (LAS unsigned char*)lds_raw; X.tid = threadIdx.x; X.lane = X.tid & 63; X.wave = __builtin_amdgcn_readfirstlane(X.tid >> 6); X.G = gridDim.x; X.bid = blockIdx.x;
    if (X.tid < 4) ((LAS unsigned*)(X.lds + BAR_OFF))[X.tid] = 0u;
    __syncthreads();
    XcdBarrier bar; bar.bar = (unsigned*)(a.ws + WS_CTL); bar.x = 0; bar.st = nullptr;
    if (!MK_PER_PHASE) bar = xcd_barrier_post((unsigned*)(a.ws + WS_CTL), (volatile LAS unsigned*)(X.lds + BAR_OFF));
    const int lo = a.ph_lo, hi = a.ph_hi;
#define IN(k) (lo <= (k) && (k) < hi)
#define REP(k, ...) do { __VA_ARGS__; if constexpr (((PROBE_MASK >> (k)) & 1u) != 0u) { __syncthreads(); __VA_ARGS__; } } while (0)
#define SEAM(k) do { if (IN(k) && IN((k) + 1)) xcd_barrier(bar); else { VM_WAIT(); __syncthreads(); } } while (0)
    unsigned char* ws = a.ws;
    if (IN(0)) { REP(0, ph_setup(a, X)); SEAM(0); }
    if (IN(1)) { REP(1, ph_prenorm0(a, X)); SEAM(1); }
    if constexpr (((PROBE_MASK >> 24) & 1u) != 0u) { for (int i_ = 0; i_ < 16; ++i_) xcd_barrier(bar); }
    if (IN(2)) {
        pg8::SchedDense S; S.so.init(T, NPROJ, X.G, X.bid); S.A = (const char*)(ws + WS_H); S.Bt = (const char*)(ws + WS_WIN); S.K = D; S.pad_ = 0;
        pg8::EpiProj E{(bf16_t*)(ws + WS_QKVPRE), (bf16_t*)(ws + WS_ZA), (bf16_t*)(ws + WS_XBCPRE), (bf16_t*)(ws + WS_ZB), (float*)(ws + WS_SMALL)};
        REP(2, pg8::gemm_phase<pg8::EpiProj, pg8::SchedDense>(X.lds, D, S, E)); SEAM(2); }
    if (IN(3)) { REP(3, ph_gdn_local(a, X)); REP(20, ph_ssd_local(a, X)); SEAM(3); }
    if (IN(4)) {
        if (X.bid < 32) { REP(4, ph_gdn_scan(a, X)); }
        else { ph_ssd_scan(a, X, 32); group_barrier((unsigned*)(ws + WS_CTL + CTL_GRP), (unsigned)(X.G - 32)); __syncthreads(); ph_ssd_out(a, X, 32); __syncthreads(); ph_moe_conv<2>(a, X, 0, 32); __syncthreads(); ph_setup_late(a, X, 32); }
        SEAM(4); }
    if (IN(6)) {
        pg8::SchedDense S; S.so.init(T, D, X.G, X.bid); S.A = (const char*)(ws + WS_OY); S.Bt = (const char*)(ws + WS_WOUT); S.K = 2048; S.pad_ = 0;
        pg8::EpiBf16 E{(bf16_t*)(ws + WS_YMIX), D, 0};
        REP(6, pg8::gemm_phase<pg8::EpiBf16, pg8::SchedDense>(X.lds, 2048, S, E)); SEAM(6); }
    if (IN(7)) { ph_router(a, X, 0); SEAM(7); }
    if (IN(8)) { REP(8, ph_moe_gu(a, X, 0)); SEAM(8); }
    if (IN(9)) { REP(9, ph_moe_down(a, X, 0)); SEAM(9); }
    if (IN(10)) { ph_combine(a, X, 0); SEAM(10); }
    if (IN(11)) {
        pg8::SchedDense S; S.so.init(T, 3072, X.G, X.bid); S.A = (const char*)(ws + WS_H); S.Bt = (const char*)(ws + WS_WQKV); S.K = D; S.pad_ = 0;
        pg8::EpiQKV E{(bf16_t*)(ws + WS_Q1KV), (const float*)(ws + WS_COS), (const float*)(ws + WS_SIN)};
        REP(11, pg8::gemm_phase<pg8::EpiQKV, pg8::SchedDense>(X.lds, D, S, E)); SEAM(11); }
    if (IN(12)) { REP(12, ph_attn(a, X)); SEAM(12); }
    if (IN(13)) {
        pg8::SchedDense S; S.so.init(T, D, X.G, X.bid); S.A = (const char*)(ws + WS_O1); S.Bt = (const char*)(ws + WS_WO); S.K = D; S.pad_ = 0;
        pg8::EpiBf16 E{(bf16_t*)(ws + WS_YMIX), D, 0};
        REP(13, pg8::gemm_phase<pg8::EpiBf16, pg8::SchedDense>(X.lds, D, S, E)); SEAM(13); }
    if (IN(14)) { ph_router(a, X, 1); REP(14, ph_moe_conv<8>(a, X, 1, 0)); SEAM(14); }
    if (IN(15)) { ph_moe_gu(a, X, 1); SEAM(15); }
    if (IN(16)) { ph_moe_down(a, X, 1); SEAM(16); }
    if (IN(17)) { REP(17, ph_combine(a, X, 1)); }
#undef IN
#undef SEAM
}

extern "C" void kernel_launch(void* const* d_in, const int* in_sizes, int n_in, void* d_out, int out_size, void* d_ws, size_t ws_size, hipStream_t stream) {
    static int grid = 0;
    if (!grid) {
        int dev = 0, cus = 0, per_cu = 0;
        if (hipGetDevice(&dev) != hipSuccess || hipDeviceGetAttribute(&cus, hipDeviceAttributeMultiprocessorCount, dev) != hipSuccess) { fprintf(stderr, "kernel_launch: device query failed\n"); grid = -1; return; }
        if (hipFuncSetAttribute((const void*)mega, hipFuncAttributeMaxDynamicSharedMemorySize, LDS_BYTES) != hipSuccess) { fprintf(stderr, "kernel_launch: hipFuncSetAttribute failed\n"); grid = -1; return; }
        if (hipOccupancyMaxActiveBlocksPerMultiprocessor(&per_cu, (const void*)mega, NTHR, LDS_BYTES) != hipSuccess || per_cu < 1) { fprintf(stderr, "kernel_launch: occupancy query says %d blocks per CU\n", per_cu); grid = -1; return; }
        grid = cus;
        if (grid < 64 || (grid & 7)) { fprintf(stderr, "kernel_launch: unsupported CU count %d\n", cus); grid = -1; return; }
    }
    if (grid < 0) return;
    if (ws_size < WS_END || n_in != 31) { fprintf(stderr, "kernel_launch: workspace %zu < %zu or n_in %d != 31\n", ws_size, (size_t)WS_END, n_in); return; }
    if (hipMemsetAsync((char*)d_ws + WS_CTL, 0, CTL_BYTES, stream) != hipSuccess) { fprintf(stderr, "kernel_launch: memset failed\n"); return; }
    Args a{};
    a.x = (const float*)d_in[0]; a.c = (const float*)d_in[1]; a.pos = (const int*)d_in[2]; a.mod_w = (const float*)d_in[3]; a.mod_b = (const float*)d_in[4];
    a.mix_pre_g = (const float*)d_in[5]; a.mix_post_g = (const float*)d_in[6]; a.ffn_pre_g = (const float*)d_in[7]; a.ffn_post_g = (const float*)d_in[8];
    a.ssm_w_in = (const float*)d_in[9]; a.gdn_conv_w = (const float*)d_in[10]; a.gdn_a_log = (const float*)d_in[11]; a.gdn_dt_bias = (const float*)d_in[12]; a.gdn_norm_w = (const float*)d_in[13];
    a.ssd_conv_w = (const float*)d_in[14]; a.ssd_conv_b = (const float*)d_in[15]; a.ssd_a_log = (const float*)d_in[16]; a.ssd_dt_bias = (const float*)d_in[17]; a.ssd_d = (const float*)d_in[18]; a.ssd_norm_w = (const float*)d_in[19];
    a.ssm_w_out = (const float*)d_in[20]; a.attn_w_qkv = (const float*)d_in[21]; a.attn_w_o = (const float*)d_in[22];
    a.router_w = (const float*)d_in[23]; a.router_bias = (const float*)d_in[24]; a.exp_gate = (const float*)d_in[25]; a.exp_up = (const float*)d_in[26]; a.exp_down = (const float*)d_in[27];
    a.sh_gate = (const float*)d_in[28]; a.sh_up = (const float*)d_in[29]; a.sh_down = (const float*)d_in[30];
    a.out = (float*)d_out; a.ws = (unsigned char*)d_ws;
#if MK_PER_PHASE
    for (int p = 0; p < NPH; ++p) { a.ph_lo = p; a.ph_hi = p + 1; hipLaunchKernelGGL(mega, dim3(grid), dim3(NTHR), LDS_BYTES, stream, a); }
#else
    a.ph_lo = 0; a.ph_hi = NPH;
    hipLaunchKernelGGL(mega, dim3(grid), dim3(NTHR), LDS_BYTES, stream, a);
#endif
}
```

```cpp
#include <hip/hip_runtime.h>
#include <stdint.h>
#include <stdio.h>

#define DEV __device__ __forceinline__
#define LAS __attribute__((address_space(3)))
typedef unsigned short bf16_t;
typedef short bf16x8 __attribute__((ext_vector_type(8)));
typedef float f32x4 __attribute__((ext_vector_type(4)));
typedef float f32x2 __attribute__((ext_vector_type(2)));
typedef unsigned u32x4 __attribute__((ext_vector_type(4)));
typedef unsigned u32x2 __attribute__((ext_vector_type(2)));
typedef float f32x16 __attribute__((ext_vector_type(16)));
typedef short s16x4 __attribute__((ext_vector_type(4)));

#ifndef PROBE_MASK
#define PROBE_MASK 0u
#endif
#ifndef MK_PER_PHASE
#define MK_PER_PHASE 0
#endif

constexpr int NB = 4, SEQ = 4096, T = NB * SEQ, D = 1024;
constexpr int PROJ = 6688, NPROJ = 6912;
constexpr int C_BETA = 4096, C_XBC = 4112, C_ZB = 5648, C_DT = 6672;
constexpr int NE = 64, TOPK = 8, ED = 256, CAP = 16384;
constexpr int SH_RB = 576;
constexpr int NRB_ALL = SH_RB + 64;
constexpr float EPS = 1e-6f;
constexpr int NTHR = 512, NWAVES = 8;
constexpr int LDS_BYTES = 163840;
constexpr int AUX_OFF = 131072;
constexpr int BAR_OFF = LDS_BYTES - 16;

constexpr size_t MiB = 1u << 20;
constexpr size_t WS_CTL = 0, CTL_BYTES = 65536;
constexpr size_t CTL_CNT = 16384;
constexpr size_t CTL_GRP = 20480;
constexpr size_t WS_MOD = 65536;
constexpr size_t WS_COS = 1 * MiB, WS_SIN = 3 * MiB;
constexpr size_t WS_IDX = 5 * MiB, WS_GW = 5 * MiB + 512 * 1024, WS_ASLOT = 6 * MiB, WS_LTOK = 6 * MiB + 512 * 1024;
constexpr size_t WS_SMALL = 11 * MiB;
constexpr size_t WS_WIN = 16 * MiB, WS_WOUT = 30 * MiB, WS_WQKV = 34 * MiB, WS_WO = 40 * MiB;
constexpr size_t WS_H = 44 * MiB;
constexpr size_t WS_QKVPRE = 78 * MiB, WS_XBCPRE = 174 * MiB, WS_ZA = 222 * MiB, WS_ZB = 254 * MiB;
constexpr size_t WS_CC = 16 * MiB, WS_ACUM = 25 * MiB, WS_CDEC = 26 * MiB, WS_YDIAG = 44 * MiB, WS_STATES = 430 * MiB;
constexpr size_t WS_GI = 286 * MiB, GI_UNIT = 73728, WS_GTMP = 462 * MiB, WS_GLAST = 27 * MiB;
constexpr size_t WS_OY = 78 * MiB, WS_YMIX = 286 * MiB, WS_XB = 240 * MiB;
constexpr size_t WS_WD = 478 * MiB, WS_WDS = 510 * MiB + 512 * 1024, WS_HID = 398 * MiB, WS_Y = 78 * MiB, WS_WGU = 142 * MiB, WS_WGUS = 207 * MiB;
constexpr size_t WS_Q1KV = 78 * MiB, WS_O1 = 174 * MiB, WS_PO = 350 * MiB, WS_PLSE = 446 * MiB;
constexpr size_t WS_END = 512 * MiB;

struct Args {
    const float* x; const float* c; const int* pos; const float* mod_w; const float* mod_b;
    const float* mix_pre_g; const float* mix_post_g; const float* ffn_pre_g; const float* ffn_post_g;
    const float* ssm_w_in; const float* gdn_conv_w; const float* gdn_a_log; const float* gdn_dt_bias; const float* gdn_norm_w;
    const float* ssd_conv_w; const float* ssd_conv_b; const float* ssd_a_log; const float* ssd_dt_bias; const float* ssd_d; const float* ssd_norm_w;
    const float* ssm_w_out; const float* attn_w_qkv; const float* attn_w_o;
    const float* router_w; const float* router_bias; const float* exp_gate; const float* exp_up; const float* exp_down;
    const float* sh_gate; const float* sh_up; const float* sh_down;
    float* out; unsigned char* ws; int ph_lo, ph_hi;
};

DEV float bf2f(bf16_t v) { return __uint_as_float(((unsigned)v) << 16); }
DEV unsigned f2bf(float f) { unsigned u = __float_as_uint(f); return (u + 0x7FFFu + ((u >> 16) & 1u)) >> 16; }
DEV unsigned pk2(float lo, float hi) { return f2bf(lo) | (f2bf(hi) << 16); }
DEV float wave_sum(float v) {
#pragma unroll
    for (int o = 32; o > 0; o >>= 1) v += __shfl_xor(v, o);
    return v;
}
DEV float siluf(float x) { return x / (1.f + __expf(-x)); }
DEV float sigmoidf_(float x) { return 1.f / (1.f + __expf(-x)); }
DEV float softplusf(float x) { return fmaxf(x, 0.f) + log1pf(__expf(-fabsf(x))); }
#define LDS_WAIT() asm volatile("s_waitcnt lgkmcnt(0)" ::: "memory")
#define VM_WAIT() asm volatile("s_waitcnt vmcnt(0)" ::: "memory")

#define XB_TMO      128
#define XB_XCNT(j)  (256  + 64 * (j))
#define XB_XSUB(j)  (1280 + 64 * (j))
#define XB_XGEN(j)  (2304 + 64 * (j))
#define XB_TOP      3328
#define XB_TOPGEN   3392
#define XCD_BAR_WORDS 3456
#define XB_SPIN_CAP (1u << 18)
#define LAS __attribute__((address_space(3)))

__device__ __forceinline__ unsigned xb_ld(unsigned* p)              { return __hip_atomic_load(p, __ATOMIC_RELAXED, __HIP_MEMORY_SCOPE_AGENT); }
__device__ __forceinline__ unsigned xb_add(unsigned* p, unsigned v) { return __hip_atomic_fetch_add(p, v, __ATOMIC_RELAXED, __HIP_MEMORY_SCOPE_AGENT); }
__device__ __forceinline__ unsigned xb_xcc_id() { return (unsigned)__builtin_amdgcn_s_getreg((3 << 11) | 20) & 0xFu; }
#define XB_SPIN(cond, bar) do { unsigned _sp = 0; while (cond) { __builtin_amdgcn_s_sleep(1); \
    if ((++_sp & 255u) == 0u) { if (xb_ld(&(bar)[XB_TMO])) break; if (_sp > XB_SPIN_CAP) { atomicAdd(&(bar)[XB_TMO], 1u); break; } } } } while (0)

struct XcdBarrier {
    unsigned* bar; unsigned x;
    volatile LAS unsigned* st;
};

__device__ __forceinline__ XcdBarrier xcd_barrier_post(unsigned* bar, volatile LAS unsigned* st) {
    XcdBarrier b; b.bar = bar; b.x = xb_xcc_id(); b.st = st;
    if (threadIdx.x == 0) (void)xb_add(&bar[XB_XCNT(b.x)], 1u);
    return b;
}
__device__ __forceinline__ void xcd_barrier_complete(unsigned* bar, unsigned x, unsigned& nloc, unsigned& nx) {
    const unsigned G = gridDim.x * gridDim.y * gridDim.z;
    unsigned sum, cnt, mine, sp = 0u;
    for (;;) {
        sum = 0u; cnt = 0u; mine = 0u;
#pragma unroll
        for (unsigned j = 0; j < 16; ++j) { const unsigned c = xb_ld(&bar[XB_XCNT(j)]); sum += c; cnt += (c > 0u) ? 1u : 0u; mine = (j == x) ? c : mine; }
        if (sum == G) break;
        __builtin_amdgcn_s_sleep(1);
        if ((++sp & 255u) == 0u) { if (xb_ld(&bar[XB_TMO])) break; if (sp > XB_SPIN_CAP) { atomicAdd(&bar[XB_TMO], 1u); break; } }
    }
    nloc = mine > 0u ? mine : 1u; nx = cnt > 0u ? cnt : 1u;
}

__device__ __forceinline__ void xcd_barrier(const XcdBarrier& b) {
    asm volatile("s_waitcnt vmcnt(0)" ::: "memory");
    __syncthreads();
    if (threadIdx.x == 0) {
        unsigned* bar = b.bar;
        __builtin_amdgcn_s_waitcnt(0);
        unsigned nloc = b.st[0], nx = b.st[1];
        if (nloc == 0u) { xcd_barrier_complete(bar, b.x, nloc, nx); b.st[0] = nloc; b.st[1] = nx; }
        const unsigned old = xb_add(&bar[XB_XSUB(b.x)], 1u);
        const unsigned gen = old / nloc;
        if (old + 1u == (gen + 1u) * nloc) {
            __builtin_amdgcn_fence(__ATOMIC_RELEASE, "agent");
            asm volatile("s_waitcnt vmcnt(0)" ::: "memory");
            const unsigned og = xb_add(&bar[XB_TOP], 1u);
            const unsigned tg = og / nx;
            if (og + 1u == (tg + 1u) * nx) xb_add(&bar[XB_TOPGEN], 1u);
            else XB_SPIN(xb_ld(&bar[XB_TOPGEN]) == tg, bar);
            __builtin_amdgcn_fence(__ATOMIC_ACQUIRE, "agent");
            xb_add(&bar[XB_XGEN(b.x)], 1u);
            asm volatile("s_waitcnt vmcnt(0)" ::: "memory");
        } else {
            XB_SPIN(xb_ld(&bar[XB_XGEN(b.x)]) == gen, bar);
            __builtin_amdgcn_fence(__ATOMIC_ACQUIRE, "agent");
            asm volatile("s_waitcnt vmcnt(0)" ::: "memory");
        }
    }
    __syncthreads();
}


DEV void group_barrier(unsigned* ctr, const unsigned n) {
    asm volatile("s_waitcnt vmcnt(0)" ::: "memory");
    __syncthreads();
    if (threadIdx.x == 0) {
        __builtin_amdgcn_fence(__ATOMIC_RELEASE, "agent");
        asm volatile("s_waitcnt vmcnt(0)" ::: "memory");
        (void)__hip_atomic_fetch_add(ctr, 1u, __ATOMIC_RELAXED, __HIP_MEMORY_SCOPE_AGENT);
        unsigned sp = 0;
        while (__hip_atomic_load(ctr, __ATOMIC_RELAXED, __HIP_MEMORY_SCOPE_AGENT) < n) { __builtin_amdgcn_s_sleep(2); if (++sp > (1u << 22)) break; }
        __builtin_amdgcn_fence(__ATOMIC_ACQUIRE, "agent");
        asm volatile("s_waitcnt vmcnt(0)" ::: "memory");
    }
    __syncthreads();
}

namespace pg8 {
constexpr int BM = 256, BK = 64, HALF = 128, HTB = HALF * BK * 2, STAGE_BYTES = 8 * HTB, NXCD = 8, WGM = 8;
DEV int lds_byte(int r, int c) { const int st = (r >> 4) * 2 + (c >> 5), rr = r & 15, cc = c & 31, ob = rr * 64 + cc * 2; return st * 1024 + (ob ^ (((ob >> 9) & 1) << 5)); }
DEV void stage_rc(int b, int& R, int& C) { const int st = b / 1024, sb = b % 1024, swz = sb ^ (((sb >> 9) & 1) << 5); R = (st >> 1) * 16 + swz / 64; C = (st & 1) * 32 + (swz % 64) / 2; }
DEV int perm32(int rho) { const int n = rho >> 4, i = rho & 15; return 8 * (i >> 2) + 4 * n + (i & 3); }
struct Unit { int pm, pn, e, slot; };
struct StaticOrder {
    int nM, nN, nwg, G, c;
    DEV void init(int M, int N, int G_, int c_) { nM = M / BM; nN = N / BM; nwg = nM * nN; G = G_; c = c_; }
    DEV bool next(int i, int& pm, int& pn) const {
        const long L = (long)i * G + c; if (L >= nwg) return false;
        int wgid = (int)L; { const int q = nwg / NXCD, r = nwg % NXCD, xcd = wgid % NXCD, off = wgid / NXCD; wgid = (xcd < r ? xcd * (q + 1) : r * (q + 1) + (xcd - r) * q) + off; }
        const int nig = WGM * nN, gid = wgid / nig, fm = gid * WGM, gsz = (nM - fm) < WGM ? (nM - fm) : WGM;
        pm = fm + ((wgid % nig) % gsz); pn = (wgid % nig) / gsz; return true;
    }
};
typedef __bf16 bf16x2_t __attribute__((ext_vector_type(2)));
DEV unsigned cvt_pk_bf16(float lo, float hi) { const bf16x2_t v = {(__bf16)lo, (__bf16)hi}; return __builtin_bit_cast(unsigned, v); }
DEV u32x4 pack8(const f32x4 a, const f32x4 b) { u32x4 w; w.x = cvt_pk_bf16(a[0], a[1]); w.y = cvt_pk_bf16(a[2], a[3]); w.z = cvt_pk_bf16(b[0], b[1]); w.w = cvt_pk_bf16(b[2], b[3]); return w; }

typedef int v8i_t __attribute__((ext_vector_type(8)));
template <class Epi, class Sched, bool F8 = false>
DEV void gemm_phase(LAS unsigned char* lds, const int K, const Sched& S, const Epi& E) {
    const int tid = threadIdx.x, wid = __builtin_amdgcn_readfirstlane(tid >> 6), lane = tid & 63, wr = wid >> 2, wc = wid & 3, fr = lane & 15, fq = lane >> 4;
    const int nt = F8 ? K / 128 : K / BK;
    const int pitch = F8 ? K : 2 * K;
    unsigned voffB[2];
#pragma unroll
    for (int i = 0; i < 2; ++i) { int R, C; stage_rc(tid * 16 + i * 8192, R, C); const int Rb = Epi::PERM ? ((R & ~31) + perm32(R & 31)) : R; voffB[i] = (unsigned)(Rb * pitch + 2 * C); }
    const unsigned kstep = (unsigned)(BK * 2);
    const size_t hstep = (size_t)HALF * pitch;
    const unsigned ldsw = (unsigned)wid * 1024u;
    const int aoff = lds_byte(wr * 64 + fr, fq * 8), boff = lds_byte(wc * 32 + fr, fq * 8);
    const size_t hsA = Sched::GATHER ? (size_t)0 : hstep;
#define PG8_SA(b, h) (((b) * 2 + (h)) * HTB)
#define PG8_SB(b, h) ((4 + (b) * 2 + (h)) * HTB)
#define PG8_STAGEB(bufoff, gbase) do { _Pragma("unroll") for (int _i = 0; _i < 2; ++_i) \
        __builtin_amdgcn_global_load_lds((const unsigned*)((const char*)(gbase) + voffB[_i]), (LAS unsigned*)(lds + (bufoff) + ldsw + _i * 8192), 16, 0, 0); } while (0)
#define PG8_STAGEA(bufoff, gbase, VO) do { _Pragma("unroll") for (int _i = 0; _i < 2; ++_i) \
        __builtin_amdgcn_global_load_lds((const unsigned*)((const char*)(gbase) + (VO)[_i]), (LAS unsigned*)(lds + (bufoff) + ldsw + _i * 8192), 16, 0, 0); } while (0)
#define PG8_LD8(var, base) do { const u32x4 _l0 = *(const LAS u32x4*)(lds + (base)), _l1 = *(const LAS u32x4*)(lds + (base) + 1024); var = __builtin_shufflevector(_l0, _l1, 0, 1, 2, 3, 4, 5, 6, 7); } while (0)
#define PG8_LDA(dst, b, h) do { if constexpr (F8) { PG8_LD8(dst##8_0, PG8_SA(b, h) + aoff); PG8_LD8(dst##8_1, PG8_SA(b, h) + aoff + 2048); PG8_LD8(dst##8_2, PG8_SA(b, h) + aoff + 4096); PG8_LD8(dst##8_3, PG8_SA(b, h) + aoff + 6144); } \
        else { _Pragma("unroll") for (int m = 0; m < 4; ++m) _Pragma("unroll") for (int k = 0; k < 2; ++k) dst[m][k] = *(const LAS bf16x8*)(lds + PG8_SA(b, h) + aoff + m * 2048 + k * 1024); } } while (0)
#define PG8_LDB(dst, b, h) do { if constexpr (F8) { PG8_LD8(dst##8_0, PG8_SB(b, h) + boff); PG8_LD8(dst##8_1, PG8_SB(b, h) + boff + 2048); } \
        else { _Pragma("unroll") for (int n = 0; n < 2; ++n) _Pragma("unroll") for (int k = 0; k < 2; ++k) dst[n][k] = *(const LAS bf16x8*)(lds + PG8_SB(b, h) + boff + n * 2048 + k * 1024); } } while (0)
#define PG8_M8(ai, bj, m, n, A8, B8) asm volatile("v_mfma_scale_f32_16x16x128_f8f6f4 %0, %1, %2, %0, %3, %4 op_sel_hi:[0,0,0]" : "+v"(acc[ai][bj][m][n]) : "v"(B8), "v"(A8), "v"(wsc_), "v"(asc_))
#define PG8_MMA(ai, bj, At, Bt) do { __builtin_amdgcn_s_setprio(1); \
        if constexpr (F8) { PG8_M8(ai, bj, 0, 0, At##8_0, Bt##8_0); PG8_M8(ai, bj, 0, 1, At##8_0, Bt##8_1); PG8_M8(ai, bj, 1, 0, At##8_1, Bt##8_0); PG8_M8(ai, bj, 1, 1, At##8_1, Bt##8_1); \
                            PG8_M8(ai, bj, 2, 0, At##8_2, Bt##8_0); PG8_M8(ai, bj, 2, 1, At##8_2, Bt##8_1); PG8_M8(ai, bj, 3, 0, At##8_3, Bt##8_0); PG8_M8(ai, bj, 3, 1, At##8_3, Bt##8_1); } \
        else { _Pragma("unroll") for (int m = 0; m < 4; ++m) _Pragma("unroll") for (int n = 0; n < 2; ++n) _Pragma("unroll") for (int k = 0; k < 2; ++k) acc[ai][bj][m][n] = __builtin_amdgcn_mfma_f32_16x16x32_bf16(Bt[n][k], At[m][k], acc[ai][bj][m][n], 0, 0, 0); } \
        __builtin_amdgcn_s_setprio(0); } while (0)
#define PG8_WAIT_V(n) asm volatile("s_waitcnt vmcnt(" #n ")" ::: "memory")
#define PG8_WAIT_L(n) asm volatile("s_waitcnt lgkmcnt(" #n ")" ::: "memory")
#define PG8_BAR __builtin_amdgcn_s_barrier()
#define PG8_SCHED __builtin_amdgcn_sched_barrier(0)
    Unit cur, nxt; int ui = 0;
    if (!S.next(0, cur)) return;
    f32x4 acc[2][2][4][2];
#pragma unroll
    for (int a = 0; a < 2; ++a)
#pragma unroll
        for (int b = 0; b < 2; ++b)
#pragma unroll
            for (int m = 0; m < 4; ++m)
#pragma unroll
                for (int n = 0; n < 2; ++n) acc[a][b][m][n] = (f32x4){0.f, 0.f, 0.f, 0.f};
    bf16x8 At[4][2], B0[2][2], B1[2][2];
    typedef unsigned u32x8_t __attribute__((ext_vector_type(8)));
    u32x8_t At8_0, At8_1, At8_2, At8_3, B08_0, B08_1, B18_0, B18_1;
    const int wsc_ = Sched::WSCALE, asc_ = Sched::ASCALE;
    unsigned va[2][2];
    S.a_voff(cur, tid, va);
    const char* cA = S.a_ptr(cur);
    const char* cB = S.b_ptr(cur);
    PG8_STAGEB(PG8_SB(0, 0), cB); PG8_STAGEB(PG8_SB(0, 1), cB + hstep); PG8_STAGEA(PG8_SA(0, 0), cA, va[0]); PG8_STAGEA(PG8_SA(0, 1), cA + hsA, va[1]);
    if (wr == 1) PG8_BAR;
    PG8_WAIT_V(2); PG8_BAR;
    PG8_STAGEB(PG8_SB(1, 0), cB + kstep); PG8_STAGEA(PG8_SA(1, 0), cA + kstep, va[0]); PG8_STAGEB(PG8_SB(1, 1), cB + hstep + kstep);
    PG8_WAIT_V(6); PG8_BAR;
    for (;;) {
        const bool has_next = S.next(ui + 1, nxt);
        const char* nB = has_next ? S.b_ptr(nxt) : cB;
        const char* nA = has_next ? S.a_ptr(nxt) : cA;
        for (int t = 0; t < nt; t += 2) {
            const bool last = (t == nt - 2);
            const char* a1 = cA + (size_t)(t + 1) * kstep;
            const char* a2 = last ? nA : cA + (size_t)(t + 2) * kstep; const char* a3 = a2 + kstep;
            unsigned v2[2][2];
            v2[0][0] = va[0][0]; v2[0][1] = va[0][1]; v2[1][0] = va[1][0]; v2[1][1] = va[1][1];
            if constexpr (Sched::GATHER) { if (last && has_next) S.a_voff(nxt, tid, v2); }
            const char* b2 = last ? nB : cB + (size_t)(t + 2) * kstep; const char* b3 = b2 + kstep;
            PG8_LDB(B0, 0, 0); PG8_LDB(B1, 0, 1); PG8_SCHED; PG8_LDA(At, 0, 0); PG8_STAGEA(PG8_SA(1, 1), a1 + hsA, va[1]);
            PG8_WAIT_V(8); PG8_WAIT_L(0); PG8_BAR; PG8_MMA(0, 0, At, B0); PG8_MMA(0, 1, At, B1); PG8_BAR; PG8_SCHED;
            PG8_LDA(At, 0, 1); PG8_STAGEB(PG8_SB(0, 0), b2); PG8_STAGEB(PG8_SB(0, 1), b2 + hstep); PG8_STAGEA(PG8_SA(0, 0), a2, v2[0]);
            PG8_WAIT_V(8); PG8_WAIT_L(0); PG8_BAR; PG8_MMA(1, 0, At, B0); PG8_MMA(1, 1, At, B1); PG8_BAR; PG8_SCHED;
            PG8_LDB(B0, 1, 0); PG8_LDB(B1, 1, 1); PG8_SCHED; PG8_LDA(At, 1, 0); PG8_STAGEA(PG8_SA(0, 1), a2 + hsA, v2[1]);
            PG8_WAIT_V(8); PG8_WAIT_L(0); PG8_BAR; PG8_MMA(0, 0, At, B0); PG8_MMA(0, 1, At, B1); PG8_BAR; PG8_SCHED;
            PG8_LDA(At, 1, 1); PG8_STAGEB(PG8_SB(1, 0), b3); PG8_STAGEB(PG8_SB(1, 1), b3 + hstep); PG8_STAGEA(PG8_SA(1, 0), a3, v2[0]);
            PG8_WAIT_V(8); PG8_WAIT_L(0); PG8_BAR; PG8_MMA(1, 0, At, B0); PG8_MMA(1, 1, At, B1); PG8_BAR; PG8_SCHED;
        }
        if (wr == 0) PG8_BAR;
        if constexpr (F8) asm volatile("s_nop 15\n\ts_nop 15" ::: "memory");
        E(acc, cur, wr, wc, fr, fq);
        if (!has_next) break;
#pragma unroll
        for (int a = 0; a < 2; ++a)
#pragma unroll
            for (int b = 0; b < 2; ++b)
#pragma unroll
                for (int m = 0; m < 4; ++m)
#pragma unroll
                    for (int n = 0; n < 2; ++n) acc[a][b][m][n] = (f32x4){0.f, 0.f, 0.f, 0.f};
        cur = nxt; cB = nB; cA = nA; ++ui;
        if constexpr (Sched::GATHER) S.a_voff(cur, tid, va);
        if (wr == 1) PG8_BAR;
    }
    PG8_WAIT_V(0);
    PG8_BAR;
#undef PG8_SA
#undef PG8_SB
#undef PG8_STAGEA
#undef PG8_STAGEB
#undef PG8_LDA
#undef PG8_LD8
#undef PG8_M8
#undef PG8_LDB
#undef PG8_MMA
#undef PG8_WAIT_V
#undef PG8_WAIT_L
#undef PG8_BAR
#undef PG8_SCHED
}

struct SchedDense {
    static constexpr bool GATHER = false; static constexpr int WSCALE = 0x7F7F7F7F, ASCALE = 0x7F7F7F7F;
    StaticOrder so; const char* A; const char* Bt; int K; int pad_;
    DEV bool next(int i, Unit& u) const { int pm, pn; if (!so.next(i, pm, pn)) return false; u.pm = pm; u.pn = pn; u.e = 0; u.slot = 0; return true; }
    DEV const char* a_ptr(const Unit& u) const { return A + (size_t)u.pm * 256 * K * 2; }
    DEV void a_voff(const Unit&, const int tid, unsigned (&vo)[2][2]) const {
#pragma unroll
        for (int i = 0; i < 2; ++i) { int R, C; stage_rc(tid * 16 + i * 8192, R, C); vo[0][i] = vo[1][i] = (unsigned)((R * K + C) * 2); }
    }
    DEV const char* b_ptr(const Unit& u) const { return Bt + (size_t)u.pn * 256 * K * 2; }
};
template <int WS_, int AS_> struct SchedDense8 {
    static constexpr bool GATHER = false; static constexpr int WSCALE = WS_, ASCALE = AS_;
    StaticOrder so; const char* A; const char* Bt; int K; int pad_;
    DEV bool next(int i, Unit& u) const { int pm, pn; if (!so.next(i, pm, pn)) return false; u.pm = pm; u.pn = pn; u.e = 0; u.slot = 0; return true; }
    DEV const char* a_ptr(const Unit& u) const { return A + (size_t)u.pm * 256 * K; }
    DEV void a_voff(const Unit&, const int tid, unsigned (&vo)[2][2]) const {
#pragma unroll
        for (int i = 0; i < 2; ++i) { int R, C; stage_rc(tid * 16 + i * 8192, R, C); vo[0][i] = vo[1][i] = (unsigned)(R * K + 2 * C); }
    }
    DEV const char* b_ptr(const Unit& u) const { return Bt + (size_t)u.pn * 256 * K; }
};
DEV bool moe_unit(int i, int NJ, int nrbt, int G, int c, Unit& u) {
    const int n = (nrbt + 64) * NJ; int L;
    if (G & 7) { L = i * G + c; if (L >= n) return false; }
    else { const int gq = G >> 3, per = (n + 7) >> 3, x = c & 7, q = c >> 3, j = i * gq + q; if (j >= per) return false; L = x * per + j; if (L >= n) return false; }
    int grb = L / NJ; const int pn = L - grb * NJ; if (grb >= nrbt) grb = SH_RB + (grb - nrbt);
    u.pm = grb; u.pn = pn; u.slot = i; u.e = 0; return true;
}
struct SchedGU {
    static constexpr bool GATHER = true; static constexpr int WSCALE = 0x79797979, ASCALE = 0x7F7F7F7F;
    const char* A; const char* Wgu; const char* Wgus; const LAS int* eofrb; const LAS int* toks; int nrbt, G, c, pad_;
    DEV bool next(int i, Unit& u) const { if (!moe_unit(i, 2, nrbt, G, c, u)) return false; u.e = __builtin_amdgcn_readfirstlane(eofrb[u.pm]); return true; }
    DEV const char* a_ptr(const Unit&) const { return A; }
    DEV void a_voff(const Unit& u, const int tid, unsigned (&vo)[2][2]) const {
#pragma unroll
        for (int i = 0; i < 2; ++i) { int R, C; stage_rc(tid * 16 + i * 8192, R, C);
#pragma unroll
            for (int h = 0; h < 2; ++h) { const int tok = toks[u.slot * 256 + h * 128 + R]; vo[h][i] = (unsigned)(tok * D + 2 * C); } }
    }
    DEV const char* b_ptr(const Unit& u) const { return (u.e < NE ? Wgu + (size_t)u.e * 512 * D : Wgus) + (size_t)u.pn * 256 * D; }
};
struct SchedDown {
    static constexpr bool GATHER = false; static constexpr int WSCALE = 0x7A7A7A7A, ASCALE = 0x7F7F7F7F;
    const char* A; const char* Wd; const char* Wds; const LAS int* eofrb; int nrbt, G, c, pad_;
    DEV bool next(int i, Unit& u) const { if (!moe_unit(i, 4, nrbt, G, c, u)) return false; u.e = __builtin_amdgcn_readfirstlane(eofrb[u.pm]); return true; }
    DEV const char* a_ptr(const Unit& u) const { return A + (size_t)u.pm * 256 * ED; }
    DEV void a_voff(const Unit&, const int tid, unsigned (&vo)[2][2]) const {
#pragma unroll
        for (int i = 0; i < 2; ++i) { int R, C; stage_rc(tid * 16 + i * 8192, R, C); vo[0][i] = vo[1][i] = (unsigned)(R * ED + 2 * C); }
    }
    DEV const char* b_ptr(const Unit& u) const { return (u.e < NE ? Wd + (size_t)u.e * D * ED : Wds) + (size_t)u.pn * 256 * ED; }
};

struct EpiProj {
    static constexpr bool PERM = true;
    bf16_t* qkv; bf16_t* za; bf16_t* xbc; bf16_t* zb; float* small;
    DEV void operator()(const f32x4 (&acc)[2][2][4][2], const Unit& u, int wr, int wc, int fr, int fq) const {
        const int row0 = u.pm * BM + wr * 64 + fr, pn = u.pn;
        if (pn == 26) {
            if (wc == 0) {
#pragma unroll
                for (int ai = 0; ai < 2; ++ai)
#pragma unroll
                    for (int m = 0; m < 4; ++m) { float* p = small + (size_t)(row0 + ai * HALF + m * 16) * 32 + 8 * fq; *(f32x4*)p = acc[ai][0][m][0]; *(f32x4*)(p + 4) = acc[ai][0][m][1]; }
            }
            return;
        }
        bf16_t* base; int ldc, ct;
        if (pn < 12) { base = qkv; ldc = 3072; ct = pn; } else if (pn < 16) { base = za; ldc = 1024; ct = pn - 12; } else if (pn < 22) { base = xbc; ldc = 1536; ct = pn - 16; } else { base = zb; ldc = 1024; ct = pn - 22; }
        const int col0 = ct * 256 + wc * 32 + 8 * fq;
#pragma unroll
        for (int ai = 0; ai < 2; ++ai)
#pragma unroll
            for (int m = 0; m < 4; ++m) { bf16_t* rowp = base + (size_t)(row0 + ai * HALF + m * 16) * ldc + col0;
#pragma unroll
                for (int bj = 0; bj < 2; ++bj) *(u32x4*)(rowp + bj * HALF) = pack8(acc[ai][bj][m][0], acc[ai][bj][m][1]); }
    }
};
struct EpiF32 {
    static constexpr bool PERM = false;
    float* Cp; int ldc; int pad_;
    DEV void operator()(const f32x4 (&acc)[2][2][4][2], const Unit& u, int wr, int wc, int fr, int fq) const {
        const int row0 = u.pm * BM + wr * 64 + fr, col0 = u.pn * BM + wc * 32 + 4 * fq;
#pragma unroll
        for (int ai = 0; ai < 2; ++ai)
#pragma unroll
            for (int m = 0; m < 4; ++m) { float* rowp = Cp + (size_t)(row0 + ai * HALF + m * 16) * ldc + col0;
#pragma unroll
                for (int bj = 0; bj < 2; ++bj)
#pragma unroll
                    for (int n = 0; n < 2; ++n) *(f32x4*)(rowp + bj * HALF + n * 16) = acc[ai][bj][m][n]; }
    }
};
struct EpiBf16 {
    static constexpr bool PERM = true;
    bf16_t* O; int ldc; int pad_;
    DEV void operator()(const f32x4 (&acc)[2][2][4][2], const Unit& u, int wr, int wc, int fr, int fq) const {
        const int row0 = u.pm * BM + wr * 64 + fr, col0 = u.pn * BM + wc * 32 + 8 * fq;
#pragma unroll
        for (int ai = 0; ai < 2; ++ai)
#pragma unroll
            for (int m = 0; m < 4; ++m) { bf16_t* rowp = O + (size_t)(row0 + ai * HALF + m * 16) * ldc + col0;
#pragma unroll
                for (int bj = 0; bj < 2; ++bj) *(u32x4*)(rowp + bj * HALF) = pack8(acc[ai][bj][m][0], acc[ai][bj][m][1]); }
    }
};
DEV u32x2 pack8_fp8(const f32x4 a, const f32x4 b) {
    f32x4 x = a, y = b;
#pragma unroll
    for (int i = 0; i < 4; ++i) { x[i] = fminf(fmaxf(x[i], -440.f), 440.f); y[i] = fminf(fmaxf(y[i], -440.f), 440.f); }
    int w0 = __builtin_amdgcn_cvt_pk_fp8_f32(x[0], x[1], 0, false); w0 = __builtin_amdgcn_cvt_pk_fp8_f32(x[2], x[3], w0, true);
    int w1 = __builtin_amdgcn_cvt_pk_fp8_f32(y[0], y[1], 0, false); w1 = __builtin_amdgcn_cvt_pk_fp8_f32(y[2], y[3], w1, true);
    return (u32x2){(unsigned)w0, (unsigned)w1};
}
struct EpiFp8 {
    static constexpr bool PERM = true;
    unsigned char* O; int ldc; int pad_;
    DEV void operator()(const f32x4 (&acc)[2][2][4][2], const Unit& u, int wr, int wc, int fr, int fq) const {
        const int row0 = u.pm * BM + wr * 64 + fr, col0 = u.pn * BM + wc * 32 + 8 * fq;
#pragma unroll
        for (int ai = 0; ai < 2; ++ai)
#pragma unroll
            for (int m = 0; m < 4; ++m) { unsigned char* rowp = O + (size_t)(row0 + ai * HALF + m * 16) * ldc + col0;
#pragma unroll
                for (int bj = 0; bj < 2; ++bj) { f32x4 a0 = acc[ai][bj][m][0] * 8.f, a1 = acc[ai][bj][m][1] * 8.f;
#pragma unroll
                    for (int i = 0; i < 4; ++i) { a0[i] = fminf(fmaxf(a0[i], -440.f), 440.f); a1[i] = fminf(fmaxf(a1[i], -440.f), 440.f); }
                    int w0 = __builtin_amdgcn_cvt_pk_fp8_f32(a0[0], a0[1], 0, false); w0 = __builtin_amdgcn_cvt_pk_fp8_f32(a0[2], a0[3], w0, true);
                    int w1 = __builtin_amdgcn_cvt_pk_fp8_f32(a1[0], a1[1], 0, false); w1 = __builtin_amdgcn_cvt_pk_fp8_f32(a1[2], a1[3], w1, true);
                    *(u32x2*)(rowp + bj * HALF) = (u32x2){(unsigned)w0, (unsigned)w1}; } }
    }
};
struct EpiGU {
    static constexpr bool PERM = true;
    unsigned char* H;
    DEV void operator()(const f32x4 (&acc)[2][2][4][2], const Unit& u, int wr, int wc, int fr, int fq) const {
        const int row0 = u.pm * BM + wr * 64 + fr, col0 = u.pn * HALF + wc * 32 + 8 * fq;
#pragma unroll
        for (int ai = 0; ai < 2; ++ai)
#pragma unroll
            for (int m = 0; m < 4; ++m) {
                f32x4 h0, h1;
#pragma unroll
                for (int i = 0; i < 4; ++i) { h0[i] = siluf(acc[ai][0][m][0][i]) * acc[ai][1][m][0][i]; h1[i] = siluf(acc[ai][0][m][1][i]) * acc[ai][1][m][1][i]; }
                *(u32x2*)(H + (size_t)(row0 + ai * HALF + m * 16) * ED + col0) = pack8_fp8(h0, h1);
            }
    }
};
struct EpiQKV {
    static constexpr bool PERM = true;
    bf16_t* O; const float* cosT; const float* sinT;
    DEV void operator()(const f32x4 (&acc)[2][2][4][2], const Unit& u, int wr, int wc, int fr, int fq) const {
        const int row0 = u.pm * BM + wr * 64 + fr, col0 = u.pn * BM + wc * 32 + 8 * fq;
        const bool rope = u.pn < 8; const float qs = u.pn < 4 ? 0.125f : 1.f;
#pragma unroll
        for (int ai = 0; ai < 2; ++ai)
#pragma unroll
            for (int m = 0; m < 4; ++m) {
                const int row = row0 + ai * HALF + m * 16;
                bf16_t* rowp = O + (size_t)row * 3072 + col0;
                if (rope) {
                    const f32x4 cs = *(const f32x4*)(cosT + (size_t)row * 32 + 16 * (wc & 1) + 4 * fq), sn = *(const f32x4*)(sinT + (size_t)row * 32 + 16 * (wc & 1) + 4 * fq);
#pragma unroll
                    for (int bj = 0; bj < 2; ++bj) { const f32x4 x1 = acc[ai][bj][m][0], x2 = acc[ai][bj][m][1];
                        *(u32x4*)(rowp + bj * HALF) = pack8((x1 * cs - x2 * sn) * qs, (x2 * cs + x1 * sn) * qs); }
                } else {
#pragma unroll
                    for (int bj = 0; bj < 2; ++bj) *(u32x4*)(rowp + bj * HALF) = pack8(acc[ai][bj][m][0], acc[ai][bj][m][1]);
                }
            }
    }
};
}

template <class SrcF, bool OUT8 = false>
DEV void conv_item(const SrcF& src, int ldw, int K, void* dstv, LAS float* scr, int item, int nblk, int lane, const float wscale = 1.f) {
    const int kb = item / nblk, nb = item - kb * nblk, k0 = 64 * kb, n0 = 32 * nb;
    const int quad = lane & 7, r0 = lane >> 3;
    const float* colp = src(n0 + 4 * quad);
    f32x4 v[8];
#pragma unroll
    for (int i = 0; i < 8; ++i) v[i] = colp ? *(const f32x4*)(colp + (size_t)(k0 + r0 + 8 * i) * ldw) : (f32x4){0.f, 0.f, 0.f, 0.f};
#pragma unroll
    for (int i = 0; i < 8; ++i) { LAS float* p = scr + (r0 + 8 * i) * 33 + 4 * quad; p[0] = v[i][0]; p[1] = v[i][1]; p[2] = v[i][2]; p[3] = v[i][3]; }
    LDS_WAIT(); asm volatile("" ::: "memory");
    const int c = lane & 7;
#pragma unroll
    for (int j = 0; j < 4; ++j) { const int n = (lane >> 3) + 8 * j; const LAS float* s = scr + (8 * c) * 33 + n;
        if constexpr (OUT8) {
            int w0 = __builtin_amdgcn_cvt_pk_fp8_f32(s[0 * 33] * wscale, s[1 * 33] * wscale, 0, false); w0 = __builtin_amdgcn_cvt_pk_fp8_f32(s[2 * 33] * wscale, s[3 * 33] * wscale, w0, true);
            int w1 = __builtin_amdgcn_cvt_pk_fp8_f32(s[4 * 33] * wscale, s[5 * 33] * wscale, 0, false); w1 = __builtin_amdgcn_cvt_pk_fp8_f32(s[6 * 33] * wscale, s[7 * 33] * wscale, w1, true);
            *(u32x2*)((unsigned char*)dstv + (size_t)(n0 + n) * K + k0 + 8 * c) = (u32x2){(unsigned)w0, (unsigned)w1};
        } else {
            u32x4 o; o.x = pk2(s[0 * 33], s[1 * 33]); o.y = pk2(s[2 * 33], s[3 * 33]); o.z = pk2(s[4 * 33], s[5 * 33]); o.w = pk2(s[6 * 33], s[7 * 33]);
            *(u32x4*)((bf16_t*)dstv + (size_t)(n0 + n) * K + k0 + 8 * c) = o; } }
    LDS_WAIT(); asm volatile("" ::: "memory");
}
struct SrcIdent { const float* W; DEV const float* operator()(int n) const { return W + n; } };
struct SrcWin { const float* W; DEV const float* operator()(int n) const {
    int s; if (n < 4096) s = n; else if (n < 5632) s = C_XBC + (n - 4096); else if (n < 6656) s = C_ZB + (n - 5632); else if (n < 6672) s = C_BETA + (n - 6656); else if (n < 6688) s = C_DT + (n - 6672); else return nullptr;
    return W + s; } };
struct SrcQKV { const float* W; DEV const float* operator()(int n) const {
    if (n >= 2048) return W + n; const int hd = n >> 6, cp = n & 63; return W + hd * 64 + 32 * ((cp >> 2) & 1) + 16 * (cp >> 5) + 4 * ((cp >> 3) & 3) + (cp & 3); } };
struct SrcGU { const float* Wg; long du; DEV const float* operator()(int r) const { const int j = r >> 8, rr = r & 255; return Wg + (rr < 128 ? 0l : du) + 128 * j + (rr & 127); } };

DEV void load_row(const float* p, int lane, float (&v)[16]) {
#pragma unroll
    for (int j = 0; j < 4; ++j) { const f32x4 t = *(const f32x4*)(p + j * 256 + lane * 4); v[4 * j] = t[0]; v[4 * j + 1] = t[1]; v[4 * j + 2] = t[2]; v[4 * j + 3] = t[3]; }
}
DEV void store_row(float* p, int lane, const float (&v)[16]) {
#pragma unroll
    for (int j = 0; j < 4; ++j) *(f32x4*)(p + j * 256 + lane * 4) = (f32x4){v[4 * j], v[4 * j + 1], v[4 * j + 2], v[4 * j + 3]};
}
DEV float row_rstd(const float (&v)[16]) { float ss = 0.f;
#pragma unroll
    for (int i = 0; i < 16; ++i) ss += v[i] * v[i];
    return rsqrtf(wave_sum(ss) * (1.f / D) + EPS); }
DEV void resid_update(float (&xv)[16], const float (&yv)[16], const float* gpost, const float* gt, int lane) {
    const float r = row_rstd(yv);
#pragma unroll
    for (int j = 0; j < 4; ++j) { const f32x4 g = *(const f32x4*)(gpost + j * 256 + lane * 4), t = *(const f32x4*)(gt + j * 256 + lane * 4);
#pragma unroll
        for (int i = 0; i < 4; ++i) xv[4 * j + i] += t[i] * (yv[4 * j + i] * r * g[i]); }
}
DEV void prenorm_pack(const float (&xv)[16], const float* gpre, const float* sc, const float* sh, int lane, u32x2 (&o)[4]) {
    const float r = row_rstd(xv);
#pragma unroll
    for (int j = 0; j < 4; ++j) { const f32x4 g = *(const f32x4*)(gpre + j * 256 + lane * 4), s = *(const f32x4*)(sc + j * 256 + lane * 4), b = *(const f32x4*)(sh + j * 256 + lane * 4);
        float h[4];
#pragma unroll
        for (int i = 0; i < 4; ++i) h[i] = xv[4 * j + i] * r * g[i] * (1.f + s[i]) + b[i];
        o[j] = (u32x2){pk2(h[0], h[1]), pk2(h[2], h[3])}; }
}

DEV void load_row8(const float* p, int lane, float (&v)[16]) {
#pragma unroll
    for (int j = 0; j < 2; ++j)
#pragma unroll
        for (int hh = 0; hh < 2; ++hh) { const f32x4 t = *(const f32x4*)(p + 512 * j + 8 * lane + 4 * hh); v[8 * j + 4 * hh] = t[0]; v[8 * j + 4 * hh + 1] = t[1]; v[8 * j + 4 * hh + 2] = t[2]; v[8 * j + 4 * hh + 3] = t[3]; }
}
DEV void store_row8(float* p, int lane, const float (&v)[16]) {
#pragma unroll
    for (int j = 0; j < 2; ++j)
#pragma unroll
        for (int hh = 0; hh < 2; ++hh) *(f32x4*)(p + 512 * j + 8 * lane + 4 * hh) = (f32x4){v[8 * j + 4 * hh], v[8 * j + 4 * hh + 1], v[8 * j + 4 * hh + 2], v[8 * j + 4 * hh + 3]};
}
DEV void resid_update8(float (&xv)[16], const float (&yv)[16], const float* gpost, const float* gt, int lane) {
    const float r = row_rstd(yv);
#pragma unroll
    for (int j = 0; j < 2; ++j)
#pragma unroll
        for (int hh = 0; hh < 2; ++hh) { const f32x4 g = *(const f32x4*)(gpost + 512 * j + 8 * lane + 4 * hh), t = *(const f32x4*)(gt + 512 * j + 8 * lane + 4 * hh);
#pragma unroll
            for (int i = 0; i < 4; ++i) xv[8 * j + 4 * hh + i] += t[i] * (yv[8 * j + 4 * hh + i] * r * g[i]); }
}
DEV void prenorm_pack8(const float (&xv)[16], const float* gpre, const float* sc, const float* sh, int lane, u32x4 (&o)[2]) {
    const float r = row_rstd(xv);
#pragma unroll
    for (int j = 0; j < 2; ++j) { float h[8];
#pragma unroll
        for (int hh = 0; hh < 2; ++hh) { const f32x4 g = *(const f32x4*)(gpre + 512 * j + 8 * lane + 4 * hh), s = *(const f32x4*)(sc + 512 * j + 8 * lane + 4 * hh), b = *(const f32x4*)(sh + 512 * j + 8 * lane + 4 * hh);
#pragma unroll
            for (int i = 0; i < 4; ++i) h[4 * hh + i] = xv[8 * j + 4 * hh + i] * r * g[i] * (1.f + s[i]) + b[i]; }
        o[j] = (u32x4){pk2(h[0], h[1]), pk2(h[2], h[3]), pk2(h[4], h[5]), pk2(h[6], h[7])}; }
}
DEV void prenorm_pack8_f8(const float (&xv)[16], const float* gpre, const float* sc, const float* sh, int lane, u32x2 (&o)[2]) {
    const float r = row_rstd(xv);
#pragma unroll
    for (int j = 0; j < 2; ++j) { float h[8];
#pragma unroll
        for (int hh = 0; hh < 2; ++hh) { const f32x4 g = *(const f32x4*)(gpre + 512 * j + 8 * lane + 4 * hh), s = *(const f32x4*)(sc + 512 * j + 8 * lane + 4 * hh), b = *(const f32x4*)(sh + 512 * j + 8 * lane + 4 * hh);
#pragma unroll
            for (int i = 0; i < 4; ++i) h[4 * hh + i] = fminf(fmaxf(xv[8 * j + 4 * hh + i] * r * g[i] * (1.f + s[i]) + b[i], -440.f), 440.f); }
        int w0 = __builtin_amdgcn_cvt_pk_fp8_f32(h[0], h[1], 0, false); w0 = __builtin_amdgcn_cvt_pk_fp8_f32(h[2], h[3], w0, true);
        int w1 = __builtin_amdgcn_cvt_pk_fp8_f32(h[4], h[5], 0, false); w1 = __builtin_amdgcn_cvt_pk_fp8_f32(h[6], h[7], w1, true);
        o[j] = (u32x2){(unsigned)w0, (unsigned)w1}; }
}
DEV void acc_row8(float (&yv)[16], const u32x2 w0, const u32x2 w1, const float g) {
#pragma unroll
    for (int e = 0; e < 2; ++e) {
        yv[4 * e] += g * __builtin_amdgcn_cvt_f32_fp8((int)w0[e], 0); yv[4 * e + 1] += g * __builtin_amdgcn_cvt_f32_fp8((int)w0[e], 1); yv[4 * e + 2] += g * __builtin_amdgcn_cvt_f32_fp8((int)w0[e], 2); yv[4 * e + 3] += g * __builtin_amdgcn_cvt_f32_fp8((int)w0[e], 3);
        yv[8 + 4 * e] += g * __builtin_amdgcn_cvt_f32_fp8((int)w1[e], 0); yv[8 + 4 * e + 1] += g * __builtin_amdgcn_cvt_f32_fp8((int)w1[e], 1); yv[8 + 4 * e + 2] += g * __builtin_amdgcn_cvt_f32_fp8((int)w1[e], 2); yv[8 + 4 * e + 3] += g * __builtin_amdgcn_cvt_f32_fp8((int)w1[e], 3); }
}

DEV void load_row_bf(const bf16_t* p, int lane, float (&v)[16]) {
#pragma unroll
    for (int j = 0; j < 4; ++j) { const u32x2 w = *(const u32x2*)(p + j * 256 + lane * 4); v[4 * j] = __uint_as_float(w.x << 16); v[4 * j + 1] = __uint_as_float(w.x & 0xFFFF0000u); v[4 * j + 2] = __uint_as_float(w.y << 16); v[4 * j + 3] = __uint_as_float(w.y & 0xFFFF0000u); }
}
DEV void store_row_bf(bf16_t* p, int lane, const float (&v)[16]) {
#pragma unroll
    for (int j = 0; j < 4; ++j) *(u32x2*)(p + j * 256 + lane * 4) = (u32x2){pk2(v[4 * j], v[4 * j + 1]), pk2(v[4 * j + 2], v[4 * j + 3])};
}
DEV void load_row8_bf(const bf16_t* p, int lane, float (&v)[16]) {
#pragma unroll
    for (int j = 0; j < 2; ++j) { const u32x4 w = *(const u32x4*)(p + 512 * j + 8 * lane);
#pragma unroll
        for (int e = 0; e < 4; ++e) { v[8 * j + 2 * e] = __uint_as_float(w[e] << 16); v[8 * j + 2 * e + 1] = __uint_as_float(w[e] & 0xFFFF0000u); } }
}
DEV void store_row8_bf(bf16_t* p, int lane, const float (&v)[16]) {
#pragma unroll
    for (int j = 0; j < 2; ++j) *(u32x4*)(p + 512 * j + 8 * lane) = (u32x4){pk2(v[8 * j], v[8 * j + 1]), pk2(v[8 * j + 2], v[8 * j + 3]), pk2(v[8 * j + 4], v[8 * j + 5]), pk2(v[8 * j + 6], v[8 * j + 7])};
}

struct Ctx { LAS unsigned char* lds; int tid, lane, wave, G, bid; };

DEV void ph_setup(const Args& a, const Ctx& X) {
    unsigned char* ws = a.ws;
    float* mod = (float*)(ws + WS_MOD);
    { LAS float* red = (LAS float*)X.lds;
      LAS float* sc = (LAS float*)(X.lds + 8192);
      for (int i = X.tid; i < NB * D; i += NTHR) sc[i] = siluf(a.c[i]);
      __syncthreads();
      const int kc = X.tid >> 6, cl = X.tid & 63;
      for (int task = X.bid; task < 2 * 96; task += X.G) {
          const int l = task / 96, col = (task % 96) * 64 + cl;
          const float* w = a.mod_w + (size_t)l * D * 6 * D + col;
          float p0 = 0.f, p1 = 0.f, p2 = 0.f, p3 = 0.f;
#pragma unroll 16
          for (int k = kc * 128; k < kc * 128 + 128; ++k) { const float wv = w[(size_t)k * 6 * D];
              p0 += sc[k] * wv; p1 += sc[D + k] * wv; p2 += sc[2 * D + k] * wv; p3 += sc[3 * D + k] * wv; }
          __syncthreads();
          red[(kc * 4 + 0) * 64 + cl] = p0; red[(kc * 4 + 1) * 64 + cl] = p1; red[(kc * 4 + 2) * 64 + cl] = p2; red[(kc * 4 + 3) * 64 + cl] = p3;
          __syncthreads();
          if (X.tid < 256) { const int b = X.tid >> 6; float s = a.mod_b[l * 6 * D + col];
#pragma unroll
              for (int q = 0; q < 8; ++q) s += red[(q * 4 + b) * 64 + cl];
              mod[(size_t)(l * NB + b) * 6 * D + col] = s; }
      }
      __syncthreads(); }
    { LAS float* scr = (LAS float*)(X.lds + X.wave * 8704);
      const int gw = X.bid * NWAVES + X.wave, NGW = X.G * NWAVES;
      constexpr int I_IN = (D / 64) * (NPROJ / 32);
      for (int it = gw; it < I_IN; it += NGW) conv_item(SrcWin{a.ssm_w_in}, PROJ, D, (bf16_t*)(ws + WS_WIN), scr, it, NPROJ / 32, X.lane);
    }
}
DEV void ph_setup_late(const Args& a, const Ctx& X, const int wg0) {
    unsigned char* ws = a.ws;
    { float* cosT = (float*)(ws + WS_COS); float* sinT = (float*)(ws + WS_SIN);
      for (int idx = (X.bid - wg0) * NTHR + X.tid; idx < T * 32; idx += (X.G - wg0) * NTHR) { const int t = idx >> 5, i = idx & 31;
          const float ang = (float)a.pos[t] * powf(10000.f, -(float)i / 32.f); float sn, cs; sincosf(ang, &sn, &cs); cosT[idx] = cs; sinT[idx] = sn; } }
    { LAS float* scr = (LAS float*)(X.lds + X.wave * 8704);
      const int gw = (X.bid - wg0) * NWAVES + X.wave, NGW = (X.G - wg0) * NWAVES;
      constexpr int I_OUT = (2048 / 64) * (D / 32), I_QKV = (D / 64) * (3072 / 32), I_O = (D / 64) * (D / 32);
      for (int it = gw; it < I_OUT + I_QKV + I_O; it += NGW) {
          int r = it;
          if (r < I_OUT) { conv_item(SrcIdent{a.ssm_w_out}, D, 2048, (bf16_t*)(ws + WS_WOUT), scr, r, D / 32, X.lane); continue; } r -= I_OUT;
          if (r < I_QKV) { conv_item<SrcQKV, true>(SrcQKV{a.attn_w_qkv}, 3072, D, ws + WS_WQKV, scr, r, 3072 / 32, X.lane, 64.f); continue; } r -= I_QKV;
          conv_item<SrcIdent, true>(SrcIdent{a.attn_w_o}, D, D, ws + WS_WO, scr, r, D / 32, X.lane, 64.f);
      } }
}

DEV void ph_prenorm0(const Args& a, const Ctx& X) {
    const float* mod = (const float*)(a.ws + WS_MOD);
    bf16_t* hb = (bf16_t*)(a.ws + WS_H);
    for (int row = X.bid * NWAVES + X.wave; row < T; row += X.G * NWAVES) {
        const int b = row / SEQ; const float* ml = mod + (size_t)b * 6 * D;
        float xv[16]; load_row(a.x + (size_t)row * D, X.lane, xv);
        u32x2 o[4]; prenorm_pack(xv, a.mix_pre_g, ml + D, ml, X.lane, o);
#pragma unroll
        for (int j = 0; j < 4; ++j) *(u32x2*)(hb + (size_t)row * D + j * 256 + X.lane * 4) = o[j];
    }
}

DEV bf16x8 acc_to_frag(const f32x4 lo, const f32x4 hi) { u32x4 w; w.x = pg8::cvt_pk_bf16(lo[0], lo[1]); w.y = pg8::cvt_pk_bf16(lo[2], lo[3]); w.z = pg8::cvt_pk_bf16(hi[0], hi[1]); w.w = pg8::cvt_pk_bf16(hi[2], hi[3]); return __builtin_bit_cast(bf16x8, w); }

DEV void gdn_solve(LAS float* M, LAS unsigned short* tf, const int lane) {
    for (int rb = 0; rb < 16; ++rb) {
        const int i0 = 4 * rb;
        float a0 = (lane == i0) ? 1.f : 0.f, a1 = (lane == i0 + 1) ? 1.f : 0.f, a2 = (lane == i0 + 2) ? 1.f : 0.f, a3 = (lane == i0 + 3) ? 1.f : 0.f;
        for (int j = 0; j < i0; j += 4) {
            const float t0 = M[j * 64 + lane], t1 = M[(j + 1) * 64 + lane], t2 = M[(j + 2) * 64 + lane], t3 = M[(j + 3) * 64 + lane];
            const f32x4 r0 = *(const LAS f32x4*)(M + i0 * 64 + j), r1 = *(const LAS f32x4*)(M + (i0 + 1) * 64 + j), r2 = *(const LAS f32x4*)(M + (i0 + 2) * 64 + j), r3 = *(const LAS f32x4*)(M + (i0 + 3) * 64 + j);
            a0 -= r0[0] * t0 + r0[1] * t1 + r0[2] * t2 + r0[3] * t3; a1 -= r1[0] * t0 + r1[1] * t1 + r1[2] * t2 + r1[3] * t3;
            a2 -= r2[0] * t0 + r2[1] * t1 + r2[2] * t2 + r2[3] * t3; a3 -= r3[0] * t0 + r3[1] * t1 + r3[2] * t2 + r3[3] * t3;
        }
        const f32x4 d1 = *(const LAS f32x4*)(M + (i0 + 1) * 64 + i0), d2 = *(const LAS f32x4*)(M + (i0 + 2) * 64 + i0), d3 = *(const LAS f32x4*)(M + (i0 + 3) * 64 + i0);
        a1 -= d1[0] * a0; a2 -= d2[0] * a0 + d2[1] * a1; a3 -= d3[0] * a0 + d3[1] * a1 + d3[2] * a2;
        M[i0 * 64 + lane] = a0; M[(i0 + 1) * 64 + lane] = a1; M[(i0 + 2) * 64 + lane] = a2; M[(i0 + 3) * 64 + lane] = a3;
    }
    const int cq = (lane >> 2) & 3, ca = (lane >> 4) & 1, ce = lane & 3, cks = lane >> 5;
    for (int i = 0; i < 64; ++i) tf[((i >> 4) * 2 + cks) * 512 + ((i & 15) + 16 * cq) * 8 + 4 * ca + ce] = (unsigned short)f2bf(M[i * 64 + lane]);
}
DEV void ph_gdn_local(const Args& a, const Ctx& X) {
    const bf16_t* qkvpre = (const bf16_t*)(a.ws + WS_QKVPRE); const float* small = (const float*)(a.ws + WS_SMALL);
    unsigned char* gi = a.ws + WS_GI; float* glast = (float*)(a.ws + WS_GLAST);
    constexpr int KP = 272;
    LAS unsigned char* kN = X.lds; LAS unsigned char* qN = X.lds + 64 * KP; LAS unsigned char* slots = X.lds + 128 * KP;
    LAS float* gcL = (LAS float*)(X.lds + 143360); LAS float* btL = gcL + 8 * 64;
    LAS unsigned char* stg = X.lds + 100352;
    const int lane = X.lane, wave = X.wave, r16 = lane & 15, q4 = lane >> 4;
    const float scale = 0.08838834764831845f;
    for (int wu = X.bid; wu < NB * 64; wu += X.G) {
        const int b = wu >> 6, n = wu & 63; const size_t t0 = (size_t)b * SEQ + 64 * n;
        unsigned char* tmp = a.ws + WS_GTMP + (size_t)X.bid * 131072;
        __syncthreads();
        {
            const float g = -__expf(a.gdn_a_log[wave]) * softplusf(small[(t0 + lane) * 32 + 8 + wave] + a.gdn_dt_bias[wave]);
            float gc = g;
#pragma unroll
            for (int o = 1; o < 64; o <<= 1) { const float v = __shfl_up(gc, o); if (lane >= o) gc += v; }
            gcL[wave * 64 + lane] = gc; btL[wave * 64 + lane] = sigmoidf_(small[(t0 + lane) * 32 + wave]);
            if (lane == 63) glast[(size_t)((b * 8 + wave) * 64 + n) * 32] = gc;
        }
        __syncthreads();
        unsigned xr[3][11];
#define GDN_LOADX(hh) do { _Pragma("unroll") for (int _p = 0; _p < 3; ++_p) _Pragma("unroll") for (int _i = 0; _i < 11; ++_i) { const int _tk = 8 * wave + _i - 3; unsigned _v = 0u; \
            if (64 * n + _tk >= 0) _v = *(const unsigned*)(qkvpre + (t0 + _tk) * 3072 + _p * 1024 + (hh) * 128 + 2 * lane); xr[_p][_i] = _v; } } while (0)
        GDN_LOADX(0);
        for (int bb = 0; bb < 2; ++bb) {
            for (int j = 0; j < 4; ++j) {
                const int h = bb * 4 + j; unsigned char* ub = gi + (size_t)((b * 8 + h) * 64 + n) * GI_UNIT;
                {
                    const float gl = gcL[h * 64 + 63];
                    const int blk = wave >> 2, pa = (wave & 3) >> 1, pq0 = 2 * (wave & 1);
                    const int ca = (2 * lane >> 4) & 1, cq = (2 * lane >> 2) & 3, ce = (2 * lane) & 3, cks = (2 * lane) >> 5;
#pragma unroll
                    for (int part = 0; part < 3; ++part) {
                        const int col = part * 1024 + h * 128 + 2 * lane;
                        float w0[4], w1[4];
#pragma unroll
                        for (int i = 0; i < 4; ++i) { const f32x2 t = *(const f32x2*)(a.gdn_conv_w + i * 3072 + col); w0[i] = t.x; w1[i] = t.y; }
                        float x0[11], x1[11];
#pragma unroll
                        for (int i = 0; i < 11; ++i) { const unsigned v = xr[part][i]; x0[i] = __uint_as_float(v << 16); x1[i] = __uint_as_float(v & 0xFFFF0000u); }
                        float v0[8], v1[8];
#pragma unroll
                        for (int i = 0; i < 8; ++i) { v0[i] = siluf(w0[0] * x0[i] + w0[1] * x0[i + 1] + w0[2] * x0[i + 2] + w0[3] * x0[i + 3]); v1[i] = siluf(w1[0] * x1[i] + w1[1] * x1[i + 1] + w1[2] * x1[i + 2] + w1[3] * x1[i + 3]); }
                        if (part < 2) {
#pragma unroll
                            for (int i = 0; i < 8; ++i) { const float r = rsqrtf(wave_sum(v0[i] * v0[i] + v1[i] * v1[i]) + 1e-6f); v0[i] *= r; v1[i] *= r; }
                        }
                        for (int rep_ = 0; rep_ < (((PROBE_MASK >> 21) & 1u) ? 2 : 1); ++rep_) {
                        if (part == 0) {
#pragma unroll
                            for (int i = 0; i < 8; ++i) { const int tok = 8 * wave + i; const float eg = __expf(gcL[h * 64 + tok]) * scale;
                                *(LAS unsigned*)(qN + tok * KP + lane * 4) = pk2(v0[i], v1[i]);
                                *(LAS unsigned*)(stg + ((tok >> 4) * 4 + cks) * 1024 + ((tok & 15) + 16 * cq) * 16 + (4 * ca + ce) * 2) = pk2(v0[i] * eg, v1[i] * eg); }
                        } else if (part == 1) {
                            unsigned short kg0[8], kg1[8], ke0[8], ke1[8];
#pragma unroll
                            for (int i = 0; i < 8; ++i) { const int tok = 8 * wave + i; const float gc = gcL[h * 64 + tok], bt = btL[h * 64 + tok], eg = __expf(gc) * bt, eend = __expf(gl - gc);
                                *(LAS unsigned*)(kN + tok * KP + lane * 4) = pk2(v0[i], v1[i]);
                                kg0[i] = (unsigned short)f2bf(v0[i] * eg); kg1[i] = (unsigned short)f2bf(v1[i] * eg); ke0[i] = (unsigned short)f2bf(v0[i] * eend); ke1[i] = (unsigned short)f2bf(v1[i] * eend); }
#pragma unroll
                            for (int hf = 0; hf < 2; ++hf) { const int pos = 32 * blk + 8 * (pq0 + hf) + 4 * pa; const int cl = 2 * lane;
                                *(u32x2*)(tmp + (size_t)j * 32768 + 16384 + cl * 128 + pos * 2) = (u32x2){(unsigned)kg0[4 * hf] | ((unsigned)kg0[4 * hf + 1] << 16), (unsigned)kg0[4 * hf + 2] | ((unsigned)kg0[4 * hf + 3] << 16)};
                                *(u32x2*)(tmp + (size_t)j * 32768 + 16384 + (cl + 1) * 128 + pos * 2) = (u32x2){(unsigned)kg1[4 * hf] | ((unsigned)kg1[4 * hf + 1] << 16), (unsigned)kg1[4 * hf + 2] | ((unsigned)kg1[4 * hf + 3] << 16)};
                                *(LAS u32x2*)(stg + 16384 + ((cl >> 4) * 2 + blk) * 1024 + ((cl & 15) + 16 * (pq0 + hf)) * 16 + (4 * pa) * 2) = (u32x2){(unsigned)ke0[4 * hf] | ((unsigned)ke0[4 * hf + 1] << 16), (unsigned)ke0[4 * hf + 2] | ((unsigned)ke0[4 * hf + 3] << 16)};
                                *(LAS u32x2*)(stg + 16384 + (((cl + 1) >> 4) * 2 + blk) * 1024 + (((cl + 1) & 15) + 16 * (pq0 + hf)) * 16 + (4 * pa) * 2) = (u32x2){(unsigned)ke1[4 * hf] | ((unsigned)ke1[4 * hf + 1] << 16), (unsigned)ke1[4 * hf + 2] | ((unsigned)ke1[4 * hf + 3] << 16)}; }
                        } else {
                            unsigned short vb0[8], vb1[8];
#pragma unroll
                            for (int i = 0; i < 8; ++i) { const float bt = btL[h * 64 + 8 * wave + i]; vb0[i] = (unsigned short)f2bf(v0[i] * bt); vb1[i] = (unsigned short)f2bf(v1[i] * bt); }
#pragma unroll
                            for (int hf = 0; hf < 2; ++hf) { const int pos = 32 * blk + 8 * (pq0 + hf) + 4 * pa; const int cl = 2 * lane;
                                *(u32x2*)(tmp + (size_t)j * 32768 + cl * 128 + pos * 2) = (u32x2){(unsigned)vb0[4 * hf] | ((unsigned)vb0[4 * hf + 1] << 16), (unsigned)vb0[4 * hf + 2] | ((unsigned)vb0[4 * hf + 3] << 16)};
                                *(u32x2*)(tmp + (size_t)j * 32768 + (cl + 1) * 128 + pos * 2) = (u32x2){(unsigned)vb1[4 * hf] | ((unsigned)vb1[4 * hf + 1] << 16), (unsigned)vb1[4 * hf + 2] | ((unsigned)vb1[4 * hf + 3] << 16)}; }
                        }
                        asm volatile("" ::: "memory"); }
                    }
                }
                if (h + 1 < 8) GDN_LOADX(h + 1);
                __syncthreads();
                {
#pragma unroll
                    for (int i = 0; i < 4; ++i) *(u32x4*)(ub + 16384 + (X.tid + 512 * i) * 16) = *(const LAS u32x4*)(stg + (X.tid + 512 * i) * 16);
                    const int mat = wave >> 2, rt = wave & 3; LAS unsigned char* An = mat ? qN : kN;
                    bf16x8 af[4];
#pragma unroll
                    for (int ks = 0; ks < 4; ++ks) af[ks] = *(const LAS bf16x8*)(An + (16 * rt + r16) * KP + (32 * ks + 8 * q4) * 2);
                    LAS float* slot = (LAS float*)(slots + j * 16384);
#pragma unroll
                    for (int ct = 0; ct < 4; ++ct) { f32x4 acc = {0.f, 0.f, 0.f, 0.f};
#pragma unroll
                        for (int ks = 0; ks < 4; ++ks) { const bf16x8 bf = *(const LAS bf16x8*)(kN + (16 * ct + r16) * KP + (32 * ks + 8 * q4) * 2); acc = __builtin_amdgcn_mfma_f32_16x16x32_bf16(af[ks], bf, acc, 0, 0, 0); }
                        const int jc = 16 * ct + r16; const float gj = gcL[h * 64 + jc];
#pragma unroll
                        for (int rg = 0; rg < 4; ++rg) { const int i = 16 * rt + 4 * q4 + rg; const float dec = __expf(gcL[h * 64 + i] - gj);
                            if (mat == 0) { slot[i * 64 + jc] = jc < i ? btL[h * 64 + i] * acc[rg] * dec : 0.f; }
                            else { const float v = jc <= i ? acc[rg] * scale * dec : 0.f;
                                *(LAS unsigned short*)(stg + 32768 + (rt * 2 + (ct >> 1)) * 1024 + ((4 * q4 + rg) + 16 * (r16 >> 2)) * 16 + (4 * (ct & 1) + (r16 & 3)) * 2) = (unsigned short)f2bf(v); } }
                    }
                }
                __syncthreads();
                *(u32x4*)(ub + 49152 + X.tid * 16) = *(const LAS u32x4*)(stg + 32768 + X.tid * 16);
            }
            if (wave < 4) gdn_solve((LAS float*)(slots + wave * 16384), (LAS unsigned short*)(X.lds + wave * 8192), lane);
            VM_WAIT(); __syncthreads();
            for (int j = 0; j < 4; ++j) {
                const int h = bb * 4 + j; unsigned char* ub = gi + (size_t)((b * 8 + h) * 64 + n) * GI_UNIT;
                const int mat = wave >> 2; LAS unsigned char* slot = X.lds + j * 8192;
#pragma unroll
                for (int cx = 0; cx < 2; ++cx) { const int ct = 2 * (wave & 3) + cx;
                    bf16x8 bfr[2];
#pragma unroll
                    for (int ks = 0; ks < 2; ++ks) { const u32x4 t = __builtin_nontemporal_load((const u32x4*)(tmp + (size_t)j * 32768 + mat * 16384 + (16 * ct + r16) * 128 + (32 * ks + 8 * q4) * 2)); bfr[ks] = __builtin_bit_cast(bf16x8, t); }
#pragma unroll
                    for (int rt = 0; rt < 4; ++rt) { f32x4 acc = {0.f, 0.f, 0.f, 0.f};
#pragma unroll
                        for (int ks = 0; ks < 2; ++ks) { const bf16x8 tf = *(const LAS bf16x8*)(slot + (rt * 2 + ks) * 1024 + lane * 16); acc = __builtin_amdgcn_mfma_f32_16x16x32_bf16(tf, bfr[ks], acc, 0, 0, 0); }
                        if (mat == 0) *(u32x2*)(ub + 57344 + (rt * 8 + ct) * 512 + lane * 8) = (u32x2){pg8::cvt_pk_bf16(acc[0], acc[1]), pg8::cvt_pk_bf16(acc[2], acc[3])};
                        else {
#pragma unroll
                            for (int rg = 0; rg < 4; ++rg) *(unsigned short*)(ub + (rt * 4 + (ct >> 1)) * 1024 + ((4 * q4 + rg) + 16 * (r16 >> 2)) * 16 + (4 * (ct & 1) + (r16 & 3)) * 2) = (unsigned short)f2bf(-acc[rg]);
                        }
                    }
                }
            }
            __syncthreads();
        }
    }
}
DEV void ph_gdn_scan(const Args& a, const Ctx& X) {
    const unsigned char* gi = a.ws + WS_GI; const float* glast = (const float*)(a.ws + WS_GLAST);
    const bf16_t* za = (const bf16_t*)(a.ws + WS_ZA); bf16_t* oy = (bf16_t*)(a.ws + WS_OY);
    const int lane = X.lane, wave = X.wave, r16 = lane & 15, q4 = lane >> 4, tid = X.tid;
    LAS float* OT = (LAS float*)(X.lds + 114688);
    const int bh = X.bid, b = bh >> 3, h = bh & 7;
    const unsigned char* ubase = gi + (size_t)bh * 64 * GI_UNIT;
    f32x4 S[8];
#pragma unroll
    for (int i = 0; i < 8; ++i) S[i] = (f32x4){0.f, 0.f, 0.f, 0.f};
    float nwv[16];
#pragma unroll
    for (int i = 0; i < 16; ++i) nwv[i] = a.gdn_norm_w[16 * (tid & 7) + i];
#define GDN_STAGE(nn, buf) do { _Pragma("unroll") for (int _i = 0; _i < 7; ++_i) \
        __builtin_amdgcn_global_load_lds((const unsigned*)(ubase + (size_t)(nn) * GI_UNIT + (size_t)(tid + 512 * _i) * 16), (LAS unsigned*)(X.lds + (buf) * 57344 + (wave * 64 + 512 * _i) * 16), 16, 0, 0); } while (0)
    u32x2 udn[4]; float gln; u32x4 zn[2];
    { const size_t tz = (size_t)b * SEQ + (tid >> 3); zn[0] = *(const u32x4*)(za + tz * 1024 + h * 128 + 16 * (tid & 7)); zn[1] = *(const u32x4*)(za + tz * 1024 + h * 128 + 16 * (tid & 7) + 8); }
#pragma unroll
    for (int ct = 0; ct < 4; ++ct) udn[ct] = *(const u32x2*)(ubase + 57344 + (ct * 8 + wave) * 512 + lane * 8);
    gln = glast[(size_t)(bh * 64) * 32];
    GDN_STAGE(0, 0);
#define GDN_EPILOGUE(nn, ZC) do { const int tok = tid >> 3, seg = tid & 7; const size_t t = (size_t)b * SEQ + 64 * (nn) + tok; \
            float ov[16]; float ss = 0.f; \
            _Pragma("unroll") for (int i = 0; i < 4; ++i) { const f32x4 v = *(const LAS f32x4*)(OT + tok * 132 + 16 * seg + 4 * i); ov[4 * i] = v[0]; ov[4 * i + 1] = v[1]; ov[4 * i + 2] = v[2]; ov[4 * i + 3] = v[3]; ss += v[0] * v[0] + v[1] * v[1] + v[2] * v[2] + v[3] * v[3]; } \
            ss += __shfl_xor(ss, 1); ss += __shfl_xor(ss, 2); ss += __shfl_xor(ss, 4); \
            const float rstd = rsqrtf(ss * (1.f / 128.f) + EPS); \
            u32x4 ow[2]; \
            _Pragma("unroll") for (int i = 0; i < 2; ++i) _Pragma("unroll") for (int e = 0; e < 4; ++e) { const unsigned zw = (ZC)[i][e]; const float z0 = __uint_as_float(zw << 16), z1 = __uint_as_float(zw & 0xFFFF0000u); \
                    ow[i][e] = pg8::cvt_pk_bf16(ov[8 * i + 2 * e] * rstd * nwv[8 * i + 2 * e] * siluf(z0), ov[8 * i + 2 * e + 1] * rstd * nwv[8 * i + 2 * e + 1] * siluf(z1)); } \
            *(u32x4*)(oy + t * 2048 + h * 128 + 16 * seg) = ow[0]; *(u32x4*)(oy + t * 2048 + h * 128 + 16 * seg + 8) = ow[1]; } while (0)
    u32x4 zp[2] = {{0u, 0u, 0u, 0u}, {0u, 0u, 0u, 0u}};
    for (int n = 0; n < 64; ++n) {
        VM_WAIT(); __syncthreads();
        f32x4 uf[4];
#pragma unroll
        for (int ct = 0; ct < 4; ++ct) { uf[ct][0] = __uint_as_float(udn[ct].x << 16); uf[ct][1] = __uint_as_float(udn[ct].x & 0xFFFF0000u); uf[ct][2] = __uint_as_float(udn[ct].y << 16); uf[ct][3] = __uint_as_float(udn[ct].y & 0xFFFF0000u); }
        const float egl = __expf(gln);
        u32x4 zc[2]; zc[0] = zn[0]; zc[1] = zn[1];
        asm volatile("" : "+v"(uf[0]), "+v"(uf[1]), "+v"(uf[2]), "+v"(uf[3]), "+v"(zc[0]), "+v"(zc[1]));
        if (n + 1 < 64) {
            const unsigned char* un = ubase + (size_t)(n + 1) * GI_UNIT;
#pragma unroll
            for (int ct = 0; ct < 4; ++ct) udn[ct] = *(const u32x2*)(un + 57344 + (ct * 8 + wave) * 512 + lane * 8);
            gln = glast[(size_t)(bh * 64 + n + 1) * 32];
            { const size_t tz = (size_t)b * SEQ + 64 * (n + 1) + (tid >> 3); zn[0] = *(const u32x4*)(za + tz * 1024 + h * 128 + 16 * (tid & 7)); zn[1] = *(const u32x4*)(za + tz * 1024 + h * 128 + 16 * (tid & 7) + 8); }
            GDN_STAGE(n + 1, (n + 1) & 1);
        }
        if (n > 0) GDN_EPILOGUE(n - 1, zp);
        zp[0] = zc[0]; zp[1] = zc[1];
        const LAS unsigned char* L = X.lds + (n & 1) * 57344;
        bf16x8 sB[4];
#pragma unroll
        for (int ks = 0; ks < 4; ++ks) sB[ks] = acc_to_frag(S[2 * ks], S[2 * ks + 1]);
        f32x4 vn[4], oo[4];
#pragma unroll
        for (int ct = 0; ct < 4; ++ct) { f32x4 acc = {0.f, 0.f, 0.f, 0.f}, ao = {0.f, 0.f, 0.f, 0.f};
#pragma unroll
            for (int ks = 0; ks < 4; ++ks) { const bf16x8 wf = *(const LAS bf16x8*)(L + (ct * 4 + ks) * 1024 + lane * 16), qf = *(const LAS bf16x8*)(L + 16384 + (ct * 4 + ks) * 1024 + lane * 16);
                acc = __builtin_amdgcn_mfma_f32_16x16x32_bf16(wf, sB[ks], acc, 0, 0, 0); ao = __builtin_amdgcn_mfma_f32_16x16x32_bf16(qf, sB[ks], ao, 0, 0, 0); }
            vn[ct] = acc; oo[ct] = ao; }
#pragma unroll
        for (int ct = 0; ct < 4; ++ct) vn[ct] = vn[ct] + uf[ct];
        bf16x8 vB[2];
#pragma unroll
        for (int ks = 0; ks < 2; ++ks) vB[ks] = acc_to_frag(vn[2 * ks], vn[2 * ks + 1]);
#pragma unroll
        for (int ct = 0; ct < 4; ++ct)
#pragma unroll
            for (int ks = 0; ks < 2; ++ks) { const bf16x8 kf = *(const LAS bf16x8*)(L + 49152 + (ct * 2 + ks) * 1024 + lane * 16); oo[ct] = __builtin_amdgcn_mfma_f32_16x16x32_bf16(kf, vB[ks], oo[ct], 0, 0, 0); }
#pragma unroll
        for (int dt = 0; dt < 8; ++dt) { f32x4 acc = S[dt] * egl;
#pragma unroll
            for (int ks = 0; ks < 2; ++ks) { const bf16x8 ef = *(const LAS bf16x8*)(L + 32768 + (dt * 2 + ks) * 1024 + lane * 16); acc = __builtin_amdgcn_mfma_f32_16x16x32_bf16(ef, vB[ks], acc, 0, 0, 0); }
            S[dt] = acc; }
        __syncthreads();
#pragma unroll
        for (int ct = 0; ct < 4; ++ct)
#pragma unroll
            for (int rg = 0; rg < 4; ++rg) OT[(16 * ct + 4 * q4 + rg) * 132 + 16 * wave + r16] = oo[ct][rg];
    }
    __syncthreads();
    GDN_EPILOGUE(63, zp);
#undef GDN_EPILOGUE
#undef GDN_STAGE
}

constexpr int SP = 272;
DEV void ph_ssd_local(const Args& a, const Ctx& X) {
    const bf16_t* xbcpre = (const bf16_t*)(a.ws + WS_XBCPRE); const float* small = (const float*)(a.ws + WS_SMALL);
    bf16_t* CC = (bf16_t*)(a.ws + WS_CC); float* acum = (float*)(a.ws + WS_ACUM); float* cdec = (float*)(a.ws + WS_CDEC);
    bf16_t* ydiag = (bf16_t*)(a.ws + WS_YDIAG); bf16_t* states = (bf16_t*)(a.ws + WS_STATES);
    LAS unsigned char* Bn = X.lds; LAS unsigned char* Cn = X.lds + 128 * SP; LAS unsigned char* BT = X.lds + 256 * SP;
    LAS unsigned char* xdT = X.lds; LAS unsigned char* xeT = X.lds + 64 * SP;
    LAS float* acL = (LAS float*)(X.lds + AUX_OFF); LAS float* dtL = acL + 8 * 128;
    const int lane = X.lane, wave = X.wave, r16 = lane & 15, q4 = lane >> 4;
    for (int unit = X.bid; unit < NB * 32 * 2; unit += X.G) {
        const int g = unit & 1, c = (unit >> 1) & 31, b = unit >> 6; const size_t t0 = (size_t)b * SEQ + 128 * c;
        __syncthreads();
        {
            const int hd = g * 8 + wave; const float an = -__expf(a.ssd_a_log[hd]), bias = a.ssd_dt_bias[hd];
            const float d0 = softplusf(small[(t0 + lane) * 32 + 16 + hd] + bias), d1 = softplusf(small[(t0 + 64 + lane) * 32 + 16 + hd] + bias);
            float s0 = d0 * an, s1 = d1 * an;
#pragma unroll
            for (int o = 1; o < 64; o <<= 1) { const float v0 = __shfl_up(s0, o), v1 = __shfl_up(s1, o); if (lane >= o) { s0 += v0; s1 += v1; } }
            s1 += __shfl(s0, 63);
            acL[wave * 128 + lane] = s0; acL[wave * 128 + 64 + lane] = s1; dtL[wave * 128 + lane] = d0; dtL[wave * 128 + 64 + lane] = d1;
            acum[((size_t)g * T + t0 + lane) * 8 + wave] = s0; acum[((size_t)g * T + t0 + 64 + lane) * 8 + wave] = s1;
            if (lane == 63) cdec[(size_t)unit * 32 + wave] = __expf(s1);
        }
        {
            const int isC = lane >> 5, cc = (lane & 31) * 4, col = 1024 + isC * 256 + g * 128 + cc;
            float w[4][4], bs[4];
#pragma unroll
            for (int i = 0; i < 4; ++i) { const f32x4 t = *(const f32x4*)(a.ssd_conv_w + i * 1536 + col); w[i][0] = t[0]; w[i][1] = t[1]; w[i][2] = t[2]; w[i][3] = t[3]; }
            { const f32x4 t = *(const f32x4*)(a.ssd_conv_b + col); bs[0] = t[0]; bs[1] = t[1]; bs[2] = t[2]; bs[3] = t[3]; }
            float xin[19][4];
#pragma unroll
            for (int i = 0; i < 19; ++i) { const int tk = 16 * wave + i - 3; const bool ok = (128 * c + tk) >= 0; u32x2 v = {0u, 0u}; if (ok) v = *(const u32x2*)(xbcpre + (t0 + tk) * 1536 + col);
                xin[i][0] = __uint_as_float(v.x << 16); xin[i][1] = __uint_as_float(v.x & 0xFFFF0000u); xin[i][2] = __uint_as_float(v.y << 16); xin[i][3] = __uint_as_float(v.y & 0xFFFF0000u); }
            unsigned short ov[16][4];
#pragma unroll
            for (int i = 0; i < 16; ++i)
#pragma unroll
                for (int e = 0; e < 4; ++e) { const float s = bs[e] + w[0][e] * xin[i][e] + w[1][e] * xin[i + 1][e] + w[2][e] * xin[i + 2][e] + w[3][e] * xin[i + 3][e]; ov[i][e] = (unsigned short)f2bf(siluf(s)); }
            LAS unsigned char* nat = isC ? Cn : Bn;
#pragma unroll
            for (int i = 0; i < 16; ++i) { const u32x2 pk = {(unsigned)ov[i][0] | ((unsigned)ov[i][1] << 16), (unsigned)ov[i][2] | ((unsigned)ov[i][3] << 16)};
                *(LAS u32x2*)(nat + (16 * wave + i) * SP + cc * 2) = pk;
                if (isC) *(u32x2*)(CC + (t0 + 16 * wave + i) * 256 + g * 128 + cc) = pk; }
            if (!isC) {
#pragma unroll
                for (int e = 0; e < 4; ++e)
#pragma unroll
                    for (int qq = 0; qq < 4; ++qq) { const u32x2 pk = {(unsigned)ov[4 * qq][e] | ((unsigned)ov[4 * qq + 1][e] << 16), (unsigned)ov[4 * qq + 2][e] | ((unsigned)ov[4 * qq + 3][e] << 16)};
                        *(LAS u32x2*)(BT + (cc + e) * SP + (32 * (wave >> 1) + 8 * qq + 4 * (wave & 1)) * 2) = pk; }
            }
        }
        __syncthreads();
        f32x4 cbt[8];
        {
            bf16x8 cf[4];
#pragma unroll
            for (int ks = 0; ks < 4; ++ks) cf[ks] = *(const LAS bf16x8*)(Cn + (16 * wave + r16) * SP + (32 * ks + 8 * q4) * 2);
#pragma unroll
            for (int st = 0; st < 8; ++st) { cbt[st] = (f32x4){0.f, 0.f, 0.f, 0.f};
#pragma unroll
                for (int ks = 0; ks < 4; ++ks) { const bf16x8 bf = *(const LAS bf16x8*)(Bn + (16 * st + r16) * SP + (32 * ks + 8 * q4) * 2); cbt[st] = __builtin_amdgcn_mfma_f32_16x16x32_bf16(bf, cf[ks], cbt[st], 0, 0, 0); } }
        }
        __syncthreads();
        const int lq = 16 * wave + r16;
        unsigned short xnx[19];
#define SSD_LOADX(hh) do { _Pragma("unroll") for (int _i = 0; _i < 19; ++_i) { const int _tk = 16 * wave + _i - 3; xnx[_i] = (128 * c + _tk) >= 0 ? xbcpre[(t0 + _tk) * 1536 + (hh) * 64 + lane] : (unsigned short)0; } } while (0)
        SSD_LOADX(g * 8);
        for (int r = 0; r < 8; ++r) {
            const int hd = g * 8 + r; const float dd = a.ssd_d[hd];
            {
                const int col = hd * 64 + lane; float w0 = a.ssd_conv_w[col], w1 = a.ssd_conv_w[1536 + col], w2 = a.ssd_conv_w[2 * 1536 + col], w3 = a.ssd_conv_w[3 * 1536 + col]; const float bs = a.ssd_conv_b[col];
                float xin[19];
#pragma unroll
                for (int i = 0; i < 19; ++i) xin[i] = bf2f(xnx[i]);
                if (r + 1 < 8) SSD_LOADX(hd + 1);
                const float aclast = acL[r * 128 + 127];
                unsigned short xd[16], xe[16];
#pragma unroll
                for (int i = 0; i < 16; ++i) { const float xv = siluf(bs + w0 * xin[i] + w1 * xin[i + 1] + w2 * xin[i + 2] + w3 * xin[i + 3]); const int tk = 16 * wave + i;
                    const float xdv = xv * dtL[r * 128 + tk]; xd[i] = (unsigned short)f2bf(xdv); xe[i] = (unsigned short)f2bf(xdv * __expf(aclast - acL[r * 128 + tk])); }
#pragma unroll
                for (int qq = 0; qq < 4; ++qq) { const int pos = 32 * (wave >> 1) + 8 * qq + 4 * (wave & 1);
                    *(LAS u32x2*)(xdT + lane * SP + pos * 2) = (u32x2){(unsigned)xd[4 * qq] | ((unsigned)xd[4 * qq + 1] << 16), (unsigned)xd[4 * qq + 2] | ((unsigned)xd[4 * qq + 3] << 16)};
                    *(LAS u32x2*)(xeT + lane * SP + pos * 2) = (u32x2){(unsigned)xe[4 * qq] | ((unsigned)xe[4 * qq + 1] << 16), (unsigned)xe[4 * qq + 2] | ((unsigned)xe[4 * qq + 3] << 16)}; }
            }
            __syncthreads();
            {
                const float acl = acL[r * 128 + lq], ddt = dd / dtL[r * 128 + lq];
                f32x4 yd[4];
#pragma unroll
                for (int pt = 0; pt < 4; ++pt) yd[pt] = (f32x4){0.f, 0.f, 0.f, 0.f};
#pragma unroll
                for (int ks = 0; ks < 4; ++ks) { if (ks <= (wave >> 1)) {
                    f32x4 mlo, mhi;
#pragma unroll
                    for (int e = 0; e < 4; ++e) {
                        const int s0 = 32 * ks + 4 * q4 + e, s1 = s0 + 16;
                        const float v0 = cbt[2 * ks][e], v1 = cbt[2 * ks + 1][e];
                        mlo[e] = s0 < lq ? v0 * __expf(acl - acL[r * 128 + s0]) : (s0 == lq ? v0 + ddt : 0.f);
                        mhi[e] = s1 < lq ? v1 * __expf(acl - acL[r * 128 + s1]) : (s1 == lq ? v1 + ddt : 0.f);
                    }
                    const bf16x8 mf = acc_to_frag(mlo, mhi);
#pragma unroll
                    for (int pt = 0; pt < 4; ++pt) { const bf16x8 xf = *(const LAS bf16x8*)(xdT + (16 * pt + r16) * SP + (32 * ks + 8 * q4) * 2); yd[pt] = __builtin_amdgcn_mfma_f32_16x16x32_bf16(xf, mf, yd[pt], 0, 0, 0); }
                } }
#pragma unroll
                for (int pt = 0; pt < 4; ++pt) *(u32x2*)(ydiag + (t0 + lq) * 1024 + hd * 64 + 16 * pt + 4 * q4) = (u32x2){pg8::cvt_pk_bf16(yd[pt][0], yd[pt][1]), pg8::cvt_pk_bf16(yd[pt][2], yd[pt][3])};
            }
            {
                bf16x8 bf[4];
#pragma unroll
                for (int ks = 0; ks < 4; ++ks) bf[ks] = *(const LAS bf16x8*)(BT + (16 * wave + r16) * SP + (32 * ks + 8 * q4) * 2);
                bf16_t* hp = states + ((size_t)(unit * 8 + r) * 64) * 128;
#pragma unroll
                for (int pt = 0; pt < 4; ++pt) { f32x4 st = {0.f, 0.f, 0.f, 0.f};
#pragma unroll
                    for (int ks = 0; ks < 4; ++ks) { const bf16x8 xf = *(const LAS bf16x8*)(xeT + (16 * pt + r16) * SP + (32 * ks + 8 * q4) * 2); st = __builtin_amdgcn_mfma_f32_16x16x32_bf16(bf[ks], xf, st, 0, 0, 0); }
                    *(u32x2*)(hp + (size_t)(16 * pt + r16) * 128 + 16 * wave + 4 * q4) = (u32x2){pg8::cvt_pk_bf16(st[0], st[1]), pg8::cvt_pk_bf16(st[2], st[3])}; }
            }
            __syncthreads();
        }
    }
}
DEV void ph_ssd_scan(const Args& a, const Ctx& X, const int wg0) {
    bf16_t* states = (bf16_t*)(a.ws + WS_STATES); const float* cdec = (const float*)(a.ws + WS_CDEC);
    for (int task = (X.bid - wg0) * NTHR + X.tid; task < NB * 16 * 64 * 32; task += (X.G - wg0) * NTHR) {
        const int n4 = task & 31, p = (task >> 5) & 63, hd = (task >> 11) & 15, b = task >> 15;
        float h0 = 0.f, h1 = 0.f, h2 = 0.f, h3 = 0.f;
        for (int c = 0; c < 32; ++c) {
            const int unit = (b * 32 + c) * 2 + (hd >> 3);
            u32x2* ptr = (u32x2*)(states + ((size_t)(unit * 8 + (hd & 7)) * 64 + p) * 128 + 4 * n4);
            const u32x2 sv = *ptr; const float dec = cdec[(size_t)unit * 32 + (hd & 7)];
            *ptr = (u32x2){pk2(h0, h1), pk2(h2, h3)};
            h0 = h0 * dec + __uint_as_float(sv.x << 16); h1 = h1 * dec + __uint_as_float(sv.x & 0xFFFF0000u); h2 = h2 * dec + __uint_as_float(sv.y << 16); h3 = h3 * dec + __uint_as_float(sv.y & 0xFFFF0000u);
        }
    }
}
DEV void ph_ssd_out(const Args& a, const Ctx& X, const int wg0) {
    const bf16_t* CC = (const bf16_t*)(a.ws + WS_CC); const float* acum = (const float*)(a.ws + WS_ACUM); const bf16_t* ydiag = (const bf16_t*)(a.ws + WS_YDIAG);
    const bf16_t* states = (const bf16_t*)(a.ws + WS_STATES); const bf16_t* zb = (const bf16_t*)(a.ws + WS_ZB); bf16_t* oy = (bf16_t*)(a.ws + WS_OY);
    const int lane = X.lane, wave = X.wave, r16 = lane & 15, q4 = lane >> 4;
    for (int unit = X.bid - wg0; unit < NB * 32 * 2; unit += X.G - wg0) {
        const int g = unit & 1, c = (unit >> 1) & 31, b = unit >> 6; const size_t t = (size_t)b * SEQ + 128 * c + 16 * wave + r16;
        bf16x8 cf[4];
#pragma unroll
        for (int ks = 0; ks < 4; ++ks) cf[ks] = *(const bf16x8*)(CC + t * 256 + g * 128 + 32 * ks + 8 * q4);
        float ss = 0.f;
        LAS u32x2* stash = (LAS u32x2*)(X.lds + wave * 16384);
        for (int r = 0; r < 8; ++r) {
            const int hd = g * 8 + r; const float eac = __expf(acum[((size_t)g * T + t) * 8 + r]);
            const bf16_t* hp = states + ((size_t)(unit * 8 + r) * 64) * 128;
#pragma unroll
            for (int pt = 0; pt < 4; ++pt) { f32x4 acc = {0.f, 0.f, 0.f, 0.f};
#pragma unroll
                for (int ks = 0; ks < 4; ++ks) { const bf16x8 hf = *(const bf16x8*)(hp + (size_t)(16 * pt + r16) * 128 + 32 * ks + 8 * q4); acc = __builtin_amdgcn_mfma_f32_16x16x32_bf16(hf, cf[ks], acc, 0, 0, 0); }
                const u32x2 yd = *(const u32x2*)(ydiag + t * 1024 + hd * 64 + 16 * pt + 4 * q4), zz = *(const u32x2*)(zb + t * 1024 + hd * 64 + 16 * pt + 4 * q4);
                f32x4 v; v[0] = acc[0] * eac + __uint_as_float(yd.x << 16); v[1] = acc[1] * eac + __uint_as_float(yd.x & 0xFFFF0000u); v[2] = acc[2] * eac + __uint_as_float(yd.y << 16); v[3] = acc[3] * eac + __uint_as_float(yd.y & 0xFFFF0000u);
                v[0] *= siluf(__uint_as_float(zz.x << 16)); v[1] *= siluf(__uint_as_float(zz.x & 0xFFFF0000u)); v[2] *= siluf(__uint_as_float(zz.y << 16)); v[3] *= siluf(__uint_as_float(zz.y & 0xFFFF0000u));
                ss += v[0] * v[0] + v[1] * v[1] + v[2] * v[2] + v[3] * v[3];
                stash[(r * 4 + pt) * 64 + lane] = (u32x2){pg8::cvt_pk_bf16(v[0], v[1]), pg8::cvt_pk_bf16(v[2], v[3])}; }
        }
        ss += __shfl_xor(ss, 16); ss += __shfl_xor(ss, 32);
        const float rstd = rsqrtf(ss * (1.f / 512.f) + EPS);
        for (int r = 0; r < 8; ++r)
#pragma unroll
            for (int pt = 0; pt < 4; ++pt) { const int cix = g * 512 + r * 64 + 16 * pt + 4 * q4; const f32x4 nw = *(const f32x4*)(a.ssd_norm_w + cix); const u32x2 w = stash[(r * 4 + pt) * 64 + lane];
                *(u32x2*)(oy + t * 2048 + 1024 + cix) = (u32x2){pg8::cvt_pk_bf16(__uint_as_float(w.x << 16) * rstd * nw[0], __uint_as_float(w.x & 0xFFFF0000u) * rstd * nw[1]), pg8::cvt_pk_bf16(__uint_as_float(w.y << 16) * rstd * nw[2], __uint_as_float(w.y & 0xFFFF0000u) * rstd * nw[3])}; }
    }
}


DEV void ph_attn(const Args& a, const Ctx& X) {
    const bf16_t* qkv = (const bf16_t*)(a.ws + WS_Q1KV); bf16_t* po = (bf16_t*)(a.ws + WS_PO); float* plse = (float*)(a.ws + WS_PLSE); unsigned char* o = a.ws + WS_O1;
    LAS unsigned char* vl = X.lds + X.wave * 12288;
    LAS unsigned char* kl = vl + 6144;
    const int lane = X.lane, q = lane & 31, h5 = lane >> 5;
    const int tr_off = ((lane & 15) >> 2) * 192 + (16 * ((lane >> 4) & 1) + 4 * (lane & 3)) * 2;
    const int prow = lane >> 3, pch = lane & 7;
    for (int unit = X.bid; unit < NB * 16 * 4; unit += X.G) {
        const int bhd = unit & 63, b = bhd >> 4, hd = bhd & 15, g = unit >> 6;
        for (int tk = 0; tk < 6; ++tk) {
            const int br = tk >> 1, idx = X.wave * 2 + (tk & 1);
            int d, r, I0;
            if (br == 0) { d = 1; r = 0; I0 = 1024 * g + 64 * idx; } else if (br == 1) { d = 4; r = idx & 3; I0 = 256 * g + 64 * (idx >> 2); } else { d = 16; r = idx; I0 = 64 * g; }
#define ATT_LOAD(dst, j0_, coff) do { _Pragma("unroll") for (int _i = 0; _i < 4; ++_i) { const size_t _t = (size_t)b * SEQ + (size_t)((j0_) + 8 * _i + prow) * d + r; \
                dst[_i] = *(const u32x4*)(qkv + _t * 3072 + (coff) + hd * 64 + pch * 8); } } while (0)
            u32x4 k0[4], v0[4], k1[4], v1[4];
            const bool e3 = (I0 - 32) >= 0, e2 = (I0 - 64) >= 0, e1 = (I0 - 96) >= 0, e0 = (I0 - 128) >= 0;
            ATT_LOAD(k0, I0, 0); ATT_LOAD(k1, I0 + 32, 0);
            bf16x8 qA[4], qB[4];
#pragma unroll
            for (int i = 0; i < 4; ++i) *(LAS u32x4*)(kl + (8 * i + prow) * 144 + pch * 16) = k0[i];
#pragma unroll
            for (int s = 0; s < 4; ++s) qA[s] = *(const LAS bf16x8*)(kl + q * 144 + (16 * s + 8 * h5) * 2);
            LDS_WAIT();
#pragma unroll
            for (int i = 0; i < 4; ++i) *(LAS u32x4*)(kl + (8 * i + prow) * 144 + pch * 16) = k1[i];
#pragma unroll
            for (int s = 0; s < 4; ++s) qB[s] = *(const LAS bf16x8*)(kl + q * 144 + (16 * s + 8 * h5) * 2);
            LDS_WAIT();
            ATT_LOAD(k0, I0 + 32, 1024); ATT_LOAD(v0, I0 + 32, 2048);
            ATT_LOAD(k1, I0, 1024); ATT_LOAD(v1, I0, 2048);
            f32x16 oA[2], oB[2];
#pragma unroll
            for (int i = 0; i < 16; ++i) { oA[0][i] = 0.f; oA[1][i] = 0.f; oB[0][i] = 0.f; oB[1][i] = 0.f; }
            float mA = -1e30f, lA = 0.f, mB = -1e30f, lB = 0.f;
            auto scores = [&](const bf16x8 (&kf)[4], const bf16x8 (&qf)[4], f32x16 (&oacc)[2], float& m, float& l, const int mode, bf16x8 (&pf)[2]) {
                f32x16 sacc;
#pragma unroll
                for (int i = 0; i < 16; ++i) sacc[i] = 0.f;
#pragma unroll
                for (int s = 0; s < 4; ++s) sacc = __builtin_amdgcn_mfma_f32_32x32x16_bf16(kf[s], qf[s], sacc, 0, 0, 0);
                if (mode == 1) {
#pragma unroll
                    for (int i = 0; i < 16; ++i) { const int kl_ = (i & 3) + 8 * (i >> 2) + 4 * h5; if (kl_ > q) sacc[i] = -1e30f; }
                } else if (mode == 2) {
#pragma unroll
                    for (int i = 0; i < 16; ++i) { const int kl_ = (i & 3) + 8 * (i >> 2) + 4 * h5; if (kl_ < q) sacc[i] = -1e30f; }
                }
                float mx = sacc[0];
#pragma unroll
                for (int i = 1; i < 16; ++i) mx = fmaxf(mx, sacc[i]);
                mx = fmaxf(mx, __shfl_xor(mx, 32));
                const float mn = fmaxf(m, mx), alpha = __expf(m - mn);
                float rs = 0.f;
#pragma unroll
                for (int i = 0; i < 16; ++i) { sacc[i] = __expf(sacc[i] - mn); rs += sacc[i]; }
                rs += __shfl_xor(rs, 32);
                l = l * alpha + rs; m = mn;
#pragma unroll
                for (int i = 0; i < 16; ++i) { oacc[0][i] *= alpha; oacc[1][i] *= alpha; }
#pragma unroll
                for (int s = 0; s < 2; ++s) { u32x4 w; w.x = pg8::cvt_pk_bf16(sacc[8 * s], sacc[8 * s + 1]); w.y = pg8::cvt_pk_bf16(sacc[8 * s + 2], sacc[8 * s + 3]); w.z = pg8::cvt_pk_bf16(sacc[8 * s + 4], sacc[8 * s + 5]); w.w = pg8::cvt_pk_bf16(sacc[8 * s + 6], sacc[8 * s + 7]);
                    pf[s] = __builtin_bit_cast(bf16x8, w); }
            };
            auto tile = [&](const u32x4 (&kp)[4], const u32x4 (&vp)[4], const int ma, const int mb) {
#pragma unroll
                for (int i = 0; i < 4; ++i) { *(LAS u32x4*)(kl + (8 * i + prow) * 144 + pch * 16) = kp[i]; *(LAS u32x4*)(vl + (8 * i + prow) * 192 + pch * 16) = vp[i]; }
                bf16x8 kf[4];
#pragma unroll
                for (int s = 0; s < 4; ++s) kf[s] = *(const LAS bf16x8*)(kl + q * 144 + (16 * s + 8 * h5) * 2);
                bf16x8 pA[2], pB[2];
                if (ma >= 0) scores(kf, qA, oA, mA, lA, ma, pA);
                if (mb >= 0) scores(kf, qB, oB, mB, lB, mb, pB);
#pragma unroll
                for (int dt = 0; dt < 2; ++dt)
#pragma unroll
                    for (int s = 0; s < 2; ++s) {
                        const s16x4 t0_ = __builtin_amdgcn_ds_read_tr16_b64_v4i16((LAS s16x4*)(vl + (16 * s + 4 * h5) * 192 + dt * 64 + tr_off));
                        const s16x4 t1_ = __builtin_amdgcn_ds_read_tr16_b64_v4i16((LAS s16x4*)(vl + (16 * s + 8 + 4 * h5) * 192 + dt * 64 + tr_off));
                        bf16x8 vf; vf[0] = t0_[0]; vf[1] = t0_[1]; vf[2] = t0_[2]; vf[3] = t0_[3]; vf[4] = t1_[0]; vf[5] = t1_[1]; vf[6] = t1_[2]; vf[7] = t1_[3];
                        if (ma >= 0) oA[dt] = __builtin_amdgcn_mfma_f32_32x32x16_bf16(vf, pA[s], oA[dt], 0, 0, 0);
                        if (mb >= 0) oB[dt] = __builtin_amdgcn_mfma_f32_32x32x16_bf16(vf, pB[s], oB[dt], 0, 0, 0);
                    }
                LDS_WAIT();
            };
            tile(k0, v0, -1, 1);
            if (e3) { ATT_LOAD(k0, I0 - 32, 1024); ATT_LOAD(v0, I0 - 32, 2048); }
            tile(k1, v1, 1, 0);
            if (e3) {
                if (e2) { ATT_LOAD(k1, I0 - 64, 1024); ATT_LOAD(v1, I0 - 64, 2048); }
                tile(k0, v0, 0, 0);
                if (e2) {
                    if (e1) { ATT_LOAD(k0, I0 - 96, 1024); ATT_LOAD(v0, I0 - 96, 2048); }
                    tile(k1, v1, 0, 0);
                    if (e1) {
                        if (e0) { ATT_LOAD(k1, I0 - 128, 1024); ATT_LOAD(v1, I0 - 128, 2048); }
                        tile(k0, v0, 0, 2);
                        if (e0) tile(k1, v1, 2, -1);
                    }
                }
            }
#undef ATT_LOAD
#pragma unroll
            for (int qt = 0; qt < 2; ++qt) {
                const size_t tq = (size_t)b * SEQ + (size_t)(I0 + 32 * qt + q) * d + r;
                const float l = qt ? lB : lA, m = qt ? mB : mA; const float inv = 1.f / l;
                bf16_t* pr = po + ((size_t)br * T + tq) * 1024 + hd * 64;
#pragma unroll
                for (int dt = 0; dt < 2; ++dt)
#pragma unroll
                    for (int gq = 0; gq < 4; ++gq) { const f32x16& oo = qt ? oB[dt] : oA[dt]; u32x2 w; w.x = pg8::cvt_pk_bf16(oo[4 * gq] * inv, oo[4 * gq + 1] * inv); w.y = pg8::cvt_pk_bf16(oo[4 * gq + 2] * inv, oo[4 * gq + 3] * inv);
                        *(u32x2*)(pr + 32 * dt + 8 * gq + 4 * h5) = w; }
                if (h5 == 0) plse[((size_t)br * T + tq) * 16 + hd] = m + __logf(l);
            }
        }
        VM_WAIT(); __syncthreads();
        for (int hf = 0; hf < 2; ++hf) {
            const size_t t = (size_t)b * SEQ + 1024 * g + 512 * hf + X.tid;
            const float l0 = plse[t * 16 + hd], l1 = plse[((size_t)T + t) * 16 + hd], l2 = plse[((size_t)2 * T + t) * 16 + hd];
            const float mx = fmaxf(l0, fmaxf(l1, l2)); float w0 = __expf(l0 - mx), w1 = __expf(l1 - mx), w2 = __expf(l2 - mx); const float wi = 1.f / (w0 + w1 + w2); w0 *= wi; w1 *= wi; w2 *= wi;
            const bf16_t* p0 = po + t * 1024 + hd * 64; const bf16_t* p1 = p0 + (size_t)T * 1024; const bf16_t* p2 = p1 + (size_t)T * 1024; unsigned char* orow = o + t * 1024 + hd * 64;
            w0 *= 4.f; w1 *= 4.f; w2 *= 4.f;
            u32x4 yq[4];
#pragma unroll
            for (int c = 0; c < 8; ++c) { const u32x4 x0 = *(const u32x4*)(p0 + 8 * c), x1 = *(const u32x4*)(p1 + 8 * c), x2 = *(const u32x4*)(p2 + 8 * c); float f[8];
#pragma unroll
                for (int e = 0; e < 4; ++e) { f[2 * e] = w0 * __uint_as_float(x0[e] << 16) + w1 * __uint_as_float(x1[e] << 16) + w2 * __uint_as_float(x2[e] << 16);
                    f[2 * e + 1] = w0 * __uint_as_float(x0[e] & 0xFFFF0000u) + w1 * __uint_as_float(x1[e] & 0xFFFF0000u) + w2 * __uint_as_float(x2[e] & 0xFFFF0000u); }
#pragma unroll
                for (int e = 0; e < 8; ++e) f[e] = fminf(fmaxf(f[e], -440.f), 440.f);
                int v0 = __builtin_amdgcn_cvt_pk_fp8_f32(f[0], f[1], 0, false); v0 = __builtin_amdgcn_cvt_pk_fp8_f32(f[2], f[3], v0, true);
                int v1 = __builtin_amdgcn_cvt_pk_fp8_f32(f[4], f[5], 0, false); v1 = __builtin_amdgcn_cvt_pk_fp8_f32(f[6], f[7], v1, true);
                yq[c >> 1][2 * (c & 1)] = (unsigned)v0; yq[c >> 1][2 * (c & 1) + 1] = (unsigned)v1; }
#pragma unroll
            for (int j = 0; j < 4; ++j) *(u32x4*)(orow + 16 * j) = yq[j];
        }
    }
}

DEV void ph_router(const Args& a, const Ctx& X, const int l) {
    unsigned char* ws = a.ws;
    const float* mod = (const float*)(ws + WS_MOD) + (size_t)l * NB * 6 * D;
    const bf16_t* ymix = (const bf16_t*)(ws + WS_YMIX);
    bf16_t* xb = (bf16_t*)(ws + WS_XB);
    bf16_t* hb = (bf16_t*)(ws + WS_H);
    int* idx = (int*)(ws + WS_IDX); float* gw = (float*)(ws + WS_GW); int* aslot = (int*)(ws + WS_ASLOT); int* ltok = (int*)(ws + WS_LTOK);
    int* cntg = (int*)(ws + WS_CTL + CTL_CNT) + l * NE;
    const float* rw = a.router_w + (size_t)l * D * NE; const float* rbias = a.router_bias + l * NE;
    constexpr int HP = 2064;
    LAS unsigned char* hL = X.lds;
    LAS float* logit = (LAS float*)(X.lds + AUX_OFF + 2048);
    LAS int* lcnt = (LAS int*)(X.lds + AUX_OFF + 2048 + 64 * 65 * 4);
    LAS int* lbase = lcnt + 64;
    LAS int* sel_e = lbase + 64;
    LAS int* sel_s = sel_e + 512;
    const int lane = X.lane, wave = X.wave;
    for (int rb = X.bid; rb < T / 64; rb += X.G) {
        if (X.tid < 64) lcnt[X.tid] = 0;
        f32x4 xf_n[4]; u32x2 xb_n[4], ym_n[4];
#define RT_LOAD(rr) do { const int _row = rb * 64 + wave * 8 + (rr); _Pragma("unroll") for (int _j = 0; _j < 4; ++_j) { \
            if (l == 0) xf_n[_j] = *(const f32x4*)(a.x + (size_t)_row * D + _j * 256 + lane * 4); else xb_n[_j] = *(const u32x2*)(xb + (size_t)_row * D + _j * 256 + lane * 4); \
            ym_n[_j] = *(const u32x2*)(ymix + (size_t)_row * D + _j * 256 + lane * 4); } } while (0)
        RT_LOAD(0);
        for (int r8 = 0; r8 < 8; ++r8) {
            const int lr = wave * 8 + r8, row = rb * 64 + lr, b = row / SEQ; const float* ml = mod + (size_t)b * 6 * D;
            float xv[16], yv[16];
#pragma unroll
            for (int j = 0; j < 4; ++j) {
                if (l == 0) { xv[4 * j] = xf_n[j][0]; xv[4 * j + 1] = xf_n[j][1]; xv[4 * j + 2] = xf_n[j][2]; xv[4 * j + 3] = xf_n[j][3]; }
                else { xv[4 * j] = __uint_as_float(xb_n[j].x << 16); xv[4 * j + 1] = __uint_as_float(xb_n[j].x & 0xFFFF0000u); xv[4 * j + 2] = __uint_as_float(xb_n[j].y << 16); xv[4 * j + 3] = __uint_as_float(xb_n[j].y & 0xFFFF0000u); }
                yv[4 * j] = __uint_as_float(ym_n[j].x << 16); yv[4 * j + 1] = __uint_as_float(ym_n[j].x & 0xFFFF0000u); yv[4 * j + 2] = __uint_as_float(ym_n[j].y << 16); yv[4 * j + 3] = __uint_as_float(ym_n[j].y & 0xFFFF0000u); }
            if (r8 + 1 < 8) RT_LOAD(r8 + 1);
            resid_update(xv, yv, a.mix_post_g + l * D, ml + 2 * D, lane);
            store_row_bf(xb + (size_t)row * D, lane, xv);
            u32x2 o[4]; prenorm_pack(xv, a.ffn_pre_g + l * D, ml + 4 * D, ml + 3 * D, lane, o);
#pragma unroll
            for (int j = 0; j < 4; ++j) { *(LAS u32x2*)(hL + lr * HP + (j * 256 + lane * 4) * 2) = o[j];
                const float h0 = __uint_as_float(o[j].x << 16), h1 = __uint_as_float(o[j].x & 0xFFFF0000u), h2 = __uint_as_float(o[j].y << 16), h3 = __uint_as_float(o[j].y & 0xFFFF0000u);
                int w = __builtin_amdgcn_cvt_pk_fp8_f32(fminf(fmaxf(h0, -440.f), 440.f), fminf(fmaxf(h1, -440.f), 440.f), 0, false); w = __builtin_amdgcn_cvt_pk_fp8_f32(fminf(fmaxf(h2, -440.f), 440.f), fminf(fmaxf(h3, -440.f), 440.f), w, true);
                *(unsigned*)((unsigned char*)hb + (size_t)row * D + j * 256 + lane * 4) = (unsigned)w; }
        }
#undef RT_LOAD
        __syncthreads();
        { const int rt = wave & 3, nh = wave >> 2, r16 = lane & 15, kq = lane >> 4;
          f32x4 acc0 = {0.f, 0.f, 0.f, 0.f}, acc1 = {0.f, 0.f, 0.f, 0.f};
          for (int c = 0; c < 32; ++c) {
              const u32x4 hv = *(const LAS u32x4*)(hL + (rt * 16 + r16) * HP + (32 * c + 8 * kq) * 2);
              const float* rp = rw + (size_t)(32 * c + 8 * kq) * NE + 4 * r16 + 2 * nh;
#pragma unroll
              for (int j = 0; j < 8; ++j) { const unsigned wj = hv[j >> 1]; const float av = (j & 1) ? __uint_as_float(wj & 0xFFFF0000u) : __uint_as_float(wj << 16);
                  const f32x2 bv = *(const f32x2*)(rp + (size_t)j * NE);
                  acc0 = __builtin_amdgcn_mfma_f32_16x16x4f32(av, bv.x, acc0, 0, 0, 0); acc1 = __builtin_amdgcn_mfma_f32_16x16x4f32(av, bv.y, acc1, 0, 0, 0); }
          }
#pragma unroll
          for (int r = 0; r < 4; ++r) { logit[(rt * 16 + 4 * kq + r) * 65 + 4 * r16 + 2 * nh] = acc0[r]; logit[(rt * 16 + 4 * kq + r) * 65 + 4 * r16 + 2 * nh + 1] = acc1[r]; } }
        __syncthreads();
        for (int r8 = 0; r8 < 8; ++r8) {
            const int lr = wave * 8 + r8, t = rb * 64 + lr;
            float lgt = logit[lr * 65 + lane]; if (!(lgt > -1e30f && lgt < 1e30f)) lgt = 0.f;
            const float score = sigmoidf_(lgt), biased = score + rbias[lane];
            float m1 = biased;
#pragma unroll
            for (int o = 1; o < 8; o <<= 1) m1 = fmaxf(m1, __shfl_xor(m1, o));
            int c1 = (biased == m1) ? (lane & 7) : 8;
#pragma unroll
            for (int o = 1; o < 8; o <<= 1) c1 = min(c1, __shfl_xor(c1, o));
            float m2 = ((lane & 7) == c1) ? -INFINITY : biased;
#pragma unroll
            for (int o = 1; o < 8; o <<= 1) m2 = fmaxf(m2, __shfl_xor(m2, o));
            const float gs = m1 + m2; const int myg = lane >> 3; int grank = 0;
#pragma unroll
            for (int g2 = 0; g2 < 8; ++g2) { const float o = __shfl(gs, g2 * 8); grank += (o > gs || (o == gs && g2 < myg)) ? 1 : 0; }
            const float cand = (grank < 4) ? biased : -INFINITY; int rank = 0;
            for (int e2 = 0; e2 < 64; ++e2) { const float o = __shfl(cand, e2); rank += (o > cand || (o == cand && e2 < lane)) ? 1 : 0; }
            const bool sel = (rank < TOPK) && (grank < 4);
            const float ssum = wave_sum(sel ? score : 0.f);
            if (sel) { idx[t * 8 + rank] = lane; gw[t * 8 + rank] = score / ssum * 2.5f; sel_e[lr * 8 + rank] = lane; sel_s[lr * 8 + rank] = __hip_atomic_fetch_add(lcnt + lane, 1, __ATOMIC_RELAXED, __HIP_MEMORY_SCOPE_WORKGROUP); }
        }
        __syncthreads();
        if (X.tid < 64) { const int n = lcnt[X.tid]; lbase[X.tid] = n ? atomicAdd(cntg + X.tid, n) : 0; }
        __syncthreads();
        { const int lr = X.tid >> 3, k = X.tid & 7, t = rb * 64 + lr, e = sel_e[lr * 8 + k], sl = lbase[e] + sel_s[lr * 8 + k];
          aslot[t * 8 + k] = sl; ltok[e * CAP + sl] = t; }
        __syncthreads();
    }
}
template <int NW>
DEV void ph_moe_conv(const Args& a, const Ctx& X, const int l, const int wg0) {
    unsigned char* ws = a.ws;
    if (X.wave >= NW) return;
    { LAS float* scr = (LAS float*)(X.lds + X.wave * 8704);
      const int gwv = (X.bid - wg0) * NW + X.wave, NGW = (X.G - wg0) * NW;
      constexpr int I_GU = (D / 64) * (512 / 32), I_D = (ED / 64) * (D / 32), I_E = I_GU + I_D;
      const float* eg = a.exp_gate + (size_t)l * NE * D * ED; const float* eu = a.exp_up + (size_t)l * NE * D * ED; const float* ed = a.exp_down + (size_t)l * NE * ED * D;
      for (int it = gwv; it < (NE + 1) * I_E; it += NGW) {
          const int e = it / I_E; int r = it - e * I_E;
          if (e < NE) {
              if (r < I_GU) conv_item<SrcGU, true>(SrcGU{eg + (size_t)e * D * ED, (long)(eu - eg)}, ED, D, ws + WS_WGU + (size_t)e * 512 * D, scr, r, 16, X.lane, 64.f);
              else conv_item<SrcIdent, true>(SrcIdent{ed + (size_t)e * ED * D}, D, ED, ws + WS_WD + (size_t)e * D * ED, scr, r - I_GU, D / 32, X.lane, 32.f);
          } else {
              if (r < I_GU) conv_item<SrcGU, true>(SrcGU{a.sh_gate + (size_t)l * D * ED, (long)(a.sh_up - a.sh_gate)}, ED, D, ws + WS_WGUS, scr, r, 16, X.lane, 64.f);
              else conv_item<SrcIdent, true>(SrcIdent{a.sh_down + (size_t)l * ED * D}, D, ED, ws + WS_WDS, scr, r - I_GU, D / 32, X.lane, 32.f);
          }
      } }
}

DEV int moe_tables(const Args& a, const Ctx& X, const int l, LAS int* t_cnt, LAS int* t_rb0, LAS int* t_eofrb) {
    const int* cntg = (const int*)(a.ws + WS_CTL + CTL_CNT) + l * NE;
    if (X.wave == 0) {
        const int c = __hip_atomic_load(cntg + X.lane, __ATOMIC_RELAXED, __HIP_MEMORY_SCOPE_AGENT), nrb = (c + 255) >> 8;
        int incl = nrb;
#pragma unroll
        for (int o = 1; o < 64; o <<= 1) { const int v = __shfl_up(incl, o); if (X.lane >= o) incl += v; }
        const int excl = incl - nrb;
        t_cnt[X.lane] = c; t_rb0[X.lane] = excl; if (X.lane == 63) t_rb0[64] = incl;
        for (int j = 0; j < nrb; ++j) t_eofrb[excl + j] = X.lane;
        t_eofrb[SH_RB + X.lane] = NE;
    }
    __syncthreads();
    return t_rb0[64];
}

DEV void ph_moe_gu(const Args& a, const Ctx& X, const int l) {
    LAS int* t_cnt = (LAS int*)(X.lds + AUX_OFF + 1024); LAS int* t_rb0 = t_cnt + 64; LAS int* t_eofrb = t_rb0 + 80; LAS int* toks = t_eofrb + NRB_ALL;
    const int nrbt = moe_tables(a, X, l, t_cnt, t_rb0, t_eofrb);
    const int* ltok = (const int*)(a.ws + WS_LTOK);
    pg8::Unit u;
    for (int i = 0; i < 8; ++i) { if (!pg8::moe_unit(i, 2, nrbt, X.G, X.bid, u)) break;
        if (X.tid < 256) { const int e = t_eofrb[u.pm]; int tok;
            if (e < NE) { const int sl = (u.pm - t_rb0[e]) * 256 + X.tid; tok = sl < t_cnt[e] ? ltok[e * CAP + sl] : 0; } else tok = (u.pm - SH_RB) * 256 + X.tid;
            toks[i * 256 + X.tid] = tok; } }
    VM_WAIT(); __syncthreads();
    pg8::SchedGU S{(const char*)(a.ws + WS_H), (const char*)(a.ws + WS_WGU), (const char*)(a.ws + WS_WGUS), t_eofrb, toks, nrbt, X.G, X.bid, 0};
    pg8::EpiGU E{a.ws + WS_HID};
    pg8::gemm_phase<pg8::EpiGU, pg8::SchedGU, true>(X.lds, D, S, E);
}
DEV void ph_moe_down(const Args& a, const Ctx& X, const int l) {
    LAS int* t_cnt = (LAS int*)(X.lds + AUX_OFF + 1024); LAS int* t_rb0 = t_cnt + 64; LAS int* t_eofrb = t_rb0 + 80;
    const int nrbt = moe_tables(a, X, l, t_cnt, t_rb0, t_eofrb);
    pg8::SchedDown S{(const char*)(a.ws + WS_HID), (const char*)(a.ws + WS_WD), (const char*)(a.ws + WS_WDS), t_eofrb, nrbt, X.G, X.bid, 0};
    pg8::EpiFp8 E{(unsigned char*)(a.ws + WS_Y), D, 0};
    int kd = ED; asm volatile("" : "+s"(kd));
    pg8::gemm_phase<pg8::EpiFp8, pg8::SchedDown, true>(X.lds, kd, S, E);
}
DEV void ph_combine(const Args& a, const Ctx& X, const int l) {
    LAS int* t_cnt = (LAS int*)(X.lds + AUX_OFF + 1024); LAS int* t_rb0 = t_cnt + 64; LAS int* t_eofrb = t_rb0 + 80;
    (void)moe_tables(a, X, l, t_cnt, t_rb0, t_eofrb);
    const float* mod = (const float*)(a.ws + WS_MOD);
    const int* idx = (const int*)(a.ws + WS_IDX); const float* gw = (const float*)(a.ws + WS_GW); const int* aslot = (const int*)(a.ws + WS_ASLOT);
    const unsigned char* y = a.ws + WS_Y; unsigned char* h8 = a.ws + WS_H;
    const int lane = X.lane;
    const int tstep = X.G * NWAVES;
    int t = X.bid * NWAVES + X.wave;
    int e_n = 0, s_n = 0; float g_n = 0.f;
    if (t < T && lane < 8) { e_n = idx[t * 8 + lane]; g_n = gw[t * 8 + lane]; s_n = aslot[t * 8 + lane]; }
    for (; t < T; t += tstep) {
        const int b = t / SEQ; const float* ml = mod + (size_t)(l * NB + b) * 6 * D;
        const int e_c = e_n, s_c = s_n; const float g_c = g_n;
        const int tn = t + tstep;
        if (tn < T && lane < 8) { e_n = idx[tn * 8 + lane]; g_n = gw[tn * 8 + lane]; s_n = aslot[tn * 8 + lane]; }
        u32x2 w0[9], w1[9];
        { const unsigned char* yr = y + ((size_t)SH_RB * 256 + t) * D; w0[8] = *(const u32x2*)(yr + 8 * lane); w1[8] = *(const u32x2*)(yr + 512 + 8 * lane); }
        float gk[8];
#pragma unroll
        for (int k = 0; k < 8; ++k) { const int e = __shfl(e_c, k), sl = __shfl(s_c, k); gk[k] = __shfl(g_c, k);
            const unsigned char* yr = y + ((size_t)t_rb0[e] * 256 + sl) * D; w0[k] = *(const u32x2*)(yr + 8 * lane); w1[k] = *(const u32x2*)(yr + 512 + 8 * lane); }
        float xv[16]; load_row8_bf((const bf16_t*)(a.ws + WS_XB) + (size_t)t * D, lane, xv);
        float yv[16];
#pragma unroll
        for (int i = 0; i < 16; ++i) yv[i] = 0.f;
        acc_row8(yv, w0[8], w1[8], 0.125f);
#pragma unroll
        for (int k = 0; k < 8; ++k) acc_row8(yv, w0[k], w1[k], gk[k] * 0.125f);
        resid_update8(xv, yv, a.ffn_post_g + l * D, ml + 5 * D, lane);
        if (l == 0) store_row8_bf((bf16_t*)(a.ws + WS_XB) + (size_t)t * D, lane, xv); else store_row8(a.out + (size_t)t * D, lane, xv);
        if (l == 0) { const float* mn = mod + (size_t)(1 * NB + b) * 6 * D; u32x2 o[2]; prenorm_pack8_f8(xv, a.mix_pre_g + D, mn + D, mn, lane, o);
            *(u32x2*)(h8 + (size_t)t * D + 8 * lane) = o[0]; *(u32x2*)(h8 + (size_t)t * D + 512 + 8 * lane) = o[1]; }
    }
}

constexpr int NPH = 18;
__global__ void __launch_bounds__(NTHR, 2) mega(Args a) {
    extern __shared__ __attribute__((aligned(16))) unsigned char lds_raw[];
    Ctx X; X.lds = (LAS unsigned char*)lds_raw; X.tid = threadIdx.x; X.lane = X.tid & 63; X.wave = __builtin_amdgcn_readfirstlane(X.tid >> 6); X.G = gridDim.x; X.bid = blockIdx.x;
    if (X.tid < 4) ((LAS unsigned*)(X.lds + BAR_OFF))[X.tid] = 0u;
    __syncthreads();
    XcdBarrier bar; bar.bar = (unsigned*)(a.ws + WS_CTL); bar.x = 0; bar.st = nullptr;
    if (!MK_PER_PHASE) bar = xcd_barrier_post((unsigned*)(a.ws + WS_CTL), (volatile LAS unsigned*)(X.lds + BAR_OFF));
    const int lo = a.ph_lo, hi = a.ph_hi;
#define IN(k) (lo <= (k) && (k) < hi)
#define REP(k, ...) do { __VA_ARGS__; if constexpr (((PROBE_MASK >> (k)) & 1u) != 0u) { __syncthreads(); __VA_ARGS__; } } while (0)
#define SEAM(k) do { if (IN(k) && IN((k) + 1)) xcd_barrier(bar); else { VM_WAIT(); __syncthreads(); } } while (0)
    unsigned char* ws = a.ws;
    if (IN(0)) { REP(0, ph_setup(a, X)); SEAM(0); }
    if (IN(1)) { REP(1, ph_prenorm0(a, X)); SEAM(1); }
    if constexpr (((PROBE_MASK >> 24) & 1u) != 0u) { for (int i_ = 0; i_ < 16; ++i_) xcd_barrier(bar); }
    if (IN(2)) {
        pg8::SchedDense S; S.so.init(T, NPROJ, X.G, X.bid); S.A = (const char*)(ws + WS_H); S.Bt = (const char*)(ws + WS_WIN); S.K = D; S.pad_ = 0;
        pg8::EpiProj E{(bf16_t*)(ws + WS_QKVPRE), (bf16_t*)(ws + WS_ZA), (bf16_t*)(ws + WS_XBCPRE), (bf16_t*)(ws + WS_ZB), (float*)(ws + WS_SMALL)};
        REP(2, pg8::gemm_phase<pg8::EpiProj, pg8::SchedDense>(X.lds, D, S, E)); SEAM(2); }
    if (IN(3)) { REP(3, ph_gdn_local(a, X)); REP(20, ph_ssd_local(a, X)); SEAM(3); }
    if (IN(4)) {
        if (X.bid < 32) { REP(4, ph_gdn_scan(a, X)); }
        else { ph_ssd_scan(a, X, 32); group_barrier((unsigned*)(ws + WS_CTL + CTL_GRP), (unsigned)(X.G - 32)); __syncthreads(); REP(5, ph_ssd_out(a, X, 32)); __syncthreads(); REP(22, ph_moe_conv<2>(a, X, 0, 32)); __syncthreads(); REP(23, ph_setup_late(a, X, 32)); }
        SEAM(4); }
    if (IN(6)) {
        pg8::SchedDense S; S.so.init(T, D, X.G, X.bid); S.A = (const char*)(ws + WS_OY); S.Bt = (const char*)(ws + WS_WOUT); S.K = 2048; S.pad_ = 0;
        pg8::EpiBf16 E{(bf16_t*)(ws + WS_YMIX), D, 0};
        REP(6, pg8::gemm_phase<pg8::EpiBf16, pg8::SchedDense>(X.lds, 2048, S, E)); SEAM(6); }
    if (IN(7)) { ph_router(a, X, 0); SEAM(7); }
    if (IN(8)) { REP(8, ph_moe_gu(a, X, 0)); SEAM(8); }
    if (IN(9)) { REP(9, ph_moe_down(a, X, 0)); SEAM(9); }
    if (IN(10)) { ph_combine(a, X, 0); SEAM(10); }
    if (IN(11)) {
        pg8::SchedDense8<0x79797979, 0x7F7F7F7F> S; S.so.init(T, 3072, X.G, X.bid); S.A = (const char*)(ws + WS_H); S.Bt = (const char*)(ws + WS_WQKV); S.K = D; S.pad_ = 0;
        pg8::EpiQKV E{(bf16_t*)(ws + WS_Q1KV), (const float*)(ws + WS_COS), (const float*)(ws + WS_SIN)};
        REP(11, pg8::gemm_phase<pg8::EpiQKV, pg8::SchedDense8<0x79797979, 0x7F7F7F7F>, true>(X.lds, D, S, E)); SEAM(11); }
    if (IN(12)) { REP(12, ph_attn(a, X)); SEAM(12); }
    if (IN(13)) {
        pg8::SchedDense8<0x79797979, 0x7D7D7D7D> S; S.so.init(T, D, X.G, X.bid); S.A = (const char*)(ws + WS_O1); S.Bt = (const char*)(ws + WS_WO); S.K = D; S.pad_ = 0;
        pg8::EpiBf16 E{(bf16_t*)(ws + WS_YMIX), D, 0};
        REP(13, pg8::gemm_phase<pg8::EpiBf16, pg8::SchedDense8<0x79797979, 0x7D7D7D7D>, true>(X.lds, D, S, E)); SEAM(13); }
    if (IN(14)) { ph_router(a, X, 1); REP(14, ph_moe_conv<8>(a, X, 1, 0)); SEAM(14); }
    if (IN(15)) { ph_moe_gu(a, X, 1); SEAM(15); }
    if (IN(16)) { ph_moe_down(a, X, 1); SEAM(16); }
    if (IN(17)) { REP(17, ph_combine(a, X, 1)); }
#undef IN
#undef SEAM
}

extern "C" void kernel_launch(void* const* d_in, const int* in_sizes, int n_in, void* d_out, int out_size, void* d_ws, size_t ws_size, hipStream_t stream) {
    static int grid = 0;
    if (!grid) {
        int dev = 0, cus = 0, per_cu = 0;
        if (hipGetDevice(&dev) != hipSuccess || hipDeviceGetAttribute(&cus, hipDeviceAttributeMultiprocessorCount, dev) != hipSuccess) { fprintf(stderr, "kernel_launch: device query failed\n"); grid = -1; return; }
        if (hipFuncSetAttribute((const void*)mega, hipFuncAttributeMaxDynamicSharedMemorySize, LDS_BYTES) != hipSuccess) { fprintf(stderr, "kernel_launch: hipFuncSetAttribute failed\n"); grid = -1; return; }
        if (hipOccupancyMaxActiveBlocksPerMultiprocessor(&per_cu, (const void*)mega, NTHR, LDS_BYTES) != hipSuccess || per_cu < 1) { fprintf(stderr, "kernel_launch: occupancy query says %d blocks per CU\n", per_cu); grid = -1; return; }
        grid = cus;
        if (grid < 64 || (grid & 7)) { fprintf(stderr, "kernel_launch: unsupported CU count %d\n", cus); grid = -1; return; }
    }
    if (grid < 0) return;
    if (ws_size < WS_END || n_in != 31) { fprintf(stderr, "kernel_launch: workspace %zu < %zu or n_in %d != 31\n", ws_size, (size_t)WS_END, n_in); return; }
    if (hipMemsetAsync((char*)d_ws + WS_CTL, 0, CTL_BYTES, stream) != hipSuccess) { fprintf(stderr, "kernel_launch: memset failed\n"); return; }
    Args a{};
    a.x = (const float*)d_in[0]; a.c = (const float*)d_in[1]; a.pos = (const int*)d_in[2]; a.mod_w = (const float*)d_in[3]; a.mod_b = (const float*)d_in[4];
    a.mix_pre_g = (const float*)d_in[5]; a.mix_post_g = (const float*)d_in[6]; a.ffn_pre_g = (const float*)d_in[7]; a.ffn_post_g = (const float*)d_in[8];
    a.ssm_w_in = (const float*)d_in[9]; a.gdn_conv_w = (const float*)d_in[10]; a.gdn_a_log = (const float*)d_in[11]; a.gdn_dt_bias = (const float*)d_in[12]; a.gdn_norm_w = (const float*)d_in[13];
    a.ssd_conv_w = (const float*)d_in[14]; a.ssd_conv_b = (const float*)d_in[15]; a.ssd_a_log = (const float*)d_in[16]; a.ssd_dt_bias = (const float*)d_in[17]; a.ssd_d = (const float*)d_in[18]; a.ssd_norm_w = (const float*)d_in[19];
    a.ssm_w_out = (const float*)d_in[20]; a.attn_w_qkv = (const float*)d_in[21]; a.attn_w_o = (const float*)d_in[22];
    a.router_w = (const float*)d_in[23]; a.router_bias = (const float*)d_in[24]; a.exp_gate = (const float*)d_in[25]; a.exp_up = (const float*)d_in[26]; a.exp_down = (const float*)d_in[27];
    a.sh_gate = (const float*)d_in[28]; a.sh_up = (const float*)d_in[29]; a.sh_down = (const float*)d_in[30];
    a.out = (float*)d_out; a.ws = (unsigned char*)d_ws;
#if MK_PER_PHASE
    for (int p = 0; p < NPH; ++p) { a.ph_lo = p; a.ph_hi = p + 1; hipLaunchKernelGGL(mega, dim3(grid), dim3(NTHR), LDS_BYTES, stream, a); }
#else
    a.ph_lo = 0; a.ph_hi = NPH;
    hipLaunchKernelGGL(mega, dim3(grid), dim3(NTHR), LDS_BYTES, stream, a);
#endif
}
```

```cpp
#include <hip/hip_runtime.h>
#include <stdint.h>
#include <stdio.h>

#define DEV __device__ __forceinline__
#define LAS __attribute__((address_space(3)))
typedef unsigned short bf16_t;
typedef short bf16x8 __attribute__((ext_vector_type(8)));
typedef float f32x4 __attribute__((ext_vector_type(4)));
typedef float f32x2 __attribute__((ext_vector_type(2)));
typedef unsigned u32x4 __attribute__((ext_vector_type(4)));
typedef unsigned u32x2 __attribute__((ext_vector_type(2)));
typedef float f32x16 __attribute__((ext_vector_type(16)));
typedef short s16x4 __attribute__((ext_vector_type(4)));

#ifndef PROBE_MASK
#define PROBE_MASK 0u
#endif
#ifndef MK_PER_PHASE
#define MK_PER_PHASE 0
#endif

constexpr int NB = 4, SEQ = 4096, T = NB * SEQ, D = 1024;
constexpr int PROJ = 6688, NPROJ = 6912;
constexpr int C_BETA = 4096, C_XBC = 4112, C_ZB = 5648, C_DT = 6672;
constexpr int NE = 64, TOPK = 8, ED = 256, CAP = 16384;
constexpr int SH_RB = 576;
constexpr int NRB_ALL = SH_RB + 64;
constexpr float EPS = 1e-6f;
constexpr int NTHR = 512, NWAVES = 8;
constexpr int LDS_BYTES = 163840;
constexpr int AUX_OFF = 131072;
constexpr int BAR_OFF = LDS_BYTES - 16;

constexpr size_t MiB = 1u << 20;
constexpr size_t WS_CTL = 0, CTL_BYTES = 65536;
constexpr size_t CTL_CNT = 16384;
constexpr size_t CTL_GRP = 20480;
constexpr size_t WS_MOD = 65536;
constexpr size_t WS_COS = 1 * MiB, WS_SIN = 3 * MiB;
constexpr size_t WS_IDX = 5 * MiB, WS_GW = 5 * MiB + 512 * 1024, WS_ASLOT = 6 * MiB, WS_LTOK = 6 * MiB + 512 * 1024;
constexpr size_t WS_SMALL = 11 * MiB;
constexpr size_t WS_WIN = 16 * MiB, WS_WOUT = 30 * MiB, WS_WQKV = 34 * MiB, WS_WO = 40 * MiB;
constexpr size_t WS_H = 44 * MiB;
constexpr size_t WS_QKVPRE = 78 * MiB, WS_XBCPRE = 174 * MiB, WS_ZA = 222 * MiB, WS_ZB = 254 * MiB;
constexpr size_t WS_CC = 16 * MiB, WS_ACUM = 25 * MiB, WS_CDEC = 26 * MiB, WS_YDIAG = 44 * MiB, WS_STATES = 430 * MiB;
constexpr size_t WS_GI = 286 * MiB, GI_UNIT = 73728, WS_GTMP = 462 * MiB, WS_GLAST = 27 * MiB;
constexpr size_t WS_OY = 78 * MiB, WS_YMIX = 286 * MiB, WS_XB = 240 * MiB;
constexpr size_t WS_WD = 478 * MiB, WS_WDS = 510 * MiB + 512 * 1024, WS_HID = 398 * MiB, WS_Y = 78 * MiB, WS_WGU = 142 * MiB, WS_WGUS = 207 * MiB;
constexpr size_t WS_Q1KV = 78 * MiB, WS_O1 = 174 * MiB, WS_PO = 350 * MiB, WS_PLSE = 446 * MiB;
constexpr size_t WS_END = 512 * MiB;

struct Args {
    const float* x; const float* c; const int* pos; const float* mod_w; const float* mod_b;
    const float* mix_pre_g; const float* mix_post_g; const float* ffn_pre_g; const float* ffn_post_g;
    const float* ssm_w_in; const float* gdn_conv_w; const float* gdn_a_log; const float* gdn_dt_bias; const float* gdn_norm_w;
    const float* ssd_conv_w; const float* ssd_conv_b; const float* ssd_a_log; const float* ssd_dt_bias; const float* ssd_d; const float* ssd_norm_w;
    const float* ssm_w_out; const float* attn_w_qkv; const float* attn_w_o;
    const float* router_w; const float* router_bias; const float* exp_gate; const float* exp_up; const float* exp_down;
    const float* sh_gate; const float* sh_up; const float* sh_down;
    float* out; unsigned char* ws; int ph_lo, ph_hi;
};

DEV float bf2f(bf16_t v) { return __uint_as_float(((unsigned)v) << 16); }
DEV unsigned f2bf(float f) { unsigned u = __float_as_uint(f); return (u + 0x7FFFu + ((u >> 16) & 1u)) >> 16; }
DEV unsigned pk2(float lo, float hi) { return f2bf(lo) | (f2bf(hi) << 16); }
DEV float wave_sum(float v) {
#pragma unroll
    for (int o = 32; o > 0; o >>= 1) v += __shfl_xor(v, o);
    return v;
}
DEV float siluf(float x) { return x / (1.f + __expf(-x)); }
DEV float sigmoidf_(float x) { return 1.f / (1.f + __expf(-x)); }
DEV float softplusf(float x) { return fmaxf(x, 0.f) + log1pf(__expf(-fabsf(x))); }
#define LDS_WAIT() asm volatile("s_waitcnt lgkmcnt(0)" ::: "memory")
#define VM_WAIT() asm volatile("s_waitcnt vmcnt(0)" ::: "memory")

#define XB_TMO      128
#define XB_XCNT(j)  (256  + 64 * (j))
#define XB_XSUB(j)  (1280 + 64 * (j))
#define XB_XGEN(j)  (2304 + 64 * (j))
#define XB_TOP      3328
#define XB_TOPGEN   3392
#define XCD_BAR_WORDS 3456
#define XB_SPIN_CAP (1u << 18)
#define LAS __attribute__((address_space(3)))

__device__ __forceinline__ unsigned xb_ld(unsigned* p)              { return __hip_atomic_load(p, __ATOMIC_RELAXED, __HIP_MEMORY_SCOPE_AGENT); }
__device__ __forceinline__ unsigned xb_add(unsigned* p, unsigned v) { return __hip_atomic_fetch_add(p, v, __ATOMIC_RELAXED, __HIP_MEMORY_SCOPE_AGENT); }
__device__ __forceinline__ unsigned xb_xcc_id() { return (unsigned)__builtin_amdgcn_s_getreg((3 << 11) | 20) & 0xFu; }
#define XB_SPIN(cond, bar) do { unsigned _sp = 0; while (cond) { __builtin_amdgcn_s_sleep(1); \
    if ((++_sp & 255u) == 0u) { if (xb_ld(&(bar)[XB_TMO])) break; if (_sp > XB_SPIN_CAP) { atomicAdd(&(bar)[XB_TMO], 1u); break; } } } } while (0)

struct XcdBarrier {
    unsigned* bar; unsigned x;
    volatile LAS unsigned* st;
};

__device__ __forceinline__ XcdBarrier xcd_barrier_post(unsigned* bar, volatile LAS unsigned* st) {
    XcdBarrier b; b.bar = bar; b.x = xb_xcc_id(); b.st = st;
    if (threadIdx.x == 0) (void)xb_add(&bar[XB_XCNT(b.x)], 1u);
    return b;
}
__device__ __forceinline__ void xcd_barrier_complete(unsigned* bar, unsigned x, unsigned& nloc, unsigned& nx) {
    const unsigned G = gridDim.x * gridDim.y * gridDim.z;
    unsigned sum, cnt, mine, sp = 0u;
    for (;;) {
        sum = 0u; cnt = 0u; mine = 0u;
#pragma unroll
        for (unsigned j = 0; j < 16; ++j) { const unsigned c = xb_ld(&bar[XB_XCNT(j)]); sum += c; cnt += (c > 0u) ? 1u : 0u; mine = (j == x) ? c : mine; }
        if (sum == G) break;
        __builtin_amdgcn_s_sleep(1);
        if ((++sp & 255u) == 0u) { if (xb_ld(&bar[XB_TMO])) break; if (sp > XB_SPIN_CAP) { atomicAdd(&bar[XB_TMO], 1u); break; } }
    }
    nloc = mine > 0u ? mine : 1u; nx = cnt > 0u ? cnt : 1u;
}

__device__ __forceinline__ void xcd_barrier(const XcdBarrier& b) {
    asm volatile("s_waitcnt vmcnt(0)" ::: "memory");
    __syncthreads();
    if (threadIdx.x == 0) {
        unsigned* bar = b.bar;
        __builtin_amdgcn_s_waitcnt(0);
        unsigned nloc = b.st[0], nx = b.st[1];
        if (nloc == 0u) { xcd_barrier_complete(bar, b.x, nloc, nx); b.st[0] = nloc; b.st[1] = nx; }
        const unsigned old = xb_add(&bar[XB_XSUB(b.x)], 1u);
        const unsigned gen = old / nloc;
        if (old + 1u == (gen + 1u) * nloc) {
            __builtin_amdgcn_fence(__ATOMIC_RELEASE, "agent");
            asm volatile("s_waitcnt vmcnt(0)" ::: "memory");
            const unsigned og = xb_add(&bar[XB_TOP], 1u);
            const unsigned tg = og / nx;
            if (og + 1u == (tg + 1u) * nx) xb_add(&bar[XB_TOPGEN], 1u);
            else XB_SPIN(xb_ld(&bar[XB_TOPGEN]) == tg, bar);
            __builtin_amdgcn_fence(__ATOMIC_ACQUIRE, "agent");
            xb_add(&bar[XB_XGEN(b.x)], 1u);
            asm volatile("s_waitcnt vmcnt(0)" ::: "memory");
        } else {
            XB_SPIN(xb_ld(&bar[XB_XGEN(b.x)]) == gen, bar);
            __builtin_amdgcn_fence(__ATOMIC_ACQUIRE, "agent");
            asm volatile("s_waitcnt vmcnt(0)" ::: "memory");
        }
    }
    __syncthreads();
}


DEV void group_barrier(unsigned* ctr, const unsigned n) {
    asm volatile("s_waitcnt vmcnt(0)" ::: "memory");
    __syncthreads();
    if (threadIdx.x == 0) {
        __builtin_amdgcn_fence(__ATOMIC_RELEASE, "agent");
        asm volatile("s_waitcnt vmcnt(0)" ::: "memory");
        (void)__hip_atomic_fetch_add(ctr, 1u, __ATOMIC_RELAXED, __HIP_MEMORY_SCOPE_AGENT);
        unsigned sp = 0;
        while (__hip_atomic_load(ctr, __ATOMIC_RELAXED, __HIP_MEMORY_SCOPE_AGENT) < n) { __builtin_amdgcn_s_sleep(2); if (++sp > (1u << 22)) break; }
        __builtin_amdgcn_fence(__ATOMIC_ACQUIRE, "agent");
        asm volatile("s_waitcnt vmcnt(0)" ::: "memory");
    }
    __syncthreads();
}

namespace pg8 {
constexpr int BM = 256, BK = 64, HALF = 128, HTB = HALF * BK * 2, STAGE_BYTES = 8 * HTB, NXCD = 8, WGM = 8;
DEV int lds_byte(int r, int c) { const int st = (r >> 4) * 2 + (c >> 5), rr = r & 15, cc = c & 31, ob = rr * 64 + cc * 2; return st * 1024 + (ob ^ (((ob >> 9) & 1) << 5)); }
DEV void stage_rc(int b, int& R, int& C) { const int st = b / 1024, sb = b % 1024, swz = sb ^ (((sb >> 9) & 1) << 5); R = (st >> 1) * 16 + swz / 64; C = (st & 1) * 32 + (swz % 64) / 2; }
DEV int perm32(int rho) { const int n = rho >> 4, i = rho & 15; return 8 * (i >> 2) + 4 * n + (i & 3); }
struct Unit { int pm, pn, e, slot; };
struct StaticOrder {
    int nM, nN, nwg, G, c;
    DEV void init(int M, int N, int G_, int c_) { nM = M / BM; nN = N / BM; nwg = nM * nN; G = G_; c = c_; }
    DEV bool next(int i, int& pm, int& pn) const {
        const long L = (long)i * G + c; if (L >= nwg) return false;
        int wgid = (int)L; { const int q = nwg / NXCD, r = nwg % NXCD, xcd = wgid % NXCD, off = wgid / NXCD; wgid = (xcd < r ? xcd * (q + 1) : r * (q + 1) + (xcd - r) * q) + off; }
        const int nig = WGM * nN, gid = wgid / nig, fm = gid * WGM, gsz = (nM - fm) < WGM ? (nM - fm) : WGM;
        pm = fm + ((wgid % nig) % gsz); pn = (wgid % nig) / gsz; return true;
    }
};
typedef __bf16 bf16x2_t __attribute__((ext_vector_type(2)));
DEV unsigned cvt_pk_bf16(float lo, float hi) { const bf16x2_t v = {(__bf16)lo, (__bf16)hi}; return __builtin_bit_cast(unsigned, v); }
DEV u32x4 pack8(const f32x4 a, const f32x4 b) { u32x4 w; w.x = cvt_pk_bf16(a[0], a[1]); w.y = cvt_pk_bf16(a[2], a[3]); w.z = cvt_pk_bf16(b[0], b[1]); w.w = cvt_pk_bf16(b[2], b[3]); return w; }

typedef int v8i_t __attribute__((ext_vector_type(8)));
template <class Epi, class Sched, bool F8 = false>
DEV void gemm_phase(LAS unsigned char* lds, const int K, const Sched& S, const Epi& E) {
    const int tid = threadIdx.x, wid = __builtin_amdgcn_readfirstlane(tid >> 6), lane = tid & 63, wr = wid >> 2, wc = wid & 3, fr = lane & 15, fq = lane >> 4;
    const int nt = F8 ? K / 128 : K / BK;
    const int pitch = F8 ? K : 2 * K;
    unsigned voffB[2];
#pragma unroll
    for (int i = 0; i < 2; ++i) { int R, C; stage_rc(tid * 16 + i * 8192, R, C); const int Rb = Epi::PERM ? ((R & ~31) + perm32(R & 31)) : R; voffB[i] = (unsigned)(Rb * pitch + 2 * C); }
    const unsigned kstep = (unsigned)(BK * 2);
    const size_t hstep = (size_t)HALF * pitch;
    const unsigned ldsw = (unsigned)wid * 1024u;
    const int aoff = lds_byte(wr * 64 + fr, fq * 8), boff = lds_byte(wc * 32 + fr, fq * 8);
    const size_t hsA = Sched::GATHER ? (size_t)0 : hstep;
#define PG8_SA(b, h) (((b) * 2 + (h)) * HTB)
#define PG8_SB(b, h) ((4 + (b) * 2 + (h)) * HTB)
#define PG8_STAGEB(bufoff, gbase) do { _Pragma("unroll") for (int _i = 0; _i < 2; ++_i) \
        __builtin_amdgcn_global_load_lds((const unsigned*)((const char*)(gbase) + voffB[_i]), (LAS unsigned*)(lds + (bufoff) + ldsw + _i * 8192), 16, 0, 0); } while (0)
#define PG8_STAGEA(bufoff, gbase, VO) do { _Pragma("unroll") for (int _i = 0; _i < 2; ++_i) \
        __builtin_amdgcn_global_load_lds((const unsigned*)((const char*)(gbase) + (VO)[_i]), (LAS unsigned*)(lds + (bufoff) + ldsw + _i * 8192), 16, 0, 0); } while (0)
#define PG8_LD8(var, base) do { const u32x4 _l0 = *(const LAS u32x4*)(lds + (base)), _l1 = *(const LAS u32x4*)(lds + (base) + 1024); var = __builtin_shufflevector(_l0, _l1, 0, 1, 2, 3, 4, 5, 6, 7); } while (0)
#define PG8_LDA(dst, b, h) do { if constexpr (F8) { PG8_LD8(dst##8_0, PG8_SA(b, h) + aoff); PG8_LD8(dst##8_1, PG8_SA(b, h) + aoff + 2048); PG8_LD8(dst##8_2, PG8_SA(b, h) + aoff + 4096); PG8_LD8(dst##8_3, PG8_SA(b, h) + aoff + 6144); } \
        else { _Pragma("unroll") for (int m = 0; m < 4; ++m) _Pragma("unroll") for (int k = 0; k < 2; ++k) dst[m][k] = *(const LAS bf16x8*)(lds + PG8_SA(b, h) + aoff + m * 2048 + k * 1024); } } while (0)
#define PG8_LDB(dst, b, h) do { if constexpr (F8) { PG8_LD8(dst##8_0, PG8_SB(b, h) + boff); PG8_LD8(dst##8_1, PG8_SB(b, h) + boff + 2048); } \
        else { _Pragma("unroll") for (int n = 0; n < 2; ++n) _Pragma("unroll") for (int k = 0; k < 2; ++k) dst[n][k] = *(const LAS bf16x8*)(lds + PG8_SB(b, h) + boff + n * 2048 + k * 1024); } } while (0)
#define PG8_M8(ai, bj, m, n, A8, B8) asm volatile("v_mfma_scale_f32_16x16x128_f8f6f4 %0, %1, %2, %0, %3, %4 op_sel_hi:[0,0,0]" : "+v"(acc[ai][bj][m][n]) : "v"(B8), "v"(A8), "v"(wsc_), "v"(asc_))
#define PG8_M8Z(ai, bj, m, n, A8, B8) asm volatile("v_mfma_scale_f32_16x16x128_f8f6f4 %0, %1, %2, %0, %3, %4 op_sel_hi:[0,0,0]" : "+v"(acc[ai][bj][m][n]) : "v"(B8), "v"(A8), "v"(zsc_), "v"(zsc_))
#define PG8_MMA(ai, bj, At, Bt) do { __builtin_amdgcn_s_setprio(1); \
        if constexpr (F8) { PG8_M8(ai, bj, 0, 0, At##8_0, Bt##8_0); PG8_M8(ai, bj, 0, 1, At##8_0, Bt##8_1); PG8_M8(ai, bj, 1, 0, At##8_1, Bt##8_0); PG8_M8(ai, bj, 1, 1, At##8_1, Bt##8_1); \
                            PG8_M8(ai, bj, 2, 0, At##8_2, Bt##8_0); PG8_M8(ai, bj, 2, 1, At##8_2, Bt##8_1); PG8_M8(ai, bj, 3, 0, At##8_3, Bt##8_0); PG8_M8(ai, bj, 3, 1, At##8_3, Bt##8_1); \
            if constexpr (((PROBE_MASK >> 26) & 1u) != 0u) { PG8_M8Z(ai, bj, 0, 0, At##8_0, Bt##8_0); PG8_M8Z(ai, bj, 0, 1, At##8_0, Bt##8_1); PG8_M8Z(ai, bj, 1, 0, At##8_1, Bt##8_0); PG8_M8Z(ai, bj, 1, 1, At##8_1, Bt##8_1); \
                            PG8_M8Z(ai, bj, 2, 0, At##8_2, Bt##8_0); PG8_M8Z(ai, bj, 2, 1, At##8_2, Bt##8_1); PG8_M8Z(ai, bj, 3, 0, At##8_3, Bt##8_0); PG8_M8Z(ai, bj, 3, 1, At##8_3, Bt##8_1); } } \
        else { _Pragma("unroll") for (int m = 0; m < 4; ++m) _Pragma("unroll") for (int n = 0; n < 2; ++n) _Pragma("unroll") for (int k = 0; k < 2; ++k) acc[ai][bj][m][n] = __builtin_amdgcn_mfma_f32_16x16x32_bf16(Bt[n][k], At[m][k], acc[ai][bj][m][n], 0, 0, 0); } \
        __builtin_amdgcn_s_setprio(0); } while (0)
#define PG8_WAIT_V(n) asm volatile("s_waitcnt vmcnt(" #n ")" ::: "memory")
#define PG8_WAIT_L(n) asm volatile("s_waitcnt lgkmcnt(" #n ")" ::: "memory")
#define PG8_BAR __builtin_amdgcn_s_barrier()
#define PG8_SCHED __builtin_amdgcn_sched_barrier(0)
    Unit cur, nxt; int ui = 0;
    if (!S.next(0, cur)) return;
    f32x4 acc[2][2][4][2];
#pragma unroll
    for (int a = 0; a < 2; ++a)
#pragma unroll
        for (int b = 0; b < 2; ++b)
#pragma unroll
            for (int m = 0; m < 4; ++m)
#pragma unroll
                for (int n = 0; n < 2; ++n) acc[a][b][m][n] = (f32x4){0.f, 0.f, 0.f, 0.f};
    bf16x8 At[4][2], B0[2][2], B1[2][2];
    typedef unsigned u32x8_t __attribute__((ext_vector_type(8)));
    u32x8_t At8_0, At8_1, At8_2, At8_3, B08_0, B08_1, B18_0, B18_1;
    int zsc_ = 0; asm volatile("" : "+v"(zsc_));
    const int wsc_ = Sched::WSCALE, asc_ = Sched::ASCALE;
    unsigned va[2][2];
    S.a_voff(cur, tid, va);
    const char* cA = S.a_ptr(cur);
    const char* cB = S.b_ptr(cur);
    PG8_STAGEB(PG8_SB(0, 0), cB); PG8_STAGEB(PG8_SB(0, 1), cB + hstep); PG8_STAGEA(PG8_SA(0, 0), cA, va[0]); PG8_STAGEA(PG8_SA(0, 1), cA + hsA, va[1]);
    if (wr == 1) PG8_BAR;
    PG8_WAIT_V(2); PG8_BAR;
    PG8_STAGEB(PG8_SB(1, 0), cB + kstep); PG8_STAGEA(PG8_SA(1, 0), cA + kstep, va[0]); PG8_STAGEB(PG8_SB(1, 1), cB + hstep + kstep);
    PG8_WAIT_V(6); PG8_BAR;
    for (;;) {
        const bool has_next = S.next(ui + 1, nxt);
        const char* nB = has_next ? S.b_ptr(nxt) : cB;
        const char* nA = has_next ? S.a_ptr(nxt) : cA;
        for (int t = 0; t < nt; t += 2) {
            const bool last = (t == nt - 2);
            const char* a1 = cA + (size_t)(t + 1) * kstep;
            const char* a2 = last ? nA : cA + (size_t)(t + 2) * kstep; const char* a3 = a2 + kstep;
            unsigned v2[2][2];
            v2[0][0] = va[0][0]; v2[0][1] = va[0][1]; v2[1][0] = va[1][0]; v2[1][1] = va[1][1];
            if constexpr (Sched::GATHER) { if (last && has_next) S.a_voff(nxt, tid, v2); }
            const char* b2 = last ? nB : cB + (size_t)(t + 2) * kstep; const char* b3 = b2 + kstep;
            PG8_LDB(B0, 0, 0); PG8_LDB(B1, 0, 1); PG8_SCHED; PG8_LDA(At, 0, 0); PG8_STAGEA(PG8_SA(1, 1), a1 + hsA, va[1]);
            PG8_WAIT_V(8); PG8_WAIT_L(0); PG8_BAR; PG8_MMA(0, 0, At, B0); PG8_MMA(0, 1, At, B1); PG8_BAR; PG8_SCHED;
            PG8_LDA(At, 0, 1); PG8_STAGEB(PG8_SB(0, 0), b2); PG8_STAGEB(PG8_SB(0, 1), b2 + hstep); PG8_STAGEA(PG8_SA(0, 0), a2, v2[0]);
            PG8_WAIT_V(8); PG8_WAIT_L(0); PG8_BAR; PG8_MMA(1, 0, At, B0); PG8_MMA(1, 1, At, B1); PG8_BAR; PG8_SCHED;
            PG8_LDB(B0, 1, 0); PG8_LDB(B1, 1, 1); PG8_SCHED; PG8_LDA(At, 1, 0); PG8_STAGEA(PG8_SA(0, 1), a2 + hsA, v2[1]);
            PG8_WAIT_V(8); PG8_WAIT_L(0); PG8_BAR; PG8_MMA(0, 0, At, B0); PG8_MMA(0, 1, At, B1); PG8_BAR; PG8_SCHED;
            PG8_LDA(At, 1, 1); PG8_STAGEB(PG8_SB(1, 0), b3); PG8_STAGEB(PG8_SB(1, 1), b3 + hstep); PG8_STAGEA(PG8_SA(1, 0), a3, v2[0]);
            PG8_WAIT_V(8); PG8_WAIT_L(0); PG8_BAR; PG8_MMA(1, 0, At, B0); PG8_MMA(1, 1, At, B1); PG8_BAR; PG8_SCHED;
        }
        if (wr == 0) PG8_BAR;
        if constexpr (F8) asm volatile("s_nop 15\n\ts_nop 15" ::: "memory");
        E(acc, cur, wr, wc, fr, fq);
        if (!has_next) break;
#pragma unroll
        for (int a = 0; a < 2; ++a)
#pragma unroll
            for (int b = 0; b < 2; ++b)
#pragma unroll
                for (int m = 0; m < 4; ++m)
#pragma unroll
                    for (int n = 0; n < 2; ++n) acc[a][b][m][n] = (f32x4){0.f, 0.f, 0.f, 0.f};
        cur = nxt; cB = nB; cA = nA; ++ui;
        if constexpr (Sched::GATHER) S.a_voff(cur, tid, va);
        if (wr == 1) PG8_BAR;
    }
    PG8_WAIT_V(0);
    PG8_BAR;
#undef PG8_SA
#undef PG8_SB
#undef PG8_STAGEA
#undef PG8_STAGEB
#undef PG8_LDA
#undef PG8_LD8
#undef PG8_M8
#undef PG8_LDB
#undef PG8_MMA
#undef PG8_WAIT_V
#undef PG8_WAIT_L
#undef PG8_BAR
#undef PG8_SCHED
}

struct SchedDense {
    static constexpr bool GATHER = false; static constexpr int WSCALE = 0x7F7F7F7F, ASCALE = 0x7F7F7F7F;
    StaticOrder so; const char* A; const char* Bt; int K; int pad_;
    DEV bool next(int i, Unit& u) const { int pm, pn; if (!so.next(i, pm, pn)) return false; u.pm = pm; u.pn = pn; u.e = 0; u.slot = 0; return true; }
    DEV const char* a_ptr(const Unit& u) const { return A + (size_t)u.pm * 256 * K * 2; }
    DEV void a_voff(const Unit&, const int tid, unsigned (&vo)[2][2]) const {
#pragma unroll
        for (int i = 0; i < 2; ++i) { int R, C; stage_rc(tid * 16 + i * 8192, R, C); vo[0][i] = vo[1][i] = (unsigned)((R * K + C) * 2); }
    }
    DEV const char* b_ptr(const Unit& u) const { return Bt + (size_t)u.pn * 256 * K * 2; }
};
template <int WS_, int AS_> struct SchedDense8 {
    static constexpr bool GATHER = false; static constexpr int WSCALE = WS_, ASCALE = AS_;
    StaticOrder so; const char* A; const char* Bt; int K; int pad_;
    DEV bool next(int i, Unit& u) const { int pm, pn; if (!so.next(i, pm, pn)) return false; u.pm = pm; u.pn = pn; u.e = 0; u.slot = 0; return true; }
    DEV const char* a_ptr(const Unit& u) const { return A + (size_t)u.pm * 256 * K; }
    DEV void a_voff(const Unit&, const int tid, unsigned (&vo)[2][2]) const {
#pragma unroll
        for (int i = 0; i < 2; ++i) { int R, C; stage_rc(tid * 16 + i * 8192, R, C); vo[0][i] = vo[1][i] = (unsigned)(R * K + 2 * C); }
    }
    DEV const char* b_ptr(const Unit& u) const { return Bt + (size_t)u.pn * 256 * K; }
};
DEV bool moe_unit(int i, int NJ, int nrbt, int G, int c, Unit& u) {
    const int n = (nrbt + 64) * NJ; int L;
    if (G & 7) { L = i * G + c; if (L >= n) return false; }
    else { const int gq = G >> 3, per = (n + 7) >> 3, x = c & 7, q = c >> 3, j = i * gq + q; if (j >= per) return false; L = x * per + j; if (L >= n) return false; }
    int grb = L / NJ; const int pn = L - grb * NJ; if (grb >= nrbt) grb = SH_RB + (grb - nrbt);
    u.pm = grb; u.pn = pn; u.slot = i; u.e = 0; return true;
}
struct SchedGU {
    static constexpr bool GATHER = true; static constexpr int WSCALE = 0x79797979, ASCALE = 0x7F7F7F7F;
    const char* A; const char* Wgu; const char* Wgus; const LAS int* eofrb; const LAS int* toks; int nrbt, G, c, pad_;
    DEV bool next(int i, Unit& u) const { if (!moe_unit(i, 2, nrbt, G, c, u)) return false; u.e = __builtin_amdgcn_readfirstlane(eofrb[u.pm]); return true; }
    DEV const char* a_ptr(const Unit&) const { return A; }
    DEV void a_voff(const Unit& u, const int tid, unsigned (&vo)[2][2]) const {
#pragma unroll
        for (int i = 0; i < 2; ++i) { int R, C; stage_rc(tid * 16 + i * 8192, R, C);
#pragma unroll
            for (int h = 0; h < 2; ++h) { const int tok = toks[u.slot * 256 + h * 128 + R]; vo[h][i] = (unsigned)(tok * D + 2 * C); } }
    }
    DEV const char* b_ptr(const Unit& u) const { return (u.e < NE ? Wgu + (size_t)u.e * 512 * D : Wgus) + (size_t)u.pn * 256 * D; }
};
struct SchedDown {
    static constexpr bool GATHER = false; static constexpr int WSCALE = 0x7A7A7A7A, ASCALE = 0x7F7F7F7F;
    const char* A; const char* Wd; const char* Wds; const LAS int* eofrb; int nrbt, G, c, pad_;
    DEV bool next(int i, Unit& u) const { if (!moe_unit(i, 4, nrbt, G, c, u)) return false; u.e = __builtin_amdgcn_readfirstlane(eofrb[u.pm]); return true; }
    DEV const char* a_ptr(const Unit& u) const { return A + (size_t)u.pm * 256 * ED; }
    DEV void a_voff(const Unit&, const int tid, unsigned (&vo)[2][2]) const {
#pragma unroll
        for (int i = 0; i < 2; ++i) { int R, C; stage_rc(tid * 16 + i * 8192, R, C); vo[0][i] = vo[1][i] = (unsigned)(R * ED + 2 * C); }
    }
    DEV const char* b_ptr(const Unit& u) const { return (u.e < NE ? Wd + (size_t)u.e * D * ED : Wds) + (size_t)u.pn * 256 * ED; }
};

struct EpiProj {
    static constexpr bool PERM = true;
    bf16_t* qkv; bf16_t* za; bf16_t* xbc; bf16_t* zb; float* small;
    DEV void operator()(const f32x4 (&acc)[2][2][4][2], const Unit& u, int wr, int wc, int fr, int fq) const {
        const int row0 = u.pm * BM + wr * 64 + fr, pn = u.pn;
        if (pn == 26) {
            if (wc == 0) {
#pragma unroll
                for (int ai = 0; ai < 2; ++ai)
#pragma unroll
                    for (int m = 0; m < 4; ++m) { float* p = small + (size_t)(row0 + ai * HALF + m * 16) * 32 + 8 * fq; *(f32x4*)p = acc[ai][0][m][0]; *(f32x4*)(p + 4) = acc[ai][0][m][1]; }
            }
            return;
        }
        bf16_t* base; int ldc, ct;
        if (pn < 12) { base = qkv; ldc = 3072; ct = pn; } else if (pn < 16) { base = za; ldc = 1024; ct = pn - 12; } else if (pn < 22) { base = xbc; ldc = 1536; ct = pn - 16; } else { base = zb; ldc = 1024; ct = pn - 22; }
        const int col0 = ct * 256 + wc * 32 + 8 * fq;
#pragma unroll
        for (int ai = 0; ai < 2; ++ai)
#pragma unroll
            for (int m = 0; m < 4; ++m) { bf16_t* rowp = base + (size_t)(row0 + ai * HALF + m * 16) * ldc + col0;
#pragma unroll
                for (int bj = 0; bj < 2; ++bj) *(u32x4*)(rowp + bj * HALF) = pack8(acc[ai][bj][m][0], acc[ai][bj][m][1]); }
    }
};
struct EpiF32 {
    static constexpr bool PERM = false;
    float* Cp; int ldc; int pad_;
    DEV void operator()(const f32x4 (&acc)[2][2][4][2], const Unit& u, int wr, int wc, int fr, int fq) const {
        const int row0 = u.pm * BM + wr * 64 + fr, col0 = u.pn * BM + wc * 32 + 4 * fq;
#pragma unroll
        for (int ai = 0; ai < 2; ++ai)
#pragma unroll
            for (int m = 0; m < 4; ++m) { float* rowp = Cp + (size_t)(row0 + ai * HALF + m * 16) * ldc + col0;
#pragma unroll
                for (int bj = 0; bj < 2; ++bj)
#pragma unroll
                    for (int n = 0; n < 2; ++n) *(f32x4*)(rowp + bj * HALF + n * 16) = acc[ai][bj][m][n]; }
    }
};
struct EpiBf16 {
    static constexpr bool PERM = true;
    bf16_t* O; int ldc; int pad_;
    DEV void operator()(const f32x4 (&acc)[2][2][4][2], const Unit& u, int wr, int wc, int fr, int fq) const {
        const int row0 = u.pm * BM + wr * 64 + fr, col0 = u.pn * BM + wc * 32 + 8 * fq;
#pragma unroll
        for (int ai = 0; ai < 2; ++ai)
#pragma unroll
            for (int m = 0; m < 4; ++m) { bf16_t* rowp = O + (size_t)(row0 + ai * HALF + m * 16) * ldc + col0;
#pragma unroll
                for (int bj = 0; bj < 2; ++bj) *(u32x4*)(rowp + bj * HALF) = pack8(acc[ai][bj][m][0], acc[ai][bj][m][1]); }
    }
};
DEV u32x2 pack8_fp8(const f32x4 a, const f32x4 b) {
    f32x4 x = a, y = b;
#pragma unroll
    for (int i = 0; i < 4; ++i) { x[i] = fminf(fmaxf(x[i], -440.f), 440.f); y[i] = fminf(fmaxf(y[i], -440.f), 440.f); }
    int w0 = __builtin_amdgcn_cvt_pk_fp8_f32(x[0], x[1], 0, false); w0 = __builtin_amdgcn_cvt_pk_fp8_f32(x[2], x[3], w0, true);
    int w1 = __builtin_amdgcn_cvt_pk_fp8_f32(y[0], y[1], 0, false); w1 = __builtin_amdgcn_cvt_pk_fp8_f32(y[2], y[3], w1, true);
    return (u32x2){(unsigned)w0, (unsigned)w1};
}
struct EpiFp8 {
    static constexpr bool PERM = true;
    unsigned char* O; int ldc; int pad_;
    DEV void operator()(const f32x4 (&acc)[2][2][4][2], const Unit& u, int wr, int wc, int fr, int fq) const {
        const int row0 = u.pm * BM + wr * 64 + fr, col0 = u.pn * BM + wc * 32 + 8 * fq;
#pragma unroll
        for (int ai = 0; ai < 2; ++ai)
#pragma unroll
            for (int m = 0; m < 4; ++m) { unsigned char* rowp = O + (size_t)(row0 + ai * HALF + m * 16) * ldc + col0;
#pragma unroll
                for (int bj = 0; bj < 2; ++bj) { f32x4 a0 = acc[ai][bj][m][0] * 8.f, a1 = acc[ai][bj][m][1] * 8.f;
#pragma unroll
                    for (int i = 0; i < 4; ++i) { a0[i] = fminf(fmaxf(a0[i], -440.f), 440.f); a1[i] = fminf(fmaxf(a1[i], -440.f), 440.f); }
                    int w0 = __builtin_amdgcn_cvt_pk_fp8_f32(a0[0], a0[1], 0, false); w0 = __builtin_amdgcn_cvt_pk_fp8_f32(a0[2], a0[3], w0, true);
                    int w1 = __builtin_amdgcn_cvt_pk_fp8_f32(a1[0], a1[1], 0, false); w1 = __builtin_amdgcn_cvt_pk_fp8_f32(a1[2], a1[3], w1, true);
                    *(u32x2*)(rowp + bj * HALF) = (u32x2){(unsigned)w0, (unsigned)w1}; } }
    }
};
struct EpiGU {
    static constexpr bool PERM = true;
    unsigned char* H;
    DEV void operator()(const f32x4 (&acc)[2][2][4][2], const Unit& u, int wr, int wc, int fr, int fq) const {
        const int row0 = u.pm * BM + wr * 64 + fr, col0 = u.pn * HALF + wc * 32 + 8 * fq;
#pragma unroll
        for (int ai = 0; ai < 2; ++ai)
#pragma unroll
            for (int m = 0; m < 4; ++m) {
                f32x4 h0, h1;
#pragma unroll
                for (int i = 0; i < 4; ++i) { h0[i] = siluf(acc[ai][0][m][0][i]) * acc[ai][1][m][0][i]; h1[i] = siluf(acc[ai][0][m][1][i]) * acc[ai][1][m][1][i]; }
                *(u32x2*)(H + (size_t)(row0 + ai * HALF + m * 16) * ED + col0) = pack8_fp8(h0, h1);
            }
    }
};
struct EpiQKV {
    static constexpr bool PERM = true;
    bf16_t* O; const float* cosT; const float* sinT;
    DEV void operator()(const f32x4 (&acc)[2][2][4][2], const Unit& u, int wr, int wc, int fr, int fq) const {
        const int row0 = u.pm * BM + wr * 64 + fr, col0 = u.pn * BM + wc * 32 + 8 * fq;
        const bool rope = u.pn < 8; const float qs = u.pn < 4 ? 0.125f : 1.f;
#pragma unroll
        for (int ai = 0; ai < 2; ++ai)
#pragma unroll
            for (int m = 0; m < 4; ++m) {
                const int row = row0 + ai * HALF + m * 16;
                bf16_t* rowp = O + (size_t)row * 3072 + col0;
                if (rope) {
                    const f32x4 cs = *(const f32x4*)(cosT + (size_t)row * 32 + 16 * (wc & 1) + 4 * fq), sn = *(const f32x4*)(sinT + (size_t)row * 32 + 16 * (wc & 1) + 4 * fq);
#pragma unroll
                    for (int bj = 0; bj < 2; ++bj) { const f32x4 x1 = acc[ai][bj][m][0], x2 = acc[ai][bj][m][1];
                        *(u32x4*)(rowp + bj * HALF) = pack8((x1 * cs - x2 * sn) * qs, (x2 * cs + x1 * sn) * qs); }
                } else {
#pragma unroll
                    for (int bj = 0; bj < 2; ++bj) *(u32x4*)(rowp + bj * HALF) = pack8(acc[ai][bj][m][0], acc[ai][bj][m][1]);
                }
            }
    }
};
}

template <class SrcF, bool OUT8 = false>
DEV void conv_item(const SrcF& src, int ldw, int K, void* dstv, LAS float* scr, int item, int nblk, int lane, const float wscale = 1.f) {
    const int kb = item / nblk, nb = item - kb * nblk, k0 = 64 * kb, n0 = 32 * nb;
    const int quad = lane & 7, r0 = lane >> 3;
    const float* colp = src(n0 + 4 * quad);
    f32x4 v[8];
#pragma unroll
    for (int i = 0; i < 8; ++i) v[i] = colp ? *(const f32x4*)(colp + (size_t)(k0 + r0 + 8 * i) * ldw) : (f32x4){0.f, 0.f, 0.f, 0.f};
#pragma unroll
    for (int i = 0; i < 8; ++i) { LAS float* p = scr + (r0 + 8 * i) * 33 + 4 * quad; p[0] = v[i][0]; p[1] = v[i][1]; p[2] = v[i][2]; p[3] = v[i][3]; }
    LDS_WAIT(); asm volatile("" ::: "memory");
    const int c = lane & 7;
#pragma unroll
    for (int j = 0; j < 4; ++j) { const int n = (lane >> 3) + 8 * j; const LAS float* s = scr + (8 * c) * 33 + n;
        if constexpr (OUT8) {
            int w0 = __builtin_amdgcn_cvt_pk_fp8_f32(s[0 * 33] * wscale, s[1 * 33] * wscale, 0, false); w0 = __builtin_amdgcn_cvt_pk_fp8_f32(s[2 * 33] * wscale, s[3 * 33] * wscale, w0, true);
            int w1 = __builtin_amdgcn_cvt_pk_fp8_f32(s[4 * 33] * wscale, s[5 * 33] * wscale, 0, false); w1 = __builtin_amdgcn_cvt_pk_fp8_f32(s[6 * 33] * wscale, s[7 * 33] * wscale, w1, true);
            *(u32x2*)((unsigned char*)dstv + (size_t)(n0 + n) * K + k0 + 8 * c) = (u32x2){(unsigned)w0, (unsigned)w1};
        } else {
            u32x4 o; o.x = pk2(s[0 * 33], s[1 * 33]); o.y = pk2(s[2 * 33], s[3 * 33]); o.z = pk2(s[4 * 33], s[5 * 33]); o.w = pk2(s[6 * 33], s[7 * 33]);
            *(u32x4*)((bf16_t*)dstv + (size_t)(n0 + n) * K + k0 + 8 * c) = o; } }
    LDS_WAIT(); asm volatile("" ::: "memory");
}
struct SrcIdent { const float* W; DEV const float* operator()(int n) const { return W + n; } };
struct SrcWin { const float* W; DEV const float* operator()(int n) const {
    int s; if (n < 4096) s = n; else if (n < 5632) s = C_XBC + (n - 4096); else if (n < 6656) s = C_ZB + (n - 5632); else if (n < 6672) s = C_BETA + (n - 6656); else if (n < 6688) s = C_DT + (n - 6672); else return nullptr;
    return W + s; } };
struct SrcQKV { const float* W; DEV const float* operator()(int n) const {
    if (n >= 2048) return W + n; const int hd = n >> 6, cp = n & 63; return W + hd * 64 + 32 * ((cp >> 2) & 1) + 16 * (cp >> 5) + 4 * ((cp >> 3) & 3) + (cp & 3); } };
struct SrcGU { const float* Wg; long du; DEV const float* operator()(int r) const { const int j = r >> 8, rr = r & 255; return Wg + (rr < 128 ? 0l : du) + 128 * j + (rr & 127); } };

DEV void load_row(const float* p, int lane, float (&v)[16]) {
#pragma unroll
    for (int j = 0; j < 4; ++j) { const f32x4 t = *(const f32x4*)(p + j * 256 + lane * 4); v[4 * j] = t[0]; v[4 * j + 1] = t[1]; v[4 * j + 2] = t[2]; v[4 * j + 3] = t[3]; }
}
DEV void store_row(float* p, int lane, const float (&v)[16]) {
#pragma unroll
    for (int j = 0; j < 4; ++j) *(f32x4*)(p + j * 256 + lane * 4) = (f32x4){v[4 * j], v[4 * j + 1], v[4 * j + 2], v[4 * j + 3]};
}
DEV float row_rstd(const float (&v)[16]) { float ss = 0.f;
#pragma unroll
    for (int i = 0; i < 16; ++i) ss += v[i] * v[i];
    return rsqrtf(wave_sum(ss) * (1.f / D) + EPS); }
DEV void resid_update(float (&xv)[16], const float (&yv)[16], const float* gpost, const float* gt, int lane) {
    const float r = row_rstd(yv);
#pragma unroll
    for (int j = 0; j < 4; ++j) { const f32x4 g = *(const f32x4*)(gpost + j * 256 + lane * 4), t = *(const f32x4*)(gt + j * 256 + lane * 4);
#pragma unroll
        for (int i = 0; i < 4; ++i) xv[4 * j + i] += t[i] * (yv[4 * j + i] * r * g[i]); }
}
DEV void prenorm_pack(const float (&xv)[16], const float* gpre, const float* sc, const float* sh, int lane, u32x2 (&o)[4]) {
    const float r = row_rstd(xv);
#pragma unroll
    for (int j = 0; j < 4; ++j) { const f32x4 g = *(const f32x4*)(gpre + j * 256 + lane * 4), s = *(const f32x4*)(sc + j * 256 + lane * 4), b = *(const f32x4*)(sh + j * 256 + lane * 4);
        float h[4];
#pragma unroll
        for (int i = 0; i < 4; ++i) h[i] = xv[4 * j + i] * r * g[i] * (1.f + s[i]) + b[i];
        o[j] = (u32x2){pk2(h[0], h[1]), pk2(h[2], h[3])}; }
}

DEV void load_row8(const float* p, int lane, float (&v)[16]) {
#pragma unroll
    for (int j = 0; j < 2; ++j)
#pragma unroll
        for (int hh = 0; hh < 2; ++hh) { const f32x4 t = *(const f32x4*)(p + 512 * j + 8 * lane + 4 * hh); v[8 * j + 4 * hh] = t[0]; v[8 * j + 4 * hh + 1] = t[1]; v[8 * j + 4 * hh + 2] = t[2]; v[8 * j + 4 * hh + 3] = t[3]; }
}
DEV void store_row8(float* p, int lane, const float (&v)[16]) {
#pragma unroll
    for (int j = 0; j < 2; ++j)
#pragma unroll
        for (int hh = 0; hh < 2; ++hh) *(f32x4*)(p + 512 * j + 8 * lane + 4 * hh) = (f32x4){v[8 * j + 4 * hh], v[8 * j + 4 * hh + 1], v[8 * j + 4 * hh + 2], v[8 * j + 4 * hh + 3]};
}
DEV void resid_update8(float (&xv)[16], const float (&yv)[16], const float* gpost, const float* gt, int lane) {
    const float r = row_rstd(yv);
#pragma unroll
    for (int j = 0; j < 2; ++j)
#pragma unroll
        for (int hh = 0; hh < 2; ++hh) { const f32x4 g = *(const f32x4*)(gpost + 512 * j + 8 * lane + 4 * hh), t = *(const f32x4*)(gt + 512 * j + 8 * lane + 4 * hh);
#pragma unroll
            for (int i = 0; i < 4; ++i) xv[8 * j + 4 * hh + i] += t[i] * (yv[8 * j + 4 * hh + i] * r * g[i]); }
}
DEV void prenorm_pack8(const float (&xv)[16], const float* gpre, const float* sc, const float* sh, int lane, u32x4 (&o)[2]) {
    const float r = row_rstd(xv);
#pragma unroll
    for (int j = 0; j < 2; ++j) { float h[8];
#pragma unroll
        for (int hh = 0; hh < 2; ++hh) { const f32x4 g = *(const f32x4*)(gpre + 512 * j + 8 * lane + 4 * hh), s = *(const f32x4*)(sc + 512 * j + 8 * lane + 4 * hh), b = *(const f32x4*)(sh + 512 * j + 8 * lane + 4 * hh);
#pragma unroll
            for (int i = 0; i < 4; ++i) h[4 * hh + i] = xv[8 * j + 4 * hh + i] * r * g[i] * (1.f + s[i]) + b[i]; }
        o[j] = (u32x4){pk2(h[0], h[1]), pk2(h[2], h[3]), pk2(h[4], h[5]), pk2(h[6], h[7])}; }
}
DEV void prenorm_pack8_f8(const float (&xv)[16], const float* gpre, const float* sc, const float* sh, int lane, u32x2 (&o)[2]) {
    const float r = row_rstd(xv);
#pragma unroll
    for (int j = 0; j < 2; ++j) { float h[8];
#pragma unroll
        for (int hh = 0; hh < 2; ++hh) { const f32x4 g = *(const f32x4*)(gpre + 512 * j + 8 * lane + 4 * hh), s = *(const f32x4*)(sc + 512 * j + 8 * lane + 4 * hh), b = *(const f32x4*)(sh + 512 * j + 8 * lane + 4 * hh);
#pragma unroll
            for (int i = 0; i < 4; ++i) h[4 * hh + i] = fminf(fmaxf(xv[8 * j + 4 * hh + i] * r * g[i] * (1.f + s[i]) + b[i], -440.f), 440.f); }
        int w0 = __builtin_amdgcn_cvt_pk_fp8_f32(h[0], h[1], 0, false); w0 = __builtin_amdgcn_cvt_pk_fp8_f32(h[2], h[3], w0, true);
        int w1 = __builtin_amdgcn_cvt_pk_fp8_f32(h[4], h[5], 0, false); w1 = __builtin_amdgcn_cvt_pk_fp8_f32(h[6], h[7], w1, true);
        o[j] = (u32x2){(unsigned)w0, (unsigned)w1}; }
}
DEV void acc_row8(float (&yv)[16], const u32x2 w0, const u32x2 w1, const float g) {
#pragma unroll
    for (int e = 0; e < 2; ++e) {
        yv[4 * e] += g * __builtin_amdgcn_cvt_f32_fp8((int)w0[e], 0); yv[4 * e + 1] += g * __builtin_amdgcn_cvt_f32_fp8((int)w0[e], 1); yv[4 * e + 2] += g * __builtin_amdgcn_cvt_f32_fp8((int)w0[e], 2); yv[4 * e + 3] += g * __builtin_amdgcn_cvt_f32_fp8((int)w0[e], 3);
        yv[8 + 4 * e] += g * __builtin_amdgcn_cvt_f32_fp8((int)w1[e], 0); yv[8 + 4 * e + 1] += g * __builtin_amdgcn_cvt_f32_fp8((int)w1[e], 1); yv[8 + 4 * e + 2] += g * __builtin_amdgcn_cvt_f32_fp8((int)w1[e], 2); yv[8 + 4 * e + 3] += g * __builtin_amdgcn_cvt_f32_fp8((int)w1[e], 3); }
}

DEV void load_row_bf(const bf16_t* p, int lane, float (&v)[16]) {
#pragma unroll
    for (int j = 0; j < 4; ++j) { const u32x2 w = *(const u32x2*)(p + j * 256 + lane * 4); v[4 * j] = __uint_as_float(w.x << 16); v[4 * j + 1] = __uint_as_float(w.x & 0xFFFF0000u); v[4 * j + 2] = __uint_as_float(w.y << 16); v[4 * j + 3] = __uint_as_float(w.y & 0xFFFF0000u); }
}
DEV void store_row_bf(bf16_t* p, int lane, const float (&v)[16]) {
#pragma unroll
    for (int j = 0; j < 4; ++j) *(u32x2*)(p + j * 256 + lane * 4) = (u32x2){pk2(v[4 * j], v[4 * j + 1]), pk2(v[4 * j + 2], v[4 * j + 3])};
}
DEV void load_row8_bf(const bf16_t* p, int lane, float (&v)[16]) {
#pragma unroll
    for (int j = 0; j < 2; ++j) { const u32x4 w = *(const u32x4*)(p + 512 * j + 8 * lane);
#pragma unroll
        for (int e = 0; e < 4; ++e) { v[8 * j + 2 * e] = __uint_as_float(w[e] << 16); v[8 * j + 2 * e + 1] = __uint_as_float(w[e] & 0xFFFF0000u); } }
}
DEV void store_row8_bf(bf16_t* p, int lane, const float (&v)[16]) {
#pragma unroll
    for (int j = 0; j < 2; ++j) *(u32x4*)(p + 512 * j + 8 * lane) = (u32x4){pk2(v[8 * j], v[8 * j + 1]), pk2(v[8 * j + 2], v[8 * j + 3]), pk2(v[8 * j + 4], v[8 * j + 5]), pk2(v[8 * j + 6], v[8 * j + 7])};
}

struct Ctx { LAS unsigned char* lds; int tid, lane, wave, G, bid; };

DEV void ph_setup(const Args& a, const Ctx& X) {
    unsigned char* ws = a.ws;
    float* mod = (float*)(ws + WS_MOD);
    { LAS float* red = (LAS float*)X.lds;
      LAS float* sc = (LAS float*)(X.lds + 8192);
      for (int i = X.tid; i < NB * D; i += NTHR) sc[i] = siluf(a.c[i]);
      __syncthreads();
      const int kc = X.tid >> 6, cl = X.tid & 63;
      for (int task = X.bid; task < 2 * 96; task += X.G) {
          const int l = task / 96, col = (task % 96) * 64 + cl;
          const float* w = a.mod_w + (size_t)l * D * 6 * D + col;
          float p0 = 0.f, p1 = 0.f, p2 = 0.f, p3 = 0.f;
#pragma unroll 16
          for (int k = kc * 128; k < kc * 128 + 128; ++k) { const float wv = w[(size_t)k * 6 * D];
              p0 += sc[k] * wv; p1 += sc[D + k] * wv; p2 += sc[2 * D + k] * wv; p3 += sc[3 * D + k] * wv; }
          __syncthreads();
          red[(kc * 4 + 0) * 64 + cl] = p0; red[(kc * 4 + 1) * 64 + cl] = p1; red[(kc * 4 + 2) * 64 + cl] = p2; red[(kc * 4 + 3) * 64 + cl] = p3;
          __syncthreads();
          if (X.tid < 256) { const int b = X.tid >> 6; float s = a.mod_b[l * 6 * D + col];
#pragma unroll
              for (int q = 0; q < 8; ++q) s += red[(q * 4 + b) * 64 + cl];
              mod[(size_t)(l * NB + b) * 6 * D + col] = s; }
      }
      __syncthreads(); }
    { LAS float* scr = (LAS float*)(X.lds + X.wave * 8704);
      const int gw = X.bid * NWAVES + X.wave, NGW = X.G * NWAVES;
      constexpr int I_IN = (D / 64) * (NPROJ / 32);
      for (int it = gw; it < I_IN; it += NGW) conv_item<SrcWin, true>(SrcWin{a.ssm_w_in}, PROJ, D, ws + WS_WIN, scr, it, NPROJ / 32, X.lane, 64.f);
    }
}
DEV void ph_setup_late(const Args& a, const Ctx& X, const int wg0) {
    unsigned char* ws = a.ws;
    { float* cosT = (float*)(ws + WS_COS); float* sinT = (float*)(ws + WS_SIN);
      for (int idx = (X.bid - wg0) * NTHR + X.tid; idx < T * 32; idx += (X.G - wg0) * NTHR) { const int t = idx >> 5, i = idx & 31;
          const float ang = (float)a.pos[t] * powf(10000.f, -(float)i / 32.f); float sn, cs; sincosf(ang, &sn, &cs); cosT[idx] = cs; sinT[idx] = sn; } }
    { LAS float* scr = (LAS float*)(X.lds + X.wave * 8704);
      const int gw = (X.bid - wg0) * NWAVES + X.wave, NGW = (X.G - wg0) * NWAVES;
      constexpr int I_OUT = (2048 / 64) * (D / 32), I_QKV = (D / 64) * (3072 / 32), I_O = (D / 64) * (D / 32);
      for (int it = gw; it < I_OUT + I_QKV + I_O; it += NGW) {
          int r = it;
          if (r < I_OUT) { conv_item(SrcIdent{a.ssm_w_out}, D, 2048, (bf16_t*)(ws + WS_WOUT), scr, r, D / 32, X.lane); continue; } r -= I_OUT;
          if (r < I_QKV) { conv_item<SrcQKV, true>(SrcQKV{a.attn_w_qkv}, 3072, D, ws + WS_WQKV, scr, r, 3072 / 32, X.lane, 64.f); continue; } r -= I_QKV;
          conv_item<SrcIdent, true>(SrcIdent{a.attn_w_o}, D, D, ws + WS_WO, scr, r, D / 32, X.lane, 64.f);
      } }
}

DEV void ph_prenorm0(const Args& a, const Ctx& X) {
    const float* mod = (const float*)(a.ws + WS_MOD);
    unsigned char* h8 = a.ws + WS_H;
    for (int row = X.bid * NWAVES + X.wave; row < T; row += X.G * NWAVES) {
        const int b = row / SEQ; const float* ml = mod + (size_t)b * 6 * D;
        float xv[16]; load_row(a.x + (size_t)row * D, X.lane, xv);
        u32x2 o[4]; prenorm_pack(xv, a.mix_pre_g, ml + D, ml, X.lane, o);
#pragma unroll
        for (int j = 0; j < 4; ++j) { const float f0 = __uint_as_float(o[j].x << 16), f1 = __uint_as_float(o[j].x & 0xFFFF0000u), f2 = __uint_as_float(o[j].y << 16), f3 = __uint_as_float(o[j].y & 0xFFFF0000u);
            int wv = __builtin_amdgcn_cvt_pk_fp8_f32(fminf(fmaxf(f0, -440.f), 440.f), fminf(fmaxf(f1, -440.f), 440.f), 0, false); wv = __builtin_amdgcn_cvt_pk_fp8_f32(fminf(fmaxf(f2, -440.f), 440.f), fminf(fmaxf(f3, -440.f), 440.f), wv, true);
            *(unsigned*)(h8 + (size_t)row * D + j * 256 + X.lane * 4) = (unsigned)wv; }
    }
}

DEV bf16x8 acc_to_frag(const f32x4 lo, const f32x4 hi) { u32x4 w; w.x = pg8::cvt_pk_bf16(lo[0], lo[1]); w.y = pg8::cvt_pk_bf16(lo[2], lo[3]); w.z = pg8::cvt_pk_bf16(hi[0], hi[1]); w.w = pg8::cvt_pk_bf16(hi[2], hi[3]); return __builtin_bit_cast(bf16x8, w); }

DEV void gdn_solve(LAS float* M, LAS unsigned short* tf, const int lane) {
    for (int rb = 0; rb < 16; ++rb) {
        const int i0 = 4 * rb;
        float a0 = (lane == i0) ? 1.f : 0.f, a1 = (lane == i0 + 1) ? 1.f : 0.f, a2 = (lane == i0 + 2) ? 1.f : 0.f, a3 = (lane == i0 + 3) ? 1.f : 0.f;
        for (int j = 0; j < i0; j += 4) {
            const float t0 = M[j * 64 + lane], t1 = M[(j + 1) * 64 + lane], t2 = M[(j + 2) * 64 + lane], t3 = M[(j + 3) * 64 + lane];
            const f32x4 r0 = *(const LAS f32x4*)(M + i0 * 64 + j), r1 = *(const LAS f32x4*)(M + (i0 + 1) * 64 + j), r2 = *(const LAS f32x4*)(M + (i0 + 2) * 64 + j), r3 = *(const LAS f32x4*)(M + (i0 + 3) * 64 + j);
            a0 -= r0[0] * t0 + r0[1] * t1 + r0[2] * t2 + r0[3] * t3; a1 -= r1[0] * t0 + r1[1] * t1 + r1[2] * t2 + r1[3] * t3;
            a2 -= r2[0] * t0 + r2[1] * t1 + r2[2] * t2 + r2[3] * t3; a3 -= r3[0] * t0 + r3[1] * t1 + r3[2] * t2 + r3[3] * t3;
        }
        const f32x4 d1 = *(const LAS f32x4*)(M + (i0 + 1) * 64 + i0), d2 = *(const LAS f32x4*)(M + (i0 + 2) * 64 + i0), d3 = *(const LAS f32x4*)(M + (i0 + 3) * 64 + i0);
        a1 -= d1[0] * a0; a2 -= d2[0] * a0 + d2[1] * a1; a3 -= d3[0] * a0 + d3[1] * a1 + d3[2] * a2;
        M[i0 * 64 + lane] = a0; M[(i0 + 1) * 64 + lane] = a1; M[(i0 + 2) * 64 + lane] = a2; M[(i0 + 3) * 64 + lane] = a3;
    }
    const int cq = (lane >> 2) & 3, ca = (lane >> 4) & 1, ce = lane & 3, cks = lane >> 5;
    for (int i = 0; i < 64; ++i) tf[((i >> 4) * 2 + cks) * 512 + ((i & 15) + 16 * cq) * 8 + 4 * ca + ce] = (unsigned short)f2bf(M[i * 64 + lane]);
}
DEV void ph_gdn_local(const Args& a, const Ctx& X) {
    const bf16_t* qkvpre = (const bf16_t*)(a.ws + WS_QKVPRE); const float* small = (const float*)(a.ws + WS_SMALL);
    unsigned char* gi = a.ws + WS_GI; float* glast = (float*)(a.ws + WS_GLAST);
    constexpr int KP = 272;
    LAS unsigned char* kN = X.lds; LAS unsigned char* qN = X.lds + 64 * KP; LAS unsigned char* slots = X.lds + 128 * KP;
    LAS float* gcL = (LAS float*)(X.lds + 143360); LAS float* btL = gcL + 8 * 64;
    LAS unsigned char* stg = X.lds + 100352;
    const int lane = X.lane, wave = X.wave, r16 = lane & 15, q4 = lane >> 4;
    const float scale = 0.08838834764831845f;
    for (int wu = X.bid; wu < NB * 64; wu += X.G) {
        const int b = wu >> 6, n = wu & 63; const size_t t0 = (size_t)b * SEQ + 64 * n;
        unsigned char* tmp = a.ws + WS_GTMP + (size_t)X.bid * 131072;
        __syncthreads();
        {
            const float g = -__expf(a.gdn_a_log[wave]) * softplusf(small[(t0 + lane) * 32 + 8 + wave] + a.gdn_dt_bias[wave]);
            float gc = g;
#pragma unroll
            for (int o = 1; o < 64; o <<= 1) { const float v = __shfl_up(gc, o); if (lane >= o) gc += v; }
            gcL[wave * 64 + lane] = gc; btL[wave * 64 + lane] = sigmoidf_(small[(t0 + lane) * 32 + wave]);
            if (lane == 63) glast[(size_t)((b * 8 + wave) * 64 + n) * 32] = gc;
        }
        __syncthreads();
        unsigned xr[3][11];
#define GDN_LOADX(hh) do { _Pragma("unroll") for (int _p = 0; _p < 3; ++_p) _Pragma("unroll") for (int _i = 0; _i < 11; ++_i) { const int _tk = 8 * wave + _i - 3; unsigned _v = 0u; \
            if (64 * n + _tk >= 0) _v = *(const unsigned*)(qkvpre + (t0 + _tk) * 3072 + _p * 1024 + (hh) * 128 + 2 * lane); xr[_p][_i] = _v; } } while (0)
        GDN_LOADX(0);
        for (int bb = 0; bb < 2; ++bb) {
            for (int j = 0; j < 4; ++j) {
                const int h = bb * 4 + j; unsigned char* ub = gi + (size_t)((b * 8 + h) * 64 + n) * GI_UNIT;
                {
                    const float gl = gcL[h * 64 + 63];
                    const int blk = wave >> 2, pa = (wave & 3) >> 1, pq0 = 2 * (wave & 1);
                    const int ca = (2 * lane >> 4) & 1, cq = (2 * lane >> 2) & 3, ce = (2 * lane) & 3, cks = (2 * lane) >> 5;
#pragma unroll
                    for (int part = 0; part < 3; ++part) {
                        const int col = part * 1024 + h * 128 + 2 * lane;
                        float w0[4], w1[4];
#pragma unroll
                        for (int i = 0; i < 4; ++i) { const f32x2 t = *(const f32x2*)(a.gdn_conv_w + i * 3072 + col); w0[i] = t.x; w1[i] = t.y; }
                        float x0[11], x1[11];
#pragma unroll
                        for (int i = 0; i < 11; ++i) { const unsigned v = xr[part][i]; x0[i] = __uint_as_float(v << 16); x1[i] = __uint_as_float(v & 0xFFFF0000u); }
                        float v0[8], v1[8];
#pragma unroll
                        for (int i = 0; i < 8; ++i) { v0[i] = siluf(w0[0] * x0[i] + w0[1] * x0[i + 1] + w0[2] * x0[i + 2] + w0[3] * x0[i + 3]); v1[i] = siluf(w1[0] * x1[i] + w1[1] * x1[i + 1] + w1[2] * x1[i + 2] + w1[3] * x1[i + 3]); }
                        if (part < 2) {
#pragma unroll
                            for (int i = 0; i < 8; ++i) { const float r = rsqrtf(wave_sum(v0[i] * v0[i] + v1[i] * v1[i]) + 1e-6f); v0[i] *= r; v1[i] *= r; }
                        }
                        for (int rep_ = 0; rep_ < (((PROBE_MASK >> 21) & 1u) ? 2 : 1); ++rep_) {
                        if (part == 0) {
#pragma unroll
                            for (int i = 0; i < 8; ++i) { const int tok = 8 * wave + i; const float eg = __expf(gcL[h * 64 + tok]) * scale;
                                *(LAS unsigned*)(qN + tok * KP + lane * 4) = pk2(v0[i], v1[i]);
                                *(LAS unsigned*)(stg + ((tok >> 4) * 4 + cks) * 1024 + ((tok & 15) + 16 * cq) * 16 + (4 * ca + ce) * 2) = pk2(v0[i] * eg, v1[i] * eg); }
                        } else if (part == 1) {
                            unsigned short kg0[8], kg1[8], ke0[8], ke1[8];
#pragma unroll
                            for (int i = 0; i < 8; ++i) { const int tok = 8 * wave + i; const float gc = gcL[h * 64 + tok], bt = btL[h * 64 + tok], eg = __expf(gc) * bt, eend = __expf(gl - gc);
                                *(LAS unsigned*)(kN + tok * KP + lane * 4) = pk2(v0[i], v1[i]);
                                kg0[i] = (unsigned short)f2bf(v0[i] * eg); kg1[i] = (unsigned short)f2bf(v1[i] * eg); ke0[i] = (unsigned short)f2bf(v0[i] * eend); ke1[i] = (unsigned short)f2bf(v1[i] * eend); }
#pragma unroll
                            for (int hf = 0; hf < 2; ++hf) { const int pos = 32 * blk + 8 * (pq0 + hf) + 4 * pa; const int cl = 2 * lane;
                                *(u32x2*)(tmp + (size_t)j * 32768 + 16384 + cl * 128 + pos * 2) = (u32x2){(unsigned)kg0[4 * hf] | ((unsigned)kg0[4 * hf + 1] << 16), (unsigned)kg0[4 * hf + 2] | ((unsigned)kg0[4 * hf + 3] << 16)};
                                *(u32x2*)(tmp + (size_t)j * 32768 + 16384 + (cl + 1) * 128 + pos * 2) = (u32x2){(unsigned)kg1[4 * hf] | ((unsigned)kg1[4 * hf + 1] << 16), (unsigned)kg1[4 * hf + 2] | ((unsigned)kg1[4 * hf + 3] << 16)};
                                *(LAS u32x2*)(stg + 16384 + ((cl >> 4) * 2 + blk) * 1024 + ((cl & 15) + 16 * (pq0 + hf)) * 16 + (4 * pa) * 2) = (u32x2){(unsigned)ke0[4 * hf] | ((unsigned)ke0[4 * hf + 1] << 16), (unsigned)ke0[4 * hf + 2] | ((unsigned)ke0[4 * hf + 3] << 16)};
                                *(LAS u32x2*)(stg + 16384 + (((cl + 1) >> 4) * 2 + blk) * 1024 + (((cl + 1) & 15) + 16 * (pq0 + hf)) * 16 + (4 * pa) * 2) = (u32x2){(unsigned)ke1[4 * hf] | ((unsigned)ke1[4 * hf + 1] << 16), (unsigned)ke1[4 * hf + 2] | ((unsigned)ke1[4 * hf + 3] << 16)}; }
                        } else {
                            unsigned short vb0[8], vb1[8];
#pragma unroll
                            for (int i = 0; i < 8; ++i) { const float bt = btL[h * 64 + 8 * wave + i]; vb0[i] = (unsigned short)f2bf(v0[i] * bt); vb1[i] = (unsigned short)f2bf(v1[i] * bt); }
#pragma unroll
                            for (int hf = 0; hf < 2; ++hf) { const int pos = 32 * blk + 8 * (pq0 + hf) + 4 * pa; const int cl = 2 * lane;
                                *(u32x2*)(tmp + (size_t)j * 32768 + cl * 128 + pos * 2) = (u32x2){(unsigned)vb0[4 * hf] | ((unsigned)vb0[4 * hf + 1] << 16), (unsigned)vb0[4 * hf + 2] | ((unsigned)vb0[4 * hf + 3] << 16)};
                                *(u32x2*)(tmp + (size_t)j * 32768 + (cl + 1) * 128 + pos * 2) = (u32x2){(unsigned)vb1[4 * hf] | ((unsigned)vb1[4 * hf + 1] << 16), (unsigned)vb1[4 * hf + 2] | ((unsigned)vb1[4 * hf + 3] << 16)}; }
                        }
                        asm volatile("" ::: "memory"); }
                    }
                }
                if (h + 1 < 8) GDN_LOADX(h + 1);
                __syncthreads();
                {
#pragma unroll
                    for (int i = 0; i < 4; ++i) *(u32x4*)(ub + 16384 + (X.tid + 512 * i) * 16) = *(const LAS u32x4*)(stg + (X.tid + 512 * i) * 16);
                    const int mat = wave >> 2, rt = wave & 3; LAS unsigned char* An = mat ? qN : kN;
                    bf16x8 af[4];
#pragma unroll
                    for (int ks = 0; ks < 4; ++ks) af[ks] = *(const LAS bf16x8*)(An + (16 * rt + r16) * KP + (32 * ks + 8 * q4) * 2);
                    LAS float* slot = (LAS float*)(slots + j * 16384);
#pragma unroll
                    for (int ct = 0; ct < 4; ++ct) { f32x4 acc = {0.f, 0.f, 0.f, 0.f};
#pragma unroll
                        for (int ks = 0; ks < 4; ++ks) { const bf16x8 bf = *(const LAS bf16x8*)(kN + (16 * ct + r16) * KP + (32 * ks + 8 * q4) * 2); acc = __builtin_amdgcn_mfma_f32_16x16x32_bf16(af[ks], bf, acc, 0, 0, 0); }
                        const int jc = 16 * ct + r16; const float gj = gcL[h * 64 + jc];
#pragma unroll
                        for (int rg = 0; rg < 4; ++rg) { const int i = 16 * rt + 4 * q4 + rg; const float dec = __expf(gcL[h * 64 + i] - gj);
                            if (mat == 0) { slot[i * 64 + jc] = jc < i ? btL[h * 64 + i] * acc[rg] * dec : 0.f; }
                            else { const float v = jc <= i ? acc[rg] * scale * dec : 0.f;
                                *(LAS unsigned short*)(stg + 32768 + (rt * 2 + (ct >> 1)) * 1024 + ((4 * q4 + rg) + 16 * (r16 >> 2)) * 16 + (4 * (ct & 1) + (r16 & 3)) * 2) = (unsigned short)f2bf(v); } }
                    }
                }
                __syncthreads();
                *(u32x4*)(ub + 49152 + X.tid * 16) = *(const LAS u32x4*)(stg + 32768 + X.tid * 16);
            }
            if (wave < 4) gdn_solve((LAS float*)(slots + wave * 16384), (LAS unsigned short*)(X.lds + wave * 8192), lane);
            VM_WAIT(); __syncthreads();
            for (int j = 0; j < 4; ++j) {
                const int h = bb * 4 + j; unsigned char* ub = gi + (size_t)((b * 8 + h) * 64 + n) * GI_UNIT;
                const int mat = wave >> 2; LAS unsigned char* slot = X.lds + j * 8192;
#pragma unroll
                for (int cx = 0; cx < 2; ++cx) { const int ct = 2 * (wave & 3) + cx;
                    bf16x8 bfr[2];
#pragma unroll
                    for (int ks = 0; ks < 2; ++ks) { const u32x4 t = __builtin_nontemporal_load((const u32x4*)(tmp + (size_t)j * 32768 + mat * 16384 + (16 * ct + r16) * 128 + (32 * ks + 8 * q4) * 2)); bfr[ks] = __builtin_bit_cast(bf16x8, t); }
#pragma unroll
                    for (int rt = 0; rt < 4; ++rt) { f32x4 acc = {0.f, 0.f, 0.f, 0.f};
#pragma unroll
                        for (int ks = 0; ks < 2; ++ks) { const bf16x8 tf = *(const LAS bf16x8*)(slot + (rt * 2 + ks) * 1024 + lane * 16); acc = __builtin_amdgcn_mfma_f32_16x16x32_bf16(tf, bfr[ks], acc, 0, 0, 0); }
                        if (mat == 0) *(u32x2*)(ub + 57344 + (rt * 8 + ct) * 512 + lane * 8) = (u32x2){pg8::cvt_pk_bf16(acc[0], acc[1]), pg8::cvt_pk_bf16(acc[2], acc[3])};
                        else {
#pragma unroll
                            for (int rg = 0; rg < 4; ++rg) *(unsigned short*)(ub + (rt * 4 + (ct >> 1)) * 1024 + ((4 * q4 + rg) + 16 * (r16 >> 2)) * 16 + (4 * (ct & 1) + (r16 & 3)) * 2) = (unsigned short)f2bf(-acc[rg]);
                        }
                    }
                }
            }
            __syncthreads();
        }
    }
}
DEV void ph_gdn_scan(const Args& a, const Ctx& X) {
    const unsigned char* gi = a.ws + WS_GI; const float* glast = (const float*)(a.ws + WS_GLAST);
    const bf16_t* za = (const bf16_t*)(a.ws + WS_ZA); bf16_t* oy = (bf16_t*)(a.ws + WS_OY);
    const int lane = X.lane, wave = X.wave, r16 = lane & 15, q4 = lane >> 4, tid = X.tid;
    LAS float* OT = (LAS float*)(X.lds + 114688);
    const int bh = X.bid, b = bh >> 3, h = bh & 7;
    const unsigned char* ubase = gi + (size_t)bh * 64 * GI_UNIT;
    f32x4 S[8];
#pragma unroll
    for (int i = 0; i < 8; ++i) S[i] = (f32x4){0.f, 0.f, 0.f, 0.f};
    float nwv[16];
#pragma unroll
    for (int i = 0; i < 16; ++i) nwv[i] = a.gdn_norm_w[16 * (tid & 7) + i];
#define GDN_STAGE(nn, buf) do { _Pragma("unroll") for (int _i = 0; _i < 7; ++_i) \
        __builtin_amdgcn_global_load_lds((const unsigned*)(ubase + (size_t)(nn) * GI_UNIT + (size_t)(tid + 512 * _i) * 16), (LAS unsigned*)(X.lds + (buf) * 57344 + (wave * 64 + 512 * _i) * 16), 16, 0, 0); } while (0)
    u32x2 udn[4]; float gln; u32x4 zn[2];
    { const size_t tz = (size_t)b * SEQ + (tid >> 3); zn[0] = *(const u32x4*)(za + tz * 1024 + h * 128 + 16 * (tid & 7)); zn[1] = *(const u32x4*)(za + tz * 1024 + h * 128 + 16 * (tid & 7) + 8); }
#pragma unroll
    for (int ct = 0; ct < 4; ++ct) udn[ct] = *(const u32x2*)(ubase + 57344 + (ct * 8 + wave) * 512 + lane * 8);
    gln = glast[(size_t)(bh * 64) * 32];
    GDN_STAGE(0, 0);
#define GDN_EPILOGUE(nn, ZC) do { const int tok = tid >> 3, seg = tid & 7; const size_t t = (size_t)b * SEQ + 64 * (nn) + tok; \
            float ov[16]; float ss = 0.f; \
            _Pragma("unroll") for (int i = 0; i < 4; ++i) { const f32x4 v = *(const LAS f32x4*)(OT + tok * 132 + 16 * seg + 4 * i); ov[4 * i] = v[0]; ov[4 * i + 1] = v[1]; ov[4 * i + 2] = v[2]; ov[4 * i + 3] = v[3]; ss += v[0] * v[0] + v[1] * v[1] + v[2] * v[2] + v[3] * v[3]; } \
            ss += __shfl_xor(ss, 1); ss += __shfl_xor(ss, 2); ss += __shfl_xor(ss, 4); \
            const float rstd = rsqrtf(ss * (1.f / 128.f) + EPS); \
            u32x4 ow[2]; \
            _Pragma("unroll") for (int i = 0; i < 2; ++i) _Pragma("unroll") for (int e = 0; e < 4; ++e) { const unsigned zw = (ZC)[i][e]; const float z0 = __uint_as_float(zw << 16), z1 = __uint_as_float(zw & 0xFFFF0000u); \
                    ow[i][e] = pg8::cvt_pk_bf16(ov[8 * i + 2 * e] * rstd * nwv[8 * i + 2 * e] * siluf(z0), ov[8 * i + 2 * e + 1] * rstd * nwv[8 * i + 2 * e + 1] * siluf(z1)); } \
            *(u32x4*)(oy + t * 2048 + h * 128 + 16 * seg) = ow[0]; *(u32x4*)(oy + t * 2048 + h * 128 + 16 * seg + 8) = ow[1]; } while (0)
    u32x4 zp[2] = {{0u, 0u, 0u, 0u}, {0u, 0u, 0u, 0u}};
    for (int n = 0; n < 64; ++n) {
        VM_WAIT(); __syncthreads();
        f32x4 uf[4];
#pragma unroll
        for (int ct = 0; ct < 4; ++ct) { uf[ct][0] = __uint_as_float(udn[ct].x << 16); uf[ct][1] = __uint_as_float(udn[ct].x & 0xFFFF0000u); uf[ct][2] = __uint_as_float(udn[ct].y << 16); uf[ct][3] = __uint_as_float(udn[ct].y & 0xFFFF0000u); }
        const float egl = __expf(gln);
        u32x4 zc[2]; zc[0] = zn[0]; zc[1] = zn[1];
        asm volatile("" : "+v"(uf[0]), "+v"(uf[1]), "+v"(uf[2]), "+v"(uf[3]), "+v"(zc[0]), "+v"(zc[1]));
        if (n + 1 < 64) {
            const unsigned char* un = ubase + (size_t)(n + 1) * GI_UNIT;
#pragma unroll
            for (int ct = 0; ct < 4; ++ct) udn[ct] = *(const u32x2*)(un + 57344 + (ct * 8 + wave) * 512 + lane * 8);
            gln = glast[(size_t)(bh * 64 + n + 1) * 32];
            { const size_t tz = (size_t)b * SEQ + 64 * (n + 1) + (tid >> 3); zn[0] = *(const u32x4*)(za + tz * 1024 + h * 128 + 16 * (tid & 7)); zn[1] = *(const u32x4*)(za + tz * 1024 + h * 128 + 16 * (tid & 7) + 8); }
            GDN_STAGE(n + 1, (n + 1) & 1);
        }
        if (n > 0) GDN_EPILOGUE(n - 1, zp);
        zp[0] = zc[0]; zp[1] = zc[1];
        const LAS unsigned char* L = X.lds + (n & 1) * 57344;
        bf16x8 sB[4];
#pragma unroll
        for (int ks = 0; ks < 4; ++ks) sB[ks] = acc_to_frag(S[2 * ks], S[2 * ks + 1]);
        f32x4 vn[4], oo[4];
#pragma unroll
        for (int ct = 0; ct < 4; ++ct) { f32x4 acc = {0.f, 0.f, 0.f, 0.f}, ao = {0.f, 0.f, 0.f, 0.f};
#pragma unroll
            for (int ks = 0; ks < 4; ++ks) { const bf16x8 wf = *(const LAS bf16x8*)(L + (ct * 4 + ks) * 1024 + lane * 16), qf = *(const LAS bf16x8*)(L + 16384 + (ct * 4 + ks) * 1024 + lane * 16);
                acc = __builtin_amdgcn_mfma_f32_16x16x32_bf16(wf, sB[ks], acc, 0, 0, 0); ao = __builtin_amdgcn_mfma_f32_16x16x32_bf16(qf, sB[ks], ao, 0, 0, 0); }
            vn[ct] = acc; oo[ct] = ao; }
#pragma unroll
        for (int ct = 0; ct < 4; ++ct) vn[ct] = vn[ct] + uf[ct];
        bf16x8 vB[2];
#pragma unroll
        for (int ks = 0; ks < 2; ++ks) vB[ks] = acc_to_frag(vn[2 * ks], vn[2 * ks + 1]);
#pragma unroll
        for (int ct = 0; ct < 4; ++ct)
#pragma unroll
            for (int ks = 0; ks < 2; ++ks) { const bf16x8 kf = *(const LAS bf16x8*)(L + 49152 + (ct * 2 + ks) * 1024 + lane * 16); oo[ct] = __builtin_amdgcn_mfma_f32_16x16x32_bf16(kf, vB[ks], oo[ct], 0, 0, 0); }
#pragma unroll
        for (int dt = 0; dt < 8; ++dt) { f32x4 acc = S[dt] * egl;
#pragma unroll
            for (int ks = 0; ks < 2; ++ks) { const bf16x8 ef = *(const LAS bf16x8*)(L + 32768 + (dt * 2 + ks) * 1024 + lane * 16); acc = __builtin_amdgcn_mfma_f32_16x16x32_bf16(ef, vB[ks], acc, 0, 0, 0); }
            S[dt] = acc; }
        __syncthreads();
#pragma unroll
        for (int ct = 0; ct < 4; ++ct)
#pragma unroll
            for (int rg = 0; rg < 4; ++rg) OT[(16 * ct + 4 * q4 + rg) * 132 + 16 * wave + r16] = oo[ct][rg];
    }
    __syncthreads();
    GDN_EPILOGUE(63, zp);
#undef GDN_EPILOGUE
#undef GDN_STAGE
}

constexpr int SP = 272;
DEV void ph_ssd_local(const Args& a, const Ctx& X) {
    const bf16_t* xbcpre = (const bf16_t*)(a.ws + WS_XBCPRE); const float* small = (const float*)(a.ws + WS_SMALL);
    bf16_t* CC = (bf16_t*)(a.ws + WS_CC); float* acum = (float*)(a.ws + WS_ACUM); float* cdec = (float*)(a.ws + WS_CDEC);
    bf16_t* ydiag = (bf16_t*)(a.ws + WS_YDIAG); bf16_t* states = (bf16_t*)(a.ws + WS_STATES);
    LAS unsigned char* Bn = X.lds; LAS unsigned char* Cn = X.lds + 128 * SP; LAS unsigned char* BT = X.lds + 256 * SP;
    LAS unsigned char* xdT = X.lds; LAS unsigned char* xeT = X.lds + 64 * SP;
    LAS float* acL = (LAS float*)(X.lds + AUX_OFF); LAS float* dtL = acL + 8 * 128;
    const int lane = X.lane, wave = X.wave, r16 = lane & 15, q4 = lane >> 4;
    for (int unit = X.bid; unit < NB * 32 * 2; unit += X.G) {
        const int g = unit & 1, c = (unit >> 1) & 31, b = unit >> 6; const size_t t0 = (size_t)b * SEQ + 128 * c;
        __syncthreads();
        {
            const int hd = g * 8 + wave; const float an = -__expf(a.ssd_a_log[hd]), bias = a.ssd_dt_bias[hd];
            const float d0 = softplusf(small[(t0 + lane) * 32 + 16 + hd] + bias), d1 = softplusf(small[(t0 + 64 + lane) * 32 + 16 + hd] + bias);
            float s0 = d0 * an, s1 = d1 * an;
#pragma unroll
            for (int o = 1; o < 64; o <<= 1) { const float v0 = __shfl_up(s0, o), v1 = __shfl_up(s1, o); if (lane >= o) { s0 += v0; s1 += v1; } }
            s1 += __shfl(s0, 63);
            acL[wave * 128 + lane] = s0; acL[wave * 128 + 64 + lane] = s1; dtL[wave * 128 + lane] = d0; dtL[wave * 128 + 64 + lane] = d1;
            acum[((size_t)g * T + t0 + lane) * 8 + wave] = s0; acum[((size_t)g * T + t0 + 64 + lane) * 8 + wave] = s1;
            if (lane == 63) cdec[(size_t)unit * 32 + wave] = __expf(s1);
        }
        {
            const int isC = lane >> 5, cc = (lane & 31) * 4, col = 1024 + isC * 256 + g * 128 + cc;
            float w[4][4], bs[4];
#pragma unroll
            for (int i = 0; i < 4; ++i) { const f32x4 t = *(const f32x4*)(a.ssd_conv_w + i * 1536 + col); w[i][0] = t[0]; w[i][1] = t[1]; w[i][2] = t[2]; w[i][3] = t[3]; }
            { const f32x4 t = *(const f32x4*)(a.ssd_conv_b + col); bs[0] = t[0]; bs[1] = t[1]; bs[2] = t[2]; bs[3] = t[3]; }
            float xin[19][4];
#pragma unroll
            for (int i = 0; i < 19; ++i) { const int tk = 16 * wave + i - 3; const bool ok = (128 * c + tk) >= 0; u32x2 v = {0u, 0u}; if (ok) v = *(const u32x2*)(xbcpre + (t0 + tk) * 1536 + col);
                xin[i][0] = __uint_as_float(v.x << 16); xin[i][1] = __uint_as_float(v.x & 0xFFFF0000u); xin[i][2] = __uint_as_float(v.y << 16); xin[i][3] = __uint_as_float(v.y & 0xFFFF0000u); }
            unsigned short ov[16][4];
#pragma unroll
            for (int i = 0; i < 16; ++i)
#pragma unroll
                for (int e = 0; e < 4; ++e) { const float s = bs[e] + w[0][e] * xin[i][e] + w[1][e] * xin[i + 1][e] + w[2][e] * xin[i + 2][e] + w[3][e] * xin[i + 3][e]; ov[i][e] = (unsigned short)f2bf(siluf(s)); }
            LAS unsigned char* nat = isC ? Cn : Bn;
#pragma unroll
            for (int i = 0; i < 16; ++i) { const u32x2 pk = {(unsigned)ov[i][0] | ((unsigned)ov[i][1] << 16), (unsigned)ov[i][2] | ((unsigned)ov[i][3] << 16)};
                *(LAS u32x2*)(nat + (16 * wave + i) * SP + cc * 2) = pk;
                if (isC) *(u32x2*)(CC + (t0 + 16 * wave + i) * 256 + g * 128 + cc) = pk; }
            if (!isC) {
#pragma unroll
                for (int e = 0; e < 4; ++e)
#pragma unroll
                    for (int qq = 0; qq < 4; ++qq) { const u32x2 pk = {(unsigned)ov[4 * qq][e] | ((unsigned)ov[4 * qq + 1][e] << 16), (unsigned)ov[4 * qq + 2][e] | ((unsigned)ov[4 * qq + 3][e] << 16)};
                        *(LAS u32x2*)(BT + (cc + e) * SP + (32 * (wave >> 1) + 8 * qq + 4 * (wave & 1)) * 2) = pk; }
            }
        }
        __syncthreads();
        f32x4 cbt[8];
        {
            bf16x8 cf[4];
#pragma unroll
            for (int ks = 0; ks < 4; ++ks) cf[ks] = *(const LAS bf16x8*)(Cn + (16 * wave + r16) * SP + (32 * ks + 8 * q4) * 2);
#pragma unroll
            for (int st = 0; st < 8; ++st) { cbt[st] = (f32x4){0.f, 0.f, 0.f, 0.f};
#pragma unroll
                for (int ks = 0; ks < 4; ++ks) { const bf16x8 bf = *(const LAS bf16x8*)(Bn + (16 * st + r16) * SP + (32 * ks + 8 * q4) * 2); cbt[st] = __builtin_amdgcn_mfma_f32_16x16x32_bf16(bf, cf[ks], cbt[st], 0, 0, 0); } }
        }
        __syncthreads();
        const int lq = 16 * wave + r16;
        unsigned short xnx[19];
#define SSD_LOADX(hh) do { _Pragma("unroll") for (int _i = 0; _i < 19; ++_i) { const int _tk = 16 * wave + _i - 3; xnx[_i] = (128 * c + _tk) >= 0 ? xbcpre[(t0 + _tk) * 1536 + (hh) * 64 + lane] : (unsigned short)0; } } while (0)
        SSD_LOADX(g * 8);
        for (int r = 0; r < 8; ++r) {
            const int hd = g * 8 + r; const float dd = a.ssd_d[hd];
            {
                const int col = hd * 64 + lane; float w0 = a.ssd_conv_w[col], w1 = a.ssd_conv_w[1536 + col], w2 = a.ssd_conv_w[2 * 1536 + col], w3 = a.ssd_conv_w[3 * 1536 + col]; const float bs = a.ssd_conv_b[col];
                float xin[19];
#pragma unroll
                for (int i = 0; i < 19; ++i) xin[i] = bf2f(xnx[i]);
                if (r + 1 < 8) SSD_LOADX(hd + 1);
                const float aclast = acL[r * 128 + 127];
                unsigned short xd[16], xe[16];
#pragma unroll
                for (int i = 0; i < 16; ++i) { const float xv = siluf(bs + w0 * xin[i] + w1 * xin[i + 1] + w2 * xin[i + 2] + w3 * xin[i + 3]); const int tk = 16 * wave + i;
                    const float xdv = xv * dtL[r * 128 + tk]; xd[i] = (unsigned short)f2bf(xdv); xe[i] = (unsigned short)f2bf(xdv * __expf(aclast - acL[r * 128 + tk])); }
#pragma unroll
                for (int qq = 0; qq < 4; ++qq) { const int pos = 32 * (wave >> 1) + 8 * qq + 4 * (wave & 1);
                    *(LAS u32x2*)(xdT + lane * SP + pos * 2) = (u32x2){(unsigned)xd[4 * qq] | ((unsigned)xd[4 * qq + 1] << 16), (unsigned)xd[4 * qq + 2] | ((unsigned)xd[4 * qq + 3] << 16)};
                    *(LAS u32x2*)(xeT + lane * SP + pos * 2) = (u32x2){(unsigned)xe[4 * qq] | ((unsigned)xe[4 * qq + 1] << 16), (unsigned)xe[4 * qq + 2] | ((unsigned)xe[4 * qq + 3] << 16)}; }
            }
            __syncthreads();
            {
                const float acl = acL[r * 128 + lq], ddt = dd / dtL[r * 128 + lq];
                f32x4 yd[4];
#pragma unroll
                for (int pt = 0; pt < 4; ++pt) yd[pt] = (f32x4){0.f, 0.f, 0.f, 0.f};
#pragma unroll
                for (int ks = 0; ks < 4; ++ks) { if (ks <= (wave >> 1)) {
                    f32x4 mlo, mhi;
#pragma unroll
                    for (int e = 0; e < 4; ++e) {
                        const int s0 = 32 * ks + 4 * q4 + e, s1 = s0 + 16;
                        const float v0 = cbt[2 * ks][e], v1 = cbt[2 * ks + 1][e];
                        mlo[e] = s0 < lq ? v0 * __expf(acl - acL[r * 128 + s0]) : (s0 == lq ? v0 + ddt : 0.f);
                        mhi[e] = s1 < lq ? v1 * __expf(acl - acL[r * 128 + s1]) : (s1 == lq ? v1 + ddt : 0.f);
                    }
                    const bf16x8 mf = acc_to_frag(mlo, mhi);
#pragma unroll
                    for (int pt = 0; pt < 4; ++pt) { const bf16x8 xf = *(const LAS bf16x8*)(xdT + (16 * pt + r16) * SP + (32 * ks + 8 * q4) * 2); yd[pt] = __builtin_amdgcn_mfma_f32_16x16x32_bf16(xf, mf, yd[pt], 0, 0, 0); }
                } }
#pragma unroll
                for (int pt = 0; pt < 4; ++pt) *(u32x2*)(ydiag + (t0 + lq) * 1024 + hd * 64 + 16 * pt + 4 * q4) = (u32x2){pg8::cvt_pk_bf16(yd[pt][0], yd[pt][1]), pg8::cvt_pk_bf16(yd[pt][2], yd[pt][3])};
            }
            {
                bf16x8 bf[4];
#pragma unroll
                for (int ks = 0; ks < 4; ++ks) bf[ks] = *(const LAS bf16x8*)(BT + (16 * wave + r16) * SP + (32 * ks + 8 * q4) * 2);
                bf16_t* hp = states + ((size_t)(unit * 8 + r) * 64) * 128;
#pragma unroll
                for (int pt = 0; pt < 4; ++pt) { f32x4 st = {0.f, 0.f, 0.f, 0.f};
#pragma unroll
                    for (int ks = 0; ks < 4; ++ks) { const bf16x8 xf = *(const LAS bf16x8*)(xeT + (16 * pt + r16) * SP + (32 * ks + 8 * q4) * 2); st = __builtin_amdgcn_mfma_f32_16x16x32_bf16(bf[ks], xf, st, 0, 0, 0); }
                    *(u32x2*)(hp + (size_t)(16 * pt + r16) * 128 + 16 * wave + 4 * q4) = (u32x2){pg8::cvt_pk_bf16(st[0], st[1]), pg8::cvt_pk_bf16(st[2], st[3])}; }
            }
            __syncthreads();
        }
    }
}
DEV void ph_ssd_scan(const Args& a, const Ctx& X, const int wg0) {
    bf16_t* states = (bf16_t*)(a.ws + WS_STATES); const float* cdec = (const float*)(a.ws + WS_CDEC);
    for (int task = (X.bid - wg0) * NTHR + X.tid; task < NB * 16 * 64 * 32; task += (X.G - wg0) * NTHR) {
        const int n4 = task & 31, p = (task >> 5) & 63, hd = (task >> 11) & 15, b = task >> 15;
        float h0 = 0.f, h1 = 0.f, h2 = 0.f, h3 = 0.f;
        for (int c = 0; c < 32; ++c) {
            const int unit = (b * 32 + c) * 2 + (hd >> 3);
            u32x2* ptr = (u32x2*)(states + ((size_t)(unit * 8 + (hd & 7)) * 64 + p) * 128 + 4 * n4);
            const u32x2 sv = *ptr; const float dec = cdec[(size_t)unit * 32 + (hd & 7)];
            *ptr = (u32x2){pk2(h0, h1), pk2(h2, h3)};
            h0 = h0 * dec + __uint_as_float(sv.x << 16); h1 = h1 * dec + __uint_as_float(sv.x & 0xFFFF0000u); h2 = h2 * dec + __uint_as_float(sv.y << 16); h3 = h3 * dec + __uint_as_float(sv.y & 0xFFFF0000u);
        }
    }
}
DEV void ph_ssd_out(const Args& a, const Ctx& X, const int wg0) {
    const bf16_t* CC = (const bf16_t*)(a.ws + WS_CC); const float* acum = (const float*)(a.ws + WS_ACUM); const bf16_t* ydiag = (const bf16_t*)(a.ws + WS_YDIAG);
    const bf16_t* states = (const bf16_t*)(a.ws + WS_STATES); const bf16_t* zb = (const bf16_t*)(a.ws + WS_ZB); bf16_t* oy = (bf16_t*)(a.ws + WS_OY);
    const int lane = X.lane, wave = X.wave, r16 = lane & 15, q4 = lane >> 4;
    for (int unit = X.bid - wg0; unit < NB * 32 * 2; unit += X.G - wg0) {
        const int g = unit & 1, c = (unit >> 1) & 31, b = unit >> 6; const size_t t = (size_t)b * SEQ + 128 * c + 16 * wave + r16;
        bf16x8 cf[4];
#pragma unroll
        for (int ks = 0; ks < 4; ++ks) cf[ks] = *(const bf16x8*)(CC + t * 256 + g * 128 + 32 * ks + 8 * q4);
        float ss = 0.f;
        LAS u32x2* stash = (LAS u32x2*)(X.lds + wave * 16384);
        for (int r = 0; r < 8; ++r) {
            const int hd = g * 8 + r; const float eac = __expf(acum[((size_t)g * T + t) * 8 + r]);
            const bf16_t* hp = states + ((size_t)(unit * 8 + r) * 64) * 128;
#pragma unroll
            for (int pt = 0; pt < 4; ++pt) { f32x4 acc = {0.f, 0.f, 0.f, 0.f};
#pragma unroll
                for (int ks = 0; ks < 4; ++ks) { const bf16x8 hf = *(const bf16x8*)(hp + (size_t)(16 * pt + r16) * 128 + 32 * ks + 8 * q4); acc = __builtin_amdgcn_mfma_f32_16x16x32_bf16(hf, cf[ks], acc, 0, 0, 0); }
                const u32x2 yd = *(const u32x2*)(ydiag + t * 1024 + hd * 64 + 16 * pt + 4 * q4), zz = *(const u32x2*)(zb + t * 1024 + hd * 64 + 16 * pt + 4 * q4);
                f32x4 v; v[0] = acc[0] * eac + __uint_as_float(yd.x << 16); v[1] = acc[1] * eac + __uint_as_float(yd.x & 0xFFFF0000u); v[2] = acc[2] * eac + __uint_as_float(yd.y << 16); v[3] = acc[3] * eac + __uint_as_float(yd.y & 0xFFFF0000u);
                v[0] *= siluf(__uint_as_float(zz.x << 16)); v[1] *= siluf(__uint_as_float(zz.x & 0xFFFF0000u)); v[2] *= siluf(__uint_as_float(zz.y << 16)); v[3] *= siluf(__uint_as_float(zz.y & 0xFFFF0000u));
                ss += v[0] * v[0] + v[1] * v[1] + v[2] * v[2] + v[3] * v[3];
                stash[(r * 4 + pt) * 64 + lane] = (u32x2){pg8::cvt_pk_bf16(v[0], v[1]), pg8::cvt_pk_bf16(v[2], v[3])}; }
        }
        ss += __shfl_xor(ss, 16); ss += __shfl_xor(ss, 32);
        const float rstd = rsqrtf(ss * (1.f / 512.f) + EPS);
        for (int r = 0; r < 8; ++r)
#pragma unroll
            for (int pt = 0; pt < 4; ++pt) { const int cix = g * 512 + r * 64 + 16 * pt + 4 * q4; const f32x4 nw = *(const f32x4*)(a.ssd_norm_w + cix); const u32x2 w = stash[(r * 4 + pt) * 64 + lane];
                *(u32x2*)(oy + t * 2048 + 1024 + cix) = (u32x2){pg8::cvt_pk_bf16(__uint_as_float(w.x << 16) * rstd * nw[0], __uint_as_float(w.x & 0xFFFF0000u) * rstd * nw[1]), pg8::cvt_pk_bf16(__uint_as_float(w.y << 16) * rstd * nw[2], __uint_as_float(w.y & 0xFFFF0000u) * rstd * nw[3])}; }
    }
}


DEV void ph_attn(const Args& a, const Ctx& X) {
    const bf16_t* qkv = (const bf16_t*)(a.ws + WS_Q1KV); bf16_t* po = (bf16_t*)(a.ws + WS_PO); float* plse = (float*)(a.ws + WS_PLSE); unsigned char* o = a.ws + WS_O1;
    LAS unsigned char* vl = X.lds + X.wave * 12288;
    LAS unsigned char* kl = vl + 6144;
    const int lane = X.lane, q = lane & 31, h5 = lane >> 5;
    const int tr_off = ((lane & 15) >> 2) * 192 + (16 * ((lane >> 4) & 1) + 4 * (lane & 3)) * 2;
    const int prow = lane >> 3, pch = lane & 7;
    for (int unit = X.bid; unit < NB * 16 * 4; unit += X.G) {
        const int bhd = unit & 63, b = bhd >> 4, hd = bhd & 15, g = unit >> 6;
        for (int tk = 0; tk < 6; ++tk) {
            const int br = tk >> 1, idx = X.wave * 2 + (tk & 1);
            int d, r, I0;
            if (br == 0) { d = 1; r = 0; I0 = 1024 * g + 64 * idx; } else if (br == 1) { d = 4; r = idx & 3; I0 = 256 * g + 64 * (idx >> 2); } else { d = 16; r = idx; I0 = 64 * g; }
#define ATT_LOAD(dst, j0_, coff) do { _Pragma("unroll") for (int _i = 0; _i < 4; ++_i) { const size_t _t = (size_t)b * SEQ + (size_t)((j0_) + 8 * _i + prow) * d + r; \
                dst[_i] = *(const u32x4*)(qkv + _t * 3072 + (coff) + hd * 64 + pch * 8); } } while (0)
            u32x4 k0[4], v0[4], k1[4], v1[4];
            const bool e3 = (I0 - 32) >= 0, e2 = (I0 - 64) >= 0, e1 = (I0 - 96) >= 0, e0 = (I0 - 128) >= 0;
            ATT_LOAD(k0, I0, 0); ATT_LOAD(k1, I0 + 32, 0);
            bf16x8 qA[4], qB[4];
#pragma unroll
            for (int i = 0; i < 4; ++i) *(LAS u32x4*)(kl + (8 * i + prow) * 144 + pch * 16) = k0[i];
#pragma unroll
            for (int s = 0; s < 4; ++s) qA[s] = *(const LAS bf16x8*)(kl + q * 144 + (16 * s + 8 * h5) * 2);
            LDS_WAIT();
#pragma unroll
            for (int i = 0; i < 4; ++i) *(LAS u32x4*)(kl + (8 * i + prow) * 144 + pch * 16) = k1[i];
#pragma unroll
            for (int s = 0; s < 4; ++s) qB[s] = *(const LAS bf16x8*)(kl + q * 144 + (16 * s + 8 * h5) * 2);
            LDS_WAIT();
            ATT_LOAD(k0, I0 + 32, 1024); ATT_LOAD(v0, I0 + 32, 2048);
            ATT_LOAD(k1, I0, 1024); ATT_LOAD(v1, I0, 2048);
            f32x16 oA[2], oB[2];
#pragma unroll
            for (int i = 0; i < 16; ++i) { oA[0][i] = 0.f; oA[1][i] = 0.f; oB[0][i] = 0.f; oB[1][i] = 0.f; }
            float mA = -1e30f, lA = 0.f, mB = -1e30f, lB = 0.f;
            auto scores = [&](const bf16x8 (&kf)[4], const bf16x8 (&qf)[4], f32x16 (&oacc)[2], float& m, float& l, const int mode, bf16x8 (&pf)[2]) {
                f32x16 sacc;
#pragma unroll
                for (int i = 0; i < 16; ++i) sacc[i] = 0.f;
#pragma unroll
                for (int s = 0; s < 4; ++s) sacc = __builtin_amdgcn_mfma_f32_32x32x16_bf16(kf[s], qf[s], sacc, 0, 0, 0);
                if (mode == 1) {
#pragma unroll
                    for (int i = 0; i < 16; ++i) { const int kl_ = (i & 3) + 8 * (i >> 2) + 4 * h5; if (kl_ > q) sacc[i] = -1e30f; }
                } else if (mode == 2) {
#pragma unroll
                    for (int i = 0; i < 16; ++i) { const int kl_ = (i & 3) + 8 * (i >> 2) + 4 * h5; if (kl_ < q) sacc[i] = -1e30f; }
                }
                float mx = sacc[0];
#pragma unroll
                for (int i = 1; i < 16; ++i) mx = fmaxf(mx, sacc[i]);
                mx = fmaxf(mx, __shfl_xor(mx, 32));
                const float mn = fmaxf(m, mx), alpha = __expf(m - mn);
                float rs = 0.f;
#pragma unroll
                for (int i = 0; i < 16; ++i) { sacc[i] = __expf(sacc[i] - mn); rs += sacc[i]; }
                rs += __shfl_xor(rs, 32);
                l = l * alpha + rs; m = mn;
#pragma unroll
                for (int i = 0; i < 16; ++i) { oacc[0][i] *= alpha; oacc[1][i] *= alpha; }
#pragma unroll
                for (int s = 0; s < 2; ++s) { u32x4 w; w.x = pg8::cvt_pk_bf16(sacc[8 * s], sacc[8 * s + 1]); w.y = pg8::cvt_pk_bf16(sacc[8 * s + 2], sacc[8 * s + 3]); w.z = pg8::cvt_pk_bf16(sacc[8 * s + 4], sacc[8 * s + 5]); w.w = pg8::cvt_pk_bf16(sacc[8 * s + 6], sacc[8 * s + 7]);
                    pf[s] = __builtin_bit_cast(bf16x8, w); }
            };
            auto tile = [&](const u32x4 (&kp)[4], const u32x4 (&vp)[4], const int ma, const int mb) {
#pragma unroll
                for (int i = 0; i < 4; ++i) { *(LAS u32x4*)(kl + (8 * i + prow) * 144 + pch * 16) = kp[i]; *(LAS u32x4*)(vl + (8 * i + prow) * 192 + pch * 16) = vp[i]; }
                bf16x8 kf[4];
#pragma unroll
                for (int s = 0; s < 4; ++s) kf[s] = *(const LAS bf16x8*)(kl + q * 144 + (16 * s + 8 * h5) * 2);
                bf16x8 pA[2], pB[2];
                if (ma >= 0) scores(kf, qA, oA, mA, lA, ma, pA);
                if (mb >= 0) scores(kf, qB, oB, mB, lB, mb, pB);
#pragma unroll
                for (int dt = 0; dt < 2; ++dt)
#pragma unroll
                    for (int s = 0; s < 2; ++s) {
                        const s16x4 t0_ = __builtin_amdgcn_ds_read_tr16_b64_v4i16((LAS s16x4*)(vl + (16 * s + 4 * h5) * 192 + dt * 64 + tr_off));
                        const s16x4 t1_ = __builtin_amdgcn_ds_read_tr16_b64_v4i16((LAS s16x4*)(vl + (16 * s + 8 + 4 * h5) * 192 + dt * 64 + tr_off));
                        bf16x8 vf; vf[0] = t0_[0]; vf[1] = t0_[1]; vf[2] = t0_[2]; vf[3] = t0_[3]; vf[4] = t1_[0]; vf[5] = t1_[1]; vf[6] = t1_[2]; vf[7] = t1_[3];
                        if (ma >= 0) oA[dt] = __builtin_amdgcn_mfma_f32_32x32x16_bf16(vf, pA[s], oA[dt], 0, 0, 0);
                        if (mb >= 0) oB[dt] = __builtin_amdgcn_mfma_f32_32x32x16_bf16(vf, pB[s], oB[dt], 0, 0, 0);
                    }
                LDS_WAIT();
            };
            tile(k0, v0, -1, 1);
            if (e3) { ATT_LOAD(k0, I0 - 32, 1024); ATT_LOAD(v0, I0 - 32, 2048); }
            tile(k1, v1, 1, 0);
            if (e3) {
                if (e2) { ATT_LOAD(k1, I0 - 64, 1024); ATT_LOAD(v1, I0 - 64, 2048); }
                tile(k0, v0, 0, 0);
                if (e2) {
                    if (e1) { ATT_LOAD(k0, I0 - 96, 1024); ATT_LOAD(v0, I0 - 96, 2048); }
                    tile(k1, v1, 0, 0);
                    if (e1) {
                        if (e0) { ATT_LOAD(k1, I0 - 128, 1024); ATT_LOAD(v1, I0 - 128, 2048); }
                        tile(k0, v0, 0, 2);
                        if (e0) tile(k1, v1, 2, -1);
                    }
                }
            }
#undef ATT_LOAD
#pragma unroll
            for (int qt = 0; qt < 2; ++qt) {
                const size_t tq = (size_t)b * SEQ + (size_t)(I0 + 32 * qt + q) * d + r;
                const float l = qt ? lB : lA, m = qt ? mB : mA; const float inv = 1.f / l;
                bf16_t* pr = po + ((size_t)br * T + tq) * 1024 + hd * 64;
#pragma unroll
                for (int dt = 0; dt < 2; ++dt)
#pragma unroll
                    for (int gq = 0; gq < 4; ++gq) { const f32x16& oo = qt ? oB[dt] : oA[dt]; u32x2 w; w.x = pg8::cvt_pk_bf16(oo[4 * gq] * inv, oo[4 * gq + 1] * inv); w.y = pg8::cvt_pk_bf16(oo[4 * gq + 2] * inv, oo[4 * gq + 3] * inv);
                        *(u32x2*)(pr + 32 * dt + 8 * gq + 4 * h5) = w; }
                if (h5 == 0) plse[((size_t)br * T + tq) * 16 + hd] = m + __logf(l);
            }
        }
        VM_WAIT(); __syncthreads();
        for (int hf = 0; hf < 2; ++hf) {
            const size_t t = (size_t)b * SEQ + 1024 * g + 512 * hf + X.tid;
            const float l0 = plse[t * 16 + hd], l1 = plse[((size_t)T + t) * 16 + hd], l2 = plse[((size_t)2 * T + t) * 16 + hd];
            const float mx = fmaxf(l0, fmaxf(l1, l2)); float w0 = __expf(l0 - mx), w1 = __expf(l1 - mx), w2 = __expf(l2 - mx); const float wi = 1.f / (w0 + w1 + w2); w0 *= wi; w1 *= wi; w2 *= wi;
            const bf16_t* p0 = po + t * 1024 + hd * 64; const bf16_t* p1 = p0 + (size_t)T * 1024; const bf16_t* p2 = p1 + (size_t)T * 1024; unsigned char* orow = o + t * 1024 + hd * 64;
            w0 *= 4.f; w1 *= 4.f; w2 *= 4.f;
            u32x4 yq[4];
#pragma unroll
            for (int c = 0; c < 8; ++c) { const u32x4 x0 = *(const u32x4*)(p0 + 8 * c), x1 = *(const u32x4*)(p1 + 8 * c), x2 = *(const u32x4*)(p2 + 8 * c); float f[8];
#pragma unroll
                for (int e = 0; e < 4; ++e) { f[2 * e] = w0 * __uint_as_float(x0[e] << 16) + w1 * __uint_as_float(x1[e] << 16) + w2 * __uint_as_float(x2[e] << 16);
                    f[2 * e + 1] = w0 * __uint_as_float(x0[e] & 0xFFFF0000u) + w1 * __uint_as_float(x1[e] & 0xFFFF0000u) + w2 * __uint_as_float(x2[e] & 0xFFFF0000u); }
#pragma unroll
                for (int e = 0; e < 8; ++e) f[e] = fminf(fmaxf(f[e], -440.f), 440.f);
                int v0 = __builtin_amdgcn_cvt_pk_fp8_f32(f[0], f[1], 0, false); v0 = __builtin_amdgcn_cvt_pk_fp8_f32(f[2], f[3], v0, true);
                int v1 = __builtin_amdgcn_cvt_pk_fp8_f32(f[4], f[5], 0, false); v1 = __builtin_amdgcn_cvt_pk_fp8_f32(f[6], f[7], v1, true);
                yq[c >> 1][2 * (c & 1)] = (unsigned)v0; yq[c >> 1][2 * (c & 1) + 1] = (unsigned)v1; }
#pragma unroll
            for (int j = 0; j < 4; ++j) *(u32x4*)(orow + 16 * j) = yq[j];
        }
    }
}

DEV void ph_router(const Args& a, const Ctx& X, const int l) {
    unsigned char* ws = a.ws;
    const float* mod = (const float*)(ws + WS_MOD) + (size_t)l * NB * 6 * D;
    const bf16_t* ymix = (const bf16_t*)(ws + WS_YMIX);
    bf16_t* xb = (bf16_t*)(ws + WS_XB);
    bf16_t* hb = (bf16_t*)(ws + WS_H);
    int* idx = (int*)(ws + WS_IDX); float* gw = (float*)(ws + WS_GW); int* aslot = (int*)(ws + WS_ASLOT); int* ltok = (int*)(ws + WS_LTOK);
    int* cntg = (int*)(ws + WS_CTL + CTL_CNT) + l * NE;
    const float* rw = a.router_w + (size_t)l * D * NE; const float* rbias = a.router_bias + l * NE;
    constexpr int HP = 2064;
    LAS unsigned char* hL = X.lds;
    LAS float* logit = (LAS float*)(X.lds + AUX_OFF + 2048);
    LAS int* lcnt = (LAS int*)(X.lds + AUX_OFF + 2048 + 64 * 65 * 4);
    LAS int* lbase = lcnt + 64;
    LAS int* sel_e = lbase + 64;
    LAS int* sel_s = sel_e + 512;
    const int lane = X.lane, wave = X.wave;
    for (int rb = X.bid; rb < T / 64; rb += X.G) {
        if (X.tid < 64) lcnt[X.tid] = 0;
        f32x4 xf_n[4]; u32x2 xb_n[4], ym_n[4];
#define RT_LOAD(rr) do { const int _row = rb * 64 + wave * 8 + (rr); _Pragma("unroll") for (int _j = 0; _j < 4; ++_j) { \
            if (l == 0) xf_n[_j] = *(const f32x4*)(a.x + (size_t)_row * D + _j * 256 + lane * 4); else xb_n[_j] = *(const u32x2*)(xb + (size_t)_row * D + _j * 256 + lane * 4); \
            ym_n[_j] = *(const u32x2*)(ymix + (size_t)_row * D + _j * 256 + lane * 4); } } while (0)
        RT_LOAD(0);
        for (int r8 = 0; r8 < 8; ++r8) {
            const int lr = wave * 8 + r8, row = rb * 64 + lr, b = row / SEQ; const float* ml = mod + (size_t)b * 6 * D;
            float xv[16], yv[16];
#pragma unroll
            for (int j = 0; j < 4; ++j) {
                if (l == 0) { xv[4 * j] = xf_n[j][0]; xv[4 * j + 1] = xf_n[j][1]; xv[4 * j + 2] = xf_n[j][2]; xv[4 * j + 3] = xf_n[j][3]; }
                else { xv[4 * j] = __uint_as_float(xb_n[j].x << 16); xv[4 * j + 1] = __uint_as_float(xb_n[j].x & 0xFFFF0000u); xv[4 * j + 2] = __uint_as_float(xb_n[j].y << 16); xv[4 * j + 3] = __uint_as_float(xb_n[j].y & 0xFFFF0000u); }
                yv[4 * j] = __uint_as_float(ym_n[j].x << 16); yv[4 * j + 1] = __uint_as_float(ym_n[j].x & 0xFFFF0000u); yv[4 * j + 2] = __uint_as_float(ym_n[j].y << 16); yv[4 * j + 3] = __uint_as_float(ym_n[j].y & 0xFFFF0000u); }
            if (r8 + 1 < 8) RT_LOAD(r8 + 1);
            resid_update(xv, yv, a.mix_post_g + l * D, ml + 2 * D, lane);
            store_row_bf(xb + (size_t)row * D, lane, xv);
            u32x2 o[4]; prenorm_pack(xv, a.ffn_pre_g + l * D, ml + 4 * D, ml + 3 * D, lane, o);
#pragma unroll
            for (int j = 0; j < 4; ++j) { *(LAS u32x2*)(hL + lr * HP + (j * 256 + lane * 4) * 2) = o[j];
                const float h0 = __uint_as_float(o[j].x << 16), h1 = __uint_as_float(o[j].x & 0xFFFF0000u), h2 = __uint_as_float(o[j].y << 16), h3 = __uint_as_float(o[j].y & 0xFFFF0000u);
                int w = __builtin_amdgcn_cvt_pk_fp8_f32(fminf(fmaxf(h0, -440.f), 440.f), fminf(fmaxf(h1, -440.f), 440.f), 0, false); w = __builtin_amdgcn_cvt_pk_fp8_f32(fminf(fmaxf(h2, -440.f), 440.f), fminf(fmaxf(h3, -440.f), 440.f), w, true);
                *(unsigned*)((unsigned char*)hb + (size_t)row * D + j * 256 + lane * 4) = (unsigned)w; }
        }
#undef RT_LOAD
        __syncthreads();
        { const int rt = wave & 3, nh = wave >> 2, r16 = lane & 15, kq = lane >> 4;
          f32x4 acc0 = {0.f, 0.f, 0.f, 0.f}, acc1 = {0.f, 0.f, 0.f, 0.f};
          for (int c = 0; c < 32; ++c) {
              const u32x4 hv = *(const LAS u32x4*)(hL + (rt * 16 + r16) * HP + (32 * c + 8 * kq) * 2);
              const float* rp = rw + (size_t)(32 * c + 8 * kq) * NE + 4 * r16 + 2 * nh;
#pragma unroll
              for (int j = 0; j < 8; ++j) { const unsigned wj = hv[j >> 1]; const float av = (j & 1) ? __uint_as_float(wj & 0xFFFF0000u) : __uint_as_float(wj << 16);
                  const f32x2 bv = *(const f32x2*)(rp + (size_t)j * NE);
                  acc0 = __builtin_amdgcn_mfma_f32_16x16x4f32(av, bv.x, acc0, 0, 0, 0); acc1 = __builtin_amdgcn_mfma_f32_16x16x4f32(av, bv.y, acc1, 0, 0, 0); }
          }
#pragma unroll
          for (int r = 0; r < 4; ++r) { logit[(rt * 16 + 4 * kq + r) * 65 + 4 * r16 + 2 * nh] = acc0[r]; logit[(rt * 16 + 4 * kq + r) * 65 + 4 * r16 + 2 * nh + 1] = acc1[r]; } }
        __syncthreads();
        for (int r8 = 0; r8 < 8; ++r8) {
            const int lr = wave * 8 + r8, t = rb * 64 + lr;
            float lgt = logit[lr * 65 + lane]; if (!(lgt > -1e30f && lgt < 1e30f)) lgt = 0.f;
            const float score = sigmoidf_(lgt), biased = score + rbias[lane];
            float m1 = biased;
#pragma unroll
            for (int o = 1; o < 8; o <<= 1) m1 = fmaxf(m1, __shfl_xor(m1, o));
            int c1 = (biased == m1) ? (lane & 7) : 8;
#pragma unroll
            for (int o = 1; o < 8; o <<= 1) c1 = min(c1, __shfl_xor(c1, o));
            float m2 = ((lane & 7) == c1) ? -INFINITY : biased;
#pragma unroll
            for (int o = 1; o < 8; o <<= 1) m2 = fmaxf(m2, __shfl_xor(m2, o));
            const float gs = m1 + m2; const int myg = lane >> 3; int grank = 0;
#pragma unroll
            for (int g2 = 0; g2 < 8; ++g2) { const float o = __shfl(gs, g2 * 8); grank += (o > gs || (o == gs && g2 < myg)) ? 1 : 0; }
            const float cand = (grank < 4) ? biased : -INFINITY; int rank = 0;
            for (int e2 = 0; e2 < 64; ++e2) { const float o = __shfl(cand, e2); rank += (o > cand || (o == cand && e2 < lane)) ? 1 : 0; }
            const bool sel = (rank < TOPK) && (grank < 4);
            const float ssum = wave_sum(sel ? score : 0.f);
            if (sel) { idx[t * 8 + rank] = lane; gw[t * 8 + rank] = score / ssum * 2.5f; sel_e[lr * 8 + rank] = lane; sel_s[lr * 8 + rank] = __hip_atomic_fetch_add(lcnt + lane, 1, __ATOMIC_RELAXED, __HIP_MEMORY_SCOPE_WORKGROUP); }
        }
        __syncthreads();
        if (X.tid < 64) { const int n = lcnt[X.tid]; lbase[X.tid] = n ? atomicAdd(cntg + X.tid, n) : 0; }
        __syncthreads();
        { const int lr = X.tid >> 3, k = X.tid & 7, t = rb * 64 + lr, e = sel_e[lr * 8 + k], sl = lbase[e] + sel_s[lr * 8 + k];
          aslot[t * 8 + k] = sl; ltok[e * CAP + sl] = t; }
        __syncthreads();
    }
}
template <int NW>
DEV void ph_moe_conv(const Args& a, const Ctx& X, const int l, const int wg0) {
    unsigned char* ws = a.ws;
    if (X.wave >= NW) return;
    { LAS float* scr = (LAS float*)(X.lds + X.wave * 8704);
      const int gwv = (X.bid - wg0) * NW + X.wave, NGW = (X.G - wg0) * NW;
      constexpr int I_GU = (D / 64) * (512 / 32), I_D = (ED / 64) * (D / 32), I_E = I_GU + I_D;
      const float* eg = a.exp_gate + (size_t)l * NE * D * ED; const float* eu = a.exp_up + (size_t)l * NE * D * ED; const float* ed = a.exp_down + (size_t)l * NE * ED * D;
      for (int it = gwv; it < (NE + 1) * I_E; it += NGW) {
          const int e = it / I_E; int r = it - e * I_E;
          if (e < NE) {
              if (r < I_GU) conv_item<SrcGU, true>(SrcGU{eg + (size_t)e * D * ED, (long)(eu - eg)}, ED, D, ws + WS_WGU + (size_t)e * 512 * D, scr, r, 16, X.lane, 64.f);
              else conv_item<SrcIdent, true>(SrcIdent{ed + (size_t)e * ED * D}, D, ED, ws + WS_WD + (size_t)e * D * ED, scr, r - I_GU, D / 32, X.lane, 32.f);
          } else {
              if (r < I_GU) conv_item<SrcGU, true>(SrcGU{a.sh_gate + (size_t)l * D * ED, (long)(a.sh_up - a.sh_gate)}, ED, D, ws + WS_WGUS, scr, r, 16, X.lane, 64.f);
              else conv_item<SrcIdent, true>(SrcIdent{a.sh_down + (size_t)l * ED * D}, D, ED, ws + WS_WDS, scr, r - I_GU, D / 32, X.lane, 32.f);
          }
      } }
}

DEV int moe_tables(const Args& a, const Ctx& X, const int l, LAS int* t_cnt, LAS int* t_rb0, LAS int* t_eofrb) {
    const int* cntg = (const int*)(a.ws + WS_CTL + CTL_CNT) + l * NE;
    if (X.wave == 0) {
        const int c = __hip_atomic_load(cntg + X.lane, __ATOMIC_RELAXED, __HIP_MEMORY_SCOPE_AGENT), nrb = (c + 255) >> 8;
        int incl = nrb;
#pragma unroll
        for (int o = 1; o < 64; o <<= 1) { const int v = __shfl_up(incl, o); if (X.lane >= o) incl += v; }
        const int excl = incl - nrb;
        t_cnt[X.lane] = c; t_rb0[X.lane] = excl; if (X.lane == 63) t_rb0[64] = incl;
        for (int j = 0; j < nrb; ++j) t_eofrb[excl + j] = X.lane;
        t_eofrb[SH_RB + X.lane] = NE;
    }
    __syncthreads();
    return t_rb0[64];
}

DEV void ph_moe_gu(const Args& a, const Ctx& X, const int l) {
    LAS int* t_cnt = (LAS int*)(X.lds + AUX_OFF + 1024); LAS int* t_rb0 = t_cnt + 64; LAS int* t_eofrb = t_rb0 + 80; LAS int* toks = t_eofrb + NRB_ALL;
    const int nrbt = moe_tables(a, X, l, t_cnt, t_rb0, t_eofrb);
    const int* ltok = (const int*)(a.ws + WS_LTOK);
    pg8::Unit u;
    for (int i = 0; i < 8; ++i) { if (!pg8::moe_unit(i, 2, nrbt, X.G, X.bid, u)) break;
        if (X.tid < 256) { const int e = t_eofrb[u.pm]; int tok;
            if (e < NE) { const int sl = (u.pm - t_rb0[e]) * 256 + X.tid; tok = sl < t_cnt[e] ? ltok[e * CAP + sl] : 0; } else tok = (u.pm - SH_RB) * 256 + X.tid;
            toks[i * 256 + X.tid] = tok; } }
    VM_WAIT(); __syncthreads();
    pg8::SchedGU S{(const char*)(a.ws + WS_H), (const char*)(a.ws + WS_WGU), (const char*)(a.ws + WS_WGUS), t_eofrb, toks, nrbt, X.G, X.bid, 0};
    pg8::EpiGU E{a.ws + WS_HID};
    pg8::gemm_phase<pg8::EpiGU, pg8::SchedGU, true>(X.lds, D, S, E);
}
DEV void ph_moe_down(const Args& a, const Ctx& X, const int l) {
    LAS int* t_cnt = (LAS int*)(X.lds + AUX_OFF + 1024); LAS int* t_rb0 = t_cnt + 64; LAS int* t_eofrb = t_rb0 + 80;
    const int nrbt = moe_tables(a, X, l, t_cnt, t_rb0, t_eofrb);
    pg8::SchedDown S{(const char*)(a.ws + WS_HID), (const char*)(a.ws + WS_WD), (const char*)(a.ws + WS_WDS), t_eofrb, nrbt, X.G, X.bid, 0};
    pg8::EpiFp8 E{(unsigned char*)(a.ws + WS_Y), D, 0};
    int kd = ED; asm volatile("" : "+s"(kd));
    pg8::gemm_phase<pg8::EpiFp8, pg8::SchedDown, true>(X.lds, kd, S, E);
}
DEV void ph_combine(const Args& a, const Ctx& X, const int l) {
    LAS int* t_cnt = (LAS int*)(X.lds + AUX_OFF + 1024); LAS int* t_rb0 = t_cnt + 64; LAS int* t_eofrb = t_rb0 + 80;
    (void)moe_tables(a, X, l, t_cnt, t_rb0, t_eofrb);
    const float* mod = (const float*)(a.ws + WS_MOD);
    const int* idx = (const int*)(a.ws + WS_IDX); const float* gw = (const float*)(a.ws + WS_GW); const int* aslot = (const int*)(a.ws + WS_ASLOT);
    const unsigned char* y = a.ws + WS_Y; unsigned char* h8 = a.ws + WS_H;
    const int lane = X.lane;
    const int tstep = X.G * NWAVES;
    int t = X.bid * NWAVES + X.wave;
    int e_n = 0, s_n = 0; float g_n = 0.f;
    if (t < T && lane < 8) { e_n = idx[t * 8 + lane]; g_n = gw[t * 8 + lane]; s_n = aslot[t * 8 + lane]; }
    for (; t < T; t += tstep) {
        const int b = t / SEQ; const float* ml = mod + (size_t)(l * NB + b) * 6 * D;
        const int e_c = e_n, s_c = s_n; const float g_c = g_n;
        const int tn = t + tstep;
        if (tn < T && lane < 8) { e_n = idx[tn * 8 + lane]; g_n = gw[tn * 8 + lane]; s_n = aslot[tn * 8 + lane]; }
        u32x2 w0[9], w1[9];
        { const unsigned char* yr = y + ((size_t)SH_RB * 256 + t) * D; w0[8] = *(const u32x2*)(yr + 8 * lane); w1[8] = *(const u32x2*)(yr + 512 + 8 * lane); }
        float gk[8];
#pragma unroll
        for (int k = 0; k < 8; ++k) { const int e = __shfl(e_c, k), sl = __shfl(s_c, k); gk[k] = __shfl(g_c, k);
            const unsigned char* yr = y + ((size_t)t_rb0[e] * 256 + sl) * D; w0[k] = *(const u32x2*)(yr + 8 * lane); w1[k] = *(const u32x2*)(yr + 512 + 8 * lane); }
        float xv[16]; load_row8_bf((const bf16_t*)(a.ws + WS_XB) + (size_t)t * D, lane, xv);
        float yv[16];
#pragma unroll
        for (int i = 0; i < 16; ++i) yv[i] = 0.f;
        acc_row8(yv, w0[8], w1[8], 0.125f);
#pragma unroll
        for (int k = 0; k < 8; ++k) acc_row8(yv, w0[k], w1[k], gk[k] * 0.125f);
        resid_update8(xv, yv, a.ffn_post_g + l * D, ml + 5 * D, lane);
        if (l == 0) store_row8_bf((bf16_t*)(a.ws + WS_XB) + (size_t)t * D, lane, xv); else store_row8(a.out + (size_t)t * D, lane, xv);
        if (l == 0) { const float* mn = mod + (size_t)(1 * NB + b) * 6 * D; u32x2 o[2]; prenorm_pack8_f8(xv, a.mix_pre_g + D, mn + D, mn, lane, o);
            *(u32x2*)(h8 + (size_t)t * D + 8 * lane) = o[0]; *(u32x2*)(h8 + (size_t)t * D + 512 + 8 * lane) = o[1]; }
    }
}

constexpr int NPH = 18;
__global__ void __launch_bounds__(NTHR, 2) mega(Args a) {
    extern __shared__ __attribute__((aligned(16))) unsigned char lds_raw[];
    Ctx X; X.lds = (LAS unsigned char*)lds_raw; X.tid = threadIdx.x; X.lane = X.tid & 63; X.wave = __builtin_amdgcn_readfirstlane(X.tid >> 6); X.G = gridDim.x; X.bid = blockIdx.x;
    if (X.tid < 4) ((LAS unsigned*)(X.lds + BAR_OFF))[X.tid] = 0u;
    __syncthreads();
    XcdBarrier bar; bar.bar = (unsigned*)(a.ws + WS_CTL); bar.x = 0; bar.st = nullptr;
    if (!MK_PER_PHASE) bar = xcd_barrier_post((unsigned*)(a.ws + WS_CTL), (volatile LAS unsigned*)(X.lds + BAR_OFF));
    const int lo = a.ph_lo, hi = a.ph_hi;
#define IN(k) (lo <= (k) && (k) < hi)
#define REP(k, ...) do { __VA_ARGS__; if constexpr (((PROBE_MASK >> (k)) & 1u) != 0u) { __syncthreads(); __VA_ARGS__; } } while (0)
#define SEAM(k) do { if (IN(k) && IN((k) + 1)) xcd_barrier(bar); else { VM_WAIT(); __syncthreads(); } } while (0)
    unsigned char* ws = a.ws;
    if (IN(0)) { REP(0, ph_setup(a, X)); SEAM(0); }
    if (IN(1)) { REP(1, ph_prenorm0(a, X)); SEAM(1); }
    if constexpr (((PROBE_MASK >> 24) & 1u) != 0u) { for (int i_ = 0; i_ < 16; ++i_) xcd_barrier(bar); }
    if (IN(2)) {
        pg8::SchedDense8<0x79797979, 0x7F7F7F7F> S; S.so.init(T, NPROJ, X.G, X.bid); S.A = (const char*)(ws + WS_H); S.Bt = (const char*)(ws + WS_WIN); S.K = D; S.pad_ = 0;
        pg8::EpiProj E{(bf16_t*)(ws + WS_QKVPRE), (bf16_t*)(ws + WS_ZA), (bf16_t*)(ws + WS_XBCPRE), (bf16_t*)(ws + WS_ZB), (float*)(ws + WS_SMALL)};
        REP(2, pg8::gemm_phase<pg8::EpiProj, pg8::SchedDense8<0x79797979, 0x7F7F7F7F>, true>(X.lds, D, S, E)); SEAM(2); }
    if (IN(3)) { REP(3, ph_gdn_local(a, X)); REP(20, ph_ssd_local(a, X)); SEAM(3); }
    if (IN(4)) {
        if (X.bid < 32) { REP(4, ph_gdn_scan(a, X)); }
        else { ph_ssd_scan(a, X, 32); group_barrier((unsigned*)(ws + WS_CTL + CTL_GRP), (unsigned)(X.G - 32)); __syncthreads(); REP(5, ph_ssd_out(a, X, 32)); __syncthreads(); REP(22, ph_moe_conv<2>(a, X, 0, 32)); __syncthreads(); REP(23, ph_setup_late(a, X, 32)); }
        SEAM(4); }
    if (IN(6)) {
        pg8::SchedDense S; S.so.init(T, D, X.G, X.bid); S.A = (const char*)(ws + WS_OY); S.Bt = (const char*)(ws + WS_WOUT); S.K = 2048; S.pad_ = 0;
        pg8::EpiBf16 E{(bf16_t*)(ws + WS_YMIX), D, 0};
        REP(6, pg8::gemm_phase<pg8::EpiBf16, pg8::SchedDense>(X.lds, 2048, S, E)); SEAM(6); }
    if (IN(7)) { ph_router(a, X, 0); SEAM(7); }
    if (IN(8)) { REP(8, ph_moe_gu(a, X, 0)); SEAM(8); }
    if (IN(9)) { REP(9, ph_moe_down(a, X, 0)); SEAM(9); }
    if (IN(10)) { ph_combine(a, X, 0); SEAM(10); }
    if (IN(11)) {
        pg8::SchedDense8<0x79797979, 0x7F7F7F7F> S; S.so.init(T, 3072, X.G, X.bid); S.A = (const char*)(ws + WS_H); S.Bt = (const char*)(ws + WS_WQKV); S.K = D; S.pad_ = 0;
        pg8::EpiQKV E{(bf16_t*)(ws + WS_Q1KV), (const float*)(ws + WS_COS), (const float*)(ws + WS_SIN)};
        REP(11, pg8::gemm_phase<pg8::EpiQKV, pg8::SchedDense8<0x79797979, 0x7F7F7F7F>, true>(X.lds, D, S, E)); SEAM(11); }
    if (IN(12)) { REP(12, ph_attn(a, X)); SEAM(12); }
    if (IN(13)) {
        pg8::SchedDense8<0x79797979, 0x7D7D7D7D> S; S.so.init(T, D, X.G, X.bid); S.A = (const char*)(ws + WS_O1); S.Bt = (const char*)(ws + WS_WO); S.K = D; S.pad_ = 0;
        pg8::EpiBf16 E{(bf16_t*)(ws + WS_YMIX), D, 0};
        REP(13, pg8::gemm_phase<pg8::EpiBf16, pg8::SchedDense8<0x79797979, 0x7D7D7D7D>, true>(X.lds, D, S, E)); SEAM(13); }
    if (IN(14)) { ph_router(a, X, 1); REP(14, ph_moe_conv<8>(a, X, 1, 0)); SEAM(14); }
    if (IN(15)) { ph_moe_gu(a, X, 1); SEAM(15); }
    if (IN(16)) { ph_moe_down(a, X, 1); SEAM(16); }
    if (IN(17)) { REP(17, ph_combine(a, X, 1)); }
#undef IN
#undef SEAM
}

extern "C" void kernel_launch(void* const* d_in, const int* in_sizes, int n_in, void* d_out, int out_size, void* d_ws, size_t ws_size, hipStream_t stream) {
    static int grid = 0;
    if (!grid) {
        int dev = 0, cus = 0, per_cu = 0;
        if (hipGetDevice(&dev) != hipSuccess || hipDeviceGetAttribute(&cus, hipDeviceAttributeMultiprocessorCount, dev) != hipSuccess) { fprintf(stderr, "kernel_launch: device query failed\n"); grid = -1; return; }
        if (hipFuncSetAttribute((const void*)mega, hipFuncAttributeMaxDynamicSharedMemorySize, LDS_BYTES) != hipSuccess) { fprintf(stderr, "kernel_launch: hipFuncSetAttribute failed\n"); grid = -1; return; }
        if (hipOccupancyMaxActiveBlocksPerMultiprocessor(&per_cu, (const void*)mega, NTHR, LDS_BYTES) != hipSuccess || per_cu < 1) { fprintf(stderr, "kernel_launch: occupancy query says %d blocks per CU\n", per_cu); grid = -1; return; }
        grid = cus;
        if (grid < 64 || (grid & 7)) { fprintf(stderr, "kernel_launch: unsupported CU count %d\n", cus); grid = -1; return; }
    }
    if (grid < 0) return;
    if (ws_size < WS_END || n_in != 31) { fprintf(stderr, "kernel_launch: workspace %zu < %zu or n_in %d != 31\n", ws_size, (size_t)WS_END, n_in); return; }
    if (hipMemsetAsync((char*)d_ws + WS_CTL, 0, CTL_BYTES, stream) != hipSuccess) { fprintf(stderr, "kernel_launch: memset failed\n"); return; }
    Args a{};
    a.x = (const float*)d_in[0]; a.c = (const float*)d_in[1]; a.pos = (const int*)d_in[2]; a.mod_w = (const float*)d_in[3]; a.mod_b = (const float*)d_in[4];
    a.mix_pre_g = (const float*)d_in[5]; a.mix_post_g = (const float*)d_in[6]; a.ffn_pre_g = (const float*)d_in[7]; a.ffn_post_g = (const float*)d_in[8];
    a.ssm_w_in = (const float*)d_in[9]; a.gdn_conv_w = (const float*)d_in[10]; a.gdn_a_log = (const float*)d_in[11]; a.gdn_dt_bias = (const float*)d_in[12]; a.gdn_norm_w = (const float*)d_in[13];
    a.ssd_conv_w = (const float*)d_in[14]; a.ssd_conv_b = (const float*)d_in[15]; a.ssd_a_log = (const float*)d_in[16]; a.ssd_dt_bias = (const float*)d_in[17]; a.ssd_d = (const float*)d_in[18]; a.ssd_norm_w = (const float*)d_in[19];
    a.ssm_w_out = (const float*)d_in[20]; a.attn_w_qkv = (const float*)d_in[21]; a.attn_w_o = (const float*)d_in[22];
    a.router_w = (const float*)d_in[23]; a.router_bias = (const float*)d_in[24]; a.exp_gate = (const float*)d_in[25]; a.exp_up = (const float*)d_in[26]; a.exp_down = (const float*)d_in[27];
    a.sh_gate = (const float*)d_in[28]; a.sh_up = (const float*)d_in[29]; a.sh_down = (const float*)d_in[30];
    a.out = (float*)d_out; a.ws = (unsigned char*)d_ws;
#if MK_PER_PHASE
    for (int p = 0; p < NPH; ++p) { a.ph_lo = p; a.ph_hi = p + 1; hipLaunchKernelGGL(mega, dim3(grid), dim3(NTHR), LDS_BYTES, stream, a); }
#else
    a.ph_lo = 0; a.ph_hi = NPH;
    hipLaunchKernelGGL(mega, dim3(grid), dim3(NTHR), LDS_BYTES, stream, a);
#endif
}
```

```cpp
#include <hip/hip_runtime.h>
#include <stdint.h>
#include <stdio.h>

#define DEV __device__ __forceinline__
#define LAS __attribute__((address_space(3)))
typedef unsigned short bf16_t;
typedef short bf16x8 __attribute__((ext_vector_type(8)));
typedef float f32x4 __attribute__((ext_vector_type(4)));
typedef float f32x2 __attribute__((ext_vector_type(2)));
typedef unsigned u32x4 __attribute__((ext_vector_type(4)));
typedef unsigned u32x2 __attribute__((ext_vector_type(2)));
typedef float f32x16 __attribute__((ext_vector_type(16)));
typedef short s16x4 __attribute__((ext_vector_type(4)));

#ifndef PROBE_MASK
#define PROBE_MASK 0u
#endif
#ifndef PROBE_CONVP1
#define PROBE_CONVP1 15360
#endif
#ifndef MK_PER_PHASE
#define MK_PER_PHASE 0
#endif

constexpr int NB = 4, SEQ = 4096, T = NB * SEQ, D = 1024;
constexpr int PROJ = 6688, NPROJ = 6912;
constexpr int C_BETA = 4096, C_XBC = 4112, C_ZB = 5648, C_DT = 6672;
constexpr int NE = 64, TOPK = 8, ED = 256, CAP = 16384;
constexpr int SH_RB = 576;
constexpr int NRB_ALL = SH_RB + 64;
constexpr float EPS = 1e-6f;
constexpr int NTHR = 512, NWAVES = 8;
constexpr int LDS_BYTES = 163840;
constexpr int AUX_OFF = 131072;
constexpr int BAR_OFF = LDS_BYTES - 16;

constexpr size_t MiB = 1u << 20;
constexpr size_t WS_CTL = 0, CTL_BYTES = 65536;
constexpr size_t CTL_CNT = 16384;
constexpr size_t CTL_GRP = 20480;
constexpr size_t WS_MOD = 65536;
constexpr size_t WS_COS = 1 * MiB, WS_SIN = 3 * MiB;
constexpr size_t WS_IDX = 5 * MiB, WS_GW = 5 * MiB + 512 * 1024, WS_ASLOT = 6 * MiB, WS_LTOK = 6 * MiB + 512 * 1024;
constexpr size_t WS_SMALL = 11 * MiB;
constexpr size_t WS_WIN = 16 * MiB, WS_WOUT = 30 * MiB, WS_WQKV = 34 * MiB, WS_WO = 40 * MiB;
constexpr size_t WS_H = 44 * MiB;
constexpr size_t WS_QKVPRE = 78 * MiB, WS_XBCPRE = 174 * MiB, WS_ZA = 222 * MiB, WS_ZB = 254 * MiB;
constexpr size_t WS_CC = 16 * MiB, WS_ACUM = 25 * MiB, WS_CDEC = 26 * MiB, WS_YDIAG = 44 * MiB, WS_STATES = 430 * MiB;
constexpr size_t WS_GI = 286 * MiB, GI_UNIT = 73728, WS_GTMP = 462 * MiB, WS_GLAST = 27 * MiB;
constexpr size_t WS_OY = 78 * MiB, WS_YMIX = 286 * MiB, WS_XB = 240 * MiB;
constexpr size_t WS_WD = 478 * MiB, WS_WDS = 510 * MiB + 512 * 1024, WS_HID = 398 * MiB, WS_Y = 78 * MiB, WS_WGU = 142 * MiB, WS_WGUS = 207 * MiB;
constexpr size_t WS_Q1KV = 78 * MiB, WS_O1 = 174 * MiB, WS_PO = 350 * MiB, WS_PLSE = 446 * MiB;
constexpr size_t WS_END = 512 * MiB;

struct Args {
    const float* x; const float* c; const int* pos; const float* mod_w; const float* mod_b;
    const float* mix_pre_g; const float* mix_post_g; const float* ffn_pre_g; const float* ffn_post_g;
    const float* ssm_w_in; const float* gdn_conv_w; const float* gdn_a_log; const float* gdn_dt_bias; const float* gdn_norm_w;
    const float* ssd_conv_w; const float* ssd_conv_b; const float* ssd_a_log; const float* ssd_dt_bias; const float* ssd_d; const float* ssd_norm_w;
    const float* ssm_w_out; const float* attn_w_qkv; const float* attn_w_o;
    const float* router_w; const float* router_bias; const float* exp_gate; const float* exp_up; const float* exp_down;
    const float* sh_gate; const float* sh_up; const float* sh_down;
    float* out; unsigned char* ws; int ph_lo, ph_hi;
};

DEV float bf2f(bf16_t v) { return __uint_as_float(((unsigned)v) << 16); }
DEV unsigned f2bf(float f) { unsigned u = __float_as_uint(f); return (u + 0x7FFFu + ((u >> 16) & 1u)) >> 16; }
DEV unsigned pk2(float lo, float hi) { return f2bf(lo) | (f2bf(hi) << 16); }
DEV float wave_sum(float v) {
#pragma unroll
    for (int o = 32; o > 0; o >>= 1) v += __shfl_xor(v, o);
    return v;
}
DEV float siluf(float x) { return x / (1.f + __expf(-x)); }
DEV float sigmoidf_(float x) { return 1.f / (1.f + __expf(-x)); }
DEV float softplusf(float x) { return fmaxf(x, 0.f) + log1pf(__expf(-fabsf(x))); }
#define LDS_WAIT() asm volatile("s_waitcnt lgkmcnt(0)" ::: "memory")
#define VM_WAIT() asm volatile("s_waitcnt vmcnt(0)" ::: "memory")

#define XB_TMO      128
#define XB_XCNT(j)  (256  + 64 * (j))
#define XB_XSUB(j)  (1280 + 64 * (j))
#define XB_XGEN(j)  (2304 + 64 * (j))
#define XB_TOP      3328
#define XB_TOPGEN   3392
#define XCD_BAR_WORDS 3456
#define XB_SPIN_CAP (1u << 18)
#define LAS __attribute__((address_space(3)))

__device__ __forceinline__ unsigned xb_ld(unsigned* p)              { return __hip_atomic_load(p, __ATOMIC_RELAXED, __HIP_MEMORY_SCOPE_AGENT); }
__device__ __forceinline__ unsigned xb_add(unsigned* p, unsigned v) { return __hip_atomic_fetch_add(p, v, __ATOMIC_RELAXED, __HIP_MEMORY_SCOPE_AGENT); }
__device__ __forceinline__ unsigned xb_xcc_id() { return (unsigned)__builtin_amdgcn_s_getreg((3 << 11) | 20) & 0xFu; }
#define XB_SPIN(cond, bar) do { unsigned _sp = 0; while (cond) { __builtin_amdgcn_s_sleep(1); \
    if ((++_sp & 255u) == 0u) { if (xb_ld(&(bar)[XB_TMO])) break; if (_sp > XB_SPIN_CAP) { atomicAdd(&(bar)[XB_TMO], 1u); break; } } } } while (0)

struct XcdBarrier {
    unsigned* bar; unsigned x;
    volatile LAS unsigned* st;
};

__device__ __forceinline__ XcdBarrier xcd_barrier_post(unsigned* bar, volatile LAS unsigned* st) {
    XcdBarrier b; b.bar = bar; b.x = xb_xcc_id(); b.st = st;
    if (threadIdx.x == 0) (void)xb_add(&bar[XB_XCNT(b.x)], 1u);
    return b;
}
__device__ __forceinline__ void xcd_barrier_complete(unsigned* bar, unsigned x, unsigned& nloc, unsigned& nx) {
    const unsigned G = gridDim.x * gridDim.y * gridDim.z;
    unsigned sum, cnt, mine, sp = 0u;
    for (;;) {
        sum = 0u; cnt = 0u; mine = 0u;
#pragma unroll
        for (unsigned j = 0; j < 16; ++j) { const unsigned c = xb_ld(&bar[XB_XCNT(j)]); sum += c; cnt += (c > 0u) ? 1u : 0u; mine = (j == x) ? c : mine; }
        if (sum == G) break;
        __builtin_amdgcn_s_sleep(1);
        if ((++sp & 255u) == 0u) { if (xb_ld(&bar[XB_TMO])) break; if (sp > XB_SPIN_CAP) { atomicAdd(&bar[XB_TMO], 1u); break; } }
    }
    nloc = mine > 0u ? mine : 1u; nx = cnt > 0u ? cnt : 1u;
}

__device__ __forceinline__ void xcd_barrier(const XcdBarrier& b) {
    asm volatile("s_waitcnt vmcnt(0)" ::: "memory");
    __syncthreads();
    if (threadIdx.x == 0) {
        unsigned* bar = b.bar;
        __builtin_amdgcn_s_waitcnt(0);
        unsigned nloc = b.st[0], nx = b.st[1];
        if (nloc == 0u) { xcd_barrier_complete(bar, b.x, nloc, nx); b.st[0] = nloc; b.st[1] = nx; }
        const unsigned old = xb_add(&bar[XB_XSUB(b.x)], 1u);
        const unsigned gen = old / nloc;
        if (old + 1u == (gen + 1u) * nloc) {
            __builtin_amdgcn_fence(__ATOMIC_RELEASE, "agent");
            asm volatile("s_waitcnt vmcnt(0)" ::: "memory");
            const unsigned og = xb_add(&bar[XB_TOP], 1u);
            const unsigned tg = og / nx;
            if (og + 1u == (tg + 1u) * nx) xb_add(&bar[XB_TOPGEN], 1u);
            else XB_SPIN(xb_ld(&bar[XB_TOPGEN]) == tg, bar);
            __builtin_amdgcn_fence(__ATOMIC_ACQUIRE, "agent");
            xb_add(&bar[XB_XGEN(b.x)], 1u);
            asm volatile("s_waitcnt vmcnt(0)" ::: "memory");
        } else {
            XB_SPIN(xb_ld(&bar[XB_XGEN(b.x)]) == gen, bar);
            __builtin_amdgcn_fence(__ATOMIC_ACQUIRE, "agent");
            asm volatile("s_waitcnt vmcnt(0)" ::: "memory");
        }
    }
    __syncthreads();
}


DEV void group_barrier(unsigned* ctr, const unsigned n) {
    asm volatile("s_waitcnt vmcnt(0)" ::: "memory");
    __syncthreads();
    if (threadIdx.x == 0) {
        __builtin_amdgcn_fence(__ATOMIC_RELEASE, "agent");
        asm volatile("s_waitcnt vmcnt(0)" ::: "memory");
        (void)__hip_atomic_fetch_add(ctr, 1u, __ATOMIC_RELAXED, __HIP_MEMORY_SCOPE_AGENT);
        unsigned sp = 0;
        while (__hip_atomic_load(ctr, __ATOMIC_RELAXED, __HIP_MEMORY_SCOPE_AGENT) < n) { __builtin_amdgcn_s_sleep(2); if (++sp > (1u << 22)) break; }
        __builtin_amdgcn_fence(__ATOMIC_ACQUIRE, "agent");
        asm volatile("s_waitcnt vmcnt(0)" ::: "memory");
    }
    __syncthreads();
}

namespace pg8 {
constexpr int BM = 256, BK = 64, HALF = 128, HTB = HALF * BK * 2, STAGE_BYTES = 8 * HTB, NXCD = 8, WGM = 8;
DEV int lds_byte(int r, int c) { const int st = (r >> 4) * 2 + (c >> 5), rr = r & 15, cc = c & 31, ob = rr * 64 + cc * 2; return st * 1024 + (ob ^ (((ob >> 9) & 1) << 5)); }
DEV void stage_rc(int b, int& R, int& C) { const int st = b / 1024, sb = b % 1024, swz = sb ^ (((sb >> 9) & 1) << 5); R = (st >> 1) * 16 + swz / 64; C = (st & 1) * 32 + (swz % 64) / 2; }
DEV int perm32(int rho) { const int n = rho >> 4, i = rho & 15; return 8 * (i >> 2) + 4 * n + (i & 3); }
struct Unit { int pm, pn, e, slot; };
struct StaticOrder {
    int nM, nN, nwg, G, c;
    DEV void init(int M, int N, int G_, int c_) { nM = M / BM; nN = N / BM; nwg = nM * nN; G = G_; c = c_; }
    DEV bool next(int i, int& pm, int& pn) const {
        const long L = (long)i * G + c; if (L >= nwg) return false;
        int wgid = (int)L; { const int q = nwg / NXCD, r = nwg % NXCD, xcd = wgid % NXCD, off = wgid / NXCD; wgid = (xcd < r ? xcd * (q + 1) : r * (q + 1) + (xcd - r) * q) + off; }
        const int nig = WGM * nN, gid = wgid / nig, fm = gid * WGM, gsz = (nM - fm) < WGM ? (nM - fm) : WGM;
        pm = fm + ((wgid % nig) % gsz); pn = (wgid % nig) / gsz; return true;
    }
};
typedef __bf16 bf16x2_t __attribute__((ext_vector_type(2)));
DEV unsigned cvt_pk_bf16(float lo, float hi) { const bf16x2_t v = {(__bf16)lo, (__bf16)hi}; return __builtin_bit_cast(unsigned, v); }
DEV u32x4 pack8(const f32x4 a, const f32x4 b) { u32x4 w; w.x = cvt_pk_bf16(a[0], a[1]); w.y = cvt_pk_bf16(a[2], a[3]); w.z = cvt_pk_bf16(b[0], b[1]); w.w = cvt_pk_bf16(b[2], b[3]); return w; }

typedef int v8i_t __attribute__((ext_vector_type(8)));
template <class Epi, class Sched, bool F8 = false>
DEV void gemm_phase(LAS unsigned char* lds, const int K, const Sched& S, const Epi& E) {
    const int tid = threadIdx.x, wid = __builtin_amdgcn_readfirstlane(tid >> 6), lane = tid & 63, wr = wid >> 2, wc = wid & 3, fr = lane & 15, fq = lane >> 4;
    const int nt = F8 ? K / 128 : K / BK;
    const int pitch = F8 ? K : 2 * K;
    unsigned voffB[2];
#pragma unroll
    for (int i = 0; i < 2; ++i) { int R, C; stage_rc(tid * 16 + i * 8192, R, C); const int Rb = Epi::PERM ? ((R & ~31) + perm32(R & 31)) : R; voffB[i] = (unsigned)(Rb * pitch + 2 * C); }
    const unsigned kstep = (unsigned)(BK * 2);
    const size_t hstep = (size_t)HALF * pitch;
    const unsigned ldsw = (unsigned)wid * 1024u;
    const int aoff = lds_byte(wr * 64 + fr, fq * 8), boff = lds_byte(wc * 32 + fr, fq * 8);
    const size_t hsA = Sched::GATHER ? (size_t)0 : hstep;
#define PG8_SA(b, h) (((b) * 2 + (h)) * HTB)
#define PG8_SB(b, h) ((4 + (b) * 2 + (h)) * HTB)
#define PG8_STAGEB(bufoff, gbase) do { _Pragma("unroll") for (int _i = 0; _i < 2; ++_i) \
        __builtin_amdgcn_global_load_lds((const unsigned*)((const char*)(gbase) + voffB[_i]), (LAS unsigned*)(lds + (bufoff) + ldsw + _i * 8192), 16, 0, 0); } while (0)
#define PG8_STAGEA(bufoff, gbase, VO) do { _Pragma("unroll") for (int _i = 0; _i < 2; ++_i) \
        __builtin_amdgcn_global_load_lds((const unsigned*)((const char*)(gbase) + (VO)[_i]), (LAS unsigned*)(lds + (bufoff) + ldsw + _i * 8192), 16, 0, 0); } while (0)
#define PG8_LD8(var, base) do { const u32x4 _l0 = *(const LAS u32x4*)(lds + (base)), _l1 = *(const LAS u32x4*)(lds + (base) + 1024); var = __builtin_shufflevector(_l0, _l1, 0, 1, 2, 3, 4, 5, 6, 7); } while (0)
#define PG8_LDA(dst, b, h) do { if constexpr (F8) { PG8_LD8(dst##8_0, PG8_SA(b, h) + aoff); PG8_LD8(dst##8_1, PG8_SA(b, h) + aoff + 2048); PG8_LD8(dst##8_2, PG8_SA(b, h) + aoff + 4096); PG8_LD8(dst##8_3, PG8_SA(b, h) + aoff + 6144); } \
        else { _Pragma("unroll") for (int m = 0; m < 4; ++m) _Pragma("unroll") for (int k = 0; k < 2; ++k) dst[m][k] = *(const LAS bf16x8*)(lds + PG8_SA(b, h) + aoff + m * 2048 + k * 1024); } } while (0)
#define PG8_LDB(dst, b, h) do { if constexpr (F8) { PG8_LD8(dst##8_0, PG8_SB(b, h) + boff); PG8_LD8(dst##8_1, PG8_SB(b, h) + boff + 2048); } \
        else { _Pragma("unroll") for (int n = 0; n < 2; ++n) _Pragma("unroll") for (int k = 0; k < 2; ++k) dst[n][k] = *(const LAS bf16x8*)(lds + PG8_SB(b, h) + boff + n * 2048 + k * 1024); } } while (0)
#define PG8_M8(ai, bj, m, n, A8, B8) asm volatile("v_mfma_scale_f32_16x16x128_f8f6f4 %0, %1, %2, %0, %3, %4 op_sel_hi:[0,0,0]" : "+v"(acc[ai][bj][m][n]) : "v"(B8), "v"(A8), "v"(wsc_), "v"(asc_))
#define PG8_M8Z(ai, bj, m, n, A8, B8) asm volatile("v_mfma_scale_f32_16x16x128_f8f6f4 %0, %1, %2, %0, %3, %4 op_sel_hi:[0,0,0]" : "+v"(acc[ai][bj][m][n]) : "v"(B8), "v"(A8), "v"(zsc_), "v"(zsc_))
#define PG8_MMA(ai, bj, At, Bt) do { __builtin_amdgcn_s_setprio(1); \
        if constexpr (F8) { PG8_M8(ai, bj, 0, 0, At##8_0, Bt##8_0); PG8_M8(ai, bj, 0, 1, At##8_0, Bt##8_1); PG8_M8(ai, bj, 1, 0, At##8_1, Bt##8_0); PG8_M8(ai, bj, 1, 1, At##8_1, Bt##8_1); \
                            PG8_M8(ai, bj, 2, 0, At##8_2, Bt##8_0); PG8_M8(ai, bj, 2, 1, At##8_2, Bt##8_1); PG8_M8(ai, bj, 3, 0, At##8_3, Bt##8_0); PG8_M8(ai, bj, 3, 1, At##8_3, Bt##8_1); \
            if constexpr (((PROBE_MASK >> 26) & 1u) != 0u) { PG8_M8Z(ai, bj, 0, 0, At##8_0, Bt##8_0); PG8_M8Z(ai, bj, 0, 1, At##8_0, Bt##8_1); PG8_M8Z(ai, bj, 1, 0, At##8_1, Bt##8_0); PG8_M8Z(ai, bj, 1, 1, At##8_1, Bt##8_1); \
                            PG8_M8Z(ai, bj, 2, 0, At##8_2, Bt##8_0); PG8_M8Z(ai, bj, 2, 1, At##8_2, Bt##8_1); PG8_M8Z(ai, bj, 3, 0, At##8_3, Bt##8_0); PG8_M8Z(ai, bj, 3, 1, At##8_3, Bt##8_1); } } \
        else { _Pragma("unroll") for (int m = 0; m < 4; ++m) _Pragma("unroll") for (int n = 0; n < 2; ++n) _Pragma("unroll") for (int k = 0; k < 2; ++k) acc[ai][bj][m][n] = __builtin_amdgcn_mfma_f32_16x16x32_bf16(Bt[n][k], At[m][k], acc[ai][bj][m][n], 0, 0, 0); } \
        __builtin_amdgcn_s_setprio(0); } while (0)
#define PG8_WAIT_V(n) asm volatile("s_waitcnt vmcnt(" #n ")" ::: "memory")
#define PG8_WAIT_L(n) asm volatile("s_waitcnt lgkmcnt(" #n ")" ::: "memory")
#define PG8_BAR __builtin_amdgcn_s_barrier()
#define PG8_SCHED __builtin_amdgcn_sched_barrier(0)
    Unit cur, nxt; int ui = 0;
    if (!S.next(0, cur)) return;
    f32x4 acc[2][2][4][2];
#pragma unroll
    for (int a = 0; a < 2; ++a)
#pragma unroll
        for (int b = 0; b < 2; ++b)
#pragma unroll
            for (int m = 0; m < 4; ++m)
#pragma unroll
                for (int n = 0; n < 2; ++n) acc[a][b][m][n] = (f32x4){0.f, 0.f, 0.f, 0.f};
    bf16x8 At[4][2], B0[2][2], B1[2][2];
    typedef unsigned u32x8_t __attribute__((ext_vector_type(8)));
    u32x8_t At8_0, At8_1, At8_2, At8_3, B08_0, B08_1, B18_0, B18_1;
    int zsc_ = 0; asm volatile("" : "+v"(zsc_));
    const int wsc_ = Sched::WSCALE, asc_ = Sched::ASCALE;
    unsigned va[2][2];
    S.a_voff(cur, tid, va);
    const char* cA = S.a_ptr(cur);
    const char* cB = S.b_ptr(cur);
    PG8_STAGEB(PG8_SB(0, 0), cB); PG8_STAGEB(PG8_SB(0, 1), cB + hstep); PG8_STAGEA(PG8_SA(0, 0), cA, va[0]); PG8_STAGEA(PG8_SA(0, 1), cA + hsA, va[1]);
    if (wr == 1) PG8_BAR;
    PG8_WAIT_V(2); PG8_BAR;
    PG8_STAGEB(PG8_SB(1, 0), cB + kstep); PG8_STAGEA(PG8_SA(1, 0), cA + kstep, va[0]); PG8_STAGEB(PG8_SB(1, 1), cB + hstep + kstep);
    PG8_WAIT_V(6); PG8_BAR;
    for (;;) {
        const bool has_next = S.next(ui + 1, nxt);
        const char* nB = has_next ? S.b_ptr(nxt) : cB;
        const char* nA = has_next ? S.a_ptr(nxt) : cA;
        for (int t = 0; t < nt; t += 2) {
            const bool last = (t == nt - 2);
            const char* a1 = cA + (size_t)(t + 1) * kstep;
            const char* a2 = last ? nA : cA + (size_t)(t + 2) * kstep; const char* a3 = a2 + kstep;
            unsigned v2[2][2];
            v2[0][0] = va[0][0]; v2[0][1] = va[0][1]; v2[1][0] = va[1][0]; v2[1][1] = va[1][1];
            if constexpr (Sched::GATHER) { if (last && has_next) S.a_voff(nxt, tid, v2); }
            const char* b2 = last ? nB : cB + (size_t)(t + 2) * kstep; const char* b3 = b2 + kstep;
            PG8_LDB(B0, 0, 0); PG8_LDB(B1, 0, 1); PG8_SCHED; PG8_LDA(At, 0, 0); PG8_STAGEA(PG8_SA(1, 1), a1 + hsA, va[1]);
            PG8_WAIT_V(8); PG8_WAIT_L(0); PG8_BAR; PG8_MMA(0, 0, At, B0); PG8_MMA(0, 1, At, B1); PG8_BAR; PG8_SCHED;
            PG8_LDA(At, 0, 1); PG8_STAGEB(PG8_SB(0, 0), b2); PG8_STAGEB(PG8_SB(0, 1), b2 + hstep); PG8_STAGEA(PG8_SA(0, 0), a2, v2[0]);
            PG8_WAIT_V(8); PG8_WAIT_L(0); PG8_BAR; PG8_MMA(1, 0, At, B0); PG8_MMA(1, 1, At, B1); PG8_BAR; PG8_SCHED;
            PG8_LDB(B0, 1, 0); PG8_LDB(B1, 1, 1); PG8_SCHED; PG8_LDA(At, 1, 0); PG8_STAGEA(PG8_SA(0, 1), a2 + hsA, v2[1]);
            PG8_WAIT_V(8); PG8_WAIT_L(0); PG8_BAR; PG8_MMA(0, 0, At, B0); PG8_MMA(0, 1, At, B1); PG8_BAR; PG8_SCHED;
            PG8_LDA(At, 1, 1); PG8_STAGEB(PG8_SB(1, 0), b3); PG8_STAGEB(PG8_SB(1, 1), b3 + hstep); PG8_STAGEA(PG8_SA(1, 0), a3, v2[0]);
            PG8_WAIT_V(8); PG8_WAIT_L(0); PG8_BAR; PG8_MMA(1, 0, At, B0); PG8_MMA(1, 1, At, B1); PG8_BAR; PG8_SCHED;
        }
        if (wr == 0) PG8_BAR;
        if constexpr (F8) asm volatile("s_nop 15\n\ts_nop 15" ::: "memory");
        E(acc, cur, wr, wc, fr, fq);
        if (!has_next) break;
#pragma unroll
        for (int a = 0; a < 2; ++a)
#pragma unroll
            for (int b = 0; b < 2; ++b)
#pragma unroll
                for (int m = 0; m < 4; ++m)
#pragma unroll
                    for (int n = 0; n < 2; ++n) acc[a][b][m][n] = (f32x4){0.f, 0.f, 0.f, 0.f};
        cur = nxt; cB = nB; cA = nA; ++ui;
        if constexpr (Sched::GATHER) S.a_voff(cur, tid, va);
        if (wr == 1) PG8_BAR;
    }
    PG8_WAIT_V(0);
    PG8_BAR;
#undef PG8_SA
#undef PG8_SB
#undef PG8_STAGEA
#undef PG8_STAGEB
#undef PG8_LDA
#undef PG8_LD8
#undef PG8_M8
#undef PG8_LDB
#undef PG8_MMA
#undef PG8_WAIT_V
#undef PG8_WAIT_L
#undef PG8_BAR
#undef PG8_SCHED
}

struct SchedDense {
    static constexpr bool GATHER = false; static constexpr int WSCALE = 0x7F7F7F7F, ASCALE = 0x7F7F7F7F;
    StaticOrder so; const char* A; const char* Bt; int K; int pad_;
    DEV bool next(int i, Unit& u) const { int pm, pn; if (!so.next(i, pm, pn)) return false; u.pm = pm; u.pn = pn; u.e = 0; u.slot = 0; return true; }
    DEV const char* a_ptr(const Unit& u) const { return A + (size_t)u.pm * 256 * K * 2; }
    DEV void a_voff(const Unit&, const int tid, unsigned (&vo)[2][2]) const {
#pragma unroll
        for (int i = 0; i < 2; ++i) { int R, C; stage_rc(tid * 16 + i * 8192, R, C); vo[0][i] = vo[1][i] = (unsigned)((R * K + C) * 2); }
    }
    DEV const char* b_ptr(const Unit& u) const { return Bt + (size_t)u.pn * 256 * K * 2; }
};
template <int WS_, int AS_> struct SchedDense8 {
    static constexpr bool GATHER = false; static constexpr int WSCALE = WS_, ASCALE = AS_;
    StaticOrder so; const char* A; const char* Bt; int K; int pad_;
    DEV bool next(int i, Unit& u) const { int pm, pn; if (!so.next(i, pm, pn)) return false; u.pm = pm; u.pn = pn; u.e = 0; u.slot = 0; return true; }
    DEV const char* a_ptr(const Unit& u) const { return A + (size_t)u.pm * 256 * K; }
    DEV void a_voff(const Unit&, const int tid, unsigned (&vo)[2][2]) const {
#pragma unroll
        for (int i = 0; i < 2; ++i) { int R, C; stage_rc(tid * 16 + i * 8192, R, C); vo[0][i] = vo[1][i] = (unsigned)(R * K + 2 * C); }
    }
    DEV const char* b_ptr(const Unit& u) const { return Bt + (size_t)u.pn * 256 * K; }
};
DEV bool moe_unit(int i, int NJ, int nrbt, int G, int c, Unit& u) {
    const int n = (nrbt + 64) * NJ; int L;
    if (G & 7) { L = i * G + c; if (L >= n) return false; }
    else { const int gq = G >> 3, per = (n + 7) >> 3, x = c & 7, q = c >> 3, j = i * gq + q; if (j >= per) return false; L = x * per + j; if (L >= n) return false; }
    int grb = L / NJ; const int pn = L - grb * NJ; if (grb >= nrbt) grb = SH_RB + (grb - nrbt);
    u.pm = grb; u.pn = pn; u.slot = i; u.e = 0; return true;
}
struct SchedGU {
    static constexpr bool GATHER = true; static constexpr int WSCALE = 0x79797979, ASCALE = 0x7F7F7F7F;
    const char* A; const char* Wgu; const char* Wgus; const LAS int* eofrb; const LAS int* toks; int nrbt, G, c, pad_;
    DEV bool next(int i, Unit& u) const { if (!moe_unit(i, 2, nrbt, G, c, u)) return false; u.e = __builtin_amdgcn_readfirstlane(eofrb[u.pm]); return true; }
    DEV const char* a_ptr(const Unit&) const { return A; }
    DEV void a_voff(const Unit& u, const int tid, unsigned (&vo)[2][2]) const {
#pragma unroll
        for (int i = 0; i < 2; ++i) { int R, C; stage_rc(tid * 16 + i * 8192, R, C);
#pragma unroll
            for (int h = 0; h < 2; ++h) { const int tok = toks[u.slot * 256 + h * 128 + R]; vo[h][i] = (unsigned)(tok * D + 2 * C); } }
    }
    DEV const char* b_ptr(const Unit& u) const { return (u.e < NE ? Wgu + (size_t)u.e * 512 * D : Wgus) + (size_t)u.pn * 256 * D; }
};
struct SchedDown {
    static constexpr bool GATHER = false; static constexpr int WSCALE = 0x7A7A7A7A, ASCALE = 0x7F7F7F7F;
    const char* A; const char* Wd; const char* Wds; const LAS int* eofrb; int nrbt, G, c, pad_;
    DEV bool next(int i, Unit& u) const { if (!moe_unit(i, 4, nrbt, G, c, u)) return false; u.e = __builtin_amdgcn_readfirstlane(eofrb[u.pm]); return true; }
    DEV const char* a_ptr(const Unit& u) const { return A + (size_t)u.pm * 256 * ED; }
    DEV void a_voff(const Unit&, const int tid, unsigned (&vo)[2][2]) const {
#pragma unroll
        for (int i = 0; i < 2; ++i) { int R, C; stage_rc(tid * 16 + i * 8192, R, C); vo[0][i] = vo[1][i] = (unsigned)(R * ED + 2 * C); }
    }
    DEV const char* b_ptr(const Unit& u) const { return (u.e < NE ? Wd + (size_t)u.e * D * ED : Wds) + (size_t)u.pn * 256 * ED; }
};

struct EpiProj {
    static constexpr bool PERM = true;
    bf16_t* qkv; bf16_t* za; bf16_t* xbc; bf16_t* zb; float* small;
    DEV void operator()(const f32x4 (&acc)[2][2][4][2], const Unit& u, int wr, int wc, int fr, int fq) const {
        const int row0 = u.pm * BM + wr * 64 + fr, pn = u.pn;
        if (pn == 26) {
            if (wc == 0) {
#pragma unroll
                for (int ai = 0; ai < 2; ++ai)
#pragma unroll
                    for (int m = 0; m < 4; ++m) { float* p = small + (size_t)(row0 + ai * HALF + m * 16) * 32 + 8 * fq; *(f32x4*)p = acc[ai][0][m][0]; *(f32x4*)(p + 4) = acc[ai][0][m][1]; }
            }
            return;
        }
        bf16_t* base; int ldc, ct;
        if (pn < 12) { base = qkv; ldc = 3072; ct = pn; } else if (pn < 16) { base = za; ldc = 1024; ct = pn - 12; } else if (pn < 22) { base = xbc; ldc = 1536; ct = pn - 16; } else { base = zb; ldc = 1024; ct = pn - 22; }
        const int col0 = ct * 256 + wc * 32 + 8 * fq;
#pragma unroll
        for (int ai = 0; ai < 2; ++ai)
#pragma unroll
            for (int m = 0; m < 4; ++m) { bf16_t* rowp = base + (size_t)(row0 + ai * HALF + m * 16) * ldc + col0;
#pragma unroll
                for (int bj = 0; bj < 2; ++bj) *(u32x4*)(rowp + bj * HALF) = pack8(acc[ai][bj][m][0], acc[ai][bj][m][1]); }
    }
};
struct EpiF32 {
    static constexpr bool PERM = false;
    float* Cp; int ldc; int pad_;
    DEV void operator()(const f32x4 (&acc)[2][2][4][2], const Unit& u, int wr, int wc, int fr, int fq) const {
        const int row0 = u.pm * BM + wr * 64 + fr, col0 = u.pn * BM + wc * 32 + 4 * fq;
#pragma unroll
        for (int ai = 0; ai < 2; ++ai)
#pragma unroll
            for (int m = 0; m < 4; ++m) { float* rowp = Cp + (size_t)(row0 + ai * HALF + m * 16) * ldc + col0;
#pragma unroll
                for (int bj = 0; bj < 2; ++bj)
#pragma unroll
                    for (int n = 0; n < 2; ++n) *(f32x4*)(rowp + bj * HALF + n * 16) = acc[ai][bj][m][n]; }
    }
};
struct EpiBf16 {
    static constexpr bool PERM = true;
    bf16_t* O; int ldc; int pad_;
    DEV void operator()(const f32x4 (&acc)[2][2][4][2], const Unit& u, int wr, int wc, int fr, int fq) const {
        const int row0 = u.pm * BM + wr * 64 + fr, col0 = u.pn * BM + wc * 32 + 8 * fq;
#pragma unroll
        for (int ai = 0; ai < 2; ++ai)
#pragma unroll
            for (int m = 0; m < 4; ++m) { bf16_t* rowp = O + (size_t)(row0 + ai * HALF + m * 16) * ldc + col0;
#pragma unroll
                for (int bj = 0; bj < 2; ++bj) *(u32x4*)(rowp + bj * HALF) = pack8(acc[ai][bj][m][0], acc[ai][bj][m][1]); }
    }
};
DEV u32x2 pack8_fp8(const f32x4 a, const f32x4 b) {
    f32x4 x = a, y = b;
#pragma unroll
    for (int i = 0; i < 4; ++i) { x[i] = fminf(fmaxf(x[i], -440.f), 440.f); y[i] = fminf(fmaxf(y[i], -440.f), 440.f); }
    int w0 = __builtin_amdgcn_cvt_pk_fp8_f32(x[0], x[1], 0, false); w0 = __builtin_amdgcn_cvt_pk_fp8_f32(x[2], x[3], w0, true);
    int w1 = __builtin_amdgcn_cvt_pk_fp8_f32(y[0], y[1], 0, false); w1 = __builtin_amdgcn_cvt_pk_fp8_f32(y[2], y[3], w1, true);
    return (u32x2){(unsigned)w0, (unsigned)w1};
}
struct EpiFp8 {
    static constexpr bool PERM = true;
    unsigned char* O; int ldc; int pad_;
    DEV void operator()(const f32x4 (&acc)[2][2][4][2], const Unit& u, int wr, int wc, int fr, int fq) const {
        const int row0 = u.pm * BM + wr * 64 + fr, col0 = u.pn * BM + wc * 32 + 8 * fq;
#pragma unroll
        for (int ai = 0; ai < 2; ++ai)
#pragma unroll
            for (int m = 0; m < 4; ++m) { unsigned char* rowp = O + (size_t)(row0 + ai * HALF + m * 16) * ldc + col0;
#pragma unroll
                for (int bj = 0; bj < 2; ++bj) { f32x4 a0 = acc[ai][bj][m][0] * 8.f, a1 = acc[ai][bj][m][1] * 8.f;
#pragma unroll
                    for (int i = 0; i < 4; ++i) { a0[i] = fminf(fmaxf(a0[i], -440.f), 440.f); a1[i] = fminf(fmaxf(a1[i], -440.f), 440.f); }
                    int w0 = __builtin_amdgcn_cvt_pk_fp8_f32(a0[0], a0[1], 0, false); w0 = __builtin_amdgcn_cvt_pk_fp8_f32(a0[2], a0[3], w0, true);
                    int w1 = __builtin_amdgcn_cvt_pk_fp8_f32(a1[0], a1[1], 0, false); w1 = __builtin_amdgcn_cvt_pk_fp8_f32(a1[2], a1[3], w1, true);
                    *(u32x2*)(rowp + bj * HALF) = (u32x2){(unsigned)w0, (unsigned)w1}; } }
    }
};
struct EpiGU {
    static constexpr bool PERM = true;
    unsigned char* H;
    DEV void operator()(const f32x4 (&acc)[2][2][4][2], const Unit& u, int wr, int wc, int fr, int fq) const {
        const int row0 = u.pm * BM + wr * 64 + fr, col0 = u.pn * HALF + wc * 32 + 8 * fq;
#pragma unroll
        for (int ai = 0; ai < 2; ++ai)
#pragma unroll
            for (int m = 0; m < 4; ++m) {
                f32x4 h0, h1;
#pragma unroll
                for (int i = 0; i < 4; ++i) { h0[i] = siluf(acc[ai][0][m][0][i]) * acc[ai][1][m][0][i]; h1[i] = siluf(acc[ai][0][m][1][i]) * acc[ai][1][m][1][i]; }
                *(u32x2*)(H + (size_t)(row0 + ai * HALF + m * 16) * ED + col0) = pack8_fp8(h0, h1);
            }
    }
};
struct EpiQKV {
    static constexpr bool PERM = true;
    bf16_t* O; const float* cosT; const float* sinT;
    DEV void operator()(const f32x4 (&acc)[2][2][4][2], const Unit& u, int wr, int wc, int fr, int fq) const {
        const int row0 = u.pm * BM + wr * 64 + fr, col0 = u.pn * BM + wc * 32 + 8 * fq;
        const bool rope = u.pn < 8; const float qs = u.pn < 4 ? 0.125f : 1.f;
#pragma unroll
        for (int ai = 0; ai < 2; ++ai)
#pragma unroll
            for (int m = 0; m < 4; ++m) {
                const int row = row0 + ai * HALF + m * 16;
                bf16_t* rowp = O + (size_t)row * 3072 + col0;
                if (rope) {
                    const f32x4 cs = *(const f32x4*)(cosT + (size_t)row * 32 + 16 * (wc & 1) + 4 * fq), sn = *(const f32x4*)(sinT + (size_t)row * 32 + 16 * (wc & 1) + 4 * fq);
#pragma unroll
                    for (int bj = 0; bj < 2; ++bj) { const f32x4 x1 = acc[ai][bj][m][0], x2 = acc[ai][bj][m][1];
                        *(u32x4*)(rowp + bj * HALF) = pack8((x1 * cs - x2 * sn) * qs, (x2 * cs + x1 * sn) * qs); }
                } else {
#pragma unroll
                    for (int bj = 0; bj < 2; ++bj) *(u32x4*)(rowp + bj * HALF) = pack8(acc[ai][bj][m][0], acc[ai][bj][m][1]);
                }
            }
    }
};
}

template <class SrcF, bool OUT8 = false>
DEV void conv_item(const SrcF& src, int ldw, int K, void* dstv, LAS float* scr, int item, int nblk, int lane, const float wscale = 1.f) {
    const int kb = item / nblk, nb = item - kb * nblk, k0 = 64 * kb, n0 = 32 * nb;
    const int quad = lane & 7, r0 = lane >> 3;
    const float* colp = src(n0 + 4 * quad);
    f32x4 v[8];
#pragma unroll
    for (int i = 0; i < 8; ++i) v[i] = colp ? *(const f32x4*)(colp + (size_t)(k0 + r0 + 8 * i) * ldw) : (f32x4){0.f, 0.f, 0.f, 0.f};
#pragma unroll
    for (int i = 0; i < 8; ++i) { LAS float* p = scr + (r0 + 8 * i) * 33 + 4 * quad; p[0] = v[i][0]; p[1] = v[i][1]; p[2] = v[i][2]; p[3] = v[i][3]; }
    LDS_WAIT(); asm volatile("" ::: "memory");
    const int c = lane & 7;
#pragma unroll
    for (int j = 0; j < 4; ++j) { const int n = (lane >> 3) + 8 * j; const LAS float* s = scr + (8 * c) * 33 + n;
        if constexpr (OUT8) {
            int w0 = __builtin_amdgcn_cvt_pk_fp8_f32(s[0 * 33] * wscale, s[1 * 33] * wscale, 0, false); w0 = __builtin_amdgcn_cvt_pk_fp8_f32(s[2 * 33] * wscale, s[3 * 33] * wscale, w0, true);
            int w1 = __builtin_amdgcn_cvt_pk_fp8_f32(s[4 * 33] * wscale, s[5 * 33] * wscale, 0, false); w1 = __builtin_amdgcn_cvt_pk_fp8_f32(s[6 * 33] * wscale, s[7 * 33] * wscale, w1, true);
            *(u32x2*)((unsigned char*)dstv + (size_t)(n0 + n) * K + k0 + 8 * c) = (u32x2){(unsigned)w0, (unsigned)w1};
        } else {
            u32x4 o; o.x = pk2(s[0 * 33], s[1 * 33]); o.y = pk2(s[2 * 33], s[3 * 33]); o.z = pk2(s[4 * 33], s[5 * 33]); o.w = pk2(s[6 * 33], s[7 * 33]);
            *(u32x4*)((bf16_t*)dstv + (size_t)(n0 + n) * K + k0 + 8 * c) = o; } }
    LDS_WAIT(); asm volatile("" ::: "memory");
}
struct SrcIdent { const float* W; DEV const float* operator()(int n) const { return W + n; } };
struct SrcWin { const float* W; DEV const float* operator()(int n) const {
    int s; if (n < 4096) s = n; else if (n < 5632) s = C_XBC + (n - 4096); else if (n < 6656) s = C_ZB + (n - 5632); else if (n < 6672) s = C_BETA + (n - 6656); else if (n < 6688) s = C_DT + (n - 6672); else return nullptr;
    return W + s; } };
struct SrcQKV { const float* W; DEV const float* operator()(int n) const {
    if (n >= 2048) return W + n; const int hd = n >> 6, cp = n & 63; return W + hd * 64 + 32 * ((cp >> 2) & 1) + 16 * (cp >> 5) + 4 * ((cp >> 3) & 3) + (cp & 3); } };
struct SrcGU { const float* Wg; long du; DEV const float* operator()(int r) const { const int j = r >> 8, rr = r & 255; return Wg + (rr < 128 ? 0l : du) + 128 * j + (rr & 127); } };

DEV void load_row(const float* p, int lane, float (&v)[16]) {
#pragma unroll
    for (int j = 0; j < 4; ++j) { const f32x4 t = *(const f32x4*)(p + j * 256 + lane * 4); v[4 * j] = t[0]; v[4 * j + 1] = t[1]; v[4 * j + 2] = t[2]; v[4 * j + 3] = t[3]; }
}
DEV void store_row(float* p, int lane, const float (&v)[16]) {
#pragma unroll
    for (int j = 0; j < 4; ++j) *(f32x4*)(p + j * 256 + lane * 4) = (f32x4){v[4 * j], v[4 * j + 1], v[4 * j + 2], v[4 * j + 3]};
}
DEV float row_rstd(const float (&v)[16]) { float ss = 0.f;
#pragma unroll
    for (int i = 0; i < 16; ++i) ss += v[i] * v[i];
    return rsqrtf(wave_sum(ss) * (1.f / D) + EPS); }
DEV void resid_update(float (&xv)[16], const float (&yv)[16], const float* gpost, const float* gt, int lane) {
    const float r = row_rstd(yv);
#pragma unroll
    for (int j = 0; j < 4; ++j) { const f32x4 g = *(const f32x4*)(gpost + j * 256 + lane * 4), t = *(const f32x4*)(gt + j * 256 + lane * 4);
#pragma unroll
        for (int i = 0; i < 4; ++i) xv[4 * j + i] += t[i] * (yv[4 * j + i] * r * g[i]); }
}
DEV void prenorm_pack(const float (&xv)[16], const float* gpre, const float* sc, const float* sh, int lane, u32x2 (&o)[4]) {
    const float r = row_rstd(xv);
#pragma unroll
    for (int j = 0; j < 4; ++j) { const f32x4 g = *(const f32x4*)(gpre + j * 256 + lane * 4), s = *(const f32x4*)(sc + j * 256 + lane * 4), b = *(const f32x4*)(sh + j * 256 + lane * 4);
        float h[4];
#pragma unroll
        for (int i = 0; i < 4; ++i) h[i] = xv[4 * j + i] * r * g[i] * (1.f + s[i]) + b[i];
        o[j] = (u32x2){pk2(h[0], h[1]), pk2(h[2], h[3])}; }
}

DEV void load_row8(const float* p, int lane, float (&v)[16]) {
#pragma unroll
    for (int j = 0; j < 2; ++j)
#pragma unroll
        for (int hh = 0; hh < 2; ++hh) { const f32x4 t = *(const f32x4*)(p + 512 * j + 8 * lane + 4 * hh); v[8 * j + 4 * hh] = t[0]; v[8 * j + 4 * hh + 1] = t[1]; v[8 * j + 4 * hh + 2] = t[2]; v[8 * j + 4 * hh + 3] = t[3]; }
}
DEV void store_row8(float* p, int lane, const float (&v)[16]) {
#pragma unroll
    for (int j = 0; j < 2; ++j)
#pragma unroll
        for (int hh = 0; hh < 2; ++hh) *(f32x4*)(p + 512 * j + 8 * lane + 4 * hh) = (f32x4){v[8 * j + 4 * hh], v[8 * j + 4 * hh + 1], v[8 * j + 4 * hh + 2], v[8 * j + 4 * hh + 3]};
}
DEV void resid_update8(float (&xv)[16], const float (&yv)[16], const float* gpost, const float* gt, int lane) {
    const float r = row_rstd(yv);
#pragma unroll
    for (int j = 0; j < 2; ++j)
#pragma unroll
        for (int hh = 0; hh < 2; ++hh) { const f32x4 g = *(const f32x4*)(gpost + 512 * j + 8 * lane + 4 * hh), t = *(const f32x4*)(gt + 512 * j + 8 * lane + 4 * hh);
#pragma unroll
            for (int i = 0; i < 4; ++i) xv[8 * j + 4 * hh + i] += t[i] * (yv[8 * j + 4 * hh + i] * r * g[i]); }
}
DEV void prenorm_pack8(const float (&xv)[16], const float* gpre, const float* sc, const float* sh, int lane, u32x4 (&o)[2]) {
    const float r = row_rstd(xv);
#pragma unroll
    for (int j = 0; j < 2; ++j) { float h[8];
#pragma unroll
        for (int hh = 0; hh < 2; ++hh) { const f32x4 g = *(const f32x4*)(gpre + 512 * j + 8 * lane + 4 * hh), s = *(const f32x4*)(sc + 512 * j + 8 * lane + 4 * hh), b = *(const f32x4*)(sh + 512 * j + 8 * lane + 4 * hh);
#pragma unroll
            for (int i = 0; i < 4; ++i) h[4 * hh + i] = xv[8 * j + 4 * hh + i] * r * g[i] * (1.f + s[i]) + b[i]; }
        o[j] = (u32x4){pk2(h[0], h[1]), pk2(h[2], h[3]), pk2(h[4], h[5]), pk2(h[6], h[7])}; }
}
DEV void prenorm_pack8_f8(const float (&xv)[16], const float* gpre, const float* sc, const float* sh, int lane, u32x2 (&o)[2]) {
    const float r = row_rstd(xv);
#pragma unroll
    for (int j = 0; j < 2; ++j) { float h[8];
#pragma unroll
        for (int hh = 0; hh < 2; ++hh) { const f32x4 g = *(const f32x4*)(gpre + 512 * j + 8 * lane + 4 * hh), s = *(const f32x4*)(sc + 512 * j + 8 * lane + 4 * hh), b = *(const f32x4*)(sh + 512 * j + 8 * lane + 4 * hh);
#pragma unroll
            for (int i = 0; i < 4; ++i) h[4 * hh + i] = fminf(fmaxf(xv[8 * j + 4 * hh + i] * r * g[i] * (1.f + s[i]) + b[i], -440.f), 440.f); }
        int w0 = __builtin_amdgcn_cvt_pk_fp8_f32(h[0], h[1], 0, false); w0 = __builtin_amdgcn_cvt_pk_fp8_f32(h[2], h[3], w0, true);
        int w1 = __builtin_amdgcn_cvt_pk_fp8_f32(h[4], h[5], 0, false); w1 = __builtin_amdgcn_cvt_pk_fp8_f32(h[6], h[7], w1, true);
        o[j] = (u32x2){(unsigned)w0, (unsigned)w1}; }
}
DEV void acc_row8(float (&yv)[16], const u32x2 w0, const u32x2 w1, const float g) {
#pragma unroll
    for (int e = 0; e < 2; ++e) {
        yv[4 * e] += g * __builtin_amdgcn_cvt_f32_fp8((int)w0[e], 0); yv[4 * e + 1] += g * __builtin_amdgcn_cvt_f32_fp8((int)w0[e], 1); yv[4 * e + 2] += g * __builtin_amdgcn_cvt_f32_fp8((int)w0[e], 2); yv[4 * e + 3] += g * __builtin_amdgcn_cvt_f32_fp8((int)w0[e], 3);
        yv[8 + 4 * e] += g * __builtin_amdgcn_cvt_f32_fp8((int)w1[e], 0); yv[8 + 4 * e + 1] += g * __builtin_amdgcn_cvt_f32_fp8((int)w1[e], 1); yv[8 + 4 * e + 2] += g * __builtin_amdgcn_cvt_f32_fp8((int)w1[e], 2); yv[8 + 4 * e + 3] += g * __builtin_amdgcn_cvt_f32_fp8((int)w1[e], 3); }
}

DEV void load_row_bf(const bf16_t* p, int lane, float (&v)[16]) {
#pragma unroll
    for (int j = 0; j < 4; ++j) { const u32x2 w = *(const u32x2*)(p + j * 256 + lane * 4); v[4 * j] = __uint_as_float(w.x << 16); v[4 * j + 1] = __uint_as_float(w.x & 0xFFFF0000u); v[4 * j + 2] = __uint_as_float(w.y << 16); v[4 * j + 3] = __uint_as_float(w.y & 0xFFFF0000u); }
}
DEV void store_row_bf(bf16_t* p, int lane, const float (&v)[16]) {
#pragma unroll
    for (int j = 0; j < 4; ++j) *(u32x2*)(p + j * 256 + lane * 4) = (u32x2){pk2(v[4 * j], v[4 * j + 1]), pk2(v[4 * j + 2], v[4 * j + 3])};
}
DEV void load_row8_bf(const bf16_t* p, int lane, float (&v)[16]) {
#pragma unroll
    for (int j = 0; j < 2; ++j) { const u32x4 w = *(const u32x4*)(p + 512 * j + 8 * lane);
#pragma unroll
        for (int e = 0; e < 4; ++e) { v[8 * j + 2 * e] = __uint_as_float(w[e] << 16); v[8 * j + 2 * e + 1] = __uint_as_float(w[e] & 0xFFFF0000u); } }
}
DEV void store_row8_bf(bf16_t* p, int lane, const float (&v)[16]) {
#pragma unroll
    for (int j = 0; j < 2; ++j) *(u32x4*)(p + 512 * j + 8 * lane) = (u32x4){pk2(v[8 * j], v[8 * j + 1]), pk2(v[8 * j + 2], v[8 * j + 3]), pk2(v[8 * j + 4], v[8 * j + 5]), pk2(v[8 * j + 6], v[8 * j + 7])};
}

struct Ctx { LAS unsigned char* lds; int tid, lane, wave, G, bid; };

DEV void ph_setup(const Args& a, const Ctx& X) {
    unsigned char* ws = a.ws;
    float* mod = (float*)(ws + WS_MOD);
    { LAS float* red = (LAS float*)X.lds;
      LAS float* sc = (LAS float*)(X.lds + 8192);
      for (int i = X.tid; i < NB * D; i += NTHR) sc[i] = siluf(a.c[i]);
      __syncthreads();
      const int kc = X.tid >> 6, cl = X.tid & 63;
      for (int task = X.bid; task < 2 * 96; task += X.G) {
          const int l = task / 96, col = (task % 96) * 64 + cl;
          const float* w = a.mod_w + (size_t)l * D * 6 * D + col;
          float p0 = 0.f, p1 = 0.f, p2 = 0.f, p3 = 0.f;
#pragma unroll 16
          for (int k = kc * 128; k < kc * 128 + 128; ++k) { const float wv = w[(size_t)k * 6 * D];
              p0 += sc[k] * wv; p1 += sc[D + k] * wv; p2 += sc[2 * D + k] * wv; p3 += sc[3 * D + k] * wv; }
          __syncthreads();
          red[(kc * 4 + 0) * 64 + cl] = p0; red[(kc * 4 + 1) * 64 + cl] = p1; red[(kc * 4 + 2) * 64 + cl] = p2; red[(kc * 4 + 3) * 64 + cl] = p3;
          __syncthreads();
          if (X.tid < 256) { const int b = X.tid >> 6; float s = a.mod_b[l * 6 * D + col];
#pragma unroll
              for (int q = 0; q < 8; ++q) s += red[(q * 4 + b) * 64 + cl];
              mod[(size_t)(l * NB + b) * 6 * D + col] = s; }
      }
      __syncthreads(); }
    { LAS float* scr = (LAS float*)(X.lds + X.wave * 8704);
      const int gw = X.bid * NWAVES + X.wave, NGW = X.G * NWAVES;
      constexpr int I_IN = (D / 64) * (NPROJ / 32);
      for (int it = gw; it < I_IN; it += NGW) conv_item<SrcWin, true>(SrcWin{a.ssm_w_in}, PROJ, D, ws + WS_WIN, scr, it, NPROJ / 32, X.lane, 64.f);
    }
}
DEV void ph_setup_late(const Args& a, const Ctx& X, const int widx, const int nwg) {
    unsigned char* ws = a.ws;
    { float* cosT = (float*)(ws + WS_COS); float* sinT = (float*)(ws + WS_SIN);
      for (int idx = widx * NTHR + X.tid; idx < T * 32; idx += nwg * NTHR) { const int t = idx >> 5, i = idx & 31;
          const float ang = (float)a.pos[t] * powf(10000.f, -(float)i / 32.f); float sn, cs; sincosf(ang, &sn, &cs); cosT[idx] = cs; sinT[idx] = sn; } }
    { LAS float* scr = (LAS float*)(X.lds + X.wave * 8704);
      const int gw = widx * NWAVES + X.wave, NGW = nwg * NWAVES;
      constexpr int I_OUT = (2048 / 64) * (D / 32), I_QKV = (D / 64) * (3072 / 32), I_O = (D / 64) * (D / 32);
      for (int it = gw; it < I_OUT + I_QKV + I_O; it += NGW) {
          int r = it;
          if (r < I_OUT) { conv_item(SrcIdent{a.ssm_w_out}, D, 2048, (bf16_t*)(ws + WS_WOUT), scr, r, D / 32, X.lane); continue; } r -= I_OUT;
          if (r < I_QKV) { conv_item<SrcQKV, true>(SrcQKV{a.attn_w_qkv}, 3072, D, ws + WS_WQKV, scr, r, 3072 / 32, X.lane, 64.f); continue; } r -= I_QKV;
          conv_item<SrcIdent, true>(SrcIdent{a.attn_w_o}, D, D, ws + WS_WO, scr, r, D / 32, X.lane, 64.f);
      } }
}

DEV void ph_prenorm0(const Args& a, const Ctx& X) {
    const float* mod = (const float*)(a.ws + WS_MOD);
    unsigned char* h8 = a.ws + WS_H;
    for (int row = X.bid * NWAVES + X.wave; row < T; row += X.G * NWAVES) {
        const int b = row / SEQ; const float* ml = mod + (size_t)b * 6 * D;
        float xv[16]; load_row(a.x + (size_t)row * D, X.lane, xv);
        u32x2 o[4]; prenorm_pack(xv, a.mix_pre_g, ml + D, ml, X.lane, o);
#pragma unroll
        for (int j = 0; j < 4; ++j) { const float f0 = __uint_as_float(o[j].x << 16), f1 = __uint_as_float(o[j].x & 0xFFFF0000u), f2 = __uint_as_float(o[j].y << 16), f3 = __uint_as_float(o[j].y & 0xFFFF0000u);
            int wv = __builtin_amdgcn_cvt_pk_fp8_f32(fminf(fmaxf(f0, -440.f), 440.f), fminf(fmaxf(f1, -440.f), 440.f), 0, false); wv = __builtin_amdgcn_cvt_pk_fp8_f32(fminf(fmaxf(f2, -440.f), 440.f), fminf(fmaxf(f3, -440.f), 440.f), wv, true);
            *(unsigned*)(h8 + (size_t)row * D + j * 256 + X.lane * 4) = (unsigned)wv; }
    }
}

DEV bf16x8 acc_to_frag(const f32x4 lo, const f32x4 hi) { u32x4 w; w.x = pg8::cvt_pk_bf16(lo[0], lo[1]); w.y = pg8::cvt_pk_bf16(lo[2], lo[3]); w.z = pg8::cvt_pk_bf16(hi[0], hi[1]); w.w = pg8::cvt_pk_bf16(hi[2], hi[3]); return __builtin_bit_cast(bf16x8, w); }

DEV void gdn_solve(LAS float* M, LAS unsigned short* tf, const int lane) {
    for (int rb = 0; rb < 16; ++rb) {
        const int i0 = 4 * rb;
        float a0 = (lane == i0) ? 1.f : 0.f, a1 = (lane == i0 + 1) ? 1.f : 0.f, a2 = (lane == i0 + 2) ? 1.f : 0.f, a3 = (lane == i0 + 3) ? 1.f : 0.f;
        for (int j = 0; j < i0; j += 4) {
            const float t0 = M[j * 64 + lane], t1 = M[(j + 1) * 64 + lane], t2 = M[(j + 2) * 64 + lane], t3 = M[(j + 3) * 64 + lane];
            const f32x4 r0 = *(const LAS f32x4*)(M + i0 * 64 + j), r1 = *(const LAS f32x4*)(M + (i0 + 1) * 64 + j), r2 = *(const LAS f32x4*)(M + (i0 + 2) * 64 + j), r3 = *(const LAS f32x4*)(M + (i0 + 3) * 64 + j);
            a0 -= r0[0] * t0 + r0[1] * t1 + r0[2] * t2 + r0[3] * t3; a1 -= r1[0] * t0 + r1[1] * t1 + r1[2] * t2 + r1[3] * t3;
            a2 -= r2[0] * t0 + r2[1] * t1 + r2[2] * t2 + r2[3] * t3; a3 -= r3[0] * t0 + r3[1] * t1 + r3[2] * t2 + r3[3] * t3;
        }
        const f32x4 d1 = *(const LAS f32x4*)(M + (i0 + 1) * 64 + i0), d2 = *(const LAS f32x4*)(M + (i0 + 2) * 64 + i0), d3 = *(const LAS f32x4*)(M + (i0 + 3) * 64 + i0);
        a1 -= d1[0] * a0; a2 -= d2[0] * a0 + d2[1] * a1; a3 -= d3[0] * a0 + d3[1] * a1 + d3[2] * a2;
        M[i0 * 64 + lane] = a0; M[(i0 + 1) * 64 + lane] = a1; M[(i0 + 2) * 64 + lane] = a2; M[(i0 + 3) * 64 + lane] = a3;
    }
    const int cq = (lane >> 2) & 3, ca = (lane >> 4) & 1, ce = lane & 3, cks = lane >> 5;
    for (int i = 0; i < 64; ++i) tf[((i >> 4) * 2 + cks) * 512 + ((i & 15) + 16 * cq) * 8 + 4 * ca + ce] = (unsigned short)f2bf(M[i * 64 + lane]);
}
DEV void ph_gdn_local(const Args& a, const Ctx& X) {
    const bf16_t* qkvpre = (const bf16_t*)(a.ws + WS_QKVPRE); const float* small = (const float*)(a.ws + WS_SMALL);
    unsigned char* gi = a.ws + WS_GI; float* glast = (float*)(a.ws + WS_GLAST);
    constexpr int KP = 272;
    LAS unsigned char* kN = X.lds; LAS unsigned char* qN = X.lds + 64 * KP; LAS unsigned char* slots = X.lds + 128 * KP;
    LAS float* gcL = (LAS float*)(X.lds + 143360); LAS float* btL = gcL + 8 * 64;
    LAS unsigned char* stg = X.lds + 100352;
    const int lane = X.lane, wave = X.wave, r16 = lane & 15, q4 = lane >> 4;
    const float scale = 0.08838834764831845f;
    for (int wu = X.bid; wu < NB * 64; wu += X.G) {
        const int b = wu >> 6, n = wu & 63; const size_t t0 = (size_t)b * SEQ + 64 * n;
        unsigned char* tmp = a.ws + WS_GTMP + (size_t)X.bid * 131072;
        __syncthreads();
        {
            const float g = -__expf(a.gdn_a_log[wave]) * softplusf(small[(t0 + lane) * 32 + 8 + wave] + a.gdn_dt_bias[wave]);
            float gc = g;
#pragma unroll
            for (int o = 1; o < 64; o <<= 1) { const float v = __shfl_up(gc, o); if (lane >= o) gc += v; }
            gcL[wave * 64 + lane] = gc; btL[wave * 64 + lane] = sigmoidf_(small[(t0 + lane) * 32 + wave]);
            if (lane == 63) glast[(size_t)((b * 8 + wave) * 64 + n) * 32] = gc;
        }
        __syncthreads();
        unsigned xr[3][11];
#define GDN_LOADX(hh) do { _Pragma("unroll") for (int _p = 0; _p < 3; ++_p) _Pragma("unroll") for (int _i = 0; _i < 11; ++_i) { const int _tk = 8 * wave + _i - 3; unsigned _v = 0u; \
            if (64 * n + _tk >= 0) _v = *(const unsigned*)(qkvpre + (t0 + _tk) * 3072 + _p * 1024 + (hh) * 128 + 2 * lane); xr[_p][_i] = _v; } } while (0)
        GDN_LOADX(0);
        for (int bb = 0; bb < 2; ++bb) {
            for (int j = 0; j < 4; ++j) {
                const int h = bb * 4 + j; unsigned char* ub = gi + (size_t)((b * 8 + h) * 64 + n) * GI_UNIT;
                {
                    const float gl = gcL[h * 64 + 63];
                    const int blk = wave >> 2, pa = (wave & 3) >> 1, pq0 = 2 * (wave & 1);
                    const int ca = (2 * lane >> 4) & 1, cq = (2 * lane >> 2) & 3, ce = (2 * lane) & 3, cks = (2 * lane) >> 5;
#pragma unroll
                    for (int part = 0; part < 3; ++part) {
                        const int col = part * 1024 + h * 128 + 2 * lane;
                        float w0[4], w1[4];
#pragma unroll
                        for (int i = 0; i < 4; ++i) { const f32x2 t = *(const f32x2*)(a.gdn_conv_w + i * 3072 + col); w0[i] = t.x; w1[i] = t.y; }
                        float x0[11], x1[11];
#pragma unroll
                        for (int i = 0; i < 11; ++i) { const unsigned v = xr[part][i]; x0[i] = __uint_as_float(v << 16); x1[i] = __uint_as_float(v & 0xFFFF0000u); }
                        float v0[8], v1[8];
#pragma unroll
                        for (int i = 0; i < 8; ++i) { v0[i] = siluf(w0[0] * x0[i] + w0[1] * x0[i + 1] + w0[2] * x0[i + 2] + w0[3] * x0[i + 3]); v1[i] = siluf(w1[0] * x1[i] + w1[1] * x1[i + 1] + w1[2] * x1[i + 2] + w1[3] * x1[i + 3]); }
                        if (part < 2) {
#pragma unroll
                            for (int i = 0; i < 8; ++i) { const float r = rsqrtf(wave_sum(v0[i] * v0[i] + v1[i] * v1[i]) + 1e-6f); v0[i] *= r; v1[i] *= r; }
                        }
                        for (int rep_ = 0; rep_ < (((PROBE_MASK >> 21) & 1u) ? 2 : 1); ++rep_) {
                        if (part == 0) {
#pragma unroll
                            for (int i = 0; i < 8; ++i) { const int tok = 8 * wave + i; const float eg = __expf(gcL[h * 64 + tok]) * scale;
                                *(LAS unsigned*)(qN + tok * KP + lane * 4) = pk2(v0[i], v1[i]);
                                *(LAS unsigned*)(stg + ((tok >> 4) * 4 + cks) * 1024 + ((tok & 15) + 16 * cq) * 16 + (4 * ca + ce) * 2) = pk2(v0[i] * eg, v1[i] * eg); }
                        } else if (part == 1) {
                            unsigned short kg0[8], kg1[8], ke0[8], ke1[8];
#pragma unroll
                            for (int i = 0; i < 8; ++i) { const int tok = 8 * wave + i; const float gc = gcL[h * 64 + tok], bt = btL[h * 64 + tok], eg = __expf(gc) * bt, eend = __expf(gl - gc);
                                *(LAS unsigned*)(kN + tok * KP + lane * 4) = pk2(v0[i], v1[i]);
                                kg0[i] = (unsigned short)f2bf(v0[i] * eg); kg1[i] = (unsigned short)f2bf(v1[i] * eg); ke0[i] = (unsigned short)f2bf(v0[i] * eend); ke1[i] = (unsigned short)f2bf(v1[i] * eend); }
#pragma unroll
                            for (int hf = 0; hf < 2; ++hf) { const int pos = 32 * blk + 8 * (pq0 + hf) + 4 * pa; const int cl = 2 * lane;
                                *(u32x2*)(tmp + (size_t)j * 32768 + 16384 + cl * 128 + pos * 2) = (u32x2){(unsigned)kg0[4 * hf] | ((unsigned)kg0[4 * hf + 1] << 16), (unsigned)kg0[4 * hf + 2] | ((unsigned)kg0[4 * hf + 3] << 16)};
                                *(u32x2*)(tmp + (size_t)j * 32768 + 16384 + (cl + 1) * 128 + pos * 2) = (u32x2){(unsigned)kg1[4 * hf] | ((unsigned)kg1[4 * hf + 1] << 16), (unsigned)kg1[4 * hf + 2] | ((unsigned)kg1[4 * hf + 3] << 16)};
                                *(LAS u32x2*)(stg + 16384 + ((cl >> 4) * 2 + blk) * 1024 + ((cl & 15) + 16 * (pq0 + hf)) * 16 + (4 * pa) * 2) = (u32x2){(unsigned)ke0[4 * hf] | ((unsigned)ke0[4 * hf + 1] << 16), (unsigned)ke0[4 * hf + 2] | ((unsigned)ke0[4 * hf + 3] << 16)};
                                *(LAS u32x2*)(stg + 16384 + (((cl + 1) >> 4) * 2 + blk) * 1024 + (((cl + 1) & 15) + 16 * (pq0 + hf)) * 16 + (4 * pa) * 2) = (u32x2){(unsigned)ke1[4 * hf] | ((unsigned)ke1[4 * hf + 1] << 16), (unsigned)ke1[4 * hf + 2] | ((unsigned)ke1[4 * hf + 3] << 16)}; }
                        } else {
                            unsigned short vb0[8], vb1[8];
#pragma unroll
                            for (int i = 0; i < 8; ++i) { const float bt = btL[h * 64 + 8 * wave + i]; vb0[i] = (unsigned short)f2bf(v0[i] * bt); vb1[i] = (unsigned short)f2bf(v1[i] * bt); }
#pragma unroll
                            for (int hf = 0; hf < 2; ++hf) { const int pos = 32 * blk + 8 * (pq0 + hf) + 4 * pa; const int cl = 2 * lane;
                                *(u32x2*)(tmp + (size_t)j * 32768 + cl * 128 + pos * 2) = (u32x2){(unsigned)vb0[4 * hf] | ((unsigned)vb0[4 * hf + 1] << 16), (unsigned)vb0[4 * hf + 2] | ((unsigned)vb0[4 * hf + 3] << 16)};
                                *(u32x2*)(tmp + (size_t)j * 32768 + (cl + 1) * 128 + pos * 2) = (u32x2){(unsigned)vb1[4 * hf] | ((unsigned)vb1[4 * hf + 1] << 16), (unsigned)vb1[4 * hf + 2] | ((unsigned)vb1[4 * hf + 3] << 16)}; }
                        }
                        asm volatile("" ::: "memory"); }
                    }
                }
                if (h + 1 < 8) GDN_LOADX(h + 1);
                __syncthreads();
                {
#pragma unroll
                    for (int i = 0; i < 4; ++i) *(u32x4*)(ub + 16384 + (X.tid + 512 * i) * 16) = *(const LAS u32x4*)(stg + (X.tid + 512 * i) * 16);
                    const int mat = wave >> 2, rt = wave & 3; LAS unsigned char* An = mat ? qN : kN;
                    bf16x8 af[4];
#pragma unroll
                    for (int ks = 0; ks < 4; ++ks) af[ks] = *(const LAS bf16x8*)(An + (16 * rt + r16) * KP + (32 * ks + 8 * q4) * 2);
                    LAS float* slot = (LAS float*)(slots + j * 16384);
#pragma unroll
                    for (int ct = 0; ct < 4; ++ct) { f32x4 acc = {0.f, 0.f, 0.f, 0.f};
#pragma unroll
                        for (int ks = 0; ks < 4; ++ks) { const bf16x8 bf = *(const LAS bf16x8*)(kN + (16 * ct + r16) * KP + (32 * ks + 8 * q4) * 2); acc = __builtin_amdgcn_mfma_f32_16x16x32_bf16(af[ks], bf, acc, 0, 0, 0); }
                        const int jc = 16 * ct + r16; const float gj = gcL[h * 64 + jc];
#pragma unroll
                        for (int rg = 0; rg < 4; ++rg) { const int i = 16 * rt + 4 * q4 + rg; const float dec = __expf(gcL[h * 64 + i] - gj);
                            if (mat == 0) { slot[i * 64 + jc] = jc < i ? btL[h * 64 + i] * acc[rg] * dec : 0.f; }
                            else { const float v = jc <= i ? acc[rg] * scale * dec : 0.f;
                                *(LAS unsigned short*)(stg + 32768 + (rt * 2 + (ct >> 1)) * 1024 + ((4 * q4 + rg) + 16 * (r16 >> 2)) * 16 + (4 * (ct & 1) + (r16 & 3)) * 2) = (unsigned short)f2bf(v); } }
                    }
                }
                __syncthreads();
                *(u32x4*)(ub + 49152 + X.tid * 16) = *(const LAS u32x4*)(stg + 32768 + X.tid * 16);
            }
            if (wave < 4) gdn_solve((LAS float*)(slots + wave * 16384), (LAS unsigned short*)(X.lds + wave * 8192), lane);
            VM_WAIT(); __syncthreads();
            for (int j = 0; j < 4; ++j) {
                const int h = bb * 4 + j; unsigned char* ub = gi + (size_t)((b * 8 + h) * 64 + n) * GI_UNIT;
                const int mat = wave >> 2; LAS unsigned char* slot = X.lds + j * 8192;
#pragma unroll
                for (int cx = 0; cx < 2; ++cx) { const int ct = 2 * (wave & 3) + cx;
                    bf16x8 bfr[2];
#pragma unroll
                    for (int ks = 0; ks < 2; ++ks) { const u32x4 t = __builtin_nontemporal_load((const u32x4*)(tmp + (size_t)j * 32768 + mat * 16384 + (16 * ct + r16) * 128 + (32 * ks + 8 * q4) * 2)); bfr[ks] = __builtin_bit_cast(bf16x8, t); }
#pragma unroll
                    for (int rt = 0; rt < 4; ++rt) { f32x4 acc = {0.f, 0.f, 0.f, 0.f};
#pragma unroll
                        for (int ks = 0; ks < 2; ++ks) { const bf16x8 tf = *(const LAS bf16x8*)(slot + (rt * 2 + ks) * 1024 + lane * 16); acc = __builtin_amdgcn_mfma_f32_16x16x32_bf16(tf, bfr[ks], acc, 0, 0, 0); }
                        if (mat == 0) *(u32x2*)(ub + 57344 + (rt * 8 + ct) * 512 + lane * 8) = (u32x2){pg8::cvt_pk_bf16(acc[0], acc[1]), pg8::cvt_pk_bf16(acc[2], acc[3])};
                        else {
#pragma unroll
                            for (int rg = 0; rg < 4; ++rg) *(unsigned short*)(ub + (rt * 4 + (ct >> 1)) * 1024 + ((4 * q4 + rg) + 16 * (r16 >> 2)) * 16 + (4 * (ct & 1) + (r16 & 3)) * 2) = (unsigned short)f2bf(-acc[rg]);
                        }
                    }
                }
            }
            __syncthreads();
        }
    }
}
DEV void ph_gdn_scan(const Args& a, const Ctx& X) {
    const unsigned char* gi = a.ws + WS_GI; const float* glast = (const float*)(a.ws + WS_GLAST);
    const bf16_t* za = (const bf16_t*)(a.ws + WS_ZA); bf16_t* oy = (bf16_t*)(a.ws + WS_OY);
    const int lane = X.lane, wave = X.wave, r16 = lane & 15, q4 = lane >> 4, tid = X.tid;
    LAS float* OT = (LAS float*)(X.lds + 114688);
    const int bh = X.bid, b = bh >> 3, h = bh & 7;
    const unsigned char* ubase = gi + (size_t)bh * 64 * GI_UNIT;
    f32x4 S[8];
#pragma unroll
    for (int i = 0; i < 8; ++i) S[i] = (f32x4){0.f, 0.f, 0.f, 0.f};
    float nwv[16];
#pragma unroll
    for (int i = 0; i < 16; ++i) nwv[i] = a.gdn_norm_w[16 * (tid & 7) + i];
#define GDN_STAGE(nn, buf) do { _Pragma("unroll") for (int _i = 0; _i < 7; ++_i) \
        __builtin_amdgcn_global_load_lds((const unsigned*)(ubase + (size_t)(nn) * GI_UNIT + (size_t)(tid + 512 * _i) * 16), (LAS unsigned*)(X.lds + (buf) * 57344 + (wave * 64 + 512 * _i) * 16), 16, 0, 0); } while (0)
    u32x2 udn[4]; float gln; u32x4 zn[2];
    { const size_t tz = (size_t)b * SEQ + (tid >> 3); zn[0] = *(const u32x4*)(za + tz * 1024 + h * 128 + 16 * (tid & 7)); zn[1] = *(const u32x4*)(za + tz * 1024 + h * 128 + 16 * (tid & 7) + 8); }
#pragma unroll
    for (int ct = 0; ct < 4; ++ct) udn[ct] = *(const u32x2*)(ubase + 57344 + (ct * 8 + wave) * 512 + lane * 8);
    gln = glast[(size_t)(bh * 64) * 32];
    GDN_STAGE(0, 0);
#define GDN_EPILOGUE(nn, ZC) do { const int tok = tid >> 3, seg = tid & 7; const size_t t = (size_t)b * SEQ + 64 * (nn) + tok; \
            float ov[16]; float ss = 0.f; \
            _Pragma("unroll") for (int i = 0; i < 4; ++i) { const f32x4 v = *(const LAS f32x4*)(OT + tok * 132 + 16 * seg + 4 * i); ov[4 * i] = v[0]; ov[4 * i + 1] = v[1]; ov[4 * i + 2] = v[2]; ov[4 * i + 3] = v[3]; ss += v[0] * v[0] + v[1] * v[1] + v[2] * v[2] + v[3] * v[3]; } \
            ss += __shfl_xor(ss, 1); ss += __shfl_xor(ss, 2); ss += __shfl_xor(ss, 4); \
            const float rstd = rsqrtf(ss * (1.f / 128.f) + EPS); \
            u32x4 ow[2]; \
            _Pragma("unroll") for (int i = 0; i < 2; ++i) _Pragma("unroll") for (int e = 0; e < 4; ++e) { const unsigned zw = (ZC)[i][e]; const float z0 = __uint_as_float(zw << 16), z1 = __uint_as_float(zw & 0xFFFF0000u); \
                    ow[i][e] = pg8::cvt_pk_bf16(ov[8 * i + 2 * e] * rstd * nwv[8 * i + 2 * e] * siluf(z0), ov[8 * i + 2 * e + 1] * rstd * nwv[8 * i + 2 * e + 1] * siluf(z1)); } \
            *(u32x4*)(oy + t * 2048 + h * 128 + 16 * seg) = ow[0]; *(u32x4*)(oy + t * 2048 + h * 128 + 16 * seg + 8) = ow[1]; } while (0)
    u32x4 zp[2] = {{0u, 0u, 0u, 0u}, {0u, 0u, 0u, 0u}};
    for (int n = 0; n < 64; ++n) {
        VM_WAIT(); __syncthreads();
        f32x4 uf[4];
#pragma unroll
        for (int ct = 0; ct < 4; ++ct) { uf[ct][0] = __uint_as_float(udn[ct].x << 16); uf[ct][1] = __uint_as_float(udn[ct].x & 0xFFFF0000u); uf[ct][2] = __uint_as_float(udn[ct].y << 16); uf[ct][3] = __uint_as_float(udn[ct].y & 0xFFFF0000u); }
        const float egl = __expf(gln);
        u32x4 zc[2]; zc[0] = zn[0]; zc[1] = zn[1];
        asm volatile("" : "+v"(uf[0]), "+v"(uf[1]), "+v"(uf[2]), "+v"(uf[3]), "+v"(zc[0]), "+v"(zc[1]));
        if (n + 1 < 64) {
            const unsigned char* un = ubase + (size_t)(n + 1) * GI_UNIT;
#pragma unroll
            for (int ct = 0; ct < 4; ++ct) udn[ct] = *(const u32x2*)(un + 57344 + (ct * 8 + wave) * 512 + lane * 8);
            gln = glast[(size_t)(bh * 64 + n + 1) * 32];
            { const size_t tz = (size_t)b * SEQ + 64 * (n + 1) + (tid >> 3); zn[0] = *(const u32x4*)(za + tz * 1024 + h * 128 + 16 * (tid & 7)); zn[1] = *(const u32x4*)(za + tz * 1024 + h * 128 + 16 * (tid & 7) + 8); }
            GDN_STAGE(n + 1, (n + 1) & 1);
        }
        if (n > 0) GDN_EPILOGUE(n - 1, zp);
        zp[0] = zc[0]; zp[1] = zc[1];
        const LAS unsigned char* L = X.lds + (n & 1) * 57344;
        bf16x8 sB[4];
#pragma unroll
        for (int ks = 0; ks < 4; ++ks) sB[ks] = acc_to_frag(S[2 * ks], S[2 * ks + 1]);
        f32x4 vn[4], oo[4];
#pragma unroll
        for (int ct = 0; ct < 4; ++ct) { f32x4 acc = {0.f, 0.f, 0.f, 0.f}, ao = {0.f, 0.f, 0.f, 0.f};
#pragma unroll
            for (int ks = 0; ks < 4; ++ks) { const bf16x8 wf = *(const LAS bf16x8*)(L + (ct * 4 + ks) * 1024 + lane * 16), qf = *(const LAS bf16x8*)(L + 16384 + (ct * 4 + ks) * 1024 + lane * 16);
                acc = __builtin_amdgcn_mfma_f32_16x16x32_bf16(wf, sB[ks], acc, 0, 0, 0); ao = __builtin_amdgcn_mfma_f32_16x16x32_bf16(qf, sB[ks], ao, 0, 0, 0); }
            vn[ct] = acc; oo[ct] = ao; }
#pragma unroll
        for (int ct = 0; ct < 4; ++ct) vn[ct] = vn[ct] + uf[ct];
        bf16x8 vB[2];
#pragma unroll
        for (int ks = 0; ks < 2; ++ks) vB[ks] = acc_to_frag(vn[2 * ks], vn[2 * ks + 1]);
#pragma unroll
        for (int ct = 0; ct < 4; ++ct)
#pragma unroll
            for (int ks = 0; ks < 2; ++ks) { const bf16x8 kf = *(const LAS bf16x8*)(L + 49152 + (ct * 2 + ks) * 1024 + lane * 16); oo[ct] = __builtin_amdgcn_mfma_f32_16x16x32_bf16(kf, vB[ks], oo[ct], 0, 0, 0); }
#pragma unroll
        for (int dt = 0; dt < 8; ++dt) { f32x4 acc = S[dt] * egl;
#pragma unroll
            for (int ks = 0; ks < 2; ++ks) { const bf16x8 ef = *(const LAS bf16x8*)(L + 32768 + (dt * 2 + ks) * 1024 + lane * 16); acc = __builtin_amdgcn_mfma_f32_16x16x32_bf16(ef, vB[ks], acc, 0, 0, 0); }
            S[dt] = acc; }
        __syncthreads();
#pragma unroll
        for (int ct = 0; ct < 4; ++ct)
#pragma unroll
            for (int rg = 0; rg < 4; ++rg) OT[(16 * ct + 4 * q4 + rg) * 132 + 16 * wave + r16] = oo[ct][rg];
    }
    __syncthreads();
    GDN_EPILOGUE(63, zp);
#undef GDN_EPILOGUE
#undef GDN_STAGE
}

constexpr int SP = 272;
DEV void ph_ssd_local(const Args& a, const Ctx& X, const int wg0) {
    const bf16_t* xbcpre = (const bf16_t*)(a.ws + WS_XBCPRE); const float* small = (const float*)(a.ws + WS_SMALL);
    bf16_t* CC = (bf16_t*)(a.ws + WS_CC); float* acum = (float*)(a.ws + WS_ACUM); float* cdec = (float*)(a.ws + WS_CDEC);
    bf16_t* ydiag = (bf16_t*)(a.ws + WS_YDIAG); bf16_t* states = (bf16_t*)(a.ws + WS_STATES);
    LAS unsigned char* Bn = X.lds; LAS unsigned char* Cn = X.lds + 128 * SP; LAS unsigned char* BT = X.lds + 256 * SP;
    LAS unsigned char* xdT = X.lds; LAS unsigned char* xeT = X.lds + 64 * SP;
    LAS float* acL = (LAS float*)(X.lds + AUX_OFF); LAS float* dtL = acL + 8 * 128;
    const int lane = X.lane, wave = X.wave, r16 = lane & 15, q4 = lane >> 4;
    for (int unit = X.bid - wg0; unit < NB * 32 * 2; unit += X.G - wg0) {
        const int g = unit & 1, c = (unit >> 1) & 31, b = unit >> 6; const size_t t0 = (size_t)b * SEQ + 128 * c;
        __syncthreads();
        {
            const int hd = g * 8 + wave; const float an = -__expf(a.ssd_a_log[hd]), bias = a.ssd_dt_bias[hd];
            const float d0 = softplusf(small[(t0 + lane) * 32 + 16 + hd] + bias), d1 = softplusf(small[(t0 + 64 + lane) * 32 + 16 + hd] + bias);
            float s0 = d0 * an, s1 = d1 * an;
#pragma unroll
            for (int o = 1; o < 64; o <<= 1) { const float v0 = __shfl_up(s0, o), v1 = __shfl_up(s1, o); if (lane >= o) { s0 += v0; s1 += v1; } }
            s1 += __shfl(s0, 63);
            acL[wave * 128 + lane] = s0; acL[wave * 128 + 64 + lane] = s1; dtL[wave * 128 + lane] = d0; dtL[wave * 128 + 64 + lane] = d1;
            acum[((size_t)g * T + t0 + lane) * 8 + wave] = s0; acum[((size_t)g * T + t0 + 64 + lane) * 8 + wave] = s1;
            if (lane == 63) cdec[(size_t)unit * 32 + wave] = __expf(s1);
        }
        {
            const int isC = lane >> 5, cc = (lane & 31) * 4, col = 1024 + isC * 256 + g * 128 + cc;
            float w[4][4], bs[4];
#pragma unroll
            for (int i = 0; i < 4; ++i) { const f32x4 t = *(const f32x4*)(a.ssd_conv_w + i * 1536 + col); w[i][0] = t[0]; w[i][1] = t[1]; w[i][2] = t[2]; w[i][3] = t[3]; }
            { const f32x4 t = *(const f32x4*)(a.ssd_conv_b + col); bs[0] = t[0]; bs[1] = t[1]; bs[2] = t[2]; bs[3] = t[3]; }
            float xin[19][4];
#pragma unroll
            for (int i = 0; i < 19; ++i) { const int tk = 16 * wave + i - 3; const bool ok = (128 * c + tk) >= 0; u32x2 v = {0u, 0u}; if (ok) v = *(const u32x2*)(xbcpre + (t0 + tk) * 1536 + col);
                xin[i][0] = __uint_as_float(v.x << 16); xin[i][1] = __uint_as_float(v.x & 0xFFFF0000u); xin[i][2] = __uint_as_float(v.y << 16); xin[i][3] = __uint_as_float(v.y & 0xFFFF0000u); }
            unsigned short ov[16][4];
#pragma unroll
            for (int i = 0; i < 16; ++i)
#pragma unroll
                for (int e = 0; e < 4; ++e) { const float s = bs[e] + w[0][e] * xin[i][e] + w[1][e] * xin[i + 1][e] + w[2][e] * xin[i + 2][e] + w[3][e] * xin[i + 3][e]; ov[i][e] = (unsigned short)f2bf(siluf(s)); }
            LAS unsigned char* nat = isC ? Cn : Bn;
#pragma unroll
            for (int i = 0; i < 16; ++i) { const u32x2 pk = {(unsigned)ov[i][0] | ((unsigned)ov[i][1] << 16), (unsigned)ov[i][2] | ((unsigned)ov[i][3] << 16)};
                *(LAS u32x2*)(nat + (16 * wave + i) * SP + cc * 2) = pk;
                if (isC) *(u32x2*)(CC + (t0 + 16 * wave + i) * 256 + g * 128 + cc) = pk; }
            if (!isC) {
#pragma unroll
                for (int e = 0; e < 4; ++e)
#pragma unroll
                    for (int qq = 0; qq < 4; ++qq) { const u32x2 pk = {(unsigned)ov[4 * qq][e] | ((unsigned)ov[4 * qq + 1][e] << 16), (unsigned)ov[4 * qq + 2][e] | ((unsigned)ov[4 * qq + 3][e] << 16)};
                        *(LAS u32x2*)(BT + (cc + e) * SP + (32 * (wave >> 1) + 8 * qq + 4 * (wave & 1)) * 2) = pk; }
            }
        }
        __syncthreads();
        f32x4 cbt[8];
        {
            bf16x8 cf[4];
#pragma unroll
            for (int ks = 0; ks < 4; ++ks) cf[ks] = *(const LAS bf16x8*)(Cn + (16 * wave + r16) * SP + (32 * ks + 8 * q4) * 2);
#pragma unroll
            for (int st = 0; st < 8; ++st) { cbt[st] = (f32x4){0.f, 0.f, 0.f, 0.f};
#pragma unroll
                for (int ks = 0; ks < 4; ++ks) { const bf16x8 bf = *(const LAS bf16x8*)(Bn + (16 * st + r16) * SP + (32 * ks + 8 * q4) * 2); cbt[st] = __builtin_amdgcn_mfma_f32_16x16x32_bf16(bf, cf[ks], cbt[st], 0, 0, 0); } }
        }
        __syncthreads();
        const int lq = 16 * wave + r16;
        unsigned short xnx[19];
#define SSD_LOADX(hh) do { _Pragma("unroll") for (int _i = 0; _i < 19; ++_i) { const int _tk = 16 * wave + _i - 3; xnx[_i] = (128 * c + _tk) >= 0 ? xbcpre[(t0 + _tk) * 1536 + (hh) * 64 + lane] : (unsigned short)0; } } while (0)
        SSD_LOADX(g * 8);
        for (int r = 0; r < 8; ++r) {
            const int hd = g * 8 + r; const float dd = a.ssd_d[hd];
            {
                const int col = hd * 64 + lane; float w0 = a.ssd_conv_w[col], w1 = a.ssd_conv_w[1536 + col], w2 = a.ssd_conv_w[2 * 1536 + col], w3 = a.ssd_conv_w[3 * 1536 + col]; const float bs = a.ssd_conv_b[col];
                float xin[19];
#pragma unroll
                for (int i = 0; i < 19; ++i) xin[i] = bf2f(xnx[i]);
                if (r + 1 < 8) SSD_LOADX(hd + 1);
                const float aclast = acL[r * 128 + 127];
                unsigned short xd[16], xe[16];
#pragma unroll
                for (int i = 0; i < 16; ++i) { const float xv = siluf(bs + w0 * xin[i] + w1 * xin[i + 1] + w2 * xin[i + 2] + w3 * xin[i + 3]); const int tk = 16 * wave + i;
                    const float xdv = xv * dtL[r * 128 + tk]; xd[i] = (unsigned short)f2bf(xdv); xe[i] = (unsigned short)f2bf(xdv * __expf(aclast - acL[r * 128 + tk])); }
#pragma unroll
                for (int qq = 0; qq < 4; ++qq) { const int pos = 32 * (wave >> 1) + 8 * qq + 4 * (wave & 1);
                    *(LAS u32x2*)(xdT + lane * SP + pos * 2) = (u32x2){(unsigned)xd[4 * qq] | ((unsigned)xd[4 * qq + 1] << 16), (unsigned)xd[4 * qq + 2] | ((unsigned)xd[4 * qq + 3] << 16)};
                    *(LAS u32x2*)(xeT + lane * SP + pos * 2) = (u32x2){(unsigned)xe[4 * qq] | ((unsigned)xe[4 * qq + 1] << 16), (unsigned)xe[4 * qq + 2] | ((unsigned)xe[4 * qq + 3] << 16)}; }
            }
            __syncthreads();
            {
                const float acl = acL[r * 128 + lq], ddt = dd / dtL[r * 128 + lq];
                f32x4 yd[4];
#pragma unroll
                for (int pt = 0; pt < 4; ++pt) yd[pt] = (f32x4){0.f, 0.f, 0.f, 0.f};
#pragma unroll
                for (int ks = 0; ks < 4; ++ks) { if (ks <= (wave >> 1)) {
                    f32x4 mlo, mhi;
#pragma unroll
                    for (int e = 0; e < 4; ++e) {
                        const int s0 = 32 * ks + 4 * q4 + e, s1 = s0 + 16;
                        const float v0 = cbt[2 * ks][e], v1 = cbt[2 * ks + 1][e];
                        mlo[e] = s0 < lq ? v0 * __expf(acl - acL[r * 128 + s0]) : (s0 == lq ? v0 + ddt : 0.f);
                        mhi[e] = s1 < lq ? v1 * __expf(acl - acL[r * 128 + s1]) : (s1 == lq ? v1 + ddt : 0.f);
                    }
                    const bf16x8 mf = acc_to_frag(mlo, mhi);
#pragma unroll
                    for (int pt = 0; pt < 4; ++pt) { const bf16x8 xf = *(const LAS bf16x8*)(xdT + (16 * pt + r16) * SP + (32 * ks + 8 * q4) * 2); yd[pt] = __builtin_amdgcn_mfma_f32_16x16x32_bf16(xf, mf, yd[pt], 0, 0, 0); }
                } }
#pragma unroll
                for (int pt = 0; pt < 4; ++pt) *(u32x2*)(ydiag + (t0 + lq) * 1024 + hd * 64 + 16 * pt + 4 * q4) = (u32x2){pg8::cvt_pk_bf16(yd[pt][0], yd[pt][1]), pg8::cvt_pk_bf16(yd[pt][2], yd[pt][3])};
            }
            {
                bf16x8 bf[4];
#pragma unroll
                for (int ks = 0; ks < 4; ++ks) bf[ks] = *(const LAS bf16x8*)(BT + (16 * wave + r16) * SP + (32 * ks + 8 * q4) * 2);
                bf16_t* hp = states + ((size_t)(unit * 8 + r) * 64) * 128;
#pragma unroll
                for (int pt = 0; pt < 4; ++pt) { f32x4 st = {0.f, 0.f, 0.f, 0.f};
#pragma unroll
                    for (int ks = 0; ks < 4; ++ks) { const bf16x8 xf = *(const LAS bf16x8*)(xeT + (16 * pt + r16) * SP + (32 * ks + 8 * q4) * 2); st = __builtin_amdgcn_mfma_f32_16x16x32_bf16(bf[ks], xf, st, 0, 0, 0); }
                    *(u32x2*)(hp + (size_t)(16 * pt + r16) * 128 + 16 * wave + 4 * q4) = (u32x2){pg8::cvt_pk_bf16(st[0], st[1]), pg8::cvt_pk_bf16(st[2], st[3])}; }
            }
            __syncthreads();
        }
    }
}
DEV void ph_ssd_scan(const Args& a, const Ctx& X, const int wg0) {
    bf16_t* states = (bf16_t*)(a.ws + WS_STATES); const float* cdec = (const float*)(a.ws + WS_CDEC);
    for (int task = (X.bid - wg0) * NTHR + X.tid; task < NB * 16 * 64 * 32; task += (X.G - wg0) * NTHR) {
        const int n4 = task & 31, p = (task >> 5) & 63, hd = (task >> 11) & 15, b = task >> 15;
        bf16_t* base = states + ((size_t)(((b * 32) * 2 + (hd >> 3)) * 8 + (hd & 7)) * 64 + p) * 128 + 4 * n4;
        const float* dbase = cdec + (size_t)((b * 32) * 2 + (hd >> 3)) * 32 + (hd & 7);
        u32x2 sv[32]; float dec[32];
#pragma unroll
        for (int c = 0; c < 32; ++c) { sv[c] = *(const u32x2*)(base + (size_t)c * 131072); dec[c] = dbase[c * 64]; }
        float h0 = 0.f, h1 = 0.f, h2 = 0.f, h3 = 0.f;
#pragma unroll
        for (int c = 0; c < 32; ++c) {
            *(u32x2*)(base + (size_t)c * 131072) = (u32x2){pk2(h0, h1), pk2(h2, h3)};
            h0 = h0 * dec[c] + __uint_as_float(sv[c].x << 16); h1 = h1 * dec[c] + __uint_as_float(sv[c].x & 0xFFFF0000u); h2 = h2 * dec[c] + __uint_as_float(sv[c].y << 16); h3 = h3 * dec[c] + __uint_as_float(sv[c].y & 0xFFFF0000u);
        }
    }
}
DEV void ph_ssd_out(const Args& a, const Ctx& X, const int wg0, const int rot) {
    const bf16_t* CC = (const bf16_t*)(a.ws + WS_CC); const float* acum = (const float*)(a.ws + WS_ACUM); const bf16_t* ydiag = (const bf16_t*)(a.ws + WS_YDIAG);
    const bf16_t* states = (const bf16_t*)(a.ws + WS_STATES); const bf16_t* zb = (const bf16_t*)(a.ws + WS_ZB); bf16_t* oy = (bf16_t*)(a.ws + WS_OY);
    const int lane = X.lane, wave = X.wave, r16 = lane & 15, q4 = lane >> 4;
    for (int unit = (X.bid - wg0 + rot) % (X.G - wg0); unit < NB * 32 * 2; unit += X.G - wg0) {
        const int g = unit & 1, c = (unit >> 1) & 31, b = unit >> 6; const size_t t = (size_t)b * SEQ + 128 * c + 16 * wave + r16;
        bf16x8 cf[4];
#pragma unroll
        for (int ks = 0; ks < 4; ++ks) cf[ks] = *(const bf16x8*)(CC + t * 256 + g * 128 + 32 * ks + 8 * q4);
        float ss = 0.f;
        LAS u32x2* stash = (LAS u32x2*)(X.lds + wave * 16384);
#define SO_LOAD(rr, HF, YD, ZZ, EA) do { const bf16_t* hp_ = states + ((size_t)(unit * 8 + (rr)) * 64) * 128; const int hd_ = g * 8 + (rr); \
            EA = acum[((size_t)g * T + t) * 8 + (rr)]; \
            _Pragma("unroll") for (int pt = 0; pt < 4; ++pt) { _Pragma("unroll") for (int ks = 0; ks < 4; ++ks) HF[pt][ks] = *(const bf16x8*)(hp_ + (size_t)(16 * pt + r16) * 128 + 32 * ks + 8 * q4); \
                YD[pt] = *(const u32x2*)(ydiag + t * 1024 + hd_ * 64 + 16 * pt + 4 * q4); ZZ[pt] = *(const u32x2*)(zb + t * 1024 + hd_ * 64 + 16 * pt + 4 * q4); } } while (0)
#define SO_COMP(rr, HF, YD, ZZ, EA) do { const float eac = __expf(EA); \
            _Pragma("unroll") for (int pt = 0; pt < 4; ++pt) { f32x4 acc = {0.f, 0.f, 0.f, 0.f}; \
                _Pragma("unroll") for (int ks = 0; ks < 4; ++ks) acc = __builtin_amdgcn_mfma_f32_16x16x32_bf16(HF[pt][ks], cf[ks], acc, 0, 0, 0); \
                const u32x2 yd = YD[pt], zz = ZZ[pt]; \
                f32x4 v; v[0] = acc[0] * eac + __uint_as_float(yd.x << 16); v[1] = acc[1] * eac + __uint_as_float(yd.x & 0xFFFF0000u); v[2] = acc[2] * eac + __uint_as_float(yd.y << 16); v[3] = acc[3] * eac + __uint_as_float(yd.y & 0xFFFF0000u); \
                v[0] *= siluf(__uint_as_float(zz.x << 16)); v[1] *= siluf(__uint_as_float(zz.x & 0xFFFF0000u)); v[2] *= siluf(__uint_as_float(zz.y << 16)); v[3] *= siluf(__uint_as_float(zz.y & 0xFFFF0000u)); \
                ss += v[0] * v[0] + v[1] * v[1] + v[2] * v[2] + v[3] * v[3]; \
                stash[((rr) * 4 + pt) * 64 + lane] = (u32x2){pg8::cvt_pk_bf16(v[0], v[1]), pg8::cvt_pk_bf16(v[2], v[3])}; } } while (0)
        bf16x8 hfA[4][4], hfB[4][4]; u32x2 ydA[4], zzA[4], ydB[4], zzB[4]; float eaA, eaB;
        SO_LOAD(0, hfA, ydA, zzA, eaA);
        for (int r = 0; r < 8; r += 2) {
            SO_LOAD(r + 1, hfB, ydB, zzB, eaB);
            SO_COMP(r, hfA, ydA, zzA, eaA);
            if (r + 2 < 8) SO_LOAD(r + 2, hfA, ydA, zzA, eaA);
            SO_COMP(r + 1, hfB, ydB, zzB, eaB);
        }
#undef SO_LOAD
#undef SO_COMP
        ss += __shfl_xor(ss, 16); ss += __shfl_xor(ss, 32);
        const float rstd = rsqrtf(ss * (1.f / 512.f) + EPS);
#pragma unroll 4
        for (int r = 0; r < 8; ++r)
#pragma unroll
            for (int pt = 0; pt < 4; ++pt) { const int cix = g * 512 + r * 64 + 16 * pt + 4 * q4; const f32x4 nw = *(const f32x4*)(a.ssd_norm_w + cix); const u32x2 w = stash[(r * 4 + pt) * 64 + lane];
                *(u32x2*)(oy + t * 2048 + 1024 + cix) = (u32x2){pg8::cvt_pk_bf16(__uint_as_float(w.x << 16) * rstd * nw[0], __uint_as_float(w.x & 0xFFFF0000u) * rstd * nw[1]), pg8::cvt_pk_bf16(__uint_as_float(w.y << 16) * rstd * nw[2], __uint_as_float(w.y & 0xFFFF0000u) * rstd * nw[3])}; }
    }
}


DEV void ph_attn(const Args& a, const Ctx& X) {
    const bf16_t* qkv = (const bf16_t*)(a.ws + WS_Q1KV); bf16_t* po = (bf16_t*)(a.ws + WS_PO); float* plse = (float*)(a.ws + WS_PLSE); unsigned char* o = a.ws + WS_O1;
    LAS unsigned char* vl = X.lds + X.wave * 12288;
    LAS unsigned char* kl = vl + 6144;
    const int lane = X.lane, q = lane & 31, h5 = lane >> 5;
    const int tr_off = ((lane & 15) >> 2) * 192 + (16 * ((lane >> 4) & 1) + 4 * (lane & 3)) * 2;
    const int prow = lane >> 3, pch = lane & 7;
    for (int unit = X.bid; unit < NB * 16 * 4; unit += X.G) {
        const int bhd = unit & 63, b = bhd >> 4, hd = bhd & 15, g = unit >> 6;
        for (int tk = 0; tk < 6; ++tk) {
            const int br = tk >> 1, idx = X.wave * 2 + (tk & 1);
            int d, r, I0;
            if (br == 0) { d = 1; r = 0; I0 = 1024 * g + 64 * idx; } else if (br == 1) { d = 4; r = idx & 3; I0 = 256 * g + 64 * (idx >> 2); } else { d = 16; r = idx; I0 = 64 * g; }
#define ATT_LOAD(dst, j0_, coff) do { _Pragma("unroll") for (int _i = 0; _i < 4; ++_i) { const size_t _t = (size_t)b * SEQ + (size_t)((j0_) + 8 * _i + prow) * d + r; \
                dst[_i] = *(const u32x4*)(qkv + _t * 3072 + (coff) + hd * 64 + pch * 8); } } while (0)
            u32x4 k0[4], v0[4], k1[4], v1[4];
            const bool e3 = (I0 - 32) >= 0, e2 = (I0 - 64) >= 0, e1 = (I0 - 96) >= 0, e0 = (I0 - 128) >= 0;
            ATT_LOAD(k0, I0, 0); ATT_LOAD(k1, I0 + 32, 0);
            bf16x8 qA[4], qB[4];
#pragma unroll
            for (int i = 0; i < 4; ++i) *(LAS u32x4*)(kl + (8 * i + prow) * 144 + pch * 16) = k0[i];
#pragma unroll
            for (int s = 0; s < 4; ++s) qA[s] = *(const LAS bf16x8*)(kl + q * 144 + (16 * s + 8 * h5) * 2);
            LDS_WAIT();
#pragma unroll
            for (int i = 0; i < 4; ++i) *(LAS u32x4*)(kl + (8 * i + prow) * 144 + pch * 16) = k1[i];
#pragma unroll
            for (int s = 0; s < 4; ++s) qB[s] = *(const LAS bf16x8*)(kl + q * 144 + (16 * s + 8 * h5) * 2);
            LDS_WAIT();
            ATT_LOAD(k0, I0 + 32, 1024); ATT_LOAD(v0, I0 + 32, 2048);
            ATT_LOAD(k1, I0, 1024); ATT_LOAD(v1, I0, 2048);
            f32x16 oA[2], oB[2];
#pragma unroll
            for (int i = 0; i < 16; ++i) { oA[0][i] = 0.f; oA[1][i] = 0.f; oB[0][i] = 0.f; oB[1][i] = 0.f; }
            float mA = -1e30f, lA = 0.f, mB = -1e30f, lB = 0.f;
            auto scores = [&](const bf16x8 (&kf)[4], const bf16x8 (&qf)[4], f32x16 (&oacc)[2], float& m, float& l, const int mode, bf16x8 (&pf)[2]) {
                f32x16 sacc;
#pragma unroll
                for (int i = 0; i < 16; ++i) sacc[i] = 0.f;
#pragma unroll
                for (int s = 0; s < 4; ++s) sacc = __builtin_amdgcn_mfma_f32_32x32x16_bf16(kf[s], qf[s], sacc, 0, 0, 0);
                if (mode == 1) {
#pragma unroll
                    for (int i = 0; i < 16; ++i) { const int kl_ = (i & 3) + 8 * (i >> 2) + 4 * h5; if (kl_ > q) sacc[i] = -1e30f; }
                } else if (mode == 2) {
#pragma unroll
                    for (int i = 0; i < 16; ++i) { const int kl_ = (i & 3) + 8 * (i >> 2) + 4 * h5; if (kl_ < q) sacc[i] = -1e30f; }
                }
                float mx = sacc[0];
#pragma unroll
                for (int i = 1; i < 16; ++i) mx = fmaxf(mx, sacc[i]);
                mx = fmaxf(mx, __shfl_xor(mx, 32));
                const float mn = fmaxf(m, mx), alpha = __expf(m - mn);
                float rs = 0.f;
#pragma unroll
                for (int i = 0; i < 16; ++i) { sacc[i] = __expf(sacc[i] - mn); rs += sacc[i]; }
                rs += __shfl_xor(rs, 32);
                l = l * alpha + rs; m = mn;
#pragma unroll
                for (int i = 0; i < 16; ++i) { oacc[0][i] *= alpha; oacc[1][i] *= alpha; }
#pragma unroll
                for (int s = 0; s < 2; ++s) { u32x4 w; w.x = pg8::cvt_pk_bf16(sacc[8 * s], sacc[8 * s + 1]); w.y = pg8::cvt_pk_bf16(sacc[8 * s + 2], sacc[8 * s + 3]); w.z = pg8::cvt_pk_bf16(sacc[8 * s + 4], sacc[8 * s + 5]); w.w = pg8::cvt_pk_bf16(sacc[8 * s + 6], sacc[8 * s + 7]);
                    pf[s] = __builtin_bit_cast(bf16x8, w); }
            };
            auto tile = [&](const u32x4 (&kp)[4], const u32x4 (&vp)[4], const int ma, const int mb) {
#pragma unroll
                for (int i = 0; i < 4; ++i) { *(LAS u32x4*)(kl + (8 * i + prow) * 144 + pch * 16) = kp[i]; *(LAS u32x4*)(vl + (8 * i + prow) * 192 + pch * 16) = vp[i]; }
                bf16x8 kf[4];
#pragma unroll
                for (int s = 0; s < 4; ++s) kf[s] = *(const LAS bf16x8*)(kl + q * 144 + (16 * s + 8 * h5) * 2);
                bf16x8 pA[2], pB[2];
                if (ma >= 0) scores(kf, qA, oA, mA, lA, ma, pA);
                if (mb >= 0) scores(kf, qB, oB, mB, lB, mb, pB);
#pragma unroll
                for (int dt = 0; dt < 2; ++dt)
#pragma unroll
                    for (int s = 0; s < 2; ++s) {
                        const s16x4 t0_ = __builtin_amdgcn_ds_read_tr16_b64_v4i16((LAS s16x4*)(vl + (16 * s + 4 * h5) * 192 + dt * 64 + tr_off));
                        const s16x4 t1_ = __builtin_amdgcn_ds_read_tr16_b64_v4i16((LAS s16x4*)(vl + (16 * s + 8 + 4 * h5) * 192 + dt * 64 + tr_off));
                        bf16x8 vf; vf[0] = t0_[0]; vf[1] = t0_[1]; vf[2] = t0_[2]; vf[3] = t0_[3]; vf[4] = t1_[0]; vf[5] = t1_[1]; vf[6] = t1_[2]; vf[7] = t1_[3];
                        if (ma >= 0) oA[dt] = __builtin_amdgcn_mfma_f32_32x32x16_bf16(vf, pA[s], oA[dt], 0, 0, 0);
                        if (mb >= 0) oB[dt] = __builtin_amdgcn_mfma_f32_32x32x16_bf16(vf, pB[s], oB[dt], 0, 0, 0);
                    }
                LDS_WAIT();
            };
            tile(k0, v0, -1, 1);
            if (e3) { ATT_LOAD(k0, I0 - 32, 1024); ATT_LOAD(v0, I0 - 32, 2048); }
            tile(k1, v1, 1, 0);
            if (e3) {
                if (e2) { ATT_LOAD(k1, I0 - 64, 1024); ATT_LOAD(v1, I0 - 64, 2048); }
                tile(k0, v0, 0, 0);
                if (e2) {
                    if (e1) { ATT_LOAD(k0, I0 - 96, 1024); ATT_LOAD(v0, I0 - 96, 2048); }
                    tile(k1, v1, 0, 0);
                    if (e1) {
                        if (e0) { ATT_LOAD(k1, I0 - 128, 1024); ATT_LOAD(v1, I0 - 128, 2048); }
                        tile(k0, v0, 0, 2);
                        if (e0) tile(k1, v1, 2, -1);
                    }
                }
            }
#undef ATT_LOAD
#pragma unroll
            for (int qt = 0; qt < 2; ++qt) {
                const size_t tq = (size_t)b * SEQ + (size_t)(I0 + 32 * qt + q) * d + r;
                const float l = qt ? lB : lA, m = qt ? mB : mA; const float inv = 1.f / l;
                bf16_t* pr = po + ((size_t)br * T + tq) * 1024 + hd * 64;
#pragma unroll
                for (int dt = 0; dt < 2; ++dt)
#pragma unroll
                    for (int gq = 0; gq < 4; ++gq) { const f32x16& oo = qt ? oB[dt] : oA[dt]; u32x2 w; w.x = pg8::cvt_pk_bf16(oo[4 * gq] * inv, oo[4 * gq + 1] * inv); w.y = pg8::cvt_pk_bf16(oo[4 * gq + 2] * inv, oo[4 * gq + 3] * inv);
                        *(u32x2*)(pr + 32 * dt + 8 * gq + 4 * h5) = w; }
                if (h5 == 0) plse[((size_t)br * T + tq) * 16 + hd] = m + __logf(l);
            }
        }
        VM_WAIT(); __syncthreads();
        for (int hf = 0; hf < 2; ++hf) {
            const size_t t = (size_t)b * SEQ + 1024 * g + 512 * hf + X.tid;
            const float l0 = plse[t * 16 + hd], l1 = plse[((size_t)T + t) * 16 + hd], l2 = plse[((size_t)2 * T + t) * 16 + hd];
            const float mx = fmaxf(l0, fmaxf(l1, l2)); float w0 = __expf(l0 - mx), w1 = __expf(l1 - mx), w2 = __expf(l2 - mx); const float wi = 1.f / (w0 + w1 + w2); w0 *= wi; w1 *= wi; w2 *= wi;
            const bf16_t* p0 = po + t * 1024 + hd * 64; const bf16_t* p1 = p0 + (size_t)T * 1024; const bf16_t* p2 = p1 + (size_t)T * 1024; unsigned char* orow = o + t * 1024 + hd * 64;
            w0 *= 4.f; w1 *= 4.f; w2 *= 4.f;
            u32x4 yq[4];
#pragma unroll
            for (int c = 0; c < 8; ++c) { const u32x4 x0 = *(const u32x4*)(p0 + 8 * c), x1 = *(const u32x4*)(p1 + 8 * c), x2 = *(const u32x4*)(p2 + 8 * c); float f[8];
#pragma unroll
                for (int e = 0; e < 4; ++e) { f[2 * e] = w0 * __uint_as_float(x0[e] << 16) + w1 * __uint_as_float(x1[e] << 16) + w2 * __uint_as_float(x2[e] << 16);
                    f[2 * e + 1] = w0 * __uint_as_float(x0[e] & 0xFFFF0000u) + w1 * __uint_as_float(x1[e] & 0xFFFF0000u) + w2 * __uint_as_float(x2[e] & 0xFFFF0000u); }
#pragma unroll
                for (int e = 0; e < 8; ++e) f[e] = fminf(fmaxf(f[e], -440.f), 440.f);
                int v0 = __builtin_amdgcn_cvt_pk_fp8_f32(f[0], f[1], 0, false); v0 = __builtin_amdgcn_cvt_pk_fp8_f32(f[2], f[3], v0, true);
                int v1 = __builtin_amdgcn_cvt_pk_fp8_f32(f[4], f[5], 0, false); v1 = __builtin_amdgcn_cvt_pk_fp8_f32(f[6], f[7], v1, true);
                yq[c >> 1][2 * (c & 1)] = (unsigned)v0; yq[c >> 1][2 * (c & 1) + 1] = (unsigned)v1; }
#pragma unroll
            for (int j = 0; j < 4; ++j) *(u32x4*)(orow + 16 * j) = yq[j];
        }
    }
}

DEV void ph_router(const Args& a, const Ctx& X, const int l) {
    unsigned char* ws = a.ws;
    const float* mod = (const float*)(ws + WS_MOD) + (size_t)l * NB * 6 * D;
    const bf16_t* ymix = (const bf16_t*)(ws + WS_YMIX);
    bf16_t* xb = (bf16_t*)(ws + WS_XB);
    bf16_t* hb = (bf16_t*)(ws + WS_H);
    int* idx = (int*)(ws + WS_IDX); float* gw = (float*)(ws + WS_GW); int* aslot = (int*)(ws + WS_ASLOT); int* ltok = (int*)(ws + WS_LTOK);
    int* cntg = (int*)(ws + WS_CTL + CTL_CNT) + l * NE;
    const float* rw = a.router_w + (size_t)l * D * NE; const float* rbias = a.router_bias + l * NE;
    constexpr int HP = 2064;
    LAS unsigned char* hL = X.lds;
    LAS float* logit = (LAS float*)(X.lds + AUX_OFF + 2048);
    LAS int* lcnt = (LAS int*)(X.lds + AUX_OFF + 2048 + 64 * 65 * 4);
    LAS int* lbase = lcnt + 64;
    LAS int* sel_e = lbase + 64;
    LAS int* sel_s = sel_e + 512;
    const int lane = X.lane, wave = X.wave;
    for (int rb = X.bid; rb < T / 64; rb += X.G) {
        if (X.tid < 64) lcnt[X.tid] = 0;
        f32x4 xf_n[4]; u32x2 xb_n[4], ym_n[4];
#define RT_LOAD(rr) do { const int _row = rb * 64 + wave * 8 + (rr); _Pragma("unroll") for (int _j = 0; _j < 4; ++_j) { \
            if (l == 0) xf_n[_j] = *(const f32x4*)(a.x + (size_t)_row * D + _j * 256 + lane * 4); else xb_n[_j] = *(const u32x2*)(xb + (size_t)_row * D + _j * 256 + lane * 4); \
            ym_n[_j] = *(const u32x2*)(ymix + (size_t)_row * D + _j * 256 + lane * 4); } } while (0)
        RT_LOAD(0);
        for (int r8 = 0; r8 < 8; ++r8) {
            const int lr = wave * 8 + r8, row = rb * 64 + lr, b = row / SEQ; const float* ml = mod + (size_t)b * 6 * D;
            float xv[16], yv[16];
#pragma unroll
            for (int j = 0; j < 4; ++j) {
                if (l == 0) { xv[4 * j] = xf_n[j][0]; xv[4 * j + 1] = xf_n[j][1]; xv[4 * j + 2] = xf_n[j][2]; xv[4 * j + 3] = xf_n[j][3]; }
                else { xv[4 * j] = __uint_as_float(xb_n[j].x << 16); xv[4 * j + 1] = __uint_as_float(xb_n[j].x & 0xFFFF0000u); xv[4 * j + 2] = __uint_as_float(xb_n[j].y << 16); xv[4 * j + 3] = __uint_as_float(xb_n[j].y & 0xFFFF0000u); }
                yv[4 * j] = __uint_as_float(ym_n[j].x << 16); yv[4 * j + 1] = __uint_as_float(ym_n[j].x & 0xFFFF0000u); yv[4 * j + 2] = __uint_as_float(ym_n[j].y << 16); yv[4 * j + 3] = __uint_as_float(ym_n[j].y & 0xFFFF0000u); }
            if (r8 + 1 < 8) RT_LOAD(r8 + 1);
            resid_update(xv, yv, a.mix_post_g + l * D, ml + 2 * D, lane);
            store_row_bf(xb + (size_t)row * D, lane, xv);
            u32x2 o[4]; prenorm_pack(xv, a.ffn_pre_g + l * D, ml + 4 * D, ml + 3 * D, lane, o);
#pragma unroll
            for (int j = 0; j < 4; ++j) { *(LAS u32x2*)(hL + lr * HP + (j * 256 + lane * 4) * 2) = o[j];
                const float h0 = __uint_as_float(o[j].x << 16), h1 = __uint_as_float(o[j].x & 0xFFFF0000u), h2 = __uint_as_float(o[j].y << 16), h3 = __uint_as_float(o[j].y & 0xFFFF0000u);
                int w = __builtin_amdgcn_cvt_pk_fp8_f32(fminf(fmaxf(h0, -440.f), 440.f), fminf(fmaxf(h1, -440.f), 440.f), 0, false); w = __builtin_amdgcn_cvt_pk_fp8_f32(fminf(fmaxf(h2, -440.f), 440.f), fminf(fmaxf(h3, -440.f), 440.f), w, true);
                *(unsigned*)((unsigned char*)hb + (size_t)row * D + j * 256 + lane * 4) = (unsigned)w; }
        }
#undef RT_LOAD
        __syncthreads();
        { const int rt = wave & 3, nh = wave >> 2, r16 = lane & 15, kq = lane >> 4;
          f32x4 acc0 = {0.f, 0.f, 0.f, 0.f}, acc1 = {0.f, 0.f, 0.f, 0.f};
          for (int c = 0; c < 32; ++c) {
              const u32x4 hv = *(const LAS u32x4*)(hL + (rt * 16 + r16) * HP + (32 * c + 8 * kq) * 2);
              const float* rp = rw + (size_t)(32 * c + 8 * kq) * NE + 4 * r16 + 2 * nh;
#pragma unroll
              for (int j = 0; j < 8; ++j) { const unsigned wj = hv[j >> 1]; const float av = (j & 1) ? __uint_as_float(wj & 0xFFFF0000u) : __uint_as_float(wj << 16);
                  const f32x2 bv = *(const f32x2*)(rp + (size_t)j * NE);
                  acc0 = __builtin_amdgcn_mfma_f32_16x16x4f32(av, bv.x, acc0, 0, 0, 0); acc1 = __builtin_amdgcn_mfma_f32_16x16x4f32(av, bv.y, acc1, 0, 0, 0); }
          }
#pragma unroll
          for (int r = 0; r < 4; ++r) { logit[(rt * 16 + 4 * kq + r) * 65 + 4 * r16 + 2 * nh] = acc0[r]; logit[(rt * 16 + 4 * kq + r) * 65 + 4 * r16 + 2 * nh + 1] = acc1[r]; } }
        __syncthreads();
        for (int r8 = 0; r8 < 8; ++r8) {
            const int lr = wave * 8 + r8, t = rb * 64 + lr;
            float lgt = logit[lr * 65 + lane]; if (!(lgt > -1e30f && lgt < 1e30f)) lgt = 0.f;
            const float score = sigmoidf_(lgt), biased = score + rbias[lane];
            float m1 = biased;
#pragma unroll
            for (int o = 1; o < 8; o <<= 1) m1 = fmaxf(m1, __shfl_xor(m1, o));
            int c1 = (biased == m1) ? (lane & 7) : 8;
#pragma unroll
            for (int o = 1; o < 8; o <<= 1) c1 = min(c1, __shfl_xor(c1, o));
            float m2 = ((lane & 7) == c1) ? -INFINITY : biased;
#pragma unroll
            for (int o = 1; o < 8; o <<= 1) m2 = fmaxf(m2, __shfl_xor(m2, o));
            const float gs = m1 + m2; const int myg = lane >> 3; int grank = 0;
#pragma unroll
            for (int g2 = 0; g2 < 8; ++g2) { const float o = __shfl(gs, g2 * 8); grank += (o > gs || (o == gs && g2 < myg)) ? 1 : 0; }
            const float cand = (grank < 4) ? biased : -INFINITY; int rank = 0;
            for (int e2 = 0; e2 < 64; ++e2) { const float o = __shfl(cand, e2); rank += (o > cand || (o == cand && e2 < lane)) ? 1 : 0; }
            const bool sel = (rank < TOPK) && (grank < 4);
            const float ssum = wave_sum(sel ? score : 0.f);
            if (sel) { idx[t * 8 + rank] = lane; gw[t * 8 + rank] = score / ssum * 2.5f; sel_e[lr * 8 + rank] = lane; sel_s[lr * 8 + rank] = __hip_atomic_fetch_add(lcnt + lane, 1, __ATOMIC_RELAXED, __HIP_MEMORY_SCOPE_WORKGROUP); }
        }
        __syncthreads();
        if (X.tid < 64) { const int n = lcnt[X.tid]; lbase[X.tid] = n ? atomicAdd(cntg + X.tid, n) : 0; }
        __syncthreads();
        { const int lr = X.tid >> 3, k = X.tid & 7, t = rb * 64 + lr, e = sel_e[lr * 8 + k], sl = lbase[e] + sel_s[lr * 8 + k];
          aslot[t * 8 + k] = sl; ltok[e * CAP + sl] = t; }
        __syncthreads();
    }
}
template <int NW>
DEV void ph_moe_conv(const Args& a, const Ctx& X, const int l, const int widx, const int nwg, const int it0, const int it1) {
    unsigned char* ws = a.ws;
    if (X.wave >= NW) return;
    { LAS float* scr = (LAS float*)(X.lds + X.wave * 8704);
      const int gwv = widx * NW + X.wave, NGW = nwg * NW;
      constexpr int I_GU = (D / 64) * (512 / 32), I_D = (ED / 64) * (D / 32), I_E = I_GU + I_D;
      const float* eg = a.exp_gate + (size_t)l * NE * D * ED; const float* eu = a.exp_up + (size_t)l * NE * D * ED; const float* ed = a.exp_down + (size_t)l * NE * ED * D;
      const int itend = it1 < 0 ? (NE + 1) * I_E : it1;
      for (int it = it0 + gwv; it < itend; it += NGW) {
          const int e = it / I_E; int r = it - e * I_E;
          if (e < NE) {
              if (r < I_GU) conv_item<SrcGU, true>(SrcGU{eg + (size_t)e * D * ED, (long)(eu - eg)}, ED, D, ws + WS_WGU + (size_t)e * 512 * D, scr, r, 16, X.lane, 64.f);
              else conv_item<SrcIdent, true>(SrcIdent{ed + (size_t)e * ED * D}, D, ED, ws + WS_WD + (size_t)e * D * ED, scr, r - I_GU, D / 32, X.lane, 32.f);
          } else {
              if (r < I_GU) conv_item<SrcGU, true>(SrcGU{a.sh_gate + (size_t)l * D * ED, (long)(a.sh_up - a.sh_gate)}, ED, D, ws + WS_WGUS, scr, r, 16, X.lane, 64.f);
              else conv_item<SrcIdent, true>(SrcIdent{a.sh_down + (size_t)l * ED * D}, D, ED, ws + WS_WDS, scr, r - I_GU, D / 32, X.lane, 32.f);
          }
      } }
}

DEV int moe_tables(const Args& a, const Ctx& X, const int l, LAS int* t_cnt, LAS int* t_rb0, LAS int* t_eofrb) {
    const int* cntg = (const int*)(a.ws + WS_CTL + CTL_CNT) + l * NE;
    if (X.wave == 0) {
        const int c = __hip_atomic_load(cntg + X.lane, __ATOMIC_RELAXED, __HIP_MEMORY_SCOPE_AGENT), nrb = (c + 255) >> 8;
        int incl = nrb;
#pragma unroll
        for (int o = 1; o < 64; o <<= 1) { const int v = __shfl_up(incl, o); if (X.lane >= o) incl += v; }
        const int excl = incl - nrb;
        t_cnt[X.lane] = c; t_rb0[X.lane] = excl; if (X.lane == 63) t_rb0[64] = incl;
        for (int j = 0; j < nrb; ++j) t_eofrb[excl + j] = X.lane;
        t_eofrb[SH_RB + X.lane] = NE;
    }
    __syncthreads();
    return t_rb0[64];
}

DEV void ph_moe_gu(const Args& a, const Ctx& X, const int l) {
    LAS int* t_cnt = (LAS int*)(X.lds + AUX_OFF + 1024); LAS int* t_rb0 = t_cnt + 64; LAS int* t_eofrb = t_rb0 + 80; LAS int* toks = t_eofrb + NRB_ALL;
    const int nrbt = moe_tables(a, X, l, t_cnt, t_rb0, t_eofrb);
    const int* ltok = (const int*)(a.ws + WS_LTOK);
    pg8::Unit u;
    for (int i = 0; i < 8; ++i) { if (!pg8::moe_unit(i, 2, nrbt, X.G, X.bid, u)) break;
        if (X.tid < 256) { const int e = t_eofrb[u.pm]; int tok;
            if (e < NE) { const int sl = (u.pm - t_rb0[e]) * 256 + X.tid; tok = sl < t_cnt[e] ? ltok[e * CAP + sl] : 0; } else tok = (u.pm - SH_RB) * 256 + X.tid;
            toks[i * 256 + X.tid] = tok; } }
    VM_WAIT(); __syncthreads();
    pg8::SchedGU S{(const char*)(a.ws + WS_H), (const char*)(a.ws + WS_WGU), (const char*)(a.ws + WS_WGUS), t_eofrb, toks, nrbt, X.G, X.bid, 0};
    pg8::EpiGU E{a.ws + WS_HID};
    pg8::gemm_phase<pg8::EpiGU, pg8::SchedGU, true>(X.lds, D, S, E);
}
DEV void ph_moe_down(const Args& a, const Ctx& X, const int l) {
    LAS int* t_cnt = (LAS int*)(X.lds + AUX_OFF + 1024); LAS int* t_rb0 = t_cnt + 64; LAS int* t_eofrb = t_rb0 + 80;
    const int nrbt = moe_tables(a, X, l, t_cnt, t_rb0, t_eofrb);
    pg8::SchedDown S{(const char*)(a.ws + WS_HID), (const char*)(a.ws + WS_WD), (const char*)(a.ws + WS_WDS), t_eofrb, nrbt, X.G, X.bid, 0};
    pg8::EpiFp8 E{(unsigned char*)(a.ws + WS_Y), D, 0};
    int kd = ED; asm volatile("" : "+s"(kd));
    pg8::gemm_phase<pg8::EpiFp8, pg8::SchedDown, true>(X.lds, kd, S, E);
}
DEV void ph_combine(const Args& a, const Ctx& X, const int l) {
    LAS int* t_cnt = (LAS int*)(X.lds + AUX_OFF + 1024); LAS int* t_rb0 = t_cnt + 64; LAS int* t_eofrb = t_rb0 + 80;
    (void)moe_tables(a, X, l, t_cnt, t_rb0, t_eofrb);
    const float* mod = (const float*)(a.ws + WS_MOD);
    const int* idx = (const int*)(a.ws + WS_IDX); const float* gw = (const float*)(a.ws + WS_GW); const int* aslot = (const int*)(a.ws + WS_ASLOT);
    const unsigned char* y = a.ws + WS_Y; unsigned char* h8 = a.ws + WS_H;
    const int lane = X.lane;
    const int tstep = X.G * NWAVES;
    int t = X.bid * NWAVES + X.wave;
    int e_n = 0, s_n = 0; float g_n = 0.f;
    if (t < T && lane < 8) { e_n = idx[t * 8 + lane]; g_n = gw[t * 8 + lane]; s_n = aslot[t * 8 + lane]; }
    for (; t < T; t += tstep) {
        const int b = t / SEQ; const float* ml = mod + (size_t)(l * NB + b) * 6 * D;
        const int e_c = e_n, s_c = s_n; const float g_c = g_n;
        const int tn = t + tstep;
        if (tn < T && lane < 8) { e_n = idx[tn * 8 + lane]; g_n = gw[tn * 8 + lane]; s_n = aslot[tn * 8 + lane]; }
        u32x2 w0[9], w1[9];
        { const unsigned char* yr = y + ((size_t)SH_RB * 256 + t) * D; w0[8] = *(const u32x2*)(yr + 8 * lane); w1[8] = *(const u32x2*)(yr + 512 + 8 * lane); }
        float gk[8];
#pragma unroll
        for (int k = 0; k < 8; ++k) { const int e = __shfl(e_c, k), sl = __shfl(s_c, k); gk[k] = __shfl(g_c, k);
            const unsigned char* yr = y + ((size_t)t_rb0[e] * 256 + sl) * D; w0[k] = *(const u32x2*)(yr + 8 * lane); w1[k] = *(const u32x2*)(yr + 512 + 8 * lane); }
        float xv[16]; load_row8_bf((const bf16_t*)(a.ws + WS_XB) + (size_t)t * D, lane, xv);
        float yv[16];
#pragma unroll
        for (int i = 0; i < 16; ++i) yv[i] = 0.f;
        acc_row8(yv, w0[8], w1[8], 0.125f);
#pragma unroll
        for (int k = 0; k < 8; ++k) acc_row8(yv, w0[k], w1[k], gk[k] * 0.125f);
        resid_update8(xv, yv, a.ffn_post_g + l * D, ml + 5 * D, lane);
        if (l == 0) store_row8_bf((bf16_t*)(a.ws + WS_XB) + (size_t)t * D, lane, xv); else store_row8(a.out + (size_t)t * D, lane, xv);
        if (l == 0) { const float* mn = mod + (size_t)(1 * NB + b) * 6 * D; u32x2 o[2]; prenorm_pack8_f8(xv, a.mix_pre_g + D, mn + D, mn, lane, o);
            *(u32x2*)(h8 + (size_t)t * D + 8 * lane) = o[0]; *(u32x2*)(h8 + (size_t)t * D + 512 + 8 * lane) = o[1]; }
    }
}

constexpr int NPH = 18;
__global__ void __launch_bounds__(NTHR, 2) mega(Args a) {
    extern __shared__ __attribute__((aligned(16))) unsigned char lds_raw[];
    Ctx X; X.lds = (LAS unsigned char*)lds_raw; X.tid = threadIdx.x; X.lane = X.tid & 63; X.wave = __builtin_amdgcn_readfirstlane(X.tid >> 6); X.G = gridDim.x; X.bid = blockIdx.x;
    if (X.tid < 4) ((LAS unsigned*)(X.lds + BAR_OFF))[X.tid] = 0u;
    __syncthreads();
    XcdBarrier bar; bar.bar = (unsigned*)(a.ws + WS_CTL); bar.x = 0; bar.st = nullptr;
    if (!MK_PER_PHASE) bar = xcd_barrier_post((unsigned*)(a.ws + WS_CTL), (volatile LAS unsigned*)(X.lds + BAR_OFF));
    const int lo = a.ph_lo, hi = a.ph_hi;
#define IN(k) (lo <= (k) && (k) < hi)
#define REP(k, ...) do { __VA_ARGS__; if constexpr (((PROBE_MASK >> (k)) & 1u) != 0u) { __syncthreads(); __VA_ARGS__; } } while (0)
#define SEAM(k) do { if (IN(k) && IN((k) + 1)) xcd_barrier(bar); else { VM_WAIT(); __syncthreads(); } } while (0)
    unsigned char* ws = a.ws;
    if (IN(0)) { REP(0, ph_setup(a, X)); SEAM(0); }
    if (IN(1)) { REP(1, ph_prenorm0(a, X)); SEAM(1); }
    if constexpr (((PROBE_MASK >> 24) & 1u) != 0u) { for (int i_ = 0; i_ < 16; ++i_) xcd_barrier(bar); }
    if (IN(2)) {
        pg8::SchedDense8<0x79797979, 0x7F7F7F7F> S; S.so.init(T, NPROJ, X.G, X.bid); S.A = (const char*)(ws + WS_H); S.Bt = (const char*)(ws + WS_WIN); S.K = D; S.pad_ = 0;
        pg8::EpiProj E{(bf16_t*)(ws + WS_QKVPRE), (bf16_t*)(ws + WS_ZA), (bf16_t*)(ws + WS_XBCPRE), (bf16_t*)(ws + WS_ZB), (float*)(ws + WS_SMALL)};
        REP(2, pg8::gemm_phase<pg8::EpiProj, pg8::SchedDense8<0x79797979, 0x7F7F7F7F>, true>(X.lds, D, S, E)); SEAM(2); }
    if (IN(3)) { REP(3, ph_gdn_local(a, X)); SEAM(3); }
    if (IN(4)) {
        if (X.bid < 32) { REP(4, ph_gdn_scan(a, X)); }
        else {
            const int w = X.bid - 32, nw = X.G - 32; unsigned* gctr = (unsigned*)(ws + WS_CTL + CTL_GRP);
            constexpr int CONV_P1 = PROBE_CONVP1;
            REP(20, ph_ssd_local(a, X, 32)); __syncthreads();
            if (w >= 32) { REP(22, ph_moe_conv<2>(a, X, 0, w - 32, nw - 32, 0, CONV_P1)); }
            group_barrier(gctr, (unsigned)nw); __syncthreads();
            ph_ssd_scan(a, X, 32);
            group_barrier(gctr, 2u * (unsigned)nw); __syncthreads();
            REP(5, ph_ssd_out(a, X, 32, nw - 32)); __syncthreads();
            if (w < 32 || w >= 64) { const int wi = w < 32 ? w : w - 32; ph_moe_conv<2>(a, X, 0, wi, nw - 32, CONV_P1, -1); __syncthreads(); REP(23, ph_setup_late(a, X, wi, nw - 32)); }
        }
        SEAM(4); }
    if (IN(6)) {
        pg8::SchedDense S; S.so.init(T, D, X.G, X.bid); S.A = (const char*)(ws + WS_OY); S.Bt = (const char*)(ws + WS_WOUT); S.K = 2048; S.pad_ = 0;
        pg8::EpiBf16 E{(bf16_t*)(ws + WS_YMIX), D, 0};
        REP(6, pg8::gemm_phase<pg8::EpiBf16, pg8::SchedDense>(X.lds, 2048, S, E)); SEAM(6); }
    if (IN(7)) { ph_router(a, X, 0); SEAM(7); }
    if (IN(8)) { REP(8, ph_moe_gu(a, X, 0)); SEAM(8); }
    if (IN(9)) { REP(9, ph_moe_down(a, X, 0)); SEAM(9); }
    if (IN(10)) { ph_combine(a, X, 0); SEAM(10); }
    if (IN(11)) {
        pg8::SchedDense8<0x79797979, 0x7F7F7F7F> S; S.so.init(T, 3072, X.G, X.bid); S.A = (const char*)(ws + WS_H); S.Bt = (const char*)(ws + WS_WQKV); S.K = D; S.pad_ = 0;
        pg8::EpiQKV E{(bf16_t*)(ws + WS_Q1KV), (const float*)(ws + WS_COS), (const float*)(ws + WS_SIN)};
        REP(11, pg8::gemm_phase<pg8::EpiQKV, pg8::SchedDense8<0x79797979, 0x7F7F7F7F>, true>(X.lds, D, S, E)); SEAM(11); }
    if (IN(12)) { REP(12, ph_attn(a, X)); SEAM(12); }
    if (IN(13)) {
        pg8::SchedDense8<0x79797979, 0x7D7D7D7D> S; S.so.init(T, D, X.G, X.bid); S.A = (const char*)(ws + WS_O1); S.Bt = (const char*)(ws + WS_WO); S.K = D; S.pad_ = 0;
        pg8::EpiBf16 E{(bf16_t*)(ws + WS_YMIX), D, 0};
        REP(13, pg8::gemm_phase<pg8::EpiBf16, pg8::SchedDense8<0x79797979, 0x7D7D7D7D>, true>(X.lds, D, S, E)); SEAM(13); }
    if (IN(14)) { ph_router(a, X, 1); REP(14, ph_moe_conv<8>(a, X, 1, X.bid, X.G, 0, -1)); SEAM(14); }
    if (IN(15)) { ph_moe_gu(a, X, 1); SEAM(15); }
    if (IN(16)) { ph_moe_down(a, X, 1); SEAM(16); }
    if (IN(17)) { REP(17, ph_combine(a, X, 1)); }
#undef IN
#undef SEAM
}

extern "C" void kernel_launch(void* const* d_in, const int* in_sizes, int n_in, void* d_out, int out_size, void* d_ws, size_t ws_size, hipStream_t stream) {
    static int grid = 0;
    if (!grid) {
        int dev = 0, cus = 0, per_cu = 0;
        if (hipGetDevice(&dev) != hipSuccess || hipDeviceGetAttribute(&cus, hipDeviceAttributeMultiprocessorCount, dev) != hipSuccess) { fprintf(stderr, "kernel_launch: device query failed\n"); grid = -1; return; }
        if (hipFuncSetAttribute((const void*)mega, hipFuncAttributeMaxDynamicSharedMemorySize, LDS_BYTES) != hipSuccess) { fprintf(stderr, "kernel_launch: hipFuncSetAttribute failed\n"); grid = -1; return; }
        if (hipOccupancyMaxActiveBlocksPerMultiprocessor(&per_cu, (const void*)mega, NTHR, LDS_BYTES) != hipSuccess || per_cu < 1) { fprintf(stderr, "kernel_launch: occupancy query says %d blocks per CU\n", per_cu); grid = -1; return; }
        grid = cus;
        if (grid < 64 || (grid & 7)) { fprintf(stderr, "kernel_launch: unsupported CU count %d\n", cus); grid = -1; return; }
    }
    if (grid < 0) return;
    if (ws_size < WS_END || n_in != 31) { fprintf(stderr, "kernel_launch: workspace %zu < %zu or n_in %d != 31\n", ws_size, (size_t)WS_END, n_in); return; }
    if (hipMemsetAsync((char*)d_ws + WS_CTL, 0, CTL_BYTES, stream) != hipSuccess) { fprintf(stderr, "kernel_launch: memset failed\n"); return; }
    Args a{};
    a.x = (const float*)d_in[0]; a.c = (const float*)d_in[1]; a.pos = (const int*)d_in[2]; a.mod_w = (const float*)d_in[3]; a.mod_b = (const float*)d_in[4];
    a.mix_pre_g = (const float*)d_in[5]; a.mix_post_g = (const float*)d_in[6]; a.ffn_pre_g = (const float*)d_in[7]; a.ffn_post_g = (const float*)d_in[8];
    a.ssm_w_in = (const float*)d_in[9]; a.gdn_conv_w = (const float*)d_in[10]; a.gdn_a_log = (const float*)d_in[11]; a.gdn_dt_bias = (const float*)d_in[12]; a.gdn_norm_w = (const float*)d_in[13];
    a.ssd_conv_w = (const float*)d_in[14]; a.ssd_conv_b = (const float*)d_in[15]; a.ssd_a_log = (const float*)d_in[16]; a.ssd_dt_bias = (const float*)d_in[17]; a.ssd_d = (const float*)d_in[18]; a.ssd_norm_w = (const float*)d_in[19];
    a.ssm_w_out = (const float*)d_in[20]; a.attn_w_qkv = (const float*)d_in[21]; a.attn_w_o = (const float*)d_in[22];
    a.router_w = (const float*)d_in[23]; a.router_bias = (const float*)d_in[24]; a.exp_gate = (const float*)d_in[25]; a.exp_up = (const float*)d_in[26]; a.exp_down = (const float*)d_in[27];
    a.sh_gate = (const float*)d_in[28]; a.sh_up = (const float*)d_in[29]; a.sh_down = (const float*)d_in[30];
    a.out = (float*)d_out; a.ws = (unsigned char*)d_ws;
#if MK_PER_PHASE
    for (int p = 0; p < NPH; ++p) { a.ph_lo = p; a.ph_hi = p + 1; hipLaunchKernelGGL(mega, dim3(grid), dim3(NTHR), LDS_BYTES, stream, a); }
#else
    a.ph_lo = 0; a.ph_hi = NPH;
    hipLaunchKernelGGL(mega, dim3(grid), dim3(NTHR), LDS_BYTES, stream, a);
#endif
}
```

```cpp
#include <hip/hip_runtime.h>
#include <stdint.h>
#include <stdio.h>

#define DEV __device__ __forceinline__
#define LAS __attribute__((address_space(3)))
typedef unsigned short bf16_t;
typedef short bf16x8 __attribute__((ext_vector_type(8)));
typedef float f32x4 __attribute__((ext_vector_type(4)));
typedef float f32x2 __attribute__((ext_vector_type(2)));
typedef unsigned u32x4 __attribute__((ext_vector_type(4)));
typedef unsigned u32x2 __attribute__((ext_vector_type(2)));
typedef float f32x16 __attribute__((ext_vector_type(16)));
typedef short s16x4 __attribute__((ext_vector_type(4)));

#ifndef PROBE_MASK
#define PROBE_MASK 0u
#endif
#ifndef PROBE_CONVP1
#define PROBE_CONVP1 15360
#endif
#ifndef MK_PER_PHASE
#define MK_PER_PHASE 0
#endif

constexpr int NB = 4, SEQ = 4096, T = NB * SEQ, D = 1024;
constexpr int PROJ = 6688, NPROJ = 6912;
constexpr int C_BETA = 4096, C_XBC = 4112, C_ZB = 5648, C_DT = 6672;
constexpr int NE = 64, TOPK = 8, ED = 256, CAP = 16384;
constexpr int SH_RB = 576;
constexpr int NRB_ALL = SH_RB + 64;
constexpr float EPS = 1e-6f;
constexpr int NTHR = 512, NWAVES = 8;
constexpr int LDS_BYTES = 163840;
constexpr int AUX_OFF = 131072;
constexpr int BAR_OFF = LDS_BYTES - 16;

constexpr size_t MiB = 1u << 20;
constexpr size_t WS_CTL = 0, CTL_BYTES = 65536;
constexpr size_t CTL_CNT = 16384;
constexpr size_t CTL_GRP = 20480;
constexpr size_t WS_MOD = 65536;
constexpr size_t WS_COS = 1 * MiB, WS_SIN = 3 * MiB;
constexpr size_t WS_IDX = 5 * MiB, WS_GW = 5 * MiB + 512 * 1024, WS_ASLOT = 6 * MiB, WS_LTOK = 6 * MiB + 512 * 1024;
constexpr size_t WS_SMALL = 11 * MiB;
constexpr size_t WS_WIN = 16 * MiB, WS_WOUT = 30 * MiB, WS_WQKV = 34 * MiB, WS_WO = 40 * MiB;
constexpr size_t WS_H = 44 * MiB;
constexpr size_t WS_QKVPRE = 78 * MiB, WS_XBCPRE = 174 * MiB, WS_ZA = 222 * MiB, WS_ZB = 254 * MiB;
constexpr size_t WS_CC = 16 * MiB, WS_ACUM = 25 * MiB, WS_CDEC = 26 * MiB, WS_YDIAG = 44 * MiB, WS_STATES = 430 * MiB;
constexpr size_t WS_GI = 286 * MiB, GI_UNIT = 73728, WS_GTMP = 462 * MiB, WS_GLAST = 27 * MiB;
constexpr size_t WS_OY = 78 * MiB, WS_YMIX = 286 * MiB, WS_XB = 240 * MiB;
constexpr size_t WS_WD = 478 * MiB, WS_WDS = 510 * MiB + 512 * 1024, WS_HID = 398 * MiB, WS_Y = 78 * MiB, WS_WGU = 142 * MiB, WS_WGUS = 207 * MiB;
constexpr size_t WS_Q1KV = 78 * MiB, WS_O1 = 174 * MiB, WS_PO = 350 * MiB, WS_PLSE = 446 * MiB;
constexpr size_t WS_END = 512 * MiB;

struct Args {
    const float* x; const float* c; const int* pos; const float* mod_w; const float* mod_b;
    const float* mix_pre_g; const float* mix_post_g; const float* ffn_pre_g; const float* ffn_post_g;
    const float* ssm_w_in; const float* gdn_conv_w; const float* gdn_a_log; const float* gdn_dt_bias; const float* gdn_norm_w;
    const float* ssd_conv_w; const float* ssd_conv_b; const float* ssd_a_log; const float* ssd_dt_bias; const float* ssd_d; const float* ssd_norm_w;
    const float* ssm_w_out; const float* attn_w_qkv; const float* attn_w_o;
    const float* router_w; const float* router_bias; const float* exp_gate; const float* exp_up; const float* exp_down;
    const float* sh_gate; const float* sh_up; const float* sh_down;
    float* out; unsigned char* ws; int ph_lo, ph_hi;
};

DEV float bf2f(bf16_t v) { return __uint_as_float(((unsigned)v) << 16); }
DEV unsigned f2bf(float f) { unsigned u = __float_as_uint(f); return (u + 0x7FFFu + ((u >> 16) & 1u)) >> 16; }
DEV unsigned pk2(float lo, float hi) { return f2bf(lo) | (f2bf(hi) << 16); }
template <int CTRL> DEV float dppf(float v) { return __builtin_bit_cast(float, __builtin_amdgcn_update_dpp(0, __builtin_bit_cast(int, v), CTRL, 0xF, 0xF, true)); }
template <int CTRL> DEV int dppi(int v) { return __builtin_amdgcn_update_dpp(0, v, CTRL, 0xF, 0xF, true); }
DEV float rlf(float v, int l) { return __builtin_bit_cast(float, __builtin_amdgcn_readlane(__builtin_bit_cast(int, v), l)); }
DEV int rli(int v, int l) { return __builtin_amdgcn_readlane(v, l); }
DEV float sum8(float v) { v += dppf<0xB1>(v); v += dppf<0x4E>(v); v += dppf<0x141>(v); return v; }
DEV float max8(float v) { v = fmaxf(v, dppf<0xB1>(v)); v = fmaxf(v, dppf<0x4E>(v)); v = fmaxf(v, dppf<0x141>(v)); return v; }
DEV int min8(int v) { v = min(v, dppi<0xB1>(v)); v = min(v, dppi<0x4E>(v)); v = min(v, dppi<0x141>(v)); return v; }
DEV float xor16_sum(float v) { const auto r = __builtin_amdgcn_permlane16_swap(__builtin_bit_cast(unsigned, v), __builtin_bit_cast(unsigned, v), false, false); return __builtin_bit_cast(float, r[0]) + __builtin_bit_cast(float, r[1]); }
DEV float xor32_sum(float v) { const auto r = __builtin_amdgcn_permlane32_swap(__builtin_bit_cast(unsigned, v), __builtin_bit_cast(unsigned, v), false, false); return __builtin_bit_cast(float, r[0]) + __builtin_bit_cast(float, r[1]); }
DEV float xor32_max(float v) { const auto r = __builtin_amdgcn_permlane32_swap(__builtin_bit_cast(unsigned, v), __builtin_bit_cast(unsigned, v), false, false); return fmaxf(__builtin_bit_cast(float, r[0]), __builtin_bit_cast(float, r[1])); }
DEV float wave_sum(float v) {
    v = sum8(v); v += dppf<0x140>(v);
    return (rlf(v, 0) + rlf(v, 16)) + (rlf(v, 32) + rlf(v, 48));
}
DEV float siluf(float x) { return x * __builtin_amdgcn_rcpf(1.f + __expf(-x)); }
DEV float sigmoidf_(float x) { return __builtin_amdgcn_rcpf(1.f + __expf(-x)); }
DEV float softplusf(float x) { return fmaxf(x, 0.f) + log1pf(__expf(-fabsf(x))); }
#define LDS_WAIT() asm volatile("s_waitcnt lgkmcnt(0)" ::: "memory")
#define VM_WAIT() asm volatile("s_waitcnt vmcnt(0)" ::: "memory")

#define XB_TMO      128
#define XB_XCNT(j)  (256  + 64 * (j))
#define XB_XSUB(j)  (1280 + 64 * (j))
#define XB_XGEN(j)  (2304 + 64 * (j))
#define XB_TOP      3328
#define XB_TOPGEN   3392
#define XCD_BAR_WORDS 3456
#define XB_SPIN_CAP (1u << 18)
#define LAS __attribute__((address_space(3)))

__device__ __forceinline__ unsigned xb_ld(unsigned* p)              { return __hip_atomic_load(p, __ATOMIC_RELAXED, __HIP_MEMORY_SCOPE_AGENT); }
__device__ __forceinline__ unsigned xb_add(unsigned* p, unsigned v) { return __hip_atomic_fetch_add(p, v, __ATOMIC_RELAXED, __HIP_MEMORY_SCOPE_AGENT); }
__device__ __forceinline__ unsigned xb_xcc_id() { return (unsigned)__builtin_amdgcn_s_getreg((3 << 11) | 20) & 0xFu; }
#define XB_SPIN(cond, bar) do { unsigned _sp = 0; while (cond) { __builtin_amdgcn_s_sleep(1); \
    if ((++_sp & 255u) == 0u) { if (xb_ld(&(bar)[XB_TMO])) break; if (_sp > XB_SPIN_CAP) { atomicAdd(&(bar)[XB_TMO], 1u); break; } } } } while (0)

struct XcdBarrier {
    unsigned* bar; unsigned x;
    volatile LAS unsigned* st;
};

__device__ __forceinline__ XcdBarrier xcd_barrier_post(unsigned* bar, volatile LAS unsigned* st) {
    XcdBarrier b; b.bar = bar; b.x = xb_xcc_id(); b.st = st;
    if (threadIdx.x == 0) (void)xb_add(&bar[XB_XCNT(b.x)], 1u);
    return b;
}
__device__ __forceinline__ void xcd_barrier_complete(unsigned* bar, unsigned x, unsigned& nloc, unsigned& nx) {
    const unsigned G = gridDim.x * gridDim.y * gridDim.z;
    unsigned sum, cnt, mine, sp = 0u;
    for (;;) {
        sum = 0u; cnt = 0u; mine = 0u;
#pragma unroll
        for (unsigned j = 0; j < 16; ++j) { const unsigned c = xb_ld(&bar[XB_XCNT(j)]); sum += c; cnt += (c > 0u) ? 1u : 0u; mine = (j == x) ? c : mine; }
        if (sum == G) break;
        __builtin_amdgcn_s_sleep(1);
        if ((++sp & 255u) == 0u) { if (xb_ld(&bar[XB_TMO])) break; if (sp > XB_SPIN_CAP) { atomicAdd(&bar[XB_TMO], 1u); break; } }
    }
    nloc = mine > 0u ? mine : 1u; nx = cnt > 0u ? cnt : 1u;
}

__device__ __forceinline__ void xcd_barrier(const XcdBarrier& b) {
    asm volatile("s_waitcnt vmcnt(0)" ::: "memory");
    __syncthreads();
    if (threadIdx.x == 0) {
        unsigned* bar = b.bar;
        __builtin_amdgcn_s_waitcnt(0);
        unsigned nloc = b.st[0], nx = b.st[1];
        if (nloc == 0u) { xcd_barrier_complete(bar, b.x, nloc, nx); b.st[0] = nloc; b.st[1] = nx; }
        const unsigned old = xb_add(&bar[XB_XSUB(b.x)], 1u);
        const unsigned gen = old / nloc;
        if (old + 1u == (gen + 1u) * nloc) {
            __builtin_amdgcn_fence(__ATOMIC_RELEASE, "agent");
            asm volatile("s_waitcnt vmcnt(0)" ::: "memory");
            const unsigned og = xb_add(&bar[XB_TOP], 1u);
            const unsigned tg = og / nx;
            if (og + 1u == (tg + 1u) * nx) xb_add(&bar[XB_TOPGEN], 1u);
            else XB_SPIN(xb_ld(&bar[XB_TOPGEN]) == tg, bar);
            __builtin_amdgcn_fence(__ATOMIC_ACQUIRE, "agent");
            xb_add(&bar[XB_XGEN(b.x)], 1u);
            asm volatile("s_waitcnt vmcnt(0)" ::: "memory");
        } else {
            XB_SPIN(xb_ld(&bar[XB_XGEN(b.x)]) == gen, bar);
            __builtin_amdgcn_fence(__ATOMIC_ACQUIRE, "agent");
            asm volatile("s_waitcnt vmcnt(0)" ::: "memory");
        }
    }
    __syncthreads();
}


DEV void group_barrier(unsigned* ctr, const unsigned n) {
    asm volatile("s_waitcnt vmcnt(0)" ::: "memory");
    __syncthreads();
    if (threadIdx.x == 0) {
        __builtin_amdgcn_fence(__ATOMIC_RELEASE, "agent");
        asm volatile("s_waitcnt vmcnt(0)" ::: "memory");
        (void)__hip_atomic_fetch_add(ctr, 1u, __ATOMIC_RELAXED, __HIP_MEMORY_SCOPE_AGENT);
        unsigned sp = 0;
        while (__hip_atomic_load(ctr, __ATOMIC_RELAXED, __HIP_MEMORY_SCOPE_AGENT) < n) { __builtin_amdgcn_s_sleep(2); if (++sp > (1u << 22)) break; }
        __builtin_amdgcn_fence(__ATOMIC_ACQUIRE, "agent");
        asm volatile("s_waitcnt vmcnt(0)" ::: "memory");
    }
    __syncthreads();
}

namespace pg8 {
constexpr int BM = 256, BK = 64, HALF = 128, HTB = HALF * BK * 2, STAGE_BYTES = 8 * HTB, NXCD = 8, WGM = 8;
DEV int lds_byte(int r, int c) { const int st = (r >> 4) * 2 + (c >> 5), rr = r & 15, cc = c & 31, ob = rr * 64 + cc * 2; return st * 1024 + (ob ^ (((ob >> 9) & 1) << 5)); }
DEV void stage_rc(int b, int& R, int& C) { const int st = b / 1024, sb = b % 1024, swz = sb ^ (((sb >> 9) & 1) << 5); R = (st >> 1) * 16 + swz / 64; C = (st & 1) * 32 + (swz % 64) / 2; }
DEV int perm32(int rho) { const int n = rho >> 4, i = rho & 15; return 8 * (i >> 2) + 4 * n + (i & 3); }
struct Unit { int pm, pn, e, slot; };
struct StaticOrder {
    int nM, nN, nwg, G, c;
    DEV void init(int M, int N, int G_, int c_) { nM = M / BM; nN = N / BM; nwg = nM * nN; G = G_; c = c_; }
    DEV bool next(int i, int& pm, int& pn) const {
        const long L = (long)i * G + c; if (L >= nwg) return false;
        int wgid = (int)L; { const int q = nwg / NXCD, r = nwg % NXCD, xcd = wgid % NXCD, off = wgid / NXCD; wgid = (xcd < r ? xcd * (q + 1) : r * (q + 1) + (xcd - r) * q) + off; }
        const int nig = WGM * nN, gid = wgid / nig, fm = gid * WGM, gsz = (nM - fm) < WGM ? (nM - fm) : WGM;
        pm = fm + ((wgid % nig) % gsz); pn = (wgid % nig) / gsz; return true;
    }
};
typedef __bf16 bf16x2_t __attribute__((ext_vector_type(2)));
DEV unsigned cvt_pk_bf16(float lo, float hi) { const bf16x2_t v = {(__bf16)lo, (__bf16)hi}; return __builtin_bit_cast(unsigned, v); }
DEV u32x4 pack8(const f32x4 a, const f32x4 b) { u32x4 w; w.x = cvt_pk_bf16(a[0], a[1]); w.y = cvt_pk_bf16(a[2], a[3]); w.z = cvt_pk_bf16(b[0], b[1]); w.w = cvt_pk_bf16(b[2], b[3]); return w; }

typedef int v8i_t __attribute__((ext_vector_type(8)));
template <class Epi, class Sched, bool F8 = false>
DEV void gemm_phase(LAS unsigned char* lds, const int K, const Sched& S, const Epi& E) {
    const int tid = threadIdx.x, wid = __builtin_amdgcn_readfirstlane(tid >> 6), lane = tid & 63, wr = wid >> 2, wc = wid & 3, fr = lane & 15, fq = lane >> 4;
    const int nt = F8 ? K / 128 : K / BK;
    const int pitch = F8 ? K : 2 * K;
    unsigned voffB[2];
#pragma unroll
    for (int i = 0; i < 2; ++i) { int R, C; stage_rc(tid * 16 + i * 8192, R, C); const int Rb = Epi::PERM ? ((R & ~31) + perm32(R & 31)) : R; voffB[i] = (unsigned)(Rb * pitch + 2 * C); }
    const unsigned kstep = (unsigned)(BK * 2);
    const size_t hstep = (size_t)HALF * pitch;
    const unsigned ldsw = (unsigned)wid * 1024u;
    const int aoff = lds_byte(wr * 64 + fr, fq * 8), boff = lds_byte(wc * 32 + fr, fq * 8);
    const size_t hsA = Sched::GATHER ? (size_t)0 : hstep;
#define PG8_SA(b, h) (((b) * 2 + (h)) * HTB)
#define PG8_SB(b, h) ((4 + (b) * 2 + (h)) * HTB)
#define PG8_STAGEB(bufoff, gbase) do { _Pragma("unroll") for (int _i = 0; _i < 2; ++_i) \
        __builtin_amdgcn_global_load_lds((const unsigned*)((const char*)(gbase) + voffB[_i]), (LAS unsigned*)(lds + (bufoff) + ldsw + _i * 8192), 16, 0, 0); } while (0)
#define PG8_STAGEA(bufoff, gbase, VO) do { _Pragma("unroll") for (int _i = 0; _i < 2; ++_i) \
        __builtin_amdgcn_global_load_lds((const unsigned*)((const char*)(gbase) + (VO)[_i]), (LAS unsigned*)(lds + (bufoff) + ldsw + _i * 8192), 16, 0, 0); } while (0)
#define PG8_LD8(var, base) do { const u32x4 _l0 = *(const LAS u32x4*)(lds + (base)), _l1 = *(const LAS u32x4*)(lds + (base) + 1024); var = __builtin_shufflevector(_l0, _l1, 0, 1, 2, 3, 4, 5, 6, 7); } while (0)
#define PG8_LDA(dst, b, h) do { if constexpr (F8) { PG8_LD8(dst##8_0, PG8_SA(b, h) + aoff); PG8_LD8(dst##8_1, PG8_SA(b, h) + aoff + 2048); PG8_LD8(dst##8_2, PG8_SA(b, h) + aoff + 4096); PG8_LD8(dst##8_3, PG8_SA(b, h) + aoff + 6144); } \
        else { _Pragma("unroll") for (int m = 0; m < 4; ++m) _Pragma("unroll") for (int k = 0; k < 2; ++k) dst[m][k] = *(const LAS bf16x8*)(lds + PG8_SA(b, h) + aoff + m * 2048 + k * 1024); } } while (0)
#define PG8_LDB(dst, b, h) do { if constexpr (F8) { PG8_LD8(dst##8_0, PG8_SB(b, h) + boff); PG8_LD8(dst##8_1, PG8_SB(b, h) + boff + 2048); } \
        else { _Pragma("unroll") for (int n = 0; n < 2; ++n) _Pragma("unroll") for (int k = 0; k < 2; ++k) dst[n][k] = *(const LAS bf16x8*)(lds + PG8_SB(b, h) + boff + n * 2048 + k * 1024); } } while (0)
#define PG8_M8(ai, bj, m, n, A8, B8) asm volatile("v_mfma_scale_f32_16x16x128_f8f6f4 %0, %1, %2, %0, %3, %4 op_sel_hi:[0,0,0]" : "+v"(acc[ai][bj][m][n]) : "v"(B8), "v"(A8), "v"(wsc_), "v"(asc_))
#define PG8_M8Z(ai, bj, m, n, A8, B8) asm volatile("v_mfma_scale_f32_16x16x128_f8f6f4 %0, %1, %2, %0, %3, %4 op_sel_hi:[0,0,0]" : "+v"(acc[ai][bj][m][n]) : "v"(B8), "v"(A8), "v"(zsc_), "v"(zsc_))
#define PG8_MMA(ai, bj, At, Bt) do { __builtin_amdgcn_s_setprio(1); \
        if constexpr (F8) { PG8_M8(ai, bj, 0, 0, At##8_0, Bt##8_0); PG8_M8(ai, bj, 0, 1, At##8_0, Bt##8_1); PG8_M8(ai, bj, 1, 0, At##8_1, Bt##8_0); PG8_M8(ai, bj, 1, 1, At##8_1, Bt##8_1); \
                            PG8_M8(ai, bj, 2, 0, At##8_2, Bt##8_0); PG8_M8(ai, bj, 2, 1, At##8_2, Bt##8_1); PG8_M8(ai, bj, 3, 0, At##8_3, Bt##8_0); PG8_M8(ai, bj, 3, 1, At##8_3, Bt##8_1); \
            if constexpr (((PROBE_MASK >> 26) & 1u) != 0u) { PG8_M8Z(ai, bj, 0, 0, At##8_0, Bt##8_0); PG8_M8Z(ai, bj, 0, 1, At##8_0, Bt##8_1); PG8_M8Z(ai, bj, 1, 0, At##8_1, Bt##8_0); PG8_M8Z(ai, bj, 1, 1, At##8_1, Bt##8_1); \
                            PG8_M8Z(ai, bj, 2, 0, At##8_2, Bt##8_0); PG8_M8Z(ai, bj, 2, 1, At##8_2, Bt##8_1); PG8_M8Z(ai, bj, 3, 0, At##8_3, Bt##8_0); PG8_M8Z(ai, bj, 3, 1, At##8_3, Bt##8_1); } } \
        else { _Pragma("unroll") for (int m = 0; m < 4; ++m) _Pragma("unroll") for (int n = 0; n < 2; ++n) _Pragma("unroll") for (int k = 0; k < 2; ++k) acc[ai][bj][m][n] = __builtin_amdgcn_mfma_f32_16x16x32_bf16(Bt[n][k], At[m][k], acc[ai][bj][m][n], 0, 0, 0); } \
        __builtin_amdgcn_s_setprio(0); } while (0)
#define PG8_WAIT_V(n) asm volatile("s_waitcnt vmcnt(" #n ")" ::: "memory")
#define PG8_WAIT_L(n) asm volatile("s_waitcnt lgkmcnt(" #n ")" ::: "memory")
#define PG8_BAR __builtin_amdgcn_s_barrier()
#define PG8_SCHED __builtin_amdgcn_sched_barrier(0)
    Unit cur, nxt; int ui = 0;
    if (!S.next(0, cur)) return;
    f32x4 acc[2][2][4][2];
#pragma unroll
    for (int a = 0; a < 2; ++a)
#pragma unroll
        for (int b = 0; b < 2; ++b)
#pragma unroll
            for (int m = 0; m < 4; ++m)
#pragma unroll
                for (int n = 0; n < 2; ++n) acc[a][b][m][n] = (f32x4){0.f, 0.f, 0.f, 0.f};
    bf16x8 At[4][2], B0[2][2], B1[2][2];
    typedef unsigned u32x8_t __attribute__((ext_vector_type(8)));
    u32x8_t At8_0, At8_1, At8_2, At8_3, B08_0, B08_1, B18_0, B18_1;
    int zsc_ = 0; asm volatile("" : "+v"(zsc_));
    const int wsc_ = Sched::WSCALE, asc_ = Sched::ASCALE;
    unsigned va[2][2];
    S.a_voff(cur, tid, va);
    const char* cA = S.a_ptr(cur);
    const char* cB = S.b_ptr(cur);
    PG8_STAGEB(PG8_SB(0, 0), cB); PG8_STAGEB(PG8_SB(0, 1), cB + hstep); PG8_STAGEA(PG8_SA(0, 0), cA, va[0]); PG8_STAGEA(PG8_SA(0, 1), cA + hsA, va[1]);
    if (wr == 1) PG8_BAR;
    PG8_WAIT_V(2); PG8_BAR;
    PG8_STAGEB(PG8_SB(1, 0), cB + kstep); PG8_STAGEA(PG8_SA(1, 0), cA + kstep, va[0]); PG8_STAGEB(PG8_SB(1, 1), cB + hstep + kstep);
    PG8_WAIT_V(6); PG8_BAR;
    for (;;) {
        const bool has_next = S.next(ui + 1, nxt);
        const char* nB = has_next ? S.b_ptr(nxt) : cB;
        const char* nA = has_next ? S.a_ptr(nxt) : cA;
        for (int t = 0; t < nt; t += 2) {
            const bool last = (t == nt - 2);
            const char* a1 = cA + (size_t)(t + 1) * kstep;
            const char* a2 = last ? nA : cA + (size_t)(t + 2) * kstep; const char* a3 = a2 + kstep;
            unsigned v2[2][2];
            v2[0][0] = va[0][0]; v2[0][1] = va[0][1]; v2[1][0] = va[1][0]; v2[1][1] = va[1][1];
            if constexpr (Sched::GATHER) { if (last && has_next) S.a_voff(nxt, tid, v2); }
            const char* b2 = last ? nB : cB + (size_t)(t + 2) * kstep; const char* b3 = b2 + kstep;
            PG8_LDB(B0, 0, 0); PG8_LDB(B1, 0, 1); PG8_SCHED; PG8_LDA(At, 0, 0); PG8_STAGEA(PG8_SA(1, 1), a1 + hsA, va[1]);
            PG8_WAIT_V(8); PG8_WAIT_L(0); PG8_BAR; PG8_MMA(0, 0, At, B0); PG8_MMA(0, 1, At, B1); PG8_BAR; PG8_SCHED;
            PG8_LDA(At, 0, 1); PG8_STAGEB(PG8_SB(0, 0), b2); PG8_STAGEB(PG8_SB(0, 1), b2 + hstep); PG8_STAGEA(PG8_SA(0, 0), a2, v2[0]);
            PG8_WAIT_V(8); PG8_WAIT_L(0); PG8_BAR; PG8_MMA(1, 0, At, B0); PG8_MMA(1, 1, At, B1); PG8_BAR; PG8_SCHED;
            PG8_LDB(B0, 1, 0); PG8_LDB(B1, 1, 1); PG8_SCHED; PG8_LDA(At, 1, 0); PG8_STAGEA(PG8_SA(0, 1), a2 + hsA, v2[1]);
            PG8_WAIT_V(8); PG8_WAIT_L(0); PG8_BAR; PG8_MMA(0, 0, At, B0); PG8_MMA(0, 1, At, B1); PG8_BAR; PG8_SCHED;
            PG8_LDA(At, 1, 1); PG8_STAGEB(PG8_SB(1, 0), b3); PG8_STAGEB(PG8_SB(1, 1), b3 + hstep); PG8_STAGEA(PG8_SA(1, 0), a3, v2[0]);
            PG8_WAIT_V(8); PG8_WAIT_L(0); PG8_BAR; PG8_MMA(1, 0, At, B0); PG8_MMA(1, 1, At, B1); PG8_BAR; PG8_SCHED;
        }
        if (wr == 0) PG8_BAR;
        if constexpr (F8) asm volatile("s_nop 15\n\ts_nop 15" ::: "memory");
        E(acc, cur, wr, wc, fr, fq);
        if constexpr (((PROBE_MASK >> 27) & 1u) != 0u) { asm volatile("" ::: "memory"); E(acc, cur, wr, wc, fr, fq); }
        if (!has_next) break;
#pragma unroll
        for (int a = 0; a < 2; ++a)
#pragma unroll
            for (int b = 0; b < 2; ++b)
#pragma unroll
                for (int m = 0; m < 4; ++m)
#pragma unroll
                    for (int n = 0; n < 2; ++n) acc[a][b][m][n] = (f32x4){0.f, 0.f, 0.f, 0.f};
        cur = nxt; cB = nB; cA = nA; ++ui;
        if constexpr (Sched::GATHER) S.a_voff(cur, tid, va);
        if (wr == 1) PG8_BAR;
    }
    PG8_WAIT_V(0);
    PG8_BAR;
#undef PG8_SA
#undef PG8_SB
#undef PG8_STAGEA
#undef PG8_STAGEB
#undef PG8_LDA
#undef PG8_LD8
#undef PG8_M8
#undef PG8_LDB
#undef PG8_MMA
#undef PG8_WAIT_V
#undef PG8_WAIT_L
#undef PG8_BAR
#undef PG8_SCHED
}

struct SchedDense {
    static constexpr bool GATHER = false; static constexpr int WSCALE = 0x7F7F7F7F, ASCALE = 0x7F7F7F7F;
    StaticOrder so; const char* A; const char* Bt; int K; int pad_;
    DEV bool next(int i, Unit& u) const { int pm, pn; if (!so.next(i, pm, pn)) return false; u.pm = pm; u.pn = pn; u.e = 0; u.slot = 0; return true; }
    DEV const char* a_ptr(const Unit& u) const { return A + (size_t)u.pm * 256 * K * 2; }
    DEV void a_voff(const Unit&, const int tid, unsigned (&vo)[2][2]) const {
#pragma unroll
        for (int i = 0; i < 2; ++i) { int R, C; stage_rc(tid * 16 + i * 8192, R, C); vo[0][i] = vo[1][i] = (unsigned)((R * K + C) * 2); }
    }
    DEV const char* b_ptr(const Unit& u) const { return Bt + (size_t)u.pn * 256 * K * 2; }
};
template <int WS_, int AS_> struct SchedDense8 {
    static constexpr bool GATHER = false; static constexpr int WSCALE = WS_, ASCALE = AS_;
    StaticOrder so; const char* A; const char* Bt; int K; int pad_;
    DEV bool next(int i, Unit& u) const { int pm, pn; if (!so.next(i, pm, pn)) return false; u.pm = pm; u.pn = pn; u.e = 0; u.slot = 0; return true; }
    DEV const char* a_ptr(const Unit& u) const { return A + (size_t)u.pm * 256 * K; }
    DEV void a_voff(const Unit&, const int tid, unsigned (&vo)[2][2]) const {
#pragma unroll
        for (int i = 0; i < 2; ++i) { int R, C; stage_rc(tid * 16 + i * 8192, R, C); vo[0][i] = vo[1][i] = (unsigned)(R * K + 2 * C); }
    }
    DEV const char* b_ptr(const Unit& u) const { return Bt + (size_t)u.pn * 256 * K; }
};
DEV bool moe_unit(int i, int NJ, int nrbt, int G, int c, Unit& u) {
    const int n = (nrbt + 64) * NJ; int L;
    if (G & 7) { L = i * G + c; if (L >= n) return false; }
    else { const int gq = G >> 3, per = (n + 7) >> 3, x = c & 7, q = c >> 3, j = i * gq + q; if (j >= per) return false; L = x * per + j; if (L >= n) return false; }
    int grb = L / NJ; const int pn = L - grb * NJ; if (grb >= nrbt) grb = SH_RB + (grb - nrbt);
    u.pm = grb; u.pn = pn; u.slot = i; u.e = 0; return true;
}
struct SchedGU {
    static constexpr bool GATHER = true; static constexpr int WSCALE = 0x79797979, ASCALE = 0x7F7F7F7F;
    const char* A; const char* Wgu; const char* Wgus; const LAS int* eofrb; const LAS int* toks; int nrbt, G, c, pad_;
    DEV bool next(int i, Unit& u) const { if (!moe_unit(i, 2, nrbt, G, c, u)) return false; u.e = __builtin_amdgcn_readfirstlane(eofrb[u.pm]); return true; }
    DEV const char* a_ptr(const Unit&) const { return A; }
    DEV void a_voff(const Unit& u, const int tid, unsigned (&vo)[2][2]) const {
#pragma unroll
        for (int i = 0; i < 2; ++i) { int R, C; stage_rc(tid * 16 + i * 8192, R, C);
#pragma unroll
            for (int h = 0; h < 2; ++h) { const int tok = toks[u.slot * 256 + h * 128 + R]; vo[h][i] = (unsigned)(tok * D + 2 * C); } }
    }
    DEV const char* b_ptr(const Unit& u) const { return (u.e < NE ? Wgu + (size_t)u.e * 512 * D : Wgus) + (size_t)u.pn * 256 * D; }
};
struct SchedDown {
    static constexpr bool GATHER = false; static constexpr int WSCALE = 0x7A7A7A7A, ASCALE = 0x7F7F7F7F;
    const char* A; const char* Wd; const char* Wds; const LAS int* eofrb; int nrbt, G, c, pad_;
    DEV bool next(int i, Unit& u) const { if (!moe_unit(i, 4, nrbt, G, c, u)) return false; u.e = __builtin_amdgcn_readfirstlane(eofrb[u.pm]); return true; }
    DEV const char* a_ptr(const Unit& u) const { return A + (size_t)u.pm * 256 * ED; }
    DEV void a_voff(const Unit&, const int tid, unsigned (&vo)[2][2]) const {
#pragma unroll
        for (int i = 0; i < 2; ++i) { int R, C; stage_rc(tid * 16 + i * 8192, R, C); vo[0][i] = vo[1][i] = (unsigned)(R * ED + 2 * C); }
    }
    DEV const char* b_ptr(const Unit& u) const { return (u.e < NE ? Wd + (size_t)u.e * D * ED : Wds) + (size_t)u.pn * 256 * ED; }
};

struct EpiProj {
    static constexpr bool PERM = true;
    bf16_t* qkv; bf16_t* za; bf16_t* xbc; bf16_t* zb; float* small;
    DEV void operator()(const f32x4 (&acc)[2][2][4][2], const Unit& u, int wr, int wc, int fr, int fq) const {
        const int row0 = u.pm * BM + wr * 64 + fr, pn = u.pn;
        if (pn == 26) {
            if (wc == 0) {
#pragma unroll
                for (int ai = 0; ai < 2; ++ai)
#pragma unroll
                    for (int m = 0; m < 4; ++m) { float* p = small + (size_t)(row0 + ai * HALF + m * 16) * 32 + 8 * fq; *(f32x4*)p = acc[ai][0][m][0]; *(f32x4*)(p + 4) = acc[ai][0][m][1]; }
            }
            return;
        }
        bf16_t* base; int ldc, ct;
        if (pn < 12) { base = qkv; ldc = 3072; ct = pn; } else if (pn < 16) { base = za; ldc = 1024; ct = pn - 12; } else if (pn < 22) { base = xbc; ldc = 1536; ct = pn - 16; } else { base = zb; ldc = 1024; ct = pn - 22; }
        const int col0 = ct * 256 + wc * 32 + 8 * fq;
#pragma unroll
        for (int ai = 0; ai < 2; ++ai)
#pragma unroll
            for (int m = 0; m < 4; ++m) { bf16_t* rowp = base + (size_t)(row0 + ai * HALF + m * 16) * ldc + col0;
#pragma unroll
                for (int bj = 0; bj < 2; ++bj) *(u32x4*)(rowp + bj * HALF) = pack8(acc[ai][bj][m][0], acc[ai][bj][m][1]); }
    }
};
struct EpiF32 {
    static constexpr bool PERM = false;
    float* Cp; int ldc; int pad_;
    DEV void operator()(const f32x4 (&acc)[2][2][4][2], const Unit& u, int wr, int wc, int fr, int fq) const {
        const int row0 = u.pm * BM + wr * 64 + fr, col0 = u.pn * BM + wc * 32 + 4 * fq;
#pragma unroll
        for (int ai = 0; ai < 2; ++ai)
#pragma unroll
            for (int m = 0; m < 4; ++m) { float* rowp = Cp + (size_t)(row0 + ai * HALF + m * 16) * ldc + col0;
#pragma unroll
                for (int bj = 0; bj < 2; ++bj)
#pragma unroll
                    for (int n = 0; n < 2; ++n) *(f32x4*)(rowp + bj * HALF + n * 16) = acc[ai][bj][m][n]; }
    }
};
struct EpiBf16 {
    static constexpr bool PERM = true;
    bf16_t* O; int ldc; int pad_;
    DEV void operator()(const f32x4 (&acc)[2][2][4][2], const Unit& u, int wr, int wc, int fr, int fq) const {
        const int row0 = u.pm * BM + wr * 64 + fr, col0 = u.pn * BM + wc * 32 + 8 * fq;
#pragma unroll
        for (int ai = 0; ai < 2; ++ai)
#pragma unroll
            for (int m = 0; m < 4; ++m) { bf16_t* rowp = O + (size_t)(row0 + ai * HALF + m * 16) * ldc + col0;
#pragma unroll
                for (int bj = 0; bj < 2; ++bj) *(u32x4*)(rowp + bj * HALF) = pack8(acc[ai][bj][m][0], acc[ai][bj][m][1]); }
    }
};
DEV u32x2 pack8_fp8(const f32x4 a, const f32x4 b) {
    f32x4 x = a, y = b;
#pragma unroll
    for (int i = 0; i < 4; ++i) { x[i] = fminf(fmaxf(x[i], -440.f), 440.f); y[i] = fminf(fmaxf(y[i], -440.f), 440.f); }
    int w0 = __builtin_amdgcn_cvt_pk_fp8_f32(x[0], x[1], 0, false); w0 = __builtin_amdgcn_cvt_pk_fp8_f32(x[2], x[3], w0, true);
    int w1 = __builtin_amdgcn_cvt_pk_fp8_f32(y[0], y[1], 0, false); w1 = __builtin_amdgcn_cvt_pk_fp8_f32(y[2], y[3], w1, true);
    return (u32x2){(unsigned)w0, (unsigned)w1};
}
struct EpiFp8 {
    static constexpr bool PERM = true;
    unsigned char* O; int ldc; int pad_;
    DEV void operator()(const f32x4 (&acc)[2][2][4][2], const Unit& u, int wr, int wc, int fr, int fq) const {
        const int row0 = u.pm * BM + wr * 64 + fr, col0 = u.pn * BM + wc * 32 + 8 * fq;
#pragma unroll
        for (int ai = 0; ai < 2; ++ai)
#pragma unroll
            for (int m = 0; m < 4; ++m) { unsigned char* rowp = O + (size_t)(row0 + ai * HALF + m * 16) * ldc + col0;
#pragma unroll
                for (int bj = 0; bj < 2; ++bj) { f32x4 a0 = acc[ai][bj][m][0] * 8.f, a1 = acc[ai][bj][m][1] * 8.f;
#pragma unroll
                    for (int i = 0; i < 4; ++i) { a0[i] = fminf(fmaxf(a0[i], -440.f), 440.f); a1[i] = fminf(fmaxf(a1[i], -440.f), 440.f); }
                    int w0 = __builtin_amdgcn_cvt_pk_fp8_f32(a0[0], a0[1], 0, false); w0 = __builtin_amdgcn_cvt_pk_fp8_f32(a0[2], a0[3], w0, true);
                    int w1 = __builtin_amdgcn_cvt_pk_fp8_f32(a1[0], a1[1], 0, false); w1 = __builtin_amdgcn_cvt_pk_fp8_f32(a1[2], a1[3], w1, true);
                    *(u32x2*)(rowp + bj * HALF) = (u32x2){(unsigned)w0, (unsigned)w1}; } }
    }
};
struct EpiGU {
    static constexpr bool PERM = true;
    unsigned char* H;
    DEV void operator()(const f32x4 (&acc)[2][2][4][2], const Unit& u, int wr, int wc, int fr, int fq) const {
        const int row0 = u.pm * BM + wr * 64 + fr, col0 = u.pn * HALF + wc * 32 + 8 * fq;
#pragma unroll
        for (int ai = 0; ai < 2; ++ai)
#pragma unroll
            for (int m = 0; m < 4; ++m) {
                f32x4 h0, h1;
#pragma unroll
                for (int i = 0; i < 4; ++i) { h0[i] = siluf(acc[ai][0][m][0][i]) * acc[ai][1][m][0][i]; h1[i] = siluf(acc[ai][0][m][1][i]) * acc[ai][1][m][1][i]; }
                *(u32x2*)(H + (size_t)(row0 + ai * HALF + m * 16) * ED + col0) = pack8_fp8(h0, h1);
            }
    }
};
struct EpiQKV {
    static constexpr bool PERM = true;
    bf16_t* O; const float* cosT; const float* sinT;
    DEV void operator()(const f32x4 (&acc)[2][2][4][2], const Unit& u, int wr, int wc, int fr, int fq) const {
        const int row0 = u.pm * BM + wr * 64 + fr, col0 = u.pn * BM + wc * 32 + 8 * fq;
        const bool rope = u.pn < 8; const float qs = u.pn < 4 ? 0.125f : 1.f;
#pragma unroll
        for (int ai = 0; ai < 2; ++ai)
#pragma unroll
            for (int m = 0; m < 4; ++m) {
                const int row = row0 + ai * HALF + m * 16;
                bf16_t* rowp = O + (size_t)row * 3072 + col0;
                if (rope) {
                    const f32x4 cs = *(const f32x4*)(cosT + (size_t)row * 32 + 16 * (wc & 1) + 4 * fq), sn = *(const f32x4*)(sinT + (size_t)row * 32 + 16 * (wc & 1) + 4 * fq);
#pragma unroll
                    for (int bj = 0; bj < 2; ++bj) { const f32x4 x1 = acc[ai][bj][m][0], x2 = acc[ai][bj][m][1];
                        *(u32x4*)(rowp + bj * HALF) = pack8((x1 * cs - x2 * sn) * qs, (x2 * cs + x1 * sn) * qs); }
                } else {
#pragma unroll
                    for (int bj = 0; bj < 2; ++bj) *(u32x4*)(rowp + bj * HALF) = pack8(acc[ai][bj][m][0], acc[ai][bj][m][1]);
                }
            }
    }
};
}

template <class SrcF, bool OUT8 = false>
DEV void conv_item(const SrcF& src, int ldw, int K, void* dstv, LAS float* scr, int item, int nblk, int lane, const float wscale = 1.f) {
    const int kb = item / nblk, nb = item - kb * nblk, k0 = 64 * kb, n0 = 32 * nb;
    const int quad = lane & 7, r0 = lane >> 3;
    const float* colp = src(n0 + 4 * quad);
    f32x4 v[8];
#pragma unroll
    for (int i = 0; i < 8; ++i) v[i] = colp ? *(const f32x4*)(colp + (size_t)(k0 + r0 + 8 * i) * ldw) : (f32x4){0.f, 0.f, 0.f, 0.f};
#pragma unroll
    for (int i = 0; i < 8; ++i) { LAS float* p = scr + (r0 + 8 * i) * 33 + 4 * quad; p[0] = v[i][0]; p[1] = v[i][1]; p[2] = v[i][2]; p[3] = v[i][3]; }
    LDS_WAIT(); asm volatile("" ::: "memory");
    const int c = lane & 7;
#pragma unroll
    for (int j = 0; j < 4; ++j) { const int n = (lane >> 3) + 8 * j; const LAS float* s = scr + (8 * c) * 33 + n;
        if constexpr (OUT8) {
            int w0 = __builtin_amdgcn_cvt_pk_fp8_f32(s[0 * 33] * wscale, s[1 * 33] * wscale, 0, false); w0 = __builtin_amdgcn_cvt_pk_fp8_f32(s[2 * 33] * wscale, s[3 * 33] * wscale, w0, true);
            int w1 = __builtin_amdgcn_cvt_pk_fp8_f32(s[4 * 33] * wscale, s[5 * 33] * wscale, 0, false); w1 = __builtin_amdgcn_cvt_pk_fp8_f32(s[6 * 33] * wscale, s[7 * 33] * wscale, w1, true);
            *(u32x2*)((unsigned char*)dstv + (size_t)(n0 + n) * K + k0 + 8 * c) = (u32x2){(unsigned)w0, (unsigned)w1};
        } else {
            u32x4 o; o.x = pk2(s[0 * 33], s[1 * 33]); o.y = pk2(s[2 * 33], s[3 * 33]); o.z = pk2(s[4 * 33], s[5 * 33]); o.w = pk2(s[6 * 33], s[7 * 33]);
            *(u32x4*)((bf16_t*)dstv + (size_t)(n0 + n) * K + k0 + 8 * c) = o; } }
    LDS_WAIT(); asm volatile("" ::: "memory");
}
struct SrcIdent { const float* W; DEV const float* operator()(int n) const { return W + n; } };
struct SrcWin { const float* W; DEV const float* operator()(int n) const {
    int s; if (n < 4096) s = n; else if (n < 5632) s = C_XBC + (n - 4096); else if (n < 6656) s = C_ZB + (n - 5632); else if (n < 6672) s = C_BETA + (n - 6656); else if (n < 6688) s = C_DT + (n - 6672); else return nullptr;
    return W + s; } };
struct SrcQKV { const float* W; DEV const float* operator()(int n) const {
    if (n >= 2048) return W + n; const int hd = n >> 6, cp = n & 63; return W + hd * 64 + 32 * ((cp >> 2) & 1) + 16 * (cp >> 5) + 4 * ((cp >> 3) & 3) + (cp & 3); } };
struct SrcGU { const float* Wg; long du; DEV const float* operator()(int r) const { const int j = r >> 8, rr = r & 255; return Wg + (rr < 128 ? 0l : du) + 128 * j + (rr & 127); } };

DEV void load_row(const float* p, int lane, float (&v)[16]) {
#pragma unroll
    for (int j = 0; j < 4; ++j) { const f32x4 t = *(const f32x4*)(p + j * 256 + lane * 4); v[4 * j] = t[0]; v[4 * j + 1] = t[1]; v[4 * j + 2] = t[2]; v[4 * j + 3] = t[3]; }
}
DEV void store_row(float* p, int lane, const float (&v)[16]) {
#pragma unroll
    for (int j = 0; j < 4; ++j) *(f32x4*)(p + j * 256 + lane * 4) = (f32x4){v[4 * j], v[4 * j + 1], v[4 * j + 2], v[4 * j + 3]};
}
DEV float row_rstd(const float (&v)[16]) { float ss = 0.f;
#pragma unroll
    for (int i = 0; i < 16; ++i) ss += v[i] * v[i];
    return rsqrtf(wave_sum(ss) * (1.f / D) + EPS); }
DEV void resid_update(float (&xv)[16], const float (&yv)[16], const float* gpost, const float* gt, int lane) {
    const float r = row_rstd(yv);
#pragma unroll
    for (int j = 0; j < 4; ++j) { const f32x4 g = *(const f32x4*)(gpost + j * 256 + lane * 4), t = *(const f32x4*)(gt + j * 256 + lane * 4);
#pragma unroll
        for (int i = 0; i < 4; ++i) xv[4 * j + i] += t[i] * (yv[4 * j + i] * r * g[i]); }
}
DEV void prenorm_pack(const float (&xv)[16], const float* gpre, const float* sc, const float* sh, int lane, u32x2 (&o)[4]) {
    const float r = row_rstd(xv);
#pragma unroll
    for (int j = 0; j < 4; ++j) { const f32x4 g = *(const f32x4*)(gpre + j * 256 + lane * 4), s = *(const f32x4*)(sc + j * 256 + lane * 4), b = *(const f32x4*)(sh + j * 256 + lane * 4);
        float h[4];
#pragma unroll
        for (int i = 0; i < 4; ++i) h[i] = xv[4 * j + i] * r * g[i] * (1.f + s[i]) + b[i];
        o[j] = (u32x2){pk2(h[0], h[1]), pk2(h[2], h[3])}; }
}

DEV void load_row8(const float* p, int lane, float (&v)[16]) {
#pragma unroll
    for (int j = 0; j < 2; ++j)
#pragma unroll
        for (int hh = 0; hh < 2; ++hh) { const f32x4 t = *(const f32x4*)(p + 512 * j + 8 * lane + 4 * hh); v[8 * j + 4 * hh] = t[0]; v[8 * j + 4 * hh + 1] = t[1]; v[8 * j + 4 * hh + 2] = t[2]; v[8 * j + 4 * hh + 3] = t[3]; }
}
DEV void store_row8(float* p, int lane, const float (&v)[16]) {
#pragma unroll
    for (int j = 0; j < 2; ++j)
#pragma unroll
        for (int hh = 0; hh < 2; ++hh) *(f32x4*)(p + 512 * j + 8 * lane + 4 * hh) = (f32x4){v[8 * j + 4 * hh], v[8 * j + 4 * hh + 1], v[8 * j + 4 * hh + 2], v[8 * j + 4 * hh + 3]};
}
DEV void resid_update8(float (&xv)[16], const float (&yv)[16], const float* gpost, const float* gt, int lane) {
    const float r = row_rstd(yv);
#pragma unroll
    for (int j = 0; j < 2; ++j)
#pragma unroll
        for (int hh = 0; hh < 2; ++hh) { const f32x4 g = *(const f32x4*)(gpost + 512 * j + 8 * lane + 4 * hh), t = *(const f32x4*)(gt + 512 * j + 8 * lane + 4 * hh);
#pragma unroll
            for (int i = 0; i < 4; ++i) xv[8 * j + 4 * hh + i] += t[i] * (yv[8 * j + 4 * hh + i] * r * g[i]); }
}
DEV void prenorm_pack8(const float (&xv)[16], const float* gpre, const float* sc, const float* sh, int lane, u32x4 (&o)[2]) {
    const float r = row_rstd(xv);
#pragma unroll
    for (int j = 0; j < 2; ++j) { float h[8];
#pragma unroll
        for (int hh = 0; hh < 2; ++hh) { const f32x4 g = *(const f32x4*)(gpre + 512 * j + 8 * lane + 4 * hh), s = *(const f32x4*)(sc + 512 * j + 8 * lane + 4 * hh), b = *(const f32x4*)(sh + 512 * j + 8 * lane + 4 * hh);
#pragma unroll
            for (int i = 0; i < 4; ++i) h[4 * hh + i] = xv[8 * j + 4 * hh + i] * r * g[i] * (1.f + s[i]) + b[i]; }
        o[j] = (u32x4){pk2(h[0], h[1]), pk2(h[2], h[3]), pk2(h[4], h[5]), pk2(h[6], h[7])}; }
}
DEV void prenorm_pack8_f8(const float (&xv)[16], const float* gpre, const float* sc, const float* sh, int lane, u32x2 (&o)[2]) {
    const float r = row_rstd(xv);
#pragma unroll
    for (int j = 0; j < 2; ++j) { float h[8];
#pragma unroll
        for (int hh = 0; hh < 2; ++hh) { const f32x4 g = *(const f32x4*)(gpre + 512 * j + 8 * lane + 4 * hh), s = *(const f32x4*)(sc + 512 * j + 8 * lane + 4 * hh), b = *(const f32x4*)(sh + 512 * j + 8 * lane + 4 * hh);
#pragma unroll
            for (int i = 0; i < 4; ++i) h[4 * hh + i] = fminf(fmaxf(xv[8 * j + 4 * hh + i] * r * g[i] * (1.f + s[i]) + b[i], -440.f), 440.f); }
        int w0 = __builtin_amdgcn_cvt_pk_fp8_f32(h[0], h[1], 0, false); w0 = __builtin_amdgcn_cvt_pk_fp8_f32(h[2], h[3], w0, true);
        int w1 = __builtin_amdgcn_cvt_pk_fp8_f32(h[4], h[5], 0, false); w1 = __builtin_amdgcn_cvt_pk_fp8_f32(h[6], h[7], w1, true);
        o[j] = (u32x2){(unsigned)w0, (unsigned)w1}; }
}
DEV void acc_row8(float (&yv)[16], const u32x2 w0, const u32x2 w1, const float g) {
#pragma unroll
    for (int e = 0; e < 2; ++e) {
        yv[4 * e] += g * __builtin_amdgcn_cvt_f32_fp8((int)w0[e], 0); yv[4 * e + 1] += g * __builtin_amdgcn_cvt_f32_fp8((int)w0[e], 1); yv[4 * e + 2] += g * __builtin_amdgcn_cvt_f32_fp8((int)w0[e], 2); yv[4 * e + 3] += g * __builtin_amdgcn_cvt_f32_fp8((int)w0[e], 3);
        yv[8 + 4 * e] += g * __builtin_amdgcn_cvt_f32_fp8((int)w1[e], 0); yv[8 + 4 * e + 1] += g * __builtin_amdgcn_cvt_f32_fp8((int)w1[e], 1); yv[8 + 4 * e + 2] += g * __builtin_amdgcn_cvt_f32_fp8((int)w1[e], 2); yv[8 + 4 * e + 3] += g * __builtin_amdgcn_cvt_f32_fp8((int)w1[e], 3); }
}

DEV void load_row_bf(const bf16_t* p, int lane, float (&v)[16]) {
#pragma unroll
    for (int j = 0; j < 4; ++j) { const u32x2 w = *(const u32x2*)(p + j * 256 + lane * 4); v[4 * j] = __uint_as_float(w.x << 16); v[4 * j + 1] = __uint_as_float(w.x & 0xFFFF0000u); v[4 * j + 2] = __uint_as_float(w.y << 16); v[4 * j + 3] = __uint_as_float(w.y & 0xFFFF0000u); }
}
DEV void store_row_bf(bf16_t* p, int lane, const float (&v)[16]) {
#pragma unroll
    for (int j = 0; j < 4; ++j) *(u32x2*)(p + j * 256 + lane * 4) = (u32x2){pk2(v[4 * j], v[4 * j + 1]), pk2(v[4 * j + 2], v[4 * j + 3])};
}
DEV void load_row8_bf(const bf16_t* p, int lane, float (&v)[16]) {
#pragma unroll
    for (int j = 0; j < 2; ++j) { const u32x4 w = *(const u32x4*)(p + 512 * j + 8 * lane);
#pragma unroll
        for (int e = 0; e < 4; ++e) { v[8 * j + 2 * e] = __uint_as_float(w[e] << 16); v[8 * j + 2 * e + 1] = __uint_as_float(w[e] & 0xFFFF0000u); } }
}
DEV void store_row8_bf(bf16_t* p, int lane, const float (&v)[16]) {
#pragma unroll
    for (int j = 0; j < 2; ++j) *(u32x4*)(p + 512 * j + 8 * lane) = (u32x4){pk2(v[8 * j], v[8 * j + 1]), pk2(v[8 * j + 2], v[8 * j + 3]), pk2(v[8 * j + 4], v[8 * j + 5]), pk2(v[8 * j + 6], v[8 * j + 7])};
}

struct Ctx { LAS unsigned char* lds; int tid, lane, wave, G, bid; };

DEV void ph_setup(const Args& a, const Ctx& X) {
    unsigned char* ws = a.ws;
    float* mod = (float*)(ws + WS_MOD);
    { LAS float* red = (LAS float*)X.lds;
      LAS float* sc = (LAS float*)(X.lds + 8192);
      for (int i = X.tid; i < NB * D; i += NTHR) sc[i] = siluf(a.c[i]);
      __syncthreads();
      const int kc = X.tid >> 6, cl = X.tid & 63;
      for (int task = X.bid; task < 2 * 96; task += X.G) {
          const int l = task / 96, col = (task % 96) * 64 + cl;
          const float* w = a.mod_w + (size_t)l * D * 6 * D + col;
          float p0 = 0.f, p1 = 0.f, p2 = 0.f, p3 = 0.f;
#pragma unroll 16
          for (int k = kc * 128; k < kc * 128 + 128; ++k) { const float wv = w[(size_t)k * 6 * D];
              p0 += sc[k] * wv; p1 += sc[D + k] * wv; p2 += sc[2 * D + k] * wv; p3 += sc[3 * D + k] * wv; }
          __syncthreads();
          red[(kc * 4 + 0) * 64 + cl] = p0; red[(kc * 4 + 1) * 64 + cl] = p1; red[(kc * 4 + 2) * 64 + cl] = p2; red[(kc * 4 + 3) * 64 + cl] = p3;
          __syncthreads();
          if (X.tid < 256) { const int b = X.tid >> 6; float s = a.mod_b[l * 6 * D + col];
#pragma unroll
              for (int q = 0; q < 8; ++q) s += red[(q * 4 + b) * 64 + cl];
              mod[(size_t)(l * NB + b) * 6 * D + col] = s; }
      }
      __syncthreads(); }
    { LAS float* scr = (LAS float*)(X.lds + X.wave * 8704);
      const int gw = X.bid * NWAVES + X.wave, NGW = X.G * NWAVES;
      constexpr int I_IN = (D / 64) * (NPROJ / 32);
      for (int it = gw; it < I_IN; it += NGW) conv_item<SrcWin, true>(SrcWin{a.ssm_w_in}, PROJ, D, ws + WS_WIN, scr, it, NPROJ / 32, X.lane, 64.f);
    }
}
DEV void ph_setup_late(const Args& a, const Ctx& X, const int widx, const int nwg) {
    unsigned char* ws = a.ws;
    { float* cosT = (float*)(ws + WS_COS); float* sinT = (float*)(ws + WS_SIN);
      for (int idx = widx * NTHR + X.tid; idx < T * 32; idx += nwg * NTHR) { const int t = idx >> 5, i = idx & 31;
          const float ang = (float)a.pos[t] * powf(10000.f, -(float)i / 32.f); float sn, cs; sincosf(ang, &sn, &cs); cosT[idx] = cs; sinT[idx] = sn; } }
    { LAS float* scr = (LAS float*)(X.lds + X.wave * 8704);
      const int gw = widx * NWAVES + X.wave, NGW = nwg * NWAVES;
      constexpr int I_OUT = (2048 / 64) * (D / 32), I_QKV = (D / 64) * (3072 / 32), I_O = (D / 64) * (D / 32);
      for (int it = gw; it < I_OUT + I_QKV + I_O; it += NGW) {
          int r = it;
          if (r < I_OUT) { conv_item(SrcIdent{a.ssm_w_out}, D, 2048, (bf16_t*)(ws + WS_WOUT), scr, r, D / 32, X.lane); continue; } r -= I_OUT;
          if (r < I_QKV) { conv_item<SrcQKV, true>(SrcQKV{a.attn_w_qkv}, 3072, D, ws + WS_WQKV, scr, r, 3072 / 32, X.lane, 64.f); continue; } r -= I_QKV;
          conv_item<SrcIdent, true>(SrcIdent{a.attn_w_o}, D, D, ws + WS_WO, scr, r, D / 32, X.lane, 64.f);
      } }
}

DEV void ph_prenorm0(const Args& a, const Ctx& X) {
    const float* mod = (const float*)(a.ws + WS_MOD);
    unsigned char* h8 = a.ws + WS_H;
    for (int row = X.bid * NWAVES + X.wave; row < T; row += X.G * NWAVES) {
        const int b = row / SEQ; const float* ml = mod + (size_t)b * 6 * D;
        float xv[16]; load_row(a.x + (size_t)row * D, X.lane, xv);
        u32x2 o[4]; prenorm_pack(xv, a.mix_pre_g, ml + D, ml, X.lane, o);
#pragma unroll
        for (int j = 0; j < 4; ++j) { const float f0 = __uint_as_float(o[j].x << 16), f1 = __uint_as_float(o[j].x & 0xFFFF0000u), f2 = __uint_as_float(o[j].y << 16), f3 = __uint_as_float(o[j].y & 0xFFFF0000u);
            int wv = __builtin_amdgcn_cvt_pk_fp8_f32(fminf(fmaxf(f0, -440.f), 440.f), fminf(fmaxf(f1, -440.f), 440.f), 0, false); wv = __builtin_amdgcn_cvt_pk_fp8_f32(fminf(fmaxf(f2, -440.f), 440.f), fminf(fmaxf(f3, -440.f), 440.f), wv, true);
            *(unsigned*)(h8 + (size_t)row * D + j * 256 + X.lane * 4) = (unsigned)wv; }
    }
}

DEV bf16x8 acc_to_frag(const f32x4 lo, const f32x4 hi) { u32x4 w; w.x = pg8::cvt_pk_bf16(lo[0], lo[1]); w.y = pg8::cvt_pk_bf16(lo[2], lo[3]); w.z = pg8::cvt_pk_bf16(hi[0], hi[1]); w.w = pg8::cvt_pk_bf16(hi[2], hi[3]); return __builtin_bit_cast(bf16x8, w); }

DEV void gdn_solve(LAS float* M, LAS unsigned short* tf, const int lane) {
    for (int rb = 0; rb < 16; ++rb) {
        const int i0 = 4 * rb;
        float a0 = (lane == i0) ? 1.f : 0.f, a1 = (lane == i0 + 1) ? 1.f : 0.f, a2 = (lane == i0 + 2) ? 1.f : 0.f, a3 = (lane == i0 + 3) ? 1.f : 0.f;
        for (int j = 0; j < i0; j += 4) {
            const float t0 = M[j * 64 + lane], t1 = M[(j + 1) * 64 + lane], t2 = M[(j + 2) * 64 + lane], t3 = M[(j + 3) * 64 + lane];
            const f32x4 r0 = *(const LAS f32x4*)(M + i0 * 64 + j), r1 = *(const LAS f32x4*)(M + (i0 + 1) * 64 + j), r2 = *(const LAS f32x4*)(M + (i0 + 2) * 64 + j), r3 = *(const LAS f32x4*)(M + (i0 + 3) * 64 + j);
            a0 -= r0[0] * t0 + r0[1] * t1 + r0[2] * t2 + r0[3] * t3; a1 -= r1[0] * t0 + r1[1] * t1 + r1[2] * t2 + r1[3] * t3;
            a2 -= r2[0] * t0 + r2[1] * t1 + r2[2] * t2 + r2[3] * t3; a3 -= r3[0] * t0 + r3[1] * t1 + r3[2] * t2 + r3[3] * t3;
        }
        const f32x4 d1 = *(const LAS f32x4*)(M + (i0 + 1) * 64 + i0), d2 = *(const LAS f32x4*)(M + (i0 + 2) * 64 + i0), d3 = *(const LAS f32x4*)(M + (i0 + 3) * 64 + i0);
        a1 -= d1[0] * a0; a2 -= d2[0] * a0 + d2[1] * a1; a3 -= d3[0] * a0 + d3[1] * a1 + d3[2] * a2;
        M[i0 * 64 + lane] = a0; M[(i0 + 1) * 64 + lane] = a1; M[(i0 + 2) * 64 + lane] = a2; M[(i0 + 3) * 64 + lane] = a3;
    }
    const int cq = (lane >> 2) & 3, ca = (lane >> 4) & 1, ce = lane & 3, cks = lane >> 5;
    for (int i = 0; i < 64; ++i) tf[((i >> 4) * 2 + cks) * 512 + ((i & 15) + 16 * cq) * 8 + 4 * ca + ce] = (unsigned short)f2bf(M[i * 64 + lane]);
}
DEV void ph_gdn_local(const Args& a, const Ctx& X) {
    const bf16_t* qkvpre = (const bf16_t*)(a.ws + WS_QKVPRE); const float* small = (const float*)(a.ws + WS_SMALL);
    unsigned char* gi = a.ws + WS_GI; float* glast = (float*)(a.ws + WS_GLAST);
    constexpr int KP = 272;
    LAS unsigned char* kN = X.lds; LAS unsigned char* qN = X.lds + 64 * KP; LAS unsigned char* slots = X.lds + 128 * KP;
    LAS float* gcL = (LAS float*)(X.lds + 143360); LAS float* btL = gcL + 8 * 64;
    LAS unsigned char* stg = X.lds + 100352;
    const int lane = X.lane, wave = X.wave, r16 = lane & 15, q4 = lane >> 4;
    const float scale = 0.08838834764831845f;
    for (int wu = X.bid; wu < NB * 64; wu += X.G) {
        const int b = wu >> 6, n = wu & 63; const size_t t0 = (size_t)b * SEQ + 64 * n;
        unsigned char* tmp = a.ws + WS_GTMP + (size_t)X.bid * 131072;
        __syncthreads();
        {
            const float g = -__expf(a.gdn_a_log[wave]) * softplusf(small[(t0 + lane) * 32 + 8 + wave] + a.gdn_dt_bias[wave]);
            float gc = g;
#pragma unroll
            for (int o = 1; o < 64; o <<= 1) { const float v = __shfl_up(gc, o); if (lane >= o) gc += v; }
            gcL[wave * 64 + lane] = gc; btL[wave * 64 + lane] = sigmoidf_(small[(t0 + lane) * 32 + wave]);
            if (lane == 63) glast[(size_t)((b * 8 + wave) * 64 + n) * 32] = gc;
        }
        __syncthreads();
        unsigned xr[3][11];
#define GDN_LOADX(hh) do { _Pragma("unroll") for (int _p = 0; _p < 3; ++_p) _Pragma("unroll") for (int _i = 0; _i < 11; ++_i) { const int _tk = 8 * wave + _i - 3; unsigned _v = 0u; \
            if (64 * n + _tk >= 0) _v = *(const unsigned*)(qkvpre + (t0 + _tk) * 3072 + _p * 1024 + (hh) * 128 + 2 * lane); xr[_p][_i] = _v; } } while (0)
        GDN_LOADX(0);
        for (int bb = 0; bb < 2; ++bb) {
            for (int j = 0; j < 4; ++j) {
                const int h = bb * 4 + j; unsigned char* ub = gi + (size_t)((b * 8 + h) * 64 + n) * GI_UNIT;
                {
                    const float gl = gcL[h * 64 + 63];
                    const int blk = wave >> 2, pa = (wave & 3) >> 1, pq0 = 2 * (wave & 1);
                    const int ca = (2 * lane >> 4) & 1, cq = (2 * lane >> 2) & 3, ce = (2 * lane) & 3, cks = (2 * lane) >> 5;
#pragma unroll
                    for (int part = 0; part < 3; ++part) {
                        const int col = part * 1024 + h * 128 + 2 * lane;
                        float w0[4], w1[4];
#pragma unroll
                        for (int i = 0; i < 4; ++i) { const f32x2 t = *(const f32x2*)(a.gdn_conv_w + i * 3072 + col); w0[i] = t.x; w1[i] = t.y; }
                        float x0[11], x1[11];
#pragma unroll
                        for (int i = 0; i < 11; ++i) { const unsigned v = xr[part][i]; x0[i] = __uint_as_float(v << 16); x1[i] = __uint_as_float(v & 0xFFFF0000u); }
                        float v0[8], v1[8];
#pragma unroll
                        for (int i = 0; i < 8; ++i) { v0[i] = siluf(w0[0] * x0[i] + w0[1] * x0[i + 1] + w0[2] * x0[i + 2] + w0[3] * x0[i + 3]); v1[i] = siluf(w1[0] * x1[i] + w1[1] * x1[i + 1] + w1[2] * x1[i + 2] + w1[3] * x1[i + 3]); }
                        if (part < 2) {
#pragma unroll
                            for (int i = 0; i < 8; ++i) { const float r = rsqrtf(wave_sum(v0[i] * v0[i] + v1[i] * v1[i]) + 1e-6f); v0[i] *= r; v1[i] *= r; }
                        }
                        for (int rep_ = 0; rep_ < (((PROBE_MASK >> 21) & 1u) ? 2 : 1); ++rep_) {
                        if (part == 0) {
#pragma unroll
                            for (int i = 0; i < 8; ++i) { const int tok = 8 * wave + i; const float eg = __expf(gcL[h * 64 + tok]) * scale;
                                *(LAS unsigned*)(qN + tok * KP + lane * 4) = pk2(v0[i], v1[i]);
                                *(LAS unsigned*)(stg + ((tok >> 4) * 4 + cks) * 1024 + ((tok & 15) + 16 * cq) * 16 + (4 * ca + ce) * 2) = pk2(v0[i] * eg, v1[i] * eg); }
                        } else if (part == 1) {
                            unsigned short kg0[8], kg1[8], ke0[8], ke1[8];
#pragma unroll
                            for (int i = 0; i < 8; ++i) { const int tok = 8 * wave + i; const float gc = gcL[h * 64 + tok], bt = btL[h * 64 + tok], eg = __expf(gc) * bt, eend = __expf(gl - gc);
                                *(LAS unsigned*)(kN + tok * KP + lane * 4) = pk2(v0[i], v1[i]);
                                kg0[i] = (unsigned short)f2bf(v0[i] * eg); kg1[i] = (unsigned short)f2bf(v1[i] * eg); ke0[i] = (unsigned short)f2bf(v0[i] * eend); ke1[i] = (unsigned short)f2bf(v1[i] * eend); }
#pragma unroll
                            for (int hf = 0; hf < 2; ++hf) { const int pos = 32 * blk + 8 * (pq0 + hf) + 4 * pa; const int cl = 2 * lane;
                                *(u32x2*)(tmp + (size_t)j * 32768 + 16384 + cl * 128 + pos * 2) = (u32x2){(unsigned)kg0[4 * hf] | ((unsigned)kg0[4 * hf + 1] << 16), (unsigned)kg0[4 * hf + 2] | ((unsigned)kg0[4 * hf + 3] << 16)};
                                *(u32x2*)(tmp + (size_t)j * 32768 + 16384 + (cl + 1) * 128 + pos * 2) = (u32x2){(unsigned)kg1[4 * hf] | ((unsigned)kg1[4 * hf + 1] << 16), (unsigned)kg1[4 * hf + 2] | ((unsigned)kg1[4 * hf + 3] << 16)};
                                *(LAS u32x2*)(stg + 16384 + ((cl >> 4) * 2 + blk) * 1024 + ((cl & 15) + 16 * (pq0 + hf)) * 16 + (4 * pa) * 2) = (u32x2){(unsigned)ke0[4 * hf] | ((unsigned)ke0[4 * hf + 1] << 16), (unsigned)ke0[4 * hf + 2] | ((unsigned)ke0[4 * hf + 3] << 16)};
                                *(LAS u32x2*)(stg + 16384 + (((cl + 1) >> 4) * 2 + blk) * 1024 + (((cl + 1) & 15) + 16 * (pq0 + hf)) * 16 + (4 * pa) * 2) = (u32x2){(unsigned)ke1[4 * hf] | ((unsigned)ke1[4 * hf + 1] << 16), (unsigned)ke1[4 * hf + 2] | ((unsigned)ke1[4 * hf + 3] << 16)}; }
                        } else {
                            unsigned short vb0[8], vb1[8];
#pragma unroll
                            for (int i = 0; i < 8; ++i) { const float bt = btL[h * 64 + 8 * wave + i]; vb0[i] = (unsigned short)f2bf(v0[i] * bt); vb1[i] = (unsigned short)f2bf(v1[i] * bt); }
#pragma unroll
                            for (int hf = 0; hf < 2; ++hf) { const int pos = 32 * blk + 8 * (pq0 + hf) + 4 * pa; const int cl = 2 * lane;
                                *(u32x2*)(tmp + (size_t)j * 32768 + cl * 128 + pos * 2) = (u32x2){(unsigned)vb0[4 * hf] | ((unsigned)vb0[4 * hf + 1] << 16), (unsigned)vb0[4 * hf + 2] | ((unsigned)vb0[4 * hf + 3] << 16)};
                                *(u32x2*)(tmp + (size_t)j * 32768 + (cl + 1) * 128 + pos * 2) = (u32x2){(unsigned)vb1[4 * hf] | ((unsigned)vb1[4 * hf + 1] << 16), (unsigned)vb1[4 * hf + 2] | ((unsigned)vb1[4 * hf + 3] << 16)}; }
                        }
                        asm volatile("" ::: "memory"); }
                    }
                }
                if (h + 1 < 8) GDN_LOADX(h + 1);
                __syncthreads();
                {
#pragma unroll
                    for (int i = 0; i < 4; ++i) *(u32x4*)(ub + 16384 + (X.tid + 512 * i) * 16) = *(const LAS u32x4*)(stg + (X.tid + 512 * i) * 16);
                    const int mat = wave >> 2, rt = wave & 3; LAS unsigned char* An = mat ? qN : kN;
                    bf16x8 af[4];
#pragma unroll
                    for (int ks = 0; ks < 4; ++ks) af[ks] = *(const LAS bf16x8*)(An + (16 * rt + r16) * KP + (32 * ks + 8 * q4) * 2);
                    LAS float* slot = (LAS float*)(slots + j * 16384);
#pragma unroll
                    for (int ct = 0; ct < 4; ++ct) { f32x4 acc = {0.f, 0.f, 0.f, 0.f};
#pragma unroll
                        for (int ks = 0; ks < 4; ++ks) { const bf16x8 bf = *(const LAS bf16x8*)(kN + (16 * ct + r16) * KP + (32 * ks + 8 * q4) * 2); acc = __builtin_amdgcn_mfma_f32_16x16x32_bf16(af[ks], bf, acc, 0, 0, 0); }
                        const int jc = 16 * ct + r16; const float gj = gcL[h * 64 + jc];
#pragma unroll
                        for (int rg = 0; rg < 4; ++rg) { const int i = 16 * rt + 4 * q4 + rg; const float dec = __expf(gcL[h * 64 + i] - gj);
                            if (mat == 0) { slot[i * 64 + jc] = jc < i ? btL[h * 64 + i] * acc[rg] * dec : 0.f; }
                            else { const float v = jc <= i ? acc[rg] * scale * dec : 0.f;
                                *(LAS unsigned short*)(stg + 32768 + (rt * 2 + (ct >> 1)) * 1024 + ((4 * q4 + rg) + 16 * (r16 >> 2)) * 16 + (4 * (ct & 1) + (r16 & 3)) * 2) = (unsigned short)f2bf(v); } }
                    }
                }
                __syncthreads();
                *(u32x4*)(ub + 49152 + X.tid * 16) = *(const LAS u32x4*)(stg + 32768 + X.tid * 16);
            }
            if (wave < 4) gdn_solve((LAS float*)(slots + wave * 16384), (LAS unsigned short*)(X.lds + wave * 8192), lane);
            VM_WAIT(); __syncthreads();
            for (int j = 0; j < 4; ++j) {
                const int h = bb * 4 + j; unsigned char* ub = gi + (size_t)((b * 8 + h) * 64 + n) * GI_UNIT;
                const int mat = wave >> 2; LAS unsigned char* slot = X.lds + j * 8192;
#pragma unroll
                for (int cx = 0; cx < 2; ++cx) { const int ct = 2 * (wave & 3) + cx;
                    bf16x8 bfr[2];
#pragma unroll
                    for (int ks = 0; ks < 2; ++ks) { const u32x4 t = __builtin_nontemporal_load((const u32x4*)(tmp + (size_t)j * 32768 + mat * 16384 + (16 * ct + r16) * 128 + (32 * ks + 8 * q4) * 2)); bfr[ks] = __builtin_bit_cast(bf16x8, t); }
#pragma unroll
                    for (int rt = 0; rt < 4; ++rt) { f32x4 acc = {0.f, 0.f, 0.f, 0.f};
#pragma unroll
                        for (int ks = 0; ks < 2; ++ks) { const bf16x8 tf = *(const LAS bf16x8*)(slot + (rt * 2 + ks) * 1024 + lane * 16); acc = __builtin_amdgcn_mfma_f32_16x16x32_bf16(tf, bfr[ks], acc, 0, 0, 0); }
                        if (mat == 0) *(u32x2*)(ub + 57344 + (rt * 8 + ct) * 512 + lane * 8) = (u32x2){pg8::cvt_pk_bf16(acc[0], acc[1]), pg8::cvt_pk_bf16(acc[2], acc[3])};
                        else {
#pragma unroll
                            for (int rg = 0; rg < 4; ++rg) *(unsigned short*)(ub + (rt * 4 + (ct >> 1)) * 1024 + ((4 * q4 + rg) + 16 * (r16 >> 2)) * 16 + (4 * (ct & 1) + (r16 & 3)) * 2) = (unsigned short)f2bf(-acc[rg]);
                        }
                    }
                }
            }
            __syncthreads();
        }
    }
}
DEV void ph_gdn_scan(const Args& a, const Ctx& X) {
    const unsigned char* gi = a.ws + WS_GI; const float* glast = (const float*)(a.ws + WS_GLAST);
    const bf16_t* za = (const bf16_t*)(a.ws + WS_ZA); bf16_t* oy = (bf16_t*)(a.ws + WS_OY);
    const int lane = X.lane, wave = X.wave, r16 = lane & 15, q4 = lane >> 4, tid = X.tid;
    LAS float* OT = (LAS float*)(X.lds + 114688);
    const int bh = X.bid, b = bh >> 3, h = bh & 7;
    const unsigned char* ubase = gi + (size_t)bh * 64 * GI_UNIT;
    f32x4 S[8];
#pragma unroll
    for (int i = 0; i < 8; ++i) S[i] = (f32x4){0.f, 0.f, 0.f, 0.f};
    LAS float* NWL = (LAS float*)(X.lds + 149504);
    if (tid < 128) NWL[tid] = a.gdn_norm_w[tid];
#define GDN_STAGE(nn, buf) do { _Pragma("unroll") for (int _i = 0; _i < 7; ++_i) \
        __builtin_amdgcn_global_load_lds((const unsigned*)(ubase + (size_t)(nn) * GI_UNIT + (size_t)(tid + 512 * _i) * 16), (LAS unsigned*)(X.lds + (buf) * 57344 + (wave * 64 + 512 * _i) * 16), 16, 0, 0); } while (0)
    u32x2 udn[4]; float gln; u32x4 zn[2];
    { const size_t tz = (size_t)b * SEQ + (tid >> 3); zn[0] = *(const u32x4*)(za + tz * 1024 + h * 128 + 16 * (tid & 7)); zn[1] = *(const u32x4*)(za + tz * 1024 + h * 128 + 16 * (tid & 7) + 8); }
#pragma unroll
    for (int ct = 0; ct < 4; ++ct) udn[ct] = *(const u32x2*)(ubase + 57344 + (ct * 8 + wave) * 512 + lane * 8);
    gln = glast[(size_t)(bh * 64) * 32];
    GDN_STAGE(0, 0);
#define GDN_EPILOGUE(nn, ZC) do { const int tok = tid >> 3, seg = tid & 7; const size_t t = (size_t)b * SEQ + 64 * (nn) + tok; \
            float ov[16]; float ss = 0.f; float nwv[16]; \
            _Pragma("unroll") for (int i = 0; i < 4; ++i) { const f32x4 v = *(const LAS f32x4*)(NWL + 16 * seg + 4 * i); nwv[4 * i] = v[0]; nwv[4 * i + 1] = v[1]; nwv[4 * i + 2] = v[2]; nwv[4 * i + 3] = v[3]; } \
            _Pragma("unroll") for (int i = 0; i < 4; ++i) { const f32x4 v = *(const LAS f32x4*)(OT + tok * 132 + 16 * seg + 4 * i); ov[4 * i] = v[0]; ov[4 * i + 1] = v[1]; ov[4 * i + 2] = v[2]; ov[4 * i + 3] = v[3]; ss += v[0] * v[0] + v[1] * v[1] + v[2] * v[2] + v[3] * v[3]; } \
            ss = sum8(ss); \
            const float rstd = rsqrtf(ss * (1.f / 128.f) + EPS); \
            u32x4 ow[2]; \
            _Pragma("unroll") for (int i = 0; i < 2; ++i) _Pragma("unroll") for (int e = 0; e < 4; ++e) { const unsigned zw = (ZC)[i][e]; const float z0 = __uint_as_float(zw << 16), z1 = __uint_as_float(zw & 0xFFFF0000u); \
                    ow[i][e] = pg8::cvt_pk_bf16(ov[8 * i + 2 * e] * rstd * nwv[8 * i + 2 * e] * siluf(z0), ov[8 * i + 2 * e + 1] * rstd * nwv[8 * i + 2 * e + 1] * siluf(z1)); } \
            *(u32x4*)(oy + t * 2048 + h * 128 + 16 * seg) = ow[0]; *(u32x4*)(oy + t * 2048 + h * 128 + 16 * seg + 8) = ow[1]; } while (0)
    u32x4 zp[2] = {{0u, 0u, 0u, 0u}, {0u, 0u, 0u, 0u}};
    for (int n = 0; n < 64; ++n) {
        VM_WAIT(); __syncthreads();
        f32x4 uf[4];
#pragma unroll
        for (int ct = 0; ct < 4; ++ct) { uf[ct][0] = __uint_as_float(udn[ct].x << 16); uf[ct][1] = __uint_as_float(udn[ct].x & 0xFFFF0000u); uf[ct][2] = __uint_as_float(udn[ct].y << 16); uf[ct][3] = __uint_as_float(udn[ct].y & 0xFFFF0000u); }
        const float egl = __expf(gln);
        u32x4 zc[2]; zc[0] = zn[0]; zc[1] = zn[1];
        asm volatile("" : "+v"(uf[0]), "+v"(uf[1]), "+v"(uf[2]), "+v"(uf[3]), "+v"(zc[0]), "+v"(zc[1]));
        if (n + 1 < 64) {
            const unsigned char* un = ubase + (size_t)(n + 1) * GI_UNIT;
#pragma unroll
            for (int ct = 0; ct < 4; ++ct) udn[ct] = *(const u32x2*)(un + 57344 + (ct * 8 + wave) * 512 + lane * 8);
            gln = glast[(size_t)(bh * 64 + n + 1) * 32];
            { const size_t tz = (size_t)b * SEQ + 64 * (n + 1) + (tid >> 3); zn[0] = *(const u32x4*)(za + tz * 1024 + h * 128 + 16 * (tid & 7)); zn[1] = *(const u32x4*)(za + tz * 1024 + h * 128 + 16 * (tid & 7) + 8); }
            GDN_STAGE(n + 1, (n + 1) & 1);
        }
        if (n > 0) GDN_EPILOGUE(n - 1, zp);
        zp[0] = zc[0]; zp[1] = zc[1];
        const LAS unsigned char* L = X.lds + (n & 1) * 57344;
        bf16x8 sB[4];
#pragma unroll
        for (int ks = 0; ks < 4; ++ks) sB[ks] = acc_to_frag(S[2 * ks], S[2 * ks + 1]);
        f32x4 vn[4], oo[4];
#pragma unroll
        for (int ct = 0; ct < 4; ++ct) { f32x4 acc = {0.f, 0.f, 0.f, 0.f}, ao = {0.f, 0.f, 0.f, 0.f};
#pragma unroll
            for (int ks = 0; ks < 4; ++ks) { const bf16x8 wf = *(const LAS bf16x8*)(L + (ct * 4 + ks) * 1024 + lane * 16), qf = *(const LAS bf16x8*)(L + 16384 + (ct * 4 + ks) * 1024 + lane * 16);
                acc = __builtin_amdgcn_mfma_f32_16x16x32_bf16(wf, sB[ks], acc, 0, 0, 0); ao = __builtin_amdgcn_mfma_f32_16x16x32_bf16(qf, sB[ks], ao, 0, 0, 0); }
            vn[ct] = acc; oo[ct] = ao; }
#pragma unroll
        for (int ct = 0; ct < 4; ++ct) vn[ct] = vn[ct] + uf[ct];
        bf16x8 vB[2];
#pragma unroll
        for (int ks = 0; ks < 2; ++ks) vB[ks] = acc_to_frag(vn[2 * ks], vn[2 * ks + 1]);
#pragma unroll
        for (int ct = 0; ct < 4; ++ct)
#pragma unroll
            for (int ks = 0; ks < 2; ++ks) { const bf16x8 kf = *(const LAS bf16x8*)(L + 49152 + (ct * 2 + ks) * 1024 + lane * 16); oo[ct] = __builtin_amdgcn_mfma_f32_16x16x32_bf16(kf, vB[ks], oo[ct], 0, 0, 0); }
#pragma unroll
        for (int dt = 0; dt < 8; ++dt) { f32x4 acc = S[dt] * egl;
#pragma unroll
            for (int ks = 0; ks < 2; ++ks) { const bf16x8 ef = *(const LAS bf16x8*)(L + 32768 + (dt * 2 + ks) * 1024 + lane * 16); acc = __builtin_amdgcn_mfma_f32_16x16x32_bf16(ef, vB[ks], acc, 0, 0, 0); }
            S[dt] = acc; }
        __syncthreads();
#pragma unroll
        for (int ct = 0; ct < 4; ++ct)
#pragma unroll
            for (int rg = 0; rg < 4; ++rg) OT[(16 * ct + 4 * q4 + rg) * 132 + 16 * wave + r16] = oo[ct][rg];
    }
    __syncthreads();
    GDN_EPILOGUE(63, zp);
#undef GDN_EPILOGUE
#undef GDN_STAGE
}

constexpr int SP = 272;
DEV void ph_ssd_local(const Args& a, const Ctx& X, const int wg0) {
    const bf16_t* xbcpre = (const bf16_t*)(a.ws + WS_XBCPRE); const float* small = (const float*)(a.ws + WS_SMALL);
    bf16_t* CC = (bf16_t*)(a.ws + WS_CC); float* acum = (float*)(a.ws + WS_ACUM); float* cdec = (float*)(a.ws + WS_CDEC);
    bf16_t* ydiag = (bf16_t*)(a.ws + WS_YDIAG); bf16_t* states = (bf16_t*)(a.ws + WS_STATES);
    LAS unsigned char* Bn = X.lds; LAS unsigned char* Cn = X.lds + 128 * SP; LAS unsigned char* BT = X.lds + 256 * SP;
    LAS unsigned char* xdT = X.lds; LAS unsigned char* xeT = X.lds + 64 * SP;
    LAS float* acL = (LAS float*)(X.lds + AUX_OFF); LAS float* dtL = acL + 8 * 128;
    const int lane = X.lane, wave = X.wave, r16 = lane & 15, q4 = lane >> 4;
    for (int unit = X.bid - wg0; unit < NB * 32 * 2; unit += X.G - wg0) {
        const int g = unit & 1, c = (unit >> 1) & 31, b = unit >> 6; const size_t t0 = (size_t)b * SEQ + 128 * c;
        __syncthreads();
        {
            const int hd = g * 8 + wave; const float an = -__expf(a.ssd_a_log[hd]), bias = a.ssd_dt_bias[hd];
            const float d0 = softplusf(small[(t0 + lane) * 32 + 16 + hd] + bias), d1 = softplusf(small[(t0 + 64 + lane) * 32 + 16 + hd] + bias);
            float s0 = d0 * an, s1 = d1 * an;
#pragma unroll
            for (int o = 1; o < 64; o <<= 1) { const float v0 = __shfl_up(s0, o), v1 = __shfl_up(s1, o); if (lane >= o) { s0 += v0; s1 += v1; } }
            s1 += __shfl(s0, 63);
            acL[wave * 128 + lane] = s0; acL[wave * 128 + 64 + lane] = s1; dtL[wave * 128 + lane] = d0; dtL[wave * 128 + 64 + lane] = d1;
            acum[((size_t)g * T + t0 + lane) * 8 + wave] = s0; acum[((size_t)g * T + t0 + 64 + lane) * 8 + wave] = s1;
            if (lane == 63) cdec[(size_t)unit * 32 + wave] = __expf(s1);
        }
        {
            const int isC = lane >> 5, cc = (lane & 31) * 4, col = 1024 + isC * 256 + g * 128 + cc;
            float w[4][4], bs[4];
#pragma unroll
            for (int i = 0; i < 4; ++i) { const f32x4 t = *(const f32x4*)(a.ssd_conv_w + i * 1536 + col); w[i][0] = t[0]; w[i][1] = t[1]; w[i][2] = t[2]; w[i][3] = t[3]; }
            { const f32x4 t = *(const f32x4*)(a.ssd_conv_b + col); bs[0] = t[0]; bs[1] = t[1]; bs[2] = t[2]; bs[3] = t[3]; }
            float xin[19][4];
#pragma unroll
            for (int i = 0; i < 19; ++i) { const int tk = 16 * wave + i - 3; const bool ok = (128 * c + tk) >= 0; u32x2 v = {0u, 0u}; if (ok) v = *(const u32x2*)(xbcpre + (t0 + tk) * 1536 + col);
                xin[i][0] = __uint_as_float(v.x << 16); xin[i][1] = __uint_as_float(v.x & 0xFFFF0000u); xin[i][2] = __uint_as_float(v.y << 16); xin[i][3] = __uint_as_float(v.y & 0xFFFF0000u); }
            unsigned short ov[16][4];
#pragma unroll
            for (int i = 0; i < 16; ++i)
#pragma unroll
                for (int e = 0; e < 4; ++e) { const float s = bs[e] + w[0][e] * xin[i][e] + w[1][e] * xin[i + 1][e] + w[2][e] * xin[i + 2][e] + w[3][e] * xin[i + 3][e]; ov[i][e] = (unsigned short)f2bf(siluf(s)); }
            LAS unsigned char* nat = isC ? Cn : Bn;
#pragma unroll
            for (int i = 0; i < 16; ++i) { const u32x2 pk = {(unsigned)ov[i][0] | ((unsigned)ov[i][1] << 16), (unsigned)ov[i][2] | ((unsigned)ov[i][3] << 16)};
                *(LAS u32x2*)(nat + (16 * wave + i) * SP + cc * 2) = pk;
                if (isC) *(u32x2*)(CC + (t0 + 16 * wave + i) * 256 + g * 128 + cc) = pk; }
            if (!isC) {
#pragma unroll
                for (int e = 0; e < 4; ++e)
#pragma unroll
                    for (int qq = 0; qq < 4; ++qq) { const u32x2 pk = {(unsigned)ov[4 * qq][e] | ((unsigned)ov[4 * qq + 1][e] << 16), (unsigned)ov[4 * qq + 2][e] | ((unsigned)ov[4 * qq + 3][e] << 16)};
                        *(LAS u32x2*)(BT + (cc + e) * SP + (32 * (wave >> 1) + 8 * qq + 4 * (wave & 1)) * 2) = pk; }
            }
        }
        __syncthreads();
        f32x4 cbt[8];
        {
            bf16x8 cf[4];
#pragma unroll
            for (int ks = 0; ks < 4; ++ks) cf[ks] = *(const LAS bf16x8*)(Cn + (16 * wave + r16) * SP + (32 * ks + 8 * q4) * 2);
#pragma unroll
            for (int st = 0; st < 8; ++st) { cbt[st] = (f32x4){0.f, 0.f, 0.f, 0.f};
#pragma unroll
                for (int ks = 0; ks < 4; ++ks) { const bf16x8 bf = *(const LAS bf16x8*)(Bn + (16 * st + r16) * SP + (32 * ks + 8 * q4) * 2); cbt[st] = __builtin_amdgcn_mfma_f32_16x16x32_bf16(bf, cf[ks], cbt[st], 0, 0, 0); } }
        }
        __syncthreads();
        const int lq = 16 * wave + r16;
        unsigned short xnx[19];
#define SSD_LOADX(hh) do { _Pragma("unroll") for (int _i = 0; _i < 19; ++_i) { const int _tk = 16 * wave + _i - 3; xnx[_i] = (128 * c + _tk) >= 0 ? xbcpre[(t0 + _tk) * 1536 + (hh) * 64 + lane] : (unsigned short)0; } } while (0)
        SSD_LOADX(g * 8);
        for (int r = 0; r < 8; ++r) {
            const int hd = g * 8 + r; const float dd = a.ssd_d[hd];
            {
                const int col = hd * 64 + lane; float w0 = a.ssd_conv_w[col], w1 = a.ssd_conv_w[1536 + col], w2 = a.ssd_conv_w[2 * 1536 + col], w3 = a.ssd_conv_w[3 * 1536 + col]; const float bs = a.ssd_conv_b[col];
                float xin[19];
#pragma unroll
                for (int i = 0; i < 19; ++i) xin[i] = bf2f(xnx[i]);
                if (r + 1 < 8) SSD_LOADX(hd + 1);
                const float aclast = acL[r * 128 + 127];
                unsigned short xd[16], xe[16];
#pragma unroll
                for (int i = 0; i < 16; ++i) { const float xv = siluf(bs + w0 * xin[i] + w1 * xin[i + 1] + w2 * xin[i + 2] + w3 * xin[i + 3]); const int tk = 16 * wave + i;
                    const float xdv = xv * dtL[r * 128 + tk]; xd[i] = (unsigned short)f2bf(xdv); xe[i] = (unsigned short)f2bf(xdv * __expf(aclast - acL[r * 128 + tk])); }
#pragma unroll
                for (int qq = 0; qq < 4; ++qq) { const int pos = 32 * (wave >> 1) + 8 * qq + 4 * (wave & 1);
                    *(LAS u32x2*)(xdT + lane * SP + pos * 2) = (u32x2){(unsigned)xd[4 * qq] | ((unsigned)xd[4 * qq + 1] << 16), (unsigned)xd[4 * qq + 2] | ((unsigned)xd[4 * qq + 3] << 16)};
                    *(LAS u32x2*)(xeT + lane * SP + pos * 2) = (u32x2){(unsigned)xe[4 * qq] | ((unsigned)xe[4 * qq + 1] << 16), (unsigned)xe[4 * qq + 2] | ((unsigned)xe[4 * qq + 3] << 16)}; }
            }
            __syncthreads();
            {
                const float acl = acL[r * 128 + lq], ddt = dd * __builtin_amdgcn_rcpf(dtL[r * 128 + lq]);
                f32x4 yd[4];
#pragma unroll
                for (int pt = 0; pt < 4; ++pt) yd[pt] = (f32x4){0.f, 0.f, 0.f, 0.f};
#pragma unroll
                for (int ks = 0; ks < 4; ++ks) { if (ks <= (wave >> 1)) {
                    f32x4 mlo, mhi;
#pragma unroll
                    for (int e = 0; e < 4; ++e) {
                        const int s0 = 32 * ks + 4 * q4 + e, s1 = s0 + 16;
                        const float v0 = cbt[2 * ks][e], v1 = cbt[2 * ks + 1][e];
                        mlo[e] = s0 < lq ? v0 * __expf(acl - acL[r * 128 + s0]) : (s0 == lq ? v0 + ddt : 0.f);
                        mhi[e] = s1 < lq ? v1 * __expf(acl - acL[r * 128 + s1]) : (s1 == lq ? v1 + ddt : 0.f);
                    }
                    const bf16x8 mf = acc_to_frag(mlo, mhi);
#pragma unroll
                    for (int pt = 0; pt < 4; ++pt) { const bf16x8 xf = *(const LAS bf16x8*)(xdT + (16 * pt + r16) * SP + (32 * ks + 8 * q4) * 2); yd[pt] = __builtin_amdgcn_mfma_f32_16x16x32_bf16(xf, mf, yd[pt], 0, 0, 0); }
                } }
#pragma unroll
                for (int pt = 0; pt < 4; ++pt) *(u32x2*)(ydiag + (t0 + lq) * 1024 + hd * 64 + 16 * pt + 4 * q4) = (u32x2){pg8::cvt_pk_bf16(yd[pt][0], yd[pt][1]), pg8::cvt_pk_bf16(yd[pt][2], yd[pt][3])};
            }
            {
                bf16x8 bf[4];
#pragma unroll
                for (int ks = 0; ks < 4; ++ks) bf[ks] = *(const LAS bf16x8*)(BT + (16 * wave + r16) * SP + (32 * ks + 8 * q4) * 2);
                bf16_t* hp = states + ((size_t)(unit * 8 + r) * 64) * 128;
#pragma unroll
                for (int pt = 0; pt < 4; ++pt) { f32x4 st = {0.f, 0.f, 0.f, 0.f};
#pragma unroll
                    for (int ks = 0; ks < 4; ++ks) { const bf16x8 xf = *(const LAS bf16x8*)(xeT + (16 * pt + r16) * SP + (32 * ks + 8 * q4) * 2); st = __builtin_amdgcn_mfma_f32_16x16x32_bf16(bf[ks], xf, st, 0, 0, 0); }
                    *(u32x2*)(hp + (size_t)(16 * pt + r16) * 128 + 16 * wave + 4 * q4) = (u32x2){pg8::cvt_pk_bf16(st[0], st[1]), pg8::cvt_pk_bf16(st[2], st[3])}; }
            }
            __syncthreads();
        }
    }
}
DEV void ph_ssd_scan(const Args& a, const Ctx& X, const int wg0) {
    bf16_t* states = (bf16_t*)(a.ws + WS_STATES); const float* cdec = (const float*)(a.ws + WS_CDEC);
    for (int task = (X.bid - wg0) * NTHR + X.tid; task < NB * 16 * 64 * 32; task += (X.G - wg0) * NTHR) {
        const int n4 = task & 31, p = (task >> 5) & 63, hd = (task >> 11) & 15, b = task >> 15;
        bf16_t* base = states + ((size_t)(((b * 32) * 2 + (hd >> 3)) * 8 + (hd & 7)) * 64 + p) * 128 + 4 * n4;
        const float* dbase = cdec + (size_t)((b * 32) * 2 + (hd >> 3)) * 32 + (hd & 7);
        u32x2 sv[32]; float dec[32];
#pragma unroll
        for (int c = 0; c < 32; ++c) { sv[c] = *(const u32x2*)(base + (size_t)c * 131072); dec[c] = dbase[c * 64]; }
        float h0 = 0.f, h1 = 0.f, h2 = 0.f, h3 = 0.f;
#pragma unroll
        for (int c = 0; c < 32; ++c) {
            *(u32x2*)(base + (size_t)c * 131072) = (u32x2){pk2(h0, h1), pk2(h2, h3)};
            h0 = h0 * dec[c] + __uint_as_float(sv[c].x << 16); h1 = h1 * dec[c] + __uint_as_float(sv[c].x & 0xFFFF0000u); h2 = h2 * dec[c] + __uint_as_float(sv[c].y << 16); h3 = h3 * dec[c] + __uint_as_float(sv[c].y & 0xFFFF0000u);
        }
    }
}
DEV void ph_ssd_out(const Args& a, const Ctx& X, const int wg0, const int rot) {
    const bf16_t* CC = (const bf16_t*)(a.ws + WS_CC); const float* acum = (const float*)(a.ws + WS_ACUM); const bf16_t* ydiag = (const bf16_t*)(a.ws + WS_YDIAG);
    const bf16_t* states = (const bf16_t*)(a.ws + WS_STATES); const bf16_t* zb = (const bf16_t*)(a.ws + WS_ZB); bf16_t* oy = (bf16_t*)(a.ws + WS_OY);
    const int lane = X.lane, wave = X.wave, r16 = lane & 15, q4 = lane >> 4;
    for (int unit = (X.bid - wg0 + rot) % (X.G - wg0); unit < NB * 32 * 2; unit += X.G - wg0) {
        const int g = unit & 1, c = (unit >> 1) & 31, b = unit >> 6; const size_t t = (size_t)b * SEQ + 128 * c + 16 * wave + r16;
        bf16x8 cf[4];
#pragma unroll
        for (int ks = 0; ks < 4; ++ks) cf[ks] = *(const bf16x8*)(CC + t * 256 + g * 128 + 32 * ks + 8 * q4);
        float ss = 0.f;
        LAS u32x2* stash = (LAS u32x2*)(X.lds + wave * 16384);
#define SO_LOAD(rr, HF, YD, ZZ, EA) do { const bf16_t* hp_ = states + ((size_t)(unit * 8 + (rr)) * 64) * 128; const int hd_ = g * 8 + (rr); \
            EA = acum[((size_t)g * T + t) * 8 + (rr)]; \
            _Pragma("unroll") for (int pt = 0; pt < 4; ++pt) { _Pragma("unroll") for (int ks = 0; ks < 4; ++ks) HF[pt][ks] = *(const bf16x8*)(hp_ + (size_t)(16 * pt + r16) * 128 + 32 * ks + 8 * q4); \
                YD[pt] = *(const u32x2*)(ydiag + t * 1024 + hd_ * 64 + 16 * pt + 4 * q4); ZZ[pt] = *(const u32x2*)(zb + t * 1024 + hd_ * 64 + 16 * pt + 4 * q4); } } while (0)
#define SO_COMP(rr, HF, YD, ZZ, EA) do { const float eac = __expf(EA); \
            _Pragma("unroll") for (int pt = 0; pt < 4; ++pt) { f32x4 acc = {0.f, 0.f, 0.f, 0.f}; \
                _Pragma("unroll") for (int ks = 0; ks < 4; ++ks) acc = __builtin_amdgcn_mfma_f32_16x16x32_bf16(HF[pt][ks], cf[ks], acc, 0, 0, 0); \
                const u32x2 yd = YD[pt], zz = ZZ[pt]; \
                f32x4 v; v[0] = acc[0] * eac + __uint_as_float(yd.x << 16); v[1] = acc[1] * eac + __uint_as_float(yd.x & 0xFFFF0000u); v[2] = acc[2] * eac + __uint_as_float(yd.y << 16); v[3] = acc[3] * eac + __uint_as_float(yd.y & 0xFFFF0000u); \
                v[0] *= siluf(__uint_as_float(zz.x << 16)); v[1] *= siluf(__uint_as_float(zz.x & 0xFFFF0000u)); v[2] *= siluf(__uint_as_float(zz.y << 16)); v[3] *= siluf(__uint_as_float(zz.y & 0xFFFF0000u)); \
                ss += v[0] * v[0] + v[1] * v[1] + v[2] * v[2] + v[3] * v[3]; \
                stash[((rr) * 4 + pt) * 64 + lane] = (u32x2){pg8::cvt_pk_bf16(v[0], v[1]), pg8::cvt_pk_bf16(v[2], v[3])}; } } while (0)
        bf16x8 hfA[4][4], hfB[4][4]; u32x2 ydA[4], zzA[4], ydB[4], zzB[4]; float eaA, eaB;
        SO_LOAD(0, hfA, ydA, zzA, eaA);
        for (int r = 0; r < 8; r += 2) {
            SO_LOAD(r + 1, hfB, ydB, zzB, eaB);
            SO_COMP(r, hfA, ydA, zzA, eaA);
            if (r + 2 < 8) SO_LOAD(r + 2, hfA, ydA, zzA, eaA);
            SO_COMP(r + 1, hfB, ydB, zzB, eaB);
        }
#undef SO_LOAD
#undef SO_COMP
        ss += __shfl_xor(ss, 16); ss += __shfl_xor(ss, 32);
        const float rstd = rsqrtf(ss * (1.f / 512.f) + EPS);
#pragma unroll 2
        for (int r = 0; r < 8; ++r)
#pragma unroll
            for (int pt = 0; pt < 4; ++pt) { const int cix = g * 512 + r * 64 + 16 * pt + 4 * q4; const f32x4 nw = *(const f32x4*)(a.ssd_norm_w + cix); const u32x2 w = stash[(r * 4 + pt) * 64 + lane];
                *(u32x2*)(oy + t * 2048 + 1024 + cix) = (u32x2){pg8::cvt_pk_bf16(__uint_as_float(w.x << 16) * rstd * nw[0], __uint_as_float(w.x & 0xFFFF0000u) * rstd * nw[1]), pg8::cvt_pk_bf16(__uint_as_float(w.y << 16) * rstd * nw[2], __uint_as_float(w.y & 0xFFFF0000u) * rstd * nw[3])}; }
    }
}


DEV void ph_attn(const Args& a, const Ctx& X) {
    const bf16_t* qkv = (const bf16_t*)(a.ws + WS_Q1KV); bf16_t* po = (bf16_t*)(a.ws + WS_PO); float* plse = (float*)(a.ws + WS_PLSE); unsigned char* o = a.ws + WS_O1;
    LAS unsigned char* vl = X.lds + X.wave * 12288;
    LAS unsigned char* kl = vl + 6144;
    const int lane = X.lane, q = lane & 31, h5 = lane >> 5;
    const int tr_off = ((lane & 15) >> 2) * 192 + (16 * ((lane >> 4) & 1) + 4 * (lane & 3)) * 2;
    const int prow = lane >> 3, pch = lane & 7;
    for (int unit = X.bid; unit < NB * 16 * 4; unit += X.G) {
        const int bhd = unit & 63, b = bhd >> 4, hd = bhd & 15, g = unit >> 6;
        for (int tk = 0; tk < 6; ++tk) {
            const int br = tk >> 1, idx = X.wave * 2 + (tk & 1);
            int d, r, I0;
            if (br == 0) { d = 1; r = 0; I0 = 1024 * g + 64 * idx; } else if (br == 1) { d = 4; r = idx & 3; I0 = 256 * g + 64 * (idx >> 2); } else { d = 16; r = idx; I0 = 64 * g; }
#define ATT_LOAD(dst, j0_, coff) do { _Pragma("unroll") for (int _i = 0; _i < 4; ++_i) { const size_t _t = (size_t)b * SEQ + (size_t)((j0_) + 8 * _i + prow) * d + r; \
                dst[_i] = *(const u32x4*)(qkv + _t * 3072 + (coff) + hd * 64 + pch * 8); } } while (0)
            u32x4 k0[4], v0[4], k1[4], v1[4];
            const bool e3 = (I0 - 32) >= 0, e2 = (I0 - 64) >= 0, e1 = (I0 - 96) >= 0, e0 = (I0 - 128) >= 0;
            ATT_LOAD(k0, I0, 0); ATT_LOAD(k1, I0 + 32, 0);
            bf16x8 qA[4], qB[4];
#pragma unroll
            for (int i = 0; i < 4; ++i) *(LAS u32x4*)(kl + (8 * i + prow) * 144 + pch * 16) = k0[i];
#pragma unroll
            for (int s = 0; s < 4; ++s) qA[s] = *(const LAS bf16x8*)(kl + q * 144 + (16 * s + 8 * h5) * 2);
            LDS_WAIT();
#pragma unroll
            for (int i = 0; i < 4; ++i) *(LAS u32x4*)(kl + (8 * i + prow) * 144 + pch * 16) = k1[i];
#pragma unroll
            for (int s = 0; s < 4; ++s) qB[s] = *(const LAS bf16x8*)(kl + q * 144 + (16 * s + 8 * h5) * 2);
            LDS_WAIT();
            ATT_LOAD(k0, I0 + 32, 1024); ATT_LOAD(v0, I0 + 32, 2048);
            ATT_LOAD(k1, I0, 1024); ATT_LOAD(v1, I0, 2048);
            f32x16 oA[2], oB[2];
#pragma unroll
            for (int i = 0; i < 16; ++i) { oA[0][i] = 0.f; oA[1][i] = 0.f; oB[0][i] = 0.f; oB[1][i] = 0.f; }
            float mA = -1e30f, lA = 0.f, mB = -1e30f, lB = 0.f;
            auto scores = [&](const bf16x8 (&kf)[4], const bf16x8 (&qf)[4], f32x16 (&oacc)[2], float& m, float& l, const int mode, bf16x8 (&pf)[2]) {
                f32x16 sacc;
#pragma unroll
                for (int i = 0; i < 16; ++i) sacc[i] = 0.f;
#pragma unroll
                for (int s = 0; s < 4; ++s) sacc = __builtin_amdgcn_mfma_f32_32x32x16_bf16(kf[s], qf[s], sacc, 0, 0, 0);
                if (mode == 1) {
#pragma unroll
                    for (int i = 0; i < 16; ++i) { const int kl_ = (i & 3) + 8 * (i >> 2) + 4 * h5; if (kl_ > q) sacc[i] = -1e30f; }
                } else if (mode == 2) {
#pragma unroll
                    for (int i = 0; i < 16; ++i) { const int kl_ = (i & 3) + 8 * (i >> 2) + 4 * h5; if (kl_ < q) sacc[i] = -1e30f; }
                }
                float mx = sacc[0];
#pragma unroll
                for (int i = 1; i < 16; ++i) mx = fmaxf(mx, sacc[i]);
                mx = fmaxf(mx, __shfl_xor(mx, 32));
                const float mn = fmaxf(m, mx), alpha = __expf(m - mn);
                float rs = 0.f;
#pragma unroll
                for (int i = 0; i < 16; ++i) { sacc[i] = __expf(sacc[i] - mn); rs += sacc[i]; }
                rs += __shfl_xor(rs, 32);
                l = l * alpha + rs; m = mn;
#pragma unroll
                for (int i = 0; i < 16; ++i) { oacc[0][i] *= alpha; oacc[1][i] *= alpha; }
#pragma unroll
                for (int s = 0; s < 2; ++s) { u32x4 w; w.x = pg8::cvt_pk_bf16(sacc[8 * s], sacc[8 * s + 1]); w.y = pg8::cvt_pk_bf16(sacc[8 * s + 2], sacc[8 * s + 3]); w.z = pg8::cvt_pk_bf16(sacc[8 * s + 4], sacc[8 * s + 5]); w.w = pg8::cvt_pk_bf16(sacc[8 * s + 6], sacc[8 * s + 7]);
                    pf[s] = __builtin_bit_cast(bf16x8, w); }
            };
            auto tile = [&](const u32x4 (&kp)[4], const u32x4 (&vp)[4], const int ma, const int mb) {
#pragma unroll
                for (int i = 0; i < 4; ++i) { *(LAS u32x4*)(kl + (8 * i + prow) * 144 + pch * 16) = kp[i]; *(LAS u32x4*)(vl + (8 * i + prow) * 192 + pch * 16) = vp[i]; }
                bf16x8 kf[4];
#pragma unroll
                for (int s = 0; s < 4; ++s) kf[s] = *(const LAS bf16x8*)(kl + q * 144 + (16 * s + 8 * h5) * 2);
                bf16x8 pA[2], pB[2];
                if (ma >= 0) scores(kf, qA, oA, mA, lA, ma, pA);
                if (mb >= 0) scores(kf, qB, oB, mB, lB, mb, pB);
#pragma unroll
                for (int dt = 0; dt < 2; ++dt)
#pragma unroll
                    for (int s = 0; s < 2; ++s) {
                        const s16x4 t0_ = __builtin_amdgcn_ds_read_tr16_b64_v4i16((LAS s16x4*)(vl + (16 * s + 4 * h5) * 192 + dt * 64 + tr_off));
                        const s16x4 t1_ = __builtin_amdgcn_ds_read_tr16_b64_v4i16((LAS s16x4*)(vl + (16 * s + 8 + 4 * h5) * 192 + dt * 64 + tr_off));
                        bf16x8 vf; vf[0] = t0_[0]; vf[1] = t0_[1]; vf[2] = t0_[2]; vf[3] = t0_[3]; vf[4] = t1_[0]; vf[5] = t1_[1]; vf[6] = t1_[2]; vf[7] = t1_[3];
                        if (ma >= 0) oA[dt] = __builtin_amdgcn_mfma_f32_32x32x16_bf16(vf, pA[s], oA[dt], 0, 0, 0);
                        if (mb >= 0) oB[dt] = __builtin_amdgcn_mfma_f32_32x32x16_bf16(vf, pB[s], oB[dt], 0, 0, 0);
                    }
                LDS_WAIT();
            };
            tile(k0, v0, -1, 1);
            if (e3) { ATT_LOAD(k0, I0 - 32, 1024); ATT_LOAD(v0, I0 - 32, 2048); }
            tile(k1, v1, 1, 0);
            if (e3) {
                if (e2) { ATT_LOAD(k1, I0 - 64, 1024); ATT_LOAD(v1, I0 - 64, 2048); }
                tile(k0, v0, 0, 0);
                if (e2) {
                    if (e1) { ATT_LOAD(k0, I0 - 96, 1024); ATT_LOAD(v0, I0 - 96, 2048); }
                    tile(k1, v1, 0, 0);
                    if (e1) {
                        if (e0) { ATT_LOAD(k1, I0 - 128, 1024); ATT_LOAD(v1, I0 - 128, 2048); }
                        tile(k0, v0, 0, 2);
                        if (e0) tile(k1, v1, 2, -1);
                    }
                }
            }
#undef ATT_LOAD
#pragma unroll
            for (int qt = 0; qt < 2; ++qt) {
                const size_t tq = (size_t)b * SEQ + (size_t)(I0 + 32 * qt + q) * d + r;
                const float l = qt ? lB : lA, m = qt ? mB : mA; const float inv = __builtin_amdgcn_rcpf(l);
                bf16_t* pr = po + ((size_t)br * T + tq) * 1024 + hd * 64;
#pragma unroll
                for (int dt = 0; dt < 2; ++dt)
#pragma unroll
                    for (int gq = 0; gq < 4; ++gq) { const f32x16& oo = qt ? oB[dt] : oA[dt]; u32x2 w; w.x = pg8::cvt_pk_bf16(oo[4 * gq] * inv, oo[4 * gq + 1] * inv); w.y = pg8::cvt_pk_bf16(oo[4 * gq + 2] * inv, oo[4 * gq + 3] * inv);
                        *(u32x2*)(pr + 32 * dt + 8 * gq + 4 * h5) = w; }
                if (h5 == 0) plse[((size_t)br * T + tq) * 16 + hd] = m + __logf(l);
            }
        }
        VM_WAIT(); __syncthreads();
        for (int hf = 0; hf < 2; ++hf) {
            const size_t t = (size_t)b * SEQ + 1024 * g + 512 * hf + X.tid;
            const float l0 = plse[t * 16 + hd], l1 = plse[((size_t)T + t) * 16 + hd], l2 = plse[((size_t)2 * T + t) * 16 + hd];
            const float mx = fmaxf(l0, fmaxf(l1, l2)); float w0 = __expf(l0 - mx), w1 = __expf(l1 - mx), w2 = __expf(l2 - mx); const float wi = __builtin_amdgcn_rcpf(w0 + w1 + w2); w0 *= wi; w1 *= wi; w2 *= wi;
            const bf16_t* p0 = po + t * 1024 + hd * 64; const bf16_t* p1 = p0 + (size_t)T * 1024; const bf16_t* p2 = p1 + (size_t)T * 1024; unsigned char* orow = o + t * 1024 + hd * 64;
            w0 *= 4.f; w1 *= 4.f; w2 *= 4.f;
            u32x4 yq[4];
#pragma unroll
            for (int c = 0; c < 8; ++c) { const u32x4 x0 = *(const u32x4*)(p0 + 8 * c), x1 = *(const u32x4*)(p1 + 8 * c), x2 = *(const u32x4*)(p2 + 8 * c); float f[8];
#pragma unroll
                for (int e = 0; e < 4; ++e) { f[2 * e] = w0 * __uint_as_float(x0[e] << 16) + w1 * __uint_as_float(x1[e] << 16) + w2 * __uint_as_float(x2[e] << 16);
                    f[2 * e + 1] = w0 * __uint_as_float(x0[e] & 0xFFFF0000u) + w1 * __uint_as_float(x1[e] & 0xFFFF0000u) + w2 * __uint_as_float(x2[e] & 0xFFFF0000u); }
#pragma unroll
                for (int e = 0; e < 8; ++e) f[e] = fminf(fmaxf(f[e], -440.f), 440.f);
                int v0 = __builtin_amdgcn_cvt_pk_fp8_f32(f[0], f[1], 0, false); v0 = __builtin_amdgcn_cvt_pk_fp8_f32(f[2], f[3], v0, true);
                int v1 = __builtin_amdgcn_cvt_pk_fp8_f32(f[4], f[5], 0, false); v1 = __builtin_amdgcn_cvt_pk_fp8_f32(f[6], f[7], v1, true);
                yq[c >> 1][2 * (c & 1)] = (unsigned)v0; yq[c >> 1][2 * (c & 1) + 1] = (unsigned)v1; }
#pragma unroll
            for (int j = 0; j < 4; ++j) *(u32x4*)(orow + 16 * j) = yq[j];
        }
    }
}

DEV void ph_router(const Args& a, const Ctx& X, const int l) {
    unsigned char* ws = a.ws;
    const float* mod = (const float*)(ws + WS_MOD) + (size_t)l * NB * 6 * D;
    const bf16_t* ymix = (const bf16_t*)(ws + WS_YMIX);
    bf16_t* xb = (bf16_t*)(ws + WS_XB);
    bf16_t* hb = (bf16_t*)(ws + WS_H);
    int* idx = (int*)(ws + WS_IDX); float* gw = (float*)(ws + WS_GW); int* aslot = (int*)(ws + WS_ASLOT); int* ltok = (int*)(ws + WS_LTOK);
    int* cntg = (int*)(ws + WS_CTL + CTL_CNT) + l * NE;
    const float* rw = a.router_w + (size_t)l * D * NE; const float* rbias = a.router_bias + l * NE;
    constexpr int HP = 2064;
    LAS unsigned char* hL = X.lds;
    LAS float* logit = (LAS float*)(X.lds + AUX_OFF + 2048);
    LAS int* lcnt = (LAS int*)(X.lds + AUX_OFF + 2048 + 64 * 65 * 4);
    LAS int* lbase = lcnt + 64;
    LAS int* sel_e = lbase + 64;
    LAS int* sel_s = sel_e + 512;
    const int lane = X.lane, wave = X.wave;
    for (int rb = X.bid; rb < T / 64; rb += X.G) {
        if (X.tid < 64) lcnt[X.tid] = 0;
        f32x4 xf_n[4]; u32x2 xb_n[4], ym_n[4];
#define RT_LOAD(rr) do { const int _row = rb * 64 + wave * 8 + (rr); _Pragma("unroll") for (int _j = 0; _j < 4; ++_j) { \
            if (l == 0) xf_n[_j] = *(const f32x4*)(a.x + (size_t)_row * D + _j * 256 + lane * 4); else xb_n[_j] = *(const u32x2*)(xb + (size_t)_row * D + _j * 256 + lane * 4); \
            ym_n[_j] = *(const u32x2*)(ymix + (size_t)_row * D + _j * 256 + lane * 4); } } while (0)
        RT_LOAD(0);
        for (int r8 = 0; r8 < 8; ++r8) {
            const int lr = wave * 8 + r8, row = rb * 64 + lr, b = row / SEQ; const float* ml = mod + (size_t)b * 6 * D;
            float xv[16], yv[16];
#pragma unroll
            for (int j = 0; j < 4; ++j) {
                if (l == 0) { xv[4 * j] = xf_n[j][0]; xv[4 * j + 1] = xf_n[j][1]; xv[4 * j + 2] = xf_n[j][2]; xv[4 * j + 3] = xf_n[j][3]; }
                else { xv[4 * j] = __uint_as_float(xb_n[j].x << 16); xv[4 * j + 1] = __uint_as_float(xb_n[j].x & 0xFFFF0000u); xv[4 * j + 2] = __uint_as_float(xb_n[j].y << 16); xv[4 * j + 3] = __uint_as_float(xb_n[j].y & 0xFFFF0000u); }
                yv[4 * j] = __uint_as_float(ym_n[j].x << 16); yv[4 * j + 1] = __uint_as_float(ym_n[j].x & 0xFFFF0000u); yv[4 * j + 2] = __uint_as_float(ym_n[j].y << 16); yv[4 * j + 3] = __uint_as_float(ym_n[j].y & 0xFFFF0000u); }
            if (r8 + 1 < 8) RT_LOAD(r8 + 1);
            resid_update(xv, yv, a.mix_post_g + l * D, ml + 2 * D, lane);
            store_row_bf(xb + (size_t)row * D, lane, xv);
            u32x2 o[4]; prenorm_pack(xv, a.ffn_pre_g + l * D, ml + 4 * D, ml + 3 * D, lane, o);
#pragma unroll
            for (int j = 0; j < 4; ++j) { *(LAS u32x2*)(hL + lr * HP + (j * 256 + lane * 4) * 2) = o[j];
                const float h0 = __uint_as_float(o[j].x << 16), h1 = __uint_as_float(o[j].x & 0xFFFF0000u), h2 = __uint_as_float(o[j].y << 16), h3 = __uint_as_float(o[j].y & 0xFFFF0000u);
                int w = __builtin_amdgcn_cvt_pk_fp8_f32(fminf(fmaxf(h0, -440.f), 440.f), fminf(fmaxf(h1, -440.f), 440.f), 0, false); w = __builtin_amdgcn_cvt_pk_fp8_f32(fminf(fmaxf(h2, -440.f), 440.f), fminf(fmaxf(h3, -440.f), 440.f), w, true);
                *(unsigned*)((unsigned char*)hb + (size_t)row * D + j * 256 + lane * 4) = (unsigned)w; }
        }
#undef RT_LOAD
        __syncthreads();
        { const int rt = wave & 3, nh = wave >> 2, r16 = lane & 15, kq = lane >> 4;
          f32x4 acc0 = {0.f, 0.f, 0.f, 0.f}, acc1 = {0.f, 0.f, 0.f, 0.f};
          for (int c = 0; c < 32; ++c) {
              const u32x4 hv = *(const LAS u32x4*)(hL + (rt * 16 + r16) * HP + (32 * c + 8 * kq) * 2);
              const float* rp = rw + (size_t)(32 * c + 8 * kq) * NE + 4 * r16 + 2 * nh;
#pragma unroll
              for (int j = 0; j < 8; ++j) { const unsigned wj = hv[j >> 1]; const float av = (j & 1) ? __uint_as_float(wj & 0xFFFF0000u) : __uint_as_float(wj << 16);
                  const f32x2 bv = *(const f32x2*)(rp + (size_t)j * NE);
                  acc0 = __builtin_amdgcn_mfma_f32_16x16x4f32(av, bv.x, acc0, 0, 0, 0); acc1 = __builtin_amdgcn_mfma_f32_16x16x4f32(av, bv.y, acc1, 0, 0, 0); }
          }
#pragma unroll
          for (int r = 0; r < 4; ++r) { logit[(rt * 16 + 4 * kq + r) * 65 + 4 * r16 + 2 * nh] = acc0[r]; logit[(rt * 16 + 4 * kq + r) * 65 + 4 * r16 + 2 * nh + 1] = acc1[r]; } }
        __syncthreads();
        for (int r8 = 0; r8 < 8; ++r8) {
            const int lr = wave * 8 + r8, t = rb * 64 + lr;
            float lgt = logit[lr * 65 + lane]; if (!(lgt > -1e30f && lgt < 1e30f)) lgt = 0.f;
            const float score = sigmoidf_(lgt), biased = score + rbias[lane];
            const float m1 = max8(biased);
            const int c1 = min8((biased == m1) ? (lane & 7) : 8);
            const float m2 = max8(((lane & 7) == c1) ? -INFINITY : biased);
            const float gs = m1 + m2; const int myg = lane >> 3; int grank = 0;
#pragma unroll
            for (int g2 = 0; g2 < 8; ++g2) { const float o = rlf(gs, g2 * 8); grank += (o > gs || (o == gs && g2 < myg)) ? 1 : 0; }
            const float cand = (grank < 4) ? biased : -INFINITY; int rank = 0;
#pragma unroll 8
            for (int e2 = 0; e2 < 64; ++e2) { const float o = rlf(cand, e2); rank += (o > cand || (o == cand && e2 < lane)) ? 1 : 0; }
            const bool sel = (rank < TOPK) && (grank < 4);
            const float ssum = wave_sum(sel ? score : 0.f);
            if (sel) { idx[t * 8 + rank] = lane; gw[t * 8 + rank] = score * __builtin_amdgcn_rcpf(ssum) * 2.5f; sel_e[lr * 8 + rank] = lane; sel_s[lr * 8 + rank] = __hip_atomic_fetch_add(lcnt + lane, 1, __ATOMIC_RELAXED, __HIP_MEMORY_SCOPE_WORKGROUP); }
        }
        __syncthreads();
        if (X.tid < 64) { const int n = lcnt[X.tid]; lbase[X.tid] = n ? atomicAdd(cntg + X.tid, n) : 0; }
        __syncthreads();
        { const int lr = X.tid >> 3, k = X.tid & 7, t = rb * 64 + lr, e = sel_e[lr * 8 + k], sl = lbase[e] + sel_s[lr * 8 + k];
          aslot[t * 8 + k] = sl; ltok[e * CAP + sl] = t; }
        __syncthreads();
    }
}
template <int NW>
DEV void ph_moe_conv(const Args& a, const Ctx& X, const int l, const int widx, const int nwg, const int it0, const int it1) {
    unsigned char* ws = a.ws;
    if (X.wave >= NW) return;
    { LAS float* scr = (LAS float*)(X.lds + X.wave * 8704);
      const int gwv = widx * NW + X.wave, NGW = nwg * NW;
      constexpr int I_GU = (D / 64) * (512 / 32), I_D = (ED / 64) * (D / 32), I_E = I_GU + I_D;
      const float* eg = a.exp_gate + (size_t)l * NE * D * ED; const float* eu = a.exp_up + (size_t)l * NE * D * ED; const float* ed = a.exp_down + (size_t)l * NE * ED * D;
      const int itend = it1 < 0 ? (NE + 1) * I_E : it1;
      for (int it = it0 + gwv; it < itend; it += NGW) {
          const int e = it / I_E; int r = it - e * I_E;
          if (e < NE) {
              if (r < I_GU) conv_item<SrcGU, true>(SrcGU{eg + (size_t)e * D * ED, (long)(eu - eg)}, ED, D, ws + WS_WGU + (size_t)e * 512 * D, scr, r, 16, X.lane, 64.f);
              else conv_item<SrcIdent, true>(SrcIdent{ed + (size_t)e * ED * D}, D, ED, ws + WS_WD + (size_t)e * D * ED, scr, r - I_GU, D / 32, X.lane, 32.f);
          } else {
              if (r < I_GU) conv_item<SrcGU, true>(SrcGU{a.sh_gate + (size_t)l * D * ED, (long)(a.sh_up - a.sh_gate)}, ED, D, ws + WS_WGUS, scr, r, 16, X.lane, 64.f);
              else conv_item<SrcIdent, true>(SrcIdent{a.sh_down + (size_t)l * ED * D}, D, ED, ws + WS_WDS, scr, r - I_GU, D / 32, X.lane, 32.f);
          }
      } }
}

DEV int moe_tables(const Args& a, const Ctx& X, const int l, LAS int* t_cnt, LAS int* t_rb0, LAS int* t_eofrb) {
    const int* cntg = (const int*)(a.ws + WS_CTL + CTL_CNT) + l * NE;
    if (X.wave == 0) {
        const int c = __hip_atomic_load(cntg + X.lane, __ATOMIC_RELAXED, __HIP_MEMORY_SCOPE_AGENT), nrb = (c + 255) >> 8;
        int incl = nrb;
#pragma unroll
        for (int o = 1; o < 64; o <<= 1) { const int v = __shfl_up(incl, o); if (X.lane >= o) incl += v; }
        const int excl = incl - nrb;
        t_cnt[X.lane] = c; t_rb0[X.lane] = excl; if (X.lane == 63) t_rb0[64] = incl;
        for (int j = 0; j < nrb; ++j) t_eofrb[excl + j] = X.lane;
        t_eofrb[SH_RB + X.lane] = NE;
    }
    __syncthreads();
    return t_rb0[64];
}

DEV void ph_moe_gu(const Args& a, const Ctx& X, const int l) {
    LAS int* t_cnt = (LAS int*)(X.lds + AUX_OFF + 1024); LAS int* t_rb0 = t_cnt + 64; LAS int* t_eofrb = t_rb0 + 80; LAS int* toks = t_eofrb + NRB_ALL;
    const int nrbt = moe_tables(a, X, l, t_cnt, t_rb0, t_eofrb);
    const int* ltok = (const int*)(a.ws + WS_LTOK);
    pg8::Unit u;
    for (int i = 0; i < 8; ++i) { if (!pg8::moe_unit(i, 2, nrbt, X.G, X.bid, u)) break;
        if (X.tid < 256) { const int e = t_eofrb[u.pm]; int tok;
            if (e < NE) { const int sl = (u.pm - t_rb0[e]) * 256 + X.tid; tok = sl < t_cnt[e] ? ltok[e * CAP + sl] : 0; } else tok = (u.pm - SH_RB) * 256 + X.tid;
            toks[i * 256 + X.tid] = tok; } }
    VM_WAIT(); __syncthreads();
    pg8::SchedGU S{(const char*)(a.ws + WS_H), (const char*)(a.ws + WS_WGU), (const char*)(a.ws + WS_WGUS), t_eofrb, toks, nrbt, X.G, X.bid, 0};
    pg8::EpiGU E{a.ws + WS_HID};
    pg8::gemm_phase<pg8::EpiGU, pg8::SchedGU, true>(X.lds, D, S, E);
}
DEV void ph_moe_down(const Args& a, const Ctx& X, const int l) {
    LAS int* t_cnt = (LAS int*)(X.lds + AUX_OFF + 1024); LAS int* t_rb0 = t_cnt + 64; LAS int* t_eofrb = t_rb0 + 80;
    const int nrbt = moe_tables(a, X, l, t_cnt, t_rb0, t_eofrb);
    pg8::SchedDown S{(const char*)(a.ws + WS_HID), (const char*)(a.ws + WS_WD), (const char*)(a.ws + WS_WDS), t_eofrb, nrbt, X.G, X.bid, 0};
    pg8::EpiFp8 E{(unsigned char*)(a.ws + WS_Y), D, 0};
    int kd = ED; asm volatile("" : "+s"(kd));
    pg8::gemm_phase<pg8::EpiFp8, pg8::SchedDown, true>(X.lds, kd, S, E);
}
DEV void ph_combine(const Args& a, const Ctx& X, const int l) {
    LAS int* t_cnt = (LAS int*)(X.lds + AUX_OFF + 1024); LAS int* t_rb0 = t_cnt + 64; LAS int* t_eofrb = t_rb0 + 80;
    (void)moe_tables(a, X, l, t_cnt, t_rb0, t_eofrb);
    const float* mod = (const float*)(a.ws + WS_MOD);
    const int* idx = (const int*)(a.ws + WS_IDX); const float* gw = (const float*)(a.ws + WS_GW); const int* aslot = (const int*)(a.ws + WS_ASLOT);
    const unsigned char* y = a.ws + WS_Y; unsigned char* h8 = a.ws + WS_H;
    const int lane = X.lane;
    const int tstep = X.G * NWAVES;
    int t = X.bid * NWAVES + X.wave;
    int e_n = 0, s_n = 0; float g_n = 0.f;
    if (t < T && lane < 8) { e_n = idx[t * 8 + lane]; g_n = gw[t * 8 + lane]; s_n = aslot[t * 8 + lane]; }
    for (; t < T; t += tstep) {
        const int b = t / SEQ; const float* ml = mod + (size_t)(l * NB + b) * 6 * D;
        const int e_c = e_n, s_c = s_n; const float g_c = g_n;
        const int tn = t + tstep;
        if (tn < T && lane < 8) { e_n = idx[tn * 8 + lane]; g_n = gw[tn * 8 + lane]; s_n = aslot[tn * 8 + lane]; }
        u32x2 w0[9], w1[9];
        { const unsigned char* yr = y + ((size_t)SH_RB * 256 + t) * D; w0[8] = *(const u32x2*)(yr + 8 * lane); w1[8] = *(const u32x2*)(yr + 512 + 8 * lane); }
        float gk[8];
#pragma unroll
        for (int k = 0; k < 8; ++k) { const int e = rli(e_c, k), sl = rli(s_c, k); gk[k] = rlf(g_c, k);
            const unsigned char* yr = y + ((size_t)t_rb0[e] * 256 + sl) * D; w0[k] = *(const u32x2*)(yr + 8 * lane); w1[k] = *(const u32x2*)(yr + 512 + 8 * lane); }
        float xv[16]; load_row8_bf((const bf16_t*)(a.ws + WS_XB) + (size_t)t * D, lane, xv);
        float yv[16];
#pragma unroll
        for (int i = 0; i < 16; ++i) yv[i] = 0.f;
        acc_row8(yv, w0[8], w1[8], 0.125f);
#pragma unroll
        for (int k = 0; k < 8; ++k) acc_row8(yv, w0[k], w1[k], gk[k] * 0.125f);
        resid_update8(xv, yv, a.ffn_post_g + l * D, ml + 5 * D, lane);
        if (l == 0) store_row8_bf((bf16_t*)(a.ws + WS_XB) + (size_t)t * D, lane, xv); else store_row8(a.out + (size_t)t * D, lane, xv);
        if (l == 0) { const float* mn = mod + (size_t)(1 * NB + b) * 6 * D; u32x2 o[2]; prenorm_pack8_f8(xv, a.mix_pre_g + D, mn + D, mn, lane, o);
            *(u32x2*)(h8 + (size_t)t * D + 8 * lane) = o[0]; *(u32x2*)(h8 + (size_t)t * D + 512 + 8 * lane) = o[1]; }
    }
}

constexpr int NPH = 18;
__global__ void __launch_bounds__(NTHR, 2) mega(Args a) {
    extern __shared__ __attribute__((aligned(16))) unsigned char lds_raw[];
    Ctx X; X.lds = (LAS unsigned char*)lds_raw; X.tid = threadIdx.x; X.lane = X.tid & 63; X.wave = __builtin_amdgcn_readfirstlane(X.tid >> 6); X.G = gridDim.x; X.bid = blockIdx.x;
    if (X.tid < 4) ((LAS unsigned*)(X.lds + BAR_OFF))[X.tid] = 0u;
    __syncthreads();
    XcdBarrier bar; bar.bar = (unsigned*)(a.ws + WS_CTL); bar.x = 0; bar.st = nullptr;
    if (!MK_PER_PHASE) bar = xcd_barrier_post((unsigned*)(a.ws + WS_CTL), (volatile LAS unsigned*)(X.lds + BAR_OFF));
    const int lo = a.ph_lo, hi = a.ph_hi;
#define IN(k) (lo <= (k) && (k) < hi)
#define REP(k, ...) do { __VA_ARGS__; if constexpr (((PROBE_MASK >> (k)) & 1u) != 0u) { __syncthreads(); __VA_ARGS__; } } while (0)
#define SEAM(k) do { if (IN(k) && IN((k) + 1)) xcd_barrier(bar); else { VM_WAIT(); __syncthreads(); } } while (0)
    unsigned char* ws = a.ws;
    if (IN(0)) { REP(0, ph_setup(a, X)); SEAM(0); }
    if (IN(1)) { REP(1, ph_prenorm0(a, X)); SEAM(1); }
    if constexpr (((PROBE_MASK >> 24) & 1u) != 0u) { for (int i_ = 0; i_ < 16; ++i_) xcd_barrier(bar); }
    if (IN(2)) {
        pg8::SchedDense8<0x79797979, 0x7F7F7F7F> S; S.so.init(T, NPROJ, X.G, X.bid); S.A = (const char*)(ws + WS_H); S.Bt = (const char*)(ws + WS_WIN); S.K = D; S.pad_ = 0;
        pg8::EpiProj E{(bf16_t*)(ws + WS_QKVPRE), (bf16_t*)(ws + WS_ZA), (bf16_t*)(ws + WS_XBCPRE), (bf16_t*)(ws + WS_ZB), (float*)(ws + WS_SMALL)};
        REP(2, pg8::gemm_phase<pg8::EpiProj, pg8::SchedDense8<0x79797979, 0x7F7F7F7F>, true>(X.lds, D, S, E)); SEAM(2); }
    if (IN(3)) { REP(3, ph_gdn_local(a, X)); SEAM(3); }
    if (IN(4)) {
        if (X.bid < 32) { REP(4, ph_gdn_scan(a, X)); }
        else {
            const int w = X.bid - 32, nw = X.G - 32; unsigned* gctr = (unsigned*)(ws + WS_CTL + CTL_GRP);
            constexpr int CONV_P1 = PROBE_CONVP1;
            REP(20, ph_ssd_local(a, X, 32)); __syncthreads();
            if (w >= 32) { REP(22, ph_moe_conv<2>(a, X, 0, w - 32, nw - 32, 0, CONV_P1)); }
            group_barrier(gctr, (unsigned)nw); __syncthreads();
            ph_ssd_scan(a, X, 32);
            group_barrier(gctr, 2u * (unsigned)nw); __syncthreads();
            REP(5, ph_ssd_out(a, X, 32, nw - 32)); __syncthreads();
            if (w < 32 || w >= 64) { const int wi = w < 32 ? w : w - 32; ph_moe_conv<2>(a, X, 0, wi, nw - 32, CONV_P1, -1); __syncthreads(); REP(23, ph_setup_late(a, X, wi, nw - 32)); }
        }
        SEAM(4); }
    if (IN(6)) {
        pg8::SchedDense S; S.so.init(T, D, X.G, X.bid); S.A = (const char*)(ws + WS_OY); S.Bt = (const char*)(ws + WS_WOUT); S.K = 2048; S.pad_ = 0;
        pg8::EpiBf16 E{(bf16_t*)(ws + WS_YMIX), D, 0};
        REP(6, pg8::gemm_phase<pg8::EpiBf16, pg8::SchedDense>(X.lds, 2048, S, E)); SEAM(6); }
    if (IN(7)) { ph_router(a, X, 0); SEAM(7); }
    if (IN(8)) { REP(8, ph_moe_gu(a, X, 0)); SEAM(8); }
    if (IN(9)) { REP(9, ph_moe_down(a, X, 0)); SEAM(9); }
    if (IN(10)) { ph_combine(a, X, 0); SEAM(10); }
    if (IN(11)) {
        pg8::SchedDense8<0x79797979, 0x7F7F7F7F> S; S.so.init(T, 3072, X.G, X.bid); S.A = (const char*)(ws + WS_H); S.Bt = (const char*)(ws + WS_WQKV); S.K = D; S.pad_ = 0;
        pg8::EpiQKV E{(bf16_t*)(ws + WS_Q1KV), (const float*)(ws + WS_COS), (const float*)(ws + WS_SIN)};
        REP(11, pg8::gemm_phase<pg8::EpiQKV, pg8::SchedDense8<0x79797979, 0x7F7F7F7F>, true>(X.lds, D, S, E)); SEAM(11); }
    if (IN(12)) { REP(12, ph_attn(a, X)); SEAM(12); }
    if (IN(13)) {
        pg8::SchedDense8<0x79797979, 0x7D7D7D7D> S; S.so.init(T, D, X.G, X.bid); S.A = (const char*)(ws + WS_O1); S.Bt = (const char*)(ws + WS_WO); S.K = D; S.pad_ = 0;
        pg8::EpiBf16 E{(bf16_t*)(ws + WS_YMIX), D, 0};
        REP(13, pg8::gemm_phase<pg8::EpiBf16, pg8::SchedDense8<0x79797979, 0x7D7D7D7D>, true>(X.lds, D, S, E)); SEAM(13); }
    if (IN(14)) { ph_router(a, X, 1); REP(14, ph_moe_conv<8>(a, X, 1, X.bid, X.G, 0, -1)); SEAM(14); }
    if (IN(15)) { ph_moe_gu(a, X, 1); SEAM(15); }
    if (IN(16)) { ph_moe_down(a, X, 1); SEAM(16); }
    if (IN(17)) { REP(17, ph_combine(a, X, 1)); }
#undef IN
#undef SEAM
}

extern "C" void kernel_launch(void* const* d_in, const int* in_sizes, int n_in, void* d_out, int out_size, void* d_ws, size_t ws_size, hipStream_t stream) {
    static int grid = 0;
    if (!grid) {
        int dev = 0, cus = 0, per_cu = 0;
        if (hipGetDevice(&dev) != hipSuccess || hipDeviceGetAttribute(&cus, hipDeviceAttributeMultiprocessorCount, dev) != hipSuccess) { fprintf(stderr, "kernel_launch: device query failed\n"); grid = -1; return; }
        if (hipFuncSetAttribute((const void*)mega, hipFuncAttributeMaxDynamicSharedMemorySize, LDS_BYTES) != hipSuccess) { fprintf(stderr, "kernel_launch: hipFuncSetAttribute failed\n"); grid = -1; return; }
        if (hipOccupancyMaxActiveBlocksPerMultiprocessor(&per_cu, (const void*)mega, NTHR, LDS_BYTES) != hipSuccess || per_cu < 1) { fprintf(stderr, "kernel_launch: occupancy query says %d blocks per CU\n", per_cu); grid = -1; return; }
        grid = cus;
        if (grid < 64 || (grid & 7)) { fprintf(stderr, "kernel_launch: unsupported CU count %d\n", cus); grid = -1; return; }
    }
    if (grid < 0) return;
    if (ws_size < WS_END || n_in != 31) { fprintf(stderr, "kernel_launch: workspace %zu < %zu or n_in %d != 31\n", ws_size, (size_t)WS_END, n_in); return; }
    if (hipMemsetAsync((char*)d_ws + WS_CTL, 0, CTL_BYTES, stream) != hipSuccess) { fprintf(stderr, "kernel_launch: memset failed\n"); return; }
    Args a{};
    a.x = (const float*)d_in[0]; a.c = (const float*)d_in[1]; a.pos = (const int*)d_in[2]; a.mod_w = (const float*)d_in[3]; a.mod_b = (const float*)d_in[4];
    a.mix_pre_g = (const float*)d_in[5]; a.mix_post_g = (const float*)d_in[6]; a.ffn_pre_g = (const float*)d_in[7]; a.ffn_post_g = (const float*)d_in[8];
    a.ssm_w_in = (const float*)d_in[9]; a.gdn_conv_w = (const float*)d_in[10]; a.gdn_a_log = (const float*)d_in[11]; a.gdn_dt_bias = (const float*)d_in[12]; a.gdn_norm_w = (const float*)d_in[13];
    a.ssd_conv_w = (const float*)d_in[14]; a.ssd_conv_b = (const float*)d_in[15]; a.ssd_a_log = (const float*)d_in[16]; a.ssd_dt_bias = (const float*)d_in[17]; a.ssd_d = (const float*)d_in[18]; a.ssd_norm_w = (const float*)d_in[19];
    a.ssm_w_out = (const float*)d_in[20]; a.attn_w_qkv = (const float*)d_in[21]; a.attn_w_o = (const float*)d_in[22];
    a.router_w = (const float*)d_in[23]; a.router_bias = (const float*)d_in[24]; a.exp_gate = (const float*)d_in[25]; a.exp_up = (const float*)d_in[26]; a.exp_down = (const float*)d_in[27];
    a.sh_gate = (const float*)d_in[28]; a.sh_up = (const float*)d_in[29]; a.sh_down = (const float*)d_in[30];
    a.out = (float*)d_out; a.ws = (unsigned char*)d_ws;
#if MK_PER_PHASE
    for (int p = 0; p < NPH; ++p) { a.ph_lo = p; a.ph_hi = p + 1; hipLaunchKernelGGL(mega, dim3(grid), dim3(NTHR), LDS_BYTES, stream, a); }
#else
    a.ph_lo = 0; a.ph_hi = NPH;
    hipLaunchKernelGGL(mega, dim3(grid), dim3(NTHR), LDS_BYTES, stream, a);
#endif
}
```

```cpp
#include <hip/hip_runtime.h>
#include <stdint.h>
#include <stdio.h>

#define DEV __device__ __forceinline__
#define LAS __attribute__((address_space(3)))
typedef unsigned short bf16_t;
typedef short bf16x8 __attribute__((ext_vector_type(8)));
typedef float f32x4 __attribute__((ext_vector_type(4)));
typedef float f32x2 __attribute__((ext_vector_type(2)));
typedef unsigned u32x4 __attribute__((ext_vector_type(4)));
typedef unsigned u32x2 __attribute__((ext_vector_type(2)));
typedef float f32x16 __attribute__((ext_vector_type(16)));
typedef short s16x4 __attribute__((ext_vector_type(4)));

#ifndef PROBE_MASK
#define PROBE_MASK 0u
#endif
#ifndef PROBE_CONVP1
#define PROBE_CONVP1 15360
#endif
#ifndef MK_PER_PHASE
#define MK_PER_PHASE 0
#endif

constexpr int NB = 4, SEQ = 4096, T = NB * SEQ, D = 1024;
constexpr int PROJ = 6688, NPROJ = 6912;
constexpr int C_BETA = 4096, C_XBC = 4112, C_ZB = 5648, C_DT = 6672;
constexpr int NE = 64, TOPK = 8, ED = 256, CAP = 16384;
constexpr int SH_RB = 576;
constexpr int NRB_ALL = SH_RB + 64;
constexpr float EPS = 1e-6f;
constexpr int NTHR = 512, NWAVES = 8;
constexpr int LDS_BYTES = 163840;
constexpr int AUX_OFF = 131072;
constexpr int BAR_OFF = LDS_BYTES - 16;

constexpr size_t MiB = 1u << 20;
constexpr size_t WS_CTL = 0, CTL_BYTES = 65536;
constexpr size_t CTL_CNT = 16384;
constexpr size_t CTL_GRP = 20480;
constexpr size_t WS_MOD = 65536;
constexpr size_t WS_COS = 1 * MiB, WS_SIN = 3 * MiB;
constexpr size_t WS_IDX = 5 * MiB, WS_GW = 5 * MiB + 512 * 1024, WS_ASLOT = 6 * MiB, WS_LTOK = 6 * MiB + 512 * 1024;
constexpr size_t WS_SMALL = 11 * MiB;
constexpr size_t WS_WIN = 16 * MiB, WS_WOUT = 30 * MiB, WS_WQKV = 34 * MiB, WS_WO = 40 * MiB;
constexpr size_t WS_H = 44 * MiB;
constexpr size_t WS_QKVPRE = 78 * MiB, WS_XBCPRE = 174 * MiB, WS_ZA = 222 * MiB, WS_ZB = 254 * MiB;
constexpr size_t WS_CC = 16 * MiB, WS_ACUM = 25 * MiB, WS_CDEC = 26 * MiB, WS_YDIAG = 44 * MiB, WS_STATES = 430 * MiB;
constexpr size_t WS_GI = 286 * MiB, GI_UNIT = 73728, WS_GTMP = 462 * MiB, WS_GLAST = 27 * MiB;
constexpr size_t WS_OY = 78 * MiB, WS_YMIX = 286 * MiB, WS_XB = 240 * MiB;
constexpr size_t WS_WD = 478 * MiB, WS_WDS = 510 * MiB + 512 * 1024, WS_HID = 398 * MiB, WS_Y = 78 * MiB, WS_WGU = 142 * MiB, WS_WGUS = 207 * MiB;
constexpr size_t WS_Q1KV = 78 * MiB, WS_O1 = 174 * MiB, WS_PO = 350 * MiB, WS_PLSE = 446 * MiB;
constexpr size_t WS_END = 512 * MiB;

struct Args {
    const float* x; const float* c; const int* pos; const float* mod_w; const float* mod_b;
    const float* mix_pre_g; const float* mix_post_g; const float* ffn_pre_g; const float* ffn_post_g;
    const float* ssm_w_in; const float* gdn_conv_w; const float* gdn_a_log; const float* gdn_dt_bias; const float* gdn_norm_w;
    const float* ssd_conv_w; const float* ssd_conv_b; const float* ssd_a_log; const float* ssd_dt_bias; const float* ssd_d; const float* ssd_norm_w;
    const float* ssm_w_out; const float* attn_w_qkv; const float* attn_w_o;
    const float* router_w; const float* router_bias; const float* exp_gate; const float* exp_up; const float* exp_down;
    const float* sh_gate; const float* sh_up; const float* sh_down;
    float* out; unsigned char* ws; int ph_lo, ph_hi;
};

DEV float bf2f(bf16_t v) { return __uint_as_float(((unsigned)v) << 16); }
typedef __bf16 bf16x2_hw __attribute__((ext_vector_type(2)));
DEV unsigned pk2(float lo, float hi) { const bf16x2_hw v = {(__bf16)lo, (__bf16)hi}; return __builtin_bit_cast(unsigned, v); }
DEV unsigned f2bf(float f) { return pk2(f, 0.f) & 0xFFFFu; }
template <int CTRL> DEV float dppf(float v) { return __builtin_bit_cast(float, __builtin_amdgcn_update_dpp(0, __builtin_bit_cast(int, v), CTRL, 0xF, 0xF, true)); }
template <int CTRL> DEV int dppi(int v) { return __builtin_amdgcn_update_dpp(0, v, CTRL, 0xF, 0xF, true); }
DEV float rlf(float v, int l) { return __builtin_bit_cast(float, __builtin_amdgcn_readlane(__builtin_bit_cast(int, v), l)); }
DEV int rli(int v, int l) { return __builtin_amdgcn_readlane(v, l); }
DEV float sum8(float v) { v += dppf<0xB1>(v); v += dppf<0x4E>(v); v += dppf<0x141>(v); return v; }
DEV float max8(float v) { v = fmaxf(v, dppf<0xB1>(v)); v = fmaxf(v, dppf<0x4E>(v)); v = fmaxf(v, dppf<0x141>(v)); return v; }
DEV int min8(int v) { v = min(v, dppi<0xB1>(v)); v = min(v, dppi<0x4E>(v)); v = min(v, dppi<0x141>(v)); return v; }
DEV float xor16_sum(float v) { const auto r = __builtin_amdgcn_permlane16_swap(__builtin_bit_cast(unsigned, v), __builtin_bit_cast(unsigned, v), false, false); return __builtin_bit_cast(float, r[0]) + __builtin_bit_cast(float, r[1]); }
DEV float xor32_sum(float v) { const auto r = __builtin_amdgcn_permlane32_swap(__builtin_bit_cast(unsigned, v), __builtin_bit_cast(unsigned, v), false, false); return __builtin_bit_cast(float, r[0]) + __builtin_bit_cast(float, r[1]); }
DEV float xor32_max(float v) { const auto r = __builtin_amdgcn_permlane32_swap(__builtin_bit_cast(unsigned, v), __builtin_bit_cast(unsigned, v), false, false); return fmaxf(__builtin_bit_cast(float, r[0]), __builtin_bit_cast(float, r[1])); }
DEV float wave_sum(float v) {
    v = sum8(v); v += dppf<0x140>(v);
    return (rlf(v, 0) + rlf(v, 16)) + (rlf(v, 32) + rlf(v, 48));
}
DEV float siluf(float x) { return x * __builtin_amdgcn_rcpf(1.f + __expf(-x)); }
DEV float sigmoidf_(float x) { return __builtin_amdgcn_rcpf(1.f + __expf(-x)); }
DEV float softplusf(float x) { return fmaxf(x, 0.f) + log1pf(__expf(-fabsf(x))); }
#define LDS_WAIT() asm volatile("s_waitcnt lgkmcnt(0)" ::: "memory")
#define VM_WAIT() asm volatile("s_waitcnt vmcnt(0)" ::: "memory")

#define XB_TMO      128
#define XB_XCNT(j)  (256  + 64 * (j))
#define XB_XSUB(j)  (1280 + 64 * (j))
#define XB_XGEN(j)  (2304 + 64 * (j))
#define XB_TOP      3328
#define XB_TOPGEN   3392
#define XCD_BAR_WORDS 3456
#define XB_SPIN_CAP (1u << 18)
#define LAS __attribute__((address_space(3)))

__device__ __forceinline__ unsigned xb_ld(unsigned* p)              { return __hip_atomic_load(p, __ATOMIC_RELAXED, __HIP_MEMORY_SCOPE_AGENT); }
__device__ __forceinline__ unsigned xb_add(unsigned* p, unsigned v) { return __hip_atomic_fetch_add(p, v, __ATOMIC_RELAXED, __HIP_MEMORY_SCOPE_AGENT); }
__device__ __forceinline__ unsigned xb_xcc_id() { return (unsigned)__builtin_amdgcn_s_getreg((3 << 11) | 20) & 0xFu; }
#define XB_SPIN(cond, bar) do { unsigned _sp = 0; while (cond) { __builtin_amdgcn_s_sleep(1); \
    if ((++_sp & 255u) == 0u) { if (xb_ld(&(bar)[XB_TMO])) break; if (_sp > XB_SPIN_CAP) { atomicAdd(&(bar)[XB_TMO], 1u); break; } } } } while (0)

struct XcdBarrier {
    unsigned* bar; unsigned x;
    volatile LAS unsigned* st;
};

__device__ __forceinline__ XcdBarrier xcd_barrier_post(unsigned* bar, volatile LAS unsigned* st) {
    XcdBarrier b; b.bar = bar; b.x = xb_xcc_id(); b.st = st;
    if (threadIdx.x == 0) (void)xb_add(&bar[XB_XCNT(b.x)], 1u);
    return b;
}
__device__ __forceinline__ void xcd_barrier_complete(unsigned* bar, unsigned x, unsigned& nloc, unsigned& nx) {
    const unsigned G = gridDim.x * gridDim.y * gridDim.z;
    unsigned sum, cnt, mine, sp = 0u;
    for (;;) {
        sum = 0u; cnt = 0u; mine = 0u;
#pragma unroll
        for (unsigned j = 0; j < 16; ++j) { const unsigned c = xb_ld(&bar[XB_XCNT(j)]); sum += c; cnt += (c > 0u) ? 1u : 0u; mine = (j == x) ? c : mine; }
        if (sum == G) break;
        __builtin_amdgcn_s_sleep(1);
        if ((++sp & 255u) == 0u) { if (xb_ld(&bar[XB_TMO])) break; if (sp > XB_SPIN_CAP) { atomicAdd(&bar[XB_TMO], 1u); break; } }
    }
    nloc = mine > 0u ? mine : 1u; nx = cnt > 0u ? cnt : 1u;
}

__device__ __forceinline__ void xcd_barrier(const XcdBarrier& b) {
    asm volatile("s_waitcnt vmcnt(0)" ::: "memory");
    __syncthreads();
    if (threadIdx.x == 0) {
        unsigned* bar = b.bar;
        __builtin_amdgcn_s_waitcnt(0);
        unsigned nloc = b.st[0], nx = b.st[1];
        if (nloc == 0u) { xcd_barrier_complete(bar, b.x, nloc, nx); b.st[0] = nloc; b.st[1] = nx; }
        const unsigned old = xb_add(&bar[XB_XSUB(b.x)], 1u);
        const unsigned gen = old / nloc;
        if (old + 1u == (gen + 1u) * nloc) {
            __builtin_amdgcn_fence(__ATOMIC_RELEASE, "agent");
            asm volatile("s_waitcnt vmcnt(0)" ::: "memory");
            const unsigned og = xb_add(&bar[XB_TOP], 1u);
            const unsigned tg = og / nx;
            if (og + 1u == (tg + 1u) * nx) xb_add(&bar[XB_TOPGEN], 1u);
            else XB_SPIN(xb_ld(&bar[XB_TOPGEN]) == tg, bar);
            __builtin_amdgcn_fence(__ATOMIC_ACQUIRE, "agent");
            xb_add(&bar[XB_XGEN(b.x)], 1u);
            asm volatile("s_waitcnt vmcnt(0)" ::: "memory");
        } else {
            XB_SPIN(xb_ld(&bar[XB_XGEN(b.x)]) == gen, bar);
            __builtin_amdgcn_fence(__ATOMIC_ACQUIRE, "agent");
            asm volatile("s_waitcnt vmcnt(0)" ::: "memory");
        }
    }
    __syncthreads();
}


DEV void group_barrier(unsigned* ctr, const unsigned n) {
    asm volatile("s_waitcnt vmcnt(0)" ::: "memory");
    __syncthreads();
    if (threadIdx.x == 0) {
        __builtin_amdgcn_fence(__ATOMIC_RELEASE, "agent");
        asm volatile("s_waitcnt vmcnt(0)" ::: "memory");
        (void)__hip_atomic_fetch_add(ctr, 1u, __ATOMIC_RELAXED, __HIP_MEMORY_SCOPE_AGENT);
        unsigned sp = 0;
        while (__hip_atomic_load(ctr, __ATOMIC_RELAXED, __HIP_MEMORY_SCOPE_AGENT) < n) { __builtin_amdgcn_s_sleep(2); if (++sp > (1u << 22)) break; }
        __builtin_amdgcn_fence(__ATOMIC_ACQUIRE, "agent");
        asm volatile("s_waitcnt vmcnt(0)" ::: "memory");
    }
    __syncthreads();
}

namespace pg8 {
constexpr int BM = 256, BK = 64, HALF = 128, HTB = HALF * BK * 2, STAGE_BYTES = 8 * HTB, NXCD = 8, WGM = 8;
DEV int lds_byte(int r, int c) { const int st = (r >> 4) * 2 + (c >> 5), rr = r & 15, cc = c & 31, ob = rr * 64 + cc * 2; return st * 1024 + (ob ^ (((ob >> 9) & 1) << 5)); }
DEV void stage_rc(int b, int& R, int& C) { const int st = b / 1024, sb = b % 1024, swz = sb ^ (((sb >> 9) & 1) << 5); R = (st >> 1) * 16 + swz / 64; C = (st & 1) * 32 + (swz % 64) / 2; }
DEV int perm32(int rho) { const int n = rho >> 4, i = rho & 15; return 8 * (i >> 2) + 4 * n + (i & 3); }
struct Unit { int pm, pn, e, slot; };
struct StaticOrder {
    int nM, nN, nwg, G, c;
    DEV void init(int M, int N, int G_, int c_) { nM = M / BM; nN = N / BM; nwg = nM * nN; G = G_; c = c_; }
    DEV bool next(int i, int& pm, int& pn) const {
        const long L = (long)i * G + c; if (L >= nwg) return false;
        int wgid = (int)L; { const int q = nwg / NXCD, r = nwg % NXCD, xcd = wgid % NXCD, off = wgid / NXCD; wgid = (xcd < r ? xcd * (q + 1) : r * (q + 1) + (xcd - r) * q) + off; }
        const int nig = WGM * nN, gid = wgid / nig, fm = gid * WGM, gsz = (nM - fm) < WGM ? (nM - fm) : WGM;
        pm = fm + ((wgid % nig) % gsz); pn = (wgid % nig) / gsz; return true;
    }
};
typedef __bf16 bf16x2_t __attribute__((ext_vector_type(2)));
DEV unsigned cvt_pk_bf16(float lo, float hi) { const bf16x2_t v = {(__bf16)lo, (__bf16)hi}; return __builtin_bit_cast(unsigned, v); }
DEV u32x4 pack8(const f32x4 a, const f32x4 b) { u32x4 w; w.x = cvt_pk_bf16(a[0], a[1]); w.y = cvt_pk_bf16(a[2], a[3]); w.z = cvt_pk_bf16(b[0], b[1]); w.w = cvt_pk_bf16(b[2], b[3]); return w; }

typedef int v8i_t __attribute__((ext_vector_type(8)));
template <class Epi, class Sched, bool F8 = false>
DEV void gemm_phase(LAS unsigned char* lds, const int K, const Sched& S, const Epi& E) {
    const int tid = threadIdx.x, wid = __builtin_amdgcn_readfirstlane(tid >> 6), lane = tid & 63, wr = wid >> 2, wc = wid & 3, fr = lane & 15, fq = lane >> 4;
    const int nt = F8 ? K / 128 : K / BK;
    const int pitch = F8 ? K : 2 * K;
    unsigned voffB[2];
#pragma unroll
    for (int i = 0; i < 2; ++i) { int R, C; stage_rc(tid * 16 + i * 8192, R, C); const int Rb = Epi::PERM ? ((R & ~31) + perm32(R & 31)) : R; voffB[i] = (unsigned)(Rb * pitch + 2 * C); }
    const unsigned kstep = (unsigned)(BK * 2);
    const size_t hstep = (size_t)HALF * pitch;
    const unsigned ldsw = (unsigned)wid * 1024u;
    const int aoff = lds_byte(wr * 64 + fr, fq * 8), boff = lds_byte(wc * 32 + fr, fq * 8);
    const size_t hsA = Sched::GATHER ? (size_t)0 : hstep;
#define PG8_SA(b, h) (((b) * 2 + (h)) * HTB)
#define PG8_SB(b, h) ((4 + (b) * 2 + (h)) * HTB)
#define PG8_STAGEB(bufoff, gbase) do { _Pragma("unroll") for (int _i = 0; _i < 2; ++_i) \
        __builtin_amdgcn_global_load_lds((const unsigned*)((const char*)(gbase) + voffB[_i]), (LAS unsigned*)(lds + (bufoff) + ldsw + _i * 8192), 16, 0, 0); } while (0)
#define PG8_STAGEA(bufoff, gbase, VO) do { _Pragma("unroll") for (int _i = 0; _i < 2; ++_i) \
        __builtin_amdgcn_global_load_lds((const unsigned*)((const char*)(gbase) + (VO)[_i]), (LAS unsigned*)(lds + (bufoff) + ldsw + _i * 8192), 16, 0, 0); } while (0)
#define PG8_LD8(var, base) do { const u32x4 _l0 = *(const LAS u32x4*)(lds + (base)), _l1 = *(const LAS u32x4*)(lds + (base) + 1024); var = __builtin_shufflevector(_l0, _l1, 0, 1, 2, 3, 4, 5, 6, 7); } while (0)
#define PG8_LDA(dst, b, h) do { if constexpr (F8) { PG8_LD8(dst##8_0, PG8_SA(b, h) + aoff); PG8_LD8(dst##8_1, PG8_SA(b, h) + aoff + 2048); PG8_LD8(dst##8_2, PG8_SA(b, h) + aoff + 4096); PG8_LD8(dst##8_3, PG8_SA(b, h) + aoff + 6144); } \
        else { _Pragma("unroll") for (int m = 0; m < 4; ++m) _Pragma("unroll") for (int k = 0; k < 2; ++k) dst[m][k] = *(const LAS bf16x8*)(lds + PG8_SA(b, h) + aoff + m * 2048 + k * 1024); } } while (0)
#define PG8_LDB(dst, b, h) do { if constexpr (F8) { PG8_LD8(dst##8_0, PG8_SB(b, h) + boff); PG8_LD8(dst##8_1, PG8_SB(b, h) + boff + 2048); } \
        else { _Pragma("unroll") for (int n = 0; n < 2; ++n) _Pragma("unroll") for (int k = 0; k < 2; ++k) dst[n][k] = *(const LAS bf16x8*)(lds + PG8_SB(b, h) + boff + n * 2048 + k * 1024); } } while (0)
#define PG8_M8(ai, bj, m, n, A8, B8) asm volatile("v_mfma_scale_f32_16x16x128_f8f6f4 %0, %1, %2, %0, %3, %4 op_sel_hi:[0,0,0]" : "+v"(acc[ai][bj][m][n]) : "v"(B8), "v"(A8), "v"(wsc_), "v"(asc_))
#define PG8_M8Z(ai, bj, m, n, A8, B8) asm volatile("v_mfma_scale_f32_16x16x128_f8f6f4 %0, %1, %2, %0, %3, %4 op_sel_hi:[0,0,0]" : "+v"(acc[ai][bj][m][n]) : "v"(B8), "v"(A8), "v"(zsc_), "v"(zsc_))
#define PG8_MMA(ai, bj, At, Bt) do { __builtin_amdgcn_s_setprio(1); \
        if constexpr (F8) { PG8_M8(ai, bj, 0, 0, At##8_0, Bt##8_0); PG8_M8(ai, bj, 0, 1, At##8_0, Bt##8_1); PG8_M8(ai, bj, 1, 0, At##8_1, Bt##8_0); PG8_M8(ai, bj, 1, 1, At##8_1, Bt##8_1); \
                            PG8_M8(ai, bj, 2, 0, At##8_2, Bt##8_0); PG8_M8(ai, bj, 2, 1, At##8_2, Bt##8_1); PG8_M8(ai, bj, 3, 0, At##8_3, Bt##8_0); PG8_M8(ai, bj, 3, 1, At##8_3, Bt##8_1); \
            if constexpr (((PROBE_MASK >> 26) & 1u) != 0u) { PG8_M8Z(ai, bj, 0, 0, At##8_0, Bt##8_0); PG8_M8Z(ai, bj, 0, 1, At##8_0, Bt##8_1); PG8_M8Z(ai, bj, 1, 0, At##8_1, Bt##8_0); PG8_M8Z(ai, bj, 1, 1, At##8_1, Bt##8_1); \
                            PG8_M8Z(ai, bj, 2, 0, At##8_2, Bt##8_0); PG8_M8Z(ai, bj, 2, 1, At##8_2, Bt##8_1); PG8_M8Z(ai, bj, 3, 0, At##8_3, Bt##8_0); PG8_M8Z(ai, bj, 3, 1, At##8_3, Bt##8_1); } } \
        else { _Pragma("unroll") for (int m = 0; m < 4; ++m) _Pragma("unroll") for (int n = 0; n < 2; ++n) _Pragma("unroll") for (int k = 0; k < 2; ++k) acc[ai][bj][m][n] = __builtin_amdgcn_mfma_f32_16x16x32_bf16(Bt[n][k], At[m][k], acc[ai][bj][m][n], 0, 0, 0); } \
        __builtin_amdgcn_s_setprio(0); } while (0)
#define PG8_WAIT_V(n) asm volatile("s_waitcnt vmcnt(" #n ")" ::: "memory")
#define PG8_WAIT_L(n) asm volatile("s_waitcnt lgkmcnt(" #n ")" ::: "memory")
#define PG8_BAR __builtin_amdgcn_s_barrier()
#define PG8_SCHED __builtin_amdgcn_sched_barrier(0)
    Unit cur, nxt; int ui = 0;
    if (!S.next(0, cur)) return;
    f32x4 acc[2][2][4][2];
#pragma unroll
    for (int a = 0; a < 2; ++a)
#pragma unroll
        for (int b = 0; b < 2; ++b)
#pragma unroll
            for (int m = 0; m < 4; ++m)
#pragma unroll
                for (int n = 0; n < 2; ++n) acc[a][b][m][n] = (f32x4){0.f, 0.f, 0.f, 0.f};
    bf16x8 At[4][2], B0[2][2], B1[2][2];
    typedef unsigned u32x8_t __attribute__((ext_vector_type(8)));
    u32x8_t At8_0, At8_1, At8_2, At8_3, B08_0, B08_1, B18_0, B18_1;
    int zsc_ = 0; asm volatile("" : "+v"(zsc_));
    const int wsc_ = Sched::WSCALE, asc_ = Sched::ASCALE;
    unsigned va[2][2];
    S.a_voff(cur, tid, va);
    const char* cA = S.a_ptr(cur);
    const char* cB = S.b_ptr(cur);
    PG8_STAGEB(PG8_SB(0, 0), cB); PG8_STAGEB(PG8_SB(0, 1), cB + hstep); PG8_STAGEA(PG8_SA(0, 0), cA, va[0]); PG8_STAGEA(PG8_SA(0, 1), cA + hsA, va[1]);
    if (wr == 1) PG8_BAR;
    PG8_WAIT_V(2); PG8_BAR;
    PG8_STAGEB(PG8_SB(1, 0), cB + kstep); PG8_STAGEA(PG8_SA(1, 0), cA + kstep, va[0]); PG8_STAGEB(PG8_SB(1, 1), cB + hstep + kstep);
    PG8_WAIT_V(6); PG8_BAR;
    for (;;) {
        const bool has_next = S.next(ui + 1, nxt);
        const char* nB = has_next ? S.b_ptr(nxt) : cB;
        const char* nA = has_next ? S.a_ptr(nxt) : cA;
        for (int t = 0; t < nt; t += 2) {
            const bool last = (t == nt - 2);
            const char* a1 = cA + (size_t)(t + 1) * kstep;
            const char* a2 = last ? nA : cA + (size_t)(t + 2) * kstep; const char* a3 = a2 + kstep;
            unsigned v2[2][2];
            v2[0][0] = va[0][0]; v2[0][1] = va[0][1]; v2[1][0] = va[1][0]; v2[1][1] = va[1][1];
            if constexpr (Sched::GATHER) { if (last && has_next) S.a_voff(nxt, tid, v2); }
            const char* b2 = last ? nB : cB + (size_t)(t + 2) * kstep; const char* b3 = b2 + kstep;
            PG8_LDB(B0, 0, 0); PG8_LDB(B1, 0, 1); PG8_SCHED; PG8_LDA(At, 0, 0); PG8_STAGEA(PG8_SA(1, 1), a1 + hsA, va[1]);
            PG8_WAIT_V(8); PG8_WAIT_L(0); PG8_BAR; PG8_MMA(0, 0, At, B0); PG8_MMA(0, 1, At, B1); PG8_BAR; PG8_SCHED;
            PG8_LDA(At, 0, 1); PG8_STAGEB(PG8_SB(0, 0), b2); PG8_STAGEB(PG8_SB(0, 1), b2 + hstep); PG8_STAGEA(PG8_SA(0, 0), a2, v2[0]);
            PG8_WAIT_V(8); PG8_WAIT_L(0); PG8_BAR; PG8_MMA(1, 0, At, B0); PG8_MMA(1, 1, At, B1); PG8_BAR; PG8_SCHED;
            PG8_LDB(B0, 1, 0); PG8_LDB(B1, 1, 1); PG8_SCHED; PG8_LDA(At, 1, 0); PG8_STAGEA(PG8_SA(0, 1), a2 + hsA, v2[1]);
            PG8_WAIT_V(8); PG8_WAIT_L(0); PG8_BAR; PG8_MMA(0, 0, At, B0); PG8_MMA(0, 1, At, B1); PG8_BAR; PG8_SCHED;
            PG8_LDA(At, 1, 1); PG8_STAGEB(PG8_SB(1, 0), b3); PG8_STAGEB(PG8_SB(1, 1), b3 + hstep); PG8_STAGEA(PG8_SA(1, 0), a3, v2[0]);
            PG8_WAIT_V(8); PG8_WAIT_L(0); PG8_BAR; PG8_MMA(1, 0, At, B0); PG8_MMA(1, 1, At, B1); PG8_BAR; PG8_SCHED;
        }
        if (wr == 0) PG8_BAR;
        if constexpr (F8) asm volatile("s_nop 15\n\ts_nop 15" ::: "memory");
        E(acc, cur, wr, wc, fr, fq);
        if constexpr (((PROBE_MASK >> 27) & 1u) != 0u) { asm volatile("" ::: "memory"); E(acc, cur, wr, wc, fr, fq); }
        if (!has_next) break;
#pragma unroll
        for (int a = 0; a < 2; ++a)
#pragma unroll
            for (int b = 0; b < 2; ++b)
#pragma unroll
                for (int m = 0; m < 4; ++m)
#pragma unroll
                    for (int n = 0; n < 2; ++n) acc[a][b][m][n] = (f32x4){0.f, 0.f, 0.f, 0.f};
        cur = nxt; cB = nB; cA = nA; ++ui;
        if constexpr (Sched::GATHER) S.a_voff(cur, tid, va);
        if (wr == 1) PG8_BAR;
    }
    PG8_WAIT_V(0);
    PG8_BAR;
#undef PG8_SA
#undef PG8_SB
#undef PG8_STAGEA
#undef PG8_STAGEB
#undef PG8_LDA
#undef PG8_LD8
#undef PG8_M8
#undef PG8_LDB
#undef PG8_MMA
#undef PG8_WAIT_V
#undef PG8_WAIT_L
#undef PG8_BAR
#undef PG8_SCHED
}

struct SchedDense {
    static constexpr bool GATHER = false; static constexpr int WSCALE = 0x7F7F7F7F, ASCALE = 0x7F7F7F7F;
    StaticOrder so; const char* A; const char* Bt; int K; int pad_;
    DEV bool next(int i, Unit& u) const { int pm, pn; if (!so.next(i, pm, pn)) return false; u.pm = pm; u.pn = pn; u.e = 0; u.slot = 0; return true; }
    DEV const char* a_ptr(const Unit& u) const { return A + (size_t)u.pm * 256 * K * 2; }
    DEV void a_voff(const Unit&, const int tid, unsigned (&vo)[2][2]) const {
#pragma unroll
        for (int i = 0; i < 2; ++i) { int R, C; stage_rc(tid * 16 + i * 8192, R, C); vo[0][i] = vo[1][i] = (unsigned)((R * K + C) * 2); }
    }
    DEV const char* b_ptr(const Unit& u) const { return Bt + (size_t)u.pn * 256 * K * 2; }
};
template <int WS_, int AS_> struct SchedDense8 {
    static constexpr bool GATHER = false; static constexpr int WSCALE = WS_, ASCALE = AS_;
    StaticOrder so; const char* A; const char* Bt; int K; int pad_;
    DEV bool next(int i, Unit& u) const { int pm, pn; if (!so.next(i, pm, pn)) return false; u.pm = pm; u.pn = pn; u.e = 0; u.slot = 0; return true; }
    DEV const char* a_ptr(const Unit& u) const { return A + (size_t)u.pm * 256 * K; }
    DEV void a_voff(const Unit&, const int tid, unsigned (&vo)[2][2]) const {
#pragma unroll
        for (int i = 0; i < 2; ++i) { int R, C; stage_rc(tid * 16 + i * 8192, R, C); vo[0][i] = vo[1][i] = (unsigned)(R * K + 2 * C); }
    }
    DEV const char* b_ptr(const Unit& u) const { return Bt + (size_t)u.pn * 256 * K; }
};
DEV bool moe_unit(int i, int NJ, int nrbt, int G, int c, Unit& u) {
    const int n = (nrbt + 64) * NJ; int L;
    if (G & 7) { L = i * G + c; if (L >= n) return false; }
    else { const int gq = G >> 3, per = (n + 7) >> 3, x = c & 7, q = c >> 3, j = i * gq + q; if (j >= per) return false; L = x * per + j; if (L >= n) return false; }
    int grb = L / NJ; const int pn = L - grb * NJ; if (grb >= nrbt) grb = SH_RB + (grb - nrbt);
    u.pm = grb; u.pn = pn; u.slot = i; u.e = 0; return true;
}
struct SchedGU {
    static constexpr bool GATHER = true; static constexpr int WSCALE = 0x79797979, ASCALE = 0x7F7F7F7F;
    const char* A; const char* Wgu; const char* Wgus; const LAS int* eofrb; const LAS int* toks; int nrbt, G, c, pad_;
    DEV bool next(int i, Unit& u) const { if (!moe_unit(i, 2, nrbt, G, c, u)) return false; u.e = __builtin_amdgcn_readfirstlane(eofrb[u.pm]); return true; }
    DEV const char* a_ptr(const Unit&) const { return A; }
    DEV void a_voff(const Unit& u, const int tid, unsigned (&vo)[2][2]) const {
#pragma unroll
        for (int i = 0; i < 2; ++i) { int R, C; stage_rc(tid * 16 + i * 8192, R, C);
#pragma unroll
            for (int h = 0; h < 2; ++h) { const int tok = toks[u.slot * 256 + h * 128 + R]; vo[h][i] = (unsigned)(tok * D + 2 * C); } }
    }
    DEV const char* b_ptr(const Unit& u) const { return (u.e < NE ? Wgu + (size_t)u.e * 512 * D : Wgus) + (size_t)u.pn * 256 * D; }
};
struct SchedDown {
    static constexpr bool GATHER = false; static constexpr int WSCALE = 0x7D7D7D7D, ASCALE = 0x7F7F7F7F;
    const char* A; const char* Wd; const char* Wds; const LAS int* eofrb; int nrbt, G, c, pad_;
    DEV bool next(int i, Unit& u) const { if (!moe_unit(i, 4, nrbt, G, c, u)) return false; u.e = __builtin_amdgcn_readfirstlane(eofrb[u.pm]); return true; }
    DEV const char* a_ptr(const Unit& u) const { return A + (size_t)u.pm * 256 * ED; }
    DEV void a_voff(const Unit&, const int tid, unsigned (&vo)[2][2]) const {
#pragma unroll
        for (int i = 0; i < 2; ++i) { int R, C; stage_rc(tid * 16 + i * 8192, R, C); vo[0][i] = vo[1][i] = (unsigned)(R * ED + 2 * C); }
    }
    DEV const char* b_ptr(const Unit& u) const { return (u.e < NE ? Wd + (size_t)u.e * D * ED : Wds) + (size_t)u.pn * 256 * ED; }
};

struct EpiProj {
    static constexpr bool PERM = true;
    bf16_t* qkv; bf16_t* za; bf16_t* xbc; bf16_t* zb; float* small;
    DEV void operator()(const f32x4 (&acc)[2][2][4][2], const Unit& u, int wr, int wc, int fr, int fq) const {
        const int row0 = u.pm * BM + wr * 64 + fr, pn = u.pn;
        if (pn == 26) {
            if (wc == 0) {
#pragma unroll
                for (int ai = 0; ai < 2; ++ai)
#pragma unroll
                    for (int m = 0; m < 4; ++m) { float* p = small + (size_t)(row0 + ai * HALF + m * 16) * 32 + 8 * fq; *(f32x4*)p = acc[ai][0][m][0]; *(f32x4*)(p + 4) = acc[ai][0][m][1]; }
            }
            return;
        }
        bf16_t* base; int ldc, ct;
        if (pn < 12) { base = qkv; ldc = 3072; ct = pn; } else if (pn < 16) { base = za; ldc = 1024; ct = pn - 12; } else if (pn < 22) { base = xbc; ldc = 1536; ct = pn - 16; } else { base = zb; ldc = 1024; ct = pn - 22; }
        const int col0 = ct * 256 + wc * 32 + 8 * fq;
#pragma unroll
        for (int ai = 0; ai < 2; ++ai)
#pragma unroll
            for (int m = 0; m < 4; ++m) { bf16_t* rowp = base + (size_t)(row0 + ai * HALF + m * 16) * ldc + col0;
#pragma unroll
                for (int bj = 0; bj < 2; ++bj) *(u32x4*)(rowp + bj * HALF) = pack8(acc[ai][bj][m][0], acc[ai][bj][m][1]); }
    }
};
struct EpiF32 {
    static constexpr bool PERM = false;
    float* Cp; int ldc; int pad_;
    DEV void operator()(const f32x4 (&acc)[2][2][4][2], const Unit& u, int wr, int wc, int fr, int fq) const {
        const int row0 = u.pm * BM + wr * 64 + fr, col0 = u.pn * BM + wc * 32 + 4 * fq;
#pragma unroll
        for (int ai = 0; ai < 2; ++ai)
#pragma unroll
            for (int m = 0; m < 4; ++m) { float* rowp = Cp + (size_t)(row0 + ai * HALF + m * 16) * ldc + col0;
#pragma unroll
                for (int bj = 0; bj < 2; ++bj)
#pragma unroll
                    for (int n = 0; n < 2; ++n) *(f32x4*)(rowp + bj * HALF + n * 16) = acc[ai][bj][m][n]; }
    }
};
struct EpiBf16 {
    static constexpr bool PERM = true;
    bf16_t* O; int ldc; int pad_;
    DEV void operator()(const f32x4 (&acc)[2][2][4][2], const Unit& u, int wr, int wc, int fr, int fq) const {
        const int row0 = u.pm * BM + wr * 64 + fr, col0 = u.pn * BM + wc * 32 + 8 * fq;
#pragma unroll
        for (int ai = 0; ai < 2; ++ai)
#pragma unroll
            for (int m = 0; m < 4; ++m) { bf16_t* rowp = O + (size_t)(row0 + ai * HALF + m * 16) * ldc + col0;
#pragma unroll
                for (int bj = 0; bj < 2; ++bj) *(u32x4*)(rowp + bj * HALF) = pack8(acc[ai][bj][m][0], acc[ai][bj][m][1]); }
    }
};
DEV u32x2 pack8_fp8(const f32x4 a, const f32x4 b) {
    f32x4 x = a, y = b;
#pragma unroll
    for (int i = 0; i < 4; ++i) { x[i] = __builtin_amdgcn_fmed3f(x[i], -440.f, 440.f); y[i] = __builtin_amdgcn_fmed3f(y[i], -440.f, 440.f); }
    int w0 = __builtin_amdgcn_cvt_pk_fp8_f32(x[0], x[1], 0, false); w0 = __builtin_amdgcn_cvt_pk_fp8_f32(x[2], x[3], w0, true);
    int w1 = __builtin_amdgcn_cvt_pk_fp8_f32(y[0], y[1], 0, false); w1 = __builtin_amdgcn_cvt_pk_fp8_f32(y[2], y[3], w1, true);
    return (u32x2){(unsigned)w0, (unsigned)w1};
}
struct EpiFp8 {
    static constexpr bool PERM = true;
    unsigned char* O; int ldc; int pad_;
    DEV void operator()(const f32x4 (&acc)[2][2][4][2], const Unit& u, int wr, int wc, int fr, int fq) const {
        const int row0 = u.pm * BM + wr * 64 + fr, col0 = u.pn * BM + wc * 32 + 8 * fq;
#pragma unroll
        for (int ai = 0; ai < 2; ++ai)
#pragma unroll
            for (int m = 0; m < 4; ++m) { unsigned char* rowp = O + (size_t)(row0 + ai * HALF + m * 16) * ldc + col0;
#pragma unroll
                for (int bj = 0; bj < 2; ++bj) { f32x4 a0 = acc[ai][bj][m][0], a1 = acc[ai][bj][m][1];
#pragma unroll
                    for (int i = 0; i < 4; ++i) { a0[i] = __builtin_amdgcn_fmed3f(a0[i], -440.f, 440.f); a1[i] = __builtin_amdgcn_fmed3f(a1[i], -440.f, 440.f); }
                    int w0 = __builtin_amdgcn_cvt_pk_fp8_f32(a0[0], a0[1], 0, false); w0 = __builtin_amdgcn_cvt_pk_fp8_f32(a0[2], a0[3], w0, true);
                    int w1 = __builtin_amdgcn_cvt_pk_fp8_f32(a1[0], a1[1], 0, false); w1 = __builtin_amdgcn_cvt_pk_fp8_f32(a1[2], a1[3], w1, true);
                    *(u32x2*)(rowp + bj * HALF) = (u32x2){(unsigned)w0, (unsigned)w1}; } }
    }
};
struct EpiGU {
    static constexpr bool PERM = true;
    unsigned char* H;
    DEV void operator()(const f32x4 (&acc)[2][2][4][2], const Unit& u, int wr, int wc, int fr, int fq) const {
        const int row0 = u.pm * BM + wr * 64 + fr, col0 = u.pn * HALF + wc * 32 + 8 * fq;
#pragma unroll
        for (int ai = 0; ai < 2; ++ai)
#pragma unroll
            for (int m = 0; m < 4; ++m) {
                f32x4 h0, h1;
#pragma unroll
                for (int i = 0; i < 4; ++i) { h0[i] = siluf(acc[ai][0][m][0][i]) * acc[ai][1][m][0][i]; h1[i] = siluf(acc[ai][0][m][1][i]) * acc[ai][1][m][1][i]; }
                *(u32x2*)(H + (size_t)(row0 + ai * HALF + m * 16) * ED + col0) = pack8_fp8(h0, h1);
            }
    }
};
struct EpiQKV {
    static constexpr bool PERM = true;
    bf16_t* O; const float* cosT; const float* sinT;
    DEV void operator()(const f32x4 (&acc)[2][2][4][2], const Unit& u, int wr, int wc, int fr, int fq) const {
        const int row0 = u.pm * BM + wr * 64 + fr, col0 = u.pn * BM + wc * 32 + 8 * fq;
        const bool rope = u.pn < 8; const float qs = u.pn < 4 ? 0.125f : 1.f;
#pragma unroll
        for (int ai = 0; ai < 2; ++ai)
#pragma unroll
            for (int m = 0; m < 4; ++m) {
                const int row = row0 + ai * HALF + m * 16;
                bf16_t* rowp = O + (size_t)row * 3072 + col0;
                if (rope) {
                    const f32x4 cs = *(const f32x4*)(cosT + (size_t)row * 32 + 16 * (wc & 1) + 4 * fq), sn = *(const f32x4*)(sinT + (size_t)row * 32 + 16 * (wc & 1) + 4 * fq);
#pragma unroll
                    for (int bj = 0; bj < 2; ++bj) { const f32x4 x1 = acc[ai][bj][m][0], x2 = acc[ai][bj][m][1];
                        *(u32x4*)(rowp + bj * HALF) = pack8((x1 * cs - x2 * sn) * qs, (x2 * cs + x1 * sn) * qs); }
                } else {
#pragma unroll
                    for (int bj = 0; bj < 2; ++bj) *(u32x4*)(rowp + bj * HALF) = pack8(acc[ai][bj][m][0], acc[ai][bj][m][1]);
                }
            }
    }
};
}

template <class SrcF, bool OUT8 = false>
DEV void conv_item(const SrcF& src, int ldw, int K, void* dstv, LAS float* scr, int item, int nblk, int lane, const float wscale = 1.f) {
    const int kb = item / nblk, nb = item - kb * nblk, k0 = 64 * kb, n0 = 32 * nb;
    const int quad = lane & 7, r0 = lane >> 3;
    const float* colp = src(n0 + 4 * quad);
    f32x4 v[8];
#pragma unroll
    for (int i = 0; i < 8; ++i) v[i] = colp ? *(const f32x4*)(colp + (size_t)(k0 + r0 + 8 * i) * ldw) : (f32x4){0.f, 0.f, 0.f, 0.f};
#pragma unroll
    for (int i = 0; i < 8; ++i) { LAS float* p = scr + (r0 + 8 * i) * 33 + 4 * quad; p[0] = v[i][0]; p[1] = v[i][1]; p[2] = v[i][2]; p[3] = v[i][3]; }
    LDS_WAIT(); asm volatile("" ::: "memory");
    const int c = lane & 7;
#pragma unroll
    for (int j = 0; j < 4; ++j) { const int n = (lane >> 3) + 8 * j; const LAS float* s = scr + (8 * c) * 33 + n;
        if constexpr (OUT8) {
            int w0 = __builtin_amdgcn_cvt_pk_fp8_f32(s[0 * 33] * wscale, s[1 * 33] * wscale, 0, false); w0 = __builtin_amdgcn_cvt_pk_fp8_f32(s[2 * 33] * wscale, s[3 * 33] * wscale, w0, true);
            int w1 = __builtin_amdgcn_cvt_pk_fp8_f32(s[4 * 33] * wscale, s[5 * 33] * wscale, 0, false); w1 = __builtin_amdgcn_cvt_pk_fp8_f32(s[6 * 33] * wscale, s[7 * 33] * wscale, w1, true);
            *(u32x2*)((unsigned char*)dstv + (size_t)(n0 + n) * K + k0 + 8 * c) = (u32x2){(unsigned)w0, (unsigned)w1};
        } else {
            u32x4 o; o.x = pk2(s[0 * 33], s[1 * 33]); o.y = pk2(s[2 * 33], s[3 * 33]); o.z = pk2(s[4 * 33], s[5 * 33]); o.w = pk2(s[6 * 33], s[7 * 33]);
            *(u32x4*)((bf16_t*)dstv + (size_t)(n0 + n) * K + k0 + 8 * c) = o; } }
    LDS_WAIT(); asm volatile("" ::: "memory");
}
struct SrcIdent { const float* W; DEV const float* operator()(int n) const { return W + n; } };
struct SrcWin { const float* W; DEV const float* operator()(int n) const {
    int s; if (n < 4096) s = n; else if (n < 5632) s = C_XBC + (n - 4096); else if (n < 6656) s = C_ZB + (n - 5632); else if (n < 6672) s = C_BETA + (n - 6656); else if (n < 6688) s = C_DT + (n - 6672); else return nullptr;
    return W + s; } };
struct SrcQKV { const float* W; DEV const float* operator()(int n) const {
    if (n >= 2048) return W + n; const int hd = n >> 6, cp = n & 63; return W + hd * 64 + 32 * ((cp >> 2) & 1) + 16 * (cp >> 5) + 4 * ((cp >> 3) & 3) + (cp & 3); } };
struct SrcGU { const float* Wg; long du; DEV const float* operator()(int r) const { const int j = r >> 8, rr = r & 255; return Wg + (rr < 128 ? 0l : du) + 128 * j + (rr & 127); } };

DEV void load_row(const float* p, int lane, float (&v)[16]) {
#pragma unroll
    for (int j = 0; j < 4; ++j) { const f32x4 t = *(const f32x4*)(p + j * 256 + lane * 4); v[4 * j] = t[0]; v[4 * j + 1] = t[1]; v[4 * j + 2] = t[2]; v[4 * j + 3] = t[3]; }
}
DEV void store_row(float* p, int lane, const float (&v)[16]) {
#pragma unroll
    for (int j = 0; j < 4; ++j) *(f32x4*)(p + j * 256 + lane * 4) = (f32x4){v[4 * j], v[4 * j + 1], v[4 * j + 2], v[4 * j + 3]};
}
DEV float row_rstd(const float (&v)[16]) { float ss = 0.f;
#pragma unroll
    for (int i = 0; i < 16; ++i) ss += v[i] * v[i];
    return rsqrtf(wave_sum(ss) * (1.f / D) + EPS); }
DEV void resid_update(float (&xv)[16], const float (&yv)[16], const float* gpost, const float* gt, int lane) {
    const float r = row_rstd(yv);
#pragma unroll
    for (int j = 0; j < 4; ++j) { const f32x4 g = *(const f32x4*)(gpost + j * 256 + lane * 4), t = *(const f32x4*)(gt + j * 256 + lane * 4);
#pragma unroll
        for (int i = 0; i < 4; ++i) xv[4 * j + i] += t[i] * (yv[4 * j + i] * r * g[i]); }
}
DEV void prenorm_pack(const float (&xv)[16], const float* gpre, const float* sc, const float* sh, int lane, u32x2 (&o)[4]) {
    const float r = row_rstd(xv);
#pragma unroll
    for (int j = 0; j < 4; ++j) { const f32x4 g = *(const f32x4*)(gpre + j * 256 + lane * 4), s = *(const f32x4*)(sc + j * 256 + lane * 4), b = *(const f32x4*)(sh + j * 256 + lane * 4);
        float h[4];
#pragma unroll
        for (int i = 0; i < 4; ++i) h[i] = xv[4 * j + i] * r * g[i] * (1.f + s[i]) + b[i];
        o[j] = (u32x2){pk2(h[0], h[1]), pk2(h[2], h[3])}; }
}

DEV void load_row8(const float* p, int lane, float (&v)[16]) {
#pragma unroll
    for (int j = 0; j < 2; ++j)
#pragma unroll
        for (int hh = 0; hh < 2; ++hh) { const f32x4 t = *(const f32x4*)(p + 512 * j + 8 * lane + 4 * hh); v[8 * j + 4 * hh] = t[0]; v[8 * j + 4 * hh + 1] = t[1]; v[8 * j + 4 * hh + 2] = t[2]; v[8 * j + 4 * hh + 3] = t[3]; }
}
DEV void store_row8(float* p, int lane, const float (&v)[16]) {
#pragma unroll
    for (int j = 0; j < 2; ++j)
#pragma unroll
        for (int hh = 0; hh < 2; ++hh) *(f32x4*)(p + 512 * j + 8 * lane + 4 * hh) = (f32x4){v[8 * j + 4 * hh], v[8 * j + 4 * hh + 1], v[8 * j + 4 * hh + 2], v[8 * j + 4 * hh + 3]};
}
DEV void resid_update8(float (&xv)[16], const float (&yv)[16], const float* gpost, const float* gt, int lane) {
    const float r = row_rstd(yv);
#pragma unroll
    for (int j = 0; j < 2; ++j)
#pragma unroll
        for (int hh = 0; hh < 2; ++hh) { const f32x4 g = *(const f32x4*)(gpost + 512 * j + 8 * lane + 4 * hh), t = *(const f32x4*)(gt + 512 * j + 8 * lane + 4 * hh);
#pragma unroll
            for (int i = 0; i < 4; ++i) xv[8 * j + 4 * hh + i] += t[i] * (yv[8 * j + 4 * hh + i] * r * g[i]); }
}
DEV void prenorm_pack8(const float (&xv)[16], const float* gpre, const float* sc, const float* sh, int lane, u32x4 (&o)[2]) {
    const float r = row_rstd(xv);
#pragma unroll
    for (int j = 0; j < 2; ++j) { float h[8];
#pragma unroll
        for (int hh = 0; hh < 2; ++hh) { const f32x4 g = *(const f32x4*)(gpre + 512 * j + 8 * lane + 4 * hh), s = *(const f32x4*)(sc + 512 * j + 8 * lane + 4 * hh), b = *(const f32x4*)(sh + 512 * j + 8 * lane + 4 * hh);
#pragma unroll
            for (int i = 0; i < 4; ++i) h[4 * hh + i] = xv[8 * j + 4 * hh + i] * r * g[i] * (1.f + s[i]) + b[i]; }
        o[j] = (u32x4){pk2(h[0], h[1]), pk2(h[2], h[3]), pk2(h[4], h[5]), pk2(h[6], h[7])}; }
}
DEV void prenorm_pack8_f8(const float (&xv)[16], const float* gpre, const float* sc, const float* sh, int lane, u32x2 (&o)[2]) {
    const float r = row_rstd(xv);
#pragma unroll
    for (int j = 0; j < 2; ++j) { float h[8];
#pragma unroll
        for (int hh = 0; hh < 2; ++hh) { const f32x4 g = *(const f32x4*)(gpre + 512 * j + 8 * lane + 4 * hh), s = *(const f32x4*)(sc + 512 * j + 8 * lane + 4 * hh), b = *(const f32x4*)(sh + 512 * j + 8 * lane + 4 * hh);
#pragma unroll
            for (int i = 0; i < 4; ++i) h[4 * hh + i] = __builtin_amdgcn_fmed3f(xv[8 * j + 4 * hh + i] * r * g[i] * (1.f + s[i]) + b[i], -440.f, 440.f); }
        int w0 = __builtin_amdgcn_cvt_pk_fp8_f32(h[0], h[1], 0, false); w0 = __builtin_amdgcn_cvt_pk_fp8_f32(h[2], h[3], w0, true);
        int w1 = __builtin_amdgcn_cvt_pk_fp8_f32(h[4], h[5], 0, false); w1 = __builtin_amdgcn_cvt_pk_fp8_f32(h[6], h[7], w1, true);
        o[j] = (u32x2){(unsigned)w0, (unsigned)w1}; }
}
DEV void acc_row8(float (&yv)[16], const u32x2 w0, const u32x2 w1, const float g) {
#pragma unroll
    for (int e = 0; e < 2; ++e) {
        yv[4 * e] += g * __builtin_amdgcn_cvt_f32_fp8((int)w0[e], 0); yv[4 * e + 1] += g * __builtin_amdgcn_cvt_f32_fp8((int)w0[e], 1); yv[4 * e + 2] += g * __builtin_amdgcn_cvt_f32_fp8((int)w0[e], 2); yv[4 * e + 3] += g * __builtin_amdgcn_cvt_f32_fp8((int)w0[e], 3);
        yv[8 + 4 * e] += g * __builtin_amdgcn_cvt_f32_fp8((int)w1[e], 0); yv[8 + 4 * e + 1] += g * __builtin_amdgcn_cvt_f32_fp8((int)w1[e], 1); yv[8 + 4 * e + 2] += g * __builtin_amdgcn_cvt_f32_fp8((int)w1[e], 2); yv[8 + 4 * e + 3] += g * __builtin_amdgcn_cvt_f32_fp8((int)w1[e], 3); }
}

DEV void load_row_bf(const bf16_t* p, int lane, float (&v)[16]) {
#pragma unroll
    for (int j = 0; j < 4; ++j) { const u32x2 w = *(const u32x2*)(p + j * 256 + lane * 4); v[4 * j] = __uint_as_float(w.x << 16); v[4 * j + 1] = __uint_as_float(w.x & 0xFFFF0000u); v[4 * j + 2] = __uint_as_float(w.y << 16); v[4 * j + 3] = __uint_as_float(w.y & 0xFFFF0000u); }
}
DEV void store_row_bf(bf16_t* p, int lane, const float (&v)[16]) {
#pragma unroll
    for (int j = 0; j < 4; ++j) *(u32x2*)(p + j * 256 + lane * 4) = (u32x2){pk2(v[4 * j], v[4 * j + 1]), pk2(v[4 * j + 2], v[4 * j + 3])};
}
DEV void load_row8_bf(const bf16_t* p, int lane, float (&v)[16]) {
#pragma unroll
    for (int j = 0; j < 2; ++j) { const u32x4 w = *(const u32x4*)(p + 512 * j + 8 * lane);
#pragma unroll
        for (int e = 0; e < 4; ++e) { v[8 * j + 2 * e] = __uint_as_float(w[e] << 16); v[8 * j + 2 * e + 1] = __uint_as_float(w[e] & 0xFFFF0000u); } }
}
DEV void store_row8_bf(bf16_t* p, int lane, const float (&v)[16]) {
#pragma unroll
    for (int j = 0; j < 2; ++j) *(u32x4*)(p + 512 * j + 8 * lane) = (u32x4){pk2(v[8 * j], v[8 * j + 1]), pk2(v[8 * j + 2], v[8 * j + 3]), pk2(v[8 * j + 4], v[8 * j + 5]), pk2(v[8 * j + 6], v[8 * j + 7])};
}

struct Ctx { LAS unsigned char* lds; int tid, lane, wave, G, bid; };

DEV void ph_setup(const Args& a, const Ctx& X) {
    unsigned char* ws = a.ws;
    float* mod = (float*)(ws + WS_MOD);
    { LAS float* red = (LAS float*)X.lds;
      LAS float* sc = (LAS float*)(X.lds + 8192);
      for (int i = X.tid; i < NB * D; i += NTHR) sc[i] = siluf(a.c[i]);
      __syncthreads();
      const int kc = X.tid >> 6, cl = X.tid & 63;
      for (int task = X.bid; task < 2 * 96; task += X.G) {
          const int l = task / 96, col = (task % 96) * 64 + cl;
          const float* w = a.mod_w + (size_t)l * D * 6 * D + col;
          float p0 = 0.f, p1 = 0.f, p2 = 0.f, p3 = 0.f;
#pragma unroll 16
          for (int k = kc * 128; k < kc * 128 + 128; ++k) { const float wv = w[(size_t)k * 6 * D];
              p0 += sc[k] * wv; p1 += sc[D + k] * wv; p2 += sc[2 * D + k] * wv; p3 += sc[3 * D + k] * wv; }
          __syncthreads();
          red[(kc * 4 + 0) * 64 + cl] = p0; red[(kc * 4 + 1) * 64 + cl] = p1; red[(kc * 4 + 2) * 64 + cl] = p2; red[(kc * 4 + 3) * 64 + cl] = p3;
          __syncthreads();
          if (X.tid < 256) { const int b = X.tid >> 6; float s = a.mod_b[l * 6 * D + col];
#pragma unroll
              for (int q = 0; q < 8; ++q) s += red[(q * 4 + b) * 64 + cl];
              mod[(size_t)(l * NB + b) * 6 * D + col] = s; }
      }
      __syncthreads(); }
    { LAS float* scr = (LAS float*)(X.lds + X.wave * 8704);
      const int gw = X.bid * NWAVES + X.wave, NGW = X.G * NWAVES;
      constexpr int I_IN = (D / 64) * (NPROJ / 32);
      for (int it = gw; it < I_IN; it += NGW) conv_item<SrcWin, true>(SrcWin{a.ssm_w_in}, PROJ, D, ws + WS_WIN, scr, it, NPROJ / 32, X.lane, 64.f);
    }
}
DEV void ph_setup_late(const Args& a, const Ctx& X, const int widx, const int nwg) {
    unsigned char* ws = a.ws;
    { float* cosT = (float*)(ws + WS_COS); float* sinT = (float*)(ws + WS_SIN);
      for (int idx = widx * NTHR + X.tid; idx < T * 32; idx += nwg * NTHR) { const int t = idx >> 5, i = idx & 31;
          const float ang = (float)a.pos[t] * powf(10000.f, -(float)i / 32.f); float sn, cs; sincosf(ang, &sn, &cs); cosT[idx] = cs; sinT[idx] = sn; } }
    { LAS float* scr = (LAS float*)(X.lds + X.wave * 8704);
      const int gw = widx * NWAVES + X.wave, NGW = nwg * NWAVES;
      constexpr int I_OUT = (2048 / 64) * (D / 32), I_QKV = (D / 64) * (3072 / 32), I_O = (D / 64) * (D / 32);
      for (int it = gw; it < I_OUT + I_QKV + I_O; it += NGW) {
          int r = it;
          if (r < I_OUT) { conv_item(SrcIdent{a.ssm_w_out}, D, 2048, (bf16_t*)(ws + WS_WOUT), scr, r, D / 32, X.lane); continue; } r -= I_OUT;
          if (r < I_QKV) { conv_item<SrcQKV, true>(SrcQKV{a.attn_w_qkv}, 3072, D, ws + WS_WQKV, scr, r, 3072 / 32, X.lane, 64.f); continue; } r -= I_QKV;
          conv_item<SrcIdent, true>(SrcIdent{a.attn_w_o}, D, D, ws + WS_WO, scr, r, D / 32, X.lane, 64.f);
      } }
}

DEV void ph_prenorm0(const Args& a, const Ctx& X) {
    const float* mod = (const float*)(a.ws + WS_MOD);
    unsigned char* h8 = a.ws + WS_H;
    for (int row = X.bid * NWAVES + X.wave; row < T; row += X.G * NWAVES) {
        const int b = row / SEQ; const float* ml = mod + (size_t)b * 6 * D;
        float xv[16]; load_row(a.x + (size_t)row * D, X.lane, xv);
        u32x2 o[4]; prenorm_pack(xv, a.mix_pre_g, ml + D, ml, X.lane, o);
#pragma unroll
        for (int j = 0; j < 4; ++j) { const float f0 = __uint_as_float(o[j].x << 16), f1 = __uint_as_float(o[j].x & 0xFFFF0000u), f2 = __uint_as_float(o[j].y << 16), f3 = __uint_as_float(o[j].y & 0xFFFF0000u);
            int wv = __builtin_amdgcn_cvt_pk_fp8_f32(__builtin_amdgcn_fmed3f(f0, -440.f, 440.f), __builtin_amdgcn_fmed3f(f1, -440.f, 440.f), 0, false); wv = __builtin_amdgcn_cvt_pk_fp8_f32(__builtin_amdgcn_fmed3f(f2, -440.f, 440.f), __builtin_amdgcn_fmed3f(f3, -440.f, 440.f), wv, true);
            *(unsigned*)(h8 + (size_t)row * D + j * 256 + X.lane * 4) = (unsigned)wv; }
    }
}

DEV bf16x8 acc_to_frag(const f32x4 lo, const f32x4 hi) { u32x4 w; w.x = pg8::cvt_pk_bf16(lo[0], lo[1]); w.y = pg8::cvt_pk_bf16(lo[2], lo[3]); w.z = pg8::cvt_pk_bf16(hi[0], hi[1]); w.w = pg8::cvt_pk_bf16(hi[2], hi[3]); return __builtin_bit_cast(bf16x8, w); }

DEV void gdn_solve(LAS float* M, LAS unsigned short* tf, const int lane) {
    for (int rb = 0; rb < 16; ++rb) {
        const int i0 = 4 * rb;
        float a0 = (lane == i0) ? 1.f : 0.f, a1 = (lane == i0 + 1) ? 1.f : 0.f, a2 = (lane == i0 + 2) ? 1.f : 0.f, a3 = (lane == i0 + 3) ? 1.f : 0.f;
        for (int j = 0; j < i0; j += 4) {
            const float t0 = M[j * 64 + lane], t1 = M[(j + 1) * 64 + lane], t2 = M[(j + 2) * 64 + lane], t3 = M[(j + 3) * 64 + lane];
            const f32x4 r0 = *(const LAS f32x4*)(M + i0 * 64 + j), r1 = *(const LAS f32x4*)(M + (i0 + 1) * 64 + j), r2 = *(const LAS f32x4*)(M + (i0 + 2) * 64 + j), r3 = *(const LAS f32x4*)(M + (i0 + 3) * 64 + j);
            a0 -= r0[0] * t0 + r0[1] * t1 + r0[2] * t2 + r0[3] * t3; a1 -= r1[0] * t0 + r1[1] * t1 + r1[2] * t2 + r1[3] * t3;
            a2 -= r2[0] * t0 + r2[1] * t1 + r2[2] * t2 + r2[3] * t3; a3 -= r3[0] * t0 + r3[1] * t1 + r3[2] * t2 + r3[3] * t3;
        }
        const f32x4 d1 = *(const LAS f32x4*)(M + (i0 + 1) * 64 + i0), d2 = *(const LAS f32x4*)(M + (i0 + 2) * 64 + i0), d3 = *(const LAS f32x4*)(M + (i0 + 3) * 64 + i0);
        a1 -= d1[0] * a0; a2 -= d2[0] * a0 + d2[1] * a1; a3 -= d3[0] * a0 + d3[1] * a1 + d3[2] * a2;
        M[i0 * 64 + lane] = a0; M[(i0 + 1) * 64 + lane] = a1; M[(i0 + 2) * 64 + lane] = a2; M[(i0 + 3) * 64 + lane] = a3;
    }
    const int cq = (lane >> 2) & 3, ca = (lane >> 4) & 1, ce = lane & 3, cks = lane >> 5;
    for (int i = 0; i < 64; ++i) tf[((i >> 4) * 2 + cks) * 512 + ((i & 15) + 16 * cq) * 8 + 4 * ca + ce] = (unsigned short)f2bf(M[i * 64 + lane]);
}
DEV void ph_gdn_local(const Args& a, const Ctx& X) {
    const bf16_t* qkvpre = (const bf16_t*)(a.ws + WS_QKVPRE); const float* small = (const float*)(a.ws + WS_SMALL);
    unsigned char* gi = a.ws + WS_GI; float* glast = (float*)(a.ws + WS_GLAST);
    constexpr int KP = 272;
    LAS unsigned char* kN = X.lds; LAS unsigned char* qN = X.lds + 64 * KP; LAS unsigned char* slots = X.lds + 128 * KP;
    LAS float* gcL = (LAS float*)(X.lds + 143360); LAS float* btL = gcL + 8 * 64;
    LAS unsigned char* stg = X.lds + 100352;
    const int lane = X.lane, wave = X.wave, r16 = lane & 15, q4 = lane >> 4;
    const float scale = 0.08838834764831845f;
    for (int wu = X.bid; wu < NB * 64; wu += X.G) {
        const int b = wu >> 6, n = wu & 63; const size_t t0 = (size_t)b * SEQ + 64 * n;
        unsigned char* tmp = a.ws + WS_GTMP + (size_t)X.bid * 131072;
        __syncthreads();
        {
            const float g = -__expf(a.gdn_a_log[wave]) * softplusf(small[(t0 + lane) * 32 + 8 + wave] + a.gdn_dt_bias[wave]);
            float gc = g;
#pragma unroll
            for (int o = 1; o < 64; o <<= 1) { const float v = __shfl_up(gc, o); if (lane >= o) gc += v; }
            gcL[wave * 64 + lane] = gc; btL[wave * 64 + lane] = sigmoidf_(small[(t0 + lane) * 32 + wave]);
            if (lane == 63) glast[(size_t)((b * 8 + wave) * 64 + n) * 32] = gc;
        }
        __syncthreads();
        unsigned xr[3][11];
#define GDN_LOADX(hh) do { _Pragma("unroll") for (int _p = 0; _p < 3; ++_p) _Pragma("unroll") for (int _i = 0; _i < 11; ++_i) { const int _tk = 8 * wave + _i - 3; unsigned _v = 0u; \
            if (64 * n + _tk >= 0) _v = *(const unsigned*)(qkvpre + (t0 + _tk) * 3072 + _p * 1024 + (hh) * 128 + 2 * lane); xr[_p][_i] = _v; } } while (0)
        GDN_LOADX(0);
        for (int bb = 0; bb < 2; ++bb) {
            for (int j = 0; j < 4; ++j) {
                const int h = bb * 4 + j; unsigned char* ub = gi + (size_t)((b * 8 + h) * 64 + n) * GI_UNIT;
                {
                    const float gl = gcL[h * 64 + 63];
                    const int blk = wave >> 2, pa = (wave & 3) >> 1, pq0 = 2 * (wave & 1);
                    const int ca = (2 * lane >> 4) & 1, cq = (2 * lane >> 2) & 3, ce = (2 * lane) & 3, cks = (2 * lane) >> 5;
#pragma unroll
                    for (int part = 0; part < 3; ++part) {
                        const int col = part * 1024 + h * 128 + 2 * lane;
                        float w0[4], w1[4];
#pragma unroll
                        for (int i = 0; i < 4; ++i) { const f32x2 t = *(const f32x2*)(a.gdn_conv_w + i * 3072 + col); w0[i] = t.x; w1[i] = t.y; }
                        float x0[11], x1[11];
#pragma unroll
                        for (int i = 0; i < 11; ++i) { const unsigned v = xr[part][i]; x0[i] = __uint_as_float(v << 16); x1[i] = __uint_as_float(v & 0xFFFF0000u); }
                        float v0[8], v1[8];
#pragma unroll
                        for (int i = 0; i < 8; ++i) { v0[i] = siluf(w0[0] * x0[i] + w0[1] * x0[i + 1] + w0[2] * x0[i + 2] + w0[3] * x0[i + 3]); v1[i] = siluf(w1[0] * x1[i] + w1[1] * x1[i + 1] + w1[2] * x1[i + 2] + w1[3] * x1[i + 3]); }
                        if (part < 2) {
#pragma unroll
                            for (int i = 0; i < 8; ++i) { const float r = rsqrtf(wave_sum(v0[i] * v0[i] + v1[i] * v1[i]) + 1e-6f); v0[i] *= r; v1[i] *= r; }
                        }
                        for (int rep_ = 0; rep_ < (((PROBE_MASK >> 21) & 1u) ? 2 : 1); ++rep_) {
                        if (part == 0) {
#pragma unroll
                            for (int i = 0; i < 8; ++i) { const int tok = 8 * wave + i; const float eg = __expf(gcL[h * 64 + tok]) * scale;
                                *(LAS unsigned*)(qN + tok * KP + lane * 4) = pk2(v0[i], v1[i]);
                                *(LAS unsigned*)(stg + ((tok >> 4) * 4 + cks) * 1024 + ((tok & 15) + 16 * cq) * 16 + (4 * ca + ce) * 2) = pk2(v0[i] * eg, v1[i] * eg); }
                        } else if (part == 1) {
                            unsigned short kg0[8], kg1[8], ke0[8], ke1[8];
#pragma unroll
                            for (int i = 0; i < 8; ++i) { const int tok = 8 * wave + i; const float gc = gcL[h * 64 + tok], bt = btL[h * 64 + tok], eg = __expf(gc) * bt, eend = __expf(gl - gc);
                                *(LAS unsigned*)(kN + tok * KP + lane * 4) = pk2(v0[i], v1[i]);
                                kg0[i] = (unsigned short)f2bf(v0[i] * eg); kg1[i] = (unsigned short)f2bf(v1[i] * eg); ke0[i] = (unsigned short)f2bf(v0[i] * eend); ke1[i] = (unsigned short)f2bf(v1[i] * eend); }
#pragma unroll
                            for (int hf = 0; hf < 2; ++hf) { const int pos = 32 * blk + 8 * (pq0 + hf) + 4 * pa; const int cl = 2 * lane;
                                *(u32x2*)(tmp + (size_t)j * 32768 + 16384 + cl * 128 + pos * 2) = (u32x2){(unsigned)kg0[4 * hf] | ((unsigned)kg0[4 * hf + 1] << 16), (unsigned)kg0[4 * hf + 2] | ((unsigned)kg0[4 * hf + 3] << 16)};
                                *(u32x2*)(tmp + (size_t)j * 32768 + 16384 + (cl + 1) * 128 + pos * 2) = (u32x2){(unsigned)kg1[4 * hf] | ((unsigned)kg1[4 * hf + 1] << 16), (unsigned)kg1[4 * hf + 2] | ((unsigned)kg1[4 * hf + 3] << 16)};
                                *(LAS u32x2*)(stg + 16384 + ((cl >> 4) * 2 + blk) * 1024 + ((cl & 15) + 16 * (pq0 + hf)) * 16 + (4 * pa) * 2) = (u32x2){(unsigned)ke0[4 * hf] | ((unsigned)ke0[4 * hf + 1] << 16), (unsigned)ke0[4 * hf + 2] | ((unsigned)ke0[4 * hf + 3] << 16)};
                                *(LAS u32x2*)(stg + 16384 + (((cl + 1) >> 4) * 2 + blk) * 1024 + (((cl + 1) & 15) + 16 * (pq0 + hf)) * 16 + (4 * pa) * 2) = (u32x2){(unsigned)ke1[4 * hf] | ((unsigned)ke1[4 * hf + 1] << 16), (unsigned)ke1[4 * hf + 2] | ((unsigned)ke1[4 * hf + 3] << 16)}; }
                        } else {
                            unsigned short vb0[8], vb1[8];
#pragma unroll
                            for (int i = 0; i < 8; ++i) { const float bt = btL[h * 64 + 8 * wave + i]; vb0[i] = (unsigned short)f2bf(v0[i] * bt); vb1[i] = (unsigned short)f2bf(v1[i] * bt); }
#pragma unroll
                            for (int hf = 0; hf < 2; ++hf) { const int pos = 32 * blk + 8 * (pq0 + hf) + 4 * pa; const int cl = 2 * lane;
                                *(u32x2*)(tmp + (size_t)j * 32768 + cl * 128 + pos * 2) = (u32x2){(unsigned)vb0[4 * hf] | ((unsigned)vb0[4 * hf + 1] << 16), (unsigned)vb0[4 * hf + 2] | ((unsigned)vb0[4 * hf + 3] << 16)};
                                *(u32x2*)(tmp + (size_t)j * 32768 + (cl + 1) * 128 + pos * 2) = (u32x2){(unsigned)vb1[4 * hf] | ((unsigned)vb1[4 * hf + 1] << 16), (unsigned)vb1[4 * hf + 2] | ((unsigned)vb1[4 * hf + 3] << 16)}; }
                        }
                        asm volatile("" ::: "memory"); }
                    }
                }
                if (h + 1 < 8) GDN_LOADX(h + 1);
                __syncthreads();
                {
#pragma unroll
                    for (int i = 0; i < 4; ++i) *(u32x4*)(ub + 16384 + (X.tid + 512 * i) * 16) = *(const LAS u32x4*)(stg + (X.tid + 512 * i) * 16);
                    const int mat = wave >> 2, rt = wave & 3; LAS unsigned char* An = mat ? qN : kN;
                    bf16x8 af[4];
#pragma unroll
                    for (int ks = 0; ks < 4; ++ks) af[ks] = *(const LAS bf16x8*)(An + (16 * rt + r16) * KP + (32 * ks + 8 * q4) * 2);
                    LAS float* slot = (LAS float*)(slots + j * 16384);
#pragma unroll
                    for (int ct = 0; ct < 4; ++ct) { f32x4 acc = {0.f, 0.f, 0.f, 0.f};
#pragma unroll
                        for (int ks = 0; ks < 4; ++ks) { const bf16x8 bf = *(const LAS bf16x8*)(kN + (16 * ct + r16) * KP + (32 * ks + 8 * q4) * 2); acc = __builtin_amdgcn_mfma_f32_16x16x32_bf16(af[ks], bf, acc, 0, 0, 0); }
                        const int jc = 16 * ct + r16; const float gj = gcL[h * 64 + jc];
#pragma unroll
                        for (int rg = 0; rg < 4; ++rg) { const int i = 16 * rt + 4 * q4 + rg; const float dec = __expf(gcL[h * 64 + i] - gj);
                            if (mat == 0) { slot[i * 64 + jc] = jc < i ? btL[h * 64 + i] * acc[rg] * dec : 0.f; }
                            else { const float v = jc <= i ? acc[rg] * scale * dec : 0.f;
                                *(LAS unsigned short*)(stg + 32768 + (rt * 2 + (ct >> 1)) * 1024 + ((4 * q4 + rg) + 16 * (r16 >> 2)) * 16 + (4 * (ct & 1) + (r16 & 3)) * 2) = (unsigned short)f2bf(v); } }
                    }
                }
                __syncthreads();
                *(u32x4*)(ub + 49152 + X.tid * 16) = *(const LAS u32x4*)(stg + 32768 + X.tid * 16);
            }
            if (wave < 4) gdn_solve((LAS float*)(slots + wave * 16384), (LAS unsigned short*)(X.lds + wave * 8192), lane);
            VM_WAIT(); __syncthreads();
            for (int j = 0; j < 4; ++j) {
                const int h = bb * 4 + j; unsigned char* ub = gi + (size_t)((b * 8 + h) * 64 + n) * GI_UNIT;
                const int mat = wave >> 2; LAS unsigned char* slot = X.lds + j * 8192;
#pragma unroll
                for (int cx = 0; cx < 2; ++cx) { const int ct = 2 * (wave & 3) + cx;
                    bf16x8 bfr[2];
#pragma unroll
                    for (int ks = 0; ks < 2; ++ks) { const u32x4 t = __builtin_nontemporal_load((const u32x4*)(tmp + (size_t)j * 32768 + mat * 16384 + (16 * ct + r16) * 128 + (32 * ks + 8 * q4) * 2)); bfr[ks] = __builtin_bit_cast(bf16x8, t); }
#pragma unroll
                    for (int rt = 0; rt < 4; ++rt) { f32x4 acc = {0.f, 0.f, 0.f, 0.f};
#pragma unroll
                        for (int ks = 0; ks < 2; ++ks) { const bf16x8 tf = *(const LAS bf16x8*)(slot + (rt * 2 + ks) * 1024 + lane * 16); acc = __builtin_amdgcn_mfma_f32_16x16x32_bf16(tf, bfr[ks], acc, 0, 0, 0); }
                        if (mat == 0) *(u32x2*)(ub + 57344 + (rt * 8 + ct) * 512 + lane * 8) = (u32x2){pg8::cvt_pk_bf16(acc[0], acc[1]), pg8::cvt_pk_bf16(acc[2], acc[3])};
                        else {
#pragma unroll
                            for (int rg = 0; rg < 4; ++rg) *(unsigned short*)(ub + (rt * 4 + (ct >> 1)) * 1024 + ((4 * q4 + rg) + 16 * (r16 >> 2)) * 16 + (4 * (ct & 1) + (r16 & 3)) * 2) = (unsigned short)f2bf(-acc[rg]);
                        }
                    }
                }
            }
            __syncthreads();
        }
    }
}
DEV void ph_gdn_scan(const Args& a, const Ctx& X) {
    const unsigned char* gi = a.ws + WS_GI; const float* glast = (const float*)(a.ws + WS_GLAST);
    const bf16_t* za = (const bf16_t*)(a.ws + WS_ZA); bf16_t* oy = (bf16_t*)(a.ws + WS_OY);
    const int lane = X.lane, wave = X.wave, r16 = lane & 15, q4 = lane >> 4, tid = X.tid;
    LAS float* OT = (LAS float*)(X.lds + 114688);
    const int bh = X.bid, b = bh >> 3, h = bh & 7;
    const unsigned char* ubase = gi + (size_t)bh * 64 * GI_UNIT;
    f32x4 S[8];
#pragma unroll
    for (int i = 0; i < 8; ++i) S[i] = (f32x4){0.f, 0.f, 0.f, 0.f};
    LAS float* NWL = (LAS float*)(X.lds + 149504);
    if (tid < 128) NWL[tid] = a.gdn_norm_w[tid];
#define GDN_STAGE(nn, buf) do { _Pragma("unroll") for (int _i = 0; _i < 7; ++_i) \
        __builtin_amdgcn_global_load_lds((const unsigned*)(ubase + (size_t)(nn) * GI_UNIT + (size_t)(tid + 512 * _i) * 16), (LAS unsigned*)(X.lds + (buf) * 57344 + (wave * 64 + 512 * _i) * 16), 16, 0, 0); } while (0)
    u32x2 udn[4]; float gln; u32x4 zn[2];
    { const size_t tz = (size_t)b * SEQ + (tid >> 3); zn[0] = *(const u32x4*)(za + tz * 1024 + h * 128 + 16 * (tid & 7)); zn[1] = *(const u32x4*)(za + tz * 1024 + h * 128 + 16 * (tid & 7) + 8); }
#pragma unroll
    for (int ct = 0; ct < 4; ++ct) udn[ct] = *(const u32x2*)(ubase + 57344 + (ct * 8 + wave) * 512 + lane * 8);
    gln = glast[(size_t)(bh * 64) * 32];
    GDN_STAGE(0, 0);
#define GDN_EPILOGUE(nn, ZC) do { const int tok = tid >> 3, seg = tid & 7; const size_t t = (size_t)b * SEQ + 64 * (nn) + tok; \
            float ov[16]; float ss = 0.f; float nwv[16]; \
            _Pragma("unroll") for (int i = 0; i < 4; ++i) { const f32x4 v = *(const LAS f32x4*)(NWL + 16 * seg + 4 * i); nwv[4 * i] = v[0]; nwv[4 * i + 1] = v[1]; nwv[4 * i + 2] = v[2]; nwv[4 * i + 3] = v[3]; } \
            _Pragma("unroll") for (int i = 0; i < 4; ++i) { const f32x4 v = *(const LAS f32x4*)(OT + tok * 132 + 16 * seg + 4 * i); ov[4 * i] = v[0]; ov[4 * i + 1] = v[1]; ov[4 * i + 2] = v[2]; ov[4 * i + 3] = v[3]; ss += v[0] * v[0] + v[1] * v[1] + v[2] * v[2] + v[3] * v[3]; } \
            ss = sum8(ss); \
            const float rstd = rsqrtf(ss * (1.f / 128.f) + EPS); \
            u32x4 ow[2]; \
            _Pragma("unroll") for (int i = 0; i < 2; ++i) _Pragma("unroll") for (int e = 0; e < 4; ++e) { const unsigned zw = (ZC)[i][e]; const float z0 = __uint_as_float(zw << 16), z1 = __uint_as_float(zw & 0xFFFF0000u); \
                    ow[i][e] = pg8::cvt_pk_bf16(ov[8 * i + 2 * e] * rstd * nwv[8 * i + 2 * e] * siluf(z0), ov[8 * i + 2 * e + 1] * rstd * nwv[8 * i + 2 * e + 1] * siluf(z1)); } \
            *(u32x4*)(oy + t * 2048 + h * 128 + 16 * seg) = ow[0]; *(u32x4*)(oy + t * 2048 + h * 128 + 16 * seg + 8) = ow[1]; } while (0)
    u32x4 zp[2] = {{0u, 0u, 0u, 0u}, {0u, 0u, 0u, 0u}};
    for (int n = 0; n < 64; ++n) {
        VM_WAIT(); __syncthreads();
        f32x4 uf[4];
#pragma unroll
        for (int ct = 0; ct < 4; ++ct) { uf[ct][0] = __uint_as_float(udn[ct].x << 16); uf[ct][1] = __uint_as_float(udn[ct].x & 0xFFFF0000u); uf[ct][2] = __uint_as_float(udn[ct].y << 16); uf[ct][3] = __uint_as_float(udn[ct].y & 0xFFFF0000u); }
        const float egl = __expf(gln);
        u32x4 zc[2]; zc[0] = zn[0]; zc[1] = zn[1];
        asm volatile("" : "+v"(uf[0]), "+v"(uf[1]), "+v"(uf[2]), "+v"(uf[3]), "+v"(zc[0]), "+v"(zc[1]));
        if (n + 1 < 64) {
            const unsigned char* un = ubase + (size_t)(n + 1) * GI_UNIT;
#pragma unroll
            for (int ct = 0; ct < 4; ++ct) udn[ct] = *(const u32x2*)(un + 57344 + (ct * 8 + wave) * 512 + lane * 8);
            gln = glast[(size_t)(bh * 64 + n + 1) * 32];
            { const size_t tz = (size_t)b * SEQ + 64 * (n + 1) + (tid >> 3); zn[0] = *(const u32x4*)(za + tz * 1024 + h * 128 + 16 * (tid & 7)); zn[1] = *(const u32x4*)(za + tz * 1024 + h * 128 + 16 * (tid & 7) + 8); }
            GDN_STAGE(n + 1, (n + 1) & 1);
        }
        if (n > 0) GDN_EPILOGUE(n - 1, zp);
        zp[0] = zc[0]; zp[1] = zc[1];
        const LAS unsigned char* L = X.lds + (n & 1) * 57344;
        bf16x8 sB[4];
#pragma unroll
        for (int ks = 0; ks < 4; ++ks) sB[ks] = acc_to_frag(S[2 * ks], S[2 * ks + 1]);
        f32x4 vn[4], oo[4];
#pragma unroll
        for (int ct = 0; ct < 4; ++ct) { f32x4 acc = {0.f, 0.f, 0.f, 0.f}, ao = {0.f, 0.f, 0.f, 0.f};
#pragma unroll
            for (int ks = 0; ks < 4; ++ks) { const bf16x8 wf = *(const LAS bf16x8*)(L + (ct * 4 + ks) * 1024 + lane * 16), qf = *(const LAS bf16x8*)(L + 16384 + (ct * 4 + ks) * 1024 + lane * 16);
                acc = __builtin_amdgcn_mfma_f32_16x16x32_bf16(wf, sB[ks], acc, 0, 0, 0); ao = __builtin_amdgcn_mfma_f32_16x16x32_bf16(qf, sB[ks], ao, 0, 0, 0); }
            vn[ct] = acc; oo[ct] = ao; }
#pragma unroll
        for (int ct = 0; ct < 4; ++ct) vn[ct] = vn[ct] + uf[ct];
        bf16x8 vB[2];
#pragma unroll
        for (int ks = 0; ks < 2; ++ks) vB[ks] = acc_to_frag(vn[2 * ks], vn[2 * ks + 1]);
#pragma unroll
        for (int ct = 0; ct < 4; ++ct)
#pragma unroll
            for (int ks = 0; ks < 2; ++ks) { const bf16x8 kf = *(const LAS bf16x8*)(L + 49152 + (ct * 2 + ks) * 1024 + lane * 16); oo[ct] = __builtin_amdgcn_mfma_f32_16x16x32_bf16(kf, vB[ks], oo[ct], 0, 0, 0); }
#pragma unroll
        for (int dt = 0; dt < 8; ++dt) { f32x4 acc = S[dt] * egl;
#pragma unroll
            for (int ks = 0; ks < 2; ++ks) { const bf16x8 ef = *(const LAS bf16x8*)(L + 32768 + (dt * 2 + ks) * 1024 + lane * 16); acc = __builtin_amdgcn_mfma_f32_16x16x32_bf16(ef, vB[ks], acc, 0, 0, 0); }
            S[dt] = acc; }
        __syncthreads();
#pragma unroll
        for (int ct = 0; ct < 4; ++ct)
#pragma unroll
            for (int rg = 0; rg < 4; ++rg) OT[(16 * ct + 4 * q4 + rg) * 132 + 16 * wave + r16] = oo[ct][rg];
    }
    __syncthreads();
    GDN_EPILOGUE(63, zp);
#undef GDN_EPILOGUE
#undef GDN_STAGE
}

constexpr int SP = 272;
DEV void ph_ssd_local(const Args& a, const Ctx& X, const int wg0) {
    const bf16_t* xbcpre = (const bf16_t*)(a.ws + WS_XBCPRE); const float* small = (const float*)(a.ws + WS_SMALL);
    bf16_t* CC = (bf16_t*)(a.ws + WS_CC); float* acum = (float*)(a.ws + WS_ACUM); float* cdec = (float*)(a.ws + WS_CDEC);
    bf16_t* ydiag = (bf16_t*)(a.ws + WS_YDIAG); bf16_t* states = (bf16_t*)(a.ws + WS_STATES);
    LAS unsigned char* Bn = X.lds; LAS unsigned char* Cn = X.lds + 128 * SP; LAS unsigned char* BT = X.lds + 256 * SP;
    LAS unsigned char* xdT = X.lds; LAS unsigned char* xeT = X.lds + 64 * SP;
    LAS float* acL = (LAS float*)(X.lds + AUX_OFF); LAS float* dtL = acL + 8 * 128;
    const int lane = X.lane, wave = X.wave, r16 = lane & 15, q4 = lane >> 4;
    for (int unit = X.bid - wg0; unit < NB * 32 * 2; unit += X.G - wg0) {
        const int g = unit & 1, c = (unit >> 1) & 31, b = unit >> 6; const size_t t0 = (size_t)b * SEQ + 128 * c;
        __syncthreads();
        {
            const int hd = g * 8 + wave; const float an = -__expf(a.ssd_a_log[hd]), bias = a.ssd_dt_bias[hd];
            const float d0 = softplusf(small[(t0 + lane) * 32 + 16 + hd] + bias), d1 = softplusf(small[(t0 + 64 + lane) * 32 + 16 + hd] + bias);
            float s0 = d0 * an, s1 = d1 * an;
#pragma unroll
            for (int o = 1; o < 64; o <<= 1) { const float v0 = __shfl_up(s0, o), v1 = __shfl_up(s1, o); if (lane >= o) { s0 += v0; s1 += v1; } }
            s1 += __shfl(s0, 63);
            acL[wave * 128 + lane] = s0; acL[wave * 128 + 64 + lane] = s1; dtL[wave * 128 + lane] = d0; dtL[wave * 128 + 64 + lane] = d1;
            acum[((size_t)g * T + t0 + lane) * 8 + wave] = s0; acum[((size_t)g * T + t0 + 64 + lane) * 8 + wave] = s1;
            if (lane == 63) cdec[(size_t)unit * 32 + wave] = __expf(s1);
        }
        {
            const int isC = lane >> 5, cc = (lane & 31) * 4, col = 1024 + isC * 256 + g * 128 + cc;
            float w[4][4], bs[4];
#pragma unroll
            for (int i = 0; i < 4; ++i) { const f32x4 t = *(const f32x4*)(a.ssd_conv_w + i * 1536 + col); w[i][0] = t[0]; w[i][1] = t[1]; w[i][2] = t[2]; w[i][3] = t[3]; }
            { const f32x4 t = *(const f32x4*)(a.ssd_conv_b + col); bs[0] = t[0]; bs[1] = t[1]; bs[2] = t[2]; bs[3] = t[3]; }
            float xin[19][4];
#pragma unroll
            for (int i = 0; i < 19; ++i) { const int tk = 16 * wave + i - 3; const bool ok = (128 * c + tk) >= 0; u32x2 v = {0u, 0u}; if (ok) v = *(const u32x2*)(xbcpre + (t0 + tk) * 1536 + col);
                xin[i][0] = __uint_as_float(v.x << 16); xin[i][1] = __uint_as_float(v.x & 0xFFFF0000u); xin[i][2] = __uint_as_float(v.y << 16); xin[i][3] = __uint_as_float(v.y & 0xFFFF0000u); }
            unsigned short ov[16][4];
#pragma unroll
            for (int i = 0; i < 16; ++i)
#pragma unroll
                for (int e = 0; e < 4; ++e) { const float s = bs[e] + w[0][e] * xin[i][e] + w[1][e] * xin[i + 1][e] + w[2][e] * xin[i + 2][e] + w[3][e] * xin[i + 3][e]; ov[i][e] = (unsigned short)f2bf(siluf(s)); }
            LAS unsigned char* nat = isC ? Cn : Bn;
#pragma unroll
            for (int i = 0; i < 16; ++i) { const u32x2 pk = {(unsigned)ov[i][0] | ((unsigned)ov[i][1] << 16), (unsigned)ov[i][2] | ((unsigned)ov[i][3] << 16)};
                *(LAS u32x2*)(nat + (16 * wave + i) * SP + cc * 2) = pk;
                if (isC) *(u32x2*)(CC + (t0 + 16 * wave + i) * 256 + g * 128 + cc) = pk; }
            if (!isC) {
#pragma unroll
                for (int e = 0; e < 4; ++e)
#pragma unroll
                    for (int qq = 0; qq < 4; ++qq) { const u32x2 pk = {(unsigned)ov[4 * qq][e] | ((unsigned)ov[4 * qq + 1][e] << 16), (unsigned)ov[4 * qq + 2][e] | ((unsigned)ov[4 * qq + 3][e] << 16)};
                        *(LAS u32x2*)(BT + (cc + e) * SP + (32 * (wave >> 1) + 8 * qq + 4 * (wave & 1)) * 2) = pk; }
            }
        }
        __syncthreads();
        f32x4 cbt[8];
        {
            bf16x8 cf[4];
#pragma unroll
            for (int ks = 0; ks < 4; ++ks) cf[ks] = *(const LAS bf16x8*)(Cn + (16 * wave + r16) * SP + (32 * ks + 8 * q4) * 2);
#pragma unroll
            for (int st = 0; st < 8; ++st) { cbt[st] = (f32x4){0.f, 0.f, 0.f, 0.f};
#pragma unroll
                for (int ks = 0; ks < 4; ++ks) { const bf16x8 bf = *(const LAS bf16x8*)(Bn + (16 * st + r16) * SP + (32 * ks + 8 * q4) * 2); cbt[st] = __builtin_amdgcn_mfma_f32_16x16x32_bf16(bf, cf[ks], cbt[st], 0, 0, 0); } }
        }
        __syncthreads();
        const int lq = 16 * wave + r16;
        unsigned short xnx[19];
#define SSD_LOADX(hh) do { _Pragma("unroll") for (int _i = 0; _i < 19; ++_i) { const int _tk = 16 * wave + _i - 3; xnx[_i] = (128 * c + _tk) >= 0 ? xbcpre[(t0 + _tk) * 1536 + (hh) * 64 + lane] : (unsigned short)0; } } while (0)
        SSD_LOADX(g * 8);
        for (int r = 0; r < 8; ++r) {
            const int hd = g * 8 + r; const float dd = a.ssd_d[hd];
            {
                const int col = hd * 64 + lane; float w0 = a.ssd_conv_w[col], w1 = a.ssd_conv_w[1536 + col], w2 = a.ssd_conv_w[2 * 1536 + col], w3 = a.ssd_conv_w[3 * 1536 + col]; const float bs = a.ssd_conv_b[col];
                float xin[19];
#pragma unroll
                for (int i = 0; i < 19; ++i) xin[i] = bf2f(xnx[i]);
                if (r + 1 < 8) SSD_LOADX(hd + 1);
                const float aclast = acL[r * 128 + 127];
                unsigned short xd[16], xe[16];
#pragma unroll
                for (int i = 0; i < 16; ++i) { const float xv = siluf(bs + w0 * xin[i] + w1 * xin[i + 1] + w2 * xin[i + 2] + w3 * xin[i + 3]); const int tk = 16 * wave + i;
                    const float xdv = xv * dtL[r * 128 + tk]; xd[i] = (unsigned short)f2bf(xdv); xe[i] = (unsigned short)f2bf(xdv * __expf(aclast - acL[r * 128 + tk])); }
#pragma unroll
                for (int qq = 0; qq < 4; ++qq) { const int pos = 32 * (wave >> 1) + 8 * qq + 4 * (wave & 1);
                    *(LAS u32x2*)(xdT + lane * SP + pos * 2) = (u32x2){(unsigned)xd[4 * qq] | ((unsigned)xd[4 * qq + 1] << 16), (unsigned)xd[4 * qq + 2] | ((unsigned)xd[4 * qq + 3] << 16)};
                    *(LAS u32x2*)(xeT + lane * SP + pos * 2) = (u32x2){(unsigned)xe[4 * qq] | ((unsigned)xe[4 * qq + 1] << 16), (unsigned)xe[4 * qq + 2] | ((unsigned)xe[4 * qq + 3] << 16)}; }
            }
            __syncthreads();
            {
                const float acl = acL[r * 128 + lq], ddt = dd * __builtin_amdgcn_rcpf(dtL[r * 128 + lq]);
                f32x4 yd[4];
#pragma unroll
                for (int pt = 0; pt < 4; ++pt) yd[pt] = (f32x4){0.f, 0.f, 0.f, 0.f};
#pragma unroll
                for (int ks = 0; ks < 4; ++ks) { if (ks <= (wave >> 1)) {
                    f32x4 mlo, mhi;
#pragma unroll
                    for (int e = 0; e < 4; ++e) {
                        const int s0 = 32 * ks + 4 * q4 + e, s1 = s0 + 16;
                        const float v0 = cbt[2 * ks][e], v1 = cbt[2 * ks + 1][e];
                        mlo[e] = s0 < lq ? v0 * __expf(acl - acL[r * 128 + s0]) : (s0 == lq ? v0 + ddt : 0.f);
                        mhi[e] = s1 < lq ? v1 * __expf(acl - acL[r * 128 + s1]) : (s1 == lq ? v1 + ddt : 0.f);
                    }
                    const bf16x8 mf = acc_to_frag(mlo, mhi);
#pragma unroll
                    for (int pt = 0; pt < 4; ++pt) { const bf16x8 xf = *(const LAS bf16x8*)(xdT + (16 * pt + r16) * SP + (32 * ks + 8 * q4) * 2); yd[pt] = __builtin_amdgcn_mfma_f32_16x16x32_bf16(xf, mf, yd[pt], 0, 0, 0); }
                } }
#pragma unroll
                for (int pt = 0; pt < 4; ++pt) *(u32x2*)(ydiag + (t0 + lq) * 1024 + hd * 64 + 16 * pt + 4 * q4) = (u32x2){pg8::cvt_pk_bf16(yd[pt][0], yd[pt][1]), pg8::cvt_pk_bf16(yd[pt][2], yd[pt][3])};
            }
            {
                bf16x8 bf[4];
#pragma unroll
                for (int ks = 0; ks < 4; ++ks) bf[ks] = *(const LAS bf16x8*)(BT + (16 * wave + r16) * SP + (32 * ks + 8 * q4) * 2);
                bf16_t* hp = states + ((size_t)(unit * 8 + r) * 64) * 128;
#pragma unroll
                for (int pt = 0; pt < 4; ++pt) { f32x4 st = {0.f, 0.f, 0.f, 0.f};
#pragma unroll
                    for (int ks = 0; ks < 4; ++ks) { const bf16x8 xf = *(const LAS bf16x8*)(xeT + (16 * pt + r16) * SP + (32 * ks + 8 * q4) * 2); st = __builtin_amdgcn_mfma_f32_16x16x32_bf16(bf[ks], xf, st, 0, 0, 0); }
                    *(u32x2*)(hp + (size_t)(16 * pt + r16) * 128 + 16 * wave + 4 * q4) = (u32x2){pg8::cvt_pk_bf16(st[0], st[1]), pg8::cvt_pk_bf16(st[2], st[3])}; }
            }
            __syncthreads();
        }
    }
}
DEV void ph_ssd_scan(const Args& a, const Ctx& X, const int wg0) {
    bf16_t* states = (bf16_t*)(a.ws + WS_STATES); const float* cdec = (const float*)(a.ws + WS_CDEC);
    for (int task = (X.bid - wg0) * NTHR + X.tid; task < NB * 16 * 64 * 32; task += (X.G - wg0) * NTHR) {
        const int n4 = task & 31, p = (task >> 5) & 63, hd = (task >> 11) & 15, b = task >> 15;
        bf16_t* base = states + ((size_t)(((b * 32) * 2 + (hd >> 3)) * 8 + (hd & 7)) * 64 + p) * 128 + 4 * n4;
        const float* dbase = cdec + (size_t)((b * 32) * 2 + (hd >> 3)) * 32 + (hd & 7);
        u32x2 sv[32]; float dec[32];
#pragma unroll
        for (int c = 0; c < 32; ++c) { sv[c] = *(const u32x2*)(base + (size_t)c * 131072); dec[c] = dbase[c * 64]; }
        float h0 = 0.f, h1 = 0.f, h2 = 0.f, h3 = 0.f;
#pragma unroll
        for (int c = 0; c < 32; ++c) {
            *(u32x2*)(base + (size_t)c * 131072) = (u32x2){pk2(h0, h1), pk2(h2, h3)};
            h0 = h0 * dec[c] + __uint_as_float(sv[c].x << 16); h1 = h1 * dec[c] + __uint_as_float(sv[c].x & 0xFFFF0000u); h2 = h2 * dec[c] + __uint_as_float(sv[c].y << 16); h3 = h3 * dec[c] + __uint_as_float(sv[c].y & 0xFFFF0000u);
        }
    }
}
DEV void ph_ssd_out(const Args& a, const Ctx& X, const int wg0, const int rot) {
    const bf16_t* CC = (const bf16_t*)(a.ws + WS_CC); const float* acum = (const float*)(a.ws + WS_ACUM); const bf16_t* ydiag = (const bf16_t*)(a.ws + WS_YDIAG);
    const bf16_t* states = (const bf16_t*)(a.ws + WS_STATES); const bf16_t* zb = (const bf16_t*)(a.ws + WS_ZB); bf16_t* oy = (bf16_t*)(a.ws + WS_OY);
    const int lane = X.lane, wave = X.wave, r16 = lane & 15, q4 = lane >> 4;
    for (int unit = (X.bid - wg0 + rot) % (X.G - wg0); unit < NB * 32 * 2; unit += X.G - wg0) {
        const int g = unit & 1, c = (unit >> 1) & 31, b = unit >> 6; const size_t t = (size_t)b * SEQ + 128 * c + 16 * wave + r16;
        bf16x8 cf[4];
#pragma unroll
        for (int ks = 0; ks < 4; ++ks) cf[ks] = *(const bf16x8*)(CC + t * 256 + g * 128 + 32 * ks + 8 * q4);
        float ss = 0.f;
        LAS u32x2* stash = (LAS u32x2*)(X.lds + wave * 16384);
#define SO_LOAD(rr, HF, YD, ZZ, EA) do { const bf16_t* hp_ = states + ((size_t)(unit * 8 + (rr)) * 64) * 128; const int hd_ = g * 8 + (rr); \
            EA = acum[((size_t)g * T + t) * 8 + (rr)]; \
            _Pragma("unroll") for (int pt = 0; pt < 4; ++pt) { _Pragma("unroll") for (int ks = 0; ks < 4; ++ks) HF[pt][ks] = *(const bf16x8*)(hp_ + (size_t)(16 * pt + r16) * 128 + 32 * ks + 8 * q4); \
                YD[pt] = *(const u32x2*)(ydiag + t * 1024 + hd_ * 64 + 16 * pt + 4 * q4); ZZ[pt] = *(const u32x2*)(zb + t * 1024 + hd_ * 64 + 16 * pt + 4 * q4); } } while (0)
#define SO_COMP(rr, HF, YD, ZZ, EA) do { const float eac = __expf(EA); \
            _Pragma("unroll") for (int pt = 0; pt < 4; ++pt) { f32x4 acc = {0.f, 0.f, 0.f, 0.f}; \
                _Pragma("unroll") for (int ks = 0; ks < 4; ++ks) acc = __builtin_amdgcn_mfma_f32_16x16x32_bf16(HF[pt][ks], cf[ks], acc, 0, 0, 0); \
                const u32x2 yd = YD[pt], zz = ZZ[pt]; \
                f32x4 v; v[0] = acc[0] * eac + __uint_as_float(yd.x << 16); v[1] = acc[1] * eac + __uint_as_float(yd.x & 0xFFFF0000u); v[2] = acc[2] * eac + __uint_as_float(yd.y << 16); v[3] = acc[3] * eac + __uint_as_float(yd.y & 0xFFFF0000u); \
                v[0] *= siluf(__uint_as_float(zz.x << 16)); v[1] *= siluf(__uint_as_float(zz.x & 0xFFFF0000u)); v[2] *= siluf(__uint_as_float(zz.y << 16)); v[3] *= siluf(__uint_as_float(zz.y & 0xFFFF0000u)); \
                ss += v[0] * v[0] + v[1] * v[1] + v[2] * v[2] + v[3] * v[3]; \
                stash[((rr) * 4 + pt) * 64 + lane] = (u32x2){pg8::cvt_pk_bf16(v[0], v[1]), pg8::cvt_pk_bf16(v[2], v[3])}; } } while (0)
        bf16x8 hfA[4][4], hfB[4][4]; u32x2 ydA[4], zzA[4], ydB[4], zzB[4]; float eaA, eaB;
        SO_LOAD(0, hfA, ydA, zzA, eaA);
        for (int r = 0; r < 8; r += 2) {
            SO_LOAD(r + 1, hfB, ydB, zzB, eaB);
            SO_COMP(r, hfA, ydA, zzA, eaA);
            if (r + 2 < 8) SO_LOAD(r + 2, hfA, ydA, zzA, eaA);
            SO_COMP(r + 1, hfB, ydB, zzB, eaB);
        }
#undef SO_LOAD
#undef SO_COMP
        ss += __shfl_xor(ss, 16); ss += __shfl_xor(ss, 32);
        const float rstd = rsqrtf(ss * (1.f / 512.f) + EPS);
#pragma unroll 2
        for (int r = 0; r < 8; ++r)
#pragma unroll
            for (int pt = 0; pt < 4; ++pt) { const int cix = g * 512 + r * 64 + 16 * pt + 4 * q4; const f32x4 nw = *(const f32x4*)(a.ssd_norm_w + cix); const u32x2 w = stash[(r * 4 + pt) * 64 + lane];
                *(u32x2*)(oy + t * 2048 + 1024 + cix) = (u32x2){pg8::cvt_pk_bf16(__uint_as_float(w.x << 16) * rstd * nw[0], __uint_as_float(w.x & 0xFFFF0000u) * rstd * nw[1]), pg8::cvt_pk_bf16(__uint_as_float(w.y << 16) * rstd * nw[2], __uint_as_float(w.y & 0xFFFF0000u) * rstd * nw[3])}; }
    }
}


DEV int att_key(int tl) { return (tl ^ (tl >> 4)) & 15; }
template <bool PAIR, bool FIRST>
DEV void att_task(const bf16_t* qkv, LAS unsigned char* vl, LAS unsigned char* kl, LAS unsigned char* OL, LAS float* LSEL, const int b, const int hd, const int d, const int r, const int I0, const int tok_base) {
    int lane; asm volatile("v_mbcnt_lo_u32_b32 %0, -1, 0\n\tv_mbcnt_hi_u32_b32 %0, -1, %0" : "=v"(lane));
    const int q = lane & 31, h5 = lane >> 5;
    const int tr_off = ((lane & 15) >> 2) * 192 + (16 * ((lane >> 4) & 1) + 4 * (lane & 3)) * 2;
    const int prow = lane >> 3, pch = lane & 7;
#define ATT_LOAD(dst, j0_, coff) do { _Pragma("unroll") for (int _i = 0; _i < 4; ++_i) { const size_t _t = (size_t)b * SEQ + (size_t)((j0_) + 8 * _i + prow) * d + r; \
        dst[_i] = *(const u32x4*)(qkv + _t * 3072 + (coff) + hd * 64 + pch * 8); } } while (0)
    u32x4 k0[4], v0[4], k1[4], v1[4];
    const bool e4 = I0 >= 0, e3 = (I0 - 32) >= 0, e2 = (I0 - 64) >= 0, e1 = (I0 - 96) >= 0, e0 = (I0 - 128) >= 0;
    bf16x8 qA[4], qB[4];
    if constexpr (PAIR) {
        ATT_LOAD(k0, I0, 0);
#pragma unroll
        for (int i = 0; i < 4; ++i) *(LAS u32x4*)(kl + (8 * i + prow) * 144 + pch * 16) = k0[i];
#pragma unroll
        for (int s = 0; s < 4; ++s) qA[s] = *(const LAS bf16x8*)(kl + q * 144 + (16 * s + 8 * h5) * 2);
        LDS_WAIT();
    }
    ATT_LOAD(k1, I0 + 32, 0);
#pragma unroll
    for (int i = 0; i < 4; ++i) *(LAS u32x4*)(kl + (8 * i + prow) * 144 + pch * 16) = k1[i];
#pragma unroll
    for (int s = 0; s < 4; ++s) qB[s] = *(const LAS bf16x8*)(kl + q * 144 + (16 * s + 8 * h5) * 2);
    LDS_WAIT();
    ATT_LOAD(k0, I0 + 32, 1024); ATT_LOAD(v0, I0 + 32, 2048);
    if (PAIR || e4) { ATT_LOAD(k1, I0, 1024); ATT_LOAD(v1, I0, 2048); }
    f32x16 oA[2], oB[2];
#pragma unroll
    for (int i = 0; i < 16; ++i) { oA[0][i] = 0.f; oA[1][i] = 0.f; oB[0][i] = 0.f; oB[1][i] = 0.f; }
    float mA = -1e30f, lA = 0.f, mB = -1e30f, lB = 0.f;
    auto scores = [&](const bf16x8 (&kf)[4], const bf16x8 (&qf)[4], f32x16 (&oacc)[2], float& m, float& l, const int mode, bf16x8 (&pf)[2]) {
        f32x16 sacc;
#pragma unroll
        for (int i = 0; i < 16; ++i) sacc[i] = 0.f;
#pragma unroll
        for (int s = 0; s < 4; ++s) sacc = __builtin_amdgcn_mfma_f32_32x32x16_bf16(kf[s], qf[s], sacc, 0, 0, 0);
        if (mode == 1) {
#pragma unroll
            for (int i = 0; i < 16; ++i) { const int kl_ = (i & 3) + 8 * (i >> 2) + 4 * h5; if (kl_ > q) sacc[i] = -1e30f; }
        } else if (mode == 2) {
#pragma unroll
            for (int i = 0; i < 16; ++i) { const int kl_ = (i & 3) + 8 * (i >> 2) + 4 * h5; if (kl_ < q) sacc[i] = -1e30f; }
        }
        float mx = sacc[0];
#pragma unroll
        for (int i = 1; i < 16; ++i) mx = fmaxf(mx, sacc[i]);
        mx = fmaxf(mx, __shfl_xor(mx, 32));
        const float mn = fmaxf(m, mx), alpha = __expf(m - mn);
        float rs = 0.f;
#pragma unroll
        for (int i = 0; i < 16; ++i) { sacc[i] = __expf(sacc[i] - mn); rs += sacc[i]; }
        rs += __shfl_xor(rs, 32);
        l = l * alpha + rs; m = mn;
#pragma unroll
        for (int i = 0; i < 16; ++i) { oacc[0][i] *= alpha; oacc[1][i] *= alpha; }
#pragma unroll
        for (int s = 0; s < 2; ++s) { u32x4 w; w.x = pg8::cvt_pk_bf16(sacc[8 * s], sacc[8 * s + 1]); w.y = pg8::cvt_pk_bf16(sacc[8 * s + 2], sacc[8 * s + 3]); w.z = pg8::cvt_pk_bf16(sacc[8 * s + 4], sacc[8 * s + 5]); w.w = pg8::cvt_pk_bf16(sacc[8 * s + 6], sacc[8 * s + 7]);
            pf[s] = __builtin_bit_cast(bf16x8, w); }
    };
    auto tile = [&](const u32x4 (&kp)[4], const u32x4 (&vp)[4], const int ma, const int mb) {
#pragma unroll
        for (int i = 0; i < 4; ++i) { *(LAS u32x4*)(kl + (8 * i + prow) * 144 + pch * 16) = kp[i]; *(LAS u32x4*)(vl + (8 * i + prow) * 192 + pch * 16) = vp[i]; }
        bf16x8 kf[4];
#pragma unroll
        for (int s = 0; s < 4; ++s) kf[s] = *(const LAS bf16x8*)(kl + q * 144 + (16 * s + 8 * h5) * 2);
        bf16x8 pA[2], pB[2];
        if (ma >= 0) scores(kf, qA, oA, mA, lA, ma, pA);
        if (mb >= 0) scores(kf, qB, oB, mB, lB, mb, pB);
#pragma unroll
        for (int dt = 0; dt < 2; ++dt)
#pragma unroll
            for (int s = 0; s < 2; ++s) {
                const s16x4 t0_ = __builtin_amdgcn_ds_read_tr16_b64_v4i16((LAS s16x4*)(vl + (16 * s + 4 * h5) * 192 + dt * 64 + tr_off));
                const s16x4 t1_ = __builtin_amdgcn_ds_read_tr16_b64_v4i16((LAS s16x4*)(vl + (16 * s + 8 + 4 * h5) * 192 + dt * 64 + tr_off));
                bf16x8 vf; vf[0] = t0_[0]; vf[1] = t0_[1]; vf[2] = t0_[2]; vf[3] = t0_[3]; vf[4] = t1_[0]; vf[5] = t1_[1]; vf[6] = t1_[2]; vf[7] = t1_[3];
                if (ma >= 0) oA[dt] = __builtin_amdgcn_mfma_f32_32x32x16_bf16(vf, pA[s], oA[dt], 0, 0, 0);
                if (mb >= 0) oB[dt] = __builtin_amdgcn_mfma_f32_32x32x16_bf16(vf, pB[s], oB[dt], 0, 0, 0);
            }
        LDS_WAIT();
    };
    constexpr int MA_C = PAIR ? 1 : -1, MA_F = PAIR ? 0 : -1;
    tile(k0, v0, -1, 1);
    if (PAIR || e4) {
        if (e3) { ATT_LOAD(k0, I0 - 32, 1024); ATT_LOAD(v0, I0 - 32, 2048); }
        tile(k1, v1, MA_C, 0);
        if (e3) {
            if (e2) { ATT_LOAD(k1, I0 - 64, 1024); ATT_LOAD(v1, I0 - 64, 2048); }
            tile(k0, v0, MA_F, 0);
            if (e2) {
                if (e1) { ATT_LOAD(k0, I0 - 96, 1024); ATT_LOAD(v0, I0 - 96, 2048); }
                tile(k1, v1, MA_F, 0);
                if (e1) {
                    if (PAIR && e0) { ATT_LOAD(k1, I0 - 128, 1024); ATT_LOAD(v1, I0 - 128, 2048); }
                    tile(k0, v0, MA_F, 2);
                    if constexpr (PAIR) { if (e0) tile(k1, v1, 2, -1); }
                }
            }
        }
    }
#undef ATT_LOAD
#pragma unroll
    for (int qt = PAIR ? 0 : 1; qt < 2; ++qt) {
        int tl = (I0 + 32 * qt + q) * d + r - tok_base; asm volatile("" : "+v"(tl));
        const int key = att_key(tl);
        const float l = qt ? lB : lA, m = qt ? mB : mA; const float lse = m + __logf(l);
        float wo = 0.f, wn = __builtin_amdgcn_rcpf(l);
        if constexpr (!FIRST) { const float lo = LSEL[tl], mx = fmaxf(lo, lse), a0 = __expf(lo - mx), a1 = __expf(lse - mx), wi = __builtin_amdgcn_rcpf(a0 + a1); wo = a0 * wi; wn *= a1 * wi;
            if (h5 == 0) LSEL[tl] = mx + __logf(a0 + a1); }
        else { if (h5 == 0) LSEL[tl] = lse; }
#pragma unroll
        for (int dt = 0; dt < 2; ++dt)
#pragma unroll
            for (int gq = 0; gq < 4; ++gq) { const f32x16& oo = qt ? oB[dt] : oA[dt];
                LAS u32x2* p = (LAS u32x2*)(OL + tl * 128 + (((8 * dt + 2 * gq + h5) ^ key) << 3));
                float f0 = oo[4 * gq] * wn, f1 = oo[4 * gq + 1] * wn, f2 = oo[4 * gq + 2] * wn, f3 = oo[4 * gq + 3] * wn;
                if constexpr (!FIRST) { const u32x2 w = *p; f0 += wo * __uint_as_float(w.x << 16); f1 += wo * __uint_as_float(w.x & 0xFFFF0000u); f2 += wo * __uint_as_float(w.y << 16); f3 += wo * __uint_as_float(w.y & 0xFFFF0000u); }
                *p = (u32x2){pg8::cvt_pk_bf16(f0, f1), pg8::cvt_pk_bf16(f2, f3)}; }
    }
}
DEV void ph_attn(const Args& a, const Ctx& X) {
    const bf16_t* qkv = (const bf16_t*)(a.ws + WS_Q1KV); unsigned char* o = a.ws + WS_O1;
    LAS unsigned char* vl = X.lds + X.wave * 10752;
    LAS unsigned char* kl = vl + 6144;
    LAS unsigned char* OL = X.lds + 86016; LAS float* LSEL = (LAS float*)(X.lds + 86016 + 65536);
    const int wave = X.wave;
    for (int unit = X.bid; unit < NB * 16 * 8; unit += X.G) {
        const int bhd = unit & 63, b = bhd >> 4, hd = bhd & 15, g = unit >> 6;
        const int tb = 512 * g;
        att_task<true, true>(qkv, vl, kl, OL, LSEL, b, hd, 1, 0, 512 * g + 64 * wave, tb);
        __syncthreads();
        att_task<true, false>(qkv, vl, kl, OL, LSEL, b, hd, 4, wave & 3, 128 * g + 64 * (wave >> 2), tb);
        __syncthreads();
        for (int j = 0; j < 2; ++j) att_task<false, false>(qkv, vl, kl, OL, LSEL, b, hd, 16, 2 * wave + j, 32 * g - 32, tb);
        __syncthreads();
        {
            int tl; asm volatile("v_mbcnt_lo_u32_b32 %0, -1, 0\n\tv_mbcnt_hi_u32_b32 %0, -1, %0" : "=v"(tl)); tl += 64 * wave; const int key = att_key(tl); u32x4 yq[4];
#pragma unroll
            for (int p = 0; p < 16; p += 2) { const u32x2 w0 = *(const LAS u32x2*)(OL + tl * 128 + ((p ^ key) << 3)), w1 = *(const LAS u32x2*)(OL + tl * 128 + (((p + 1) ^ key) << 3));
                float f[8] = {__uint_as_float(w0.x << 16), __uint_as_float(w0.x & 0xFFFF0000u), __uint_as_float(w0.y << 16), __uint_as_float(w0.y & 0xFFFF0000u), __uint_as_float(w1.x << 16), __uint_as_float(w1.x & 0xFFFF0000u), __uint_as_float(w1.y << 16), __uint_as_float(w1.y & 0xFFFF0000u)};
#pragma unroll
                for (int e = 0; e < 8; ++e) f[e] = __builtin_amdgcn_fmed3f(f[e] * 4.f, -440.f, 440.f);
                int v0 = __builtin_amdgcn_cvt_pk_fp8_f32(f[0], f[1], 0, false); v0 = __builtin_amdgcn_cvt_pk_fp8_f32(f[2], f[3], v0, true);
                int v1 = __builtin_amdgcn_cvt_pk_fp8_f32(f[4], f[5], 0, false); v1 = __builtin_amdgcn_cvt_pk_fp8_f32(f[6], f[7], v1, true);
                yq[p >> 2][p & 2] = (unsigned)v0; yq[p >> 2][(p & 2) + 1] = (unsigned)v1; }
            unsigned char* orow = o + ((size_t)b * SEQ + tb + tl) * 1024 + hd * 64;
#pragma unroll
            for (int j = 0; j < 4; ++j) *(u32x4*)(orow + 16 * j) = yq[j];
        }
        __syncthreads();
    }
}

DEV void ph_router(const Args& a, const Ctx& X, const int l) {
    unsigned char* ws = a.ws;
    const float* mod = (const float*)(ws + WS_MOD) + (size_t)l * NB * 6 * D;
    const bf16_t* ymix = (const bf16_t*)(ws + WS_YMIX);
    bf16_t* xb = (bf16_t*)(ws + WS_XB);
    bf16_t* hb = (bf16_t*)(ws + WS_H);
    int* idx = (int*)(ws + WS_IDX); float* gw = (float*)(ws + WS_GW); int* aslot = (int*)(ws + WS_ASLOT); int* ltok = (int*)(ws + WS_LTOK);
    int* cntg = (int*)(ws + WS_CTL + CTL_CNT) + l * NE;
    const float* rw = a.router_w + (size_t)l * D * NE; const float* rbias = a.router_bias + l * NE;
    constexpr int HP = 2064;
    LAS unsigned char* hL = X.lds;
    LAS float* logit = (LAS float*)(X.lds + AUX_OFF + 2048);
    LAS int* lcnt = (LAS int*)(X.lds + AUX_OFF + 2048 + 64 * 65 * 4);
    LAS int* lbase = lcnt + 64;
    LAS int* sel_e = lbase + 64;
    LAS int* sel_s = sel_e + 512;
    const int lane = X.lane, wave = X.wave;
    for (int rb = X.bid; rb < T / 64; rb += X.G) {
        if (X.tid < 64) lcnt[X.tid] = 0;
        f32x4 xf_n[4]; u32x2 xb_n[4], ym_n[4];
#define RT_LOAD(rr) do { const int _row = rb * 64 + wave * 8 + (rr); _Pragma("unroll") for (int _j = 0; _j < 4; ++_j) { \
            if (l == 0) xf_n[_j] = *(const f32x4*)(a.x + (size_t)_row * D + _j * 256 + lane * 4); else xb_n[_j] = *(const u32x2*)(xb + (size_t)_row * D + _j * 256 + lane * 4); \
            ym_n[_j] = *(const u32x2*)(ymix + (size_t)_row * D + _j * 256 + lane * 4); } } while (0)
        RT_LOAD(0);
        for (int r8 = 0; r8 < 8; ++r8) {
            const int lr = wave * 8 + r8, row = rb * 64 + lr, b = row / SEQ; const float* ml = mod + (size_t)b * 6 * D;
            float xv[16], yv[16];
#pragma unroll
            for (int j = 0; j < 4; ++j) {
                if (l == 0) { xv[4 * j] = xf_n[j][0]; xv[4 * j + 1] = xf_n[j][1]; xv[4 * j + 2] = xf_n[j][2]; xv[4 * j + 3] = xf_n[j][3]; }
                else { xv[4 * j] = __uint_as_float(xb_n[j].x << 16); xv[4 * j + 1] = __uint_as_float(xb_n[j].x & 0xFFFF0000u); xv[4 * j + 2] = __uint_as_float(xb_n[j].y << 16); xv[4 * j + 3] = __uint_as_float(xb_n[j].y & 0xFFFF0000u); }
                yv[4 * j] = __uint_as_float(ym_n[j].x << 16); yv[4 * j + 1] = __uint_as_float(ym_n[j].x & 0xFFFF0000u); yv[4 * j + 2] = __uint_as_float(ym_n[j].y << 16); yv[4 * j + 3] = __uint_as_float(ym_n[j].y & 0xFFFF0000u); }
            if (r8 + 1 < 8) RT_LOAD(r8 + 1);
            resid_update(xv, yv, a.mix_post_g + l * D, ml + 2 * D, lane);
            store_row_bf(xb + (size_t)row * D, lane, xv);
            u32x2 o[4]; prenorm_pack(xv, a.ffn_pre_g + l * D, ml + 4 * D, ml + 3 * D, lane, o);
#pragma unroll
            for (int j = 0; j < 4; ++j) { *(LAS u32x2*)(hL + lr * HP + (j * 256 + lane * 4) * 2) = o[j];
                const float h0 = __uint_as_float(o[j].x << 16), h1 = __uint_as_float(o[j].x & 0xFFFF0000u), h2 = __uint_as_float(o[j].y << 16), h3 = __uint_as_float(o[j].y & 0xFFFF0000u);
                int w = __builtin_amdgcn_cvt_pk_fp8_f32(__builtin_amdgcn_fmed3f(h0, -440.f, 440.f), __builtin_amdgcn_fmed3f(h1, -440.f, 440.f), 0, false); w = __builtin_amdgcn_cvt_pk_fp8_f32(__builtin_amdgcn_fmed3f(h2, -440.f, 440.f), __builtin_amdgcn_fmed3f(h3, -440.f, 440.f), w, true);
                *(unsigned*)((unsigned char*)hb + (size_t)row * D + j * 256 + lane * 4) = (unsigned)w; }
        }
#undef RT_LOAD
        __syncthreads();
        { const int rt = wave & 3, nh = wave >> 2, r16 = lane & 15, kq = lane >> 4;
          f32x4 acc0 = {0.f, 0.f, 0.f, 0.f}, acc1 = {0.f, 0.f, 0.f, 0.f};
          for (int c = 0; c < 32; ++c) {
              const u32x4 hv = *(const LAS u32x4*)(hL + (rt * 16 + r16) * HP + (32 * c + 8 * kq) * 2);
              const float* rp = rw + (size_t)(32 * c + 8 * kq) * NE + 4 * r16 + 2 * nh;
#pragma unroll
              for (int j = 0; j < 8; ++j) { const unsigned wj = hv[j >> 1]; const float av = (j & 1) ? __uint_as_float(wj & 0xFFFF0000u) : __uint_as_float(wj << 16);
                  const f32x2 bv = *(const f32x2*)(rp + (size_t)j * NE);
                  acc0 = __builtin_amdgcn_mfma_f32_16x16x4f32(av, bv.x, acc0, 0, 0, 0); acc1 = __builtin_amdgcn_mfma_f32_16x16x4f32(av, bv.y, acc1, 0, 0, 0); }
          }
#pragma unroll
          for (int r = 0; r < 4; ++r) { logit[(rt * 16 + 4 * kq + r) * 65 + 4 * r16 + 2 * nh] = acc0[r]; logit[(rt * 16 + 4 * kq + r) * 65 + 4 * r16 + 2 * nh + 1] = acc1[r]; } }
        __syncthreads();
        for (int r8 = 0; r8 < 8; ++r8) {
            const int lr = wave * 8 + r8, t = rb * 64 + lr;
            float lgt = logit[lr * 65 + lane]; if (!(lgt > -1e30f && lgt < 1e30f)) lgt = 0.f;
            const float score = sigmoidf_(lgt), biased = score + rbias[lane];
            const float m1 = max8(biased);
            const int c1 = min8((biased == m1) ? (lane & 7) : 8);
            const float m2 = max8(((lane & 7) == c1) ? -INFINITY : biased);
            const float gs = m1 + m2; const int myg = lane >> 3; int grank = 0;
#pragma unroll
            for (int g2 = 0; g2 < 8; ++g2) { const float o = rlf(gs, g2 * 8); grank += (o > gs || (o == gs && g2 < myg)) ? 1 : 0; }
            const float cand = (grank < 4) ? biased : -INFINITY; int rank = 0;
#pragma unroll 8
            for (int e2 = 0; e2 < 64; ++e2) { const float o = rlf(cand, e2); rank += (o > cand || (o == cand && e2 < lane)) ? 1 : 0; }
            const bool sel = (rank < TOPK) && (grank < 4);
            const float ssum = wave_sum(sel ? score : 0.f);
            if (sel) { idx[t * 8 + rank] = lane; gw[t * 8 + rank] = score * __builtin_amdgcn_rcpf(ssum) * 2.5f; sel_e[lr * 8 + rank] = lane; sel_s[lr * 8 + rank] = __hip_atomic_fetch_add(lcnt + lane, 1, __ATOMIC_RELAXED, __HIP_MEMORY_SCOPE_WORKGROUP); }
        }
        __syncthreads();
        if (X.tid < 64) { const int n = lcnt[X.tid]; lbase[X.tid] = n ? atomicAdd(cntg + X.tid, n) : 0; }
        __syncthreads();
        { const int lr = X.tid >> 3, k = X.tid & 7, t = rb * 64 + lr, e = sel_e[lr * 8 + k], sl = lbase[e] + sel_s[lr * 8 + k];
          aslot[t * 8 + k] = sl; ltok[e * CAP + sl] = t; }
        __syncthreads();
    }
}
template <int NW>
DEV void ph_moe_conv(const Args& a, const Ctx& X, const int l, const int widx, const int nwg, const int it0, const int it1) {
    unsigned char* ws = a.ws;
    if (X.wave >= NW) return;
    { LAS float* scr = (LAS float*)(X.lds + X.wave * 8704);
      const int gwv = widx * NW + X.wave, NGW = nwg * NW;
      constexpr int I_GU = (D / 64) * (512 / 32), I_D = (ED / 64) * (D / 32), I_E = I_GU + I_D;
      const float* eg = a.exp_gate + (size_t)l * NE * D * ED; const float* eu = a.exp_up + (size_t)l * NE * D * ED; const float* ed = a.exp_down + (size_t)l * NE * ED * D;
      const int itend = it1 < 0 ? (NE + 1) * I_E : it1;
      for (int it = it0 + gwv; it < itend; it += NGW) {
          const int e = it / I_E; int r = it - e * I_E;
          if (e < NE) {
              if (r < I_GU) conv_item<SrcGU, true>(SrcGU{eg + (size_t)e * D * ED, (long)(eu - eg)}, ED, D, ws + WS_WGU + (size_t)e * 512 * D, scr, r, 16, X.lane, 64.f);
              else conv_item<SrcIdent, true>(SrcIdent{ed + (size_t)e * ED * D}, D, ED, ws + WS_WD + (size_t)e * D * ED, scr, r - I_GU, D / 32, X.lane, 32.f);
          } else {
              if (r < I_GU) conv_item<SrcGU, true>(SrcGU{a.sh_gate + (size_t)l * D * ED, (long)(a.sh_up - a.sh_gate)}, ED, D, ws + WS_WGUS, scr, r, 16, X.lane, 64.f);
              else conv_item<SrcIdent, true>(SrcIdent{a.sh_down + (size_t)l * ED * D}, D, ED, ws + WS_WDS, scr, r - I_GU, D / 32, X.lane, 32.f);
          }
      } }
}

DEV int moe_tables(const Args& a, const Ctx& X, const int l, LAS int* t_cnt, LAS int* t_rb0, LAS int* t_eofrb) {
    const int* cntg = (const int*)(a.ws + WS_CTL + CTL_CNT) + l * NE;
    if (X.wave == 0) {
        const int c = __hip_atomic_load(cntg + X.lane, __ATOMIC_RELAXED, __HIP_MEMORY_SCOPE_AGENT), nrb = (c + 255) >> 8;
        int incl = nrb;
#pragma unroll
        for (int o = 1; o < 64; o <<= 1) { const int v = __shfl_up(incl, o); if (X.lane >= o) incl += v; }
        const int excl = incl - nrb;
        t_cnt[X.lane] = c; t_rb0[X.lane] = excl; if (X.lane == 63) t_rb0[64] = incl;
        for (int j = 0; j < nrb; ++j) t_eofrb[excl + j] = X.lane;
        t_eofrb[SH_RB + X.lane] = NE;
    }
    __syncthreads();
    return t_rb0[64];
}

DEV void ph_moe_gu(const Args& a, const Ctx& X, const int l) {
    LAS int* t_cnt = (LAS int*)(X.lds + AUX_OFF + 1024); LAS int* t_rb0 = t_cnt + 64; LAS int* t_eofrb = t_rb0 + 80; LAS int* toks = t_eofrb + NRB_ALL;
    const int nrbt = moe_tables(a, X, l, t_cnt, t_rb0, t_eofrb);
    const int* ltok = (const int*)(a.ws + WS_LTOK);
    pg8::Unit u;
    for (int i = 0; i < 8; ++i) { if (!pg8::moe_unit(i, 2, nrbt, X.G, X.bid, u)) break;
        if (X.tid < 256) { const int e = t_eofrb[u.pm]; int tok;
            if (e < NE) { const int sl = (u.pm - t_rb0[e]) * 256 + X.tid; tok = sl < t_cnt[e] ? ltok[e * CAP + sl] : 0; } else tok = (u.pm - SH_RB) * 256 + X.tid;
            toks[i * 256 + X.tid] = tok; } }
    VM_WAIT(); __syncthreads();
    pg8::SchedGU S{(const char*)(a.ws + WS_H), (const char*)(a.ws + WS_WGU), (const char*)(a.ws + WS_WGUS), t_eofrb, toks, nrbt, X.G, X.bid, 0};
    pg8::EpiGU E{a.ws + WS_HID};
    pg8::gemm_phase<pg8::EpiGU, pg8::SchedGU, true>(X.lds, D, S, E);
}
DEV void ph_moe_down(const Args& a, const Ctx& X, const int l) {
    LAS int* t_cnt = (LAS int*)(X.lds + AUX_OFF + 1024); LAS int* t_rb0 = t_cnt + 64; LAS int* t_eofrb = t_rb0 + 80;
    const int nrbt = moe_tables(a, X, l, t_cnt, t_rb0, t_eofrb);
    pg8::SchedDown S{(const char*)(a.ws + WS_HID), (const char*)(a.ws + WS_WD), (const char*)(a.ws + WS_WDS), t_eofrb, nrbt, X.G, X.bid, 0};
    pg8::EpiFp8 E{(unsigned char*)(a.ws + WS_Y), D, 0};
    int kd = ED; asm volatile("" : "+s"(kd));
    pg8::gemm_phase<pg8::EpiFp8, pg8::SchedDown, true>(X.lds, kd, S, E);
}
DEV void ph_combine(const Args& a, const Ctx& X, const int l) {
    LAS int* t_cnt = (LAS int*)(X.lds + AUX_OFF + 1024); LAS int* t_rb0 = t_cnt + 64; LAS int* t_eofrb = t_rb0 + 80;
    (void)moe_tables(a, X, l, t_cnt, t_rb0, t_eofrb);
    const float* mod = (const float*)(a.ws + WS_MOD);
    const int* idx = (const int*)(a.ws + WS_IDX); const float* gw = (const float*)(a.ws + WS_GW); const int* aslot = (const int*)(a.ws + WS_ASLOT);
    const unsigned char* y = a.ws + WS_Y; unsigned char* h8 = a.ws + WS_H;
    const int lane = X.lane;
    const int tstep = X.G * NWAVES;
    int t = X.bid * NWAVES + X.wave;
    int e_n = 0, s_n = 0; float g_n = 0.f;
    if (t < T && lane < 8) { e_n = idx[t * 8 + lane]; g_n = gw[t * 8 + lane]; s_n = aslot[t * 8 + lane]; }
    for (; t < T; t += tstep) {
        const int b = t / SEQ; const float* ml = mod + (size_t)(l * NB + b) * 6 * D;
        const int e_c = e_n, s_c = s_n; const float g_c = g_n;
        const int tn = t + tstep;
        if (tn < T && lane < 8) { e_n = idx[tn * 8 + lane]; g_n = gw[tn * 8 + lane]; s_n = aslot[tn * 8 + lane]; }
        u32x2 w0[9], w1[9];
        { const unsigned char* yr = y + ((size_t)SH_RB * 256 + t) * D; w0[8] = *(const u32x2*)(yr + 8 * lane); w1[8] = *(const u32x2*)(yr + 512 + 8 * lane); }
        float gk[8];
#pragma unroll
        for (int k = 0; k < 8; ++k) { const int e = rli(e_c, k), sl = rli(s_c, k); gk[k] = rlf(g_c, k);
            const unsigned char* yr = y + ((size_t)t_rb0[e] * 256 + sl) * D; w0[k] = *(const u32x2*)(yr + 8 * lane); w1[k] = *(const u32x2*)(yr + 512 + 8 * lane); }
        float xv[16]; load_row8_bf((const bf16_t*)(a.ws + WS_XB) + (size_t)t * D, lane, xv);
        float yv[16];
#pragma unroll
        for (int i = 0; i < 16; ++i) yv[i] = 0.f;
        acc_row8(yv, w0[8], w1[8], 0.125f);
#pragma unroll
        for (int k = 0; k < 8; ++k) acc_row8(yv, w0[k], w1[k], gk[k] * 0.125f);
        resid_update8(xv, yv, a.ffn_post_g + l * D, ml + 5 * D, lane);
        if (l == 0) store_row8_bf((bf16_t*)(a.ws + WS_XB) + (size_t)t * D, lane, xv); else store_row8(a.out + (size_t)t * D, lane, xv);
        if (l == 0) { const float* mn = mod + (size_t)(1 * NB + b) * 6 * D; u32x2 o[2]; prenorm_pack8_f8(xv, a.mix_pre_g + D, mn + D, mn, lane, o);
            *(u32x2*)(h8 + (size_t)t * D + 8 * lane) = o[0]; *(u32x2*)(h8 + (size_t)t * D + 512 + 8 * lane) = o[1]; }
    }
}

constexpr int NPH = 18;
__global__ void __launch_bounds__(NTHR, 2) mega(Args a) {
    extern __shared__ __attribute__((aligned(16))) unsigned char lds_raw[];
    Ctx X; X.lds = (LAS unsigned char*)lds_raw; X.tid = threadIdx.x; X.lane = X.tid & 63; X.wave = __builtin_amdgcn_readfirstlane(X.tid >> 6); X.G = gridDim.x; X.bid = blockIdx.x;
    if (X.tid < 4) ((LAS unsigned*)(X.lds + BAR_OFF))[X.tid] = 0u;
    __syncthreads();
    XcdBarrier bar; bar.bar = (unsigned*)(a.ws + WS_CTL); bar.x = 0; bar.st = nullptr;
    if (!MK_PER_PHASE) bar = xcd_barrier_post((unsigned*)(a.ws + WS_CTL), (volatile LAS unsigned*)(X.lds + BAR_OFF));
    const int lo = a.ph_lo, hi = a.ph_hi;
#define TIDR() do { int l_; asm volatile("v_mbcnt_lo_u32_b32 %0, -1, 0\n\tv_mbcnt_hi_u32_b32 %0, -1, %0" : "=v"(l_)); X.lane = l_; X.tid = X.wave * 64 + l_; } while (0)
#define IN(k) (lo <= (k) && (k) < hi)
#define REP(k, ...) do { __VA_ARGS__; if constexpr (((PROBE_MASK >> (k)) & 1u) != 0u) { __syncthreads(); __VA_ARGS__; } } while (0)
#define SEAM(k) do { if (IN(k) && IN((k) + 1)) xcd_barrier(bar); else { VM_WAIT(); __syncthreads(); } } while (0)
    unsigned char* ws = a.ws;
    if (IN(0)) { TIDR(); REP(0, ph_setup(a, X)); SEAM(0); }
    if (IN(1)) { TIDR(); REP(1, ph_prenorm0(a, X)); SEAM(1); }
    if constexpr (((PROBE_MASK >> 24) & 1u) != 0u) { for (int i_ = 0; i_ < 16; ++i_) xcd_barrier(bar); }
    if (IN(2)) { TIDR();
        pg8::SchedDense8<0x79797979, 0x7F7F7F7F> S; S.so.init(T, NPROJ, X.G, X.bid); S.A = (const char*)(ws + WS_H); S.Bt = (const char*)(ws + WS_WIN); S.K = D; S.pad_ = 0;
        pg8::EpiProj E{(bf16_t*)(ws + WS_QKVPRE), (bf16_t*)(ws + WS_ZA), (bf16_t*)(ws + WS_XBCPRE), (bf16_t*)(ws + WS_ZB), (float*)(ws + WS_SMALL)};
        REP(2, pg8::gemm_phase<pg8::EpiProj, pg8::SchedDense8<0x79797979, 0x7F7F7F7F>, true>(X.lds, D, S, E)); SEAM(2); }
    if (IN(3)) { TIDR(); REP(3, ph_gdn_local(a, X)); SEAM(3); }
    if (IN(4)) { TIDR();
        if (X.bid < 32) { REP(4, ph_gdn_scan(a, X)); }
        else {
            const int w = X.bid - 32, nw = X.G - 32; unsigned* gctr = (unsigned*)(ws + WS_CTL + CTL_GRP);
            constexpr int CONV_P1 = PROBE_CONVP1;
            REP(20, ph_ssd_local(a, X, 32)); __syncthreads();
            if (w >= 32) { REP(22, ph_moe_conv<2>(a, X, 0, w - 32, nw - 32, 0, CONV_P1)); }
            group_barrier(gctr, (unsigned)nw); __syncthreads();
            ph_ssd_scan(a, X, 32);
            group_barrier(gctr, 2u * (unsigned)nw); __syncthreads();
            REP(5, ph_ssd_out(a, X, 32, nw - 32)); __syncthreads();
            if (w < 32 || w >= 64) { const int wi = w < 32 ? w : w - 32; ph_moe_conv<2>(a, X, 0, wi, nw - 32, CONV_P1, -1); __syncthreads(); REP(23, ph_setup_late(a, X, wi, nw - 32)); }
        }
        SEAM(4); }
    if (IN(6)) { TIDR();
        pg8::SchedDense S; S.so.init(T, D, X.G, X.bid); S.A = (const char*)(ws + WS_OY); S.Bt = (const char*)(ws + WS_WOUT); S.K = 2048; S.pad_ = 0;
        pg8::EpiBf16 E{(bf16_t*)(ws + WS_YMIX), D, 0};
        REP(6, pg8::gemm_phase<pg8::EpiBf16, pg8::SchedDense>(X.lds, 2048, S, E)); SEAM(6); }
    if (IN(7)) { TIDR(); ph_router(a, X, 0); SEAM(7); }
    if (IN(8)) { TIDR(); REP(8, ph_moe_gu(a, X, 0)); SEAM(8); }
    if (IN(9)) { TIDR(); REP(9, ph_moe_down(a, X, 0)); SEAM(9); }
    if (IN(10)) { TIDR(); ph_combine(a, X, 0); SEAM(10); }
    if (IN(11)) { TIDR();
        pg8::SchedDense8<0x79797979, 0x7F7F7F7F> S; S.so.init(T, 3072, X.G, X.bid); S.A = (const char*)(ws + WS_H); S.Bt = (const char*)(ws + WS_WQKV); S.K = D; S.pad_ = 0;
        pg8::EpiQKV E{(bf16_t*)(ws + WS_Q1KV), (const float*)(ws + WS_COS), (const float*)(ws + WS_SIN)};
        REP(11, pg8::gemm_phase<pg8::EpiQKV, pg8::SchedDense8<0x79797979, 0x7F7F7F7F>, true>(X.lds, D, S, E)); SEAM(11); }
    if (IN(12)) { TIDR(); REP(12, ph_attn(a, X)); SEAM(12); }
    if (IN(13)) { TIDR();
        pg8::SchedDense8<0x79797979, 0x7D7D7D7D> S; S.so.init(T, D, X.G, X.bid); S.A = (const char*)(ws + WS_O1); S.Bt = (const char*)(ws + WS_WO); S.K = D; S.pad_ = 0;
        pg8::EpiBf16 E{(bf16_t*)(ws + WS_YMIX), D, 0};
        REP(13, pg8::gemm_phase<pg8::EpiBf16, pg8::SchedDense8<0x79797979, 0x7D7D7D7D>, true>(X.lds, D, S, E)); SEAM(13); }
    if (IN(14)) { TIDR(); ph_router(a, X, 1); REP(14, ph_moe_conv<8>(a, X, 1, X.bid, X.G, 0, -1)); SEAM(14); }
    if (IN(15)) { TIDR(); ph_moe_gu(a, X, 1); SEAM(15); }
    if (IN(16)) { TIDR(); ph_moe_down(a, X, 1); SEAM(16); }
    if (IN(17)) { TIDR(); REP(17, ph_combine(a, X, 1)); }
#undef IN
#undef SEAM
}

extern "C" void kernel_launch(void* const* d_in, const int* in_sizes, int n_in, void* d_out, int out_size, void* d_ws, size_t ws_size, hipStream_t stream) {
    static int grid = 0;
    if (!grid) {
        int dev = 0, cus = 0, per_cu = 0;
        if (hipGetDevice(&dev) != hipSuccess || hipDeviceGetAttribute(&cus, hipDeviceAttributeMultiprocessorCount, dev) != hipSuccess) { fprintf(stderr, "kernel_launch: device query failed\n"); grid = -1; return; }
        if (hipFuncSetAttribute((const void*)mega, hipFuncAttributeMaxDynamicSharedMemorySize, LDS_BYTES) != hipSuccess) { fprintf(stderr, "kernel_launch: hipFuncSetAttribute failed\n"); grid = -1; return; }
        if (hipOccupancyMaxActiveBlocksPerMultiprocessor(&per_cu, (const void*)mega, NTHR, LDS_BYTES) != hipSuccess || per_cu < 1) { fprintf(stderr, "kernel_launch: occupancy query says %d blocks per CU\n", per_cu); grid = -1; return; }
        grid = cus;
        if (grid < 64 || (grid & 7)) { fprintf(stderr, "kernel_launch: unsupported CU count %d\n", cus); grid = -1; return; }
    }
    if (grid < 0) return;
    if (ws_size < WS_END || n_in != 31) { fprintf(stderr, "kernel_launch: workspace %zu < %zu or n_in %d != 31\n", ws_size, (size_t)WS_END, n_in); return; }
    if (hipMemsetAsync((char*)d_ws + WS_CTL, 0, CTL_BYTES, stream) != hipSuccess) { fprintf(stderr, "kernel_launch: memset failed\n"); return; }
    Args a{};
    a.x = (const float*)d_in[0]; a.c = (const float*)d_in[1]; a.pos = (const int*)d_in[2]; a.mod_w = (const float*)d_in[3]; a.mod_b = (const float*)d_in[4];
    a.mix_pre_g = (const float*)d_in[5]; a.mix_post_g = (const float*)d_in[6]; a.ffn_pre_g = (const float*)d_in[7]; a.ffn_post_g = (const float*)d_in[8];
    a.ssm_w_in = (const float*)d_in[9]; a.gdn_conv_w = (const float*)d_in[10]; a.gdn_a_log = (const float*)d_in[11]; a.gdn_dt_bias = (const float*)d_in[12]; a.gdn_norm_w = (const float*)d_in[13];
    a.ssd_conv_w = (const float*)d_in[14]; a.ssd_conv_b = (const float*)d_in[15]; a.ssd_a_log = (const float*)d_in[16]; a.ssd_dt_bias = (const float*)d_in[17]; a.ssd_d = (const float*)d_in[18]; a.ssd_norm_w = (const float*)d_in[19];
    a.ssm_w_out = (const float*)d_in[20]; a.attn_w_qkv = (const float*)d_in[21]; a.attn_w_o = (const float*)d_in[22];
    a.router_w = (const float*)d_in[23]; a.router_bias = (const float*)d_in[24]; a.exp_gate = (const float*)d_in[25]; a.exp_up = (const float*)d_in[26]; a.exp_down = (const float*)d_in[27];
    a.sh_gate = (const float*)d_in[28]; a.sh_up = (const float*)d_in[29]; a.sh_down = (const float*)d_in[30];
    a.out = (float*)d_out; a.ws = (unsigned char*)d_ws;
#if MK_PER_PHASE
    for (int p = 0; p < NPH; ++p) { a.ph_lo = p; a.ph_hi = p + 1; hipLaunchKernelGGL(mega, dim3(grid), dim3(NTHR), LDS_BYTES, stream, a); }
#else
    a.ph_lo = 0; a.ph_hi = NPH;
    hipLaunchKernelGGL(mega, dim3(grid), dim3(NTHR), LDS_BYTES, stream, a);
#endif
}
```

```cpp
#include <hip/hip_runtime.h>
#include <stdint.h>
#include <stdio.h>

#define DEV __device__ __forceinline__
#define LAS __attribute__((address_space(3)))
typedef unsigned short bf16_t;
typedef short bf16x8 __attribute__((ext_vector_type(8)));
typedef float f32x4 __attribute__((ext_vector_type(4)));
typedef float f32x2 __attribute__((ext_vector_type(2)));
typedef unsigned u32x4 __attribute__((ext_vector_type(4)));
typedef unsigned u32x2 __attribute__((ext_vector_type(2)));
typedef float f32x16 __attribute__((ext_vector_type(16)));
typedef short s16x4 __attribute__((ext_vector_type(4)));

#ifndef PROBE_MASK
#define PROBE_MASK 0u
#endif
#ifndef PROBE_CONVP1
#define PROBE_CONVP1 15360
#endif
#ifndef MK_PER_PHASE
#define MK_PER_PHASE 0
#endif

constexpr int NB = 4, SEQ = 4096, T = NB * SEQ, D = 1024;
constexpr int PROJ = 6688, NPROJ = 6912;
constexpr int C_BETA = 4096, C_XBC = 4112, C_ZB = 5648, C_DT = 6672;
constexpr int NE = 64, TOPK = 8, ED = 256, CAP = 16384;
constexpr int SH_RB = 576;
constexpr int NRB_ALL = SH_RB + 64;
constexpr float EPS = 1e-6f;
constexpr int NTHR = 512, NWAVES = 8;
constexpr int LDS_BYTES = 163840;
constexpr int AUX_OFF = 131072;
constexpr int BAR_OFF = LDS_BYTES - 16;

constexpr size_t MiB = 1u << 20;
constexpr size_t WS_CTL = 0, CTL_BYTES = 65536;
constexpr size_t CTL_CNT = 16384;
constexpr size_t CTL_GRP = 20480;
constexpr size_t WS_MOD = 65536;
constexpr size_t WS_COS = 1 * MiB, WS_SIN = 3 * MiB;
constexpr size_t WS_IDX = 5 * MiB, WS_GW = 5 * MiB + 512 * 1024, WS_ASLOT = 6 * MiB, WS_LTOK = 6 * MiB + 512 * 1024;
constexpr size_t WS_SMALL = 11 * MiB;
constexpr size_t WS_WIN = 16 * MiB, WS_WOUT = 30 * MiB, WS_WQKV = 34 * MiB, WS_WO = 40 * MiB;
constexpr size_t WS_H = 44 * MiB;
constexpr size_t WS_QKVPRE = 78 * MiB, WS_XBCPRE = 174 * MiB, WS_ZA = 222 * MiB, WS_ZB = 254 * MiB;
constexpr size_t WS_CC = 16 * MiB, WS_ACUM = 25 * MiB, WS_CDEC = 26 * MiB, WS_YDIAG = 44 * MiB, WS_STATES = 430 * MiB;
constexpr size_t WS_GI = 286 * MiB, GI_UNIT = 73728, WS_GTMP = 462 * MiB, WS_GLAST = 27 * MiB;
constexpr size_t WS_OY = 78 * MiB, WS_YMIX = 286 * MiB, WS_XB = 240 * MiB;
constexpr size_t WS_WD = 478 * MiB, WS_WDS = 510 * MiB + 512 * 1024, WS_HID = 398 * MiB, WS_Y = 78 * MiB, WS_WGU = 142 * MiB, WS_WGUS = 207 * MiB;
constexpr size_t WS_Q1KV = 78 * MiB, WS_O1 = 174 * MiB, WS_PO = 350 * MiB, WS_PLSE = 446 * MiB;
constexpr size_t WS_END = 512 * MiB;

struct Args {
    const float* x; const float* c; const int* pos; const float* mod_w; const float* mod_b;
    const float* mix_pre_g; const float* mix_post_g; const float* ffn_pre_g; const float* ffn_post_g;
    const float* ssm_w_in; const float* gdn_conv_w; const float* gdn_a_log; const float* gdn_dt_bias; const float* gdn_norm_w;
    const float* ssd_conv_w; const float* ssd_conv_b; const float* ssd_a_log; const float* ssd_dt_bias; const float* ssd_d; const float* ssd_norm_w;
    const float* ssm_w_out; const float* attn_w_qkv; const float* attn_w_o;
    const float* router_w; const float* router_bias; const float* exp_gate; const float* exp_up; const float* exp_down;
    const float* sh_gate; const float* sh_up; const float* sh_down;
    float* out; unsigned char* ws; int ph_lo, ph_hi;
};

DEV float bf2f(bf16_t v) { return __uint_as_float(((unsigned)v) << 16); }
typedef __bf16 bf16x2_hw __attribute__((ext_vector_type(2)));
DEV unsigned pk2(float lo, float hi) { const bf16x2_hw v = {(__bf16)lo, (__bf16)hi}; return __builtin_bit_cast(unsigned, v); }
DEV unsigned f2bf(float f) { return pk2(f, 0.f) & 0xFFFFu; }
template <int CTRL> DEV float dppf(float v) { return __builtin_bit_cast(float, __builtin_amdgcn_update_dpp(0, __builtin_bit_cast(int, v), CTRL, 0xF, 0xF, true)); }
template <int CTRL> DEV int dppi(int v) { return __builtin_amdgcn_update_dpp(0, v, CTRL, 0xF, 0xF, true); }
DEV float rlf(float v, int l) { return __builtin_bit_cast(float, __builtin_amdgcn_readlane(__builtin_bit_cast(int, v), l)); }
DEV int rli(int v, int l) { return __builtin_amdgcn_readlane(v, l); }
DEV float sum8(float v) { v += dppf<0xB1>(v); v += dppf<0x4E>(v); v += dppf<0x141>(v); return v; }
DEV float max8(float v) { v = fmaxf(v, dppf<0xB1>(v)); v = fmaxf(v, dppf<0x4E>(v)); v = fmaxf(v, dppf<0x141>(v)); return v; }
DEV int min8(int v) { v = min(v, dppi<0xB1>(v)); v = min(v, dppi<0x4E>(v)); v = min(v, dppi<0x141>(v)); return v; }
DEV float xor16_sum(float v) { const auto r = __builtin_amdgcn_permlane16_swap(__builtin_bit_cast(unsigned, v), __builtin_bit_cast(unsigned, v), false, false); return __builtin_bit_cast(float, r[0]) + __builtin_bit_cast(float, r[1]); }
DEV float xor32_sum(float v) { const auto r = __builtin_amdgcn_permlane32_swap(__builtin_bit_cast(unsigned, v), __builtin_bit_cast(unsigned, v), false, false); return __builtin_bit_cast(float, r[0]) + __builtin_bit_cast(float, r[1]); }
DEV float xor32_max(float v) { const auto r = __builtin_amdgcn_permlane32_swap(__builtin_bit_cast(unsigned, v), __builtin_bit_cast(unsigned, v), false, false); return fmaxf(__builtin_bit_cast(float, r[0]), __builtin_bit_cast(float, r[1])); }
DEV float wave_sum(float v) {
    v = sum8(v); v += dppf<0x140>(v);
    return (rlf(v, 0) + rlf(v, 16)) + (rlf(v, 32) + rlf(v, 48));
}
DEV float siluf(float x) { return x * __builtin_amdgcn_rcpf(1.f + __expf(-x)); }
DEV float sigmoidf_(float x) { return __builtin_amdgcn_rcpf(1.f + __expf(-x)); }
DEV float softplusf(float x) { return fmaxf(x, 0.f) + log1pf(__expf(-fabsf(x))); }
#define LDS_WAIT() asm volatile("s_waitcnt lgkmcnt(0)" ::: "memory")
#define VM_WAIT() asm volatile("s_waitcnt vmcnt(0)" ::: "memory")

#define XB_TMO      128
#define XB_XCNT(j)  (256  + 64 * (j))
#define XB_XSUB(j)  (1280 + 64 * (j))
#define XB_XGEN(j)  (2304 + 64 * (j))
#define XB_TOP      3328
#define XB_TOPGEN   3392
#define XCD_BAR_WORDS 3456
#define XB_SPIN_CAP (1u << 18)
#define LAS __attribute__((address_space(3)))

__device__ __forceinline__ unsigned xb_ld(unsigned* p)              { return __hip_atomic_load(p, __ATOMIC_RELAXED, __HIP_MEMORY_SCOPE_AGENT); }
__device__ __forceinline__ unsigned xb_add(unsigned* p, unsigned v) { return __hip_atomic_fetch_add(p, v, __ATOMIC_RELAXED, __HIP_MEMORY_SCOPE_AGENT); }
__device__ __forceinline__ unsigned xb_xcc_id() { return (unsigned)__builtin_amdgcn_s_getreg((3 << 11) | 20) & 0xFu; }
#define XB_SPIN(cond, bar) do { unsigned _sp = 0; while (cond) { __builtin_amdgcn_s_sleep(1); \
    if ((++_sp & 255u) == 0u) { if (xb_ld(&(bar)[XB_TMO])) break; if (_sp > XB_SPIN_CAP) { atomicAdd(&(bar)[XB_TMO], 1u); break; } } } } while (0)

struct XcdBarrier {
    unsigned* bar; unsigned x;
    volatile LAS unsigned* st;
};

__device__ __forceinline__ XcdBarrier xcd_barrier_post(unsigned* bar, volatile LAS unsigned* st) {
    XcdBarrier b; b.bar = bar; b.x = xb_xcc_id(); b.st = st;
    if (threadIdx.x == 0) (void)xb_add(&bar[XB_XCNT(b.x)], 1u);
    return b;
}
__device__ __forceinline__ void xcd_barrier_complete(unsigned* bar, unsigned x, unsigned& nloc, unsigned& nx) {
    const unsigned G = gridDim.x * gridDim.y * gridDim.z;
    unsigned sum, cnt, mine, sp = 0u;
    for (;;) {
        sum = 0u; cnt = 0u; mine = 0u;
#pragma unroll
        for (unsigned j = 0; j < 16; ++j) { const unsigned c = xb_ld(&bar[XB_XCNT(j)]); sum += c; cnt += (c > 0u) ? 1u : 0u; mine = (j == x) ? c : mine; }
        if (sum == G) break;
        __builtin_amdgcn_s_sleep(1);
        if ((++sp & 255u) == 0u) { if (xb_ld(&bar[XB_TMO])) break; if (sp > XB_SPIN_CAP) { atomicAdd(&bar[XB_TMO], 1u); break; } }
    }
    nloc = mine > 0u ? mine : 1u; nx = cnt > 0u ? cnt : 1u;
}

__device__ __forceinline__ void xcd_barrier(const XcdBarrier& b) {
    asm volatile("s_waitcnt vmcnt(0)" ::: "memory");
    __syncthreads();
    if (threadIdx.x == 0) {
        unsigned* bar = b.bar;
        __builtin_amdgcn_s_waitcnt(0);
        unsigned nloc = b.st[0], nx = b.st[1];
        if (nloc == 0u) { xcd_barrier_complete(bar, b.x, nloc, nx); b.st[0] = nloc; b.st[1] = nx; }
        const unsigned old = xb_add(&bar[XB_XSUB(b.x)], 1u);
        const unsigned gen = old / nloc;
        if (old + 1u == (gen + 1u) * nloc) {
            __builtin_amdgcn_fence(__ATOMIC_RELEASE, "agent");
            asm volatile("s_waitcnt vmcnt(0)" ::: "memory");
            const unsigned og = xb_add(&bar[XB_TOP], 1u);
            const unsigned tg = og / nx;
            if (og + 1u == (tg + 1u) * nx) xb_add(&bar[XB_TOPGEN], 1u);
            else XB_SPIN(xb_ld(&bar[XB_TOPGEN]) == tg, bar);
            __builtin_amdgcn_fence(__ATOMIC_ACQUIRE, "agent");
            xb_add(&bar[XB_XGEN(b.x)], 1u);
            asm volatile("s_waitcnt vmcnt(0)" ::: "memory");
        } else {
            XB_SPIN(xb_ld(&bar[XB_XGEN(b.x)]) == gen, bar);
            __builtin_amdgcn_fence(__ATOMIC_ACQUIRE, "agent");
            asm volatile("s_waitcnt vmcnt(0)" ::: "memory");
        }
    }
    __syncthreads();
}


DEV void group_barrier(unsigned* ctr, const unsigned n) {
    asm volatile("s_waitcnt vmcnt(0)" ::: "memory");
    __syncthreads();
    if (threadIdx.x == 0) {
        __builtin_amdgcn_fence(__ATOMIC_RELEASE, "agent");
        asm volatile("s_waitcnt vmcnt(0)" ::: "memory");
        (void)__hip_atomic_fetch_add(ctr, 1u, __ATOMIC_RELAXED, __HIP_MEMORY_SCOPE_AGENT);
        unsigned sp = 0;
        while (__hip_atomic_load(ctr, __ATOMIC_RELAXED, __HIP_MEMORY_SCOPE_AGENT) < n) { __builtin_amdgcn_s_sleep(2); if (++sp > (1u << 22)) break; }
        __builtin_amdgcn_fence(__ATOMIC_ACQUIRE, "agent");
        asm volatile("s_waitcnt vmcnt(0)" ::: "memory");
    }
    __syncthreads();
}

namespace pg8 {
constexpr int BM = 256, BK = 64, HALF = 128, HTB = HALF * BK * 2, STAGE_BYTES = 8 * HTB, NXCD = 8, WGM = 8;
DEV int lds_byte(int r, int c) { const int st = (r >> 4) * 2 + (c >> 5), rr = r & 15, cc = c & 31, ob = rr * 64 + cc * 2; return st * 1024 + (ob ^ (((ob >> 9) & 1) << 5)); }
DEV void stage_rc(int b, int& R, int& C) { const int st = b / 1024, sb = b % 1024, swz = sb ^ (((sb >> 9) & 1) << 5); R = (st >> 1) * 16 + swz / 64; C = (st & 1) * 32 + (swz % 64) / 2; }
DEV int perm32(int rho) { const int n = rho >> 4, i = rho & 15; return 8 * (i >> 2) + 4 * n + (i & 3); }
struct Unit { int pm, pn, e, slot; };
struct StaticOrder {
    int nM, nN, nwg, G, c;
    DEV void init(int M, int N, int G_, int c_) { nM = M / BM; nN = N / BM; nwg = nM * nN; G = G_; c = c_; }
    DEV bool next(int i, int& pm, int& pn) const {
        const long L = (long)i * G + c; if (L >= nwg) return false;
        int wgid = (int)L; { const int q = nwg / NXCD, r = nwg % NXCD, xcd = wgid % NXCD, off = wgid / NXCD; wgid = (xcd < r ? xcd * (q + 1) : r * (q + 1) + (xcd - r) * q) + off; }
        const int nig = WGM * nN, gid = wgid / nig, fm = gid * WGM, gsz = (nM - fm) < WGM ? (nM - fm) : WGM;
        pm = fm + ((wgid % nig) % gsz); pn = (wgid % nig) / gsz; return true;
    }
};
typedef __bf16 bf16x2_t __attribute__((ext_vector_type(2)));
DEV unsigned cvt_pk_bf16(float lo, float hi) { const bf16x2_t v = {(__bf16)lo, (__bf16)hi}; return __builtin_bit_cast(unsigned, v); }
DEV u32x4 pack8(const f32x4 a, const f32x4 b) { u32x4 w; w.x = cvt_pk_bf16(a[0], a[1]); w.y = cvt_pk_bf16(a[2], a[3]); w.z = cvt_pk_bf16(b[0], b[1]); w.w = cvt_pk_bf16(b[2], b[3]); return w; }

typedef int v8i_t __attribute__((ext_vector_type(8)));
template <class Epi, class Sched, bool F8 = false>
DEV void gemm_phase(LAS unsigned char* lds, const int K, const Sched& S, const Epi& E) {
    const int tid = threadIdx.x, wid = __builtin_amdgcn_readfirstlane(tid >> 6), lane = tid & 63, wr = wid >> 2, wc = wid & 3, fr = lane & 15, fq = lane >> 4;
    const int nt = F8 ? K / 128 : K / BK;
    const int pitch = F8 ? K : 2 * K;
    unsigned voffB[2];
#pragma unroll
    for (int i = 0; i < 2; ++i) { int R, C; stage_rc(tid * 16 + i * 8192, R, C); const int Rb = Epi::PERM ? ((R & ~31) + perm32(R & 31)) : R; voffB[i] = (unsigned)(Rb * pitch + 2 * C); }
    const unsigned kstep = (unsigned)(BK * 2);
    const size_t hstep = (size_t)HALF * pitch;
    const unsigned ldsw = (unsigned)wid * 1024u;
    const int aoff = lds_byte(wr * 64 + fr, fq * 8), boff = lds_byte(wc * 32 + fr, fq * 8);
    const size_t hsA = Sched::GATHER ? (size_t)0 : hstep;
#define PG8_SA(b, h) (((b) * 2 + (h)) * HTB)
#define PG8_SB(b, h) ((4 + (b) * 2 + (h)) * HTB)
#define PG8_STAGEB(bufoff, gbase) do { _Pragma("unroll") for (int _i = 0; _i < 2; ++_i) \
        __builtin_amdgcn_global_load_lds((const unsigned*)((const char*)(gbase) + voffB[_i]), (LAS unsigned*)(lds + (bufoff) + ldsw + _i * 8192), 16, 0, 0); } while (0)
#define PG8_STAGEA(bufoff, gbase, VO) do { _Pragma("unroll") for (int _i = 0; _i < 2; ++_i) \
        __builtin_amdgcn_global_load_lds((const unsigned*)((const char*)(gbase) + (VO)[_i]), (LAS unsigned*)(lds + (bufoff) + ldsw + _i * 8192), 16, 0, 0); } while (0)
#define PG8_LD8(var, base) do { const u32x4 _l0 = *(const LAS u32x4*)(lds + (base)), _l1 = *(const LAS u32x4*)(lds + (base) + 1024); var = __builtin_shufflevector(_l0, _l1, 0, 1, 2, 3, 4, 5, 6, 7); } while (0)
#define PG8_LDA(dst, b, h) do { if constexpr (F8) { PG8_LD8(dst##8_0, PG8_SA(b, h) + aoff); PG8_LD8(dst##8_1, PG8_SA(b, h) + aoff + 2048); PG8_LD8(dst##8_2, PG8_SA(b, h) + aoff + 4096); PG8_LD8(dst##8_3, PG8_SA(b, h) + aoff + 6144); } \
        else { _Pragma("unroll") for (int m = 0; m < 4; ++m) _Pragma("unroll") for (int k = 0; k < 2; ++k) dst[m][k] = *(const LAS bf16x8*)(lds + PG8_SA(b, h) + aoff + m * 2048 + k * 1024); } } while (0)
#define PG8_LDB(dst, b, h) do { if constexpr (F8) { PG8_LD8(dst##8_0, PG8_SB(b, h) + boff); PG8_LD8(dst##8_1, PG8_SB(b, h) + boff + 2048); } \
        else { _Pragma("unroll") for (int n = 0; n < 2; ++n) _Pragma("unroll") for (int k = 0; k < 2; ++k) dst[n][k] = *(const LAS bf16x8*)(lds + PG8_SB(b, h) + boff + n * 2048 + k * 1024); } } while (0)
#define PG8_M8(ai, bj, m, n, A8, B8) asm volatile("v_mfma_scale_f32_16x16x128_f8f6f4 %0, %1, %2, %0, %3, %4 op_sel_hi:[0,0,0]" : "+v"(acc[ai][bj][m][n]) : "v"(B8), "v"(A8), "v"(wsc_), "v"(asc_))
#define PG8_M8Z(ai, bj, m, n, A8, B8) asm volatile("v_mfma_scale_f32_16x16x128_f8f6f4 %0, %1, %2, %0, %3, %4 op_sel_hi:[0,0,0]" : "+v"(acc[ai][bj][m][n]) : "v"(B8), "v"(A8), "v"(zsc_), "v"(zsc_))
#define PG8_MMA(ai, bj, At, Bt) do { __builtin_amdgcn_s_setprio(1); \
        if constexpr (F8) { PG8_M8(ai, bj, 0, 0, At##8_0, Bt##8_0); PG8_M8(ai, bj, 0, 1, At##8_0, Bt##8_1); PG8_M8(ai, bj, 1, 0, At##8_1, Bt##8_0); PG8_M8(ai, bj, 1, 1, At##8_1, Bt##8_1); \
                            PG8_M8(ai, bj, 2, 0, At##8_2, Bt##8_0); PG8_M8(ai, bj, 2, 1, At##8_2, Bt##8_1); PG8_M8(ai, bj, 3, 0, At##8_3, Bt##8_0); PG8_M8(ai, bj, 3, 1, At##8_3, Bt##8_1); \
            if constexpr (((PROBE_MASK >> 26) & 1u) != 0u) { PG8_M8Z(ai, bj, 0, 0, At##8_0, Bt##8_0); PG8_M8Z(ai, bj, 0, 1, At##8_0, Bt##8_1); PG8_M8Z(ai, bj, 1, 0, At##8_1, Bt##8_0); PG8_M8Z(ai, bj, 1, 1, At##8_1, Bt##8_1); \
                            PG8_M8Z(ai, bj, 2, 0, At##8_2, Bt##8_0); PG8_M8Z(ai, bj, 2, 1, At##8_2, Bt##8_1); PG8_M8Z(ai, bj, 3, 0, At##8_3, Bt##8_0); PG8_M8Z(ai, bj, 3, 1, At##8_3, Bt##8_1); } } \
        else { _Pragma("unroll") for (int m = 0; m < 4; ++m) _Pragma("unroll") for (int n = 0; n < 2; ++n) _Pragma("unroll") for (int k = 0; k < 2; ++k) acc[ai][bj][m][n] = __builtin_amdgcn_mfma_f32_16x16x32_bf16(Bt[n][k], At[m][k], acc[ai][bj][m][n], 0, 0, 0); } \
        __builtin_amdgcn_s_setprio(0); } while (0)
#define PG8_WAIT_V(n) asm volatile("s_waitcnt vmcnt(" #n ")" ::: "memory")
#define PG8_WAIT_L(n) asm volatile("s_waitcnt lgkmcnt(" #n ")" ::: "memory")
#define PG8_BAR __builtin_amdgcn_s_barrier()
#define PG8_SCHED __builtin_amdgcn_sched_barrier(0)
    Unit cur, nxt; int ui = 0;
    if (!S.next(0, cur)) return;
    f32x4 acc[2][2][4][2];
#pragma unroll
    for (int a = 0; a < 2; ++a)
#pragma unroll
        for (int b = 0; b < 2; ++b)
#pragma unroll
            for (int m = 0; m < 4; ++m)
#pragma unroll
                for (int n = 0; n < 2; ++n) acc[a][b][m][n] = (f32x4){0.f, 0.f, 0.f, 0.f};
    bf16x8 At[4][2], B0[2][2], B1[2][2];
    typedef unsigned u32x8_t __attribute__((ext_vector_type(8)));
    u32x8_t At8_0, At8_1, At8_2, At8_3, B08_0, B08_1, B18_0, B18_1;
    int zsc_ = 0; asm volatile("" : "+v"(zsc_));
    const int wsc_ = Sched::WSCALE, asc_ = Sched::ASCALE;
    unsigned va[2][2];
    S.a_voff(cur, tid, va);
    const char* cA = S.a_ptr(cur);
    const char* cB = S.b_ptr(cur);
    PG8_STAGEB(PG8_SB(0, 0), cB); PG8_STAGEB(PG8_SB(0, 1), cB + hstep); PG8_STAGEA(PG8_SA(0, 0), cA, va[0]); PG8_STAGEA(PG8_SA(0, 1), cA + hsA, va[1]);
    if (wr == 1) PG8_BAR;
    PG8_WAIT_V(2); PG8_BAR;
    PG8_STAGEB(PG8_SB(1, 0), cB + kstep); PG8_STAGEA(PG8_SA(1, 0), cA + kstep, va[0]); PG8_STAGEB(PG8_SB(1, 1), cB + hstep + kstep);
    PG8_WAIT_V(6); PG8_BAR;
    for (;;) {
        const bool has_next = S.next(ui + 1, nxt);
        const char* nB = has_next ? S.b_ptr(nxt) : cB;
        const char* nA = has_next ? S.a_ptr(nxt) : cA;
        for (int t = 0; t < nt; t += 2) {
            const bool last = (t == nt - 2);
            const char* a1 = cA + (size_t)(t + 1) * kstep;
            const char* a2 = last ? nA : cA + (size_t)(t + 2) * kstep; const char* a3 = a2 + kstep;
            unsigned v2[2][2];
            v2[0][0] = va[0][0]; v2[0][1] = va[0][1]; v2[1][0] = va[1][0]; v2[1][1] = va[1][1];
            if constexpr (Sched::GATHER) { if (last && has_next) S.a_voff(nxt, tid, v2); }
            const char* b2 = last ? nB : cB + (size_t)(t + 2) * kstep; const char* b3 = b2 + kstep;
            PG8_LDB(B0, 0, 0); PG8_LDB(B1, 0, 1); PG8_SCHED; PG8_LDA(At, 0, 0); PG8_STAGEA(PG8_SA(1, 1), a1 + hsA, va[1]);
            PG8_WAIT_V(8); PG8_WAIT_L(0); PG8_BAR; PG8_MMA(0, 0, At, B0); PG8_MMA(0, 1, At, B1); PG8_BAR; PG8_SCHED;
            PG8_LDA(At, 0, 1); PG8_STAGEB(PG8_SB(0, 0), b2); PG8_STAGEB(PG8_SB(0, 1), b2 + hstep); PG8_STAGEA(PG8_SA(0, 0), a2, v2[0]);
            PG8_WAIT_V(8); PG8_WAIT_L(0); PG8_BAR; PG8_MMA(1, 0, At, B0); PG8_MMA(1, 1, At, B1); PG8_BAR; PG8_SCHED;
            PG8_LDB(B0, 1, 0); PG8_LDB(B1, 1, 1); PG8_SCHED; PG8_LDA(At, 1, 0); PG8_STAGEA(PG8_SA(0, 1), a2 + hsA, v2[1]);
            PG8_WAIT_V(8); PG8_WAIT_L(0); PG8_BAR; PG8_MMA(0, 0, At, B0); PG8_MMA(0, 1, At, B1); PG8_BAR; PG8_SCHED;
            PG8_LDA(At, 1, 1); PG8_STAGEB(PG8_SB(1, 0), b3); PG8_STAGEB(PG8_SB(1, 1), b3 + hstep); PG8_STAGEA(PG8_SA(1, 0), a3, v2[0]);
            PG8_WAIT_V(8); PG8_WAIT_L(0); PG8_BAR; PG8_MMA(1, 0, At, B0); PG8_MMA(1, 1, At, B1); PG8_BAR; PG8_SCHED;
        }
        if (wr == 0) PG8_BAR;
        if constexpr (F8) asm volatile("s_nop 15\n\ts_nop 15" ::: "memory");
        E(acc, cur, wr, wc, fr, fq);
        if constexpr (((PROBE_MASK >> 27) & 1u) != 0u) { asm volatile("" ::: "memory"); E(acc, cur, wr, wc, fr, fq); }
        if (!has_next) break;
#pragma unroll
        for (int a = 0; a < 2; ++a)
#pragma unroll
            for (int b = 0; b < 2; ++b)
#pragma unroll
                for (int m = 0; m < 4; ++m)
#pragma unroll
                    for (int n = 0; n < 2; ++n) acc[a][b][m][n] = (f32x4){0.f, 0.f, 0.f, 0.f};
        cur = nxt; cB = nB; cA = nA; ++ui;
        if constexpr (Sched::GATHER) S.a_voff(cur, tid, va);
        if (wr == 1) PG8_BAR;
    }
    PG8_WAIT_V(0);
    PG8_BAR;
#undef PG8_SA
#undef PG8_SB
#undef PG8_STAGEA
#undef PG8_STAGEB
#undef PG8_LDA
#undef PG8_LD8
#undef PG8_M8
#undef PG8_LDB
#undef PG8_MMA
#undef PG8_WAIT_V
#undef PG8_WAIT_L
#undef PG8_BAR
#undef PG8_SCHED
}

struct SchedDense {
    static constexpr bool GATHER = false; static constexpr int WSCALE = 0x7F7F7F7F, ASCALE = 0x7F7F7F7F;
    StaticOrder so; const char* A; const char* Bt; int K; int pad_;
    DEV bool next(int i, Unit& u) const { int pm, pn; if (!so.next(i, pm, pn)) return false; u.pm = pm; u.pn = pn; u.e = 0; u.slot = 0; return true; }
    DEV const char* a_ptr(const Unit& u) const { return A + (size_t)u.pm * 256 * K * 2; }
    DEV void a_voff(const Unit&, const int tid, unsigned (&vo)[2][2]) const {
#pragma unroll
        for (int i = 0; i < 2; ++i) { int R, C; stage_rc(tid * 16 + i * 8192, R, C); vo[0][i] = vo[1][i] = (unsigned)((R * K + C) * 2); }
    }
    DEV const char* b_ptr(const Unit& u) const { return Bt + (size_t)u.pn * 256 * K * 2; }
};
template <int WS_, int AS_> struct SchedDense8 {
    static constexpr bool GATHER = false; static constexpr int WSCALE = WS_, ASCALE = AS_;
    StaticOrder so; const char* A; const char* Bt; int K; int pad_;
    DEV bool next(int i, Unit& u) const { int pm, pn; if (!so.next(i, pm, pn)) return false; u.pm = pm; u.pn = pn; u.e = 0; u.slot = 0; return true; }
    DEV const char* a_ptr(const Unit& u) const { return A + (size_t)u.pm * 256 * K; }
    DEV void a_voff(const Unit&, const int tid, unsigned (&vo)[2][2]) const {
#pragma unroll
        for (int i = 0; i < 2; ++i) { int R, C; stage_rc(tid * 16 + i * 8192, R, C); vo[0][i] = vo[1][i] = (unsigned)(R * K + 2 * C); }
    }
    DEV const char* b_ptr(const Unit& u) const { return Bt + (size_t)u.pn * 256 * K; }
};
DEV bool moe_unit(int i, int NJ, int nrbt, int G, int c, Unit& u) {
    const int n = (nrbt + 64) * NJ; int L;
    if (G & 7) { L = i * G + c; if (L >= n) return false; }
    else { const int gq = G >> 3, per = (n + 7) >> 3, x = c & 7, q = c >> 3, j = i * gq + q; if (j >= per) return false; L = x * per + j; if (L >= n) return false; }
    int grb = L / NJ; const int pn = L - grb * NJ; if (grb >= nrbt) grb = SH_RB + (grb - nrbt);
    u.pm = grb; u.pn = pn; u.slot = i; u.e = 0; return true;
}
struct SchedGU {
    static constexpr bool GATHER = true; static constexpr int WSCALE = 0x79797979, ASCALE = 0x7F7F7F7F;
    const char* A; const char* Wgu; const char* Wgus; const LAS int* eofrb; const LAS int* toks; int nrbt, G, c, pad_;
    DEV bool next(int i, Unit& u) const { if (!moe_unit(i, 2, nrbt, G, c, u)) return false; u.e = __builtin_amdgcn_readfirstlane(eofrb[u.pm]); return true; }
    DEV const char* a_ptr(const Unit&) const { return A; }
    DEV void a_voff(const Unit& u, const int tid, unsigned (&vo)[2][2]) const {
#pragma unroll
        for (int i = 0; i < 2; ++i) { int R, C; stage_rc(tid * 16 + i * 8192, R, C);
#pragma unroll
            for (int h = 0; h < 2; ++h) { const int tok = toks[u.slot * 256 + h * 128 + R]; vo[h][i] = (unsigned)(tok * D + 2 * C); } }
    }
    DEV const char* b_ptr(const Unit& u) const { return (u.e < NE ? Wgu + (size_t)u.e * 512 * D : Wgus) + (size_t)u.pn * 256 * D; }
};
struct SchedDown {
    static constexpr bool GATHER = false; static constexpr int WSCALE = 0x7D7D7D7D, ASCALE = 0x7F7F7F7F;
    const char* A; const char* Wd; const char* Wds; const LAS int* eofrb; int nrbt, G, c, pad_;
    DEV bool next(int i, Unit& u) const { if (!moe_unit(i, 4, nrbt, G, c, u)) return false; u.e = __builtin_amdgcn_readfirstlane(eofrb[u.pm]); return true; }
    DEV const char* a_ptr(const Unit& u) const { return A + (size_t)u.pm * 256 * ED; }
    DEV void a_voff(const Unit&, const int tid, unsigned (&vo)[2][2]) const {
#pragma unroll
        for (int i = 0; i < 2; ++i) { int R, C; stage_rc(tid * 16 + i * 8192, R, C); vo[0][i] = vo[1][i] = (unsigned)(R * ED + 2 * C); }
    }
    DEV const char* b_ptr(const Unit& u) const { return (u.e < NE ? Wd + (size_t)u.e * D * ED : Wds) + (size_t)u.pn * 256 * ED; }
};

struct EpiProj {
    static constexpr bool PERM = true;
    bf16_t* qkv; bf16_t* za; bf16_t* xbc; bf16_t* zb; float* small;
    DEV void operator()(const f32x4 (&acc)[2][2][4][2], const Unit& u, int wr, int wc, int fr, int fq) const {
        const int row0 = u.pm * BM + wr * 64 + fr, pn = u.pn;
        if (pn == 26) {
            if (wc == 0) {
#pragma unroll
                for (int ai = 0; ai < 2; ++ai)
#pragma unroll
                    for (int m = 0; m < 4; ++m) { float* p = small + (size_t)(row0 + ai * HALF + m * 16) * 32 + 8 * fq; *(f32x4*)p = acc[ai][0][m][0]; *(f32x4*)(p + 4) = acc[ai][0][m][1]; }
            }
            return;
        }
        bf16_t* base; int ldc, ct;
        if (pn < 12) { base = qkv; ldc = 3072; ct = pn; } else if (pn < 16) { base = za; ldc = 1024; ct = pn - 12; } else if (pn < 22) { base = xbc; ldc = 1536; ct = pn - 16; } else { base = zb; ldc = 1024; ct = pn - 22; }
        const int col0 = ct * 256 + wc * 32 + 8 * fq;
#pragma unroll
        for (int ai = 0; ai < 2; ++ai)
#pragma unroll
            for (int m = 0; m < 4; ++m) { bf16_t* rowp = base + (size_t)(row0 + ai * HALF + m * 16) * ldc + col0;
#pragma unroll
                for (int bj = 0; bj < 2; ++bj) *(u32x4*)(rowp + bj * HALF) = pack8(acc[ai][bj][m][0], acc[ai][bj][m][1]); }
    }
};
struct EpiF32 {
    static constexpr bool PERM = false;
    float* Cp; int ldc; int pad_;
    DEV void operator()(const f32x4 (&acc)[2][2][4][2], const Unit& u, int wr, int wc, int fr, int fq) const {
        const int row0 = u.pm * BM + wr * 64 + fr, col0 = u.pn * BM + wc * 32 + 4 * fq;
#pragma unroll
        for (int ai = 0; ai < 2; ++ai)
#pragma unroll
            for (int m = 0; m < 4; ++m) { float* rowp = Cp + (size_t)(row0 + ai * HALF + m * 16) * ldc + col0;
#pragma unroll
                for (int bj = 0; bj < 2; ++bj)
#pragma unroll
                    for (int n = 0; n < 2; ++n) *(f32x4*)(rowp + bj * HALF + n * 16) = acc[ai][bj][m][n]; }
    }
};
struct EpiBf16 {
    static constexpr bool PERM = true;
    bf16_t* O; int ldc; int pad_;
    DEV void operator()(const f32x4 (&acc)[2][2][4][2], const Unit& u, int wr, int wc, int fr, int fq) const {
        const int row0 = u.pm * BM + wr * 64 + fr, col0 = u.pn * BM + wc * 32 + 8 * fq;
#pragma unroll
        for (int ai = 0; ai < 2; ++ai)
#pragma unroll
            for (int m = 0; m < 4; ++m) { bf16_t* rowp = O + (size_t)(row0 + ai * HALF + m * 16) * ldc + col0;
#pragma unroll
                for (int bj = 0; bj < 2; ++bj) *(u32x4*)(rowp + bj * HALF) = pack8(acc[ai][bj][m][0], acc[ai][bj][m][1]); }
    }
};
DEV u32x2 pack8_fp8(const f32x4 a, const f32x4 b) {
    f32x4 x = a, y = b;
#pragma unroll
    for (int i = 0; i < 4; ++i) { x[i] = __builtin_amdgcn_fmed3f(x[i], -440.f, 440.f); y[i] = __builtin_amdgcn_fmed3f(y[i], -440.f, 440.f); }
    int w0 = __builtin_amdgcn_cvt_pk_fp8_f32(x[0], x[1], 0, false); w0 = __builtin_amdgcn_cvt_pk_fp8_f32(x[2], x[3], w0, true);
    int w1 = __builtin_amdgcn_cvt_pk_fp8_f32(y[0], y[1], 0, false); w1 = __builtin_amdgcn_cvt_pk_fp8_f32(y[2], y[3], w1, true);
    return (u32x2){(unsigned)w0, (unsigned)w1};
}
struct EpiFp8 {
    static constexpr bool PERM = true;
    unsigned char* O; int ldc; int pad_;
    DEV void operator()(const f32x4 (&acc)[2][2][4][2], const Unit& u, int wr, int wc, int fr, int fq) const {
        const int row0 = u.pm * BM + wr * 64 + fr, col0 = u.pn * BM + wc * 32 + 8 * fq;
#pragma unroll
        for (int ai = 0; ai < 2; ++ai)
#pragma unroll
            for (int m = 0; m < 4; ++m) { unsigned char* rowp = O + (size_t)(row0 + ai * HALF + m * 16) * ldc + col0;
#pragma unroll
                for (int bj = 0; bj < 2; ++bj) { f32x4 a0 = acc[ai][bj][m][0], a1 = acc[ai][bj][m][1];
#pragma unroll
                    for (int i = 0; i < 4; ++i) { a0[i] = __builtin_amdgcn_fmed3f(a0[i], -440.f, 440.f); a1[i] = __builtin_amdgcn_fmed3f(a1[i], -440.f, 440.f); }
                    int w0 = __builtin_amdgcn_cvt_pk_fp8_f32(a0[0], a0[1], 0, false); w0 = __builtin_amdgcn_cvt_pk_fp8_f32(a0[2], a0[3], w0, true);
                    int w1 = __builtin_amdgcn_cvt_pk_fp8_f32(a1[0], a1[1], 0, false); w1 = __builtin_amdgcn_cvt_pk_fp8_f32(a1[2], a1[3], w1, true);
                    *(u32x2*)(rowp + bj * HALF) = (u32x2){(unsigned)w0, (unsigned)w1}; } }
    }
};
struct EpiGU {
    static constexpr bool PERM = true;
    unsigned char* H;
    DEV void operator()(const f32x4 (&acc)[2][2][4][2], const Unit& u, int wr, int wc, int fr, int fq) const {
        const int row0 = u.pm * BM + wr * 64 + fr, col0 = u.pn * HALF + wc * 32 + 8 * fq;
#pragma unroll
        for (int ai = 0; ai < 2; ++ai)
#pragma unroll
            for (int m = 0; m < 4; ++m) {
                f32x4 h0, h1;
#pragma unroll
                for (int i = 0; i < 4; ++i) { h0[i] = siluf(acc[ai][0][m][0][i]) * acc[ai][1][m][0][i]; h1[i] = siluf(acc[ai][0][m][1][i]) * acc[ai][1][m][1][i]; }
                *(u32x2*)(H + (size_t)(row0 + ai * HALF + m * 16) * ED + col0) = pack8_fp8(h0, h1);
            }
    }
};
struct EpiQKV {
    static constexpr bool PERM = true;
    bf16_t* O; const float* cosT; const float* sinT;
    DEV void operator()(const f32x4 (&acc)[2][2][4][2], const Unit& u, int wr, int wc, int fr, int fq) const {
        const int row0 = u.pm * BM + wr * 64 + fr, col0 = u.pn * BM + wc * 32 + 8 * fq;
        const bool rope = u.pn < 8; const float qs = u.pn < 4 ? 0.125f : 1.f;
#pragma unroll
        for (int ai = 0; ai < 2; ++ai)
#pragma unroll
            for (int m = 0; m < 4; ++m) {
                const int row = row0 + ai * HALF + m * 16;
                bf16_t* rowp = O + (size_t)row * 3072 + col0;
                if (rope) {
                    const f32x4 cs = *(const f32x4*)(cosT + (size_t)row * 32 + 16 * (wc & 1) + 4 * fq), sn = *(const f32x4*)(sinT + (size_t)row * 32 + 16 * (wc & 1) + 4 * fq);
#pragma unroll
                    for (int bj = 0; bj < 2; ++bj) { const f32x4 x1 = acc[ai][bj][m][0], x2 = acc[ai][bj][m][1];
                        *(u32x4*)(rowp + bj * HALF) = pack8((x1 * cs - x2 * sn) * qs, (x2 * cs + x1 * sn) * qs); }
                } else {
#pragma unroll
                    for (int bj = 0; bj < 2; ++bj) *(u32x4*)(rowp + bj * HALF) = pack8(acc[ai][bj][m][0], acc[ai][bj][m][1]);
                }
            }
    }
};
}

template <class SrcF, bool OUT8 = false>
DEV void conv_item(const SrcF& src, int ldw, int K, void* dstv, LAS float* scr, int item, int nblk, int lane, const float wscale = 1.f) {
    const int kb = item / nblk, nb = item - kb * nblk, k0 = 64 * kb, n0 = 32 * nb;
    const int quad = lane & 7, r0 = lane >> 3;
    const float* colp = src(n0 + 4 * quad);
    f32x4 v[8];
#pragma unroll
    for (int i = 0; i < 8; ++i) v[i] = colp ? *(const f32x4*)(colp + (size_t)(k0 + r0 + 8 * i) * ldw) : (f32x4){0.f, 0.f, 0.f, 0.f};
#pragma unroll
    for (int i = 0; i < 8; ++i) { LAS float* p = scr + (r0 + 8 * i) * 33 + 4 * quad; p[0] = v[i][0]; p[1] = v[i][1]; p[2] = v[i][2]; p[3] = v[i][3]; }
    LDS_WAIT(); asm volatile("" ::: "memory");
    const int c = lane & 7;
#pragma unroll
    for (int j = 0; j < 4; ++j) { const int n = (lane >> 3) + 8 * j; const LAS float* s = scr + (8 * c) * 33 + n;
        if constexpr (OUT8) {
            int w0 = __builtin_amdgcn_cvt_pk_fp8_f32(s[0 * 33] * wscale, s[1 * 33] * wscale, 0, false); w0 = __builtin_amdgcn_cvt_pk_fp8_f32(s[2 * 33] * wscale, s[3 * 33] * wscale, w0, true);
            int w1 = __builtin_amdgcn_cvt_pk_fp8_f32(s[4 * 33] * wscale, s[5 * 33] * wscale, 0, false); w1 = __builtin_amdgcn_cvt_pk_fp8_f32(s[6 * 33] * wscale, s[7 * 33] * wscale, w1, true);
            *(u32x2*)((unsigned char*)dstv + (size_t)(n0 + n) * K + k0 + 8 * c) = (u32x2){(unsigned)w0, (unsigned)w1};
        } else {
            u32x4 o; o.x = pk2(s[0 * 33], s[1 * 33]); o.y = pk2(s[2 * 33], s[3 * 33]); o.z = pk2(s[4 * 33], s[5 * 33]); o.w = pk2(s[6 * 33], s[7 * 33]);
            *(u32x4*)((bf16_t*)dstv + (size_t)(n0 + n) * K + k0 + 8 * c) = o; } }
    LDS_WAIT(); asm volatile("" ::: "memory");
}
struct SrcIdent { const float* W; DEV const float* operator()(int n) const { return W + n; } };
struct SrcWin { const float* W; DEV const float* operator()(int n) const {
    int s; if (n < 4096) s = n; else if (n < 5632) s = C_XBC + (n - 4096); else if (n < 6656) s = C_ZB + (n - 5632); else if (n < 6672) s = C_BETA + (n - 6656); else if (n < 6688) s = C_DT + (n - 6672); else return nullptr;
    return W + s; } };
struct SrcQKV { const float* W; DEV const float* operator()(int n) const {
    if (n >= 2048) return W + n; const int hd = n >> 6, cp = n & 63; return W + hd * 64 + 32 * ((cp >> 2) & 1) + 16 * (cp >> 5) + 4 * ((cp >> 3) & 3) + (cp & 3); } };
struct SrcGU { const float* Wg; long du; DEV const float* operator()(int r) const { const int j = r >> 8, rr = r & 255; return Wg + (rr < 128 ? 0l : du) + 128 * j + (rr & 127); } };

DEV void load_row(const float* p, int lane, float (&v)[16]) {
#pragma unroll
    for (int j = 0; j < 4; ++j) { const f32x4 t = *(const f32x4*)(p + j * 256 + lane * 4); v[4 * j] = t[0]; v[4 * j + 1] = t[1]; v[4 * j + 2] = t[2]; v[4 * j + 3] = t[3]; }
}
DEV void store_row(float* p, int lane, const float (&v)[16]) {
#pragma unroll
    for (int j = 0; j < 4; ++j) *(f32x4*)(p + j * 256 + lane * 4) = (f32x4){v[4 * j], v[4 * j + 1], v[4 * j + 2], v[4 * j + 3]};
}
DEV float row_rstd(const float (&v)[16]) { float ss = 0.f;
#pragma unroll
    for (int i = 0; i < 16; ++i) ss += v[i] * v[i];
    return rsqrtf(wave_sum(ss) * (1.f / D) + EPS); }
DEV void resid_update(float (&xv)[16], const float (&yv)[16], const float* gpost, const float* gt, int lane) {
    const float r = row_rstd(yv);
#pragma unroll
    for (int j = 0; j < 4; ++j) { const f32x4 g = *(const f32x4*)(gpost + j * 256 + lane * 4), t = *(const f32x4*)(gt + j * 256 + lane * 4);
#pragma unroll
        for (int i = 0; i < 4; ++i) xv[4 * j + i] += t[i] * (yv[4 * j + i] * r * g[i]); }
}
DEV void prenorm_pack(const float (&xv)[16], const float* gpre, const float* sc, const float* sh, int lane, u32x2 (&o)[4]) {
    const float r = row_rstd(xv);
#pragma unroll
    for (int j = 0; j < 4; ++j) { const f32x4 g = *(const f32x4*)(gpre + j * 256 + lane * 4), s = *(const f32x4*)(sc + j * 256 + lane * 4), b = *(const f32x4*)(sh + j * 256 + lane * 4);
        float h[4];
#pragma unroll
        for (int i = 0; i < 4; ++i) h[i] = xv[4 * j + i] * r * g[i] * (1.f + s[i]) + b[i];
        o[j] = (u32x2){pk2(h[0], h[1]), pk2(h[2], h[3])}; }
}

DEV void load_row8(const float* p, int lane, float (&v)[16]) {
#pragma unroll
    for (int j = 0; j < 2; ++j)
#pragma unroll
        for (int hh = 0; hh < 2; ++hh) { const f32x4 t = *(const f32x4*)(p + 512 * j + 8 * lane + 4 * hh); v[8 * j + 4 * hh] = t[0]; v[8 * j + 4 * hh + 1] = t[1]; v[8 * j + 4 * hh + 2] = t[2]; v[8 * j + 4 * hh + 3] = t[3]; }
}
DEV void store_row8(float* p, int lane, const float (&v)[16]) {
#pragma unroll
    for (int j = 0; j < 2; ++j)
#pragma unroll
        for (int hh = 0; hh < 2; ++hh) *(f32x4*)(p + 512 * j + 8 * lane + 4 * hh) = (f32x4){v[8 * j + 4 * hh], v[8 * j + 4 * hh + 1], v[8 * j + 4 * hh + 2], v[8 * j + 4 * hh + 3]};
}
DEV void resid_update8(float (&xv)[16], const float (&yv)[16], const float* gpost, const float* gt, int lane) {
    const float r = row_rstd(yv);
#pragma unroll
    for (int j = 0; j < 2; ++j)
#pragma unroll
        for (int hh = 0; hh < 2; ++hh) { const f32x4 g = *(const f32x4*)(gpost + 512 * j + 8 * lane + 4 * hh), t = *(const f32x4*)(gt + 512 * j + 8 * lane + 4 * hh);
#pragma unroll
            for (int i = 0; i < 4; ++i) xv[8 * j + 4 * hh + i] += t[i] * (yv[8 * j + 4 * hh + i] * r * g[i]); }
}
DEV void prenorm_pack8(const float (&xv)[16], const float* gpre, const float* sc, const float* sh, int lane, u32x4 (&o)[2]) {
    const float r = row_rstd(xv);
#pragma unroll
    for (int j = 0; j < 2; ++j) { float h[8];
#pragma unroll
        for (int hh = 0; hh < 2; ++hh) { const f32x4 g = *(const f32x4*)(gpre + 512 * j + 8 * lane + 4 * hh), s = *(const f32x4*)(sc + 512 * j + 8 * lane + 4 * hh), b = *(const f32x4*)(sh + 512 * j + 8 * lane + 4 * hh);
#pragma unroll
            for (int i = 0; i < 4; ++i) h[4 * hh + i] = xv[8 * j + 4 * hh + i] * r * g[i] * (1.f + s[i]) + b[i]; }
        o[j] = (u32x4){pk2(h[0], h[1]), pk2(h[2], h[3]), pk2(h[4], h[5]), pk2(h[6], h[7])}; }
}
DEV void prenorm_pack8_f8(const float (&xv)[16], const float* gpre, const float* sc, const float* sh, int lane, u32x2 (&o)[2]) {
    const float r = row_rstd(xv);
#pragma unroll
    for (int j = 0; j < 2; ++j) { float h[8];
#pragma unroll
        for (int hh = 0; hh < 2; ++hh) { const f32x4 g = *(const f32x4*)(gpre + 512 * j + 8 * lane + 4 * hh), s = *(const f32x4*)(sc + 512 * j + 8 * lane + 4 * hh), b = *(const f32x4*)(sh + 512 * j + 8 * lane + 4 * hh);
#pragma unroll
            for (int i = 0; i < 4; ++i) h[4 * hh + i] = __builtin_amdgcn_fmed3f(xv[8 * j + 4 * hh + i] * r * g[i] * (1.f + s[i]) + b[i], -440.f, 440.f); }
        int w0 = __builtin_amdgcn_cvt_pk_fp8_f32(h[0], h[1], 0, false); w0 = __builtin_amdgcn_cvt_pk_fp8_f32(h[2], h[3], w0, true);
        int w1 = __builtin_amdgcn_cvt_pk_fp8_f32(h[4], h[5], 0, false); w1 = __builtin_amdgcn_cvt_pk_fp8_f32(h[6], h[7], w1, true);
        o[j] = (u32x2){(unsigned)w0, (unsigned)w1}; }
}
DEV void acc_row8(float (&yv)[16], const u32x2 w0, const u32x2 w1, const float g) {
#pragma unroll
    for (int e = 0; e < 2; ++e) {
        yv[4 * e] += g * __builtin_amdgcn_cvt_f32_fp8((int)w0[e], 0); yv[4 * e + 1] += g * __builtin_amdgcn_cvt_f32_fp8((int)w0[e], 1); yv[4 * e + 2] += g * __builtin_amdgcn_cvt_f32_fp8((int)w0[e], 2); yv[4 * e + 3] += g * __builtin_amdgcn_cvt_f32_fp8((int)w0[e], 3);
        yv[8 + 4 * e] += g * __builtin_amdgcn_cvt_f32_fp8((int)w1[e], 0); yv[8 + 4 * e + 1] += g * __builtin_amdgcn_cvt_f32_fp8((int)w1[e], 1); yv[8 + 4 * e + 2] += g * __builtin_amdgcn_cvt_f32_fp8((int)w1[e], 2); yv[8 + 4 * e + 3] += g * __builtin_amdgcn_cvt_f32_fp8((int)w1[e], 3); }
}

DEV void load_row_bf(const bf16_t* p, int lane, float (&v)[16]) {
#pragma unroll
    for (int j = 0; j < 4; ++j) { const u32x2 w = *(const u32x2*)(p + j * 256 + lane * 4); v[4 * j] = __uint_as_float(w.x << 16); v[4 * j + 1] = __uint_as_float(w.x & 0xFFFF0000u); v[4 * j + 2] = __uint_as_float(w.y << 16); v[4 * j + 3] = __uint_as_float(w.y & 0xFFFF0000u); }
}
DEV void store_row_bf(bf16_t* p, int lane, const float (&v)[16]) {
#pragma unroll
    for (int j = 0; j < 4; ++j) *(u32x2*)(p + j * 256 + lane * 4) = (u32x2){pk2(v[4 * j], v[4 * j + 1]), pk2(v[4 * j + 2], v[4 * j + 3])};
}
DEV void load_row8_bf(const bf16_t* p, int lane, float (&v)[16]) {
#pragma unroll
    for (int j = 0; j < 2; ++j) { const u32x4 w = *(const u32x4*)(p + 512 * j + 8 * lane);
#pragma unroll
        for (int e = 0; e < 4; ++e) { v[8 * j + 2 * e] = __uint_as_float(w[e] << 16); v[8 * j + 2 * e + 1] = __uint_as_float(w[e] & 0xFFFF0000u); } }
}
DEV void store_row8_bf(bf16_t* p, int lane, const float (&v)[16]) {
#pragma unroll
    for (int j = 0; j < 2; ++j) *(u32x4*)(p + 512 * j + 8 * lane) = (u32x4){pk2(v[8 * j], v[8 * j + 1]), pk2(v[8 * j + 2], v[8 * j + 3]), pk2(v[8 * j + 4], v[8 * j + 5]), pk2(v[8 * j + 6], v[8 * j + 7])};
}

struct Ctx { LAS unsigned char* lds; int tid, lane, wave, G, bid; };

DEV void ph_setup(const Args& a, const Ctx& X) {
    unsigned char* ws = a.ws;
    float* mod = (float*)(ws + WS_MOD);
    { LAS float* red = (LAS float*)X.lds;
      LAS float* sc = (LAS float*)(X.lds + 8192);
      for (int i = X.tid; i < NB * D; i += NTHR) sc[i] = siluf(a.c[i]);
      __syncthreads();
      const int kc = X.tid >> 6, cl = X.tid & 63;
      for (int task = X.bid; task < 2 * 96; task += X.G) {
          const int l = task / 96, col = (task % 96) * 64 + cl;
          const float* w = a.mod_w + (size_t)l * D * 6 * D + col;
          float p0 = 0.f, p1 = 0.f, p2 = 0.f, p3 = 0.f;
#pragma unroll 16
          for (int k = kc * 128; k < kc * 128 + 128; ++k) { const float wv = w[(size_t)k * 6 * D];
              p0 += sc[k] * wv; p1 += sc[D + k] * wv; p2 += sc[2 * D + k] * wv; p3 += sc[3 * D + k] * wv; }
          __syncthreads();
          red[(kc * 4 + 0) * 64 + cl] = p0; red[(kc * 4 + 1) * 64 + cl] = p1; red[(kc * 4 + 2) * 64 + cl] = p2; red[(kc * 4 + 3) * 64 + cl] = p3;
          __syncthreads();
          if (X.tid < 256) { const int b = X.tid >> 6; float s = a.mod_b[l * 6 * D + col];
#pragma unroll
              for (int q = 0; q < 8; ++q) s += red[(q * 4 + b) * 64 + cl];
              mod[(size_t)(l * NB + b) * 6 * D + col] = s; }
      }
      __syncthreads(); }
    { LAS float* scr = (LAS float*)(X.lds + X.wave * 8704);
      const int gw = X.bid * NWAVES + X.wave, NGW = X.G * NWAVES;
      constexpr int I_IN = (D / 64) * (NPROJ / 32);
      for (int it = gw; it < I_IN; it += NGW) conv_item<SrcWin, true>(SrcWin{a.ssm_w_in}, PROJ, D, ws + WS_WIN, scr, it, NPROJ / 32, X.lane, 64.f);
    }
}
DEV void ph_setup_late(const Args& a, const Ctx& X, const int widx, const int nwg) {
    unsigned char* ws = a.ws;
    { float* cosT = (float*)(ws + WS_COS); float* sinT = (float*)(ws + WS_SIN);
      for (int idx = widx * NTHR + X.tid; idx < T * 32; idx += nwg * NTHR) { const int t = idx >> 5, i = idx & 31;
          const float ang = (float)a.pos[t] * powf(10000.f, -(float)i / 32.f); float sn, cs; sincosf(ang, &sn, &cs); cosT[idx] = cs; sinT[idx] = sn; } }
    { LAS float* scr = (LAS float*)(X.lds + X.wave * 8704);
      const int gw = widx * NWAVES + X.wave, NGW = nwg * NWAVES;
      constexpr int I_OUT = (2048 / 64) * (D / 32), I_QKV = (D / 64) * (3072 / 32), I_O = (D / 64) * (D / 32);
      for (int it = gw; it < I_OUT + I_QKV + I_O; it += NGW) {
          int r = it;
          if (r < I_OUT) { conv_item(SrcIdent{a.ssm_w_out}, D, 2048, (bf16_t*)(ws + WS_WOUT), scr, r, D / 32, X.lane); continue; } r -= I_OUT;
          if (r < I_QKV) { conv_item<SrcQKV, true>(SrcQKV{a.attn_w_qkv}, 3072, D, ws + WS_WQKV, scr, r, 3072 / 32, X.lane, 64.f); continue; } r -= I_QKV;
          conv_item<SrcIdent, true>(SrcIdent{a.attn_w_o}, D, D, ws + WS_WO, scr, r, D / 32, X.lane, 64.f);
      } }
}

DEV void ph_prenorm0(const Args& a, const Ctx& X) {
    const float* mod = (const float*)(a.ws + WS_MOD);
    unsigned char* h8 = a.ws + WS_H;
    for (int row = X.bid * NWAVES + X.wave; row < T; row += X.G * NWAVES) {
        const int b = row / SEQ; const float* ml = mod + (size_t)b * 6 * D;
        float xv[16]; load_row(a.x + (size_t)row * D, X.lane, xv);
        u32x2 o[4]; prenorm_pack(xv, a.mix_pre_g, ml + D, ml, X.lane, o);
#pragma unroll
        for (int j = 0; j < 4; ++j) { const float f0 = __uint_as_float(o[j].x << 16), f1 = __uint_as_float(o[j].x & 0xFFFF0000u), f2 = __uint_as_float(o[j].y << 16), f3 = __uint_as_float(o[j].y & 0xFFFF0000u);
            int wv = __builtin_amdgcn_cvt_pk_fp8_f32(__builtin_amdgcn_fmed3f(f0, -440.f, 440.f), __builtin_amdgcn_fmed3f(f1, -440.f, 440.f), 0, false); wv = __builtin_amdgcn_cvt_pk_fp8_f32(__builtin_amdgcn_fmed3f(f2, -440.f, 440.f), __builtin_amdgcn_fmed3f(f3, -440.f, 440.f), wv, true);
            *(unsigned*)(h8 + (size_t)row * D + j * 256 + X.lane * 4) = (unsigned)wv; }
    }
}

DEV bf16x8 acc_to_frag(const f32x4 lo, const f32x4 hi) { u32x4 w; w.x = pg8::cvt_pk_bf16(lo[0], lo[1]); w.y = pg8::cvt_pk_bf16(lo[2], lo[3]); w.z = pg8::cvt_pk_bf16(hi[0], hi[1]); w.w = pg8::cvt_pk_bf16(hi[2], hi[3]); return __builtin_bit_cast(bf16x8, w); }

DEV void gdn_solve(LAS float* M, LAS unsigned short* tf, const int lane) {
    for (int rb = 0; rb < 16; ++rb) {
        const int i0 = 4 * rb;
        float a0 = (lane == i0) ? 1.f : 0.f, a1 = (lane == i0 + 1) ? 1.f : 0.f, a2 = (lane == i0 + 2) ? 1.f : 0.f, a3 = (lane == i0 + 3) ? 1.f : 0.f;
        for (int j = 0; j < i0; j += 4) {
            const float t0 = M[j * 64 + lane], t1 = M[(j + 1) * 64 + lane], t2 = M[(j + 2) * 64 + lane], t3 = M[(j + 3) * 64 + lane];
            const f32x4 r0 = *(const LAS f32x4*)(M + i0 * 64 + j), r1 = *(const LAS f32x4*)(M + (i0 + 1) * 64 + j), r2 = *(const LAS f32x4*)(M + (i0 + 2) * 64 + j), r3 = *(const LAS f32x4*)(M + (i0 + 3) * 64 + j);
            a0 -= r0[0] * t0 + r0[1] * t1 + r0[2] * t2 + r0[3] * t3; a1 -= r1[0] * t0 + r1[1] * t1 + r1[2] * t2 + r1[3] * t3;
            a2 -= r2[0] * t0 + r2[1] * t1 + r2[2] * t2 + r2[3] * t3; a3 -= r3[0] * t0 + r3[1] * t1 + r3[2] * t2 + r3[3] * t3;
        }
        const f32x4 d1 = *(const LAS f32x4*)(M + (i0 + 1) * 64 + i0), d2 = *(const LAS f32x4*)(M + (i0 + 2) * 64 + i0), d3 = *(const LAS f32x4*)(M + (i0 + 3) * 64 + i0);
        a1 -= d1[0] * a0; a2 -= d2[0] * a0 + d2[1] * a1; a3 -= d3[0] * a0 + d3[1] * a1 + d3[2] * a2;
        M[i0 * 64 + lane] = a0; M[(i0 + 1) * 64 + lane] = a1; M[(i0 + 2) * 64 + lane] = a2; M[(i0 + 3) * 64 + lane] = a3;
    }
    const int cq = (lane >> 2) & 3, ca = (lane >> 4) & 1, ce = lane & 3, cks = lane >> 5;
    for (int i = 0; i < 64; ++i) tf[((i >> 4) * 2 + cks) * 512 + ((i & 15) + 16 * cq) * 8 + 4 * ca + ce] = (unsigned short)f2bf(M[i * 64 + lane]);
}
DEV void ph_gdn_local(const Args& a, const Ctx& X) {
    const bf16_t* qkvpre = (const bf16_t*)(a.ws + WS_QKVPRE); const float* small = (const float*)(a.ws + WS_SMALL);
    unsigned char* gi = a.ws + WS_GI; float* glast = (float*)(a.ws + WS_GLAST);
    constexpr int KP = 272;
    LAS unsigned char* kN = X.lds; LAS unsigned char* qN = X.lds + 64 * KP; LAS unsigned char* slots = X.lds + 128 * KP;
    LAS float* gcL = (LAS float*)(X.lds + 143360); LAS float* btL = gcL + 8 * 64;
    LAS unsigned char* stg = X.lds + 100352;
    const int lane = X.lane, wave = X.wave, r16 = lane & 15, q4 = lane >> 4;
    const float scale = 0.08838834764831845f;
    for (int wu = X.bid; wu < NB * 64; wu += X.G) {
        const int b = wu >> 6, n = wu & 63; const size_t t0 = (size_t)b * SEQ + 64 * n;
        unsigned char* tmp = a.ws + WS_GTMP + (size_t)X.bid * 131072;
        __syncthreads();
        {
            const float g = -__expf(a.gdn_a_log[wave]) * softplusf(small[(t0 + lane) * 32 + 8 + wave] + a.gdn_dt_bias[wave]);
            float gc = g;
#pragma unroll
            for (int o = 1; o < 64; o <<= 1) { const float v = __shfl_up(gc, o); if (lane >= o) gc += v; }
            gcL[wave * 64 + lane] = gc; btL[wave * 64 + lane] = sigmoidf_(small[(t0 + lane) * 32 + wave]);
            if (lane == 63) glast[(size_t)((b * 8 + wave) * 64 + n) * 32] = gc;
        }
        __syncthreads();
        unsigned xr[3][11];
#define GDN_LOADX(hh) do { _Pragma("unroll") for (int _p = 0; _p < 3; ++_p) _Pragma("unroll") for (int _i = 0; _i < 11; ++_i) { const int _tk = 8 * wave + _i - 3; unsigned _v = 0u; \
            if (64 * n + _tk >= 0) _v = *(const unsigned*)(qkvpre + (t0 + _tk) * 3072 + _p * 1024 + (hh) * 128 + 2 * lane); xr[_p][_i] = _v; } } while (0)
        GDN_LOADX(0);
        for (int bb = 0; bb < 2; ++bb) {
            for (int j = 0; j < 4; ++j) {
                const int h = bb * 4 + j; unsigned char* ub = gi + (size_t)((b * 8 + h) * 64 + n) * GI_UNIT;
                {
                    const float gl = gcL[h * 64 + 63];
                    const int blk = wave >> 2, pa = (wave & 3) >> 1, pq0 = 2 * (wave & 1);
                    const int ca = (2 * lane >> 4) & 1, cq = (2 * lane >> 2) & 3, ce = (2 * lane) & 3, cks = (2 * lane) >> 5;
#pragma unroll
                    for (int part = 0; part < 3; ++part) {
                        const int col = part * 1024 + h * 128 + 2 * lane;
                        float w0[4], w1[4];
#pragma unroll
                        for (int i = 0; i < 4; ++i) { const f32x2 t = *(const f32x2*)(a.gdn_conv_w + i * 3072 + col); w0[i] = t.x; w1[i] = t.y; }
                        float x0[11], x1[11];
#pragma unroll
                        for (int i = 0; i < 11; ++i) { const unsigned v = xr[part][i]; x0[i] = __uint_as_float(v << 16); x1[i] = __uint_as_float(v & 0xFFFF0000u); }
                        float v0[8], v1[8];
#pragma unroll
                        for (int i = 0; i < 8; ++i) { v0[i] = siluf(w0[0] * x0[i] + w0[1] * x0[i + 1] + w0[2] * x0[i + 2] + w0[3] * x0[i + 3]); v1[i] = siluf(w1[0] * x1[i] + w1[1] * x1[i + 1] + w1[2] * x1[i + 2] + w1[3] * x1[i + 3]); }
                        if (part < 2) {
#pragma unroll
                            for (int i = 0; i < 8; ++i) { const float r = rsqrtf(wave_sum(v0[i] * v0[i] + v1[i] * v1[i]) + 1e-6f); v0[i] *= r; v1[i] *= r; }
                        }
                        for (int rep_ = 0; rep_ < (((PROBE_MASK >> 21) & 1u) ? 2 : 1); ++rep_) {
                        if (part == 0) {
#pragma unroll
                            for (int i = 0; i < 8; ++i) { const int tok = 8 * wave + i; const float eg = __expf(gcL[h * 64 + tok]) * scale;
                                *(LAS unsigned*)(qN + tok * KP + lane * 4) = pk2(v0[i], v1[i]);
                                *(LAS unsigned*)(stg + ((tok >> 4) * 4 + cks) * 1024 + ((tok & 15) + 16 * cq) * 16 + (4 * ca + ce) * 2) = pk2(v0[i] * eg, v1[i] * eg); }
                        } else if (part == 1) {
                            unsigned short kg0[8], kg1[8], ke0[8], ke1[8];
#pragma unroll
                            for (int i = 0; i < 8; ++i) { const int tok = 8 * wave + i; const float gc = gcL[h * 64 + tok], bt = btL[h * 64 + tok], eg = __expf(gc) * bt, eend = __expf(gl - gc);
                                *(LAS unsigned*)(kN + tok * KP + lane * 4) = pk2(v0[i], v1[i]);
                                kg0[i] = (unsigned short)f2bf(v0[i] * eg); kg1[i] = (unsigned short)f2bf(v1[i] * eg); ke0[i] = (unsigned short)f2bf(v0[i] * eend); ke1[i] = (unsigned short)f2bf(v1[i] * eend); }
#pragma unroll
                            for (int hf = 0; hf < 2; ++hf) { const int pos = 32 * blk + 8 * (pq0 + hf) + 4 * pa; const int cl = 2 * lane;
                                *(u32x2*)(tmp + (size_t)j * 32768 + 16384 + cl * 128 + pos * 2) = (u32x2){(unsigned)kg0[4 * hf] | ((unsigned)kg0[4 * hf + 1] << 16), (unsigned)kg0[4 * hf + 2] | ((unsigned)kg0[4 * hf + 3] << 16)};
                                *(u32x2*)(tmp + (size_t)j * 32768 + 16384 + (cl + 1) * 128 + pos * 2) = (u32x2){(unsigned)kg1[4 * hf] | ((unsigned)kg1[4 * hf + 1] << 16), (unsigned)kg1[4 * hf + 2] | ((unsigned)kg1[4 * hf + 3] << 16)};
                                *(LAS u32x2*)(stg + 16384 + ((cl >> 4) * 2 + blk) * 1024 + ((cl & 15) + 16 * (pq0 + hf)) * 16 + (4 * pa) * 2) = (u32x2){(unsigned)ke0[4 * hf] | ((unsigned)ke0[4 * hf + 1] << 16), (unsigned)ke0[4 * hf + 2] | ((unsigned)ke0[4 * hf + 3] << 16)};
                                *(LAS u32x2*)(stg + 16384 + (((cl + 1) >> 4) * 2 + blk) * 1024 + (((cl + 1) & 15) + 16 * (pq0 + hf)) * 16 + (4 * pa) * 2) = (u32x2){(unsigned)ke1[4 * hf] | ((unsigned)ke1[4 * hf + 1] << 16), (unsigned)ke1[4 * hf + 2] | ((unsigned)ke1[4 * hf + 3] << 16)}; }
                        } else {
                            unsigned short vb0[8], vb1[8];
#pragma unroll
                            for (int i = 0; i < 8; ++i) { const float bt = btL[h * 64 + 8 * wave + i]; vb0[i] = (unsigned short)f2bf(v0[i] * bt); vb1[i] = (unsigned short)f2bf(v1[i] * bt); }
#pragma unroll
                            for (int hf = 0; hf < 2; ++hf) { const int pos = 32 * blk + 8 * (pq0 + hf) + 4 * pa; const int cl = 2 * lane;
                                *(u32x2*)(tmp + (size_t)j * 32768 + cl * 128 + pos * 2) = (u32x2){(unsigned)vb0[4 * hf] | ((unsigned)vb0[4 * hf + 1] << 16), (unsigned)vb0[4 * hf + 2] | ((unsigned)vb0[4 * hf + 3] << 16)};
                                *(u32x2*)(tmp + (size_t)j * 32768 + (cl + 1) * 128 + pos * 2) = (u32x2){(unsigned)vb1[4 * hf] | ((unsigned)vb1[4 * hf + 1] << 16), (unsigned)vb1[4 * hf + 2] | ((unsigned)vb1[4 * hf + 3] << 16)}; }
                        }
                        asm volatile("" ::: "memory"); }
                    }
                }
                if (h + 1 < 8) GDN_LOADX(h + 1);
                __syncthreads();
                {
#pragma unroll
                    for (int i = 0; i < 4; ++i) *(u32x4*)(ub + 16384 + (X.tid + 512 * i) * 16) = *(const LAS u32x4*)(stg + (X.tid + 512 * i) * 16);
                    const int mat = wave >> 2, rt = wave & 3; LAS unsigned char* An = mat ? qN : kN;
                    bf16x8 af[4];
#pragma unroll
                    for (int ks = 0; ks < 4; ++ks) af[ks] = *(const LAS bf16x8*)(An + (16 * rt + r16) * KP + (32 * ks + 8 * q4) * 2);
                    LAS float* slot = (LAS float*)(slots + j * 16384);
#pragma unroll
                    for (int ct = 0; ct < 4; ++ct) { f32x4 acc = {0.f, 0.f, 0.f, 0.f};
#pragma unroll
                        for (int ks = 0; ks < 4; ++ks) { const bf16x8 bf = *(const LAS bf16x8*)(kN + (16 * ct + r16) * KP + (32 * ks + 8 * q4) * 2); acc = __builtin_amdgcn_mfma_f32_16x16x32_bf16(af[ks], bf, acc, 0, 0, 0); }
                        const int jc = 16 * ct + r16; const float gj = gcL[h * 64 + jc];
#pragma unroll
                        for (int rg = 0; rg < 4; ++rg) { const int i = 16 * rt + 4 * q4 + rg; const float dec = __expf(gcL[h * 64 + i] - gj);
                            if (mat == 0) { slot[i * 64 + jc] = jc < i ? btL[h * 64 + i] * acc[rg] * dec : 0.f; }
                            else { const float v = jc <= i ? acc[rg] * scale * dec : 0.f;
                                *(LAS unsigned short*)(stg + 32768 + (rt * 2 + (ct >> 1)) * 1024 + ((4 * q4 + rg) + 16 * (r16 >> 2)) * 16 + (4 * (ct & 1) + (r16 & 3)) * 2) = (unsigned short)f2bf(v); } }
                    }
                }
                __syncthreads();
                *(u32x4*)(ub + 49152 + X.tid * 16) = *(const LAS u32x4*)(stg + 32768 + X.tid * 16);
            }
            if (wave < 4) gdn_solve((LAS float*)(slots + wave * 16384), (LAS unsigned short*)(X.lds + wave * 8192), lane);
            VM_WAIT(); __syncthreads();
            for (int j = 0; j < 4; ++j) {
                const int h = bb * 4 + j; unsigned char* ub = gi + (size_t)((b * 8 + h) * 64 + n) * GI_UNIT;
                const int mat = wave >> 2; LAS unsigned char* slot = X.lds + j * 8192;
#pragma unroll
                for (int cx = 0; cx < 2; ++cx) { const int ct = 2 * (wave & 3) + cx;
                    bf16x8 bfr[2];
#pragma unroll
                    for (int ks = 0; ks < 2; ++ks) { const u32x4 t = __builtin_nontemporal_load((const u32x4*)(tmp + (size_t)j * 32768 + mat * 16384 + (16 * ct + r16) * 128 + (32 * ks + 8 * q4) * 2)); bfr[ks] = __builtin_bit_cast(bf16x8, t); }
#pragma unroll
                    for (int rt = 0; rt < 4; ++rt) { f32x4 acc = {0.f, 0.f, 0.f, 0.f};
#pragma unroll
                        for (int ks = 0; ks < 2; ++ks) { const bf16x8 tf = *(const LAS bf16x8*)(slot + (rt * 2 + ks) * 1024 + lane * 16); acc = __builtin_amdgcn_mfma_f32_16x16x32_bf16(tf, bfr[ks], acc, 0, 0, 0); }
                        if (mat == 0) *(u32x2*)(ub + 57344 + (rt * 8 + ct) * 512 + lane * 8) = (u32x2){pg8::cvt_pk_bf16(acc[0], acc[1]), pg8::cvt_pk_bf16(acc[2], acc[3])};
                        else {
#pragma unroll
                            for (int rg = 0; rg < 4; ++rg) *(unsigned short*)(ub + (rt * 4 + (ct >> 1)) * 1024 + ((4 * q4 + rg) + 16 * (r16 >> 2)) * 16 + (4 * (ct & 1) + (r16 & 3)) * 2) = (unsigned short)f2bf(-acc[rg]);
                        }
                    }
                }
            }
            __syncthreads();
        }
    }
}
DEV void ph_gdn_scan(const Args& a, const Ctx& X) {
    const unsigned char* gi = a.ws + WS_GI; const float* glast = (const float*)(a.ws + WS_GLAST);
    const bf16_t* za = (const bf16_t*)(a.ws + WS_ZA); bf16_t* oy = (bf16_t*)(a.ws + WS_OY);
    const int lane = X.lane, wave = X.wave, r16 = lane & 15, q4 = lane >> 4, tid = X.tid;
    LAS float* OT = (LAS float*)(X.lds + 114688);
    const int bh = X.bid, b = bh >> 3, h = bh & 7;
    const unsigned char* ubase = gi + (size_t)bh * 64 * GI_UNIT;
    f32x4 S[8];
#pragma unroll
    for (int i = 0; i < 8; ++i) S[i] = (f32x4){0.f, 0.f, 0.f, 0.f};
    LAS float* NWL = (LAS float*)(X.lds + 149504);
    if (tid < 128) NWL[tid] = a.gdn_norm_w[tid];
#define GDN_STAGE(nn, buf) do { _Pragma("unroll") for (int _i = 0; _i < 7; ++_i) \
        __builtin_amdgcn_global_load_lds((const unsigned*)(ubase + (size_t)(nn) * GI_UNIT + (size_t)(tid + 512 * _i) * 16), (LAS unsigned*)(X.lds + (buf) * 57344 + (wave * 64 + 512 * _i) * 16), 16, 0, 0); } while (0)
    u32x2 udn[4]; float gln; u32x4 zn[2];
    { const size_t tz = (size_t)b * SEQ + (tid >> 3); zn[0] = *(const u32x4*)(za + tz * 1024 + h * 128 + 16 * (tid & 7)); zn[1] = *(const u32x4*)(za + tz * 1024 + h * 128 + 16 * (tid & 7) + 8); }
#pragma unroll
    for (int ct = 0; ct < 4; ++ct) udn[ct] = *(const u32x2*)(ubase + 57344 + (ct * 8 + wave) * 512 + lane * 8);
    gln = glast[(size_t)(bh * 64) * 32];
    GDN_STAGE(0, 0);
#define GDN_EPILOGUE(nn, ZC) do { const int tok = tid >> 3, seg = tid & 7; const size_t t = (size_t)b * SEQ + 64 * (nn) + tok; \
            float ov[16]; float ss = 0.f; float nwv[16]; \
            _Pragma("unroll") for (int i = 0; i < 4; ++i) { const f32x4 v = *(const LAS f32x4*)(NWL + 16 * seg + 4 * i); nwv[4 * i] = v[0]; nwv[4 * i + 1] = v[1]; nwv[4 * i + 2] = v[2]; nwv[4 * i + 3] = v[3]; } \
            _Pragma("unroll") for (int i = 0; i < 4; ++i) { const f32x4 v = *(const LAS f32x4*)(OT + tok * 132 + 16 * seg + 4 * i); ov[4 * i] = v[0]; ov[4 * i + 1] = v[1]; ov[4 * i + 2] = v[2]; ov[4 * i + 3] = v[3]; ss += v[0] * v[0] + v[1] * v[1] + v[2] * v[2] + v[3] * v[3]; } \
            ss = sum8(ss); \
            const float rstd = rsqrtf(ss * (1.f / 128.f) + EPS); \
            u32x4 ow[2]; \
            _Pragma("unroll") for (int i = 0; i < 2; ++i) _Pragma("unroll") for (int e = 0; e < 4; ++e) { const unsigned zw = (ZC)[i][e]; const float z0 = __uint_as_float(zw << 16), z1 = __uint_as_float(zw & 0xFFFF0000u); \
                    ow[i][e] = pg8::cvt_pk_bf16(ov[8 * i + 2 * e] * rstd * nwv[8 * i + 2 * e] * siluf(z0), ov[8 * i + 2 * e + 1] * rstd * nwv[8 * i + 2 * e + 1] * siluf(z1)); } \
            *(u32x4*)(oy + t * 2048 + h * 128 + 16 * seg) = ow[0]; *(u32x4*)(oy + t * 2048 + h * 128 + 16 * seg + 8) = ow[1]; } while (0)
    u32x4 zp[2] = {{0u, 0u, 0u, 0u}, {0u, 0u, 0u, 0u}};
    for (int n = 0; n < 64; ++n) {
        VM_WAIT(); __syncthreads();
        f32x4 uf[4];
#pragma unroll
        for (int ct = 0; ct < 4; ++ct) { uf[ct][0] = __uint_as_float(udn[ct].x << 16); uf[ct][1] = __uint_as_float(udn[ct].x & 0xFFFF0000u); uf[ct][2] = __uint_as_float(udn[ct].y << 16); uf[ct][3] = __uint_as_float(udn[ct].y & 0xFFFF0000u); }
        const float egl = __expf(gln);
        u32x4 zc[2]; zc[0] = zn[0]; zc[1] = zn[1];
        asm volatile("" : "+v"(uf[0]), "+v"(uf[1]), "+v"(uf[2]), "+v"(uf[3]), "+v"(zc[0]), "+v"(zc[1]));
        if (n + 1 < 64) {
            const unsigned char* un = ubase + (size_t)(n + 1) * GI_UNIT;
#pragma unroll
            for (int ct = 0; ct < 4; ++ct) udn[ct] = *(const u32x2*)(un + 57344 + (ct * 8 + wave) * 512 + lane * 8);
            gln = glast[(size_t)(bh * 64 + n + 1) * 32];
            { const size_t tz = (size_t)b * SEQ + 64 * (n + 1) + (tid >> 3); zn[0] = *(const u32x4*)(za + tz * 1024 + h * 128 + 16 * (tid & 7)); zn[1] = *(const u32x4*)(za + tz * 1024 + h * 128 + 16 * (tid & 7) + 8); }
            GDN_STAGE(n + 1, (n + 1) & 1);
        }
        if (n > 0) GDN_EPILOGUE(n - 1, zp);
        zp[0] = zc[0]; zp[1] = zc[1];
        const LAS unsigned char* L = X.lds + (n & 1) * 57344;
        bf16x8 sB[4];
#pragma unroll
        for (int ks = 0; ks < 4; ++ks) sB[ks] = acc_to_frag(S[2 * ks], S[2 * ks + 1]);
#define GS_LD(off) (*(const LAS bf16x8*)(L + (off) + lane * 16))
#define GS_LOADWQ(dst, ct) do { _Pragma("unroll") for (int _k = 0; _k < 4; ++_k) { dst[_k] = GS_LD(((ct) * 4 + _k) * 1024); dst[4 + _k] = GS_LD(16384 + ((ct) * 4 + _k) * 1024); } } while (0)
#define GS_LOAD8(dst, base) do { _Pragma("unroll") for (int _k = 0; _k < 8; ++_k) dst[_k] = GS_LD((base) + _k * 1024); } while (0)
#define GS_WQ(src, ct) do { f32x4 acc = {0.f, 0.f, 0.f, 0.f}, ao = {0.f, 0.f, 0.f, 0.f}; \
            _Pragma("unroll") for (int _k = 0; _k < 4; ++_k) { acc = __builtin_amdgcn_mfma_f32_16x16x32_bf16(src[_k], sB[_k], acc, 0, 0, 0); ao = __builtin_amdgcn_mfma_f32_16x16x32_bf16(src[4 + _k], sB[_k], ao, 0, 0, 0); } \
            vn[ct] = acc; oo[ct] = ao; } while (0)
#define GS_SB __builtin_amdgcn_sched_barrier(0)
        f32x4 vn[4], oo[4];
        bf16x8 fa[8], fb[8];
        GS_LOADWQ(fa, 0); GS_SB;
        GS_LOADWQ(fb, 1); GS_SB; GS_WQ(fa, 0); GS_SB;
        GS_LOADWQ(fa, 2); GS_SB; GS_WQ(fb, 1); GS_SB;
        GS_LOADWQ(fb, 3); GS_SB; GS_WQ(fa, 2); GS_SB;
        GS_LOAD8(fa, 49152); GS_SB; GS_WQ(fb, 3); GS_SB;
#pragma unroll
        for (int ct = 0; ct < 4; ++ct) vn[ct] = vn[ct] + uf[ct];
        bf16x8 vB[2];
#pragma unroll
        for (int ks = 0; ks < 2; ++ks) vB[ks] = acc_to_frag(vn[2 * ks], vn[2 * ks + 1]);
        GS_SB; GS_LOAD8(fb, 32768); GS_SB;
#pragma unroll
        for (int ct = 0; ct < 4; ++ct)
#pragma unroll
            for (int ks = 0; ks < 2; ++ks) oo[ct] = __builtin_amdgcn_mfma_f32_16x16x32_bf16(fa[ct * 2 + ks], vB[ks], oo[ct], 0, 0, 0);
        GS_SB; GS_LOAD8(fa, 32768 + 8192); GS_SB;
#pragma unroll
        for (int dt = 0; dt < 4; ++dt) { f32x4 acc = S[dt] * egl;
#pragma unroll
            for (int ks = 0; ks < 2; ++ks) acc = __builtin_amdgcn_mfma_f32_16x16x32_bf16(fb[dt * 2 + ks], vB[ks], acc, 0, 0, 0);
            S[dt] = acc; }
        GS_SB;
#pragma unroll
        for (int dt = 4; dt < 8; ++dt) { f32x4 acc = S[dt] * egl;
#pragma unroll
            for (int ks = 0; ks < 2; ++ks) acc = __builtin_amdgcn_mfma_f32_16x16x32_bf16(fa[(dt - 4) * 2 + ks], vB[ks], acc, 0, 0, 0);
            S[dt] = acc; }
#undef GS_LD
#undef GS_LOADWQ
#undef GS_LOAD8
#undef GS_WQ
#undef GS_SB
        __syncthreads();
#pragma unroll
        for (int ct = 0; ct < 4; ++ct)
#pragma unroll
            for (int rg = 0; rg < 4; ++rg) OT[(16 * ct + 4 * q4 + rg) * 132 + 16 * wave + r16] = oo[ct][rg];
    }
    __syncthreads();
    GDN_EPILOGUE(63, zp);
#undef GDN_EPILOGUE
#undef GDN_STAGE
}

constexpr int SP = 272;
DEV void ph_ssd_local(const Args& a, const Ctx& X, const int wg0) {
    const bf16_t* xbcpre = (const bf16_t*)(a.ws + WS_XBCPRE); const float* small = (const float*)(a.ws + WS_SMALL);
    bf16_t* CC = (bf16_t*)(a.ws + WS_CC); float* acum = (float*)(a.ws + WS_ACUM); float* cdec = (float*)(a.ws + WS_CDEC);
    bf16_t* ydiag = (bf16_t*)(a.ws + WS_YDIAG); bf16_t* states = (bf16_t*)(a.ws + WS_STATES);
    LAS unsigned char* Bn = X.lds; LAS unsigned char* Cn = X.lds + 128 * SP; LAS unsigned char* BT = X.lds + 256 * SP;
    LAS unsigned char* xdT = X.lds; LAS unsigned char* xeT = X.lds + 64 * SP;
    LAS float* acL = (LAS float*)(X.lds + AUX_OFF); LAS float* dtL = acL + 8 * 128;
    const int lane = X.lane, wave = X.wave, r16 = lane & 15, q4 = lane >> 4;
    for (int unit = X.bid - wg0; unit < NB * 32 * 2; unit += X.G - wg0) {
        const int g = unit & 1, c = (unit >> 1) & 31, b = unit >> 6; const size_t t0 = (size_t)b * SEQ + 128 * c;
        __syncthreads();
        {
            const int hd = g * 8 + wave; const float an = -__expf(a.ssd_a_log[hd]), bias = a.ssd_dt_bias[hd];
            const float d0 = softplusf(small[(t0 + lane) * 32 + 16 + hd] + bias), d1 = softplusf(small[(t0 + 64 + lane) * 32 + 16 + hd] + bias);
            float s0 = d0 * an, s1 = d1 * an;
#pragma unroll
            for (int o = 1; o < 64; o <<= 1) { const float v0 = __shfl_up(s0, o), v1 = __shfl_up(s1, o); if (lane >= o) { s0 += v0; s1 += v1; } }
            s1 += __shfl(s0, 63);
            acL[wave * 128 + lane] = s0; acL[wave * 128 + 64 + lane] = s1; dtL[wave * 128 + lane] = d0; dtL[wave * 128 + 64 + lane] = d1;
            acum[((size_t)g * T + t0 + lane) * 8 + wave] = s0; acum[((size_t)g * T + t0 + 64 + lane) * 8 + wave] = s1;
            if (lane == 63) cdec[(size_t)unit * 32 + wave] = __expf(s1);
        }
        {
            const int isC = lane >> 5, cc = (lane & 31) * 4, col = 1024 + isC * 256 + g * 128 + cc;
            float w[4][4], bs[4];
#pragma unroll
            for (int i = 0; i < 4; ++i) { const f32x4 t = *(const f32x4*)(a.ssd_conv_w + i * 1536 + col); w[i][0] = t[0]; w[i][1] = t[1]; w[i][2] = t[2]; w[i][3] = t[3]; }
            { const f32x4 t = *(const f32x4*)(a.ssd_conv_b + col); bs[0] = t[0]; bs[1] = t[1]; bs[2] = t[2]; bs[3] = t[3]; }
            float xin[19][4];
#pragma unroll
            for (int i = 0; i < 19; ++i) { const int tk = 16 * wave + i - 3; const bool ok = (128 * c + tk) >= 0; u32x2 v = {0u, 0u}; if (ok) v = *(const u32x2*)(xbcpre + (t0 + tk) * 1536 + col);
                xin[i][0] = __uint_as_float(v.x << 16); xin[i][1] = __uint_as_float(v.x & 0xFFFF0000u); xin[i][2] = __uint_as_float(v.y << 16); xin[i][3] = __uint_as_float(v.y & 0xFFFF0000u); }
            unsigned short ov[16][4];
#pragma unroll
            for (int i = 0; i < 16; ++i)
#pragma unroll
                for (int e = 0; e < 4; ++e) { const float s = bs[e] + w[0][e] * xin[i][e] + w[1][e] * xin[i + 1][e] + w[2][e] * xin[i + 2][e] + w[3][e] * xin[i + 3][e]; ov[i][e] = (unsigned short)f2bf(siluf(s)); }
            LAS unsigned char* nat = isC ? Cn : Bn;
#pragma unroll
            for (int i = 0; i < 16; ++i) { const u32x2 pk = {(unsigned)ov[i][0] | ((unsigned)ov[i][1] << 16), (unsigned)ov[i][2] | ((unsigned)ov[i][3] << 16)};
                *(LAS u32x2*)(nat + (16 * wave + i) * SP + cc * 2) = pk;
                if (isC) *(u32x2*)(CC + (t0 + 16 * wave + i) * 256 + g * 128 + cc) = pk; }
            if (!isC) {
#pragma unroll
                for (int e = 0; e < 4; ++e)
#pragma unroll
                    for (int qq = 0; qq < 4; ++qq) { const u32x2 pk = {(unsigned)ov[4 * qq][e] | ((unsigned)ov[4 * qq + 1][e] << 16), (unsigned)ov[4 * qq + 2][e] | ((unsigned)ov[4 * qq + 3][e] << 16)};
                        *(LAS u32x2*)(BT + (cc + e) * SP + (32 * (wave >> 1) + 8 * qq + 4 * (wave & 1)) * 2) = pk; }
            }
        }
        __syncthreads();
        f32x4 cbt[8];
        {
            bf16x8 cf[4];
#pragma unroll
            for (int ks = 0; ks < 4; ++ks) cf[ks] = *(const LAS bf16x8*)(Cn + (16 * wave + r16) * SP + (32 * ks + 8 * q4) * 2);
#pragma unroll
            for (int st = 0; st < 8; ++st) { cbt[st] = (f32x4){0.f, 0.f, 0.f, 0.f};
#pragma unroll
                for (int ks = 0; ks < 4; ++ks) { const bf16x8 bf = *(const LAS bf16x8*)(Bn + (16 * st + r16) * SP + (32 * ks + 8 * q4) * 2); cbt[st] = __builtin_amdgcn_mfma_f32_16x16x32_bf16(bf, cf[ks], cbt[st], 0, 0, 0); } }
        }
        __syncthreads();
        const int lq = 16 * wave + r16;
        unsigned short xnx[19];
#define SSD_LOADX(hh) do { _Pragma("unroll") for (int _i = 0; _i < 19; ++_i) { const int _tk = 16 * wave + _i - 3; xnx[_i] = (128 * c + _tk) >= 0 ? xbcpre[(t0 + _tk) * 1536 + (hh) * 64 + lane] : (unsigned short)0; } } while (0)
        SSD_LOADX(g * 8);
        for (int r = 0; r < 8; ++r) {
            const int hd = g * 8 + r; const float dd = a.ssd_d[hd];
            {
                const int col = hd * 64 + lane; float w0 = a.ssd_conv_w[col], w1 = a.ssd_conv_w[1536 + col], w2 = a.ssd_conv_w[2 * 1536 + col], w3 = a.ssd_conv_w[3 * 1536 + col]; const float bs = a.ssd_conv_b[col];
                float xin[19];
#pragma unroll
                for (int i = 0; i < 19; ++i) xin[i] = bf2f(xnx[i]);
                if (r + 1 < 8) SSD_LOADX(hd + 1);
                const float aclast = acL[r * 128 + 127];
                unsigned short xd[16], xe[16];
#pragma unroll
                for (int i = 0; i < 16; ++i) { const float xv = siluf(bs + w0 * xin[i] + w1 * xin[i + 1] + w2 * xin[i + 2] + w3 * xin[i + 3]); const int tk = 16 * wave + i;
                    const float xdv = xv * dtL[r * 128 + tk]; xd[i] = (unsigned short)f2bf(xdv); xe[i] = (unsigned short)f2bf(xdv * __expf(aclast - acL[r * 128 + tk])); }
#pragma unroll
                for (int qq = 0; qq < 4; ++qq) { const int pos = 32 * (wave >> 1) + 8 * qq + 4 * (wave & 1);
                    *(LAS u32x2*)(xdT + lane * SP + pos * 2) = (u32x2){(unsigned)xd[4 * qq] | ((unsigned)xd[4 * qq + 1] << 16), (unsigned)xd[4 * qq + 2] | ((unsigned)xd[4 * qq + 3] << 16)};
                    *(LAS u32x2*)(xeT + lane * SP + pos * 2) = (u32x2){(unsigned)xe[4 * qq] | ((unsigned)xe[4 * qq + 1] << 16), (unsigned)xe[4 * qq + 2] | ((unsigned)xe[4 * qq + 3] << 16)}; }
            }
            __syncthreads();
            {
                const float acl = acL[r * 128 + lq], ddt = dd * __builtin_amdgcn_rcpf(dtL[r * 128 + lq]);
                f32x4 yd[4];
#pragma unroll
                for (int pt = 0; pt < 4; ++pt) yd[pt] = (f32x4){0.f, 0.f, 0.f, 0.f};
#pragma unroll
                for (int ks = 0; ks < 4; ++ks) { if (ks <= (wave >> 1)) {
                    f32x4 mlo, mhi;
#pragma unroll
                    for (int e = 0; e < 4; ++e) {
                        const int s0 = 32 * ks + 4 * q4 + e, s1 = s0 + 16;
                        const float v0 = cbt[2 * ks][e], v1 = cbt[2 * ks + 1][e];
                        mlo[e] = s0 < lq ? v0 * __expf(acl - acL[r * 128 + s0]) : (s0 == lq ? v0 + ddt : 0.f);
                        mhi[e] = s1 < lq ? v1 * __expf(acl - acL[r * 128 + s1]) : (s1 == lq ? v1 + ddt : 0.f);
                    }
                    const bf16x8 mf = acc_to_frag(mlo, mhi);
#pragma unroll
                    for (int pt = 0; pt < 4; ++pt) { const bf16x8 xf = *(const LAS bf16x8*)(xdT + (16 * pt + r16) * SP + (32 * ks + 8 * q4) * 2); yd[pt] = __builtin_amdgcn_mfma_f32_16x16x32_bf16(xf, mf, yd[pt], 0, 0, 0); }
                } }
#pragma unroll
                for (int pt = 0; pt < 4; ++pt) *(u32x2*)(ydiag + (t0 + lq) * 1024 + hd * 64 + 16 * pt + 4 * q4) = (u32x2){pg8::cvt_pk_bf16(yd[pt][0], yd[pt][1]), pg8::cvt_pk_bf16(yd[pt][2], yd[pt][3])};
            }
            {
                bf16x8 bf[4];
#pragma unroll
                for (int ks = 0; ks < 4; ++ks) bf[ks] = *(const LAS bf16x8*)(BT + (16 * wave + r16) * SP + (32 * ks + 8 * q4) * 2);
                bf16_t* hp = states + ((size_t)(unit * 8 + r) * 64) * 128;
#pragma unroll
                for (int pt = 0; pt < 4; ++pt) { f32x4 st = {0.f, 0.f, 0.f, 0.f};
#pragma unroll
                    for (int ks = 0; ks < 4; ++ks) { const bf16x8 xf = *(const LAS bf16x8*)(xeT + (16 * pt + r16) * SP + (32 * ks + 8 * q4) * 2); st = __builtin_amdgcn_mfma_f32_16x16x32_bf16(bf[ks], xf, st, 0, 0, 0); }
                    *(u32x2*)(hp + (size_t)(16 * pt + r16) * 128 + 16 * wave + 4 * q4) = (u32x2){pg8::cvt_pk_bf16(st[0], st[1]), pg8::cvt_pk_bf16(st[2], st[3])}; }
            }
            __syncthreads();
        }
    }
}
DEV void ph_ssd_scan(const Args& a, const Ctx& X, const int wg0) {
    bf16_t* states = (bf16_t*)(a.ws + WS_STATES); const float* cdec = (const float*)(a.ws + WS_CDEC);
    for (int task = (X.bid - wg0) * NTHR + X.tid; task < NB * 16 * 64 * 32; task += (X.G - wg0) * NTHR) {
        const int n4 = task & 31, p = (task >> 5) & 63, hd = (task >> 11) & 15, b = task >> 15;
        bf16_t* base = states + ((size_t)(((b * 32) * 2 + (hd >> 3)) * 8 + (hd & 7)) * 64 + p) * 128 + 4 * n4;
        const float* dbase = cdec + (size_t)((b * 32) * 2 + (hd >> 3)) * 32 + (hd & 7);
        u32x2 sv[32]; float dec[32];
#pragma unroll
        for (int c = 0; c < 32; ++c) { sv[c] = *(const u32x2*)(base + (size_t)c * 131072); dec[c] = dbase[c * 64]; }
        float h0 = 0.f, h1 = 0.f, h2 = 0.f, h3 = 0.f;
#pragma unroll
        for (int c = 0; c < 32; ++c) {
            *(u32x2*)(base + (size_t)c * 131072) = (u32x2){pk2(h0, h1), pk2(h2, h3)};
            h0 = h0 * dec[c] + __uint_as_float(sv[c].x << 16); h1 = h1 * dec[c] + __uint_as_float(sv[c].x & 0xFFFF0000u); h2 = h2 * dec[c] + __uint_as_float(sv[c].y << 16); h3 = h3 * dec[c] + __uint_as_float(sv[c].y & 0xFFFF0000u);
        }
    }
}
DEV void ph_ssd_out(const Args& a, const Ctx& X, const int wg0, const int rot) {
    const bf16_t* CC = (const bf16_t*)(a.ws + WS_CC); const float* acum = (const float*)(a.ws + WS_ACUM); const bf16_t* ydiag = (const bf16_t*)(a.ws + WS_YDIAG);
    const bf16_t* states = (const bf16_t*)(a.ws + WS_STATES); const bf16_t* zb = (const bf16_t*)(a.ws + WS_ZB); bf16_t* oy = (bf16_t*)(a.ws + WS_OY);
    const int lane = X.lane, wave = X.wave, r16 = lane & 15, q4 = lane >> 4;
    for (int unit = (X.bid - wg0 + rot) % (X.G - wg0); unit < NB * 32 * 2; unit += X.G - wg0) {
        const int g = unit & 1, c = (unit >> 1) & 31, b = unit >> 6; const size_t t = (size_t)b * SEQ + 128 * c + 16 * wave + r16;
        bf16x8 cf[4];
#pragma unroll
        for (int ks = 0; ks < 4; ++ks) cf[ks] = *(const bf16x8*)(CC + t * 256 + g * 128 + 32 * ks + 8 * q4);
        float ss = 0.f;
        LAS u32x2* stash = (LAS u32x2*)(X.lds + wave * 16384);
#define SO_LOAD(rr, HF, YD, ZZ, EA) do { const bf16_t* hp_ = states + ((size_t)(unit * 8 + (rr)) * 64) * 128; const int hd_ = g * 8 + (rr); \
            EA = acum[((size_t)g * T + t) * 8 + (rr)]; \
            _Pragma("unroll") for (int pt = 0; pt < 4; ++pt) { _Pragma("unroll") for (int ks = 0; ks < 4; ++ks) HF[pt][ks] = *(const bf16x8*)(hp_ + (size_t)(16 * pt + r16) * 128 + 32 * ks + 8 * q4); \
                YD[pt] = *(const u32x2*)(ydiag + t * 1024 + hd_ * 64 + 16 * pt + 4 * q4); ZZ[pt] = *(const u32x2*)(zb + t * 1024 + hd_ * 64 + 16 * pt + 4 * q4); } } while (0)
#define SO_COMP(rr, HF, YD, ZZ, EA) do { const float eac = __expf(EA); \
            _Pragma("unroll") for (int pt = 0; pt < 4; ++pt) { f32x4 acc = {0.f, 0.f, 0.f, 0.f}; \
                _Pragma("unroll") for (int ks = 0; ks < 4; ++ks) acc = __builtin_amdgcn_mfma_f32_16x16x32_bf16(HF[pt][ks], cf[ks], acc, 0, 0, 0); \
                const u32x2 yd = YD[pt], zz = ZZ[pt]; \
                f32x4 v; v[0] = acc[0] * eac + __uint_as_float(yd.x << 16); v[1] = acc[1] * eac + __uint_as_float(yd.x & 0xFFFF0000u); v[2] = acc[2] * eac + __uint_as_float(yd.y << 16); v[3] = acc[3] * eac + __uint_as_float(yd.y & 0xFFFF0000u); \
                v[0] *= siluf(__uint_as_float(zz.x << 16)); v[1] *= siluf(__uint_as_float(zz.x & 0xFFFF0000u)); v[2] *= siluf(__uint_as_float(zz.y << 16)); v[3] *= siluf(__uint_as_float(zz.y & 0xFFFF0000u)); \
                ss += v[0] * v[0] + v[1] * v[1] + v[2] * v[2] + v[3] * v[3]; \
                stash[((rr) * 4 + pt) * 64 + lane] = (u32x2){pg8::cvt_pk_bf16(v[0], v[1]), pg8::cvt_pk_bf16(v[2], v[3])}; } } while (0)
        bf16x8 hfA[4][4], hfB[4][4]; u32x2 ydA[4], zzA[4], ydB[4], zzB[4]; float eaA, eaB;
        SO_LOAD(0, hfA, ydA, zzA, eaA);
        for (int r = 0; r < 8; r += 2) {
            SO_LOAD(r + 1, hfB, ydB, zzB, eaB);
            SO_COMP(r, hfA, ydA, zzA, eaA);
            if (r + 2 < 8) SO_LOAD(r + 2, hfA, ydA, zzA, eaA);
            SO_COMP(r + 1, hfB, ydB, zzB, eaB);
        }
#undef SO_LOAD
#undef SO_COMP
        ss += __shfl_xor(ss, 16); ss += __shfl_xor(ss, 32);
        const float rstd = rsqrtf(ss * (1.f / 512.f) + EPS);
#pragma unroll 2
        for (int r = 0; r < 8; ++r)
#pragma unroll
            for (int pt = 0; pt < 4; ++pt) { const int cix = g * 512 + r * 64 + 16 * pt + 4 * q4; const f32x4 nw = *(const f32x4*)(a.ssd_norm_w + cix); const u32x2 w = stash[(r * 4 + pt) * 64 + lane];
                *(u32x2*)(oy + t * 2048 + 1024 + cix) = (u32x2){pg8::cvt_pk_bf16(__uint_as_float(w.x << 16) * rstd * nw[0], __uint_as_float(w.x & 0xFFFF0000u) * rstd * nw[1]), pg8::cvt_pk_bf16(__uint_as_float(w.y << 16) * rstd * nw[2], __uint_as_float(w.y & 0xFFFF0000u) * rstd * nw[3])}; }
    }
}


DEV int att_key(int tl) { return (tl ^ (tl >> 4)) & 15; }
template <bool PAIR, bool FIRST>
DEV void att_task(const bf16_t* qkv, LAS unsigned char* vl, LAS unsigned char* kl, LAS unsigned char* OL, LAS float* LSEL, const int b, const int hd, const int d, const int r, const int I0, const int tok_base) {
    int lane; asm volatile("v_mbcnt_lo_u32_b32 %0, -1, 0\n\tv_mbcnt_hi_u32_b32 %0, -1, %0" : "=v"(lane));
    const int q = lane & 31, h5 = lane >> 5;
    const int tr_off = ((lane & 15) >> 2) * 192 + (16 * ((lane >> 4) & 1) + 4 * (lane & 3)) * 2;
    const int prow = lane >> 3, pch = lane & 7;
#define ATT_LOAD(dst, j0_, coff) do { _Pragma("unroll") for (int _i = 0; _i < 4; ++_i) { const size_t _t = (size_t)b * SEQ + (size_t)((j0_) + 8 * _i + prow) * d + r; \
        dst[_i] = *(const u32x4*)(qkv + _t * 3072 + (coff) + hd * 64 + pch * 8); } } while (0)
    u32x4 k0[4], v0[4], k1[4], v1[4];
    const bool e4 = I0 >= 0, e3 = (I0 - 32) >= 0, e2 = (I0 - 64) >= 0, e1 = (I0 - 96) >= 0, e0 = (I0 - 128) >= 0;
    bf16x8 qA[4], qB[4];
    if constexpr (PAIR) {
        ATT_LOAD(k0, I0, 0);
#pragma unroll
        for (int i = 0; i < 4; ++i) *(LAS u32x4*)(kl + (8 * i + prow) * 144 + pch * 16) = k0[i];
#pragma unroll
        for (int s = 0; s < 4; ++s) qA[s] = *(const LAS bf16x8*)(kl + q * 144 + (16 * s + 8 * h5) * 2);
        LDS_WAIT();
    }
    ATT_LOAD(k1, I0 + 32, 0);
#pragma unroll
    for (int i = 0; i < 4; ++i) *(LAS u32x4*)(kl + (8 * i + prow) * 144 + pch * 16) = k1[i];
#pragma unroll
    for (int s = 0; s < 4; ++s) qB[s] = *(const LAS bf16x8*)(kl + q * 144 + (16 * s + 8 * h5) * 2);
    LDS_WAIT();
    ATT_LOAD(k0, I0 + 32, 1024); ATT_LOAD(v0, I0 + 32, 2048);
    if (PAIR || e4) { ATT_LOAD(k1, I0, 1024); ATT_LOAD(v1, I0, 2048); }
    f32x16 oA[2], oB[2];
#pragma unroll
    for (int i = 0; i < 16; ++i) { oA[0][i] = 0.f; oA[1][i] = 0.f; oB[0][i] = 0.f; oB[1][i] = 0.f; }
    float mA = -1e30f, lA = 0.f, mB = -1e30f, lB = 0.f;
    auto scores = [&](const bf16x8 (&kf)[4], const bf16x8 (&qf)[4], f32x16 (&oacc)[2], float& m, float& l, const int mode, bf16x8 (&pf)[2]) {
        f32x16 sacc;
#pragma unroll
        for (int i = 0; i < 16; ++i) sacc[i] = 0.f;
#pragma unroll
        for (int s = 0; s < 4; ++s) sacc = __builtin_amdgcn_mfma_f32_32x32x16_bf16(kf[s], qf[s], sacc, 0, 0, 0);
        if (mode == 1) {
#pragma unroll
            for (int i = 0; i < 16; ++i) { const int kl_ = (i & 3) + 8 * (i >> 2) + 4 * h5; if (kl_ > q) sacc[i] = -1e30f; }
        } else if (mode == 2) {
#pragma unroll
            for (int i = 0; i < 16; ++i) { const int kl_ = (i & 3) + 8 * (i >> 2) + 4 * h5; if (kl_ < q) sacc[i] = -1e30f; }
        }
        float mx = sacc[0];
#pragma unroll
        for (int i = 1; i < 16; ++i) mx = fmaxf(mx, sacc[i]);
        mx = fmaxf(mx, __shfl_xor(mx, 32));
        const float mn = fmaxf(m, mx), alpha = __expf(m - mn);
        float rs = 0.f;
#pragma unroll
        for (int i = 0; i < 16; ++i) { sacc[i] = __expf(sacc[i] - mn); rs += sacc[i]; }
        rs += __shfl_xor(rs, 32);
        l = l * alpha + rs; m = mn;
#pragma unroll
        for (int i = 0; i < 16; ++i) { oacc[0][i] *= alpha; oacc[1][i] *= alpha; }
#pragma unroll
        for (int s = 0; s < 2; ++s) { u32x4 w; w.x = pg8::cvt_pk_bf16(sacc[8 * s], sacc[8 * s + 1]); w.y = pg8::cvt_pk_bf16(sacc[8 * s + 2], sacc[8 * s + 3]); w.z = pg8::cvt_pk_bf16(sacc[8 * s + 4], sacc[8 * s + 5]); w.w = pg8::cvt_pk_bf16(sacc[8 * s + 6], sacc[8 * s + 7]);
            pf[s] = __builtin_bit_cast(bf16x8, w); }
    };
    auto tile = [&](const u32x4 (&kp)[4], const u32x4 (&vp)[4], const int ma, const int mb) {
#pragma unroll
        for (int i = 0; i < 4; ++i) { *(LAS u32x4*)(kl + (8 * i + prow) * 144 + pch * 16) = kp[i]; *(LAS u32x4*)(vl + (8 * i + prow) * 192 + pch * 16) = vp[i]; }
        bf16x8 kf[4];
#pragma unroll
        for (int s = 0; s < 4; ++s) kf[s] = *(const LAS bf16x8*)(kl + q * 144 + (16 * s + 8 * h5) * 2);
        bf16x8 pA[2], pB[2];
        if (ma >= 0) scores(kf, qA, oA, mA, lA, ma, pA);
        if (mb >= 0) scores(kf, qB, oB, mB, lB, mb, pB);
#pragma unroll
        for (int dt = 0; dt < 2; ++dt)
#pragma unroll
            for (int s = 0; s < 2; ++s) {
                const s16x4 t0_ = __builtin_amdgcn_ds_read_tr16_b64_v4i16((LAS s16x4*)(vl + (16 * s + 4 * h5) * 192 + dt * 64 + tr_off));
                const s16x4 t1_ = __builtin_amdgcn_ds_read_tr16_b64_v4i16((LAS s16x4*)(vl + (16 * s + 8 + 4 * h5) * 192 + dt * 64 + tr_off));
                bf16x8 vf; vf[0] = t0_[0]; vf[1] = t0_[1]; vf[2] = t0_[2]; vf[3] = t0_[3]; vf[4] = t1_[0]; vf[5] = t1_[1]; vf[6] = t1_[2]; vf[7] = t1_[3];
                if (ma >= 0) oA[dt] = __builtin_amdgcn_mfma_f32_32x32x16_bf16(vf, pA[s], oA[dt], 0, 0, 0);
                if (mb >= 0) oB[dt] = __builtin_amdgcn_mfma_f32_32x32x16_bf16(vf, pB[s], oB[dt], 0, 0, 0);
            }
        LDS_WAIT();
    };
    constexpr int MA_C = PAIR ? 1 : -1, MA_F = PAIR ? 0 : -1;
    tile(k0, v0, -1, 1);
    if (PAIR || e4) {
        if (e3) { ATT_LOAD(k0, I0 - 32, 1024); ATT_LOAD(v0, I0 - 32, 2048); }
        tile(k1, v1, MA_C, 0);
        if (e3) {
            if (e2) { ATT_LOAD(k1, I0 - 64, 1024); ATT_LOAD(v1, I0 - 64, 2048); }
            tile(k0, v0, MA_F, 0);
            if (e2) {
                if (e1) { ATT_LOAD(k0, I0 - 96, 1024); ATT_LOAD(v0, I0 - 96, 2048); }
                tile(k1, v1, MA_F, 0);
                if (e1) {
                    if (PAIR && e0) { ATT_LOAD(k1, I0 - 128, 1024); ATT_LOAD(v1, I0 - 128, 2048); }
                    tile(k0, v0, MA_F, 2);
                    if constexpr (PAIR) { if (e0) tile(k1, v1, 2, -1); }
                }
            }
        }
    }
#undef ATT_LOAD
#pragma unroll
    for (int qt = PAIR ? 0 : 1; qt < 2; ++qt) {
        int tl = (I0 + 32 * qt + q) * d + r - tok_base; asm volatile("" : "+v"(tl));
        const int key = att_key(tl);
        const float l = qt ? lB : lA, m = qt ? mB : mA; const float lse = m + __logf(l);
        float wo = 0.f, wn = __builtin_amdgcn_rcpf(l);
        if constexpr (!FIRST) { const float lo = LSEL[tl], mx = fmaxf(lo, lse), a0 = __expf(lo - mx), a1 = __expf(lse - mx), wi = __builtin_amdgcn_rcpf(a0 + a1); wo = a0 * wi; wn *= a1 * wi;
            if (h5 == 0) LSEL[tl] = mx + __logf(a0 + a1); }
        else { if (h5 == 0) LSEL[tl] = lse; }
#pragma unroll
        for (int dt = 0; dt < 2; ++dt)
#pragma unroll
            for (int gq = 0; gq < 4; ++gq) { const f32x16& oo = qt ? oB[dt] : oA[dt];
                LAS u32x2* p = (LAS u32x2*)(OL + tl * 128 + (((8 * dt + 2 * gq + h5) ^ key) << 3));
                float f0 = oo[4 * gq] * wn, f1 = oo[4 * gq + 1] * wn, f2 = oo[4 * gq + 2] * wn, f3 = oo[4 * gq + 3] * wn;
                if constexpr (!FIRST) { const u32x2 w = *p; f0 += wo * __uint_as_float(w.x << 16); f1 += wo * __uint_as_float(w.x & 0xFFFF0000u); f2 += wo * __uint_as_float(w.y << 16); f3 += wo * __uint_as_float(w.y & 0xFFFF0000u); }
                *p = (u32x2){pg8::cvt_pk_bf16(f0, f1), pg8::cvt_pk_bf16(f2, f3)}; }
    }
}
DEV void ph_attn(const Args& a, const Ctx& X) {
    const bf16_t* qkv = (const bf16_t*)(a.ws + WS_Q1KV); unsigned char* o = a.ws + WS_O1;
    LAS unsigned char* vl = X.lds + X.wave * 10752;
    LAS unsigned char* kl = vl + 6144;
    LAS unsigned char* OL = X.lds + 86016; LAS float* LSEL = (LAS float*)(X.lds + 86016 + 65536);
    const int wave = X.wave;
    for (int unit = X.bid; unit < NB * 16 * 8; unit += X.G) {
        const int bhd = unit & 63, b = bhd >> 4, hd = bhd & 15, g = unit >> 6;
        const int tb = 512 * g;
        att_task<true, true>(qkv, vl, kl, OL, LSEL, b, hd, 1, 0, 512 * g + 64 * wave, tb);
        __syncthreads();
        att_task<true, false>(qkv, vl, kl, OL, LSEL, b, hd, 4, wave & 3, 128 * g + 64 * (wave >> 2), tb);
        __syncthreads();
        for (int j = 0; j < 2; ++j) att_task<false, false>(qkv, vl, kl, OL, LSEL, b, hd, 16, 2 * wave + j, 32 * g - 32, tb);
        __syncthreads();
        {
            int tl; asm volatile("v_mbcnt_lo_u32_b32 %0, -1, 0\n\tv_mbcnt_hi_u32_b32 %0, -1, %0" : "=v"(tl)); tl += 64 * wave; const int key = att_key(tl); u32x4 yq[4];
#pragma unroll
            for (int p = 0; p < 16; p += 2) { const u32x2 w0 = *(const LAS u32x2*)(OL + tl * 128 + ((p ^ key) << 3)), w1 = *(const LAS u32x2*)(OL + tl * 128 + (((p + 1) ^ key) << 3));
                float f[8] = {__uint_as_float(w0.x << 16), __uint_as_float(w0.x & 0xFFFF0000u), __uint_as_float(w0.y << 16), __uint_as_float(w0.y & 0xFFFF0000u), __uint_as_float(w1.x << 16), __uint_as_float(w1.x & 0xFFFF0000u), __uint_as_float(w1.y << 16), __uint_as_float(w1.y & 0xFFFF0000u)};
#pragma unroll
                for (int e = 0; e < 8; ++e) f[e] = __builtin_amdgcn_fmed3f(f[e] * 4.f, -440.f, 440.f);
                int v0 = __builtin_amdgcn_cvt_pk_fp8_f32(f[0], f[1], 0, false); v0 = __builtin_amdgcn_cvt_pk_fp8_f32(f[2], f[3], v0, true);
                int v1 = __builtin_amdgcn_cvt_pk_fp8_f32(f[4], f[5], 0, false); v1 = __builtin_amdgcn_cvt_pk_fp8_f32(f[6], f[7], v1, true);
                yq[p >> 2][p & 2] = (unsigned)v0; yq[p >> 2][(p & 2) + 1] = (unsigned)v1; }
            unsigned char* orow = o + ((size_t)b * SEQ + tb + tl) * 1024 + hd * 64;
#pragma unroll
            for (int j = 0; j < 4; ++j) *(u32x4*)(orow + 16 * j) = yq[j];
        }
        __syncthreads();
    }
}

DEV void ph_router(const Args& a, const Ctx& X, const int l) {
    unsigned char* ws = a.ws;
    const float* mod = (const float*)(ws + WS_MOD) + (size_t)l * NB * 6 * D;
    const bf16_t* ymix = (const bf16_t*)(ws + WS_YMIX);
    bf16_t* xb = (bf16_t*)(ws + WS_XB);
    bf16_t* hb = (bf16_t*)(ws + WS_H);
    int* idx = (int*)(ws + WS_IDX); float* gw = (float*)(ws + WS_GW); int* aslot = (int*)(ws + WS_ASLOT); int* ltok = (int*)(ws + WS_LTOK);
    int* cntg = (int*)(ws + WS_CTL + CTL_CNT) + l * NE;
    const float* rw = a.router_w + (size_t)l * D * NE; const float* rbias = a.router_bias + l * NE;
    constexpr int HP = 2064;
    LAS unsigned char* hL = X.lds;
    LAS float* logit = (LAS float*)(X.lds + AUX_OFF + 2048);
    LAS int* lcnt = (LAS int*)(X.lds + AUX_OFF + 2048 + 64 * 65 * 4);
    LAS int* lbase = lcnt + 64;
    LAS int* sel_e = lbase + 64;
    LAS int* sel_s = sel_e + 512;
    const int lane = X.lane, wave = X.wave;
    for (int rb = X.bid; rb < T / 64; rb += X.G) {
        if (X.tid < 64) lcnt[X.tid] = 0;
        f32x4 xf_n[4]; u32x2 xb_n[4], ym_n[4];
#define RT_LOAD(rr) do { const int _row = rb * 64 + wave * 8 + (rr); _Pragma("unroll") for (int _j = 0; _j < 4; ++_j) { \
            if (l == 0) xf_n[_j] = *(const f32x4*)(a.x + (size_t)_row * D + _j * 256 + lane * 4); else xb_n[_j] = *(const u32x2*)(xb + (size_t)_row * D + _j * 256 + lane * 4); \
            ym_n[_j] = *(const u32x2*)(ymix + (size_t)_row * D + _j * 256 + lane * 4); } } while (0)
        RT_LOAD(0);
        for (int r8 = 0; r8 < 8; ++r8) {
            const int lr = wave * 8 + r8, row = rb * 64 + lr, b = row / SEQ; const float* ml = mod + (size_t)b * 6 * D;
            float xv[16], yv[16];
#pragma unroll
            for (int j = 0; j < 4; ++j) {
                if (l == 0) { xv[4 * j] = xf_n[j][0]; xv[4 * j + 1] = xf_n[j][1]; xv[4 * j + 2] = xf_n[j][2]; xv[4 * j + 3] = xf_n[j][3]; }
                else { xv[4 * j] = __uint_as_float(xb_n[j].x << 16); xv[4 * j + 1] = __uint_as_float(xb_n[j].x & 0xFFFF0000u); xv[4 * j + 2] = __uint_as_float(xb_n[j].y << 16); xv[4 * j + 3] = __uint_as_float(xb_n[j].y & 0xFFFF0000u); }
                yv[4 * j] = __uint_as_float(ym_n[j].x << 16); yv[4 * j + 1] = __uint_as_float(ym_n[j].x & 0xFFFF0000u); yv[4 * j + 2] = __uint_as_float(ym_n[j].y << 16); yv[4 * j + 3] = __uint_as_float(ym_n[j].y & 0xFFFF0000u); }
            if (r8 + 1 < 8) RT_LOAD(r8 + 1);
            resid_update(xv, yv, a.mix_post_g + l * D, ml + 2 * D, lane);
            store_row_bf(xb + (size_t)row * D, lane, xv);
            u32x2 o[4]; prenorm_pack(xv, a.ffn_pre_g + l * D, ml + 4 * D, ml + 3 * D, lane, o);
#pragma unroll
            for (int j = 0; j < 4; ++j) { *(LAS u32x2*)(hL + lr * HP + (j * 256 + lane * 4) * 2) = o[j];
                const float h0 = __uint_as_float(o[j].x << 16), h1 = __uint_as_float(o[j].x & 0xFFFF0000u), h2 = __uint_as_float(o[j].y << 16), h3 = __uint_as_float(o[j].y & 0xFFFF0000u);
                int w = __builtin_amdgcn_cvt_pk_fp8_f32(__builtin_amdgcn_fmed3f(h0, -440.f, 440.f), __builtin_amdgcn_fmed3f(h1, -440.f, 440.f), 0, false); w = __builtin_amdgcn_cvt_pk_fp8_f32(__builtin_amdgcn_fmed3f(h2, -440.f, 440.f), __builtin_amdgcn_fmed3f(h3, -440.f, 440.f), w, true);
                *(unsigned*)((unsigned char*)hb + (size_t)row * D + j * 256 + lane * 4) = (unsigned)w; }
        }
#undef RT_LOAD
        __syncthreads();
        { const int rt = wave & 3, nh = wave >> 2, r16 = lane & 15, kq = lane >> 4;
          f32x4 acc0 = {0.f, 0.f, 0.f, 0.f}, acc1 = {0.f, 0.f, 0.f, 0.f};
          for (int c = 0; c < 32; ++c) {
              const u32x4 hv = *(const LAS u32x4*)(hL + (rt * 16 + r16) * HP + (32 * c + 8 * kq) * 2);
              const float* rp = rw + (size_t)(32 * c + 8 * kq) * NE + 4 * r16 + 2 * nh;
#pragma unroll
              for (int j = 0; j < 8; ++j) { const unsigned wj = hv[j >> 1]; const float av = (j & 1) ? __uint_as_float(wj & 0xFFFF0000u) : __uint_as_float(wj << 16);
                  const f32x2 bv = *(const f32x2*)(rp + (size_t)j * NE);
                  acc0 = __builtin_amdgcn_mfma_f32_16x16x4f32(av, bv.x, acc0, 0, 0, 0); acc1 = __builtin_amdgcn_mfma_f32_16x16x4f32(av, bv.y, acc1, 0, 0, 0); }
          }
#pragma unroll
          for (int r = 0; r < 4; ++r) { logit[(rt * 16 + 4 * kq + r) * 65 + 4 * r16 + 2 * nh] = acc0[r]; logit[(rt * 16 + 4 * kq + r) * 65 + 4 * r16 + 2 * nh + 1] = acc1[r]; } }
        __syncthreads();
        for (int r8 = 0; r8 < 8; ++r8) {
            const int lr = wave * 8 + r8, t = rb * 64 + lr;
            float lgt = logit[lr * 65 + lane]; if (!(lgt > -1e30f && lgt < 1e30f)) lgt = 0.f;
            const float score = sigmoidf_(lgt), biased = score + rbias[lane];
            const float m1 = max8(biased);
            const int c1 = min8((biased == m1) ? (lane & 7) : 8);
            const float m2 = max8(((lane & 7) == c1) ? -INFINITY : biased);
            const float gs = m1 + m2; const int myg = lane >> 3; int grank = 0;
#pragma unroll
            for (int g2 = 0; g2 < 8; ++g2) { const float o = rlf(gs, g2 * 8); grank += (o > gs || (o == gs && g2 < myg)) ? 1 : 0; }
            const float cand = (grank < 4) ? biased : -INFINITY; int rank = 0;
#pragma unroll 8
            for (int e2 = 0; e2 < 64; ++e2) { const float o = rlf(cand, e2); rank += (o > cand || (o == cand && e2 < lane)) ? 1 : 0; }
            const bool sel = (rank < TOPK) && (grank < 4);
            const float ssum = wave_sum(sel ? score : 0.f);
            if (sel) { idx[t * 8 + rank] = lane; gw[t * 8 + rank] = score * __builtin_amdgcn_rcpf(ssum) * 2.5f; sel_e[lr * 8 + rank] = lane; sel_s[lr * 8 + rank] = __hip_atomic_fetch_add(lcnt + lane, 1, __ATOMIC_RELAXED, __HIP_MEMORY_SCOPE_WORKGROUP); }
        }
        __syncthreads();
        if (X.tid < 64) { const int n = lcnt[X.tid]; lbase[X.tid] = n ? atomicAdd(cntg + X.tid, n) : 0; }
        __syncthreads();
        { const int lr = X.tid >> 3, k = X.tid & 7, t = rb * 64 + lr, e = sel_e[lr * 8 + k], sl = lbase[e] + sel_s[lr * 8 + k];
          aslot[t * 8 + k] = sl; ltok[e * CAP + sl] = t; }
        __syncthreads();
    }
}
template <int NW>
DEV void ph_moe_conv(const Args& a, const Ctx& X, const int l, const int widx, const int nwg, const int it0, const int it1) {
    unsigned char* ws = a.ws;
    if (X.wave >= NW) return;
    { LAS float* scr = (LAS float*)(X.lds + X.wave * 8704);
      const int gwv = widx * NW + X.wave, NGW = nwg * NW;
      constexpr int I_GU = (D / 64) * (512 / 32), I_D = (ED / 64) * (D / 32), I_E = I_GU + I_D;
      const float* eg = a.exp_gate + (size_t)l * NE * D * ED; const float* eu = a.exp_up + (size_t)l * NE * D * ED; const float* ed = a.exp_down + (size_t)l * NE * ED * D;
      const int itend = it1 < 0 ? (NE + 1) * I_E : it1;
      for (int it = it0 + gwv; it < itend; it += NGW) {
          const int e = it / I_E; int r = it - e * I_E;
          if (e < NE) {
              if (r < I_GU) conv_item<SrcGU, true>(SrcGU{eg + (size_t)e * D * ED, (long)(eu - eg)}, ED, D, ws + WS_WGU + (size_t)e * 512 * D, scr, r, 16, X.lane, 64.f);
              else conv_item<SrcIdent, true>(SrcIdent{ed + (size_t)e * ED * D}, D, ED, ws + WS_WD + (size_t)e * D * ED, scr, r - I_GU, D / 32, X.lane, 32.f);
          } else {
              if (r < I_GU) conv_item<SrcGU, true>(SrcGU{a.sh_gate + (size_t)l * D * ED, (long)(a.sh_up - a.sh_gate)}, ED, D, ws + WS_WGUS, scr, r, 16, X.lane, 64.f);
              else conv_item<SrcIdent, true>(SrcIdent{a.sh_down + (size_t)l * ED * D}, D, ED, ws + WS_WDS, scr, r - I_GU, D / 32, X.lane, 32.f);
          }
      } }
}

DEV int moe_tables(const Args& a, const Ctx& X, const int l, LAS int* t_cnt, LAS int* t_rb0, LAS int* t_eofrb) {
    const int* cntg = (const int*)(a.ws + WS_CTL + CTL_CNT) + l * NE;
    if (X.wave == 0) {
        const int c = __hip_atomic_load(cntg + X.lane, __ATOMIC_RELAXED, __HIP_MEMORY_SCOPE_AGENT), nrb = (c + 255) >> 8;
        int incl = nrb;
#pragma unroll
        for (int o = 1; o < 64; o <<= 1) { const int v = __shfl_up(incl, o); if (X.lane >= o) incl += v; }
        const int excl = incl - nrb;
        t_cnt[X.lane] = c; t_rb0[X.lane] = excl; if (X.lane == 63) t_rb0[64] = incl;
        for (int j = 0; j < nrb; ++j) t_eofrb[excl + j] = X.lane;
        t_eofrb[SH_RB + X.lane] = NE;
    }
    __syncthreads();
    return t_rb0[64];
}

DEV void ph_moe_gu(const Args& a, const Ctx& X, const int l) {
    LAS int* t_cnt = (LAS int*)(X.lds + AUX_OFF + 1024); LAS int* t_rb0 = t_cnt + 64; LAS int* t_eofrb = t_rb0 + 80; LAS int* toks = t_eofrb + NRB_ALL;
    const int nrbt = moe_tables(a, X, l, t_cnt, t_rb0, t_eofrb);
    const int* ltok = (const int*)(a.ws + WS_LTOK);
    pg8::Unit u;
    for (int i = 0; i < 8; ++i) { if (!pg8::moe_unit(i, 2, nrbt, X.G, X.bid, u)) break;
        if (X.tid < 256) { const int e = t_eofrb[u.pm]; int tok;
            if (e < NE) { const int sl = (u.pm - t_rb0[e]) * 256 + X.tid; tok = sl < t_cnt[e] ? ltok[e * CAP + sl] : 0; } else tok = (u.pm - SH_RB) * 256 + X.tid;
            toks[i * 256 + X.tid] = tok; } }
    VM_WAIT(); __syncthreads();
    pg8::SchedGU S{(const char*)(a.ws + WS_H), (const char*)(a.ws + WS_WGU), (const char*)(a.ws + WS_WGUS), t_eofrb, toks, nrbt, X.G, X.bid, 0};
    pg8::EpiGU E{a.ws + WS_HID};
    pg8::gemm_phase<pg8::EpiGU, pg8::SchedGU, true>(X.lds, D, S, E);
}
DEV void ph_moe_down(const Args& a, const Ctx& X, const int l) {
    LAS int* t_cnt = (LAS int*)(X.lds + AUX_OFF + 1024); LAS int* t_rb0 = t_cnt + 64; LAS int* t_eofrb = t_rb0 + 80;
    const int nrbt = moe_tables(a, X, l, t_cnt, t_rb0, t_eofrb);
    pg8::SchedDown S{(const char*)(a.ws + WS_HID), (const char*)(a.ws + WS_WD), (const char*)(a.ws + WS_WDS), t_eofrb, nrbt, X.G, X.bid, 0};
    pg8::EpiFp8 E{(unsigned char*)(a.ws + WS_Y), D, 0};
    int kd = ED; asm volatile("" : "+s"(kd));
    pg8::gemm_phase<pg8::EpiFp8, pg8::SchedDown, true>(X.lds, kd, S, E);
}
DEV void ph_combine(const Args& a, const Ctx& X, const int l) {
    LAS int* t_cnt = (LAS int*)(X.lds + AUX_OFF + 1024); LAS int* t_rb0 = t_cnt + 64; LAS int* t_eofrb = t_rb0 + 80;
    (void)moe_tables(a, X, l, t_cnt, t_rb0, t_eofrb);
    const float* mod = (const float*)(a.ws + WS_MOD);
    const int* idx = (const int*)(a.ws + WS_IDX); const float* gw = (const float*)(a.ws + WS_GW); const int* aslot = (const int*)(a.ws + WS_ASLOT);
    const unsigned char* y = a.ws + WS_Y; unsigned char* h8 = a.ws + WS_H;
    const int lane = X.lane;
    const int tstep = X.G * NWAVES;
    int t = X.bid * NWAVES + X.wave;
    int e_n = 0, s_n = 0; float g_n = 0.f;
    if (t < T && lane < 8) { e_n = idx[t * 8 + lane]; g_n = gw[t * 8 + lane]; s_n = aslot[t * 8 + lane]; }
    for (; t < T; t += tstep) {
        const int b = t / SEQ; const float* ml = mod + (size_t)(l * NB + b) * 6 * D;
        const int e_c = e_n, s_c = s_n; const float g_c = g_n;
        const int tn = t + tstep;
        if (tn < T && lane < 8) { e_n = idx[tn * 8 + lane]; g_n = gw[tn * 8 + lane]; s_n = aslot[tn * 8 + lane]; }
        u32x2 w0[9], w1[9];
        { const unsigned char* yr = y + ((size_t)SH_RB * 256 + t) * D; w0[8] = *(const u32x2*)(yr + 8 * lane); w1[8] = *(const u32x2*)(yr + 512 + 8 * lane); }
        float gk[8];
#pragma unroll
        for (int k = 0; k < 8; ++k) { const int e = rli(e_c, k), sl = rli(s_c, k); gk[k] = rlf(g_c, k);
            const unsigned char* yr = y + ((size_t)t_rb0[e] * 256 + sl) * D; w0[k] = *(const u32x2*)(yr + 8 * lane); w1[k] = *(const u32x2*)(yr + 512 + 8 * lane); }
        float xv[16]; load_row8_bf((const bf16_t*)(a.ws + WS_XB) + (size_t)t * D, lane, xv);
        float yv[16];
#pragma unroll
        for (int i = 0; i < 16; ++i) yv[i] = 0.f;
        acc_row8(yv, w0[8], w1[8], 0.125f);
#pragma unroll
        for (int k = 0; k < 8; ++k) acc_row8(yv, w0[k], w1[k], gk[k] * 0.125f);
        resid_update8(xv, yv, a.ffn_post_g + l * D, ml + 5 * D, lane);
        if (l == 0) store_row8_bf((bf16_t*)(a.ws + WS_XB) + (size_t)t * D, lane, xv); else store_row8(a.out + (size_t)t * D, lane, xv);
        if (l == 0) { const float* mn = mod + (size_t)(1 * NB + b) * 6 * D; u32x2 o[2]; prenorm_pack8_f8(xv, a.mix_pre_g + D, mn + D, mn, lane, o);
            *(u32x2*)(h8 + (size_t)t * D + 8 * lane) = o[0]; *(u32x2*)(h8 + (size_t)t * D + 512 + 8 * lane) = o[1]; }
    }
}

constexpr int NPH = 18;
__global__ void __launch_bounds__(NTHR, 2) mega(Args a) {
    extern __shared__ __attribute__((aligned(16))) unsigned char lds_raw[];
    Ctx X; X.lds = (LAS unsigned char*)lds_raw; X.tid = threadIdx.x; X.lane = X.tid & 63; X.wave = __builtin_amdgcn_readfirstlane(X.tid >> 6); X.G = gridDim.x; X.bid = blockIdx.x;
    if (X.tid < 4) ((LAS unsigned*)(X.lds + BAR_OFF))[X.tid] = 0u;
    __syncthreads();
    XcdBarrier bar; bar.bar = (unsigned*)(a.ws + WS_CTL); bar.x = 0; bar.st = nullptr;
    if (!MK_PER_PHASE) bar = xcd_barrier_post((unsigned*)(a.ws + WS_CTL), (volatile LAS unsigned*)(X.lds + BAR_OFF));
    const int lo = a.ph_lo, hi = a.ph_hi;
#define TIDR() do { int l_; asm volatile("v_mbcnt_lo_u32_b32 %0, -1, 0\n\tv_mbcnt_hi_u32_b32 %0, -1, %0" : "=v"(l_)); X.lane = l_; X.tid = X.wave * 64 + l_; } while (0)
#define IN(k) (lo <= (k) && (k) < hi)
#define REP(k, ...) do { __VA_ARGS__; if constexpr (((PROBE_MASK >> (k)) & 1u) != 0u) { __syncthreads(); __VA_ARGS__; } } while (0)
#define SEAM(k) do { if (IN(k) && IN((k) + 1)) xcd_barrier(bar); else { VM_WAIT(); __syncthreads(); } } while (0)
    unsigned char* ws = a.ws;
    if (IN(0)) { TIDR(); REP(0, ph_setup(a, X)); SEAM(0); }
    if (IN(1)) { TIDR(); REP(1, ph_prenorm0(a, X)); SEAM(1); }
    if constexpr (((PROBE_MASK >> 24) & 1u) != 0u) { for (int i_ = 0; i_ < 16; ++i_) xcd_barrier(bar); }
    if (IN(2)) { TIDR();
        pg8::SchedDense8<0x79797979, 0x7F7F7F7F> S; S.so.init(T, NPROJ, X.G, X.bid); S.A = (const char*)(ws + WS_H); S.Bt = (const char*)(ws + WS_WIN); S.K = D; S.pad_ = 0;
        pg8::EpiProj E{(bf16_t*)(ws + WS_QKVPRE), (bf16_t*)(ws + WS_ZA), (bf16_t*)(ws + WS_XBCPRE), (bf16_t*)(ws + WS_ZB), (float*)(ws + WS_SMALL)};
        REP(2, pg8::gemm_phase<pg8::EpiProj, pg8::SchedDense8<0x79797979, 0x7F7F7F7F>, true>(X.lds, D, S, E)); SEAM(2); }
    if (IN(3)) { TIDR(); REP(3, ph_gdn_local(a, X)); SEAM(3); }
    if (IN(4)) { TIDR();
        if (X.bid < 32) { REP(4, ph_gdn_scan(a, X)); }
        else {
            const int w = X.bid - 32, nw = X.G - 32; unsigned* gctr = (unsigned*)(ws + WS_CTL + CTL_GRP);
            constexpr int CONV_P1 = PROBE_CONVP1;
            REP(20, ph_ssd_local(a, X, 32)); __syncthreads();
            if (w >= 32) { REP(22, ph_moe_conv<2>(a, X, 0, w - 32, nw - 32, 0, CONV_P1)); }
            group_barrier(gctr, (unsigned)nw); __syncthreads();
            ph_ssd_scan(a, X, 32);
            group_barrier(gctr, 2u * (unsigned)nw); __syncthreads();
            REP(5, ph_ssd_out(a, X, 32, nw - 32)); __syncthreads();
            if (w < 32 || w >= 64) { const int wi = w < 32 ? w : w - 32; ph_moe_conv<2>(a, X, 0, wi, nw - 32, CONV_P1, -1); __syncthreads(); REP(23, ph_setup_late(a, X, wi, nw - 32)); }
        }
        SEAM(4); }
    if (IN(6)) { TIDR();
        pg8::SchedDense S; S.so.init(T, D, X.G, X.bid); S.A = (const char*)(ws + WS_OY); S.Bt = (const char*)(ws + WS_WOUT); S.K = 2048; S.pad_ = 0;
        pg8::EpiBf16 E{(bf16_t*)(ws + WS_YMIX), D, 0};
        REP(6, pg8::gemm_phase<pg8::EpiBf16, pg8::SchedDense>(X.lds, 2048, S, E)); SEAM(6); }
    if (IN(7)) { TIDR(); ph_router(a, X, 0); SEAM(7); }
    if (IN(8)) { TIDR(); REP(8, ph_moe_gu(a, X, 0)); SEAM(8); }
    if (IN(9)) { TIDR(); REP(9, ph_moe_down(a, X, 0)); SEAM(9); }
    if (IN(10)) { TIDR(); ph_combine(a, X, 0); SEAM(10); }
    if (IN(11)) { TIDR();
        pg8::SchedDense8<0x79797979, 0x7F7F7F7F> S; S.so.init(T, 3072, X.G, X.bid); S.A = (const char*)(ws + WS_H); S.Bt = (const char*)(ws + WS_WQKV); S.K = D; S.pad_ = 0;
        pg8::EpiQKV E{(bf16_t*)(ws + WS_Q1KV), (const float*)(ws + WS_COS), (const float*)(ws + WS_SIN)};
        REP(11, pg8::gemm_phase<pg8::EpiQKV, pg8::SchedDense8<0x79797979, 0x7F7F7F7F>, true>(X.lds, D, S, E)); SEAM(11); }
    if (IN(12)) { TIDR(); REP(12, ph_attn(a, X)); SEAM(12); }
    if (IN(13)) { TIDR();
        pg8::SchedDense8<0x79797979, 0x7D7D7D7D> S; S.so.init(T, D, X.G, X.bid); S.A = (const char*)(ws + WS_O1); S.Bt = (const char*)(ws + WS_WO); S.K = D; S.pad_ = 0;
        pg8::EpiBf16 E{(bf16_t*)(ws + WS_YMIX), D, 0};
        REP(13, pg8::gemm_phase<pg8::EpiBf16, pg8::SchedDense8<0x79797979, 0x7D7D7D7D>, true>(X.lds, D, S, E)); SEAM(13); }
    if (IN(14)) { TIDR(); ph_router(a, X, 1); REP(14, ph_moe_conv<8>(a, X, 1, X.bid, X.G, 0, -1)); SEAM(14); }
    if (IN(15)) { TIDR(); ph_moe_gu(a, X, 1); SEAM(15); }
    if (IN(16)) { TIDR(); ph_moe_down(a, X, 1); SEAM(16); }
    if (IN(17)) { TIDR(); REP(17, ph_combine(a, X, 1)); }
#undef IN
#undef SEAM
}

extern "C" void kernel_launch(void* const* d_in, const int* in_sizes, int n_in, void* d_out, int out_size, void* d_ws, size_t ws_size, hipStream_t stream) {
    static int grid = 0;
    if (!grid) {
        int dev = 0, cus = 0, per_cu = 0;
        if (hipGetDevice(&dev) != hipSuccess || hipDeviceGetAttribute(&cus, hipDeviceAttributeMultiprocessorCount, dev) != hipSuccess) { fprintf(stderr, "kernel_launch: device query failed\n"); grid = -1; return; }
        if (hipFuncSetAttribute((const void*)mega, hipFuncAttributeMaxDynamicSharedMemorySize, LDS_BYTES) != hipSuccess) { fprintf(stderr, "kernel_launch: hipFuncSetAttribute failed\n"); grid = -1; return; }
        if (hipOccupancyMaxActiveBlocksPerMultiprocessor(&per_cu, (const void*)mega, NTHR, LDS_BYTES) != hipSuccess || per_cu < 1) { fprintf(stderr, "kernel_launch: occupancy query says %d blocks per CU\n", per_cu); grid = -1; return; }
        grid = cus;
        if (grid < 64 || (grid & 7)) { fprintf(stderr, "kernel_launch: unsupported CU count %d\n", cus); grid = -1; return; }
    }
    if (grid < 0) return;
    if (ws_size < WS_END || n_in != 31) { fprintf(stderr, "kernel_launch: workspace %zu < %zu or n_in %d != 31\n", ws_size, (size_t)WS_END, n_in); return; }
    if (hipMemsetAsync((char*)d_ws + WS_CTL, 0, CTL_BYTES, stream) != hipSuccess) { fprintf(stderr, "kernel_launch: memset failed\n"); return; }
    Args a{};
    a.x = (const float*)d_in[0]; a.c = (const float*)d_in[1]; a.pos = (const int*)d_in[2]; a.mod_w = (const float*)d_in[3]; a.mod_b = (const float*)d_in[4];
    a.mix_pre_g = (const float*)d_in[5]; a.mix_post_g = (const float*)d_in[6]; a.ffn_pre_g = (const float*)d_in[7]; a.ffn_post_g = (const float*)d_in[8];
    a.ssm_w_in = (const float*)d_in[9]; a.gdn_conv_w = (const float*)d_in[10]; a.gdn_a_log = (const float*)d_in[11]; a.gdn_dt_bias = (const float*)d_in[12]; a.gdn_norm_w = (const float*)d_in[13];
    a.ssd_conv_w = (const float*)d_in[14]; a.ssd_conv_b = (const float*)d_in[15]; a.ssd_a_log = (const float*)d_in[16]; a.ssd_dt_bias = (const float*)d_in[17]; a.ssd_d = (const float*)d_in[18]; a.ssd_norm_w = (const float*)d_in[19];
    a.ssm_w_out = (const float*)d_in[20]; a.attn_w_qkv = (const float*)d_in[21]; a.attn_w_o = (const float*)d_in[22];
    a.router_w = (const float*)d_in[23]; a.router_bias = (const float*)d_in[24]; a.exp_gate = (const float*)d_in[25]; a.exp_up = (const float*)d_in[26]; a.exp_down = (const float*)d_in[27];
    a.sh_gate = (const float*)d_in[28]; a.sh_up = (const float*)d_in[29]; a.sh_down = (const float*)d_in[30];
    a.out = (float*)d_out; a.ws = (unsigned char*)d_ws;
#if MK_PER_PHASE
    for (int p = 0; p < NPH; ++p) { a.ph_lo = p; a.ph_hi = p + 1; hipLaunchKernelGGL(mega, dim3(grid), dim3(NTHR), LDS_BYTES, stream, a); }
#else
    a.ph_lo = 0; a.ph_hi = NPH;
    hipLaunchKernelGGL(mega, dim3(grid), dim3(NTHR), LDS_BYTES, stream, a);
#endif
}
```

```cpp
#include <hip/hip_runtime.h>
#include <stdint.h>
#include <stdio.h>

#define DEV __device__ __forceinline__
#define LAS __attribute__((address_space(3)))
typedef unsigned short bf16_t;
typedef short bf16x8 __attribute__((ext_vector_type(8)));
typedef float f32x4 __attribute__((ext_vector_type(4)));
typedef float f32x2 __attribute__((ext_vector_type(2)));
typedef unsigned u32x4 __attribute__((ext_vector_type(4)));
typedef unsigned u32x2 __attribute__((ext_vector_type(2)));
typedef float f32x16 __attribute__((ext_vector_type(16)));
typedef short s16x4 __attribute__((ext_vector_type(4)));

#ifndef PROBE_MASK
#define PROBE_MASK 0u
#endif
#ifndef PROBE_CONVP1
#define PROBE_CONVP1 15360
#endif
#ifndef MK_PER_PHASE
#define MK_PER_PHASE 0
#endif

constexpr int NB = 4, SEQ = 4096, T = NB * SEQ, D = 1024;
constexpr int PROJ = 6688, NPROJ = 6912;
constexpr int C_BETA = 4096, C_XBC = 4112, C_ZB = 5648, C_DT = 6672;
constexpr int NE = 64, TOPK = 8, ED = 256, CAP = 16384;
constexpr int SH_RB = 576;
constexpr int NRB_ALL = SH_RB + 64;
constexpr float EPS = 1e-6f;
constexpr int NTHR = 512, NWAVES = 8;
constexpr int LDS_BYTES = 163840;
constexpr int AUX_OFF = 131072;
constexpr int BAR_OFF = LDS_BYTES - 16;

constexpr size_t MiB = 1u << 20;
constexpr size_t WS_CTL = 0, CTL_BYTES = 65536;
constexpr size_t CTL_CNT = 16384;
constexpr size_t CTL_GRP = 20480;
constexpr size_t WS_MOD = 65536;
constexpr size_t WS_COS = 1 * MiB, WS_SIN = 3 * MiB;
constexpr size_t WS_IDX = 5 * MiB, WS_GW = 5 * MiB + 512 * 1024, WS_ASLOT = 6 * MiB, WS_LTOK = 6 * MiB + 512 * 1024;
constexpr size_t WS_SMALL = 11 * MiB;
constexpr size_t WS_WIN = 16 * MiB, WS_WOUT = 30 * MiB, WS_WQKV = 34 * MiB, WS_WO = 40 * MiB;
constexpr size_t WS_WIN8 = WS_WIN + 8 * MiB, WS_H8 = 350 * MiB;
constexpr size_t WS_H = 44 * MiB;
constexpr size_t WS_QKVPRE = 78 * MiB, WS_XBCPRE = 174 * MiB, WS_ZA = 222 * MiB, WS_ZB = 254 * MiB;
constexpr size_t WS_CC = 16 * MiB, WS_ACUM = 25 * MiB, WS_CDEC = 26 * MiB, WS_YDIAG = 44 * MiB, WS_STATES = 430 * MiB;
constexpr size_t WS_GI = 286 * MiB, GI_UNIT = 73728, WS_GTMP = 462 * MiB, WS_GLAST = 27 * MiB;
constexpr size_t WS_OY = 78 * MiB, WS_YMIX = 286 * MiB, WS_XB = 240 * MiB;
constexpr size_t WS_WD = 478 * MiB, WS_WDS = 510 * MiB + 512 * 1024, WS_HID = 398 * MiB, WS_Y = 78 * MiB, WS_WGU = 142 * MiB, WS_WGUS = 207 * MiB;
constexpr size_t WS_Q1KV = 78 * MiB, WS_O1 = 174 * MiB, WS_PO = 350 * MiB, WS_PLSE = 446 * MiB;
constexpr size_t WS_END = 512 * MiB;

struct Args {
    const float* x; const float* c; const int* pos; const float* mod_w; const float* mod_b;
    const float* mix_pre_g; const float* mix_post_g; const float* ffn_pre_g; const float* ffn_post_g;
    const float* ssm_w_in; const float* gdn_conv_w; const float* gdn_a_log; const float* gdn_dt_bias; const float* gdn_norm_w;
    const float* ssd_conv_w; const float* ssd_conv_b; const float* ssd_a_log; const float* ssd_dt_bias; const float* ssd_d; const float* ssd_norm_w;
    const float* ssm_w_out; const float* attn_w_qkv; const float* attn_w_o;
    const float* router_w; const float* router_bias; const float* exp_gate; const float* exp_up; const float* exp_down;
    const float* sh_gate; const float* sh_up; const float* sh_down;
    float* out; unsigned char* ws; int ph_lo, ph_hi;
};

DEV float bf2f(bf16_t v) { return __uint_as_float(((unsigned)v) << 16); }
typedef __bf16 bf16x2_hw __attribute__((ext_vector_type(2)));
DEV unsigned pk2(float lo, float hi) { const bf16x2_hw v = {(__bf16)lo, (__bf16)hi}; return __builtin_bit_cast(unsigned, v); }
DEV unsigned f2bf(float f) { return pk2(f, 0.f) & 0xFFFFu; }
template <int CTRL> DEV float dppf(float v) { return __builtin_bit_cast(float, __builtin_amdgcn_update_dpp(0, __builtin_bit_cast(int, v), CTRL, 0xF, 0xF, true)); }
template <int CTRL> DEV int dppi(int v) { return __builtin_amdgcn_update_dpp(0, v, CTRL, 0xF, 0xF, true); }
DEV float rlf(float v, int l) { return __builtin_bit_cast(float, __builtin_amdgcn_readlane(__builtin_bit_cast(int, v), l)); }
DEV int rli(int v, int l) { return __builtin_amdgcn_readlane(v, l); }
DEV float sum8(float v) { v += dppf<0xB1>(v); v += dppf<0x4E>(v); v += dppf<0x141>(v); return v; }
DEV float max8(float v) { v = fmaxf(v, dppf<0xB1>(v)); v = fmaxf(v, dppf<0x4E>(v)); v = fmaxf(v, dppf<0x141>(v)); return v; }
DEV int min8(int v) { v = min(v, dppi<0xB1>(v)); v = min(v, dppi<0x4E>(v)); v = min(v, dppi<0x141>(v)); return v; }
DEV float xor16_sum(float v) { const auto r = __builtin_amdgcn_permlane16_swap(__builtin_bit_cast(unsigned, v), __builtin_bit_cast(unsigned, v), false, false); return __builtin_bit_cast(float, r[0]) + __builtin_bit_cast(float, r[1]); }
DEV float xor32_sum(float v) { const auto r = __builtin_amdgcn_permlane32_swap(__builtin_bit_cast(unsigned, v), __builtin_bit_cast(unsigned, v), false, false); return __builtin_bit_cast(float, r[0]) + __builtin_bit_cast(float, r[1]); }
DEV float xor32_max(float v) { const auto r = __builtin_amdgcn_permlane32_swap(__builtin_bit_cast(unsigned, v), __builtin_bit_cast(unsigned, v), false, false); return fmaxf(__builtin_bit_cast(float, r[0]), __builtin_bit_cast(float, r[1])); }
DEV float wave_sum(float v) {
    v = sum8(v); v += dppf<0x140>(v);
    return (rlf(v, 0) + rlf(v, 16)) + (rlf(v, 32) + rlf(v, 48));
}
DEV float siluf(float x) { return x * __builtin_amdgcn_rcpf(1.f + __expf(-x)); }
DEV float sigmoidf_(float x) { return __builtin_amdgcn_rcpf(1.f + __expf(-x)); }
DEV float softplusf(float x) { return fmaxf(x, 0.f) + log1pf(__expf(-fabsf(x))); }
#define LDS_WAIT() asm volatile("s_waitcnt lgkmcnt(0)" ::: "memory")
#define VM_WAIT() asm volatile("s_waitcnt vmcnt(0)" ::: "memory")

#define XB_TMO      128
#define XB_XCNT(j)  (256  + 64 * (j))
#define XB_XSUB(j)  (1280 + 64 * (j))
#define XB_XGEN(j)  (2304 + 64 * (j))
#define XB_TOP      3328
#define XB_TOPGEN   3392
#define XCD_BAR_WORDS 3456
#define XB_SPIN_CAP (1u << 18)
#define LAS __attribute__((address_space(3)))

__device__ __forceinline__ unsigned xb_ld(unsigned* p)              { return __hip_atomic_load(p, __ATOMIC_RELAXED, __HIP_MEMORY_SCOPE_AGENT); }
__device__ __forceinline__ unsigned xb_add(unsigned* p, unsigned v) { return __hip_atomic_fetch_add(p, v, __ATOMIC_RELAXED, __HIP_MEMORY_SCOPE_AGENT); }
__device__ __forceinline__ unsigned xb_xcc_id() { return (unsigned)__builtin_amdgcn_s_getreg((3 << 11) | 20) & 0xFu; }
#define XB_SPIN(cond, bar) do { unsigned _sp = 0; while (cond) { __builtin_amdgcn_s_sleep(1); \
    if ((++_sp & 255u) == 0u) { if (xb_ld(&(bar)[XB_TMO])) break; if (_sp > XB_SPIN_CAP) { atomicAdd(&(bar)[XB_TMO], 1u); break; } } } } while (0)

struct XcdBarrier {
    unsigned* bar; unsigned x;
    volatile LAS unsigned* st;
};

__device__ __forceinline__ XcdBarrier xcd_barrier_post(unsigned* bar, volatile LAS unsigned* st) {
    XcdBarrier b; b.bar = bar; b.x = xb_xcc_id(); b.st = st;
    if (threadIdx.x == 0) (void)xb_add(&bar[XB_XCNT(b.x)], 1u);
    return b;
}
__device__ __forceinline__ void xcd_barrier_complete(unsigned* bar, unsigned x, unsigned& nloc, unsigned& nx) {
    const unsigned G = gridDim.x * gridDim.y * gridDim.z;
    unsigned sum, cnt, mine, sp = 0u;
    for (;;) {
        sum = 0u; cnt = 0u; mine = 0u;
#pragma unroll
        for (unsigned j = 0; j < 16; ++j) { const unsigned c = xb_ld(&bar[XB_XCNT(j)]); sum += c; cnt += (c > 0u) ? 1u : 0u; mine = (j == x) ? c : mine; }
        if (sum == G) break;
        __builtin_amdgcn_s_sleep(1);
        if ((++sp & 255u) == 0u) { if (xb_ld(&bar[XB_TMO])) break; if (sp > XB_SPIN_CAP) { atomicAdd(&bar[XB_TMO], 1u); break; } }
    }
    nloc = mine > 0u ? mine : 1u; nx = cnt > 0u ? cnt : 1u;
}

__device__ __forceinline__ void xcd_barrier(const XcdBarrier& b) {
    asm volatile("s_waitcnt vmcnt(0)" ::: "memory");
    __syncthreads();
    if (threadIdx.x == 0) {
        unsigned* bar = b.bar;
        __builtin_amdgcn_s_waitcnt(0);
        unsigned nloc = b.st[0], nx = b.st[1];
        if (nloc == 0u) { xcd_barrier_complete(bar, b.x, nloc, nx); b.st[0] = nloc; b.st[1] = nx; }
        const unsigned old = xb_add(&bar[XB_XSUB(b.x)], 1u);
        const unsigned gen = old / nloc;
        if (old + 1u == (gen + 1u) * nloc) {
            __builtin_amdgcn_fence(__ATOMIC_RELEASE, "agent");
            asm volatile("s_waitcnt vmcnt(0)" ::: "memory");
            const unsigned og = xb_add(&bar[XB_TOP], 1u);
            const unsigned tg = og / nx;
            if (og + 1u == (tg + 1u) * nx) xb_add(&bar[XB_TOPGEN], 1u);
            else XB_SPIN(xb_ld(&bar[XB_TOPGEN]) == tg, bar);
            __builtin_amdgcn_fence(__ATOMIC_ACQUIRE, "agent");
            xb_add(&bar[XB_XGEN(b.x)], 1u);
            asm volatile("s_waitcnt vmcnt(0)" ::: "memory");
        } else {
            XB_SPIN(xb_ld(&bar[XB_XGEN(b.x)]) == gen, bar);
            __builtin_amdgcn_fence(__ATOMIC_ACQUIRE, "agent");
            asm volatile("s_waitcnt vmcnt(0)" ::: "memory");
        }
    }
    __syncthreads();
}


DEV void group_barrier(unsigned* ctr, const unsigned n) {
    asm volatile("s_waitcnt vmcnt(0)" ::: "memory");
    __syncthreads();
    if (threadIdx.x == 0) {
        __builtin_amdgcn_fence(__ATOMIC_RELEASE, "agent");
        asm volatile("s_waitcnt vmcnt(0)" ::: "memory");
        (void)__hip_atomic_fetch_add(ctr, 1u, __ATOMIC_RELAXED, __HIP_MEMORY_SCOPE_AGENT);
        unsigned sp = 0;
        while (__hip_atomic_load(ctr, __ATOMIC_RELAXED, __HIP_MEMORY_SCOPE_AGENT) < n) { __builtin_amdgcn_s_sleep(2); if (++sp > (1u << 22)) break; }
        __builtin_amdgcn_fence(__ATOMIC_ACQUIRE, "agent");
        asm volatile("s_waitcnt vmcnt(0)" ::: "memory");
    }
    __syncthreads();
}

namespace pg8 {
constexpr int BM = 256, BK = 64, HALF = 128, HTB = HALF * BK * 2, STAGE_BYTES = 8 * HTB, NXCD = 8, WGM = 8;
DEV int lds_byte(int r, int c) { const int st = (r >> 4) * 2 + (c >> 5), rr = r & 15, cc = c & 31, ob = rr * 64 + cc * 2; return st * 1024 + (ob ^ (((ob >> 9) & 1) << 5)); }
DEV void stage_rc(int b, int& R, int& C) { const int st = b / 1024, sb = b % 1024, swz = sb ^ (((sb >> 9) & 1) << 5); R = (st >> 1) * 16 + swz / 64; C = (st & 1) * 32 + (swz % 64) / 2; }
DEV int perm32(int rho) { const int n = rho >> 4, i = rho & 15; return 8 * (i >> 2) + 4 * n + (i & 3); }
struct Unit { int pm, pn, e, slot; };
struct StaticOrder {
    int nM, nN, nwg, G, c;
    DEV void init(int M, int N, int G_, int c_) { nM = M / BM; nN = N / BM; nwg = nM * nN; G = G_; c = c_; }
    DEV bool next(int i, int& pm, int& pn) const {
        const long L = (long)i * G + c; if (L >= nwg) return false;
        int wgid = (int)L; { const int q = nwg / NXCD, r = nwg % NXCD, xcd = wgid % NXCD, off = wgid / NXCD; wgid = (xcd < r ? xcd * (q + 1) : r * (q + 1) + (xcd - r) * q) + off; }
        const int nig = WGM * nN, gid = wgid / nig, fm = gid * WGM, gsz = (nM - fm) < WGM ? (nM - fm) : WGM;
        pm = fm + ((wgid % nig) % gsz); pn = (wgid % nig) / gsz; return true;
    }
};
typedef __bf16 bf16x2_t __attribute__((ext_vector_type(2)));
DEV unsigned cvt_pk_bf16(float lo, float hi) { const bf16x2_t v = {(__bf16)lo, (__bf16)hi}; return __builtin_bit_cast(unsigned, v); }
DEV u32x4 pack8(const f32x4 a, const f32x4 b) { u32x4 w; w.x = cvt_pk_bf16(a[0], a[1]); w.y = cvt_pk_bf16(a[2], a[3]); w.z = cvt_pk_bf16(b[0], b[1]); w.w = cvt_pk_bf16(b[2], b[3]); return w; }

typedef int v8i_t __attribute__((ext_vector_type(8)));
template <class Epi, class Sched, bool F8 = false>
DEV void gemm_phase(LAS unsigned char* lds, const int K, const Sched& S, const Epi& E) {
    const int tid = threadIdx.x, wid = __builtin_amdgcn_readfirstlane(tid >> 6), lane = tid & 63, wr = wid >> 2, wc = wid & 3, fr = lane & 15, fq = lane >> 4;
    const int nt = F8 ? K / 128 : K / BK;
    const int pitch = F8 ? K : 2 * K;
    unsigned voffB[2];
#pragma unroll
    for (int i = 0; i < 2; ++i) { int R, C; stage_rc(tid * 16 + i * 8192, R, C); const int Rb = Epi::PERM ? ((R & ~31) + perm32(R & 31)) : R; voffB[i] = (unsigned)(Rb * pitch + 2 * C); }
    const unsigned kstep = (unsigned)(BK * 2);
    const size_t hstep = (size_t)HALF * pitch;
    const unsigned ldsw = (unsigned)wid * 1024u;
    const int aoff = lds_byte(wr * 64 + fr, fq * 8), boff = lds_byte(wc * 32 + fr, fq * 8);
    const size_t hsA = Sched::GATHER ? (size_t)0 : hstep;
#define PG8_SA(b, h) (((b) * 2 + (h)) * HTB)
#define PG8_SB(b, h) ((4 + (b) * 2 + (h)) * HTB)
#define PG8_STAGEB(bufoff, gbase) do { _Pragma("unroll") for (int _i = 0; _i < 2; ++_i) \
        __builtin_amdgcn_global_load_lds((const unsigned*)((const char*)(gbase) + voffB[_i]), (LAS unsigned*)(lds + (bufoff) + ldsw + _i * 8192), 16, 0, 0); } while (0)
#define PG8_STAGEA(bufoff, gbase, VO) do { _Pragma("unroll") for (int _i = 0; _i < 2; ++_i) \
        __builtin_amdgcn_global_load_lds((const unsigned*)((const char*)(gbase) + (VO)[_i]), (LAS unsigned*)(lds + (bufoff) + ldsw + _i * 8192), 16, 0, 0); } while (0)
#define PG8_LD8(var, base) do { const u32x4 _l0 = *(const LAS u32x4*)(lds + (base)), _l1 = *(const LAS u32x4*)(lds + (base) + 1024); var = __builtin_shufflevector(_l0, _l1, 0, 1, 2, 3, 4, 5, 6, 7); } while (0)
#define PG8_LDA(dst, b, h) do { if constexpr (F8) { PG8_LD8(dst##8_0, PG8_SA(b, h) + aoff); PG8_LD8(dst##8_1, PG8_SA(b, h) + aoff + 2048); PG8_LD8(dst##8_2, PG8_SA(b, h) + aoff + 4096); PG8_LD8(dst##8_3, PG8_SA(b, h) + aoff + 6144); } \
        else { _Pragma("unroll") for (int m = 0; m < 4; ++m) _Pragma("unroll") for (int k = 0; k < 2; ++k) dst[m][k] = *(const LAS bf16x8*)(lds + PG8_SA(b, h) + aoff + m * 2048 + k * 1024); } } while (0)
#define PG8_LDB(dst, b, h) do { if constexpr (F8) { PG8_LD8(dst##8_0, PG8_SB(b, h) + boff); PG8_LD8(dst##8_1, PG8_SB(b, h) + boff + 2048); } \
        else { _Pragma("unroll") for (int n = 0; n < 2; ++n) _Pragma("unroll") for (int k = 0; k < 2; ++k) dst[n][k] = *(const LAS bf16x8*)(lds + PG8_SB(b, h) + boff + n * 2048 + k * 1024); } } while (0)
#define PG8_M8(ai, bj, m, n, A8, B8) asm volatile("v_mfma_scale_f32_16x16x128_f8f6f4 %0, %1, %2, %0, %3, %4 op_sel_hi:[0,0,0]" : "+v"(acc[ai][bj][m][n]) : "v"(B8), "v"(A8), "v"(wsc_), "v"(asc_))
#define PG8_M8Z(ai, bj, m, n, A8, B8) asm volatile("v_mfma_scale_f32_16x16x128_f8f6f4 %0, %1, %2, %0, %3, %4 op_sel_hi:[0,0,0]" : "+v"(acc[ai][bj][m][n]) : "v"(B8), "v"(A8), "v"(zsc_), "v"(zsc_))
#define PG8_MMA(ai, bj, At, Bt) do { __builtin_amdgcn_s_setprio(1); \
        if constexpr (F8) { PG8_M8(ai, bj, 0, 0, At##8_0, Bt##8_0); PG8_M8(ai, bj, 0, 1, At##8_0, Bt##8_1); PG8_M8(ai, bj, 1, 0, At##8_1, Bt##8_0); PG8_M8(ai, bj, 1, 1, At##8_1, Bt##8_1); \
                            PG8_M8(ai, bj, 2, 0, At##8_2, Bt##8_0); PG8_M8(ai, bj, 2, 1, At##8_2, Bt##8_1); PG8_M8(ai, bj, 3, 0, At##8_3, Bt##8_0); PG8_M8(ai, bj, 3, 1, At##8_3, Bt##8_1); \
            if constexpr (((PROBE_MASK >> 26) & 1u) != 0u) { PG8_M8Z(ai, bj, 0, 0, At##8_0, Bt##8_0); PG8_M8Z(ai, bj, 0, 1, At##8_0, Bt##8_1); PG8_M8Z(ai, bj, 1, 0, At##8_1, Bt##8_0); PG8_M8Z(ai, bj, 1, 1, At##8_1, Bt##8_1); \
                            PG8_M8Z(ai, bj, 2, 0, At##8_2, Bt##8_0); PG8_M8Z(ai, bj, 2, 1, At##8_2, Bt##8_1); PG8_M8Z(ai, bj, 3, 0, At##8_3, Bt##8_0); PG8_M8Z(ai, bj, 3, 1, At##8_3, Bt##8_1); } } \
        else { _Pragma("unroll") for (int m = 0; m < 4; ++m) _Pragma("unroll") for (int n = 0; n < 2; ++n) _Pragma("unroll") for (int k = 0; k < 2; ++k) acc[ai][bj][m][n] = __builtin_amdgcn_mfma_f32_16x16x32_bf16(Bt[n][k], At[m][k], acc[ai][bj][m][n], 0, 0, 0); } \
        __builtin_amdgcn_s_setprio(0); } while (0)
#define PG8_WAIT_V(n) asm volatile("s_waitcnt vmcnt(" #n ")" ::: "memory")
#define PG8_WAIT_L(n) asm volatile("s_waitcnt lgkmcnt(" #n ")" ::: "memory")
#define PG8_BAR __builtin_amdgcn_s_barrier()
#define PG8_SCHED __builtin_amdgcn_sched_barrier(0)
    Unit cur, nxt; int ui = 0;
    if (!S.next(0, cur)) return;
    f32x4 acc[2][2][4][2];
#pragma unroll
    for (int a = 0; a < 2; ++a)
#pragma unroll
        for (int b = 0; b < 2; ++b)
#pragma unroll
            for (int m = 0; m < 4; ++m)
#pragma unroll
                for (int n = 0; n < 2; ++n) acc[a][b][m][n] = (f32x4){0.f, 0.f, 0.f, 0.f};
    bf16x8 At[4][2], B0[2][2], B1[2][2];
    typedef unsigned u32x8_t __attribute__((ext_vector_type(8)));
    u32x8_t At8_0, At8_1, At8_2, At8_3, B08_0, B08_1, B18_0, B18_1;
    int zsc_ = 0; asm volatile("" : "+v"(zsc_));
    const int wsc_ = Sched::WSCALE, asc_ = Sched::ASCALE;
    unsigned va[2][2];
    S.a_voff(cur, tid, va);
    const char* cA = S.a_ptr(cur);
    const char* cB = S.b_ptr(cur);
    PG8_STAGEB(PG8_SB(0, 0), cB); PG8_STAGEB(PG8_SB(0, 1), cB + hstep); PG8_STAGEA(PG8_SA(0, 0), cA, va[0]); PG8_STAGEA(PG8_SA(0, 1), cA + hsA, va[1]);
    if (wr == 1) PG8_BAR;
    PG8_WAIT_V(2); PG8_BAR;
    PG8_STAGEB(PG8_SB(1, 0), cB + kstep); PG8_STAGEA(PG8_SA(1, 0), cA + kstep, va[0]); PG8_STAGEB(PG8_SB(1, 1), cB + hstep + kstep);
    PG8_WAIT_V(6); PG8_BAR;
    for (;;) {
        const bool has_next = S.next(ui + 1, nxt);
        const char* nB = has_next ? S.b_ptr(nxt) : cB;
        const char* nA = has_next ? S.a_ptr(nxt) : cA;
        for (int t = 0; t < nt; t += 2) {
            const bool last = (t == nt - 2);
            const char* a1 = cA + (size_t)(t + 1) * kstep;
            const char* a2 = last ? nA : cA + (size_t)(t + 2) * kstep; const char* a3 = a2 + kstep;
            unsigned v2[2][2];
            v2[0][0] = va[0][0]; v2[0][1] = va[0][1]; v2[1][0] = va[1][0]; v2[1][1] = va[1][1];
            if constexpr (Sched::GATHER) { if (last && has_next) S.a_voff(nxt, tid, v2); }
            const char* b2 = last ? nB : cB + (size_t)(t + 2) * kstep; const char* b3 = b2 + kstep;
            PG8_LDB(B0, 0, 0); PG8_LDB(B1, 0, 1); PG8_SCHED; PG8_LDA(At, 0, 0); PG8_STAGEA(PG8_SA(1, 1), a1 + hsA, va[1]);
            PG8_WAIT_V(8); PG8_WAIT_L(0); PG8_BAR; PG8_MMA(0, 0, At, B0); PG8_MMA(0, 1, At, B1); PG8_BAR; PG8_SCHED;
            PG8_LDA(At, 0, 1); PG8_STAGEB(PG8_SB(0, 0), b2); PG8_STAGEB(PG8_SB(0, 1), b2 + hstep); PG8_STAGEA(PG8_SA(0, 0), a2, v2[0]);
            PG8_WAIT_V(8); PG8_WAIT_L(0); PG8_BAR; PG8_MMA(1, 0, At, B0); PG8_MMA(1, 1, At, B1); PG8_BAR; PG8_SCHED;
            PG8_LDB(B0, 1, 0); PG8_LDB(B1, 1, 1); PG8_SCHED; PG8_LDA(At, 1, 0); PG8_STAGEA(PG8_SA(0, 1), a2 + hsA, v2[1]);
            PG8_WAIT_V(8); PG8_WAIT_L(0); PG8_BAR; PG8_MMA(0, 0, At, B0); PG8_MMA(0, 1, At, B1); PG8_BAR; PG8_SCHED;
            PG8_LDA(At, 1, 1); PG8_STAGEB(PG8_SB(1, 0), b3); PG8_STAGEB(PG8_SB(1, 1), b3 + hstep); PG8_STAGEA(PG8_SA(1, 0), a3, v2[0]);
            PG8_WAIT_V(8); PG8_WAIT_L(0); PG8_BAR; PG8_MMA(1, 0, At, B0); PG8_MMA(1, 1, At, B1); PG8_BAR; PG8_SCHED;
        }
        if (wr == 0) PG8_BAR;
        if constexpr (F8) asm volatile("s_nop 15\n\ts_nop 15" ::: "memory");
        E(acc, cur, wr, wc, fr, fq);
        if constexpr (((PROBE_MASK >> 27) & 1u) != 0u) { asm volatile("" ::: "memory"); E(acc, cur, wr, wc, fr, fq); }
        if (!has_next) break;
#pragma unroll
        for (int a = 0; a < 2; ++a)
#pragma unroll
            for (int b = 0; b < 2; ++b)
#pragma unroll
                for (int m = 0; m < 4; ++m)
#pragma unroll
                    for (int n = 0; n < 2; ++n) acc[a][b][m][n] = (f32x4){0.f, 0.f, 0.f, 0.f};
        cur = nxt; cB = nB; cA = nA; ++ui;
        if constexpr (Sched::GATHER) S.a_voff(cur, tid, va);
        if (wr == 1) PG8_BAR;
    }
    PG8_WAIT_V(0);
    PG8_BAR;
#undef PG8_SA
#undef PG8_SB
#undef PG8_STAGEA
#undef PG8_STAGEB
#undef PG8_LDA
#undef PG8_LD8
#undef PG8_M8
#undef PG8_LDB
#undef PG8_MMA
#undef PG8_WAIT_V
#undef PG8_WAIT_L
#undef PG8_BAR
#undef PG8_SCHED
}

struct SchedDense {
    static constexpr bool GATHER = false; static constexpr int WSCALE = 0x7F7F7F7F, ASCALE = 0x7F7F7F7F;
    StaticOrder so; const char* A; const char* Bt; int K; int pad_;
    DEV bool next(int i, Unit& u) const { int pm, pn; if (!so.next(i, pm, pn)) return false; u.pm = pm; u.pn = pn + pad_; u.e = 0; u.slot = 0; return true; }
    DEV const char* a_ptr(const Unit& u) const { return A + (size_t)u.pm * 256 * K * 2; }
    DEV void a_voff(const Unit&, const int tid, unsigned (&vo)[2][2]) const {
#pragma unroll
        for (int i = 0; i < 2; ++i) { int R, C; stage_rc(tid * 16 + i * 8192, R, C); vo[0][i] = vo[1][i] = (unsigned)((R * K + C) * 2); }
    }
    DEV const char* b_ptr(const Unit& u) const { return Bt + (size_t)(u.pn - pad_) * 256 * K * 2; }
};
template <int WS_, int AS_> struct SchedDense8 {
    static constexpr bool GATHER = false; static constexpr int WSCALE = WS_, ASCALE = AS_;
    StaticOrder so; const char* A; const char* Bt; int K; int pad_;
    DEV bool next(int i, Unit& u) const { int pm, pn; if (!so.next(i, pm, pn)) return false; u.pm = pm; u.pn = pn + pad_; u.e = 0; u.slot = 0; return true; }
    DEV const char* a_ptr(const Unit& u) const { return A + (size_t)u.pm * 256 * K; }
    DEV void a_voff(const Unit&, const int tid, unsigned (&vo)[2][2]) const {
#pragma unroll
        for (int i = 0; i < 2; ++i) { int R, C; stage_rc(tid * 16 + i * 8192, R, C); vo[0][i] = vo[1][i] = (unsigned)(R * K + 2 * C); }
    }
    DEV const char* b_ptr(const Unit& u) const { return Bt + (size_t)(u.pn - pad_) * 256 * K; }
};
DEV bool moe_unit(int i, int NJ, int nrbt, int G, int c, Unit& u) {
    const int n = (nrbt + 64) * NJ; int L;
    if (G & 7) { L = i * G + c; if (L >= n) return false; }
    else { const int gq = G >> 3, per = (n + 7) >> 3, x = c & 7, q = c >> 3, j = i * gq + q; if (j >= per) return false; L = x * per + j; if (L >= n) return false; }
    int grb = L / NJ; const int pn = L - grb * NJ; if (grb >= nrbt) grb = SH_RB + (grb - nrbt);
    u.pm = grb; u.pn = pn; u.slot = i; u.e = 0; return true;
}
struct SchedGU {
    static constexpr bool GATHER = true; static constexpr int WSCALE = 0x79797979, ASCALE = 0x7F7F7F7F;
    const char* A; const char* Wgu; const char* Wgus; const LAS int* eofrb; const LAS int* toks; int nrbt, G, c, pad_;
    DEV bool next(int i, Unit& u) const { if (!moe_unit(i, 2, nrbt, G, c, u)) return false; u.e = __builtin_amdgcn_readfirstlane(eofrb[u.pm]); return true; }
    DEV const char* a_ptr(const Unit&) const { return A; }
    DEV void a_voff(const Unit& u, const int tid, unsigned (&vo)[2][2]) const {
#pragma unroll
        for (int i = 0; i < 2; ++i) { int R, C; stage_rc(tid * 16 + i * 8192, R, C);
#pragma unroll
            for (int h = 0; h < 2; ++h) { const int tok = toks[u.slot * 256 + h * 128 + R]; vo[h][i] = (unsigned)(tok * D + 2 * C); } }
    }
    DEV const char* b_ptr(const Unit& u) const { return (u.e < NE ? Wgu + (size_t)u.e * 512 * D : Wgus) + (size_t)u.pn * 256 * D; }
};
struct SchedDown {
    static constexpr bool GATHER = false; static constexpr int WSCALE = 0x7D7D7D7D, ASCALE = 0x7F7F7F7F;
    const char* A; const char* Wd; const char* Wds; const LAS int* eofrb; int nrbt, G, c, pad_;
    DEV bool next(int i, Unit& u) const { if (!moe_unit(i, 4, nrbt, G, c, u)) return false; u.e = __builtin_amdgcn_readfirstlane(eofrb[u.pm]); return true; }
    DEV const char* a_ptr(const Unit& u) const { return A + (size_t)u.pm * 256 * ED; }
    DEV void a_voff(const Unit&, const int tid, unsigned (&vo)[2][2]) const {
#pragma unroll
        for (int i = 0; i < 2; ++i) { int R, C; stage_rc(tid * 16 + i * 8192, R, C); vo[0][i] = vo[1][i] = (unsigned)(R * ED + 2 * C); }
    }
    DEV const char* b_ptr(const Unit& u) const { return (u.e < NE ? Wd + (size_t)u.e * D * ED : Wds) + (size_t)u.pn * 256 * ED; }
};

struct EpiProj {
    static constexpr bool PERM = true;
    bf16_t* qkv; bf16_t* za; bf16_t* xbc; bf16_t* zb; float* small;
    DEV void operator()(const f32x4 (&acc)[2][2][4][2], const Unit& u, int wr, int wc, int fr, int fq) const {
        const int row0 = u.pm * BM + wr * 64 + fr, pn = u.pn;
        if (pn == 26) {
            if (wc == 0) {
#pragma unroll
                for (int ai = 0; ai < 2; ++ai)
#pragma unroll
                    for (int m = 0; m < 4; ++m) { float* p = small + (size_t)(row0 + ai * HALF + m * 16) * 32 + 8 * fq; *(f32x4*)p = acc[ai][0][m][0]; *(f32x4*)(p + 4) = acc[ai][0][m][1]; }
            }
            return;
        }
        bf16_t* base; int ldc, ct;
        if (pn < 12) { base = qkv; ldc = 3072; ct = pn; } else if (pn < 16) { base = za; ldc = 1024; ct = pn - 12; } else if (pn < 22) { base = xbc; ldc = 1536; ct = pn - 16; } else { base = zb; ldc = 1024; ct = pn - 22; }
        const int col0 = ct * 256 + wc * 32 + 8 * fq;
#pragma unroll
        for (int ai = 0; ai < 2; ++ai)
#pragma unroll
            for (int m = 0; m < 4; ++m) { bf16_t* rowp = base + (size_t)(row0 + ai * HALF + m * 16) * ldc + col0;
#pragma unroll
                for (int bj = 0; bj < 2; ++bj) *(u32x4*)(rowp + bj * HALF) = pack8(acc[ai][bj][m][0], acc[ai][bj][m][1]); }
    }
};
struct EpiF32 {
    static constexpr bool PERM = false;
    float* Cp; int ldc; int pad_;
    DEV void operator()(const f32x4 (&acc)[2][2][4][2], const Unit& u, int wr, int wc, int fr, int fq) const {
        const int row0 = u.pm * BM + wr * 64 + fr, col0 = u.pn * BM + wc * 32 + 4 * fq;
#pragma unroll
        for (int ai = 0; ai < 2; ++ai)
#pragma unroll
            for (int m = 0; m < 4; ++m) { float* rowp = Cp + (size_t)(row0 + ai * HALF + m * 16) * ldc + col0;
#pragma unroll
                for (int bj = 0; bj < 2; ++bj)
#pragma unroll
                    for (int n = 0; n < 2; ++n) *(f32x4*)(rowp + bj * HALF + n * 16) = acc[ai][bj][m][n]; }
    }
};
struct EpiBf16 {
    static constexpr bool PERM = true;
    bf16_t* O; int ldc; int pad_;
    DEV void operator()(const f32x4 (&acc)[2][2][4][2], const Unit& u, int wr, int wc, int fr, int fq) const {
        const int row0 = u.pm * BM + wr * 64 + fr, col0 = u.pn * BM + wc * 32 + 8 * fq;
#pragma unroll
        for (int ai = 0; ai < 2; ++ai)
#pragma unroll
            for (int m = 0; m < 4; ++m) { bf16_t* rowp = O + (size_t)(row0 + ai * HALF + m * 16) * ldc + col0;
#pragma unroll
                for (int bj = 0; bj < 2; ++bj) *(u32x4*)(rowp + bj * HALF) = pack8(acc[ai][bj][m][0], acc[ai][bj][m][1]); }
    }
};
DEV u32x2 pack8_fp8(const f32x4 a, const f32x4 b) {
    f32x4 x = a, y = b;
#pragma unroll
    for (int i = 0; i < 4; ++i) { x[i] = __builtin_amdgcn_fmed3f(x[i], -440.f, 440.f); y[i] = __builtin_amdgcn_fmed3f(y[i], -440.f, 440.f); }
    int w0 = __builtin_amdgcn_cvt_pk_fp8_f32(x[0], x[1], 0, false); w0 = __builtin_amdgcn_cvt_pk_fp8_f32(x[2], x[3], w0, true);
    int w1 = __builtin_amdgcn_cvt_pk_fp8_f32(y[0], y[1], 0, false); w1 = __builtin_amdgcn_cvt_pk_fp8_f32(y[2], y[3], w1, true);
    return (u32x2){(unsigned)w0, (unsigned)w1};
}
struct EpiFp8 {
    static constexpr bool PERM = true;
    unsigned char* O; int ldc; int pad_;
    DEV void operator()(const f32x4 (&acc)[2][2][4][2], const Unit& u, int wr, int wc, int fr, int fq) const {
        const int row0 = u.pm * BM + wr * 64 + fr, col0 = u.pn * BM + wc * 32 + 8 * fq;
#pragma unroll
        for (int ai = 0; ai < 2; ++ai)
#pragma unroll
            for (int m = 0; m < 4; ++m) { unsigned char* rowp = O + (size_t)(row0 + ai * HALF + m * 16) * ldc + col0;
#pragma unroll
                for (int bj = 0; bj < 2; ++bj) { f32x4 a0 = acc[ai][bj][m][0], a1 = acc[ai][bj][m][1];
#pragma unroll
                    for (int i = 0; i < 4; ++i) { a0[i] = __builtin_amdgcn_fmed3f(a0[i], -440.f, 440.f); a1[i] = __builtin_amdgcn_fmed3f(a1[i], -440.f, 440.f); }
                    int w0 = __builtin_amdgcn_cvt_pk_fp8_f32(a0[0], a0[1], 0, false); w0 = __builtin_amdgcn_cvt_pk_fp8_f32(a0[2], a0[3], w0, true);
                    int w1 = __builtin_amdgcn_cvt_pk_fp8_f32(a1[0], a1[1], 0, false); w1 = __builtin_amdgcn_cvt_pk_fp8_f32(a1[2], a1[3], w1, true);
                    *(u32x2*)(rowp + bj * HALF) = (u32x2){(unsigned)w0, (unsigned)w1}; } }
    }
};
struct EpiGU {
    static constexpr bool PERM = true;
    unsigned char* H;
    DEV void operator()(const f32x4 (&acc)[2][2][4][2], const Unit& u, int wr, int wc, int fr, int fq) const {
        const int row0 = u.pm * BM + wr * 64 + fr, col0 = u.pn * HALF + wc * 32 + 8 * fq;
#pragma unroll
        for (int ai = 0; ai < 2; ++ai)
#pragma unroll
            for (int m = 0; m < 4; ++m) {
                f32x4 h0, h1;
#pragma unroll
                for (int i = 0; i < 4; ++i) { h0[i] = siluf(acc[ai][0][m][0][i]) * acc[ai][1][m][0][i]; h1[i] = siluf(acc[ai][0][m][1][i]) * acc[ai][1][m][1][i]; }
                *(u32x2*)(H + (size_t)(row0 + ai * HALF + m * 16) * ED + col0) = pack8_fp8(h0, h1);
            }
    }
};
struct EpiQKV {
    static constexpr bool PERM = true;
    bf16_t* O; const float* cosT; const float* sinT;
    DEV void operator()(const f32x4 (&acc)[2][2][4][2], const Unit& u, int wr, int wc, int fr, int fq) const {
        const int row0 = u.pm * BM + wr * 64 + fr, col0 = u.pn * BM + wc * 32 + 8 * fq;
        const bool rope = u.pn < 8; const float qs = u.pn < 4 ? 0.125f * 1.4426950408889634f : 1.f;
#pragma unroll
        for (int ai = 0; ai < 2; ++ai)
#pragma unroll
            for (int m = 0; m < 4; ++m) {
                const int row = row0 + ai * HALF + m * 16;
                bf16_t* rowp = O + (size_t)row * 3072 + col0;
                if (rope) {
                    const f32x4 cs = *(const f32x4*)(cosT + (size_t)row * 32 + 16 * (wc & 1) + 4 * fq), sn = *(const f32x4*)(sinT + (size_t)row * 32 + 16 * (wc & 1) + 4 * fq);
#pragma unroll
                    for (int bj = 0; bj < 2; ++bj) { const f32x4 x1 = acc[ai][bj][m][0], x2 = acc[ai][bj][m][1];
                        *(u32x4*)(rowp + bj * HALF) = pack8((x1 * cs - x2 * sn) * qs, (x2 * cs + x1 * sn) * qs); }
                } else {
#pragma unroll
                    for (int bj = 0; bj < 2; ++bj) *(u32x4*)(rowp + bj * HALF) = pack8(acc[ai][bj][m][0], acc[ai][bj][m][1]);
                }
            }
    }
};
}

template <class SrcF, bool OUT8 = false>
DEV void conv_item(const SrcF& src, int ldw, int K, void* dstv, LAS float* scr, int item, int nblk, int lane, const float wscale = 1.f) {
    const int kb = item / nblk, nb = item - kb * nblk, k0 = 64 * kb, n0 = 32 * nb;
    const int quad = lane & 7, r0 = lane >> 3;
    const float* colp = src(n0 + 4 * quad);
    f32x4 v[8];
#pragma unroll
    for (int i = 0; i < 8; ++i) v[i] = colp ? __builtin_nontemporal_load((const f32x4*)(colp + (size_t)(k0 + r0 + 8 * i) * ldw)) : (f32x4){0.f, 0.f, 0.f, 0.f};
#pragma unroll
    for (int i = 0; i < 8; ++i) { LAS float* p = scr + (r0 + 8 * i) * 33 + 4 * quad; p[0] = v[i][0]; p[1] = v[i][1]; p[2] = v[i][2]; p[3] = v[i][3]; }
    LDS_WAIT(); asm volatile("" ::: "memory");
    const int c = lane & 7;
#pragma unroll
    for (int j = 0; j < 4; ++j) { const int n = (lane >> 3) + 8 * j; const LAS float* s = scr + (8 * c) * 33 + n;
        if constexpr (OUT8) {
            int w0 = __builtin_amdgcn_cvt_pk_fp8_f32(s[0 * 33] * wscale, s[1 * 33] * wscale, 0, false); w0 = __builtin_amdgcn_cvt_pk_fp8_f32(s[2 * 33] * wscale, s[3 * 33] * wscale, w0, true);
            int w1 = __builtin_amdgcn_cvt_pk_fp8_f32(s[4 * 33] * wscale, s[5 * 33] * wscale, 0, false); w1 = __builtin_amdgcn_cvt_pk_fp8_f32(s[6 * 33] * wscale, s[7 * 33] * wscale, w1, true);
            *(u32x2*)((unsigned char*)dstv + (size_t)(n0 + n) * K + k0 + 8 * c) = (u32x2){(unsigned)w0, (unsigned)w1};
        } else {
            u32x4 o; o.x = pk2(s[0 * 33], s[1 * 33]); o.y = pk2(s[2 * 33], s[3 * 33]); o.z = pk2(s[4 * 33], s[5 * 33]); o.w = pk2(s[6 * 33], s[7 * 33]);
            *(u32x4*)((bf16_t*)dstv + (size_t)(n0 + n) * K + k0 + 8 * c) = o; } }
    LDS_WAIT(); asm volatile("" ::: "memory");
}
struct SrcIdent { const float* W; DEV const float* operator()(int n) const { return W + n; } };
struct SrcWin { const float* W; DEV const float* operator()(int n) const {
    int s; if (n < 4096) s = n; else if (n < 5632) s = C_XBC + (n - 4096); else if (n < 6656) s = C_ZB + (n - 5632); else if (n < 6672) s = C_BETA + (n - 6656); else if (n < 6688) s = C_DT + (n - 6672); else return nullptr;
    return W + s; } };
struct SrcQKV { const float* W; DEV const float* operator()(int n) const {
    if (n >= 2048) return W + n; const int hd = n >> 6, cp = n & 63; return W + hd * 64 + 32 * ((cp >> 2) & 1) + 16 * (cp >> 5) + 4 * ((cp >> 3) & 3) + (cp & 3); } };
struct SrcGU { const float* Wg; long du; DEV const float* operator()(int r) const { const int j = r >> 8, rr = r & 255; return Wg + (rr < 128 ? 0l : du) + 128 * j + (rr & 127); } };

DEV void load_row(const float* p, int lane, float (&v)[16]) {
#pragma unroll
    for (int j = 0; j < 4; ++j) { const f32x4 t = *(const f32x4*)(p + j * 256 + lane * 4); v[4 * j] = t[0]; v[4 * j + 1] = t[1]; v[4 * j + 2] = t[2]; v[4 * j + 3] = t[3]; }
}
DEV void store_row(float* p, int lane, const float (&v)[16]) {
#pragma unroll
    for (int j = 0; j < 4; ++j) *(f32x4*)(p + j * 256 + lane * 4) = (f32x4){v[4 * j], v[4 * j + 1], v[4 * j + 2], v[4 * j + 3]};
}
DEV float row_rstd(const float (&v)[16]) { float ss = 0.f;
#pragma unroll
    for (int i = 0; i < 16; ++i) ss += v[i] * v[i];
    return rsqrtf(wave_sum(ss) * (1.f / D) + EPS); }
DEV void resid_update(float (&xv)[16], const float (&yv)[16], const float* gpost, const float* gt, int lane) {
    const float r = row_rstd(yv);
#pragma unroll
    for (int j = 0; j < 4; ++j) { const f32x4 g = *(const f32x4*)(gpost + j * 256 + lane * 4), t = *(const f32x4*)(gt + j * 256 + lane * 4);
#pragma unroll
        for (int i = 0; i < 4; ++i) xv[4 * j + i] += t[i] * (yv[4 * j + i] * r * g[i]); }
}
DEV void prenorm_pack(const float (&xv)[16], const float* gpre, const float* sc, const float* sh, int lane, u32x2 (&o)[4]) {
    const float r = row_rstd(xv);
#pragma unroll
    for (int j = 0; j < 4; ++j) { const f32x4 g = *(const f32x4*)(gpre + j * 256 + lane * 4), s = *(const f32x4*)(sc + j * 256 + lane * 4), b = *(const f32x4*)(sh + j * 256 + lane * 4);
        float h[4];
#pragma unroll
        for (int i = 0; i < 4; ++i) h[i] = xv[4 * j + i] * r * g[i] * (1.f + s[i]) + b[i];
        o[j] = (u32x2){pk2(h[0], h[1]), pk2(h[2], h[3])}; }
}

DEV void load_row8(const float* p, int lane, float (&v)[16]) {
#pragma unroll
    for (int j = 0; j < 2; ++j)
#pragma unroll
        for (int hh = 0; hh < 2; ++hh) { const f32x4 t = *(const f32x4*)(p + 512 * j + 8 * lane + 4 * hh); v[8 * j + 4 * hh] = t[0]; v[8 * j + 4 * hh + 1] = t[1]; v[8 * j + 4 * hh + 2] = t[2]; v[8 * j + 4 * hh + 3] = t[3]; }
}
DEV void store_row8(float* p, int lane, const float (&v)[16]) {
#pragma unroll
    for (int j = 0; j < 2; ++j)
#pragma unroll
        for (int hh = 0; hh < 2; ++hh) *(f32x4*)(p + 512 * j + 8 * lane + 4 * hh) = (f32x4){v[8 * j + 4 * hh], v[8 * j + 4 * hh + 1], v[8 * j + 4 * hh + 2], v[8 * j + 4 * hh + 3]};
}
DEV void resid_update8(float (&xv)[16], const float (&yv)[16], const float* gpost, const float* gt, int lane) {
    const float r = row_rstd(yv);
#pragma unroll
    for (int j = 0; j < 2; ++j)
#pragma unroll
        for (int hh = 0; hh < 2; ++hh) { const f32x4 g = *(const f32x4*)(gpost + 512 * j + 8 * lane + 4 * hh), t = *(const f32x4*)(gt + 512 * j + 8 * lane + 4 * hh);
#pragma unroll
            for (int i = 0; i < 4; ++i) xv[8 * j + 4 * hh + i] += t[i] * (yv[8 * j + 4 * hh + i] * r * g[i]); }
}
DEV void prenorm_pack8(const float (&xv)[16], const float* gpre, const float* sc, const float* sh, int lane, u32x4 (&o)[2]) {
    const float r = row_rstd(xv);
#pragma unroll
    for (int j = 0; j < 2; ++j) { float h[8];
#pragma unroll
        for (int hh = 0; hh < 2; ++hh) { const f32x4 g = *(const f32x4*)(gpre + 512 * j + 8 * lane + 4 * hh), s = *(const f32x4*)(sc + 512 * j + 8 * lane + 4 * hh), b = *(const f32x4*)(sh + 512 * j + 8 * lane + 4 * hh);
#pragma unroll
            for (int i = 0; i < 4; ++i) h[4 * hh + i] = xv[8 * j + 4 * hh + i] * r * g[i] * (1.f + s[i]) + b[i]; }
        o[j] = (u32x4){pk2(h[0], h[1]), pk2(h[2], h[3]), pk2(h[4], h[5]), pk2(h[6], h[7])}; }
}
DEV void prenorm_pack8_f8(const float (&xv)[16], const float* gpre, const float* sc, const float* sh, int lane, u32x2 (&o)[2]) {
    const float r = row_rstd(xv);
#pragma unroll
    for (int j = 0; j < 2; ++j) { float h[8];
#pragma unroll
        for (int hh = 0; hh < 2; ++hh) { const f32x4 g = *(const f32x4*)(gpre + 512 * j + 8 * lane + 4 * hh), s = *(const f32x4*)(sc + 512 * j + 8 * lane + 4 * hh), b = *(const f32x4*)(sh + 512 * j + 8 * lane + 4 * hh);
#pragma unroll
            for (int i = 0; i < 4; ++i) h[4 * hh + i] = __builtin_amdgcn_fmed3f(xv[8 * j + 4 * hh + i] * r * g[i] * (1.f + s[i]) + b[i], -440.f, 440.f); }
        int w0 = __builtin_amdgcn_cvt_pk_fp8_f32(h[0], h[1], 0, false); w0 = __builtin_amdgcn_cvt_pk_fp8_f32(h[2], h[3], w0, true);
        int w1 = __builtin_amdgcn_cvt_pk_fp8_f32(h[4], h[5], 0, false); w1 = __builtin_amdgcn_cvt_pk_fp8_f32(h[6], h[7], w1, true);
        o[j] = (u32x2){(unsigned)w0, (unsigned)w1}; }
}
DEV void acc_row8(float (&yv)[16], const u32x2 w0, const u32x2 w1, const float g) {
#pragma unroll
    for (int e = 0; e < 2; ++e) {
        yv[4 * e] += g * __builtin_amdgcn_cvt_f32_fp8((int)w0[e], 0); yv[4 * e + 1] += g * __builtin_amdgcn_cvt_f32_fp8((int)w0[e], 1); yv[4 * e + 2] += g * __builtin_amdgcn_cvt_f32_fp8((int)w0[e], 2); yv[4 * e + 3] += g * __builtin_amdgcn_cvt_f32_fp8((int)w0[e], 3);
        yv[8 + 4 * e] += g * __builtin_amdgcn_cvt_f32_fp8((int)w1[e], 0); yv[8 + 4 * e + 1] += g * __builtin_amdgcn_cvt_f32_fp8((int)w1[e], 1); yv[8 + 4 * e + 2] += g * __builtin_amdgcn_cvt_f32_fp8((int)w1[e], 2); yv[8 + 4 * e + 3] += g * __builtin_amdgcn_cvt_f32_fp8((int)w1[e], 3); }
}

DEV void load_row_bf(const bf16_t* p, int lane, float (&v)[16]) {
#pragma unroll
    for (int j = 0; j < 4; ++j) { const u32x2 w = *(const u32x2*)(p + j * 256 + lane * 4); v[4 * j] = __uint_as_float(w.x << 16); v[4 * j + 1] = __uint_as_float(w.x & 0xFFFF0000u); v[4 * j + 2] = __uint_as_float(w.y << 16); v[4 * j + 3] = __uint_as_float(w.y & 0xFFFF0000u); }
}
DEV void store_row_bf(bf16_t* p, int lane, const float (&v)[16]) {
#pragma unroll
    for (int j = 0; j < 4; ++j) *(u32x2*)(p + j * 256 + lane * 4) = (u32x2){pk2(v[4 * j], v[4 * j + 1]), pk2(v[4 * j + 2], v[4 * j + 3])};
}
DEV void load_row8_bf(const bf16_t* p, int lane, float (&v)[16]) {
#pragma unroll
    for (int j = 0; j < 2; ++j) { const u32x4 w = *(const u32x4*)(p + 512 * j + 8 * lane);
#pragma unroll
        for (int e = 0; e < 4; ++e) { v[8 * j + 2 * e] = __uint_as_float(w[e] << 16); v[8 * j + 2 * e + 1] = __uint_as_float(w[e] & 0xFFFF0000u); } }
}
DEV void store_row8_bf(bf16_t* p, int lane, const float (&v)[16]) {
#pragma unroll
    for (int j = 0; j < 2; ++j) *(u32x4*)(p + 512 * j + 8 * lane) = (u32x4){pk2(v[8 * j], v[8 * j + 1]), pk2(v[8 * j + 2], v[8 * j + 3]), pk2(v[8 * j + 4], v[8 * j + 5]), pk2(v[8 * j + 6], v[8 * j + 7])};
}

struct Ctx { LAS unsigned char* lds; int tid, lane, wave, G, bid; };

DEV void ph_setup(const Args& a, const Ctx& X) {
    unsigned char* ws = a.ws;
    float* mod = (float*)(ws + WS_MOD);
    { LAS float* red = (LAS float*)X.lds;
      LAS float* sc = (LAS float*)(X.lds + 8192);
      for (int i = X.tid; i < NB * D; i += NTHR) sc[i] = siluf(a.c[i]);
      __syncthreads();
      const int kc = X.tid >> 6, cl = X.tid & 63;
      for (int task = X.bid; task < 2 * 96; task += X.G) {
          const int l = task / 96, col = (task % 96) * 64 + cl;
          const float* w = a.mod_w + (size_t)l * D * 6 * D + col;
          float p0 = 0.f, p1 = 0.f, p2 = 0.f, p3 = 0.f;
#pragma unroll 16
          for (int k = kc * 128; k < kc * 128 + 128; ++k) { const float wv = w[(size_t)k * 6 * D];
              p0 += sc[k] * wv; p1 += sc[D + k] * wv; p2 += sc[2 * D + k] * wv; p3 += sc[3 * D + k] * wv; }
          __syncthreads();
          red[(kc * 4 + 0) * 64 + cl] = p0; red[(kc * 4 + 1) * 64 + cl] = p1; red[(kc * 4 + 2) * 64 + cl] = p2; red[(kc * 4 + 3) * 64 + cl] = p3;
          __syncthreads();
          if (X.tid < 256) { const int b = X.tid >> 6; float s = a.mod_b[l * 6 * D + col];
#pragma unroll
              for (int q = 0; q < 8; ++q) s += red[(q * 4 + b) * 64 + cl];
              mod[(size_t)(l * NB + b) * 6 * D + col] = s; }
      }
      __syncthreads(); }
    { LAS float* scr = (LAS float*)(X.lds + X.wave * 8704);
      const int gw = X.bid * NWAVES + X.wave, NGW = X.G * NWAVES;
      constexpr int I_IN = (D / 64) * (NPROJ / 32);
      for (int it = gw; it < I_IN; it += NGW) {
          if (true) conv_item<SrcWin, true>(SrcWin{a.ssm_w_in}, PROJ, D, ws + WS_WIN8, scr, it, NPROJ / 32, X.lane, 64.f);
          else conv_item(SrcWin{a.ssm_w_in}, PROJ, D, (bf16_t*)(ws + WS_WIN) - (size_t)3072 * D, scr, it, NPROJ / 32, X.lane); }
    }
}
DEV void ph_setup_late(const Args& a, const Ctx& X, const int widx, const int nwg) {
    unsigned char* ws = a.ws;
    { float* cosT = (float*)(ws + WS_COS); float* sinT = (float*)(ws + WS_SIN);
      for (int idx = widx * NTHR + X.tid; idx < T * 32; idx += nwg * NTHR) { const int t = idx >> 5, i = idx & 31;
          const float ang = (float)a.pos[t] * powf(10000.f, -(float)i / 32.f); float sn, cs; sincosf(ang, &sn, &cs); cosT[idx] = cs; sinT[idx] = sn; } }
    { LAS float* scr = (LAS float*)(X.lds + X.wave * 8704);
      const int gw = widx * NWAVES + X.wave, NGW = nwg * NWAVES;
      constexpr int I_OUT = (2048 / 64) * (D / 32), I_QKV = (D / 64) * (3072 / 32), I_O = (D / 64) * (D / 32);
      for (int it = gw; it < I_OUT + I_QKV + I_O; it += NGW) {
          int r = it;
          if (r < I_OUT) { conv_item(SrcIdent{a.ssm_w_out}, D, 2048, (bf16_t*)(ws + WS_WOUT), scr, r, D / 32, X.lane); continue; } r -= I_OUT;
          if (r < I_QKV) { conv_item<SrcQKV, true>(SrcQKV{a.attn_w_qkv}, 3072, D, ws + WS_WQKV, scr, r, 3072 / 32, X.lane, 64.f); continue; } r -= I_QKV;
          conv_item<SrcIdent, true>(SrcIdent{a.attn_w_o}, D, D, ws + WS_WO, scr, r, D / 32, X.lane, 64.f);
      } }
}

DEV void ph_prenorm0(const Args& a, const Ctx& X) {
    const float* mod = (const float*)(a.ws + WS_MOD);
    bf16_t* hb = (bf16_t*)(a.ws + WS_H);
    for (int row = X.bid * NWAVES + X.wave; row < T; row += X.G * NWAVES) {
        const int b = row / SEQ; const float* ml = mod + (size_t)b * 6 * D;
        float xv[16]; load_row(a.x + (size_t)row * D, X.lane, xv);
        u32x2 o[4]; prenorm_pack(xv, a.mix_pre_g, ml + D, ml, X.lane, o);
#pragma unroll
        for (int j = 0; j < 4; ++j) {
            const float f0 = __uint_as_float(o[j].x << 16), f1 = __uint_as_float(o[j].x & 0xFFFF0000u), f2 = __uint_as_float(o[j].y << 16), f3 = __uint_as_float(o[j].y & 0xFFFF0000u);
            int wv = __builtin_amdgcn_cvt_pk_fp8_f32(__builtin_amdgcn_fmed3f(f0, -440.f, 440.f), __builtin_amdgcn_fmed3f(f1, -440.f, 440.f), 0, false); wv = __builtin_amdgcn_cvt_pk_fp8_f32(__builtin_amdgcn_fmed3f(f2, -440.f, 440.f), __builtin_amdgcn_fmed3f(f3, -440.f, 440.f), wv, true);
            *(unsigned*)(a.ws + WS_H8 + (size_t)row * D + j * 256 + X.lane * 4) = (unsigned)wv; }
    }
}

DEV bf16x8 acc_to_frag(const f32x4 lo, const f32x4 hi) { u32x4 w; w.x = pg8::cvt_pk_bf16(lo[0], lo[1]); w.y = pg8::cvt_pk_bf16(lo[2], lo[3]); w.z = pg8::cvt_pk_bf16(hi[0], hi[1]); w.w = pg8::cvt_pk_bf16(hi[2], hi[3]); return __builtin_bit_cast(bf16x8, w); }

DEV void gdn_solve8(LAS unsigned char* slots, LAS unsigned char* tfbase, const int wave, const int lane_in) {
    const int lane = lane_in;
    int wv_ = wave; asm volatile("" : "+s"(wv_));
    int ln_ = lane; asm volatile("" : "+v"(ln_));
    const int u = wv_ & 3, hf = wv_ >> 2, r16 = ln_ & 15, q4 = ln_ >> 4;
    LAS float* M = (LAS float*)(slots + u * 16384);
    LAS unsigned short* tf = (LAS unsigned short*)(tfbase + u * 8192);
    { const int c0 = 32 * hf, col = c0 + (lane & 31);
      for (int rb = 0; rb < 8; ++rb) {
          const int i0 = c0 + 4 * rb;
          float a0 = (col == i0) ? 1.f : 0.f, a1 = (col == i0 + 1) ? 1.f : 0.f, a2 = (col == i0 + 2) ? 1.f : 0.f, a3 = (col == i0 + 3) ? 1.f : 0.f;
          for (int j = c0; j < i0; j += 4) {
              const float t0 = M[j * 64 + col], t1 = M[(j + 1) * 64 + col], t2 = M[(j + 2) * 64 + col], t3 = M[(j + 3) * 64 + col];
              const f32x4 r0 = *(const LAS f32x4*)(M + i0 * 64 + j), r1 = *(const LAS f32x4*)(M + (i0 + 1) * 64 + j), r2 = *(const LAS f32x4*)(M + (i0 + 2) * 64 + j), r3 = *(const LAS f32x4*)(M + (i0 + 3) * 64 + j);
              a0 -= r0[0] * t0 + r0[1] * t1 + r0[2] * t2 + r0[3] * t3; a1 -= r1[0] * t0 + r1[1] * t1 + r1[2] * t2 + r1[3] * t3;
              a2 -= r2[0] * t0 + r2[1] * t1 + r2[2] * t2 + r2[3] * t3; a3 -= r3[0] * t0 + r3[1] * t1 + r3[2] * t2 + r3[3] * t3;
          }
          const f32x4 d1 = *(const LAS f32x4*)(M + (i0 + 1) * 64 + i0), d2 = *(const LAS f32x4*)(M + (i0 + 2) * 64 + i0), d3 = *(const LAS f32x4*)(M + (i0 + 3) * 64 + i0);
          a1 -= d1[0] * a0; a2 -= d2[0] * a0 + d2[1] * a1; a3 -= d3[0] * a0 + d3[1] * a1 + d3[2] * a2;
          M[i0 * 64 + col] = a0; M[(i0 + 1) * 64 + col] = a1; M[(i0 + 2) * 64 + col] = a2; M[(i0 + 3) * 64 + col] = a3;
      } }
    __syncthreads();
    {
        f32x4 acc0 = {0.f, 0.f, 0.f, 0.f}, acc1 = {0.f, 0.f, 0.f, 0.f};
#pragma unroll 2
        for (int ks = 0; ks < 8; ++ks) { const float av = M[(32 + 16 * hf + r16) * 64 + 4 * ks + q4], b0 = M[(4 * ks + q4) * 64 + r16], b1 = M[(4 * ks + q4) * 64 + 16 + r16];
            acc0 = __builtin_amdgcn_mfma_f32_16x16x4f32(av, b0, acc0, 0, 0, 0); acc1 = __builtin_amdgcn_mfma_f32_16x16x4f32(av, b1, acc1, 0, 0, 0); }
#pragma unroll
        for (int r = 0; r < 4; ++r) { M[(16 * hf + 4 * q4 + r) * 64 + 32 + r16] = acc0[r]; M[(16 * hf + 4 * q4 + r) * 64 + 48 + r16] = acc1[r]; }
    }
    __syncthreads();
    {
        f32x4 acc0 = {0.f, 0.f, 0.f, 0.f}, acc1 = {0.f, 0.f, 0.f, 0.f};
#pragma unroll 2
        for (int ks = 0; ks < 8; ++ks) { const float av = M[(32 + 16 * hf + r16) * 64 + 32 + 4 * ks + q4], b0 = M[(4 * ks + q4) * 64 + 32 + r16], b1 = M[(4 * ks + q4) * 64 + 48 + r16];
            acc0 = __builtin_amdgcn_mfma_f32_16x16x4f32(av, b0, acc0, 0, 0, 0); acc1 = __builtin_amdgcn_mfma_f32_16x16x4f32(av, b1, acc1, 0, 0, 0); }
        __syncthreads();
#pragma unroll
        for (int r = 0; r < 4; ++r) { M[(32 + 16 * hf + 4 * q4 + r) * 64 + r16] = -acc0[r]; M[(32 + 16 * hf + 4 * q4 + r) * 64 + 16 + r16] = -acc1[r]; }
    }
    __syncthreads();
    const int cq = (lane >> 2) & 3, ca = (lane >> 4) & 1, ce = lane & 3, cks = lane >> 5;
#pragma unroll 8
    for (int i = 32 * hf; i < 32 * hf + 32; ++i) tf[((i >> 4) * 2 + cks) * 512 + ((i & 15) + 16 * cq) * 8 + 4 * ca + ce] = (unsigned short)f2bf(lane > i ? 0.f : M[i * 64 + lane]);
}
DEV void ph_gdn_local(const Args& a, const Ctx& X) {
    const bf16_t* qkvpre = (const bf16_t*)(a.ws + WS_QKVPRE); const float* small = (const float*)(a.ws + WS_SMALL);
    unsigned char* gi = a.ws + WS_GI; float* glast = (float*)(a.ws + WS_GLAST);
    constexpr int KP = 272;
    LAS unsigned char* kN = X.lds; LAS unsigned char* qN = X.lds + 64 * KP; LAS unsigned char* slots = X.lds + 128 * KP;
    LAS float* gcL = (LAS float*)(X.lds + 143360); LAS float* btL = gcL + 8 * 64;
    LAS unsigned char* stg = X.lds + 100352;
    const int lane = X.lane, wave = X.wave, r16 = lane & 15, q4 = lane >> 4;
    const float scale = 0.08838834764831845f;
    for (int wu = X.bid; wu < NB * 64; wu += X.G) {
        const int b = wu >> 6, n = wu & 63; const size_t t0 = (size_t)b * SEQ + 64 * n;
        unsigned char* tmp = a.ws + WS_GTMP + (size_t)X.bid * 131072;
        __syncthreads();
        {
            const float g = -__expf(a.gdn_a_log[wave]) * softplusf(small[(t0 + lane) * 32 + 8 + wave] + a.gdn_dt_bias[wave]);
            float gc = g;
#pragma unroll
            for (int o = 1; o < 64; o <<= 1) { const float v = __shfl_up(gc, o); if (lane >= o) gc += v; }
            gcL[wave * 64 + lane] = gc; btL[wave * 64 + lane] = sigmoidf_(small[(t0 + lane) * 32 + wave]);
            if (lane == 63) glast[(size_t)((b * 8 + wave) * 64 + n) * 32] = gc;
        }
        __syncthreads();
        unsigned xr[3][11];
#define GDN_LOADX(hh) do { _Pragma("unroll") for (int _p = 0; _p < 3; ++_p) _Pragma("unroll") for (int _i = 0; _i < 11; ++_i) { const int _tk = 8 * wave + _i - 3; unsigned _v = 0u; \
            if (64 * n + _tk >= 0) _v = *(const unsigned*)(qkvpre + (t0 + _tk) * 3072 + _p * 1024 + (hh) * 128 + 2 * lane); xr[_p][_i] = _v; } } while (0)
        GDN_LOADX(0);
        for (int bb = 0; bb < 2; ++bb) {
            for (int j = 0; j < 4; ++j) {
                const int h = bb * 4 + j; unsigned char* ub = gi + (size_t)((b * 8 + h) * 64 + n) * GI_UNIT;
                {
                    const float gl = gcL[h * 64 + 63];
                    const int blk = wave >> 2, pa = (wave & 3) >> 1, pq0 = 2 * (wave & 1);
                    const int ca = (2 * lane >> 4) & 1, cq = (2 * lane >> 2) & 3, ce = (2 * lane) & 3, cks = (2 * lane) >> 5;
#pragma unroll
                    for (int part = 0; part < 3; ++part) {
                        const int col = part * 1024 + h * 128 + 2 * lane;
                        float w0[4], w1[4];
#pragma unroll
                        for (int i = 0; i < 4; ++i) { const f32x2 t = *(const f32x2*)(a.gdn_conv_w + i * 3072 + col); w0[i] = t.x; w1[i] = t.y; }
                        float x0[11], x1[11];
#pragma unroll
                        for (int i = 0; i < 11; ++i) { const unsigned v = xr[part][i]; x0[i] = __uint_as_float(v << 16); x1[i] = __uint_as_float(v & 0xFFFF0000u); }
                        float v0[8], v1[8];
#pragma unroll
                        for (int i = 0; i < 8; ++i) { v0[i] = siluf(w0[0] * x0[i] + w0[1] * x0[i + 1] + w0[2] * x0[i + 2] + w0[3] * x0[i + 3]); v1[i] = siluf(w1[0] * x1[i] + w1[1] * x1[i + 1] + w1[2] * x1[i + 2] + w1[3] * x1[i + 3]); }
                        if (part < 2) {
#pragma unroll
                            for (int i = 0; i < 8; ++i) { const float r = rsqrtf(wave_sum(v0[i] * v0[i] + v1[i] * v1[i]) + 1e-6f); v0[i] *= r; v1[i] *= r; }
                        }
                        for (int rep_ = 0; rep_ < (((PROBE_MASK >> 21) & 1u) ? 2 : 1); ++rep_) {
                        if (part == 0) {
#pragma unroll
                            for (int i = 0; i < 8; ++i) { const int tok = 8 * wave + i; const float eg = __expf(gcL[h * 64 + tok]) * scale;
                                *(LAS unsigned*)(qN + tok * KP + lane * 4) = pk2(v0[i], v1[i]);
                                *(LAS unsigned*)(stg + ((tok >> 4) * 4 + cks) * 1024 + ((tok & 15) + 16 * cq) * 16 + (4 * ca + ce) * 2) = pk2(v0[i] * eg, v1[i] * eg); }
                        } else if (part == 1) {
                            unsigned short kg0[8], kg1[8], ke0[8], ke1[8];
#pragma unroll
                            for (int i = 0; i < 8; ++i) { const int tok = 8 * wave + i; const float gc = gcL[h * 64 + tok], bt = btL[h * 64 + tok], eg = __expf(gc) * bt, eend = __expf(gl - gc);
                                *(LAS unsigned*)(kN + tok * KP + lane * 4) = pk2(v0[i], v1[i]);
                                kg0[i] = (unsigned short)f2bf(v0[i] * eg); kg1[i] = (unsigned short)f2bf(v1[i] * eg); ke0[i] = (unsigned short)f2bf(v0[i] * eend); ke1[i] = (unsigned short)f2bf(v1[i] * eend); }
#pragma unroll
                            for (int hf = 0; hf < 2; ++hf) { const int pos = 32 * blk + 8 * (pq0 + hf) + 4 * pa; const int cl = 2 * lane;
                                *(u32x2*)(tmp + (size_t)j * 32768 + 16384 + cl * 128 + pos * 2) = (u32x2){(unsigned)kg0[4 * hf] | ((unsigned)kg0[4 * hf + 1] << 16), (unsigned)kg0[4 * hf + 2] | ((unsigned)kg0[4 * hf + 3] << 16)};
                                *(u32x2*)(tmp + (size_t)j * 32768 + 16384 + (cl + 1) * 128 + pos * 2) = (u32x2){(unsigned)kg1[4 * hf] | ((unsigned)kg1[4 * hf + 1] << 16), (unsigned)kg1[4 * hf + 2] | ((unsigned)kg1[4 * hf + 3] << 16)};
                                *(LAS u32x2*)(stg + 16384 + ((cl >> 4) * 2 + blk) * 1024 + ((cl & 15) + 16 * (pq0 + hf)) * 16 + (4 * pa) * 2) = (u32x2){(unsigned)ke0[4 * hf] | ((unsigned)ke0[4 * hf + 1] << 16), (unsigned)ke0[4 * hf + 2] | ((unsigned)ke0[4 * hf + 3] << 16)};
                                *(LAS u32x2*)(stg + 16384 + (((cl + 1) >> 4) * 2 + blk) * 1024 + (((cl + 1) & 15) + 16 * (pq0 + hf)) * 16 + (4 * pa) * 2) = (u32x2){(unsigned)ke1[4 * hf] | ((unsigned)ke1[4 * hf + 1] << 16), (unsigned)ke1[4 * hf + 2] | ((unsigned)ke1[4 * hf + 3] << 16)}; }
                        } else {
                            unsigned short vb0[8], vb1[8];
#pragma unroll
                            for (int i = 0; i < 8; ++i) { const float bt = btL[h * 64 + 8 * wave + i]; vb0[i] = (unsigned short)f2bf(v0[i] * bt); vb1[i] = (unsigned short)f2bf(v1[i] * bt); }
#pragma unroll
                            for (int hf = 0; hf < 2; ++hf) { const int pos = 32 * blk + 8 * (pq0 + hf) + 4 * pa; const int cl = 2 * lane;
                                *(u32x2*)(tmp + (size_t)j * 32768 + cl * 128 + pos * 2) = (u32x2){(unsigned)vb0[4 * hf] | ((unsigned)vb0[4 * hf + 1] << 16), (unsigned)vb0[4 * hf + 2] | ((unsigned)vb0[4 * hf + 3] << 16)};
                                *(u32x2*)(tmp + (size_t)j * 32768 + (cl + 1) * 128 + pos * 2) = (u32x2){(unsigned)vb1[4 * hf] | ((unsigned)vb1[4 * hf + 1] << 16), (unsigned)vb1[4 * hf + 2] | ((unsigned)vb1[4 * hf + 3] << 16)}; }
                        }
                        asm volatile("" ::: "memory"); }
                    }
                }
                if (h + 1 < 8) GDN_LOADX(h + 1);
                __syncthreads();
                {
#pragma unroll
                    for (int i = 0; i < 4; ++i) *(u32x4*)(ub + 16384 + (X.tid + 512 * i) * 16) = *(const LAS u32x4*)(stg + (X.tid + 512 * i) * 16);
                    const int mat = wave >> 2, rt = wave & 3; LAS unsigned char* An = mat ? qN : kN;
                    bf16x8 af[4];
#pragma unroll
                    for (int ks = 0; ks < 4; ++ks) af[ks] = *(const LAS bf16x8*)(An + (16 * rt + r16) * KP + (32 * ks + 8 * q4) * 2);
                    LAS float* slot = (LAS float*)(slots + j * 16384);
                    bf16x8 bfk[4][4];
#pragma unroll
                    for (int ct = 0; ct < 4; ++ct)
#pragma unroll
                        for (int ks = 0; ks < 4; ++ks) bfk[ct][ks] = *(const LAS bf16x8*)(kN + (16 * ct + r16) * KP + (32 * ks + 8 * q4) * 2);
                    __builtin_amdgcn_sched_barrier(0);
#pragma unroll
                    for (int ct = 0; ct < 4; ++ct) { f32x4 acc = {0.f, 0.f, 0.f, 0.f};
#pragma unroll
                        for (int ks = 0; ks < 4; ++ks) acc = __builtin_amdgcn_mfma_f32_16x16x32_bf16(af[ks], bfk[ct][ks], acc, 0, 0, 0);
                        const int jc = 16 * ct + r16; const float gj = gcL[h * 64 + jc];
#pragma unroll
                        for (int rg = 0; rg < 4; ++rg) { const int i = 16 * rt + 4 * q4 + rg; const float dec = __expf(gcL[h * 64 + i] - gj);
                            if (mat == 0) { slot[i * 64 + jc] = jc < i ? btL[h * 64 + i] * acc[rg] * dec : 0.f; }
                            else { const float v = jc <= i ? acc[rg] * scale * dec : 0.f;
                                *(LAS unsigned short*)(stg + 32768 + (rt * 2 + (ct >> 1)) * 1024 + ((4 * q4 + rg) + 16 * (r16 >> 2)) * 16 + (4 * (ct & 1) + (r16 & 3)) * 2) = (unsigned short)f2bf(v); } }
                    }
                }
                __syncthreads();
                *(u32x4*)(ub + 49152 + X.tid * 16) = *(const LAS u32x4*)(stg + 32768 + X.tid * 16);
            }
            gdn_solve8(slots, X.lds, wave, lane);
            VM_WAIT(); __syncthreads();
            {
                const int mat = wave >> 2;
                u32x4 bq[2][2], bn[2][2];
#define P3_LOAD(jj, dst) do { _Pragma("unroll") for (int cx = 0; cx < 2; ++cx) _Pragma("unroll") for (int ks = 0; ks < 2; ++ks) \
                    dst[cx][ks] = __builtin_nontemporal_load((const u32x4*)(tmp + (size_t)(jj) * 32768 + mat * 16384 + (16 * (2 * (wave & 3) + cx) + r16) * 128 + (32 * ks + 8 * q4) * 2)); } while (0)
                P3_LOAD(0, bq);
                for (int j = 0; j < 4; ++j) {
                    const int h = bb * 4 + j; unsigned char* ub = gi + (size_t)((b * 8 + h) * 64 + n) * GI_UNIT;
                    LAS unsigned char* slot = X.lds + j * 8192;
                    if (j + 1 < 4) P3_LOAD(j + 1, bn);
                    bf16x8 tfr[4][2];
#pragma unroll
                    for (int rt = 0; rt < 4; ++rt)
#pragma unroll
                        for (int ks = 0; ks < 2; ++ks) tfr[rt][ks] = *(const LAS bf16x8*)(slot + (rt * 2 + ks) * 1024 + lane * 16);
                    __builtin_amdgcn_sched_barrier(0);
#pragma unroll
                    for (int cx = 0; cx < 2; ++cx) { const int ct = 2 * (wave & 3) + cx;
#pragma unroll
                        for (int rt = 0; rt < 4; ++rt) { f32x4 acc = {0.f, 0.f, 0.f, 0.f};
#pragma unroll
                            for (int ks = 0; ks < 2; ++ks) acc = __builtin_amdgcn_mfma_f32_16x16x32_bf16(tfr[rt][ks], __builtin_bit_cast(bf16x8, bq[cx][ks]), acc, 0, 0, 0);
                            if (mat == 0) *(u32x2*)(ub + 57344 + (rt * 8 + ct) * 512 + lane * 8) = (u32x2){pg8::cvt_pk_bf16(acc[0], acc[1]), pg8::cvt_pk_bf16(acc[2], acc[3])};
                            else {
#pragma unroll
                                for (int rg = 0; rg < 4; ++rg) *(unsigned short*)(ub + (rt * 4 + (ct >> 1)) * 1024 + ((4 * q4 + rg) + 16 * (r16 >> 2)) * 16 + (4 * (ct & 1) + (r16 & 3)) * 2) = (unsigned short)f2bf(-acc[rg]);
                            }
                        }
                    }
#pragma unroll
                    for (int cx = 0; cx < 2; ++cx)
#pragma unroll
                        for (int ks = 0; ks < 2; ++ks) bq[cx][ks] = bn[cx][ks];
                }
#undef P3_LOAD
            }
            __syncthreads();
        }
    }
}
DEV void ph_gdn_scan(const Args& a, const Ctx& X) {
    const unsigned char* gi = a.ws + WS_GI; const float* glast = (const float*)(a.ws + WS_GLAST);
    const bf16_t* za = (const bf16_t*)(a.ws + WS_ZA); bf16_t* oy = (bf16_t*)(a.ws + WS_OY);
    const int lane = X.lane, wave = X.wave, r16 = lane & 15, q4 = lane >> 4, tid = X.tid;
    LAS float* OT = (LAS float*)(X.lds + 114688);
    const int bh = X.bid, b = bh >> 3, h = bh & 7;
    const unsigned char* ubase = gi + (size_t)bh * 64 * GI_UNIT;
    f32x4 S[8];
#pragma unroll
    for (int i = 0; i < 8; ++i) S[i] = (f32x4){0.f, 0.f, 0.f, 0.f};
    LAS float* NWL = (LAS float*)(X.lds + 149504);
    if (tid < 128) NWL[tid] = a.gdn_norm_w[tid];
#define GDN_STAGE(nn, buf) do { _Pragma("unroll") for (int _i = 0; _i < 7; ++_i) \
        __builtin_amdgcn_global_load_lds((const unsigned*)(ubase + (size_t)(nn) * GI_UNIT + (size_t)(tid + 512 * _i) * 16), (LAS unsigned*)(X.lds + (buf) * 57344 + (wave * 64 + 512 * _i) * 16), 16, 0, 2); } while (0)
    u32x2 udn[4]; float gln; u32x4 zn[2];
    { const size_t tz = (size_t)b * SEQ + (tid >> 3); zn[0] = __builtin_nontemporal_load((const u32x4*)(za + tz * 1024 + h * 128 + 16 * (tid & 7))); zn[1] = __builtin_nontemporal_load((const u32x4*)(za + tz * 1024 + h * 128 + 16 * (tid & 7) + 8)); }
#pragma unroll
    for (int ct = 0; ct < 4; ++ct) udn[ct] = __builtin_nontemporal_load((const u32x2*)(ubase + 57344 + (ct * 8 + wave) * 512 + lane * 8));
    gln = glast[(size_t)(bh * 64) * 32];
    GDN_STAGE(0, 0);
#define GDN_EPILOGUE(nn, ZC) do { const int tok = tid >> 3, seg = tid & 7; const size_t t = (size_t)b * SEQ + 64 * (nn) + tok; \
            float ov[16]; float ss = 0.f; float nwv[16]; \
            _Pragma("unroll") for (int i = 0; i < 4; ++i) { const f32x4 v = *(const LAS f32x4*)(NWL + 16 * seg + 4 * i); nwv[4 * i] = v[0]; nwv[4 * i + 1] = v[1]; nwv[4 * i + 2] = v[2]; nwv[4 * i + 3] = v[3]; } \
            _Pragma("unroll") for (int i = 0; i < 4; ++i) { const f32x4 v = *(const LAS f32x4*)(OT + tok * 132 + 16 * seg + 4 * i); ov[4 * i] = v[0]; ov[4 * i + 1] = v[1]; ov[4 * i + 2] = v[2]; ov[4 * i + 3] = v[3]; ss += v[0] * v[0] + v[1] * v[1] + v[2] * v[2] + v[3] * v[3]; } \
            ss = sum8(ss); \
            const float rstd = rsqrtf(ss * (1.f / 128.f) + EPS); \
            u32x4 ow[2]; \
            _Pragma("unroll") for (int i = 0; i < 2; ++i) _Pragma("unroll") for (int e = 0; e < 4; ++e) { const unsigned zw = (ZC)[i][e]; const float z0 = __uint_as_float(zw << 16), z1 = __uint_as_float(zw & 0xFFFF0000u); \
                    ow[i][e] = pg8::cvt_pk_bf16(ov[8 * i + 2 * e] * rstd * nwv[8 * i + 2 * e] * siluf(z0), ov[8 * i + 2 * e + 1] * rstd * nwv[8 * i + 2 * e + 1] * siluf(z1)); } \
            *(u32x4*)(oy + t * 2048 + h * 128 + 16 * seg) = ow[0]; *(u32x4*)(oy + t * 2048 + h * 128 + 16 * seg + 8) = ow[1]; } while (0)
    u32x4 zp[2] = {{0u, 0u, 0u, 0u}, {0u, 0u, 0u, 0u}};
    for (int n = 0; n < 64; ++n) {
        VM_WAIT(); __syncthreads();
        f32x4 uf[4];
#pragma unroll
        for (int ct = 0; ct < 4; ++ct) { uf[ct][0] = __uint_as_float(udn[ct].x << 16); uf[ct][1] = __uint_as_float(udn[ct].x & 0xFFFF0000u); uf[ct][2] = __uint_as_float(udn[ct].y << 16); uf[ct][3] = __uint_as_float(udn[ct].y & 0xFFFF0000u); }
        const float egl = __expf(gln);
        u32x4 zc[2]; zc[0] = zn[0]; zc[1] = zn[1];
        asm volatile("" : "+v"(uf[0]), "+v"(uf[1]), "+v"(uf[2]), "+v"(uf[3]), "+v"(zc[0]), "+v"(zc[1]));
        if (n + 1 < 64) {
            const unsigned char* un = ubase + (size_t)(n + 1) * GI_UNIT;
#pragma unroll
            for (int ct = 0; ct < 4; ++ct) udn[ct] = __builtin_nontemporal_load((const u32x2*)(un + 57344 + (ct * 8 + wave) * 512 + lane * 8));
            gln = glast[(size_t)(bh * 64 + n + 1) * 32];
            { const size_t tz = (size_t)b * SEQ + 64 * (n + 1) + (tid >> 3); zn[0] = __builtin_nontemporal_load((const u32x4*)(za + tz * 1024 + h * 128 + 16 * (tid & 7))); zn[1] = __builtin_nontemporal_load((const u32x4*)(za + tz * 1024 + h * 128 + 16 * (tid & 7) + 8)); }
            GDN_STAGE(n + 1, (n + 1) & 1);
        }
        if (n > 0) GDN_EPILOGUE(n - 1, zp);
        zp[0] = zc[0]; zp[1] = zc[1];
        const LAS unsigned char* L = X.lds + (n & 1) * 57344;
        bf16x8 sB[4];
#pragma unroll
        for (int ks = 0; ks < 4; ++ks) sB[ks] = acc_to_frag(S[2 * ks], S[2 * ks + 1]);
#define GS_LD(off) (*(const LAS bf16x8*)(L + (off) + lane * 16))
#define GS_LOADWQ(dst, ct) do { _Pragma("unroll") for (int _k = 0; _k < 4; ++_k) { dst[_k] = GS_LD(((ct) * 4 + _k) * 1024); dst[4 + _k] = GS_LD(16384 + ((ct) * 4 + _k) * 1024); } } while (0)
#define GS_LOAD8(dst, base) do { _Pragma("unroll") for (int _k = 0; _k < 8; ++_k) dst[_k] = GS_LD((base) + _k * 1024); } while (0)
#define GS_WQ(src, ct) do { f32x4 acc = {0.f, 0.f, 0.f, 0.f}, ao = {0.f, 0.f, 0.f, 0.f}; \
            _Pragma("unroll") for (int _k = 0; _k < 4; ++_k) { acc = __builtin_amdgcn_mfma_f32_16x16x32_bf16(src[_k], sB[_k], acc, 0, 0, 0); ao = __builtin_amdgcn_mfma_f32_16x16x32_bf16(src[4 + _k], sB[_k], ao, 0, 0, 0); } \
            vn[ct] = acc; oo[ct] = ao; } while (0)
#define GS_SB __builtin_amdgcn_sched_barrier(0)
        f32x4 vn[4], oo[4];
        bf16x8 fa[8], fb[8];
        GS_LOADWQ(fa, 0); GS_SB;
        GS_LOADWQ(fb, 1); GS_SB; GS_WQ(fa, 0); GS_SB;
        GS_LOADWQ(fa, 2); GS_SB; GS_WQ(fb, 1); GS_SB;
        GS_LOADWQ(fb, 3); GS_SB; GS_WQ(fa, 2); GS_SB;
        GS_LOAD8(fa, 49152); GS_SB; GS_WQ(fb, 3); GS_SB;
#pragma unroll
        for (int ct = 0; ct < 4; ++ct) vn[ct] = vn[ct] + uf[ct];
        bf16x8 vB[2];
#pragma unroll
        for (int ks = 0; ks < 2; ++ks) vB[ks] = acc_to_frag(vn[2 * ks], vn[2 * ks + 1]);
        GS_SB; GS_LOAD8(fb, 32768); GS_SB;
#pragma unroll
        for (int ct = 0; ct < 4; ++ct)
#pragma unroll
            for (int ks = 0; ks < 2; ++ks) oo[ct] = __builtin_amdgcn_mfma_f32_16x16x32_bf16(fa[ct * 2 + ks], vB[ks], oo[ct], 0, 0, 0);
        GS_SB; GS_LOAD8(fa, 32768 + 8192); GS_SB;
#pragma unroll
        for (int dt = 0; dt < 4; ++dt) { f32x4 acc = S[dt] * egl;
#pragma unroll
            for (int ks = 0; ks < 2; ++ks) acc = __builtin_amdgcn_mfma_f32_16x16x32_bf16(fb[dt * 2 + ks], vB[ks], acc, 0, 0, 0);
            S[dt] = acc; }
        GS_SB;
#pragma unroll
        for (int dt = 4; dt < 8; ++dt) { f32x4 acc = S[dt] * egl;
#pragma unroll
            for (int ks = 0; ks < 2; ++ks) acc = __builtin_amdgcn_mfma_f32_16x16x32_bf16(fa[(dt - 4) * 2 + ks], vB[ks], acc, 0, 0, 0);
            S[dt] = acc; }
#undef GS_LD
#undef GS_LOADWQ
#undef GS_LOAD8
#undef GS_WQ
#undef GS_SB
        __syncthreads();
#pragma unroll
        for (int ct = 0; ct < 4; ++ct)
#pragma unroll
            for (int rg = 0; rg < 4; ++rg) OT[(16 * ct + 4 * q4 + rg) * 132 + 16 * wave + r16] = oo[ct][rg];
    }
    __syncthreads();
    GDN_EPILOGUE(63, zp);
#undef GDN_EPILOGUE
#undef GDN_STAGE
}

constexpr int SP = 272;
DEV void ph_ssd_local(const Args& a, const Ctx& X, const int wg0) {
    const bf16_t* xbcpre = (const bf16_t*)(a.ws + WS_XBCPRE); const float* small = (const float*)(a.ws + WS_SMALL);
    bf16_t* CC = (bf16_t*)(a.ws + WS_CC); float* acum = (float*)(a.ws + WS_ACUM); float* cdec = (float*)(a.ws + WS_CDEC);
    bf16_t* ydiag = (bf16_t*)(a.ws + WS_YDIAG); bf16_t* states = (bf16_t*)(a.ws + WS_STATES);
    LAS unsigned char* Bn = X.lds; LAS unsigned char* Cn = X.lds + 128 * SP; LAS unsigned char* BT = X.lds + 256 * SP;
    LAS unsigned char* xdT = X.lds; LAS unsigned char* xeT = X.lds + 64 * SP;
    LAS float* acL = (LAS float*)(X.lds + AUX_OFF); LAS float* dtL = acL + 8 * 128;
    const int lane = X.lane, wave = X.wave, r16 = lane & 15, q4 = lane >> 4;
    for (int unit = X.bid - wg0; unit < NB * 32 * 2; unit += X.G - wg0) {
        const int g = unit & 1, c = (unit >> 1) & 31, b = unit >> 6; const size_t t0 = (size_t)b * SEQ + 128 * c;
        __syncthreads();
        {
            const int hd = g * 8 + wave; const float an = -__expf(a.ssd_a_log[hd]), bias = a.ssd_dt_bias[hd];
            const float d0 = softplusf(small[(t0 + lane) * 32 + 16 + hd] + bias), d1 = softplusf(small[(t0 + 64 + lane) * 32 + 16 + hd] + bias);
            float s0 = d0 * an, s1 = d1 * an;
#pragma unroll
            for (int o = 1; o < 64; o <<= 1) { const float v0 = __shfl_up(s0, o), v1 = __shfl_up(s1, o); if (lane >= o) { s0 += v0; s1 += v1; } }
            s1 += __shfl(s0, 63);
            acL[wave * 128 + lane] = s0; acL[wave * 128 + 64 + lane] = s1; dtL[wave * 128 + lane] = d0; dtL[wave * 128 + 64 + lane] = d1;
            acum[((size_t)g * T + t0 + lane) * 8 + wave] = s0; acum[((size_t)g * T + t0 + 64 + lane) * 8 + wave] = s1;
            if (lane == 63) cdec[(size_t)unit * 32 + wave] = __expf(s1);
        }
        {
            const int isC = lane >> 5, cc = (lane & 31) * 4, col = 1024 + isC * 256 + g * 128 + cc;
            float w[4][4], bs[4];
#pragma unroll
            for (int i = 0; i < 4; ++i) { const f32x4 t = *(const f32x4*)(a.ssd_conv_w + i * 1536 + col); w[i][0] = t[0]; w[i][1] = t[1]; w[i][2] = t[2]; w[i][3] = t[3]; }
            { const f32x4 t = *(const f32x4*)(a.ssd_conv_b + col); bs[0] = t[0]; bs[1] = t[1]; bs[2] = t[2]; bs[3] = t[3]; }
            float xin[19][4];
#pragma unroll
            for (int i = 0; i < 19; ++i) { const int tk = 16 * wave + i - 3; const bool ok = (128 * c + tk) >= 0; u32x2 v = {0u, 0u}; if (ok) v = __builtin_nontemporal_load((const u32x2*)(xbcpre + (t0 + tk) * 1536 + col));
                xin[i][0] = __uint_as_float(v.x << 16); xin[i][1] = __uint_as_float(v.x & 0xFFFF0000u); xin[i][2] = __uint_as_float(v.y << 16); xin[i][3] = __uint_as_float(v.y & 0xFFFF0000u); }
            unsigned short ov[16][4];
#pragma unroll
            for (int i = 0; i < 16; ++i)
#pragma unroll
                for (int e = 0; e < 4; ++e) { const float s = bs[e] + w[0][e] * xin[i][e] + w[1][e] * xin[i + 1][e] + w[2][e] * xin[i + 2][e] + w[3][e] * xin[i + 3][e]; ov[i][e] = (unsigned short)f2bf(siluf(s)); }
            LAS unsigned char* nat = isC ? Cn : Bn;
#pragma unroll
            for (int i = 0; i < 16; ++i) { const u32x2 pk = {(unsigned)ov[i][0] | ((unsigned)ov[i][1] << 16), (unsigned)ov[i][2] | ((unsigned)ov[i][3] << 16)};
                *(LAS u32x2*)(nat + (16 * wave + i) * SP + cc * 2) = pk;
                if (isC) *(u32x2*)(CC + (t0 + 16 * wave + i) * 256 + g * 128 + cc) = pk; }
            if (!isC) {
#pragma unroll
                for (int e = 0; e < 4; ++e)
#pragma unroll
                    for (int qq = 0; qq < 4; ++qq) { const u32x2 pk = {(unsigned)ov[4 * qq][e] | ((unsigned)ov[4 * qq + 1][e] << 16), (unsigned)ov[4 * qq + 2][e] | ((unsigned)ov[4 * qq + 3][e] << 16)};
                        *(LAS u32x2*)(BT + (cc + e) * SP + (32 * (wave >> 1) + 8 * qq + 4 * (wave & 1)) * 2) = pk; }
            }
        }
        __syncthreads();
        f32x4 cbt[8];
        {
            bf16x8 cf[4];
#pragma unroll
            for (int ks = 0; ks < 4; ++ks) cf[ks] = *(const LAS bf16x8*)(Cn + (16 * wave + r16) * SP + (32 * ks + 8 * q4) * 2);
#pragma unroll
            for (int sp = 0; sp < 8; sp += 2) {
                bf16x8 bfr[2][4];
#pragma unroll
                for (int u = 0; u < 2; ++u)
#pragma unroll
                    for (int ks = 0; ks < 4; ++ks) bfr[u][ks] = *(const LAS bf16x8*)(Bn + (16 * (sp + u) + r16) * SP + (32 * ks + 8 * q4) * 2);
                __builtin_amdgcn_sched_barrier(0);
#pragma unroll
                for (int u = 0; u < 2; ++u) { cbt[sp + u] = (f32x4){0.f, 0.f, 0.f, 0.f};
#pragma unroll
                    for (int ks = 0; ks < 4; ++ks) cbt[sp + u] = __builtin_amdgcn_mfma_f32_16x16x32_bf16(bfr[u][ks], cf[ks], cbt[sp + u], 0, 0, 0); }
                __builtin_amdgcn_sched_barrier(0); }
        }
        __syncthreads();
        const int lq = 16 * wave + r16;
        float wtn[6];
        unsigned short xnx[19];
#define SSD_LOADX(hh) do { _Pragma("unroll") for (int _i = 0; _i < 19; ++_i) { const int _tk = 16 * wave + _i - 3; xnx[_i] = (128 * c + _tk) >= 0 ? __builtin_nontemporal_load(xbcpre + (t0 + _tk) * 1536 + (hh) * 64 + lane) : (unsigned short)0; }  { const int _c = (hh) * 64 + lane; wtn[0] = a.ssd_conv_w[_c]; wtn[1] = a.ssd_conv_w[1536 + _c]; wtn[2] = a.ssd_conv_w[2 * 1536 + _c]; wtn[3] = a.ssd_conv_w[3 * 1536 + _c]; wtn[4] = a.ssd_conv_b[_c]; wtn[5] = a.ssd_d[hh]; } } while (0)
        SSD_LOADX(g * 8);
        for (int r = 0; r < 8; ++r) {
            const int hd = g * 8 + r; const float dd = wtn[5];
            {
                const float w0 = wtn[0], w1 = wtn[1], w2 = wtn[2], w3 = wtn[3], bs = wtn[4];
                float xin[19];
#pragma unroll
                for (int i = 0; i < 19; ++i) xin[i] = bf2f(xnx[i]);
                if (r + 1 < 8) SSD_LOADX(hd + 1);
                const float aclast = acL[r * 128 + 127];
                unsigned short xd[16], xe[16];
#pragma unroll
                for (int i = 0; i < 16; ++i) { const float xv = siluf(bs + w0 * xin[i] + w1 * xin[i + 1] + w2 * xin[i + 2] + w3 * xin[i + 3]); const int tk = 16 * wave + i;
                    const float xdv = xv * dtL[r * 128 + tk]; xd[i] = (unsigned short)f2bf(xdv); xe[i] = (unsigned short)f2bf(xdv * __expf(aclast - acL[r * 128 + tk])); }
#pragma unroll
                for (int qq = 0; qq < 4; ++qq) { const int pos = 32 * (wave >> 1) + 8 * qq + 4 * (wave & 1);
                    *(LAS u32x2*)(xdT + lane * SP + pos * 2) = (u32x2){(unsigned)xd[4 * qq] | ((unsigned)xd[4 * qq + 1] << 16), (unsigned)xd[4 * qq + 2] | ((unsigned)xd[4 * qq + 3] << 16)};
                    *(LAS u32x2*)(xeT + lane * SP + pos * 2) = (u32x2){(unsigned)xe[4 * qq] | ((unsigned)xe[4 * qq + 1] << 16), (unsigned)xe[4 * qq + 2] | ((unsigned)xe[4 * qq + 3] << 16)}; }
            }
            __syncthreads();
            {
                const float acl = acL[r * 128 + lq], ddt = dd * __builtin_amdgcn_rcpf(dtL[r * 128 + lq]);
                f32x4 yd[4];
#pragma unroll
                for (int pt = 0; pt < 4; ++pt) yd[pt] = (f32x4){0.f, 0.f, 0.f, 0.f};
#pragma unroll
                for (int ks = 0; ks < 4; ++ks) { if (ks <= (wave >> 1)) {
                    bf16x8 xfd[4];
#pragma unroll
                    for (int pt = 0; pt < 4; ++pt) xfd[pt] = *(const LAS bf16x8*)(xdT + (16 * pt + r16) * SP + (32 * ks + 8 * q4) * 2);
                    __builtin_amdgcn_sched_barrier(0);
                    f32x4 mlo, mhi;
#pragma unroll
                    for (int e = 0; e < 4; ++e) {
                        const int s0 = 32 * ks + 4 * q4 + e, s1 = s0 + 16;
                        const float v0 = cbt[2 * ks][e], v1 = cbt[2 * ks + 1][e];
                        mlo[e] = s0 < lq ? v0 * __expf(acl - acL[r * 128 + s0]) : (s0 == lq ? v0 + ddt : 0.f);
                        mhi[e] = s1 < lq ? v1 * __expf(acl - acL[r * 128 + s1]) : (s1 == lq ? v1 + ddt : 0.f);
                    }
                    const bf16x8 mf = acc_to_frag(mlo, mhi);
#pragma unroll
                    for (int pt = 0; pt < 4; ++pt) yd[pt] = __builtin_amdgcn_mfma_f32_16x16x32_bf16(xfd[pt], mf, yd[pt], 0, 0, 0);
                } }
#pragma unroll
                for (int pt = 0; pt < 4; ++pt) *(u32x2*)(ydiag + (t0 + lq) * 1024 + hd * 64 + 16 * pt + 4 * q4) = (u32x2){pg8::cvt_pk_bf16(yd[pt][0], yd[pt][1]), pg8::cvt_pk_bf16(yd[pt][2], yd[pt][3])};
            }
            {
                bf16x8 bf[4];
#pragma unroll
                for (int ks = 0; ks < 4; ++ks) bf[ks] = *(const LAS bf16x8*)(BT + (16 * wave + r16) * SP + (32 * ks + 8 * q4) * 2);
                bf16_t* hp = states + ((size_t)(unit * 8 + r) * 64) * 128;
                bf16x8 xfe[4][4];
#pragma unroll
                for (int pt = 0; pt < 4; ++pt)
#pragma unroll
                    for (int ks = 0; ks < 4; ++ks) xfe[pt][ks] = *(const LAS bf16x8*)(xeT + (16 * pt + r16) * SP + (32 * ks + 8 * q4) * 2);
                __builtin_amdgcn_sched_barrier(0);
#pragma unroll
                for (int pt = 0; pt < 4; ++pt) { f32x4 st = {0.f, 0.f, 0.f, 0.f};
#pragma unroll
                    for (int ks = 0; ks < 4; ++ks) st = __builtin_amdgcn_mfma_f32_16x16x32_bf16(bf[ks], xfe[pt][ks], st, 0, 0, 0);
                    *(u32x2*)(hp + (size_t)(16 * pt + r16) * 128 + 16 * wave + 4 * q4) = (u32x2){pg8::cvt_pk_bf16(st[0], st[1]), pg8::cvt_pk_bf16(st[2], st[3])}; }
            }
            __syncthreads();
        }
    }
}
DEV void ph_ssd_scan(const Args& a, const Ctx& X, const int wg0) {
    bf16_t* states = (bf16_t*)(a.ws + WS_STATES); const float* cdec = (const float*)(a.ws + WS_CDEC);
    for (int task = (X.bid - wg0) * NTHR + X.tid; task < NB * 16 * 64 * 32; task += (X.G - wg0) * NTHR) {
        const int n4 = task & 31, p = (task >> 5) & 63, hd = (task >> 11) & 15, b = task >> 15;
        bf16_t* base = states + ((size_t)(((b * 32) * 2 + (hd >> 3)) * 8 + (hd & 7)) * 64 + p) * 128 + 4 * n4;
        const float* dbase = cdec + (size_t)((b * 32) * 2 + (hd >> 3)) * 32 + (hd & 7);
        u32x2 sv[32]; float dec[32];
#pragma unroll
        for (int c = 0; c < 32; ++c) { sv[c] = __builtin_nontemporal_load((const u32x2*)(base + (size_t)c * 131072)); dec[c] = dbase[c * 64]; }
        float h0 = 0.f, h1 = 0.f, h2 = 0.f, h3 = 0.f;
#pragma unroll
        for (int c = 0; c < 32; ++c) {
            *(u32x2*)(base + (size_t)c * 131072) = (u32x2){pk2(h0, h1), pk2(h2, h3)};
            h0 = h0 * dec[c] + __uint_as_float(sv[c].x << 16); h1 = h1 * dec[c] + __uint_as_float(sv[c].x & 0xFFFF0000u); h2 = h2 * dec[c] + __uint_as_float(sv[c].y << 16); h3 = h3 * dec[c] + __uint_as_float(sv[c].y & 0xFFFF0000u);
        }
    }
}
DEV void ph_ssd_out(const Args& a, const Ctx& X, const int wg0, const int rot) {
    const bf16_t* CC = (const bf16_t*)(a.ws + WS_CC); const float* acum = (const float*)(a.ws + WS_ACUM); const bf16_t* ydiag = (const bf16_t*)(a.ws + WS_YDIAG);
    const bf16_t* states = (const bf16_t*)(a.ws + WS_STATES); const bf16_t* zb = (const bf16_t*)(a.ws + WS_ZB); bf16_t* oy = (bf16_t*)(a.ws + WS_OY);
    const int lane = X.lane, wave = X.wave, r16 = lane & 15, q4 = lane >> 4;
    LAS float* NWS = (LAS float*)(X.lds + 131072);
    for (int i = X.tid; i < 1024; i += NTHR) NWS[i] = a.ssd_norm_w[i];
    __syncthreads();
    for (int unit = (X.bid - wg0 + rot) % (X.G - wg0); unit < NB * 32 * 2; unit += X.G - wg0) {
        const int g = unit & 1, c = (unit >> 1) & 31, b = unit >> 6; const size_t t = (size_t)b * SEQ + 128 * c + 16 * wave + r16;
        bf16x8 cf[4];
#pragma unroll
        for (int ks = 0; ks < 4; ++ks) cf[ks] = *(const bf16x8*)(CC + t * 256 + g * 128 + 32 * ks + 8 * q4);
        float ss = 0.f;
        LAS u32x2* stash = (LAS u32x2*)(X.lds + wave * 16384);
#define SO_LOAD(rr, HF, YD, ZZ, EA) do { const bf16_t* hp_ = states + ((size_t)(unit * 8 + (rr)) * 64) * 128; const int hd_ = g * 8 + (rr); \
            EA = acum[((size_t)g * T + t) * 8 + (rr)]; \
            _Pragma("unroll") for (int pt = 0; pt < 4; ++pt) { _Pragma("unroll") for (int ks = 0; ks < 4; ++ks) HF[pt][ks] = *(const bf16x8*)(hp_ + (size_t)(16 * pt + r16) * 128 + 32 * ks + 8 * q4); \
                YD[pt] = *(const u32x2*)(ydiag + t * 1024 + hd_ * 64 + 16 * pt + 4 * q4); ZZ[pt] = *(const u32x2*)(zb + t * 1024 + hd_ * 64 + 16 * pt + 4 * q4); } } while (0)
#define SO_COMP(rr, HF, YD, ZZ, EA) do { const float eac = __expf(EA); \
            _Pragma("unroll") for (int pt = 0; pt < 4; ++pt) { f32x4 acc = {0.f, 0.f, 0.f, 0.f}; \
                _Pragma("unroll") for (int ks = 0; ks < 4; ++ks) acc = __builtin_amdgcn_mfma_f32_16x16x32_bf16(HF[pt][ks], cf[ks], acc, 0, 0, 0); \
                const u32x2 yd = YD[pt], zz = ZZ[pt]; \
                f32x4 v; v[0] = acc[0] * eac + __uint_as_float(yd.x << 16); v[1] = acc[1] * eac + __uint_as_float(yd.x & 0xFFFF0000u); v[2] = acc[2] * eac + __uint_as_float(yd.y << 16); v[3] = acc[3] * eac + __uint_as_float(yd.y & 0xFFFF0000u); \
                v[0] *= siluf(__uint_as_float(zz.x << 16)); v[1] *= siluf(__uint_as_float(zz.x & 0xFFFF0000u)); v[2] *= siluf(__uint_as_float(zz.y << 16)); v[3] *= siluf(__uint_as_float(zz.y & 0xFFFF0000u)); \
                ss += v[0] * v[0] + v[1] * v[1] + v[2] * v[2] + v[3] * v[3]; \
                stash[((rr) * 4 + pt) * 64 + lane] = (u32x2){pg8::cvt_pk_bf16(v[0], v[1]), pg8::cvt_pk_bf16(v[2], v[3])}; } } while (0)
        bf16x8 hfA[4][4], hfB[4][4]; u32x2 ydA[4], zzA[4], ydB[4], zzB[4]; float eaA, eaB;
        SO_LOAD(0, hfA, ydA, zzA, eaA);
        for (int r = 0; r < 8; r += 2) {
            SO_LOAD(r + 1, hfB, ydB, zzB, eaB);
            SO_COMP(r, hfA, ydA, zzA, eaA);
            if (r + 2 < 8) SO_LOAD(r + 2, hfA, ydA, zzA, eaA);
            SO_COMP(r + 1, hfB, ydB, zzB, eaB);
        }
#undef SO_LOAD
#undef SO_COMP
        ss += __shfl_xor(ss, 16); ss += __shfl_xor(ss, 32);
        const float rstd = rsqrtf(ss * (1.f / 512.f) + EPS);
#pragma unroll 1
        for (int r = 0; r < 8; ++r)
#pragma unroll
            for (int pt = 0; pt < 4; ++pt) { const int cix = g * 512 + r * 64 + 16 * pt + 4 * q4; const f32x4 nw = *(const LAS f32x4*)(NWS + cix); const u32x2 w = stash[(r * 4 + pt) * 64 + lane];
                *(u32x2*)(oy + t * 2048 + 1024 + cix) = (u32x2){pg8::cvt_pk_bf16(__uint_as_float(w.x << 16) * rstd * nw[0], __uint_as_float(w.x & 0xFFFF0000u) * rstd * nw[1]), pg8::cvt_pk_bf16(__uint_as_float(w.y << 16) * rstd * nw[2], __uint_as_float(w.y & 0xFFFF0000u) * rstd * nw[3])}; }
    }
}


DEV int att_key(int tl) { return (tl ^ (tl >> 4)) & 15; }
template <bool PAIR, bool FIRST>
DEV void att_task(const bf16_t* qkv, LAS unsigned char* vl, LAS unsigned char* kl, LAS unsigned char* OL, LAS float* LSEL, const int b, const int hd, const int d, const int r, const int I0, const int tok_base) {
    int lane; asm volatile("v_mbcnt_lo_u32_b32 %0, -1, 0\n\tv_mbcnt_hi_u32_b32 %0, -1, %0" : "=v"(lane));
    const int q = lane & 31, h5 = lane >> 5;
    const int tr_off = ((lane & 15) >> 2) * 192 + (16 * ((lane >> 4) & 1) + 4 * (lane & 3)) * 2;
    const int prow = lane >> 3, pch = lane & 7;
#define ATT_LOAD(dst, j0_, coff) do { _Pragma("unroll") for (int _i = 0; _i < 4; ++_i) { const size_t _t = (size_t)b * SEQ + (size_t)((j0_) + 8 * _i + prow) * d + r; \
        dst[_i] = *(const u32x4*)(qkv + _t * 3072 + (coff) + hd * 64 + pch * 8); } } while (0)
    u32x4 k0[4], v0[4], k1[4], v1[4];
    const bool e4 = I0 >= 0, e3 = (I0 - 32) >= 0, e2 = (I0 - 64) >= 0, e1 = (I0 - 96) >= 0, e0 = (I0 - 128) >= 0;
    bf16x8 qA[4], qB[4];
    if constexpr (PAIR) {
        ATT_LOAD(k0, I0, 0);
#pragma unroll
        for (int i = 0; i < 4; ++i) *(LAS u32x4*)(kl + (8 * i + prow) * 144 + pch * 16) = k0[i];
#pragma unroll
        for (int s = 0; s < 4; ++s) qA[s] = *(const LAS bf16x8*)(kl + q * 144 + (16 * s + 8 * h5) * 2);
        LDS_WAIT();
    }
    ATT_LOAD(k1, I0 + 32, 0);
#pragma unroll
    for (int i = 0; i < 4; ++i) *(LAS u32x4*)(kl + (8 * i + prow) * 144 + pch * 16) = k1[i];
#pragma unroll
    for (int s = 0; s < 4; ++s) qB[s] = *(const LAS bf16x8*)(kl + q * 144 + (16 * s + 8 * h5) * 2);
    LDS_WAIT();
    ATT_LOAD(k0, I0 + 32, 1024); ATT_LOAD(v0, I0 + 32, 2048);
    if (PAIR || e4) { ATT_LOAD(k1, I0, 1024); ATT_LOAD(v1, I0, 2048); }
    f32x16 oA[2], oB[2];
#pragma unroll
    for (int i = 0; i < 16; ++i) { oA[0][i] = 0.f; oA[1][i] = 0.f; oB[0][i] = 0.f; oB[1][i] = 0.f; }
    float mA = -1e30f, lA = 0.f, mB = -1e30f, lB = 0.f;
    auto scores = [&](const bf16x8 (&kf)[4], const bf16x8 (&qf)[4], f32x16 (&oacc)[2], float& m, float& l, const int mode, bf16x8 (&pf)[2]) {
        f32x16 sacc;
#pragma unroll
        for (int i = 0; i < 16; ++i) sacc[i] = 0.f;
#pragma unroll
        for (int s = 0; s < 4; ++s) sacc = __builtin_amdgcn_mfma_f32_32x32x16_bf16(kf[s], qf[s], sacc, 0, 0, 0);
        if (mode == 1) {
#pragma unroll
            for (int i = 0; i < 16; ++i) { const int kl_ = (i & 3) + 8 * (i >> 2) + 4 * h5; if (kl_ > q) sacc[i] = -1e30f; }
        } else if (mode == 2) {
#pragma unroll
            for (int i = 0; i < 16; ++i) { const int kl_ = (i & 3) + 8 * (i >> 2) + 4 * h5; if (kl_ < q) sacc[i] = -1e30f; }
        }
        float mx = sacc[0];
#pragma unroll
        for (int i = 1; i < 16; ++i) mx = fmaxf(mx, sacc[i]);
        mx = fmaxf(mx, __shfl_xor(mx, 32));
        const bool up = mx > m + 8.f;
        if (__builtin_amdgcn_ballot_w64(up) != 0ull) {
            const float mn = up ? mx : m, alpha = __builtin_amdgcn_exp2f(m - mn);
            l *= alpha; m = mn;
#pragma unroll
            for (int i = 0; i < 16; ++i) { oacc[0][i] *= alpha; oacc[1][i] *= alpha; }
        }
        float rs = 0.f;
#pragma unroll
        for (int i = 0; i < 16; ++i) { sacc[i] = __builtin_amdgcn_exp2f(sacc[i] - m); rs += sacc[i]; }
        rs += __shfl_xor(rs, 32);
        l += rs;
#pragma unroll
        for (int s = 0; s < 2; ++s) { u32x4 w; w.x = pg8::cvt_pk_bf16(sacc[8 * s], sacc[8 * s + 1]); w.y = pg8::cvt_pk_bf16(sacc[8 * s + 2], sacc[8 * s + 3]); w.z = pg8::cvt_pk_bf16(sacc[8 * s + 4], sacc[8 * s + 5]); w.w = pg8::cvt_pk_bf16(sacc[8 * s + 6], sacc[8 * s + 7]);
            pf[s] = __builtin_bit_cast(bf16x8, w); }
    };
    auto tile = [&](const u32x4 (&kp)[4], const u32x4 (&vp)[4], const int ma, const int mb) {
#pragma unroll
        for (int i = 0; i < 4; ++i) { *(LAS u32x4*)(kl + (8 * i + prow) * 144 + pch * 16) = kp[i]; *(LAS u32x4*)(vl + (8 * i + prow) * 192 + pch * 16) = vp[i]; }
        bf16x8 kf[4];
#pragma unroll
        for (int s = 0; s < 4; ++s) kf[s] = *(const LAS bf16x8*)(kl + q * 144 + (16 * s + 8 * h5) * 2);
        bf16x8 pA[2], pB[2];
        if (ma >= 0) scores(kf, qA, oA, mA, lA, ma, pA);
        if (mb >= 0) scores(kf, qB, oB, mB, lB, mb, pB);
#pragma unroll
        for (int dt = 0; dt < 2; ++dt)
#pragma unroll
            for (int s = 0; s < 2; ++s) {
                const s16x4 t0_ = __builtin_amdgcn_ds_read_tr16_b64_v4i16((LAS s16x4*)(vl + (16 * s + 4 * h5) * 192 + dt * 64 + tr_off));
                const s16x4 t1_ = __builtin_amdgcn_ds_read_tr16_b64_v4i16((LAS s16x4*)(vl + (16 * s + 8 + 4 * h5) * 192 + dt * 64 + tr_off));
                bf16x8 vf; vf[0] = t0_[0]; vf[1] = t0_[1]; vf[2] = t0_[2]; vf[3] = t0_[3]; vf[4] = t1_[0]; vf[5] = t1_[1]; vf[6] = t1_[2]; vf[7] = t1_[3];
                if (ma >= 0) oA[dt] = __builtin_amdgcn_mfma_f32_32x32x16_bf16(vf, pA[s], oA[dt], 0, 0, 0);
                if (mb >= 0) oB[dt] = __builtin_amdgcn_mfma_f32_32x32x16_bf16(vf, pB[s], oB[dt], 0, 0, 0);
            }
        LDS_WAIT();
    };
    constexpr int MA_C = PAIR ? 1 : -1, MA_F = PAIR ? 0 : -1;
    tile(k0, v0, -1, 1);
    if (PAIR || e4) {
        if (e3) { ATT_LOAD(k0, I0 - 32, 1024); ATT_LOAD(v0, I0 - 32, 2048); }
        tile(k1, v1, MA_C, 0);
        if (e3) {
            if (e2) { ATT_LOAD(k1, I0 - 64, 1024); ATT_LOAD(v1, I0 - 64, 2048); }
            tile(k0, v0, MA_F, 0);
            if (e2) {
                if (e1) { ATT_LOAD(k0, I0 - 96, 1024); ATT_LOAD(v0, I0 - 96, 2048); }
                tile(k1, v1, MA_F, 0);
                if (e1) {
                    if (PAIR && e0) { ATT_LOAD(k1, I0 - 128, 1024); ATT_LOAD(v1, I0 - 128, 2048); }
                    tile(k0, v0, MA_F, 2);
                    if constexpr (PAIR) { if (e0) tile(k1, v1, 2, -1); }
                }
            }
        }
    }
#undef ATT_LOAD
#pragma unroll
    for (int qt = PAIR ? 0 : 1; qt < 2; ++qt) {
        int tl = (I0 + 32 * qt + q) * d + r - tok_base; asm volatile("" : "+v"(tl));
        const int key = att_key(tl);
        const float l = qt ? lB : lA, m = qt ? mB : mA; const float lse = m + __builtin_amdgcn_logf(l);
        float wo = 0.f, wn = __builtin_amdgcn_rcpf(l);
        if constexpr (!FIRST) { const float lo = LSEL[tl], mx = fmaxf(lo, lse), a0 = __builtin_amdgcn_exp2f(lo - mx), a1 = __builtin_amdgcn_exp2f(lse - mx), wi = __builtin_amdgcn_rcpf(a0 + a1); wo = a0 * wi; wn *= a1 * wi;
            if (h5 == 0) LSEL[tl] = mx + __builtin_amdgcn_logf(a0 + a1); }
        else { if (h5 == 0) LSEL[tl] = lse; }
#pragma unroll
        for (int dt = 0; dt < 2; ++dt)
#pragma unroll
            for (int gq = 0; gq < 4; ++gq) { const f32x16& oo = qt ? oB[dt] : oA[dt];
                LAS u32x2* p = (LAS u32x2*)(OL + tl * 128 + (((8 * dt + 2 * gq + h5) ^ key) << 3));
                float f0 = oo[4 * gq] * wn, f1 = oo[4 * gq + 1] * wn, f2 = oo[4 * gq + 2] * wn, f3 = oo[4 * gq + 3] * wn;
                if constexpr (!FIRST) { const u32x2 w = *p; f0 += wo * __uint_as_float(w.x << 16); f1 += wo * __uint_as_float(w.x & 0xFFFF0000u); f2 += wo * __uint_as_float(w.y << 16); f3 += wo * __uint_as_float(w.y & 0xFFFF0000u); }
                *p = (u32x2){pg8::cvt_pk_bf16(f0, f1), pg8::cvt_pk_bf16(f2, f3)}; }
    }
}
DEV void ph_attn(const Args& a, const Ctx& X) {
    const bf16_t* qkv = (const bf16_t*)(a.ws + WS_Q1KV); unsigned char* o = a.ws + WS_O1;
    LAS unsigned char* vl = X.lds + X.wave * 10752;
    LAS unsigned char* kl = vl + 6144;
    LAS unsigned char* OL = X.lds + 86016; LAS float* LSEL = (LAS float*)(X.lds + 86016 + 65536);
    const int wave = X.wave;
    for (int unit = X.bid; unit < NB * 16 * 8; unit += X.G) {
        const int bhd = unit & 63, b = bhd >> 4, hd = bhd & 15, g = unit >> 6;
        const int tb = 512 * g;
        att_task<true, true>(qkv, vl, kl, OL, LSEL, b, hd, 1, 0, 512 * g + 64 * wave, tb);
        __syncthreads();
        att_task<true, false>(qkv, vl, kl, OL, LSEL, b, hd, 4, wave & 3, 128 * g + 64 * (wave >> 2), tb);
        __syncthreads();
        for (int j = 0; j < 2; ++j) att_task<false, false>(qkv, vl, kl, OL, LSEL, b, hd, 16, 2 * wave + j, 32 * g - 32, tb);
        __syncthreads();
        {
            int tl; asm volatile("v_mbcnt_lo_u32_b32 %0, -1, 0\n\tv_mbcnt_hi_u32_b32 %0, -1, %0" : "=v"(tl)); tl += 64 * wave; const int key = att_key(tl); u32x4 yq[4];
#pragma unroll
            for (int p = 0; p < 16; p += 2) { const u32x2 w0 = *(const LAS u32x2*)(OL + tl * 128 + ((p ^ key) << 3)), w1 = *(const LAS u32x2*)(OL + tl * 128 + (((p + 1) ^ key) << 3));
                float f[8] = {__uint_as_float(w0.x << 16), __uint_as_float(w0.x & 0xFFFF0000u), __uint_as_float(w0.y << 16), __uint_as_float(w0.y & 0xFFFF0000u), __uint_as_float(w1.x << 16), __uint_as_float(w1.x & 0xFFFF0000u), __uint_as_float(w1.y << 16), __uint_as_float(w1.y & 0xFFFF0000u)};
#pragma unroll
                for (int e = 0; e < 8; ++e) f[e] = __builtin_amdgcn_fmed3f(f[e] * 4.f, -440.f, 440.f);
                int v0 = __builtin_amdgcn_cvt_pk_fp8_f32(f[0], f[1], 0, false); v0 = __builtin_amdgcn_cvt_pk_fp8_f32(f[2], f[3], v0, true);
                int v1 = __builtin_amdgcn_cvt_pk_fp8_f32(f[4], f[5], 0, false); v1 = __builtin_amdgcn_cvt_pk_fp8_f32(f[6], f[7], v1, true);
                yq[p >> 2][p & 2] = (unsigned)v0; yq[p >> 2][(p & 2) + 1] = (unsigned)v1; }
            unsigned char* orow = o + ((size_t)b * SEQ + tb + tl) * 1024 + hd * 64;
#pragma unroll
            for (int j = 0; j < 4; ++j) *(u32x4*)(orow + 16 * j) = yq[j];
        }
        __syncthreads();
    }
}

DEV void ph_router(const Args& a, const Ctx& X, const int l) {
    unsigned char* ws = a.ws;
    const float* mod = (const float*)(ws + WS_MOD) + (size_t)l * NB * 6 * D;
    const bf16_t* ymix = (const bf16_t*)(ws + WS_YMIX);
    bf16_t* xb = (bf16_t*)(ws + WS_XB);
    bf16_t* hb = (bf16_t*)(ws + WS_H);
    int* idx = (int*)(ws + WS_IDX); float* gw = (float*)(ws + WS_GW); int* aslot = (int*)(ws + WS_ASLOT); int* ltok = (int*)(ws + WS_LTOK);
    int* cntg = (int*)(ws + WS_CTL + CTL_CNT) + l * NE;
    const float* rw = a.router_w + (size_t)l * D * NE; const float* rbias = a.router_bias + l * NE;
    constexpr int HP = 2064;
    LAS unsigned char* hL = X.lds;
    LAS float* logit = (LAS float*)(X.lds + AUX_OFF + 2048);
    LAS int* lcnt = (LAS int*)(X.lds + AUX_OFF + 2048 + 64 * 65 * 4);
    LAS int* lbase = lcnt + 64;
    LAS int* sel_e = lbase + 64;
    LAS int* sel_s = sel_e + 512;
    const int lane = X.lane, wave = X.wave;
    for (int rb = X.bid; rb < T / 64; rb += X.G) {
        if (X.tid < 64) lcnt[X.tid] = 0;
        f32x4 xf_n[4]; u32x2 xb_n[4], ym_n[4];
#define RT_LOAD(rr) do { const int _row = rb * 64 + wave * 8 + (rr); _Pragma("unroll") for (int _j = 0; _j < 4; ++_j) { \
            if (l == 0) xf_n[_j] = *(const f32x4*)(a.x + (size_t)_row * D + _j * 256 + lane * 4); else xb_n[_j] = *(const u32x2*)(xb + (size_t)_row * D + _j * 256 + lane * 4); \
            ym_n[_j] = __builtin_nontemporal_load((const u32x2*)(ymix + (size_t)_row * D + _j * 256 + lane * 4)); } } while (0)
        RT_LOAD(0);
        float cg[16], pg[16], ps[16];
        { const float* ml = mod + (size_t)((rb * 64) / SEQ) * 6 * D;
#pragma unroll
          for (int j = 0; j < 4; ++j) { const int c0 = j * 256 + lane * 4;
              const f32x4 g = *(const f32x4*)(a.mix_post_g + l * D + c0), t = *(const f32x4*)(ml + 2 * D + c0), gp = *(const f32x4*)(a.ffn_pre_g + l * D + c0), sc = *(const f32x4*)(ml + 4 * D + c0), sh = *(const f32x4*)(ml + 3 * D + c0);
#pragma unroll
              for (int i = 0; i < 4; ++i) { cg[4 * j + i] = g[i] * t[i]; pg[4 * j + i] = gp[i] * (1.f + sc[i]); ps[4 * j + i] = sh[i]; } } }
        for (int r8 = 0; r8 < 8; ++r8) {
            const int lr = wave * 8 + r8, row = rb * 64 + lr;
            float xv[16], yv[16];
#pragma unroll
            for (int j = 0; j < 4; ++j) {
                if (l == 0) { xv[4 * j] = xf_n[j][0]; xv[4 * j + 1] = xf_n[j][1]; xv[4 * j + 2] = xf_n[j][2]; xv[4 * j + 3] = xf_n[j][3]; }
                else { xv[4 * j] = __uint_as_float(xb_n[j].x << 16); xv[4 * j + 1] = __uint_as_float(xb_n[j].x & 0xFFFF0000u); xv[4 * j + 2] = __uint_as_float(xb_n[j].y << 16); xv[4 * j + 3] = __uint_as_float(xb_n[j].y & 0xFFFF0000u); }
                yv[4 * j] = __uint_as_float(ym_n[j].x << 16); yv[4 * j + 1] = __uint_as_float(ym_n[j].x & 0xFFFF0000u); yv[4 * j + 2] = __uint_as_float(ym_n[j].y << 16); yv[4 * j + 3] = __uint_as_float(ym_n[j].y & 0xFFFF0000u); }
            if (r8 + 1 < 8) RT_LOAD(r8 + 1);
            { const float r = row_rstd(yv);
#pragma unroll
              for (int i = 0; i < 16; ++i) xv[i] += (yv[i] * r) * cg[i]; }
            store_row_bf(xb + (size_t)row * D, lane, xv);
            u32x2 o[4];
            { const float r = row_rstd(xv);
#pragma unroll
              for (int j = 0; j < 4; ++j) { float h[4];
#pragma unroll
                  for (int i = 0; i < 4; ++i) h[i] = (xv[4 * j + i] * r) * pg[4 * j + i] + ps[4 * j + i];
                  o[j] = (u32x2){pk2(h[0], h[1]), pk2(h[2], h[3])}; } }
#pragma unroll
            for (int j = 0; j < 4; ++j) { *(LAS u32x2*)(hL + lr * HP + (j * 256 + lane * 4) * 2) = o[j];
                const float h0 = __uint_as_float(o[j].x << 16), h1 = __uint_as_float(o[j].x & 0xFFFF0000u), h2 = __uint_as_float(o[j].y << 16), h3 = __uint_as_float(o[j].y & 0xFFFF0000u);
                int w = __builtin_amdgcn_cvt_pk_fp8_f32(__builtin_amdgcn_fmed3f(h0, -440.f, 440.f), __builtin_amdgcn_fmed3f(h1, -440.f, 440.f), 0, false); w = __builtin_amdgcn_cvt_pk_fp8_f32(__builtin_amdgcn_fmed3f(h2, -440.f, 440.f), __builtin_amdgcn_fmed3f(h3, -440.f, 440.f), w, true);
                *(unsigned*)((unsigned char*)hb + (size_t)row * D + j * 256 + lane * 4) = (unsigned)w; }
        }
#undef RT_LOAD
        __syncthreads();
        { const int rt = wave & 3, nh = wave >> 2, r16 = lane & 15, kq = lane >> 4;
          f32x4 acc0 = {0.f, 0.f, 0.f, 0.f}, acc1 = {0.f, 0.f, 0.f, 0.f};
#define RL_LOAD(cc, HV, BV) do { HV = *(const LAS u32x4*)(hL + (rt * 16 + r16) * HP + (32 * (cc) + 8 * kq) * 2); const float* rp_ = rw + (size_t)(32 * (cc) + 8 * kq) * NE + 4 * r16 + 2 * nh; \
              _Pragma("unroll") for (int j = 0; j < 8; ++j) BV[j] = *(const f32x2*)(rp_ + (size_t)j * NE); } while (0)
#define RL_COMP(HV, BV) do { _Pragma("unroll") for (int j = 0; j < 8; ++j) { const unsigned wj = HV[j >> 1]; const float av = (j & 1) ? __uint_as_float(wj & 0xFFFF0000u) : __uint_as_float(wj << 16); \
              acc0 = __builtin_amdgcn_mfma_f32_16x16x4f32(av, BV[j].x, acc0, 0, 0, 0); acc1 = __builtin_amdgcn_mfma_f32_16x16x4f32(av, BV[j].y, acc1, 0, 0, 0); } } while (0)
          u32x4 hvA, hvB; f32x2 bvA[8], bvB[8];
          RL_LOAD(0, hvA, bvA);
          for (int c = 0; c < 32; c += 2) {
              RL_LOAD(c + 1, hvB, bvB);
              RL_COMP(hvA, bvA);
              if (c + 2 < 32) RL_LOAD(c + 2, hvA, bvA);
              RL_COMP(hvB, bvB);
          }
#undef RL_LOAD
#undef RL_COMP
#pragma unroll
          for (int r = 0; r < 4; ++r) { logit[(rt * 16 + 4 * kq + r) * 65 + 4 * r16 + 2 * nh] = acc0[r]; logit[(rt * 16 + 4 * kq + r) * 65 + 4 * r16 + 2 * nh + 1] = acc1[r]; } }
        __syncthreads();
        for (int r8 = 0; r8 < 8; ++r8) {
            const int lr = wave * 8 + r8, t = rb * 64 + lr;
            float lgt = logit[lr * 65 + lane]; if (!(lgt > -1e30f && lgt < 1e30f)) lgt = 0.f;
            const float score = sigmoidf_(lgt), biased = score + rbias[lane];
            const float m1 = max8(biased);
            const int c1 = min8((biased == m1) ? (lane & 7) : 8);
            const float m2 = max8(((lane & 7) == c1) ? -INFINITY : biased);
            const float gs = m1 + m2; const int myg = lane >> 3; int grank = 0;
#pragma unroll
            for (int g2 = 0; g2 < 8; ++g2) { const float o = rlf(gs, g2 * 8); grank += (o > gs || (o == gs && g2 < myg)) ? 1 : 0; }
            const float cand = (grank < 4) ? biased : -INFINITY; int rank = 0;
#pragma unroll 8
            for (int e2 = 0; e2 < 64; ++e2) { const float o = rlf(cand, e2); rank += (o > cand || (o == cand && e2 < lane)) ? 1 : 0; }
            const bool sel = (rank < TOPK) && (grank < 4);
            const float ssum = wave_sum(sel ? score : 0.f);
            if (sel) { idx[t * 8 + rank] = lane; gw[t * 8 + rank] = score * __builtin_amdgcn_rcpf(ssum) * 2.5f; sel_e[lr * 8 + rank] = lane; sel_s[lr * 8 + rank] = __hip_atomic_fetch_add(lcnt + lane, 1, __ATOMIC_RELAXED, __HIP_MEMORY_SCOPE_WORKGROUP); }
        }
        __syncthreads();
        if (X.tid < 64) { const int n = lcnt[X.tid]; lbase[X.tid] = n ? atomicAdd(cntg + X.tid, n) : 0; }
        __syncthreads();
        { const int lr = X.tid >> 3, k = X.tid & 7, t = rb * 64 + lr, e = sel_e[lr * 8 + k], sl = lbase[e] + sel_s[lr * 8 + k];
          aslot[t * 8 + k] = sl; ltok[e * CAP + sl] = t; }
        __syncthreads();
    }
}
template <int NW>
DEV void ph_moe_conv(const Args& a, const Ctx& X, const int l, const int widx, const int nwg, const int it0, const int it1) {
    unsigned char* ws = a.ws;
    if (X.wave >= NW) return;
    LAS float* scr = (LAS float*)(X.lds + X.wave * 8704);
    const int lane = X.lane, quad = lane & 7, r0 = lane >> 3;
    const int gwv = widx * NW + X.wave, NGW = nwg * NW;
    constexpr int I_GU = (D / 64) * (512 / 32), I_D = (ED / 64) * (D / 32), I_E = I_GU + I_D;
    const float* eg = a.exp_gate + (size_t)l * NE * D * ED; const float* eu = a.exp_up + (size_t)l * NE * D * ED; const float* ed = a.exp_down + (size_t)l * NE * ED * D;
    const int itend = it1 < 0 ? (NE + 1) * I_E : it1;
    struct It { const float* colp; unsigned char* dst; int ldw, K, k0, n0; float wsc; };
    auto decode = [&](const int it) { It d; const int e = it / I_E, r = it - e * I_E;
        if (r < I_GU) { const int kb = r >> 4, nb = r & 15; d.k0 = 64 * kb; d.n0 = 32 * nb; const int n = d.n0 + 4 * quad, j = n >> 8, rr = n & 255;
            const float* g0 = e < NE ? eg + (size_t)e * D * ED : a.sh_gate + (size_t)l * D * ED; const long du = e < NE ? (long)(eu - eg) : (long)(a.sh_up - a.sh_gate);
            d.colp = g0 + (rr < 128 ? 0l : du) + 128 * j + (rr & 127); d.ldw = ED; d.K = D; d.dst = e < NE ? ws + WS_WGU + (size_t)e * 512 * D : ws + WS_WGUS; d.wsc = 64.f; }
        else { const int r2 = r - I_GU, kb = r2 >> 5, nb = r2 & 31; d.k0 = 64 * kb; d.n0 = 32 * nb;
            const float* d0 = e < NE ? ed + (size_t)e * ED * D : a.sh_down + (size_t)l * ED * D;
            d.colp = d0 + d.n0 + 4 * quad; d.ldw = D; d.K = ED; d.dst = e < NE ? ws + WS_WD + (size_t)e * D * ED : ws + WS_WDS; d.wsc = 32.f; }
        return d; };
    int it = it0 + gwv; if (it >= itend) return;
    It cur = decode(it); f32x4 v[8];
#pragma unroll
    for (int i = 0; i < 8; ++i) v[i] = __builtin_nontemporal_load((const f32x4*)(cur.colp + (size_t)(cur.k0 + r0 + 8 * i) * cur.ldw));
    for (;;) {
        const int nx = it + NGW; const bool more = nx < itend; It nd = cur; f32x4 vn[8];
        if (more) { nd = decode(nx);
#pragma unroll
            for (int i = 0; i < 8; ++i) vn[i] = __builtin_nontemporal_load((const f32x4*)(nd.colp + (size_t)(nd.k0 + r0 + 8 * i) * nd.ldw)); }
#pragma unroll
        for (int i = 0; i < 8; ++i) { LAS float* p = scr + (r0 + 8 * i) * 33 + 4 * quad; p[0] = v[i][0]; p[1] = v[i][1]; p[2] = v[i][2]; p[3] = v[i][3]; }
        LDS_WAIT(); asm volatile("" ::: "memory");
        const int c = lane & 7; const float wscale = cur.wsc;
#pragma unroll
        for (int j = 0; j < 4; ++j) { const int n = (lane >> 3) + 8 * j; const LAS float* sp = scr + (8 * c) * 33 + n;
            int w0 = __builtin_amdgcn_cvt_pk_fp8_f32(sp[0 * 33] * wscale, sp[1 * 33] * wscale, 0, false); w0 = __builtin_amdgcn_cvt_pk_fp8_f32(sp[2 * 33] * wscale, sp[3 * 33] * wscale, w0, true);
            int w1 = __builtin_amdgcn_cvt_pk_fp8_f32(sp[4 * 33] * wscale, sp[5 * 33] * wscale, 0, false); w1 = __builtin_amdgcn_cvt_pk_fp8_f32(sp[6 * 33] * wscale, sp[7 * 33] * wscale, w1, true);
            *(u32x2*)(cur.dst + (size_t)(cur.n0 + n) * cur.K + cur.k0 + 8 * c) = (u32x2){(unsigned)w0, (unsigned)w1}; }
        LDS_WAIT(); asm volatile("" ::: "memory");
        if (!more) break;
        cur = nd; it = nx;
#pragma unroll
        for (int i = 0; i < 8; ++i) v[i] = vn[i];
    }
}

DEV int moe_tables(const Args& a, const Ctx& X, const int l, LAS int* t_cnt, LAS int* t_rb0, LAS int* t_eofrb) {
    const int* cntg = (const int*)(a.ws + WS_CTL + CTL_CNT) + l * NE;
    if (X.wave == 0) {
        const int c = __hip_atomic_load(cntg + X.lane, __ATOMIC_RELAXED, __HIP_MEMORY_SCOPE_AGENT), nrb = (c + 255) >> 8;
        int incl = nrb;
#pragma unroll
        for (int o = 1; o < 64; o <<= 1) { const int v = __shfl_up(incl, o); if (X.lane >= o) incl += v; }
        const int excl = incl - nrb;
        t_cnt[X.lane] = c; t_rb0[X.lane] = excl; if (X.lane == 63) t_rb0[64] = incl;
        for (int j = 0; j < nrb; ++j) t_eofrb[excl + j] = X.lane;
        t_eofrb[SH_RB + X.lane] = NE;
    }
    __syncthreads();
    return t_rb0[64];
}

DEV void ph_moe_gu(const Args& a, const Ctx& X, const int l) {
    LAS int* t_cnt = (LAS int*)(X.lds + AUX_OFF + 1024); LAS int* t_rb0 = t_cnt + 64; LAS int* t_eofrb = t_rb0 + 80; LAS int* toks = t_eofrb + NRB_ALL;
    const int nrbt = moe_tables(a, X, l, t_cnt, t_rb0, t_eofrb);
    const int* ltok = (const int*)(a.ws + WS_LTOK);
    pg8::Unit u;
    for (int i = 0; i < 8; ++i) { if (!pg8::moe_unit(i, 2, nrbt, X.G, X.bid, u)) break;
        if (X.tid < 256) { const int e = t_eofrb[u.pm]; int tok;
            if (e < NE) { const int sl = (u.pm - t_rb0[e]) * 256 + X.tid; tok = sl < t_cnt[e] ? ltok[e * CAP + sl] : 0; } else tok = (u.pm - SH_RB) * 256 + X.tid;
            toks[i * 256 + X.tid] = tok; } }
    VM_WAIT(); __syncthreads();
    pg8::SchedGU S{(const char*)(a.ws + WS_H), (const char*)(a.ws + WS_WGU), (const char*)(a.ws + WS_WGUS), t_eofrb, toks, nrbt, X.G, X.bid, 0};
    pg8::EpiGU E{a.ws + WS_HID};
    pg8::gemm_phase<pg8::EpiGU, pg8::SchedGU, true>(X.lds, D, S, E);
}
DEV void ph_moe_down(const Args& a, const Ctx& X, const int l) {
    LAS int* t_cnt = (LAS int*)(X.lds + AUX_OFF + 1024); LAS int* t_rb0 = t_cnt + 64; LAS int* t_eofrb = t_rb0 + 80;
    const int nrbt = moe_tables(a, X, l, t_cnt, t_rb0, t_eofrb);
    pg8::SchedDown S{(const char*)(a.ws + WS_HID), (const char*)(a.ws + WS_WD), (const char*)(a.ws + WS_WDS), t_eofrb, nrbt, X.G, X.bid, 0};
    pg8::EpiFp8 E{(unsigned char*)(a.ws + WS_Y), D, 0};
    int kd = ED; asm volatile("" : "+s"(kd));
    pg8::gemm_phase<pg8::EpiFp8, pg8::SchedDown, true>(X.lds, kd, S, E);
}
DEV void ph_combine(const Args& a, const Ctx& X, const int l) {
    LAS int* t_cnt = (LAS int*)(X.lds + AUX_OFF + 1024); LAS int* t_rb0 = t_cnt + 64; LAS int* t_eofrb = t_rb0 + 80;
    (void)moe_tables(a, X, l, t_cnt, t_rb0, t_eofrb);
    const float* mod = (const float*)(a.ws + WS_MOD);
    const int* idx = (const int*)(a.ws + WS_IDX); const float* gw = (const float*)(a.ws + WS_GW); const int* aslot = (const int*)(a.ws + WS_ASLOT);
    const unsigned char* y = a.ws + WS_Y; unsigned char* h8 = a.ws + WS_H;
    const int lane = X.lane;
    for (int t8 = (X.bid * NWAVES + X.wave) * 8; t8 < T; t8 += X.G * NWAVES * 8) {
    const int b = t8 / SEQ; const float* ml = mod + (size_t)(l * NB + b) * 6 * D;
    float cg[16], pg[16], ps[16];
#pragma unroll
    for (int j = 0; j < 2; ++j)
#pragma unroll
        for (int hh = 0; hh < 2; ++hh) { const int c0 = 512 * j + 8 * lane + 4 * hh; const f32x4 g = *(const f32x4*)(a.ffn_post_g + l * D + c0), tg = *(const f32x4*)(ml + 5 * D + c0);
#pragma unroll
            for (int i = 0; i < 4; ++i) cg[8 * j + 4 * hh + i] = g[i] * tg[i];
            if (l == 0) { const float* mn = mod + (size_t)(1 * NB + b) * 6 * D; const f32x4 gp = *(const f32x4*)(a.mix_pre_g + D + c0), sc = *(const f32x4*)(mn + D + c0), sh = *(const f32x4*)(mn + c0);
#pragma unroll
                for (int i = 0; i < 4; ++i) { pg[8 * j + 4 * hh + i] = gp[i] * (1.f + sc[i]); ps[8 * j + 4 * hh + i] = sh[i]; } } }
    int e_n = 0, s_n = 0; float g_n = 0.f;
    if (lane < 8) { e_n = idx[t8 * 8 + lane]; g_n = gw[t8 * 8 + lane]; s_n = aslot[t8 * 8 + lane]; }
    for (int t = t8; t < t8 + 8; ++t) {
        const int e_c = e_n, s_c = s_n; const float g_c = g_n;
        const int tn = t + 1;
        if (tn < t8 + 8 && lane < 8) { e_n = idx[tn * 8 + lane]; g_n = gw[tn * 8 + lane]; s_n = aslot[tn * 8 + lane]; }
        u32x2 w0[9], w1[9];
        { const unsigned char* yr = y + ((size_t)SH_RB * 256 + t) * D; w0[8] = *(const u32x2*)(yr + 8 * lane); w1[8] = *(const u32x2*)(yr + 512 + 8 * lane); }
        float gk[8];
#pragma unroll
        for (int k = 0; k < 8; ++k) { const int e = rli(e_c, k), sl = rli(s_c, k); gk[k] = rlf(g_c, k);
            const unsigned char* yr = y + ((size_t)t_rb0[e] * 256 + sl) * D; w0[k] = *(const u32x2*)(yr + 8 * lane); w1[k] = *(const u32x2*)(yr + 512 + 8 * lane); }
        float xv[16]; load_row8_bf((const bf16_t*)(a.ws + WS_XB) + (size_t)t * D, lane, xv);
        float yv[16];
#pragma unroll
        for (int i = 0; i < 16; ++i) yv[i] = 0.f;
        acc_row8(yv, w0[8], w1[8], 0.125f);
#pragma unroll
        for (int k = 0; k < 8; ++k) acc_row8(yv, w0[k], w1[k], gk[k] * 0.125f);
        { const float r = row_rstd(yv);
#pragma unroll
          for (int i = 0; i < 16; ++i) xv[i] += (yv[i] * r) * cg[i]; }
        if (l == 0) store_row8_bf((bf16_t*)(a.ws + WS_XB) + (size_t)t * D, lane, xv); else store_row8(a.out + (size_t)t * D, lane, xv);
        if (l == 0) { u32x2 o[2]; const float r = row_rstd(xv);
#pragma unroll
            for (int j = 0; j < 2; ++j) { float h[8];
#pragma unroll
                for (int i = 0; i < 8; ++i) h[i] = __builtin_amdgcn_fmed3f((xv[8 * j + i] * r) * pg[8 * j + i] + ps[8 * j + i], -440.f, 440.f);
                int w0_ = __builtin_amdgcn_cvt_pk_fp8_f32(h[0], h[1], 0, false); w0_ = __builtin_amdgcn_cvt_pk_fp8_f32(h[2], h[3], w0_, true);
                int w1_ = __builtin_amdgcn_cvt_pk_fp8_f32(h[4], h[5], 0, false); w1_ = __builtin_amdgcn_cvt_pk_fp8_f32(h[6], h[7], w1_, true);
                o[j] = (u32x2){(unsigned)w0_, (unsigned)w1_}; }
            *(u32x2*)(h8 + (size_t)t * D + 8 * lane) = o[0]; *(u32x2*)(h8 + (size_t)t * D + 512 + 8 * lane) = o[1]; }
    }
    }
}

constexpr int NPH = 18;
__global__ void __launch_bounds__(NTHR, 2) mega(Args a) {
    extern __shared__ __attribute__((aligned(16))) unsigned char lds_raw[];
    Ctx X; X.lds = (LAS unsigned char*)lds_raw; X.tid = threadIdx.x; X.lane = X.tid & 63; X.wave = __builtin_amdgcn_readfirstlane(X.tid >> 6); X.G = gridDim.x; X.bid = blockIdx.x;
    if (X.tid < 4) ((LAS unsigned*)(X.lds + BAR_OFF))[X.tid] = 0u;
    __syncthreads();
    XcdBarrier bar; bar.bar = (unsigned*)(a.ws + WS_CTL); bar.x = 0; bar.st = nullptr;
    if (!MK_PER_PHASE) bar = xcd_barrier_post((unsigned*)(a.ws + WS_CTL), (volatile LAS unsigned*)(X.lds + BAR_OFF));
    const int lo = a.ph_lo, hi = a.ph_hi;
#define TIDR() do { int l_; asm volatile("v_mbcnt_lo_u32_b32 %0, -1, 0\n\tv_mbcnt_hi_u32_b32 %0, -1, %0" : "=v"(l_)); X.lane = l_; X.tid = X.wave * 64 + l_; } while (0)
#define IN(k) (lo <= (k) && (k) < hi)
#define REP(k, ...) do { __VA_ARGS__; if constexpr (((PROBE_MASK >> (k)) & 1u) != 0u) { __syncthreads(); __VA_ARGS__; } } while (0)
#define SEAM(k) do { if (IN(k) && IN((k) + 1)) xcd_barrier(bar); else { VM_WAIT(); __syncthreads(); } } while (0)
    unsigned char* ws = a.ws;
    if (IN(0)) { TIDR(); REP(0, ph_setup(a, X)); SEAM(0); }
    if (IN(1)) { TIDR(); REP(1, ph_prenorm0(a, X)); SEAM(1); }
    if constexpr (((PROBE_MASK >> 24) & 1u) != 0u) { for (int i_ = 0; i_ < 16; ++i_) xcd_barrier(bar); }
    if (IN(2)) { TIDR();
        pg8::SchedDense8<0x79797979, 0x7F7F7F7F> S8; S8.so.init(T, NPROJ, X.G, X.bid); S8.A = (const char*)(ws + WS_H8); S8.Bt = (const char*)(ws + WS_WIN8); S8.K = D; S8.pad_ = 0;
        pg8::SchedDense S; S.so.init(T, NPROJ - 3072, X.G, X.bid); S.A = (const char*)(ws + WS_H); S.Bt = (const char*)(ws + WS_WIN); S.K = D; S.pad_ = 12;
        pg8::EpiProj E{(bf16_t*)(ws + WS_QKVPRE), (bf16_t*)(ws + WS_ZA), (bf16_t*)(ws + WS_XBCPRE), (bf16_t*)(ws + WS_ZB), (float*)(ws + WS_SMALL)};
        pg8::gemm_phase<pg8::EpiProj, pg8::SchedDense8<0x79797979, 0x7F7F7F7F>, true>(X.lds, D, S8, E); SEAM(2); }
    if (IN(3)) { TIDR(); REP(3, ph_gdn_local(a, X)); SEAM(3); }
    if (IN(4)) { TIDR();
        if (X.bid < 32) { REP(4, ph_gdn_scan(a, X)); }
        else {
            const int w = X.bid - 32, nw = X.G - 32; unsigned* gctr = (unsigned*)(ws + WS_CTL + CTL_GRP);
            constexpr int CONV_P1 = PROBE_CONVP1;
            REP(20, ph_ssd_local(a, X, 32)); __syncthreads();
            if (w >= 32) { REP(22, ph_moe_conv<2>(a, X, 0, w - 32, nw - 32, 0, CONV_P1)); }
            group_barrier(gctr, (unsigned)nw); __syncthreads();
            ph_ssd_scan(a, X, 32);
            group_barrier(gctr, 2u * (unsigned)nw); __syncthreads();
            REP(5, ph_ssd_out(a, X, 32, nw - 32)); __syncthreads();
            if (w < 32 || w >= 64) { const int wi = w < 32 ? w : w - 32; ph_moe_conv<2>(a, X, 0, wi, nw - 32, CONV_P1, -1); __syncthreads(); REP(23, ph_setup_late(a, X, wi, nw - 32)); }
        }
        SEAM(4); }
    if (IN(6)) { TIDR();
        pg8::SchedDense S; S.so.init(T, D, X.G, X.bid); S.A = (const char*)(ws + WS_OY); S.Bt = (const char*)(ws + WS_WOUT); S.K = 2048; S.pad_ = 0;
        pg8::EpiBf16 E{(bf16_t*)(ws + WS_YMIX), D, 0};
        REP(6, pg8::gemm_phase<pg8::EpiBf16, pg8::SchedDense>(X.lds, 2048, S, E)); SEAM(6); }
    if (IN(7)) { TIDR(); ph_router(a, X, 0); SEAM(7); }
    if (IN(8)) { TIDR(); REP(8, ph_moe_gu(a, X, 0)); SEAM(8); }
    if (IN(9)) { TIDR(); REP(9, ph_moe_down(a, X, 0)); SEAM(9); }
    if (IN(10)) { TIDR(); ph_combine(a, X, 0); SEAM(10); }
    if (IN(11)) { TIDR();
        pg8::SchedDense8<0x79797979, 0x7F7F7F7F> S; S.so.init(T, 3072, X.G, X.bid); S.A = (const char*)(ws + WS_H); S.Bt = (const char*)(ws + WS_WQKV); S.K = D; S.pad_ = 0;
        pg8::EpiQKV E{(bf16_t*)(ws + WS_Q1KV), (const float*)(ws + WS_COS), (const float*)(ws + WS_SIN)};
        REP(11, pg8::gemm_phase<pg8::EpiQKV, pg8::SchedDense8<0x79797979, 0x7F7F7F7F>, true>(X.lds, D, S, E)); SEAM(11); }
    if (IN(12)) { TIDR(); REP(12, ph_attn(a, X)); SEAM(12); }
    if (IN(13)) { TIDR();
        pg8::SchedDense8<0x79797979, 0x7D7D7D7D> S; S.so.init(T, D, X.G, X.bid); S.A = (const char*)(ws + WS_O1); S.Bt = (const char*)(ws + WS_WO); S.K = D; S.pad_ = 0;
        pg8::EpiBf16 E{(bf16_t*)(ws + WS_YMIX), D, 0};
        REP(13, pg8::gemm_phase<pg8::EpiBf16, pg8::SchedDense8<0x79797979, 0x7D7D7D7D>, true>(X.lds, D, S, E)); SEAM(13); }
    if (IN(14)) { TIDR(); ph_router(a, X, 1); REP(14, ph_moe_conv<8>(a, X, 1, X.bid, X.G, 0, -1)); SEAM(14); }
    if (IN(15)) { TIDR(); ph_moe_gu(a, X, 1); SEAM(15); }
    if (IN(16)) { TIDR(); ph_moe_down(a, X, 1); SEAM(16); }
    if (IN(17)) { TIDR(); REP(17, ph_combine(a, X, 1)); }
#undef IN
#undef SEAM
}

extern "C" void kernel_launch(void* const* d_in, const int* in_sizes, int n_in, void* d_out, int out_size, void* d_ws, size_t ws_size, hipStream_t stream) {
    static int grid = 0;
    if (!grid) {
        int dev = 0, cus = 0, per_cu = 0;
        if (hipGetDevice(&dev) != hipSuccess || hipDeviceGetAttribute(&cus, hipDeviceAttributeMultiprocessorCount, dev) != hipSuccess) { fprintf(stderr, "kernel_launch: device query failed\n"); grid = -1; return; }
        if (hipFuncSetAttribute((const void*)mega, hipFuncAttributeMaxDynamicSharedMemorySize, LDS_BYTES) != hipSuccess) { fprintf(stderr, "kernel_launch: hipFuncSetAttribute failed\n"); grid = -1; return; }
        if (hipOccupancyMaxActiveBlocksPerMultiprocessor(&per_cu, (const void*)mega, NTHR, LDS_BYTES) != hipSuccess || per_cu < 1) { fprintf(stderr, "kernel_launch: occupancy query says %d blocks per CU\n", per_cu); grid = -1; return; }
        grid = cus;
        if (grid < 64 || (grid & 7)) { fprintf(stderr, "kernel_launch: unsupported CU count %d\n", cus); grid = -1; return; }
    }
    if (grid < 0) return;
    if (ws_size < WS_END || n_in != 31) { fprintf(stderr, "kernel_launch: workspace %zu < %zu or n_in %d != 31\n", ws_size, (size_t)WS_END, n_in); return; }
    if (hipMemsetAsync((char*)d_ws + WS_CTL, 0, CTL_BYTES, stream) != hipSuccess) { fprintf(stderr, "kernel_launch: memset failed\n"); return; }
    Args a{};
    a.x = (const float*)d_in[0]; a.c = (const float*)d_in[1]; a.pos = (const int*)d_in[2]; a.mod_w = (const float*)d_in[3]; a.mod_b = (const float*)d_in[4];
    a.mix_pre_g = (const float*)d_in[5]; a.mix_post_g = (const float*)d_in[6]; a.ffn_pre_g = (const float*)d_in[7]; a.ffn_post_g = (const float*)d_in[8];
    a.ssm_w_in = (const float*)d_in[9]; a.gdn_conv_w = (const float*)d_in[10]; a.gdn_a_log = (const float*)d_in[11]; a.gdn_dt_bias = (const float*)d_in[12]; a.gdn_norm_w = (const float*)d_in[13];
    a.ssd_conv_w = (const float*)d_in[14]; a.ssd_conv_b = (const float*)d_in[15]; a.ssd_a_log = (const float*)d_in[16]; a.ssd_dt_bias = (const float*)d_in[17]; a.ssd_d = (const float*)d_in[18]; a.ssd_norm_w = (const float*)d_in[19];
    a.ssm_w_out = (const float*)d_in[20]; a.attn_w_qkv = (const float*)d_in[21]; a.attn_w_o = (const float*)d_in[22];
    a.router_w = (const float*)d_in[23]; a.router_bias = (const float*)d_in[24]; a.exp_gate = (const float*)d_in[25]; a.exp_up = (const float*)d_in[26]; a.exp_down = (const float*)d_in[27];
    a.sh_gate = (const float*)d_in[28]; a.sh_up = (const float*)d_in[29]; a.sh_down = (const float*)d_in[30];
    a.out = (float*)d_out; a.ws = (unsigned char*)d_ws;
#if MK_PER_PHASE
    for (int p = 0; p < NPH; ++p) { a.ph_lo = p; a.ph_hi = p + 1; hipLaunchKernelGGL(mega, dim3(grid), dim3(NTHR), LDS_BYTES, stream, a); }
#else
    a.ph_lo = 0; a.ph_hi = NPH;
    hipLaunchKernelGGL(mega, dim3(grid), dim3(NTHR), LDS_BYTES, stream, a);
#endif
}
```
